# Optimizing an MI355X kernel written in HIP

```python
import math
import jax, jax.numpy as jnp
from jax import lax
import numpy as np

D_MODEL = 2048
BATCH = 2
SEQ = 8192
DEPTH = 4

GRID_W = 64
CTX_LEN = 256
HEAD_DIM = 64
GROUP_W = D_MODEL // 4
N_MOD = 9
D_FF = 5632
NORM_EPS = 1e-6
ROPE_BASE = 10000.0
NEG_INF = -1e30
F32 = jnp.float32

NA_HEADS = GROUP_W // HEAD_DIM
NA_WIN_R = 8
NA_WIN_C = 16
NA_QBLOCK = 128
RW_HEADS = GROUP_W // HEAD_DIM
RW_N = HEAD_DIM
RW_DECAY_RANK = 32
RW_ICLR_RANK = 32
RW_GATE_RANK = 96
RW_GN_EPS = 64e-5
WA_HEADS = GROUP_W // HEAD_DIM
WA_KV_HEADS = 2
WA_GROUP = WA_HEADS // WA_KV_HEADS
WA_WINDOW = 128
WA_BLOCK = 128
S5_P = 16
S5_GROUPS = GROUP_W // S5_P
S5_N = 64

IN_SPLITS = (GROUP_W, GROUP_W, GROUP_W,
             GROUP_W, GROUP_W, GROUP_W, RW_DECAY_RANK, RW_ICLR_RANK, RW_GATE_RANK,
             WA_HEADS * HEAD_DIM, WA_KV_HEADS * HEAD_DIM, WA_KV_HEADS * HEAD_DIM,
             GROUP_W)
D_IN = sum(IN_SPLITS)

kernel_name = "hybrid_parallel_group_diffusion_trunk"


def rmsnorm(x, g, eps=NORM_EPS):
    xf = x.astype(F32)
    y = xf * lax.rsqrt(jnp.mean(xf * xf, axis=-1, keepdims=True) + eps)
    return (y * g.astype(F32)).astype(x.dtype)


def modulate(x, g, shift, scale):
    return rmsnorm(x, g) * (1 + scale) + shift


def swiglu(h, wg, wu, wd):
    return (jax.nn.silu(h @ wg) * (h @ wu)) @ wd


def centred_conv3(x, w):
    xp = jnp.pad(x, ((0, 0), (1, 1), (0, 0)))
    return xp[:, :-2] * w[0] + xp[:, 1:-1] * w[1] + xp[:, 2:] * w[2]


def axial_rope_tables(n_tokens):
    t = jnp.arange(n_tokens)
    nf = HEAD_DIM // 4
    inv = 1.0 / (ROPE_BASE ** (jnp.arange(nf, dtype=F32) / nf))

    def ang(p):
        a = p.astype(F32)[:, None] * inv[None, :]
        return jnp.concatenate([a, a], -1)

    a = jnp.concatenate([ang(t // GRID_W), ang(t % GRID_W)], -1)
    return jnp.cos(a), jnp.sin(a)


def _rot_half(t):
    h = t.shape[-1] // 2
    return jnp.concatenate([-t[..., h:], t[..., :h]], -1)


def apply_axial_rope(x, cos, sin):
    half = HEAD_DIM // 2
    cos, sin = cos.astype(x.dtype), sin.astype(x.dtype)
    xr, xc = x[..., :half], x[..., half:]
    return jnp.concatenate([xr * cos[..., :half] + _rot_half(xr) * sin[..., :half],
                            xc * cos[..., half:] + _rot_half(xc) * sin[..., half:]], -1)


def context_attention(q, k, v, sink=None):
    s = jnp.einsum('bqkgd,bckd->bkgqc', q, k).astype(F32) * q.shape[-1] ** -0.5
    if sink is not None:
        s = jnp.concatenate([s, jnp.broadcast_to(sink.astype(F32)[None, :, :, None, None], s.shape[:-1] + (1,))], -1)
    p = jax.nn.softmax(s, axis=-1)[..., :k.shape[1]].astype(v.dtype)
    return jnp.einsum('bkgqc,bckd->bqkgd', p, v)


def neighbourhood_indices(n_tokens):
    rows = n_tokens // GRID_W
    kr = min(NA_WIN_R, rows)
    t = jnp.arange(n_tokens)
    r, c = t // GRID_W, t % GRID_W
    rs = jnp.clip(r - kr // 2, 0, rows - kr)
    cs = jnp.clip(c - NA_WIN_C // 2, 0, GRID_W - NA_WIN_C)
    key_r = rs[:, None, None] + jnp.arange(kr)[None, :, None]
    key_c = cs[:, None, None] + jnp.arange(NA_WIN_C)[None, None, :]
    idx = (key_r * GRID_W + key_c).reshape(n_tokens, kr * NA_WIN_C)
    off_r = key_r - r[:, None, None] + (NA_WIN_R - 1)
    off_c = key_c - c[:, None, None] + (NA_WIN_C - 1)
    bidx = (off_r * (2 * NA_WIN_C - 1) + off_c).reshape(n_tokens, kr * NA_WIN_C)
    return idx, bidx


def neighbourhood_attention(q, k, v, kc, vc, rpb):
    bsz, n, h, dh = q.shape
    idx, bidx = neighbourhood_indices(n)
    nk = idx.shape[1]
    nb = n // NA_QBLOCK
    qb = jnp.moveaxis(q.reshape(bsz, nb, NA_QBLOCK, h, dh), 1, 0)
    idxb = idx.reshape(nb, NA_QBLOCK, nk)
    bidxb = bidx.reshape(nb, NA_QBLOCK, nk)
    scale = dh ** -0.5
    rpb32 = rpb.astype(F32)

    def block(args):
        qq, ii, bi = args
        kk, vv = k[:, ii], v[:, ii]
        s_n = jnp.einsum('bqhd,bqkhd->bhqk', qq, kk).astype(F32) * scale + rpb32[:, bi]
        s_c = jnp.einsum('bqhd,bchd->bhqc', qq, kc).astype(F32) * scale
        p = jax.nn.softmax(jnp.concatenate([s_n, s_c], -1), axis=-1).astype(v.dtype)
        return (jnp.einsum('bhqk,bqkhd->bqhd', p[..., :nk], vv)
                + jnp.einsum('bhqc,bchd->bqhd', p[..., nk:], vc))

    out = lax.map(block, (qb, idxb, bidxb))
    return jnp.moveaxis(out, 0, 1).reshape(bsz, n, h, dh)


def mixer_neighbourhood(pa, pac, q_g, k_g, rpb, want_ctx):
    def qkv(p):
        q, k, v = (t.reshape(*t.shape[:-1], NA_HEADS, HEAD_DIM) for t in p)
        return rmsnorm(q, q_g), rmsnorm(k, k_g), v

    q, k, v = qkv(pa)
    qc, kc, vc = qkv(pac)
    o = neighbourhood_attention(q, k, v, kc, vc, rpb)
    o = o.reshape(*o.shape[:2], GROUP_W)
    oc = context_attention(qc[:, :, :, None], kc, vc).reshape(*qc.shape[:2], GROUP_W) if want_ctx else None
    return o, oc


def _heads(t):
    return t.astype(F32).reshape(*t.shape[:-1], RW_HEADS, RW_N)


def rwkv7_prepare(p, conv_w, w0, w_up, a0, a_up, g_up, k_k, k_a):
    r, k, v, dw, da, dg = p
    r, k, v = jnp.split(centred_conv3(jnp.concatenate([r, k, v], -1), conv_w), 3, axis=-1)
    dwt = jnp.tanh(dw.astype(F32))
    daf = da.astype(F32)
    g = jax.nn.sigmoid(dg.astype(F32)) @ g_up.astype(F32)
    kf = _heads(k)
    kk = kf * _heads(k_k)
    kk = kk / jnp.maximum(jnp.sqrt(jnp.sum(kk * kk, -1, keepdims=True)), 1e-12)
    k_a_h = _heads(k_a)
    dirs = []
    for d in range(2):
        wlog = -jax.nn.softplus(-(w0[d].astype(F32) + dwt @ w_up[d].astype(F32))) - 0.5
        decay = _heads(jnp.exp(-jnp.exp(wlog)))
        a = _heads(jax.nn.sigmoid(a0[d].astype(F32) + daf @ a_up[d].astype(F32)))
        dirs.append((decay, kf * (1 + (a - 1) * k_a_h), a))
    return _heads(r), _heads(v), kk, g, dirs


def rwkv7_scan(r, w, k, v, kk, a, s0, reverse, want_y):
    xs = tuple(jnp.moveaxis(t, 1, 0) for t in (r, w, k, v, kk, a))

    def step(S, inp):
        rt, wt, kt, vt, kkt, at = inp
        sa = jnp.einsum('bhvk,bhk->bhv', S, -kkt)
        S = S * wt[:, :, None, :] + sa[..., None] * (kkt * at)[:, :, None, :] + vt[..., None] * kt[:, :, None, :]
        return S, (jnp.einsum('bhvk,bhk->bhv', S, rt) if want_y else None)

    S, ys = lax.scan(step, s0, xs, reverse=reverse)
    return S, (jnp.moveaxis(ys, 0, 1) if want_y else None)


def rwkv7_readout(r, v, g, k_sum, y, r_k, gn_w, gn_b, dtype):
    y = y + jnp.sum(r * k_sum * r_k.astype(F32), -1, keepdims=True) * v
    mu = jnp.mean(y, -1, keepdims=True)
    var = jnp.mean(jnp.square(y - mu), -1, keepdims=True)
    yn = ((y - mu) * lax.rsqrt(var + RW_GN_EPS)).reshape(*y.shape[:2], GROUP_W)
    return ((yn * gn_w.astype(F32) + gn_b.astype(F32)) * g).astype(dtype)


def mixer_rwkv7(pb, pbc, conv_w, w0, w_up, a0, a_up, g_up, k_k, k_a, r_k, gn_w, gn_b, want_ctx):
    prm = (conv_w, w0, w_up, a0, a_up, g_up, k_k, k_a)
    r, v, kk, g, dirs = rwkv7_prepare(pb, *prm)
    rc, vc, kkc, gc, dirs_c = rwkv7_prepare(pbc, *prm)
    zero = jnp.zeros((r.shape[0], RW_HEADS, RW_N, RW_N), F32)
    ys, ycs = [], []
    for d in range(2):
        wc_, kc_, ac_ = dirs_c[d]
        s_ctx, yc = rwkv7_scan(rc, wc_, kc_, vc, kkc, ac_, zero, d == 1, want_ctx)
        w_, k_, a_ = dirs[d]
        _, y = rwkv7_scan(r, w_, k_, v, kk, a_, s_ctx, d == 1, True)
        ys.append(y)
        ycs.append(yc)
    dtype = pb[0].dtype
    o = rwkv7_readout(r, v, g, dirs[0][1] + dirs[1][1], ys[0] + ys[1], r_k, gn_w, gn_b, dtype)
    oc = (rwkv7_readout(rc, vc, gc, dirs_c[0][1] + dirs_c[1][1], ycs[0] + ycs[1], r_k, gn_w, gn_b, dtype)
          if want_ctx else None)
    return o, oc


def window_attention(q, k, v, kc, vc, sink):
    bsz, n, hk, g, dh = q.shape
    nb = n // WA_BLOCK
    pad = ((0, 0), (WA_BLOCK, WA_BLOCK), (0, 0), (0, 0))

    def bands(t):
        tp = jnp.pad(t, pad)
        return jnp.concatenate([tp[:, i * WA_BLOCK:i * WA_BLOCK + n].reshape(bsz, nb, WA_BLOCK, hk, dh)
                                for i in range(3)], axis=2)

    kb, vb = bands(k), bands(v)
    qb = q.reshape(bsz, nb, WA_BLOCK, hk, g, dh)
    scale = dh ** -0.5
    s_w = jnp.einsum('bnqkgd,bnskd->bnkgqs', qb, kb).astype(F32) * scale
    rel = jnp.arange(3 * WA_BLOCK)[None, :] - WA_BLOCK - jnp.arange(WA_BLOCK)[:, None]
    kpos = jnp.arange(nb)[:, None, None] * WA_BLOCK - WA_BLOCK + jnp.arange(3 * WA_BLOCK)[None, None, :]
    valid = (jnp.abs(rel) <= WA_WINDOW)[None] & (kpos >= 0) & (kpos < n)
    s_w = jnp.where(valid[None, :, None, None], s_w, NEG_INF)
    s_c = jnp.einsum('bnqkgd,bckd->bnkgqc', qb, kc).astype(F32) * scale
    s_s = jnp.broadcast_to(sink.astype(F32)[None, None, :, :, None, None], s_w.shape[:-1] + (1,))
    p = jax.nn.softmax(jnp.concatenate([s_w, s_c, s_s], -1), axis=-1).astype(v.dtype)
    nw, nc = 3 * WA_BLOCK, kc.shape[1]
    o = (jnp.einsum('bnkgqs,bnskd->bnqkgd', p[..., :nw], vb)
         + jnp.einsum('bnkgqc,bckd->bnqkgd', p[..., nw:nw + nc], vc))
    return o.reshape(bsz, n, hk * g * dh)


def mixer_window(pc, pcc, q_g, k_g, sink, cos, sin, want_ctx):
    def qkv(p):
        q, k, v = p
        q = rmsnorm(q.reshape(*q.shape[:-1], WA_KV_HEADS, WA_GROUP, HEAD_DIM), q_g)
        k = rmsnorm(k.reshape(*k.shape[:-1], WA_KV_HEADS, HEAD_DIM), k_g)
        return q, k, v.reshape(*v.shape[:-1], WA_KV_HEADS, HEAD_DIM)

    q, k, v = qkv(pc)
    qc, kc, vc = qkv(pcc)
    q = apply_axial_rope(q, cos[None, :, None, None], sin[None, :, None, None])
    k = apply_axial_rope(k, cos[None, :, None], sin[None, :, None])
    sink2 = sink.reshape(WA_KV_HEADS, WA_GROUP)
    o = window_attention(q, k, v, kc, vc, sink2)
    oc = context_attention(qc, kc, vc, sink2).reshape(*qc.shape[:2], GROUP_W) if want_ctx else None
    return o, oc


def _cmul(ar, ai, br, bi):
    return ar * br - ai * bi, ar * bi + ai * br


def s5_discretise(a_re, a_im, log_dt):
    are, aim = a_re.astype(F32), a_im.astype(F32)
    dt = jnp.exp(log_dt.astype(F32))[:, None]
    mag = jnp.exp(dt * are)
    ang = dt * aim
    ab_re, ab_im = mag * jnp.cos(ang), mag * jnp.sin(ang)
    den = are * are + aim * aim
    nr = ab_re - 1.0
    return ab_re, ab_im, (nr * are + ab_im * aim) / den, (ab_im * are - nr * aim) / den


def s5_scan(bu_re, bu_im, disc, s0, reverse):
    ab_re, ab_im, cf_re, cf_im = disc
    b_re, b_im = _cmul(cf_re, cf_im, bu_re, bu_im)
    if s0 is not None:
        i = -1 if reverse else 0
        i_re, i_im = _cmul(ab_re, ab_im, s0[0], s0[1])
        b_re = b_re.at[:, i].add(i_re)
        b_im = b_im.at[:, i].add(i_im)
    a_re = jnp.broadcast_to(ab_re, b_re.shape)
    a_im = jnp.broadcast_to(ab_im, b_im.shape)

    def combine(e1, e2):
        a1r, a1i, b1r, b1i = e1
        a2r, a2i, b2r, b2i = e2
        ar, ai = _cmul(a2r, a2i, a1r, a1i)
        br, bi = _cmul(a2r, a2i, b1r, b1i)
        return ar, ai, br + b2r, bi + b2i

    _, _, x_re, x_im = lax.associative_scan(combine, (a_re, a_im, b_re, b_im), reverse=reverse, axis=1)
    return x_re, x_im


def mixer_s5(u, uc, a_re, a_im, log_dt, b_re, b_im, c_re, c_im, d_skip, glu_w, glu_b, want_ctx):
    discs = [s5_discretise(a_re[d], a_im[d], log_dt[d]) for d in range(2)]
    bre, bim = b_re.astype(F32), b_im.astype(F32)
    cre, cim = c_re.astype(F32), c_im.astype(F32)
    dsk = d_skip.astype(F32).reshape(S5_GROUPS, S5_P)

    def project(t):
        tg = t.astype(F32).reshape(*t.shape[:-1], S5_GROUPS, S5_P)
        return tg, jnp.einsum('gnp,btgp->btgn', bre, tg), jnp.einsum('gnp,btgp->btgn', bim, tg)

    def readout(tg, x_re, x_im):
        y = (jnp.einsum('gpn,btgn->btgp', cre, x_re) - jnp.einsum('gpn,btgn->btgp', cim, x_im) + dsk * tg)
        y = jax.nn.gelu(y.reshape(*y.shape[:2], GROUP_W)).astype(u.dtype)
        return y * jax.nn.sigmoid(y @ glu_w + glu_b)

    ug, bu_re, bu_im = project(u)
    ucg, buc_re, buc_im = project(uc)
    xf_c = s5_scan(buc_re, buc_im, discs[0], None, False)
    xb_c = s5_scan(buc_re, buc_im, discs[1], None, True)
    xf = s5_scan(bu_re, bu_im, discs[0], (xf_c[0][:, -1], xf_c[1][:, -1]), False)
    xb = s5_scan(bu_re, bu_im, discs[1], (xb_c[0][:, 0], xb_c[1][:, 0]), True)
    o = readout(ug, xf[0] + xb[0], xf[1] + xb[1])
    oc = readout(ucg, xf_c[0] + xb_c[0], xf_c[1] + xb_c[1]) if want_ctx else None
    return o, oc


def setup_inputs(seed: int = 0) -> dict:
    key = jax.random.key(seed)
    ks = iter(jax.random.split(key, 48))
    nrm = lambda shape, s=1.0: s * jax.random.normal(next(ks), shape, F32)
    gain = lambda shape: 1.0 + nrm(shape, 0.05)
    D, L = D_MODEL, DEPTH
    n_idx = jnp.arange(S5_N, dtype=F32)
    conv_base = jnp.array([0.25, 0.5, 0.25], F32)[None, :, None]
    return {
        "x": nrm((BATCH, SEQ, D)),
        "c": nrm((BATCH, D)),
        "ctx": nrm((BATCH, CTX_LEN, D)),
        "c_ctx": nrm((D,)),
        "w_ada": nrm((L, D, N_MOD * D), 0.5 * D ** -0.5),
        "b_ada": nrm((L, N_MOD * D), 0.02),
        "norm_g": gain((L, 3, D)),
        "ffn1_wg": nrm((L, D, D_FF), D ** -0.5),
        "ffn1_wu": nrm((L, D, D_FF), D ** -0.5),
        "ffn1_wd": nrm((L, D_FF, D), D_FF ** -0.5),
        "ffn2_wg": nrm((L, D, D_FF), D ** -0.5),
        "ffn2_wu": nrm((L, D, D_FF), D ** -0.5),
        "ffn2_wd": nrm((L, D_FF, D), D_FF ** -0.5),
        "w_in": nrm((L, D, D_IN), D ** -0.5),
        "w_out": nrm((L, D, D), D ** -0.5),
        "na_q_g": gain((L, HEAD_DIM)),
        "na_k_g": gain((L, HEAD_DIM)),
        "na_rpb": nrm((L, NA_HEADS, (2 * NA_WIN_R - 1) * (2 * NA_WIN_C - 1)), 0.1),
        "rw_conv": conv_base + nrm((L, 3, 3 * GROUP_W), 0.05),
        "rw_w0": jax.random.uniform(next(ks), (L, 2, GROUP_W), F32, -7.0, -1.0),
        "rw_w_up": nrm((L, 2, RW_DECAY_RANK, GROUP_W), 0.1),
        "rw_a0": nrm((L, 2, GROUP_W), 0.1),
        "rw_a_up": nrm((L, 2, RW_ICLR_RANK, GROUP_W), 0.1),
        "rw_g_up": nrm((L, RW_GATE_RANK, GROUP_W), RW_GATE_RANK ** -0.5),
        "rw_k_k": 0.85 + nrm((L, GROUP_W), 0.05),
        "rw_k_a": gain((L, GROUP_W)),
        "rw_r_k": nrm((L, RW_HEADS, RW_N), 0.1),
        "rw_gn_w": gain((L, GROUP_W)),
        "rw_gn_b": nrm((L, GROUP_W), 0.02),
        "wa_q_g": gain((L, HEAD_DIM)),
        "wa_k_g": gain((L, HEAD_DIM)),
        "wa_sink": nrm((L, WA_HEADS), 0.5),
        "s5_a_re": -0.5 + nrm((L, 2, S5_GROUPS, S5_N), 0.01),
        "s5_a_im": math.pi * n_idx + nrm((L, 2, S5_GROUPS, S5_N), 0.01),
        "s5_log_dt": jax.random.uniform(next(ks), (L, 2, S5_GROUPS), F32, math.log(1e-3), math.log(1e-1)),
        "s5_b_re": nrm((L, S5_GROUPS, S5_N, S5_P), (2 * S5_P) ** -0.5),
        "s5_b_im": nrm((L, S5_GROUPS, S5_N, S5_P), (2 * S5_P) ** -0.5),
        "s5_c_re": nrm((L, S5_GROUPS, S5_P, S5_N), S5_N ** -0.5),
        "s5_c_im": nrm((L, S5_GROUPS, S5_P, S5_N), S5_N ** -0.5),
        "s5_d": nrm((L, GROUP_W)),
        "s5_glu_w": nrm((L, GROUP_W, GROUP_W), GROUP_W ** -0.5),
        "s5_glu_b": nrm((L, GROUP_W), 0.02),
    }


def reference(x, c, ctx, c_ctx, w_ada, b_ada, norm_g, ffn1_wg, ffn1_wu, ffn1_wd, ffn2_wg, ffn2_wu, ffn2_wd,
              w_in, w_out, na_q_g, na_k_g, na_rpb, rw_conv, rw_w0, rw_w_up, rw_a0, rw_a_up, rw_g_up,
              rw_k_k, rw_k_a, rw_r_k, rw_gn_w, rw_gn_b, wa_q_g, wa_k_g, wa_sink, s5_a_re, s5_a_im,
              s5_log_dt, s5_b_re, s5_b_im, s5_c_re, s5_c_im, s5_d, s5_glu_w, s5_glu_b):
    cos, sin = axial_rope_tables(x.shape[1])
    cuts = np.cumsum(IN_SPLITS)[:-1].tolist()
    xc = ctx
    for l in range(DEPTH):
        want_ctx = l < DEPTH - 1
        mod = jnp.split((jax.nn.silu(c) @ w_ada[l] + b_ada[l])[:, None, :], N_MOD, axis=-1)
        mod_c = jnp.split((jax.nn.silu(c_ctx) @ w_ada[l] + b_ada[l])[None, None, :], N_MOD, axis=-1)
        x = x + 0.5 * mod[2] * swiglu(modulate(x, norm_g[l, 0], mod[0], mod[1]), ffn1_wg[l], ffn1_wu[l], ffn1_wd[l])
        xc = xc + 0.5 * mod_c[2] * swiglu(modulate(xc, norm_g[l, 0], mod_c[0], mod_c[1]),
                                          ffn1_wg[l], ffn1_wu[l], ffn1_wd[l])
        h = modulate(x, norm_g[l, 1], mod[3], mod[4])
        hc = modulate(xc, norm_g[l, 1], mod_c[3], mod_c[4])
        pa = jnp.split(h @ w_in[l], cuts, axis=-1)
        pc = jnp.split(hc @ w_in[l], cuts, axis=-1)
        o_a, oc_a = mixer_neighbourhood(pa[0:3], pc[0:3], na_q_g[l], na_k_g[l], na_rpb[l], want_ctx)
        o_b, oc_b = mixer_rwkv7(pa[3:9], pc[3:9], rw_conv[l], rw_w0[l], rw_w_up[l], rw_a0[l], rw_a_up[l],
                                rw_g_up[l], rw_k_k[l], rw_k_a[l], rw_r_k[l], rw_gn_w[l], rw_gn_b[l], want_ctx)
        o_c, oc_c = mixer_window(pa[9:12], pc[9:12], wa_q_g[l], wa_k_g[l], wa_sink[l], cos, sin, want_ctx)
        o_d, oc_d = mixer_s5(pa[12], pc[12], s5_a_re[l], s5_a_im[l], s5_log_dt[l], s5_b_re[l], s5_b_im[l],
                             s5_c_re[l], s5_c_im[l], s5_d[l], s5_glu_w[l], s5_glu_b[l], want_ctx)
        x = x + mod[5] * (jnp.concatenate([o_a, o_b, o_c, o_d], axis=-1) @ w_out[l])
        x = x + 0.5 * mod[8] * swiglu(modulate(x, norm_g[l, 2], mod[6], mod[7]), ffn2_wg[l], ffn2_wu[l], ffn2_wd[l])
        if want_ctx:
            xc = xc + mod_c[5] * (jnp.concatenate([oc_a, oc_b, oc_c, oc_d], axis=-1) @ w_out[l])
            xc = xc + 0.5 * mod_c[8] * swiglu(modulate(xc, norm_g[l, 2], mod_c[6], mod_c[7]),
                                              ffn2_wg[l], ffn2_wu[l], ffn2_wd[l])
    return x
```

```cpp
#ifdef EMU
#include "emu/emu.h"
#define LAS
#define GAS
#define ASMV(...) ((void)0)
#define WSYNC() do { int _z = 0; (void)emu::wave_gather(&_z, 4); } while (0)
#define OPAQUE(x) ((void)0)
#else
#include <hip/hip_runtime.h>
#include <cstdio>
#include <cstdint>
#define LAS __attribute__((address_space(3)))
#define GAS __attribute__((address_space(1)))
#define ASMV(...) asm volatile(__VA_ARGS__)
#define OPAQUE(x) asm volatile("" : "+v"(x))
#define WSYNC() asm volatile("s_waitcnt lgkmcnt(0)" ::: "memory")
#endif

#ifdef EMU
constexpr int D = 1024, NB = 2, T = 1024, NL = 2, TC = 256, FF = 1024;
#else
constexpr int D = 2048, NB = 2, T = 8192, NL = 4, TC = 256, FF = 5632;
#endif
constexpr int GW = D / 4, NH = GW / 64, WAG = NH / 2, S5G = GW / 16, GRW = 64, GRH = T / GRW;
constexpr int M_LAT = NB * T, M_CTX = NB * TC, M = M_LAT + M_CTX, NPAN = M / 256;
constexpr int TP = GW / 256;
constexpr int NT_IN = 8 * TP + 2, NINP = NT_IN * 256, D_IN = 8 * GW + 416;
constexpr int PN_AQ = 0, PN_AK = TP, PN_AV = 2 * TP, PN_BR = 3 * TP, PN_BK = 4 * TP, PN_BV = 5 * TP, PN_BS = 6 * TP, PN_CQ = 6 * TP + 1, PN_CKV = 7 * TP + 1, PN_DU = 7 * TP + 2;
constexpr int SRC_AQ = 0, SRC_AK = GW, SRC_AV = 2 * GW, SRC_BR = 3 * GW, SRC_BK = 4 * GW, SRC_BV = 5 * GW, SRC_BS = 6 * GW, SRC_CQ = 6 * GW + 160, SRC_CK = 7 * GW + 160, SRC_CV = 7 * GW + 288, SRC_DU = 7 * GW + 416;
constexpr int S5L = 32, NCH = M / S5L, NCHP = ((NCH + 255) / 256) * 256, S5K = 768;
constexpr int NW = 8, NTHR = 512;
constexpr float NORM_EPS = 1e-6f, RW_GN_EPS = 64e-5f;

typedef unsigned short bf16;
typedef short bf16x8 __attribute__((ext_vector_type(8)));
typedef short s16x4 __attribute__((ext_vector_type(4)));
typedef float f32x4 __attribute__((ext_vector_type(4)));
typedef float f32x2 __attribute__((ext_vector_type(2)));
typedef float f32x16 __attribute__((ext_vector_type(16)));
typedef unsigned u32x4 __attribute__((ext_vector_type(4)));
typedef unsigned u32x2 __attribute__((ext_vector_type(2)));
#define DI __device__ __forceinline__

constexpr size_t al256(size_t x) { return (x + 255) & ~(size_t)255; }
constexpr size_t SZ_BIAS_GU = (size_t)3 * 2 * FF * 4, SZ_BIAS_IN = (size_t)3 * NINP * 4;
constexpr size_t WS_CTL = 0;
constexpr size_t WS_BIAS = 65536;
constexpr size_t SZ_BIAS_L = 2 * SZ_BIAS_GU + SZ_BIAS_IN;
constexpr size_t WS_ROWSS = al256(WS_BIAS + NL * SZ_BIAS_L);
constexpr size_t WS_ZERO_END = al256(WS_ROWSS + (size_t)NL * 3 * M * 4);
constexpr size_t WS_MODV = WS_ZERO_END;
constexpr size_t WS_GS = al256(WS_MODV + (size_t)NL * 3 * 9 * D * 4);
constexpr size_t WS_GATE = al256(WS_GS + (size_t)NL * 9 * D * 4);
constexpr size_t WS_ROPE = al256(WS_GATE + (size_t)NL * 9 * D * 4);
constexpr size_t SZ_WGU = (size_t)2 * FF * D * 2, SZ_WD = (size_t)D * FF * 2, SZ_WIN = (size_t)NINP * D * 2, SZ_WOUT = (size_t)D * D * 2, SZ_WGLU = (size_t)GW * GW * 2;
constexpr size_t OFF_W1GU = 0, OFF_W1D = OFF_W1GU + SZ_WGU, OFF_WIN = OFF_W1D + SZ_WD, OFF_WOUT = OFF_WIN + SZ_WIN, OFF_W2GU = OFF_WOUT + SZ_WOUT, OFF_W2D = OFF_W2GU + SZ_WGU, OFF_WGLU = OFF_W2D + SZ_WD, SZ_WL = OFF_WGLU + SZ_WGLU;
constexpr size_t WS_W = al256(WS_ROPE + 128 * 16 * 8);
constexpr size_t SZ_S5KC = (size_t)S5G * 2 * S5L * 256 * 4, SZ_S5ET = (size_t)S5G * 256 * 512 * 2, SZ_S5BT = (size_t)S5G * 512 * S5K * 2, SZ_S5LAM = (size_t)2 * GW * 4 * 8;
constexpr size_t OFF_S5KC = 0, OFF_S5ET = OFF_S5KC + SZ_S5KC, OFF_S5BT = OFF_S5ET + SZ_S5ET, OFF_S5LAM = OFF_S5BT + SZ_S5BT, SZ_S5L = al256(OFF_S5LAM + SZ_S5LAM);
constexpr size_t WS_S5T = al256(WS_W + NL * SZ_WL);
constexpr size_t WS_XC = al256(WS_S5T + NL * SZ_S5L);
constexpr size_t WS_AP = al256(WS_XC + (size_t)M_CTX * D * 4);
constexpr size_t WS_H = al256(WS_AP + (size_t)M * D * 2);
constexpr size_t WS_QA = al256(WS_H + (size_t)M * FF * 2);
constexpr size_t WS_KA = WS_QA + (size_t)M * GW * 2, WS_VA = WS_KA + (size_t)M * GW * 2, WS_QC = WS_VA + (size_t)M * GW * 2;
constexpr size_t WS_KC = WS_QC + (size_t)M * GW * 2, WS_VC = WS_KC + (size_t)M * 128 * 2;
constexpr size_t WS_PB = WS_VC + (size_t)M * 128 * 2;
constexpr size_t WS_PS = al256(WS_PB + (size_t)M * 3 * GW * 2);
constexpr size_t WS_UG = al256(WS_PS + (size_t)M * 160 * 4);
constexpr size_t WS_RW = al256(WS_UG + (size_t)S5G * NCHP * S5K * 2);
constexpr size_t SZ_RWA = (size_t)M * GW * 4;
enum { RW_R = 0, RW_V, RW_NKK, RW_G, RW_W0, RW_W1, RW_K0, RW_K1, RW_B0, RW_B1, RW_Y0, RW_Y1, RW_NARR };
constexpr size_t WS_XEND = al256(WS_RW + RW_NARR * SZ_RWA);
constexpr size_t WS_YG = al256(WS_XEND + (size_t)S5G * NCHP * 256 * 4);
constexpr size_t WS_OB = al256(WS_YG + (size_t)M * GW * 2);
constexpr size_t WS_END = al256(WS_OB + (size_t)M * D * 2);
constexpr int CW_BAR = 1024;

constexpr int LDS_BYTES = 147456, RING_BYTES = 131072, MISC_OFF = LDS_BYTES - 256;

DI unsigned f2bf(float f) { unsigned u = __float_as_uint(f); return (u + 0x7fffu + ((u >> 16) & 1u)) >> 16; }
DI unsigned pk2(float lo, float hi) { return f2bf(lo) | (f2bf(hi) << 16); }
DI float bf2f(unsigned short b) { return __uint_as_float(((unsigned)b) << 16); }
DI float bflo(unsigned w) { return __uint_as_float(w << 16); }
DI float bfhi(unsigned w) { return __uint_as_float(w & 0xffff0000u); }
DI float wave_sum(float v) {
#pragma unroll
    for (int o = 1; o < 64; o <<= 1) v += __shfl_xor(v, o);
    return v;
}
DI float siluf(float x) { return x / (1.f + __expf(-x)); }
DI float sigmf(float x) { return 1.f / (1.f + __expf(-x)); }
DI float geluf(float x) { const float z = 0.7978845608028654f * (x + 0.044715f * x * x * x); const float e = __expf(2.f * z); return 0.5f * x * (1.f + (1.f - 2.f / (e + 1.f))); }
DI int stream_of_row(int row) { return row < M_LAT ? row / T : NB; }
DI int stream_of_panel(int pm) { return stream_of_row(pm * 256); }

#define XB_TMO      128
#define XB_XCNT(j)  (256  + 64 * (j))
#define XB_XSUB(j)  (1280 + 64 * (j))
#define XB_XGEN(j)  (2304 + 64 * (j))
#define XB_TOP      3328
#define XB_TOPGEN   3392
#define XCD_BAR_WORDS 3456
#define XB_SPIN_CAP (1u << 18)
DI unsigned xb_ld(unsigned* p)              { return __hip_atomic_load(p, __ATOMIC_RELAXED, __HIP_MEMORY_SCOPE_AGENT); }
DI unsigned xb_add(unsigned* p, unsigned v) { return __hip_atomic_fetch_add(p, v, __ATOMIC_RELAXED, __HIP_MEMORY_SCOPE_AGENT); }
DI unsigned xb_xcc_id() { return (unsigned)__builtin_amdgcn_s_getreg((3 << 11) | 20) & 0xFu; }
#define XB_SPIN(cond, bar) do { unsigned _sp = 0; while (cond) { __builtin_amdgcn_s_sleep(1); \
    if ((++_sp & 255u) == 0u) { if (xb_ld(&(bar)[XB_TMO])) break; if (_sp > XB_SPIN_CAP) { atomicAdd(&(bar)[XB_TMO], 1u); break; } } } } while (0)
struct XcdBarrier { unsigned* bar; unsigned x; volatile LAS unsigned* st; };
DI XcdBarrier xcd_barrier_post(unsigned* bar, volatile LAS unsigned* st) {
    XcdBarrier b; b.bar = bar; b.x = xb_xcc_id(); b.st = st;
    if (threadIdx.x == 0) (void)xb_add(&bar[XB_XCNT(b.x)], 1u);
    return b;
}
DI void xcd_barrier_complete(unsigned* bar, unsigned x, unsigned& nloc, unsigned& nx) {
    const unsigned G = gridDim.x * gridDim.y * gridDim.z;
    unsigned sum, cnt, mine, sp = 0u;
    for (;;) {
        sum = 0u; cnt = 0u; mine = 0u;
#pragma unroll
        for (unsigned j = 0; j < 16; ++j) { const unsigned c = xb_ld(&bar[XB_XCNT(j)]); sum += c; cnt += (c > 0u) ? 1u : 0u; mine = (j == x) ? c : mine; }
        if (sum == G) break;
        __builtin_amdgcn_s_sleep(1);
        if ((++sp & 255u) == 0u) { if (xb_ld(&bar[XB_TMO])) break; if (sp > XB_SPIN_CAP) { atomicAdd(&bar[XB_TMO], 1u); break; } }
    }
    nloc = mine > 0u ? mine : 1u; nx = cnt > 0u ? cnt : 1u;
}
DI void xcd_barrier(const XcdBarrier& b) {
    ASMV("s_waitcnt vmcnt(0)" ::: "memory");
    __syncthreads();
    if (threadIdx.x == 0) {
        unsigned* bar = b.bar;
        __builtin_amdgcn_s_waitcnt(0);
        unsigned nloc = b.st[0], nx = b.st[1];
        if (nloc == 0u) { xcd_barrier_complete(bar, b.x, nloc, nx); b.st[0] = nloc; b.st[1] = nx; }
        const unsigned old = xb_add(&bar[XB_XSUB(b.x)], 1u);
        const unsigned gen = old / nloc;
        if (old + 1u == (gen + 1u) * nloc) {
            __builtin_amdgcn_fence(__ATOMIC_RELEASE, "agent");
            ASMV("s_waitcnt vmcnt(0)" ::: "memory");
            const unsigned og = xb_add(&bar[XB_TOP], 1u);
            const unsigned tg = og / nx;
            if (og + 1u == (tg + 1u) * nx) xb_add(&bar[XB_TOPGEN], 1u);
            else XB_SPIN(xb_ld(&bar[XB_TOPGEN]) == tg, bar);
            __builtin_amdgcn_fence(__ATOMIC_ACQUIRE, "agent");
            xb_add(&bar[XB_XGEN(b.x)], 1u);
            ASMV("s_waitcnt vmcnt(0)" ::: "memory");
        } else {
            XB_SPIN(xb_ld(&bar[XB_XGEN(b.x)]) == gen, bar);
            __builtin_amdgcn_fence(__ATOMIC_ACQUIRE, "agent");
            ASMV("s_waitcnt vmcnt(0)" ::: "memory");
        }
    }
    __syncthreads();
}

constexpr int BK = 64, HALF = 128, HTB = HALF * BK * 2, NXCD = 8, WGM = 8;
DI int lds_byte(int r, int c) { const int st = (r >> 4) * 2 + (c >> 5), rr = r & 15, cc = c & 31, ob = rr * 64 + cc * 2; return st * 1024 + (ob ^ (((ob >> 9) & 1) << 5)); }
DI void stage_rc(int b, int& R, int& C) { const int st = b / 1024, sb = b % 1024, swz = sb ^ (((sb >> 9) & 1) << 5); R = (st >> 1) * 16 + swz / 64; C = (st & 1) * 32 + (swz % 64) / 2; }
struct Unit { int pm, pn, z; };
struct Gemm { const bf16* A; const bf16* Bt; int lda, ldb, K; size_t zA, zB; };
struct Order {
    int nM, nN, nZ, per, total, G, c;
    DI void init(int nM_, int nN_, int nZ_, int G_, int c_) { nM = nM_; nN = nN_; nZ = nZ_; per = nM * nN; total = per * nZ; G = G_; c = c_; }
    DI bool next(int i, Unit& u) const {
        const long L = (long)i * G + c; if (L >= total) return false;
        u.z = (int)(L / per); int wgid = (int)(L % per);
        { const int q = per / NXCD, r = per % NXCD, xcd = wgid % NXCD, off = wgid / NXCD; wgid = (xcd < r ? xcd * (q + 1) : r * (q + 1) + (xcd - r) * q) + off; }
        const int nig = WGM * nN, gid = wgid / nig, fm = gid * WGM, gsz = (nM - fm) < WGM ? (nM - fm) : WGM;
        u.pm = fm + ((wgid % nig) % gsz); u.pn = (wgid % nig) / gsz; return true;
    }
};

template <class Epi>
DI void gemm_phase(LAS unsigned char* lds, const Gemm g, const Order& S, const Epi& E) {
    int tid_ = threadIdx.x; OPAQUE(tid_);
    const int tid = tid_, wid = __builtin_amdgcn_readfirstlane(tid >> 6), lane = tid & 63, wr = wid >> 2, wc = wid & 3, fr = lane & 15, fq = lane >> 4;
    Unit cur, nxt; int ui = 0;
    if (!S.next(0, cur)) return;
    f32x4 acc[2][2][4][2];
#ifdef EMU
    (void)lds;
    for (;; ++ui) {
        if (ui > 0) { if (!S.next(ui, cur)) break; }
        const bf16* A = (const bf16*)((const char*)g.A + cur.z * g.zA); const bf16* B = (const bf16*)((const char*)g.Bt + cur.z * g.zB);
        for (int ai = 0; ai < 2; ++ai) for (int bj = 0; bj < 2; ++bj) for (int m = 0; m < 4; ++m) for (int n = 0; n < 2; ++n) for (int j = 0; j < 4; ++j) {
            const int r = 256 * cur.pm + 128 * ai + 64 * wr + 16 * m + fr, c = 256 * cur.pn + 128 * bj + 32 * wc + 16 * n + 4 * fq + j;
            const bf16* a = A + (size_t)r * g.lda; const bf16* b = B + (size_t)c * g.ldb; float s = 0.f;
            for (int k = 0; k < g.K; ++k) s += bf2f(a[k]) * bf2f(b[k]);
            acc[ai][bj][m][n][j] = s; }
        E(acc, cur, wr, wc, fr, fq);
    }
#else
    const int K = g.K, nt = K / BK;
    unsigned voffA[2], voffB[2];
#pragma unroll
    for (int i = 0; i < 2; ++i) { int R, C; stage_rc(tid * 16 + i * 8192, R, C); voffA[i] = (unsigned)(R * g.lda + C) * 2u; voffB[i] = (unsigned)(R * g.ldb + C) * 2u; }
    const size_t kstep = (size_t)(BK * 2);
    const size_t hstepA = (size_t)HALF * g.lda * 2, hstepB = (size_t)HALF * g.ldb * 2, tstepA = 2 * hstepA, tstepB = 2 * hstepB;
    const unsigned ldsw = (unsigned)wid * 1024u;
    const int aoff = lds_byte(wr * 64 + fr, fq * 8), boff = lds_byte(wc * 32 + fr, fq * 8);
#define PG8_SA(b, h) (((b) * 2 + (h)) * HTB)
#define PG8_SB(b, h) ((4 + (b) * 2 + (h)) * HTB)
#define PG8_STAGE(bufoff, gbase, voff) do { _Pragma("unroll") for (int _i = 0; _i < 2; ++_i) \
        __builtin_amdgcn_global_load_lds((const unsigned*)((const char*)(gbase) + (voff)[_i]), (LAS unsigned*)(lds + (bufoff) + ldsw + _i * 8192), 16, 0, 0); } while (0)
#define PG8_LDA(dst, b, h) do { _Pragma("unroll") for (int m = 0; m < 4; ++m) _Pragma("unroll") for (int k = 0; k < 2; ++k) dst[m][k] = *(const LAS bf16x8*)(lds + PG8_SA(b, h) + aoff + m * 2048 + k * 1024); } while (0)
#define PG8_LDB(dst, b, h) do { _Pragma("unroll") for (int n = 0; n < 2; ++n) _Pragma("unroll") for (int k = 0; k < 2; ++k) dst[n][k] = *(const LAS bf16x8*)(lds + PG8_SB(b, h) + boff + n * 2048 + k * 1024); } while (0)
#define PG8_MMA(ai, bj, At, Bt) do { __builtin_amdgcn_s_setprio(1); _Pragma("unroll") for (int m = 0; m < 4; ++m) _Pragma("unroll") for (int n = 0; n < 2; ++n) _Pragma("unroll") for (int k = 0; k < 2; ++k) \
        acc[ai][bj][m][n] = __builtin_amdgcn_mfma_f32_16x16x32_bf16(Bt[n][k], At[m][k], acc[ai][bj][m][n], 0, 0, 0); __builtin_amdgcn_s_setprio(0); } while (0)
#define PG8_WAIT_V(n) asm volatile("s_waitcnt vmcnt(" #n ")" ::: "memory")
#define PG8_WAIT_L(n) asm volatile("s_waitcnt lgkmcnt(" #n ")" ::: "memory")
#define PG8_BAR __builtin_amdgcn_s_barrier()
#define PG8_SCHED __builtin_amdgcn_sched_barrier(0)
#pragma unroll
    for (int a = 0; a < 2; ++a)
#pragma unroll
        for (int b = 0; b < 2; ++b)
#pragma unroll
            for (int m = 0; m < 4; ++m)
#pragma unroll
                for (int n = 0; n < 2; ++n) acc[a][b][m][n] = (f32x4){0.f, 0.f, 0.f, 0.f};
    bf16x8 At[4][2], B0[2][2], B1[2][2];
    const char* cA = (const char*)g.A + (size_t)cur.z * g.zA + (size_t)cur.pm * tstepA; const char* cB = (const char*)g.Bt + (size_t)cur.z * g.zB + (size_t)cur.pn * tstepB;
    PG8_STAGE(PG8_SB(0, 0), cB, voffB); PG8_STAGE(PG8_SB(0, 1), cB + hstepB, voffB); PG8_STAGE(PG8_SA(0, 0), cA, voffA); PG8_STAGE(PG8_SA(0, 1), cA + hstepA, voffA);
    if (wr == 1) PG8_BAR;
    PG8_WAIT_V(2); PG8_BAR;
    PG8_STAGE(PG8_SB(1, 0), cB + kstep, voffB); PG8_STAGE(PG8_SA(1, 0), cA + kstep, voffA); PG8_STAGE(PG8_SB(1, 1), cB + hstepB + kstep, voffB);
    PG8_WAIT_V(6); PG8_BAR;
    for (;;) {
        const bool has_next = S.next(ui + 1, nxt);
        const char* nA = has_next ? (const char*)g.A + (size_t)nxt.z * g.zA + (size_t)nxt.pm * tstepA : cA; const char* nB = has_next ? (const char*)g.Bt + (size_t)nxt.z * g.zB + (size_t)nxt.pn * tstepB : cB;
        for (int t = 0; t < nt; t += 2) {
            const bool last = (t == nt - 2);
            const char* a1 = cA + (size_t)(t + 1) * kstep;
            const char* a2 = last ? nA : cA + (size_t)(t + 2) * kstep; const char* b2 = last ? nB : cB + (size_t)(t + 2) * kstep;
            const char* a3 = a2 + kstep; const char* b3 = b2 + kstep;
            PG8_LDB(B0, 0, 0); PG8_LDB(B1, 0, 1); PG8_SCHED; PG8_LDA(At, 0, 0); PG8_STAGE(PG8_SA(1, 1), a1 + hstepA, voffA);
            PG8_WAIT_V(8); PG8_WAIT_L(0); PG8_BAR; PG8_MMA(0, 0, At, B0); PG8_MMA(0, 1, At, B1); PG8_BAR; PG8_SCHED;
            PG8_LDA(At, 0, 1); PG8_STAGE(PG8_SB(0, 0), b2, voffB); PG8_STAGE(PG8_SB(0, 1), b2 + hstepB, voffB); PG8_STAGE(PG8_SA(0, 0), a2, voffA);
            PG8_WAIT_V(8); PG8_WAIT_L(0); PG8_BAR; PG8_MMA(1, 0, At, B0); PG8_MMA(1, 1, At, B1); PG8_BAR; PG8_SCHED;
            PG8_LDB(B0, 1, 0); PG8_LDB(B1, 1, 1); PG8_SCHED; PG8_LDA(At, 1, 0); PG8_STAGE(PG8_SA(0, 1), a2 + hstepA, voffA);
            PG8_WAIT_V(8); PG8_WAIT_L(0); PG8_BAR; PG8_MMA(0, 0, At, B0); PG8_MMA(0, 1, At, B1); PG8_BAR; PG8_SCHED;
            PG8_LDA(At, 1, 1); PG8_STAGE(PG8_SB(1, 0), b3, voffB); PG8_STAGE(PG8_SB(1, 1), b3 + hstepB, voffB); PG8_STAGE(PG8_SA(1, 0), a3, voffA);
            PG8_WAIT_V(8); PG8_WAIT_L(0); PG8_BAR; PG8_MMA(1, 0, At, B0); PG8_MMA(1, 1, At, B1); PG8_BAR; PG8_SCHED;
        }
        if (wr == 0) PG8_BAR;
        E(acc, cur, wr, wc, fr, fq);
        if (!has_next) break;
#pragma unroll
        for (int a = 0; a < 2; ++a)
#pragma unroll
            for (int b = 0; b < 2; ++b)
#pragma unroll
                for (int m = 0; m < 4; ++m)
#pragma unroll
                    for (int n = 0; n < 2; ++n) acc[a][b][m][n] = (f32x4){0.f, 0.f, 0.f, 0.f};
        cur = nxt; cA = nA; cB = nB; ++ui;
        if (wr == 1) PG8_BAR;
    }
    PG8_WAIT_V(0);
    PG8_BAR;
#undef PG8_SA
#undef PG8_SB
#undef PG8_STAGE
#undef PG8_LDA
#undef PG8_LDB
#undef PG8_MMA
#undef PG8_WAIT_V
#undef PG8_WAIT_L
#undef PG8_BAR
#undef PG8_SCHED
#endif
}

struct Args {
    const float* in[42]; float* out; unsigned char* ws;
    int ph_lo, ph_hi;
};
struct Ctx {
    const float* const* in; float* out; unsigned char* ws;
    LAS unsigned char* lds; int tid, lane, wave, G, bid;
};
DI float* xrow_ptr(const Ctx& C, int row) { return row < M_LAT ? C.out + (size_t)row * D : (float*)(C.ws + WS_XC) + (size_t)(row - M_LAT) * D; }
DI const bf16* wl(const Ctx& C, int l, size_t off) { return (const bf16*)(C.ws + WS_W + (size_t)l * SZ_WL + off); }
DI float* bias_ptr(const Ctx& C, int l, int which  ) { return (float*)(C.ws + WS_BIAS + (size_t)l * SZ_BIAS_L + (which == 0 ? 0 : which == 1 ? SZ_BIAS_GU : SZ_BIAS_GU + SZ_BIAS_IN)); }
DI float* rowss_ptr(const Ctx& C, int l, int sub) { return (float*)(C.ws + WS_ROWSS) + ((size_t)l * 3 + sub) * M; }
DI const float* gs_ptr(const Ctx& C, int l, int sub, int s) { return (const float*)(C.ws + WS_GS) + (((size_t)l * 3 + sub) * 3 + s) * D; }
DI const float* gate_ptr(const Ctx& C, int l, int sub, int s) { return (const float*)(C.ws + WS_GATE) + (((size_t)l * 3 + sub) * 3 + s) * D; }
DI float* rw_arr(const Ctx& C, int a) { return (float*)(C.ws + WS_RW + (size_t)a * SZ_RWA); }
enum { I_X = 0, I_C, I_CTX, I_CCTX, I_WADA, I_BADA, I_NORMG, I_F1WG, I_F1WU, I_F1WD, I_F2WG, I_F2WU, I_F2WD, I_WIN, I_WOUT, I_NAQG, I_NAKG, I_NARPB, I_RWCONV, I_RWW0, I_RWWUP, I_RWA0, I_RWAUP,
       I_RWGUP, I_RWKK, I_RWKA, I_RWRK, I_RWGNW, I_RWGNB, I_WAQG, I_WAKG, I_WASINK, I_S5ARE, I_S5AIM, I_S5LDT, I_S5BRE, I_S5BIM, I_S5CRE, I_S5CIM, I_S5D, I_S5GLUW, I_S5GLUB, I_NIN };

struct EpiGU {
    const float* rowss; const float* bias  ; bf16* H; int mrows;
    DI void operator()(const f32x4 (&acc)[2][2][4][2], const Unit& u, int wr, int wc, int fr_, int fq_) const {
        int tz_ = threadIdx.x; OPAQUE(tz_); const int fr = tz_ & 15, fq = (tz_ & 63) >> 4; (void)fr_; (void)fq_;
        const int s = stream_of_panel(u.pm); const float* bs = bias + (size_t)s * 2 * FF + u.pn * 256 + wc * 32 + 4 * fq;
        f32x4 bg[2], bu[2];
#pragma unroll
        for (int n = 0; n < 2; ++n) { bg[n] = *(const f32x4*)(bs + 16 * n); bu[n] = *(const f32x4*)(bs + 128 + 16 * n); }
#pragma unroll
        for (int ai = 0; ai < 2; ++ai)
#pragma unroll
            for (int m = 0; m < 4; ++m) {
                const int row = u.pm * 256 + ai * 128 + wr * 64 + m * 16 + fr;
                const float rstd = 1.0f / sqrtf(rowss[row] * (1.0f / D) + NORM_EPS);
                bf16* hp = H + (size_t)row * FF + u.pn * 128 + wc * 32 + 4 * fq;
#pragma unroll
                for (int n = 0; n < 2; ++n) { const f32x4 g = acc[ai][0][m][n] * rstd + bg[n], v = acc[ai][1][m][n] * rstd + bu[n];
                    u32x2 w; w.x = pk2(siluf(g[0]) * v[0], siluf(g[1]) * v[1]); w.y = pk2(siluf(g[2]) * v[2], siluf(g[3]) * v[3]);
                    *(u32x2*)(hp + 16 * n) = w; }
            }
    }
};
struct EpiRes {
    const Ctx* C; const float* gate  ; const float* gsn  ; float* rowss_next; bf16* AP;
    DI void operator()(const f32x4 (&acc)[2][2][4][2], const Unit& u, int wr, int wc, int fr_, int fq_) const {
        int tz_ = threadIdx.x; OPAQUE(tz_); const int fr = tz_ & 15, fq = (tz_ & 63) >> 4; (void)fr_; (void)fq_;
        const int s = stream_of_panel(u.pm); const int col0 = u.pn * 256 + wc * 32 + 4 * fq;
        f32x4 gv[2][2], sv[2][2];
#pragma unroll
        for (int bj = 0; bj < 2; ++bj)
#pragma unroll
            for (int n = 0; n < 2; ++n) { gv[bj][n] = *(const f32x4*)(gate + (size_t)s * D + col0 + bj * 128 + n * 16); sv[bj][n] = gsn ? *(const f32x4*)(gsn + (size_t)s * D + col0 + bj * 128 + n * 16) : (f32x4){0.f, 0.f, 0.f, 0.f}; }
#pragma unroll
        for (int ai = 0; ai < 2; ++ai)
#pragma unroll
            for (int m = 0; m < 4; ++m) {
                const int row = u.pm * 256 + ai * 128 + wr * 64 + m * 16 + fr;
                float* xp = xrow_ptr(*C, row) + col0; float ss = 0.f;
#pragma unroll
                for (int bj = 0; bj < 2; ++bj)
#pragma unroll
                    for (int n = 0; n < 2; ++n) { f32x4 x = *(const f32x4*)(xp + bj * 128 + n * 16); x += gv[bj][n] * acc[ai][bj][m][n]; *(f32x4*)(xp + bj * 128 + n * 16) = x;
                        if (gsn) { ss += (x[0] * x[0] + x[1] * x[1]) + (x[2] * x[2] + x[3] * x[3]); const f32x4 a = x * sv[bj][n]; u32x2 w; w.x = pk2(a[0], a[1]); w.y = pk2(a[2], a[3]);
                            *(u32x2*)(AP + (size_t)row * D + col0 + bj * 128 + n * 16) = w; } }
                if (gsn) { ss += __shfl_xor(ss, 16); ss += __shfl_xor(ss, 32); if (fq == 0) atomicAdd(rowss_next + row, ss); }
            }
    }
};
struct EpiIn {
    const Ctx* C; const float* rowss; const float* bias  ; int l;
    DI void operator()(const f32x4 (&acc)[2][2][4][2], const Unit& u, int wr, int wc, int fr_, int fq_) const {
        int tz_ = threadIdx.x; OPAQUE(tz_); const int fr = tz_ & 15, fq = (tz_ & 63) >> 4; (void)fr_; (void)fq_;
        const int s = stream_of_panel(u.pm), pn = u.pn; const float* bs = bias + (size_t)s * NINP + pn * 256 + wc * 32 + 4 * fq;
        unsigned char* ws = C->ws;
        f32x4 bv[2][2];
#pragma unroll
        for (int bj = 0; bj < 2; ++bj)
#pragma unroll
            for (int n = 0; n < 2; ++n) bv[bj][n] = *(const f32x4*)(bs + bj * 128 + n * 16);
        const bool permuted = pn < PN_AV || (pn >= PN_CQ && pn < PN_DU);
        if (permuted) {
            const bool is_ckv = pn == PN_CKV, is_c = pn >= PN_CQ, is_q = pn < PN_AK || (pn >= PN_CQ && pn < PN_CKV);
            const bool plain_v = is_ckv && wc >= 2;
            const float* gsrc = C->in[is_c ? (is_q ? I_WAQG : I_WAKG) : (is_q ? I_NAQG : I_NAKG)] + (size_t)l * 64;
            f32x4 gn[2][2];
#pragma unroll
            for (int bj = 0; bj < 2; ++bj)
#pragma unroll
                for (int n = 0; n < 2; ++n) { gn[bj][n] = *(const f32x4*)(gsrc + 32 * bj + 16 * n + 4 * fq); if (is_q) gn[bj][n] *= 0.125f; }
            bf16* dst; int pitch, hcol;
            if (pn < PN_AK) { dst = (bf16*)(ws + WS_QA); pitch = GW; hcol = ((pn - PN_AQ) * 4 + wc) * 64; }
            else if (pn < PN_AV) { dst = (bf16*)(ws + WS_KA); pitch = GW; hcol = ((pn - PN_AK) * 4 + wc) * 64; }
            else if (pn < PN_CKV) { dst = (bf16*)(ws + WS_QC); pitch = GW; hcol = ((pn - PN_CQ) * 4 + wc) * 64; }
            else if (wc < 2) { dst = (bf16*)(ws + WS_KC); pitch = 128; hcol = wc * 64; }
            else { dst = (bf16*)(ws + WS_VC); pitch = 128; hcol = (wc - 2) * 64; }
            const f32x4* rope = (const f32x4*)(ws + WS_ROPE);
#pragma unroll
            for (int ai = 0; ai < 2; ++ai)
#pragma unroll
                for (int m = 0; m < 4; ++m) {
                    const int row = pn * 0 + u.pm * 256 + ai * 128 + wr * 64 + m * 16 + fr;
                    const float rstd = 1.0f / sqrtf(rowss[row] * (1.0f / D) + NORM_EPS);
                    f32x4 v[2][2]; float ss = 0.f;
#pragma unroll
                    for (int bj = 0; bj < 2; ++bj)
#pragma unroll
                        for (int n = 0; n < 2; ++n) { v[bj][n] = acc[ai][bj][m][n] * rstd + bv[bj][n]; ss += (v[bj][n][0] * v[bj][n][0] + v[bj][n][1] * v[bj][n][1]) + (v[bj][n][2] * v[bj][n][2] + v[bj][n][3] * v[bj][n][3]); }
                    ss += __shfl_xor(ss, 16); ss += __shfl_xor(ss, 32);
                    if (!plain_v) { const float rs = 1.0f / sqrtf(ss * (1.0f / 64.0f) + NORM_EPS);
#pragma unroll
                        for (int bj = 0; bj < 2; ++bj)
#pragma unroll
                            for (int n = 0; n < 2; ++n) v[bj][n] = v[bj][n] * rs * gn[bj][n];
                        if (is_c && row < M_LAT) {
                            const int t = row % T; const int pos[2] = {t / GRW, t % GRW};
#pragma unroll
                            for (int bj = 0; bj < 2; ++bj) { const f32x4 cs0 = rope[(pos[bj] * 16 + 4 * fq) / 2], cs1 = rope[(pos[bj] * 16 + 4 * fq) / 2 + 1];
                                const float cc[4] = {cs0[0], cs0[2], cs1[0], cs1[2]}, sn[4] = {cs0[1], cs0[3], cs1[1], cs1[3]};
#pragma unroll
                                for (int j = 0; j < 4; ++j) { const float x1 = v[bj][0][j], x2 = v[bj][1][j]; v[bj][0][j] = x1 * cc[j] - x2 * sn[j]; v[bj][1][j] = x2 * cc[j] + x1 * sn[j]; } }
                        }
                    }
                    bf16* op = dst + (size_t)row * pitch + hcol + 4 * fq;
#pragma unroll
                    for (int bj = 0; bj < 2; ++bj)
#pragma unroll
                        for (int n = 0; n < 2; ++n) { u32x2 w; w.x = pk2(v[bj][n][0], v[bj][n][1]); w.y = pk2(v[bj][n][2], v[bj][n][3]); *(u32x2*)(op + 32 * bj + 16 * n) = w; }
                }
        } else {
#pragma unroll
            for (int ai = 0; ai < 2; ++ai)
#pragma unroll
                for (int m = 0; m < 4; ++m) {
                    const int row = u.pm * 256 + ai * 128 + wr * 64 + m * 16 + fr;
                    const float rstd = 1.0f / sqrtf(rowss[row] * (1.0f / D) + NORM_EPS);
#pragma unroll
                    for (int bj = 0; bj < 2; ++bj)
#pragma unroll
                        for (int n = 0; n < 2; ++n) { const f32x4 v = acc[ai][bj][m][n] * rstd + bv[bj][n]; const int c = bj * 128 + wc * 32 + n * 16 + 4 * fq;
                            u32x2 w; w.x = pk2(v[0], v[1]); w.y = pk2(v[2], v[3]);
                            if (pn < PN_BR) *(u32x2*)((bf16*)(ws + WS_VA) + (size_t)row * GW + (pn - PN_AV) * 256 + c) = w;
                            else if (pn < PN_BS) *(u32x2*)((bf16*)(ws + WS_PB) + (size_t)row * 3 * GW + (pn - PN_BR) * 256 + c) = w;
                            else if (pn == PN_BS) { if (c < 160) *(f32x4*)((float*)(ws + WS_PS) + (size_t)row * 160 + c) = v; }
                            else { const int cu = (pn - PN_DU) * 256 + c, gq = cu >> 4, p0 = cu & 15;
                                *(u32x2*)((bf16*)(ws + WS_UG) + ((size_t)gq * NCHP + row / S5L) * S5K + (row % S5L) * 16 + p0) = w; } }
                }
        }
    }
};
struct EpiS5A {
    float* XE;
    DI void operator()(const f32x4 (&acc)[2][2][4][2], const Unit& u, int wr, int wc, int fr_, int fq_) const {
        int tz_ = threadIdx.x; OPAQUE(tz_); const int fr = tz_ & 15, fq = (tz_ & 63) >> 4; (void)fr_; (void)fq_;
#pragma unroll
        for (int ai = 0; ai < 2; ++ai)
#pragma unroll
            for (int m = 0; m < 4; ++m) { const int ch = u.pm * 256 + ai * 128 + wr * 64 + m * 16 + fr; if (ch < NCH) { float* p = XE + ((size_t)u.z * NCHP + ch) * 256 + wc * 32 + 4 * fq;
#pragma unroll
                for (int bj = 0; bj < 2; ++bj)
#pragma unroll
                    for (int n = 0; n < 2; ++n) *(f32x4*)(p + bj * 128 + n * 16) = acc[ai][bj][m][n]; } }
    }
};
struct EpiS5C {
    const bf16* UG; const float* dsk  ; bf16* YG;
    DI void operator()(const f32x4 (&acc)[2][2][4][2], const Unit& u, int wr, int wc, int fr_, int fq_) const {
        int tz_ = threadIdx.x; OPAQUE(tz_); const int fr = tz_ & 15, fq = (tz_ & 63) >> 4; (void)fr_; (void)fq_;
        const int g = u.z;
#pragma unroll
        for (int ai = 0; ai < 2; ++ai)
#pragma unroll
            for (int m = 0; m < 4; ++m) { const int ch = u.pm * 256 + ai * 128 + wr * 64 + m * 16 + fr; if (ch < NCH) {
#pragma unroll
                for (int bj = 0; bj < 2; ++bj)
#pragma unroll
                    for (int n = 0; n < 2; ++n) { const int col = u.pn * 256 + bj * 128 + wc * 32 + n * 16 + 4 * fq, i = col >> 4, p0 = col & 15;
                        const u32x2 uw = *(const u32x2*)(UG + ((size_t)g * NCHP + ch) * S5K + col); const f32x4 dv = *(const f32x4*)(dsk + 16 * g + p0);
                        const f32x4 a = acc[ai][bj][m][n]; const float y0 = a[0] + dv[0] * bflo(uw.x), y1 = a[1] + dv[1] * bfhi(uw.x), y2 = a[2] + dv[2] * bflo(uw.y), y3 = a[3] + dv[3] * bfhi(uw.y);
                        u32x2 w; w.x = pk2(geluf(y0), geluf(y1)); w.y = pk2(geluf(y2), geluf(y3));
                        *(u32x2*)(YG + (size_t)(ch * S5L + i) * GW + 16 * g + p0) = w; } } }
    }
};
struct EpiGLU {
    const bf16* YG; const float* gb; bf16* OB;
    DI void operator()(const f32x4 (&acc)[2][2][4][2], const Unit& u, int wr, int wc, int fr_, int fq_) const {
        int tz_ = threadIdx.x; OPAQUE(tz_); const int fr = tz_ & 15, fq = (tz_ & 63) >> 4; (void)fr_; (void)fq_;
#pragma unroll
        for (int ai = 0; ai < 2; ++ai)
#pragma unroll
            for (int m = 0; m < 4; ++m) { const int row = u.pm * 256 + ai * 128 + wr * 64 + m * 16 + fr;
#pragma unroll
                for (int bj = 0; bj < 2; ++bj)
#pragma unroll
                    for (int n = 0; n < 2; ++n) { const int col = u.pn * 256 + bj * 128 + wc * 32 + n * 16 + 4 * fq; const f32x4 b = *(const f32x4*)(gb + col); const f32x4 a = acc[ai][bj][m][n] + b;
                        const u32x2 yw = *(const u32x2*)(YG + (size_t)row * GW + col);
                        u32x2 w; w.x = pk2(bflo(yw.x) * sigmf(a[0]), bfhi(yw.x) * sigmf(a[1])); w.y = pk2(bflo(yw.y) * sigmf(a[2]), bfhi(yw.y) * sigmf(a[3]));
                        *(u32x2*)(OB + (size_t)row * D + 3 * GW + col) = w; } }
    }
};

DI void ph_ada(const Ctx& C) {
    LAS float* sc = (LAS float*)C.lds;
    LAS float* red = sc + 3 * D;
    for (int i = C.tid; i < 3 * D; i += NTHR) { const int s = i / D, k = i % D; const float c = s < NB ? C.in[I_C][s * D + k] : C.in[I_CCTX][k]; sc[i] = siluf(c); }
    __syncthreads();
    const int nun = NL * (9 * D / 256);
    for (int un = C.bid; un < nun; un += C.G) {
        const int l = un / (9 * D / 256), col0 = (un % (9 * D / 256)) * 256;
        const float* W = C.in[I_WADA] + (size_t)l * D * 9 * D + col0 + 4 * C.lane;
        f32x4 a0 = {0.f, 0.f, 0.f, 0.f}, a1 = a0, a2 = a0;
        const int k0 = C.wave * (D / 8);
#pragma unroll 4
        for (int k = k0; k < k0 + D / 8; ++k) { const f32x4 w = *(const f32x4*)(W + (size_t)k * 9 * D); a0 += w * sc[k]; a1 += w * sc[D + k]; a2 += w * sc[2 * D + k]; }
        LAS float* r = red + C.wave * 768 + 4 * C.lane;
        *(LAS f32x4*)(r) = a0; *(LAS f32x4*)(r + 256) = a1; *(LAS f32x4*)(r + 512) = a2;
        __syncthreads();
        for (int i = C.tid; i < 768; i += NTHR) { float s = 0.f;
#pragma unroll
            for (int w = 0; w < 8; ++w) s += red[w * 768 + i];
            const int st = i / 256, c = col0 + (i % 256);
            ((float*)(C.ws + WS_MODV))[((size_t)l * 3 + st) * 9 * D + c] = s + C.in[I_BADA][(size_t)l * 9 * D + c]; }
        __syncthreads();
    }
}
DI const float* modv_ptr(const Ctx& C, int l, int s, int chunk) { return (const float*)(C.ws + WS_MODV) + ((size_t)l * 3 + s) * 9 * D + (size_t)chunk * D; }

DI int win_dest(int n) {
    if (n >= D_IN) return -1;
    if (n < SRC_AV) { const int piece = n / GW, loc = n % GW, head = loc / 64, d = loc % 64; return ((piece == 0 ? PN_AQ : PN_AK) + head / 4) * 256 + 128 * (d / 32) + 32 * (head % 4) + (d % 32); }
    if (n < SRC_BS) return PN_AV * 256 + (n - SRC_AV);
    if (n < SRC_CQ) return PN_BS * 256 + (n - SRC_BS);
    if (n < SRC_CK) { const int loc = n - SRC_CQ, head = loc / 64, d = loc % 64; return (PN_CQ + head / 4) * 256 + 128 * (d / 32) + 32 * (head % 4) + (d % 32); }
    if (n < SRC_DU) { const int loc = n - SRC_CK, hh = loc / 64, d = loc % 64; return PN_CKV * 256 + 128 * (d / 32) + 32 * hh + (d % 32); }
    return PN_DU * 256 + (n - SRC_DU);
}
DI void conv_item(const Ctx& C, const float* W, int K, int N, bf16* Wt, int mode, int k0, int n0, float* bias, int bias_pitch, const float* shift  ) {
    LAS float* scr = (LAS float*)(C.lds + C.wave * 16640);
    const int n = n0 + C.lane; const bool ok = n < N; float b0 = 0.f, b1 = 0.f, b2 = 0.f;
#pragma unroll 8
    for (int kk = 0; kk < 64; ++kk) { const float v = ok ? W[(size_t)(k0 + kk) * N + n] : 0.f; scr[kk * 65 + C.lane] = v;
        if (bias) { b0 += shift[k0 + kk] * v; b1 += shift[9 * D + k0 + kk] * v; b2 += shift[18 * D + k0 + kk] * v; } }
    WSYNC();
    const int dme = !ok ? -1 : mode == 0 ? n : mode == 1 ? (n / 128) * 256 + n % 128 : mode == 2 ? (n / 128) * 256 + 128 + n % 128 : win_dest(n);
    if (bias && dme >= 0) { atomicAdd(bias + dme, b0); atomicAdd(bias + bias_pitch + dme, b1); atomicAdd(bias + 2 * bias_pitch + dme, b2); }
    const int c = C.lane & 7;
#pragma unroll
    for (int i = 0; i < 8; ++i) { const int nl = (C.lane >> 3) + 8 * i, nn = n0 + nl;
        const int dr = nn >= N ? -1 : mode == 0 ? nn : mode == 1 ? (nn / 128) * 256 + nn % 128 : mode == 2 ? (nn / 128) * 256 + 128 + nn % 128 : win_dest(nn);
        const LAS float* s = scr + (8 * c) * 65 + nl;
        u32x4 o; o.x = pk2(s[0], s[65]); o.y = pk2(s[2 * 65], s[3 * 65]); o.z = pk2(s[4 * 65], s[5 * 65]); o.w = pk2(s[6 * 65], s[7 * 65]);
        if (dr >= 0) *(u32x4*)(Wt + (size_t)dr * K + k0 + 8 * c) = o; }
    WSYNC();
}
struct Cplx { float re, im; };
DI Cplx cmul(Cplx a, Cplx b) { return Cplx{a.re * b.re - a.im * b.im, a.re * b.im + a.im * b.re}; }
DI Cplx s5_lam_pow(const Ctx& C, int l, int dir, int g, int n, float tau) {
    const size_t i = (((size_t)l * 2 + dir) * S5G + g) * 64 + n; const float dt = __expf(C.in[I_S5LDT][((size_t)l * 2 + dir) * S5G + g]);
    const float mag = __expf(tau * dt * C.in[I_S5ARE][i]), ang = tau * dt * C.in[I_S5AIM][i]; float sn, cs; sincosf(ang, &sn, &cs); return Cplx{mag * cs, mag * sn};
}
DI Cplx s5_coef(const Ctx& C, int l, int dir, int g, int n) {
    const size_t i = (((size_t)l * 2 + dir) * S5G + g) * 64 + n; const float are = C.in[I_S5ARE][i], aim = C.in[I_S5AIM][i];
    const Cplx ab = s5_lam_pow(C, l, dir, g, n, 1.0f); const float den = are * are + aim * aim, nr = ab.re - 1.0f;
    return Cplx{(nr * are + ab.im * aim) / den, (ab.im * are - nr * aim) / den};
}
DI Cplx s5_beta(const Ctx& C, int l, int dir, int g, int n, int q) {
    const size_t i = (((size_t)l * S5G + g) * 64 + n) * 16 + q; return cmul(s5_coef(C, l, dir, g, n), Cplx{C.in[I_S5BRE][i], C.in[I_S5BIM][i]});
}
DI Cplx s5_gamma(const Ctx& C, int l, int g, int p, int n) { const size_t i = (((size_t)l * S5G + g) * 16 + p) * 64 + n; return Cplx{C.in[I_S5CRE][i], C.in[I_S5CIM][i]}; }

constexpr int CI_GU = (D / 64) * (FF / 64), CI_DN = (FF / 64) * (D / 64), CI_IN = (D / 64) * ((D_IN + 63) / 64), CI_OUT = (D / 64) * (D / 64), CI_GLU = (GW / 64) * (GW / 64);
constexpr int CI_LAYER = 4 * CI_GU + 2 * CI_DN + CI_IN + CI_OUT + CI_GLU;
DI void ph_conv(const Ctx& C) {
    const int gt = C.bid * NTHR + C.tid, GT = C.G * NTHR;
    for (int i = gt; i < NL * 9 * D; i += GT) { const int k = i % D, s = (i / D) % 3, sub = (i / (3 * D)) % 3, l = i / (9 * D);
        const float* mv = (const float*)(C.ws + WS_MODV) + ((size_t)l * 3 + s) * 9 * D;
        ((float*)(C.ws + WS_GS))[i] = C.in[I_NORMG][((size_t)l * 3 + sub) * D + k] * (1.0f + mv[(3 * sub + 1) * D + k]);
        ((float*)(C.ws + WS_GATE))[i] = mv[(3 * sub + 2) * D + k] * (sub == 1 ? 1.0f : 0.5f); }
    for (int i = gt; i < 128 * 16; i += GT) { const int pos = i / 16, f = i % 16; const float inv = __expf(-(float)f * (9.210340371976184f / 16.0f)); float sn, cs; sincosf((float)pos * inv, &sn, &cs);
        ((f32x2*)(C.ws + WS_ROPE))[i] = (f32x2){cs, sn}; }
    const int gw = C.bid * NW + C.wave, GWV = C.G * NW;
    for (int it = gw; it < NL * CI_LAYER; it += GWV) {
        const int l = it / CI_LAYER; int r = it % CI_LAYER;
        unsigned char* wbase = C.ws + WS_W + (size_t)l * SZ_WL;
        if (r < 2 * CI_GU) { const int up = r >= CI_GU; r -= up * CI_GU; const int kb = r / (FF / 64), nb = r % (FF / 64);
            conv_item(C, C.in[up ? I_F1WU : I_F1WG] + (size_t)l * D * FF, D, FF, (bf16*)(wbase + OFF_W1GU), 1 + up, kb * 64, nb * 64, bias_ptr(C, l, 0), 2 * FF, modv_ptr(C, l, 0, 0)); continue; } r -= 2 * CI_GU;
        if (r < CI_DN) { const int kb = r / (D / 64), nb = r % (D / 64); conv_item(C, C.in[I_F1WD] + (size_t)l * FF * D, FF, D, (bf16*)(wbase + OFF_W1D), 0, kb * 64, nb * 64, nullptr, 0, nullptr); continue; } r -= CI_DN;
        if (r < CI_IN) { const int nbn = (D_IN + 63) / 64, kb = r / nbn, nb = r % nbn; conv_item(C, C.in[I_WIN] + (size_t)l * D * D_IN, D, D_IN, (bf16*)(wbase + OFF_WIN), 3, kb * 64, nb * 64, bias_ptr(C, l, 1), NINP, modv_ptr(C, l, 0, 3)); continue; } r -= CI_IN;
        if (r < CI_OUT) { const int kb = r / (D / 64), nb = r % (D / 64); conv_item(C, C.in[I_WOUT] + (size_t)l * D * D, D, D, (bf16*)(wbase + OFF_WOUT), 0, kb * 64, nb * 64, nullptr, 0, nullptr); continue; } r -= CI_OUT;
        if (r < 2 * CI_GU) { const int up = r >= CI_GU; r -= up * CI_GU; const int kb = r / (FF / 64), nb = r % (FF / 64);
            conv_item(C, C.in[up ? I_F2WU : I_F2WG] + (size_t)l * D * FF, D, FF, (bf16*)(wbase + OFF_W2GU), 1 + up, kb * 64, nb * 64, bias_ptr(C, l, 2), 2 * FF, modv_ptr(C, l, 0, 6)); continue; } r -= 2 * CI_GU;
        if (r < CI_DN) { const int kb = r / (D / 64), nb = r % (D / 64); conv_item(C, C.in[I_F2WD] + (size_t)l * FF * D, FF, D, (bf16*)(wbase + OFF_W2D), 0, kb * 64, nb * 64, nullptr, 0, nullptr); continue; } r -= CI_DN;
        { const int kb = r / (GW / 64), nb = r % (GW / 64); conv_item(C, C.in[I_S5GLUW] + (size_t)l * GW * GW, GW, GW, (bf16*)(wbase + OFF_WGLU), 0, kb * 64, nb * 64, nullptr, 0, nullptr); }
    }
    LAS float* wsc = (LAS float*)(C.lds + C.wave * 16640);
    for (int it = gw; it < NL * S5G * 2 * S5L; it += GWV) {
        const int tau = it % S5L, dir = (it / S5L) % 2, g = (it / (2 * S5L)) % S5G, l = it / (2 * S5L * S5G);
        const Cplx z = cmul(s5_lam_pow(C, l, dir, g, C.lane, (float)tau), s5_coef(C, l, dir, g, C.lane));
#pragma unroll 4
        for (int q = 0; q < 16; ++q) { const size_t i = (((size_t)l * S5G + g) * 64 + C.lane) * 16 + q; const Cplx w = cmul(z, Cplx{C.in[I_S5BRE][i], C.in[I_S5BIM][i]}); wsc[(C.lane * 16 + q) * 2] = w.re; wsc[(C.lane * 16 + q) * 2 + 1] = w.im; }
        WSYNC();
        float* kc = (float*)(C.ws + WS_S5T + (size_t)l * SZ_S5L + OFF_S5KC) + (((size_t)g * 2 + dir) * S5L + tau) * 256;
#pragma unroll 1
        for (int e = 0; e < 4; ++e) { const int pq = C.lane + 64 * e, p = pq >> 4, q = pq & 15; float s = 0.f;
#pragma unroll 4
            for (int n = 0; n < 64; ++n) { const Cplx gm = s5_gamma(C, l, g, p, n); s += gm.re * wsc[(n * 16 + q) * 2] - gm.im * wsc[(n * 16 + q) * 2 + 1]; }
            kc[pq] = s; }
        WSYNC();
    }
    for (int i = gt; i < NL * 2 * GW * 4; i += GT) { const int n = i % 64, g = (i / 64) % S5G, dir = (i / (64 * S5G)) % 2, l = i / (2 * 64 * S5G); const Cplx z = s5_lam_pow(C, l, dir, g, n, (float)S5L);
        ((f32x2*)(C.ws + WS_S5T + (size_t)l * SZ_S5L + OFF_S5LAM))[(dir * S5G + g) * 64 + n] = (f32x2){z.re, z.im}; }
}
DI void ph_tab(const Ctx& C) {
    const long gt = (long)C.bid * NTHR + C.tid, GT = (long)C.G * NTHR;
    for (long i = gt; i < (long)NL * S5G * 256 * 512; i += GT) {
        const int k = (int)(i % 512), np = (int)((i / 512) % 256), g = (int)((i / (512 * 256)) % S5G), l = (int)(i / ((long)512 * 256 * S5G));
        const int j = k >> 4, q = k & 15, dir = np >> 7, n = np & 63, im = (np >> 6) & 1;
        const Cplx w = cmul(s5_lam_pow(C, l, dir, g, n, dir == 0 ? (float)(S5L - 1 - j) : (float)j), s5_beta(C, l, dir, g, n, q));
        ((bf16*)(C.ws + WS_S5T + (size_t)l * SZ_S5L + OFF_S5ET))[((size_t)g * 256 + np) * 512 + k] = (bf16)f2bf(im ? w.im : w.re); }
    for (long i = gt; i < (long)NL * S5G * 512 * S5K; i += GT) {
        const int k = (int)(i % S5K), nn = (int)((i / S5K) % 512), g = (int)((i / ((long)S5K * 512)) % S5G), l = (int)(i / ((long)S5K * 512 * S5G));
        const int ti = nn >> 4, p = nn & 15; float v;
        if (k < 512) { const int j = k >> 4, q = k & 15; const float* kc = (const float*)(C.ws + WS_S5T + (size_t)l * SZ_S5L + OFF_S5KC) + (size_t)g * 2 * S5L * 256;
            v = 0.f; if (j <= ti) v += kc[((ti - j)) * 256 + p * 16 + q]; if (j >= ti) v += kc[(S5L + (j - ti)) * 256 + p * 16 + q]; }
        else { const int kk = k - 512, dir = kk >> 7, im = (kk >> 6) & 1, n = kk & 63;
            const Cplx w = cmul(s5_gamma(C, l, g, p, n), s5_lam_pow(C, l, dir, g, n, dir == 0 ? (float)(ti + 1) : (float)(S5L - ti))); v = im ? -w.im : w.re; }
        ((bf16*)(C.ws + WS_S5T + (size_t)l * SZ_S5L + OFF_S5BT))[((size_t)g * 512 + nn) * S5K + k] = (bf16)f2bf(v); }
    const int gw = C.bid * NW + C.wave, GWV = C.G * NW;
    for (int row = gw; row < M; row += GWV) {
        const float* src = row < M_LAT ? C.in[I_X] + (size_t)row * D : C.in[I_CTX] + (size_t)(row - M_LAT) * D;
        float* dst = xrow_ptr(C, row); const float* gs = gs_ptr(C, 0, 0, stream_of_row(row)); bf16* ap = (bf16*)(C.ws + WS_AP) + (size_t)row * D; float ss = 0.f;
        for (int c = 4 * C.lane; c < D; c += 256) { const f32x4 x = *(const f32x4*)(src + c); *(f32x4*)(dst + c) = x; ss += (x[0] * x[0] + x[1] * x[1]) + (x[2] * x[2] + x[3] * x[3]);
            const f32x4 a = x * *(const f32x4*)(gs + c); u32x2 w; w.x = pk2(a[0], a[1]); w.y = pk2(a[2], a[3]); *(u32x2*)(ap + c) = w; }
        ss = wave_sum(ss); if (C.lane == 0) rowss_ptr(C, 0, 0)[row] = ss;
    }
}

#ifdef EMU
DI s16x4 tr_read1(const LAS unsigned char* a) { return emu_tr_read(a); }
#else
DI s16x4 tr_read1(const LAS unsigned char* a) { s16x4 r; asm volatile("ds_read_b64_tr_b16 %0, %1\n\ts_waitcnt lgkmcnt(0)" : "=&v"(r) : "v"((unsigned)(size_t)a) : "memory"); return r; }
#endif
DI bf16x8 pack8(const f32x16& x, int s) {
    u32x4 p; p.x = pk2(x[8 * s], x[8 * s + 1]); p.y = pk2(x[8 * s + 2], x[8 * s + 3]); p.z = pk2(x[8 * s + 4], x[8 * s + 5]); p.w = pk2(x[8 * s + 6], x[8 * s + 7]);
    return __builtin_bit_cast(bf16x8, p);
}
struct AttnSt { f32x16 o0, o1; float m, l; };
template <bool MASKED>
DI void attn_block(AttnSt& st, const bf16x8 (&qf)[4], const bf16* Kb, int kp, const bf16* Vb, int vp, LAS unsigned char* vl, int lane, const float (&addv)[16], unsigned vmask) {
    const int r32 = lane & 31, h = lane >> 5;
#pragma unroll
    for (int i = 0; i < 4; ++i) { const int idx = lane + 64 * i, key = idx >> 3, ch = idx & 7; *(LAS u32x4*)(vl + key * 128 + ch * 16) = *(const u32x4*)(Vb + (size_t)key * vp + ch * 8); }
    f32x16 s;
#pragma unroll
    for (int i = 0; i < 16; ++i) s[i] = 0.f;
#pragma unroll
    for (int kk = 0; kk < 4; ++kk) { const bf16x8 kf = *(const bf16x8*)(Kb + (size_t)r32 * kp + 16 * kk + 8 * h); s = __builtin_amdgcn_mfma_f32_32x32x16_bf16(kf, qf[kk], s, 0, 0, 0); }
    float bm = -1e30f;
#pragma unroll
    for (int i = 0; i < 16; ++i) { if (MASKED) { s[i] += addv[i]; if ((vmask >> i) & 1u) bm = fmaxf(bm, s[i]); } else bm = fmaxf(bm, s[i]); }
    bm = fmaxf(bm, __shfl_xor(bm, 32));
    const float mn = fmaxf(st.m, bm), alpha = __expf(st.m - mn); st.m = mn;
    float ls = 0.f;
#pragma unroll
    for (int i = 0; i < 16; ++i) { float p = __expf(s[i] - mn); if (MASKED) p = ((vmask >> i) & 1u) ? p : 0.f; s[i] = p; ls += p; }
    st.l = st.l * alpha + ls;
#pragma unroll
    for (int i = 0; i < 16; ++i) { st.o0[i] *= alpha; st.o1[i] *= alpha; }
    WSYNC();
    const int q = (lane & 15) >> 2, p4 = lane & 3, blk = (lane >> 4) & 1;
#pragma unroll
    for (int sx = 0; sx < 2; ++sx) {
        const bf16x8 pf = pack8(s, sx);
#pragma unroll
        for (int dt = 0; dt < 2; ++dt) {
            const LAS unsigned char* a0 = vl + (16 * sx + 4 * h + q) * 128 + (32 * dt + 16 * blk) * 2 + 8 * p4;
            const s16x4 lo = tr_read1(a0), hi = tr_read1(a0 + 8 * 128);
            const bf16x8 vf = __builtin_shufflevector(lo, hi, 0, 1, 2, 3, 4, 5, 6, 7);
            if (dt == 0) st.o0 = __builtin_amdgcn_mfma_f32_32x32x16_bf16(vf, pf, st.o0, 0, 0, 0); else st.o1 = __builtin_amdgcn_mfma_f32_32x32x16_bf16(vf, pf, st.o1, 0, 0, 0);
        }
    }
}
DI void attn_finish(AttnSt& st, bf16* orow  , int lane, float extra_l) {
    const int h = lane >> 5; float l = st.l + __shfl_xor(st.l, 32) + extra_l; const float inv = 1.0f / l;
#pragma unroll
    for (int g = 0; g < 4; ++g) {
        u32x2 w0, w1; w0.x = pk2(st.o0[4 * g] * inv, st.o0[4 * g + 1] * inv); w0.y = pk2(st.o0[4 * g + 2] * inv, st.o0[4 * g + 3] * inv);
        w1.x = pk2(st.o1[4 * g] * inv, st.o1[4 * g + 1] * inv); w1.y = pk2(st.o1[4 * g + 2] * inv, st.o1[4 * g + 3] * inv);
        *(u32x2*)(orow + 8 * g + 4 * h) = w0; *(u32x2*)(orow + 32 + 8 * g + 4 * h) = w1; }
}
DI int clampi(int v, int lo, int hi) { return v < lo ? lo : (v > hi ? hi : v); }
constexpr int AT_NA = NB * NH * (GRH / 2) * 4, AT_WA = NB * NH * (T / 32), AT_CX = NB * NH * (TC / 32);
DI void ph_attn(const Ctx& C, int l, bool want_ctx) {
    const int gw = C.bid * NW + C.wave, GWV = C.G * NW, lane = C.lane, r32 = lane & 31, h = lane >> 5;
    LAS unsigned char* vl = C.lds + C.wave * 4096;
    const bf16* QA = (const bf16*)(C.ws + WS_QA); const bf16* KA = (const bf16*)(C.ws + WS_KA); const bf16* VA = (const bf16*)(C.ws + WS_VA);
    const bf16* QC = (const bf16*)(C.ws + WS_QC); const bf16* KC = (const bf16*)(C.ws + WS_KC); const bf16* VC = (const bf16*)(C.ws + WS_VC);
    bf16* OB = (bf16*)(C.ws + WS_OB);
    const int ntiles = AT_NA + AT_WA + (want_ctx ? 2 * AT_CX : 0);
    const float zero16[16] = {0.f, 0.f, 0.f, 0.f, 0.f, 0.f, 0.f, 0.f, 0.f, 0.f, 0.f, 0.f, 0.f, 0.f, 0.f, 0.f};
    for (int tile = gw; tile < ntiles; tile += GWV) {
        AttnSt st; st.m = -1e30f; st.l = 0.f;
#pragma unroll
        for (int i = 0; i < 16; ++i) { st.o0[i] = 0.f; st.o1[i] = 0.f; }
        bf16x8 qf[4];
        if (tile < AT_NA) {
            const int cb = tile & 3, rp = (tile >> 2) % (GRH / 2), hd = (tile / (4 * (GRH / 2))) % NH, b = tile / (4 * (GRH / 2) * NH);
            const int r0 = 2 * rp, c0 = 16 * cb, qr = r0 + (r32 >> 4), qc = c0 + (r32 & 15), qrow = b * T + qr * GRW + qc;
#pragma unroll
            for (int kk = 0; kk < 4; ++kk) qf[kk] = *(const bf16x8*)(QA + (size_t)qrow * GW + hd * 64 + 16 * kk + 8 * h);
            const int rsq = clampi(qr - 4, 0, GRH - 8), csq = clampi(qc - 8, 0, GRW - 16);
            const int rsA = clampi(r0 - 4, 0, GRH - 8), rsB = clampi(r0 + 1 - 4, 0, GRH - 8), kc0 = clampi(c0 - 8, 0, GRW - 32);
            const float* rpb = C.in[I_NARPB] + ((size_t)l * NH + hd) * 465;
            for (int kr = rsA; kr <= rsB + 7; ++kr) {
                float addv[16]; unsigned vm = 0u; const bool rok = kr >= rsq && kr <= rsq + 7;
#pragma unroll
                for (int i = 0; i < 16; ++i) { const int kb = (i & 3) + 8 * (i >> 2) + 4 * h, kc = kc0 + kb; const bool ok = rok && kc >= csq && kc <= csq + 15;
                    const int bi = ok ? (kr - qr + 7) * 31 + (kc - qc + 15) : 0; addv[i] = rpb[bi]; vm |= ok ? (1u << i) : 0u; }
                const size_t krow = (size_t)b * T + kr * GRW + kc0;
                attn_block<true>(st, qf, KA + krow * GW + hd * 64, GW, VA + krow * GW + hd * 64, GW, vl, lane, addv, vm);
            }
            for (int cbk = 0; cbk < TC / 32; ++cbk) { const size_t krow = (size_t)M_LAT + b * TC + 32 * cbk;
                attn_block<false>(st, qf, KA + krow * GW + hd * 64, GW, VA + krow * GW + hd * 64, GW, vl, lane, zero16, 0xffffu); }
            attn_finish(st, OB + (size_t)qrow * D + hd * 64, lane, 0.f);
        } else if (tile < AT_NA + AT_WA) {
            const int t2 = tile - AT_NA, qb = t2 % (T / 32), hd = (t2 / (T / 32)) % NH, b = t2 / ((T / 32) * NH), kvh = hd / WAG;
            const int qt = 32 * qb + r32, qrow = b * T + qt;
#pragma unroll
            for (int kk = 0; kk < 4; ++kk) qf[kk] = *(const bf16x8*)(QC + (size_t)qrow * GW + hd * 64 + 16 * kk + 8 * h);
            for (int i9 = 0; i9 < 9; ++i9) { const int t0 = 32 * qb - 128 + 32 * i9; if (t0 < 0 || t0 >= T) continue;
                float addv[16]; unsigned vm = 0u;
#pragma unroll
                for (int i = 0; i < 16; ++i) { const int kt = t0 + (i & 3) + 8 * (i >> 2) + 4 * h, rel = kt - qt; addv[i] = 0.f; vm |= (rel >= -128 && rel <= 128) ? (1u << i) : 0u; }
                const size_t krow = (size_t)b * T + t0;
                attn_block<true>(st, qf, KC + krow * 128 + kvh * 64, 128, VC + krow * 128 + kvh * 64, 128, vl, lane, addv, vm); }
            for (int cbk = 0; cbk < TC / 32; ++cbk) { const size_t krow = (size_t)M_LAT + b * TC + 32 * cbk;
                attn_block<false>(st, qf, KC + krow * 128 + kvh * 64, 128, VC + krow * 128 + kvh * 64, 128, vl, lane, zero16, 0xffffu); }
            const float sk = C.in[I_WASINK][(size_t)l * NH + hd];
            const float mfin = fmaxf(st.m, sk), a2 = __expf(st.m - mfin);
#pragma unroll
            for (int i = 0; i < 16; ++i) { st.o0[i] *= a2; st.o1[i] *= a2; }
            st.l *= a2; st.m = mfin;
            attn_finish(st, OB + (size_t)qrow * D + 2 * GW + hd * 64, lane, __expf(sk - mfin));
        } else {
            const int t2 = tile - AT_NA - AT_WA, isc = t2 >= AT_CX, t3 = t2 - isc * AT_CX, qb = t3 % (TC / 32), hd = (t3 / (TC / 32)) % NH, b = t3 / ((TC / 32) * NH), kvh = hd / WAG;
            const int qrow = M_LAT + b * TC + 32 * qb + r32;
            const bf16* Qs = isc ? QC : QA; const bf16* Ks = isc ? KC + kvh * 64 : KA + hd * 64; const bf16* Vs = isc ? VC + kvh * 64 : VA + hd * 64; const int kp = isc ? 128 : GW;
#pragma unroll
            for (int kk = 0; kk < 4; ++kk) qf[kk] = *(const bf16x8*)(Qs + (size_t)qrow * GW + hd * 64 + 16 * kk + 8 * h);
            for (int cbk = 0; cbk < TC / 32; ++cbk) { const size_t krow = (size_t)M_LAT + b * TC + 32 * cbk;
                attn_block<false>(st, qf, Ks + krow * kp, kp, Vs + krow * kp, kp, vl, lane, zero16, 0xffffu); }
            float extra = 0.f;
            if (isc) { const float sk = C.in[I_WASINK][(size_t)l * NH + hd]; const float mfin = fmaxf(st.m, sk), a2 = __expf(st.m - mfin);
#pragma unroll
                for (int i = 0; i < 16; ++i) { st.o0[i] *= a2; st.o1[i] *= a2; }
                st.l *= a2; st.m = mfin; extra = __expf(sk - mfin); }
            attn_finish(st, OB + (size_t)qrow * D + (isc ? 2 * GW : 0) + hd * 64, lane, extra);
        }
    }
}

DI void ph_rwprep(const Ctx& C, int l) {
    LAS float* sm = (LAS float*)C.lds;
    const int c = C.tid; const bool act = c < GW;
    const bf16* PB = (const bf16*)(C.ws + WS_PB); const float* PS = (const float*)(C.ws + WS_PS);
    const float* cw = C.in[I_RWCONV] + (size_t)l * 9 * GW;
    float cwv[3][3];
    if (act) {
#pragma unroll
        for (int j = 0; j < 3; ++j)
#pragma unroll
            for (int x = 0; x < 3; ++x) cwv[j][x] = cw[(size_t)j * 3 * GW + x * GW + c]; }
    const float w00 = act ? C.in[I_RWW0][((size_t)l * 2 + 0) * GW + c] : 0.f, w01 = act ? C.in[I_RWW0][((size_t)l * 2 + 1) * GW + c] : 0.f;
    const float a00 = act ? C.in[I_RWA0][((size_t)l * 2 + 0) * GW + c] : 0.f, a01 = act ? C.in[I_RWA0][((size_t)l * 2 + 1) * GW + c] : 0.f;
    const float kkw = act ? C.in[I_RWKK][(size_t)l * GW + c] : 0.f, kaw = act ? C.in[I_RWKA][(size_t)l * GW + c] : 0.f;
    const float* wup = C.in[I_RWWUP] + (size_t)l * 2 * 32 * GW; const float* aup = C.in[I_RWAUP] + (size_t)l * 2 * 32 * GW; const float* gup = C.in[I_RWGUP] + (size_t)l * 96 * GW;
    for (int it = C.bid; it < M / 16; it += C.G) {
        const int row0 = it * 16;
        const int seq_lo = row0 < M_LAT ? (row0 / T) * T : M_LAT + ((row0 - M_LAT) / TC) * TC, seq_hi = row0 < M_LAT ? seq_lo + T : seq_lo + TC;
        __syncthreads();
        for (int i = C.tid; i < 16 * 160; i += NTHR) { const int t = i / 160, k = i % 160; const float v = PS[(size_t)(row0 + t) * 160 + k]; sm[i] = k < 32 ? tanhf(v) : (k < 64 ? v : sigmf(v)); }
        __syncthreads();
        if (act) {
            float aw0[16], aw1[16], aa0[16], aa1[16], ag[16];
#pragma unroll
            for (int t = 0; t < 16; ++t) { aw0[t] = 0.f; aw1[t] = 0.f; aa0[t] = 0.f; aa1[t] = 0.f; ag[t] = 0.f; }
            for (int k = 0; k < 32; ++k) { const float u0 = wup[(size_t)k * GW + c], u1 = wup[(size_t)(32 + k) * GW + c], v0 = aup[(size_t)k * GW + c], v1 = aup[(size_t)(32 + k) * GW + c];
#pragma unroll
                for (int t = 0; t < 16; ++t) { const float dw = sm[t * 160 + k], da = sm[t * 160 + 32 + k]; aw0[t] += dw * u0; aw1[t] += dw * u1; aa0[t] += da * v0; aa1[t] += da * v1; } }
            for (int k = 0; k < 96; ++k) { const float gv = gup[(size_t)k * GW + c];
#pragma unroll
                for (int t = 0; t < 16; ++t) ag[t] += sm[t * 160 + 64 + k] * gv; }
            float pr[3], cu[3], nx[3];
#pragma unroll
            for (int x = 0; x < 3; ++x) { pr[x] = row0 - 1 >= seq_lo ? bf2f(PB[(size_t)(row0 - 1) * 3 * GW + x * GW + c]) : 0.f; cu[x] = bf2f(PB[(size_t)row0 * 3 * GW + x * GW + c]); }
#pragma unroll
            for (int t = 0; t < 16; ++t) { const int row = row0 + t;
#pragma unroll
                for (int x = 0; x < 3; ++x) nx[x] = row + 1 < seq_hi ? bf2f(PB[(size_t)(row + 1) * 3 * GW + x * GW + c]) : 0.f;
                const float r = pr[0] * cwv[0][0] + cu[0] * cwv[1][0] + nx[0] * cwv[2][0], kf = pr[1] * cwv[0][1] + cu[1] * cwv[1][1] + nx[1] * cwv[2][1], v = pr[2] * cwv[0][2] + cu[2] * cwv[1][2] + nx[2] * cwv[2][2];
#pragma unroll
                for (int x = 0; x < 3; ++x) { pr[x] = cu[x]; cu[x] = nx[x]; }
                const float kkv = kf * kkw, ssq = wave_sum(kkv * kkv), kk = kkv / fmaxf(sqrtf(ssq), 1e-12f);
                const size_t o = (size_t)row * GW + c;
                rw_arr(C, RW_R)[o] = r; rw_arr(C, RW_V)[o] = v; rw_arr(C, RW_NKK)[o] = -kk; rw_arr(C, RW_G)[o] = ag[t];
                { const float z = -(w00 + aw0[t]), sp = z > 20.f ? z : log1pf(__expf(z)), wlog = -sp - 0.5f, a = sigmf(a00 + aa0[t]);
                  rw_arr(C, RW_W0)[o] = __expf(-__expf(wlog)); rw_arr(C, RW_K0)[o] = kf * (1.f + (a - 1.f) * kaw); rw_arr(C, RW_B0)[o] = kk * a; }
                { const float z = -(w01 + aw1[t]), sp = z > 20.f ? z : log1pf(__expf(z)), wlog = -sp - 0.5f, a = sigmf(a01 + aa1[t]);
                  rw_arr(C, RW_W1)[o] = __expf(-__expf(wlog)); rw_arr(C, RW_K1)[o] = kf * (1.f + (a - 1.f) * kaw); rw_arr(C, RW_B1)[o] = kk * a; }
            }
        }
    }
    __syncthreads();
}
template <int N> DI float ror_add(float v) { return v + __int_as_float(__builtin_amdgcn_mov_dpp(__float_as_int(v), 0x120 + N, 0xf, 0xf, true)); }
DI float row16_sum(float v) { v = ror_add<8>(v); v = ror_add<4>(v); v = ror_add<2>(v); v = ror_add<1>(v); return v; }
DI void ph_rwscan(const Ctx& C) {
    if (C.wave >= 4) return;
    const int lane = C.lane, sub = lane & 15, vr = lane >> 4;
    const int nitems = NB * NH * 2 * 16;
    for (int it = C.bid * 4 + C.wave; it < nitems; it += C.G * 4) {
        const int rg = it & 15, dir = (it >> 4) & 1, hd = (it >> 5) % NH, b = it / (32 * NH);
        const int col = hd * 64 + 4 * sub, vcol = hd * 64 + 4 * rg + vr;
        const float* Wd = rw_arr(C, dir ? RW_W1 : RW_W0); const float* Kd = rw_arr(C, dir ? RW_K1 : RW_K0); const float* Bd = rw_arr(C, dir ? RW_B1 : RW_B0);
        const float* Rr = rw_arr(C, RW_R); const float* Vv = rw_arr(C, RW_V); const float* Nk = rw_arr(C, RW_NKK); float* Y = rw_arr(C, dir ? RW_Y1 : RW_Y0);
        f32x4 s = {0.f, 0.f, 0.f, 0.f};
        for (int seg = 0; seg < 2; ++seg) {
            const int base = seg == 0 ? M_LAT + b * TC : b * T, len = seg == 0 ? TC : T;
            for (int i0 = 0; i0 < len; i0 += 4) {
                f32x4 nk[4], w4[4], b4[4], k4[4], r4[4]; float vv[4]; int rows[4];
#pragma unroll
                for (int u = 0; u < 4; ++u) { const int i = i0 + u, row = base + (dir ? len - 1 - i : i); rows[u] = row; const size_t o = (size_t)row * GW + col;
                    nk[u] = *(const f32x4*)(Nk + o); w4[u] = *(const f32x4*)(Wd + o); b4[u] = *(const f32x4*)(Bd + o); k4[u] = *(const f32x4*)(Kd + o); r4[u] = *(const f32x4*)(Rr + o); vv[u] = Vv[(size_t)row * GW + vcol]; }
#pragma unroll
                for (int u = 0; u < 4; ++u) {
                    const f32x4 p = s * nk[u]; const float sa = row16_sum((p[0] + p[1]) + (p[2] + p[3]));
                    s = s * w4[u] + b4[u] * sa + k4[u] * vv[u];
                    const f32x4 yq = s * r4[u]; const float y = row16_sum((yq[0] + yq[1]) + (yq[2] + yq[3]));
                    if (sub == 0) Y[(size_t)rows[u] * GW + vcol] = y;
                }
            }
        }
    }
}
DI void ph_rwout(const Ctx& C, int l, int mrows) {
    const int gw = C.bid * NW + C.wave, GWV = C.G * NW, lane = C.lane;
    bf16* OB = (bf16*)(C.ws + WS_OB);
    for (int it = gw; it < mrows * NH; it += GWV) {
        const int hd = it % NH, row = it / NH, c = hd * 64 + lane; const size_t o = (size_t)row * GW + c;
        const float r = rw_arr(C, RW_R)[o], v = rw_arr(C, RW_V)[o], ks = rw_arr(C, RW_K0)[o] + rw_arr(C, RW_K1)[o];
        float y = rw_arr(C, RW_Y0)[o] + rw_arr(C, RW_Y1)[o];
        y += wave_sum(r * ks * C.in[I_RWRK][((size_t)l * NH + hd) * 64 + lane]) * v;
        const float mu = wave_sum(y) * (1.f / 64.f), dlt = y - mu, var = wave_sum(dlt * dlt) * (1.f / 64.f);
        const float yn = dlt / sqrtf(var + RW_GN_EPS);
        const float ov = (yn * C.in[I_RWGNW][(size_t)l * GW + c] + C.in[I_RWGNB][(size_t)l * GW + c]) * rw_arr(C, RW_G)[o];
        OB[(size_t)row * D + GW + c] = (bf16)f2bf(ov);
    }
}
DI void ph_s5scan(const Ctx& C, int l, int first_block) {
    const int nthreads_total = NB * 2 * S5G * 64;
    if (C.bid < first_block) return;
    const float* XE = (const float*)(C.ws + WS_XEND); bf16* UG = (bf16*)(C.ws + WS_UG);
    const f32x2* LAM = (const f32x2*)(C.ws + WS_S5T + (size_t)l * SZ_S5L + OFF_S5LAM);
    for (int id = (C.bid - first_block) * NTHR + C.tid; id < nthreads_total; id += (C.G - first_block) * NTHR) {
        const int n = id & 63, g = (id >> 6) % S5G, dir = (id / (64 * S5G)) & 1, b = id / (128 * S5G);
        const f32x2 lm = LAM[(dir * S5G + g) * 64 + n]; float xr = 0.f, xi = 0.f;
        const int nc_ctx = TC / S5L, nc_lat = T / S5L, ntot = nc_ctx + nc_lat;
        for (int i0 = 0; i0 < ntot; i0 += 8) {
            float er[8], ei[8]; int chs[8];
#pragma unroll
            for (int u = 0; u < 8; ++u) { const int i = i0 + u; int ch;
                if (i < nc_ctx) ch = (M_LAT + b * TC) / S5L + (dir ? nc_ctx - 1 - i : i); else ch = (b * T) / S5L + (dir ? nc_lat - 1 - (i - nc_ctx) : (i - nc_ctx));
                chs[u] = ch; const float* p = XE + ((size_t)g * NCHP + ch) * 256 + dir * 128 + n; er[u] = p[0]; ei[u] = p[64]; }
#pragma unroll
            for (int u = 0; u < 8; ++u) { bf16* q = UG + ((size_t)g * NCHP + chs[u]) * S5K + 512 + dir * 128 + n; q[0] = (bf16)f2bf(xr); q[64] = (bf16)f2bf(xi);
                const float nr = lm[0] * xr - lm[1] * xi + er[u], ni = lm[0] * xi + lm[1] * xr + ei[u]; xr = nr; xi = ni; }
        }
    }
}

constexpr int PH_PRO = 3, PH_PER_L = 10, NPH = PH_PRO + PH_PER_L * NL;
#ifdef ONLY
#define EN(k) ((k) == ONLY)
#else
#define EN(k) true
#endif
#ifdef EMU
void fwd(Args args) {
    unsigned char* lds = emu::lds_base();
#else
__global__ void __launch_bounds__(NTHR, 2) fwd(Args args) {
    extern __shared__ __attribute__((aligned(16))) unsigned char lds[];
#endif
    Ctx C; C.in = args.in; C.out = args.out; C.ws = args.ws; C.lds = (LAS unsigned char*)lds;
    C.tid = threadIdx.x; C.lane = C.tid & 63; C.wave = __builtin_amdgcn_readfirstlane(C.tid >> 6); C.G = gridDim.x; C.bid = blockIdx.x;
#define REFRESH() do { int t_ = threadIdx.x; OPAQUE(t_); C.tid = t_; C.lane = t_ & 63; C.wave = __builtin_amdgcn_readfirstlane(t_ >> 6); } while (0)
    volatile LAS unsigned* MISC = (volatile LAS unsigned*)(C.lds + MISC_OFF);
    if (C.tid < 32) MISC[C.tid] = 0u;
    __syncthreads();
    const int lo = args.ph_lo, hi = args.ph_hi;
    const bool use_bar = (hi - lo) > 1;
    XcdBarrier bar; bar.bar = (unsigned*)(C.ws + WS_CTL) + CW_BAR; bar.x = 0; bar.st = MISC + 8;
    if (use_bar) bar = xcd_barrier_post((unsigned*)(C.ws + WS_CTL) + CW_BAR, MISC + 8);
#define IN(k) (lo <= (k) && (k) < hi)
#define SEAM(k) do { if (IN(k) && IN((k) + 1)) xcd_barrier(bar); } while (0)
    if (EN(0) && IN(0)) { REFRESH(); ph_ada(C); }
    SEAM(0);
    if (EN(1) && IN(1)) { REFRESH(); ph_conv(C); }
    SEAM(1);
    if (EN(2) && IN(2)) { REFRESH(); ph_tab(C); }
    SEAM(2);
    for (int l = 0; l < NL; ++l) {
        const int pb = PH_PRO + PH_PER_L * l; const bool want_ctx = l < NL - 1;
        const int mrows_full = M, mrows_out = want_ctx ? M : M_LAT;
        bf16* AP = (bf16*)(C.ws + WS_AP); bf16* Hb = (bf16*)(C.ws + WS_H); bf16* OB = (bf16*)(C.ws + WS_OB);
        if (EN(3) && IN(pb + 0)) { REFRESH();
            Gemm g{AP, wl(C, l, OFF_W1GU), D, D, D, 0, 0}; Order S; S.init(mrows_full / 256, 2 * FF / 256, 1, C.G, C.bid);
            EpiGU E{rowss_ptr(C, l, 0), bias_ptr(C, l, 0), Hb, mrows_full}; gemm_phase(C.lds, g, S, E); }
        SEAM(pb + 0);
        if (EN(4) && IN(pb + 1)) { REFRESH();
            Gemm g{Hb, wl(C, l, OFF_W1D), FF, FF, FF, 0, 0}; Order S; S.init(mrows_full / 256, D / 256, 1, C.G, C.bid);
            EpiRes E{&C, gate_ptr(C, l, 0, 0), gs_ptr(C, l, 1, 0), rowss_ptr(C, l, 1), AP}; gemm_phase(C.lds, g, S, E); }
        SEAM(pb + 1);
        if (EN(5) && IN(pb + 2)) { REFRESH();
            Gemm g{AP, wl(C, l, OFF_WIN), D, D, D, 0, 0}; Order S; S.init(mrows_full / 256, NT_IN, 1, C.G, C.bid);
            EpiIn E{&C, rowss_ptr(C, l, 1), bias_ptr(C, l, 1), l}; gemm_phase(C.lds, g, S, E); }
        SEAM(pb + 2);
        if (IN(pb + 3)) {
            if (EN(6)) { REFRESH(); Gemm g{(const bf16*)(C.ws + WS_UG), (const bf16*)(C.ws + WS_S5T + (size_t)l * SZ_S5L + OFF_S5ET), S5K, 512, 512, (size_t)NCHP * S5K * 2, (size_t)256 * 512 * 2};
              Order S; S.init(NCHP / 256, 1, S5G, C.G, C.bid); EpiS5A E{(float*)(C.ws + WS_XEND)}; gemm_phase(C.lds, g, S, E); }
            __syncthreads();
            if (EN(7)) { REFRESH(); ph_attn(C, l, want_ctx); }
            if (EN(8)) { REFRESH(); ph_rwprep(C, l); }
        }
        SEAM(pb + 3);
        if (IN(pb + 4)) { if (EN(9)) { REFRESH(); ph_rwscan(C); } if (EN(10)) { REFRESH(); ph_s5scan(C, l, C.G >= 256 ? 128 : 0); } }
        SEAM(pb + 4);
        if (IN(pb + 5)) {
            if (EN(11)) { REFRESH(); Gemm g{(const bf16*)(C.ws + WS_UG), (const bf16*)(C.ws + WS_S5T + (size_t)l * SZ_S5L + OFF_S5BT), S5K, S5K, S5K, (size_t)NCHP * S5K * 2, (size_t)512 * S5K * 2};
              Order S; S.init(NCHP / 256, 2, S5G, C.G, C.bid); EpiS5C E{(const bf16*)(C.ws + WS_UG), C.in[I_S5D] + (size_t)l * GW, (bf16*)(C.ws + WS_YG)}; gemm_phase(C.lds, g, S, E); }
            if (EN(12)) { REFRESH(); ph_rwout(C, l, mrows_out); }
        }
        SEAM(pb + 5);
        if (EN(13) && IN(pb + 6)) { REFRESH();
            Gemm g{(const bf16*)(C.ws + WS_YG), wl(C, l, OFF_WGLU), GW, GW, GW, 0, 0}; Order S; S.init(mrows_out / 256, GW / 256, 1, C.G, C.bid);
            EpiGLU E{(const bf16*)(C.ws + WS_YG), C.in[I_S5GLUB] + (size_t)l * GW, OB}; gemm_phase(C.lds, g, S, E); }
        SEAM(pb + 6);
        if (EN(14) && IN(pb + 7)) { REFRESH();
            Gemm g{OB, wl(C, l, OFF_WOUT), D, D, D, 0, 0}; Order S; S.init(mrows_out / 256, D / 256, 1, C.G, C.bid);
            EpiRes E{&C, gate_ptr(C, l, 1, 0), gs_ptr(C, l, 2, 0), rowss_ptr(C, l, 2), AP}; gemm_phase(C.lds, g, S, E); }
        SEAM(pb + 7);
        if (EN(15) && IN(pb + 8)) { REFRESH();
            Gemm g{AP, wl(C, l, OFF_W2GU), D, D, D, 0, 0}; Order S; S.init(mrows_out / 256, 2 * FF / 256, 1, C.G, C.bid);
            EpiGU E{rowss_ptr(C, l, 2), bias_ptr(C, l, 2), Hb, mrows_out}; gemm_phase(C.lds, g, S, E); }
        SEAM(pb + 8);
        if (EN(16) && IN(pb + 9)) { REFRESH();
            Gemm g{Hb, wl(C, l, OFF_W2D), FF, FF, FF, 0, 0}; Order S; S.init(mrows_out / 256, D / 256, 1, C.G, C.bid);
            const bool more = l + 1 < NL;
            EpiRes E{&C, gate_ptr(C, l, 2, 0), more ? gs_ptr(C, l + 1, 0, 0) : nullptr, more ? rowss_ptr(C, l + 1, 0) : nullptr, AP}; gemm_phase(C.lds, g, S, E); }
        SEAM(pb + 9);
    }
#undef IN
#undef SEAM
}

#ifndef MK_PER_PHASE
#define MK_PER_PHASE 0
#endif
#ifdef EMU
int g_emu_grid = 4, g_emu_lo = 0, g_emu_hi = NPH;
#endif
extern "C" void kernel_launch(void* const* d_in, const int* in_sizes, int n_in, void* d_out, int out_size, void* d_ws, size_t ws_size, hipStream_t stream) {
    Args a{};
    for (int i = 0; i < 42; ++i) a.in[i] = (const float*)d_in[i];
    a.out = (float*)d_out; a.ws = (unsigned char*)d_ws;
#ifdef EMU
    if (g_emu_lo == 0) hipMemsetAsync(d_ws, 0, WS_ZERO_END, stream);
    for (int ph = g_emu_lo; ph < g_emu_hi; ++ph) { a.ph_lo = ph; a.ph_hi = ph + 1; fprintf(stderr, "phase %d\n", ph); emu::launch(g_emu_grid, NTHR, LDS_BYTES, [=] { fwd(a); }); }
#else
    static int grid = 0;
    if (grid == 0) {
        if (n_in != 42 || out_size != M_LAT * D || ws_size < WS_END) { fprintf(stderr, "kernel_launch: unexpected shapes (n_in %d out %d ws %zu need %zu)\n", n_in, out_size, ws_size, (size_t)WS_END); grid = -1; return; }
        int dev = 0, cus = 0;
        if (hipGetDevice(&dev) != hipSuccess || hipDeviceGetAttribute(&cus, hipDeviceAttributeMultiprocessorCount, dev) != hipSuccess) { grid = -1; return; }
        if (hipFuncSetAttribute((const void*)fwd, hipFuncAttributeMaxDynamicSharedMemorySize, LDS_BYTES) != hipSuccess) { fprintf(stderr, "kernel_launch: hipFuncSetAttribute failed\n"); grid = -1; return; }
        int per_cu = 0; (void)hipOccupancyMaxActiveBlocksPerMultiprocessor(&per_cu, (const void*)fwd, NTHR, LDS_BYTES); (void)hipGetLastError();
        if (per_cu < 1) fprintf(stderr, "kernel_launch: occupancy query reports %d\n", per_cu);
        grid = cus;
    }
    if (grid < 0) return;
    (void)hipMemsetAsync(d_ws, 0, WS_ZERO_END, stream);
#if MK_PER_PHASE
    for (int ph = 0; ph < NPH; ++ph) { a.ph_lo = ph; a.ph_hi = ph + 1; hipLaunchKernelGGL(fwd, dim3(grid), dim3(NTHR), LDS_BYTES, stream, a); }
#else
    a.ph_lo = 0; a.ph_hi = NPH;
    hipLaunchKernelGGL(fwd, dim3(grid), dim3(NTHR), LDS_BYTES, stream, a);
#endif
#endif
}
```

```cpp
#ifdef EMU
#include "emu/emu.h"
#define LAS
#define GAS
#define ASMV(...) ((void)0)
#define WSYNC() do { int _z = 0; (void)emu::wave_gather(&_z, 4); } while (0)
#define OPAQUE(x) ((void)0)
#define PIN(x) ((void)0)
#define OPAQUE_LDS(p) (p)
#else
#include <hip/hip_runtime.h>
#include <cstdio>
#include <cstdint>
#define LAS __attribute__((address_space(3)))
#define GAS __attribute__((address_space(1)))
#define ASMV(...) asm volatile(__VA_ARGS__)
#define PIN(x) asm volatile("" : "+v"(x) :: "memory")
template <class P> __device__ __forceinline__ P opaque_lds(P p) { unsigned a = (unsigned)(size_t)p; asm volatile("" : "+v"(a)); return (P)(size_t)a; }
#define OPAQUE_LDS(p) opaque_lds(p)
#define OPAQUE(x) asm volatile("" : "+v"(x))
#define WSYNC() asm volatile("s_waitcnt lgkmcnt(0)" ::: "memory")
#endif

#ifdef EMU
constexpr int D = 1024, NB = 2, T = 1024, NL = 2, TC = 256, FF = 1024;
#else
constexpr int D = 2048, NB = 2, T = 8192, NL = 4, TC = 256, FF = 5632;
#endif
constexpr int GW = D / 4, NH = GW / 64, WAG = NH / 2, S5G = GW / 16, GRW = 64, GRH = T / GRW;
constexpr int M_LAT = NB * T, M_CTX = NB * TC, M = M_LAT + M_CTX, NPAN = M / 256;
constexpr int TP = GW / 256;
constexpr int NT_IN = 8 * TP + 2, NINP = NT_IN * 256, D_IN = 8 * GW + 416;
constexpr int PN_AQ = 0, PN_AK = TP, PN_AV = 2 * TP, PN_BR = 3 * TP, PN_BK = 4 * TP, PN_BV = 5 * TP, PN_BS = 6 * TP, PN_CQ = 6 * TP + 1, PN_CKV = 7 * TP + 1, PN_DU = 7 * TP + 2;
constexpr int SRC_AQ = 0, SRC_AK = GW, SRC_AV = 2 * GW, SRC_BR = 3 * GW, SRC_BK = 4 * GW, SRC_BV = 5 * GW, SRC_BS = 6 * GW, SRC_CQ = 6 * GW + 160, SRC_CK = 7 * GW + 160, SRC_CV = 7 * GW + 288, SRC_DU = 7 * GW + 416;
constexpr int S5L = 32, NCH = M / S5L, NCHP = ((NCH + 255) / 256) * 256, S5K = 768;
constexpr int NW = 8, NTHR = 512;
constexpr float NORM_EPS = 1e-6f, RW_GN_EPS = 64e-5f;

typedef unsigned short bf16;
typedef short bf16x8 __attribute__((ext_vector_type(8)));
typedef short s16x4 __attribute__((ext_vector_type(4)));
typedef float f32x4 __attribute__((ext_vector_type(4)));
typedef float f32x2 __attribute__((ext_vector_type(2)));
typedef float f32x16 __attribute__((ext_vector_type(16)));
typedef unsigned u32x4 __attribute__((ext_vector_type(4)));
typedef unsigned u32x2 __attribute__((ext_vector_type(2)));
#define DI __device__ __forceinline__

constexpr size_t al256(size_t x) { return (x + 255) & ~(size_t)255; }
constexpr size_t SZ_BIAS_GU = (size_t)3 * 2 * FF * 4, SZ_BIAS_IN = (size_t)3 * NINP * 4;
constexpr size_t WS_CTL = 0;
constexpr size_t WS_BIAS = 65536;
constexpr size_t SZ_BIAS_L = 2 * SZ_BIAS_GU + SZ_BIAS_IN;
constexpr size_t WS_ROWSS = al256(WS_BIAS + NL * SZ_BIAS_L);
constexpr size_t WS_ZERO_END = al256(WS_ROWSS + (size_t)NL * 3 * M * 4);
constexpr size_t WS_MODV = WS_ZERO_END;
constexpr size_t WS_GS = al256(WS_MODV + (size_t)NL * 3 * 9 * D * 4);
constexpr size_t WS_GATE = al256(WS_GS + (size_t)NL * 9 * D * 4);
constexpr size_t WS_ROPE = al256(WS_GATE + (size_t)NL * 9 * D * 4);
constexpr size_t SZ_WGU = (size_t)2 * FF * D * 2, SZ_WD = (size_t)D * FF * 2, SZ_WIN = (size_t)NINP * D * 2, SZ_WOUT = (size_t)D * D * 2, SZ_WGLU = (size_t)GW * GW * 2;
constexpr size_t OFF_W1GU = 0, OFF_W1D = OFF_W1GU + SZ_WGU, OFF_WIN = OFF_W1D + SZ_WD, OFF_WOUT = OFF_WIN + SZ_WIN, OFF_W2GU = OFF_WOUT + SZ_WOUT, OFF_W2D = OFF_W2GU + SZ_WGU, OFF_WGLU = OFF_W2D + SZ_WD, SZ_WL = OFF_WGLU + SZ_WGLU;
constexpr size_t WS_W = al256(WS_ROPE + 128 * 16 * 8);
constexpr size_t SZ_S5KC = (size_t)S5G * 2 * S5L * 256 * 4, SZ_S5ET = (size_t)S5G * 256 * 512 * 2, SZ_S5BT = (size_t)S5G * 512 * S5K * 2, SZ_S5LAM = (size_t)2 * GW * 4 * 8;
constexpr size_t OFF_S5KC = 0, OFF_S5ET = OFF_S5KC + SZ_S5KC, OFF_S5BT = OFF_S5ET + SZ_S5ET, OFF_S5LAM = OFF_S5BT + SZ_S5BT, SZ_S5L = al256(OFF_S5LAM + SZ_S5LAM);
constexpr size_t WS_S5T = al256(WS_W + NL * SZ_WL);
constexpr size_t WS_XC = al256(WS_S5T + NL * SZ_S5L);
constexpr size_t WS_AP = al256(WS_XC + (size_t)M_CTX * D * 4);
constexpr size_t WS_H = al256(WS_AP + (size_t)M * D * 2);
constexpr size_t WS_QA = al256(WS_H + (size_t)M * FF * 2);
constexpr size_t WS_KA = WS_QA + (size_t)M * GW * 2, WS_VA = WS_KA + (size_t)M * GW * 2, WS_QC = WS_VA + (size_t)M * GW * 2;
constexpr size_t WS_KC = WS_QC + (size_t)M * GW * 2, WS_VC = WS_KC + (size_t)M * 128 * 2;
constexpr size_t WS_PB = WS_VC + (size_t)M * 128 * 2;
constexpr size_t WS_PS = al256(WS_PB + (size_t)M * 3 * GW * 2);
constexpr size_t WS_UG = al256(WS_PS + (size_t)M * 160 * 4);
constexpr size_t WS_RW = al256(WS_UG + (size_t)S5G * NCHP * S5K * 2);
constexpr size_t SZ_RWA = (size_t)M * GW * 4;
enum { RW_R = 0, RW_V, RW_NKK, RW_G, RW_W0, RW_W1, RW_K0, RW_K1, RW_B0, RW_B1, RW_Y0, RW_Y1, RW_NARR };
constexpr size_t WS_XEND = al256(WS_RW + RW_NARR * SZ_RWA);
constexpr size_t WS_YG = al256(WS_XEND + (size_t)S5G * NCHP * 256 * 4);
constexpr size_t WS_OB = al256(WS_YG + (size_t)M * GW * 2);
constexpr int RCK = (TC + T) / 64, RSTR = NB * NH * 2, RITEM = RSTR * RCK;
constexpr size_t WS_QH = al256(WS_OB + (size_t)M * D * 2);
constexpr size_t WS_YL = al256(WS_QH + (size_t)RITEM * 8192);
constexpr size_t WS_MF = al256(WS_YL + (size_t)RITEM * 16384);
constexpr size_t WS_GF = al256(WS_MF + (size_t)RITEM * 8192);
constexpr size_t WS_SF = al256(WS_GF + (size_t)RITEM * 16384);
constexpr size_t WS_END = al256(WS_SF + (size_t)RITEM * 8192);
constexpr int CW_BAR = 1024;

constexpr int LDS_BYTES = 147456, RING_BYTES = 131072, MISC_OFF = LDS_BYTES - 256;

DI unsigned f2bf(float f) { unsigned u = __float_as_uint(f); return (u + 0x7fffu + ((u >> 16) & 1u)) >> 16; }
DI unsigned pk2(float lo, float hi) { return f2bf(lo) | (f2bf(hi) << 16); }
DI float bf2f(unsigned short b) { return __uint_as_float(((unsigned)b) << 16); }
DI float bflo(unsigned w) { return __uint_as_float(w << 16); }
DI float bfhi(unsigned w) { return __uint_as_float(w & 0xffff0000u); }
DI float wave_sum(float v) {
#pragma unroll
    for (int o = 1; o < 64; o <<= 1) v += __shfl_xor(v, o);
    return v;
}
DI float siluf(float x) { return x / (1.f + __expf(-x)); }
DI float sigmf(float x) { return 1.f / (1.f + __expf(-x)); }
DI float geluf(float x) { const float z = 0.7978845608028654f * (x + 0.044715f * x * x * x); const float e = __expf(2.f * z); return 0.5f * x * (1.f + (1.f - 2.f / (e + 1.f))); }
DI int stream_of_row(int row) { return row < M_LAT ? row / T : NB; }
DI int stream_of_panel(int pm) { return stream_of_row(pm * 256); }

#define XB_TMO      128
#define XB_XCNT(j)  (256  + 64 * (j))
#define XB_XSUB(j)  (1280 + 64 * (j))
#define XB_XGEN(j)  (2304 + 64 * (j))
#define XB_TOP      3328
#define XB_TOPGEN   3392
#define XCD_BAR_WORDS 3456
#define XB_SPIN_CAP (1u << 18)
DI unsigned xb_ld(unsigned* p)              { return __hip_atomic_load(p, __ATOMIC_RELAXED, __HIP_MEMORY_SCOPE_AGENT); }
DI unsigned xb_add(unsigned* p, unsigned v) { return __hip_atomic_fetch_add(p, v, __ATOMIC_RELAXED, __HIP_MEMORY_SCOPE_AGENT); }
DI unsigned xb_xcc_id() { return (unsigned)__builtin_amdgcn_s_getreg((3 << 11) | 20) & 0xFu; }
#define XB_SPIN(cond, bar) do { unsigned _sp = 0; while (cond) { __builtin_amdgcn_s_sleep(1); \
    if ((++_sp & 255u) == 0u) { if (xb_ld(&(bar)[XB_TMO])) break; if (_sp > XB_SPIN_CAP) { atomicAdd(&(bar)[XB_TMO], 1u); break; } } } } while (0)
struct XcdBarrier { unsigned* bar; unsigned x; volatile LAS unsigned* st; };
DI XcdBarrier xcd_barrier_post(unsigned* bar, volatile LAS unsigned* st) {
    XcdBarrier b; b.bar = bar; b.x = xb_xcc_id(); b.st = st;
    if (threadIdx.x == 0) (void)xb_add(&bar[XB_XCNT(b.x)], 1u);
    return b;
}
DI void xcd_barrier_complete(unsigned* bar, unsigned x, unsigned& nloc, unsigned& nx) {
    const unsigned G = gridDim.x * gridDim.y * gridDim.z;
    unsigned sum, cnt, mine, sp = 0u;
    for (;;) {
        sum = 0u; cnt = 0u; mine = 0u;
#pragma unroll
        for (unsigned j = 0; j < 16; ++j) { const unsigned c = xb_ld(&bar[XB_XCNT(j)]); sum += c; cnt += (c > 0u) ? 1u : 0u; mine = (j == x) ? c : mine; }
        if (sum == G) break;
        __builtin_amdgcn_s_sleep(1);
        if ((++sp & 255u) == 0u) { if (xb_ld(&bar[XB_TMO])) break; if (sp > XB_SPIN_CAP) { atomicAdd(&bar[XB_TMO], 1u); break; } }
    }
    nloc = mine > 0u ? mine : 1u; nx = cnt > 0u ? cnt : 1u;
}
DI void xcd_barrier(const XcdBarrier& b) {
    ASMV("s_waitcnt vmcnt(0)" ::: "memory");
    __syncthreads();
    if (threadIdx.x == 0) {
        unsigned* bar = b.bar;
        __builtin_amdgcn_s_waitcnt(0);
        unsigned nloc = b.st[0], nx = b.st[1];
        if (nloc == 0u) { xcd_barrier_complete(bar, b.x, nloc, nx); b.st[0] = nloc; b.st[1] = nx; }
        const unsigned old = xb_add(&bar[XB_XSUB(b.x)], 1u);
        const unsigned gen = old / nloc;
        if (old + 1u == (gen + 1u) * nloc) {
            __builtin_amdgcn_fence(__ATOMIC_RELEASE, "agent");
            ASMV("s_waitcnt vmcnt(0)" ::: "memory");
            const unsigned og = xb_add(&bar[XB_TOP], 1u);
            const unsigned tg = og / nx;
            if (og + 1u == (tg + 1u) * nx) xb_add(&bar[XB_TOPGEN], 1u);
            else XB_SPIN(xb_ld(&bar[XB_TOPGEN]) == tg, bar);
            __builtin_amdgcn_fence(__ATOMIC_ACQUIRE, "agent");
            xb_add(&bar[XB_XGEN(b.x)], 1u);
            ASMV("s_waitcnt vmcnt(0)" ::: "memory");
        } else {
            XB_SPIN(xb_ld(&bar[XB_XGEN(b.x)]) == gen, bar);
            __builtin_amdgcn_fence(__ATOMIC_ACQUIRE, "agent");
            ASMV("s_waitcnt vmcnt(0)" ::: "memory");
        }
    }
    __syncthreads();
}

constexpr int BK = 64, HALF = 128, HTB = HALF * BK * 2, NXCD = 8, WGM = 8;
DI int lds_byte(int r, int c) { const int st = (r >> 4) * 2 + (c >> 5), rr = r & 15, cc = c & 31, ob = rr * 64 + cc * 2; return st * 1024 + (ob ^ (((ob >> 9) & 1) << 5)); }
DI void stage_rc(int b, int& R, int& C) { const int st = b / 1024, sb = b % 1024, swz = sb ^ (((sb >> 9) & 1) << 5); R = (st >> 1) * 16 + swz / 64; C = (st & 1) * 32 + (swz % 64) / 2; }
struct Unit { int pm, pn, z; };
struct Gemm { const bf16* A; const bf16* Bt; int lda, ldb, K; size_t zA, zB; };
struct Order {
    int nM, nN, nZ, per, total, G, c;
    DI void init(int nM_, int nN_, int nZ_, int G_, int c_) { nM = nM_; nN = nN_; nZ = nZ_; per = nM * nN; total = per * nZ; G = G_; c = c_; }
    DI bool next(int i, Unit& u) const {
        const long L = (long)i * G + c; if (L >= total) return false;
        u.z = (int)(L / per); int wgid = (int)(L % per);
        { const int q = per / NXCD, r = per % NXCD, xcd = wgid % NXCD, off = wgid / NXCD; wgid = (xcd < r ? xcd * (q + 1) : r * (q + 1) + (xcd - r) * q) + off; }
        const int nig = WGM * nN, gid = wgid / nig, fm = gid * WGM, gsz = (nM - fm) < WGM ? (nM - fm) : WGM;
        u.pm = fm + ((wgid % nig) % gsz); u.pn = (wgid % nig) / gsz; return true;
    }
};

template <class Epi>
DI void gemm_phase(LAS unsigned char* lds, const Gemm g, const Order& S, const Epi& E) {
    int tid_ = threadIdx.x; OPAQUE(tid_);
    const int tid = tid_, wid = __builtin_amdgcn_readfirstlane(tid >> 6), lane = tid & 63, wr = wid >> 2, wc = wid & 3, fr = lane & 15, fq = lane >> 4;
    Unit cur, nxt; int ui = 0;
    if (!S.next(0, cur)) return;
    f32x4 acc[2][2][4][2];
#ifdef EMU
    (void)lds;
    for (;; ++ui) {
        if (ui > 0) { if (!S.next(ui, cur)) break; }
        const bf16* A = (const bf16*)((const char*)g.A + cur.z * g.zA); const bf16* B = (const bf16*)((const char*)g.Bt + cur.z * g.zB);
        for (int ai = 0; ai < 2; ++ai) for (int bj = 0; bj < 2; ++bj) for (int m = 0; m < 4; ++m) for (int n = 0; n < 2; ++n) for (int j = 0; j < 4; ++j) {
            const int r = 256 * cur.pm + 128 * ai + 64 * wr + 16 * m + fr, c = 256 * cur.pn + 128 * bj + 32 * wc + 16 * n + 4 * fq + j;
            const bf16* a = A + (size_t)r * g.lda; const bf16* b = B + (size_t)c * g.ldb; float s = 0.f;
            for (int k = 0; k < g.K; ++k) s += bf2f(a[k]) * bf2f(b[k]);
            acc[ai][bj][m][n][j] = s; }
        E(acc, cur, wr, wc, fr, fq);
    }
#else
    const int K = g.K, nt = K / BK;
    unsigned voffA[2], voffB[2];
#pragma unroll
    for (int i = 0; i < 2; ++i) { int R, C; stage_rc(tid * 16 + i * 8192, R, C); voffA[i] = (unsigned)(R * g.lda + C) * 2u; voffB[i] = (unsigned)(R * g.ldb + C) * 2u; }
    const size_t kstep = (size_t)(BK * 2);
    const size_t hstepA = (size_t)HALF * g.lda * 2, hstepB = (size_t)HALF * g.ldb * 2, tstepA = 2 * hstepA, tstepB = 2 * hstepB;
    const unsigned ldsw = (unsigned)wid * 1024u;
    const int aoff = lds_byte(wr * 64 + fr, fq * 8), boff = lds_byte(wc * 32 + fr, fq * 8);
#define PG8_SA(b, h) (((b) * 2 + (h)) * HTB)
#define PG8_SB(b, h) ((4 + (b) * 2 + (h)) * HTB)
#define PG8_STAGE(bufoff, gbase, voff) do { _Pragma("unroll") for (int _i = 0; _i < 2; ++_i) \
        __builtin_amdgcn_global_load_lds((const unsigned*)((const char*)(gbase) + (voff)[_i]), (LAS unsigned*)(lds + (bufoff) + ldsw + _i * 8192), 16, 0, 0); } while (0)
#define PG8_LDA(dst, b, h) do { _Pragma("unroll") for (int m = 0; m < 4; ++m) _Pragma("unroll") for (int k = 0; k < 2; ++k) dst[m][k] = *(const LAS bf16x8*)(lds + PG8_SA(b, h) + aoff + m * 2048 + k * 1024); } while (0)
#define PG8_LDB(dst, b, h) do { _Pragma("unroll") for (int n = 0; n < 2; ++n) _Pragma("unroll") for (int k = 0; k < 2; ++k) dst[n][k] = *(const LAS bf16x8*)(lds + PG8_SB(b, h) + boff + n * 2048 + k * 1024); } while (0)
#define PG8_MMA(ai, bj, At, Bt) do { __builtin_amdgcn_s_setprio(1); _Pragma("unroll") for (int m = 0; m < 4; ++m) _Pragma("unroll") for (int n = 0; n < 2; ++n) _Pragma("unroll") for (int k = 0; k < 2; ++k) \
        acc[ai][bj][m][n] = __builtin_amdgcn_mfma_f32_16x16x32_bf16(Bt[n][k], At[m][k], acc[ai][bj][m][n], 0, 0, 0); __builtin_amdgcn_s_setprio(0); } while (0)
#define PG8_WAIT_V(n) asm volatile("s_waitcnt vmcnt(" #n ")" ::: "memory")
#define PG8_WAIT_L(n) asm volatile("s_waitcnt lgkmcnt(" #n ")" ::: "memory")
#define PG8_BAR __builtin_amdgcn_s_barrier()
#define PG8_SCHED __builtin_amdgcn_sched_barrier(0)
#pragma unroll
    for (int a = 0; a < 2; ++a)
#pragma unroll
        for (int b = 0; b < 2; ++b)
#pragma unroll
            for (int m = 0; m < 4; ++m)
#pragma unroll
                for (int n = 0; n < 2; ++n) acc[a][b][m][n] = (f32x4){0.f, 0.f, 0.f, 0.f};
    bf16x8 At[4][2], B0[2][2], B1[2][2];
    const char* cA = (const char*)g.A + (size_t)cur.z * g.zA + (size_t)cur.pm * tstepA; const char* cB = (const char*)g.Bt + (size_t)cur.z * g.zB + (size_t)cur.pn * tstepB;
    PG8_STAGE(PG8_SB(0, 0), cB, voffB); PG8_STAGE(PG8_SB(0, 1), cB + hstepB, voffB); PG8_STAGE(PG8_SA(0, 0), cA, voffA); PG8_STAGE(PG8_SA(0, 1), cA + hstepA, voffA);
    if (wr == 1) PG8_BAR;
    PG8_WAIT_V(2); PG8_BAR;
    PG8_STAGE(PG8_SB(1, 0), cB + kstep, voffB); PG8_STAGE(PG8_SA(1, 0), cA + kstep, voffA); PG8_STAGE(PG8_SB(1, 1), cB + hstepB + kstep, voffB);
    PG8_WAIT_V(6); PG8_BAR;
    for (;;) {
        const bool has_next = S.next(ui + 1, nxt);
        const char* nA = has_next ? (const char*)g.A + (size_t)nxt.z * g.zA + (size_t)nxt.pm * tstepA : cA; const char* nB = has_next ? (const char*)g.Bt + (size_t)nxt.z * g.zB + (size_t)nxt.pn * tstepB : cB;
        for (int t = 0; t < nt; t += 2) {
            const bool last = (t == nt - 2);
            const char* a1 = cA + (size_t)(t + 1) * kstep;
            const char* a2 = last ? nA : cA + (size_t)(t + 2) * kstep; const char* b2 = last ? nB : cB + (size_t)(t + 2) * kstep;
            const char* a3 = a2 + kstep; const char* b3 = b2 + kstep;
            PG8_LDB(B0, 0, 0); PG8_LDB(B1, 0, 1); PG8_SCHED; PG8_LDA(At, 0, 0); PG8_STAGE(PG8_SA(1, 1), a1 + hstepA, voffA);
            PG8_WAIT_V(8); PG8_WAIT_L(0); PG8_BAR; PG8_MMA(0, 0, At, B0); PG8_MMA(0, 1, At, B1); PG8_BAR; PG8_SCHED;
            PG8_LDA(At, 0, 1); PG8_STAGE(PG8_SB(0, 0), b2, voffB); PG8_STAGE(PG8_SB(0, 1), b2 + hstepB, voffB); PG8_STAGE(PG8_SA(0, 0), a2, voffA);
            PG8_WAIT_V(8); PG8_WAIT_L(0); PG8_BAR; PG8_MMA(1, 0, At, B0); PG8_MMA(1, 1, At, B1); PG8_BAR; PG8_SCHED;
            PG8_LDB(B0, 1, 0); PG8_LDB(B1, 1, 1); PG8_SCHED; PG8_LDA(At, 1, 0); PG8_STAGE(PG8_SA(0, 1), a2 + hstepA, voffA);
            PG8_WAIT_V(8); PG8_WAIT_L(0); PG8_BAR; PG8_MMA(0, 0, At, B0); PG8_MMA(0, 1, At, B1); PG8_BAR; PG8_SCHED;
            PG8_LDA(At, 1, 1); PG8_STAGE(PG8_SB(1, 0), b3, voffB); PG8_STAGE(PG8_SB(1, 1), b3 + hstepB, voffB); PG8_STAGE(PG8_SA(1, 0), a3, voffA);
            PG8_WAIT_V(8); PG8_WAIT_L(0); PG8_BAR; PG8_MMA(1, 0, At, B0); PG8_MMA(1, 1, At, B1); PG8_BAR; PG8_SCHED;
        }
        if (wr == 0) PG8_BAR;
        E(acc, cur, wr, wc, fr, fq);
        if (!has_next) break;
#pragma unroll
        for (int a = 0; a < 2; ++a)
#pragma unroll
            for (int b = 0; b < 2; ++b)
#pragma unroll
                for (int m = 0; m < 4; ++m)
#pragma unroll
                    for (int n = 0; n < 2; ++n) acc[a][b][m][n] = (f32x4){0.f, 0.f, 0.f, 0.f};
        cur = nxt; cA = nA; cB = nB; ++ui;
        if (wr == 1) PG8_BAR;
    }
    PG8_WAIT_V(0);
    PG8_BAR;
#undef PG8_SA
#undef PG8_SB
#undef PG8_STAGE
#undef PG8_LDA
#undef PG8_LDB
#undef PG8_MMA
#undef PG8_WAIT_V
#undef PG8_WAIT_L
#undef PG8_BAR
#undef PG8_SCHED
#endif
}

struct Args {
    const float* in[42]; float* out; unsigned char* ws;
    int ph_lo, ph_hi;
};
struct Ctx {
    const float* const* in; float* out; unsigned char* ws;
    LAS unsigned char* lds; int tid, lane, wave, G, bid;
};
DI float* xrow_ptr(const Ctx& C, int row) { return row < M_LAT ? C.out + (size_t)row * D : (float*)(C.ws + WS_XC) + (size_t)(row - M_LAT) * D; }
DI const bf16* wl(const Ctx& C, int l, size_t off) { return (const bf16*)(C.ws + WS_W + (size_t)l * SZ_WL + off); }
DI float* bias_ptr(const Ctx& C, int l, int which  ) { return (float*)(C.ws + WS_BIAS + (size_t)l * SZ_BIAS_L + (which == 0 ? 0 : which == 1 ? SZ_BIAS_GU : SZ_BIAS_GU + SZ_BIAS_IN)); }
DI float* rowss_ptr(const Ctx& C, int l, int sub) { return (float*)(C.ws + WS_ROWSS) + ((size_t)l * 3 + sub) * M; }
DI const float* gs_ptr(const Ctx& C, int l, int sub, int s) { return (const float*)(C.ws + WS_GS) + (((size_t)l * 3 + sub) * 3 + s) * D; }
DI const float* gate_ptr(const Ctx& C, int l, int sub, int s) { return (const float*)(C.ws + WS_GATE) + (((size_t)l * 3 + sub) * 3 + s) * D; }
DI float* rw_arr(const Ctx& C, int a) { return (float*)(C.ws + WS_RW + (size_t)a * SZ_RWA); }
enum { I_X = 0, I_C, I_CTX, I_CCTX, I_WADA, I_BADA, I_NORMG, I_F1WG, I_F1WU, I_F1WD, I_F2WG, I_F2WU, I_F2WD, I_WIN, I_WOUT, I_NAQG, I_NAKG, I_NARPB, I_RWCONV, I_RWW0, I_RWWUP, I_RWA0, I_RWAUP,
       I_RWGUP, I_RWKK, I_RWKA, I_RWRK, I_RWGNW, I_RWGNB, I_WAQG, I_WAKG, I_WASINK, I_S5ARE, I_S5AIM, I_S5LDT, I_S5BRE, I_S5BIM, I_S5CRE, I_S5CIM, I_S5D, I_S5GLUW, I_S5GLUB, I_NIN };

struct EpiGU {
    const float* rowss; const float* bias  ; bf16* H; int mrows;
    DI void operator()(const f32x4 (&acc)[2][2][4][2], const Unit& u, int wr, int wc, int fr_, int fq_) const {
        int tz_ = threadIdx.x; OPAQUE(tz_); const int fr = tz_ & 15, fq = (tz_ & 63) >> 4; (void)fr_; (void)fq_;
        const int s = stream_of_panel(u.pm); const float* bs = bias + (size_t)s * 2 * FF + u.pn * 256 + wc * 32 + 4 * fq;
        f32x4 bg[2], bu[2];
#pragma unroll
        for (int n = 0; n < 2; ++n) { bg[n] = *(const f32x4*)(bs + 16 * n); bu[n] = *(const f32x4*)(bs + 128 + 16 * n); }
#pragma unroll
        for (int ai = 0; ai < 2; ++ai)
#pragma unroll
            for (int m = 0; m < 4; ++m) {
                const int row = u.pm * 256 + ai * 128 + wr * 64 + m * 16 + fr;
                const float rstd = 1.0f / sqrtf(rowss[row] * (1.0f / D) + NORM_EPS);
                bf16* hp = H + (size_t)row * FF + u.pn * 128 + wc * 32 + 4 * fq;
#pragma unroll
                for (int n = 0; n < 2; ++n) { const f32x4 g = acc[ai][0][m][n] * rstd + bg[n], v = acc[ai][1][m][n] * rstd + bu[n];
                    u32x2 w; w.x = pk2(siluf(g[0]) * v[0], siluf(g[1]) * v[1]); w.y = pk2(siluf(g[2]) * v[2], siluf(g[3]) * v[3]);
                    *(u32x2*)(hp + 16 * n) = w; }
            }
    }
};
struct EpiRes {
    const Ctx* C; const float* gate  ; const float* gsn  ; float* rowss_next; bf16* AP;
    DI void operator()(const f32x4 (&acc)[2][2][4][2], const Unit& u, int wr, int wc, int fr_, int fq_) const {
        int tz_ = threadIdx.x; OPAQUE(tz_); const int fr = tz_ & 15, fq = (tz_ & 63) >> 4; (void)fr_; (void)fq_;
        const int s = stream_of_panel(u.pm); const int col0 = u.pn * 256 + wc * 32 + 4 * fq;
        f32x4 gv[2][2], sv[2][2];
#pragma unroll
        for (int bj = 0; bj < 2; ++bj)
#pragma unroll
            for (int n = 0; n < 2; ++n) { gv[bj][n] = *(const f32x4*)(gate + (size_t)s * D + col0 + bj * 128 + n * 16); sv[bj][n] = gsn ? *(const f32x4*)(gsn + (size_t)s * D + col0 + bj * 128 + n * 16) : (f32x4){0.f, 0.f, 0.f, 0.f}; }
#pragma unroll
        for (int ai = 0; ai < 2; ++ai)
#pragma unroll
            for (int m = 0; m < 4; ++m) {
                const int row = u.pm * 256 + ai * 128 + wr * 64 + m * 16 + fr;
                float* xp = xrow_ptr(*C, row) + col0; float ss = 0.f;
#pragma unroll
                for (int bj = 0; bj < 2; ++bj)
#pragma unroll
                    for (int n = 0; n < 2; ++n) { f32x4 x = *(const f32x4*)(xp + bj * 128 + n * 16); x += gv[bj][n] * acc[ai][bj][m][n]; *(f32x4*)(xp + bj * 128 + n * 16) = x;
                        if (gsn) { ss += (x[0] * x[0] + x[1] * x[1]) + (x[2] * x[2] + x[3] * x[3]); const f32x4 a = x * sv[bj][n]; u32x2 w; w.x = pk2(a[0], a[1]); w.y = pk2(a[2], a[3]);
                            *(u32x2*)(AP + (size_t)row * D + col0 + bj * 128 + n * 16) = w; } }
                if (gsn) { ss += __shfl_xor(ss, 16); ss += __shfl_xor(ss, 32); if (fq == 0) atomicAdd(rowss_next + row, ss); }
            }
    }
};
struct EpiIn {
    const Ctx* C; const float* rowss; const float* bias  ; int l;
    DI void operator()(const f32x4 (&acc)[2][2][4][2], const Unit& u, int wr, int wc, int fr_, int fq_) const {
        int tz_ = threadIdx.x; OPAQUE(tz_); const int fr = tz_ & 15, fq = (tz_ & 63) >> 4; (void)fr_; (void)fq_;
        const int s = stream_of_panel(u.pm), pn = u.pn; const float* bs = bias + (size_t)s * NINP + pn * 256 + wc * 32 + 4 * fq;
        unsigned char* ws = C->ws;
        f32x4 bv[2][2];
#pragma unroll
        for (int bj = 0; bj < 2; ++bj)
#pragma unroll
            for (int n = 0; n < 2; ++n) bv[bj][n] = *(const f32x4*)(bs + bj * 128 + n * 16);
        const bool permuted = pn < PN_AV || (pn >= PN_CQ && pn < PN_DU);
        if (permuted) {
            const bool is_ckv = pn == PN_CKV, is_c = pn >= PN_CQ, is_q = pn < PN_AK || (pn >= PN_CQ && pn < PN_CKV);
            const bool plain_v = is_ckv && wc >= 2;
            const float* gsrc = C->in[is_c ? (is_q ? I_WAQG : I_WAKG) : (is_q ? I_NAQG : I_NAKG)] + (size_t)l * 64;
            f32x4 gn[2][2];
#pragma unroll
            for (int bj = 0; bj < 2; ++bj)
#pragma unroll
                for (int n = 0; n < 2; ++n) { gn[bj][n] = *(const f32x4*)(gsrc + 32 * bj + 16 * n + 4 * fq); if (is_q) gn[bj][n] *= 0.125f; }
            bf16* dst; int pitch, hcol;
            if (pn < PN_AK) { dst = (bf16*)(ws + WS_QA); pitch = GW; hcol = ((pn - PN_AQ) * 4 + wc) * 64; }
            else if (pn < PN_AV) { dst = (bf16*)(ws + WS_KA); pitch = GW; hcol = ((pn - PN_AK) * 4 + wc) * 64; }
            else if (pn < PN_CKV) { dst = (bf16*)(ws + WS_QC); pitch = GW; hcol = ((pn - PN_CQ) * 4 + wc) * 64; }
            else if (wc < 2) { dst = (bf16*)(ws + WS_KC); pitch = 128; hcol = wc * 64; }
            else { dst = (bf16*)(ws + WS_VC); pitch = 128; hcol = (wc - 2) * 64; }
            const f32x4* rope = (const f32x4*)(ws + WS_ROPE);
#pragma unroll
            for (int ai = 0; ai < 2; ++ai)
#pragma unroll
                for (int m = 0; m < 4; ++m) {
                    const int row = pn * 0 + u.pm * 256 + ai * 128 + wr * 64 + m * 16 + fr;
                    const float rstd = 1.0f / sqrtf(rowss[row] * (1.0f / D) + NORM_EPS);
                    f32x4 v[2][2]; float ss = 0.f;
#pragma unroll
                    for (int bj = 0; bj < 2; ++bj)
#pragma unroll
                        for (int n = 0; n < 2; ++n) { v[bj][n] = acc[ai][bj][m][n] * rstd + bv[bj][n]; ss += (v[bj][n][0] * v[bj][n][0] + v[bj][n][1] * v[bj][n][1]) + (v[bj][n][2] * v[bj][n][2] + v[bj][n][3] * v[bj][n][3]); }
                    ss += __shfl_xor(ss, 16); ss += __shfl_xor(ss, 32);
                    if (!plain_v) { const float rs = 1.0f / sqrtf(ss * (1.0f / 64.0f) + NORM_EPS);
#pragma unroll
                        for (int bj = 0; bj < 2; ++bj)
#pragma unroll
                            for (int n = 0; n < 2; ++n) v[bj][n] = v[bj][n] * rs * gn[bj][n];
                        if (is_c && row < M_LAT) {
                            const int t = row % T; const int pos[2] = {t / GRW, t % GRW};
#pragma unroll
                            for (int bj = 0; bj < 2; ++bj) { const f32x4 cs0 = rope[(pos[bj] * 16 + 4 * fq) / 2], cs1 = rope[(pos[bj] * 16 + 4 * fq) / 2 + 1];
                                const float cc[4] = {cs0[0], cs0[2], cs1[0], cs1[2]}, sn[4] = {cs0[1], cs0[3], cs1[1], cs1[3]};
#pragma unroll
                                for (int j = 0; j < 4; ++j) { const float x1 = v[bj][0][j], x2 = v[bj][1][j]; v[bj][0][j] = x1 * cc[j] - x2 * sn[j]; v[bj][1][j] = x2 * cc[j] + x1 * sn[j]; } }
                        }
                    }
                    bf16* op = dst + (size_t)row * pitch + hcol + 4 * fq;
#pragma unroll
                    for (int bj = 0; bj < 2; ++bj)
#pragma unroll
                        for (int n = 0; n < 2; ++n) { u32x2 w; w.x = pk2(v[bj][n][0], v[bj][n][1]); w.y = pk2(v[bj][n][2], v[bj][n][3]); *(u32x2*)(op + 32 * bj + 16 * n) = w; }
                }
        } else {
#pragma unroll
            for (int ai = 0; ai < 2; ++ai)
#pragma unroll
                for (int m = 0; m < 4; ++m) {
                    const int row = u.pm * 256 + ai * 128 + wr * 64 + m * 16 + fr;
                    const float rstd = 1.0f / sqrtf(rowss[row] * (1.0f / D) + NORM_EPS);
#pragma unroll
                    for (int bj = 0; bj < 2; ++bj)
#pragma unroll
                        for (int n = 0; n < 2; ++n) { const f32x4 v = acc[ai][bj][m][n] * rstd + bv[bj][n]; const int c = bj * 128 + wc * 32 + n * 16 + 4 * fq;
                            u32x2 w; w.x = pk2(v[0], v[1]); w.y = pk2(v[2], v[3]);
                            if (pn < PN_BR) *(u32x2*)((bf16*)(ws + WS_VA) + (size_t)row * GW + (pn - PN_AV) * 256 + c) = w;
                            else if (pn < PN_BS) *(u32x2*)((bf16*)(ws + WS_PB) + (size_t)row * 3 * GW + (pn - PN_BR) * 256 + c) = w;
                            else if (pn == PN_BS) { if (c < 160) *(f32x4*)((float*)(ws + WS_PS) + (size_t)row * 160 + c) = v; }
                            else { const int cu = (pn - PN_DU) * 256 + c, gq = cu >> 4, p0 = cu & 15;
                                *(u32x2*)((bf16*)(ws + WS_UG) + ((size_t)gq * NCHP + row / S5L) * S5K + (row % S5L) * 16 + p0) = w; } }
                }
        }
    }
};
struct EpiS5A {
    float* XE;
    DI void operator()(const f32x4 (&acc)[2][2][4][2], const Unit& u, int wr, int wc, int fr_, int fq_) const {
        int tz_ = threadIdx.x; OPAQUE(tz_); const int fr = tz_ & 15, fq = (tz_ & 63) >> 4; (void)fr_; (void)fq_;
#pragma unroll
        for (int ai = 0; ai < 2; ++ai)
#pragma unroll
            for (int m = 0; m < 4; ++m) { const int ch = u.pm * 256 + ai * 128 + wr * 64 + m * 16 + fr; if (ch < NCH) { float* p = XE + ((size_t)u.z * NCHP + ch) * 256 + wc * 32 + 4 * fq;
#pragma unroll
                for (int bj = 0; bj < 2; ++bj)
#pragma unroll
                    for (int n = 0; n < 2; ++n) *(f32x4*)(p + bj * 128 + n * 16) = acc[ai][bj][m][n]; } }
    }
};
struct EpiS5C {
    const bf16* UG; const float* dsk  ; bf16* YG;
    DI void operator()(const f32x4 (&acc)[2][2][4][2], const Unit& u, int wr, int wc, int fr_, int fq_) const {
        int tz_ = threadIdx.x; OPAQUE(tz_); const int fr = tz_ & 15, fq = (tz_ & 63) >> 4; (void)fr_; (void)fq_;
        const int g = u.z;
#pragma unroll
        for (int ai = 0; ai < 2; ++ai)
#pragma unroll
            for (int m = 0; m < 4; ++m) { const int ch = u.pm * 256 + ai * 128 + wr * 64 + m * 16 + fr; if (ch < NCH) {
#pragma unroll
                for (int bj = 0; bj < 2; ++bj)
#pragma unroll
                    for (int n = 0; n < 2; ++n) { const int col = u.pn * 256 + bj * 128 + wc * 32 + n * 16 + 4 * fq, i = col >> 4, p0 = col & 15;
                        const u32x2 uw = *(const u32x2*)(UG + ((size_t)g * NCHP + ch) * S5K + col); const f32x4 dv = *(const f32x4*)(dsk + 16 * g + p0);
                        const f32x4 a = acc[ai][bj][m][n]; const float y0 = a[0] + dv[0] * bflo(uw.x), y1 = a[1] + dv[1] * bfhi(uw.x), y2 = a[2] + dv[2] * bflo(uw.y), y3 = a[3] + dv[3] * bfhi(uw.y);
                        u32x2 w; w.x = pk2(geluf(y0), geluf(y1)); w.y = pk2(geluf(y2), geluf(y3));
                        *(u32x2*)(YG + (size_t)(ch * S5L + i) * GW + 16 * g + p0) = w; } } }
    }
};
struct EpiGLU {
    const bf16* YG; const float* gb; bf16* OB;
    DI void operator()(const f32x4 (&acc)[2][2][4][2], const Unit& u, int wr, int wc, int fr_, int fq_) const {
        int tz_ = threadIdx.x; OPAQUE(tz_); const int fr = tz_ & 15, fq = (tz_ & 63) >> 4; (void)fr_; (void)fq_;
#pragma unroll
        for (int ai = 0; ai < 2; ++ai)
#pragma unroll
            for (int m = 0; m < 4; ++m) { const int row = u.pm * 256 + ai * 128 + wr * 64 + m * 16 + fr;
#pragma unroll
                for (int bj = 0; bj < 2; ++bj)
#pragma unroll
                    for (int n = 0; n < 2; ++n) { const int col = u.pn * 256 + bj * 128 + wc * 32 + n * 16 + 4 * fq; const f32x4 b = *(const f32x4*)(gb + col); const f32x4 a = acc[ai][bj][m][n] + b;
                        const u32x2 yw = *(const u32x2*)(YG + (size_t)row * GW + col);
                        u32x2 w; w.x = pk2(bflo(yw.x) * sigmf(a[0]), bfhi(yw.x) * sigmf(a[1])); w.y = pk2(bflo(yw.y) * sigmf(a[2]), bfhi(yw.y) * sigmf(a[3]));
                        *(u32x2*)(OB + (size_t)row * D + 3 * GW + col) = w; } }
    }
};

DI void ph_ada(const Ctx& C) {
    LAS float* sc = (LAS float*)C.lds;
    LAS float* red = sc + 3 * D;
    for (int i = C.tid; i < 3 * D; i += NTHR) { const int s = i / D, k = i % D; const float c = s < NB ? C.in[I_C][s * D + k] : C.in[I_CCTX][k]; sc[i] = siluf(c); }
    __syncthreads();
    const int nun = NL * (9 * D / 256);
    for (int un = C.bid; un < nun; un += C.G) {
        const int l = un / (9 * D / 256), col0 = (un % (9 * D / 256)) * 256;
        const float* W = C.in[I_WADA] + (size_t)l * D * 9 * D + col0 + 4 * C.lane;
        f32x4 a0 = {0.f, 0.f, 0.f, 0.f}, a1 = a0, a2 = a0;
        const int k0 = C.wave * (D / 8);
#pragma unroll 4
        for (int k = k0; k < k0 + D / 8; ++k) { const f32x4 w = *(const f32x4*)(W + (size_t)k * 9 * D); a0 += w * sc[k]; a1 += w * sc[D + k]; a2 += w * sc[2 * D + k]; }
        LAS float* r = red + C.wave * 768 + 4 * C.lane;
        *(LAS f32x4*)(r) = a0; *(LAS f32x4*)(r + 256) = a1; *(LAS f32x4*)(r + 512) = a2;
        __syncthreads();
        for (int i = C.tid; i < 768; i += NTHR) { float s = 0.f;
#pragma unroll
            for (int w = 0; w < 8; ++w) s += red[w * 768 + i];
            const int st = i / 256, c = col0 + (i % 256);
            ((float*)(C.ws + WS_MODV))[((size_t)l * 3 + st) * 9 * D + c] = s + C.in[I_BADA][(size_t)l * 9 * D + c]; }
        __syncthreads();
    }
}
DI const float* modv_ptr(const Ctx& C, int l, int s, int chunk) { return (const float*)(C.ws + WS_MODV) + ((size_t)l * 3 + s) * 9 * D + (size_t)chunk * D; }

DI int win_dest(int n) {
    if (n >= D_IN) return -1;
    if (n < SRC_AV) { const int piece = n / GW, loc = n % GW, head = loc / 64, d = loc % 64; return ((piece == 0 ? PN_AQ : PN_AK) + head / 4) * 256 + 128 * (d / 32) + 32 * (head % 4) + (d % 32); }
    if (n < SRC_BS) return PN_AV * 256 + (n - SRC_AV);
    if (n < SRC_CQ) return PN_BS * 256 + (n - SRC_BS);
    if (n < SRC_CK) { const int loc = n - SRC_CQ, head = loc / 64, d = loc % 64; return (PN_CQ + head / 4) * 256 + 128 * (d / 32) + 32 * (head % 4) + (d % 32); }
    if (n < SRC_DU) { const int loc = n - SRC_CK, hh = loc / 64, d = loc % 64; return PN_CKV * 256 + 128 * (d / 32) + 32 * hh + (d % 32); }
    return PN_DU * 256 + (n - SRC_DU);
}
DI void conv_item(const Ctx& C, const float* W, int K, int N, bf16* Wt, int mode, int k0, int n0, float* bias, int bias_pitch, const float* shift  ) {
    LAS float* scr = (LAS float*)(C.lds + C.wave * 16640);
    const int n = n0 + C.lane; const bool ok = n < N; float b0 = 0.f, b1 = 0.f, b2 = 0.f;
#pragma unroll 8
    for (int kk = 0; kk < 64; ++kk) { const float v = ok ? W[(size_t)(k0 + kk) * N + n] : 0.f; scr[kk * 65 + C.lane] = v;
        if (bias) { b0 += shift[k0 + kk] * v; b1 += shift[9 * D + k0 + kk] * v; b2 += shift[18 * D + k0 + kk] * v; } }
    WSYNC();
    const int dme = !ok ? -1 : mode == 0 ? n : mode == 1 ? (n / 128) * 256 + n % 128 : mode == 2 ? (n / 128) * 256 + 128 + n % 128 : win_dest(n);
    if (bias && dme >= 0) { atomicAdd(bias + dme, b0); atomicAdd(bias + bias_pitch + dme, b1); atomicAdd(bias + 2 * bias_pitch + dme, b2); }
    const int c = C.lane & 7;
#pragma unroll
    for (int i = 0; i < 8; ++i) { const int nl = (C.lane >> 3) + 8 * i, nn = n0 + nl;
        const int dr = nn >= N ? -1 : mode == 0 ? nn : mode == 1 ? (nn / 128) * 256 + nn % 128 : mode == 2 ? (nn / 128) * 256 + 128 + nn % 128 : win_dest(nn);
        const LAS float* s = scr + (8 * c) * 65 + nl;
        u32x4 o; o.x = pk2(s[0], s[65]); o.y = pk2(s[2 * 65], s[3 * 65]); o.z = pk2(s[4 * 65], s[5 * 65]); o.w = pk2(s[6 * 65], s[7 * 65]);
        if (dr >= 0) *(u32x4*)(Wt + (size_t)dr * K + k0 + 8 * c) = o; }
    WSYNC();
}
struct Cplx { float re, im; };
DI Cplx cmul(Cplx a, Cplx b) { return Cplx{a.re * b.re - a.im * b.im, a.re * b.im + a.im * b.re}; }
DI Cplx s5_lam_pow(const Ctx& C, int l, int dir, int g, int n, float tau) {
    const size_t i = (((size_t)l * 2 + dir) * S5G + g) * 64 + n; const float dt = __expf(C.in[I_S5LDT][((size_t)l * 2 + dir) * S5G + g]);
    const float mag = __expf(tau * dt * C.in[I_S5ARE][i]), ang = tau * dt * C.in[I_S5AIM][i]; float sn, cs; sincosf(ang, &sn, &cs); return Cplx{mag * cs, mag * sn};
}
DI Cplx s5_coef(const Ctx& C, int l, int dir, int g, int n) {
    const size_t i = (((size_t)l * 2 + dir) * S5G + g) * 64 + n; const float are = C.in[I_S5ARE][i], aim = C.in[I_S5AIM][i];
    const Cplx ab = s5_lam_pow(C, l, dir, g, n, 1.0f); const float den = are * are + aim * aim, nr = ab.re - 1.0f;
    return Cplx{(nr * are + ab.im * aim) / den, (ab.im * are - nr * aim) / den};
}
DI Cplx s5_beta(const Ctx& C, int l, int dir, int g, int n, int q) {
    const size_t i = (((size_t)l * S5G + g) * 64 + n) * 16 + q; return cmul(s5_coef(C, l, dir, g, n), Cplx{C.in[I_S5BRE][i], C.in[I_S5BIM][i]});
}
DI Cplx s5_gamma(const Ctx& C, int l, int g, int p, int n) { const size_t i = (((size_t)l * S5G + g) * 16 + p) * 64 + n; return Cplx{C.in[I_S5CRE][i], C.in[I_S5CIM][i]}; }

constexpr int CI_GU = (D / 64) * (FF / 64), CI_DN = (FF / 64) * (D / 64), CI_IN = (D / 64) * ((D_IN + 63) / 64), CI_OUT = (D / 64) * (D / 64), CI_GLU = (GW / 64) * (GW / 64);
constexpr int CI_LAYER = 4 * CI_GU + 2 * CI_DN + CI_IN + CI_OUT + CI_GLU;
DI void ph_conv(const Ctx& C) {
    const int gt = C.bid * NTHR + C.tid, GT = C.G * NTHR;
    for (int i = gt; i < NL * 9 * D; i += GT) { const int k = i % D, s = (i / D) % 3, sub = (i / (3 * D)) % 3, l = i / (9 * D);
        const float* mv = (const float*)(C.ws + WS_MODV) + ((size_t)l * 3 + s) * 9 * D;
        ((float*)(C.ws + WS_GS))[i] = C.in[I_NORMG][((size_t)l * 3 + sub) * D + k] * (1.0f + mv[(3 * sub + 1) * D + k]);
        ((float*)(C.ws + WS_GATE))[i] = mv[(3 * sub + 2) * D + k] * (sub == 1 ? 1.0f : 0.5f); }
    for (int i = gt; i < 128 * 16; i += GT) { const int pos = i / 16, f = i % 16; const float inv = __expf(-(float)f * (9.210340371976184f / 16.0f)); float sn, cs; sincosf((float)pos * inv, &sn, &cs);
        ((f32x2*)(C.ws + WS_ROPE))[i] = (f32x2){cs, sn}; }
    const int gw = C.bid * NW + C.wave, GWV = C.G * NW;
    for (int it = gw; it < NL * CI_LAYER; it += GWV) {
        const int l = it / CI_LAYER; int r = it % CI_LAYER;
        unsigned char* wbase = C.ws + WS_W + (size_t)l * SZ_WL;
        if (r < 2 * CI_GU) { const int up = r >= CI_GU; r -= up * CI_GU; const int kb = r / (FF / 64), nb = r % (FF / 64);
            conv_item(C, C.in[up ? I_F1WU : I_F1WG] + (size_t)l * D * FF, D, FF, (bf16*)(wbase + OFF_W1GU), 1 + up, kb * 64, nb * 64, bias_ptr(C, l, 0), 2 * FF, modv_ptr(C, l, 0, 0)); continue; } r -= 2 * CI_GU;
        if (r < CI_DN) { const int kb = r / (D / 64), nb = r % (D / 64); conv_item(C, C.in[I_F1WD] + (size_t)l * FF * D, FF, D, (bf16*)(wbase + OFF_W1D), 0, kb * 64, nb * 64, nullptr, 0, nullptr); continue; } r -= CI_DN;
        if (r < CI_IN) { const int nbn = (D_IN + 63) / 64, kb = r / nbn, nb = r % nbn; conv_item(C, C.in[I_WIN] + (size_t)l * D * D_IN, D, D_IN, (bf16*)(wbase + OFF_WIN), 3, kb * 64, nb * 64, bias_ptr(C, l, 1), NINP, modv_ptr(C, l, 0, 3)); continue; } r -= CI_IN;
        if (r < CI_OUT) { const int kb = r / (D / 64), nb = r % (D / 64); conv_item(C, C.in[I_WOUT] + (size_t)l * D * D, D, D, (bf16*)(wbase + OFF_WOUT), 0, kb * 64, nb * 64, nullptr, 0, nullptr); continue; } r -= CI_OUT;
        if (r < 2 * CI_GU) { const int up = r >= CI_GU; r -= up * CI_GU; const int kb = r / (FF / 64), nb = r % (FF / 64);
            conv_item(C, C.in[up ? I_F2WU : I_F2WG] + (size_t)l * D * FF, D, FF, (bf16*)(wbase + OFF_W2GU), 1 + up, kb * 64, nb * 64, bias_ptr(C, l, 2), 2 * FF, modv_ptr(C, l, 0, 6)); continue; } r -= 2 * CI_GU;
        if (r < CI_DN) { const int kb = r / (D / 64), nb = r % (D / 64); conv_item(C, C.in[I_F2WD] + (size_t)l * FF * D, FF, D, (bf16*)(wbase + OFF_W2D), 0, kb * 64, nb * 64, nullptr, 0, nullptr); continue; } r -= CI_DN;
        { const int kb = r / (GW / 64), nb = r % (GW / 64); conv_item(C, C.in[I_S5GLUW] + (size_t)l * GW * GW, GW, GW, (bf16*)(wbase + OFF_WGLU), 0, kb * 64, nb * 64, nullptr, 0, nullptr); }
    }
    LAS float* wsc = (LAS float*)(C.lds + C.wave * 16640);
    for (int it = gw; it < NL * S5G * 2 * S5L; it += GWV) {
        const int tau = it % S5L, dir = (it / S5L) % 2, g = (it / (2 * S5L)) % S5G, l = it / (2 * S5L * S5G);
        const Cplx z = cmul(s5_lam_pow(C, l, dir, g, C.lane, (float)tau), s5_coef(C, l, dir, g, C.lane));
#pragma unroll 4
        for (int q = 0; q < 16; ++q) { const size_t i = (((size_t)l * S5G + g) * 64 + C.lane) * 16 + q; const Cplx w = cmul(z, Cplx{C.in[I_S5BRE][i], C.in[I_S5BIM][i]}); wsc[(C.lane * 16 + q) * 2] = w.re; wsc[(C.lane * 16 + q) * 2 + 1] = w.im; }
        WSYNC();
        float* kc = (float*)(C.ws + WS_S5T + (size_t)l * SZ_S5L + OFF_S5KC) + (((size_t)g * 2 + dir) * S5L + tau) * 256;
#pragma unroll 1
        for (int e = 0; e < 4; ++e) { const int pq = C.lane + 64 * e, p = pq >> 4, q = pq & 15; float s = 0.f;
#pragma unroll 4
            for (int n = 0; n < 64; ++n) { const Cplx gm = s5_gamma(C, l, g, p, n); s += gm.re * wsc[(n * 16 + q) * 2] - gm.im * wsc[(n * 16 + q) * 2 + 1]; }
            kc[pq] = s; }
        WSYNC();
    }
    for (int i = gt; i < NL * 2 * GW * 4; i += GT) { const int n = i % 64, g = (i / 64) % S5G, dir = (i / (64 * S5G)) % 2, l = i / (2 * 64 * S5G); const Cplx z = s5_lam_pow(C, l, dir, g, n, (float)S5L);
        ((f32x2*)(C.ws + WS_S5T + (size_t)l * SZ_S5L + OFF_S5LAM))[(dir * S5G + g) * 64 + n] = (f32x2){z.re, z.im}; }
}
DI void ph_tab(const Ctx& C) {
    const long gt = (long)C.bid * NTHR + C.tid, GT = (long)C.G * NTHR;
    for (long i = gt; i < (long)NL * S5G * 256 * 512; i += GT) {
        const int k = (int)(i % 512), np = (int)((i / 512) % 256), g = (int)((i / (512 * 256)) % S5G), l = (int)(i / ((long)512 * 256 * S5G));
        const int j = k >> 4, q = k & 15, dir = np >> 7, n = np & 63, im = (np >> 6) & 1;
        const Cplx w = cmul(s5_lam_pow(C, l, dir, g, n, dir == 0 ? (float)(S5L - 1 - j) : (float)j), s5_beta(C, l, dir, g, n, q));
        ((bf16*)(C.ws + WS_S5T + (size_t)l * SZ_S5L + OFF_S5ET))[((size_t)g * 256 + np) * 512 + k] = (bf16)f2bf(im ? w.im : w.re); }
    for (long i = gt; i < (long)NL * S5G * 512 * S5K; i += GT) {
        const int k = (int)(i % S5K), nn = (int)((i / S5K) % 512), g = (int)((i / ((long)S5K * 512)) % S5G), l = (int)(i / ((long)S5K * 512 * S5G));
        const int ti = nn >> 4, p = nn & 15; float v;
        if (k < 512) { const int j = k >> 4, q = k & 15; const float* kc = (const float*)(C.ws + WS_S5T + (size_t)l * SZ_S5L + OFF_S5KC) + (size_t)g * 2 * S5L * 256;
            v = 0.f; if (j <= ti) v += kc[((ti - j)) * 256 + p * 16 + q]; if (j >= ti) v += kc[(S5L + (j - ti)) * 256 + p * 16 + q]; }
        else { const int kk = k - 512, dir = kk >> 7, im = (kk >> 6) & 1, n = kk & 63;
            const Cplx w = cmul(s5_gamma(C, l, g, p, n), s5_lam_pow(C, l, dir, g, n, dir == 0 ? (float)(ti + 1) : (float)(S5L - ti))); v = im ? -w.im : w.re; }
        ((bf16*)(C.ws + WS_S5T + (size_t)l * SZ_S5L + OFF_S5BT))[((size_t)g * 512 + nn) * S5K + k] = (bf16)f2bf(v); }
    const int gw = C.bid * NW + C.wave, GWV = C.G * NW;
    for (int row = gw; row < M; row += GWV) {
        const float* src = row < M_LAT ? C.in[I_X] + (size_t)row * D : C.in[I_CTX] + (size_t)(row - M_LAT) * D;
        float* dst = xrow_ptr(C, row); const float* gs = gs_ptr(C, 0, 0, stream_of_row(row)); bf16* ap = (bf16*)(C.ws + WS_AP) + (size_t)row * D; float ss = 0.f;
        for (int c = 4 * C.lane; c < D; c += 256) { const f32x4 x = *(const f32x4*)(src + c); *(f32x4*)(dst + c) = x; ss += (x[0] * x[0] + x[1] * x[1]) + (x[2] * x[2] + x[3] * x[3]);
            const f32x4 a = x * *(const f32x4*)(gs + c); u32x2 w; w.x = pk2(a[0], a[1]); w.y = pk2(a[2], a[3]); *(u32x2*)(ap + c) = w; }
        ss = wave_sum(ss); if (C.lane == 0) rowss_ptr(C, 0, 0)[row] = ss;
    }
}

#ifdef EMU
DI s16x4 tr_read1(const LAS unsigned char* a) { return emu_tr_read(a); }
#else
DI s16x4 tr_read1(const LAS unsigned char* a) { s16x4 r; asm volatile("ds_read_b64_tr_b16 %0, %1\n\ts_waitcnt lgkmcnt(0)" : "=&v"(r) : "v"((unsigned)(size_t)a) : "memory"); return r; }
#endif
DI bf16x8 pack8(const f32x16& x, int s) {
    u32x4 p; p.x = pk2(x[8 * s], x[8 * s + 1]); p.y = pk2(x[8 * s + 2], x[8 * s + 3]); p.z = pk2(x[8 * s + 4], x[8 * s + 5]); p.w = pk2(x[8 * s + 6], x[8 * s + 7]);
    return __builtin_bit_cast(bf16x8, p);
}
struct AttnSt { f32x16 o0, o1; float m, l; };
template <bool MASKED>
DI void attn_block(AttnSt& st, const bf16x8 (&qf)[4], const bf16* Kb, int kp, const bf16* Vb, int vp, LAS unsigned char* vl, int lane, const float (&addv)[16], unsigned vmask) {
    const int r32 = lane & 31, h = lane >> 5;
#pragma unroll
    for (int i = 0; i < 4; ++i) { const int idx = lane + 64 * i, key = idx >> 3, ch = idx & 7; *(LAS u32x4*)(vl + key * 128 + ch * 16) = *(const u32x4*)(Vb + (size_t)key * vp + ch * 8); }
    f32x16 s;
#pragma unroll
    for (int i = 0; i < 16; ++i) s[i] = 0.f;
#pragma unroll
    for (int kk = 0; kk < 4; ++kk) { const bf16x8 kf = *(const bf16x8*)(Kb + (size_t)r32 * kp + 16 * kk + 8 * h); s = __builtin_amdgcn_mfma_f32_32x32x16_bf16(kf, qf[kk], s, 0, 0, 0); }
    float bm = -1e30f;
#pragma unroll
    for (int i = 0; i < 16; ++i) { if (MASKED) { s[i] += addv[i]; if ((vmask >> i) & 1u) bm = fmaxf(bm, s[i]); } else bm = fmaxf(bm, s[i]); }
    bm = fmaxf(bm, __shfl_xor(bm, 32));
    const float mn = fmaxf(st.m, bm), alpha = __expf(st.m - mn); st.m = mn;
    float ls = 0.f;
#pragma unroll
    for (int i = 0; i < 16; ++i) { float p = __expf(s[i] - mn); if (MASKED) p = ((vmask >> i) & 1u) ? p : 0.f; s[i] = p; ls += p; }
    st.l = st.l * alpha + ls;
#pragma unroll
    for (int i = 0; i < 16; ++i) { st.o0[i] *= alpha; st.o1[i] *= alpha; }
    WSYNC();
    const int q = (lane & 15) >> 2, p4 = lane & 3, blk = (lane >> 4) & 1;
#pragma unroll
    for (int sx = 0; sx < 2; ++sx) {
        const bf16x8 pf = pack8(s, sx);
#pragma unroll
        for (int dt = 0; dt < 2; ++dt) {
            const LAS unsigned char* a0 = vl + (16 * sx + 4 * h + q) * 128 + (32 * dt + 16 * blk) * 2 + 8 * p4;
            const s16x4 lo = tr_read1(a0), hi = tr_read1(a0 + 8 * 128);
            const bf16x8 vf = __builtin_shufflevector(lo, hi, 0, 1, 2, 3, 4, 5, 6, 7);
            if (dt == 0) st.o0 = __builtin_amdgcn_mfma_f32_32x32x16_bf16(vf, pf, st.o0, 0, 0, 0); else st.o1 = __builtin_amdgcn_mfma_f32_32x32x16_bf16(vf, pf, st.o1, 0, 0, 0);
        }
    }
}
DI void attn_finish(AttnSt& st, bf16* orow  , int lane, float extra_l) {
    const int h = lane >> 5; float l = st.l + __shfl_xor(st.l, 32) + extra_l; const float inv = 1.0f / l;
#pragma unroll
    for (int g = 0; g < 4; ++g) {
        u32x2 w0, w1; w0.x = pk2(st.o0[4 * g] * inv, st.o0[4 * g + 1] * inv); w0.y = pk2(st.o0[4 * g + 2] * inv, st.o0[4 * g + 3] * inv);
        w1.x = pk2(st.o1[4 * g] * inv, st.o1[4 * g + 1] * inv); w1.y = pk2(st.o1[4 * g + 2] * inv, st.o1[4 * g + 3] * inv);
        *(u32x2*)(orow + 8 * g + 4 * h) = w0; *(u32x2*)(orow + 32 + 8 * g + 4 * h) = w1; }
}
DI int clampi(int v, int lo, int hi) { return v < lo ? lo : (v > hi ? hi : v); }
constexpr int AT_NA = NB * NH * (GRH / 2) * 4, AT_WA = NB * NH * (T / 32), AT_CX = NB * NH * (TC / 32);
DI void ph_attn(const Ctx& C, int l, bool want_ctx) {
    const int gw = C.bid * NW + C.wave, GWV = C.G * NW, lane = C.lane, r32 = lane & 31, h = lane >> 5;
    LAS unsigned char* vl = C.lds + C.wave * 4096;
    const bf16* QA = (const bf16*)(C.ws + WS_QA); const bf16* KA = (const bf16*)(C.ws + WS_KA); const bf16* VA = (const bf16*)(C.ws + WS_VA);
    const bf16* QC = (const bf16*)(C.ws + WS_QC); const bf16* KC = (const bf16*)(C.ws + WS_KC); const bf16* VC = (const bf16*)(C.ws + WS_VC);
    bf16* OB = (bf16*)(C.ws + WS_OB);
    const int ntiles = AT_NA + AT_WA + (want_ctx ? 2 * AT_CX : 0);
    const float zero16[16] = {0.f, 0.f, 0.f, 0.f, 0.f, 0.f, 0.f, 0.f, 0.f, 0.f, 0.f, 0.f, 0.f, 0.f, 0.f, 0.f};
    for (int tile = gw; tile < ntiles; tile += GWV) {
        AttnSt st; st.m = -1e30f; st.l = 0.f;
#pragma unroll
        for (int i = 0; i < 16; ++i) { st.o0[i] = 0.f; st.o1[i] = 0.f; }
        bf16x8 qf[4];
        if (tile < AT_NA) {
            const int cb = tile & 3, rp = (tile >> 2) % (GRH / 2), hd = (tile / (4 * (GRH / 2))) % NH, b = tile / (4 * (GRH / 2) * NH);
            const int r0 = 2 * rp, c0 = 16 * cb, qr = r0 + (r32 >> 4), qc = c0 + (r32 & 15), qrow = b * T + qr * GRW + qc;
#pragma unroll
            for (int kk = 0; kk < 4; ++kk) qf[kk] = *(const bf16x8*)(QA + (size_t)qrow * GW + hd * 64 + 16 * kk + 8 * h);
            const int rsq = clampi(qr - 4, 0, GRH - 8), csq = clampi(qc - 8, 0, GRW - 16);
            const int rsA = clampi(r0 - 4, 0, GRH - 8), rsB = clampi(r0 + 1 - 4, 0, GRH - 8), kc0 = clampi(c0 - 8, 0, GRW - 32);
            const float* rpb = C.in[I_NARPB] + ((size_t)l * NH + hd) * 465;
            for (int kr = rsA; kr <= rsB + 7; ++kr) {
                float addv[16]; unsigned vm = 0u; const bool rok = kr >= rsq && kr <= rsq + 7;
#pragma unroll
                for (int i = 0; i < 16; ++i) { const int kb = (i & 3) + 8 * (i >> 2) + 4 * h, kc = kc0 + kb; const bool ok = rok && kc >= csq && kc <= csq + 15;
                    const int bi = ok ? (kr - qr + 7) * 31 + (kc - qc + 15) : 0; addv[i] = rpb[bi]; vm |= ok ? (1u << i) : 0u; }
                const size_t krow = (size_t)b * T + kr * GRW + kc0;
                attn_block<true>(st, qf, KA + krow * GW + hd * 64, GW, VA + krow * GW + hd * 64, GW, vl, lane, addv, vm);
            }
            for (int cbk = 0; cbk < TC / 32; ++cbk) { const size_t krow = (size_t)M_LAT + b * TC + 32 * cbk;
                attn_block<false>(st, qf, KA + krow * GW + hd * 64, GW, VA + krow * GW + hd * 64, GW, vl, lane, zero16, 0xffffu); }
            attn_finish(st, OB + (size_t)qrow * D + hd * 64, lane, 0.f);
        } else if (tile < AT_NA + AT_WA) {
            const int t2 = tile - AT_NA, qb = t2 % (T / 32), hd = (t2 / (T / 32)) % NH, b = t2 / ((T / 32) * NH), kvh = hd / WAG;
            const int qt = 32 * qb + r32, qrow = b * T + qt;
#pragma unroll
            for (int kk = 0; kk < 4; ++kk) qf[kk] = *(const bf16x8*)(QC + (size_t)qrow * GW + hd * 64 + 16 * kk + 8 * h);
            for (int i9 = 0; i9 < 9; ++i9) { const int t0 = 32 * qb - 128 + 32 * i9; if (t0 < 0 || t0 >= T) continue;
                float addv[16]; unsigned vm = 0u;
#pragma unroll
                for (int i = 0; i < 16; ++i) { const int kt = t0 + (i & 3) + 8 * (i >> 2) + 4 * h, rel = kt - qt; addv[i] = 0.f; vm |= (rel >= -128 && rel <= 128) ? (1u << i) : 0u; }
                const size_t krow = (size_t)b * T + t0;
                attn_block<true>(st, qf, KC + krow * 128 + kvh * 64, 128, VC + krow * 128 + kvh * 64, 128, vl, lane, addv, vm); }
            for (int cbk = 0; cbk < TC / 32; ++cbk) { const size_t krow = (size_t)M_LAT + b * TC + 32 * cbk;
                attn_block<false>(st, qf, KC + krow * 128 + kvh * 64, 128, VC + krow * 128 + kvh * 64, 128, vl, lane, zero16, 0xffffu); }
            const float sk = C.in[I_WASINK][(size_t)l * NH + hd];
            const float mfin = fmaxf(st.m, sk), a2 = __expf(st.m - mfin);
#pragma unroll
            for (int i = 0; i < 16; ++i) { st.o0[i] *= a2; st.o1[i] *= a2; }
            st.l *= a2; st.m = mfin;
            attn_finish(st, OB + (size_t)qrow * D + 2 * GW + hd * 64, lane, __expf(sk - mfin));
        } else {
            const int t2 = tile - AT_NA - AT_WA, isc = t2 >= AT_CX, t3 = t2 - isc * AT_CX, qb = t3 % (TC / 32), hd = (t3 / (TC / 32)) % NH, b = t3 / ((TC / 32) * NH), kvh = hd / WAG;
            const int qrow = M_LAT + b * TC + 32 * qb + r32;
            const bf16* Qs = isc ? QC : QA; const bf16* Ks = isc ? KC + kvh * 64 : KA + hd * 64; const bf16* Vs = isc ? VC + kvh * 64 : VA + hd * 64; const int kp = isc ? 128 : GW;
#pragma unroll
            for (int kk = 0; kk < 4; ++kk) qf[kk] = *(const bf16x8*)(Qs + (size_t)qrow * GW + hd * 64 + 16 * kk + 8 * h);
            for (int cbk = 0; cbk < TC / 32; ++cbk) { const size_t krow = (size_t)M_LAT + b * TC + 32 * cbk;
                attn_block<false>(st, qf, Ks + krow * kp, kp, Vs + krow * kp, kp, vl, lane, zero16, 0xffffu); }
            float extra = 0.f;
            if (isc) { const float sk = C.in[I_WASINK][(size_t)l * NH + hd]; const float mfin = fmaxf(st.m, sk), a2 = __expf(st.m - mfin);
#pragma unroll
                for (int i = 0; i < 16; ++i) { st.o0[i] *= a2; st.o1[i] *= a2; }
                st.l *= a2; st.m = mfin; extra = __expf(sk - mfin); }
            attn_finish(st, OB + (size_t)qrow * D + (isc ? 2 * GW : 0) + hd * 64, lane, extra);
        }
    }
}

DI void ph_rwprep(const Ctx& C, int l) {
    LAS float* sm = (LAS float*)C.lds;
    const int c = C.tid; const bool act = c < GW;
    const bf16* PB = (const bf16*)(C.ws + WS_PB); const float* PS = (const float*)(C.ws + WS_PS);
    const float* cw = C.in[I_RWCONV] + (size_t)l * 9 * GW;
    float cwv[3][3];
    if (act) {
#pragma unroll
        for (int j = 0; j < 3; ++j)
#pragma unroll
            for (int x = 0; x < 3; ++x) cwv[j][x] = cw[(size_t)j * 3 * GW + x * GW + c]; }
    const float w00 = act ? C.in[I_RWW0][((size_t)l * 2 + 0) * GW + c] : 0.f, w01 = act ? C.in[I_RWW0][((size_t)l * 2 + 1) * GW + c] : 0.f;
    const float a00 = act ? C.in[I_RWA0][((size_t)l * 2 + 0) * GW + c] : 0.f, a01 = act ? C.in[I_RWA0][((size_t)l * 2 + 1) * GW + c] : 0.f;
    const float kkw = act ? C.in[I_RWKK][(size_t)l * GW + c] : 0.f, kaw = act ? C.in[I_RWKA][(size_t)l * GW + c] : 0.f;
    const float* wup = C.in[I_RWWUP] + (size_t)l * 2 * 32 * GW; const float* aup = C.in[I_RWAUP] + (size_t)l * 2 * 32 * GW; const float* gup = C.in[I_RWGUP] + (size_t)l * 96 * GW;
    for (int it = C.bid; it < M / 16; it += C.G) {
        const int row0 = it * 16;
        const int seq_lo = row0 < M_LAT ? (row0 / T) * T : M_LAT + ((row0 - M_LAT) / TC) * TC, seq_hi = row0 < M_LAT ? seq_lo + T : seq_lo + TC;
        __syncthreads();
        for (int i = C.tid; i < 16 * 160; i += NTHR) { const int t = i / 160, k = i % 160; const float v = PS[(size_t)(row0 + t) * 160 + k]; sm[i] = k < 32 ? tanhf(v) : (k < 64 ? v : sigmf(v)); }
        __syncthreads();
        if (act) {
            float aw0[16], aw1[16], aa0[16], aa1[16], ag[16];
#pragma unroll
            for (int t = 0; t < 16; ++t) { aw0[t] = 0.f; aw1[t] = 0.f; aa0[t] = 0.f; aa1[t] = 0.f; ag[t] = 0.f; }
            for (int k = 0; k < 32; ++k) { const float u0 = wup[(size_t)k * GW + c], u1 = wup[(size_t)(32 + k) * GW + c], v0 = aup[(size_t)k * GW + c], v1 = aup[(size_t)(32 + k) * GW + c];
#pragma unroll
                for (int t = 0; t < 16; ++t) { const float dw = sm[t * 160 + k], da = sm[t * 160 + 32 + k]; aw0[t] += dw * u0; aw1[t] += dw * u1; aa0[t] += da * v0; aa1[t] += da * v1; } }
            for (int k = 0; k < 96; ++k) { const float gv = gup[(size_t)k * GW + c];
#pragma unroll
                for (int t = 0; t < 16; ++t) ag[t] += sm[t * 160 + 64 + k] * gv; }
            float pr[3], cu[3], nx[3];
#pragma unroll
            for (int x = 0; x < 3; ++x) { pr[x] = row0 - 1 >= seq_lo ? bf2f(PB[(size_t)(row0 - 1) * 3 * GW + x * GW + c]) : 0.f; cu[x] = bf2f(PB[(size_t)row0 * 3 * GW + x * GW + c]); }
#pragma unroll
            for (int t = 0; t < 16; ++t) { const int row = row0 + t;
#pragma unroll
                for (int x = 0; x < 3; ++x) nx[x] = row + 1 < seq_hi ? bf2f(PB[(size_t)(row + 1) * 3 * GW + x * GW + c]) : 0.f;
                const float r = pr[0] * cwv[0][0] + cu[0] * cwv[1][0] + nx[0] * cwv[2][0], kf = pr[1] * cwv[0][1] + cu[1] * cwv[1][1] + nx[1] * cwv[2][1], v = pr[2] * cwv[0][2] + cu[2] * cwv[1][2] + nx[2] * cwv[2][2];
#pragma unroll
                for (int x = 0; x < 3; ++x) { pr[x] = cu[x]; cu[x] = nx[x]; }
                const float kkv = kf * kkw, ssq = wave_sum(kkv * kkv), kk = kkv / fmaxf(sqrtf(ssq), 1e-12f);
                const size_t o = (size_t)row * GW + c;
                rw_arr(C, RW_R)[o] = r; rw_arr(C, RW_V)[o] = v; rw_arr(C, RW_NKK)[o] = -kk; rw_arr(C, RW_G)[o] = ag[t];
                { const float z = -(w00 + aw0[t]), sp = z > 20.f ? z : log1pf(__expf(z)), wlog = -sp - 0.5f, a = sigmf(a00 + aa0[t]);
                  rw_arr(C, RW_W0)[o] = __expf(-__expf(wlog)); rw_arr(C, RW_K0)[o] = kf * (1.f + (a - 1.f) * kaw); rw_arr(C, RW_B0)[o] = kk * a; }
                { const float z = -(w01 + aw1[t]), sp = z > 20.f ? z : log1pf(__expf(z)), wlog = -sp - 0.5f, a = sigmf(a01 + aa1[t]);
                  rw_arr(C, RW_W1)[o] = __expf(-__expf(wlog)); rw_arr(C, RW_K1)[o] = kf * (1.f + (a - 1.f) * kaw); rw_arr(C, RW_B1)[o] = kk * a; }
            }
        }
    }
    __syncthreads();
}
template <int N> DI float ror_add(float v) { return v + __int_as_float(__builtin_amdgcn_mov_dpp(__float_as_int(v), 0x120 + N, 0xf, 0xf, true)); }
DI float row16_sum(float v) { v = ror_add<8>(v); v = ror_add<4>(v); v = ror_add<2>(v); v = ror_add<1>(v); return v; }
DI void ph_rwscan(const Ctx& C) {
    if (C.wave >= 4) return;
    const int lane = C.lane, sub = lane & 15, vr = lane >> 4;
    const int nitems = NB * NH * 2 * 16;
    for (int it = C.bid * 4 + C.wave; it < nitems; it += C.G * 4) {
        const int rg = it & 15, dir = (it >> 4) & 1, hd = (it >> 5) % NH, b = it / (32 * NH);
        const int col = hd * 64 + 4 * sub, vcol = hd * 64 + 4 * rg + vr;
        const float* Wd = rw_arr(C, dir ? RW_W1 : RW_W0); const float* Kd = rw_arr(C, dir ? RW_K1 : RW_K0); const float* Bd = rw_arr(C, dir ? RW_B1 : RW_B0);
        const float* Rr = rw_arr(C, RW_R); const float* Vv = rw_arr(C, RW_V); const float* Nk = rw_arr(C, RW_NKK); float* Y = rw_arr(C, dir ? RW_Y1 : RW_Y0);
        f32x4 s = {0.f, 0.f, 0.f, 0.f};
        for (int seg = 0; seg < 2; ++seg) {
            const int base = seg == 0 ? M_LAT + b * TC : b * T, len = seg == 0 ? TC : T;
            for (int i0 = 0; i0 < len; i0 += 4) {
                f32x4 nk[4], w4[4], b4[4], k4[4], r4[4]; float vv[4]; int rows[4];
#pragma unroll
                for (int u = 0; u < 4; ++u) { const int i = i0 + u, row = base + (dir ? len - 1 - i : i); rows[u] = row; const size_t o = (size_t)row * GW + col;
                    nk[u] = *(const f32x4*)(Nk + o); w4[u] = *(const f32x4*)(Wd + o); b4[u] = *(const f32x4*)(Bd + o); k4[u] = *(const f32x4*)(Kd + o); r4[u] = *(const f32x4*)(Rr + o); vv[u] = Vv[(size_t)row * GW + vcol]; }
#pragma unroll
                for (int u = 0; u < 4; ++u) {
                    const f32x4 p = s * nk[u]; const float sa = row16_sum((p[0] + p[1]) + (p[2] + p[3]));
                    s = s * w4[u] + b4[u] * sa + k4[u] * vv[u];
                    const f32x4 yq = s * r4[u]; const float y = row16_sum((yq[0] + yq[1]) + (yq[2] + yq[3]));
                    if (sub == 0) Y[(size_t)rows[u] * GW + vcol] = y;
                }
            }
        }
    }
}
DI void ph_rwout(const Ctx& C, int l, int mrows) {
    const int gw = C.bid * NW + C.wave, GWV = C.G * NW, lane = C.lane;
    bf16* OB = (bf16*)(C.ws + WS_OB);
    for (int it = gw; it < mrows * NH; it += GWV) {
        const int hd = it % NH, row = it / NH, c = hd * 64 + lane; const size_t o = (size_t)row * GW + c;
        const float r = rw_arr(C, RW_R)[o], v = rw_arr(C, RW_V)[o], ks = rw_arr(C, RW_K0)[o] + rw_arr(C, RW_K1)[o];
        float y = rw_arr(C, RW_Y0)[o] + rw_arr(C, RW_Y1)[o];
        y += wave_sum(r * ks * C.in[I_RWRK][((size_t)l * NH + hd) * 64 + lane]) * v;
        const float mu = wave_sum(y) * (1.f / 64.f), dlt = y - mu, var = wave_sum(dlt * dlt) * (1.f / 64.f);
        const float yn = dlt / sqrtf(var + RW_GN_EPS);
        const float ov = (yn * C.in[I_RWGNW][(size_t)l * GW + c] + C.in[I_RWGNB][(size_t)l * GW + c]) * rw_arr(C, RW_G)[o];
        OB[(size_t)row * D + GW + c] = (bf16)f2bf(ov);
    }
}
constexpr int PT = 144;
constexpr int RW_HALF = 73472, IM_BT = 0, IM_KT = 9216, IM_RT = 18432, IM_ARB = 27648, IM_AT = 36864, IM_AAK = 46080, IM_F = 55296, IM_GC = 72704, FP = 68;
DI void chunk_rows(int b, int dir, int c, int& row0, int& step) {
    if (c < TC / 64) { const int p0 = 64 * c; row0 = M_LAT + b * TC + (dir ? TC - 1 - p0 : p0); } else { const int p0 = 64 * (c - TC / 64); row0 = b * T + (dir ? T - 1 - p0 : p0); }
    step = dir ? -1 : 1;
}
DI bf16x8 frag_rows(const LAS unsigned char* img, int tile, int s, int lane) { return *(const LAS bf16x8*)(img + (32 * tile + (lane & 31)) * PT + (16 * s + 8 * (lane >> 5)) * 2); }
DI bf16x8 frag_cols(const LAS unsigned char* img, int tile, int s, int lane) {
    const int h = lane >> 5, q = (lane & 15) >> 2, p4 = lane & 3, blk = (lane >> 4) & 1;
    const LAS unsigned char* a0 = img + (16 * s + 8 * h + q) * PT + (32 * tile + 16 * blk) * 2 + 8 * p4;
    const s16x4 lo = tr_read1(a0), hi = tr_read1(a0 + 4 * PT);
    return __builtin_shufflevector(lo, hi, 0, 1, 2, 3, 4, 5, 6, 7);
}
DI void store_T(const f32x16& acc, LAS unsigned char* img, int ti, int tj, int lane) {
    const int c = lane & 31, h = lane >> 5;
#pragma unroll
    for (int g = 0; g < 4; ++g) { u32x2 w; w.x = pk2(acc[4 * g], acc[4 * g + 1]); w.y = pk2(acc[4 * g + 2], acc[4 * g + 3]); *(LAS u32x2*)(img + (32 * tj + c) * PT + (32 * ti + 8 * g + 4 * h) * 2) = w; }
}
DI f32x16 zero16v() { f32x16 z;
#pragma unroll
    for (int i = 0; i < 16; ++i) z[i] = 0.f; return z; }
#define MMA32(a, b, c) __builtin_amdgcn_mfma_f32_32x32x16_bf16((a), (b), (c), 0, 0, 0)
DI void ph_rw1(const Ctx& C) {
    const int lane = C.lane, wg = C.wave & 3, grp = C.wave >> 2, ti = wg >> 1, tj = wg & 1, c32 = lane & 31, h = lane >> 5;
    LAS unsigned char* L = C.lds + grp * RW_HALF;
    LAS float* F = (LAS float*)(L + IM_F); LAS float* SEG = (LAS float*)(L + IM_F); LAS float* GC = (LAS float*)(L + IM_GC);
    bf16* QH = (bf16*)(C.ws + WS_QH); float* YL = (float*)(C.ws + WS_YL); bf16* MF = (bf16*)(C.ws + WS_MF); float* GF = (float*)(C.ws + WS_GF);
    for (int it0 = 2 * C.bid; it0 < RITEM; it0 += 2 * C.G) {
        const int item = it0 + grp; const bool live = item < RITEM; const int itc = live ? item : RITEM - 1;
        const int c = itc % RCK, stream = itc / RCK, dir = stream & 1, hd = (stream >> 1) % NH, b = stream / (2 * NH);
        int row0, step; chunk_rows(b, dir, c, row0, step);
        const float* Wd = rw_arr(C, dir ? RW_W1 : RW_W0); const float* Kd = rw_arr(C, dir ? RW_K1 : RW_K0); const float* Bd = rw_arr(C, dir ? RW_B1 : RW_B0);
        const float* Rr = rw_arr(C, RW_R); const float* Vv = rw_arr(C, RW_V); const float* Nk = rw_arr(C, RW_NKK);
        __syncthreads();
        { float lw[16], run = 0.f;
#pragma unroll
          for (int t = 0; t < 16; ++t) { const int i = 16 * wg + t; lw[t] = __logf(Wd[(size_t)(row0 + step * i) * GW + hd * 64 + lane]); run += lw[t]; lw[t] = run; }
          SEG[wg * 64 + lane] = run;
          __syncthreads();
          float off = 0.f;
#pragma unroll
          for (int w2 = 0; w2 < 3; ++w2) off += (w2 < wg) ? SEG[w2 * 64 + lane] : 0.f;
          const float tot = SEG[lane] + SEG[64 + lane] + SEG[128 + lane] + SEG[192 + lane];
          __syncthreads();
          if (wg == 0) GC[lane] = __expf(tot);
#pragma unroll
          for (int t = 0; t < 16; ++t) { const int i = 16 * wg + t; const size_t o = (size_t)(row0 + step * i) * GW + hd * 64 + lane;
              const float Li = lw[t] + off, eL = __expf(Li), ieL = 1.0f / eL, eLm = eL / __expf(lw[t] - (t ? lw[t - 1] : 0.f));
              *(LAS bf16*)(L + IM_AT + i * PT + lane * 2) = (bf16)f2bf(Nk[o] * eLm);
              *(LAS bf16*)(L + IM_BT + i * PT + lane * 2) = (bf16)f2bf(Bd[o] * ieL);
              *(LAS bf16*)(L + IM_KT + i * PT + lane * 2) = (bf16)f2bf(Kd[o] * ieL);
              *(LAS bf16*)(L + IM_RT + i * PT + lane * 2) = (bf16)f2bf(Rr[o] * eL); }
        }
        __syncthreads();
        f32x16 accP;
        { f32x16 aab = zero16v(), aak = zero16v(), arb = zero16v(); accP = zero16v();
#pragma unroll
          for (int s = 0; s < 4; ++s) { const bf16x8 at_i = frag_rows(L + IM_AT, ti, s, lane), bt_j = frag_rows(L + IM_BT, tj, s, lane), kt_j = frag_rows(L + IM_KT, ti, s, lane), at_c = frag_rows(L + IM_AT, tj, s, lane),
                                          bt_r = frag_rows(L + IM_BT, ti, s, lane), rt_c = frag_rows(L + IM_RT, tj, s, lane);
              aab = MMA32(at_i, bt_j, aab);
              aak = MMA32(kt_j, at_c, aak);
              arb = MMA32(bt_r, rt_c, arb);
              accP = MMA32(kt_j, rt_c, accP); }
#pragma unroll
          for (int r = 0; r < 16; ++r) { const int row = 32 * ti + (r & 3) + 8 * (r >> 2) + 4 * h, col = 32 * tj + c32;
              F[row * FP + col] = col < row ? aab[r] : 0.f; aak[r] = row < col ? aak[r] : 0.f; arb[r] = row <= col ? arb[r] : 0.f; accP[r] = row <= col ? accP[r] : 0.f; }
          store_T(aak, L + IM_AAK, ti, tj, lane);
          store_T(arb, L + IM_ARB, ti, tj, lane); }
        __syncthreads();
        { float Wc[64]; const int col = 32 * wg + c32; const LAS unsigned char* src = col < 64 ? L + IM_AT + col * 2 : L + IM_AAK + (col - 64) * 2;
          const LAS float* Fo = OPAQUE_LDS(F);
#pragma unroll
          for (int i = 0; i < 64; ++i) Wc[i] = bf2f(*(const LAS bf16*)(src + i * PT));
#pragma unroll
          for (int i = 1; i < 64; ++i) { float a = Wc[i];
#pragma unroll
              for (int j4 = 0; j4 < (i + 3) / 4; ++j4) { const f32x4 f = *(const LAS f32x4*)(Fo + i * FP + 4 * j4); a += f[0] * Wc[4 * j4] + f[1] * Wc[4 * j4 + 1] + f[2] * Wc[4 * j4 + 2] + f[3] * Wc[4 * j4 + 3];
                  if ((j4 & 3) == 3) PIN(a); }
              PIN(a); Wc[i] = a; }
          __syncthreads();
          if (h == 0) { LAS unsigned char* dst = (col < 64 ? L + IM_AT + col * PT : L + IM_AAK + (col - 64) * PT);
#pragma unroll
              for (int i8 = 0; i8 < 8; ++i8) { u32x4 w; w.x = pk2(Wc[8 * i8], Wc[8 * i8 + 1]); w.y = pk2(Wc[8 * i8 + 2], Wc[8 * i8 + 3]); w.z = pk2(Wc[8 * i8 + 4], Wc[8 * i8 + 5]); w.w = pk2(Wc[8 * i8 + 6], Wc[8 * i8 + 7]); *(LAS u32x4*)(dst + i8 * 16) = w; } }
#pragma unroll
          for (int t = 0; t < 16; ++t) { const int i = 16 * wg + t; *(LAS bf16*)(L + IM_F + i * PT + lane * 2) = (bf16)f2bf(Vv[(size_t)(row0 + step * i) * GW + hd * 64 + lane]); }
        }
        __syncthreads();
        { f32x16 q;
#pragma unroll
          for (int g = 0; g < 4; ++g) { const u32x2 w = *(const LAS u32x2*)(L + IM_RT + (32 * tj + c32) * PT + (32 * ti + 8 * g + 4 * h) * 2); q[4 * g] = bflo(w.x); q[4 * g + 1] = bfhi(w.x); q[4 * g + 2] = bflo(w.y); q[4 * g + 3] = bfhi(w.y); }
#pragma unroll
          for (int s = 0; s < 4; ++s) { const bf16x8 arb = frag_rows(L + IM_ARB, tj, s, lane); q = MMA32(frag_rows(L + IM_AT, ti, s, lane), arb, q); accP = MMA32(frag_rows(L + IM_AAK, ti, s, lane), arb, accP); }
          if (live) {
#pragma unroll
              for (int g = 0; g < 4; ++g) { u32x2 w; w.x = pk2(q[4 * g], q[4 * g + 1]); w.y = pk2(q[4 * g + 2], q[4 * g + 3]); *(u32x2*)(QH + (size_t)item * 4096 + (32 * tj + c32) * 64 + 32 * ti + 8 * g + 4 * h) = w; } }
        }
        __syncthreads();
        store_T(accP, L + IM_RT, ti, tj, lane);
        __syncthreads();
        { f32x16 y = zero16v(), m = zero16v(), n;
#pragma unroll
          for (int g = 0; g < 4; ++g) { const u32x2 w = *(const LAS u32x2*)(L + IM_KT + (32 * tj + c32) * PT + (32 * ti + 8 * g + 4 * h) * 2); n[4 * g] = bflo(w.x); n[4 * g + 1] = bfhi(w.x); n[4 * g + 2] = bflo(w.y); n[4 * g + 3] = bfhi(w.y); }
#pragma unroll
          for (int s = 0; s < 4; ++s) { const bf16x8 btc_j = frag_cols(L + IM_BT, tj, s, lane), btc_i = frag_cols(L + IM_BT, ti, s, lane);
              y = MMA32(frag_rows(L + IM_RT, ti, s, lane), frag_cols(L + IM_F, tj, s, lane), y);
              m = MMA32(frag_rows(L + IM_AT, ti, s, lane), btc_j, m);
              n = MMA32(btc_i, frag_rows(L + IM_AAK, tj, s, lane), n); }
          const float gck = GC[32 * tj + c32];
#pragma unroll
          for (int r = 0; r < 16; ++r) { const int row = 32 * ti + (r & 3) + 8 * (r >> 2) + 4 * h, col = 32 * tj + c32; m[r] = (m[r] + (row == col ? 1.0f : 0.f)) * gck; n[r] *= GC[row]; }
          if (live) {
#pragma unroll
              for (int g = 0; g < 4; ++g) *(f32x4*)(YL + (size_t)item * 4096 + ((wg * 4 + g) * 64 + lane) * 4) = (f32x4){y[4 * g], y[4 * g + 1], y[4 * g + 2], y[4 * g + 3]};
#pragma unroll
              for (int s2 = 0; s2 < 2; ++s2) *(bf16x8*)(MF + (size_t)item * 4096 + ((wg * 2 + s2) * 64 + lane) * 8) = pack8(m, s2); }
          store_T(n, L + IM_ARB, ti, tj, lane);
        }
        __syncthreads();
        { f32x16 gacc = zero16v();
#pragma unroll
          for (int s = 0; s < 4; ++s) gacc = MMA32(frag_cols(L + IM_ARB, ti, s, lane), frag_cols(L + IM_F, tj, s, lane), gacc);
          if (live) {
#pragma unroll
              for (int g = 0; g < 4; ++g) *(f32x4*)(GF + (size_t)item * 4096 + ((wg * 4 + g) * 64 + lane) * 4) = (f32x4){gacc[4 * g], gacc[4 * g + 1], gacc[4 * g + 2], gacc[4 * g + 3]}; }
        }
    }
    __syncthreads();
}
DI void ph_rw2(const Ctx& C) {
    const int lane = C.lane;
    const bf16* MF = (const bf16*)(C.ws + WS_MF); const float* GF = (const float*)(C.ws + WS_GF); bf16* SF = (bf16*)(C.ws + WS_SF);
    const int nwork = RSTR * 2;
    for (int wk = C.wave == 0 ? C.bid : nwork; wk < nwork; wk += C.G) {
        const int tj = wk & 1, stream = wk >> 1;
        f32x16 s0 = zero16v(), s1 = zero16v();
        for (int c = 0; c < RCK; ++c) {
            const size_t item = (size_t)stream * RCK + c;
            bf16x8 sf[2][2];
#pragma unroll
            for (int s = 0; s < 2; ++s) { sf[0][s] = pack8(s0, s); sf[1][s] = pack8(s1, s); *(bf16x8*)(SF + item * 4096 + (((0 * 2 + tj) * 2 + s) * 64 + lane) * 8) = sf[0][s]; *(bf16x8*)(SF + item * 4096 + (((1 * 2 + tj) * 2 + s) * 64 + lane) * 8) = sf[1][s]; }
            f32x16 n0, n1;
#pragma unroll
            for (int g = 0; g < 4; ++g) { const f32x4 a = *(const f32x4*)(GF + item * 4096 + (((0 * 2 + tj) * 4 + g) * 64 + lane) * 4), bq = *(const f32x4*)(GF + item * 4096 + (((1 * 2 + tj) * 4 + g) * 64 + lane) * 4);
                n0[4 * g] = a[0]; n0[4 * g + 1] = a[1]; n0[4 * g + 2] = a[2]; n0[4 * g + 3] = a[3]; n1[4 * g] = bq[0]; n1[4 * g + 1] = bq[1]; n1[4 * g + 2] = bq[2]; n1[4 * g + 3] = bq[3]; }
#pragma unroll
            for (int kp = 0; kp < 2; ++kp)
#pragma unroll
                for (int s = 0; s < 2; ++s) {
                    n0 = MMA32(*(const bf16x8*)(MF + item * 4096 + (((kp * 2 + 0) * 2 + s) * 64 + lane) * 8), sf[kp][s], n0);
                    n1 = MMA32(*(const bf16x8*)(MF + item * 4096 + (((kp * 2 + 1) * 2 + s) * 64 + lane) * 8), sf[kp][s], n1); }
            s0 = n0; s1 = n1;
        }
    }
}
DI void ph_rw3(const Ctx& C, int l, int mrows) {
    const int lane = C.lane, wg = C.wave & 3, grp = C.wave >> 2, ti = wg >> 1, tj = wg & 1, c32 = lane & 31, h = lane >> 5;
    LAS float* Ysum = (LAS float*)(C.lds + grp * RW_HALF);
    const bf16* QH = (const bf16*)(C.ws + WS_QH); const float* YL = (const float*)(C.ws + WS_YL); const bf16* SF = (const bf16*)(C.ws + WS_SF); bf16* OB = (bf16*)(C.ws + WS_OB);
    const int nblk = (TC + T) / 64, nitems = NB * NH * nblk;
    for (int it0 = 2 * C.bid; it0 < nitems; it0 += 2 * C.G) {
        const int item = it0 + grp; const bool live = item < nitems; const int itc = live ? item : nitems - 1;
        const int tb = itc % nblk, hd = (itc / nblk) % NH, b = itc / (nblk * NH);
        const int rowb = tb < TC / 64 ? M_LAT + b * TC + 64 * tb : b * T + 64 * (tb - TC / 64);
        __syncthreads();
#pragma unroll
        for (int dir = 0; dir < 2; ++dir) {
            const int c = dir == 0 ? tb : (tb < TC / 64 ? TC / 64 - 1 - tb : TC / 64 + (T / 64 - 1 - (tb - TC / 64)));
            const size_t ci = ((size_t)((b * NH + hd) * 2 + dir)) * RCK + c;
            f32x16 y;
#pragma unroll
            for (int g = 0; g < 4; ++g) { const f32x4 a = *(const f32x4*)(YL + ci * 4096 + ((wg * 4 + g) * 64 + lane) * 4); y[4 * g] = a[0]; y[4 * g + 1] = a[1]; y[4 * g + 2] = a[2]; y[4 * g + 3] = a[3]; }
#pragma unroll
            for (int kp = 0; kp < 2; ++kp)
#pragma unroll
                for (int s = 0; s < 2; ++s) {
                    const bf16* qp = QH + ci * 4096 + (32 * ti + c32) * 64 + 32 * kp + 16 * s + 4 * h; const u32x2 lo = *(const u32x2*)qp, hi = *(const u32x2*)(qp + 8);
                    u32x4 av; av.x = lo.x; av.y = lo.y; av.z = hi.x; av.w = hi.y;
                    y = MMA32(__builtin_bit_cast(bf16x8, av), *(const bf16x8*)(SF + ci * 4096 + (((kp * 2 + tj) * 2 + s) * 64 + lane) * 8), y); }
#pragma unroll
            for (int r = 0; r < 16; ++r) { const int i = 32 * ti + (r & 3) + 8 * (r >> 2) + 4 * h, tk = dir ? 63 - i : i; LAS float* p = Ysum + tk * FP + 32 * tj + c32; if (dir == 0) *p = y[r]; else *p += y[r]; }
            __syncthreads();
        }
        if (live) {
            const int cch = hd * 64 + lane; const float rk = C.in[I_RWRK][((size_t)l * NH + hd) * 64 + lane], gw = C.in[I_RWGNW][(size_t)l * GW + cch], gb = C.in[I_RWGNB][(size_t)l * GW + cch];
            for (int t = 0; t < 16; ++t) { const int tk = 16 * wg + t, row = rowb + tk; if (row >= mrows) continue; const size_t o = (size_t)row * GW + cch;
                const float r = rw_arr(C, RW_R)[o], v = rw_arr(C, RW_V)[o], ks = rw_arr(C, RW_K0)[o] + rw_arr(C, RW_K1)[o];
                float y = Ysum[tk * FP + lane] + wave_sum(r * ks * rk) * v;
                const float mu = wave_sum(y) * (1.f / 64.f), dlt = y - mu, var = wave_sum(dlt * dlt) * (1.f / 64.f);
                OB[(size_t)row * D + GW + cch] = (bf16)f2bf((dlt / sqrtf(var + RW_GN_EPS) * gw + gb) * rw_arr(C, RW_G)[o]); }
        }
    }
    __syncthreads();
}
DI void ph_s5scan(const Ctx& C, int l, int first_block) {
    const int nthreads_total = NB * 2 * S5G * 64;
    if (C.bid < first_block) return;
    const float* XE = (const float*)(C.ws + WS_XEND); bf16* UG = (bf16*)(C.ws + WS_UG);
    const f32x2* LAM = (const f32x2*)(C.ws + WS_S5T + (size_t)l * SZ_S5L + OFF_S5LAM);
    for (int id = (C.bid - first_block) * NTHR + C.tid; id < nthreads_total; id += (C.G - first_block) * NTHR) {
        const int n = id & 63, g = (id >> 6) % S5G, dir = (id / (64 * S5G)) & 1, b = id / (128 * S5G);
        const f32x2 lm = LAM[(dir * S5G + g) * 64 + n]; float xr = 0.f, xi = 0.f;
        const int nc_ctx = TC / S5L, nc_lat = T / S5L, ntot = nc_ctx + nc_lat;
        for (int i0 = 0; i0 < ntot; i0 += 8) {
            float er[8], ei[8]; int chs[8];
#pragma unroll
            for (int u = 0; u < 8; ++u) { const int i = i0 + u; int ch;
                if (i < nc_ctx) ch = (M_LAT + b * TC) / S5L + (dir ? nc_ctx - 1 - i : i); else ch = (b * T) / S5L + (dir ? nc_lat - 1 - (i - nc_ctx) : (i - nc_ctx));
                chs[u] = ch; const float* p = XE + ((size_t)g * NCHP + ch) * 256 + dir * 128 + n; er[u] = p[0]; ei[u] = p[64]; }
#pragma unroll
            for (int u = 0; u < 8; ++u) { bf16* q = UG + ((size_t)g * NCHP + chs[u]) * S5K + 512 + dir * 128 + n; q[0] = (bf16)f2bf(xr); q[64] = (bf16)f2bf(xi);
                const float nr = lm[0] * xr - lm[1] * xi + er[u], ni = lm[0] * xi + lm[1] * xr + ei[u]; xr = nr; xi = ni; }
        }
    }
}

constexpr int PH_PRO = 3, PH_PER_L = 11, NPH = PH_PRO + PH_PER_L * NL;
#ifndef PROBE_REP
#define PROBE_REP -1
#endif
#define NREP(k) ((k) == PROBE_REP ? 2 : 1)
#ifdef ONLY
#define EN(k) ((k) == ONLY)
#else
#define EN(k) true
#endif
#ifdef EMU
void fwd(Args args) {
    unsigned char* lds = emu::lds_base();
#else
__global__ void __launch_bounds__(NTHR, 2) fwd(Args args) {
    extern __shared__ __attribute__((aligned(16))) unsigned char lds[];
#endif
    Ctx C; C.in = args.in; C.out = args.out; C.ws = args.ws; C.lds = (LAS unsigned char*)lds;
    C.tid = threadIdx.x; C.lane = C.tid & 63; C.wave = __builtin_amdgcn_readfirstlane(C.tid >> 6); C.G = gridDim.x; C.bid = blockIdx.x;
#define REFRESH() do { int t_ = threadIdx.x; OPAQUE(t_); C.tid = t_; C.lane = t_ & 63; C.wave = __builtin_amdgcn_readfirstlane(t_ >> 6); } while (0)
    volatile LAS unsigned* MISC = (volatile LAS unsigned*)(C.lds + MISC_OFF);
    if (C.tid < 32) MISC[C.tid] = 0u;
    __syncthreads();
    const int lo = args.ph_lo, hi = args.ph_hi;
    const bool use_bar = (hi - lo) > 1;
    XcdBarrier bar; bar.bar = (unsigned*)(C.ws + WS_CTL) + CW_BAR; bar.x = 0; bar.st = MISC + 8;
    if (use_bar) bar = xcd_barrier_post((unsigned*)(C.ws + WS_CTL) + CW_BAR, MISC + 8);
#define IN(k) (lo <= (k) && (k) < hi)
#define SEAM(k) do { if (IN(k) && IN((k) + 1)) xcd_barrier(bar); } while (0)
    if (EN(0) && IN(0)) { REFRESH(); ph_ada(C); }
    SEAM(0);
    if (EN(1) && IN(1)) { REFRESH(); ph_conv(C); }
    SEAM(1);
    if (EN(2) && IN(2)) { REFRESH(); ph_tab(C); }
    SEAM(2);
    for (int l = 0; l < NL; ++l) {
        const int pb = PH_PRO + PH_PER_L * l; const bool want_ctx = l < NL - 1;
        const int mrows_full = M, mrows_out = want_ctx ? M : M_LAT;
        bf16* AP = (bf16*)(C.ws + WS_AP); bf16* Hb = (bf16*)(C.ws + WS_H); bf16* OB = (bf16*)(C.ws + WS_OB);
        if (EN(3) && IN(pb + 0)) { REFRESH();
            Gemm g{AP, wl(C, l, OFF_W1GU), D, D, D, 0, 0}; Order S; S.init(mrows_full / 256, 2 * FF / 256, 1, C.G, C.bid);
            EpiGU E{rowss_ptr(C, l, 0), bias_ptr(C, l, 0), Hb, mrows_full}; gemm_phase(C.lds, g, S, E); }
        SEAM(pb + 0);
        if (EN(4) && IN(pb + 1)) { REFRESH();
            Gemm g{Hb, wl(C, l, OFF_W1D), FF, FF, FF, 0, 0}; Order S; S.init(mrows_full / 256, D / 256, 1, C.G, C.bid);
            EpiRes E{&C, gate_ptr(C, l, 0, 0), gs_ptr(C, l, 1, 0), rowss_ptr(C, l, 1), AP}; gemm_phase(C.lds, g, S, E); }
        SEAM(pb + 1);
        if (EN(5) && IN(pb + 2)) { REFRESH();
            Gemm g{AP, wl(C, l, OFF_WIN), D, D, D, 0, 0}; Order S; S.init(mrows_full / 256, NT_IN, 1, C.G, C.bid);
            EpiIn E{&C, rowss_ptr(C, l, 1), bias_ptr(C, l, 1), l}; gemm_phase(C.lds, g, S, E); }
        SEAM(pb + 2);
        if (IN(pb + 3)) {
            if (EN(6)) { REFRESH(); Gemm g{(const bf16*)(C.ws + WS_UG), (const bf16*)(C.ws + WS_S5T + (size_t)l * SZ_S5L + OFF_S5ET), S5K, 512, 512, (size_t)NCHP * S5K * 2, (size_t)256 * 512 * 2};
              Order S; S.init(NCHP / 256, 1, S5G, C.G, C.bid); EpiS5A E{(float*)(C.ws + WS_XEND)}; gemm_phase(C.lds, g, S, E); }
            __syncthreads();
            if (EN(7)) { REFRESH(); ph_attn(C, l, want_ctx); }
            if (EN(8)) { REFRESH(); ph_rwprep(C, l); }
        }
        SEAM(pb + 3);
        if (IN(pb + 4)) { for (int rep = 0; rep < NREP(9); ++rep) { if (EN(9)) { REFRESH(); ph_rw1(C); } } }
        SEAM(pb + 4);
        if (IN(pb + 5)) { if (EN(17)) { REFRESH(); ph_rw2(C); } if (EN(10)) { REFRESH(); ph_s5scan(C, l, C.G >= 256 ? 128 : 0); } }
        SEAM(pb + 5);
        if (IN(pb + 6)) {
            if (EN(11)) { REFRESH(); Gemm g{(const bf16*)(C.ws + WS_UG), (const bf16*)(C.ws + WS_S5T + (size_t)l * SZ_S5L + OFF_S5BT), S5K, S5K, S5K, (size_t)NCHP * S5K * 2, (size_t)512 * S5K * 2};
              Order S; S.init(NCHP / 256, 2, S5G, C.G, C.bid); EpiS5C E{(const bf16*)(C.ws + WS_UG), C.in[I_S5D] + (size_t)l * GW, (bf16*)(C.ws + WS_YG)}; gemm_phase(C.lds, g, S, E); }
            if (EN(12)) { REFRESH(); ph_rw3(C, l, mrows_out); }
        }
        SEAM(pb + 6);
        if (EN(13) && IN(pb + 7)) { REFRESH();
            Gemm g{(const bf16*)(C.ws + WS_YG), wl(C, l, OFF_WGLU), GW, GW, GW, 0, 0}; Order S; S.init(mrows_out / 256, GW / 256, 1, C.G, C.bid);
            EpiGLU E{(const bf16*)(C.ws + WS_YG), C.in[I_S5GLUB] + (size_t)l * GW, OB}; gemm_phase(C.lds, g, S, E); }
        SEAM(pb + 7);
        if (EN(14) && IN(pb + 8)) { REFRESH();
            Gemm g{OB, wl(C, l, OFF_WOUT), D, D, D, 0, 0}; Order S; S.init(mrows_out / 256, D / 256, 1, C.G, C.bid);
            EpiRes E{&C, gate_ptr(C, l, 1, 0), gs_ptr(C, l, 2, 0), rowss_ptr(C, l, 2), AP}; gemm_phase(C.lds, g, S, E); }
        SEAM(pb + 8);
        if (EN(15) && IN(pb + 9)) { REFRESH();
            Gemm g{AP, wl(C, l, OFF_W2GU), D, D, D, 0, 0}; Order S; S.init(mrows_out / 256, 2 * FF / 256, 1, C.G, C.bid);
            EpiGU E{rowss_ptr(C, l, 2), bias_ptr(C, l, 2), Hb, mrows_out}; gemm_phase(C.lds, g, S, E); }
        SEAM(pb + 9);
        if (EN(16) && IN(pb + 10)) { REFRESH();
            Gemm g{Hb, wl(C, l, OFF_W2D), FF, FF, FF, 0, 0}; Order S; S.init(mrows_out / 256, D / 256, 1, C.G, C.bid);
            const bool more = l + 1 < NL;
            EpiRes E{&C, gate_ptr(C, l, 2, 0), more ? gs_ptr(C, l + 1, 0, 0) : nullptr, more ? rowss_ptr(C, l + 1, 0) : nullptr, AP}; gemm_phase(C.lds, g, S, E); }
        SEAM(pb + 10);
    }
#undef IN
#undef SEAM
}

#ifndef MK_PER_PHASE
#define MK_PER_PHASE 0
#endif
#ifdef EMU
int g_emu_grid = 4, g_emu_lo = 0, g_emu_hi = NPH;
#endif
extern "C" void kernel_launch(void* const* d_in, const int* in_sizes, int n_in, void* d_out, int out_size, void* d_ws, size_t ws_size, hipStream_t stream) {
    Args a{};
    for (int i = 0; i < 42; ++i) a.in[i] = (const float*)d_in[i];
    a.out = (float*)d_out; a.ws = (unsigned char*)d_ws;
#ifdef EMU
    if (g_emu_lo == 0) hipMemsetAsync(d_ws, 0, WS_ZERO_END, stream);
    for (int ph = g_emu_lo; ph < g_emu_hi; ++ph) { a.ph_lo = ph; a.ph_hi = ph + 1; fprintf(stderr, "phase %d\n", ph); emu::launch(g_emu_grid, NTHR, LDS_BYTES, [=] { fwd(a); }); }
#else
    static int grid = 0;
    if (grid == 0) {
        if (n_in != 42 || out_size != M_LAT * D || ws_size < WS_END) { fprintf(stderr, "kernel_launch: unexpected shapes (n_in %d out %d ws %zu need %zu)\n", n_in, out_size, ws_size, (size_t)WS_END); grid = -1; return; }
        int dev = 0, cus = 0;
        if (hipGetDevice(&dev) != hipSuccess || hipDeviceGetAttribute(&cus, hipDeviceAttributeMultiprocessorCount, dev) != hipSuccess) { grid = -1; return; }
        if (hipFuncSetAttribute((const void*)fwd, hipFuncAttributeMaxDynamicSharedMemorySize, LDS_BYTES) != hipSuccess) { fprintf(stderr, "kernel_launch: hipFuncSetAttribute failed\n"); grid = -1; return; }
        int per_cu = 0; (void)hipOccupancyMaxActiveBlocksPerMultiprocessor(&per_cu, (const void*)fwd, NTHR, LDS_BYTES); (void)hipGetLastError();
        if (per_cu < 1) fprintf(stderr, "kernel_launch: occupancy query reports %d\n", per_cu);
        grid = cus;
    }
    if (grid < 0) return;
    (void)hipMemsetAsync(d_ws, 0, WS_ZERO_END, stream);
#if MK_PER_PHASE
    for (int ph = 0; ph < NPH; ++ph) { a.ph_lo = ph; a.ph_hi = ph + 1; hipLaunchKernelGGL(fwd, dim3(grid), dim3(NTHR), LDS_BYTES, stream, a); }
#else
    a.ph_lo = 0; a.ph_hi = NPH;
    hipLaunchKernelGGL(fwd, dim3(grid), dim3(NTHR), LDS_BYTES, stream, a);
#endif
#endif
}
```

```cpp
#ifdef EMU
#include "emu/emu.h"
#define LAS
#define GAS
#define ASMV(...) ((void)0)
#define WSYNC() do { int _z = 0; (void)emu::wave_gather(&_z, 4); } while (0)
#define OPAQUE(x) ((void)0)
#define PIN(x) ((void)0)
#define OPAQUE_LDS(p) (p)
#else
#include <hip/hip_runtime.h>
#include <cstdio>
#include <cstdint>
#define LAS __attribute__((address_space(3)))
#define GAS __attribute__((address_space(1)))
#define ASMV(...) asm volatile(__VA_ARGS__)
#define PIN(x) asm volatile("" : "+v"(x) :: "memory")
template <class P> __device__ __forceinline__ P opaque_lds(P p) { unsigned a = (unsigned)(size_t)p; asm volatile("" : "+v"(a)); return (P)(size_t)a; }
#define OPAQUE_LDS(p) opaque_lds(p)
#define OPAQUE(x) asm volatile("" : "+v"(x))
#define WSYNC() asm volatile("s_waitcnt lgkmcnt(0)" ::: "memory")
#endif

#ifdef EMU
constexpr int D = 1024, NB = 2, T = 1024, NL = 2, TC = 256, FF = 1024;
#else
constexpr int D = 2048, NB = 2, T = 8192, NL = 4, TC = 256, FF = 5632;
#endif
constexpr int GW = D / 4, NH = GW / 64, WAG = NH / 2, S5G = GW / 16, GRW = 64, GRH = T / GRW;
constexpr int M_LAT = NB * T, M_CTX = NB * TC, M = M_LAT + M_CTX, NPAN = M / 256;
constexpr int TP = GW / 256;
constexpr int NT_IN = 8 * TP + 2, NINP = NT_IN * 256, D_IN = 8 * GW + 416;
constexpr int PN_AQ = 0, PN_AK = TP, PN_AV = 2 * TP, PN_BR = 3 * TP, PN_BK = 4 * TP, PN_BV = 5 * TP, PN_BS = 6 * TP, PN_CQ = 6 * TP + 1, PN_CKV = 7 * TP + 1, PN_DU = 7 * TP + 2;
constexpr int SRC_AQ = 0, SRC_AK = GW, SRC_AV = 2 * GW, SRC_BR = 3 * GW, SRC_BK = 4 * GW, SRC_BV = 5 * GW, SRC_BS = 6 * GW, SRC_CQ = 6 * GW + 160, SRC_CK = 7 * GW + 160, SRC_CV = 7 * GW + 288, SRC_DU = 7 * GW + 416;
constexpr int S5L = 32, NCH = M / S5L, NCHP = ((NCH + 255) / 256) * 256, S5K = 768;
constexpr int NW = 8, NTHR = 512;
constexpr float NORM_EPS = 1e-6f, RW_GN_EPS = 64e-5f;

typedef unsigned short bf16;
typedef short bf16x8 __attribute__((ext_vector_type(8)));
typedef short s16x4 __attribute__((ext_vector_type(4)));
typedef float f32x4 __attribute__((ext_vector_type(4)));
typedef float f32x2 __attribute__((ext_vector_type(2)));
typedef float f32x16 __attribute__((ext_vector_type(16)));
typedef unsigned u32x4 __attribute__((ext_vector_type(4)));
typedef unsigned u32x2 __attribute__((ext_vector_type(2)));
#define DI __device__ __forceinline__

constexpr size_t al256(size_t x) { return (x + 255) & ~(size_t)255; }
constexpr size_t SZ_BIAS_GU = (size_t)3 * 2 * FF * 4, SZ_BIAS_IN = (size_t)3 * NINP * 4;
constexpr size_t WS_CTL = 0;
constexpr size_t WS_BIAS = 65536;
constexpr size_t SZ_BIAS_L = 2 * SZ_BIAS_GU + SZ_BIAS_IN;
constexpr size_t WS_ROWSS = al256(WS_BIAS + NL * SZ_BIAS_L);
constexpr size_t WS_ZERO_END = al256(WS_ROWSS + (size_t)NL * 3 * M * 4);
constexpr size_t WS_MODV = WS_ZERO_END;
constexpr size_t WS_GS = al256(WS_MODV + (size_t)NL * 3 * 9 * D * 4);
constexpr size_t WS_GATE = al256(WS_GS + (size_t)NL * 9 * D * 4);
constexpr size_t WS_ROPE = al256(WS_GATE + (size_t)NL * 9 * D * 4);
constexpr size_t SZ_WGU = (size_t)2 * FF * D * 2, SZ_WD = (size_t)D * FF * 2, SZ_WIN = (size_t)NINP * D * 2, SZ_WOUT = (size_t)D * D * 2, SZ_WGLU = (size_t)GW * GW * 2;
constexpr size_t OFF_W1GU = 0, OFF_W1D = OFF_W1GU + SZ_WGU, OFF_WIN = OFF_W1D + SZ_WD, OFF_WOUT = OFF_WIN + SZ_WIN, OFF_W2GU = OFF_WOUT + SZ_WOUT, OFF_W2D = OFF_W2GU + SZ_WGU, OFF_WGLU = OFF_W2D + SZ_WD, SZ_WL = OFF_WGLU + SZ_WGLU;
constexpr size_t WS_W = al256(WS_ROPE + 128 * 16 * 8);
constexpr size_t SZ_S5KC = (size_t)S5G * 2 * S5L * 256 * 4, SZ_S5ET = (size_t)S5G * 256 * 512 * 2, SZ_S5BT = (size_t)S5G * 512 * S5K * 2, SZ_S5LAM = (size_t)2 * GW * 4 * 8;
constexpr size_t SZ_S5LP = (size_t)2 * S5G * 64 * (S5L + 1) * 8, SZ_S5BETA = (size_t)2 * S5G * 64 * 16 * 8;
constexpr size_t OFF_S5KC = 0, OFF_S5ET = OFF_S5KC + SZ_S5KC, OFF_S5BT = OFF_S5ET + SZ_S5ET, OFF_S5LAM = OFF_S5BT + SZ_S5BT, OFF_S5LP = al256(OFF_S5LAM + SZ_S5LAM), OFF_S5BETA = OFF_S5LP + SZ_S5LP, SZ_S5L = al256(OFF_S5BETA + SZ_S5BETA);
constexpr size_t WS_S5T = al256(WS_W + NL * SZ_WL);
constexpr size_t WS_XC = al256(WS_S5T + NL * SZ_S5L);
constexpr size_t WS_AP = al256(WS_XC + (size_t)M_CTX * D * 4);
constexpr size_t WS_H = al256(WS_AP + (size_t)M * D * 2);
constexpr size_t WS_QA = al256(WS_H + (size_t)M * FF * 2);
constexpr size_t WS_KA = WS_QA + (size_t)M * GW * 2, WS_VA = WS_KA + (size_t)M * GW * 2, WS_QC = WS_VA + (size_t)M * GW * 2;
constexpr size_t WS_KC = WS_QC + (size_t)M * GW * 2, WS_VC = WS_KC + (size_t)M * 128 * 2;
constexpr size_t WS_PB = WS_VC + (size_t)M * 128 * 2;
constexpr size_t WS_PS = al256(WS_PB + (size_t)M * 3 * GW * 2);
constexpr size_t WS_UG = al256(WS_PS + (size_t)M * 160 * 4);
constexpr size_t WS_RW = al256(WS_UG + (size_t)S5G * NCHP * S5K * 2);
constexpr size_t SZ_RWA = (size_t)M * GW * 4;
enum { RW_R = 0, RW_V, RW_NKK, RW_G, RW_W0, RW_W1, RW_K0, RW_K1, RW_B0, RW_B1, RW_Y0, RW_Y1, RW_NARR };
constexpr size_t WS_XEND = al256(WS_RW + RW_NARR * SZ_RWA);
constexpr size_t WS_YG = al256(WS_XEND + (size_t)S5G * NCHP * 256 * 4);
constexpr size_t WS_OB = al256(WS_YG + (size_t)M * GW * 2);
constexpr int RCK = (TC + T) / 64, RSTR = NB * NH * 2, RITEM = RSTR * RCK;
constexpr size_t WS_QH = al256(WS_OB + (size_t)M * D * 2);
constexpr size_t WS_YL = al256(WS_QH + (size_t)RITEM * 8192);
constexpr size_t WS_MF = al256(WS_YL + (size_t)RITEM * 16384);
constexpr size_t WS_GF = al256(WS_MF + (size_t)RITEM * 8192);
constexpr size_t WS_SF = al256(WS_GF + (size_t)RITEM * 16384);
constexpr int RBLK = NB * NH * ((TC + T) / 64);
constexpr size_t WS_RVKG = al256(WS_SF + (size_t)RITEM * 8192);
constexpr size_t SZ_RWF = (size_t)14 * NH * 2 * 64 * 16;
constexpr size_t WS_RWF = al256(WS_RVKG + (size_t)RBLK * 32768);
constexpr size_t WS_RWS = al256(WS_RWF + NL * SZ_RWF);
constexpr size_t WS_END = al256(WS_RWS + (size_t)512 * 2 * 65536);
constexpr int CW_BAR = 1024;

constexpr int LDS_BYTES = 147456, RING_BYTES = 131072, MISC_OFF = LDS_BYTES - 256;

DI unsigned f2bf(float f) { unsigned u = __float_as_uint(f); return (u + 0x7fffu + ((u >> 16) & 1u)) >> 16; }
DI unsigned pk2(float lo, float hi) { return f2bf(lo) | (f2bf(hi) << 16); }
DI float bf2f(unsigned short b) { return __uint_as_float(((unsigned)b) << 16); }
DI float bflo(unsigned w) { return __uint_as_float(w << 16); }
DI float bfhi(unsigned w) { return __uint_as_float(w & 0xffff0000u); }
DI float wave_sum(float v) {
#pragma unroll
    for (int o = 1; o < 64; o <<= 1) v += __shfl_xor(v, o);
    return v;
}
DI float siluf(float x) { return x * __builtin_amdgcn_rcpf(1.f + __expf(-x)); }
DI float sigmf(float x) { return __builtin_amdgcn_rcpf(1.f + __expf(-x)); }
DI float geluf(float x) { const float z = 0.7978845608028654f * (x + 0.044715f * x * x * x); const float e = __expf(2.f * z); return 0.5f * x * (1.f + (1.f - 2.f * __builtin_amdgcn_rcpf(e + 1.f))); }
DI int stream_of_row(int row) { return row < M_LAT ? row / T : NB; }
DI int stream_of_panel(int pm) { return stream_of_row(pm * 256); }

#define XB_TMO      128
#define XB_XCNT(j)  (256  + 64 * (j))
#define XB_XSUB(j)  (1280 + 64 * (j))
#define XB_XGEN(j)  (2304 + 64 * (j))
#define XB_TOP      3328
#define XB_TOPGEN   3392
#define XCD_BAR_WORDS 3456
#define XB_SPIN_CAP (1u << 18)
DI unsigned xb_ld(unsigned* p)              { return __hip_atomic_load(p, __ATOMIC_RELAXED, __HIP_MEMORY_SCOPE_AGENT); }
DI unsigned xb_add(unsigned* p, unsigned v) { return __hip_atomic_fetch_add(p, v, __ATOMIC_RELAXED, __HIP_MEMORY_SCOPE_AGENT); }
DI unsigned xb_xcc_id() { return (unsigned)__builtin_amdgcn_s_getreg((3 << 11) | 20) & 0xFu; }
#define XB_SPIN(cond, bar) do { unsigned _sp = 0; while (cond) { __builtin_amdgcn_s_sleep(1); \
    if ((++_sp & 255u) == 0u) { if (xb_ld(&(bar)[XB_TMO])) break; if (_sp > XB_SPIN_CAP) { atomicAdd(&(bar)[XB_TMO], 1u); break; } } } } while (0)
struct XcdBarrier { unsigned* bar; unsigned x; volatile LAS unsigned* st; };
DI XcdBarrier xcd_barrier_post(unsigned* bar, volatile LAS unsigned* st) {
    XcdBarrier b; b.bar = bar; b.x = xb_xcc_id(); b.st = st;
    if (threadIdx.x == 0) (void)xb_add(&bar[XB_XCNT(b.x)], 1u);
    return b;
}
DI void xcd_barrier_complete(unsigned* bar, unsigned x, unsigned& nloc, unsigned& nx) {
    const unsigned G = gridDim.x * gridDim.y * gridDim.z;
    unsigned sum, cnt, mine, sp = 0u;
    for (;;) {
        sum = 0u; cnt = 0u; mine = 0u;
#pragma unroll
        for (unsigned j = 0; j < 16; ++j) { const unsigned c = xb_ld(&bar[XB_XCNT(j)]); sum += c; cnt += (c > 0u) ? 1u : 0u; mine = (j == x) ? c : mine; }
        if (sum == G) break;
        __builtin_amdgcn_s_sleep(1);
        if ((++sp & 255u) == 0u) { if (xb_ld(&bar[XB_TMO])) break; if (sp > XB_SPIN_CAP) { atomicAdd(&bar[XB_TMO], 1u); break; } }
    }
    nloc = mine > 0u ? mine : 1u; nx = cnt > 0u ? cnt : 1u;
}
DI void xcd_barrier(const XcdBarrier& b) {
    ASMV("s_waitcnt vmcnt(0)" ::: "memory");
    __syncthreads();
    if (threadIdx.x == 0) {
        unsigned* bar = b.bar;
        __builtin_amdgcn_s_waitcnt(0);
        unsigned nloc = b.st[0], nx = b.st[1];
        if (nloc == 0u) { xcd_barrier_complete(bar, b.x, nloc, nx); b.st[0] = nloc; b.st[1] = nx; }
        const unsigned old = xb_add(&bar[XB_XSUB(b.x)], 1u);
        const unsigned gen = old / nloc;
        if (old + 1u == (gen + 1u) * nloc) {
            __builtin_amdgcn_fence(__ATOMIC_RELEASE, "agent");
            ASMV("s_waitcnt vmcnt(0)" ::: "memory");
            const unsigned og = xb_add(&bar[XB_TOP], 1u);
            const unsigned tg = og / nx;
            if (og + 1u == (tg + 1u) * nx) xb_add(&bar[XB_TOPGEN], 1u);
            else XB_SPIN(xb_ld(&bar[XB_TOPGEN]) == tg, bar);
            __builtin_amdgcn_fence(__ATOMIC_ACQUIRE, "agent");
            xb_add(&bar[XB_XGEN(b.x)], 1u);
            ASMV("s_waitcnt vmcnt(0)" ::: "memory");
        } else {
            XB_SPIN(xb_ld(&bar[XB_XGEN(b.x)]) == gen, bar);
            __builtin_amdgcn_fence(__ATOMIC_ACQUIRE, "agent");
            ASMV("s_waitcnt vmcnt(0)" ::: "memory");
        }
    }
    __syncthreads();
}

constexpr int BK = 64, HALF = 128, HTB = HALF * BK * 2, NXCD = 8, WGM = 8;
DI int lds_byte(int r, int c) { const int st = (r >> 4) * 2 + (c >> 5), rr = r & 15, cc = c & 31, ob = rr * 64 + cc * 2; return st * 1024 + (ob ^ (((ob >> 9) & 1) << 5)); }
DI void stage_rc(int b, int& R, int& C) { const int st = b / 1024, sb = b % 1024, swz = sb ^ (((sb >> 9) & 1) << 5); R = (st >> 1) * 16 + swz / 64; C = (st & 1) * 32 + (swz % 64) / 2; }
struct Unit { int pm, pn, z; };
struct Gemm { const bf16* A; const bf16* Bt; int lda, ldb, K; size_t zA, zB; };
struct Order {
    int nM, nN, nZ, per, total, G, c;
    DI void init(int nM_, int nN_, int nZ_, int G_, int c_) { nM = nM_; nN = nN_; nZ = nZ_; per = nM * nN; total = per * nZ; G = G_; c = c_; }
    DI bool next(int i, Unit& u) const {
        const long L = (long)i * G + c; if (L >= total) return false;
        u.z = (int)(L / per); int wgid = (int)(L % per);
        { const int q = per / NXCD, r = per % NXCD, xcd = wgid % NXCD, off = wgid / NXCD; wgid = (xcd < r ? xcd * (q + 1) : r * (q + 1) + (xcd - r) * q) + off; }
        const int nig = WGM * nN, gid = wgid / nig, fm = gid * WGM, gsz = (nM - fm) < WGM ? (nM - fm) : WGM;
        u.pm = fm + ((wgid % nig) % gsz); u.pn = (wgid % nig) / gsz; return true;
    }
};

template <class Epi>
DI void gemm_phase(LAS unsigned char* lds, const Gemm g, const Order& S, const Epi& E) {
    int tid_ = threadIdx.x; OPAQUE(tid_);
    const int tid = tid_, wid = __builtin_amdgcn_readfirstlane(tid >> 6), lane = tid & 63, wr = wid >> 2, wc = wid & 3, fr = lane & 15, fq = lane >> 4;
    Unit cur, nxt; int ui = 0;
    if (!S.next(0, cur)) return;
    f32x4 acc[2][2][4][2];
#ifdef EMU
    (void)lds;
    for (;; ++ui) {
        if (ui > 0) { if (!S.next(ui, cur)) break; }
        const bf16* A = (const bf16*)((const char*)g.A + cur.z * g.zA); const bf16* B = (const bf16*)((const char*)g.Bt + cur.z * g.zB);
        for (int ai = 0; ai < 2; ++ai) for (int bj = 0; bj < 2; ++bj) for (int m = 0; m < 4; ++m) for (int n = 0; n < 2; ++n) for (int j = 0; j < 4; ++j) {
            const int r = 256 * cur.pm + 128 * ai + 64 * wr + 16 * m + fr, c = 256 * cur.pn + 128 * bj + 32 * wc + 16 * n + 4 * fq + j;
            const bf16* a = A + (size_t)r * g.lda; const bf16* b = B + (size_t)c * g.ldb; float s = 0.f;
            for (int k = 0; k < g.K; ++k) s += bf2f(a[k]) * bf2f(b[k]);
            acc[ai][bj][m][n][j] = s; }
        E(acc, cur, wr, wc, fr, fq);
    }
#else
    const int K = g.K, nt = K / BK;
    unsigned voffA[2], voffB[2];
#pragma unroll
    for (int i = 0; i < 2; ++i) { int R, C; stage_rc(tid * 16 + i * 8192, R, C); voffA[i] = (unsigned)(R * g.lda + C) * 2u; voffB[i] = (unsigned)(R * g.ldb + C) * 2u; }
    const size_t kstep = (size_t)(BK * 2);
    const size_t hstepA = (size_t)HALF * g.lda * 2, hstepB = (size_t)HALF * g.ldb * 2, tstepA = 2 * hstepA, tstepB = 2 * hstepB;
    const unsigned ldsw = (unsigned)wid * 1024u;
    const int aoff = lds_byte(wr * 64 + fr, fq * 8), boff = lds_byte(wc * 32 + fr, fq * 8);
#define PG8_SA(b, h) (((b) * 2 + (h)) * HTB)
#define PG8_SB(b, h) ((4 + (b) * 2 + (h)) * HTB)
#define PG8_STAGE(bufoff, gbase, voff) do { _Pragma("unroll") for (int _i = 0; _i < 2; ++_i) \
        __builtin_amdgcn_global_load_lds((const unsigned*)((const char*)(gbase) + (voff)[_i]), (LAS unsigned*)(lds + (bufoff) + ldsw + _i * 8192), 16, 0, 0); } while (0)
#define PG8_LDA(dst, b, h) do { _Pragma("unroll") for (int m = 0; m < 4; ++m) _Pragma("unroll") for (int k = 0; k < 2; ++k) dst[m][k] = *(const LAS bf16x8*)(lds + PG8_SA(b, h) + aoff + m * 2048 + k * 1024); } while (0)
#define PG8_LDB(dst, b, h) do { _Pragma("unroll") for (int n = 0; n < 2; ++n) _Pragma("unroll") for (int k = 0; k < 2; ++k) dst[n][k] = *(const LAS bf16x8*)(lds + PG8_SB(b, h) + boff + n * 2048 + k * 1024); } while (0)
#define PG8_MMA(ai, bj, At, Bt) do { __builtin_amdgcn_s_setprio(1); _Pragma("unroll") for (int m = 0; m < 4; ++m) _Pragma("unroll") for (int n = 0; n < 2; ++n) _Pragma("unroll") for (int k = 0; k < 2; ++k) \
        acc[ai][bj][m][n] = __builtin_amdgcn_mfma_f32_16x16x32_bf16(Bt[n][k], At[m][k], acc[ai][bj][m][n], 0, 0, 0); __builtin_amdgcn_s_setprio(0); } while (0)
#define PG8_WAIT_V(n) asm volatile("s_waitcnt vmcnt(" #n ")" ::: "memory")
#define PG8_WAIT_L(n) asm volatile("s_waitcnt lgkmcnt(" #n ")" ::: "memory")
#define PG8_BAR __builtin_amdgcn_s_barrier()
#define PG8_SCHED __builtin_amdgcn_sched_barrier(0)
#pragma unroll
    for (int a = 0; a < 2; ++a)
#pragma unroll
        for (int b = 0; b < 2; ++b)
#pragma unroll
            for (int m = 0; m < 4; ++m)
#pragma unroll
                for (int n = 0; n < 2; ++n) acc[a][b][m][n] = (f32x4){0.f, 0.f, 0.f, 0.f};
    bf16x8 At[4][2], B0[2][2], B1[2][2];
    const char* cA = (const char*)g.A + (size_t)cur.z * g.zA + (size_t)cur.pm * tstepA; const char* cB = (const char*)g.Bt + (size_t)cur.z * g.zB + (size_t)cur.pn * tstepB;
    PG8_STAGE(PG8_SB(0, 0), cB, voffB); PG8_STAGE(PG8_SB(0, 1), cB + hstepB, voffB); PG8_STAGE(PG8_SA(0, 0), cA, voffA); PG8_STAGE(PG8_SA(0, 1), cA + hstepA, voffA);
    if (wr == 1) PG8_BAR;
    PG8_WAIT_V(2); PG8_BAR;
    PG8_STAGE(PG8_SB(1, 0), cB + kstep, voffB); PG8_STAGE(PG8_SA(1, 0), cA + kstep, voffA); PG8_STAGE(PG8_SB(1, 1), cB + hstepB + kstep, voffB);
    PG8_WAIT_V(6); PG8_BAR;
    for (;;) {
        const bool has_next = S.next(ui + 1, nxt);
        const char* nA = has_next ? (const char*)g.A + (size_t)nxt.z * g.zA + (size_t)nxt.pm * tstepA : cA; const char* nB = has_next ? (const char*)g.Bt + (size_t)nxt.z * g.zB + (size_t)nxt.pn * tstepB : cB;
        for (int t = 0; t < nt; t += 2) {
            const bool last = (t == nt - 2);
            const char* a1 = cA + (size_t)(t + 1) * kstep;
            const char* a2 = last ? nA : cA + (size_t)(t + 2) * kstep; const char* b2 = last ? nB : cB + (size_t)(t + 2) * kstep;
            const char* a3 = a2 + kstep; const char* b3 = b2 + kstep;
            PG8_LDB(B0, 0, 0); PG8_LDB(B1, 0, 1); PG8_SCHED; PG8_LDA(At, 0, 0); PG8_STAGE(PG8_SA(1, 1), a1 + hstepA, voffA);
            PG8_WAIT_V(8); PG8_WAIT_L(0); PG8_BAR; PG8_MMA(0, 0, At, B0); PG8_MMA(0, 1, At, B1); PG8_BAR; PG8_SCHED;
            PG8_LDA(At, 0, 1); PG8_STAGE(PG8_SB(0, 0), b2, voffB); PG8_STAGE(PG8_SB(0, 1), b2 + hstepB, voffB); PG8_STAGE(PG8_SA(0, 0), a2, voffA);
            PG8_WAIT_V(8); PG8_WAIT_L(0); PG8_BAR; PG8_MMA(1, 0, At, B0); PG8_MMA(1, 1, At, B1); PG8_BAR; PG8_SCHED;
            PG8_LDB(B0, 1, 0); PG8_LDB(B1, 1, 1); PG8_SCHED; PG8_LDA(At, 1, 0); PG8_STAGE(PG8_SA(0, 1), a2 + hstepA, voffA);
            PG8_WAIT_V(8); PG8_WAIT_L(0); PG8_BAR; PG8_MMA(0, 0, At, B0); PG8_MMA(0, 1, At, B1); PG8_BAR; PG8_SCHED;
            PG8_LDA(At, 1, 1); PG8_STAGE(PG8_SB(1, 0), b3, voffB); PG8_STAGE(PG8_SB(1, 1), b3 + hstepB, voffB); PG8_STAGE(PG8_SA(1, 0), a3, voffA);
            PG8_WAIT_V(8); PG8_WAIT_L(0); PG8_BAR; PG8_MMA(1, 0, At, B0); PG8_MMA(1, 1, At, B1); PG8_BAR; PG8_SCHED;
        }
        if (wr == 0) PG8_BAR;
        E(acc, cur, wr, wc, fr, fq);
        if (!has_next) break;
#pragma unroll
        for (int a = 0; a < 2; ++a)
#pragma unroll
            for (int b = 0; b < 2; ++b)
#pragma unroll
                for (int m = 0; m < 4; ++m)
#pragma unroll
                    for (int n = 0; n < 2; ++n) acc[a][b][m][n] = (f32x4){0.f, 0.f, 0.f, 0.f};
        cur = nxt; cA = nA; cB = nB; ++ui;
        if (wr == 1) PG8_BAR;
    }
    PG8_WAIT_V(0);
    PG8_BAR;
#undef PG8_SA
#undef PG8_SB
#undef PG8_STAGE
#undef PG8_LDA
#undef PG8_LDB
#undef PG8_MMA
#undef PG8_WAIT_V
#undef PG8_WAIT_L
#undef PG8_BAR
#undef PG8_SCHED
#endif
}

struct Args {
    const float* in[42]; float* out; unsigned char* ws;
    int ph_lo, ph_hi;
};
struct Ctx {
    const float* const* in; float* out; unsigned char* ws;
    LAS unsigned char* lds; int tid, lane, wave, G, bid;
};
DI float* xrow_ptr(const Ctx& C, int row) { return row < M_LAT ? C.out + (size_t)row * D : (float*)(C.ws + WS_XC) + (size_t)(row - M_LAT) * D; }
DI const bf16* wl(const Ctx& C, int l, size_t off) { return (const bf16*)(C.ws + WS_W + (size_t)l * SZ_WL + off); }
DI float* bias_ptr(const Ctx& C, int l, int which  ) { return (float*)(C.ws + WS_BIAS + (size_t)l * SZ_BIAS_L + (which == 0 ? 0 : which == 1 ? SZ_BIAS_GU : SZ_BIAS_GU + SZ_BIAS_IN)); }
DI float* rowss_ptr(const Ctx& C, int l, int sub) { return (float*)(C.ws + WS_ROWSS) + ((size_t)l * 3 + sub) * M; }
DI const float* gs_ptr(const Ctx& C, int l, int sub, int s) { return (const float*)(C.ws + WS_GS) + (((size_t)l * 3 + sub) * 3 + s) * D; }
DI const float* gate_ptr(const Ctx& C, int l, int sub, int s) { return (const float*)(C.ws + WS_GATE) + (((size_t)l * 3 + sub) * 3 + s) * D; }
DI float* rw_arr(const Ctx& C, int a) { return (float*)(C.ws + WS_RW + (size_t)a * SZ_RWA); }
enum { I_X = 0, I_C, I_CTX, I_CCTX, I_WADA, I_BADA, I_NORMG, I_F1WG, I_F1WU, I_F1WD, I_F2WG, I_F2WU, I_F2WD, I_WIN, I_WOUT, I_NAQG, I_NAKG, I_NARPB, I_RWCONV, I_RWW0, I_RWWUP, I_RWA0, I_RWAUP,
       I_RWGUP, I_RWKK, I_RWKA, I_RWRK, I_RWGNW, I_RWGNB, I_WAQG, I_WAKG, I_WASINK, I_S5ARE, I_S5AIM, I_S5LDT, I_S5BRE, I_S5BIM, I_S5CRE, I_S5CIM, I_S5D, I_S5GLUW, I_S5GLUB, I_NIN };

struct EpiGU {
    const float* rowss; const float* bias  ; bf16* H; int mrows;
    DI void operator()(const f32x4 (&acc)[2][2][4][2], const Unit& u, int wr, int wc, int fr_, int fq_) const {
        int tz_ = threadIdx.x; OPAQUE(tz_); const int fr = tz_ & 15, fq = (tz_ & 63) >> 4; (void)fr_; (void)fq_;
        const int s = stream_of_panel(u.pm); const float* bs = bias + (size_t)s * 2 * FF + u.pn * 256 + wc * 32 + 4 * fq;
        f32x4 bg[2], bu[2];
#pragma unroll
        for (int n = 0; n < 2; ++n) { bg[n] = *(const f32x4*)(bs + 16 * n); bu[n] = *(const f32x4*)(bs + 128 + 16 * n); }
#pragma unroll
        for (int ai = 0; ai < 2; ++ai)
#pragma unroll
            for (int m = 0; m < 4; ++m) {
                const int row = u.pm * 256 + ai * 128 + wr * 64 + m * 16 + fr;
                const float rstd = __builtin_amdgcn_rsqf(rowss[row] * (1.0f / D) + NORM_EPS);
                bf16* hp = H + (size_t)row * FF + u.pn * 128 + wc * 32 + 4 * fq;
#pragma unroll
                for (int n = 0; n < 2; ++n) { const f32x4 g = acc[ai][0][m][n] * rstd + bg[n], v = acc[ai][1][m][n] * rstd + bu[n];
                    u32x2 w; w.x = pk2(siluf(g[0]) * v[0], siluf(g[1]) * v[1]); w.y = pk2(siluf(g[2]) * v[2], siluf(g[3]) * v[3]);
                    *(u32x2*)(hp + 16 * n) = w; }
            }
    }
};
struct EpiRes {
    const Ctx* C; const float* gate  ; const float* gsn  ; float* rowss_next; bf16* AP;
    DI void operator()(const f32x4 (&acc)[2][2][4][2], const Unit& u, int wr, int wc, int fr_, int fq_) const {
        int tz_ = threadIdx.x; OPAQUE(tz_); const int fr = tz_ & 15, fq = (tz_ & 63) >> 4; (void)fr_; (void)fq_;
        const int s = stream_of_panel(u.pm); const int col0 = u.pn * 256 + wc * 32 + 4 * fq;
        f32x4 gv[2][2], sv[2][2];
#pragma unroll
        for (int bj = 0; bj < 2; ++bj)
#pragma unroll
            for (int n = 0; n < 2; ++n) { gv[bj][n] = *(const f32x4*)(gate + (size_t)s * D + col0 + bj * 128 + n * 16); sv[bj][n] = gsn ? *(const f32x4*)(gsn + (size_t)s * D + col0 + bj * 128 + n * 16) : (f32x4){0.f, 0.f, 0.f, 0.f}; }
#pragma unroll
        for (int ai = 0; ai < 2; ++ai)
#pragma unroll
            for (int m = 0; m < 4; ++m) {
                const int row = u.pm * 256 + ai * 128 + wr * 64 + m * 16 + fr;
                float* xp = xrow_ptr(*C, row) + col0; float ss = 0.f;
#pragma unroll
                for (int bj = 0; bj < 2; ++bj)
#pragma unroll
                    for (int n = 0; n < 2; ++n) { f32x4 x = *(const f32x4*)(xp + bj * 128 + n * 16); x += gv[bj][n] * acc[ai][bj][m][n]; *(f32x4*)(xp + bj * 128 + n * 16) = x;
                        if (gsn) { ss += (x[0] * x[0] + x[1] * x[1]) + (x[2] * x[2] + x[3] * x[3]); const f32x4 a = x * sv[bj][n]; u32x2 w; w.x = pk2(a[0], a[1]); w.y = pk2(a[2], a[3]);
                            *(u32x2*)(AP + (size_t)row * D + col0 + bj * 128 + n * 16) = w; } }
                if (gsn) { ss += __shfl_xor(ss, 16); ss += __shfl_xor(ss, 32); if (fq == 0) atomicAdd(rowss_next + row, ss); }
            }
    }
};
struct EpiIn {
    const Ctx* C; const float* rowss; const float* bias  ; int l;
    DI void operator()(const f32x4 (&acc)[2][2][4][2], const Unit& u, int wr, int wc, int fr_, int fq_) const {
        int tz_ = threadIdx.x; OPAQUE(tz_); const int fr = tz_ & 15, fq = (tz_ & 63) >> 4; (void)fr_; (void)fq_;
        const int s = stream_of_panel(u.pm), pn = u.pn; const float* bs = bias + (size_t)s * NINP + pn * 256 + wc * 32 + 4 * fq;
        unsigned char* ws = C->ws;
        f32x4 bv[2][2];
#pragma unroll
        for (int bj = 0; bj < 2; ++bj)
#pragma unroll
            for (int n = 0; n < 2; ++n) bv[bj][n] = *(const f32x4*)(bs + bj * 128 + n * 16);
        const bool permuted = pn < PN_AV || (pn >= PN_CQ && pn < PN_DU);
        if (permuted) {
            const bool is_ckv = pn == PN_CKV, is_c = pn >= PN_CQ, is_q = pn < PN_AK || (pn >= PN_CQ && pn < PN_CKV);
            const bool plain_v = is_ckv && wc >= 2;
            const float* gsrc = C->in[is_c ? (is_q ? I_WAQG : I_WAKG) : (is_q ? I_NAQG : I_NAKG)] + (size_t)l * 64;
            f32x4 gn[2][2];
#pragma unroll
            for (int bj = 0; bj < 2; ++bj)
#pragma unroll
                for (int n = 0; n < 2; ++n) { gn[bj][n] = *(const f32x4*)(gsrc + 32 * bj + 16 * n + 4 * fq); if (is_q) gn[bj][n] *= 0.125f; }
            bf16* dst; int pitch, hcol;
            if (pn < PN_AK) { dst = (bf16*)(ws + WS_QA); pitch = GW; hcol = ((pn - PN_AQ) * 4 + wc) * 64; }
            else if (pn < PN_AV) { dst = (bf16*)(ws + WS_KA); pitch = GW; hcol = ((pn - PN_AK) * 4 + wc) * 64; }
            else if (pn < PN_CKV) { dst = (bf16*)(ws + WS_QC); pitch = GW; hcol = ((pn - PN_CQ) * 4 + wc) * 64; }
            else if (wc < 2) { dst = (bf16*)(ws + WS_KC); pitch = 128; hcol = wc * 64; }
            else { dst = (bf16*)(ws + WS_VC); pitch = 128; hcol = (wc - 2) * 64; }
            const f32x4* rope = (const f32x4*)(ws + WS_ROPE);
#pragma unroll
            for (int ai = 0; ai < 2; ++ai)
#pragma unroll
                for (int m = 0; m < 4; ++m) {
                    const int row = pn * 0 + u.pm * 256 + ai * 128 + wr * 64 + m * 16 + fr;
                    const float rstd = __builtin_amdgcn_rsqf(rowss[row] * (1.0f / D) + NORM_EPS);
                    f32x4 v[2][2]; float ss = 0.f;
#pragma unroll
                    for (int bj = 0; bj < 2; ++bj)
#pragma unroll
                        for (int n = 0; n < 2; ++n) { v[bj][n] = acc[ai][bj][m][n] * rstd + bv[bj][n]; ss += (v[bj][n][0] * v[bj][n][0] + v[bj][n][1] * v[bj][n][1]) + (v[bj][n][2] * v[bj][n][2] + v[bj][n][3] * v[bj][n][3]); }
                    ss += __shfl_xor(ss, 16); ss += __shfl_xor(ss, 32);
                    if (!plain_v) { const float rs = 1.0f / sqrtf(ss * (1.0f / 64.0f) + NORM_EPS);
#pragma unroll
                        for (int bj = 0; bj < 2; ++bj)
#pragma unroll
                            for (int n = 0; n < 2; ++n) v[bj][n] = v[bj][n] * rs * gn[bj][n];
                        if (is_c && row < M_LAT) {
                            const int t = row % T; const int pos[2] = {t / GRW, t % GRW};
#pragma unroll
                            for (int bj = 0; bj < 2; ++bj) { const f32x4 cs0 = rope[(pos[bj] * 16 + 4 * fq) / 2], cs1 = rope[(pos[bj] * 16 + 4 * fq) / 2 + 1];
                                const float cc[4] = {cs0[0], cs0[2], cs1[0], cs1[2]}, sn[4] = {cs0[1], cs0[3], cs1[1], cs1[3]};
#pragma unroll
                                for (int j = 0; j < 4; ++j) { const float x1 = v[bj][0][j], x2 = v[bj][1][j]; v[bj][0][j] = x1 * cc[j] - x2 * sn[j]; v[bj][1][j] = x2 * cc[j] + x1 * sn[j]; } }
                        }
                    }
                    bf16* op = dst + (size_t)row * pitch + hcol + 4 * fq;
#pragma unroll
                    for (int bj = 0; bj < 2; ++bj)
#pragma unroll
                        for (int n = 0; n < 2; ++n) { u32x2 w; w.x = pk2(v[bj][n][0], v[bj][n][1]); w.y = pk2(v[bj][n][2], v[bj][n][3]); *(u32x2*)(op + 32 * bj + 16 * n) = w; }
                }
        } else {
#pragma unroll
            for (int ai = 0; ai < 2; ++ai)
#pragma unroll
                for (int m = 0; m < 4; ++m) {
                    const int row = u.pm * 256 + ai * 128 + wr * 64 + m * 16 + fr;
                    const float rstd = __builtin_amdgcn_rsqf(rowss[row] * (1.0f / D) + NORM_EPS);
#pragma unroll
                    for (int bj = 0; bj < 2; ++bj)
#pragma unroll
                        for (int n = 0; n < 2; ++n) { const f32x4 v = acc[ai][bj][m][n] * rstd + bv[bj][n]; const int c = bj * 128 + wc * 32 + n * 16 + 4 * fq;
                            u32x2 w; w.x = pk2(v[0], v[1]); w.y = pk2(v[2], v[3]);
                            if (pn < PN_BR) *(u32x2*)((bf16*)(ws + WS_VA) + (size_t)row * GW + (pn - PN_AV) * 256 + c) = w;
                            else if (pn < PN_BS) *(u32x2*)((bf16*)(ws + WS_PB) + (size_t)row * 3 * GW + (pn - PN_BR) * 256 + c) = w;
                            else if (pn == PN_BS) { if (c < 160) *(f32x4*)((float*)(ws + WS_PS) + (size_t)row * 160 + c) = v; }
                            else { const int cu = (pn - PN_DU) * 256 + c, gq = cu >> 4, p0 = cu & 15;
                                *(u32x2*)((bf16*)(ws + WS_UG) + ((size_t)gq * NCHP + row / S5L) * S5K + (row % S5L) * 16 + p0) = w; } }
                }
        }
    }
};
struct EpiS5A {
    float* XE;
    DI void operator()(const f32x4 (&acc)[2][2][4][2], const Unit& u, int wr, int wc, int fr_, int fq_) const {
        int tz_ = threadIdx.x; OPAQUE(tz_); const int fr = tz_ & 15, fq = (tz_ & 63) >> 4; (void)fr_; (void)fq_;
#pragma unroll
        for (int ai = 0; ai < 2; ++ai)
#pragma unroll
            for (int m = 0; m < 4; ++m) { const int ch = u.pm * 256 + ai * 128 + wr * 64 + m * 16 + fr; if (ch < NCH) { float* p = XE + ((size_t)u.z * NCHP + ch) * 256 + wc * 32 + 4 * fq;
#pragma unroll
                for (int bj = 0; bj < 2; ++bj)
#pragma unroll
                    for (int n = 0; n < 2; ++n) *(f32x4*)(p + bj * 128 + n * 16) = acc[ai][bj][m][n]; } }
    }
};
struct EpiS5C {
    const bf16* UG; const float* dsk  ; bf16* YG;
    DI void operator()(const f32x4 (&acc)[2][2][4][2], const Unit& u, int wr, int wc, int fr_, int fq_) const {
        int tz_ = threadIdx.x; OPAQUE(tz_); const int fr = tz_ & 15, fq = (tz_ & 63) >> 4; (void)fr_; (void)fq_;
        const int g = u.z;
#pragma unroll
        for (int ai = 0; ai < 2; ++ai)
#pragma unroll
            for (int m = 0; m < 4; ++m) { const int ch = u.pm * 256 + ai * 128 + wr * 64 + m * 16 + fr; if (ch < NCH) {
#pragma unroll
                for (int bj = 0; bj < 2; ++bj)
#pragma unroll
                    for (int n = 0; n < 2; ++n) { const int col = u.pn * 256 + bj * 128 + wc * 32 + n * 16 + 4 * fq, i = col >> 4, p0 = col & 15;
                        const u32x2 uw = *(const u32x2*)(UG + ((size_t)g * NCHP + ch) * S5K + col); const f32x4 dv = *(const f32x4*)(dsk + 16 * g + p0);
                        const f32x4 a = acc[ai][bj][m][n]; const float y0 = a[0] + dv[0] * bflo(uw.x), y1 = a[1] + dv[1] * bfhi(uw.x), y2 = a[2] + dv[2] * bflo(uw.y), y3 = a[3] + dv[3] * bfhi(uw.y);
                        u32x2 w; w.x = pk2(geluf(y0), geluf(y1)); w.y = pk2(geluf(y2), geluf(y3));
                        *(u32x2*)(YG + (size_t)(ch * S5L + i) * GW + 16 * g + p0) = w; } } }
    }
};
struct EpiGLU {
    const bf16* YG; const float* gb; bf16* OB;
    DI void operator()(const f32x4 (&acc)[2][2][4][2], const Unit& u, int wr, int wc, int fr_, int fq_) const {
        int tz_ = threadIdx.x; OPAQUE(tz_); const int fr = tz_ & 15, fq = (tz_ & 63) >> 4; (void)fr_; (void)fq_;
#pragma unroll
        for (int ai = 0; ai < 2; ++ai)
#pragma unroll
            for (int m = 0; m < 4; ++m) { const int row = u.pm * 256 + ai * 128 + wr * 64 + m * 16 + fr;
#pragma unroll
                for (int bj = 0; bj < 2; ++bj)
#pragma unroll
                    for (int n = 0; n < 2; ++n) { const int col = u.pn * 256 + bj * 128 + wc * 32 + n * 16 + 4 * fq; const f32x4 b = *(const f32x4*)(gb + col); const f32x4 a = acc[ai][bj][m][n] + b;
                        const u32x2 yw = *(const u32x2*)(YG + (size_t)row * GW + col);
                        u32x2 w; w.x = pk2(bflo(yw.x) * sigmf(a[0]), bfhi(yw.x) * sigmf(a[1])); w.y = pk2(bflo(yw.y) * sigmf(a[2]), bfhi(yw.y) * sigmf(a[3]));
                        *(u32x2*)(OB + (size_t)row * D + 3 * GW + col) = w; } }
    }
};

DI void ph_ada(const Ctx& C) {
    LAS float* sc = (LAS float*)C.lds;
    LAS float* red = sc + 3 * D;
    for (int i = C.tid; i < 3 * D; i += NTHR) { const int s = i / D, k = i % D; const float c = s < NB ? C.in[I_C][s * D + k] : C.in[I_CCTX][k]; sc[i] = siluf(c); }
    __syncthreads();
    const int nun = NL * (9 * D / 256);
    for (int un = C.bid; un < nun; un += C.G) {
        const int l = un / (9 * D / 256), col0 = (un % (9 * D / 256)) * 256;
        const float* W = C.in[I_WADA] + (size_t)l * D * 9 * D + col0 + 4 * C.lane;
        f32x4 a0 = {0.f, 0.f, 0.f, 0.f}, a1 = a0, a2 = a0;
        const int k0 = C.wave * (D / 8);
#pragma unroll 1
        for (int kb = k0; kb < k0 + D / 8; kb += 16) {
            f32x4 wv[16];
#pragma unroll
            for (int u = 0; u < 16; ++u) wv[u] = *(const f32x4*)(W + (size_t)(kb + u) * 9 * D);
#pragma unroll
            for (int u = 0; u < 16; ++u) { a0 += wv[u] * sc[kb + u]; a1 += wv[u] * sc[D + kb + u]; a2 += wv[u] * sc[2 * D + kb + u]; } }
        LAS float* r = red + C.wave * 768 + 4 * C.lane;
        *(LAS f32x4*)(r) = a0; *(LAS f32x4*)(r + 256) = a1; *(LAS f32x4*)(r + 512) = a2;
        __syncthreads();
        for (int i = C.tid; i < 768; i += NTHR) { float s = 0.f;
#pragma unroll
            for (int w = 0; w < 8; ++w) s += red[w * 768 + i];
            const int st = i / 256, c = col0 + (i % 256);
            ((float*)(C.ws + WS_MODV))[((size_t)l * 3 + st) * 9 * D + c] = s + C.in[I_BADA][(size_t)l * 9 * D + c]; }
        __syncthreads();
    }
}
DI const float* modv_ptr(const Ctx& C, int l, int s, int chunk) { return (const float*)(C.ws + WS_MODV) + ((size_t)l * 3 + s) * 9 * D + (size_t)chunk * D; }

DI int win_dest(int n) {
    if (n >= D_IN) return -1;
    if (n < SRC_AV) { const int piece = n / GW, loc = n % GW, head = loc / 64, d = loc % 64; return ((piece == 0 ? PN_AQ : PN_AK) + head / 4) * 256 + 128 * (d / 32) + 32 * (head % 4) + (d % 32); }
    if (n < SRC_BS) return PN_AV * 256 + (n - SRC_AV);
    if (n < SRC_CQ) return PN_BS * 256 + (n - SRC_BS);
    if (n < SRC_CK) { const int loc = n - SRC_CQ, head = loc / 64, d = loc % 64; return (PN_CQ + head / 4) * 256 + 128 * (d / 32) + 32 * (head % 4) + (d % 32); }
    if (n < SRC_DU) { const int loc = n - SRC_CK, hh = loc / 64, d = loc % 64; return PN_CKV * 256 + 128 * (d / 32) + 32 * hh + (d % 32); }
    return PN_DU * 256 + (n - SRC_DU);
}
DI void conv_item(const Ctx& C, const float* W, int K, int N, bf16* Wt, int mode, int k0, int n0, float* bias, int bias_pitch, const float* shift  ) {
    LAS float* scr = (LAS float*)(C.lds + C.wave * 16640);
    const int n = n0 + C.lane; const bool ok = n < N; float b0 = 0.f, b1 = 0.f, b2 = 0.f;
#pragma unroll 1
    for (int kh = 0; kh < 4; ++kh) {
        float wv[16];
#pragma unroll
        for (int kk = 0; kk < 16; ++kk) wv[kk] = ok ? W[(size_t)(k0 + 16 * kh + kk) * N + n] : 0.f;
#pragma unroll
        for (int kk = 0; kk < 16; ++kk) { const float v = wv[kk]; scr[(16 * kh + kk) * 65 + C.lane] = v;
            if (bias) { b0 += shift[k0 + 16 * kh + kk] * v; b1 += shift[9 * D + k0 + 16 * kh + kk] * v; b2 += shift[18 * D + k0 + 16 * kh + kk] * v; } } }
    WSYNC();
    const int dme = !ok ? -1 : mode == 0 ? n : mode == 1 ? (n / 128) * 256 + n % 128 : mode == 2 ? (n / 128) * 256 + 128 + n % 128 : win_dest(n);
    if (bias && dme >= 0) { atomicAdd(bias + dme, b0); atomicAdd(bias + bias_pitch + dme, b1); atomicAdd(bias + 2 * bias_pitch + dme, b2); }
    const int c = C.lane & 7;
#pragma unroll
    for (int i = 0; i < 8; ++i) { const int nl = (C.lane >> 3) + 8 * i, nn = n0 + nl;
        const int dr = nn >= N ? -1 : mode == 0 ? nn : mode == 1 ? (nn / 128) * 256 + nn % 128 : mode == 2 ? (nn / 128) * 256 + 128 + nn % 128 : win_dest(nn);
        const LAS float* s = scr + (8 * c) * 65 + nl;
        u32x4 o; o.x = pk2(s[0], s[65]); o.y = pk2(s[2 * 65], s[3 * 65]); o.z = pk2(s[4 * 65], s[5 * 65]); o.w = pk2(s[6 * 65], s[7 * 65]);
        if (dr >= 0) *(u32x4*)(Wt + (size_t)dr * K + k0 + 8 * c) = o; }
    WSYNC();
}
struct Cplx { float re, im; };
DI Cplx cmul(Cplx a, Cplx b) { return Cplx{a.re * b.re - a.im * b.im, a.re * b.im + a.im * b.re}; }
DI Cplx s5_lam_pow(const Ctx& C, int l, int dir, int g, int n, float tau) {
    const size_t i = (((size_t)l * 2 + dir) * S5G + g) * 64 + n; const float dt = __expf(C.in[I_S5LDT][((size_t)l * 2 + dir) * S5G + g]);
    const float mag = __expf(tau * dt * C.in[I_S5ARE][i]), ang = tau * dt * C.in[I_S5AIM][i]; float sn, cs; sincosf(ang, &sn, &cs); return Cplx{mag * cs, mag * sn};
}
DI Cplx s5_coef(const Ctx& C, int l, int dir, int g, int n) {
    const size_t i = (((size_t)l * 2 + dir) * S5G + g) * 64 + n; const float are = C.in[I_S5ARE][i], aim = C.in[I_S5AIM][i];
    const Cplx ab = s5_lam_pow(C, l, dir, g, n, 1.0f); const float den = are * are + aim * aim, nr = ab.re - 1.0f;
    return Cplx{(nr * are + ab.im * aim) / den, (ab.im * are - nr * aim) / den};
}
DI Cplx s5_beta(const Ctx& C, int l, int dir, int g, int n, int q) {
    const size_t i = (((size_t)l * S5G + g) * 64 + n) * 16 + q; return cmul(s5_coef(C, l, dir, g, n), Cplx{C.in[I_S5BRE][i], C.in[I_S5BIM][i]});
}
DI Cplx s5_gamma(const Ctx& C, int l, int g, int p, int n) { const size_t i = (((size_t)l * S5G + g) * 16 + p) * 64 + n; return Cplx{C.in[I_S5CRE][i], C.in[I_S5CIM][i]}; }

constexpr int CI_GU = (D / 64) * (FF / 64), CI_DN = (FF / 64) * (D / 64), CI_IN = (D / 64) * ((D_IN + 63) / 64), CI_OUT = (D / 64) * (D / 64), CI_GLU = (GW / 64) * (GW / 64);
constexpr int CI_LAYER = 4 * CI_GU + 2 * CI_DN + CI_IN + CI_OUT + CI_GLU;
DI void ph_conv(const Ctx& C) {
    const int gt = C.bid * NTHR + C.tid, GT = C.G * NTHR;
    for (int i = gt; i < NL * 9 * D; i += GT) { const int k = i % D, s = (i / D) % 3, sub = (i / (3 * D)) % 3, l = i / (9 * D);
        const float* mv = (const float*)(C.ws + WS_MODV) + ((size_t)l * 3 + s) * 9 * D;
        ((float*)(C.ws + WS_GS))[i] = C.in[I_NORMG][((size_t)l * 3 + sub) * D + k] * (1.0f + mv[(3 * sub + 1) * D + k]);
        ((float*)(C.ws + WS_GATE))[i] = mv[(3 * sub + 2) * D + k] * (sub == 1 ? 1.0f : 0.5f); }
    for (int i = gt; i < 128 * 16; i += GT) { const int pos = i / 16, f = i % 16; const float inv = __expf(-(float)f * (9.210340371976184f / 16.0f)); float sn, cs; sincosf((float)pos * inv, &sn, &cs);
        ((f32x2*)(C.ws + WS_ROPE))[i] = (f32x2){cs, sn}; }
    const int gw = C.bid * NW + C.wave, GWV = C.G * NW;
    for (int it = gw; it < NL * CI_LAYER; it += GWV) {
        const int l = it / CI_LAYER; int r = it % CI_LAYER;
        unsigned char* wbase = C.ws + WS_W + (size_t)l * SZ_WL;
        if (r < 2 * CI_GU) { const int up = r >= CI_GU; r -= up * CI_GU; const int kb = r / (FF / 64), nb = r % (FF / 64);
            conv_item(C, C.in[up ? I_F1WU : I_F1WG] + (size_t)l * D * FF, D, FF, (bf16*)(wbase + OFF_W1GU), 1 + up, kb * 64, nb * 64, bias_ptr(C, l, 0), 2 * FF, modv_ptr(C, l, 0, 0)); continue; } r -= 2 * CI_GU;
        if (r < CI_DN) { const int kb = r / (D / 64), nb = r % (D / 64); conv_item(C, C.in[I_F1WD] + (size_t)l * FF * D, FF, D, (bf16*)(wbase + OFF_W1D), 0, kb * 64, nb * 64, nullptr, 0, nullptr); continue; } r -= CI_DN;
        if (r < CI_IN) { const int nbn = (D_IN + 63) / 64, kb = r / nbn, nb = r % nbn; conv_item(C, C.in[I_WIN] + (size_t)l * D * D_IN, D, D_IN, (bf16*)(wbase + OFF_WIN), 3, kb * 64, nb * 64, bias_ptr(C, l, 1), NINP, modv_ptr(C, l, 0, 3)); continue; } r -= CI_IN;
        if (r < CI_OUT) { const int kb = r / (D / 64), nb = r % (D / 64); conv_item(C, C.in[I_WOUT] + (size_t)l * D * D, D, D, (bf16*)(wbase + OFF_WOUT), 0, kb * 64, nb * 64, nullptr, 0, nullptr); continue; } r -= CI_OUT;
        if (r < 2 * CI_GU) { const int up = r >= CI_GU; r -= up * CI_GU; const int kb = r / (FF / 64), nb = r % (FF / 64);
            conv_item(C, C.in[up ? I_F2WU : I_F2WG] + (size_t)l * D * FF, D, FF, (bf16*)(wbase + OFF_W2GU), 1 + up, kb * 64, nb * 64, bias_ptr(C, l, 2), 2 * FF, modv_ptr(C, l, 0, 6)); continue; } r -= 2 * CI_GU;
        if (r < CI_DN) { const int kb = r / (D / 64), nb = r % (D / 64); conv_item(C, C.in[I_F2WD] + (size_t)l * FF * D, FF, D, (bf16*)(wbase + OFF_W2D), 0, kb * 64, nb * 64, nullptr, 0, nullptr); continue; } r -= CI_DN;
        { const int kb = r / (GW / 64), nb = r % (GW / 64); conv_item(C, C.in[I_S5GLUW] + (size_t)l * GW * GW, GW, GW, (bf16*)(wbase + OFF_WGLU), 0, kb * 64, nb * 64, nullptr, 0, nullptr); }
    }
    for (int i = gt; i < NL * 14 * NH * 2 * 64 * 8; i += GT) {
        const int j = i & 7, ln = (i >> 3) & 63, tj = (i >> 9) & 1, hd = (i >> 10) % NH, f = (i / (1024 * NH)) % 14, l = i / (1024 * NH * 14);
        const int col = hd * 64 + 32 * tj + (ln & 31); float v;
        if (f < 8) { const int d = (f >> 1) & 1, sx = f & 1, k = 16 * sx + 8 * (ln >> 5) + j; v = C.in[f < 4 ? I_RWWUP : I_RWAUP][(((size_t)l * 2 + d) * 32 + k) * GW + col]; }
        else { const int k = 16 * (f - 8) + 8 * (ln >> 5) + j; v = C.in[I_RWGUP][((size_t)l * 96 + k) * GW + col]; }
        ((bf16*)(C.ws + WS_RWF))[i] = (bf16)f2bf(v); }
    LAS float* wsc = (LAS float*)(C.lds + C.wave * 16640);
    for (int it = gw; it < NL * S5G * 2 * S5L; it += GWV) {
        const int tau = it % S5L, dir = (it / S5L) % 2, g = (it / (2 * S5L)) % S5G, l = it / (2 * S5L * S5G);
        const Cplx z = cmul(s5_lam_pow(C, l, dir, g, C.lane, (float)tau), s5_coef(C, l, dir, g, C.lane));
#pragma unroll 4
        for (int q = 0; q < 16; ++q) { const size_t i = (((size_t)l * S5G + g) * 64 + C.lane) * 16 + q; const Cplx w = cmul(z, Cplx{C.in[I_S5BRE][i], C.in[I_S5BIM][i]}); wsc[(C.lane * 16 + q) * 2] = w.re; wsc[(C.lane * 16 + q) * 2 + 1] = w.im; }
        WSYNC();
        float* kc = (float*)(C.ws + WS_S5T + (size_t)l * SZ_S5L + OFF_S5KC) + (((size_t)g * 2 + dir) * S5L + tau) * 256;
#pragma unroll 1
        for (int e = 0; e < 4; ++e) { const int pq = C.lane + 64 * e, p = pq >> 4, q = pq & 15; float s = 0.f;
#pragma unroll 4
            for (int n = 0; n < 64; ++n) { const Cplx gm = s5_gamma(C, l, g, p, n); s += gm.re * wsc[(n * 16 + q) * 2] - gm.im * wsc[(n * 16 + q) * 2 + 1]; }
            kc[pq] = s; }
        WSYNC();
    }
    for (int i = gt; i < NL * 2 * GW * 4 * (S5L + 1); i += GT) { const int tau = i % (S5L + 1), r = i / (S5L + 1), n = r % 64, g = (r / 64) % S5G, dir = (r / (64 * S5G)) % 2, l = r / (2 * 64 * S5G);
        const Cplx z = s5_lam_pow(C, l, dir, g, n, (float)tau); ((f32x2*)(C.ws + WS_S5T + (size_t)l * SZ_S5L + OFF_S5LP))[((size_t)(dir * S5G + g) * 64 + n) * (S5L + 1) + tau] = (f32x2){z.re, z.im}; }
    for (int i = gt; i < NL * 2 * GW * 4 * 16; i += GT) { const int q = i % 16, r = i / 16, n = r % 64, g = (r / 64) % S5G, dir = (r / (64 * S5G)) % 2, l = r / (2 * 64 * S5G);
        const Cplx z = s5_beta(C, l, dir, g, n, q); ((f32x2*)(C.ws + WS_S5T + (size_t)l * SZ_S5L + OFF_S5BETA))[((size_t)(dir * S5G + g) * 64 + n) * 16 + q] = (f32x2){z.re, z.im}; }
    for (int i = gt; i < NL * 2 * GW * 4; i += GT) { const int n = i % 64, g = (i / 64) % S5G, dir = (i / (64 * S5G)) % 2, l = i / (2 * 64 * S5G); const Cplx z = s5_lam_pow(C, l, dir, g, n, (float)S5L);
        ((f32x2*)(C.ws + WS_S5T + (size_t)l * SZ_S5L + OFF_S5LAM))[(dir * S5G + g) * 64 + n] = (f32x2){z.re, z.im}; }
}
DI void ph_tab(const Ctx& C) {
    const long gt = (long)C.bid * NTHR + C.tid, GT = (long)C.G * NTHR;
    for (long i = gt; i < (long)NL * S5G * 256 * 512; i += GT) {
        const int k = (int)(i % 512), np = (int)((i / 512) % 256), g = (int)((i / (512 * 256)) % S5G), l = (int)(i / ((long)512 * 256 * S5G));
        const int j = k >> 4, q = k & 15, dir = np >> 7, n = np & 63, im = (np >> 6) & 1;
        const f32x2 lp = ((const f32x2*)(C.ws + WS_S5T + (size_t)l * SZ_S5L + OFF_S5LP))[((size_t)(dir * S5G + g) * 64 + n) * (S5L + 1) + (dir == 0 ? S5L - 1 - j : j)];
        const f32x2 be = ((const f32x2*)(C.ws + WS_S5T + (size_t)l * SZ_S5L + OFF_S5BETA))[((size_t)(dir * S5G + g) * 64 + n) * 16 + q];
        const Cplx w = cmul(Cplx{lp[0], lp[1]}, Cplx{be[0], be[1]});
        ((bf16*)(C.ws + WS_S5T + (size_t)l * SZ_S5L + OFF_S5ET))[((size_t)g * 256 + np) * 512 + k] = (bf16)f2bf(im ? w.im : w.re); }
    for (long i = gt; i < (long)NL * S5G * 512 * S5K; i += GT) {
        const int k = (int)(i % S5K), nn = (int)((i / S5K) % 512), g = (int)((i / ((long)S5K * 512)) % S5G), l = (int)(i / ((long)S5K * 512 * S5G));
        const int ti = nn >> 4, p = nn & 15; float v;
        if (k < 512) { const int j = k >> 4, q = k & 15; const float* kc = (const float*)(C.ws + WS_S5T + (size_t)l * SZ_S5L + OFF_S5KC) + (size_t)g * 2 * S5L * 256;
            v = 0.f; if (j <= ti) v += kc[((ti - j)) * 256 + p * 16 + q]; if (j >= ti) v += kc[(S5L + (j - ti)) * 256 + p * 16 + q]; }
        else { const int kk = k - 512, dir = kk >> 7, im = (kk >> 6) & 1, n = kk & 63;
            const f32x2 lp = ((const f32x2*)(C.ws + WS_S5T + (size_t)l * SZ_S5L + OFF_S5LP))[((size_t)(dir * S5G + g) * 64 + n) * (S5L + 1) + (dir == 0 ? ti + 1 : S5L - ti)];
            const Cplx w = cmul(s5_gamma(C, l, g, p, n), Cplx{lp[0], lp[1]}); v = im ? -w.im : w.re; }
        ((bf16*)(C.ws + WS_S5T + (size_t)l * SZ_S5L + OFF_S5BT))[((size_t)g * 512 + nn) * S5K + k] = (bf16)f2bf(v); }
    const int gw = C.bid * NW + C.wave, GWV = C.G * NW;
    for (int row = gw; row < M; row += GWV) {
        const float* src = row < M_LAT ? C.in[I_X] + (size_t)row * D : C.in[I_CTX] + (size_t)(row - M_LAT) * D;
        float* dst = xrow_ptr(C, row); const float* gs = gs_ptr(C, 0, 0, stream_of_row(row)); bf16* ap = (bf16*)(C.ws + WS_AP) + (size_t)row * D; float ss = 0.f;
        for (int c = 4 * C.lane; c < D; c += 256) { const f32x4 x = *(const f32x4*)(src + c); *(f32x4*)(dst + c) = x; ss += (x[0] * x[0] + x[1] * x[1]) + (x[2] * x[2] + x[3] * x[3]);
            const f32x4 a = x * *(const f32x4*)(gs + c); u32x2 w; w.x = pk2(a[0], a[1]); w.y = pk2(a[2], a[3]); *(u32x2*)(ap + c) = w; }
        ss = wave_sum(ss); if (C.lane == 0) rowss_ptr(C, 0, 0)[row] = ss;
    }
}

#ifdef EMU
DI s16x4 tr_read1(const LAS unsigned char* a) { return emu_tr_read(a); }
#else
DI s16x4 tr_read1(const LAS unsigned char* a) { s16x4 r; asm volatile("ds_read_b64_tr_b16 %0, %1\n\ts_waitcnt lgkmcnt(0)" : "=&v"(r) : "v"((unsigned)(size_t)a) : "memory"); return r; }
#endif
DI bf16x8 pack8(const f32x16& x, int s) {
    u32x4 p; p.x = pk2(x[8 * s], x[8 * s + 1]); p.y = pk2(x[8 * s + 2], x[8 * s + 3]); p.z = pk2(x[8 * s + 4], x[8 * s + 5]); p.w = pk2(x[8 * s + 6], x[8 * s + 7]);
    return __builtin_bit_cast(bf16x8, p);
}
struct AttnSt { f32x16 o0, o1; float m, l; };
template <bool MASKED>
DI void attn_block(AttnSt& st, const bf16x8 (&qf)[4], const bf16* Kb, int kp, const bf16* Vb, int vp, LAS unsigned char* vl, int lane, const float (&addv)[16], unsigned vmask) {
    const int r32 = lane & 31, h = lane >> 5;
#pragma unroll
    for (int i = 0; i < 4; ++i) { const int idx = lane + 64 * i, key = idx >> 3, ch = idx & 7; *(LAS u32x4*)(vl + key * 128 + ch * 16) = *(const u32x4*)(Vb + (size_t)key * vp + ch * 8); }
    f32x16 s;
#pragma unroll
    for (int i = 0; i < 16; ++i) s[i] = 0.f;
#pragma unroll
    for (int kk = 0; kk < 4; ++kk) { const bf16x8 kf = *(const bf16x8*)(Kb + (size_t)r32 * kp + 16 * kk + 8 * h); s = __builtin_amdgcn_mfma_f32_32x32x16_bf16(kf, qf[kk], s, 0, 0, 0); }
    float bm = -1e30f;
#pragma unroll
    for (int i = 0; i < 16; ++i) { if (MASKED) { s[i] += addv[i]; if ((vmask >> i) & 1u) bm = fmaxf(bm, s[i]); } else bm = fmaxf(bm, s[i]); }
    bm = fmaxf(bm, __shfl_xor(bm, 32));
    const float mn = fmaxf(st.m, bm), alpha = __expf(st.m - mn); st.m = mn;
    float ls = 0.f;
#pragma unroll
    for (int i = 0; i < 16; ++i) { float p = __expf(s[i] - mn); if (MASKED) p = ((vmask >> i) & 1u) ? p : 0.f; s[i] = p; ls += p; }
    st.l = st.l * alpha + ls;
#pragma unroll
    for (int i = 0; i < 16; ++i) { st.o0[i] *= alpha; st.o1[i] *= alpha; }
    WSYNC();
    const int q = (lane & 15) >> 2, p4 = lane & 3, blk = (lane >> 4) & 1;
#pragma unroll
    for (int sx = 0; sx < 2; ++sx) {
        const bf16x8 pf = pack8(s, sx);
#pragma unroll
        for (int dt = 0; dt < 2; ++dt) {
            const LAS unsigned char* a0 = vl + (16 * sx + 4 * h + q) * 128 + (32 * dt + 16 * blk) * 2 + 8 * p4;
            const s16x4 lo = tr_read1(a0), hi = tr_read1(a0 + 8 * 128);
            const bf16x8 vf = __builtin_shufflevector(lo, hi, 0, 1, 2, 3, 4, 5, 6, 7);
            if (dt == 0) st.o0 = __builtin_amdgcn_mfma_f32_32x32x16_bf16(vf, pf, st.o0, 0, 0, 0); else st.o1 = __builtin_amdgcn_mfma_f32_32x32x16_bf16(vf, pf, st.o1, 0, 0, 0);
        }
    }
}
DI void attn_finish(AttnSt& st, bf16* orow  , int lane, float extra_l) {
    const int h = lane >> 5; float l = st.l + __shfl_xor(st.l, 32) + extra_l; const float inv = 1.0f / l;
#pragma unroll
    for (int g = 0; g < 4; ++g) {
        u32x2 w0, w1; w0.x = pk2(st.o0[4 * g] * inv, st.o0[4 * g + 1] * inv); w0.y = pk2(st.o0[4 * g + 2] * inv, st.o0[4 * g + 3] * inv);
        w1.x = pk2(st.o1[4 * g] * inv, st.o1[4 * g + 1] * inv); w1.y = pk2(st.o1[4 * g + 2] * inv, st.o1[4 * g + 3] * inv);
        *(u32x2*)(orow + 8 * g + 4 * h) = w0; *(u32x2*)(orow + 32 + 8 * g + 4 * h) = w1; }
}
DI int clampi(int v, int lo, int hi) { return v < lo ? lo : (v > hi ? hi : v); }
constexpr int AT_NA = NB * NH * (GRH / 2) * 4, AT_WA = NB * NH * (T / 32), AT_CX = NB * NH * (TC / 32);
DI void ph_attn(const Ctx& C, int l, bool want_ctx) {
    const int gw = C.bid * NW + C.wave, GWV = C.G * NW, lane = C.lane, r32 = lane & 31, h = lane >> 5;
    LAS unsigned char* vl = C.lds + C.wave * 4096;
    const bf16* QA = (const bf16*)(C.ws + WS_QA); const bf16* KA = (const bf16*)(C.ws + WS_KA); const bf16* VA = (const bf16*)(C.ws + WS_VA);
    const bf16* QC = (const bf16*)(C.ws + WS_QC); const bf16* KC = (const bf16*)(C.ws + WS_KC); const bf16* VC = (const bf16*)(C.ws + WS_VC);
    bf16* OB = (bf16*)(C.ws + WS_OB);
    const int ntiles = AT_NA + AT_WA + (want_ctx ? 2 * AT_CX : 0);
    const float zero16[16] = {0.f, 0.f, 0.f, 0.f, 0.f, 0.f, 0.f, 0.f, 0.f, 0.f, 0.f, 0.f, 0.f, 0.f, 0.f, 0.f};
    for (int tile = gw; tile < ntiles; tile += GWV) {
        AttnSt st; st.m = -1e30f; st.l = 0.f;
#pragma unroll
        for (int i = 0; i < 16; ++i) { st.o0[i] = 0.f; st.o1[i] = 0.f; }
        bf16x8 qf[4];
        if (tile < AT_NA) {
            const int cb = tile & 3, rp = (tile >> 2) % (GRH / 2), hd = (tile / (4 * (GRH / 2))) % NH, b = tile / (4 * (GRH / 2) * NH);
            const int r0 = 2 * rp, c0 = 16 * cb, qr = r0 + (r32 >> 4), qc = c0 + (r32 & 15), qrow = b * T + qr * GRW + qc;
#pragma unroll
            for (int kk = 0; kk < 4; ++kk) qf[kk] = *(const bf16x8*)(QA + (size_t)qrow * GW + hd * 64 + 16 * kk + 8 * h);
            const int rsq = clampi(qr - 4, 0, GRH - 8), csq = clampi(qc - 8, 0, GRW - 16);
            const int rsA = clampi(r0 - 4, 0, GRH - 8), rsB = clampi(r0 + 1 - 4, 0, GRH - 8), kc0 = clampi(c0 - 8, 0, GRW - 32);
            const float* rpb = C.in[I_NARPB] + ((size_t)l * NH + hd) * 465;
            for (int kr = rsA; kr <= rsB + 7; ++kr) {
                float addv[16]; unsigned vm = 0u; const bool rok = kr >= rsq && kr <= rsq + 7;
#pragma unroll
                for (int i = 0; i < 16; ++i) { const int kb = (i & 3) + 8 * (i >> 2) + 4 * h, kc = kc0 + kb; const bool ok = rok && kc >= csq && kc <= csq + 15;
                    const int bi = ok ? (kr - qr + 7) * 31 + (kc - qc + 15) : 0; addv[i] = rpb[bi]; vm |= ok ? (1u << i) : 0u; }
                const size_t krow = (size_t)b * T + kr * GRW + kc0;
                attn_block<true>(st, qf, KA + krow * GW + hd * 64, GW, VA + krow * GW + hd * 64, GW, vl, lane, addv, vm);
            }
            for (int cbk = 0; cbk < TC / 32; ++cbk) { const size_t krow = (size_t)M_LAT + b * TC + 32 * cbk;
                attn_block<false>(st, qf, KA + krow * GW + hd * 64, GW, VA + krow * GW + hd * 64, GW, vl, lane, zero16, 0xffffu); }
            attn_finish(st, OB + (size_t)qrow * D + hd * 64, lane, 0.f);
        } else if (tile < AT_NA + AT_WA) {
            const int t2 = tile - AT_NA, qb = t2 % (T / 32), hd = (t2 / (T / 32)) % NH, b = t2 / ((T / 32) * NH), kvh = hd / WAG;
            const int qt = 32 * qb + r32, qrow = b * T + qt;
#pragma unroll
            for (int kk = 0; kk < 4; ++kk) qf[kk] = *(const bf16x8*)(QC + (size_t)qrow * GW + hd * 64 + 16 * kk + 8 * h);
            for (int i9 = 0; i9 < 9; ++i9) { const int t0 = 32 * qb - 128 + 32 * i9; if (t0 < 0 || t0 >= T) continue;
                float addv[16]; unsigned vm = 0u;
#pragma unroll
                for (int i = 0; i < 16; ++i) { const int kt = t0 + (i & 3) + 8 * (i >> 2) + 4 * h, rel = kt - qt; addv[i] = 0.f; vm |= (rel >= -128 && rel <= 128) ? (1u << i) : 0u; }
                const size_t krow = (size_t)b * T + t0;
                attn_block<true>(st, qf, KC + krow * 128 + kvh * 64, 128, VC + krow * 128 + kvh * 64, 128, vl, lane, addv, vm); }
            for (int cbk = 0; cbk < TC / 32; ++cbk) { const size_t krow = (size_t)M_LAT + b * TC + 32 * cbk;
                attn_block<false>(st, qf, KC + krow * 128 + kvh * 64, 128, VC + krow * 128 + kvh * 64, 128, vl, lane, zero16, 0xffffu); }
            const float sk = C.in[I_WASINK][(size_t)l * NH + hd];
            const float mfin = fmaxf(st.m, sk), a2 = __expf(st.m - mfin);
#pragma unroll
            for (int i = 0; i < 16; ++i) { st.o0[i] *= a2; st.o1[i] *= a2; }
            st.l *= a2; st.m = mfin;
            attn_finish(st, OB + (size_t)qrow * D + 2 * GW + hd * 64, lane, __expf(sk - mfin));
        } else {
            const int t2 = tile - AT_NA - AT_WA, isc = t2 >= AT_CX, t3 = t2 - isc * AT_CX, qb = t3 % (TC / 32), hd = (t3 / (TC / 32)) % NH, b = t3 / ((TC / 32) * NH), kvh = hd / WAG;
            const int qrow = M_LAT + b * TC + 32 * qb + r32;
            const bf16* Qs = isc ? QC : QA; const bf16* Ks = isc ? KC + kvh * 64 : KA + hd * 64; const bf16* Vs = isc ? VC + kvh * 64 : VA + hd * 64; const int kp = isc ? 128 : GW;
#pragma unroll
            for (int kk = 0; kk < 4; ++kk) qf[kk] = *(const bf16x8*)(Qs + (size_t)qrow * GW + hd * 64 + 16 * kk + 8 * h);
            for (int cbk = 0; cbk < TC / 32; ++cbk) { const size_t krow = (size_t)M_LAT + b * TC + 32 * cbk;
                attn_block<false>(st, qf, Ks + krow * kp, kp, Vs + krow * kp, kp, vl, lane, zero16, 0xffffu); }
            float extra = 0.f;
            if (isc) { const float sk = C.in[I_WASINK][(size_t)l * NH + hd]; const float mfin = fmaxf(st.m, sk), a2 = __expf(st.m - mfin);
#pragma unroll
                for (int i = 0; i < 16; ++i) { st.o0[i] *= a2; st.o1[i] *= a2; }
                st.l *= a2; st.m = mfin; extra = __expf(sk - mfin); }
            attn_finish(st, OB + (size_t)qrow * D + (isc ? 2 * GW : 0) + hd * 64, lane, extra);
        }
    }
}

DI void ph_rwprep(const Ctx& C, int l) {
    LAS float* sm = (LAS float*)C.lds;
    const int c = C.tid; const bool act = c < GW;
    const bf16* PB = (const bf16*)(C.ws + WS_PB); const float* PS = (const float*)(C.ws + WS_PS);
    const float* cw = C.in[I_RWCONV] + (size_t)l * 9 * GW;
    float cwv[3][3];
    if (act) {
#pragma unroll
        for (int j = 0; j < 3; ++j)
#pragma unroll
            for (int x = 0; x < 3; ++x) cwv[j][x] = cw[(size_t)j * 3 * GW + x * GW + c]; }
    const float w00 = act ? C.in[I_RWW0][((size_t)l * 2 + 0) * GW + c] : 0.f, w01 = act ? C.in[I_RWW0][((size_t)l * 2 + 1) * GW + c] : 0.f;
    const float a00 = act ? C.in[I_RWA0][((size_t)l * 2 + 0) * GW + c] : 0.f, a01 = act ? C.in[I_RWA0][((size_t)l * 2 + 1) * GW + c] : 0.f;
    const float kkw = act ? C.in[I_RWKK][(size_t)l * GW + c] : 0.f, kaw = act ? C.in[I_RWKA][(size_t)l * GW + c] : 0.f;
    const float* wup = C.in[I_RWWUP] + (size_t)l * 2 * 32 * GW; const float* aup = C.in[I_RWAUP] + (size_t)l * 2 * 32 * GW; const float* gup = C.in[I_RWGUP] + (size_t)l * 96 * GW;
    for (int it = C.bid; it < M / 16; it += C.G) {
        const int row0 = it * 16;
        const int seq_lo = row0 < M_LAT ? (row0 / T) * T : M_LAT + ((row0 - M_LAT) / TC) * TC, seq_hi = row0 < M_LAT ? seq_lo + T : seq_lo + TC;
        __syncthreads();
        for (int i = C.tid; i < 16 * 160; i += NTHR) { const int t = i / 160, k = i % 160; const float v = PS[(size_t)(row0 + t) * 160 + k]; sm[i] = k < 32 ? tanhf(v) : (k < 64 ? v : sigmf(v)); }
        __syncthreads();
        if (act) {
            float aw0[16], aw1[16], aa0[16], aa1[16], ag[16];
#pragma unroll
            for (int t = 0; t < 16; ++t) { aw0[t] = 0.f; aw1[t] = 0.f; aa0[t] = 0.f; aa1[t] = 0.f; ag[t] = 0.f; }
            for (int k = 0; k < 32; ++k) { const float u0 = wup[(size_t)k * GW + c], u1 = wup[(size_t)(32 + k) * GW + c], v0 = aup[(size_t)k * GW + c], v1 = aup[(size_t)(32 + k) * GW + c];
#pragma unroll
                for (int t = 0; t < 16; ++t) { const float dw = sm[t * 160 + k], da = sm[t * 160 + 32 + k]; aw0[t] += dw * u0; aw1[t] += dw * u1; aa0[t] += da * v0; aa1[t] += da * v1; } }
            for (int k = 0; k < 96; ++k) { const float gv = gup[(size_t)k * GW + c];
#pragma unroll
                for (int t = 0; t < 16; ++t) ag[t] += sm[t * 160 + 64 + k] * gv; }
            float pr[3], cu[3], nx[3];
#pragma unroll
            for (int x = 0; x < 3; ++x) { pr[x] = row0 - 1 >= seq_lo ? bf2f(PB[(size_t)(row0 - 1) * 3 * GW + x * GW + c]) : 0.f; cu[x] = bf2f(PB[(size_t)row0 * 3 * GW + x * GW + c]); }
#pragma unroll
            for (int t = 0; t < 16; ++t) { const int row = row0 + t;
#pragma unroll
                for (int x = 0; x < 3; ++x) nx[x] = row + 1 < seq_hi ? bf2f(PB[(size_t)(row + 1) * 3 * GW + x * GW + c]) : 0.f;
                const float r = pr[0] * cwv[0][0] + cu[0] * cwv[1][0] + nx[0] * cwv[2][0], kf = pr[1] * cwv[0][1] + cu[1] * cwv[1][1] + nx[1] * cwv[2][1], v = pr[2] * cwv[0][2] + cu[2] * cwv[1][2] + nx[2] * cwv[2][2];
#pragma unroll
                for (int x = 0; x < 3; ++x) { pr[x] = cu[x]; cu[x] = nx[x]; }
                const float kkv = kf * kkw, ssq = wave_sum(kkv * kkv), kk = kkv / fmaxf(sqrtf(ssq), 1e-12f);
                const size_t o = (size_t)row * GW + c;
                rw_arr(C, RW_R)[o] = r; rw_arr(C, RW_V)[o] = v; rw_arr(C, RW_NKK)[o] = -kk; rw_arr(C, RW_G)[o] = ag[t];
                { const float z = -(w00 + aw0[t]), sp = z > 20.f ? z : log1pf(__expf(z)), wlog = -sp - 0.5f, a = sigmf(a00 + aa0[t]);
                  rw_arr(C, RW_W0)[o] = __expf(-__expf(wlog)); rw_arr(C, RW_K0)[o] = kf * (1.f + (a - 1.f) * kaw); rw_arr(C, RW_B0)[o] = kk * a; }
                { const float z = -(w01 + aw1[t]), sp = z > 20.f ? z : log1pf(__expf(z)), wlog = -sp - 0.5f, a = sigmf(a01 + aa1[t]);
                  rw_arr(C, RW_W1)[o] = __expf(-__expf(wlog)); rw_arr(C, RW_K1)[o] = kf * (1.f + (a - 1.f) * kaw); rw_arr(C, RW_B1)[o] = kk * a; }
            }
        }
    }
    __syncthreads();
}
template <int N> DI float ror_add(float v) { return v + __int_as_float(__builtin_amdgcn_mov_dpp(__float_as_int(v), 0x120 + N, 0xf, 0xf, true)); }
DI float row16_sum(float v) { v = ror_add<8>(v); v = ror_add<4>(v); v = ror_add<2>(v); v = ror_add<1>(v); return v; }
DI void ph_rwscan(const Ctx& C) {
    if (C.wave >= 4) return;
    const int lane = C.lane, sub = lane & 15, vr = lane >> 4;
    const int nitems = NB * NH * 2 * 16;
    for (int it = C.bid * 4 + C.wave; it < nitems; it += C.G * 4) {
        const int rg = it & 15, dir = (it >> 4) & 1, hd = (it >> 5) % NH, b = it / (32 * NH);
        const int col = hd * 64 + 4 * sub, vcol = hd * 64 + 4 * rg + vr;
        const float* Wd = rw_arr(C, dir ? RW_W1 : RW_W0); const float* Kd = rw_arr(C, dir ? RW_K1 : RW_K0); const float* Bd = rw_arr(C, dir ? RW_B1 : RW_B0);
        const float* Rr = rw_arr(C, RW_R); const float* Vv = rw_arr(C, RW_V); const float* Nk = rw_arr(C, RW_NKK); float* Y = rw_arr(C, dir ? RW_Y1 : RW_Y0);
        f32x4 s = {0.f, 0.f, 0.f, 0.f};
        for (int seg = 0; seg < 2; ++seg) {
            const int base = seg == 0 ? M_LAT + b * TC : b * T, len = seg == 0 ? TC : T;
            for (int i0 = 0; i0 < len; i0 += 4) {
                f32x4 nk[4], w4[4], b4[4], k4[4], r4[4]; float vv[4]; int rows[4];
#pragma unroll
                for (int u = 0; u < 4; ++u) { const int i = i0 + u, row = base + (dir ? len - 1 - i : i); rows[u] = row; const size_t o = (size_t)row * GW + col;
                    nk[u] = *(const f32x4*)(Nk + o); w4[u] = *(const f32x4*)(Wd + o); b4[u] = *(const f32x4*)(Bd + o); k4[u] = *(const f32x4*)(Kd + o); r4[u] = *(const f32x4*)(Rr + o); vv[u] = Vv[(size_t)row * GW + vcol]; }
#pragma unroll
                for (int u = 0; u < 4; ++u) {
                    const f32x4 p = s * nk[u]; const float sa = row16_sum((p[0] + p[1]) + (p[2] + p[3]));
                    s = s * w4[u] + b4[u] * sa + k4[u] * vv[u];
                    const f32x4 yq = s * r4[u]; const float y = row16_sum((yq[0] + yq[1]) + (yq[2] + yq[3]));
                    if (sub == 0) Y[(size_t)rows[u] * GW + vcol] = y;
                }
            }
        }
    }
}
DI void ph_rwout(const Ctx& C, int l, int mrows) {
    const int gw = C.bid * NW + C.wave, GWV = C.G * NW, lane = C.lane;
    bf16* OB = (bf16*)(C.ws + WS_OB);
    for (int it = gw; it < mrows * NH; it += GWV) {
        const int hd = it % NH, row = it / NH, c = hd * 64 + lane; const size_t o = (size_t)row * GW + c;
        const float r = rw_arr(C, RW_R)[o], v = rw_arr(C, RW_V)[o], ks = rw_arr(C, RW_K0)[o] + rw_arr(C, RW_K1)[o];
        float y = rw_arr(C, RW_Y0)[o] + rw_arr(C, RW_Y1)[o];
        y += wave_sum(r * ks * C.in[I_RWRK][((size_t)l * NH + hd) * 64 + lane]) * v;
        const float mu = wave_sum(y) * (1.f / 64.f), dlt = y - mu, var = wave_sum(dlt * dlt) * (1.f / 64.f);
        const float yn = dlt / sqrtf(var + RW_GN_EPS);
        const float ov = (yn * C.in[I_RWGNW][(size_t)l * GW + c] + C.in[I_RWGNB][(size_t)l * GW + c]) * rw_arr(C, RW_G)[o];
        OB[(size_t)row * D + GW + c] = (bf16)f2bf(ov);
    }
}
constexpr int PT = 144;
constexpr int RW_HALF = 73472, IM_BT = 0, IM_KT = 9216, IM_RT = 18432, IM_ARB = 27648, IM_AT = 36864, IM_AAK = 46080, IM_F = 55296, IM_GC = 72704, FP = 68;
DI void chunk_rows(int b, int dir, int c, int& row0, int& step) {
    if (c < TC / 64) { const int p0 = 64 * c; row0 = M_LAT + b * TC + (dir ? TC - 1 - p0 : p0); } else { const int p0 = 64 * (c - TC / 64); row0 = b * T + (dir ? T - 1 - p0 : p0); }
    step = dir ? -1 : 1;
}
DI bf16x8 frag_rows(const LAS unsigned char* img, int tile, int s, int lane) { return *(const LAS bf16x8*)(img + (32 * tile + (lane & 31)) * PT + (16 * s + 8 * (lane >> 5)) * 2); }
DI bf16x8 frag_cols(const LAS unsigned char* img, int tile, int s, int lane) {
    const int h = lane >> 5, q = (lane & 15) >> 2, p4 = lane & 3, blk = (lane >> 4) & 1;
    const LAS unsigned char* a0 = img + (16 * s + 8 * h + q) * PT + (32 * tile + 16 * blk) * 2 + 8 * p4;
    const s16x4 lo = tr_read1(a0), hi = tr_read1(a0 + 4 * PT);
    return __builtin_shufflevector(lo, hi, 0, 1, 2, 3, 4, 5, 6, 7);
}
DI void store_T(const f32x16& acc, LAS unsigned char* img, int ti, int tj, int lane) {
    const int c = lane & 31, h = lane >> 5;
#pragma unroll
    for (int g = 0; g < 4; ++g) { u32x2 w; w.x = pk2(acc[4 * g], acc[4 * g + 1]); w.y = pk2(acc[4 * g + 2], acc[4 * g + 3]); *(LAS u32x2*)(img + (32 * tj + c) * PT + (32 * ti + 8 * g + 4 * h) * 2) = w; }
}
DI f32x16 zero16v() { f32x16 z;
#pragma unroll
    for (int i = 0; i < 16; ++i) z[i] = 0.f; return z; }
#define MMA32(a, b, c) __builtin_amdgcn_mfma_f32_32x32x16_bf16((a), (b), (c), 0, 0, 0)
constexpr int PDW = 80, PDG = 208, IM_TW = 0, IM_TA = 17408, IM_DW = 36864, IM_DA = 41984, IM_DG = 47104;
DI void ph_rw1(const Ctx& C, int l) {
    const int wg = C.wave & 3, grp = C.wave >> 2, ti = wg >> 1, tj = wg & 1;
    bf16* QH = (bf16*)(C.ws + WS_QH); float* YL = (float*)(C.ws + WS_YL); bf16* MF = (bf16*)(C.ws + WS_MF); float* GF = (float*)(C.ws + WS_GF); bf16* RVKG = (bf16*)(C.ws + WS_RVKG);
    const bf16* PB = (const bf16*)(C.ws + WS_PB); const float* PS = (const float*)(C.ws + WS_PS);
    const bf16x8* RWF = (const bf16x8*)(C.ws + WS_RWF + (size_t)l * SZ_RWF);
    constexpr int nblk = (TC + T) / 64;
    for (int it0 = 2 * C.bid; it0 < RBLK; it0 += 2 * C.G) {
        int lane_ = C.lane; OPAQUE(lane_); const int lane = lane_, c32 = lane & 31, h = lane >> 5;
        LAS unsigned char* L = OPAQUE_LDS(C.lds + grp * RW_HALF);
        LAS float* F = (LAS float*)(L + IM_F); LAS float* SEG = (LAS float*)(L + IM_F); LAS float* GC = (LAS float*)(L + IM_GC);
        LAS float* TW = (LAS float*)(L + IM_TW); LAS float* TA = (LAS float*)(L + IM_TA);
        unsigned char* PK = C.ws + WS_RWS + ((size_t)C.bid * 2 + grp) * 65536;
        const int item = it0 + grp; const bool live = item < RBLK; const int itc = live ? item : RBLK - 1;
        const int tb = itc % nblk, hd = (itc / nblk) % NH, b = itc / (nblk * NH), cg = hd * 64 + lane;
        const int rowb = tb < TC / 64 ? M_LAT + b * TC + 64 * tb : b * T + 64 * (tb - TC / 64);
        const int seq_lo = tb < TC / 64 ? M_LAT + b * TC : b * T, seq_hi = seq_lo + (tb < TC / 64 ? TC : T);
        bf16* RV = RVKG + (size_t)itc * 4 * 4096;
        __syncthreads();
        float r_[16], kf_[16], kk_[16], ks_[16];
        { const float* cw = C.in[I_RWCONV] + (size_t)l * 9 * GW; float cwv[3][3];
#pragma unroll
          for (int j = 0; j < 3; ++j)
#pragma unroll
              for (int x = 0; x < 3; ++x) cwv[j][x] = cw[(size_t)j * 3 * GW + x * GW + cg];
          const float kkw = C.in[I_RWKK][(size_t)l * GW + cg];
          const int r0 = rowb + 16 * wg; float pr[3], cu[3], nx[3];
#pragma unroll
          for (int x = 0; x < 3; ++x) { pr[x] = r0 - 1 >= seq_lo ? bf2f(PB[(size_t)(r0 - 1) * 3 * GW + x * GW + cg]) : 0.f; cu[x] = bf2f(PB[(size_t)r0 * 3 * GW + x * GW + cg]); }
#pragma unroll
          for (int t = 0; t < 16; ++t) { const int row = r0 + t;
#pragma unroll
              for (int x = 0; x < 3; ++x) nx[x] = row + 1 < seq_hi ? bf2f(PB[(size_t)(row + 1) * 3 * GW + x * GW + cg]) : 0.f;
              r_[t] = pr[0] * cwv[0][0] + cu[0] * cwv[1][0] + nx[0] * cwv[2][0]; kf_[t] = pr[1] * cwv[0][1] + cu[1] * cwv[1][1] + nx[1] * cwv[2][1]; const float v_t = pr[2] * cwv[0][2] + cu[2] * cwv[1][2] + nx[2] * cwv[2][2];
#pragma unroll
              for (int x = 0; x < 3; ++x) { pr[x] = cu[x]; cu[x] = nx[x]; }
              const float kkv = kf_[t] * kkw, ssq = wave_sum(kkv * kkv); kk_[t] = kkv / fmaxf(sqrtf(ssq), 1e-12f); ks_[t] = 0.f;
              RV[(16 * wg + t) * 64 + lane] = (bf16)f2bf(r_[t]); RV[4096 + (16 * wg + t) * 64 + lane] = (bf16)f2bf(v_t);
#pragma unroll
              for (int kq = 0; kq < 3; ++kq) { const int k = lane + 64 * kq; if (k < 160) { const float pv = PS[(size_t)row * 160 + k]; const int tk = 16 * wg + t;
                  if (k < 32) *(LAS bf16*)(L + IM_DW + tk * PDW + k * 2) = (bf16)f2bf(tanhf(pv)); else if (k < 64) *(LAS bf16*)(L + IM_DA + tk * PDW + (k - 32) * 2) = (bf16)f2bf(pv); else *(LAS bf16*)(L + IM_DG + tk * PDG + (k - 64) * 2) = (bf16)f2bf(sigmf(pv)); } }
          }
        }
        __syncthreads();
        f32x16 lwd[2], ad[2];
        { f32x16 gacc = zero16v();
#pragma unroll
          for (int sx = 0; sx < 6; ++sx) gacc = MMA32(*(const LAS bf16x8*)(L + IM_DG + (32 * ti + c32) * PDG + (16 * sx + 8 * h) * 2), RWF[(((8 + sx) * NH + hd) * 2 + tj) * 64 + lane], gacc);
#pragma unroll
          for (int rg = 0; rg < 16; ++rg) { const int tk = 32 * ti + (rg & 3) + 8 * (rg >> 2) + 4 * h; RV[3 * 4096 + tk * 64 + 32 * tj + c32] = (bf16)f2bf(gacc[rg]); }
#pragma unroll
          for (int d = 0; d < 2; ++d) { f32x16 pw = zero16v(), pa = zero16v();
#pragma unroll
              for (int sx = 0; sx < 2; ++sx) { pw = MMA32(*(const LAS bf16x8*)(L + IM_DW + (32 * ti + c32) * PDW + (16 * sx + 8 * h) * 2), RWF[(((0 + 2 * d + sx) * NH + hd) * 2 + tj) * 64 + lane], pw);
                                              pa = MMA32(*(const LAS bf16x8*)(L + IM_DA + (32 * ti + c32) * PDW + (16 * sx + 8 * h) * 2), RWF[(((4 + 2 * d + sx) * NH + hd) * 2 + tj) * 64 + lane], pa); }
              const float w0 = C.in[I_RWW0][((size_t)l * 2 + d) * GW + hd * 64 + 32 * tj + c32], a0 = C.in[I_RWA0][((size_t)l * 2 + d) * GW + hd * 64 + 32 * tj + c32];
#pragma unroll
              for (int rg = 0; rg < 16; ++rg) { const float z = -(w0 + pw[rg]), sp = z > 20.f ? z : log1pf(__expf(z)); lwd[d][rg] = -__expf(-sp - 0.5f); ad[d][rg] = sigmf(a0 + pa[rg]); } }
        }
        const float kaw = C.in[I_RWKA][(size_t)l * GW + cg];
#pragma unroll
        for (int pss = 0; pss < 2; ++pss) {
            const int dir = 1 - pss;
            __syncthreads();
#pragma unroll
            for (int rg = 0; rg < 16; ++rg) { const int tk = 32 * ti + (rg & 3) + 8 * (rg >> 2) + 4 * h; TW[tk * FP + 32 * tj + c32] = lwd[dir][rg]; TA[tk * FP + 32 * tj + c32] = ad[dir][rg]; }
            __syncthreads();
            const int cs = dir ? 3 - wg : wg;
            float lw[16], av[16], run = 0.f;
#pragma unroll
            for (int ii = 0; ii < 16; ++ii) { const int tl = dir ? 15 - ii : ii, tk = 16 * wg + tl; av[ii] = TA[tk * FP + lane]; run += TW[tk * FP + lane]; lw[ii] = run; }
            __syncthreads();
            SEG[cs * 64 + lane] = run;
            __syncthreads();
            float off = 0.f;
#pragma unroll
            for (int w2 = 0; w2 < 3; ++w2) off += (w2 < cs) ? SEG[w2 * 64 + lane] : 0.f;
            const float tot = SEG[lane] + SEG[64 + lane] + SEG[128 + lane] + SEG[192 + lane];
            if (wg == 0) { if (dir) ((float*)(PK + 32768))[lane] = __expf(tot); else GC[lane] = __expf(tot); }
#pragma unroll
            for (int ii = 0; ii < 16; ++ii) { const int tl = dir ? 15 - ii : ii, i = 16 * cs + ii;
                const float Li = lw[ii] + off, eL = __expf(Li), ieL = __builtin_amdgcn_rcpf(eL), eLm = __expf(Li - (lw[ii] - (ii ? lw[ii - 1] : 0.f)));
                const float a = av[ii], kd = kf_[tl] * (1.f + (a - 1.f) * kaw); ks_[tl] += kd;
                const bf16 vat = (bf16)f2bf(-kk_[tl] * eLm), vbt = (bf16)f2bf(kk_[tl] * a * ieL), vkt = (bf16)f2bf(kd * ieL), vrt = (bf16)f2bf(r_[tl] * eL);
                if (dir) { bf16* pk = (bf16*)PK + i * 64 + lane; pk[0] = vat; pk[4096] = vbt; pk[8192] = vkt; pk[12288] = vrt; }
                else { *(LAS bf16*)(L + IM_AT + i * PT + lane * 2) = vat; *(LAS bf16*)(L + IM_BT + i * PT + lane * 2) = vbt; *(LAS bf16*)(L + IM_KT + i * PT + lane * 2) = vkt; *(LAS bf16*)(L + IM_RT + i * PT + lane * 2) = vrt; } }
        }
#pragma unroll
        for (int t = 0; t < 16; ++t) RV[2 * 4096 + (16 * wg + t) * 64 + lane] = (bf16)f2bf(ks_[t]);
#pragma unroll 1
        for (int dir = 0; dir < 2; ++dir) {
            const int c = dir == 0 ? tb : (tb < TC / 64 ? TC / 64 - 1 - tb : TC / 64 + (T / 64 - 1 - (tb - TC / 64)));
            const size_t ci = ((size_t)((b * NH + hd) * 2 + dir)) * RCK + c;
            __syncthreads();
            if (dir) {
                const int tg = wg * 64 + lane;
#pragma unroll
                for (int im = 0; im < 4; ++im)
#pragma unroll
                    for (int rr = 0; rr < 2; ++rr) { const int idx = tg + 256 * rr, row = idx >> 3, ch = idx & 7; const int dsto = im == 0 ? IM_AT : im == 1 ? IM_BT : im == 2 ? IM_KT : IM_RT;
                        *(LAS u32x4*)(L + dsto + row * PT + ch * 16) = *(const u32x4*)(PK + im * 8192 + row * 128 + ch * 16); }
                if (wg == 0) GC[lane] = ((const float*)(PK + 32768))[lane];
                __syncthreads();
            }
            f32x16 accP;
            { f32x16 aab = zero16v(), aak = zero16v(), arb = zero16v(); accP = zero16v();
#pragma unroll
              for (int s = 0; s < 4; ++s) { const bf16x8 at_i = frag_rows(L + IM_AT, ti, s, lane), bt_j = frag_rows(L + IM_BT, tj, s, lane), kt_j = frag_rows(L + IM_KT, ti, s, lane), at_c = frag_rows(L + IM_AT, tj, s, lane),
                                              bt_r = frag_rows(L + IM_BT, ti, s, lane), rt_c = frag_rows(L + IM_RT, tj, s, lane);
                  aab = MMA32(at_i, bt_j, aab); aak = MMA32(kt_j, at_c, aak); arb = MMA32(bt_r, rt_c, arb); accP = MMA32(kt_j, rt_c, accP); }
#pragma unroll
              for (int r = 0; r < 16; ++r) { const int row = 32 * ti + (r & 3) + 8 * (r >> 2) + 4 * h, col = 32 * tj + c32;
                  F[row * FP + col] = col < row ? aab[r] : 0.f; aak[r] = row < col ? aak[r] : 0.f; arb[r] = row <= col ? arb[r] : 0.f; accP[r] = row <= col ? accP[r] : 0.f; }
              store_T(aak, L + IM_AAK, ti, tj, lane);
              store_T(arb, L + IM_ARB, ti, tj, lane); }
            __syncthreads();
            { float Wc[64]; const int col = 32 * wg + c32; const LAS unsigned char* src = col < 64 ? L + IM_AT + col * 2 : L + IM_AAK + (col - 64) * 2;
              const LAS float* Fo = OPAQUE_LDS(F);
#pragma unroll
              for (int i = 0; i < 64; ++i) Wc[i] = bf2f(*(const LAS bf16*)(src + i * PT));
#pragma unroll
              for (int i = 1; i < 64; ++i) { float a = Wc[i];
#pragma unroll
                  for (int j4 = 0; j4 < (i + 3) / 4; ++j4) { const f32x4 f = *(const LAS f32x4*)(Fo + i * FP + 4 * j4); a += f[0] * Wc[4 * j4] + f[1] * Wc[4 * j4 + 1] + f[2] * Wc[4 * j4 + 2] + f[3] * Wc[4 * j4 + 3];
                      if ((j4 & 3) == 3) PIN(a); }
                  PIN(a); Wc[i] = a; }
              __syncthreads();
              if (h == 0) { LAS unsigned char* dst = (col < 64 ? L + IM_AT + col * PT : L + IM_AAK + (col - 64) * PT);
#pragma unroll
                  for (int i8 = 0; i8 < 8; ++i8) { u32x4 w; w.x = pk2(Wc[8 * i8], Wc[8 * i8 + 1]); w.y = pk2(Wc[8 * i8 + 2], Wc[8 * i8 + 3]); w.z = pk2(Wc[8 * i8 + 4], Wc[8 * i8 + 5]); w.w = pk2(Wc[8 * i8 + 6], Wc[8 * i8 + 7]); *(LAS u32x4*)(dst + i8 * 16) = w; } }
#pragma unroll
              for (int ii = 0; ii < 16; ++ii) { const int tl = dir ? 15 - ii : ii, i = 16 * (dir ? 3 - wg : wg) + ii; *(LAS bf16*)(L + IM_F + i * PT + lane * 2) = RV[4096 + (16 * wg + tl) * 64 + lane]; }
            }
            __syncthreads();
            { f32x16 q;
#pragma unroll
              for (int g = 0; g < 4; ++g) { const u32x2 w = *(const LAS u32x2*)(L + IM_RT + (32 * tj + c32) * PT + (32 * ti + 8 * g + 4 * h) * 2); q[4 * g] = bflo(w.x); q[4 * g + 1] = bfhi(w.x); q[4 * g + 2] = bflo(w.y); q[4 * g + 3] = bfhi(w.y); }
#pragma unroll
              for (int s = 0; s < 4; ++s) { const bf16x8 arb = frag_rows(L + IM_ARB, tj, s, lane); q = MMA32(frag_rows(L + IM_AT, ti, s, lane), arb, q); accP = MMA32(frag_rows(L + IM_AAK, ti, s, lane), arb, accP); }
              if (live) {
#pragma unroll
                  for (int g = 0; g < 4; ++g) { u32x2 w; w.x = pk2(q[4 * g], q[4 * g + 1]); w.y = pk2(q[4 * g + 2], q[4 * g + 3]); *(u32x2*)(QH + ci * 4096 + (32 * tj + c32) * 64 + 32 * ti + 8 * g + 4 * h) = w; } }
            }
            __syncthreads();
            store_T(accP, L + IM_RT, ti, tj, lane);
            __syncthreads();
            { f32x16 y = zero16v(), m = zero16v(), n;
#pragma unroll
              for (int g = 0; g < 4; ++g) { const u32x2 w = *(const LAS u32x2*)(L + IM_KT + (32 * tj + c32) * PT + (32 * ti + 8 * g + 4 * h) * 2); n[4 * g] = bflo(w.x); n[4 * g + 1] = bfhi(w.x); n[4 * g + 2] = bflo(w.y); n[4 * g + 3] = bfhi(w.y); }
#pragma unroll
              for (int s = 0; s < 4; ++s) { const bf16x8 btc_j = frag_cols(L + IM_BT, tj, s, lane), btc_i = frag_cols(L + IM_BT, ti, s, lane);
                  y = MMA32(frag_rows(L + IM_RT, ti, s, lane), frag_cols(L + IM_F, tj, s, lane), y);
                  m = MMA32(frag_rows(L + IM_AT, ti, s, lane), btc_j, m);
                  n = MMA32(btc_i, frag_rows(L + IM_AAK, tj, s, lane), n); }
              const float gck = GC[32 * tj + c32];
#pragma unroll
              for (int r = 0; r < 16; ++r) { const int row = 32 * ti + (r & 3) + 8 * (r >> 2) + 4 * h, col = 32 * tj + c32; m[r] = (m[r] + (row == col ? 1.0f : 0.f)) * gck; n[r] *= GC[row]; }
              if (live) {
#pragma unroll
                  for (int g = 0; g < 4; ++g) *(f32x4*)(YL + ci * 4096 + ((wg * 4 + g) * 64 + lane) * 4) = (f32x4){y[4 * g], y[4 * g + 1], y[4 * g + 2], y[4 * g + 3]};
#pragma unroll
                  for (int s2 = 0; s2 < 2; ++s2) *(bf16x8*)(MF + ci * 4096 + ((wg * 2 + s2) * 64 + lane) * 8) = pack8(m, s2); }
              store_T(n, L + IM_ARB, ti, tj, lane);
            }
            __syncthreads();
            { f32x16 gacc = zero16v();
#pragma unroll
              for (int s = 0; s < 4; ++s) gacc = MMA32(frag_cols(L + IM_ARB, ti, s, lane), frag_cols(L + IM_F, tj, s, lane), gacc);
              if (live) {
#pragma unroll
                  for (int g = 0; g < 4; ++g) *(f32x4*)(GF + ci * 4096 + ((wg * 4 + g) * 64 + lane) * 4) = (f32x4){gacc[4 * g], gacc[4 * g + 1], gacc[4 * g + 2], gacc[4 * g + 3]}; }
            }
        }
    }
    __syncthreads();
}
DI void ph_rw2(const Ctx& C) {
    const int lane = C.lane;
    const bf16* MF = (const bf16*)(C.ws + WS_MF); const float* GF = (const float*)(C.ws + WS_GF); bf16* SF = (bf16*)(C.ws + WS_SF);
    const int nwork = RSTR * 2;
    for (int wk = C.wave == 0 ? C.bid : nwork; wk < nwork; wk += C.G) {
        const int tj = wk & 1, stream = wk >> 1;
        f32x16 s0 = zero16v(), s1 = zero16v();
        bf16x8 mf[2][2][2]; f32x4 gq[2][4];
#define RW2_LOAD(item_) do { const size_t it_ = (item_); \
            _Pragma("unroll") for (int kp = 0; kp < 2; ++kp) _Pragma("unroll") for (int kt = 0; kt < 2; ++kt) _Pragma("unroll") for (int s = 0; s < 2; ++s) mf[kp][kt][s] = *(const bf16x8*)(MF + it_ * 4096 + (((kp * 2 + kt) * 2 + s) * 64 + lane) * 8); \
            _Pragma("unroll") for (int kt = 0; kt < 2; ++kt) _Pragma("unroll") for (int g = 0; g < 4; ++g) gq[kt][g] = *(const f32x4*)(GF + it_ * 4096 + (((kt * 2 + tj) * 4 + g) * 64 + lane) * 4); } while (0)
        RW2_LOAD((size_t)stream * RCK);
        for (int c = 0; c < RCK; ++c) {
            const size_t item = (size_t)stream * RCK + c;
            bf16x8 sf[2][2];
#pragma unroll
            for (int s = 0; s < 2; ++s) { sf[0][s] = pack8(s0, s); sf[1][s] = pack8(s1, s); *(bf16x8*)(SF + item * 4096 + (((0 * 2 + tj) * 2 + s) * 64 + lane) * 8) = sf[0][s]; *(bf16x8*)(SF + item * 4096 + (((1 * 2 + tj) * 2 + s) * 64 + lane) * 8) = sf[1][s]; }
            f32x16 n0, n1;
#pragma unroll
            for (int g = 0; g < 4; ++g) { n0[4 * g] = gq[0][g][0]; n0[4 * g + 1] = gq[0][g][1]; n0[4 * g + 2] = gq[0][g][2]; n0[4 * g + 3] = gq[0][g][3]; n1[4 * g] = gq[1][g][0]; n1[4 * g + 1] = gq[1][g][1]; n1[4 * g + 2] = gq[1][g][2]; n1[4 * g + 3] = gq[1][g][3]; }
            bf16x8 mc[2][2][2];
#pragma unroll
            for (int kp = 0; kp < 2; ++kp)
#pragma unroll
                for (int kt = 0; kt < 2; ++kt)
#pragma unroll
                    for (int s = 0; s < 2; ++s) mc[kp][kt][s] = mf[kp][kt][s];
            if (c + 1 < RCK) RW2_LOAD(item + 1);
#pragma unroll
            for (int kp = 0; kp < 2; ++kp)
#pragma unroll
                for (int s = 0; s < 2; ++s) { n0 = MMA32(mc[kp][0][s], sf[kp][s], n0); n1 = MMA32(mc[kp][1][s], sf[kp][s], n1); }
            s0 = n0; s1 = n1;
        }
#undef RW2_LOAD
    }
}
DI void ph_rw3(const Ctx& C, int l, int mrows) {
    const int lane = C.lane, wg = C.wave & 3, grp = C.wave >> 2, ti = wg >> 1, tj = wg & 1, c32 = lane & 31, h = lane >> 5;
    LAS float* Ysum = (LAS float*)(C.lds + grp * RW_HALF);
    const bf16* QH = (const bf16*)(C.ws + WS_QH); const float* YL = (const float*)(C.ws + WS_YL); const bf16* SF = (const bf16*)(C.ws + WS_SF); bf16* OB = (bf16*)(C.ws + WS_OB);
    const int nblk = (TC + T) / 64, nitems = NB * NH * nblk;
    for (int it0 = 2 * C.bid; it0 < nitems; it0 += 2 * C.G) {
        const int item = it0 + grp; const bool live = item < nitems; const int itc = live ? item : nitems - 1;
        const int tb = itc % nblk, hd = (itc / nblk) % NH, b = itc / (nblk * NH);
        const int rowb = tb < TC / 64 ? M_LAT + b * TC + 64 * tb : b * T + 64 * (tb - TC / 64);
        __syncthreads();
#pragma unroll
        for (int dir = 0; dir < 2; ++dir) {
            const int c = dir == 0 ? tb : (tb < TC / 64 ? TC / 64 - 1 - tb : TC / 64 + (T / 64 - 1 - (tb - TC / 64)));
            const size_t ci = ((size_t)((b * NH + hd) * 2 + dir)) * RCK + c;
            f32x16 y;
#pragma unroll
            for (int g = 0; g < 4; ++g) { const f32x4 a = *(const f32x4*)(YL + ci * 4096 + ((wg * 4 + g) * 64 + lane) * 4); y[4 * g] = a[0]; y[4 * g + 1] = a[1]; y[4 * g + 2] = a[2]; y[4 * g + 3] = a[3]; }
#pragma unroll
            for (int kp = 0; kp < 2; ++kp)
#pragma unroll
                for (int s = 0; s < 2; ++s) {
                    const bf16* qp = QH + ci * 4096 + (32 * ti + c32) * 64 + 32 * kp + 16 * s + 4 * h; const u32x2 lo = *(const u32x2*)qp, hi = *(const u32x2*)(qp + 8);
                    u32x4 av; av.x = lo.x; av.y = lo.y; av.z = hi.x; av.w = hi.y;
                    y = MMA32(__builtin_bit_cast(bf16x8, av), *(const bf16x8*)(SF + ci * 4096 + (((kp * 2 + tj) * 2 + s) * 64 + lane) * 8), y); }
#pragma unroll
            for (int r = 0; r < 16; ++r) { const int i = 32 * ti + (r & 3) + 8 * (r >> 2) + 4 * h, tk = dir ? 63 - i : i; LAS float* p = Ysum + tk * FP + 32 * tj + c32; if (dir == 0) *p = y[r]; else *p += y[r]; }
            __syncthreads();
        }
        if (live) {
            const int cch = hd * 64 + lane; const float rk = C.in[I_RWRK][((size_t)l * NH + hd) * 64 + lane], gw = C.in[I_RWGNW][(size_t)l * GW + cch], gb = C.in[I_RWGNB][(size_t)l * GW + cch];
            for (int t = 0; t < 16; ++t) { const int tk = 16 * wg + t, row = rowb + tk; if (row >= mrows) continue; const size_t o = (size_t)row * GW + cch;
                const bf16* rv = (const bf16*)(C.ws + WS_RVKG) + (size_t)item * 4 * 4096 + tk * 64 + lane; const float r = bf2f(rv[0]), v = bf2f(rv[4096]), ks = bf2f(rv[8192]), gg = bf2f(rv[12288]); (void)o;
                float y = Ysum[tk * FP + lane] + wave_sum(r * ks * rk) * v;
                const float mu = wave_sum(y) * (1.f / 64.f), dlt = y - mu, var = wave_sum(dlt * dlt) * (1.f / 64.f);
                OB[(size_t)row * D + GW + cch] = (bf16)f2bf((dlt * __builtin_amdgcn_rsqf(var + RW_GN_EPS) * gw + gb) * gg); }
        }
    }
    __syncthreads();
}
DI void ph_s5scan(const Ctx& C, int l, int first_block) {
    const int nthreads_total = NB * 2 * S5G * 64;
    if (C.bid < first_block) return;
    const float* XE = (const float*)(C.ws + WS_XEND); bf16* UG = (bf16*)(C.ws + WS_UG);
    const f32x2* LAM = (const f32x2*)(C.ws + WS_S5T + (size_t)l * SZ_S5L + OFF_S5LAM);
    for (int id = (C.bid - first_block) * NTHR + C.tid; id < nthreads_total; id += (C.G - first_block) * NTHR) {
        const int n = id & 63, g = (id >> 6) % S5G, dir = (id / (64 * S5G)) & 1, b = id / (128 * S5G);
        const f32x2 lm = LAM[(dir * S5G + g) * 64 + n]; float xr = 0.f, xi = 0.f;
        const int nc_ctx = TC / S5L, nc_lat = T / S5L, ntot = nc_ctx + nc_lat;
        for (int i0 = 0; i0 < ntot; i0 += 8) {
            float er[8], ei[8]; int chs[8];
#pragma unroll
            for (int u = 0; u < 8; ++u) { const int i = i0 + u; int ch;
                if (i < nc_ctx) ch = (M_LAT + b * TC) / S5L + (dir ? nc_ctx - 1 - i : i); else ch = (b * T) / S5L + (dir ? nc_lat - 1 - (i - nc_ctx) : (i - nc_ctx));
                chs[u] = ch; const float* p = XE + ((size_t)g * NCHP + ch) * 256 + dir * 128 + n; er[u] = p[0]; ei[u] = p[64]; }
#pragma unroll
            for (int u = 0; u < 8; ++u) { bf16* q = UG + ((size_t)g * NCHP + chs[u]) * S5K + 512 + dir * 128 + n; q[0] = (bf16)f2bf(xr); q[64] = (bf16)f2bf(xi);
                const float nr = lm[0] * xr - lm[1] * xi + er[u], ni = lm[0] * xi + lm[1] * xr + ei[u]; xr = nr; xi = ni; }
        }
    }
}

constexpr int PH_PRO = 3, PH_PER_L = 11, NPH = PH_PRO + PH_PER_L * NL;
#ifndef PROBE_REP
#define PROBE_REP -1
#endif
#define NREP(k) ((k) == PROBE_REP ? 2 : 1)
#ifdef ONLY
#define EN(k) ((k) == ONLY)
#else
#define EN(k) true
#endif
#ifdef EMU
void fwd(Args args) {
    unsigned char* lds = emu::lds_base();
#else
__global__ void __launch_bounds__(NTHR, 2) fwd(Args args) {
    extern __shared__ __attribute__((aligned(16))) unsigned char lds[];
#endif
    Ctx C; C.in = args.in; C.out = args.out; C.ws = args.ws; C.lds = (LAS unsigned char*)lds;
    C.tid = threadIdx.x; C.lane = C.tid & 63; C.wave = __builtin_amdgcn_readfirstlane(C.tid >> 6); C.G = gridDim.x; C.bid = blockIdx.x;
#define REFRESH() do { int t_ = threadIdx.x; OPAQUE(t_); C.tid = t_; C.lane = t_ & 63; C.wave = __builtin_amdgcn_readfirstlane(t_ >> 6); } while (0)
    volatile LAS unsigned* MISC = (volatile LAS unsigned*)(C.lds + MISC_OFF);
    if (C.tid < 32) MISC[C.tid] = 0u;
    __syncthreads();
    const int lo = args.ph_lo, hi = args.ph_hi;
    const bool use_bar = (hi - lo) > 1;
    XcdBarrier bar; bar.bar = (unsigned*)(C.ws + WS_CTL) + CW_BAR; bar.x = 0; bar.st = MISC + 8;
    if (use_bar) bar = xcd_barrier_post((unsigned*)(C.ws + WS_CTL) + CW_BAR, MISC + 8);
#define IN(k) (lo <= (k) && (k) < hi)
#define SEAM(k) do { if (IN(k) && IN((k) + 1)) xcd_barrier(bar); } while (0)
    if (EN(0) && IN(0)) for (int rep = 0; rep < NREP(0); ++rep) { REFRESH(); ph_ada(C); }
    SEAM(0);
    if (EN(1) && IN(1)) { REFRESH(); ph_conv(C); }
    SEAM(1);
    if (EN(2) && IN(2)) for (int rep = 0; rep < NREP(2); ++rep) { REFRESH(); ph_tab(C); }
    SEAM(2);
    for (int l = 0; l < NL; ++l) {
        const int pb = PH_PRO + PH_PER_L * l; const bool want_ctx = l < NL - 1;
        const int mrows_full = M, mrows_out = want_ctx ? M : M_LAT;
        bf16* AP = (bf16*)(C.ws + WS_AP); bf16* Hb = (bf16*)(C.ws + WS_H); bf16* OB = (bf16*)(C.ws + WS_OB);
        if (EN(3) && IN(pb + 0)) for (int rep = 0; rep < NREP(3); ++rep) { REFRESH();
            Gemm g{AP, wl(C, l, OFF_W1GU), D, D, D, 0, 0}; Order S; S.init(mrows_full / 256, 2 * FF / 256, 1, C.G, C.bid);
            EpiGU E{rowss_ptr(C, l, 0), bias_ptr(C, l, 0), Hb, mrows_full}; gemm_phase(C.lds, g, S, E); }
        SEAM(pb + 0);
        if (EN(4) && IN(pb + 1)) { REFRESH();
            Gemm g{Hb, wl(C, l, OFF_W1D), FF, FF, FF, 0, 0}; Order S; S.init(mrows_full / 256, D / 256, 1, C.G, C.bid);
            EpiRes E{&C, gate_ptr(C, l, 0, 0), gs_ptr(C, l, 1, 0), rowss_ptr(C, l, 1), AP}; gemm_phase(C.lds, g, S, E); }
        SEAM(pb + 1);
        if (EN(5) && IN(pb + 2)) for (int rep = 0; rep < NREP(5); ++rep) { REFRESH();
            Gemm g{AP, wl(C, l, OFF_WIN), D, D, D, 0, 0}; Order S; S.init(mrows_full / 256, NT_IN, 1, C.G, C.bid);
            EpiIn E{&C, rowss_ptr(C, l, 1), bias_ptr(C, l, 1), l}; gemm_phase(C.lds, g, S, E); }
        SEAM(pb + 2);
        if (IN(pb + 3)) {
            if (EN(6)) for (int rep = 0; rep < NREP(6); ++rep) { REFRESH(); Gemm g{(const bf16*)(C.ws + WS_UG), (const bf16*)(C.ws + WS_S5T + (size_t)l * SZ_S5L + OFF_S5ET), S5K, 512, 512, (size_t)NCHP * S5K * 2, (size_t)256 * 512 * 2};
              Order S; S.init(NCHP / 256, 1, S5G, C.G, C.bid); EpiS5A E{(float*)(C.ws + WS_XEND)}; gemm_phase(C.lds, g, S, E); }
            __syncthreads();
            if (EN(7)) for (int rep = 0; rep < NREP(7); ++rep) { REFRESH(); ph_attn(C, l, want_ctx); }
        }
        SEAM(pb + 3);
        if (IN(pb + 4)) { for (int rep = 0; rep < NREP(9); ++rep) { if (EN(9)) { REFRESH(); ph_rw1(C, l); } } }
        SEAM(pb + 4);
        if (IN(pb + 5)) { if (EN(17)) for (int rep = 0; rep < NREP(17); ++rep) { REFRESH(); ph_rw2(C); } if (EN(10)) for (int rep = 0; rep < NREP(10); ++rep) { REFRESH(); ph_s5scan(C, l, C.G >= 256 ? 128 : 0); } }
        SEAM(pb + 5);
        if (IN(pb + 6)) {
            if (EN(11)) for (int rep = 0; rep < NREP(11); ++rep) { REFRESH(); Gemm g{(const bf16*)(C.ws + WS_UG), (const bf16*)(C.ws + WS_S5T + (size_t)l * SZ_S5L + OFF_S5BT), S5K, S5K, S5K, (size_t)NCHP * S5K * 2, (size_t)512 * S5K * 2};
              Order S; S.init(NCHP / 256, 2, S5G, C.G, C.bid); EpiS5C E{(const bf16*)(C.ws + WS_UG), C.in[I_S5D] + (size_t)l * GW, (bf16*)(C.ws + WS_YG)}; gemm_phase(C.lds, g, S, E); }
            if (EN(12)) for (int rep = 0; rep < NREP(12); ++rep) { REFRESH(); ph_rw3(C, l, mrows_out); }
        }
        SEAM(pb + 6);
        if (EN(13) && IN(pb + 7)) for (int rep = 0; rep < NREP(13); ++rep) { REFRESH();
            Gemm g{(const bf16*)(C.ws + WS_YG), wl(C, l, OFF_WGLU), GW, GW, GW, 0, 0}; Order S; S.init(mrows_out / 256, GW / 256, 1, C.G, C.bid);
            EpiGLU E{(const bf16*)(C.ws + WS_YG), C.in[I_S5GLUB] + (size_t)l * GW, OB}; gemm_phase(C.lds, g, S, E); }
        SEAM(pb + 7);
        if (EN(14) && IN(pb + 8)) { REFRESH();
            Gemm g{OB, wl(C, l, OFF_WOUT), D, D, D, 0, 0}; Order S; S.init(mrows_out / 256, D / 256, 1, C.G, C.bid);
            EpiRes E{&C, gate_ptr(C, l, 1, 0), gs_ptr(C, l, 2, 0), rowss_ptr(C, l, 2), AP}; gemm_phase(C.lds, g, S, E); }
        SEAM(pb + 8);
        if (EN(15) && IN(pb + 9)) { REFRESH();
            Gemm g{AP, wl(C, l, OFF_W2GU), D, D, D, 0, 0}; Order S; S.init(mrows_out / 256, 2 * FF / 256, 1, C.G, C.bid);
            EpiGU E{rowss_ptr(C, l, 2), bias_ptr(C, l, 2), Hb, mrows_out}; gemm_phase(C.lds, g, S, E); }
        SEAM(pb + 9);
        if (EN(16) && IN(pb + 10)) { REFRESH();
            Gemm g{Hb, wl(C, l, OFF_W2D), FF, FF, FF, 0, 0}; Order S; S.init(mrows_out / 256, D / 256, 1, C.G, C.bid);
            const bool more = l + 1 < NL;
            EpiRes E{&C, gate_ptr(C, l, 2, 0), more ? gs_ptr(C, l + 1, 0, 0) : nullptr, more ? rowss_ptr(C, l + 1, 0) : nullptr, AP}; gemm_phase(C.lds, g, S, E); }
        SEAM(pb + 10);
    }
#undef IN
#undef SEAM
}

#ifndef MK_PER_PHASE
#define MK_PER_PHASE 0
#endif
#ifdef EMU
int g_emu_grid = 4, g_emu_lo = 0, g_emu_hi = NPH;
#endif
extern "C" void kernel_launch(void* const* d_in, const int* in_sizes, int n_in, void* d_out, int out_size, void* d_ws, size_t ws_size, hipStream_t stream) {
    Args a{};
    for (int i = 0; i < 42; ++i) a.in[i] = (const float*)d_in[i];
    a.out = (float*)d_out; a.ws = (unsigned char*)d_ws;
#ifdef EMU
    if (g_emu_lo == 0) hipMemsetAsync(d_ws, 0, WS_ZERO_END, stream);
    for (int ph = g_emu_lo; ph < g_emu_hi; ++ph) { a.ph_lo = ph; a.ph_hi = ph + 1; fprintf(stderr, "phase %d\n", ph); emu::launch(g_emu_grid, NTHR, LDS_BYTES, [=] { fwd(a); }); }
#else
    static int grid = 0;
    if (grid == 0) {
        if (n_in != 42 || out_size != M_LAT * D || ws_size < WS_END) { fprintf(stderr, "kernel_launch: unexpected shapes (n_in %d out %d ws %zu need %zu)\n", n_in, out_size, ws_size, (size_t)WS_END); grid = -1; return; }
        int dev = 0, cus = 0;
        if (hipGetDevice(&dev) != hipSuccess || hipDeviceGetAttribute(&cus, hipDeviceAttributeMultiprocessorCount, dev) != hipSuccess) { grid = -1; return; }
        if (hipFuncSetAttribute((const void*)fwd, hipFuncAttributeMaxDynamicSharedMemorySize, LDS_BYTES) != hipSuccess) { fprintf(stderr, "kernel_launch: hipFuncSetAttribute failed\n"); grid = -1; return; }
        int per_cu = 0; (void)hipOccupancyMaxActiveBlocksPerMultiprocessor(&per_cu, (const void*)fwd, NTHR, LDS_BYTES); (void)hipGetLastError();
        if (per_cu < 1) fprintf(stderr, "kernel_launch: occupancy query reports %d\n", per_cu);
        grid = cus;
    }
    if (grid < 0) return;
    (void)hipMemsetAsync(d_ws, 0, WS_ZERO_END, stream);
#if MK_PER_PHASE
    for (int ph = 0; ph < NPH; ++ph) { a.ph_lo = ph; a.ph_hi = ph + 1; hipLaunchKernelGGL(fwd, dim3(grid), dim3(NTHR), LDS_BYTES, stream, a); }
#else
    a.ph_lo = 0; a.ph_hi = NPH;
    hipLaunchKernelGGL(fwd, dim3(grid), dim3(NTHR), LDS_BYTES, stream, a);
#endif
#endif
}
```

```cpp
#ifdef EMU
#include "emu/emu.h"
#define LAS
#define GAS
#define ASMV(...) ((void)0)
#define WSYNC() do { int _z = 0; (void)emu::wave_gather(&_z, 4); } while (0)
#define OPAQUE(x) ((void)0)
#define OPAQUE_S(x) ((void)0)
#define PIN(x) ((void)0)
#define OPAQUE_LDS(p) (p)
#else
#include <hip/hip_runtime.h>
#include <cstdio>
#include <cstdint>
#define LAS __attribute__((address_space(3)))
#define GAS __attribute__((address_space(1)))
#define ASMV(...) asm volatile(__VA_ARGS__)
#define PIN(x) asm volatile("" : "+v"(x) :: "memory")
template <class P> __device__ __forceinline__ P opaque_lds(P p) { unsigned a = (unsigned)(size_t)p; asm volatile("" : "+v"(a)); return (P)(size_t)a; }
#define OPAQUE_LDS(p) opaque_lds(p)
#define OPAQUE_S(x) asm volatile("" : "+s"(x))
#define OPAQUE(x) asm volatile("" : "+v"(x))
#define WSYNC() asm volatile("s_waitcnt lgkmcnt(0)" ::: "memory")
#endif

#ifdef EMU
constexpr int D = 1024, NB = 2, T = 1024, NL = 2, TC = 256, FF = 1024;
#else
constexpr int D = 2048, NB = 2, T = 8192, NL = 4, TC = 256, FF = 5632;
#endif
constexpr int GW = D / 4, NH = GW / 64, WAG = NH / 2, S5G = GW / 16, GRW = 64, GRH = T / GRW;
constexpr int M_LAT = NB * T, M_CTX = NB * TC, M = M_LAT + M_CTX, NPAN = M / 256;
constexpr int TP = GW / 256;
constexpr int NT_IN = 8 * TP + 2, NINP = NT_IN * 256, D_IN = 8 * GW + 416;
constexpr int PN_AQ = 0, PN_AK = TP, PN_AV = 2 * TP, PN_BR = 3 * TP, PN_BK = 4 * TP, PN_BV = 5 * TP, PN_BS = 6 * TP, PN_CQ = 6 * TP + 1, PN_CKV = 7 * TP + 1, PN_DU = 7 * TP + 2;
constexpr int SRC_AQ = 0, SRC_AK = GW, SRC_AV = 2 * GW, SRC_BR = 3 * GW, SRC_BK = 4 * GW, SRC_BV = 5 * GW, SRC_BS = 6 * GW, SRC_CQ = 6 * GW + 160, SRC_CK = 7 * GW + 160, SRC_CV = 7 * GW + 288, SRC_DU = 7 * GW + 416;
constexpr int S5L = 32, NCH = M / S5L, NCHP = ((NCH + 255) / 256) * 256, S5K = 768;
constexpr int NW = 8, NTHR = 512;
constexpr float NORM_EPS = 1e-6f, RW_GN_EPS = 64e-5f;

typedef unsigned short bf16;
typedef short bf16x8 __attribute__((ext_vector_type(8)));
typedef short s16x4 __attribute__((ext_vector_type(4)));
typedef float f32x4 __attribute__((ext_vector_type(4)));
typedef float f32x2 __attribute__((ext_vector_type(2)));
typedef float f32x16 __attribute__((ext_vector_type(16)));
typedef unsigned u32x4 __attribute__((ext_vector_type(4)));
typedef unsigned u32x2 __attribute__((ext_vector_type(2)));
#define DI __device__ __forceinline__

constexpr size_t al256(size_t x) { return (x + 255) & ~(size_t)255; }
constexpr size_t SZ_BIAS_GU = (size_t)3 * 2 * FF * 4, SZ_BIAS_IN = (size_t)3 * NINP * 4;
constexpr size_t WS_CTL = 0;
constexpr size_t WS_BIAS = 65536;
constexpr size_t SZ_BIAS_L = 2 * SZ_BIAS_GU + SZ_BIAS_IN;
constexpr size_t WS_ROWSS = al256(WS_BIAS + NL * SZ_BIAS_L);
constexpr size_t WS_ZERO_END = al256(WS_ROWSS + (size_t)NL * 3 * M * 4);
constexpr size_t WS_MODV = WS_ZERO_END;
constexpr size_t WS_GS = al256(WS_MODV + (size_t)NL * 3 * 9 * D * 4);
constexpr size_t WS_GATE = al256(WS_GS + (size_t)NL * 9 * D * 4);
constexpr size_t WS_ROPE = al256(WS_GATE + (size_t)NL * 9 * D * 4);
constexpr size_t SZ_WGU = (size_t)2 * FF * D * 2, SZ_WD = (size_t)D * FF * 2, SZ_WIN = (size_t)NINP * D * 2, SZ_WOUT = (size_t)D * D * 2, SZ_WGLU = (size_t)GW * GW * 2;
constexpr size_t OFF_W1GU = 0, OFF_W1D = OFF_W1GU + SZ_WGU, OFF_WIN = OFF_W1D + SZ_WD, OFF_WOUT = OFF_WIN + SZ_WIN, OFF_W2GU = OFF_WOUT + SZ_WOUT, OFF_W2D = OFF_W2GU + SZ_WGU, OFF_WGLU = OFF_W2D + SZ_WD, SZ_WL = OFF_WGLU + SZ_WGLU;
constexpr size_t WS_W = al256(WS_ROPE + 128 * 16 * 8);
constexpr size_t SZ_S5KC = (size_t)S5G * 2 * S5L * 256 * 4, SZ_S5ET = (size_t)S5G * 256 * 512 * 2, SZ_S5BT = (size_t)S5G * 512 * S5K * 2, SZ_S5LAM = (size_t)2 * GW * 4 * 8;
constexpr size_t SZ_S5LP = (size_t)2 * S5G * 64 * (S5L + 1) * 8, SZ_S5BETA = (size_t)2 * S5G * 64 * 16 * 8;
constexpr size_t OFF_S5KC = 0, OFF_S5ET = OFF_S5KC + SZ_S5KC, OFF_S5BT = OFF_S5ET + SZ_S5ET, OFF_S5LAM = OFF_S5BT + SZ_S5BT, OFF_S5LP = al256(OFF_S5LAM + SZ_S5LAM), OFF_S5BETA = OFF_S5LP + SZ_S5LP, SZ_S5L = al256(OFF_S5BETA + SZ_S5BETA);
constexpr size_t WS_S5T = al256(WS_W + NL * SZ_WL);
constexpr size_t WS_XC = al256(WS_S5T + NL * SZ_S5L);
constexpr size_t WS_AP = al256(WS_XC + (size_t)M_CTX * D * 4);
constexpr size_t WS_H = al256(WS_AP + (size_t)M * D * 2);
constexpr size_t WS_QA = al256(WS_H + (size_t)M * FF * 2);
constexpr size_t WS_KA = WS_QA + (size_t)M * GW * 2, WS_VA = WS_KA + (size_t)M * GW * 2, WS_QC = WS_VA + (size_t)M * GW * 2;
constexpr size_t WS_KC = WS_QC + (size_t)M * GW * 2, WS_VC = WS_KC + (size_t)M * 128 * 2;
constexpr size_t WS_PB = WS_VC + (size_t)M * 128 * 2;
constexpr size_t WS_PS = al256(WS_PB + (size_t)M * 3 * GW * 2);
constexpr size_t WS_UG = al256(WS_PS + (size_t)M * 160 * 4);
constexpr size_t WS_RW = al256(WS_UG + (size_t)S5G * NCHP * S5K * 2);
constexpr size_t SZ_RWA = (size_t)M * GW * 4;
enum { RW_R = 0, RW_V, RW_NKK, RW_G, RW_W0, RW_W1, RW_K0, RW_K1, RW_B0, RW_B1, RW_Y0, RW_Y1, RW_NARR };
constexpr size_t WS_XEND = al256(WS_RW + RW_NARR * SZ_RWA);
constexpr size_t WS_YG = al256(WS_XEND + (size_t)S5G * NCHP * 256 * 4);
constexpr size_t WS_OB = al256(WS_YG + (size_t)M * GW * 2);
constexpr int RCK = (TC + T) / 64, RSTR = NB * NH * 2, RITEM = RSTR * RCK;
constexpr size_t WS_QH = al256(WS_OB + (size_t)M * D * 2);
constexpr size_t WS_YL = al256(WS_QH + (size_t)RITEM * 8192);
constexpr size_t WS_MF = al256(WS_YL + (size_t)RITEM * 16384);
constexpr size_t WS_GF = al256(WS_MF + (size_t)RITEM * 8192);
constexpr size_t WS_SF = al256(WS_GF + (size_t)RITEM * 16384);
constexpr int RBLK = NB * NH * ((TC + T) / 64);
constexpr size_t WS_RVKG = al256(WS_SF + (size_t)RITEM * 8192);
constexpr size_t SZ_RWF = (size_t)14 * NH * 2 * 64 * 16;
constexpr size_t WS_RWF = al256(WS_RVKG + (size_t)RBLK * 32768);
constexpr size_t WS_RWS = al256(WS_RWF + NL * SZ_RWF);
constexpr size_t WS_END = al256(WS_RWS + (size_t)512 * 2 * 65536);
constexpr int CW_BAR = 1024;

constexpr int LDS_BYTES = 147456, RING_BYTES = 131072, MISC_OFF = LDS_BYTES - 256;

DI unsigned f2bf(float f) { unsigned u = __float_as_uint(f); return (u + 0x7fffu + ((u >> 16) & 1u)) >> 16; }
#ifdef EMU
DI unsigned pk2(float lo, float hi) { return f2bf(lo) | (f2bf(hi) << 16); }
#else
typedef __bf16 hbf16x2 __attribute__((ext_vector_type(2)));
DI unsigned pk2(float lo, float hi) { const f32x2 v = {lo, hi}; const hbf16x2 b = __builtin_convertvector(v, hbf16x2); return __builtin_bit_cast(unsigned, b); }
#endif
DI float bf2f(unsigned short b) { return __uint_as_float(((unsigned)b) << 16); }
DI float bflo(unsigned w) { return __uint_as_float(w << 16); }
DI float bfhi(unsigned w) { return __uint_as_float(w & 0xffff0000u); }
DI float wave_sum(float v) {
#pragma unroll
    for (int o = 1; o < 64; o <<= 1) v += __shfl_xor(v, o);
    return v;
}
DI float siluf(float x) { return x * __builtin_amdgcn_rcpf(1.f + __expf(-x)); }
DI float sigmf(float x) { return __builtin_amdgcn_rcpf(1.f + __expf(-x)); }
DI float geluf(float x) { const float z = 0.7978845608028654f * (x + 0.044715f * x * x * x); const float e = __expf(2.f * z); return 0.5f * x * (1.f + (1.f - 2.f * __builtin_amdgcn_rcpf(e + 1.f))); }
DI int stream_of_row(int row) { return row < M_LAT ? row / T : NB; }
DI int stream_of_panel(int pm) { return stream_of_row(pm * 256); }

#define XB_TMO      128
#define XB_XCNT(j)  (256  + 64 * (j))
#define XB_XSUB(j)  (1280 + 64 * (j))
#define XB_XGEN(j)  (2304 + 64 * (j))
#define XB_TOP      3328
#define XB_TOPGEN   3392
#define XCD_BAR_WORDS 3456
#define XB_SPIN_CAP (1u << 18)
DI unsigned xb_ld(unsigned* p)              { return __hip_atomic_load(p, __ATOMIC_RELAXED, __HIP_MEMORY_SCOPE_AGENT); }
DI unsigned xb_add(unsigned* p, unsigned v) { return __hip_atomic_fetch_add(p, v, __ATOMIC_RELAXED, __HIP_MEMORY_SCOPE_AGENT); }
DI unsigned xb_xcc_id() { return (unsigned)__builtin_amdgcn_s_getreg((3 << 11) | 20) & 0xFu; }
#define XB_SPIN(cond, bar) do { unsigned _sp = 0; while (cond) { __builtin_amdgcn_s_sleep(1); \
    if ((++_sp & 255u) == 0u) { if (xb_ld(&(bar)[XB_TMO])) break; if (_sp > XB_SPIN_CAP) { atomicAdd(&(bar)[XB_TMO], 1u); break; } } } } while (0)
struct XcdBarrier { unsigned* bar; unsigned x; volatile LAS unsigned* st; };
DI XcdBarrier xcd_barrier_post(unsigned* bar, volatile LAS unsigned* st) {
    XcdBarrier b; b.bar = bar; b.x = xb_xcc_id(); b.st = st;
    if (threadIdx.x == 0) (void)xb_add(&bar[XB_XCNT(b.x)], 1u);
    return b;
}
DI void xcd_barrier_complete(unsigned* bar, unsigned x, unsigned& nloc, unsigned& nx) {
    const unsigned G = gridDim.x * gridDim.y * gridDim.z;
    unsigned sum, cnt, mine, sp = 0u;
    for (;;) {
        sum = 0u; cnt = 0u; mine = 0u;
#pragma unroll
        for (unsigned j = 0; j < 16; ++j) { const unsigned c = xb_ld(&bar[XB_XCNT(j)]); sum += c; cnt += (c > 0u) ? 1u : 0u; mine = (j == x) ? c : mine; }
        if (sum == G) break;
        __builtin_amdgcn_s_sleep(1);
        if ((++sp & 255u) == 0u) { if (xb_ld(&bar[XB_TMO])) break; if (sp > XB_SPIN_CAP) { atomicAdd(&bar[XB_TMO], 1u); break; } }
    }
    nloc = mine > 0u ? mine : 1u; nx = cnt > 0u ? cnt : 1u;
}
DI void xcd_barrier(const XcdBarrier& b) {
    ASMV("s_waitcnt vmcnt(0)" ::: "memory");
    __syncthreads();
    if (threadIdx.x == 0) {
        unsigned* bar = b.bar;
        __builtin_amdgcn_s_waitcnt(0);
        unsigned nloc = b.st[0], nx = b.st[1];
        if (nloc == 0u) { xcd_barrier_complete(bar, b.x, nloc, nx); b.st[0] = nloc; b.st[1] = nx; }
        const unsigned old = xb_add(&bar[XB_XSUB(b.x)], 1u);
        const unsigned gen = old / nloc;
        if (old + 1u == (gen + 1u) * nloc) {
            __builtin_amdgcn_fence(__ATOMIC_RELEASE, "agent");
            ASMV("s_waitcnt vmcnt(0)" ::: "memory");
            const unsigned og = xb_add(&bar[XB_TOP], 1u);
            const unsigned tg = og / nx;
            if (og + 1u == (tg + 1u) * nx) xb_add(&bar[XB_TOPGEN], 1u);
            else XB_SPIN(xb_ld(&bar[XB_TOPGEN]) == tg, bar);
            __builtin_amdgcn_fence(__ATOMIC_ACQUIRE, "agent");
            xb_add(&bar[XB_XGEN(b.x)], 1u);
            ASMV("s_waitcnt vmcnt(0)" ::: "memory");
        } else {
            XB_SPIN(xb_ld(&bar[XB_XGEN(b.x)]) == gen, bar);
            __builtin_amdgcn_fence(__ATOMIC_ACQUIRE, "agent");
            ASMV("s_waitcnt vmcnt(0)" ::: "memory");
        }
    }
    __syncthreads();
}

constexpr int BK = 64, HALF = 128, HTB = HALF * BK * 2, NXCD = 8, WGM = 8;
DI int lds_byte(int r, int c) { const int st = (r >> 4) * 2 + (c >> 5), rr = r & 15, cc = c & 31, ob = rr * 64 + cc * 2; return st * 1024 + (ob ^ (((ob >> 9) & 1) << 5)); }
DI void stage_rc(int b, int& R, int& C) { const int st = b / 1024, sb = b % 1024, swz = sb ^ (((sb >> 9) & 1) << 5); R = (st >> 1) * 16 + swz / 64; C = (st & 1) * 32 + (swz % 64) / 2; }
struct Unit { int pm, pn, z, kt0; };
struct Gemm { const bf16* A; const bf16* Bt; int lda, ldb, K; size_t zA, zB; };
struct Order {
    int nM, nN, nZ, per, total, G, c, nkt, pm0, spl;
    DI void init(int nM_, int nN_, int nZ_, int G_, int c_, int nkt_) { nM = nM_; nN = nN_; nZ = nZ_; per = nM * nN; total = per * nZ; G = G_; c = c_; nkt = nkt_; pm0 = 0; spl = 0; }
    DI void init_split(int pm0_, int xM, int nN_, int spl_, int G_, int c_, int nkt_full) { nM = xM; nN = nN_; nZ = 1; per = xM * nN_ * spl_; total = per; G = G_; c = c_; nkt = nkt_full / spl_; pm0 = pm0_; spl = spl_; }
    DI bool next(int i, Unit& u) const {
        const long L = (long)i * G + c; if (L >= total) return false;
        if (spl) { const int j = (int)L; u.z = 0; u.pm = pm0 + j / (nN * spl); const int rem = j % (nN * spl); u.pn = rem / spl; u.kt0 = (rem % spl) * nkt; return true; }
        u.kt0 = 0;
        u.z = (int)(L / per); int wgid = (int)(L % per);
        { const int q = per / NXCD, r = per % NXCD, xcd = wgid % NXCD, off = wgid / NXCD; wgid = (xcd < r ? xcd * (q + 1) : r * (q + 1) + (xcd - r) * q) + off; }
        const int nig = WGM * nN, gid = wgid / nig, fm = gid * WGM, gsz = (nM - fm) < WGM ? (nM - fm) : WGM;
        u.pm = fm + ((wgid % nig) % gsz); u.pn = (wgid % nig) / gsz; return true;
    }
};

template <class Epi>
DI void gemm_phase(LAS unsigned char* lds, const Gemm g, const Order& S, const Epi& E) {
    int tid_ = threadIdx.x; OPAQUE(tid_);
    const int tid = tid_, wid = __builtin_amdgcn_readfirstlane(tid >> 6), lane = tid & 63, wr = wid >> 2, wc = wid & 3, fr = lane & 15, fq = lane >> 4;
    Unit cur, nxt; int ui = 0;
    if (!S.next(0, cur)) return;
    f32x4 acc[2][2][4][2];
#ifdef EMU
    (void)lds;
    for (;; ++ui) {
        if (ui > 0) { if (!S.next(ui, cur)) break; }
        const bf16* A = (const bf16*)((const char*)g.A + cur.z * g.zA); const bf16* B = (const bf16*)((const char*)g.Bt + cur.z * g.zB);
        for (int ai = 0; ai < 2; ++ai) for (int bj = 0; bj < 2; ++bj) for (int m = 0; m < 4; ++m) for (int n = 0; n < 2; ++n) for (int j = 0; j < 4; ++j) {
            const int r = 256 * cur.pm + 128 * ai + 64 * wr + 16 * m + fr, c = 256 * cur.pn + 128 * bj + 32 * wc + 16 * n + 4 * fq + j;
            const bf16* a = A + (size_t)r * g.lda; const bf16* b = B + (size_t)c * g.ldb; float s = 0.f;
            for (int k = cur.kt0 * BK; k < (cur.kt0 + S.nkt) * BK; ++k) s += bf2f(a[k]) * bf2f(b[k]);
            acc[ai][bj][m][n][j] = s; }
        E(acc, cur, wr, wc, fr, fq);
    }
#else
    unsigned voffA[2], voffB[2];
#pragma unroll
    for (int i = 0; i < 2; ++i) { int R, C; stage_rc(tid * 16 + i * 8192, R, C); voffA[i] = (unsigned)(R * g.lda + C) * 2u; voffB[i] = (unsigned)(R * g.ldb + C) * 2u; }
    const size_t kstep = (size_t)(BK * 2);
    const size_t hstepA = (size_t)HALF * g.lda * 2, hstepB = (size_t)HALF * g.ldb * 2, tstepA = 2 * hstepA, tstepB = 2 * hstepB;
    const unsigned ldsw = (unsigned)wid * 1024u;
    const int aoff = lds_byte(wr * 64 + fr, fq * 8), boff = lds_byte(wc * 32 + fr, fq * 8);
#define PG8_SA(b, h) (((b) * 2 + (h)) * HTB)
#define PG8_SB(b, h) ((4 + (b) * 2 + (h)) * HTB)
#define PG8_STAGE(bufoff, gbase, voff) do { _Pragma("unroll") for (int _i = 0; _i < 2; ++_i) \
        __builtin_amdgcn_global_load_lds((const unsigned*)((const char*)(gbase) + (voff)[_i]), (LAS unsigned*)(lds + (bufoff) + ldsw + _i * 8192), 16, 0, 0); } while (0)
#define PG8_LDA(dst, b, h) do { _Pragma("unroll") for (int m = 0; m < 4; ++m) _Pragma("unroll") for (int k = 0; k < 2; ++k) dst[m][k] = *(const LAS bf16x8*)(lds + PG8_SA(b, h) + aoff + m * 2048 + k * 1024); } while (0)
#define PG8_LDB(dst, b, h) do { _Pragma("unroll") for (int n = 0; n < 2; ++n) _Pragma("unroll") for (int k = 0; k < 2; ++k) dst[n][k] = *(const LAS bf16x8*)(lds + PG8_SB(b, h) + boff + n * 2048 + k * 1024); } while (0)
#define PG8_MMA(ai, bj, At, Bt) do { __builtin_amdgcn_s_setprio(1); _Pragma("unroll") for (int m = 0; m < 4; ++m) _Pragma("unroll") for (int n = 0; n < 2; ++n) _Pragma("unroll") for (int k = 0; k < 2; ++k) \
        acc[ai][bj][m][n] = __builtin_amdgcn_mfma_f32_16x16x32_bf16(Bt[n][k], At[m][k], acc[ai][bj][m][n], 0, 0, 0); __builtin_amdgcn_s_setprio(0); } while (0)
#define PG8_WAIT_V(n) asm volatile("s_waitcnt vmcnt(" #n ")" ::: "memory")
#define PG8_WAIT_L(n) asm volatile("s_waitcnt lgkmcnt(" #n ")" ::: "memory")
#define PG8_BAR __builtin_amdgcn_s_barrier()
#define PG8_SCHED __builtin_amdgcn_sched_barrier(0)
#pragma unroll
    for (int a = 0; a < 2; ++a)
#pragma unroll
        for (int b = 0; b < 2; ++b)
#pragma unroll
            for (int m = 0; m < 4; ++m)
#pragma unroll
                for (int n = 0; n < 2; ++n) acc[a][b][m][n] = (f32x4){0.f, 0.f, 0.f, 0.f};
    bf16x8 At[4][2], B0[2][2], B1[2][2];
    const char* cA = (const char*)g.A + (size_t)cur.z * g.zA + (size_t)cur.pm * tstepA + (size_t)cur.kt0 * kstep; const char* cB = (const char*)g.Bt + (size_t)cur.z * g.zB + (size_t)cur.pn * tstepB + (size_t)cur.kt0 * kstep;
    PG8_STAGE(PG8_SB(0, 0), cB, voffB); PG8_STAGE(PG8_SB(0, 1), cB + hstepB, voffB); PG8_STAGE(PG8_SA(0, 0), cA, voffA); PG8_STAGE(PG8_SA(0, 1), cA + hstepA, voffA);
    if (wr == 1) PG8_BAR;
    PG8_WAIT_V(2); PG8_BAR;
    PG8_STAGE(PG8_SB(1, 0), cB + kstep, voffB); PG8_STAGE(PG8_SA(1, 0), cA + kstep, voffA); PG8_STAGE(PG8_SB(1, 1), cB + hstepB + kstep, voffB);
    PG8_WAIT_V(6); PG8_BAR;
    for (;;) {
        const bool has_next = S.next(ui + 1, nxt);
        const char* nA = has_next ? (const char*)g.A + (size_t)nxt.z * g.zA + (size_t)nxt.pm * tstepA + (size_t)nxt.kt0 * kstep : cA; const char* nB = has_next ? (const char*)g.Bt + (size_t)nxt.z * g.zB + (size_t)nxt.pn * tstepB + (size_t)nxt.kt0 * kstep : cB;
        const int nt = S.nkt;
        for (int t = 0; t < nt; t += 2) {
            const bool last = (t == nt - 2);
            const char* a1 = cA + (size_t)(t + 1) * kstep;
            const char* a2 = last ? nA : cA + (size_t)(t + 2) * kstep; const char* b2 = last ? nB : cB + (size_t)(t + 2) * kstep;
            const char* a3 = a2 + kstep; const char* b3 = b2 + kstep;
            PG8_LDB(B0, 0, 0); PG8_LDB(B1, 0, 1); PG8_SCHED; PG8_LDA(At, 0, 0); PG8_STAGE(PG8_SA(1, 1), a1 + hstepA, voffA);
            PG8_WAIT_V(8); PG8_WAIT_L(0); PG8_BAR; PG8_MMA(0, 0, At, B0); PG8_MMA(0, 1, At, B1); PG8_BAR; PG8_SCHED;
            PG8_LDA(At, 0, 1); PG8_STAGE(PG8_SB(0, 0), b2, voffB); PG8_STAGE(PG8_SB(0, 1), b2 + hstepB, voffB); PG8_STAGE(PG8_SA(0, 0), a2, voffA);
            PG8_WAIT_V(8); PG8_WAIT_L(0); PG8_BAR; PG8_MMA(1, 0, At, B0); PG8_MMA(1, 1, At, B1); PG8_BAR; PG8_SCHED;
            PG8_LDB(B0, 1, 0); PG8_LDB(B1, 1, 1); PG8_SCHED; PG8_LDA(At, 1, 0); PG8_STAGE(PG8_SA(0, 1), a2 + hstepA, voffA);
            PG8_WAIT_V(8); PG8_WAIT_L(0); PG8_BAR; PG8_MMA(0, 0, At, B0); PG8_MMA(0, 1, At, B1); PG8_BAR; PG8_SCHED;
            PG8_LDA(At, 1, 1); PG8_STAGE(PG8_SB(1, 0), b3, voffB); PG8_STAGE(PG8_SB(1, 1), b3 + hstepB, voffB); PG8_STAGE(PG8_SA(1, 0), a3, voffA);
            PG8_WAIT_V(8); PG8_WAIT_L(0); PG8_BAR; PG8_MMA(1, 0, At, B0); PG8_MMA(1, 1, At, B1); PG8_BAR; PG8_SCHED;
        }
        if (wr == 0) PG8_BAR;
        E(acc, cur, wr, wc, fr, fq);
        if (!has_next) break;
#pragma unroll
        for (int a = 0; a < 2; ++a)
#pragma unroll
            for (int b = 0; b < 2; ++b)
#pragma unroll
                for (int m = 0; m < 4; ++m)
#pragma unroll
                    for (int n = 0; n < 2; ++n) acc[a][b][m][n] = (f32x4){0.f, 0.f, 0.f, 0.f};
        cur = nxt; cA = nA; cB = nB; ++ui;
        if (wr == 1) PG8_BAR;
    }
    PG8_WAIT_V(0);
    PG8_BAR;
#undef PG8_SA
#undef PG8_SB
#undef PG8_STAGE
#undef PG8_LDA
#undef PG8_LDB
#undef PG8_MMA
#undef PG8_WAIT_V
#undef PG8_WAIT_L
#undef PG8_BAR
#undef PG8_SCHED
#endif
}

struct Args {
    const float* in[42]; float* out; unsigned char* ws;
    int ph_lo, ph_hi;
};
struct Ctx {
    const float* const* in; float* out; unsigned char* ws;
    LAS unsigned char* lds; int tid, lane, wave, G, bid;
};
DI float* xrow_ptr(const Ctx& C, int row) { return row < M_LAT ? C.out + (size_t)row * D : (float*)(C.ws + WS_XC) + (size_t)(row - M_LAT) * D; }
DI const bf16* wl(const Ctx& C, int l, size_t off) { return (const bf16*)(C.ws + WS_W + (size_t)l * SZ_WL + off); }
DI float* bias_ptr(const Ctx& C, int l, int which  ) { return (float*)(C.ws + WS_BIAS + (size_t)l * SZ_BIAS_L + (which == 0 ? 0 : which == 1 ? SZ_BIAS_GU : SZ_BIAS_GU + SZ_BIAS_IN)); }
DI float* rowss_ptr(const Ctx& C, int l, int sub) { return (float*)(C.ws + WS_ROWSS) + ((size_t)l * 3 + sub) * M; }
DI const float* gs_ptr(const Ctx& C, int l, int sub, int s) { return (const float*)(C.ws + WS_GS) + (((size_t)l * 3 + sub) * 3 + s) * D; }
DI const float* gate_ptr(const Ctx& C, int l, int sub, int s) { return (const float*)(C.ws + WS_GATE) + (((size_t)l * 3 + sub) * 3 + s) * D; }
DI float* rw_arr(const Ctx& C, int a) { return (float*)(C.ws + WS_RW + (size_t)a * SZ_RWA); }
enum { I_X = 0, I_C, I_CTX, I_CCTX, I_WADA, I_BADA, I_NORMG, I_F1WG, I_F1WU, I_F1WD, I_F2WG, I_F2WU, I_F2WD, I_WIN, I_WOUT, I_NAQG, I_NAKG, I_NARPB, I_RWCONV, I_RWW0, I_RWWUP, I_RWA0, I_RWAUP,
       I_RWGUP, I_RWKK, I_RWKA, I_RWRK, I_RWGNW, I_RWGNB, I_WAQG, I_WAKG, I_WASINK, I_S5ARE, I_S5AIM, I_S5LDT, I_S5BRE, I_S5BIM, I_S5CRE, I_S5CIM, I_S5D, I_S5GLUW, I_S5GLUB, I_NIN };

struct EpiGU {
    const float* rowss; const float* bias  ; bf16* H; int mrows;
    DI void operator()(const f32x4 (&acc)[2][2][4][2], const Unit& u, int wr, int wc, int fr_, int fq_) const {
        int tz_ = threadIdx.x; OPAQUE(tz_); const int fr = tz_ & 15, fq = (tz_ & 63) >> 4; (void)fr_; (void)fq_;
        const int s = stream_of_panel(u.pm); const float* bs = bias + (size_t)s * 2 * FF + u.pn * 256 + wc * 32 + 4 * fq;
        f32x4 bg[2], bu[2];
#pragma unroll
        for (int n = 0; n < 2; ++n) { bg[n] = *(const f32x4*)(bs + 16 * n); bu[n] = *(const f32x4*)(bs + 128 + 16 * n); }
#pragma unroll
        for (int ai = 0; ai < 2; ++ai)
#pragma unroll
            for (int m = 0; m < 4; ++m) {
                const int row = u.pm * 256 + ai * 128 + wr * 64 + m * 16 + fr;
                const float rstd = __builtin_amdgcn_rsqf(rowss[row] * (1.0f / D) + NORM_EPS);
                bf16* hp = H + (size_t)row * FF + u.pn * 128 + wc * 32 + 4 * fq;
#pragma unroll
                for (int n = 0; n < 2; ++n) { const f32x4 g = acc[ai][0][m][n] * rstd + bg[n], v = acc[ai][1][m][n] * rstd + bu[n];
                    u32x2 w; w.x = pk2(siluf(g[0]) * v[0], siluf(g[1]) * v[1]); w.y = pk2(siluf(g[2]) * v[2], siluf(g[3]) * v[3]);
                    *(u32x2*)(hp + 16 * n) = w; }
            }
    }
};
struct EpiRes {
    const Ctx* C; const float* gate  ; const float* gsn  ; float* rowss_next; bf16* AP;
    DI void operator()(const f32x4 (&acc)[2][2][4][2], const Unit& u, int wr, int wc, int fr_, int fq_) const {
        int tz_ = threadIdx.x; OPAQUE(tz_); const int fr = tz_ & 15, fq = (tz_ & 63) >> 4; (void)fr_; (void)fq_;
        const int s = stream_of_panel(u.pm); const int col0 = u.pn * 256 + wc * 32 + 4 * fq;
        f32x4 gv[2][2], sv[2][2];
#pragma unroll
        for (int bj = 0; bj < 2; ++bj)
#pragma unroll
            for (int n = 0; n < 2; ++n) { gv[bj][n] = *(const f32x4*)(gate + (size_t)s * D + col0 + bj * 128 + n * 16); sv[bj][n] = gsn ? *(const f32x4*)(gsn + (size_t)s * D + col0 + bj * 128 + n * 16) : (f32x4){0.f, 0.f, 0.f, 0.f}; }
#pragma unroll
        for (int ai = 0; ai < 2; ++ai)
#pragma unroll
            for (int m = 0; m < 4; ++m) {
                const int row = u.pm * 256 + ai * 128 + wr * 64 + m * 16 + fr;
                float* xp = xrow_ptr(*C, row) + col0; float ss = 0.f;
#pragma unroll
                for (int bj = 0; bj < 2; ++bj)
#pragma unroll
                    for (int n = 0; n < 2; ++n) { f32x4 x = *(const f32x4*)(xp + bj * 128 + n * 16); x += gv[bj][n] * acc[ai][bj][m][n]; *(f32x4*)(xp + bj * 128 + n * 16) = x;
                        if (gsn) { ss += (x[0] * x[0] + x[1] * x[1]) + (x[2] * x[2] + x[3] * x[3]); const f32x4 a = x * sv[bj][n]; u32x2 w; w.x = pk2(a[0], a[1]); w.y = pk2(a[2], a[3]);
                            *(u32x2*)(AP + (size_t)row * D + col0 + bj * 128 + n * 16) = w; } }
                if (gsn) { ss += __shfl_xor(ss, 16); ss += __shfl_xor(ss, 32); if (fq == 0) atomicAdd(rowss_next + row, ss); }
            }
    }
};
struct EpiAcc {
    const Ctx* C; const float* gate;
    DI void operator()(const f32x4 (&acc)[2][2][4][2], const Unit& u, int wr, int wc, int fr_, int fq_) const {
        int tz_ = threadIdx.x; OPAQUE(tz_); const int fr = tz_ & 15, fq = (tz_ & 63) >> 4; (void)fr_; (void)fq_;
        const int s = stream_of_panel(u.pm); const int col0 = u.pn * 256 + wc * 32 + 4 * fq;
#pragma unroll
        for (int bj = 0; bj < 2; ++bj)
#pragma unroll
            for (int n = 0; n < 2; ++n) { const f32x4 gv = *(const f32x4*)(gate + (size_t)s * D + col0 + bj * 128 + n * 16);
#pragma unroll
                for (int ai = 0; ai < 2; ++ai)
#pragma unroll
                    for (int m = 0; m < 4; ++m) { float* xp = xrow_ptr(*C, u.pm * 256 + ai * 128 + wr * 64 + m * 16 + fr) + col0 + bj * 128 + n * 16; const f32x4 d = gv * acc[ai][bj][m][n];
#pragma unroll
                        for (int j = 0; j < 4; ++j) atomicAdd(xp + j, d[j]); } }
    }
};
struct EpiIn {
    const Ctx* C; const float* rowss; const float* bias  ; int l;
    DI void operator()(const f32x4 (&acc)[2][2][4][2], const Unit& u, int wr, int wc, int fr_, int fq_) const {
        int tz_ = threadIdx.x; OPAQUE(tz_); const int fr = tz_ & 15, fq = (tz_ & 63) >> 4; (void)fr_; (void)fq_;
        const int s = stream_of_panel(u.pm), pn = u.pn; const float* bs = bias + (size_t)s * NINP + pn * 256 + wc * 32 + 4 * fq;
        unsigned char* ws = C->ws;
        f32x4 bv[2][2];
#pragma unroll
        for (int bj = 0; bj < 2; ++bj)
#pragma unroll
            for (int n = 0; n < 2; ++n) bv[bj][n] = *(const f32x4*)(bs + bj * 128 + n * 16);
        const bool permuted = pn < PN_AV || (pn >= PN_CQ && pn < PN_DU);
        if (permuted) {
            const bool is_ckv = pn == PN_CKV, is_c = pn >= PN_CQ, is_q = pn < PN_AK || (pn >= PN_CQ && pn < PN_CKV);
            const bool plain_v = is_ckv && wc >= 2;
            const float* gsrc = C->in[is_c ? (is_q ? I_WAQG : I_WAKG) : (is_q ? I_NAQG : I_NAKG)] + (size_t)l * 64;
            f32x4 gn[2][2];
#pragma unroll
            for (int bj = 0; bj < 2; ++bj)
#pragma unroll
                for (int n = 0; n < 2; ++n) { gn[bj][n] = *(const f32x4*)(gsrc + 32 * bj + 16 * n + 4 * fq); if (is_q) gn[bj][n] *= 0.125f; }
            bf16* dst; int pitch, hcol;
            if (pn < PN_AK) { dst = (bf16*)(ws + WS_QA); pitch = GW; hcol = ((pn - PN_AQ) * 4 + wc) * 64; }
            else if (pn < PN_AV) { dst = (bf16*)(ws + WS_KA); pitch = GW; hcol = ((pn - PN_AK) * 4 + wc) * 64; }
            else if (pn < PN_CKV) { dst = (bf16*)(ws + WS_QC); pitch = GW; hcol = ((pn - PN_CQ) * 4 + wc) * 64; }
            else if (wc < 2) { dst = (bf16*)(ws + WS_KC); pitch = 128; hcol = wc * 64; }
            else { dst = (bf16*)(ws + WS_VC); pitch = 128; hcol = (wc - 2) * 64; }
            const f32x4* rope = (const f32x4*)(ws + WS_ROPE);
#pragma unroll
            for (int ai = 0; ai < 2; ++ai)
#pragma unroll
                for (int m = 0; m < 4; ++m) {
                    const int row = pn * 0 + u.pm * 256 + ai * 128 + wr * 64 + m * 16 + fr;
                    const float rstd = __builtin_amdgcn_rsqf(rowss[row] * (1.0f / D) + NORM_EPS);
                    f32x4 v[2][2]; float ss = 0.f;
#pragma unroll
                    for (int bj = 0; bj < 2; ++bj)
#pragma unroll
                        for (int n = 0; n < 2; ++n) { v[bj][n] = acc[ai][bj][m][n] * rstd + bv[bj][n]; ss += (v[bj][n][0] * v[bj][n][0] + v[bj][n][1] * v[bj][n][1]) + (v[bj][n][2] * v[bj][n][2] + v[bj][n][3] * v[bj][n][3]); }
                    ss += __shfl_xor(ss, 16); ss += __shfl_xor(ss, 32);
                    if (!plain_v) { const float rs = 1.0f / sqrtf(ss * (1.0f / 64.0f) + NORM_EPS);
#pragma unroll
                        for (int bj = 0; bj < 2; ++bj)
#pragma unroll
                            for (int n = 0; n < 2; ++n) v[bj][n] = v[bj][n] * rs * gn[bj][n];
                        if (is_c && row < M_LAT) {
                            const int t = row % T; const int pos[2] = {t / GRW, t % GRW};
#pragma unroll
                            for (int bj = 0; bj < 2; ++bj) { const f32x4 cs0 = rope[(pos[bj] * 16 + 4 * fq) / 2], cs1 = rope[(pos[bj] * 16 + 4 * fq) / 2 + 1];
                                const float cc[4] = {cs0[0], cs0[2], cs1[0], cs1[2]}, sn[4] = {cs0[1], cs0[3], cs1[1], cs1[3]};
#pragma unroll
                                for (int j = 0; j < 4; ++j) { const float x1 = v[bj][0][j], x2 = v[bj][1][j]; v[bj][0][j] = x1 * cc[j] - x2 * sn[j]; v[bj][1][j] = x2 * cc[j] + x1 * sn[j]; } }
                        }
                    }
                    bf16* op = dst + (size_t)row * pitch + hcol + 4 * fq;
#pragma unroll
                    for (int bj = 0; bj < 2; ++bj)
#pragma unroll
                        for (int n = 0; n < 2; ++n) { u32x2 w; w.x = pk2(v[bj][n][0], v[bj][n][1]); w.y = pk2(v[bj][n][2], v[bj][n][3]); *(u32x2*)(op + 32 * bj + 16 * n) = w; }
                }
        } else {
#pragma unroll
            for (int ai = 0; ai < 2; ++ai)
#pragma unroll
                for (int m = 0; m < 4; ++m) {
                    const int row = u.pm * 256 + ai * 128 + wr * 64 + m * 16 + fr;
                    const float rstd = __builtin_amdgcn_rsqf(rowss[row] * (1.0f / D) + NORM_EPS);
#pragma unroll
                    for (int bj = 0; bj < 2; ++bj)
#pragma unroll
                        for (int n = 0; n < 2; ++n) { const f32x4 v = acc[ai][bj][m][n] * rstd + bv[bj][n]; const int c = bj * 128 + wc * 32 + n * 16 + 4 * fq;
                            u32x2 w; w.x = pk2(v[0], v[1]); w.y = pk2(v[2], v[3]);
                            if (pn < PN_BR) *(u32x2*)((bf16*)(ws + WS_VA) + (size_t)row * GW + (pn - PN_AV) * 256 + c) = w;
                            else if (pn < PN_BS) *(u32x2*)((bf16*)(ws + WS_PB) + (size_t)row * 3 * GW + (pn - PN_BR) * 256 + c) = w;
                            else if (pn == PN_BS) { if (c < 160) *(f32x4*)((float*)(ws + WS_PS) + (size_t)row * 160 + c) = v; }
                            else { const int cu = (pn - PN_DU) * 256 + c, gq = cu >> 4, p0 = cu & 15;
                                *(u32x2*)((bf16*)(ws + WS_UG) + ((size_t)gq * NCHP + row / S5L) * S5K + (row % S5L) * 16 + p0) = w; } }
                }
        }
    }
};
struct EpiS5A {
    float* XE;
    DI void operator()(const f32x4 (&acc)[2][2][4][2], const Unit& u, int wr, int wc, int fr_, int fq_) const {
        int tz_ = threadIdx.x; OPAQUE(tz_); const int fr = tz_ & 15, fq = (tz_ & 63) >> 4; (void)fr_; (void)fq_;
#pragma unroll
        for (int ai = 0; ai < 2; ++ai)
#pragma unroll
            for (int m = 0; m < 4; ++m) { const int ch = u.pm * 256 + ai * 128 + wr * 64 + m * 16 + fr; if (ch < NCH) { float* p = XE + ((size_t)u.z * NCHP + ch) * 256 + wc * 32 + 4 * fq;
#pragma unroll
                for (int bj = 0; bj < 2; ++bj)
#pragma unroll
                    for (int n = 0; n < 2; ++n) *(f32x4*)(p + bj * 128 + n * 16) = acc[ai][bj][m][n]; } }
    }
};
struct EpiS5C {
    const bf16* UG; const float* dsk  ; bf16* YG;
    DI void operator()(const f32x4 (&acc)[2][2][4][2], const Unit& u, int wr, int wc, int fr_, int fq_) const {
        int tz_ = threadIdx.x; OPAQUE(tz_); const int fr = tz_ & 15, fq = (tz_ & 63) >> 4; (void)fr_; (void)fq_;
        const int g = u.z;
#pragma unroll
        for (int ai = 0; ai < 2; ++ai)
#pragma unroll
            for (int m = 0; m < 4; ++m) { const int ch = u.pm * 256 + ai * 128 + wr * 64 + m * 16 + fr; if (ch < NCH) {
#pragma unroll
                for (int bj = 0; bj < 2; ++bj)
#pragma unroll
                    for (int n = 0; n < 2; ++n) { const int col = u.pn * 256 + bj * 128 + wc * 32 + n * 16 + 4 * fq, i = col >> 4, p0 = col & 15;
                        const u32x2 uw = *(const u32x2*)(UG + ((size_t)g * NCHP + ch) * S5K + col); const f32x4 dv = *(const f32x4*)(dsk + 16 * g + p0);
                        const f32x4 a = acc[ai][bj][m][n]; const float y0 = a[0] + dv[0] * bflo(uw.x), y1 = a[1] + dv[1] * bfhi(uw.x), y2 = a[2] + dv[2] * bflo(uw.y), y3 = a[3] + dv[3] * bfhi(uw.y);
                        u32x2 w; w.x = pk2(geluf(y0), geluf(y1)); w.y = pk2(geluf(y2), geluf(y3));
                        *(u32x2*)(YG + (size_t)(ch * S5L + i) * GW + 16 * g + p0) = w; } } }
    }
};
struct EpiGLU {
    const bf16* YG; const float* gb; bf16* OB;
    DI void operator()(const f32x4 (&acc)[2][2][4][2], const Unit& u, int wr, int wc, int fr_, int fq_) const {
        int tz_ = threadIdx.x; OPAQUE(tz_); const int fr = tz_ & 15, fq = (tz_ & 63) >> 4; (void)fr_; (void)fq_;
#pragma unroll
        for (int ai = 0; ai < 2; ++ai)
#pragma unroll
            for (int m = 0; m < 4; ++m) { const int row = u.pm * 256 + ai * 128 + wr * 64 + m * 16 + fr;
#pragma unroll
                for (int bj = 0; bj < 2; ++bj)
#pragma unroll
                    for (int n = 0; n < 2; ++n) { const int col = u.pn * 256 + bj * 128 + wc * 32 + n * 16 + 4 * fq; const f32x4 b = *(const f32x4*)(gb + col); const f32x4 a = acc[ai][bj][m][n] + b;
                        const u32x2 yw = *(const u32x2*)(YG + (size_t)row * GW + col);
                        u32x2 w; w.x = pk2(bflo(yw.x) * sigmf(a[0]), bfhi(yw.x) * sigmf(a[1])); w.y = pk2(bflo(yw.y) * sigmf(a[2]), bfhi(yw.y) * sigmf(a[3]));
                        *(u32x2*)(OB + (size_t)row * D + 3 * GW + col) = w; } }
    }
};

DI void ph_ada(const Ctx& C) {
    LAS float* sc = (LAS float*)C.lds;
    LAS float* red = sc + 3 * D;
    for (int i = C.tid; i < 3 * D; i += NTHR) { const int s = i / D, k = i % D; const float c = s < NB ? C.in[I_C][s * D + k] : C.in[I_CCTX][k]; sc[i] = siluf(c); }
    __syncthreads();
    const int nun = NL * (9 * D / 256);
    for (int un = C.bid; un < nun; un += C.G) {
        const int l = un / (9 * D / 256), col0 = (un % (9 * D / 256)) * 256;
        const float* W = C.in[I_WADA] + (size_t)l * D * 9 * D + col0 + 4 * C.lane;
        f32x4 a0 = {0.f, 0.f, 0.f, 0.f}, a1 = a0, a2 = a0;
        const int k0 = C.wave * (D / 8);
#pragma unroll 1
        for (int kb = k0; kb < k0 + D / 8; kb += 16) {
            f32x4 wv[16];
#pragma unroll
            for (int u = 0; u < 16; ++u) wv[u] = *(const f32x4*)(W + (size_t)(kb + u) * 9 * D);
#pragma unroll
            for (int u = 0; u < 16; ++u) { a0 += wv[u] * sc[kb + u]; a1 += wv[u] * sc[D + kb + u]; a2 += wv[u] * sc[2 * D + kb + u]; } }
        LAS float* r = red + C.wave * 768 + 4 * C.lane;
        *(LAS f32x4*)(r) = a0; *(LAS f32x4*)(r + 256) = a1; *(LAS f32x4*)(r + 512) = a2;
        __syncthreads();
        for (int i = C.tid; i < 768; i += NTHR) { float s = 0.f;
#pragma unroll
            for (int w = 0; w < 8; ++w) s += red[w * 768 + i];
            const int st = i / 256, c = col0 + (i % 256);
            ((float*)(C.ws + WS_MODV))[((size_t)l * 3 + st) * 9 * D + c] = s + C.in[I_BADA][(size_t)l * 9 * D + c]; }
        __syncthreads();
    }
}
DI const float* modv_ptr(const Ctx& C, int l, int s, int chunk) { return (const float*)(C.ws + WS_MODV) + ((size_t)l * 3 + s) * 9 * D + (size_t)chunk * D; }

DI int win_dest(int n) {
    if (n >= D_IN) return -1;
    if (n < SRC_AV) { const int piece = n / GW, loc = n % GW, head = loc / 64, d = loc % 64; return ((piece == 0 ? PN_AQ : PN_AK) + head / 4) * 256 + 128 * (d / 32) + 32 * (head % 4) + (d % 32); }
    if (n < SRC_BS) return PN_AV * 256 + (n - SRC_AV);
    if (n < SRC_CQ) return PN_BS * 256 + (n - SRC_BS);
    if (n < SRC_CK) { const int loc = n - SRC_CQ, head = loc / 64, d = loc % 64; return (PN_CQ + head / 4) * 256 + 128 * (d / 32) + 32 * (head % 4) + (d % 32); }
    if (n < SRC_DU) { const int loc = n - SRC_CK, hh = loc / 64, d = loc % 64; return PN_CKV * 256 + 128 * (d / 32) + 32 * hh + (d % 32); }
    return PN_DU * 256 + (n - SRC_DU);
}
DI void conv_item(const Ctx& C, const float* W, int K, int N, bf16* Wt, int mode, int k0, int n0, float* bias, int bias_pitch, const float* shift  ) {
    LAS float* scr = (LAS float*)(C.lds + C.wave * 16640);
    const int n = n0 + C.lane; const bool ok = n < N; float b0 = 0.f, b1 = 0.f, b2 = 0.f;
#pragma unroll 1
    for (int kh = 0; kh < 4; ++kh) {
        float wv[16];
#pragma unroll
        for (int kk = 0; kk < 16; ++kk) wv[kk] = ok ? W[(size_t)(k0 + 16 * kh + kk) * N + n] : 0.f;
#pragma unroll
        for (int kk = 0; kk < 16; ++kk) { const float v = wv[kk]; scr[(16 * kh + kk) * 65 + C.lane] = v;
            if (bias) { b0 += shift[k0 + 16 * kh + kk] * v; b1 += shift[9 * D + k0 + 16 * kh + kk] * v; b2 += shift[18 * D + k0 + 16 * kh + kk] * v; } } }
    WSYNC();
    const int dme = !ok ? -1 : mode == 0 ? n : mode == 1 ? (n / 128) * 256 + n % 128 : mode == 2 ? (n / 128) * 256 + 128 + n % 128 : win_dest(n);
    if (bias && dme >= 0) { atomicAdd(bias + dme, b0); atomicAdd(bias + bias_pitch + dme, b1); atomicAdd(bias + 2 * bias_pitch + dme, b2); }
    const int c = C.lane & 7;
#pragma unroll
    for (int i = 0; i < 8; ++i) { const int nl = (C.lane >> 3) + 8 * i, nn = n0 + nl;
        const int dr = nn >= N ? -1 : mode == 0 ? nn : mode == 1 ? (nn / 128) * 256 + nn % 128 : mode == 2 ? (nn / 128) * 256 + 128 + nn % 128 : win_dest(nn);
        const LAS float* s = scr + (8 * c) * 65 + nl;
        u32x4 o; o.x = pk2(s[0], s[65]); o.y = pk2(s[2 * 65], s[3 * 65]); o.z = pk2(s[4 * 65], s[5 * 65]); o.w = pk2(s[6 * 65], s[7 * 65]);
        if (dr >= 0) *(u32x4*)(Wt + (size_t)dr * K + k0 + 8 * c) = o; }
    WSYNC();
}
struct Cplx { float re, im; };
DI Cplx cmul(Cplx a, Cplx b) { return Cplx{a.re * b.re - a.im * b.im, a.re * b.im + a.im * b.re}; }
DI Cplx s5_lam_pow(const Ctx& C, int l, int dir, int g, int n, float tau) {
    const size_t i = (((size_t)l * 2 + dir) * S5G + g) * 64 + n; const float dt = __expf(C.in[I_S5LDT][((size_t)l * 2 + dir) * S5G + g]);
    const float mag = __expf(tau * dt * C.in[I_S5ARE][i]), ang = tau * dt * C.in[I_S5AIM][i]; float sn, cs; sincosf(ang, &sn, &cs); return Cplx{mag * cs, mag * sn};
}
DI Cplx s5_coef(const Ctx& C, int l, int dir, int g, int n) {
    const size_t i = (((size_t)l * 2 + dir) * S5G + g) * 64 + n; const float are = C.in[I_S5ARE][i], aim = C.in[I_S5AIM][i];
    const Cplx ab = s5_lam_pow(C, l, dir, g, n, 1.0f); const float den = are * are + aim * aim, nr = ab.re - 1.0f;
    return Cplx{(nr * are + ab.im * aim) / den, (ab.im * are - nr * aim) / den};
}
DI Cplx s5_beta(const Ctx& C, int l, int dir, int g, int n, int q) {
    const size_t i = (((size_t)l * S5G + g) * 64 + n) * 16 + q; return cmul(s5_coef(C, l, dir, g, n), Cplx{C.in[I_S5BRE][i], C.in[I_S5BIM][i]});
}
DI Cplx s5_gamma(const Ctx& C, int l, int g, int p, int n) { const size_t i = (((size_t)l * S5G + g) * 16 + p) * 64 + n; return Cplx{C.in[I_S5CRE][i], C.in[I_S5CIM][i]}; }

constexpr int CI_GU = (D / 64) * (FF / 64), CI_DN = (FF / 64) * (D / 64), CI_IN = (D / 64) * ((D_IN + 63) / 64), CI_OUT = (D / 64) * (D / 64), CI_GLU = (GW / 64) * (GW / 64);
constexpr int CI_LAYER = 4 * CI_GU + 2 * CI_DN + CI_IN + CI_OUT + CI_GLU;
DI void conv_weights(const Ctx& C, int l, int wslot, int nslots) {
    for (int it = wslot; it < CI_LAYER; it += nslots) {
        int r = it;
        unsigned char* wbase = C.ws + WS_W + (size_t)l * SZ_WL;
        if (r < 2 * CI_GU) { const int up = r >= CI_GU; r -= up * CI_GU; const int kb = r / (FF / 64), nb = r % (FF / 64);
            conv_item(C, C.in[up ? I_F1WU : I_F1WG] + (size_t)l * D * FF, D, FF, (bf16*)(wbase + OFF_W1GU), 1 + up, kb * 64, nb * 64, bias_ptr(C, l, 0), 2 * FF, modv_ptr(C, l, 0, 0)); continue; } r -= 2 * CI_GU;
        if (r < CI_DN) { const int kb = r / (D / 64), nb = r % (D / 64); conv_item(C, C.in[I_F1WD] + (size_t)l * FF * D, FF, D, (bf16*)(wbase + OFF_W1D), 0, kb * 64, nb * 64, nullptr, 0, nullptr); continue; } r -= CI_DN;
        if (r < CI_IN) { const int nbn = (D_IN + 63) / 64, kb = r / nbn, nb = r % nbn; conv_item(C, C.in[I_WIN] + (size_t)l * D * D_IN, D, D_IN, (bf16*)(wbase + OFF_WIN), 3, kb * 64, nb * 64, bias_ptr(C, l, 1), NINP, modv_ptr(C, l, 0, 3)); continue; } r -= CI_IN;
        if (r < CI_OUT) { const int kb = r / (D / 64), nb = r % (D / 64); conv_item(C, C.in[I_WOUT] + (size_t)l * D * D, D, D, (bf16*)(wbase + OFF_WOUT), 0, kb * 64, nb * 64, nullptr, 0, nullptr); continue; } r -= CI_OUT;
        if (r < 2 * CI_GU) { const int up = r >= CI_GU; r -= up * CI_GU; const int kb = r / (FF / 64), nb = r % (FF / 64);
            conv_item(C, C.in[up ? I_F2WU : I_F2WG] + (size_t)l * D * FF, D, FF, (bf16*)(wbase + OFF_W2GU), 1 + up, kb * 64, nb * 64, bias_ptr(C, l, 2), 2 * FF, modv_ptr(C, l, 0, 6)); continue; } r -= 2 * CI_GU;
        if (r < CI_DN) { const int kb = r / (D / 64), nb = r % (D / 64); conv_item(C, C.in[I_F2WD] + (size_t)l * FF * D, FF, D, (bf16*)(wbase + OFF_W2D), 0, kb * 64, nb * 64, nullptr, 0, nullptr); continue; } r -= CI_DN;
        { const int kb = r / (GW / 64), nb = r % (GW / 64); conv_item(C, C.in[I_S5GLUW] + (size_t)l * GW * GW, GW, GW, (bf16*)(wbase + OFF_WGLU), 0, kb * 64, nb * 64, nullptr, 0, nullptr); }
    }
}
DI void ph_conv(const Ctx& C) {
    const int gt = C.bid * NTHR + C.tid, GT = C.G * NTHR;
    for (int i = gt; i < NL * 9 * D; i += GT) { const int k = i % D, s = (i / D) % 3, sub = (i / (3 * D)) % 3, l = i / (9 * D);
        const float* mv = (const float*)(C.ws + WS_MODV) + ((size_t)l * 3 + s) * 9 * D;
        ((float*)(C.ws + WS_GS))[i] = C.in[I_NORMG][((size_t)l * 3 + sub) * D + k] * (1.0f + mv[(3 * sub + 1) * D + k]);
        ((float*)(C.ws + WS_GATE))[i] = mv[(3 * sub + 2) * D + k] * (sub == 1 ? 1.0f : 0.5f); }
    for (int i = gt; i < 128 * 16; i += GT) { const int pos = i / 16, f = i % 16; const float inv = __expf(-(float)f * (9.210340371976184f / 16.0f)); float sn, cs; sincosf((float)pos * inv, &sn, &cs);
        ((f32x2*)(C.ws + WS_ROPE))[i] = (f32x2){cs, sn}; }
    const int gw = C.bid * NW + C.wave, GWV = C.G * NW;
    conv_weights(C, 0, gw, GWV);
    for (int i = gt; i < NL * 14 * NH * 2 * 64 * 8; i += GT) {
        const int j = i & 7, ln = (i >> 3) & 63, tj = (i >> 9) & 1, hd = (i >> 10) % NH, f = (i / (1024 * NH)) % 14, l = i / (1024 * NH * 14);
        const int col = hd * 64 + 32 * tj + (ln & 31); float v;
        if (f < 8) { const int d = (f >> 1) & 1, sx = f & 1, k = 16 * sx + 8 * (ln >> 5) + j; v = C.in[f < 4 ? I_RWWUP : I_RWAUP][(((size_t)l * 2 + d) * 32 + k) * GW + col]; }
        else { const int k = 16 * (f - 8) + 8 * (ln >> 5) + j; v = C.in[I_RWGUP][((size_t)l * 96 + k) * GW + col]; }
        ((bf16*)(C.ws + WS_RWF))[i] = (bf16)f2bf(v); }
    LAS float* wsc = (LAS float*)(C.lds + C.wave * 16640);
    for (int it = gw; it < NL * S5G * 2 * S5L; it += GWV) {
        const int tau = it % S5L, dir = (it / S5L) % 2, g = (it / (2 * S5L)) % S5G, l = it / (2 * S5L * S5G);
        const Cplx z = cmul(s5_lam_pow(C, l, dir, g, C.lane, (float)tau), s5_coef(C, l, dir, g, C.lane));
#pragma unroll 4
        for (int q = 0; q < 16; ++q) { const size_t i = (((size_t)l * S5G + g) * 64 + C.lane) * 16 + q; const Cplx w = cmul(z, Cplx{C.in[I_S5BRE][i], C.in[I_S5BIM][i]}); wsc[(C.lane * 16 + q) * 2] = w.re; wsc[(C.lane * 16 + q) * 2 + 1] = w.im; }
        WSYNC();
        float* kc = (float*)(C.ws + WS_S5T + (size_t)l * SZ_S5L + OFF_S5KC) + (((size_t)g * 2 + dir) * S5L + tau) * 256;
#pragma unroll 1
        for (int e = 0; e < 4; ++e) { const int pq = C.lane + 64 * e, p = pq >> 4, q = pq & 15; float s = 0.f;
#pragma unroll 4
            for (int n = 0; n < 64; ++n) { const Cplx gm = s5_gamma(C, l, g, p, n); s += gm.re * wsc[(n * 16 + q) * 2] - gm.im * wsc[(n * 16 + q) * 2 + 1]; }
            kc[pq] = s; }
        WSYNC();
    }
    for (int i = gt; i < NL * 2 * GW * 4 * (S5L + 1); i += GT) { const int tau = i % (S5L + 1), r = i / (S5L + 1), n = r % 64, g = (r / 64) % S5G, dir = (r / (64 * S5G)) % 2, l = r / (2 * 64 * S5G);
        const Cplx z = s5_lam_pow(C, l, dir, g, n, (float)tau); ((f32x2*)(C.ws + WS_S5T + (size_t)l * SZ_S5L + OFF_S5LP))[((size_t)(dir * S5G + g) * 64 + n) * (S5L + 1) + tau] = (f32x2){z.re, z.im}; }
    for (int i = gt; i < NL * 2 * GW * 4 * 16; i += GT) { const int q = i % 16, r = i / 16, n = r % 64, g = (r / 64) % S5G, dir = (r / (64 * S5G)) % 2, l = r / (2 * 64 * S5G);
        const Cplx z = s5_beta(C, l, dir, g, n, q); ((f32x2*)(C.ws + WS_S5T + (size_t)l * SZ_S5L + OFF_S5BETA))[((size_t)(dir * S5G + g) * 64 + n) * 16 + q] = (f32x2){z.re, z.im}; }
    for (int i = gt; i < NL * 2 * GW * 4; i += GT) { const int n = i % 64, g = (i / 64) % S5G, dir = (i / (64 * S5G)) % 2, l = i / (2 * 64 * S5G); const Cplx z = s5_lam_pow(C, l, dir, g, n, (float)S5L);
        ((f32x2*)(C.ws + WS_S5T + (size_t)l * SZ_S5L + OFF_S5LAM))[(dir * S5G + g) * 64 + n] = (f32x2){z.re, z.im}; }
}
DI void ph_tab(const Ctx& C) {
    const long gt = (long)C.bid * NTHR + C.tid, GT = (long)C.G * NTHR;
    for (long i = gt; i < (long)NL * S5G * 256 * 512; i += GT) {
        const int k = (int)(i % 512), np = (int)((i / 512) % 256), g = (int)((i / (512 * 256)) % S5G), l = (int)(i / ((long)512 * 256 * S5G));
        const int j = k >> 4, q = k & 15, dir = np >> 7, n = np & 63, im = (np >> 6) & 1;
        const f32x2 lp = ((const f32x2*)(C.ws + WS_S5T + (size_t)l * SZ_S5L + OFF_S5LP))[((size_t)(dir * S5G + g) * 64 + n) * (S5L + 1) + (dir == 0 ? S5L - 1 - j : j)];
        const f32x2 be = ((const f32x2*)(C.ws + WS_S5T + (size_t)l * SZ_S5L + OFF_S5BETA))[((size_t)(dir * S5G + g) * 64 + n) * 16 + q];
        const Cplx w = cmul(Cplx{lp[0], lp[1]}, Cplx{be[0], be[1]});
        ((bf16*)(C.ws + WS_S5T + (size_t)l * SZ_S5L + OFF_S5ET))[((size_t)g * 256 + np) * 512 + k] = (bf16)f2bf(im ? w.im : w.re); }
    for (long i = gt; i < (long)NL * S5G * 512 * S5K; i += GT) {
        const int k = (int)(i % S5K), nn = (int)((i / S5K) % 512), g = (int)((i / ((long)S5K * 512)) % S5G), l = (int)(i / ((long)S5K * 512 * S5G));
        const int ti = nn >> 4, p = nn & 15; float v;
        if (k < 512) { const int j = k >> 4, q = k & 15; const float* kc = (const float*)(C.ws + WS_S5T + (size_t)l * SZ_S5L + OFF_S5KC) + (size_t)g * 2 * S5L * 256;
            v = 0.f; if (j <= ti) v += kc[((ti - j)) * 256 + p * 16 + q]; if (j >= ti) v += kc[(S5L + (j - ti)) * 256 + p * 16 + q]; }
        else { const int kk = k - 512, dir = kk >> 7, im = (kk >> 6) & 1, n = kk & 63;
            const f32x2 lp = ((const f32x2*)(C.ws + WS_S5T + (size_t)l * SZ_S5L + OFF_S5LP))[((size_t)(dir * S5G + g) * 64 + n) * (S5L + 1) + (dir == 0 ? ti + 1 : S5L - ti)];
            const Cplx w = cmul(s5_gamma(C, l, g, p, n), Cplx{lp[0], lp[1]}); v = im ? -w.im : w.re; }
        ((bf16*)(C.ws + WS_S5T + (size_t)l * SZ_S5L + OFF_S5BT))[((size_t)g * 512 + nn) * S5K + k] = (bf16)f2bf(v); }
    const int gw = C.bid * NW + C.wave, GWV = C.G * NW;
    for (int row = gw; row < M; row += GWV) {
        const float* src = row < M_LAT ? C.in[I_X] + (size_t)row * D : C.in[I_CTX] + (size_t)(row - M_LAT) * D;
        float* dst = xrow_ptr(C, row); const float* gs = gs_ptr(C, 0, 0, stream_of_row(row)); bf16* ap = (bf16*)(C.ws + WS_AP) + (size_t)row * D; float ss = 0.f;
        for (int c = 4 * C.lane; c < D; c += 256) { const f32x4 x = *(const f32x4*)(src + c); *(f32x4*)(dst + c) = x; ss += (x[0] * x[0] + x[1] * x[1]) + (x[2] * x[2] + x[3] * x[3]);
            const f32x4 a = x * *(const f32x4*)(gs + c); u32x2 w; w.x = pk2(a[0], a[1]); w.y = pk2(a[2], a[3]); *(u32x2*)(ap + c) = w; }
        ss = wave_sum(ss); if (C.lane == 0) rowss_ptr(C, 0, 0)[row] = ss;
    }
}

#ifdef EMU
DI s16x4 tr_read1(const LAS unsigned char* a) { return emu_tr_read(a); }
#else
DI s16x4 tr_read1(const LAS unsigned char* a) { s16x4 r; asm volatile("ds_read_b64_tr_b16 %0, %1\n\ts_waitcnt lgkmcnt(0)" : "=&v"(r) : "v"((unsigned)(size_t)a) : "memory"); return r; }
#endif
DI bf16x8 pack8(const f32x16& x, int s) {
    u32x4 p; p.x = pk2(x[8 * s], x[8 * s + 1]); p.y = pk2(x[8 * s + 2], x[8 * s + 3]); p.z = pk2(x[8 * s + 4], x[8 * s + 5]); p.w = pk2(x[8 * s + 6], x[8 * s + 7]);
    return __builtin_bit_cast(bf16x8, p);
}
struct AttnSt { f32x16 o0, o1; float m, l; };
template <bool MASKED>
DI void attn_block(AttnSt& st, const bf16x8 (&qf)[4], const bf16* Kb, int kp, const bf16* Vb, int vp, LAS unsigned char* vl, int lane, const float (&addv)[16], unsigned vmask) {
    const int r32 = lane & 31, h = lane >> 5;
#pragma unroll
    for (int i = 0; i < 4; ++i) { const int idx = lane + 64 * i, key = idx >> 3, ch = idx & 7; *(LAS u32x4*)(vl + key * 128 + ch * 16) = *(const u32x4*)(Vb + (size_t)key * vp + ch * 8); }
    f32x16 s;
#pragma unroll
    for (int i = 0; i < 16; ++i) s[i] = 0.f;
#pragma unroll
    for (int kk = 0; kk < 4; ++kk) { const bf16x8 kf = *(const bf16x8*)(Kb + (size_t)r32 * kp + 16 * kk + 8 * h); s = __builtin_amdgcn_mfma_f32_32x32x16_bf16(kf, qf[kk], s, 0, 0, 0); }
    float bm = -1e30f;
#pragma unroll
    for (int i = 0; i < 16; ++i) { if (MASKED) { s[i] += addv[i]; if ((vmask >> i) & 1u) bm = fmaxf(bm, s[i]); } else bm = fmaxf(bm, s[i]); }
    bm = fmaxf(bm, __shfl_xor(bm, 32));
    const float mn = fmaxf(st.m, bm), alpha = __expf(st.m - mn); st.m = mn;
    float ls = 0.f;
#pragma unroll
    for (int i = 0; i < 16; ++i) { float p = __expf(s[i] - mn); if (MASKED) p = ((vmask >> i) & 1u) ? p : 0.f; s[i] = p; ls += p; }
    st.l = st.l * alpha + ls;
#pragma unroll
    for (int i = 0; i < 16; ++i) { st.o0[i] *= alpha; st.o1[i] *= alpha; }
    WSYNC();
    const int q = (lane & 15) >> 2, p4 = lane & 3, blk = (lane >> 4) & 1;
#pragma unroll
    for (int sx = 0; sx < 2; ++sx) {
        const bf16x8 pf = pack8(s, sx);
#pragma unroll
        for (int dt = 0; dt < 2; ++dt) {
            const LAS unsigned char* a0 = vl + (16 * sx + 4 * h + q) * 128 + (32 * dt + 16 * blk) * 2 + 8 * p4;
            const s16x4 lo = tr_read1(a0), hi = tr_read1(a0 + 8 * 128);
            const bf16x8 vf = __builtin_shufflevector(lo, hi, 0, 1, 2, 3, 4, 5, 6, 7);
            if (dt == 0) st.o0 = __builtin_amdgcn_mfma_f32_32x32x16_bf16(vf, pf, st.o0, 0, 0, 0); else st.o1 = __builtin_amdgcn_mfma_f32_32x32x16_bf16(vf, pf, st.o1, 0, 0, 0);
        }
    }
}
DI void attn_finish(AttnSt& st, bf16* orow  , int lane, float extra_l) {
    const int h = lane >> 5; float l = st.l + __shfl_xor(st.l, 32) + extra_l; const float inv = 1.0f / l;
#pragma unroll
    for (int g = 0; g < 4; ++g) {
        u32x2 w0, w1; w0.x = pk2(st.o0[4 * g] * inv, st.o0[4 * g + 1] * inv); w0.y = pk2(st.o0[4 * g + 2] * inv, st.o0[4 * g + 3] * inv);
        w1.x = pk2(st.o1[4 * g] * inv, st.o1[4 * g + 1] * inv); w1.y = pk2(st.o1[4 * g + 2] * inv, st.o1[4 * g + 3] * inv);
        *(u32x2*)(orow + 8 * g + 4 * h) = w0; *(u32x2*)(orow + 32 + 8 * g + 4 * h) = w1; }
}
DI int clampi(int v, int lo, int hi) { return v < lo ? lo : (v > hi ? hi : v); }
constexpr int AT_NA = NB * NH * (GRH / 2) * 4, AT_WA = NB * NH * (T / 32), AT_CX = NB * NH * (TC / 32);
DI void ph_attn(const Ctx& C, int l, bool want_ctx, int first_block) {
    if (C.bid < first_block) return;
    const int gw = (C.bid - first_block) * NW + C.wave, GWV = (C.G - first_block) * NW, lane = C.lane, r32 = lane & 31, h = lane >> 5;
    LAS unsigned char* vl = C.lds + C.wave * 4096;
    const bf16* QA = (const bf16*)(C.ws + WS_QA); const bf16* KA = (const bf16*)(C.ws + WS_KA); const bf16* VA = (const bf16*)(C.ws + WS_VA);
    const bf16* QC = (const bf16*)(C.ws + WS_QC); const bf16* KC = (const bf16*)(C.ws + WS_KC); const bf16* VC = (const bf16*)(C.ws + WS_VC);
    bf16* OB = (bf16*)(C.ws + WS_OB);
    const int ntiles = AT_NA + AT_WA + (want_ctx ? 2 * AT_CX : 0);
    const float zero16[16] = {0.f, 0.f, 0.f, 0.f, 0.f, 0.f, 0.f, 0.f, 0.f, 0.f, 0.f, 0.f, 0.f, 0.f, 0.f, 0.f};
    for (int tile = gw; tile < ntiles; tile += GWV) {
        AttnSt st; st.m = -1e30f; st.l = 0.f;
#pragma unroll
        for (int i = 0; i < 16; ++i) { st.o0[i] = 0.f; st.o1[i] = 0.f; }
        bf16x8 qf[4];
        if (tile < AT_NA) {
            const int cb = tile & 3, rp = (tile >> 2) % (GRH / 2), hd = (tile / (4 * (GRH / 2))) % NH, b = tile / (4 * (GRH / 2) * NH);
            const int r0 = 2 * rp, c0 = 16 * cb, qr = r0 + (r32 >> 4), qc = c0 + (r32 & 15), qrow = b * T + qr * GRW + qc;
#pragma unroll
            for (int kk = 0; kk < 4; ++kk) qf[kk] = *(const bf16x8*)(QA + (size_t)qrow * GW + hd * 64 + 16 * kk + 8 * h);
            const int rsq = clampi(qr - 4, 0, GRH - 8), csq = clampi(qc - 8, 0, GRW - 16);
            const int rsA = clampi(r0 - 4, 0, GRH - 8), rsB = clampi(r0 + 1 - 4, 0, GRH - 8), kc0 = clampi(c0 - 8, 0, GRW - 32);
            const float* rpb = C.in[I_NARPB] + ((size_t)l * NH + hd) * 465;
            for (int kr = rsA; kr <= rsB + 7; ++kr) {
                float addv[16]; unsigned vm = 0u; const bool rok = kr >= rsq && kr <= rsq + 7;
#pragma unroll
                for (int i = 0; i < 16; ++i) { const int kb = (i & 3) + 8 * (i >> 2) + 4 * h, kc = kc0 + kb; const bool ok = rok && kc >= csq && kc <= csq + 15;
                    const int bi = ok ? (kr - qr + 7) * 31 + (kc - qc + 15) : 0; addv[i] = rpb[bi]; vm |= ok ? (1u << i) : 0u; }
                const size_t krow = (size_t)b * T + kr * GRW + kc0;
                attn_block<true>(st, qf, KA + krow * GW + hd * 64, GW, VA + krow * GW + hd * 64, GW, vl, lane, addv, vm);
            }
            for (int cbk = 0; cbk < TC / 32; ++cbk) { const size_t krow = (size_t)M_LAT + b * TC + 32 * cbk;
                attn_block<false>(st, qf, KA + krow * GW + hd * 64, GW, VA + krow * GW + hd * 64, GW, vl, lane, zero16, 0xffffu); }
            attn_finish(st, OB + (size_t)qrow * D + hd * 64, lane, 0.f);
        } else if (tile < AT_NA + AT_WA) {
            const int t2 = tile - AT_NA, qb = t2 % (T / 32), hd = (t2 / (T / 32)) % NH, b = t2 / ((T / 32) * NH), kvh = hd / WAG;
            const int qt = 32 * qb + r32, qrow = b * T + qt;
#pragma unroll
            for (int kk = 0; kk < 4; ++kk) qf[kk] = *(const bf16x8*)(QC + (size_t)qrow * GW + hd * 64 + 16 * kk + 8 * h);
            for (int i9 = 0; i9 < 9; ++i9) { const int t0 = 32 * qb - 128 + 32 * i9; if (t0 < 0 || t0 >= T) continue;
                float addv[16]; unsigned vm = 0u;
#pragma unroll
                for (int i = 0; i < 16; ++i) { const int kt = t0 + (i & 3) + 8 * (i >> 2) + 4 * h, rel = kt - qt; addv[i] = 0.f; vm |= (rel >= -128 && rel <= 128) ? (1u << i) : 0u; }
                const size_t krow = (size_t)b * T + t0;
                attn_block<true>(st, qf, KC + krow * 128 + kvh * 64, 128, VC + krow * 128 + kvh * 64, 128, vl, lane, addv, vm); }
            for (int cbk = 0; cbk < TC / 32; ++cbk) { const size_t krow = (size_t)M_LAT + b * TC + 32 * cbk;
                attn_block<false>(st, qf, KC + krow * 128 + kvh * 64, 128, VC + krow * 128 + kvh * 64, 128, vl, lane, zero16, 0xffffu); }
            const float sk = C.in[I_WASINK][(size_t)l * NH + hd];
            const float mfin = fmaxf(st.m, sk), a2 = __expf(st.m - mfin);
#pragma unroll
            for (int i = 0; i < 16; ++i) { st.o0[i] *= a2; st.o1[i] *= a2; }
            st.l *= a2; st.m = mfin;
            attn_finish(st, OB + (size_t)qrow * D + 2 * GW + hd * 64, lane, __expf(sk - mfin));
        } else {
            const int t2 = tile - AT_NA - AT_WA, isc = t2 >= AT_CX, t3 = t2 - isc * AT_CX, qb = t3 % (TC / 32), hd = (t3 / (TC / 32)) % NH, b = t3 / ((TC / 32) * NH), kvh = hd / WAG;
            const int qrow = M_LAT + b * TC + 32 * qb + r32;
            const bf16* Qs = isc ? QC : QA; const bf16* Ks = isc ? KC + kvh * 64 : KA + hd * 64; const bf16* Vs = isc ? VC + kvh * 64 : VA + hd * 64; const int kp = isc ? 128 : GW;
#pragma unroll
            for (int kk = 0; kk < 4; ++kk) qf[kk] = *(const bf16x8*)(Qs + (size_t)qrow * GW + hd * 64 + 16 * kk + 8 * h);
            for (int cbk = 0; cbk < TC / 32; ++cbk) { const size_t krow = (size_t)M_LAT + b * TC + 32 * cbk;
                attn_block<false>(st, qf, Ks + krow * kp, kp, Vs + krow * kp, kp, vl, lane, zero16, 0xffffu); }
            float extra = 0.f;
            if (isc) { const float sk = C.in[I_WASINK][(size_t)l * NH + hd]; const float mfin = fmaxf(st.m, sk), a2 = __expf(st.m - mfin);
#pragma unroll
                for (int i = 0; i < 16; ++i) { st.o0[i] *= a2; st.o1[i] *= a2; }
                st.l *= a2; st.m = mfin; extra = __expf(sk - mfin); }
            attn_finish(st, OB + (size_t)qrow * D + (isc ? 2 * GW : 0) + hd * 64, lane, extra);
        }
    }
}

DI void ph_ctxfix(const Ctx& C, const float* gsn  , float* rowss_next) {
    const int gw = C.bid * NW + C.wave, GWV = C.G * NW;
    for (int r = gw; r < M_CTX; r += GWV) { const int row = M_LAT + r; const float* xp = xrow_ptr(C, row); const float* gs = gsn + (size_t)NB * D; bf16* ap = (bf16*)(C.ws + WS_AP) + (size_t)row * D; float ss = 0.f;
        for (int c = 4 * C.lane; c < D; c += 256) { const f32x4 x = *(const f32x4*)(xp + c); ss += (x[0] * x[0] + x[1] * x[1]) + (x[2] * x[2] + x[3] * x[3]);
            const f32x4 a = x * *(const f32x4*)(gs + c); u32x2 w; w.x = pk2(a[0], a[1]); w.y = pk2(a[2], a[3]); *(u32x2*)(ap + c) = w; }
        ss = wave_sum(ss); if (C.lane == 0) rowss_next[row] = ss; }
}
DI void ph_rwprep(const Ctx& C, int l) {
    LAS float* sm = (LAS float*)C.lds;
    const int c = C.tid; const bool act = c < GW;
    const bf16* PB = (const bf16*)(C.ws + WS_PB); const float* PS = (const float*)(C.ws + WS_PS);
    const float* cw = C.in[I_RWCONV] + (size_t)l * 9 * GW;
    float cwv[3][3];
    if (act) {
#pragma unroll
        for (int j = 0; j < 3; ++j)
#pragma unroll
            for (int x = 0; x < 3; ++x) cwv[j][x] = cw[(size_t)j * 3 * GW + x * GW + c]; }
    const float w00 = act ? C.in[I_RWW0][((size_t)l * 2 + 0) * GW + c] : 0.f, w01 = act ? C.in[I_RWW0][((size_t)l * 2 + 1) * GW + c] : 0.f;
    const float a00 = act ? C.in[I_RWA0][((size_t)l * 2 + 0) * GW + c] : 0.f, a01 = act ? C.in[I_RWA0][((size_t)l * 2 + 1) * GW + c] : 0.f;
    const float kkw = act ? C.in[I_RWKK][(size_t)l * GW + c] : 0.f, kaw = act ? C.in[I_RWKA][(size_t)l * GW + c] : 0.f;
    const float* wup = C.in[I_RWWUP] + (size_t)l * 2 * 32 * GW; const float* aup = C.in[I_RWAUP] + (size_t)l * 2 * 32 * GW; const float* gup = C.in[I_RWGUP] + (size_t)l * 96 * GW;
    for (int it = C.bid; it < M / 16; it += C.G) {
        const int row0 = it * 16;
        const int seq_lo = row0 < M_LAT ? (row0 / T) * T : M_LAT + ((row0 - M_LAT) / TC) * TC, seq_hi = row0 < M_LAT ? seq_lo + T : seq_lo + TC;
        __syncthreads();
        for (int i = C.tid; i < 16 * 160; i += NTHR) { const int t = i / 160, k = i % 160; const float v = PS[(size_t)(row0 + t) * 160 + k]; sm[i] = k < 32 ? tanhf(v) : (k < 64 ? v : sigmf(v)); }
        __syncthreads();
        if (act) {
            float aw0[16], aw1[16], aa0[16], aa1[16], ag[16];
#pragma unroll
            for (int t = 0; t < 16; ++t) { aw0[t] = 0.f; aw1[t] = 0.f; aa0[t] = 0.f; aa1[t] = 0.f; ag[t] = 0.f; }
            for (int k = 0; k < 32; ++k) { const float u0 = wup[(size_t)k * GW + c], u1 = wup[(size_t)(32 + k) * GW + c], v0 = aup[(size_t)k * GW + c], v1 = aup[(size_t)(32 + k) * GW + c];
#pragma unroll
                for (int t = 0; t < 16; ++t) { const float dw = sm[t * 160 + k], da = sm[t * 160 + 32 + k]; aw0[t] += dw * u0; aw1[t] += dw * u1; aa0[t] += da * v0; aa1[t] += da * v1; } }
            for (int k = 0; k < 96; ++k) { const float gv = gup[(size_t)k * GW + c];
#pragma unroll
                for (int t = 0; t < 16; ++t) ag[t] += sm[t * 160 + 64 + k] * gv; }
            float pr[3], cu[3], nx[3];
#pragma unroll
            for (int x = 0; x < 3; ++x) { pr[x] = row0 - 1 >= seq_lo ? bf2f(PB[(size_t)(row0 - 1) * 3 * GW + x * GW + c]) : 0.f; cu[x] = bf2f(PB[(size_t)row0 * 3 * GW + x * GW + c]); }
#pragma unroll
            for (int t = 0; t < 16; ++t) { const int row = row0 + t;
#pragma unroll
                for (int x = 0; x < 3; ++x) nx[x] = row + 1 < seq_hi ? bf2f(PB[(size_t)(row + 1) * 3 * GW + x * GW + c]) : 0.f;
                const float r = pr[0] * cwv[0][0] + cu[0] * cwv[1][0] + nx[0] * cwv[2][0], kf = pr[1] * cwv[0][1] + cu[1] * cwv[1][1] + nx[1] * cwv[2][1], v = pr[2] * cwv[0][2] + cu[2] * cwv[1][2] + nx[2] * cwv[2][2];
#pragma unroll
                for (int x = 0; x < 3; ++x) { pr[x] = cu[x]; cu[x] = nx[x]; }
                const float kkv = kf * kkw, ssq = wave_sum(kkv * kkv), kk = kkv / fmaxf(sqrtf(ssq), 1e-12f);
                const size_t o = (size_t)row * GW + c;
                rw_arr(C, RW_R)[o] = r; rw_arr(C, RW_V)[o] = v; rw_arr(C, RW_NKK)[o] = -kk; rw_arr(C, RW_G)[o] = ag[t];
                { const float z = -(w00 + aw0[t]), sp = z > 20.f ? z : log1pf(__expf(z)), wlog = -sp - 0.5f, a = sigmf(a00 + aa0[t]);
                  rw_arr(C, RW_W0)[o] = __expf(-__expf(wlog)); rw_arr(C, RW_K0)[o] = kf * (1.f + (a - 1.f) * kaw); rw_arr(C, RW_B0)[o] = kk * a; }
                { const float z = -(w01 + aw1[t]), sp = z > 20.f ? z : log1pf(__expf(z)), wlog = -sp - 0.5f, a = sigmf(a01 + aa1[t]);
                  rw_arr(C, RW_W1)[o] = __expf(-__expf(wlog)); rw_arr(C, RW_K1)[o] = kf * (1.f + (a - 1.f) * kaw); rw_arr(C, RW_B1)[o] = kk * a; }
            }
        }
    }
    __syncthreads();
}
template <int N> DI float ror_add(float v) { return v + __int_as_float(__builtin_amdgcn_mov_dpp(__float_as_int(v), 0x120 + N, 0xf, 0xf, true)); }
DI float row16_sum(float v) { v = ror_add<8>(v); v = ror_add<4>(v); v = ror_add<2>(v); v = ror_add<1>(v); return v; }
DI void ph_rwscan(const Ctx& C) {
    if (C.wave >= 4) return;
    const int lane = C.lane, sub = lane & 15, vr = lane >> 4;
    const int nitems = NB * NH * 2 * 16;
    for (int it = C.bid * 4 + C.wave; it < nitems; it += C.G * 4) {
        const int rg = it & 15, dir = (it >> 4) & 1, hd = (it >> 5) % NH, b = it / (32 * NH);
        const int col = hd * 64 + 4 * sub, vcol = hd * 64 + 4 * rg + vr;
        const float* Wd = rw_arr(C, dir ? RW_W1 : RW_W0); const float* Kd = rw_arr(C, dir ? RW_K1 : RW_K0); const float* Bd = rw_arr(C, dir ? RW_B1 : RW_B0);
        const float* Rr = rw_arr(C, RW_R); const float* Vv = rw_arr(C, RW_V); const float* Nk = rw_arr(C, RW_NKK); float* Y = rw_arr(C, dir ? RW_Y1 : RW_Y0);
        f32x4 s = {0.f, 0.f, 0.f, 0.f};
        for (int seg = 0; seg < 2; ++seg) {
            const int base = seg == 0 ? M_LAT + b * TC : b * T, len = seg == 0 ? TC : T;
            for (int i0 = 0; i0 < len; i0 += 4) {
                f32x4 nk[4], w4[4], b4[4], k4[4], r4[4]; float vv[4]; int rows[4];
#pragma unroll
                for (int u = 0; u < 4; ++u) { const int i = i0 + u, row = base + (dir ? len - 1 - i : i); rows[u] = row; const size_t o = (size_t)row * GW + col;
                    nk[u] = *(const f32x4*)(Nk + o); w4[u] = *(const f32x4*)(Wd + o); b4[u] = *(const f32x4*)(Bd + o); k4[u] = *(const f32x4*)(Kd + o); r4[u] = *(const f32x4*)(Rr + o); vv[u] = Vv[(size_t)row * GW + vcol]; }
#pragma unroll
                for (int u = 0; u < 4; ++u) {
                    const f32x4 p = s * nk[u]; const float sa = row16_sum((p[0] + p[1]) + (p[2] + p[3]));
                    s = s * w4[u] + b4[u] * sa + k4[u] * vv[u];
                    const f32x4 yq = s * r4[u]; const float y = row16_sum((yq[0] + yq[1]) + (yq[2] + yq[3]));
                    if (sub == 0) Y[(size_t)rows[u] * GW + vcol] = y;
                }
            }
        }
    }
}
DI void ph_rwout(const Ctx& C, int l, int mrows) {
    const int gw = C.bid * NW + C.wave, GWV = C.G * NW, lane = C.lane;
    bf16* OB = (bf16*)(C.ws + WS_OB);
    for (int it = gw; it < mrows * NH; it += GWV) {
        const int hd = it % NH, row = it / NH, c = hd * 64 + lane; const size_t o = (size_t)row * GW + c;
        const float r = rw_arr(C, RW_R)[o], v = rw_arr(C, RW_V)[o], ks = rw_arr(C, RW_K0)[o] + rw_arr(C, RW_K1)[o];
        float y = rw_arr(C, RW_Y0)[o] + rw_arr(C, RW_Y1)[o];
        y += wave_sum(r * ks * C.in[I_RWRK][((size_t)l * NH + hd) * 64 + lane]) * v;
        const float mu = wave_sum(y) * (1.f / 64.f), dlt = y - mu, var = wave_sum(dlt * dlt) * (1.f / 64.f);
        const float yn = dlt / sqrtf(var + RW_GN_EPS);
        const float ov = (yn * C.in[I_RWGNW][(size_t)l * GW + c] + C.in[I_RWGNB][(size_t)l * GW + c]) * rw_arr(C, RW_G)[o];
        OB[(size_t)row * D + GW + c] = (bf16)f2bf(ov);
    }
}
constexpr int PT = 144;
constexpr int RW_HALF = 73472, IM_BT = 0, IM_KT = 9216, IM_RT = 18432, IM_ARB = 27648, IM_AT = 36864, IM_AAK = 46080, IM_F = 55296, IM_GC = 72704, FP = 68;
DI void chunk_rows(int b, int dir, int c, int& row0, int& step) {
    if (c < TC / 64) { const int p0 = 64 * c; row0 = M_LAT + b * TC + (dir ? TC - 1 - p0 : p0); } else { const int p0 = 64 * (c - TC / 64); row0 = b * T + (dir ? T - 1 - p0 : p0); }
    step = dir ? -1 : 1;
}
DI bf16x8 frag_rows(const LAS unsigned char* img, int tile, int s, int lane) { return *(const LAS bf16x8*)(img + (32 * tile + (lane & 31)) * PT + (16 * s + 8 * (lane >> 5)) * 2); }
DI bf16x8 frag_cols(const LAS unsigned char* img, int tile, int s, int lane) {
    const int h = lane >> 5, q = (lane & 15) >> 2, p4 = lane & 3, blk = (lane >> 4) & 1;
    const LAS unsigned char* a0 = img + (16 * s + 8 * h + q) * PT + (32 * tile + 16 * blk) * 2 + 8 * p4;
    const s16x4 lo = tr_read1(a0), hi = tr_read1(a0 + 4 * PT);
    return __builtin_shufflevector(lo, hi, 0, 1, 2, 3, 4, 5, 6, 7);
}
DI void store_T(const f32x16& acc, LAS unsigned char* img, int ti, int tj, int lane) {
    const int c = lane & 31, h = lane >> 5;
#pragma unroll
    for (int g = 0; g < 4; ++g) { u32x2 w; w.x = pk2(acc[4 * g], acc[4 * g + 1]); w.y = pk2(acc[4 * g + 2], acc[4 * g + 3]); *(LAS u32x2*)(img + (32 * tj + c) * PT + (32 * ti + 8 * g + 4 * h) * 2) = w; }
}
DI f32x16 zero16v() { f32x16 z;
#pragma unroll
    for (int i = 0; i < 16; ++i) z[i] = 0.f; return z; }
#define MMA32(a, b, c) __builtin_amdgcn_mfma_f32_32x32x16_bf16((a), (b), (c), 0, 0, 0)
constexpr int PDW = 80, PDG = 208, IM_TW = 0, IM_TA = 17408, IM_DW = 36864, IM_DA = 41984, IM_DG = 47104;
DI void ph_rw1(const Ctx& C, int l) {
    const int wg = C.wave & 3, grp = C.wave >> 2, ti = wg >> 1, tj = wg & 1;
    bf16* QH = (bf16*)(C.ws + WS_QH); float* YL = (float*)(C.ws + WS_YL); bf16* MF = (bf16*)(C.ws + WS_MF); float* GF = (float*)(C.ws + WS_GF); bf16* RVKG = (bf16*)(C.ws + WS_RVKG);
    const bf16* PB = (const bf16*)(C.ws + WS_PB); const float* PS = (const float*)(C.ws + WS_PS);
    const bf16x8* RWF = (const bf16x8*)(C.ws + WS_RWF + (size_t)l * SZ_RWF);
    constexpr int nblk = (TC + T) / 64;
    for (int it0 = 2 * C.bid; it0 < RBLK; it0 += 2 * C.G) {
        int lane_ = C.lane; OPAQUE(lane_); const int lane = lane_, c32 = lane & 31, h = lane >> 5;
        LAS unsigned char* L = OPAQUE_LDS(C.lds + grp * RW_HALF);
        LAS float* F = (LAS float*)(L + IM_F); LAS float* SEG = (LAS float*)(L + IM_F); LAS float* GC = (LAS float*)(L + IM_GC);
        LAS float* TW = (LAS float*)(L + IM_TW); LAS float* TA = (LAS float*)(L + IM_TA);
        unsigned char* PK = C.ws + WS_RWS + ((size_t)C.bid * 2 + grp) * 65536;
        const int item = it0 + grp; const bool live = item < RBLK; const int itc = live ? item : RBLK - 1;
        const int tb = itc % nblk, hd = (itc / nblk) % NH, b = itc / (nblk * NH), cg = hd * 64 + lane;
        const int rowb = tb < TC / 64 ? M_LAT + b * TC + 64 * tb : b * T + 64 * (tb - TC / 64);
        const int seq_lo = tb < TC / 64 ? M_LAT + b * TC : b * T, seq_hi = seq_lo + (tb < TC / 64 ? TC : T);
        bf16* RV = RVKG + (size_t)itc * 4 * 4096;
        __syncthreads();
        float r_[16], kf_[16], kk_[16], ks_[16];
        { const float* cw = C.in[I_RWCONV] + (size_t)l * 9 * GW; float cwv[3][3];
#pragma unroll
          for (int j = 0; j < 3; ++j)
#pragma unroll
              for (int x = 0; x < 3; ++x) cwv[j][x] = cw[(size_t)j * 3 * GW + x * GW + cg];
          const float kkw = C.in[I_RWKK][(size_t)l * GW + cg];
          const int r0 = rowb + 16 * wg; float pr[3], cu[3], nx[3];
#pragma unroll
          for (int x = 0; x < 3; ++x) { pr[x] = r0 - 1 >= seq_lo ? bf2f(PB[(size_t)(r0 - 1) * 3 * GW + x * GW + cg]) : 0.f; cu[x] = bf2f(PB[(size_t)r0 * 3 * GW + x * GW + cg]); }
#pragma unroll
          for (int t = 0; t < 16; ++t) { const int row = r0 + t;
#pragma unroll
              for (int x = 0; x < 3; ++x) nx[x] = row + 1 < seq_hi ? bf2f(PB[(size_t)(row + 1) * 3 * GW + x * GW + cg]) : 0.f;
              r_[t] = pr[0] * cwv[0][0] + cu[0] * cwv[1][0] + nx[0] * cwv[2][0]; kf_[t] = pr[1] * cwv[0][1] + cu[1] * cwv[1][1] + nx[1] * cwv[2][1]; const float v_t = pr[2] * cwv[0][2] + cu[2] * cwv[1][2] + nx[2] * cwv[2][2];
#pragma unroll
              for (int x = 0; x < 3; ++x) { pr[x] = cu[x]; cu[x] = nx[x]; }
              const float kkv = kf_[t] * kkw, ssq = wave_sum(kkv * kkv); kk_[t] = kkv / fmaxf(sqrtf(ssq), 1e-12f); ks_[t] = 0.f;
              RV[(16 * wg + t) * 64 + lane] = (bf16)f2bf(r_[t]); RV[4096 + (16 * wg + t) * 64 + lane] = (bf16)f2bf(v_t);
#pragma unroll
              for (int kq = 0; kq < 3; ++kq) { const int k = lane + 64 * kq; if (k < 160) { const float pv = PS[(size_t)row * 160 + k]; const int tk = 16 * wg + t;
                  if (k < 32) *(LAS bf16*)(L + IM_DW + tk * PDW + k * 2) = (bf16)f2bf(tanhf(pv)); else if (k < 64) *(LAS bf16*)(L + IM_DA + tk * PDW + (k - 32) * 2) = (bf16)f2bf(pv); else *(LAS bf16*)(L + IM_DG + tk * PDG + (k - 64) * 2) = (bf16)f2bf(sigmf(pv)); } }
          }
        }
        __syncthreads();
        f32x16 lwd[2], ad[2];
        { f32x16 gacc = zero16v();
#pragma unroll
          for (int sx = 0; sx < 6; ++sx) gacc = MMA32(*(const LAS bf16x8*)(L + IM_DG + (32 * ti + c32) * PDG + (16 * sx + 8 * h) * 2), RWF[(((8 + sx) * NH + hd) * 2 + tj) * 64 + lane], gacc);
#pragma unroll
          for (int rg = 0; rg < 16; ++rg) { const int tk = 32 * ti + (rg & 3) + 8 * (rg >> 2) + 4 * h; RV[3 * 4096 + tk * 64 + 32 * tj + c32] = (bf16)f2bf(gacc[rg]); }
#pragma unroll
          for (int d = 0; d < 2; ++d) { f32x16 pw = zero16v(), pa = zero16v();
#pragma unroll
              for (int sx = 0; sx < 2; ++sx) { pw = MMA32(*(const LAS bf16x8*)(L + IM_DW + (32 * ti + c32) * PDW + (16 * sx + 8 * h) * 2), RWF[(((0 + 2 * d + sx) * NH + hd) * 2 + tj) * 64 + lane], pw);
                                              pa = MMA32(*(const LAS bf16x8*)(L + IM_DA + (32 * ti + c32) * PDW + (16 * sx + 8 * h) * 2), RWF[(((4 + 2 * d + sx) * NH + hd) * 2 + tj) * 64 + lane], pa); }
              const float w0 = C.in[I_RWW0][((size_t)l * 2 + d) * GW + hd * 64 + 32 * tj + c32], a0 = C.in[I_RWA0][((size_t)l * 2 + d) * GW + hd * 64 + 32 * tj + c32];
#pragma unroll
              for (int rg = 0; rg < 16; ++rg) { const float z = -(w0 + pw[rg]), sp = z > 20.f ? z : log1pf(__expf(z)); lwd[d][rg] = -__expf(-sp - 0.5f); ad[d][rg] = sigmf(a0 + pa[rg]); } }
        }
        const float kaw = C.in[I_RWKA][(size_t)l * GW + cg];
#pragma unroll
        for (int pss = 0; pss < 2; ++pss) {
            const int dir = 1 - pss;
            __syncthreads();
#pragma unroll
            for (int rg = 0; rg < 16; ++rg) { const int tk = 32 * ti + (rg & 3) + 8 * (rg >> 2) + 4 * h; TW[tk * FP + 32 * tj + c32] = lwd[dir][rg]; TA[tk * FP + 32 * tj + c32] = ad[dir][rg]; }
            __syncthreads();
            const int cs = dir ? 3 - wg : wg;
            float lw[16], av[16], run = 0.f;
#pragma unroll
            for (int ii = 0; ii < 16; ++ii) { const int tl = dir ? 15 - ii : ii, tk = 16 * wg + tl; av[ii] = TA[tk * FP + lane]; run += TW[tk * FP + lane]; lw[ii] = run; }
            __syncthreads();
            SEG[cs * 64 + lane] = run;
            __syncthreads();
            float off = 0.f;
#pragma unroll
            for (int w2 = 0; w2 < 3; ++w2) off += (w2 < cs) ? SEG[w2 * 64 + lane] : 0.f;
            const float tot = SEG[lane] + SEG[64 + lane] + SEG[128 + lane] + SEG[192 + lane];
            if (wg == 0) { if (dir) ((float*)(PK + 32768))[lane] = __expf(tot); else GC[lane] = __expf(tot); }
#pragma unroll
            for (int ii = 0; ii < 16; ++ii) { const int tl = dir ? 15 - ii : ii, i = 16 * cs + ii;
                const float Li = lw[ii] + off, eL = __expf(Li), ieL = __builtin_amdgcn_rcpf(eL), eLm = __expf(Li - (lw[ii] - (ii ? lw[ii - 1] : 0.f)));
                const float a = av[ii], kd = kf_[tl] * (1.f + (a - 1.f) * kaw); ks_[tl] += kd;
                const bf16 vat = (bf16)f2bf(-kk_[tl] * eLm), vbt = (bf16)f2bf(kk_[tl] * a * ieL), vkt = (bf16)f2bf(kd * ieL), vrt = (bf16)f2bf(r_[tl] * eL);
                if (dir) { bf16* pk = (bf16*)PK + i * 64 + lane; pk[0] = vat; pk[4096] = vbt; pk[8192] = vkt; pk[12288] = vrt; }
                else { *(LAS bf16*)(L + IM_AT + i * PT + lane * 2) = vat; *(LAS bf16*)(L + IM_BT + i * PT + lane * 2) = vbt; *(LAS bf16*)(L + IM_KT + i * PT + lane * 2) = vkt; *(LAS bf16*)(L + IM_RT + i * PT + lane * 2) = vrt; } }
        }
#pragma unroll
        for (int t = 0; t < 16; ++t) RV[2 * 4096 + (16 * wg + t) * 64 + lane] = (bf16)f2bf(ks_[t]);
#pragma unroll 1
        for (int dir = 0; dir < 2; ++dir) {
            const int c = dir == 0 ? tb : (tb < TC / 64 ? TC / 64 - 1 - tb : TC / 64 + (T / 64 - 1 - (tb - TC / 64)));
            const size_t ci = ((size_t)((b * NH + hd) * 2 + dir)) * RCK + c;
            __syncthreads();
            if (dir) {
                const int tg = wg * 64 + lane;
#pragma unroll
                for (int im = 0; im < 4; ++im)
#pragma unroll
                    for (int rr = 0; rr < 2; ++rr) { const int idx = tg + 256 * rr, row = idx >> 3, ch = idx & 7; const int dsto = im == 0 ? IM_AT : im == 1 ? IM_BT : im == 2 ? IM_KT : IM_RT;
                        *(LAS u32x4*)(L + dsto + row * PT + ch * 16) = *(const u32x4*)(PK + im * 8192 + row * 128 + ch * 16); }
                if (wg == 0) GC[lane] = ((const float*)(PK + 32768))[lane];
                __syncthreads();
            }
            f32x16 accP;
            { f32x16 aab = zero16v(), aak = zero16v(), arb = zero16v(); accP = zero16v();
#pragma unroll
              for (int s = 0; s < 4; ++s) { const bf16x8 at_i = frag_rows(L + IM_AT, ti, s, lane), bt_j = frag_rows(L + IM_BT, tj, s, lane), kt_j = frag_rows(L + IM_KT, ti, s, lane), at_c = frag_rows(L + IM_AT, tj, s, lane),
                                              bt_r = frag_rows(L + IM_BT, ti, s, lane), rt_c = frag_rows(L + IM_RT, tj, s, lane);
                  aab = MMA32(at_i, bt_j, aab); aak = MMA32(kt_j, at_c, aak); arb = MMA32(bt_r, rt_c, arb); accP = MMA32(kt_j, rt_c, accP); }
#pragma unroll
              for (int r = 0; r < 16; ++r) { const int row = 32 * ti + (r & 3) + 8 * (r >> 2) + 4 * h, col = 32 * tj + c32;
                  F[row * FP + col] = col < row ? aab[r] : 0.f; aak[r] = row < col ? aak[r] : 0.f; arb[r] = row <= col ? arb[r] : 0.f; accP[r] = row <= col ? accP[r] : 0.f; }
              store_T(aak, L + IM_AAK, ti, tj, lane);
              store_T(arb, L + IM_ARB, ti, tj, lane); }
            __syncthreads();
            { float Wc[64]; const int col = 32 * wg + c32; const LAS unsigned char* src = col < 64 ? L + IM_AT + col * 2 : L + IM_AAK + (col - 64) * 2;
              const LAS float* Fo = OPAQUE_LDS(F);
#pragma unroll
              for (int i = 0; i < 64; ++i) Wc[i] = bf2f(*(const LAS bf16*)(src + i * PT));
#pragma unroll
              for (int i = 1; i < 64; ++i) { float a = Wc[i];
#pragma unroll
                  for (int j4 = 0; j4 < (i + 3) / 4; ++j4) { const f32x4 f = *(const LAS f32x4*)(Fo + i * FP + 4 * j4); a += f[0] * Wc[4 * j4] + f[1] * Wc[4 * j4 + 1] + f[2] * Wc[4 * j4 + 2] + f[3] * Wc[4 * j4 + 3];
                      if ((j4 & 3) == 3) PIN(a); }
                  PIN(a); Wc[i] = a; }
              __syncthreads();
              if (h == 0) { LAS unsigned char* dst = (col < 64 ? L + IM_AT + col * PT : L + IM_AAK + (col - 64) * PT);
#pragma unroll
                  for (int i8 = 0; i8 < 8; ++i8) { u32x4 w; w.x = pk2(Wc[8 * i8], Wc[8 * i8 + 1]); w.y = pk2(Wc[8 * i8 + 2], Wc[8 * i8 + 3]); w.z = pk2(Wc[8 * i8 + 4], Wc[8 * i8 + 5]); w.w = pk2(Wc[8 * i8 + 6], Wc[8 * i8 + 7]); *(LAS u32x4*)(dst + i8 * 16) = w; } }
#pragma unroll
              for (int ii = 0; ii < 16; ++ii) { const int tl = dir ? 15 - ii : ii, i = 16 * (dir ? 3 - wg : wg) + ii; *(LAS bf16*)(L + IM_F + i * PT + lane * 2) = RV[4096 + (16 * wg + tl) * 64 + lane]; }
            }
            __syncthreads();
            { f32x16 q;
#pragma unroll
              for (int g = 0; g < 4; ++g) { const u32x2 w = *(const LAS u32x2*)(L + IM_RT + (32 * tj + c32) * PT + (32 * ti + 8 * g + 4 * h) * 2); q[4 * g] = bflo(w.x); q[4 * g + 1] = bfhi(w.x); q[4 * g + 2] = bflo(w.y); q[4 * g + 3] = bfhi(w.y); }
#pragma unroll
              for (int s = 0; s < 4; ++s) { const bf16x8 arb = frag_rows(L + IM_ARB, tj, s, lane); q = MMA32(frag_rows(L + IM_AT, ti, s, lane), arb, q); accP = MMA32(frag_rows(L + IM_AAK, ti, s, lane), arb, accP); }
              if (live) {
#pragma unroll
                  for (int g = 0; g < 4; ++g) { u32x2 w; w.x = pk2(q[4 * g], q[4 * g + 1]); w.y = pk2(q[4 * g + 2], q[4 * g + 3]); *(u32x2*)(QH + ci * 4096 + (32 * tj + c32) * 64 + 32 * ti + 8 * g + 4 * h) = w; } }
            }
            __syncthreads();
            store_T(accP, L + IM_RT, ti, tj, lane);
            __syncthreads();
            { f32x16 y = zero16v(), m = zero16v(), n;
#pragma unroll
              for (int g = 0; g < 4; ++g) { const u32x2 w = *(const LAS u32x2*)(L + IM_KT + (32 * tj + c32) * PT + (32 * ti + 8 * g + 4 * h) * 2); n[4 * g] = bflo(w.x); n[4 * g + 1] = bfhi(w.x); n[4 * g + 2] = bflo(w.y); n[4 * g + 3] = bfhi(w.y); }
#pragma unroll
              for (int s = 0; s < 4; ++s) { const bf16x8 btc_j = frag_cols(L + IM_BT, tj, s, lane), btc_i = frag_cols(L + IM_BT, ti, s, lane);
                  y = MMA32(frag_rows(L + IM_RT, ti, s, lane), frag_cols(L + IM_F, tj, s, lane), y);
                  m = MMA32(frag_rows(L + IM_AT, ti, s, lane), btc_j, m);
                  n = MMA32(btc_i, frag_rows(L + IM_AAK, tj, s, lane), n); }
              const float gck = GC[32 * tj + c32];
#pragma unroll
              for (int r = 0; r < 16; ++r) { const int row = 32 * ti + (r & 3) + 8 * (r >> 2) + 4 * h, col = 32 * tj + c32; m[r] = (m[r] + (row == col ? 1.0f : 0.f)) * gck; n[r] *= GC[row]; }
              if (live) {
#pragma unroll
                  for (int g = 0; g < 4; ++g) *(f32x4*)(YL + ci * 4096 + ((wg * 4 + g) * 64 + lane) * 4) = (f32x4){y[4 * g], y[4 * g + 1], y[4 * g + 2], y[4 * g + 3]};
#pragma unroll
                  for (int s2 = 0; s2 < 2; ++s2) *(bf16x8*)(MF + ci * 4096 + ((wg * 2 + s2) * 64 + lane) * 8) = pack8(m, s2); }
              store_T(n, L + IM_ARB, ti, tj, lane);
            }
            __syncthreads();
            { f32x16 gacc = zero16v();
#pragma unroll
              for (int s = 0; s < 4; ++s) gacc = MMA32(frag_cols(L + IM_ARB, ti, s, lane), frag_cols(L + IM_F, tj, s, lane), gacc);
              if (live) {
#pragma unroll
                  for (int g = 0; g < 4; ++g) *(f32x4*)(GF + ci * 4096 + ((wg * 4 + g) * 64 + lane) * 4) = (f32x4){gacc[4 * g], gacc[4 * g + 1], gacc[4 * g + 2], gacc[4 * g + 3]}; }
            }
        }
    }
    __syncthreads();
}
DI void ph_rw2(const Ctx& C) {
    const int lane = C.lane;
    const bf16* MF = (const bf16*)(C.ws + WS_MF); const float* GF = (const float*)(C.ws + WS_GF); bf16* SF = (bf16*)(C.ws + WS_SF);
    const int nwork = RSTR * 2;
    for (int wk = C.wave == 0 ? C.bid : nwork; wk < nwork; wk += C.G) {
        const int tj = wk & 1, stream = wk >> 1;
        f32x16 s0 = zero16v(), s1 = zero16v();
        bf16x8 mf[2][2][2]; f32x4 gq[2][4];
#define RW2_LOAD(item_) do { const size_t it_ = (item_); \
            _Pragma("unroll") for (int kp = 0; kp < 2; ++kp) _Pragma("unroll") for (int kt = 0; kt < 2; ++kt) _Pragma("unroll") for (int s = 0; s < 2; ++s) mf[kp][kt][s] = *(const bf16x8*)(MF + it_ * 4096 + (((kp * 2 + kt) * 2 + s) * 64 + lane) * 8); \
            _Pragma("unroll") for (int kt = 0; kt < 2; ++kt) _Pragma("unroll") for (int g = 0; g < 4; ++g) gq[kt][g] = *(const f32x4*)(GF + it_ * 4096 + (((kt * 2 + tj) * 4 + g) * 64 + lane) * 4); } while (0)
        RW2_LOAD((size_t)stream * RCK);
        for (int c = 0; c < RCK; ++c) {
            const size_t item = (size_t)stream * RCK + c;
            bf16x8 sf[2][2];
#pragma unroll
            for (int s = 0; s < 2; ++s) { sf[0][s] = pack8(s0, s); sf[1][s] = pack8(s1, s); *(bf16x8*)(SF + item * 4096 + (((0 * 2 + tj) * 2 + s) * 64 + lane) * 8) = sf[0][s]; *(bf16x8*)(SF + item * 4096 + (((1 * 2 + tj) * 2 + s) * 64 + lane) * 8) = sf[1][s]; }
            f32x16 n0, n1;
#pragma unroll
            for (int g = 0; g < 4; ++g) { n0[4 * g] = gq[0][g][0]; n0[4 * g + 1] = gq[0][g][1]; n0[4 * g + 2] = gq[0][g][2]; n0[4 * g + 3] = gq[0][g][3]; n1[4 * g] = gq[1][g][0]; n1[4 * g + 1] = gq[1][g][1]; n1[4 * g + 2] = gq[1][g][2]; n1[4 * g + 3] = gq[1][g][3]; }
            bf16x8 mc[2][2][2];
#pragma unroll
            for (int kp = 0; kp < 2; ++kp)
#pragma unroll
                for (int kt = 0; kt < 2; ++kt)
#pragma unroll
                    for (int s = 0; s < 2; ++s) mc[kp][kt][s] = mf[kp][kt][s];
            if (c + 1 < RCK) RW2_LOAD(item + 1);
#pragma unroll
            for (int kp = 0; kp < 2; ++kp)
#pragma unroll
                for (int s = 0; s < 2; ++s) { n0 = MMA32(mc[kp][0][s], sf[kp][s], n0); n1 = MMA32(mc[kp][1][s], sf[kp][s], n1); }
            s0 = n0; s1 = n1;
        }
#undef RW2_LOAD
    }
}
DI void ph_rw3(const Ctx& C, int l, int mrows) {
    const int lane = C.lane, wg = C.wave & 3, grp = C.wave >> 2, ti = wg >> 1, tj = wg & 1, c32 = lane & 31, h = lane >> 5;
    LAS float* Ysum = (LAS float*)(C.lds + grp * RW_HALF);
    const bf16* QH = (const bf16*)(C.ws + WS_QH); const float* YL = (const float*)(C.ws + WS_YL); const bf16* SF = (const bf16*)(C.ws + WS_SF); bf16* OB = (bf16*)(C.ws + WS_OB);
    const int nblk = (TC + T) / 64, nitems = NB * NH * nblk;
    for (int it0 = 2 * C.bid; it0 < nitems; it0 += 2 * C.G) {
        const int item = it0 + grp; const bool live = item < nitems; const int itc = live ? item : nitems - 1;
        const int tb = itc % nblk, hd = (itc / nblk) % NH, b = itc / (nblk * NH);
        const int rowb = tb < TC / 64 ? M_LAT + b * TC + 64 * tb : b * T + 64 * (tb - TC / 64);
        __syncthreads();
#pragma unroll
        for (int dir = 0; dir < 2; ++dir) {
            const int c = dir == 0 ? tb : (tb < TC / 64 ? TC / 64 - 1 - tb : TC / 64 + (T / 64 - 1 - (tb - TC / 64)));
            const size_t ci = ((size_t)((b * NH + hd) * 2 + dir)) * RCK + c;
            f32x16 y;
#pragma unroll
            for (int g = 0; g < 4; ++g) { const f32x4 a = *(const f32x4*)(YL + ci * 4096 + ((wg * 4 + g) * 64 + lane) * 4); y[4 * g] = a[0]; y[4 * g + 1] = a[1]; y[4 * g + 2] = a[2]; y[4 * g + 3] = a[3]; }
#pragma unroll
            for (int kp = 0; kp < 2; ++kp)
#pragma unroll
                for (int s = 0; s < 2; ++s) {
                    const bf16* qp = QH + ci * 4096 + (32 * ti + c32) * 64 + 32 * kp + 16 * s + 4 * h; const u32x2 lo = *(const u32x2*)qp, hi = *(const u32x2*)(qp + 8);
                    u32x4 av; av.x = lo.x; av.y = lo.y; av.z = hi.x; av.w = hi.y;
                    y = MMA32(__builtin_bit_cast(bf16x8, av), *(const bf16x8*)(SF + ci * 4096 + (((kp * 2 + tj) * 2 + s) * 64 + lane) * 8), y); }
#pragma unroll
            for (int r = 0; r < 16; ++r) { const int i = 32 * ti + (r & 3) + 8 * (r >> 2) + 4 * h, tk = dir ? 63 - i : i; LAS float* p = Ysum + tk * FP + 32 * tj + c32; if (dir == 0) *p = y[r]; else *p += y[r]; }
            __syncthreads();
        }
        if (live) {
            const int cch = hd * 64 + lane; const float rk = C.in[I_RWRK][((size_t)l * NH + hd) * 64 + lane], gw = C.in[I_RWGNW][(size_t)l * GW + cch], gb = C.in[I_RWGNB][(size_t)l * GW + cch];
            for (int t = 0; t < 16; ++t) { const int tk = 16 * wg + t, row = rowb + tk; if (row >= mrows) continue; const size_t o = (size_t)row * GW + cch;
                const bf16* rv = (const bf16*)(C.ws + WS_RVKG) + (size_t)item * 4 * 4096 + tk * 64 + lane; const float r = bf2f(rv[0]), v = bf2f(rv[4096]), ks = bf2f(rv[8192]), gg = bf2f(rv[12288]); (void)o;
                float y = Ysum[tk * FP + lane] + wave_sum(r * ks * rk) * v;
                const float mu = wave_sum(y) * (1.f / 64.f), dlt = y - mu, var = wave_sum(dlt * dlt) * (1.f / 64.f);
                OB[(size_t)row * D + GW + cch] = (bf16)f2bf((dlt * __builtin_amdgcn_rsqf(var + RW_GN_EPS) * gw + gb) * gg); }
        }
    }
    __syncthreads();
}
DI void ph_s5scan(const Ctx& C, int l, int first_block) {
    const int nthreads_total = NB * 2 * S5G * 64;
    if (C.bid < first_block) return;
    const float* XE = (const float*)(C.ws + WS_XEND); bf16* UG = (bf16*)(C.ws + WS_UG);
    const f32x2* LAM = (const f32x2*)(C.ws + WS_S5T + (size_t)l * SZ_S5L + OFF_S5LAM);
    for (int id = (C.bid - first_block) * NTHR + C.tid; id < nthreads_total; id += (C.G - first_block) * NTHR) {
        const int n = id & 63, g = (id >> 6) % S5G, dir = (id / (64 * S5G)) & 1, b = id / (128 * S5G);
        const f32x2 lm = LAM[(dir * S5G + g) * 64 + n]; float xr = 0.f, xi = 0.f;
        const int nc_ctx = TC / S5L, nc_lat = T / S5L, ntot = nc_ctx + nc_lat;
        for (int i0 = 0; i0 < ntot; i0 += 8) {
            float er[8], ei[8]; int chs[8];
#pragma unroll
            for (int u = 0; u < 8; ++u) { const int i = i0 + u; int ch;
                if (i < nc_ctx) ch = (M_LAT + b * TC) / S5L + (dir ? nc_ctx - 1 - i : i); else ch = (b * T) / S5L + (dir ? nc_lat - 1 - (i - nc_ctx) : (i - nc_ctx));
                chs[u] = ch; const float* p = XE + ((size_t)g * NCHP + ch) * 256 + dir * 128 + n; er[u] = p[0]; ei[u] = p[64]; }
#pragma unroll
            for (int u = 0; u < 8; ++u) { bf16* q = UG + ((size_t)g * NCHP + chs[u]) * S5K + 512 + dir * 128 + n; q[0] = (bf16)f2bf(xr); q[64] = (bf16)f2bf(xi);
                const float nr = lm[0] * xr - lm[1] * xi + er[u], ni = lm[0] * xi + lm[1] * xr + ei[u]; xr = nr; xi = ni; }
        }
    }
}

constexpr int PH_PRO = 3, PH_PER_L = 13, NPH = PH_PRO + PH_PER_L * NL;
#ifndef PROBE_REP
#define PROBE_REP -1
#endif
#define NREP(k) ((k) == PROBE_REP ? 2 : 1)
#ifdef ONLY
#define EN(k) ((k) == ONLY)
#else
#define EN(k) true
#endif
#ifdef EMU
void fwd(Args args) {
    unsigned char* lds = emu::lds_base();
#else
__global__ void __launch_bounds__(NTHR, 2) fwd(Args args) {
    extern __shared__ __attribute__((aligned(16))) unsigned char lds[];
#endif
    Ctx C; C.in = args.in; C.out = args.out; C.ws = args.ws; C.lds = (LAS unsigned char*)lds;
    C.tid = threadIdx.x; C.lane = C.tid & 63; C.wave = __builtin_amdgcn_readfirstlane(C.tid >> 6); C.G = gridDim.x; C.bid = blockIdx.x;
#define REFRESH() do { int t_ = threadIdx.x; OPAQUE(t_); C.tid = t_; C.lane = t_ & 63; C.wave = __builtin_amdgcn_readfirstlane(t_ >> 6); } while (0)
    volatile LAS unsigned* MISC = (volatile LAS unsigned*)(C.lds + MISC_OFF);
    if (C.tid < 32) MISC[C.tid] = 0u;
    __syncthreads();
    const int lo = args.ph_lo, hi = args.ph_hi;
    const bool use_bar = (hi - lo) > 1;
    XcdBarrier bar; bar.bar = (unsigned*)(C.ws + WS_CTL) + CW_BAR; bar.x = 0; bar.st = MISC + 8;
    if (use_bar) bar = xcd_barrier_post((unsigned*)(C.ws + WS_CTL) + CW_BAR, MISC + 8);
#define IN(k) (lo <= (k) && (k) < hi)
#define SEAM(k) do { if (IN(k) && IN((k) + 1)) xcd_barrier(bar); } while (0)
    if (EN(0) && IN(0)) for (int rep = 0; rep < NREP(0); ++rep) { REFRESH(); ph_ada(C); }
    SEAM(0);
    if (EN(1) && IN(1)) { REFRESH(); ph_conv(C); }
    SEAM(1);
    if (EN(2) && IN(2)) for (int rep = 0; rep < NREP(2); ++rep) { REFRESH(); ph_tab(C); }
    SEAM(2);
    for (int l = 0; l < NL; ++l) {
        const int pb = PH_PRO + PH_PER_L * l; const bool want_ctx = l < NL - 1;
        const int mrows_full = M, mrows_out = want_ctx ? M : M_LAT;
        bf16* AP = (bf16*)(C.ws + WS_AP); bf16* Hb = (bf16*)(C.ws + WS_H); bf16* OB = (bf16*)(C.ws + WS_OB);
        if (EN(3) && IN(pb + 0)) for (int rep = 0; rep < NREP(3); ++rep) { REFRESH();
            Gemm g{AP, wl(C, l, OFF_W1GU), D, D, D, 0, 0}; Order S; S.init(mrows_full / 256, 2 * FF / 256, 1, C.G, C.bid, D / 64);
            EpiGU E{rowss_ptr(C, l, 0), bias_ptr(C, l, 0), Hb, mrows_full}; gemm_phase(C.lds, g, S, E); }
        SEAM(pb + 0);
        if (EN(4) && IN(pb + 1)) { REFRESH();
            Gemm g{Hb, wl(C, l, OFF_W1D), FF, FF, FF, 0, 0}; Order S; S.init(M_LAT / 256, D / 256, 1, C.G, C.bid, FF / 64);
            EpiRes E{&C, gate_ptr(C, l, 0, 0), gs_ptr(C, l, 1, 0), rowss_ptr(C, l, 1), AP}; gemm_phase(C.lds, g, S, E);
            { REFRESH(); Order S2; S2.init_split(M_LAT / 256, M_CTX / 256, D / 256, 4, C.G, C.bid, FF / 64); EpiAcc E2{&C, gate_ptr(C, l, 0, 0)}; gemm_phase(C.lds, g, S2, E2); } }
        SEAM(pb + 1);
        if (EN(18) && IN(pb + 2)) { REFRESH(); ph_ctxfix(C, gs_ptr(C, l, 1, 0), rowss_ptr(C, l, 1)); }
        SEAM(pb + 2);
        if (EN(5) && IN(pb + 3)) for (int rep = 0; rep < NREP(5); ++rep) { REFRESH();
            Gemm g{AP, wl(C, l, OFF_WIN), D, D, D, 0, 0}; Order S; S.init(mrows_full / 256, NT_IN, 1, C.G, C.bid, D / 64);
            EpiIn E{&C, rowss_ptr(C, l, 1), bias_ptr(C, l, 1), l}; gemm_phase(C.lds, g, S, E); }
        SEAM(pb + 3);
        if (IN(pb + 4)) {
            if (EN(6)) for (int rep = 0; rep < NREP(6); ++rep) { REFRESH(); Gemm g{(const bf16*)(C.ws + WS_UG), (const bf16*)(C.ws + WS_S5T + (size_t)l * SZ_S5L + OFF_S5ET), S5K, 512, 512, (size_t)NCHP * S5K * 2, (size_t)256 * 512 * 2};
              Order S; S.init(NCHP / 256, 1, S5G, C.G, C.bid, 512 / 64); EpiS5A E{(float*)(C.ws + WS_XEND)}; gemm_phase(C.lds, g, S, E); }
            __syncthreads();
            for (int rep = 0; rep < NREP(9); ++rep) { if (EN(9)) { REFRESH(); ph_rw1(C, l); } }
            if (EN(7)) for (int rep = 0; rep < NREP(7); ++rep) { REFRESH(); ph_attn(C, l, want_ctx, (C.G >= 256 && 2 * C.G < RBLK && RBLK % (2 * C.G) != 0) ? (RBLK % (2 * C.G) + 1) / 2 : 0); }
        }
        SEAM(pb + 4);
        if (IN(pb + 5)) { if (EN(17)) for (int rep = 0; rep < NREP(17); ++rep) { REFRESH(); ph_rw2(C); } if (EN(10)) for (int rep = 0; rep < NREP(10); ++rep) { REFRESH(); ph_s5scan(C, l, C.G >= 256 ? 128 : 0); }
            if (EN(1) && l + 1 < NL) { REFRESH();
                if (C.G >= 256) { if (C.bid >= 64 && !(C.bid >= 128 && C.bid < 144)) { const int rk = C.bid - 64 - (C.bid >= 144 ? 16 : 0); conv_weights(C, l + 1, rk * NW + C.wave, (C.G - 80) * NW); } }
                else conv_weights(C, l + 1, C.bid * NW + C.wave, C.G * NW); } }
        SEAM(pb + 5);
        if (IN(pb + 6)) {
            if (EN(11)) for (int rep = 0; rep < NREP(11); ++rep) { REFRESH(); Gemm g{(const bf16*)(C.ws + WS_UG), (const bf16*)(C.ws + WS_S5T + (size_t)l * SZ_S5L + OFF_S5BT), S5K, S5K, S5K, (size_t)NCHP * S5K * 2, (size_t)512 * S5K * 2};
              Order S; S.init(NCHP / 256, 2, S5G, C.G, C.bid, S5K / 64); EpiS5C E{(const bf16*)(C.ws + WS_UG), C.in[I_S5D] + (size_t)l * GW, (bf16*)(C.ws + WS_YG)}; gemm_phase(C.lds, g, S, E); }
            if (EN(12)) for (int rep = 0; rep < NREP(12); ++rep) { REFRESH(); ph_rw3(C, l, mrows_out); }
        }
        SEAM(pb + 6);
        if (EN(13) && IN(pb + 7)) for (int rep = 0; rep < NREP(13); ++rep) { REFRESH();
            Gemm g{(const bf16*)(C.ws + WS_YG), wl(C, l, OFF_WGLU), GW, GW, GW, 0, 0}; Order S; S.init(mrows_out / 256, GW / 256, 1, C.G, C.bid, GW / 64);
            EpiGLU E{(const bf16*)(C.ws + WS_YG), C.in[I_S5GLUB] + (size_t)l * GW, OB}; gemm_phase(C.lds, g, S, E); }
        SEAM(pb + 7);
        if (EN(14) && IN(pb + 8)) { REFRESH();
            Gemm g{OB, wl(C, l, OFF_WOUT), D, D, D, 0, 0}; Order S; S.init(M_LAT / 256, D / 256, 1, C.G, C.bid, D / 64);
            EpiRes E{&C, gate_ptr(C, l, 1, 0), gs_ptr(C, l, 2, 0), rowss_ptr(C, l, 2), AP}; gemm_phase(C.lds, g, S, E);
            if (want_ctx) { REFRESH(); Order S2; S2.init_split(M_LAT / 256, M_CTX / 256, D / 256, 4, C.G, C.bid, D / 64); EpiAcc E2{&C, gate_ptr(C, l, 1, 0)}; gemm_phase(C.lds, g, S2, E2); } }
        SEAM(pb + 8);
        if (EN(18) && IN(pb + 9) && want_ctx) { REFRESH(); ph_ctxfix(C, gs_ptr(C, l, 2, 0), rowss_ptr(C, l, 2)); }
        SEAM(pb + 9);
        if (EN(15) && IN(pb + 10)) { REFRESH();
            Gemm g{AP, wl(C, l, OFF_W2GU), D, D, D, 0, 0}; Order S; S.init(mrows_out / 256, 2 * FF / 256, 1, C.G, C.bid, D / 64);
            EpiGU E{rowss_ptr(C, l, 2), bias_ptr(C, l, 2), Hb, mrows_out}; gemm_phase(C.lds, g, S, E); }
        SEAM(pb + 10);
        if (EN(16) && IN(pb + 11)) { REFRESH();
            Gemm g{Hb, wl(C, l, OFF_W2D), FF, FF, FF, 0, 0}; Order S; S.init(M_LAT / 256, D / 256, 1, C.G, C.bid, FF / 64);
            const bool more = l + 1 < NL;
            EpiRes E{&C, gate_ptr(C, l, 2, 0), more ? gs_ptr(C, l + 1, 0, 0) : nullptr, more ? rowss_ptr(C, l + 1, 0) : nullptr, AP}; gemm_phase(C.lds, g, S, E);
            if (want_ctx) { REFRESH(); Order S2; S2.init_split(M_LAT / 256, M_CTX / 256, D / 256, 4, C.G, C.bid, FF / 64); EpiAcc E2{&C, gate_ptr(C, l, 2, 0)}; gemm_phase(C.lds, g, S2, E2); } }
        SEAM(pb + 11);
        if (EN(18) && IN(pb + 12) && want_ctx) { REFRESH(); ph_ctxfix(C, gs_ptr(C, l + 1, 0, 0), rowss_ptr(C, l + 1, 0)); }
        SEAM(pb + 12);
    }
#undef IN
#undef SEAM
}

#ifndef MK_PER_PHASE
#define MK_PER_PHASE 0
#endif
#ifdef EMU
int g_emu_grid = 4, g_emu_lo = 0, g_emu_hi = NPH;
#endif
extern "C" void kernel_launch(void* const* d_in, const int* in_sizes, int n_in, void* d_out, int out_size, void* d_ws, size_t ws_size, hipStream_t stream) {
    Args a{};
    for (int i = 0; i < 42; ++i) a.in[i] = (const float*)d_in[i];
    a.out = (float*)d_out; a.ws = (unsigned char*)d_ws;
#ifdef EMU
    if (g_emu_lo == 0) hipMemsetAsync(d_ws, 0, WS_ZERO_END, stream);
    for (int ph = g_emu_lo; ph < g_emu_hi; ++ph) { a.ph_lo = ph; a.ph_hi = ph + 1; fprintf(stderr, "phase %d\n", ph); emu::launch(g_emu_grid, NTHR, LDS_BYTES, [=] { fwd(a); }); }
#else
    static int grid = 0;
    if (grid == 0) {
        if (n_in != 42 || out_size != M_LAT * D || ws_size < WS_END) { fprintf(stderr, "kernel_launch: unexpected shapes (n_in %d out %d ws %zu need %zu)\n", n_in, out_size, ws_size, (size_t)WS_END); grid = -1; return; }
        int dev = 0, cus = 0;
        if (hipGetDevice(&dev) != hipSuccess || hipDeviceGetAttribute(&cus, hipDeviceAttributeMultiprocessorCount, dev) != hipSuccess) { grid = -1; return; }
        if (hipFuncSetAttribute((const void*)fwd, hipFuncAttributeMaxDynamicSharedMemorySize, LDS_BYTES) != hipSuccess) { fprintf(stderr, "kernel_launch: hipFuncSetAttribute failed\n"); grid = -1; return; }
        int per_cu = 0; (void)hipOccupancyMaxActiveBlocksPerMultiprocessor(&per_cu, (const void*)fwd, NTHR, LDS_BYTES); (void)hipGetLastError();
        if (per_cu < 1) fprintf(stderr, "kernel_launch: occupancy query reports %d\n", per_cu);
        grid = cus;
    }
    if (grid < 0) return;
    (void)hipMemsetAsync(d_ws, 0, WS_ZERO_END, stream);
#if MK_PER_PHASE
    for (int ph = 0; ph < NPH; ++ph) { a.ph_lo = ph; a.ph_hi = ph + 1; hipLaunchKernelGGL(fwd, dim3(grid), dim3(NTHR), LDS_BYTES, stream, a); }
#else
    a.ph_lo = 0; a.ph_hi = NPH;
    hipLaunchKernelGGL(fwd, dim3(grid), dim3(NTHR), LDS_BYTES, stream, a);
#endif
#endif
}
```

```cpp
#ifdef EMU
#include "emu/emu.h"
#define LAS
#define GAS
#define ASMV(...) ((void)0)
#define WSYNC() do { int _z = 0; (void)emu::wave_gather(&_z, 4); } while (0)
#define OPAQUE(x) ((void)0)
#define OPAQUE_S(x) ((void)0)
#define PIN(x) ((void)0)
#define PIN4(a, b, c, d) ((void)0)
#define OPAQUE_LDS(p) (p)
#else
#include <hip/hip_runtime.h>
#include <cstdio>
#include <cstdint>
#define LAS __attribute__((address_space(3)))
#define GAS __attribute__((address_space(1)))
#define ASMV(...) asm volatile(__VA_ARGS__)
#define PIN(x) asm volatile("" : "+v"(x) :: "memory")
#define PIN4(a, b, c, d) asm volatile("" : "+v"(a), "+v"(b), "+v"(c), "+v"(d) :: "memory")
template <class P> __device__ __forceinline__ P opaque_lds(P p) { unsigned a = (unsigned)(size_t)p; asm volatile("" : "+v"(a)); return (P)(size_t)a; }
#define OPAQUE_LDS(p) opaque_lds(p)
#define OPAQUE_S(x) asm volatile("" : "+s"(x))
#define OPAQUE(x) asm volatile("" : "+v"(x))
#define WSYNC() asm volatile("s_waitcnt lgkmcnt(0)" ::: "memory")
#endif

#ifdef EMU
constexpr int D = 1024, NB = 2, T = 1024, NL = 2, TC = 256, FF = 1024;
#else
constexpr int D = 2048, NB = 2, T = 8192, NL = 4, TC = 256, FF = 5632;
#endif
constexpr int GW = D / 4, NH = GW / 64, WAG = NH / 2, S5G = GW / 16, GRW = 64, GRH = T / GRW;
constexpr int M_LAT = NB * T, M_CTX = NB * TC, M = M_LAT + M_CTX, NPAN = M / 256;
constexpr int TP = GW / 256;
constexpr int NT_IN = 8 * TP + 2, NINP = NT_IN * 256, D_IN = 8 * GW + 416;
constexpr int PN_AQ = 0, PN_AK = TP, PN_AV = 2 * TP, PN_BR = 3 * TP, PN_BK = 4 * TP, PN_BV = 5 * TP, PN_BS = 6 * TP, PN_CQ = 6 * TP + 1, PN_CKV = 7 * TP + 1, PN_DU = 7 * TP + 2;
constexpr int SRC_AQ = 0, SRC_AK = GW, SRC_AV = 2 * GW, SRC_BR = 3 * GW, SRC_BK = 4 * GW, SRC_BV = 5 * GW, SRC_BS = 6 * GW, SRC_CQ = 6 * GW + 160, SRC_CK = 7 * GW + 160, SRC_CV = 7 * GW + 288, SRC_DU = 7 * GW + 416;
constexpr int S5L = 32, NCH = M / S5L, NCHP = ((NCH + 255) / 256) * 256, S5K = 768;
constexpr int NW = 8, NTHR = 512;
constexpr float NORM_EPS = 1e-6f, RW_GN_EPS = 64e-5f;

typedef unsigned short bf16;
typedef short bf16x8 __attribute__((ext_vector_type(8)));
typedef short s16x4 __attribute__((ext_vector_type(4)));
typedef float f32x4 __attribute__((ext_vector_type(4)));
typedef float f32x2 __attribute__((ext_vector_type(2)));
typedef float f32x16 __attribute__((ext_vector_type(16)));
typedef unsigned u32x4 __attribute__((ext_vector_type(4)));
typedef unsigned u32x2 __attribute__((ext_vector_type(2)));
#define DI __device__ __forceinline__

constexpr size_t al256(size_t x) { return (x + 255) & ~(size_t)255; }
constexpr size_t SZ_BIAS_GU = (size_t)3 * 2 * FF * 4, SZ_BIAS_IN = (size_t)3 * NINP * 4;
constexpr size_t WS_CTL = 0;
constexpr size_t WS_BIAS = 65536;
constexpr size_t SZ_BIAS_L = 2 * SZ_BIAS_GU + SZ_BIAS_IN;
constexpr size_t WS_ROWSS = al256(WS_BIAS + NL * SZ_BIAS_L);
constexpr size_t WS_ZERO_END = al256(WS_ROWSS + (size_t)NL * 3 * M * 4);
constexpr size_t WS_MODV = WS_ZERO_END;
constexpr size_t WS_GS = al256(WS_MODV + (size_t)NL * 3 * 9 * D * 4);
constexpr size_t WS_GATE = al256(WS_GS + (size_t)NL * 9 * D * 4);
constexpr size_t WS_ROPE = al256(WS_GATE + (size_t)NL * 9 * D * 4);
constexpr size_t SZ_WGU = (size_t)2 * FF * D * 2, SZ_WD = (size_t)D * FF * 2, SZ_WIN = (size_t)NINP * D * 2, SZ_WOUT = (size_t)D * D * 2, SZ_WGLU = (size_t)GW * GW * 2;
constexpr size_t OFF_W1GU = 0, OFF_W1D = OFF_W1GU + SZ_WGU, OFF_WIN = OFF_W1D + SZ_WD, OFF_WOUT = OFF_WIN + SZ_WIN, OFF_W2GU = OFF_WOUT + SZ_WOUT, OFF_W2D = OFF_W2GU + SZ_WGU, OFF_WGLU = OFF_W2D + SZ_WD, SZ_WL = OFF_WGLU + SZ_WGLU;
constexpr size_t WS_W = al256(WS_ROPE + 128 * 16 * 8);
constexpr size_t SZ_S5KC = (size_t)S5G * 2 * S5L * 256 * 4, SZ_S5ET = (size_t)S5G * 256 * 512 * 2, SZ_S5BT = (size_t)S5G * 512 * S5K * 2, SZ_S5LAM = (size_t)2 * GW * 4 * 8;
constexpr size_t SZ_S5LP = (size_t)2 * S5G * 64 * (S5L + 1) * 8, SZ_S5BETA = (size_t)2 * S5G * 64 * 16 * 8;
constexpr size_t OFF_S5KC = 0, OFF_S5ET = OFF_S5KC + SZ_S5KC, OFF_S5BT = OFF_S5ET + SZ_S5ET, OFF_S5LAM = OFF_S5BT + SZ_S5BT, OFF_S5LP = al256(OFF_S5LAM + SZ_S5LAM), OFF_S5BETA = OFF_S5LP + SZ_S5LP, SZ_S5L = al256(OFF_S5BETA + SZ_S5BETA);
constexpr size_t WS_S5T = al256(WS_W + NL * SZ_WL);
constexpr size_t WS_XC = al256(WS_S5T + NL * SZ_S5L);
constexpr size_t WS_AP = al256(WS_XC + (size_t)M_CTX * D * 4);
constexpr size_t WS_H = al256(WS_AP + (size_t)M * D * 2);
constexpr size_t WS_QA = al256(WS_H + (size_t)M * FF * 2);
constexpr size_t WS_KA = WS_QA + (size_t)M * GW * 2, WS_VA = WS_KA + (size_t)M * GW * 2, WS_QC = WS_VA + (size_t)M * GW * 2;
constexpr size_t WS_KC = WS_QC + (size_t)M * GW * 2, WS_VC = WS_KC + (size_t)M * 128 * 2;
constexpr size_t WS_PB = WS_VC + (size_t)M * 128 * 2;
constexpr size_t WS_PS = al256(WS_PB + (size_t)M * 3 * GW * 2);
constexpr size_t WS_UG = al256(WS_PS + (size_t)M * 160 * 4);
constexpr size_t WS_RW = al256(WS_UG + (size_t)S5G * NCHP * S5K * 2);
constexpr size_t SZ_RWA = (size_t)M * GW * 4;
enum { RW_R = 0, RW_V, RW_NKK, RW_G, RW_W0, RW_W1, RW_K0, RW_K1, RW_B0, RW_B1, RW_Y0, RW_Y1, RW_NARR };
constexpr size_t WS_XEND = al256(WS_RW + RW_NARR * SZ_RWA);
constexpr size_t WS_YG = al256(WS_XEND + (size_t)S5G * NCHP * 256 * 4);
constexpr size_t WS_OB = al256(WS_YG + (size_t)M * GW * 2);
constexpr int RCK = (TC + T) / 64, RSTR = NB * NH * 2, RITEM = RSTR * RCK;
constexpr size_t WS_QH = al256(WS_OB + (size_t)M * D * 2);
constexpr size_t WS_YL = al256(WS_QH + (size_t)RITEM * 8192);
constexpr size_t WS_MF = al256(WS_YL + (size_t)RITEM * 16384);
constexpr size_t WS_GF = al256(WS_MF + (size_t)RITEM * 8192);
constexpr size_t WS_SF = al256(WS_GF + (size_t)RITEM * 16384);
constexpr int RBLK = NB * NH * ((TC + T) / 64);
constexpr size_t WS_RVKG = al256(WS_SF + (size_t)RITEM * 8192);
constexpr size_t SZ_RWF = (size_t)14 * NH * 2 * 64 * 16;
constexpr size_t WS_RWF = al256(WS_RVKG + (size_t)RBLK * 32768);
constexpr size_t WS_RWS = al256(WS_RWF + NL * SZ_RWF);
constexpr size_t WS_END = al256(WS_RWS + (size_t)512 * 2 * 65536);
constexpr int CW_BAR = 1024;

constexpr int LDS_BYTES = 147456, RING_BYTES = 131072, MISC_OFF = LDS_BYTES - 256;

DI unsigned f2bf(float f) { unsigned u = __float_as_uint(f); return (u + 0x7fffu + ((u >> 16) & 1u)) >> 16; }
#ifdef EMU
DI unsigned pk2(float lo, float hi) { return f2bf(lo) | (f2bf(hi) << 16); }
#else
typedef __bf16 hbf16x2 __attribute__((ext_vector_type(2)));
DI unsigned pk2(float lo, float hi) { const f32x2 v = {lo, hi}; const hbf16x2 b = __builtin_convertvector(v, hbf16x2); return __builtin_bit_cast(unsigned, b); }
#endif
DI float bf2f(unsigned short b) { return __uint_as_float(((unsigned)b) << 16); }
DI float bflo(unsigned w) { return __uint_as_float(w << 16); }
DI float bfhi(unsigned w) { return __uint_as_float(w & 0xffff0000u); }
template <int N> DI float ror_add(float v) { return v + __int_as_float(__builtin_amdgcn_mov_dpp(__float_as_int(v), 0x120 + N, 0xf, 0xf, true)); }
DI float row16_sum(float v) { v = ror_add<8>(v); v = ror_add<4>(v); v = ror_add<2>(v); v = ror_add<1>(v); return v; }
DI float wave_sum(float v) {
    v = row16_sum(v);
    const float a = __int_as_float(__builtin_amdgcn_readlane(__float_as_int(v), 0)), b = __int_as_float(__builtin_amdgcn_readlane(__float_as_int(v), 16)),
                c = __int_as_float(__builtin_amdgcn_readlane(__float_as_int(v), 32)), d = __int_as_float(__builtin_amdgcn_readlane(__float_as_int(v), 48));
    return (a + b) + (c + d);
}
DI float siluf(float x) { return x * __builtin_amdgcn_rcpf(1.f + __expf(-x)); }
DI float sigmf(float x) { return __builtin_amdgcn_rcpf(1.f + __expf(-x)); }
DI float geluf(float x) { const float z = 0.7978845608028654f * (x + 0.044715f * x * x * x); const float e = __expf(2.f * z); return 0.5f * x * (1.f + (1.f - 2.f * __builtin_amdgcn_rcpf(e + 1.f))); }
DI int stream_of_row(int row) { return row < M_LAT ? row / T : NB; }
DI int stream_of_panel(int pm) { return stream_of_row(pm * 256); }

#define XB_TMO      128
#define XB_XCNT(j)  (256  + 64 * (j))
#define XB_XSUB(j)  (1280 + 64 * (j))
#define XB_XGEN(j)  (2304 + 64 * (j))
#define XB_TOP      3328
#define XB_TOPGEN   3392
#define XCD_BAR_WORDS 3456
#define XB_SPIN_CAP (1u << 18)
DI unsigned xb_ld(unsigned* p)              { return __hip_atomic_load(p, __ATOMIC_RELAXED, __HIP_MEMORY_SCOPE_AGENT); }
DI unsigned xb_add(unsigned* p, unsigned v) { return __hip_atomic_fetch_add(p, v, __ATOMIC_RELAXED, __HIP_MEMORY_SCOPE_AGENT); }
DI unsigned xb_xcc_id() { return (unsigned)__builtin_amdgcn_s_getreg((3 << 11) | 20) & 0xFu; }
#define XB_SPIN(cond, bar) do { unsigned _sp = 0; while (cond) { __builtin_amdgcn_s_sleep(1); \
    if ((++_sp & 255u) == 0u) { if (xb_ld(&(bar)[XB_TMO])) break; if (_sp > XB_SPIN_CAP) { atomicAdd(&(bar)[XB_TMO], 1u); break; } } } } while (0)
struct XcdBarrier { unsigned* bar; unsigned x; volatile LAS unsigned* st; };
DI XcdBarrier xcd_barrier_post(unsigned* bar, volatile LAS unsigned* st) {
    XcdBarrier b; b.bar = bar; b.x = xb_xcc_id(); b.st = st;
    if (threadIdx.x == 0) (void)xb_add(&bar[XB_XCNT(b.x)], 1u);
    return b;
}
DI void xcd_barrier_complete(unsigned* bar, unsigned x, unsigned& nloc, unsigned& nx) {
    const unsigned G = gridDim.x * gridDim.y * gridDim.z;
    unsigned sum, cnt, mine, sp = 0u;
    for (;;) {
        sum = 0u; cnt = 0u; mine = 0u;
#pragma unroll
        for (unsigned j = 0; j < 16; ++j) { const unsigned c = xb_ld(&bar[XB_XCNT(j)]); sum += c; cnt += (c > 0u) ? 1u : 0u; mine = (j == x) ? c : mine; }
        if (sum == G) break;
        __builtin_amdgcn_s_sleep(1);
        if ((++sp & 255u) == 0u) { if (xb_ld(&bar[XB_TMO])) break; if (sp > XB_SPIN_CAP) { atomicAdd(&bar[XB_TMO], 1u); break; } }
    }
    nloc = mine > 0u ? mine : 1u; nx = cnt > 0u ? cnt : 1u;
}
DI void xcd_barrier(const XcdBarrier& b) {
    ASMV("s_waitcnt vmcnt(0)" ::: "memory");
    __syncthreads();
    if (threadIdx.x == 0) {
        unsigned* bar = b.bar;
        __builtin_amdgcn_s_waitcnt(0);
        unsigned nloc = b.st[0], nx = b.st[1];
        if (nloc == 0u) { xcd_barrier_complete(bar, b.x, nloc, nx); b.st[0] = nloc; b.st[1] = nx; }
        const unsigned old = xb_add(&bar[XB_XSUB(b.x)], 1u);
        const unsigned gen = old / nloc;
        if (old + 1u == (gen + 1u) * nloc) {
            __builtin_amdgcn_fence(__ATOMIC_RELEASE, "agent");
            ASMV("s_waitcnt vmcnt(0)" ::: "memory");
            const unsigned og = xb_add(&bar[XB_TOP], 1u);
            const unsigned tg = og / nx;
            if (og + 1u == (tg + 1u) * nx) xb_add(&bar[XB_TOPGEN], 1u);
            else XB_SPIN(xb_ld(&bar[XB_TOPGEN]) == tg, bar);
            __builtin_amdgcn_fence(__ATOMIC_ACQUIRE, "agent");
            xb_add(&bar[XB_XGEN(b.x)], 1u);
            ASMV("s_waitcnt vmcnt(0)" ::: "memory");
        } else {
            XB_SPIN(xb_ld(&bar[XB_XGEN(b.x)]) == gen, bar);
            __builtin_amdgcn_fence(__ATOMIC_ACQUIRE, "agent");
            ASMV("s_waitcnt vmcnt(0)" ::: "memory");
        }
    }
    __syncthreads();
}

constexpr int BK = 64, HALF = 128, HTB = HALF * BK * 2, NXCD = 8, WGM = 8;
DI int lds_byte(int r, int c) { const int st = (r >> 4) * 2 + (c >> 5), rr = r & 15, cc = c & 31, ob = rr * 64 + cc * 2; return st * 1024 + (ob ^ (((ob >> 9) & 1) << 5)); }
DI void stage_rc(int b, int& R, int& C) { const int st = b / 1024, sb = b % 1024, swz = sb ^ (((sb >> 9) & 1) << 5); R = (st >> 1) * 16 + swz / 64; C = (st & 1) * 32 + (swz % 64) / 2; }
struct Unit { int pm, pn, z, kt0; };
struct Gemm { const bf16* A; const bf16* Bt; int lda, ldb, K; size_t zA, zB; };
struct Order {
    int nM, nN, nZ, per, total, G, c, nkt, pm0, spl;
    DI void init(int nM_, int nN_, int nZ_, int G_, int c_, int nkt_) { nM = nM_; nN = nN_; nZ = nZ_; per = nM * nN; total = per * nZ; G = G_; c = c_; nkt = nkt_; pm0 = 0; spl = 0; }
    DI void init_split(int pm0_, int xM, int nN_, int spl_, int G_, int c_, int nkt_full) { nM = xM; nN = nN_; nZ = 1; per = xM * nN_ * spl_; total = per; G = G_; c = c_; nkt = nkt_full / spl_; pm0 = pm0_; spl = spl_; }
    DI bool next(int i, Unit& u) const {
        const long L = (long)i * G + c; if (L >= total) return false;
        if (spl) { const int j = (int)L; u.z = 0; u.pm = pm0 + j / (nN * spl); const int rem = j % (nN * spl); u.pn = rem / spl; u.kt0 = (rem % spl) * nkt; return true; }
        u.kt0 = 0;
        u.z = (int)(L / per); int wgid = (int)(L % per);
        { const int q = per / NXCD, r = per % NXCD, xcd = wgid % NXCD, off = wgid / NXCD; wgid = (xcd < r ? xcd * (q + 1) : r * (q + 1) + (xcd - r) * q) + off; }
        const int nig = WGM * nN, gid = wgid / nig, fm = gid * WGM, gsz = (nM - fm) < WGM ? (nM - fm) : WGM;
        u.pm = fm + ((wgid % nig) % gsz); u.pn = (wgid % nig) / gsz; return true;
    }
};

template <class Epi>
DI void gemm_phase(LAS unsigned char* lds, const Gemm g, const Order& S, const Epi& E) {
    int tid_ = threadIdx.x; OPAQUE(tid_);
    const int tid = tid_, wid = __builtin_amdgcn_readfirstlane(tid >> 6), lane = tid & 63, wr = wid >> 2, wc = wid & 3, fr = lane & 15, fq = lane >> 4;
    Unit cur, nxt; int ui = 0;
    if (!S.next(0, cur)) return;
    f32x4 acc[2][2][4][2];
#ifdef EMU
    (void)lds;
    for (;; ++ui) {
        if (ui > 0) { if (!S.next(ui, cur)) break; }
        const bf16* A = (const bf16*)((const char*)g.A + cur.z * g.zA); const bf16* B = (const bf16*)((const char*)g.Bt + cur.z * g.zB);
        for (int ai = 0; ai < 2; ++ai) for (int bj = 0; bj < 2; ++bj) for (int m = 0; m < 4; ++m) for (int n = 0; n < 2; ++n) for (int j = 0; j < 4; ++j) {
            const int r = 256 * cur.pm + 128 * ai + 64 * wr + 16 * m + fr, c = 256 * cur.pn + 128 * bj + 32 * wc + 16 * n + 4 * fq + j;
            const bf16* a = A + (size_t)r * g.lda; const bf16* b = B + (size_t)c * g.ldb; float s = 0.f;
            for (int k = cur.kt0 * BK; k < (cur.kt0 + S.nkt) * BK; ++k) s += bf2f(a[k]) * bf2f(b[k]);
            acc[ai][bj][m][n][j] = s; }
        E(acc, cur, wr, wc, fr, fq);
    }
#else
    unsigned voffA[2], voffB[2];
#pragma unroll
    for (int i = 0; i < 2; ++i) { int R, C; stage_rc(tid * 16 + i * 8192, R, C); voffA[i] = (unsigned)(R * g.lda + C) * 2u; voffB[i] = (unsigned)(R * g.ldb + C) * 2u; }
    const size_t kstep = (size_t)(BK * 2);
    const size_t hstepA = (size_t)HALF * g.lda * 2, hstepB = (size_t)HALF * g.ldb * 2, tstepA = 2 * hstepA, tstepB = 2 * hstepB;
    const unsigned ldsw = (unsigned)wid * 1024u;
    const int aoff = lds_byte(wr * 64 + fr, fq * 8), boff = lds_byte(wc * 32 + fr, fq * 8);
#define PG8_SA(b, h) (((b) * 2 + (h)) * HTB)
#define PG8_SB(b, h) ((4 + (b) * 2 + (h)) * HTB)
#define PG8_STAGE(bufoff, gbase, voff) do { _Pragma("unroll") for (int _i = 0; _i < 2; ++_i) \
        __builtin_amdgcn_global_load_lds((const unsigned*)((const char*)(gbase) + (voff)[_i]), (LAS unsigned*)(lds + (bufoff) + ldsw + _i * 8192), 16, 0, 0); } while (0)
#define PG8_LDA(dst, b, h) do { _Pragma("unroll") for (int m = 0; m < 4; ++m) _Pragma("unroll") for (int k = 0; k < 2; ++k) dst[m][k] = *(const LAS bf16x8*)(lds + PG8_SA(b, h) + aoff + m * 2048 + k * 1024); } while (0)
#define PG8_LDB(dst, b, h) do { _Pragma("unroll") for (int n = 0; n < 2; ++n) _Pragma("unroll") for (int k = 0; k < 2; ++k) dst[n][k] = *(const LAS bf16x8*)(lds + PG8_SB(b, h) + boff + n * 2048 + k * 1024); } while (0)
#define PG8_MMA(ai, bj, At, Bt) do { __builtin_amdgcn_s_setprio(1); _Pragma("unroll") for (int m = 0; m < 4; ++m) _Pragma("unroll") for (int n = 0; n < 2; ++n) _Pragma("unroll") for (int k = 0; k < 2; ++k) \
        acc[ai][bj][m][n] = __builtin_amdgcn_mfma_f32_16x16x32_bf16(Bt[n][k], At[m][k], acc[ai][bj][m][n], 0, 0, 0); __builtin_amdgcn_s_setprio(0); } while (0)
#define PG8_WAIT_V(n) asm volatile("s_waitcnt vmcnt(" #n ")" ::: "memory")
#define PG8_WAIT_L(n) asm volatile("s_waitcnt lgkmcnt(" #n ")" ::: "memory")
#define PG8_BAR __builtin_amdgcn_s_barrier()
#define PG8_SCHED __builtin_amdgcn_sched_barrier(0)
#pragma unroll
    for (int a = 0; a < 2; ++a)
#pragma unroll
        for (int b = 0; b < 2; ++b)
#pragma unroll
            for (int m = 0; m < 4; ++m)
#pragma unroll
                for (int n = 0; n < 2; ++n) acc[a][b][m][n] = (f32x4){0.f, 0.f, 0.f, 0.f};
    bf16x8 At[4][2], B0[2][2], B1[2][2];
    const char* cA = (const char*)g.A + (size_t)cur.z * g.zA + (size_t)cur.pm * tstepA + (size_t)cur.kt0 * kstep; const char* cB = (const char*)g.Bt + (size_t)cur.z * g.zB + (size_t)cur.pn * tstepB + (size_t)cur.kt0 * kstep;
    PG8_STAGE(PG8_SB(0, 0), cB, voffB); PG8_STAGE(PG8_SB(0, 1), cB + hstepB, voffB); PG8_STAGE(PG8_SA(0, 0), cA, voffA); PG8_STAGE(PG8_SA(0, 1), cA + hstepA, voffA);
    if (wr == 1) PG8_BAR;
    PG8_WAIT_V(2); PG8_BAR;
    PG8_STAGE(PG8_SB(1, 0), cB + kstep, voffB); PG8_STAGE(PG8_SA(1, 0), cA + kstep, voffA); PG8_STAGE(PG8_SB(1, 1), cB + hstepB + kstep, voffB);
    PG8_WAIT_V(6); PG8_BAR;
    for (;;) {
        const bool has_next = S.next(ui + 1, nxt);
        const char* nA = has_next ? (const char*)g.A + (size_t)nxt.z * g.zA + (size_t)nxt.pm * tstepA + (size_t)nxt.kt0 * kstep : cA; const char* nB = has_next ? (const char*)g.Bt + (size_t)nxt.z * g.zB + (size_t)nxt.pn * tstepB + (size_t)nxt.kt0 * kstep : cB;
        const int nt = S.nkt;
        for (int t = 0; t < nt; t += 2) {
            const bool last = (t == nt - 2);
            const char* a1 = cA + (size_t)(t + 1) * kstep;
            const char* a2 = last ? nA : cA + (size_t)(t + 2) * kstep; const char* b2 = last ? nB : cB + (size_t)(t + 2) * kstep;
            const char* a3 = a2 + kstep; const char* b3 = b2 + kstep;
            PG8_LDB(B0, 0, 0); PG8_LDB(B1, 0, 1); PG8_SCHED; PG8_LDA(At, 0, 0); PG8_STAGE(PG8_SA(1, 1), a1 + hstepA, voffA);
            PG8_WAIT_V(8); PG8_WAIT_L(0); PG8_BAR; PG8_MMA(0, 0, At, B0); PG8_MMA(0, 1, At, B1); PG8_BAR; PG8_SCHED;
            PG8_LDA(At, 0, 1); PG8_STAGE(PG8_SB(0, 0), b2, voffB); PG8_STAGE(PG8_SB(0, 1), b2 + hstepB, voffB); PG8_STAGE(PG8_SA(0, 0), a2, voffA);
            PG8_WAIT_V(8); PG8_WAIT_L(0); PG8_BAR; PG8_MMA(1, 0, At, B0); PG8_MMA(1, 1, At, B1); PG8_BAR; PG8_SCHED;
            PG8_LDB(B0, 1, 0); PG8_LDB(B1, 1, 1); PG8_SCHED; PG8_LDA(At, 1, 0); PG8_STAGE(PG8_SA(0, 1), a2 + hstepA, voffA);
            PG8_WAIT_V(8); PG8_WAIT_L(0); PG8_BAR; PG8_MMA(0, 0, At, B0); PG8_MMA(0, 1, At, B1); PG8_BAR; PG8_SCHED;
            PG8_LDA(At, 1, 1); PG8_STAGE(PG8_SB(1, 0), b3, voffB); PG8_STAGE(PG8_SB(1, 1), b3 + hstepB, voffB); PG8_STAGE(PG8_SA(1, 0), a3, voffA);
            PG8_WAIT_V(8); PG8_WAIT_L(0); PG8_BAR; PG8_MMA(1, 0, At, B0); PG8_MMA(1, 1, At, B1); PG8_BAR; PG8_SCHED;
        }
        if (wr == 0) PG8_BAR;
        E(acc, cur, wr, wc, fr, fq);
        if (!has_next) break;
#pragma unroll
        for (int a = 0; a < 2; ++a)
#pragma unroll
            for (int b = 0; b < 2; ++b)
#pragma unroll
                for (int m = 0; m < 4; ++m)
#pragma unroll
                    for (int n = 0; n < 2; ++n) acc[a][b][m][n] = (f32x4){0.f, 0.f, 0.f, 0.f};
        cur = nxt; cA = nA; cB = nB; ++ui;
        if (wr == 1) PG8_BAR;
    }
    PG8_WAIT_V(0);
    PG8_BAR;
#undef PG8_SA
#undef PG8_SB
#undef PG8_STAGE
#undef PG8_LDA
#undef PG8_LDB
#undef PG8_MMA
#undef PG8_WAIT_V
#undef PG8_WAIT_L
#undef PG8_BAR
#undef PG8_SCHED
#endif
}

struct Args {
    const float* in[42]; float* out; unsigned char* ws;
    int ph_lo, ph_hi;
};
struct Ctx {
    const float* const* in; float* out; unsigned char* ws;
    LAS unsigned char* lds; int tid, lane, wave, G, bid;
};
DI float* xrow_ptr(const Ctx& C, int row) { return row < M_LAT ? C.out + (size_t)row * D : (float*)(C.ws + WS_XC) + (size_t)(row - M_LAT) * D; }
DI const bf16* wl(const Ctx& C, int l, size_t off) { return (const bf16*)(C.ws + WS_W + (size_t)l * SZ_WL + off); }
DI float* bias_ptr(const Ctx& C, int l, int which  ) { return (float*)(C.ws + WS_BIAS + (size_t)l * SZ_BIAS_L + (which == 0 ? 0 : which == 1 ? SZ_BIAS_GU : SZ_BIAS_GU + SZ_BIAS_IN)); }
DI float* rowss_ptr(const Ctx& C, int l, int sub) { return (float*)(C.ws + WS_ROWSS) + ((size_t)l * 3 + sub) * M; }
DI const float* gs_ptr(const Ctx& C, int l, int sub, int s) { return (const float*)(C.ws + WS_GS) + (((size_t)l * 3 + sub) * 3 + s) * D; }
DI const float* gate_ptr(const Ctx& C, int l, int sub, int s) { return (const float*)(C.ws + WS_GATE) + (((size_t)l * 3 + sub) * 3 + s) * D; }
DI float* rw_arr(const Ctx& C, int a) { return (float*)(C.ws + WS_RW + (size_t)a * SZ_RWA); }
enum { I_X = 0, I_C, I_CTX, I_CCTX, I_WADA, I_BADA, I_NORMG, I_F1WG, I_F1WU, I_F1WD, I_F2WG, I_F2WU, I_F2WD, I_WIN, I_WOUT, I_NAQG, I_NAKG, I_NARPB, I_RWCONV, I_RWW0, I_RWWUP, I_RWA0, I_RWAUP,
       I_RWGUP, I_RWKK, I_RWKA, I_RWRK, I_RWGNW, I_RWGNB, I_WAQG, I_WAKG, I_WASINK, I_S5ARE, I_S5AIM, I_S5LDT, I_S5BRE, I_S5BIM, I_S5CRE, I_S5CIM, I_S5D, I_S5GLUW, I_S5GLUB, I_NIN };

struct EpiGU {
    const float* rowss; const float* bias  ; bf16* H; int mrows;
    DI void operator()(const f32x4 (&acc)[2][2][4][2], const Unit& u, int wr, int wc, int fr_, int fq_) const {
        int tz_ = threadIdx.x; OPAQUE(tz_); const int fr = tz_ & 15, fq = (tz_ & 63) >> 4; (void)fr_; (void)fq_;
        const int s = stream_of_panel(u.pm); const float* bs = bias + (size_t)s * 2 * FF + u.pn * 256 + wc * 32 + 4 * fq;
        f32x4 bg[2], bu[2];
#pragma unroll
        for (int n = 0; n < 2; ++n) { bg[n] = *(const f32x4*)(bs + 16 * n); bu[n] = *(const f32x4*)(bs + 128 + 16 * n); }
#pragma unroll
        for (int ai = 0; ai < 2; ++ai)
#pragma unroll
            for (int m = 0; m < 4; ++m) {
                const int row = u.pm * 256 + ai * 128 + wr * 64 + m * 16 + fr;
                const float rstd = __builtin_amdgcn_rsqf(rowss[row] * (1.0f / D) + NORM_EPS);
                bf16* hp = H + (size_t)row * FF + u.pn * 128 + wc * 32 + 8 * fq;
                u32x4 w;
                { const f32x4 g = acc[ai][0][m][0] * rstd + bg[0], v = acc[ai][1][m][0] * rstd + bu[0]; w.x = pk2(siluf(g[0]) * v[0], siluf(g[1]) * v[1]); w.y = pk2(siluf(g[2]) * v[2], siluf(g[3]) * v[3]); }
                { const f32x4 g = acc[ai][0][m][1] * rstd + bg[1], v = acc[ai][1][m][1] * rstd + bu[1]; w.z = pk2(siluf(g[0]) * v[0], siluf(g[1]) * v[1]); w.w = pk2(siluf(g[2]) * v[2], siluf(g[3]) * v[3]); }
                *(u32x4*)hp = w;
            }
    }
};
struct EpiRes {
    const Ctx* C; const float* gate  ; const float* gsn  ; float* rowss_next; bf16* AP;
    DI void operator()(const f32x4 (&acc)[2][2][4][2], const Unit& u, int wr, int wc, int fr_, int fq_) const {
        int tz_ = threadIdx.x; OPAQUE(tz_); const int fr = tz_ & 15, fq = (tz_ & 63) >> 4; (void)fr_; (void)fq_;
        const int s = stream_of_panel(u.pm); const int col0 = u.pn * 256 + wc * 32 + 4 * fq;
        f32x4 gv[2][2], sv[2][2];
#pragma unroll
        for (int bj = 0; bj < 2; ++bj)
#pragma unroll
            for (int n = 0; n < 2; ++n) { gv[bj][n] = *(const f32x4*)(gate + (size_t)s * D + col0 + bj * 128 + n * 16); sv[bj][n] = gsn ? *(const f32x4*)(gsn + (size_t)s * D + col0 + bj * 128 + n * 16) : (f32x4){0.f, 0.f, 0.f, 0.f}; }
#pragma unroll
        for (int ai = 0; ai < 2; ++ai)
#pragma unroll
            for (int m = 0; m < 4; ++m) {
                const int row = u.pm * 256 + ai * 128 + wr * 64 + m * 16 + fr;
                float* xp = xrow_ptr(*C, row) + col0; float ss = 0.f;
#pragma unroll
                for (int bj = 0; bj < 2; ++bj)
#pragma unroll
                    for (int n = 0; n < 2; ++n) { f32x4 x = *(const f32x4*)(xp + bj * 128 + n * 16); x += gv[bj][n] * acc[ai][bj][m][n]; *(f32x4*)(xp + bj * 128 + n * 16) = x;
                        if (gsn) { ss += (x[0] * x[0] + x[1] * x[1]) + (x[2] * x[2] + x[3] * x[3]); const f32x4 a = x * sv[bj][n]; u32x2 w; w.x = pk2(a[0], a[1]); w.y = pk2(a[2], a[3]);
                            *(u32x2*)(AP + (size_t)row * D + col0 + bj * 128 + n * 16) = w; } }
                if (gsn) { ss += __shfl_xor(ss, 16); ss += __shfl_xor(ss, 32); if (fq == 0) atomicAdd(rowss_next + row, ss); }
            }
    }
};
struct EpiAcc {
    const Ctx* C; const float* gate;
    DI void operator()(const f32x4 (&acc)[2][2][4][2], const Unit& u, int wr, int wc, int fr_, int fq_) const {
        int tz_ = threadIdx.x; OPAQUE(tz_); const int fr = tz_ & 15, fq = (tz_ & 63) >> 4; (void)fr_; (void)fq_;
        const int s = stream_of_panel(u.pm); const int col0 = u.pn * 256 + wc * 32 + 4 * fq;
#pragma unroll
        for (int bj = 0; bj < 2; ++bj)
#pragma unroll
            for (int n = 0; n < 2; ++n) { const f32x4 gv = *(const f32x4*)(gate + (size_t)s * D + col0 + bj * 128 + n * 16);
#pragma unroll
                for (int ai = 0; ai < 2; ++ai)
#pragma unroll
                    for (int m = 0; m < 4; ++m) { float* xp = xrow_ptr(*C, u.pm * 256 + ai * 128 + wr * 64 + m * 16 + fr) + col0 + bj * 128 + n * 16; const f32x4 d = gv * acc[ai][bj][m][n];
#pragma unroll
                        for (int j = 0; j < 4; ++j) atomicAdd(xp + j, d[j]); } }
    }
};
struct EpiIn {
    const Ctx* C; const float* rowss; const float* bias  ; int l;
    DI void operator()(const f32x4 (&acc)[2][2][4][2], const Unit& u, int wr, int wc, int fr_, int fq_) const {
        int tz_ = threadIdx.x; OPAQUE(tz_); const int fr = tz_ & 15, fq = (tz_ & 63) >> 4; (void)fr_; (void)fq_;
        const int s = stream_of_panel(u.pm), pn = u.pn; const float* bs = bias + (size_t)s * NINP + pn * 256 + wc * 32 + 4 * fq;
        unsigned char* ws = C->ws;
        f32x4 bv[2][2];
#pragma unroll
        for (int bj = 0; bj < 2; ++bj)
#pragma unroll
            for (int n = 0; n < 2; ++n) bv[bj][n] = *(const f32x4*)(bs + bj * 128 + n * 16);
        const bool permuted = pn < PN_AV || (pn >= PN_CQ && pn < PN_DU);
        if (permuted) {
            const bool is_ckv = pn == PN_CKV, is_c = pn >= PN_CQ, is_q = pn < PN_AK || (pn >= PN_CQ && pn < PN_CKV);
            const bool plain_v = is_ckv && wc >= 2;
            const float* gsrc = C->in[is_c ? (is_q ? I_WAQG : I_WAKG) : (is_q ? I_NAQG : I_NAKG)] + (size_t)l * 64;
            f32x4 gn[2][2];
#pragma unroll
            for (int bj = 0; bj < 2; ++bj)
#pragma unroll
                for (int n = 0; n < 2; ++n) { gn[bj][n] = *(const f32x4*)(gsrc + 32 * bj + 16 * n + 4 * fq); if (is_q) gn[bj][n] *= 0.125f; }
            bf16* dst; int pitch, hcol;
            if (pn < PN_AK) { dst = (bf16*)(ws + WS_QA); pitch = GW; hcol = ((pn - PN_AQ) * 4 + wc) * 64; }
            else if (pn < PN_AV) { dst = (bf16*)(ws + WS_KA); pitch = GW; hcol = ((pn - PN_AK) * 4 + wc) * 64; }
            else if (pn < PN_CKV) { dst = (bf16*)(ws + WS_QC); pitch = GW; hcol = ((pn - PN_CQ) * 4 + wc) * 64; }
            else if (wc < 2) { dst = (bf16*)(ws + WS_KC); pitch = 128; hcol = wc * 64; }
            else { dst = (bf16*)(ws + WS_VC); pitch = 128; hcol = (wc - 2) * 64; }
            const f32x4* rope = (const f32x4*)(ws + WS_ROPE);
#pragma unroll
            for (int ai = 0; ai < 2; ++ai)
#pragma unroll
                for (int m = 0; m < 4; ++m) {
                    const int row = pn * 0 + u.pm * 256 + ai * 128 + wr * 64 + m * 16 + fr;
                    const float rstd = __builtin_amdgcn_rsqf(rowss[row] * (1.0f / D) + NORM_EPS);
                    f32x4 v[2][2]; float ss = 0.f;
#pragma unroll
                    for (int bj = 0; bj < 2; ++bj)
#pragma unroll
                        for (int n = 0; n < 2; ++n) { v[bj][n] = acc[ai][bj][m][n] * rstd + bv[bj][n]; ss += (v[bj][n][0] * v[bj][n][0] + v[bj][n][1] * v[bj][n][1]) + (v[bj][n][2] * v[bj][n][2] + v[bj][n][3] * v[bj][n][3]); }
                    ss += __shfl_xor(ss, 16); ss += __shfl_xor(ss, 32);
                    if (!plain_v) { const float rs = 1.0f / sqrtf(ss * (1.0f / 64.0f) + NORM_EPS);
#pragma unroll
                        for (int bj = 0; bj < 2; ++bj)
#pragma unroll
                            for (int n = 0; n < 2; ++n) v[bj][n] = v[bj][n] * rs * gn[bj][n];
                        if (is_c && row < M_LAT) {
                            const int t = row % T; const int pos[2] = {t / GRW, t % GRW};
#pragma unroll
                            for (int bj = 0; bj < 2; ++bj) { const f32x4 cs0 = rope[(pos[bj] * 16 + 4 * fq) / 2], cs1 = rope[(pos[bj] * 16 + 4 * fq) / 2 + 1];
                                const float cc[4] = {cs0[0], cs0[2], cs1[0], cs1[2]}, sn[4] = {cs0[1], cs0[3], cs1[1], cs1[3]};
#pragma unroll
                                for (int j = 0; j < 4; ++j) { const float x1 = v[bj][0][j], x2 = v[bj][1][j]; v[bj][0][j] = x1 * cc[j] - x2 * sn[j]; v[bj][1][j] = x2 * cc[j] + x1 * sn[j]; } }
                        }
                    }
                    bf16* op = dst + (size_t)row * pitch + hcol + 4 * fq;
#pragma unroll
                    for (int bj = 0; bj < 2; ++bj)
#pragma unroll
                        for (int n = 0; n < 2; ++n) { u32x2 w; w.x = pk2(v[bj][n][0], v[bj][n][1]); w.y = pk2(v[bj][n][2], v[bj][n][3]); *(u32x2*)(op + 32 * bj + 16 * n) = w; }
                }
        } else {
#pragma unroll
            for (int ai = 0; ai < 2; ++ai)
#pragma unroll
                for (int m = 0; m < 4; ++m) {
                    const int row = u.pm * 256 + ai * 128 + wr * 64 + m * 16 + fr;
                    const float rstd = __builtin_amdgcn_rsqf(rowss[row] * (1.0f / D) + NORM_EPS);
#pragma unroll
                    for (int bj = 0; bj < 2; ++bj)
#pragma unroll
                        for (int n = 0; n < 2; ++n) { const f32x4 v = acc[ai][bj][m][n] * rstd + bv[bj][n]; const int c = bj * 128 + wc * 32 + n * 16 + 4 * fq;
                            u32x2 w; w.x = pk2(v[0], v[1]); w.y = pk2(v[2], v[3]);
                            if (pn < PN_BR) *(u32x2*)((bf16*)(ws + WS_VA) + (size_t)row * GW + (pn - PN_AV) * 256 + c) = w;
                            else if (pn < PN_BS) *(u32x2*)((bf16*)(ws + WS_PB) + (size_t)row * 3 * GW + (pn - PN_BR) * 256 + c) = w;
                            else if (pn == PN_BS) { if (c < 160) *(f32x4*)((float*)(ws + WS_PS) + (size_t)row * 160 + c) = v; }
                            else { const int cu = (pn - PN_DU) * 256 + c, gq = cu >> 4, p0 = cu & 15;
                                *(u32x2*)((bf16*)(ws + WS_UG) + ((size_t)gq * NCHP + row / S5L) * S5K + (row % S5L) * 16 + p0) = w; } }
                }
        }
    }
};
struct EpiS5A {
    float* XE;
    DI void operator()(const f32x4 (&acc)[2][2][4][2], const Unit& u, int wr, int wc, int fr_, int fq_) const {
        int tz_ = threadIdx.x; OPAQUE(tz_); const int fr = tz_ & 15, fq = (tz_ & 63) >> 4; (void)fr_; (void)fq_;
#pragma unroll
        for (int ai = 0; ai < 2; ++ai)
#pragma unroll
            for (int m = 0; m < 4; ++m) { const int ch = u.pm * 256 + ai * 128 + wr * 64 + m * 16 + fr; if (ch < NCH) { float* p = XE + ((size_t)u.z * NCHP + ch) * 256 + wc * 32 + 4 * fq;
#pragma unroll
                for (int bj = 0; bj < 2; ++bj)
#pragma unroll
                    for (int n = 0; n < 2; ++n) *(f32x4*)(p + bj * 128 + n * 16) = acc[ai][bj][m][n]; } }
    }
};
struct EpiS5C {
    const bf16* UG; const float* dsk  ; bf16* YG;
    DI void operator()(const f32x4 (&acc)[2][2][4][2], const Unit& u, int wr, int wc, int fr_, int fq_) const {
        int tz_ = threadIdx.x; OPAQUE(tz_); const int fr = tz_ & 15, fq = (tz_ & 63) >> 4; (void)fr_; (void)fq_;
        const int g = u.z;
#pragma unroll
        for (int ai = 0; ai < 2; ++ai)
#pragma unroll
            for (int m = 0; m < 4; ++m) { const int ch = u.pm * 256 + ai * 128 + wr * 64 + m * 16 + fr; if (ch < NCH) {
#pragma unroll
                for (int bj = 0; bj < 2; ++bj)
#pragma unroll
                    for (int n = 0; n < 2; ++n) { const int col = u.pn * 256 + bj * 128 + wc * 32 + n * 16 + 4 * fq, i = col >> 4, p0 = col & 15;
                        const u32x2 uw = *(const u32x2*)(UG + ((size_t)g * NCHP + ch) * S5K + col); const f32x4 dv = *(const f32x4*)(dsk + 16 * g + p0);
                        const f32x4 a = acc[ai][bj][m][n]; const float y0 = a[0] + dv[0] * bflo(uw.x), y1 = a[1] + dv[1] * bfhi(uw.x), y2 = a[2] + dv[2] * bflo(uw.y), y3 = a[3] + dv[3] * bfhi(uw.y);
                        u32x2 w; w.x = pk2(geluf(y0), geluf(y1)); w.y = pk2(geluf(y2), geluf(y3));
                        *(u32x2*)(YG + (size_t)(ch * S5L + i) * GW + 16 * g + p0) = w; } } }
    }
};
struct EpiGLU {
    const bf16* YG; const float* gb; bf16* OB;
    DI void operator()(const f32x4 (&acc)[2][2][4][2], const Unit& u, int wr, int wc, int fr_, int fq_) const {
        int tz_ = threadIdx.x; OPAQUE(tz_); const int fr = tz_ & 15, fq = (tz_ & 63) >> 4; (void)fr_; (void)fq_;
#pragma unroll
        for (int ai = 0; ai < 2; ++ai)
#pragma unroll
            for (int m = 0; m < 4; ++m) { const int row = u.pm * 256 + ai * 128 + wr * 64 + m * 16 + fr;
#pragma unroll
                for (int bj = 0; bj < 2; ++bj)
#pragma unroll
                    for (int n = 0; n < 2; ++n) { const int col = u.pn * 256 + bj * 128 + wc * 32 + n * 16 + 4 * fq; const f32x4 b = *(const f32x4*)(gb + col); const f32x4 a = acc[ai][bj][m][n] + b;
                        const u32x2 yw = *(const u32x2*)(YG + (size_t)row * GW + col);
                        u32x2 w; w.x = pk2(bflo(yw.x) * sigmf(a[0]), bfhi(yw.x) * sigmf(a[1])); w.y = pk2(bflo(yw.y) * sigmf(a[2]), bfhi(yw.y) * sigmf(a[3]));
                        *(u32x2*)(OB + (size_t)row * D + 3 * GW + col) = w; } }
    }
};

DI void ph_ada(const Ctx& C) {
    LAS float* sc = (LAS float*)C.lds;
    LAS float* red = sc + 3 * D;
    for (int i = C.tid; i < 3 * D; i += NTHR) { const int s = i / D, k = i % D; const float c = s < NB ? C.in[I_C][s * D + k] : C.in[I_CCTX][k]; sc[i] = siluf(c); }
    __syncthreads();
    const int nun = NL * (9 * D / 256);
    for (int un = C.bid; un < nun; un += C.G) {
        const int l = un / (9 * D / 256), col0 = (un % (9 * D / 256)) * 256;
        const float* W = C.in[I_WADA] + (size_t)l * D * 9 * D + col0 + 4 * C.lane;
        f32x4 a0 = {0.f, 0.f, 0.f, 0.f}, a1 = a0, a2 = a0;
        const int k0 = C.wave * (D / 8);
#pragma unroll 1
        for (int kb = k0; kb < k0 + D / 8; kb += 16) {
            f32x4 wv[16];
#pragma unroll
            for (int u = 0; u < 16; ++u) wv[u] = *(const f32x4*)(W + (size_t)(kb + u) * 9 * D);
#pragma unroll
            for (int u = 0; u < 16; ++u) { a0 += wv[u] * sc[kb + u]; a1 += wv[u] * sc[D + kb + u]; a2 += wv[u] * sc[2 * D + kb + u]; } }
        LAS float* r = red + C.wave * 768 + 4 * C.lane;
        *(LAS f32x4*)(r) = a0; *(LAS f32x4*)(r + 256) = a1; *(LAS f32x4*)(r + 512) = a2;
        __syncthreads();
        for (int i = C.tid; i < 768; i += NTHR) { float s = 0.f;
#pragma unroll
            for (int w = 0; w < 8; ++w) s += red[w * 768 + i];
            const int st = i / 256, c = col0 + (i % 256);
            ((float*)(C.ws + WS_MODV))[((size_t)l * 3 + st) * 9 * D + c] = s + C.in[I_BADA][(size_t)l * 9 * D + c]; }
        __syncthreads();
    }
}
DI const float* modv_ptr(const Ctx& C, int l, int s, int chunk) { return (const float*)(C.ws + WS_MODV) + ((size_t)l * 3 + s) * 9 * D + (size_t)chunk * D; }

DI int win_dest(int n) {
    if (n >= D_IN) return -1;
    if (n < SRC_AV) { const int piece = n / GW, loc = n % GW, head = loc / 64, d = loc % 64; return ((piece == 0 ? PN_AQ : PN_AK) + head / 4) * 256 + 128 * (d / 32) + 32 * (head % 4) + (d % 32); }
    if (n < SRC_BS) return PN_AV * 256 + (n - SRC_AV);
    if (n < SRC_CQ) return PN_BS * 256 + (n - SRC_BS);
    if (n < SRC_CK) { const int loc = n - SRC_CQ, head = loc / 64, d = loc % 64; return (PN_CQ + head / 4) * 256 + 128 * (d / 32) + 32 * (head % 4) + (d % 32); }
    if (n < SRC_DU) { const int loc = n - SRC_CK, hh = loc / 64, d = loc % 64; return PN_CKV * 256 + 128 * (d / 32) + 32 * hh + (d % 32); }
    return PN_DU * 256 + (n - SRC_DU);
}
DI int gu_dest(int n) { const int e = n & 31; return (n / 128) * 256 + (n % 128 - e) + 16 * ((e >> 2) & 1) + 4 * (e >> 3) + (e & 3); }
DI void conv_item(const Ctx& C, const float* W, int K, int N, bf16* Wt, int mode, int k0, int n0, float* bias, int bias_pitch, const float* shift  ) {
    LAS float* scr = (LAS float*)(C.lds + C.wave * 16640);
    const int n = n0 + C.lane; const bool ok = n < N; float b0 = 0.f, b1 = 0.f, b2 = 0.f;
#pragma unroll 1
    for (int kh = 0; kh < 4; ++kh) {
        float wv[16];
#pragma unroll
        for (int kk = 0; kk < 16; ++kk) wv[kk] = ok ? W[(size_t)(k0 + 16 * kh + kk) * N + n] : 0.f;
#pragma unroll
        for (int kk = 0; kk < 16; ++kk) { const float v = wv[kk]; scr[(16 * kh + kk) * 65 + C.lane] = v;
            if (bias) { b0 += shift[k0 + 16 * kh + kk] * v; b1 += shift[9 * D + k0 + 16 * kh + kk] * v; b2 += shift[18 * D + k0 + 16 * kh + kk] * v; } } }
    WSYNC();
    const int dme = !ok ? -1 : mode == 0 ? n : mode == 1 ? gu_dest(n) : mode == 2 ? gu_dest(n) + 128 : win_dest(n);
    if (bias && dme >= 0) { atomicAdd(bias + dme, b0); atomicAdd(bias + bias_pitch + dme, b1); atomicAdd(bias + 2 * bias_pitch + dme, b2); }
    const int c = C.lane & 7;
#pragma unroll
    for (int i = 0; i < 8; ++i) { const int nl = (C.lane >> 3) + 8 * i, nn = n0 + nl;
        const int dr = nn >= N ? -1 : mode == 0 ? nn : mode == 1 ? gu_dest(nn) : mode == 2 ? gu_dest(nn) + 128 : win_dest(nn);
        const LAS float* s = scr + (8 * c) * 65 + nl;
        u32x4 o; o.x = pk2(s[0], s[65]); o.y = pk2(s[2 * 65], s[3 * 65]); o.z = pk2(s[4 * 65], s[5 * 65]); o.w = pk2(s[6 * 65], s[7 * 65]);
        if (dr >= 0) *(u32x4*)(Wt + (size_t)dr * K + k0 + 8 * c) = o; }
    WSYNC();
}
struct Cplx { float re, im; };
DI Cplx cmul(Cplx a, Cplx b) { return Cplx{a.re * b.re - a.im * b.im, a.re * b.im + a.im * b.re}; }
DI Cplx s5_lam_pow(const Ctx& C, int l, int dir, int g, int n, float tau) {
    const size_t i = (((size_t)l * 2 + dir) * S5G + g) * 64 + n; const float dt = __expf(C.in[I_S5LDT][((size_t)l * 2 + dir) * S5G + g]);
    const float mag = __expf(tau * dt * C.in[I_S5ARE][i]), ang = tau * dt * C.in[I_S5AIM][i]; float sn, cs; sincosf(ang, &sn, &cs); return Cplx{mag * cs, mag * sn};
}
DI Cplx s5_coef(const Ctx& C, int l, int dir, int g, int n) {
    const size_t i = (((size_t)l * 2 + dir) * S5G + g) * 64 + n; const float are = C.in[I_S5ARE][i], aim = C.in[I_S5AIM][i];
    const Cplx ab = s5_lam_pow(C, l, dir, g, n, 1.0f); const float den = are * are + aim * aim, nr = ab.re - 1.0f;
    return Cplx{(nr * are + ab.im * aim) / den, (ab.im * are - nr * aim) / den};
}
DI Cplx s5_beta(const Ctx& C, int l, int dir, int g, int n, int q) {
    const size_t i = (((size_t)l * S5G + g) * 64 + n) * 16 + q; return cmul(s5_coef(C, l, dir, g, n), Cplx{C.in[I_S5BRE][i], C.in[I_S5BIM][i]});
}
DI Cplx s5_gamma(const Ctx& C, int l, int g, int p, int n) { const size_t i = (((size_t)l * S5G + g) * 16 + p) * 64 + n; return Cplx{C.in[I_S5CRE][i], C.in[I_S5CIM][i]}; }

constexpr int CI_GU = (D / 64) * (FF / 64), CI_DN = (FF / 64) * (D / 64), CI_IN = (D / 64) * ((D_IN + 63) / 64), CI_OUT = (D / 64) * (D / 64), CI_GLU = (GW / 64) * (GW / 64);
constexpr int CI_LAYER = 4 * CI_GU + 2 * CI_DN + CI_IN + CI_OUT + CI_GLU;
DI void conv_weights(const Ctx& C, int l, int wslot, int nslots) {
    for (int it = wslot; it < CI_LAYER; it += nslots) {
        int r = it;
        unsigned char* wbase = C.ws + WS_W + (size_t)l * SZ_WL;
        if (r < 2 * CI_GU) { const int up = r >= CI_GU; r -= up * CI_GU; const int kb = r / (FF / 64), nb = r % (FF / 64);
            conv_item(C, C.in[up ? I_F1WU : I_F1WG] + (size_t)l * D * FF, D, FF, (bf16*)(wbase + OFF_W1GU), 1 + up, kb * 64, nb * 64, bias_ptr(C, l, 0), 2 * FF, modv_ptr(C, l, 0, 0)); continue; } r -= 2 * CI_GU;
        if (r < CI_DN) { const int kb = r / (D / 64), nb = r % (D / 64); conv_item(C, C.in[I_F1WD] + (size_t)l * FF * D, FF, D, (bf16*)(wbase + OFF_W1D), 0, kb * 64, nb * 64, nullptr, 0, nullptr); continue; } r -= CI_DN;
        if (r < CI_IN) { const int nbn = (D_IN + 63) / 64, kb = r / nbn, nb = r % nbn; conv_item(C, C.in[I_WIN] + (size_t)l * D * D_IN, D, D_IN, (bf16*)(wbase + OFF_WIN), 3, kb * 64, nb * 64, bias_ptr(C, l, 1), NINP, modv_ptr(C, l, 0, 3)); continue; } r -= CI_IN;
        if (r < CI_OUT) { const int kb = r / (D / 64), nb = r % (D / 64); conv_item(C, C.in[I_WOUT] + (size_t)l * D * D, D, D, (bf16*)(wbase + OFF_WOUT), 0, kb * 64, nb * 64, nullptr, 0, nullptr); continue; } r -= CI_OUT;
        if (r < 2 * CI_GU) { const int up = r >= CI_GU; r -= up * CI_GU; const int kb = r / (FF / 64), nb = r % (FF / 64);
            conv_item(C, C.in[up ? I_F2WU : I_F2WG] + (size_t)l * D * FF, D, FF, (bf16*)(wbase + OFF_W2GU), 1 + up, kb * 64, nb * 64, bias_ptr(C, l, 2), 2 * FF, modv_ptr(C, l, 0, 6)); continue; } r -= 2 * CI_GU;
        if (r < CI_DN) { const int kb = r / (D / 64), nb = r % (D / 64); conv_item(C, C.in[I_F2WD] + (size_t)l * FF * D, FF, D, (bf16*)(wbase + OFF_W2D), 0, kb * 64, nb * 64, nullptr, 0, nullptr); continue; } r -= CI_DN;
        { const int kb = r / (GW / 64), nb = r % (GW / 64); conv_item(C, C.in[I_S5GLUW] + (size_t)l * GW * GW, GW, GW, (bf16*)(wbase + OFF_WGLU), 0, kb * 64, nb * 64, nullptr, 0, nullptr); }
    }
}
DI void ph_conv(const Ctx& C) {
    const int gt = C.bid * NTHR + C.tid, GT = C.G * NTHR;
    for (int i = gt; i < NL * 9 * D; i += GT) { const int k = i % D, s = (i / D) % 3, sub = (i / (3 * D)) % 3, l = i / (9 * D);
        const float* mv = (const float*)(C.ws + WS_MODV) + ((size_t)l * 3 + s) * 9 * D;
        ((float*)(C.ws + WS_GS))[i] = C.in[I_NORMG][((size_t)l * 3 + sub) * D + k] * (1.0f + mv[(3 * sub + 1) * D + k]);
        ((float*)(C.ws + WS_GATE))[i] = mv[(3 * sub + 2) * D + k] * (sub == 1 ? 1.0f : 0.5f); }
    for (int i = gt; i < 128 * 16; i += GT) { const int pos = i / 16, f = i % 16; const float inv = __expf(-(float)f * (9.210340371976184f / 16.0f)); float sn, cs; sincosf((float)pos * inv, &sn, &cs);
        ((f32x2*)(C.ws + WS_ROPE))[i] = (f32x2){cs, sn}; }
    const int gw = C.bid * NW + C.wave, GWV = C.G * NW;
    conv_weights(C, 0, gw, GWV);
    for (int i = gt; i < NL * 14 * NH * 2 * 64 * 8; i += GT) {
        const int j = i & 7, ln = (i >> 3) & 63, tj = (i >> 9) & 1, hd = (i >> 10) % NH, f = (i / (1024 * NH)) % 14, l = i / (1024 * NH * 14);
        const int col = hd * 64 + 32 * tj + (ln & 31); float v;
        if (f < 8) { const int d = (f >> 1) & 1, sx = f & 1, k = 16 * sx + 8 * (ln >> 5) + j; v = C.in[f < 4 ? I_RWWUP : I_RWAUP][(((size_t)l * 2 + d) * 32 + k) * GW + col]; }
        else { const int k = 16 * (f - 8) + 8 * (ln >> 5) + j; v = C.in[I_RWGUP][((size_t)l * 96 + k) * GW + col]; }
        ((bf16*)(C.ws + WS_RWF))[i] = (bf16)f2bf(v); }
    LAS float* wsc = (LAS float*)(C.lds + C.wave * 16640);
    for (int it = gw; it < NL * S5G * 2 * S5L; it += GWV) {
        const int tau = it % S5L, dir = (it / S5L) % 2, g = (it / (2 * S5L)) % S5G, l = it / (2 * S5L * S5G);
        const Cplx z = cmul(s5_lam_pow(C, l, dir, g, C.lane, (float)tau), s5_coef(C, l, dir, g, C.lane));
#pragma unroll 4
        for (int q = 0; q < 16; ++q) { const size_t i = (((size_t)l * S5G + g) * 64 + C.lane) * 16 + q; const Cplx w = cmul(z, Cplx{C.in[I_S5BRE][i], C.in[I_S5BIM][i]}); wsc[(C.lane * 16 + q) * 2] = w.re; wsc[(C.lane * 16 + q) * 2 + 1] = w.im; }
        WSYNC();
        float* kc = (float*)(C.ws + WS_S5T + (size_t)l * SZ_S5L + OFF_S5KC) + (((size_t)g * 2 + dir) * S5L + tau) * 256;
#pragma unroll 1
        for (int e = 0; e < 4; ++e) { const int pq = C.lane + 64 * e, p = pq >> 4, q = pq & 15; float s = 0.f;
#pragma unroll 4
            for (int n = 0; n < 64; ++n) { const Cplx gm = s5_gamma(C, l, g, p, n); s += gm.re * wsc[(n * 16 + q) * 2] - gm.im * wsc[(n * 16 + q) * 2 + 1]; }
            kc[pq] = s; }
        WSYNC();
    }
    for (int i = gt; i < NL * 2 * GW * 4 * (S5L + 1); i += GT) { const int tau = i % (S5L + 1), r = i / (S5L + 1), n = r % 64, g = (r / 64) % S5G, dir = (r / (64 * S5G)) % 2, l = r / (2 * 64 * S5G);
        const Cplx z = s5_lam_pow(C, l, dir, g, n, (float)tau); ((f32x2*)(C.ws + WS_S5T + (size_t)l * SZ_S5L + OFF_S5LP))[((size_t)(dir * S5G + g) * 64 + n) * (S5L + 1) + tau] = (f32x2){z.re, z.im}; }
    for (int i = gt; i < NL * 2 * GW * 4 * 16; i += GT) { const int q = i % 16, r = i / 16, n = r % 64, g = (r / 64) % S5G, dir = (r / (64 * S5G)) % 2, l = r / (2 * 64 * S5G);
        const Cplx z = s5_beta(C, l, dir, g, n, q); ((f32x2*)(C.ws + WS_S5T + (size_t)l * SZ_S5L + OFF_S5BETA))[((size_t)(dir * S5G + g) * 64 + n) * 16 + q] = (f32x2){z.re, z.im}; }
    for (int i = gt; i < NL * 2 * GW * 4; i += GT) { const int n = i % 64, g = (i / 64) % S5G, dir = (i / (64 * S5G)) % 2, l = i / (2 * 64 * S5G); const Cplx z = s5_lam_pow(C, l, dir, g, n, (float)S5L);
        ((f32x2*)(C.ws + WS_S5T + (size_t)l * SZ_S5L + OFF_S5LAM))[(dir * S5G + g) * 64 + n] = (f32x2){z.re, z.im}; }
}
DI void ph_tab(const Ctx& C) {
    const long gt = (long)C.bid * NTHR + C.tid, GT = (long)C.G * NTHR;
    for (long i = gt; i < (long)NL * S5G * 256 * 512; i += GT) {
        const int k = (int)(i % 512), np = (int)((i / 512) % 256), g = (int)((i / (512 * 256)) % S5G), l = (int)(i / ((long)512 * 256 * S5G));
        const int j = k >> 4, q = k & 15, dir = np >> 7, n = np & 63, im = (np >> 6) & 1;
        const f32x2 lp = ((const f32x2*)(C.ws + WS_S5T + (size_t)l * SZ_S5L + OFF_S5LP))[((size_t)(dir * S5G + g) * 64 + n) * (S5L + 1) + (dir == 0 ? S5L - 1 - j : j)];
        const f32x2 be = ((const f32x2*)(C.ws + WS_S5T + (size_t)l * SZ_S5L + OFF_S5BETA))[((size_t)(dir * S5G + g) * 64 + n) * 16 + q];
        const Cplx w = cmul(Cplx{lp[0], lp[1]}, Cplx{be[0], be[1]});
        ((bf16*)(C.ws + WS_S5T + (size_t)l * SZ_S5L + OFF_S5ET))[((size_t)g * 256 + np) * 512 + k] = (bf16)f2bf(im ? w.im : w.re); }
    for (long i = gt; i < (long)NL * S5G * 512 * S5K; i += GT) {
        const int k = (int)(i % S5K), nn = (int)((i / S5K) % 512), g = (int)((i / ((long)S5K * 512)) % S5G), l = (int)(i / ((long)S5K * 512 * S5G));
        const int ti = nn >> 4, p = nn & 15; float v;
        if (k < 512) { const int j = k >> 4, q = k & 15; const float* kc = (const float*)(C.ws + WS_S5T + (size_t)l * SZ_S5L + OFF_S5KC) + (size_t)g * 2 * S5L * 256;
            v = 0.f; if (j <= ti) v += kc[((ti - j)) * 256 + p * 16 + q]; if (j >= ti) v += kc[(S5L + (j - ti)) * 256 + p * 16 + q]; }
        else { const int kk = k - 512, dir = kk >> 7, im = (kk >> 6) & 1, n = kk & 63;
            const f32x2 lp = ((const f32x2*)(C.ws + WS_S5T + (size_t)l * SZ_S5L + OFF_S5LP))[((size_t)(dir * S5G + g) * 64 + n) * (S5L + 1) + (dir == 0 ? ti + 1 : S5L - ti)];
            const Cplx w = cmul(s5_gamma(C, l, g, p, n), Cplx{lp[0], lp[1]}); v = im ? -w.im : w.re; }
        ((bf16*)(C.ws + WS_S5T + (size_t)l * SZ_S5L + OFF_S5BT))[((size_t)g * 512 + nn) * S5K + k] = (bf16)f2bf(v); }
    const int gw = C.bid * NW + C.wave, GWV = C.G * NW;
    for (int row = gw; row < M; row += GWV) {
        const float* src = row < M_LAT ? C.in[I_X] + (size_t)row * D : C.in[I_CTX] + (size_t)(row - M_LAT) * D;
        float* dst = xrow_ptr(C, row); const float* gs = gs_ptr(C, 0, 0, stream_of_row(row)); bf16* ap = (bf16*)(C.ws + WS_AP) + (size_t)row * D; float ss = 0.f;
        for (int c = 4 * C.lane; c < D; c += 256) { const f32x4 x = *(const f32x4*)(src + c); *(f32x4*)(dst + c) = x; ss += (x[0] * x[0] + x[1] * x[1]) + (x[2] * x[2] + x[3] * x[3]);
            const f32x4 a = x * *(const f32x4*)(gs + c); u32x2 w; w.x = pk2(a[0], a[1]); w.y = pk2(a[2], a[3]); *(u32x2*)(ap + c) = w; }
        ss = wave_sum(ss); if (C.lane == 0) rowss_ptr(C, 0, 0)[row] = ss;
    }
}

#ifdef EMU
DI s16x4 tr_read1(const LAS unsigned char* a) { return emu_tr_read(a); }
#else
DI s16x4 tr_read1(const LAS unsigned char* a) { s16x4 r; asm volatile("ds_read_b64_tr_b16 %0, %1\n\ts_waitcnt lgkmcnt(0)" : "=&v"(r) : "v"((unsigned)(size_t)a) : "memory"); return r; }
#endif
DI bf16x8 tr_frag(const LAS unsigned char* a0, int hi_off) {
#ifdef EMU
    const s16x4 lo = emu_tr_read(a0), hi = emu_tr_read(a0 + hi_off);
#else
    s16x4 lo, hi; asm volatile("ds_read_b64_tr_b16 %0, %2\n\tds_read_b64_tr_b16 %1, %3\n\ts_waitcnt lgkmcnt(0)" : "=&v"(lo), "=&v"(hi) : "v"((unsigned)(size_t)a0), "v"((unsigned)(size_t)(a0 + hi_off)) : "memory");
#endif
    return __builtin_shufflevector(lo, hi, 0, 1, 2, 3, 4, 5, 6, 7);
}
DI void tr_frag4(const LAS unsigned char* a0, const LAS unsigned char* a1, const LAS unsigned char* a2, const LAS unsigned char* a3, int hi_off, bf16x8 (&f)[4]) {
#ifdef EMU
    f[0] = tr_frag(a0, hi_off); f[1] = tr_frag(a1, hi_off); f[2] = tr_frag(a2, hi_off); f[3] = tr_frag(a3, hi_off);
#else
    s16x4 l0, h0, l1, h1, l2, h2, l3, h3;
    asm volatile("ds_read_b64_tr_b16 %0, %8\n\tds_read_b64_tr_b16 %1, %9\n\tds_read_b64_tr_b16 %2, %10\n\tds_read_b64_tr_b16 %3, %11\n\tds_read_b64_tr_b16 %4, %12\n\tds_read_b64_tr_b16 %5, %13\n\tds_read_b64_tr_b16 %6, %14\n\tds_read_b64_tr_b16 %7, %15\n\ts_waitcnt lgkmcnt(0)"
        : "=&v"(l0), "=&v"(h0), "=&v"(l1), "=&v"(h1), "=&v"(l2), "=&v"(h2), "=&v"(l3), "=&v"(h3)
        : "v"((unsigned)(size_t)a0), "v"((unsigned)(size_t)(a0 + hi_off)), "v"((unsigned)(size_t)a1), "v"((unsigned)(size_t)(a1 + hi_off)), "v"((unsigned)(size_t)a2), "v"((unsigned)(size_t)(a2 + hi_off)), "v"((unsigned)(size_t)a3), "v"((unsigned)(size_t)(a3 + hi_off)) : "memory");
    f[0] = __builtin_shufflevector(l0, h0, 0, 1, 2, 3, 4, 5, 6, 7); f[1] = __builtin_shufflevector(l1, h1, 0, 1, 2, 3, 4, 5, 6, 7); f[2] = __builtin_shufflevector(l2, h2, 0, 1, 2, 3, 4, 5, 6, 7); f[3] = __builtin_shufflevector(l3, h3, 0, 1, 2, 3, 4, 5, 6, 7);
#endif
}
DI bf16x8 pack8(const f32x16& x, int s) {
    u32x4 p; p.x = pk2(x[8 * s], x[8 * s + 1]); p.y = pk2(x[8 * s + 2], x[8 * s + 3]); p.z = pk2(x[8 * s + 4], x[8 * s + 5]); p.w = pk2(x[8 * s + 6], x[8 * s + 7]);
    return __builtin_bit_cast(bf16x8, p);
}
struct AttnSt { f32x16 o0, o1; float m, l; };
template <bool MASKED>
DI void attn_block(AttnSt& st, const bf16x8 (&qf)[4], const bf16* Kb, int kp, const bf16* Vb, int vp, LAS unsigned char* vl, int lane, const float (&addv)[16], unsigned vmask) {
    const int r32 = lane & 31, h = lane >> 5;
#pragma unroll
    for (int i = 0; i < 4; ++i) { const int idx = lane + 64 * i, key = idx >> 3, ch = idx & 7; *(LAS u32x4*)(vl + key * 128 + ch * 16) = *(const u32x4*)(Vb + (size_t)key * vp + ch * 8); }
    f32x16 s;
#pragma unroll
    for (int i = 0; i < 16; ++i) s[i] = 0.f;
#pragma unroll
    for (int kk = 0; kk < 4; ++kk) { const bf16x8 kf = *(const bf16x8*)(Kb + (size_t)r32 * kp + 16 * kk + 8 * h); s = __builtin_amdgcn_mfma_f32_32x32x16_bf16(kf, qf[kk], s, 0, 0, 0); }
    float bm = -1e30f;
#pragma unroll
    for (int i = 0; i < 16; ++i) { if (MASKED) { s[i] += addv[i]; if ((vmask >> i) & 1u) bm = fmaxf(bm, s[i]); } else bm = fmaxf(bm, s[i]); }
    bm = fmaxf(bm, __shfl_xor(bm, 32));
    const float mn = fmaxf(st.m, bm), alpha = __expf(st.m - mn); st.m = mn;
    float ls = 0.f;
#pragma unroll
    for (int i = 0; i < 16; ++i) { float p = __expf(s[i] - mn); if (MASKED) p = ((vmask >> i) & 1u) ? p : 0.f; s[i] = p; ls += p; }
    st.l = st.l * alpha + ls;
#pragma unroll
    for (int i = 0; i < 16; ++i) { st.o0[i] *= alpha; st.o1[i] *= alpha; }
    WSYNC();
    const int q = (lane & 15) >> 2, p4 = lane & 3, blk = (lane >> 4) & 1;
    { const LAS unsigned char* ab = vl + (4 * h + q) * 128 + (16 * blk) * 2 + 8 * p4; bf16x8 vf[4];
      tr_frag4(ab, ab + 64, ab + 16 * 128, ab + 16 * 128 + 64, 8 * 128, vf);
      const bf16x8 pf0 = pack8(s, 0), pf1 = pack8(s, 1);
      st.o0 = __builtin_amdgcn_mfma_f32_32x32x16_bf16(vf[0], pf0, st.o0, 0, 0, 0); st.o1 = __builtin_amdgcn_mfma_f32_32x32x16_bf16(vf[1], pf0, st.o1, 0, 0, 0);
      st.o0 = __builtin_amdgcn_mfma_f32_32x32x16_bf16(vf[2], pf1, st.o0, 0, 0, 0); st.o1 = __builtin_amdgcn_mfma_f32_32x32x16_bf16(vf[3], pf1, st.o1, 0, 0, 0); }
}
DI void attn_finish(AttnSt& st, bf16* orow  , int lane, float extra_l) {
    const int h = lane >> 5; float l = st.l + __shfl_xor(st.l, 32) + extra_l; const float inv = 1.0f / l;
#pragma unroll
    for (int g = 0; g < 4; ++g) {
        u32x2 w0, w1; w0.x = pk2(st.o0[4 * g] * inv, st.o0[4 * g + 1] * inv); w0.y = pk2(st.o0[4 * g + 2] * inv, st.o0[4 * g + 3] * inv);
        w1.x = pk2(st.o1[4 * g] * inv, st.o1[4 * g + 1] * inv); w1.y = pk2(st.o1[4 * g + 2] * inv, st.o1[4 * g + 3] * inv);
        *(u32x2*)(orow + 8 * g + 4 * h) = w0; *(u32x2*)(orow + 32 + 8 * g + 4 * h) = w1; }
}
DI int clampi(int v, int lo, int hi) { return v < lo ? lo : (v > hi ? hi : v); }
constexpr int AT_NA = NB * NH * (GRH / 2) * 4, AT_WA = NB * NH * (T / 32), AT_CX = NB * NH * (TC / 32);
DI void ph_attn(const Ctx& C, int l, bool want_ctx, int first_block) {
    if (C.bid < first_block) return;
    const int gw = (C.bid - first_block) * NW + C.wave, GWV = (C.G - first_block) * NW, lane = C.lane, r32 = lane & 31, h = lane >> 5;
    LAS unsigned char* vl = C.lds + C.wave * 4096;
    const bf16* QA = (const bf16*)(C.ws + WS_QA); const bf16* KA = (const bf16*)(C.ws + WS_KA); const bf16* VA = (const bf16*)(C.ws + WS_VA);
    const bf16* QC = (const bf16*)(C.ws + WS_QC); const bf16* KC = (const bf16*)(C.ws + WS_KC); const bf16* VC = (const bf16*)(C.ws + WS_VC);
    bf16* OB = (bf16*)(C.ws + WS_OB);
    const int ntiles = AT_NA + AT_WA + (want_ctx ? 2 * AT_CX : 0);
    const float zero16[16] = {0.f, 0.f, 0.f, 0.f, 0.f, 0.f, 0.f, 0.f, 0.f, 0.f, 0.f, 0.f, 0.f, 0.f, 0.f, 0.f};
    for (int tile = gw; tile < ntiles; tile += GWV) {
        AttnSt st; st.m = -1e30f; st.l = 0.f;
#pragma unroll
        for (int i = 0; i < 16; ++i) { st.o0[i] = 0.f; st.o1[i] = 0.f; }
        bf16x8 qf[4];
        if (tile < AT_NA) {
            const int cb = tile & 3, rp = (tile >> 2) % (GRH / 2), hd = (tile / (4 * (GRH / 2))) % NH, b = tile / (4 * (GRH / 2) * NH);
            const int r0 = 2 * rp, c0 = 16 * cb, qr = r0 + (r32 >> 4), qc = c0 + (r32 & 15), qrow = b * T + qr * GRW + qc;
#pragma unroll
            for (int kk = 0; kk < 4; ++kk) qf[kk] = *(const bf16x8*)(QA + (size_t)qrow * GW + hd * 64 + 16 * kk + 8 * h);
            const int rsq = clampi(qr - 4, 0, GRH - 8), csq = clampi(qc - 8, 0, GRW - 16);
            const int rsA = clampi(r0 - 4, 0, GRH - 8), rsB = clampi(r0 + 1 - 4, 0, GRH - 8), kc0 = clampi(c0 - 8, 0, GRW - 32);
            const float* rpb = C.in[I_NARPB] + ((size_t)l * NH + hd) * 465;
            for (int kr = rsA; kr <= rsB + 7; ++kr) {
                float addv[16]; unsigned vm = 0u; const bool rok = kr >= rsq && kr <= rsq + 7;
#pragma unroll
                for (int i = 0; i < 16; ++i) { const int kb = (i & 3) + 8 * (i >> 2) + 4 * h, kc = kc0 + kb; const bool ok = rok && kc >= csq && kc <= csq + 15;
                    const int bi = ok ? (kr - qr + 7) * 31 + (kc - qc + 15) : 0; addv[i] = rpb[bi]; vm |= ok ? (1u << i) : 0u; }
                const size_t krow = (size_t)b * T + kr * GRW + kc0;
                attn_block<true>(st, qf, KA + krow * GW + hd * 64, GW, VA + krow * GW + hd * 64, GW, vl, lane, addv, vm);
            }
            for (int cbk = 0; cbk < TC / 32; ++cbk) { const size_t krow = (size_t)M_LAT + b * TC + 32 * cbk;
                attn_block<false>(st, qf, KA + krow * GW + hd * 64, GW, VA + krow * GW + hd * 64, GW, vl, lane, zero16, 0xffffu); }
            attn_finish(st, OB + (size_t)qrow * D + hd * 64, lane, 0.f);
        } else if (tile < AT_NA + AT_WA) {
            const int t2 = tile - AT_NA, qb = t2 % (T / 32), hd = (t2 / (T / 32)) % NH, b = t2 / ((T / 32) * NH), kvh = hd / WAG;
            const int qt = 32 * qb + r32, qrow = b * T + qt;
#pragma unroll
            for (int kk = 0; kk < 4; ++kk) qf[kk] = *(const bf16x8*)(QC + (size_t)qrow * GW + hd * 64 + 16 * kk + 8 * h);
            for (int i9 = 0; i9 < 9; ++i9) { const int t0 = 32 * qb - 128 + 32 * i9; if (t0 < 0 || t0 >= T) continue;
                float addv[16]; unsigned vm = 0u;
#pragma unroll
                for (int i = 0; i < 16; ++i) { const int kt = t0 + (i & 3) + 8 * (i >> 2) + 4 * h, rel = kt - qt; addv[i] = 0.f; vm |= (rel >= -128 && rel <= 128) ? (1u << i) : 0u; }
                const size_t krow = (size_t)b * T + t0;
                attn_block<true>(st, qf, KC + krow * 128 + kvh * 64, 128, VC + krow * 128 + kvh * 64, 128, vl, lane, addv, vm); }
            for (int cbk = 0; cbk < TC / 32; ++cbk) { const size_t krow = (size_t)M_LAT + b * TC + 32 * cbk;
                attn_block<false>(st, qf, KC + krow * 128 + kvh * 64, 128, VC + krow * 128 + kvh * 64, 128, vl, lane, zero16, 0xffffu); }
            const float sk = C.in[I_WASINK][(size_t)l * NH + hd];
            const float mfin = fmaxf(st.m, sk), a2 = __expf(st.m - mfin);
#pragma unroll
            for (int i = 0; i < 16; ++i) { st.o0[i] *= a2; st.o1[i] *= a2; }
            st.l *= a2; st.m = mfin;
            attn_finish(st, OB + (size_t)qrow * D + 2 * GW + hd * 64, lane, __expf(sk - mfin));
        } else {
            const int t2 = tile - AT_NA - AT_WA, isc = t2 >= AT_CX, t3 = t2 - isc * AT_CX, qb = t3 % (TC / 32), hd = (t3 / (TC / 32)) % NH, b = t3 / ((TC / 32) * NH), kvh = hd / WAG;
            const int qrow = M_LAT + b * TC + 32 * qb + r32;
            const bf16* Qs = isc ? QC : QA; const bf16* Ks = isc ? KC + kvh * 64 : KA + hd * 64; const bf16* Vs = isc ? VC + kvh * 64 : VA + hd * 64; const int kp = isc ? 128 : GW;
#pragma unroll
            for (int kk = 0; kk < 4; ++kk) qf[kk] = *(const bf16x8*)(Qs + (size_t)qrow * GW + hd * 64 + 16 * kk + 8 * h);
            for (int cbk = 0; cbk < TC / 32; ++cbk) { const size_t krow = (size_t)M_LAT + b * TC + 32 * cbk;
                attn_block<false>(st, qf, Ks + krow * kp, kp, Vs + krow * kp, kp, vl, lane, zero16, 0xffffu); }
            float extra = 0.f;
            if (isc) { const float sk = C.in[I_WASINK][(size_t)l * NH + hd]; const float mfin = fmaxf(st.m, sk), a2 = __expf(st.m - mfin);
#pragma unroll
                for (int i = 0; i < 16; ++i) { st.o0[i] *= a2; st.o1[i] *= a2; }
                st.l *= a2; st.m = mfin; extra = __expf(sk - mfin); }
            attn_finish(st, OB + (size_t)qrow * D + (isc ? 2 * GW : 0) + hd * 64, lane, extra);
        }
    }
}

DI void ph_ctxfix(const Ctx& C, const float* gsn  , float* rowss_next) {
    const int gw = C.bid * NW + C.wave, GWV = C.G * NW;
    for (int r = gw; r < M_CTX; r += GWV) { const int row = M_LAT + r; const float* xp = xrow_ptr(C, row); const float* gs = gsn + (size_t)NB * D; bf16* ap = (bf16*)(C.ws + WS_AP) + (size_t)row * D; float ss = 0.f;
        for (int c = 4 * C.lane; c < D; c += 256) { const f32x4 x = *(const f32x4*)(xp + c); ss += (x[0] * x[0] + x[1] * x[1]) + (x[2] * x[2] + x[3] * x[3]);
            const f32x4 a = x * *(const f32x4*)(gs + c); u32x2 w; w.x = pk2(a[0], a[1]); w.y = pk2(a[2], a[3]); *(u32x2*)(ap + c) = w; }
        ss = wave_sum(ss); if (C.lane == 0) rowss_next[row] = ss; }
}
DI void ph_rwprep(const Ctx& C, int l) {
    LAS float* sm = (LAS float*)C.lds;
    const int c = C.tid; const bool act = c < GW;
    const bf16* PB = (const bf16*)(C.ws + WS_PB); const float* PS = (const float*)(C.ws + WS_PS);
    const float* cw = C.in[I_RWCONV] + (size_t)l * 9 * GW;
    float cwv[3][3];
    if (act) {
#pragma unroll
        for (int j = 0; j < 3; ++j)
#pragma unroll
            for (int x = 0; x < 3; ++x) cwv[j][x] = cw[(size_t)j * 3 * GW + x * GW + c]; }
    const float w00 = act ? C.in[I_RWW0][((size_t)l * 2 + 0) * GW + c] : 0.f, w01 = act ? C.in[I_RWW0][((size_t)l * 2 + 1) * GW + c] : 0.f;
    const float a00 = act ? C.in[I_RWA0][((size_t)l * 2 + 0) * GW + c] : 0.f, a01 = act ? C.in[I_RWA0][((size_t)l * 2 + 1) * GW + c] : 0.f;
    const float kkw = act ? C.in[I_RWKK][(size_t)l * GW + c] : 0.f, kaw = act ? C.in[I_RWKA][(size_t)l * GW + c] : 0.f;
    const float* wup = C.in[I_RWWUP] + (size_t)l * 2 * 32 * GW; const float* aup = C.in[I_RWAUP] + (size_t)l * 2 * 32 * GW; const float* gup = C.in[I_RWGUP] + (size_t)l * 96 * GW;
    for (int it = C.bid; it < M / 16; it += C.G) {
        const int row0 = it * 16;
        const int seq_lo = row0 < M_LAT ? (row0 / T) * T : M_LAT + ((row0 - M_LAT) / TC) * TC, seq_hi = row0 < M_LAT ? seq_lo + T : seq_lo + TC;
        __syncthreads();
        for (int i = C.tid; i < 16 * 160; i += NTHR) { const int t = i / 160, k = i % 160; const float v = PS[(size_t)(row0 + t) * 160 + k]; sm[i] = k < 32 ? tanhf(v) : (k < 64 ? v : sigmf(v)); }
        __syncthreads();
        if (act) {
            float aw0[16], aw1[16], aa0[16], aa1[16], ag[16];
#pragma unroll
            for (int t = 0; t < 16; ++t) { aw0[t] = 0.f; aw1[t] = 0.f; aa0[t] = 0.f; aa1[t] = 0.f; ag[t] = 0.f; }
            for (int k = 0; k < 32; ++k) { const float u0 = wup[(size_t)k * GW + c], u1 = wup[(size_t)(32 + k) * GW + c], v0 = aup[(size_t)k * GW + c], v1 = aup[(size_t)(32 + k) * GW + c];
#pragma unroll
                for (int t = 0; t < 16; ++t) { const float dw = sm[t * 160 + k], da = sm[t * 160 + 32 + k]; aw0[t] += dw * u0; aw1[t] += dw * u1; aa0[t] += da * v0; aa1[t] += da * v1; } }
            for (int k = 0; k < 96; ++k) { const float gv = gup[(size_t)k * GW + c];
#pragma unroll
                for (int t = 0; t < 16; ++t) ag[t] += sm[t * 160 + 64 + k] * gv; }
            float pr[3], cu[3], nx[3];
#pragma unroll
            for (int x = 0; x < 3; ++x) { pr[x] = row0 - 1 >= seq_lo ? bf2f(PB[(size_t)(row0 - 1) * 3 * GW + x * GW + c]) : 0.f; cu[x] = bf2f(PB[(size_t)row0 * 3 * GW + x * GW + c]); }
#pragma unroll
            for (int t = 0; t < 16; ++t) { const int row = row0 + t;
#pragma unroll
                for (int x = 0; x < 3; ++x) nx[x] = row + 1 < seq_hi ? bf2f(PB[(size_t)(row + 1) * 3 * GW + x * GW + c]) : 0.f;
                const float r = pr[0] * cwv[0][0] + cu[0] * cwv[1][0] + nx[0] * cwv[2][0], kf = pr[1] * cwv[0][1] + cu[1] * cwv[1][1] + nx[1] * cwv[2][1], v = pr[2] * cwv[0][2] + cu[2] * cwv[1][2] + nx[2] * cwv[2][2];
#pragma unroll
                for (int x = 0; x < 3; ++x) { pr[x] = cu[x]; cu[x] = nx[x]; }
                const float kkv = kf * kkw, ssq = wave_sum(kkv * kkv), kk = kkv / fmaxf(sqrtf(ssq), 1e-12f);
                const size_t o = (size_t)row * GW + c;
                rw_arr(C, RW_R)[o] = r; rw_arr(C, RW_V)[o] = v; rw_arr(C, RW_NKK)[o] = -kk; rw_arr(C, RW_G)[o] = ag[t];
                { const float z = -(w00 + aw0[t]), sp = z > 20.f ? z : log1pf(__expf(z)), wlog = -sp - 0.5f, a = sigmf(a00 + aa0[t]);
                  rw_arr(C, RW_W0)[o] = __expf(-__expf(wlog)); rw_arr(C, RW_K0)[o] = kf * (1.f + (a - 1.f) * kaw); rw_arr(C, RW_B0)[o] = kk * a; }
                { const float z = -(w01 + aw1[t]), sp = z > 20.f ? z : log1pf(__expf(z)), wlog = -sp - 0.5f, a = sigmf(a01 + aa1[t]);
                  rw_arr(C, RW_W1)[o] = __expf(-__expf(wlog)); rw_arr(C, RW_K1)[o] = kf * (1.f + (a - 1.f) * kaw); rw_arr(C, RW_B1)[o] = kk * a; }
            }
        }
    }
    __syncthreads();
}
DI void ph_rwscan(const Ctx& C) {
    if (C.wave >= 4) return;
    const int lane = C.lane, sub = lane & 15, vr = lane >> 4;
    const int nitems = NB * NH * 2 * 16;
    for (int it = C.bid * 4 + C.wave; it < nitems; it += C.G * 4) {
        const int rg = it & 15, dir = (it >> 4) & 1, hd = (it >> 5) % NH, b = it / (32 * NH);
        const int col = hd * 64 + 4 * sub, vcol = hd * 64 + 4 * rg + vr;
        const float* Wd = rw_arr(C, dir ? RW_W1 : RW_W0); const float* Kd = rw_arr(C, dir ? RW_K1 : RW_K0); const float* Bd = rw_arr(C, dir ? RW_B1 : RW_B0);
        const float* Rr = rw_arr(C, RW_R); const float* Vv = rw_arr(C, RW_V); const float* Nk = rw_arr(C, RW_NKK); float* Y = rw_arr(C, dir ? RW_Y1 : RW_Y0);
        f32x4 s = {0.f, 0.f, 0.f, 0.f};
        for (int seg = 0; seg < 2; ++seg) {
            const int base = seg == 0 ? M_LAT + b * TC : b * T, len = seg == 0 ? TC : T;
            for (int i0 = 0; i0 < len; i0 += 4) {
                f32x4 nk[4], w4[4], b4[4], k4[4], r4[4]; float vv[4]; int rows[4];
#pragma unroll
                for (int u = 0; u < 4; ++u) { const int i = i0 + u, row = base + (dir ? len - 1 - i : i); rows[u] = row; const size_t o = (size_t)row * GW + col;
                    nk[u] = *(const f32x4*)(Nk + o); w4[u] = *(const f32x4*)(Wd + o); b4[u] = *(const f32x4*)(Bd + o); k4[u] = *(const f32x4*)(Kd + o); r4[u] = *(const f32x4*)(Rr + o); vv[u] = Vv[(size_t)row * GW + vcol]; }
#pragma unroll
                for (int u = 0; u < 4; ++u) {
                    const f32x4 p = s * nk[u]; const float sa = row16_sum((p[0] + p[1]) + (p[2] + p[3]));
                    s = s * w4[u] + b4[u] * sa + k4[u] * vv[u];
                    const f32x4 yq = s * r4[u]; const float y = row16_sum((yq[0] + yq[1]) + (yq[2] + yq[3]));
                    if (sub == 0) Y[(size_t)rows[u] * GW + vcol] = y;
                }
            }
        }
    }
}
DI void ph_rwout(const Ctx& C, int l, int mrows) {
    const int gw = C.bid * NW + C.wave, GWV = C.G * NW, lane = C.lane;
    bf16* OB = (bf16*)(C.ws + WS_OB);
    for (int it = gw; it < mrows * NH; it += GWV) {
        const int hd = it % NH, row = it / NH, c = hd * 64 + lane; const size_t o = (size_t)row * GW + c;
        const float r = rw_arr(C, RW_R)[o], v = rw_arr(C, RW_V)[o], ks = rw_arr(C, RW_K0)[o] + rw_arr(C, RW_K1)[o];
        float y = rw_arr(C, RW_Y0)[o] + rw_arr(C, RW_Y1)[o];
        y += wave_sum(r * ks * C.in[I_RWRK][((size_t)l * NH + hd) * 64 + lane]) * v;
        const float mu = wave_sum(y) * (1.f / 64.f), dlt = y - mu, var = wave_sum(dlt * dlt) * (1.f / 64.f);
        const float yn = dlt / sqrtf(var + RW_GN_EPS);
        const float ov = (yn * C.in[I_RWGNW][(size_t)l * GW + c] + C.in[I_RWGNB][(size_t)l * GW + c]) * rw_arr(C, RW_G)[o];
        OB[(size_t)row * D + GW + c] = (bf16)f2bf(ov);
    }
}
constexpr int PT = 144;
constexpr int RW_HALF = 73472, IM_BT = 0, IM_KT = 9216, IM_RT = 18432, IM_ARB = 27648, IM_AT = 36864, IM_AAK = 46080, IM_F = 55296, IM_GC = 72704, FP = 68;
DI void chunk_rows(int b, int dir, int c, int& row0, int& step) {
    if (c < TC / 64) { const int p0 = 64 * c; row0 = M_LAT + b * TC + (dir ? TC - 1 - p0 : p0); } else { const int p0 = 64 * (c - TC / 64); row0 = b * T + (dir ? T - 1 - p0 : p0); }
    step = dir ? -1 : 1;
}
DI bf16x8 frag_rows(const LAS unsigned char* img, int tile, int s, int lane) { return *(const LAS bf16x8*)(img + (32 * tile + (lane & 31)) * PT + (16 * s + 8 * (lane >> 5)) * 2); }
DI bf16x8 frag_cols(const LAS unsigned char* img, int tile, int s, int lane) {
    const int h = lane >> 5, q = (lane & 15) >> 2, p4 = lane & 3, blk = (lane >> 4) & 1;
    const LAS unsigned char* a0 = img + (16 * s + 8 * h + q) * PT + (32 * tile + 16 * blk) * 2 + 8 * p4;
    return tr_frag(a0, 4 * PT);
}
DI void store_T(const f32x16& acc, LAS unsigned char* img, int ti, int tj, int lane) {
    const int c = lane & 31, h = lane >> 5;
#pragma unroll
    for (int g = 0; g < 4; ++g) { u32x2 w; w.x = pk2(acc[4 * g], acc[4 * g + 1]); w.y = pk2(acc[4 * g + 2], acc[4 * g + 3]); *(LAS u32x2*)(img + (32 * tj + c) * PT + (32 * ti + 8 * g + 4 * h) * 2) = w; }
}
DI f32x16 zero16v() { f32x16 z;
#pragma unroll
    for (int i = 0; i < 16; ++i) z[i] = 0.f; return z; }
#define MMA32(a, b, c) __builtin_amdgcn_mfma_f32_32x32x16_bf16((a), (b), (c), 0, 0, 0)
constexpr int PDW = 80, PDG = 208, IM_TW = 0, IM_TA = 17408, IM_DW = 36864, IM_DA = 41984, IM_DG = 47104;
DI void ph_rw1(const Ctx& C, int l) {
    const int wg = C.wave & 3, grp = C.wave >> 2, ti = wg >> 1, tj = wg & 1;
    bf16* QH = (bf16*)(C.ws + WS_QH); float* YL = (float*)(C.ws + WS_YL); bf16* MF = (bf16*)(C.ws + WS_MF); float* GF = (float*)(C.ws + WS_GF); bf16* RVKG = (bf16*)(C.ws + WS_RVKG);
    const bf16* PB = (const bf16*)(C.ws + WS_PB); const float* PS = (const float*)(C.ws + WS_PS);
    const bf16x8* RWF = (const bf16x8*)(C.ws + WS_RWF + (size_t)l * SZ_RWF);
    constexpr int nblk = (TC + T) / 64;
    for (int it0 = 2 * C.bid; it0 < RBLK; it0 += 2 * C.G) {
        int lane_ = threadIdx.x & 63; OPAQUE(lane_); const int lane = lane_, c32 = lane & 31, h = lane >> 5;
        LAS unsigned char* L = OPAQUE_LDS(C.lds + grp * RW_HALF);
        LAS float* F = (LAS float*)(L + IM_F); LAS float* SEG = (LAS float*)(L + IM_F); LAS float* GC = (LAS float*)(L + IM_GC);
        LAS float* TW = (LAS float*)(L + IM_TW); LAS float* TA = (LAS float*)(L + IM_TA);
        unsigned char* PK = C.ws + WS_RWS + ((size_t)C.bid * 2 + grp) * 65536;
        const int item = it0 + grp; const bool live = item < RBLK; const int itc = live ? item : RBLK - 1;
        const int tb = itc % nblk, hd = (itc / nblk) % NH, b = itc / (nblk * NH), cg = hd * 64 + lane;
        const int rowb = tb < TC / 64 ? M_LAT + b * TC + 64 * tb : b * T + 64 * (tb - TC / 64);
        const int seq_lo = tb < TC / 64 ? M_LAT + b * TC : b * T, seq_hi = seq_lo + (tb < TC / 64 ? TC : T);
        bf16* RV = RVKG + (size_t)itc * 4 * 4096;
        __syncthreads();
        float r_[16], kf_[16], kk_[16], ks_[16];
        { const float* cw = C.in[I_RWCONV] + (size_t)l * 9 * GW; float cwv[3][3];
#pragma unroll
          for (int j = 0; j < 3; ++j)
#pragma unroll
              for (int x = 0; x < 3; ++x) cwv[j][x] = cw[(size_t)j * 3 * GW + x * GW + cg];
          const float kkw = C.in[I_RWKK][(size_t)l * GW + cg];
          const int r0 = rowb + 16 * wg; float pr[3], cu[3], nx[3];
#pragma unroll
          for (int x = 0; x < 3; ++x) { pr[x] = r0 - 1 >= seq_lo ? bf2f(PB[(size_t)(r0 - 1) * 3 * GW + x * GW + cg]) : 0.f; cu[x] = bf2f(PB[(size_t)r0 * 3 * GW + x * GW + cg]); }
#pragma unroll
          for (int t = 0; t < 16; ++t) { const int row = r0 + t;
#pragma unroll
              for (int x = 0; x < 3; ++x) nx[x] = row + 1 < seq_hi ? bf2f(PB[(size_t)(row + 1) * 3 * GW + x * GW + cg]) : 0.f;
              r_[t] = pr[0] * cwv[0][0] + cu[0] * cwv[1][0] + nx[0] * cwv[2][0]; kf_[t] = pr[1] * cwv[0][1] + cu[1] * cwv[1][1] + nx[1] * cwv[2][1]; const float v_t = pr[2] * cwv[0][2] + cu[2] * cwv[1][2] + nx[2] * cwv[2][2];
#pragma unroll
              for (int x = 0; x < 3; ++x) { pr[x] = cu[x]; cu[x] = nx[x]; }
              const float kkv = kf_[t] * kkw, ssq = wave_sum(kkv * kkv); kk_[t] = kkv / fmaxf(sqrtf(ssq), 1e-12f); ks_[t] = 0.f;
              RV[(16 * wg + t) * 64 + lane] = (bf16)f2bf(r_[t]); RV[4096 + (16 * wg + t) * 64 + lane] = (bf16)f2bf(v_t);
#pragma unroll
              for (int kq = 0; kq < 3; ++kq) { const int k = lane + 64 * kq; if (k < 160) { const float pv = PS[(size_t)row * 160 + k]; const int tk = 16 * wg + t;
                  if (k < 32) *(LAS bf16*)(L + IM_DW + tk * PDW + k * 2) = (bf16)f2bf(tanhf(pv)); else if (k < 64) *(LAS bf16*)(L + IM_DA + tk * PDW + (k - 32) * 2) = (bf16)f2bf(pv); else *(LAS bf16*)(L + IM_DG + tk * PDG + (k - 64) * 2) = (bf16)f2bf(sigmf(pv)); } }
          }
        }
        __syncthreads();
        { f32x16 gacc = zero16v();
#pragma unroll
          for (int sx = 0; sx < 6; ++sx) gacc = MMA32(*(const LAS bf16x8*)(L + IM_DG + (32 * ti + c32) * PDG + (16 * sx + 8 * h) * 2), RWF[(((8 + sx) * NH + hd) * 2 + tj) * 64 + lane], gacc);
#pragma unroll
          for (int rg = 0; rg < 16; ++rg) { const int tk = 32 * ti + (rg & 3) + 8 * (rg >> 2) + 4 * h; RV[3 * 4096 + tk * 64 + 32 * tj + c32] = (bf16)f2bf(gacc[rg]); }
        }
        const float kaw = C.in[I_RWKA][(size_t)l * GW + cg];
#pragma unroll
        for (int pss = 0; pss < 2; ++pss) {
            const int dir = 1 - pss;
            __syncthreads();
            { f32x16 pw = zero16v(), pa = zero16v();
#pragma unroll
              for (int sx = 0; sx < 2; ++sx) { pw = MMA32(*(const LAS bf16x8*)(L + IM_DW + (32 * ti + c32) * PDW + (16 * sx + 8 * h) * 2), RWF[(((0 + 2 * dir + sx) * NH + hd) * 2 + tj) * 64 + lane], pw);
                                              pa = MMA32(*(const LAS bf16x8*)(L + IM_DA + (32 * ti + c32) * PDW + (16 * sx + 8 * h) * 2), RWF[(((4 + 2 * dir + sx) * NH + hd) * 2 + tj) * 64 + lane], pa); }
              const float w0 = C.in[I_RWW0][((size_t)l * 2 + dir) * GW + hd * 64 + 32 * tj + c32], a0 = C.in[I_RWA0][((size_t)l * 2 + dir) * GW + hd * 64 + 32 * tj + c32];
#pragma unroll
              for (int rg = 0; rg < 16; ++rg) { const int tk = 32 * ti + (rg & 3) + 8 * (rg >> 2) + 4 * h; const float z = -(w0 + pw[rg]), sp = z > 20.f ? z : log1pf(__expf(z));
                  TW[tk * FP + 32 * tj + c32] = -__expf(-sp - 0.5f); TA[tk * FP + 32 * tj + c32] = sigmf(a0 + pa[rg]); } }
            __syncthreads();
            const int cs = dir ? 3 - wg : wg;
            float lw[16], av[16], run = 0.f;
#pragma unroll
            for (int ii = 0; ii < 16; ++ii) { const int tl = dir ? 15 - ii : ii, tk = 16 * wg + tl; av[ii] = TA[tk * FP + lane]; run += TW[tk * FP + lane]; lw[ii] = run; }
            __syncthreads();
            SEG[cs * 64 + lane] = run;
            __syncthreads();
            float off = 0.f;
#pragma unroll
            for (int w2 = 0; w2 < 3; ++w2) off += (w2 < cs) ? SEG[w2 * 64 + lane] : 0.f;
            const float tot = SEG[lane] + SEG[64 + lane] + SEG[128 + lane] + SEG[192 + lane];
            if (wg == 0) { if (dir) ((float*)(PK + 32768))[lane] = __expf(tot); else GC[lane] = __expf(tot); }
#pragma unroll
            for (int ii = 0; ii < 16; ++ii) { const int tl = dir ? 15 - ii : ii, i = 16 * cs + ii;
                const float Li = lw[ii] + off, eL = __expf(Li), ieL = __builtin_amdgcn_rcpf(eL), eLm = __expf(Li - (lw[ii] - (ii ? lw[ii - 1] : 0.f)));
                const float a = av[ii], kd = kf_[tl] * (1.f + (a - 1.f) * kaw); ks_[tl] += kd;
                const bf16 vat = (bf16)f2bf(-kk_[tl] * eLm), vbt = (bf16)f2bf(kk_[tl] * a * ieL), vkt = (bf16)f2bf(kd * ieL), vrt = (bf16)f2bf(r_[tl] * eL);
                if (dir) { bf16* pk = (bf16*)PK + i * 64 + lane; pk[0] = vat; pk[4096] = vbt; pk[8192] = vkt; pk[12288] = vrt; }
                else { *(LAS bf16*)(L + IM_AT + i * PT + lane * 2) = vat; *(LAS bf16*)(L + IM_BT + i * PT + lane * 2) = vbt; *(LAS bf16*)(L + IM_KT + i * PT + lane * 2) = vkt; *(LAS bf16*)(L + IM_RT + i * PT + lane * 2) = vrt; } }
        }
#pragma unroll
        for (int t = 0; t < 16; ++t) RV[2 * 4096 + (16 * wg + t) * 64 + lane] = (bf16)f2bf(ks_[t]);
#pragma unroll 1
        for (int dir = 0; dir < 2; ++dir) {
            const int c = dir == 0 ? tb : (tb < TC / 64 ? TC / 64 - 1 - tb : TC / 64 + (T / 64 - 1 - (tb - TC / 64)));
            const size_t ci = ((size_t)((b * NH + hd) * 2 + dir)) * RCK + c;
            __syncthreads();
            if (dir) {
                const int tg = wg * 64 + lane;
#pragma unroll
                for (int im = 0; im < 4; ++im)
#pragma unroll
                    for (int rr = 0; rr < 2; ++rr) { const int idx = tg + 256 * rr, row = idx >> 3, ch = idx & 7; const int dsto = im == 0 ? IM_AT : im == 1 ? IM_BT : im == 2 ? IM_KT : IM_RT;
                        *(LAS u32x4*)(L + dsto + row * PT + ch * 16) = *(const u32x4*)(PK + im * 8192 + row * 128 + ch * 16); }
                if (wg == 0) GC[lane] = ((const float*)(PK + 32768))[lane];
                __syncthreads();
            }
            f32x16 accP;
            { f32x16 aab = zero16v(), aak = zero16v(), arb = zero16v(); accP = zero16v();
#pragma unroll
              for (int s = 0; s < 4; ++s) { const bf16x8 at_i = frag_rows(L + IM_AT, ti, s, lane), bt_j = frag_rows(L + IM_BT, tj, s, lane), kt_j = frag_rows(L + IM_KT, ti, s, lane), at_c = frag_rows(L + IM_AT, tj, s, lane),
                                              bt_r = frag_rows(L + IM_BT, ti, s, lane), rt_c = frag_rows(L + IM_RT, tj, s, lane);
                  aab = MMA32(at_i, bt_j, aab); aak = MMA32(kt_j, at_c, aak); arb = MMA32(bt_r, rt_c, arb); accP = MMA32(kt_j, rt_c, accP); }
#pragma unroll
              for (int r = 0; r < 16; ++r) { const int row = 32 * ti + (r & 3) + 8 * (r >> 2) + 4 * h, col = 32 * tj + c32;
                  F[row * FP + col] = col < row ? aab[r] : 0.f; aak[r] = row < col ? aak[r] : 0.f; arb[r] = row <= col ? arb[r] : 0.f; accP[r] = row <= col ? accP[r] : 0.f; }
              store_T(aak, L + IM_AAK, ti, tj, lane);
              store_T(arb, L + IM_ARB, ti, tj, lane); }
            __syncthreads();
            { float Wc[64]; const int col = 32 * wg + c32; const LAS unsigned char* src = col < 64 ? L + IM_AT + col * 2 : L + IM_AAK + (col - 64) * 2;
              const LAS float* Fo = OPAQUE_LDS(F);
#pragma unroll
              for (int i = 0; i < 64; ++i) Wc[i] = bf2f(*(const LAS bf16*)(src + i * PT));
#pragma unroll
              for (int i = 1; i < 64; ++i) { float a0 = Wc[i], a1 = 0.f, a2 = 0.f, a3 = 0.f;
#pragma unroll
                  for (int j4 = 0; j4 < (i + 3) / 4; ++j4) { const f32x4 f = *(const LAS f32x4*)(Fo + i * FP + 4 * j4); a0 += f[0] * Wc[4 * j4]; a1 += f[1] * Wc[4 * j4 + 1]; a2 += f[2] * Wc[4 * j4 + 2]; a3 += f[3] * Wc[4 * j4 + 3];
                      if ((j4 & 7) == 7) PIN4(a0, a1, a2, a3); }
                  PIN4(a0, a1, a2, a3); Wc[i] = (a0 + a1) + (a2 + a3); }
              __syncthreads();
              if (h == 0) { LAS unsigned char* dst = (col < 64 ? L + IM_AT + col * PT : L + IM_AAK + (col - 64) * PT);
#pragma unroll
                  for (int i8 = 0; i8 < 8; ++i8) { u32x4 w; w.x = pk2(Wc[8 * i8], Wc[8 * i8 + 1]); w.y = pk2(Wc[8 * i8 + 2], Wc[8 * i8 + 3]); w.z = pk2(Wc[8 * i8 + 4], Wc[8 * i8 + 5]); w.w = pk2(Wc[8 * i8 + 6], Wc[8 * i8 + 7]); *(LAS u32x4*)(dst + i8 * 16) = w; } }
#pragma unroll
              for (int ii = 0; ii < 16; ++ii) { const int tl = dir ? 15 - ii : ii, i = 16 * (dir ? 3 - wg : wg) + ii; *(LAS bf16*)(L + IM_F + i * PT + lane * 2) = RV[4096 + (16 * wg + tl) * 64 + lane]; }
            }
            __syncthreads();
            { f32x16 q;
#pragma unroll
              for (int g = 0; g < 4; ++g) { const u32x2 w = *(const LAS u32x2*)(L + IM_RT + (32 * tj + c32) * PT + (32 * ti + 8 * g + 4 * h) * 2); q[4 * g] = bflo(w.x); q[4 * g + 1] = bfhi(w.x); q[4 * g + 2] = bflo(w.y); q[4 * g + 3] = bfhi(w.y); }
#pragma unroll
              for (int s = 0; s < 4; ++s) { const bf16x8 arb = frag_rows(L + IM_ARB, tj, s, lane); q = MMA32(frag_rows(L + IM_AT, ti, s, lane), arb, q); accP = MMA32(frag_rows(L + IM_AAK, ti, s, lane), arb, accP); }
              if (live) {
#pragma unroll
                  for (int g = 0; g < 4; ++g) { u32x2 w; w.x = pk2(q[4 * g], q[4 * g + 1]); w.y = pk2(q[4 * g + 2], q[4 * g + 3]); *(u32x2*)(QH + ci * 4096 + (32 * tj + c32) * 64 + 32 * ti + 8 * g + 4 * h) = w; } }
            }
            __syncthreads();
            store_T(accP, L + IM_RT, ti, tj, lane);
            __syncthreads();
            { f32x16 y = zero16v(), m = zero16v(), n;
#pragma unroll
              for (int g = 0; g < 4; ++g) { const u32x2 w = *(const LAS u32x2*)(L + IM_KT + (32 * tj + c32) * PT + (32 * ti + 8 * g + 4 * h) * 2); n[4 * g] = bflo(w.x); n[4 * g + 1] = bfhi(w.x); n[4 * g + 2] = bflo(w.y); n[4 * g + 3] = bfhi(w.y); }
#pragma unroll
              for (int s = 0; s < 4; ++s) { const bf16x8 btc_j = frag_cols(L + IM_BT, tj, s, lane), btc_i = frag_cols(L + IM_BT, ti, s, lane);
                  y = MMA32(frag_rows(L + IM_RT, ti, s, lane), frag_cols(L + IM_F, tj, s, lane), y);
                  m = MMA32(frag_rows(L + IM_AT, ti, s, lane), btc_j, m);
                  n = MMA32(btc_i, frag_rows(L + IM_AAK, tj, s, lane), n); }
              const float gck = GC[32 * tj + c32];
#pragma unroll
              for (int r = 0; r < 16; ++r) { const int row = 32 * ti + (r & 3) + 8 * (r >> 2) + 4 * h, col = 32 * tj + c32; m[r] = (m[r] + (row == col ? 1.0f : 0.f)) * gck; n[r] *= GC[row]; }
              if (live) {
#pragma unroll
                  for (int g = 0; g < 4; ++g) *(f32x4*)(YL + ci * 4096 + ((wg * 4 + g) * 64 + lane) * 4) = (f32x4){y[4 * g], y[4 * g + 1], y[4 * g + 2], y[4 * g + 3]};
#pragma unroll
                  for (int s2 = 0; s2 < 2; ++s2) *(bf16x8*)(MF + ci * 4096 + ((wg * 2 + s2) * 64 + lane) * 8) = pack8(m, s2); }
              store_T(n, L + IM_ARB, ti, tj, lane);
            }
            __syncthreads();
            { f32x16 gacc = zero16v();
#pragma unroll
              for (int s = 0; s < 4; ++s) gacc = MMA32(frag_cols(L + IM_ARB, ti, s, lane), frag_cols(L + IM_F, tj, s, lane), gacc);
              if (live) {
#pragma unroll
                  for (int g = 0; g < 4; ++g) *(f32x4*)(GF + ci * 4096 + ((wg * 4 + g) * 64 + lane) * 4) = (f32x4){gacc[4 * g], gacc[4 * g + 1], gacc[4 * g + 2], gacc[4 * g + 3]}; }
            }
        }
    }
    __syncthreads();
}
DI void ph_rw2(const Ctx& C) {
    const int lane = C.lane;
    const bf16* MF = (const bf16*)(C.ws + WS_MF); const float* GF = (const float*)(C.ws + WS_GF); bf16* SF = (bf16*)(C.ws + WS_SF);
    const int nwork = RSTR * 2;
    for (int wk = C.wave == 0 ? C.bid : nwork; wk < nwork; wk += C.G) {
        const int tj = wk & 1, stream = wk >> 1;
        f32x16 s0 = zero16v(), s1 = zero16v();
        bf16x8 mf[2][2][2]; f32x4 gq[2][4];
#define RW2_LOAD(item_) do { const size_t it_ = (item_); \
            _Pragma("unroll") for (int kp = 0; kp < 2; ++kp) _Pragma("unroll") for (int kt = 0; kt < 2; ++kt) _Pragma("unroll") for (int s = 0; s < 2; ++s) mf[kp][kt][s] = *(const bf16x8*)(MF + it_ * 4096 + (((kp * 2 + kt) * 2 + s) * 64 + lane) * 8); \
            _Pragma("unroll") for (int kt = 0; kt < 2; ++kt) _Pragma("unroll") for (int g = 0; g < 4; ++g) gq[kt][g] = *(const f32x4*)(GF + it_ * 4096 + (((kt * 2 + tj) * 4 + g) * 64 + lane) * 4); } while (0)
        RW2_LOAD((size_t)stream * RCK);
        for (int c = 0; c < RCK; ++c) {
            const size_t item = (size_t)stream * RCK + c;
            bf16x8 sf[2][2];
#pragma unroll
            for (int s = 0; s < 2; ++s) { sf[0][s] = pack8(s0, s); sf[1][s] = pack8(s1, s); *(bf16x8*)(SF + item * 4096 + (((0 * 2 + tj) * 2 + s) * 64 + lane) * 8) = sf[0][s]; *(bf16x8*)(SF + item * 4096 + (((1 * 2 + tj) * 2 + s) * 64 + lane) * 8) = sf[1][s]; }
            f32x16 n0, n1;
#pragma unroll
            for (int g = 0; g < 4; ++g) { n0[4 * g] = gq[0][g][0]; n0[4 * g + 1] = gq[0][g][1]; n0[4 * g + 2] = gq[0][g][2]; n0[4 * g + 3] = gq[0][g][3]; n1[4 * g] = gq[1][g][0]; n1[4 * g + 1] = gq[1][g][1]; n1[4 * g + 2] = gq[1][g][2]; n1[4 * g + 3] = gq[1][g][3]; }
            bf16x8 mc[2][2][2];
#pragma unroll
            for (int kp = 0; kp < 2; ++kp)
#pragma unroll
                for (int kt = 0; kt < 2; ++kt)
#pragma unroll
                    for (int s = 0; s < 2; ++s) mc[kp][kt][s] = mf[kp][kt][s];
            if (c + 1 < RCK) RW2_LOAD(item + 1);
#pragma unroll
            for (int kp = 0; kp < 2; ++kp)
#pragma unroll
                for (int s = 0; s < 2; ++s) { n0 = MMA32(mc[kp][0][s], sf[kp][s], n0); n1 = MMA32(mc[kp][1][s], sf[kp][s], n1); }
            s0 = n0; s1 = n1;
        }
#undef RW2_LOAD
    }
}
DI void ph_rw3(const Ctx& C, int l, int mrows) {
    const int lane = C.lane, wg = C.wave & 3, grp = C.wave >> 2, ti = wg >> 1, tj = wg & 1, c32 = lane & 31, h = lane >> 5;
    LAS float* Ysum = (LAS float*)(C.lds + grp * RW_HALF);
    const bf16* QH = (const bf16*)(C.ws + WS_QH); const float* YL = (const float*)(C.ws + WS_YL); const bf16* SF = (const bf16*)(C.ws + WS_SF); bf16* OB = (bf16*)(C.ws + WS_OB);
    const int nblk = (TC + T) / 64, nitems = NB * NH * nblk;
    for (int it0 = 2 * C.bid; it0 < nitems; it0 += 2 * C.G) {
        const int item = it0 + grp; const bool live = item < nitems; const int itc = live ? item : nitems - 1;
        const int tb = itc % nblk, hd = (itc / nblk) % NH, b = itc / (nblk * NH);
        const int rowb = tb < TC / 64 ? M_LAT + b * TC + 64 * tb : b * T + 64 * (tb - TC / 64);
        __syncthreads();
#pragma unroll
        for (int dir = 0; dir < 2; ++dir) {
            const int c = dir == 0 ? tb : (tb < TC / 64 ? TC / 64 - 1 - tb : TC / 64 + (T / 64 - 1 - (tb - TC / 64)));
            const size_t ci = ((size_t)((b * NH + hd) * 2 + dir)) * RCK + c;
            f32x16 y;
#pragma unroll
            for (int g = 0; g < 4; ++g) { const f32x4 a = *(const f32x4*)(YL + ci * 4096 + ((wg * 4 + g) * 64 + lane) * 4); y[4 * g] = a[0]; y[4 * g + 1] = a[1]; y[4 * g + 2] = a[2]; y[4 * g + 3] = a[3]; }
#pragma unroll
            for (int kp = 0; kp < 2; ++kp)
#pragma unroll
                for (int s = 0; s < 2; ++s) {
                    const bf16* qp = QH + ci * 4096 + (32 * ti + c32) * 64 + 32 * kp + 16 * s + 4 * h; const u32x2 lo = *(const u32x2*)qp, hi = *(const u32x2*)(qp + 8);
                    u32x4 av; av.x = lo.x; av.y = lo.y; av.z = hi.x; av.w = hi.y;
                    y = MMA32(__builtin_bit_cast(bf16x8, av), *(const bf16x8*)(SF + ci * 4096 + (((kp * 2 + tj) * 2 + s) * 64 + lane) * 8), y); }
#pragma unroll
            for (int r = 0; r < 16; ++r) { const int i = 32 * ti + (r & 3) + 8 * (r >> 2) + 4 * h, tk = dir ? 63 - i : i; LAS float* p = Ysum + tk * FP + 32 * tj + c32; if (dir == 0) *p = y[r]; else *p += y[r]; }
            __syncthreads();
        }
        if (live) {
            const int cch = hd * 64 + lane; const float rk = C.in[I_RWRK][((size_t)l * NH + hd) * 64 + lane], gw = C.in[I_RWGNW][(size_t)l * GW + cch], gb = C.in[I_RWGNB][(size_t)l * GW + cch];
            for (int t = 0; t < 16; ++t) { const int tk = 16 * wg + t, row = rowb + tk; if (row >= mrows) continue; const size_t o = (size_t)row * GW + cch;
                const bf16* rv = (const bf16*)(C.ws + WS_RVKG) + (size_t)item * 4 * 4096 + tk * 64 + lane; const float r = bf2f(rv[0]), v = bf2f(rv[4096]), ks = bf2f(rv[8192]), gg = bf2f(rv[12288]); (void)o;
                float y = Ysum[tk * FP + lane] + wave_sum(r * ks * rk) * v;
                const float mu = wave_sum(y) * (1.f / 64.f), dlt = y - mu, var = wave_sum(dlt * dlt) * (1.f / 64.f);
                OB[(size_t)row * D + GW + cch] = (bf16)f2bf((dlt * __builtin_amdgcn_rsqf(var + RW_GN_EPS) * gw + gb) * gg); }
        }
    }
    __syncthreads();
}
DI void ph_s5scan(const Ctx& C, int l, int first_block) {
    const int nthreads_total = NB * 2 * S5G * 64;
    if (C.bid < first_block) return;
    const float* XE = (const float*)(C.ws + WS_XEND); bf16* UG = (bf16*)(C.ws + WS_UG);
    const f32x2* LAM = (const f32x2*)(C.ws + WS_S5T + (size_t)l * SZ_S5L + OFF_S5LAM);
    for (int id = (C.bid - first_block) * NTHR + C.tid; id < nthreads_total; id += (C.G - first_block) * NTHR) {
        const int n = id & 63, g = (id >> 6) % S5G, dir = (id / (64 * S5G)) & 1, b = id / (128 * S5G);
        const f32x2 lm = LAM[(dir * S5G + g) * 64 + n]; float xr = 0.f, xi = 0.f;
        const int nc_ctx = TC / S5L, nc_lat = T / S5L, ntot = nc_ctx + nc_lat;
        for (int i0 = 0; i0 < ntot; i0 += 8) {
            float er[8], ei[8]; int chs[8];
#pragma unroll
            for (int u = 0; u < 8; ++u) { const int i = i0 + u; int ch;
                if (i < nc_ctx) ch = (M_LAT + b * TC) / S5L + (dir ? nc_ctx - 1 - i : i); else ch = (b * T) / S5L + (dir ? nc_lat - 1 - (i - nc_ctx) : (i - nc_ctx));
                chs[u] = ch; const float* p = XE + ((size_t)g * NCHP + ch) * 256 + dir * 128 + n; er[u] = p[0]; ei[u] = p[64]; }
#pragma unroll
            for (int u = 0; u < 8; ++u) { bf16* q = UG + ((size_t)g * NCHP + chs[u]) * S5K + 512 + dir * 128 + n; q[0] = (bf16)f2bf(xr); q[64] = (bf16)f2bf(xi);
                const float nr = lm[0] * xr - lm[1] * xi + er[u], ni = lm[0] * xi + lm[1] * xr + ei[u]; xr = nr; xi = ni; }
        }
    }
}

constexpr int PH_PRO = 3, PH_PER_L = 13, NPH = PH_PRO + PH_PER_L * NL;
#ifndef PROBE_REP
#define PROBE_REP -1
#endif
#define NREP(k) ((k) == PROBE_REP ? 2 : 1)
#ifdef ONLY
#define EN(k) ((k) == ONLY)
#else
#define EN(k) true
#endif
#ifdef EMU
void fwd(Args args) {
    unsigned char* lds = emu::lds_base();
#else
__global__ void __launch_bounds__(NTHR, 2) fwd(Args args) {
    extern __shared__ __attribute__((aligned(16))) unsigned char lds[];
#endif
    Ctx C; C.in = args.in; C.out = args.out; C.ws = args.ws; C.lds = (LAS unsigned char*)lds;
    C.tid = threadIdx.x; C.lane = C.tid & 63; C.wave = __builtin_amdgcn_readfirstlane(C.tid >> 6); C.G = gridDim.x; C.bid = blockIdx.x;
#define REFRESH() do { int t_ = threadIdx.x; OPAQUE(t_); C.tid = t_; C.lane = t_ & 63; C.wave = __builtin_amdgcn_readfirstlane(t_ >> 6); } while (0)
    volatile LAS unsigned* MISC = (volatile LAS unsigned*)(C.lds + MISC_OFF);
    if (C.tid < 32) MISC[C.tid] = 0u;
    __syncthreads();
    const int lo = args.ph_lo, hi = args.ph_hi;
    const bool use_bar = (hi - lo) > 1;
    XcdBarrier bar; bar.bar = (unsigned*)(C.ws + WS_CTL) + CW_BAR; bar.x = 0; bar.st = MISC + 8;
    if (use_bar) bar = xcd_barrier_post((unsigned*)(C.ws + WS_CTL) + CW_BAR, MISC + 8);
#define IN(k) (lo <= (k) && (k) < hi)
#define SEAM(k) do { if (IN(k) && IN((k) + 1)) xcd_barrier(bar); } while (0)
    if (EN(0) && IN(0)) for (int rep = 0; rep < NREP(0); ++rep) { REFRESH(); ph_ada(C); }
    SEAM(0);
    if (EN(1) && IN(1)) { REFRESH(); ph_conv(C); }
    SEAM(1);
    if (EN(2) && IN(2)) for (int rep = 0; rep < NREP(2); ++rep) { REFRESH(); ph_tab(C); }
    SEAM(2);
    for (int l = 0; l < NL; ++l) {
        const int pb = PH_PRO + PH_PER_L * l; const bool want_ctx = l < NL - 1;
        const int mrows_full = M, mrows_out = want_ctx ? M : M_LAT;
        bf16* AP = (bf16*)(C.ws + WS_AP); bf16* Hb = (bf16*)(C.ws + WS_H); bf16* OB = (bf16*)(C.ws + WS_OB);
        if (EN(3) && IN(pb + 0)) for (int rep = 0; rep < NREP(3); ++rep) { REFRESH();
            Gemm g{AP, wl(C, l, OFF_W1GU), D, D, D, 0, 0}; Order S; S.init(mrows_full / 256, 2 * FF / 256, 1, C.G, C.bid, D / 64);
            EpiGU E{rowss_ptr(C, l, 0), bias_ptr(C, l, 0), Hb, mrows_full}; gemm_phase(C.lds, g, S, E); }
        SEAM(pb + 0);
        if (EN(4) && IN(pb + 1)) { REFRESH();
            Gemm g{Hb, wl(C, l, OFF_W1D), FF, FF, FF, 0, 0}; Order S; S.init(M_LAT / 256, D / 256, 1, C.G, C.bid, FF / 64);
            EpiRes E{&C, gate_ptr(C, l, 0, 0), gs_ptr(C, l, 1, 0), rowss_ptr(C, l, 1), AP}; gemm_phase(C.lds, g, S, E);
            { REFRESH(); Order S2; S2.init_split(M_LAT / 256, M_CTX / 256, D / 256, 4, C.G, C.bid, FF / 64); EpiAcc E2{&C, gate_ptr(C, l, 0, 0)}; gemm_phase(C.lds, g, S2, E2); } }
        SEAM(pb + 1);
        if (EN(18) && IN(pb + 2)) { REFRESH(); ph_ctxfix(C, gs_ptr(C, l, 1, 0), rowss_ptr(C, l, 1)); }
        SEAM(pb + 2);
        if (EN(5) && IN(pb + 3)) for (int rep = 0; rep < NREP(5); ++rep) { REFRESH();
            Gemm g{AP, wl(C, l, OFF_WIN), D, D, D, 0, 0}; Order S; S.init(mrows_full / 256, NT_IN, 1, C.G, C.bid, D / 64);
            EpiIn E{&C, rowss_ptr(C, l, 1), bias_ptr(C, l, 1), l}; gemm_phase(C.lds, g, S, E); }
        SEAM(pb + 3);
        if (IN(pb + 4)) {
            if (EN(6)) for (int rep = 0; rep < NREP(6); ++rep) { REFRESH(); Gemm g{(const bf16*)(C.ws + WS_UG), (const bf16*)(C.ws + WS_S5T + (size_t)l * SZ_S5L + OFF_S5ET), S5K, 512, 512, (size_t)NCHP * S5K * 2, (size_t)256 * 512 * 2};
              Order S; S.init(NCHP / 256, 1, S5G, C.G, C.bid, 512 / 64); EpiS5A E{(float*)(C.ws + WS_XEND)}; gemm_phase(C.lds, g, S, E); }
            __syncthreads();
            for (int rep = 0; rep < NREP(9); ++rep) { if (EN(9)) { REFRESH(); ph_rw1(C, l); } }
            if (EN(7)) for (int rep = 0; rep < NREP(7); ++rep) { REFRESH(); ph_attn(C, l, want_ctx, (C.G >= 256 && 2 * C.G < RBLK && RBLK % (2 * C.G) != 0) ? (RBLK % (2 * C.G) + 1) / 2 : 0); }
        }
        SEAM(pb + 4);
        if (IN(pb + 5)) { if (EN(17)) for (int rep = 0; rep < NREP(17); ++rep) { REFRESH(); ph_rw2(C); } if (EN(10)) for (int rep = 0; rep < NREP(10); ++rep) { REFRESH(); ph_s5scan(C, l, C.G >= 256 ? 128 : 0); }
            if (EN(1) && l + 1 < NL) { REFRESH();
                if (C.G >= 256) { if (C.bid >= 64 && !(C.bid >= 128 && C.bid < 144)) { const int rk = C.bid - 64 - (C.bid >= 144 ? 16 : 0); conv_weights(C, l + 1, rk * NW + C.wave, (C.G - 80) * NW); } }
                else conv_weights(C, l + 1, C.bid * NW + C.wave, C.G * NW); } }
        SEAM(pb + 5);
        if (IN(pb + 6)) {
            if (EN(11)) for (int rep = 0; rep < NREP(11); ++rep) { REFRESH(); Gemm g{(const bf16*)(C.ws + WS_UG), (const bf16*)(C.ws + WS_S5T + (size_t)l * SZ_S5L + OFF_S5BT), S5K, S5K, S5K, (size_t)NCHP * S5K * 2, (size_t)512 * S5K * 2};
              Order S; S.init(NCHP / 256, 2, S5G, C.G, C.bid, S5K / 64); EpiS5C E{(const bf16*)(C.ws + WS_UG), C.in[I_S5D] + (size_t)l * GW, (bf16*)(C.ws + WS_YG)}; gemm_phase(C.lds, g, S, E); }
            if (EN(12)) for (int rep = 0; rep < NREP(12); ++rep) { REFRESH(); ph_rw3(C, l, mrows_out); }
        }
        SEAM(pb + 6);
        if (EN(13) && IN(pb + 7)) for (int rep = 0; rep < NREP(13); ++rep) { REFRESH();
            Gemm g{(const bf16*)(C.ws + WS_YG), wl(C, l, OFF_WGLU), GW, GW, GW, 0, 0}; Order S; S.init(mrows_out / 256, GW / 256, 1, C.G, C.bid, GW / 64);
            EpiGLU E{(const bf16*)(C.ws + WS_YG), C.in[I_S5GLUB] + (size_t)l * GW, OB}; gemm_phase(C.lds, g, S, E); }
        SEAM(pb + 7);
        if (EN(14) && IN(pb + 8)) { REFRESH();
            Gemm g{OB, wl(C, l, OFF_WOUT), D, D, D, 0, 0}; Order S; S.init(M_LAT / 256, D / 256, 1, C.G, C.bid, D / 64);
            EpiRes E{&C, gate_ptr(C, l, 1, 0), gs_ptr(C, l, 2, 0), rowss_ptr(C, l, 2), AP}; gemm_phase(C.lds, g, S, E);
            if (want_ctx) { REFRESH(); Order S2; S2.init_split(M_LAT / 256, M_CTX / 256, D / 256, 4, C.G, C.bid, D / 64); EpiAcc E2{&C, gate_ptr(C, l, 1, 0)}; gemm_phase(C.lds, g, S2, E2); } }
        SEAM(pb + 8);
        if (EN(18) && IN(pb + 9) && want_ctx) { REFRESH(); ph_ctxfix(C, gs_ptr(C, l, 2, 0), rowss_ptr(C, l, 2)); }
        SEAM(pb + 9);
        if (EN(15) && IN(pb + 10)) { REFRESH();
            Gemm g{AP, wl(C, l, OFF_W2GU), D, D, D, 0, 0}; Order S; S.init(mrows_out / 256, 2 * FF / 256, 1, C.G, C.bid, D / 64);
            EpiGU E{rowss_ptr(C, l, 2), bias_ptr(C, l, 2), Hb, mrows_out}; gemm_phase(C.lds, g, S, E); }
        SEAM(pb + 10);
        if (EN(16) && IN(pb + 11)) { REFRESH();
            Gemm g{Hb, wl(C, l, OFF_W2D), FF, FF, FF, 0, 0}; Order S; S.init(M_LAT / 256, D / 256, 1, C.G, C.bid, FF / 64);
            const bool more = l + 1 < NL;
            EpiRes E{&C, gate_ptr(C, l, 2, 0), more ? gs_ptr(C, l + 1, 0, 0) : nullptr, more ? rowss_ptr(C, l + 1, 0) : nullptr, AP}; gemm_phase(C.lds, g, S, E);
            if (want_ctx) { REFRESH(); Order S2; S2.init_split(M_LAT / 256, M_CTX / 256, D / 256, 4, C.G, C.bid, FF / 64); EpiAcc E2{&C, gate_ptr(C, l, 2, 0)}; gemm_phase(C.lds, g, S2, E2); } }
        SEAM(pb + 11);
        if (EN(18) && IN(pb + 12) && want_ctx) { REFRESH(); ph_ctxfix(C, gs_ptr(C, l + 1, 0, 0), rowss_ptr(C, l + 1, 0)); }
        SEAM(pb + 12);
    }
#undef IN
#undef SEAM
}

#ifndef MK_PER_PHASE
#define MK_PER_PHASE 0
#endif
#ifdef EMU
int g_emu_grid = 4, g_emu_lo = 0, g_emu_hi = NPH;
#endif
extern "C" void kernel_launch(void* const* d_in, const int* in_sizes, int n_in, void* d_out, int out_size, void* d_ws, size_t ws_size, hipStream_t stream) {
    Args a{};
    for (int i = 0; i < 42; ++i) a.in[i] = (const float*)d_in[i];
    a.out = (float*)d_out; a.ws = (unsigned char*)d_ws;
#ifdef EMU
    if (g_emu_lo == 0) hipMemsetAsync(d_ws, 0, WS_ZERO_END, stream);
    for (int ph = g_emu_lo; ph < g_emu_hi; ++ph) { a.ph_lo = ph; a.ph_hi = ph + 1; fprintf(stderr, "phase %d\n", ph); emu::launch(g_emu_grid, NTHR, LDS_BYTES, [=] { fwd(a); }); }
#else
    static int grid = 0;
    if (grid == 0) {
        if (n_in != 42 || out_size != M_LAT * D || ws_size < WS_END) { fprintf(stderr, "kernel_launch: unexpected shapes (n_in %d out %d ws %zu need %zu)\n", n_in, out_size, ws_size, (size_t)WS_END); grid = -1; return; }
        int dev = 0, cus = 0;
        if (hipGetDevice(&dev) != hipSuccess || hipDeviceGetAttribute(&cus, hipDeviceAttributeMultiprocessorCount, dev) != hipSuccess) { grid = -1; return; }
        if (hipFuncSetAttribute((const void*)fwd, hipFuncAttributeMaxDynamicSharedMemorySize, LDS_BYTES) != hipSuccess) { fprintf(stderr, "kernel_launch: hipFuncSetAttribute failed\n"); grid = -1; return; }
        int per_cu = 0; (void)hipOccupancyMaxActiveBlocksPerMultiprocessor(&per_cu, (const void*)fwd, NTHR, LDS_BYTES); (void)hipGetLastError();
        if (per_cu < 1) fprintf(stderr, "kernel_launch: occupancy query reports %d\n", per_cu);
        grid = cus;
    }
    if (grid < 0) return;
    (void)hipMemsetAsync(d_ws, 0, WS_ZERO_END, stream);
#if MK_PER_PHASE
    for (int ph = 0; ph < NPH; ++ph) { a.ph_lo = ph; a.ph_hi = ph + 1; hipLaunchKernelGGL(fwd, dim3(grid), dim3(NTHR), LDS_BYTES, stream, a); }
#else
    a.ph_lo = 0; a.ph_hi = NPH;
    hipLaunchKernelGGL(fwd, dim3(grid), dim3(NTHR), LDS_BYTES, stream, a);
#endif
#endif
}
```

```cpp
#ifdef EMU
#include "emu/emu.h"
#define LAS
#define GAS
#define ASMV(...) ((void)0)
#define WSYNC() do { int _z = 0; (void)emu::wave_gather(&_z, 4); } while (0)
#define OPAQUE(x) ((void)0)
#define OPAQUE_S(x) ((void)0)
#define PIN(x) ((void)0)
#define PIN4(a, b, c, d) ((void)0)
#define OPAQUE_LDS(p) (p)
#else
#include <hip/hip_runtime.h>
#include <cstdio>
#include <cstdint>
#define LAS __attribute__((address_space(3)))
#define GAS __attribute__((address_space(1)))
#define ASMV(...) asm volatile(__VA_ARGS__)
#define PIN(x) asm volatile("" : "+v"(x) :: "memory")
#define PIN4(a, b, c, d) asm volatile("" : "+v"(a), "+v"(b), "+v"(c), "+v"(d) :: "memory")
template <class P> __device__ __forceinline__ P opaque_lds(P p) { unsigned a = (unsigned)(size_t)p; asm volatile("" : "+v"(a)); return (P)(size_t)a; }
#define OPAQUE_LDS(p) opaque_lds(p)
#define OPAQUE_S(x) asm volatile("" : "+s"(x))
#define OPAQUE(x) asm volatile("" : "+v"(x))
#define WSYNC() asm volatile("s_waitcnt lgkmcnt(0)" ::: "memory")
#endif

#ifdef EMU
constexpr int D = 1024, NB = 2, T = 1024, NL = 2, TC = 256, FF = 1024;
#else
constexpr int D = 2048, NB = 2, T = 8192, NL = 4, TC = 256, FF = 5632;
#endif
constexpr int GW = D / 4, NH = GW / 64, WAG = NH / 2, S5G = GW / 16, GRW = 64, GRH = T / GRW;
constexpr int M_LAT = NB * T, M_CTX = NB * TC, M = M_LAT + M_CTX, NPAN = M / 256;
constexpr int TP = GW / 256;
constexpr int NT_IN = 8 * TP + 2, NINP = NT_IN * 256, D_IN = 8 * GW + 416;
constexpr int PN_AQ = 0, PN_AK = TP, PN_AV = 2 * TP, PN_BR = 3 * TP, PN_BK = 4 * TP, PN_BV = 5 * TP, PN_BS = 6 * TP, PN_CQ = 6 * TP + 1, PN_CKV = 7 * TP + 1, PN_DU = 7 * TP + 2;
constexpr int SRC_AQ = 0, SRC_AK = GW, SRC_AV = 2 * GW, SRC_BR = 3 * GW, SRC_BK = 4 * GW, SRC_BV = 5 * GW, SRC_BS = 6 * GW, SRC_CQ = 6 * GW + 160, SRC_CK = 7 * GW + 160, SRC_CV = 7 * GW + 288, SRC_DU = 7 * GW + 416;
constexpr int S5L = 32, NCH = M / S5L, NCHP = ((NCH + 255) / 256) * 256, S5K = 768;
constexpr int NW = 8, NTHR = 512;
constexpr float NORM_EPS = 1e-6f, RW_GN_EPS = 64e-5f;

typedef unsigned short bf16;
typedef short bf16x8 __attribute__((ext_vector_type(8)));
typedef short s16x4 __attribute__((ext_vector_type(4)));
typedef float f32x4 __attribute__((ext_vector_type(4)));
typedef float f32x2 __attribute__((ext_vector_type(2)));
typedef float f32x16 __attribute__((ext_vector_type(16)));
typedef unsigned u32x4 __attribute__((ext_vector_type(4)));
typedef unsigned u32x2 __attribute__((ext_vector_type(2)));
#define DI __device__ __forceinline__

constexpr size_t al256(size_t x) { return (x + 255) & ~(size_t)255; }
constexpr size_t SZ_BIAS_GU = (size_t)3 * 2 * FF * 4, SZ_BIAS_IN = (size_t)3 * NINP * 4;
constexpr size_t WS_CTL = 0;
constexpr size_t WS_BIAS = 65536;
constexpr size_t SZ_BIAS_L = 2 * SZ_BIAS_GU + SZ_BIAS_IN;
constexpr size_t WS_ROWSS = al256(WS_BIAS + NL * SZ_BIAS_L);
constexpr size_t WS_ZERO_END = al256(WS_ROWSS + (size_t)NL * 3 * M * 4);
constexpr size_t WS_MODV = WS_ZERO_END;
constexpr size_t WS_GS = al256(WS_MODV + (size_t)NL * 3 * 9 * D * 4);
constexpr size_t WS_GATE = al256(WS_GS + (size_t)NL * 9 * D * 4);
constexpr size_t WS_ROPE = al256(WS_GATE + (size_t)NL * 9 * D * 4);
constexpr size_t SZ_WGU = (size_t)2 * FF * D * 2, SZ_WD = (size_t)D * FF * 2, SZ_WIN = (size_t)NINP * D * 2, SZ_WOUT = (size_t)D * D * 2, SZ_WGLU = (size_t)GW * GW * 2;
constexpr size_t OFF_W1GU = 0, OFF_W1D = OFF_W1GU + SZ_WGU, OFF_WIN = OFF_W1D + SZ_WD, OFF_WOUT = OFF_WIN + SZ_WIN, OFF_W2GU = OFF_WOUT + SZ_WOUT, OFF_W2D = OFF_W2GU + SZ_WGU, OFF_WGLU = OFF_W2D + SZ_WD, SZ_WL = OFF_WGLU + SZ_WGLU;
constexpr size_t WS_W = al256(WS_ROPE + 128 * 16 * 8);
constexpr size_t SZ_S5KC = (size_t)S5G * 2 * S5L * 256 * 4, SZ_S5ET = (size_t)S5G * 256 * 512 * 2, SZ_S5BT = (size_t)S5G * 512 * S5K * 2, SZ_S5LAM = (size_t)2 * GW * 4 * 8;
constexpr size_t SZ_S5LP = (size_t)2 * S5G * 64 * (S5L + 1) * 8, SZ_S5BETA = (size_t)2 * S5G * 64 * 16 * 8;
constexpr size_t OFF_S5KC = 0, OFF_S5ET = OFF_S5KC + SZ_S5KC, OFF_S5BT = OFF_S5ET + SZ_S5ET, OFF_S5LAM = OFF_S5BT + SZ_S5BT, OFF_S5LP = al256(OFF_S5LAM + SZ_S5LAM), OFF_S5BETA = OFF_S5LP + SZ_S5LP, SZ_S5L = al256(OFF_S5BETA + SZ_S5BETA);
constexpr size_t WS_S5T = al256(WS_W + NL * SZ_WL);
constexpr size_t WS_XC = al256(WS_S5T + NL * SZ_S5L);
constexpr size_t WS_AP = al256(WS_XC + (size_t)M_CTX * D * 4);
constexpr size_t WS_H = al256(WS_AP + (size_t)M * D * 2);
constexpr size_t WS_QA = al256(WS_H + (size_t)M * FF * 2);
constexpr size_t WS_KA = WS_QA + (size_t)M * GW * 2, WS_VA = WS_KA + (size_t)M * GW * 2, WS_QC = WS_VA + (size_t)M * GW * 2;
constexpr size_t WS_KC = WS_QC + (size_t)M * GW * 2, WS_VC = WS_KC + (size_t)M * 128 * 2;
constexpr size_t WS_PB = WS_VC + (size_t)M * 128 * 2;
constexpr size_t WS_PS = al256(WS_PB + (size_t)M * 3 * GW * 2);
constexpr size_t WS_UG = al256(WS_PS + (size_t)M * 160 * 4);
constexpr size_t WS_RW = al256(WS_UG + (size_t)S5G * NCHP * S5K * 2);
constexpr size_t SZ_RWA = (size_t)M * GW * 4;
enum { RW_R = 0, RW_V, RW_NKK, RW_G, RW_W0, RW_W1, RW_K0, RW_K1, RW_B0, RW_B1, RW_Y0, RW_Y1, RW_NARR };
constexpr size_t WS_XEND = al256(WS_RW + RW_NARR * SZ_RWA);
constexpr size_t WS_YG = al256(WS_XEND + (size_t)S5G * NCHP * 256 * 4);
constexpr size_t WS_OB = al256(WS_YG + (size_t)M * GW * 2);
constexpr int RCK = (TC + T) / 64, RSTR = NB * NH * 2, RITEM = RSTR * RCK;
constexpr size_t WS_QH = al256(WS_OB + (size_t)M * D * 2);
constexpr size_t WS_YL = al256(WS_QH + (size_t)RITEM * 8192);
constexpr size_t WS_MF = al256(WS_YL + (size_t)RITEM * 16384);
constexpr size_t WS_GF = al256(WS_MF + (size_t)RITEM * 8192);
constexpr size_t WS_SF = al256(WS_GF + (size_t)RITEM * 16384);
constexpr int RBLK = NB * NH * ((TC + T) / 64);
constexpr size_t WS_RVKG = al256(WS_SF + (size_t)RITEM * 8192);
constexpr size_t SZ_RWF = (size_t)14 * NH * 2 * 64 * 16;
constexpr size_t WS_RWF = al256(WS_RVKG + (size_t)RBLK * 32768);
constexpr size_t WS_RWS = al256(WS_RWF + NL * SZ_RWF);
constexpr size_t WS_END = al256(WS_RWS + (size_t)512 * 2 * 65536);
constexpr int CW_BAR = 1024;

constexpr int LDS_BYTES = 147456, RING_BYTES = 131072, MISC_OFF = LDS_BYTES - 256;

DI unsigned f2bf(float f) { unsigned u = __float_as_uint(f); return (u + 0x7fffu + ((u >> 16) & 1u)) >> 16; }
#ifdef EMU
DI unsigned pk2(float lo, float hi) { return f2bf(lo) | (f2bf(hi) << 16); }
#else
typedef __bf16 hbf16x2 __attribute__((ext_vector_type(2)));
DI unsigned pk2(float lo, float hi) { const f32x2 v = {lo, hi}; const hbf16x2 b = __builtin_convertvector(v, hbf16x2); return __builtin_bit_cast(unsigned, b); }
#endif
DI float bf2f(unsigned short b) { return __uint_as_float(((unsigned)b) << 16); }
DI float bflo(unsigned w) { return __uint_as_float(w << 16); }
DI float bfhi(unsigned w) { return __uint_as_float(w & 0xffff0000u); }
template <int N> DI float ror_add(float v) { return v + __int_as_float(__builtin_amdgcn_mov_dpp(__float_as_int(v), 0x120 + N, 0xf, 0xf, true)); }
DI float row16_sum(float v) { v = ror_add<8>(v); v = ror_add<4>(v); v = ror_add<2>(v); v = ror_add<1>(v); return v; }
DI float wave_sum(float v) {
    v = row16_sum(v);
    const float a = __int_as_float(__builtin_amdgcn_readlane(__float_as_int(v), 0)), b = __int_as_float(__builtin_amdgcn_readlane(__float_as_int(v), 16)),
                c = __int_as_float(__builtin_amdgcn_readlane(__float_as_int(v), 32)), d = __int_as_float(__builtin_amdgcn_readlane(__float_as_int(v), 48));
    return (a + b) + (c + d);
}
DI float siluf(float x) { return x * __builtin_amdgcn_rcpf(1.f + __expf(-x)); }
DI float sigmf(float x) { return __builtin_amdgcn_rcpf(1.f + __expf(-x)); }
DI float geluf(float x) { const float z = 0.7978845608028654f * (x + 0.044715f * x * x * x); const float e = __expf(2.f * z); return 0.5f * x * (1.f + (1.f - 2.f * __builtin_amdgcn_rcpf(e + 1.f))); }
DI int stream_of_row(int row) { return row < M_LAT ? row / T : NB; }
DI int stream_of_panel(int pm) { return stream_of_row(pm * 256); }

#define XB_TMO      128
#define XB_XCNT(j)  (256  + 64 * (j))
#define XB_XSUB(j)  (1280 + 64 * (j))
#define XB_XGEN(j)  (2304 + 64 * (j))
#define XB_TOP      3328
#define XB_TOPGEN   3392
#define XCD_BAR_WORDS 3456
#define XB_SPIN_CAP (1u << 18)
DI unsigned xb_ld(unsigned* p)              { return __hip_atomic_load(p, __ATOMIC_RELAXED, __HIP_MEMORY_SCOPE_AGENT); }
DI unsigned xb_add(unsigned* p, unsigned v) { return __hip_atomic_fetch_add(p, v, __ATOMIC_RELAXED, __HIP_MEMORY_SCOPE_AGENT); }
DI unsigned xb_xcc_id() { return (unsigned)__builtin_amdgcn_s_getreg((3 << 11) | 20) & 0xFu; }
#define XB_SPIN(cond, bar) do { unsigned _sp = 0; while (cond) { __builtin_amdgcn_s_sleep(1); \
    if ((++_sp & 255u) == 0u) { if (xb_ld(&(bar)[XB_TMO])) break; if (_sp > XB_SPIN_CAP) { atomicAdd(&(bar)[XB_TMO], 1u); break; } } } } while (0)
struct XcdBarrier { unsigned* bar; unsigned x; volatile LAS unsigned* st; };
DI XcdBarrier xcd_barrier_post(unsigned* bar, volatile LAS unsigned* st) {
    XcdBarrier b; b.bar = bar; b.x = xb_xcc_id(); b.st = st;
    if (threadIdx.x == 0) (void)xb_add(&bar[XB_XCNT(b.x)], 1u);
    return b;
}
DI void xcd_barrier_complete(unsigned* bar, unsigned x, unsigned& nloc, unsigned& nx) {
    const unsigned G = gridDim.x * gridDim.y * gridDim.z;
    unsigned sum, cnt, mine, sp = 0u;
    for (;;) {
        sum = 0u; cnt = 0u; mine = 0u;
#pragma unroll
        for (unsigned j = 0; j < 16; ++j) { const unsigned c = xb_ld(&bar[XB_XCNT(j)]); sum += c; cnt += (c > 0u) ? 1u : 0u; mine = (j == x) ? c : mine; }
        if (sum == G) break;
        __builtin_amdgcn_s_sleep(1);
        if ((++sp & 255u) == 0u) { if (xb_ld(&bar[XB_TMO])) break; if (sp > XB_SPIN_CAP) { atomicAdd(&bar[XB_TMO], 1u); break; } }
    }
    nloc = mine > 0u ? mine : 1u; nx = cnt > 0u ? cnt : 1u;
}
DI void xcd_barrier(const XcdBarrier& b) {
    ASMV("s_waitcnt vmcnt(0)" ::: "memory");
    __syncthreads();
    if (threadIdx.x == 0) {
        unsigned* bar = b.bar;
        __builtin_amdgcn_s_waitcnt(0);
        unsigned nloc = b.st[0], nx = b.st[1];
        if (nloc == 0u) { xcd_barrier_complete(bar, b.x, nloc, nx); b.st[0] = nloc; b.st[1] = nx; }
        const unsigned old = xb_add(&bar[XB_XSUB(b.x)], 1u);
        const unsigned gen = old / nloc;
        if (old + 1u == (gen + 1u) * nloc) {
            __builtin_amdgcn_fence(__ATOMIC_RELEASE, "agent");
            ASMV("s_waitcnt vmcnt(0)" ::: "memory");
            const unsigned og = xb_add(&bar[XB_TOP], 1u);
            const unsigned tg = og / nx;
            if (og + 1u == (tg + 1u) * nx) xb_add(&bar[XB_TOPGEN], 1u);
            else XB_SPIN(xb_ld(&bar[XB_TOPGEN]) == tg, bar);
            __builtin_amdgcn_fence(__ATOMIC_ACQUIRE, "agent");
            xb_add(&bar[XB_XGEN(b.x)], 1u);
            ASMV("s_waitcnt vmcnt(0)" ::: "memory");
        } else {
            XB_SPIN(xb_ld(&bar[XB_XGEN(b.x)]) == gen, bar);
            __builtin_amdgcn_fence(__ATOMIC_ACQUIRE, "agent");
            ASMV("s_waitcnt vmcnt(0)" ::: "memory");
        }
    }
    __syncthreads();
}

constexpr int BK = 64, HALF = 128, HTB = HALF * BK * 2, NXCD = 8, WGM = 8;
DI int lds_byte(int r, int c) { const int st = (r >> 4) * 2 + (c >> 5), rr = r & 15, cc = c & 31, ob = rr * 64 + cc * 2; return st * 1024 + (ob ^ (((ob >> 9) & 1) << 5)); }
DI void stage_rc(int b, int& R, int& C) { const int st = b / 1024, sb = b % 1024, swz = sb ^ (((sb >> 9) & 1) << 5); R = (st >> 1) * 16 + swz / 64; C = (st & 1) * 32 + (swz % 64) / 2; }
struct Unit { int pm, pn, z, kt0; };
struct Gemm { const bf16* A; const bf16* Bt; int lda, ldb, K; size_t zA, zB; };
struct Order {
    int nM, nN, nZ, per, total, G, c, nkt, pm0, spl;
    DI void init(int nM_, int nN_, int nZ_, int G_, int c_, int nkt_) { nM = nM_; nN = nN_; nZ = nZ_; per = nM * nN; total = per * nZ; G = G_; c = c_; nkt = nkt_; pm0 = 0; spl = 0; }
    DI void init_split(int pm0_, int xM, int nN_, int spl_, int G_, int c_, int nkt_full) { nM = xM; nN = nN_; nZ = 1; per = xM * nN_ * spl_; total = per; G = G_; c = c_; nkt = nkt_full / spl_; pm0 = pm0_; spl = spl_; }
    DI bool next(int i, Unit& u) const {
        const long L = (long)i * G + c; if (L >= total) return false;
        if (spl) { const int j = (int)L; u.z = 0; u.pm = pm0 + j / (nN * spl); const int rem = j % (nN * spl); u.pn = rem / spl; u.kt0 = (rem % spl) * nkt; return true; }
        u.kt0 = 0;
        u.z = (int)(L / per); int wgid = (int)(L % per);
        { const int q = per / NXCD, r = per % NXCD, xcd = wgid % NXCD, off = wgid / NXCD; wgid = (xcd < r ? xcd * (q + 1) : r * (q + 1) + (xcd - r) * q) + off; }
        const int nig = WGM * nN, gid = wgid / nig, fm = gid * WGM, gsz = (nM - fm) < WGM ? (nM - fm) : WGM;
        u.pm = fm + ((wgid % nig) % gsz); u.pn = (wgid % nig) / gsz; return true;
    }
};

template <class Epi>
DI void gemm_phase(LAS unsigned char* lds, const Gemm g, const Order& S, const Epi& E) {
    int tid_ = threadIdx.x; OPAQUE(tid_);
    const int tid = tid_, wid = __builtin_amdgcn_readfirstlane(tid >> 6), lane = tid & 63, wr = wid >> 2, wc = wid & 3, fr = lane & 15, fq = lane >> 4;
    Unit cur, nxt; int ui = 0;
    if (!S.next(0, cur)) return;
    f32x4 acc[2][2][4][2];
#ifdef EMU
    (void)lds;
    for (;; ++ui) {
        if (ui > 0) { if (!S.next(ui, cur)) break; }
        const bf16* A = (const bf16*)((const char*)g.A + cur.z * g.zA); const bf16* B = (const bf16*)((const char*)g.Bt + cur.z * g.zB);
        for (int ai = 0; ai < 2; ++ai) for (int bj = 0; bj < 2; ++bj) for (int m = 0; m < 4; ++m) for (int n = 0; n < 2; ++n) for (int j = 0; j < 4; ++j) {
            const int r = 256 * cur.pm + 128 * ai + 64 * wr + 16 * m + fr, c = 256 * cur.pn + 128 * bj + 32 * wc + 16 * n + 4 * fq + j;
            const bf16* a = A + (size_t)r * g.lda; const bf16* b = B + (size_t)c * g.ldb; float s = 0.f;
            for (int k = cur.kt0 * BK; k < (cur.kt0 + S.nkt) * BK; ++k) s += bf2f(a[k]) * bf2f(b[k]);
            acc[ai][bj][m][n][j] = s; }
        E(acc, cur, wr, wc, fr, fq);
    }
#else
    unsigned voffA[2], voffB[2];
#pragma unroll
    for (int i = 0; i < 2; ++i) { int R, C; stage_rc(tid * 16 + i * 8192, R, C); voffA[i] = (unsigned)(R * g.lda + C) * 2u; voffB[i] = (unsigned)(R * g.ldb + C) * 2u; }
    const size_t kstep = (size_t)(BK * 2);
    const size_t hstepA = (size_t)HALF * g.lda * 2, hstepB = (size_t)HALF * g.ldb * 2, tstepA = 2 * hstepA, tstepB = 2 * hstepB;
    const unsigned ldsw = (unsigned)wid * 1024u;
    const int aoff = lds_byte(wr * 64 + fr, fq * 8), boff = lds_byte(wc * 32 + fr, fq * 8);
#define PG8_SA(b, h) (((b) * 2 + (h)) * HTB)
#define PG8_SB(b, h) ((4 + (b) * 2 + (h)) * HTB)
#define PG8_STAGE(bufoff, gbase, voff) do { _Pragma("unroll") for (int _i = 0; _i < 2; ++_i) \
        __builtin_amdgcn_global_load_lds((const unsigned*)((const char*)(gbase) + (voff)[_i]), (LAS unsigned*)(lds + (bufoff) + ldsw + _i * 8192), 16, 0, 0); } while (0)
#define PG8_LDA(dst, b, h) do { _Pragma("unroll") for (int m = 0; m < 4; ++m) _Pragma("unroll") for (int k = 0; k < 2; ++k) dst[m][k] = *(const LAS bf16x8*)(lds + PG8_SA(b, h) + aoff + m * 2048 + k * 1024); } while (0)
#define PG8_LDB(dst, b, h) do { _Pragma("unroll") for (int n = 0; n < 2; ++n) _Pragma("unroll") for (int k = 0; k < 2; ++k) dst[n][k] = *(const LAS bf16x8*)(lds + PG8_SB(b, h) + boff + n * 2048 + k * 1024); } while (0)
#define PG8_MMA(ai, bj, At, Bt) do { __builtin_amdgcn_s_setprio(1); _Pragma("unroll") for (int m = 0; m < 4; ++m) _Pragma("unroll") for (int n = 0; n < 2; ++n) _Pragma("unroll") for (int k = 0; k < 2; ++k) \
        acc[ai][bj][m][n] = __builtin_amdgcn_mfma_f32_16x16x32_bf16(Bt[n][k], At[m][k], acc[ai][bj][m][n], 0, 0, 0); __builtin_amdgcn_s_setprio(0); } while (0)
#define PG8_WAIT_V(n) asm volatile("s_waitcnt vmcnt(" #n ")" ::: "memory")
#define PG8_WAIT_L(n) asm volatile("s_waitcnt lgkmcnt(" #n ")" ::: "memory")
#define PG8_BAR __builtin_amdgcn_s_barrier()
#define PG8_SCHED __builtin_amdgcn_sched_barrier(0)
#pragma unroll
    for (int a = 0; a < 2; ++a)
#pragma unroll
        for (int b = 0; b < 2; ++b)
#pragma unroll
            for (int m = 0; m < 4; ++m)
#pragma unroll
                for (int n = 0; n < 2; ++n) acc[a][b][m][n] = (f32x4){0.f, 0.f, 0.f, 0.f};
    bf16x8 At[4][2], B0[2][2], B1[2][2];
    const char* cA = (const char*)g.A + (size_t)cur.z * g.zA + (size_t)cur.pm * tstepA + (size_t)cur.kt0 * kstep; const char* cB = (const char*)g.Bt + (size_t)cur.z * g.zB + (size_t)cur.pn * tstepB + (size_t)cur.kt0 * kstep;
    PG8_STAGE(PG8_SB(0, 0), cB, voffB); PG8_STAGE(PG8_SB(0, 1), cB + hstepB, voffB); PG8_STAGE(PG8_SA(0, 0), cA, voffA); PG8_STAGE(PG8_SA(0, 1), cA + hstepA, voffA);
    if (wr == 1) PG8_BAR;
    PG8_WAIT_V(2); PG8_BAR;
    PG8_STAGE(PG8_SB(1, 0), cB + kstep, voffB); PG8_STAGE(PG8_SA(1, 0), cA + kstep, voffA); PG8_STAGE(PG8_SB(1, 1), cB + hstepB + kstep, voffB);
    PG8_WAIT_V(6); PG8_BAR;
    for (;;) {
        const bool has_next = S.next(ui + 1, nxt);
        const char* nA = has_next ? (const char*)g.A + (size_t)nxt.z * g.zA + (size_t)nxt.pm * tstepA + (size_t)nxt.kt0 * kstep : cA; const char* nB = has_next ? (const char*)g.Bt + (size_t)nxt.z * g.zB + (size_t)nxt.pn * tstepB + (size_t)nxt.kt0 * kstep : cB;
        const int nt = S.nkt;
        for (int t = 0; t < nt; t += 2) {
            const bool last = (t == nt - 2);
            const char* a1 = cA + (size_t)(t + 1) * kstep;
            const char* a2 = last ? nA : cA + (size_t)(t + 2) * kstep; const char* b2 = last ? nB : cB + (size_t)(t + 2) * kstep;
            const char* a3 = a2 + kstep; const char* b3 = b2 + kstep;
            PG8_LDB(B0, 0, 0); PG8_LDB(B1, 0, 1); PG8_SCHED; PG8_LDA(At, 0, 0); PG8_STAGE(PG8_SA(1, 1), a1 + hstepA, voffA);
            PG8_WAIT_V(8); PG8_WAIT_L(0); PG8_BAR; PG8_MMA(0, 0, At, B0); PG8_MMA(0, 1, At, B1); PG8_BAR; PG8_SCHED;
            PG8_LDA(At, 0, 1); PG8_STAGE(PG8_SB(0, 0), b2, voffB); PG8_STAGE(PG8_SB(0, 1), b2 + hstepB, voffB); PG8_STAGE(PG8_SA(0, 0), a2, voffA);
            PG8_WAIT_V(8); PG8_WAIT_L(0); PG8_BAR; PG8_MMA(1, 0, At, B0); PG8_MMA(1, 1, At, B1); PG8_BAR; PG8_SCHED;
            PG8_LDB(B0, 1, 0); PG8_LDB(B1, 1, 1); PG8_SCHED; PG8_LDA(At, 1, 0); PG8_STAGE(PG8_SA(0, 1), a2 + hstepA, voffA);
            PG8_WAIT_V(8); PG8_WAIT_L(0); PG8_BAR; PG8_MMA(0, 0, At, B0); PG8_MMA(0, 1, At, B1); PG8_BAR; PG8_SCHED;
            PG8_LDA(At, 1, 1); PG8_STAGE(PG8_SB(1, 0), b3, voffB); PG8_STAGE(PG8_SB(1, 1), b3 + hstepB, voffB); PG8_STAGE(PG8_SA(1, 0), a3, voffA);
            PG8_WAIT_V(8); PG8_WAIT_L(0); PG8_BAR; PG8_MMA(1, 0, At, B0); PG8_MMA(1, 1, At, B1); PG8_BAR; PG8_SCHED;
        }
        if (wr == 0) PG8_BAR;
        E(acc, cur, wr, wc, fr, fq);
        if (!has_next) break;
#pragma unroll
        for (int a = 0; a < 2; ++a)
#pragma unroll
            for (int b = 0; b < 2; ++b)
#pragma unroll
                for (int m = 0; m < 4; ++m)
#pragma unroll
                    for (int n = 0; n < 2; ++n) acc[a][b][m][n] = (f32x4){0.f, 0.f, 0.f, 0.f};
        cur = nxt; cA = nA; cB = nB; ++ui;
        if (wr == 1) PG8_BAR;
    }
    PG8_WAIT_V(0);
    PG8_BAR;
#undef PG8_SA
#undef PG8_SB
#undef PG8_STAGE
#undef PG8_LDA
#undef PG8_LDB
#undef PG8_MMA
#undef PG8_WAIT_V
#undef PG8_WAIT_L
#undef PG8_BAR
#undef PG8_SCHED
#endif
}

struct Args {
    const float* in[42]; float* out; unsigned char* ws;
    int ph_lo, ph_hi;
};
struct Ctx {
    const float* const* in; float* out; unsigned char* ws;
    LAS unsigned char* lds; int tid, lane, wave, G, bid;
};
DI float* xrow_ptr(const Ctx& C, int row) { return row < M_LAT ? C.out + (size_t)row * D : (float*)(C.ws + WS_XC) + (size_t)(row - M_LAT) * D; }
DI const bf16* wl(const Ctx& C, int l, size_t off) { return (const bf16*)(C.ws + WS_W + (size_t)l * SZ_WL + off); }
DI float* bias_ptr(const Ctx& C, int l, int which  ) { return (float*)(C.ws + WS_BIAS + (size_t)l * SZ_BIAS_L + (which == 0 ? 0 : which == 1 ? SZ_BIAS_GU : SZ_BIAS_GU + SZ_BIAS_IN)); }
DI float* rowss_ptr(const Ctx& C, int l, int sub) { return (float*)(C.ws + WS_ROWSS) + ((size_t)l * 3 + sub) * M; }
DI const float* gs_ptr(const Ctx& C, int l, int sub, int s) { return (const float*)(C.ws + WS_GS) + (((size_t)l * 3 + sub) * 3 + s) * D; }
DI const float* gate_ptr(const Ctx& C, int l, int sub, int s) { return (const float*)(C.ws + WS_GATE) + (((size_t)l * 3 + sub) * 3 + s) * D; }
DI float* rw_arr(const Ctx& C, int a) { return (float*)(C.ws + WS_RW + (size_t)a * SZ_RWA); }
enum { I_X = 0, I_C, I_CTX, I_CCTX, I_WADA, I_BADA, I_NORMG, I_F1WG, I_F1WU, I_F1WD, I_F2WG, I_F2WU, I_F2WD, I_WIN, I_WOUT, I_NAQG, I_NAKG, I_NARPB, I_RWCONV, I_RWW0, I_RWWUP, I_RWA0, I_RWAUP,
       I_RWGUP, I_RWKK, I_RWKA, I_RWRK, I_RWGNW, I_RWGNB, I_WAQG, I_WAKG, I_WASINK, I_S5ARE, I_S5AIM, I_S5LDT, I_S5BRE, I_S5BIM, I_S5CRE, I_S5CIM, I_S5D, I_S5GLUW, I_S5GLUB, I_NIN };

struct EpiGU {
    const float* rowss; const float* bias  ; bf16* H; int mrows;
    DI void operator()(const f32x4 (&acc)[2][2][4][2], const Unit& u, int wr, int wc, int fr_, int fq_) const {
        int tz_ = threadIdx.x; OPAQUE(tz_); const int fr = tz_ & 15, fq = (tz_ & 63) >> 4; (void)fr_; (void)fq_;
        const int s = stream_of_panel(u.pm); const float* bs = bias + (size_t)s * 2 * FF + u.pn * 256 + wc * 32 + 4 * fq;
        f32x4 bg[2], bu[2];
#pragma unroll
        for (int n = 0; n < 2; ++n) { bg[n] = *(const f32x4*)(bs + 16 * n); bu[n] = *(const f32x4*)(bs + 128 + 16 * n); }
        float rsv[2][4];
#pragma unroll
        for (int ai = 0; ai < 2; ++ai)
#pragma unroll
            for (int m = 0; m < 4; ++m) rsv[ai][m] = rowss[u.pm * 256 + ai * 128 + wr * 64 + m * 16 + fr];
#pragma unroll
        for (int ai = 0; ai < 2; ++ai)
#pragma unroll
            for (int m = 0; m < 4; ++m) {
                const int row = u.pm * 256 + ai * 128 + wr * 64 + m * 16 + fr;
                const float rstd = __builtin_amdgcn_rsqf(rsv[ai][m] * (1.0f / D) + NORM_EPS);
                bf16* hp = H + (size_t)row * FF + u.pn * 128 + wc * 32 + 8 * fq;
                u32x4 w;
                { const f32x4 g = acc[ai][0][m][0] * rstd + bg[0], v = acc[ai][1][m][0] * rstd + bu[0]; w.x = pk2(siluf(g[0]) * v[0], siluf(g[1]) * v[1]); w.y = pk2(siluf(g[2]) * v[2], siluf(g[3]) * v[3]); }
                { const f32x4 g = acc[ai][0][m][1] * rstd + bg[1], v = acc[ai][1][m][1] * rstd + bu[1]; w.z = pk2(siluf(g[0]) * v[0], siluf(g[1]) * v[1]); w.w = pk2(siluf(g[2]) * v[2], siluf(g[3]) * v[3]); }
                *(u32x4*)hp = w;
            }
    }
};
struct EpiRes {
    const Ctx* C; const float* gate  ; const float* gsn  ; float* rowss_next; bf16* AP;
    DI void operator()(const f32x4 (&acc)[2][2][4][2], const Unit& u, int wr, int wc, int fr_, int fq_) const {
        int tz_ = threadIdx.x; OPAQUE(tz_); const int fr = tz_ & 15, fq = (tz_ & 63) >> 4; (void)fr_; (void)fq_;
        const int s = stream_of_panel(u.pm); const int col0 = u.pn * 256 + wc * 32 + 4 * fq;
        f32x4 gv[2][2], sv[2][2];
#pragma unroll
        for (int bj = 0; bj < 2; ++bj)
#pragma unroll
            for (int n = 0; n < 2; ++n) { gv[bj][n] = *(const f32x4*)(gate + (size_t)s * D + col0 + bj * 128 + n * 16); sv[bj][n] = gsn ? *(const f32x4*)(gsn + (size_t)s * D + col0 + bj * 128 + n * 16) : (f32x4){0.f, 0.f, 0.f, 0.f}; }
        f32x4 xc[2][2], xn[2][2];
        { const float* xp0 = xrow_ptr(*C, u.pm * 256 + wr * 64 + fr) + col0;
#pragma unroll
          for (int bj = 0; bj < 2; ++bj)
#pragma unroll
              for (int n = 0; n < 2; ++n) xn[bj][n] = *(const f32x4*)(xp0 + bj * 128 + n * 16); }
#pragma unroll
        for (int ai = 0; ai < 2; ++ai)
#pragma unroll
            for (int m = 0; m < 4; ++m) {
                const int row = u.pm * 256 + ai * 128 + wr * 64 + m * 16 + fr;
                float* xp = xrow_ptr(*C, row) + col0; float ss = 0.f;
#pragma unroll
                for (int bj = 0; bj < 2; ++bj)
#pragma unroll
                    for (int n = 0; n < 2; ++n) xc[bj][n] = xn[bj][n];
                if (ai * 4 + m < 7) { const int rn = ai * 4 + m + 1; const float* xq = xrow_ptr(*C, u.pm * 256 + (rn >> 2) * 128 + wr * 64 + (rn & 3) * 16 + fr) + col0;
#pragma unroll
                    for (int bj = 0; bj < 2; ++bj)
#pragma unroll
                        for (int n = 0; n < 2; ++n) xn[bj][n] = *(const f32x4*)(xq + bj * 128 + n * 16); }
#pragma unroll
                for (int bj = 0; bj < 2; ++bj)
#pragma unroll
                    for (int n = 0; n < 2; ++n) { f32x4 x = xc[bj][n]; x += gv[bj][n] * acc[ai][bj][m][n]; *(f32x4*)(xp + bj * 128 + n * 16) = x;
                        if (gsn) { ss += (x[0] * x[0] + x[1] * x[1]) + (x[2] * x[2] + x[3] * x[3]); const f32x4 a = x * sv[bj][n]; u32x2 w; w.x = pk2(a[0], a[1]); w.y = pk2(a[2], a[3]);
                            *(u32x2*)(AP + (size_t)row * D + col0 + bj * 128 + n * 16) = w; } }
                if (gsn) { ss += __shfl_xor(ss, 16); ss += __shfl_xor(ss, 32); if (fq == 0) atomicAdd(rowss_next + row, ss); }
            }
    }
};
struct EpiAcc {
    const Ctx* C; const float* gate;
    DI void operator()(const f32x4 (&acc)[2][2][4][2], const Unit& u, int wr, int wc, int fr_, int fq_) const {
        int tz_ = threadIdx.x; OPAQUE(tz_); const int fr = tz_ & 15, fq = (tz_ & 63) >> 4; (void)fr_; (void)fq_;
        const int s = stream_of_panel(u.pm); const int col0 = u.pn * 256 + wc * 32 + 4 * fq;
#pragma unroll
        for (int bj = 0; bj < 2; ++bj)
#pragma unroll
            for (int n = 0; n < 2; ++n) { const f32x4 gv = *(const f32x4*)(gate + (size_t)s * D + col0 + bj * 128 + n * 16);
#pragma unroll
                for (int ai = 0; ai < 2; ++ai)
#pragma unroll
                    for (int m = 0; m < 4; ++m) { float* xp = xrow_ptr(*C, u.pm * 256 + ai * 128 + wr * 64 + m * 16 + fr) + col0 + bj * 128 + n * 16; const f32x4 d = gv * acc[ai][bj][m][n];
#pragma unroll
                        for (int j = 0; j < 4; ++j) atomicAdd(xp + j, d[j]); } }
    }
};
struct EpiIn {
    const Ctx* C; const float* rowss; const float* bias  ; int l;
    DI void operator()(const f32x4 (&acc)[2][2][4][2], const Unit& u, int wr, int wc, int fr_, int fq_) const {
        int tz_ = threadIdx.x; OPAQUE(tz_); const int fr = tz_ & 15, fq = (tz_ & 63) >> 4; (void)fr_; (void)fq_;
        const int s = stream_of_panel(u.pm), pn = u.pn; const float* bs = bias + (size_t)s * NINP + pn * 256 + wc * 32 + 4 * fq;
        unsigned char* ws = C->ws;
        f32x4 bv[2][2];
#pragma unroll
        for (int bj = 0; bj < 2; ++bj)
#pragma unroll
            for (int n = 0; n < 2; ++n) bv[bj][n] = *(const f32x4*)(bs + bj * 128 + n * 16);
        float rsv[2][4];
#pragma unroll
        for (int ai = 0; ai < 2; ++ai)
#pragma unroll
            for (int m = 0; m < 4; ++m) rsv[ai][m] = rowss[u.pm * 256 + ai * 128 + wr * 64 + m * 16 + fr];
        const bool permuted = pn < PN_AV || (pn >= PN_CQ && pn < PN_DU);
        if (permuted) {
            const bool is_ckv = pn == PN_CKV, is_c = pn >= PN_CQ, is_q = pn < PN_AK || (pn >= PN_CQ && pn < PN_CKV);
            const bool plain_v = is_ckv && wc >= 2;
            const float* gsrc = C->in[is_c ? (is_q ? I_WAQG : I_WAKG) : (is_q ? I_NAQG : I_NAKG)] + (size_t)l * 64;
            f32x4 gn[2][2];
#pragma unroll
            for (int bj = 0; bj < 2; ++bj)
#pragma unroll
                for (int n = 0; n < 2; ++n) { gn[bj][n] = *(const f32x4*)(gsrc + 32 * bj + 16 * n + 4 * fq); if (is_q) gn[bj][n] *= 0.125f; }
            bf16* dst; int pitch, hcol;
            if (pn < PN_AK) { dst = (bf16*)(ws + WS_QA); pitch = GW; hcol = ((pn - PN_AQ) * 4 + wc) * 64; }
            else if (pn < PN_AV) { dst = (bf16*)(ws + WS_KA); pitch = GW; hcol = ((pn - PN_AK) * 4 + wc) * 64; }
            else if (pn < PN_CKV) { dst = (bf16*)(ws + WS_QC); pitch = GW; hcol = ((pn - PN_CQ) * 4 + wc) * 64; }
            else if (wc < 2) { dst = (bf16*)(ws + WS_KC); pitch = 128; hcol = wc * 64; }
            else { dst = (bf16*)(ws + WS_VC); pitch = 128; hcol = (wc - 2) * 64; }
            const f32x4* rope = (const f32x4*)(ws + WS_ROPE);
#pragma unroll
            for (int ai = 0; ai < 2; ++ai)
#pragma unroll
                for (int m = 0; m < 4; ++m) {
                    const int row = pn * 0 + u.pm * 256 + ai * 128 + wr * 64 + m * 16 + fr;
                    const float rstd = __builtin_amdgcn_rsqf(rsv[ai][m] * (1.0f / D) + NORM_EPS);
                    f32x4 v[2][2]; float ss = 0.f;
#pragma unroll
                    for (int bj = 0; bj < 2; ++bj)
#pragma unroll
                        for (int n = 0; n < 2; ++n) { v[bj][n] = acc[ai][bj][m][n] * rstd + bv[bj][n]; ss += (v[bj][n][0] * v[bj][n][0] + v[bj][n][1] * v[bj][n][1]) + (v[bj][n][2] * v[bj][n][2] + v[bj][n][3] * v[bj][n][3]); }
                    ss += __shfl_xor(ss, 16); ss += __shfl_xor(ss, 32);
                    if (!plain_v) { const float rs = 1.0f / sqrtf(ss * (1.0f / 64.0f) + NORM_EPS);
#pragma unroll
                        for (int bj = 0; bj < 2; ++bj)
#pragma unroll
                            for (int n = 0; n < 2; ++n) v[bj][n] = v[bj][n] * rs * gn[bj][n];
                        if (is_c && row < M_LAT) {
                            const int t = row % T; const int pos[2] = {t / GRW, t % GRW};
#pragma unroll
                            for (int bj = 0; bj < 2; ++bj) { const f32x4 cs0 = rope[(pos[bj] * 16 + 4 * fq) / 2], cs1 = rope[(pos[bj] * 16 + 4 * fq) / 2 + 1];
                                const float cc[4] = {cs0[0], cs0[2], cs1[0], cs1[2]}, sn[4] = {cs0[1], cs0[3], cs1[1], cs1[3]};
#pragma unroll
                                for (int j = 0; j < 4; ++j) { const float x1 = v[bj][0][j], x2 = v[bj][1][j]; v[bj][0][j] = x1 * cc[j] - x2 * sn[j]; v[bj][1][j] = x2 * cc[j] + x1 * sn[j]; } }
                        }
                    }
                    bf16* op = dst + (size_t)row * pitch + hcol + 4 * fq;
#pragma unroll
                    for (int bj = 0; bj < 2; ++bj)
#pragma unroll
                        for (int n = 0; n < 2; ++n) { u32x2 w; w.x = pk2(v[bj][n][0], v[bj][n][1]); w.y = pk2(v[bj][n][2], v[bj][n][3]); *(u32x2*)(op + 32 * bj + 16 * n) = w; }
                }
        } else {
#pragma unroll
            for (int ai = 0; ai < 2; ++ai)
#pragma unroll
                for (int m = 0; m < 4; ++m) {
                    const int row = u.pm * 256 + ai * 128 + wr * 64 + m * 16 + fr;
                    const float rstd = __builtin_amdgcn_rsqf(rsv[ai][m] * (1.0f / D) + NORM_EPS);
#pragma unroll
                    for (int bj = 0; bj < 2; ++bj)
#pragma unroll
                        for (int n = 0; n < 2; ++n) { const f32x4 v = acc[ai][bj][m][n] * rstd + bv[bj][n]; const int c = bj * 128 + wc * 32 + n * 16 + 4 * fq;
                            u32x2 w; w.x = pk2(v[0], v[1]); w.y = pk2(v[2], v[3]);
                            if (pn < PN_BR) *(u32x2*)((bf16*)(ws + WS_VA) + (size_t)row * GW + (pn - PN_AV) * 256 + c) = w;
                            else if (pn < PN_BS) *(u32x2*)((bf16*)(ws + WS_PB) + (size_t)row * 3 * GW + (pn - PN_BR) * 256 + c) = w;
                            else if (pn == PN_BS) { if (c < 160) *(f32x4*)((float*)(ws + WS_PS) + (size_t)row * 160 + c) = v; }
                            else { const int cu = (pn - PN_DU) * 256 + c, gq = cu >> 4, p0 = cu & 15;
                                *(u32x2*)((bf16*)(ws + WS_UG) + ((size_t)gq * NCHP + row / S5L) * S5K + (row % S5L) * 16 + p0) = w; } }
                }
        }
    }
};
struct EpiS5A {
    float* XE;
    DI void operator()(const f32x4 (&acc)[2][2][4][2], const Unit& u, int wr, int wc, int fr_, int fq_) const {
        int tz_ = threadIdx.x; OPAQUE(tz_); const int fr = tz_ & 15, fq = (tz_ & 63) >> 4; (void)fr_; (void)fq_;
#pragma unroll
        for (int ai = 0; ai < 2; ++ai)
#pragma unroll
            for (int m = 0; m < 4; ++m) { const int ch = u.pm * 256 + ai * 128 + wr * 64 + m * 16 + fr; if (ch < NCH) { float* p = XE + ((size_t)u.z * NCHP + ch) * 256 + wc * 32 + 4 * fq;
#pragma unroll
                for (int bj = 0; bj < 2; ++bj)
#pragma unroll
                    for (int n = 0; n < 2; ++n) *(f32x4*)(p + bj * 128 + n * 16) = acc[ai][bj][m][n]; } }
    }
};
struct EpiS5C {
    const bf16* UG; const float* dsk  ; bf16* YG;
    DI void operator()(const f32x4 (&acc)[2][2][4][2], const Unit& u, int wr, int wc, int fr_, int fq_) const {
        int tz_ = threadIdx.x; OPAQUE(tz_); const int fr = tz_ & 15, fq = (tz_ & 63) >> 4; (void)fr_; (void)fq_;
        const int g = u.z;
#pragma unroll
        for (int ai = 0; ai < 2; ++ai)
#pragma unroll
            for (int m = 0; m < 4; ++m) { const int ch = u.pm * 256 + ai * 128 + wr * 64 + m * 16 + fr; if (ch < NCH) {
#pragma unroll
                for (int bj = 0; bj < 2; ++bj)
#pragma unroll
                    for (int n = 0; n < 2; ++n) { const int col = u.pn * 256 + bj * 128 + wc * 32 + n * 16 + 4 * fq, i = col >> 4, p0 = col & 15;
                        const u32x2 uw = *(const u32x2*)(UG + ((size_t)g * NCHP + ch) * S5K + col); const f32x4 dv = *(const f32x4*)(dsk + 16 * g + p0);
                        const f32x4 a = acc[ai][bj][m][n]; const float y0 = a[0] + dv[0] * bflo(uw.x), y1 = a[1] + dv[1] * bfhi(uw.x), y2 = a[2] + dv[2] * bflo(uw.y), y3 = a[3] + dv[3] * bfhi(uw.y);
                        u32x2 w; w.x = pk2(geluf(y0), geluf(y1)); w.y = pk2(geluf(y2), geluf(y3));
                        *(u32x2*)(YG + (size_t)(ch * S5L + i) * GW + 16 * g + p0) = w; } } }
    }
};
struct EpiGLU {
    const bf16* YG; const float* gb; bf16* OB;
    DI void operator()(const f32x4 (&acc)[2][2][4][2], const Unit& u, int wr, int wc, int fr_, int fq_) const {
        int tz_ = threadIdx.x; OPAQUE(tz_); const int fr = tz_ & 15, fq = (tz_ & 63) >> 4; (void)fr_; (void)fq_;
#pragma unroll
        for (int ai = 0; ai < 2; ++ai)
#pragma unroll
            for (int m = 0; m < 4; ++m) { const int row = u.pm * 256 + ai * 128 + wr * 64 + m * 16 + fr;
#pragma unroll
                for (int bj = 0; bj < 2; ++bj)
#pragma unroll
                    for (int n = 0; n < 2; ++n) { const int col = u.pn * 256 + bj * 128 + wc * 32 + n * 16 + 4 * fq; const f32x4 b = *(const f32x4*)(gb + col); const f32x4 a = acc[ai][bj][m][n] + b;
                        const u32x2 yw = *(const u32x2*)(YG + (size_t)row * GW + col);
                        u32x2 w; w.x = pk2(bflo(yw.x) * sigmf(a[0]), bfhi(yw.x) * sigmf(a[1])); w.y = pk2(bflo(yw.y) * sigmf(a[2]), bfhi(yw.y) * sigmf(a[3]));
                        *(u32x2*)(OB + (size_t)row * D + 3 * GW + col) = w; } }
    }
};

DI void ph_ada(const Ctx& C) {
    LAS float* sc = (LAS float*)C.lds;
    LAS float* red = sc + 3 * D;
    for (int i = C.tid; i < 3 * D; i += NTHR) { const int s = i / D, k = i % D; const float c = s < NB ? C.in[I_C][s * D + k] : C.in[I_CCTX][k]; sc[i] = siluf(c); }
    __syncthreads();
    const int nun = NL * (9 * D / 256);
    for (int un = C.bid; un < nun; un += C.G) {
        const int l = un / (9 * D / 256), col0 = (un % (9 * D / 256)) * 256;
        const float* W = C.in[I_WADA] + (size_t)l * D * 9 * D + col0 + 4 * C.lane;
        f32x4 a0 = {0.f, 0.f, 0.f, 0.f}, a1 = a0, a2 = a0;
        const int k0 = C.wave * (D / 8);
#pragma unroll 1
        for (int kb = k0; kb < k0 + D / 8; kb += 16) {
            f32x4 wv[16];
#pragma unroll
            for (int u = 0; u < 16; ++u) wv[u] = *(const f32x4*)(W + (size_t)(kb + u) * 9 * D);
#pragma unroll
            for (int u = 0; u < 16; ++u) { a0 += wv[u] * sc[kb + u]; a1 += wv[u] * sc[D + kb + u]; a2 += wv[u] * sc[2 * D + kb + u]; } }
        LAS float* r = red + C.wave * 768 + 4 * C.lane;
        *(LAS f32x4*)(r) = a0; *(LAS f32x4*)(r + 256) = a1; *(LAS f32x4*)(r + 512) = a2;
        __syncthreads();
        for (int i = C.tid; i < 768; i += NTHR) { float s = 0.f;
#pragma unroll
            for (int w = 0; w < 8; ++w) s += red[w * 768 + i];
            const int st = i / 256, c = col0 + (i % 256);
            ((float*)(C.ws + WS_MODV))[((size_t)l * 3 + st) * 9 * D + c] = s + C.in[I_BADA][(size_t)l * 9 * D + c]; }
        __syncthreads();
    }
}
DI const float* modv_ptr(const Ctx& C, int l, int s, int chunk) { return (const float*)(C.ws + WS_MODV) + ((size_t)l * 3 + s) * 9 * D + (size_t)chunk * D; }

DI int win_dest(int n) {
    if (n >= D_IN) return -1;
    if (n < SRC_AV) { const int piece = n / GW, loc = n % GW, head = loc / 64, d = loc % 64; return ((piece == 0 ? PN_AQ : PN_AK) + head / 4) * 256 + 128 * (d / 32) + 32 * (head % 4) + (d % 32); }
    if (n < SRC_BS) return PN_AV * 256 + (n - SRC_AV);
    if (n < SRC_CQ) return PN_BS * 256 + (n - SRC_BS);
    if (n < SRC_CK) { const int loc = n - SRC_CQ, head = loc / 64, d = loc % 64; return (PN_CQ + head / 4) * 256 + 128 * (d / 32) + 32 * (head % 4) + (d % 32); }
    if (n < SRC_DU) { const int loc = n - SRC_CK, hh = loc / 64, d = loc % 64; return PN_CKV * 256 + 128 * (d / 32) + 32 * hh + (d % 32); }
    return PN_DU * 256 + (n - SRC_DU);
}
DI int gu_dest(int n) { const int e = n & 31; return (n / 128) * 256 + (n % 128 - e) + 16 * ((e >> 2) & 1) + 4 * (e >> 3) + (e & 3); }
DI void conv_item(const Ctx& C, const float* W, int K, int N, bf16* Wt, int mode, int k0, int n0, float* bias, int bias_pitch, const float* shift  ) {
    LAS float* scr = (LAS float*)(C.lds + C.wave * 16640);
    const int n = n0 + C.lane; const bool ok = n < N; float b0 = 0.f, b1 = 0.f, b2 = 0.f;
#pragma unroll 1
    for (int kh = 0; kh < 4; ++kh) {
        float wv[16];
#pragma unroll
        for (int kk = 0; kk < 16; ++kk) wv[kk] = ok ? W[(size_t)(k0 + 16 * kh + kk) * N + n] : 0.f;
#pragma unroll
        for (int kk = 0; kk < 16; ++kk) { const float v = wv[kk]; scr[(16 * kh + kk) * 65 + C.lane] = v;
            if (bias) { b0 += shift[k0 + 16 * kh + kk] * v; b1 += shift[9 * D + k0 + 16 * kh + kk] * v; b2 += shift[18 * D + k0 + 16 * kh + kk] * v; } } }
    WSYNC();
    const int dme = !ok ? -1 : mode == 0 ? n : mode == 1 ? gu_dest(n) : mode == 2 ? gu_dest(n) + 128 : win_dest(n);
    if (bias && dme >= 0) { atomicAdd(bias + dme, b0); atomicAdd(bias + bias_pitch + dme, b1); atomicAdd(bias + 2 * bias_pitch + dme, b2); }
    const int c = C.lane & 7;
#pragma unroll
    for (int i = 0; i < 8; ++i) { const int nl = (C.lane >> 3) + 8 * i, nn = n0 + nl;
        const int dr = nn >= N ? -1 : mode == 0 ? nn : mode == 1 ? gu_dest(nn) : mode == 2 ? gu_dest(nn) + 128 : win_dest(nn);
        const LAS float* s = scr + (8 * c) * 65 + nl;
        u32x4 o; o.x = pk2(s[0], s[65]); o.y = pk2(s[2 * 65], s[3 * 65]); o.z = pk2(s[4 * 65], s[5 * 65]); o.w = pk2(s[6 * 65], s[7 * 65]);
        if (dr >= 0) *(u32x4*)(Wt + (size_t)dr * K + k0 + 8 * c) = o; }
    WSYNC();
}
struct Cplx { float re, im; };
DI Cplx cmul(Cplx a, Cplx b) { return Cplx{a.re * b.re - a.im * b.im, a.re * b.im + a.im * b.re}; }
DI Cplx s5_lam_pow(const Ctx& C, int l, int dir, int g, int n, float tau) {
    const size_t i = (((size_t)l * 2 + dir) * S5G + g) * 64 + n; const float dt = __expf(C.in[I_S5LDT][((size_t)l * 2 + dir) * S5G + g]);
    const float mag = __expf(tau * dt * C.in[I_S5ARE][i]), ang = tau * dt * C.in[I_S5AIM][i]; float sn, cs; sincosf(ang, &sn, &cs); return Cplx{mag * cs, mag * sn};
}
DI Cplx s5_coef(const Ctx& C, int l, int dir, int g, int n) {
    const size_t i = (((size_t)l * 2 + dir) * S5G + g) * 64 + n; const float are = C.in[I_S5ARE][i], aim = C.in[I_S5AIM][i];
    const Cplx ab = s5_lam_pow(C, l, dir, g, n, 1.0f); const float den = are * are + aim * aim, nr = ab.re - 1.0f;
    return Cplx{(nr * are + ab.im * aim) / den, (ab.im * are - nr * aim) / den};
}
DI Cplx s5_beta(const Ctx& C, int l, int dir, int g, int n, int q) {
    const size_t i = (((size_t)l * S5G + g) * 64 + n) * 16 + q; return cmul(s5_coef(C, l, dir, g, n), Cplx{C.in[I_S5BRE][i], C.in[I_S5BIM][i]});
}
DI Cplx s5_gamma(const Ctx& C, int l, int g, int p, int n) { const size_t i = (((size_t)l * S5G + g) * 16 + p) * 64 + n; return Cplx{C.in[I_S5CRE][i], C.in[I_S5CIM][i]}; }

constexpr int CI_GU = (D / 64) * (FF / 64), CI_DN = (FF / 64) * (D / 64), CI_IN = (D / 64) * ((D_IN + 63) / 64), CI_OUT = (D / 64) * (D / 64), CI_GLU = (GW / 64) * (GW / 64);
constexpr int CI_LAYER = 4 * CI_GU + 2 * CI_DN + CI_IN + CI_OUT + CI_GLU;
DI void conv_weights(const Ctx& C, int l, int wslot, int nslots) {
    for (int it = wslot; it < CI_LAYER; it += nslots) {
        int r = it;
        unsigned char* wbase = C.ws + WS_W + (size_t)l * SZ_WL;
        if (r < 2 * CI_GU) { const int up = r >= CI_GU; r -= up * CI_GU; const int kb = r / (FF / 64), nb = r % (FF / 64);
            conv_item(C, C.in[up ? I_F1WU : I_F1WG] + (size_t)l * D * FF, D, FF, (bf16*)(wbase + OFF_W1GU), 1 + up, kb * 64, nb * 64, bias_ptr(C, l, 0), 2 * FF, modv_ptr(C, l, 0, 0)); continue; } r -= 2 * CI_GU;
        if (r < CI_DN) { const int kb = r / (D / 64), nb = r % (D / 64); conv_item(C, C.in[I_F1WD] + (size_t)l * FF * D, FF, D, (bf16*)(wbase + OFF_W1D), 0, kb * 64, nb * 64, nullptr, 0, nullptr); continue; } r -= CI_DN;
        if (r < CI_IN) { const int nbn = (D_IN + 63) / 64, kb = r / nbn, nb = r % nbn; conv_item(C, C.in[I_WIN] + (size_t)l * D * D_IN, D, D_IN, (bf16*)(wbase + OFF_WIN), 3, kb * 64, nb * 64, bias_ptr(C, l, 1), NINP, modv_ptr(C, l, 0, 3)); continue; } r -= CI_IN;
        if (r < CI_OUT) { const int kb = r / (D / 64), nb = r % (D / 64); conv_item(C, C.in[I_WOUT] + (size_t)l * D * D, D, D, (bf16*)(wbase + OFF_WOUT), 0, kb * 64, nb * 64, nullptr, 0, nullptr); continue; } r -= CI_OUT;
        if (r < 2 * CI_GU) { const int up = r >= CI_GU; r -= up * CI_GU; const int kb = r / (FF / 64), nb = r % (FF / 64);
            conv_item(C, C.in[up ? I_F2WU : I_F2WG] + (size_t)l * D * FF, D, FF, (bf16*)(wbase + OFF_W2GU), 1 + up, kb * 64, nb * 64, bias_ptr(C, l, 2), 2 * FF, modv_ptr(C, l, 0, 6)); continue; } r -= 2 * CI_GU;
        if (r < CI_DN) { const int kb = r / (D / 64), nb = r % (D / 64); conv_item(C, C.in[I_F2WD] + (size_t)l * FF * D, FF, D, (bf16*)(wbase + OFF_W2D), 0, kb * 64, nb * 64, nullptr, 0, nullptr); continue; } r -= CI_DN;
        { const int kb = r / (GW / 64), nb = r % (GW / 64); conv_item(C, C.in[I_S5GLUW] + (size_t)l * GW * GW, GW, GW, (bf16*)(wbase + OFF_WGLU), 0, kb * 64, nb * 64, nullptr, 0, nullptr); }
    }
}
DI void ph_conv(const Ctx& C) {
    const int gt = C.bid * NTHR + C.tid, GT = C.G * NTHR;
    for (int i = gt; i < NL * 9 * D; i += GT) { const int k = i % D, s = (i / D) % 3, sub = (i / (3 * D)) % 3, l = i / (9 * D);
        const float* mv = (const float*)(C.ws + WS_MODV) + ((size_t)l * 3 + s) * 9 * D;
        ((float*)(C.ws + WS_GS))[i] = C.in[I_NORMG][((size_t)l * 3 + sub) * D + k] * (1.0f + mv[(3 * sub + 1) * D + k]);
        ((float*)(C.ws + WS_GATE))[i] = mv[(3 * sub + 2) * D + k] * (sub == 1 ? 1.0f : 0.5f); }
    for (int i = gt; i < 128 * 16; i += GT) { const int pos = i / 16, f = i % 16; const float inv = __expf(-(float)f * (9.210340371976184f / 16.0f)); float sn, cs; sincosf((float)pos * inv, &sn, &cs);
        ((f32x2*)(C.ws + WS_ROPE))[i] = (f32x2){cs, sn}; }
    const int gw = C.bid * NW + C.wave, GWV = C.G * NW;
    conv_weights(C, 0, gw, GWV);
    for (int i = gt; i < NL * 14 * NH * 2 * 64 * 8; i += GT) {
        const int j = i & 7, ln = (i >> 3) & 63, tj = (i >> 9) & 1, hd = (i >> 10) % NH, f = (i / (1024 * NH)) % 14, l = i / (1024 * NH * 14);
        const int col = hd * 64 + 32 * tj + (ln & 31); float v;
        if (f < 8) { const int d = (f >> 1) & 1, sx = f & 1, k = 16 * sx + 8 * (ln >> 5) + j; v = C.in[f < 4 ? I_RWWUP : I_RWAUP][(((size_t)l * 2 + d) * 32 + k) * GW + col]; }
        else { const int k = 16 * (f - 8) + 8 * (ln >> 5) + j; v = C.in[I_RWGUP][((size_t)l * 96 + k) * GW + col]; }
        ((bf16*)(C.ws + WS_RWF))[i] = (bf16)f2bf(v); }
    LAS float* wsc = (LAS float*)(C.lds + C.wave * 16640);
    for (int it = gw; it < NL * S5G * 2 * S5L; it += GWV) {
        const int tau = it % S5L, dir = (it / S5L) % 2, g = (it / (2 * S5L)) % S5G, l = it / (2 * S5L * S5G);
        const Cplx z = cmul(s5_lam_pow(C, l, dir, g, C.lane, (float)tau), s5_coef(C, l, dir, g, C.lane));
#pragma unroll 4
        for (int q = 0; q < 16; ++q) { const size_t i = (((size_t)l * S5G + g) * 64 + C.lane) * 16 + q; const Cplx w = cmul(z, Cplx{C.in[I_S5BRE][i], C.in[I_S5BIM][i]}); wsc[(C.lane * 16 + q) * 2] = w.re; wsc[(C.lane * 16 + q) * 2 + 1] = w.im; }
        WSYNC();
        float* kc = (float*)(C.ws + WS_S5T + (size_t)l * SZ_S5L + OFF_S5KC) + (((size_t)g * 2 + dir) * S5L + tau) * 256;
#pragma unroll 1
        for (int e = 0; e < 4; ++e) { const int pq = C.lane + 64 * e, p = pq >> 4, q = pq & 15; float s = 0.f;
#pragma unroll 4
            for (int n = 0; n < 64; ++n) { const Cplx gm = s5_gamma(C, l, g, p, n); s += gm.re * wsc[(n * 16 + q) * 2] - gm.im * wsc[(n * 16 + q) * 2 + 1]; }
            kc[pq] = s; }
        WSYNC();
    }
    for (int i = gt; i < NL * 2 * GW * 4 * (S5L + 1); i += GT) { const int tau = i % (S5L + 1), r = i / (S5L + 1), n = r % 64, g = (r / 64) % S5G, dir = (r / (64 * S5G)) % 2, l = r / (2 * 64 * S5G);
        const Cplx z = s5_lam_pow(C, l, dir, g, n, (float)tau); ((f32x2*)(C.ws + WS_S5T + (size_t)l * SZ_S5L + OFF_S5LP))[((size_t)(dir * S5G + g) * 64 + n) * (S5L + 1) + tau] = (f32x2){z.re, z.im}; }
    for (int i = gt; i < NL * 2 * GW * 4 * 16; i += GT) { const int q = i % 16, r = i / 16, n = r % 64, g = (r / 64) % S5G, dir = (r / (64 * S5G)) % 2, l = r / (2 * 64 * S5G);
        const Cplx z = s5_beta(C, l, dir, g, n, q); ((f32x2*)(C.ws + WS_S5T + (size_t)l * SZ_S5L + OFF_S5BETA))[((size_t)(dir * S5G + g) * 64 + n) * 16 + q] = (f32x2){z.re, z.im}; }
    for (int i = gt; i < NL * 2 * GW * 4; i += GT) { const int n = i % 64, g = (i / 64) % S5G, dir = (i / (64 * S5G)) % 2, l = i / (2 * 64 * S5G); const Cplx z = s5_lam_pow(C, l, dir, g, n, (float)S5L);
        ((f32x2*)(C.ws + WS_S5T + (size_t)l * SZ_S5L + OFF_S5LAM))[(dir * S5G + g) * 64 + n] = (f32x2){z.re, z.im}; }
}
DI void ph_tab(const Ctx& C) {
    const long gt = (long)C.bid * NTHR + C.tid, GT = (long)C.G * NTHR;
    for (long i = gt; i < (long)NL * S5G * 256 * 512; i += GT) {
        const int k = (int)(i % 512), np = (int)((i / 512) % 256), g = (int)((i / (512 * 256)) % S5G), l = (int)(i / ((long)512 * 256 * S5G));
        const int j = k >> 4, q = k & 15, dir = np >> 7, n = np & 63, im = (np >> 6) & 1;
        const f32x2 lp = ((const f32x2*)(C.ws + WS_S5T + (size_t)l * SZ_S5L + OFF_S5LP))[((size_t)(dir * S5G + g) * 64 + n) * (S5L + 1) + (dir == 0 ? S5L - 1 - j : j)];
        const f32x2 be = ((const f32x2*)(C.ws + WS_S5T + (size_t)l * SZ_S5L + OFF_S5BETA))[((size_t)(dir * S5G + g) * 64 + n) * 16 + q];
        const Cplx w = cmul(Cplx{lp[0], lp[1]}, Cplx{be[0], be[1]});
        ((bf16*)(C.ws + WS_S5T + (size_t)l * SZ_S5L + OFF_S5ET))[((size_t)g * 256 + np) * 512 + k] = (bf16)f2bf(im ? w.im : w.re); }
    for (long i = gt; i < (long)NL * S5G * 512 * S5K; i += GT) {
        const int k = (int)(i % S5K), nn = (int)((i / S5K) % 512), g = (int)((i / ((long)S5K * 512)) % S5G), l = (int)(i / ((long)S5K * 512 * S5G));
        const int ti = nn >> 4, p = nn & 15; float v;
        if (k < 512) { const int j = k >> 4, q = k & 15; const float* kc = (const float*)(C.ws + WS_S5T + (size_t)l * SZ_S5L + OFF_S5KC) + (size_t)g * 2 * S5L * 256;
            v = 0.f; if (j <= ti) v += kc[((ti - j)) * 256 + p * 16 + q]; if (j >= ti) v += kc[(S5L + (j - ti)) * 256 + p * 16 + q]; }
        else { const int kk = k - 512, dir = kk >> 7, im = (kk >> 6) & 1, n = kk & 63;
            const f32x2 lp = ((const f32x2*)(C.ws + WS_S5T + (size_t)l * SZ_S5L + OFF_S5LP))[((size_t)(dir * S5G + g) * 64 + n) * (S5L + 1) + (dir == 0 ? ti + 1 : S5L - ti)];
            const Cplx w = cmul(s5_gamma(C, l, g, p, n), Cplx{lp[0], lp[1]}); v = im ? -w.im : w.re; }
        ((bf16*)(C.ws + WS_S5T + (size_t)l * SZ_S5L + OFF_S5BT))[((size_t)g * 512 + nn) * S5K + k] = (bf16)f2bf(v); }
    const int gw = C.bid * NW + C.wave, GWV = C.G * NW;
    for (int row = gw; row < M; row += GWV) {
        const float* src = row < M_LAT ? C.in[I_X] + (size_t)row * D : C.in[I_CTX] + (size_t)(row - M_LAT) * D;
        float* dst = xrow_ptr(C, row); const float* gs = gs_ptr(C, 0, 0, stream_of_row(row)); bf16* ap = (bf16*)(C.ws + WS_AP) + (size_t)row * D; float ss = 0.f;
        for (int c = 4 * C.lane; c < D; c += 256) { const f32x4 x = *(const f32x4*)(src + c); *(f32x4*)(dst + c) = x; ss += (x[0] * x[0] + x[1] * x[1]) + (x[2] * x[2] + x[3] * x[3]);
            const f32x4 a = x * *(const f32x4*)(gs + c); u32x2 w; w.x = pk2(a[0], a[1]); w.y = pk2(a[2], a[3]); *(u32x2*)(ap + c) = w; }
        ss = wave_sum(ss); if (C.lane == 0) rowss_ptr(C, 0, 0)[row] = ss;
    }
}

#ifdef EMU
DI s16x4 tr_read1(const LAS unsigned char* a) { return emu_tr_read(a); }
#else
DI s16x4 tr_read1(const LAS unsigned char* a) { s16x4 r; asm volatile("ds_read_b64_tr_b16 %0, %1\n\ts_waitcnt lgkmcnt(0)" : "=&v"(r) : "v"((unsigned)(size_t)a) : "memory"); return r; }
#endif
DI bf16x8 tr_frag(const LAS unsigned char* a0, int hi_off) {
#ifdef EMU
    const s16x4 lo = emu_tr_read(a0), hi = emu_tr_read(a0 + hi_off);
#else
    s16x4 lo, hi; asm volatile("ds_read_b64_tr_b16 %0, %2\n\tds_read_b64_tr_b16 %1, %3\n\ts_waitcnt lgkmcnt(0)" : "=&v"(lo), "=&v"(hi) : "v"((unsigned)(size_t)a0), "v"((unsigned)(size_t)(a0 + hi_off)) : "memory");
#endif
    return __builtin_shufflevector(lo, hi, 0, 1, 2, 3, 4, 5, 6, 7);
}
DI void tr_frag4(const LAS unsigned char* a0, const LAS unsigned char* a1, const LAS unsigned char* a2, const LAS unsigned char* a3, int hi_off, bf16x8 (&f)[4]) {
#ifdef EMU
    f[0] = tr_frag(a0, hi_off); f[1] = tr_frag(a1, hi_off); f[2] = tr_frag(a2, hi_off); f[3] = tr_frag(a3, hi_off);
#else
    s16x4 l0, h0, l1, h1, l2, h2, l3, h3;
    asm volatile("ds_read_b64_tr_b16 %0, %8\n\tds_read_b64_tr_b16 %1, %9\n\tds_read_b64_tr_b16 %2, %10\n\tds_read_b64_tr_b16 %3, %11\n\tds_read_b64_tr_b16 %4, %12\n\tds_read_b64_tr_b16 %5, %13\n\tds_read_b64_tr_b16 %6, %14\n\tds_read_b64_tr_b16 %7, %15\n\ts_waitcnt lgkmcnt(0)"
        : "=&v"(l0), "=&v"(h0), "=&v"(l1), "=&v"(h1), "=&v"(l2), "=&v"(h2), "=&v"(l3), "=&v"(h3)
        : "v"((unsigned)(size_t)a0), "v"((unsigned)(size_t)(a0 + hi_off)), "v"((unsigned)(size_t)a1), "v"((unsigned)(size_t)(a1 + hi_off)), "v"((unsigned)(size_t)a2), "v"((unsigned)(size_t)(a2 + hi_off)), "v"((unsigned)(size_t)a3), "v"((unsigned)(size_t)(a3 + hi_off)) : "memory");
    f[0] = __builtin_shufflevector(l0, h0, 0, 1, 2, 3, 4, 5, 6, 7); f[1] = __builtin_shufflevector(l1, h1, 0, 1, 2, 3, 4, 5, 6, 7); f[2] = __builtin_shufflevector(l2, h2, 0, 1, 2, 3, 4, 5, 6, 7); f[3] = __builtin_shufflevector(l3, h3, 0, 1, 2, 3, 4, 5, 6, 7);
#endif
}
DI bf16x8 pack8(const f32x16& x, int s) {
    u32x4 p; p.x = pk2(x[8 * s], x[8 * s + 1]); p.y = pk2(x[8 * s + 2], x[8 * s + 3]); p.z = pk2(x[8 * s + 4], x[8 * s + 5]); p.w = pk2(x[8 * s + 6], x[8 * s + 7]);
    return __builtin_bit_cast(bf16x8, p);
}
struct AttnSt { f32x16 o0, o1; float m, l; };
struct KVregs { bf16x8 k[4]; u32x4 v[4]; };
struct Kregs { bf16x8 k[4]; };
DI void k_load(Kregs& r, const bf16* Kb, int kp, int lane) {
    const int r32 = lane & 31, h = lane >> 5;
#pragma unroll
    for (int kk = 0; kk < 4; ++kk) r.k[kk] = *(const bf16x8*)(Kb + (size_t)r32 * kp + 16 * kk + 8 * h);
}
DI void kv_load(KVregs& r, const Kregs& kpre, const bf16* Vb, int vp, int lane) {
#pragma unroll
    for (int kk = 0; kk < 4; ++kk) r.k[kk] = kpre.k[kk];
#pragma unroll
    for (int i = 0; i < 4; ++i) { const int idx = lane + 64 * i, key = idx >> 3, ch = idx & 7; r.v[i] = *(const u32x4*)(Vb + (size_t)key * vp + ch * 8); }
}
template <bool MASKED>
DI void attn_block(AttnSt& st, const bf16x8 (&qf)[4], const KVregs& kv, LAS unsigned char* vl, int lane, const float (&addv)[16], unsigned vmask) {
    const int h = lane >> 5;
#pragma unroll
    for (int i = 0; i < 4; ++i) { const int idx = lane + 64 * i, key = idx >> 3, ch = idx & 7; *(LAS u32x4*)(vl + key * 128 + ch * 16) = kv.v[i]; }
    f32x16 s;
#pragma unroll
    for (int i = 0; i < 16; ++i) s[i] = 0.f;
#pragma unroll
    for (int kk = 0; kk < 4; ++kk) s = __builtin_amdgcn_mfma_f32_32x32x16_bf16(kv.k[kk], qf[kk], s, 0, 0, 0);
    float bm = -1e30f;
#pragma unroll
    for (int i = 0; i < 16; ++i) { if (MASKED) { s[i] += addv[i]; if ((vmask >> i) & 1u) bm = fmaxf(bm, s[i]); } else bm = fmaxf(bm, s[i]); }
    bm = fmaxf(bm, __shfl_xor(bm, 32));
    const float mn = fmaxf(st.m, bm), alpha = __expf(st.m - mn); st.m = mn;
    float ls = 0.f;
#pragma unroll
    for (int i = 0; i < 16; ++i) { float p = __expf(s[i] - mn); if (MASKED) p = ((vmask >> i) & 1u) ? p : 0.f; s[i] = p; ls += p; }
    st.l = st.l * alpha + ls;
#pragma unroll
    for (int i = 0; i < 16; ++i) { st.o0[i] *= alpha; st.o1[i] *= alpha; }
    WSYNC();
    const int q = (lane & 15) >> 2, p4 = lane & 3, blk = (lane >> 4) & 1;
    { const LAS unsigned char* ab = vl + (4 * h + q) * 128 + (16 * blk) * 2 + 8 * p4; bf16x8 vf[4];
      tr_frag4(ab, ab + 64, ab + 16 * 128, ab + 16 * 128 + 64, 8 * 128, vf);
      const bf16x8 pf0 = pack8(s, 0), pf1 = pack8(s, 1);
      st.o0 = __builtin_amdgcn_mfma_f32_32x32x16_bf16(vf[0], pf0, st.o0, 0, 0, 0); st.o1 = __builtin_amdgcn_mfma_f32_32x32x16_bf16(vf[1], pf0, st.o1, 0, 0, 0);
      st.o0 = __builtin_amdgcn_mfma_f32_32x32x16_bf16(vf[2], pf1, st.o0, 0, 0, 0); st.o1 = __builtin_amdgcn_mfma_f32_32x32x16_bf16(vf[3], pf1, st.o1, 0, 0, 0); }
}
DI void attn_finish(AttnSt& st, bf16* orow  , int lane, float extra_l) {
    const int h = lane >> 5; float l = st.l + __shfl_xor(st.l, 32) + extra_l; const float inv = 1.0f / l;
#pragma unroll
    for (int g = 0; g < 4; ++g) {
        u32x2 w0, w1; w0.x = pk2(st.o0[4 * g] * inv, st.o0[4 * g + 1] * inv); w0.y = pk2(st.o0[4 * g + 2] * inv, st.o0[4 * g + 3] * inv);
        w1.x = pk2(st.o1[4 * g] * inv, st.o1[4 * g + 1] * inv); w1.y = pk2(st.o1[4 * g + 2] * inv, st.o1[4 * g + 3] * inv);
        *(u32x2*)(orow + 8 * g + 4 * h) = w0; *(u32x2*)(orow + 32 + 8 * g + 4 * h) = w1; }
}
DI int clampi(int v, int lo, int hi) { return v < lo ? lo : (v > hi ? hi : v); }
constexpr int AT_NA = NB * NH * (GRH / 2) * 4, AT_WA = NB * NH * (T / 32), AT_CX = NB * NH * (TC / 32);
DI void ph_attn(const Ctx& C, int l, bool want_ctx, int first_block) {
    if (C.bid < first_block) return;
    const int gw = (C.bid - first_block) * NW + C.wave, GWV = (C.G - first_block) * NW, lane = C.lane, r32 = lane & 31, h = lane >> 5;
    LAS unsigned char* vl = C.lds + C.wave * 4096;
    const bf16* QA = (const bf16*)(C.ws + WS_QA); const bf16* KA = (const bf16*)(C.ws + WS_KA); const bf16* VA = (const bf16*)(C.ws + WS_VA);
    const bf16* QC = (const bf16*)(C.ws + WS_QC); const bf16* KC = (const bf16*)(C.ws + WS_KC); const bf16* VC = (const bf16*)(C.ws + WS_VC);
    bf16* OB = (bf16*)(C.ws + WS_OB);
    const int ntiles = AT_NA + AT_WA + (want_ctx ? 2 * AT_CX : 0);
    const float zero16[16] = {0.f, 0.f, 0.f, 0.f, 0.f, 0.f, 0.f, 0.f, 0.f, 0.f, 0.f, 0.f, 0.f, 0.f, 0.f, 0.f};
    for (int tile = gw; tile < ntiles; tile += GWV) {
        AttnSt st; st.m = -1e30f; st.l = 0.f;
#pragma unroll
        for (int i = 0; i < 16; ++i) { st.o0[i] = 0.f; st.o1[i] = 0.f; }
        bf16x8 qf[4];
        if (tile < AT_NA) {
            const int cb = tile & 3, rp = (tile >> 2) % (GRH / 2), hd = (tile / (4 * (GRH / 2))) % NH, b = tile / (4 * (GRH / 2) * NH);
            const int r0 = 2 * rp, c0 = 16 * cb, qr = r0 + (r32 >> 4), qc = c0 + (r32 & 15), qrow = b * T + qr * GRW + qc;
#pragma unroll
            for (int kk = 0; kk < 4; ++kk) qf[kk] = *(const bf16x8*)(QA + (size_t)qrow * GW + hd * 64 + 16 * kk + 8 * h);
            const int rsq = clampi(qr - 4, 0, GRH - 8), csq = clampi(qc - 8, 0, GRW - 16);
            const int rsA = clampi(r0 - 4, 0, GRH - 8), rsB = clampi(r0 + 1 - 4, 0, GRH - 8), kc0 = clampi(c0 - 8, 0, GRW - 32);
            const float* rpb = C.in[I_NARPB] + ((size_t)l * NH + hd) * 465;
            const int nbn = rsB + 8 - rsA, nbt = nbn + TC / 32; KVregs cur; Kregs nxt;
#define NA_ROW(i) ((i) < nbn ? (size_t)b * T + (rsA + (i)) * GRW + kc0 : (size_t)M_LAT + b * TC + 32 * ((i) - nbn))
            { const size_t kr0 = NA_ROW(0); k_load(nxt, KA + kr0 * GW + hd * 64, GW, lane); }
            for (int ib = 0; ib < nbt; ++ib) {
                { const size_t kr0 = NA_ROW(ib); kv_load(cur, nxt, VA + kr0 * GW + hd * 64, GW, lane); }
                if (ib + 1 < nbt) { const size_t kr1 = NA_ROW(ib + 1); k_load(nxt, KA + kr1 * GW + hd * 64, GW, lane); }
                if (ib < nbn) { const int kr = rsA + ib; float addv[16]; unsigned vm = 0u; const bool rok = kr >= rsq && kr <= rsq + 7;
#pragma unroll
                    for (int i = 0; i < 16; ++i) { const int kb = (i & 3) + 8 * (i >> 2) + 4 * h, kc = kc0 + kb; const bool ok = rok && kc >= csq && kc <= csq + 15;
                        const int bi = ok ? (kr - qr + 7) * 31 + (kc - qc + 15) : 0; addv[i] = rpb[bi]; vm |= ok ? (1u << i) : 0u; }
                    attn_block<true>(st, qf, cur, vl, lane, addv, vm); }
                else attn_block<false>(st, qf, cur, vl, lane, zero16, 0xffffu); }
#undef NA_ROW
            attn_finish(st, OB + (size_t)qrow * D + hd * 64, lane, 0.f);
        } else if (tile < AT_NA + AT_WA) {
            const int t2 = tile - AT_NA, qb = t2 % (T / 32), hd = (t2 / (T / 32)) % NH, b = t2 / ((T / 32) * NH), kvh = hd / WAG;
            const int qt = 32 * qb + r32, qrow = b * T + qt;
#pragma unroll
            for (int kk = 0; kk < 4; ++kk) qf[kk] = *(const bf16x8*)(QC + (size_t)qrow * GW + hd * 64 + 16 * kk + 8 * h);
            const int i_lo = 4 - qb > 0 ? 4 - qb : 0, i_hi = (T / 32 - qb + 4) < 9 ? (T / 32 - qb + 4) : 9, nbw = i_hi - i_lo, nbt = nbw + TC / 32; KVregs cur; Kregs nxt;
#define WA_ROW(i) ((i) < nbw ? (size_t)b * T + 32 * qb - 128 + 32 * (i_lo + (i)) : (size_t)M_LAT + b * TC + 32 * ((i) - nbw))
            { const size_t kr0 = WA_ROW(0); k_load(nxt, KC + kr0 * 128 + kvh * 64, 128, lane); }
            for (int ib = 0; ib < nbt; ++ib) {
                { const size_t kr0 = WA_ROW(ib); kv_load(cur, nxt, VC + kr0 * 128 + kvh * 64, 128, lane); }
                if (ib + 1 < nbt) { const size_t kr1 = WA_ROW(ib + 1); k_load(nxt, KC + kr1 * 128 + kvh * 64, 128, lane); }
                if (ib < nbw) { const int t0 = 32 * qb - 128 + 32 * (i_lo + ib); float addv[16]; unsigned vm = 0u;
#pragma unroll
                    for (int i = 0; i < 16; ++i) { const int kt = t0 + (i & 3) + 8 * (i >> 2) + 4 * h, rel = kt - qt; addv[i] = 0.f; vm |= (rel >= -128 && rel <= 128) ? (1u << i) : 0u; }
                    attn_block<true>(st, qf, cur, vl, lane, addv, vm); }
                else attn_block<false>(st, qf, cur, vl, lane, zero16, 0xffffu); }
#undef WA_ROW
            const float sk = C.in[I_WASINK][(size_t)l * NH + hd];
            const float mfin = fmaxf(st.m, sk), a2 = __expf(st.m - mfin);
#pragma unroll
            for (int i = 0; i < 16; ++i) { st.o0[i] *= a2; st.o1[i] *= a2; }
            st.l *= a2; st.m = mfin;
            attn_finish(st, OB + (size_t)qrow * D + 2 * GW + hd * 64, lane, __expf(sk - mfin));
        } else {
            const int t2 = tile - AT_NA - AT_WA, isc = t2 >= AT_CX, t3 = t2 - isc * AT_CX, qb = t3 % (TC / 32), hd = (t3 / (TC / 32)) % NH, b = t3 / ((TC / 32) * NH), kvh = hd / WAG;
            const int qrow = M_LAT + b * TC + 32 * qb + r32;
            const bf16* Qs = isc ? QC : QA; const bf16* Ks = isc ? KC + kvh * 64 : KA + hd * 64; const bf16* Vs = isc ? VC + kvh * 64 : VA + hd * 64; const int kp = isc ? 128 : GW;
#pragma unroll
            for (int kk = 0; kk < 4; ++kk) qf[kk] = *(const bf16x8*)(Qs + (size_t)qrow * GW + hd * 64 + 16 * kk + 8 * h);
            { KVregs cur; Kregs nxt; const size_t kr0 = (size_t)M_LAT + b * TC; k_load(nxt, Ks + kr0 * kp, kp, lane);
              for (int cbk = 0; cbk < TC / 32; ++cbk) { kv_load(cur, nxt, Vs + (kr0 + 32 * cbk) * kp, kp, lane); if (cbk + 1 < TC / 32) k_load(nxt, Ks + (kr0 + 32 * (cbk + 1)) * kp, kp, lane);
                  attn_block<false>(st, qf, cur, vl, lane, zero16, 0xffffu); } }
            float extra = 0.f;
            if (isc) { const float sk = C.in[I_WASINK][(size_t)l * NH + hd]; const float mfin = fmaxf(st.m, sk), a2 = __expf(st.m - mfin);
#pragma unroll
                for (int i = 0; i < 16; ++i) { st.o0[i] *= a2; st.o1[i] *= a2; }
                st.l *= a2; st.m = mfin; extra = __expf(sk - mfin); }
            attn_finish(st, OB + (size_t)qrow * D + (isc ? 2 * GW : 0) + hd * 64, lane, extra);
        }
    }
}

DI void ph_ctxfix(const Ctx& C, const float* gsn  , float* rowss_next) {
    const int gw = C.bid * NW + C.wave, GWV = C.G * NW;
    for (int r = gw; r < M_CTX; r += GWV) { const int row = M_LAT + r; const float* xp = xrow_ptr(C, row); const float* gs = gsn + (size_t)NB * D; bf16* ap = (bf16*)(C.ws + WS_AP) + (size_t)row * D; float ss = 0.f;
        for (int c = 4 * C.lane; c < D; c += 256) { const f32x4 x = *(const f32x4*)(xp + c); ss += (x[0] * x[0] + x[1] * x[1]) + (x[2] * x[2] + x[3] * x[3]);
            const f32x4 a = x * *(const f32x4*)(gs + c); u32x2 w; w.x = pk2(a[0], a[1]); w.y = pk2(a[2], a[3]); *(u32x2*)(ap + c) = w; }
        ss = wave_sum(ss); if (C.lane == 0) rowss_next[row] = ss; }
}
DI void ph_rwprep(const Ctx& C, int l) {
    LAS float* sm = (LAS float*)C.lds;
    const int c = C.tid; const bool act = c < GW;
    const bf16* PB = (const bf16*)(C.ws + WS_PB); const float* PS = (const float*)(C.ws + WS_PS);
    const float* cw = C.in[I_RWCONV] + (size_t)l * 9 * GW;
    float cwv[3][3];
    if (act) {
#pragma unroll
        for (int j = 0; j < 3; ++j)
#pragma unroll
            for (int x = 0; x < 3; ++x) cwv[j][x] = cw[(size_t)j * 3 * GW + x * GW + c]; }
    const float w00 = act ? C.in[I_RWW0][((size_t)l * 2 + 0) * GW + c] : 0.f, w01 = act ? C.in[I_RWW0][((size_t)l * 2 + 1) * GW + c] : 0.f;
    const float a00 = act ? C.in[I_RWA0][((size_t)l * 2 + 0) * GW + c] : 0.f, a01 = act ? C.in[I_RWA0][((size_t)l * 2 + 1) * GW + c] : 0.f;
    const float kkw = act ? C.in[I_RWKK][(size_t)l * GW + c] : 0.f, kaw = act ? C.in[I_RWKA][(size_t)l * GW + c] : 0.f;
    const float* wup = C.in[I_RWWUP] + (size_t)l * 2 * 32 * GW; const float* aup = C.in[I_RWAUP] + (size_t)l * 2 * 32 * GW; const float* gup = C.in[I_RWGUP] + (size_t)l * 96 * GW;
    for (int it = C.bid; it < M / 16; it += C.G) {
        const int row0 = it * 16;
        const int seq_lo = row0 < M_LAT ? (row0 / T) * T : M_LAT + ((row0 - M_LAT) / TC) * TC, seq_hi = row0 < M_LAT ? seq_lo + T : seq_lo + TC;
        __syncthreads();
        for (int i = C.tid; i < 16 * 160; i += NTHR) { const int t = i / 160, k = i % 160; const float v = PS[(size_t)(row0 + t) * 160 + k]; sm[i] = k < 32 ? tanhf(v) : (k < 64 ? v : sigmf(v)); }
        __syncthreads();
        if (act) {
            float aw0[16], aw1[16], aa0[16], aa1[16], ag[16];
#pragma unroll
            for (int t = 0; t < 16; ++t) { aw0[t] = 0.f; aw1[t] = 0.f; aa0[t] = 0.f; aa1[t] = 0.f; ag[t] = 0.f; }
            for (int k = 0; k < 32; ++k) { const float u0 = wup[(size_t)k * GW + c], u1 = wup[(size_t)(32 + k) * GW + c], v0 = aup[(size_t)k * GW + c], v1 = aup[(size_t)(32 + k) * GW + c];
#pragma unroll
                for (int t = 0; t < 16; ++t) { const float dw = sm[t * 160 + k], da = sm[t * 160 + 32 + k]; aw0[t] += dw * u0; aw1[t] += dw * u1; aa0[t] += da * v0; aa1[t] += da * v1; } }
            for (int k = 0; k < 96; ++k) { const float gv = gup[(size_t)k * GW + c];
#pragma unroll
                for (int t = 0; t < 16; ++t) ag[t] += sm[t * 160 + 64 + k] * gv; }
            float pr[3], cu[3], nx[3];
#pragma unroll
            for (int x = 0; x < 3; ++x) { pr[x] = row0 - 1 >= seq_lo ? bf2f(PB[(size_t)(row0 - 1) * 3 * GW + x * GW + c]) : 0.f; cu[x] = bf2f(PB[(size_t)row0 * 3 * GW + x * GW + c]); }
#pragma unroll
            for (int t = 0; t < 16; ++t) { const int row = row0 + t;
#pragma unroll
                for (int x = 0; x < 3; ++x) nx[x] = row + 1 < seq_hi ? bf2f(PB[(size_t)(row + 1) * 3 * GW + x * GW + c]) : 0.f;
                const float r = pr[0] * cwv[0][0] + cu[0] * cwv[1][0] + nx[0] * cwv[2][0], kf = pr[1] * cwv[0][1] + cu[1] * cwv[1][1] + nx[1] * cwv[2][1], v = pr[2] * cwv[0][2] + cu[2] * cwv[1][2] + nx[2] * cwv[2][2];
#pragma unroll
                for (int x = 0; x < 3; ++x) { pr[x] = cu[x]; cu[x] = nx[x]; }
                const float kkv = kf * kkw, ssq = wave_sum(kkv * kkv), kk = kkv / fmaxf(sqrtf(ssq), 1e-12f);
                const size_t o = (size_t)row * GW + c;
                rw_arr(C, RW_R)[o] = r; rw_arr(C, RW_V)[o] = v; rw_arr(C, RW_NKK)[o] = -kk; rw_arr(C, RW_G)[o] = ag[t];
                { const float z = -(w00 + aw0[t]), sp = z > 20.f ? z : log1pf(__expf(z)), wlog = -sp - 0.5f, a = sigmf(a00 + aa0[t]);
                  rw_arr(C, RW_W0)[o] = __expf(-__expf(wlog)); rw_arr(C, RW_K0)[o] = kf * (1.f + (a - 1.f) * kaw); rw_arr(C, RW_B0)[o] = kk * a; }
                { const float z = -(w01 + aw1[t]), sp = z > 20.f ? z : log1pf(__expf(z)), wlog = -sp - 0.5f, a = sigmf(a01 + aa1[t]);
                  rw_arr(C, RW_W1)[o] = __expf(-__expf(wlog)); rw_arr(C, RW_K1)[o] = kf * (1.f + (a - 1.f) * kaw); rw_arr(C, RW_B1)[o] = kk * a; }
            }
        }
    }
    __syncthreads();
}
DI void ph_rwscan(const Ctx& C) {
    if (C.wave >= 4) return;
    const int lane = C.lane, sub = lane & 15, vr = lane >> 4;
    const int nitems = NB * NH * 2 * 16;
    for (int it = C.bid * 4 + C.wave; it < nitems; it += C.G * 4) {
        const int rg = it & 15, dir = (it >> 4) & 1, hd = (it >> 5) % NH, b = it / (32 * NH);
        const int col = hd * 64 + 4 * sub, vcol = hd * 64 + 4 * rg + vr;
        const float* Wd = rw_arr(C, dir ? RW_W1 : RW_W0); const float* Kd = rw_arr(C, dir ? RW_K1 : RW_K0); const float* Bd = rw_arr(C, dir ? RW_B1 : RW_B0);
        const float* Rr = rw_arr(C, RW_R); const float* Vv = rw_arr(C, RW_V); const float* Nk = rw_arr(C, RW_NKK); float* Y = rw_arr(C, dir ? RW_Y1 : RW_Y0);
        f32x4 s = {0.f, 0.f, 0.f, 0.f};
        for (int seg = 0; seg < 2; ++seg) {
            const int base = seg == 0 ? M_LAT + b * TC : b * T, len = seg == 0 ? TC : T;
            for (int i0 = 0; i0 < len; i0 += 4) {
                f32x4 nk[4], w4[4], b4[4], k4[4], r4[4]; float vv[4]; int rows[4];
#pragma unroll
                for (int u = 0; u < 4; ++u) { const int i = i0 + u, row = base + (dir ? len - 1 - i : i); rows[u] = row; const size_t o = (size_t)row * GW + col;
                    nk[u] = *(const f32x4*)(Nk + o); w4[u] = *(const f32x4*)(Wd + o); b4[u] = *(const f32x4*)(Bd + o); k4[u] = *(const f32x4*)(Kd + o); r4[u] = *(const f32x4*)(Rr + o); vv[u] = Vv[(size_t)row * GW + vcol]; }
#pragma unroll
                for (int u = 0; u < 4; ++u) {
                    const f32x4 p = s * nk[u]; const float sa = row16_sum((p[0] + p[1]) + (p[2] + p[3]));
                    s = s * w4[u] + b4[u] * sa + k4[u] * vv[u];
                    const f32x4 yq = s * r4[u]; const float y = row16_sum((yq[0] + yq[1]) + (yq[2] + yq[3]));
                    if (sub == 0) Y[(size_t)rows[u] * GW + vcol] = y;
                }
            }
        }
    }
}
DI void ph_rwout(const Ctx& C, int l, int mrows) {
    const int gw = C.bid * NW + C.wave, GWV = C.G * NW, lane = C.lane;
    bf16* OB = (bf16*)(C.ws + WS_OB);
    for (int it = gw; it < mrows * NH; it += GWV) {
        const int hd = it % NH, row = it / NH, c = hd * 64 + lane; const size_t o = (size_t)row * GW + c;
        const float r = rw_arr(C, RW_R)[o], v = rw_arr(C, RW_V)[o], ks = rw_arr(C, RW_K0)[o] + rw_arr(C, RW_K1)[o];
        float y = rw_arr(C, RW_Y0)[o] + rw_arr(C, RW_Y1)[o];
        y += wave_sum(r * ks * C.in[I_RWRK][((size_t)l * NH + hd) * 64 + lane]) * v;
        const float mu = wave_sum(y) * (1.f / 64.f), dlt = y - mu, var = wave_sum(dlt * dlt) * (1.f / 64.f);
        const float yn = dlt / sqrtf(var + RW_GN_EPS);
        const float ov = (yn * C.in[I_RWGNW][(size_t)l * GW + c] + C.in[I_RWGNB][(size_t)l * GW + c]) * rw_arr(C, RW_G)[o];
        OB[(size_t)row * D + GW + c] = (bf16)f2bf(ov);
    }
}
constexpr int PT = 144;
constexpr int RW_HALF = 73472, IM_BT = 0, IM_KT = 9216, IM_RT = 18432, IM_ARB = 27648, IM_AT = 36864, IM_AAK = 46080, IM_F = 55296, IM_GC = 72704, FP = 68;
DI void chunk_rows(int b, int dir, int c, int& row0, int& step) {
    if (c < TC / 64) { const int p0 = 64 * c; row0 = M_LAT + b * TC + (dir ? TC - 1 - p0 : p0); } else { const int p0 = 64 * (c - TC / 64); row0 = b * T + (dir ? T - 1 - p0 : p0); }
    step = dir ? -1 : 1;
}
DI bf16x8 frag_rows(const LAS unsigned char* img, int tile, int s, int lane) { return *(const LAS bf16x8*)(img + (32 * tile + (lane & 31)) * PT + (16 * s + 8 * (lane >> 5)) * 2); }
DI bf16x8 frag_cols(const LAS unsigned char* img, int tile, int s, int lane) {
    const int h = lane >> 5, q = (lane & 15) >> 2, p4 = lane & 3, blk = (lane >> 4) & 1;
    const LAS unsigned char* a0 = img + (16 * s + 8 * h + q) * PT + (32 * tile + 16 * blk) * 2 + 8 * p4;
    return tr_frag(a0, 4 * PT);
}
DI void store_T(const f32x16& acc, LAS unsigned char* img, int ti, int tj, int lane) {
    const int c = lane & 31, h = lane >> 5;
#pragma unroll
    for (int g = 0; g < 4; ++g) { u32x2 w; w.x = pk2(acc[4 * g], acc[4 * g + 1]); w.y = pk2(acc[4 * g + 2], acc[4 * g + 3]); *(LAS u32x2*)(img + (32 * tj + c) * PT + (32 * ti + 8 * g + 4 * h) * 2) = w; }
}
DI f32x16 zero16v() { f32x16 z;
#pragma unroll
    for (int i = 0; i < 16; ++i) z[i] = 0.f; return z; }
#define MMA32(a, b, c) __builtin_amdgcn_mfma_f32_32x32x16_bf16((a), (b), (c), 0, 0, 0)
constexpr int PDW = 80, PDG = 208, IM_TW = 0, IM_TA = 17408, IM_DW = 36864, IM_DA = 41984, IM_DG = 47104;
DI void ph_rw1(const Ctx& C, int l) {
    const int wg = C.wave & 3, grp = C.wave >> 2, ti = wg >> 1, tj = wg & 1;
    bf16* QH = (bf16*)(C.ws + WS_QH); float* YL = (float*)(C.ws + WS_YL); bf16* MF = (bf16*)(C.ws + WS_MF); float* GF = (float*)(C.ws + WS_GF); bf16* RVKG = (bf16*)(C.ws + WS_RVKG);
    const bf16* PB = (const bf16*)(C.ws + WS_PB); const float* PS = (const float*)(C.ws + WS_PS);
    const bf16x8* RWF = (const bf16x8*)(C.ws + WS_RWF + (size_t)l * SZ_RWF);
    constexpr int nblk = (TC + T) / 64;
    for (int it0 = 2 * C.bid; it0 < RBLK; it0 += 2 * C.G) {
        int lane_ = threadIdx.x & 63; OPAQUE(lane_); const int lane = lane_, c32 = lane & 31, h = lane >> 5;
        LAS unsigned char* L = OPAQUE_LDS(C.lds + grp * RW_HALF);
        LAS float* F = (LAS float*)(L + IM_F); LAS float* SEG = (LAS float*)(L + IM_F); LAS float* GC = (LAS float*)(L + IM_GC);
        LAS float* TW = (LAS float*)(L + IM_TW); LAS float* TA = (LAS float*)(L + IM_TA);
        unsigned char* PK = C.ws + WS_RWS + ((size_t)C.bid * 2 + grp) * 65536;
        const int item = it0 + grp; const bool live = item < RBLK; const int itc = live ? item : RBLK - 1;
        const int tb = itc % nblk, hd = (itc / nblk) % NH, b = itc / (nblk * NH), cg = hd * 64 + lane;
        const int rowb = tb < TC / 64 ? M_LAT + b * TC + 64 * tb : b * T + 64 * (tb - TC / 64);
        const int seq_lo = tb < TC / 64 ? M_LAT + b * TC : b * T, seq_hi = seq_lo + (tb < TC / 64 ? TC : T);
        bf16* RV = RVKG + (size_t)itc * 4 * 4096;
        __syncthreads();
        float r_[16], kf_[16], kk_[16], ks_[16];
        { const float* cw = C.in[I_RWCONV] + (size_t)l * 9 * GW; float cwv[3][3];
#pragma unroll
          for (int j = 0; j < 3; ++j)
#pragma unroll
              for (int x = 0; x < 3; ++x) cwv[j][x] = cw[(size_t)j * 3 * GW + x * GW + cg];
          const float kkw = C.in[I_RWKK][(size_t)l * GW + cg];
          const int r0 = rowb + 16 * wg; float pr[3], cu[3], nx[3];
#pragma unroll
          for (int x = 0; x < 3; ++x) { pr[x] = r0 - 1 >= seq_lo ? bf2f(PB[(size_t)(r0 - 1) * 3 * GW + x * GW + cg]) : 0.f; cu[x] = bf2f(PB[(size_t)r0 * 3 * GW + x * GW + cg]); }
#pragma unroll
          for (int t = 0; t < 16; ++t) { const int row = r0 + t;
#pragma unroll
              for (int x = 0; x < 3; ++x) nx[x] = row + 1 < seq_hi ? bf2f(PB[(size_t)(row + 1) * 3 * GW + x * GW + cg]) : 0.f;
              r_[t] = pr[0] * cwv[0][0] + cu[0] * cwv[1][0] + nx[0] * cwv[2][0]; kf_[t] = pr[1] * cwv[0][1] + cu[1] * cwv[1][1] + nx[1] * cwv[2][1]; const float v_t = pr[2] * cwv[0][2] + cu[2] * cwv[1][2] + nx[2] * cwv[2][2];
#pragma unroll
              for (int x = 0; x < 3; ++x) { pr[x] = cu[x]; cu[x] = nx[x]; }
              const float kkv = kf_[t] * kkw, ssq = wave_sum(kkv * kkv); kk_[t] = kkv / fmaxf(sqrtf(ssq), 1e-12f); ks_[t] = 0.f;
              RV[(16 * wg + t) * 64 + lane] = (bf16)f2bf(r_[t]); RV[4096 + (16 * wg + t) * 64 + lane] = (bf16)f2bf(v_t);
#pragma unroll
              for (int kq = 0; kq < 3; ++kq) { const int k = lane + 64 * kq; if (k < 160) { const float pv = PS[(size_t)row * 160 + k]; const int tk = 16 * wg + t;
                  if (k < 32) *(LAS bf16*)(L + IM_DW + tk * PDW + k * 2) = (bf16)f2bf(tanhf(pv)); else if (k < 64) *(LAS bf16*)(L + IM_DA + tk * PDW + (k - 32) * 2) = (bf16)f2bf(pv); else *(LAS bf16*)(L + IM_DG + tk * PDG + (k - 64) * 2) = (bf16)f2bf(sigmf(pv)); } }
          }
        }
        __syncthreads();
        { f32x16 gacc = zero16v();
#pragma unroll
          for (int sx = 0; sx < 6; ++sx) gacc = MMA32(*(const LAS bf16x8*)(L + IM_DG + (32 * ti + c32) * PDG + (16 * sx + 8 * h) * 2), RWF[(((8 + sx) * NH + hd) * 2 + tj) * 64 + lane], gacc);
#pragma unroll
          for (int rg = 0; rg < 16; ++rg) { const int tk = 32 * ti + (rg & 3) + 8 * (rg >> 2) + 4 * h; RV[3 * 4096 + tk * 64 + 32 * tj + c32] = (bf16)f2bf(gacc[rg]); }
        }
        const float kaw = C.in[I_RWKA][(size_t)l * GW + cg];
#pragma unroll
        for (int pss = 0; pss < 2; ++pss) {
            const int dir = 1 - pss;
            __syncthreads();
            { f32x16 pw = zero16v(), pa = zero16v();
#pragma unroll
              for (int sx = 0; sx < 2; ++sx) { pw = MMA32(*(const LAS bf16x8*)(L + IM_DW + (32 * ti + c32) * PDW + (16 * sx + 8 * h) * 2), RWF[(((0 + 2 * dir + sx) * NH + hd) * 2 + tj) * 64 + lane], pw);
                                              pa = MMA32(*(const LAS bf16x8*)(L + IM_DA + (32 * ti + c32) * PDW + (16 * sx + 8 * h) * 2), RWF[(((4 + 2 * dir + sx) * NH + hd) * 2 + tj) * 64 + lane], pa); }
              const float w0 = C.in[I_RWW0][((size_t)l * 2 + dir) * GW + hd * 64 + 32 * tj + c32], a0 = C.in[I_RWA0][((size_t)l * 2 + dir) * GW + hd * 64 + 32 * tj + c32];
#pragma unroll
              for (int rg = 0; rg < 16; ++rg) { const int tk = 32 * ti + (rg & 3) + 8 * (rg >> 2) + 4 * h; const float z = -(w0 + pw[rg]), sp = z > 20.f ? z : log1pf(__expf(z));
                  TW[tk * FP + 32 * tj + c32] = -__expf(-sp - 0.5f); TA[tk * FP + 32 * tj + c32] = sigmf(a0 + pa[rg]); } }
            __syncthreads();
            const int cs = dir ? 3 - wg : wg;
            float lw[16], av[16], run = 0.f;
#pragma unroll
            for (int ii = 0; ii < 16; ++ii) { const int tl = dir ? 15 - ii : ii, tk = 16 * wg + tl; av[ii] = TA[tk * FP + lane]; run += TW[tk * FP + lane]; lw[ii] = run; }
            __syncthreads();
            SEG[cs * 64 + lane] = run;
            __syncthreads();
            float off = 0.f;
#pragma unroll
            for (int w2 = 0; w2 < 3; ++w2) off += (w2 < cs) ? SEG[w2 * 64 + lane] : 0.f;
            const float tot = SEG[lane] + SEG[64 + lane] + SEG[128 + lane] + SEG[192 + lane];
            if (wg == 0) { if (dir) ((float*)(PK + 32768))[lane] = __expf(tot); else GC[lane] = __expf(tot); }
#pragma unroll
            for (int ii = 0; ii < 16; ++ii) { const int tl = dir ? 15 - ii : ii, i = 16 * cs + ii;
                const float Li = lw[ii] + off, eL = __expf(Li), ieL = __builtin_amdgcn_rcpf(eL), eLm = __expf(Li - (lw[ii] - (ii ? lw[ii - 1] : 0.f)));
                const float a = av[ii], kd = kf_[tl] * (1.f + (a - 1.f) * kaw); ks_[tl] += kd;
                const bf16 vat = (bf16)f2bf(-kk_[tl] * eLm), vbt = (bf16)f2bf(kk_[tl] * a * ieL), vkt = (bf16)f2bf(kd * ieL), vrt = (bf16)f2bf(r_[tl] * eL);
                if (dir) { bf16* pk = (bf16*)PK + i * 64 + lane; pk[0] = vat; pk[4096] = vbt; pk[8192] = vkt; pk[12288] = vrt; }
                else { *(LAS bf16*)(L + IM_AT + i * PT + lane * 2) = vat; *(LAS bf16*)(L + IM_BT + i * PT + lane * 2) = vbt; *(LAS bf16*)(L + IM_KT + i * PT + lane * 2) = vkt; *(LAS bf16*)(L + IM_RT + i * PT + lane * 2) = vrt; } }
        }
#pragma unroll
        for (int t = 0; t < 16; ++t) RV[2 * 4096 + (16 * wg + t) * 64 + lane] = (bf16)f2bf(ks_[t]);
#pragma unroll 1
        for (int dir = 0; dir < 2; ++dir) {
            const int c = dir == 0 ? tb : (tb < TC / 64 ? TC / 64 - 1 - tb : TC / 64 + (T / 64 - 1 - (tb - TC / 64)));
            const size_t ci = ((size_t)((b * NH + hd) * 2 + dir)) * RCK + c;
            __syncthreads();
            if (dir) {
                const int tg = wg * 64 + lane;
#pragma unroll
                for (int im = 0; im < 4; ++im)
#pragma unroll
                    for (int rr = 0; rr < 2; ++rr) { const int idx = tg + 256 * rr, row = idx >> 3, ch = idx & 7; const int dsto = im == 0 ? IM_AT : im == 1 ? IM_BT : im == 2 ? IM_KT : IM_RT;
                        *(LAS u32x4*)(L + dsto + row * PT + ch * 16) = *(const u32x4*)(PK + im * 8192 + row * 128 + ch * 16); }
                if (wg == 0) GC[lane] = ((const float*)(PK + 32768))[lane];
                __syncthreads();
            }
            f32x16 accP;
            { f32x16 aab = zero16v(), aak = zero16v(), arb = zero16v(); accP = zero16v();
#pragma unroll
              for (int s = 0; s < 4; ++s) { const bf16x8 at_i = frag_rows(L + IM_AT, ti, s, lane), bt_j = frag_rows(L + IM_BT, tj, s, lane), kt_j = frag_rows(L + IM_KT, ti, s, lane), at_c = frag_rows(L + IM_AT, tj, s, lane),
                                              bt_r = frag_rows(L + IM_BT, ti, s, lane), rt_c = frag_rows(L + IM_RT, tj, s, lane);
                  aab = MMA32(at_i, bt_j, aab); aak = MMA32(kt_j, at_c, aak); arb = MMA32(bt_r, rt_c, arb); accP = MMA32(kt_j, rt_c, accP); }
#pragma unroll
              for (int r = 0; r < 16; ++r) { const int row = 32 * ti + (r & 3) + 8 * (r >> 2) + 4 * h, col = 32 * tj + c32;
                  F[row * FP + col] = col < row ? aab[r] : 0.f; aak[r] = row < col ? aak[r] : 0.f; arb[r] = row <= col ? arb[r] : 0.f; accP[r] = row <= col ? accP[r] : 0.f; }
              store_T(aak, L + IM_AAK, ti, tj, lane);
              store_T(arb, L + IM_ARB, ti, tj, lane); }
            __syncthreads();
            { float Wc[64]; const int col = 32 * wg + c32; const LAS unsigned char* src = col < 64 ? L + IM_AT + col * 2 : L + IM_AAK + (col - 64) * 2;
              const LAS float* Fo = OPAQUE_LDS(F);
#pragma unroll
              for (int i = 0; i < 64; ++i) Wc[i] = bf2f(*(const LAS bf16*)(src + i * PT));
#pragma unroll
              for (int i = 1; i < 64; ++i) { float a0 = Wc[i], a1 = 0.f, a2 = 0.f, a3 = 0.f;
#pragma unroll
                  for (int j4 = 0; j4 < (i + 3) / 4; ++j4) { const f32x4 f = *(const LAS f32x4*)(Fo + i * FP + 4 * j4); a0 += f[0] * Wc[4 * j4]; a1 += f[1] * Wc[4 * j4 + 1]; a2 += f[2] * Wc[4 * j4 + 2]; a3 += f[3] * Wc[4 * j4 + 3];
                      if ((j4 & 7) == 7) PIN4(a0, a1, a2, a3); }
                  PIN4(a0, a1, a2, a3); Wc[i] = (a0 + a1) + (a2 + a3); }
              __syncthreads();
              if (h == 0) { LAS unsigned char* dst = (col < 64 ? L + IM_AT + col * PT : L + IM_AAK + (col - 64) * PT);
#pragma unroll
                  for (int i8 = 0; i8 < 8; ++i8) { u32x4 w; w.x = pk2(Wc[8 * i8], Wc[8 * i8 + 1]); w.y = pk2(Wc[8 * i8 + 2], Wc[8 * i8 + 3]); w.z = pk2(Wc[8 * i8 + 4], Wc[8 * i8 + 5]); w.w = pk2(Wc[8 * i8 + 6], Wc[8 * i8 + 7]); *(LAS u32x4*)(dst + i8 * 16) = w; } }
#pragma unroll
              for (int ii = 0; ii < 16; ++ii) { const int tl = dir ? 15 - ii : ii, i = 16 * (dir ? 3 - wg : wg) + ii; *(LAS bf16*)(L + IM_F + i * PT + lane * 2) = RV[4096 + (16 * wg + tl) * 64 + lane]; }
            }
            __syncthreads();
            { f32x16 q;
#pragma unroll
              for (int g = 0; g < 4; ++g) { const u32x2 w = *(const LAS u32x2*)(L + IM_RT + (32 * tj + c32) * PT + (32 * ti + 8 * g + 4 * h) * 2); q[4 * g] = bflo(w.x); q[4 * g + 1] = bfhi(w.x); q[4 * g + 2] = bflo(w.y); q[4 * g + 3] = bfhi(w.y); }
#pragma unroll
              for (int s = 0; s < 4; ++s) { const bf16x8 arb = frag_rows(L + IM_ARB, tj, s, lane); q = MMA32(frag_rows(L + IM_AT, ti, s, lane), arb, q); accP = MMA32(frag_rows(L + IM_AAK, ti, s, lane), arb, accP); }
              if (live) {
#pragma unroll
                  for (int g = 0; g < 4; ++g) { u32x2 w; w.x = pk2(q[4 * g], q[4 * g + 1]); w.y = pk2(q[4 * g + 2], q[4 * g + 3]); *(u32x2*)(QH + ci * 4096 + (32 * tj + c32) * 64 + 32 * ti + 8 * g + 4 * h) = w; } }
            }
            __syncthreads();
            store_T(accP, L + IM_RT, ti, tj, lane);
            __syncthreads();
            { f32x16 y = zero16v(), m = zero16v(), n;
#pragma unroll
              for (int g = 0; g < 4; ++g) { const u32x2 w = *(const LAS u32x2*)(L + IM_KT + (32 * tj + c32) * PT + (32 * ti + 8 * g + 4 * h) * 2); n[4 * g] = bflo(w.x); n[4 * g + 1] = bfhi(w.x); n[4 * g + 2] = bflo(w.y); n[4 * g + 3] = bfhi(w.y); }
#pragma unroll
              for (int s = 0; s < 4; ++s) { const bf16x8 btc_j = frag_cols(L + IM_BT, tj, s, lane), btc_i = frag_cols(L + IM_BT, ti, s, lane);
                  y = MMA32(frag_rows(L + IM_RT, ti, s, lane), frag_cols(L + IM_F, tj, s, lane), y);
                  m = MMA32(frag_rows(L + IM_AT, ti, s, lane), btc_j, m);
                  n = MMA32(btc_i, frag_rows(L + IM_AAK, tj, s, lane), n); }
              const float gck = GC[32 * tj + c32];
#pragma unroll
              for (int r = 0; r < 16; ++r) { const int row = 32 * ti + (r & 3) + 8 * (r >> 2) + 4 * h, col = 32 * tj + c32; m[r] = (m[r] + (row == col ? 1.0f : 0.f)) * gck; n[r] *= GC[row]; }
              if (live) {
#pragma unroll
                  for (int g = 0; g < 4; ++g) *(f32x4*)(YL + ci * 4096 + ((wg * 4 + g) * 64 + lane) * 4) = (f32x4){y[4 * g], y[4 * g + 1], y[4 * g + 2], y[4 * g + 3]};
#pragma unroll
                  for (int s2 = 0; s2 < 2; ++s2) *(bf16x8*)(MF + ci * 4096 + ((wg * 2 + s2) * 64 + lane) * 8) = pack8(m, s2); }
              store_T(n, L + IM_ARB, ti, tj, lane);
            }
            __syncthreads();
            { f32x16 gacc = zero16v();
#pragma unroll
              for (int s = 0; s < 4; ++s) gacc = MMA32(frag_cols(L + IM_ARB, ti, s, lane), frag_cols(L + IM_F, tj, s, lane), gacc);
              if (live) {
#pragma unroll
                  for (int g = 0; g < 4; ++g) *(f32x4*)(GF + ci * 4096 + ((wg * 4 + g) * 64 + lane) * 4) = (f32x4){gacc[4 * g], gacc[4 * g + 1], gacc[4 * g + 2], gacc[4 * g + 3]}; }
            }
        }
    }
    __syncthreads();
}
DI void ph_rw2(const Ctx& C) {
    const int lane = C.lane;
    const bf16* MF = (const bf16*)(C.ws + WS_MF); const float* GF = (const float*)(C.ws + WS_GF); bf16* SF = (bf16*)(C.ws + WS_SF);
    const int nwork = RSTR * 2;
    for (int wk = C.wave == 0 ? C.bid : nwork; wk < nwork; wk += C.G) {
        const int tj = wk & 1, stream = wk >> 1;
        f32x16 s0 = zero16v(), s1 = zero16v();
        bf16x8 mf[2][2][2]; f32x4 gq[2][4];
#define RW2_LOAD(item_) do { const size_t it_ = (item_); \
            _Pragma("unroll") for (int kp = 0; kp < 2; ++kp) _Pragma("unroll") for (int kt = 0; kt < 2; ++kt) _Pragma("unroll") for (int s = 0; s < 2; ++s) mf[kp][kt][s] = *(const bf16x8*)(MF + it_ * 4096 + (((kp * 2 + kt) * 2 + s) * 64 + lane) * 8); \
            _Pragma("unroll") for (int kt = 0; kt < 2; ++kt) _Pragma("unroll") for (int g = 0; g < 4; ++g) gq[kt][g] = *(const f32x4*)(GF + it_ * 4096 + (((kt * 2 + tj) * 4 + g) * 64 + lane) * 4); } while (0)
        RW2_LOAD((size_t)stream * RCK);
        for (int c = 0; c < RCK; ++c) {
            const size_t item = (size_t)stream * RCK + c;
            bf16x8 sf[2][2];
#pragma unroll
            for (int s = 0; s < 2; ++s) { sf[0][s] = pack8(s0, s); sf[1][s] = pack8(s1, s); *(bf16x8*)(SF + item * 4096 + (((0 * 2 + tj) * 2 + s) * 64 + lane) * 8) = sf[0][s]; *(bf16x8*)(SF + item * 4096 + (((1 * 2 + tj) * 2 + s) * 64 + lane) * 8) = sf[1][s]; }
            f32x16 n0, n1;
#pragma unroll
            for (int g = 0; g < 4; ++g) { n0[4 * g] = gq[0][g][0]; n0[4 * g + 1] = gq[0][g][1]; n0[4 * g + 2] = gq[0][g][2]; n0[4 * g + 3] = gq[0][g][3]; n1[4 * g] = gq[1][g][0]; n1[4 * g + 1] = gq[1][g][1]; n1[4 * g + 2] = gq[1][g][2]; n1[4 * g + 3] = gq[1][g][3]; }
            bf16x8 mc[2][2][2];
#pragma unroll
            for (int kp = 0; kp < 2; ++kp)
#pragma unroll
                for (int kt = 0; kt < 2; ++kt)
#pragma unroll
                    for (int s = 0; s < 2; ++s) mc[kp][kt][s] = mf[kp][kt][s];
            if (c + 1 < RCK) RW2_LOAD(item + 1);
#pragma unroll
            for (int kp = 0; kp < 2; ++kp)
#pragma unroll
                for (int s = 0; s < 2; ++s) { n0 = MMA32(mc[kp][0][s], sf[kp][s], n0); n1 = MMA32(mc[kp][1][s], sf[kp][s], n1); }
            s0 = n0; s1 = n1;
        }
#undef RW2_LOAD
    }
}
DI void ph_rw3(const Ctx& C, int l, int mrows) {
    const int lane = C.lane, wg = C.wave & 3, grp = C.wave >> 2, ti = wg >> 1, tj = wg & 1, c32 = lane & 31, h = lane >> 5;
    LAS float* Ysum = (LAS float*)(C.lds + grp * RW_HALF);
    const bf16* QH = (const bf16*)(C.ws + WS_QH); const float* YL = (const float*)(C.ws + WS_YL); const bf16* SF = (const bf16*)(C.ws + WS_SF); bf16* OB = (bf16*)(C.ws + WS_OB);
    const int nblk = (TC + T) / 64, nitems = NB * NH * nblk;
    for (int it0 = 2 * C.bid; it0 < nitems; it0 += 2 * C.G) {
        const int item = it0 + grp; const bool live = item < nitems; const int itc = live ? item : nitems - 1;
        const int tb = itc % nblk, hd = (itc / nblk) % NH, b = itc / (nblk * NH);
        const int rowb = tb < TC / 64 ? M_LAT + b * TC + 64 * tb : b * T + 64 * (tb - TC / 64);
        __syncthreads();
        f32x4 yl[2][4]; u32x4 qa[2][4]; bf16x8 sb[2][4];
#pragma unroll
        for (int dir = 0; dir < 2; ++dir) {
            const int c = dir == 0 ? tb : (tb < TC / 64 ? TC / 64 - 1 - tb : TC / 64 + (T / 64 - 1 - (tb - TC / 64)));
            const size_t ci = ((size_t)((b * NH + hd) * 2 + dir)) * RCK + c;
#pragma unroll
            for (int g = 0; g < 4; ++g) yl[dir][g] = *(const f32x4*)(YL + ci * 4096 + ((wg * 4 + g) * 64 + lane) * 4);
#pragma unroll
            for (int kp = 0; kp < 2; ++kp)
#pragma unroll
                for (int s = 0; s < 2; ++s) { const bf16* qp = QH + ci * 4096 + (32 * ti + c32) * 64 + 32 * kp + 16 * s + 4 * h; const u32x2 lo = *(const u32x2*)qp, hi = *(const u32x2*)(qp + 8);
                    qa[dir][kp * 2 + s].x = lo.x; qa[dir][kp * 2 + s].y = lo.y; qa[dir][kp * 2 + s].z = hi.x; qa[dir][kp * 2 + s].w = hi.y;
                    sb[dir][kp * 2 + s] = *(const bf16x8*)(SF + ci * 4096 + (((kp * 2 + tj) * 2 + s) * 64 + lane) * 8); }
        }
#pragma unroll
        for (int dir = 0; dir < 2; ++dir) {
            f32x16 y;
#pragma unroll
            for (int g = 0; g < 4; ++g) { const f32x4 a = yl[dir][g]; y[4 * g] = a[0]; y[4 * g + 1] = a[1]; y[4 * g + 2] = a[2]; y[4 * g + 3] = a[3]; }
#pragma unroll
            for (int q4 = 0; q4 < 4; ++q4) y = MMA32(__builtin_bit_cast(bf16x8, qa[dir][q4]), sb[dir][q4], y);
#pragma unroll
            for (int r = 0; r < 16; ++r) { const int i = 32 * ti + (r & 3) + 8 * (r >> 2) + 4 * h, tk = dir ? 63 - i : i; LAS float* p = Ysum + tk * FP + 32 * tj + c32; if (dir == 0) *p = y[r]; else *p += y[r]; }
            __syncthreads();
        }
        if (live) {
            const int cch = hd * 64 + lane; const float rk = C.in[I_RWRK][((size_t)l * NH + hd) * 64 + lane], gw = C.in[I_RWGNW][(size_t)l * GW + cch], gb = C.in[I_RWGNB][(size_t)l * GW + cch];
#pragma unroll 1
            for (int t4 = 0; t4 < 16; t4 += 8) {
                bf16 rb[8], vb[8], kb[8], gb8[8];
#pragma unroll
                for (int u = 0; u < 8; ++u) { const bf16* rv = (const bf16*)(C.ws + WS_RVKG) + (size_t)item * 4 * 4096 + (16 * wg + t4 + u) * 64 + lane; rb[u] = rv[0]; vb[u] = rv[4096]; kb[u] = rv[8192]; gb8[u] = rv[12288]; }
#pragma unroll
                for (int u = 0; u < 8; ++u) { const int tk = 16 * wg + t4 + u, row = rowb + tk; const float r = bf2f(rb[u]), v = bf2f(vb[u]), ks = bf2f(kb[u]), gg = bf2f(gb8[u]);
                    float y = Ysum[tk * FP + lane] + wave_sum(r * ks * rk) * v;
                    const float mu = wave_sum(y) * (1.f / 64.f), dlt = y - mu, var = wave_sum(dlt * dlt) * (1.f / 64.f);
                    if (row < mrows) OB[(size_t)row * D + GW + cch] = (bf16)f2bf((dlt * __builtin_amdgcn_rsqf(var + RW_GN_EPS) * gw + gb) * gg); } }
        }
    }
    __syncthreads();
}
DI void ph_s5scan(const Ctx& C, int l, int first_block) {
    const int nthreads_total = NB * 2 * S5G * 64;
    if (C.bid < first_block) return;
    const float* XE = (const float*)(C.ws + WS_XEND); bf16* UG = (bf16*)(C.ws + WS_UG);
    const f32x2* LAM = (const f32x2*)(C.ws + WS_S5T + (size_t)l * SZ_S5L + OFF_S5LAM);
    for (int id = (C.bid - first_block) * NTHR + C.tid; id < nthreads_total; id += (C.G - first_block) * NTHR) {
        const int n = id & 63, g = (id >> 6) % S5G, dir = (id / (64 * S5G)) & 1, b = id / (128 * S5G);
        const f32x2 lm = LAM[(dir * S5G + g) * 64 + n]; float xr = 0.f, xi = 0.f;
        const int nc_ctx = TC / S5L, nc_lat = T / S5L, ntot = nc_ctx + nc_lat;
        for (int i0 = 0; i0 < ntot; i0 += 8) {
            float er[8], ei[8]; int chs[8];
#pragma unroll
            for (int u = 0; u < 8; ++u) { const int i = i0 + u; int ch;
                if (i < nc_ctx) ch = (M_LAT + b * TC) / S5L + (dir ? nc_ctx - 1 - i : i); else ch = (b * T) / S5L + (dir ? nc_lat - 1 - (i - nc_ctx) : (i - nc_ctx));
                chs[u] = ch; const float* p = XE + ((size_t)g * NCHP + ch) * 256 + dir * 128 + n; er[u] = p[0]; ei[u] = p[64]; }
#pragma unroll
            for (int u = 0; u < 8; ++u) { bf16* q = UG + ((size_t)g * NCHP + chs[u]) * S5K + 512 + dir * 128 + n; q[0] = (bf16)f2bf(xr); q[64] = (bf16)f2bf(xi);
                const float nr = lm[0] * xr - lm[1] * xi + er[u], ni = lm[0] * xi + lm[1] * xr + ei[u]; xr = nr; xi = ni; }
        }
    }
}

constexpr int PH_PRO = 3, PH_PER_L = 13, NPH = PH_PRO + PH_PER_L * NL;
#ifndef PROBE_REP
#define PROBE_REP -1
#endif
#define NREP(k) ((k) == PROBE_REP ? 2 : 1)
#ifdef ONLY
#define EN(k) ((k) == ONLY)
#else
#define EN(k) true
#endif
#ifdef EMU
void fwd(Args args) {
    unsigned char* lds = emu::lds_base();
#else
__global__ void __launch_bounds__(NTHR, 2) fwd(Args args) {
    extern __shared__ __attribute__((aligned(16))) unsigned char lds[];
#endif
    Ctx C; C.in = args.in; C.out = args.out; C.ws = args.ws; C.lds = (LAS unsigned char*)lds;
    C.tid = threadIdx.x; C.lane = C.tid & 63; C.wave = __builtin_amdgcn_readfirstlane(C.tid >> 6); C.G = gridDim.x; C.bid = blockIdx.x;
#define REFRESH() do { int t_ = threadIdx.x; OPAQUE(t_); C.tid = t_; C.lane = t_ & 63; C.wave = __builtin_amdgcn_readfirstlane(t_ >> 6); } while (0)
    volatile LAS unsigned* MISC = (volatile LAS unsigned*)(C.lds + MISC_OFF);
    if (C.tid < 32) MISC[C.tid] = 0u;
    __syncthreads();
    const int lo = args.ph_lo, hi = args.ph_hi;
    const bool use_bar = (hi - lo) > 1;
    XcdBarrier bar; bar.bar = (unsigned*)(C.ws + WS_CTL) + CW_BAR; bar.x = 0; bar.st = MISC + 8;
    if (use_bar) bar = xcd_barrier_post((unsigned*)(C.ws + WS_CTL) + CW_BAR, MISC + 8);
#define IN(k) (lo <= (k) && (k) < hi)
#define SEAM(k) do { if (IN(k) && IN((k) + 1)) xcd_barrier(bar); } while (0)
    if (EN(0) && IN(0)) for (int rep = 0; rep < NREP(0); ++rep) { REFRESH(); ph_ada(C); }
    SEAM(0);
    if (EN(1) && IN(1)) { REFRESH(); ph_conv(C); }
    SEAM(1);
    if (EN(2) && IN(2)) for (int rep = 0; rep < NREP(2); ++rep) { REFRESH(); ph_tab(C); }
    SEAM(2);
    for (int l = 0; l < NL; ++l) {
        const int pb = PH_PRO + PH_PER_L * l; const bool want_ctx = l < NL - 1;
        const int mrows_full = M, mrows_out = want_ctx ? M : M_LAT;
        bf16* AP = (bf16*)(C.ws + WS_AP); bf16* Hb = (bf16*)(C.ws + WS_H); bf16* OB = (bf16*)(C.ws + WS_OB);
        if (EN(3) && IN(pb + 0)) for (int rep = 0; rep < NREP(3); ++rep) { REFRESH();
            Gemm g{AP, wl(C, l, OFF_W1GU), D, D, D, 0, 0}; Order S; S.init(mrows_full / 256, 2 * FF / 256, 1, C.G, C.bid, D / 64);
            EpiGU E{rowss_ptr(C, l, 0), bias_ptr(C, l, 0), Hb, mrows_full}; gemm_phase(C.lds, g, S, E); }
        SEAM(pb + 0);
        if (EN(4) && IN(pb + 1)) { REFRESH();
            Gemm g{Hb, wl(C, l, OFF_W1D), FF, FF, FF, 0, 0}; Order S; S.init(M_LAT / 256, D / 256, 1, C.G, C.bid, FF / 64);
            EpiRes E{&C, gate_ptr(C, l, 0, 0), gs_ptr(C, l, 1, 0), rowss_ptr(C, l, 1), AP}; gemm_phase(C.lds, g, S, E);
            { REFRESH(); Order S2; S2.init_split(M_LAT / 256, M_CTX / 256, D / 256, 4, C.G, C.bid, FF / 64); EpiAcc E2{&C, gate_ptr(C, l, 0, 0)}; gemm_phase(C.lds, g, S2, E2); } }
        SEAM(pb + 1);
        if (EN(18) && IN(pb + 2)) { REFRESH(); ph_ctxfix(C, gs_ptr(C, l, 1, 0), rowss_ptr(C, l, 1)); }
        SEAM(pb + 2);
        if (EN(5) && IN(pb + 3)) for (int rep = 0; rep < NREP(5); ++rep) { REFRESH();
            Gemm g{AP, wl(C, l, OFF_WIN), D, D, D, 0, 0}; Order S; S.init(mrows_full / 256, NT_IN, 1, C.G, C.bid, D / 64);
            EpiIn E{&C, rowss_ptr(C, l, 1), bias_ptr(C, l, 1), l}; gemm_phase(C.lds, g, S, E); }
        SEAM(pb + 3);
        if (IN(pb + 4)) {
            if (EN(6)) for (int rep = 0; rep < NREP(6); ++rep) { REFRESH(); Gemm g{(const bf16*)(C.ws + WS_UG), (const bf16*)(C.ws + WS_S5T + (size_t)l * SZ_S5L + OFF_S5ET), S5K, 512, 512, (size_t)NCHP * S5K * 2, (size_t)256 * 512 * 2};
              Order S; S.init(NCHP / 256, 1, S5G, C.G, C.bid, 512 / 64); EpiS5A E{(float*)(C.ws + WS_XEND)}; gemm_phase(C.lds, g, S, E); }
            __syncthreads();
            for (int rep = 0; rep < NREP(9); ++rep) { if (EN(9)) { REFRESH(); ph_rw1(C, l); } }
            if (EN(7)) for (int rep = 0; rep < NREP(7); ++rep) { REFRESH(); ph_attn(C, l, want_ctx, (C.G >= 256 && 2 * C.G < RBLK && RBLK % (2 * C.G) != 0) ? (RBLK % (2 * C.G) + 1) / 2 : 0); }
        }
        SEAM(pb + 4);
        if (IN(pb + 5)) { if (EN(17)) for (int rep = 0; rep < NREP(17); ++rep) { REFRESH(); ph_rw2(C); } if (EN(10)) for (int rep = 0; rep < NREP(10); ++rep) { REFRESH(); ph_s5scan(C, l, C.G >= 256 ? 128 : 0); }
            if (EN(1) && l + 1 < NL) { REFRESH();
                if (C.G >= 256) { if (C.bid >= 64 && !(C.bid >= 128 && C.bid < 144)) { const int rk = C.bid - 64 - (C.bid >= 144 ? 16 : 0); conv_weights(C, l + 1, rk * NW + C.wave, (C.G - 80) * NW); } }
                else conv_weights(C, l + 1, C.bid * NW + C.wave, C.G * NW); } }
        SEAM(pb + 5);
        if (IN(pb + 6)) {
            if (EN(11)) for (int rep = 0; rep < NREP(11); ++rep) { REFRESH(); Gemm g{(const bf16*)(C.ws + WS_UG), (const bf16*)(C.ws + WS_S5T + (size_t)l * SZ_S5L + OFF_S5BT), S5K, S5K, S5K, (size_t)NCHP * S5K * 2, (size_t)512 * S5K * 2};
              Order S; S.init(NCHP / 256, 2, S5G, C.G, C.bid, S5K / 64); EpiS5C E{(const bf16*)(C.ws + WS_UG), C.in[I_S5D] + (size_t)l * GW, (bf16*)(C.ws + WS_YG)}; gemm_phase(C.lds, g, S, E); }
            if (EN(12)) for (int rep = 0; rep < NREP(12); ++rep) { REFRESH(); ph_rw3(C, l, mrows_out); }
        }
        SEAM(pb + 6);
        if (EN(13) && IN(pb + 7)) for (int rep = 0; rep < NREP(13); ++rep) { REFRESH();
            Gemm g{(const bf16*)(C.ws + WS_YG), wl(C, l, OFF_WGLU), GW, GW, GW, 0, 0}; Order S; S.init(mrows_out / 256, GW / 256, 1, C.G, C.bid, GW / 64);
            EpiGLU E{(const bf16*)(C.ws + WS_YG), C.in[I_S5GLUB] + (size_t)l * GW, OB}; gemm_phase(C.lds, g, S, E); }
        SEAM(pb + 7);
        if (EN(14) && IN(pb + 8)) { REFRESH();
            Gemm g{OB, wl(C, l, OFF_WOUT), D, D, D, 0, 0}; Order S; S.init(M_LAT / 256, D / 256, 1, C.G, C.bid, D / 64);
            EpiRes E{&C, gate_ptr(C, l, 1, 0), gs_ptr(C, l, 2, 0), rowss_ptr(C, l, 2), AP}; gemm_phase(C.lds, g, S, E);
            if (want_ctx) { REFRESH(); Order S2; S2.init_split(M_LAT / 256, M_CTX / 256, D / 256, 4, C.G, C.bid, D / 64); EpiAcc E2{&C, gate_ptr(C, l, 1, 0)}; gemm_phase(C.lds, g, S2, E2); } }
        SEAM(pb + 8);
        if (EN(18) && IN(pb + 9) && want_ctx) { REFRESH(); ph_ctxfix(C, gs_ptr(C, l, 2, 0), rowss_ptr(C, l, 2)); }
        SEAM(pb + 9);
        if (EN(15) && IN(pb + 10)) { REFRESH();
            Gemm g{AP, wl(C, l, OFF_W2GU), D, D, D, 0, 0}; Order S; S.init(mrows_out / 256, 2 * FF / 256, 1, C.G, C.bid, D / 64);
            EpiGU E{rowss_ptr(C, l, 2), bias_ptr(C, l, 2), Hb, mrows_out}; gemm_phase(C.lds, g, S, E); }
        SEAM(pb + 10);
        if (EN(16) && IN(pb + 11)) { REFRESH();
            Gemm g{Hb, wl(C, l, OFF_W2D), FF, FF, FF, 0, 0}; Order S; S.init(M_LAT / 256, D / 256, 1, C.G, C.bid, FF / 64);
            const bool more = l + 1 < NL;
            EpiRes E{&C, gate_ptr(C, l, 2, 0), more ? gs_ptr(C, l + 1, 0, 0) : nullptr, more ? rowss_ptr(C, l + 1, 0) : nullptr, AP}; gemm_phase(C.lds, g, S, E);
            if (want_ctx) { REFRESH(); Order S2; S2.init_split(M_LAT / 256, M_CTX / 256, D / 256, 4, C.G, C.bid, FF / 64); EpiAcc E2{&C, gate_ptr(C, l, 2, 0)}; gemm_phase(C.lds, g, S2, E2); } }
        SEAM(pb + 11);
        if (EN(18) && IN(pb + 12) && want_ctx) { REFRESH(); ph_ctxfix(C, gs_ptr(C, l + 1, 0, 0), rowss_ptr(C, l + 1, 0)); }
        SEAM(pb + 12);
    }
#undef IN
#undef SEAM
}

#ifndef MK_PER_PHASE
#define MK_PER_PHASE 0
#endif
#ifdef EMU
int g_emu_grid = 4, g_emu_lo = 0, g_emu_hi = NPH;
#endif
extern "C" void kernel_launch(void* const* d_in, const int* in_sizes, int n_in, void* d_out, int out_size, void* d_ws, size_t ws_size, hipStream_t stream) {
    Args a{};
    for (int i = 0; i < 42; ++i) a.in[i] = (const float*)d_in[i];
    a.out = (float*)d_out; a.ws = (unsigned char*)d_ws;
#ifdef EMU
    if (g_emu_lo == 0) hipMemsetAsync(d_ws, 0, WS_ZERO_END, stream);
    for (int ph = g_emu_lo; ph < g_emu_hi; ++ph) { a.ph_lo = ph; a.ph_hi = ph + 1; fprintf(stderr, "phase %d\n", ph); emu::launch(g_emu_grid, NTHR, LDS_BYTES, [=] { fwd(a); }); }
#else
    static int grid = 0;
    if (grid == 0) {
        if (n_in != 42 || out_size != M_LAT * D || ws_size < WS_END) { fprintf(stderr, "kernel_launch: unexpected shapes (n_in %d out %d ws %zu need %zu)\n", n_in, out_size, ws_size, (size_t)WS_END); grid = -1; return; }
        int dev = 0, cus = 0;
        if (hipGetDevice(&dev) != hipSuccess || hipDeviceGetAttribute(&cus, hipDeviceAttributeMultiprocessorCount, dev) != hipSuccess) { grid = -1; return; }
        if (hipFuncSetAttribute((const void*)fwd, hipFuncAttributeMaxDynamicSharedMemorySize, LDS_BYTES) != hipSuccess) { fprintf(stderr, "kernel_launch: hipFuncSetAttribute failed\n"); grid = -1; return; }
        int per_cu = 0; (void)hipOccupancyMaxActiveBlocksPerMultiprocessor(&per_cu, (const void*)fwd, NTHR, LDS_BYTES); (void)hipGetLastError();
        if (per_cu < 1) fprintf(stderr, "kernel_launch: occupancy query reports %d\n", per_cu);
        grid = cus;
    }
    if (grid < 0) return;
    (void)hipMemsetAsync(d_ws, 0, WS_ZERO_END, stream);
#if MK_PER_PHASE
    for (int ph = 0; ph < NPH; ++ph) { a.ph_lo = ph; a.ph_hi = ph + 1; hipLaunchKernelGGL(fwd, dim3(grid), dim3(NTHR), LDS_BYTES, stream, a); }
#else
    a.ph_lo = 0; a.ph_hi = NPH;
    hipLaunchKernelGGL(fwd, dim3(grid), dim3(NTHR), LDS_BYTES, stream, a);
#endif
#endif
}
```

```cpp
#ifdef EMU
#include "emu/emu.h"
#define LAS
#define GAS
#define ASMV(...) ((void)0)
#define WSYNC() do { int _z = 0; (void)emu::wave_gather(&_z, 4); } while (0)
#define OPAQUE(x) ((void)0)
#define OPAQUE_S(x) ((void)0)
#define PIN(x) ((void)0)
#define PIN4(a, b, c, d) ((void)0)
#define OPAQUE_LDS(p) (p)
#else
#include <hip/hip_runtime.h>
#include <cstdio>
#include <cstdint>
#define LAS __attribute__((address_space(3)))
#define GAS __attribute__((address_space(1)))
#define ASMV(...) asm volatile(__VA_ARGS__)
#define PIN(x) asm volatile("" : "+v"(x) :: "memory")
#define PIN4(a, b, c, d) asm volatile("" : "+v"(a), "+v"(b), "+v"(c), "+v"(d) :: "memory")
template <class P> __device__ __forceinline__ P opaque_lds(P p) { unsigned a = (unsigned)(size_t)p; asm volatile("" : "+v"(a)); return (P)(size_t)a; }
#define OPAQUE_LDS(p) opaque_lds(p)
#define OPAQUE_S(x) asm volatile("" : "+s"(x))
#define OPAQUE(x) asm volatile("" : "+v"(x))
#define WSYNC() asm volatile("s_waitcnt lgkmcnt(0)" ::: "memory")
#endif

#ifdef EMU
constexpr int D = 1024, NB = 2, T = 1024, NL = 2, TC = 256, FF = 1024;
#else
constexpr int D = 2048, NB = 2, T = 8192, NL = 4, TC = 256, FF = 5632;
#endif
constexpr int GW = D / 4, NH = GW / 64, WAG = NH / 2, S5G = GW / 16, GRW = 64, GRH = T / GRW;
constexpr int M_LAT = NB * T, M_CTX = NB * TC, M = M_LAT + M_CTX, NPAN = M / 256;
constexpr int TP = GW / 256;
constexpr int NT_IN = 8 * TP + 2, NINP = NT_IN * 256, D_IN = 8 * GW + 416;
constexpr int PN_AQ = 0, PN_AK = TP, PN_AV = 2 * TP, PN_BR = 3 * TP, PN_BK = 4 * TP, PN_BV = 5 * TP, PN_BS = 6 * TP, PN_CQ = 6 * TP + 1, PN_CKV = 7 * TP + 1, PN_DU = 7 * TP + 2;
constexpr int SRC_AQ = 0, SRC_AK = GW, SRC_AV = 2 * GW, SRC_BR = 3 * GW, SRC_BK = 4 * GW, SRC_BV = 5 * GW, SRC_BS = 6 * GW, SRC_CQ = 6 * GW + 160, SRC_CK = 7 * GW + 160, SRC_CV = 7 * GW + 288, SRC_DU = 7 * GW + 416;
constexpr int S5L = 32, NCH = M / S5L, NCHP = ((NCH + 255) / 256) * 256, S5K = 768;
constexpr int NW = 8, NTHR = 512;
constexpr float NORM_EPS = 1e-6f, RW_GN_EPS = 64e-5f;

typedef unsigned short bf16;
typedef short bf16x8 __attribute__((ext_vector_type(8)));
typedef short s16x4 __attribute__((ext_vector_type(4)));
typedef float f32x4 __attribute__((ext_vector_type(4)));
typedef float f32x2 __attribute__((ext_vector_type(2)));
typedef float f32x16 __attribute__((ext_vector_type(16)));
typedef unsigned u32x4 __attribute__((ext_vector_type(4)));
typedef unsigned u32x2 __attribute__((ext_vector_type(2)));
#define DI __device__ __forceinline__

constexpr size_t al256(size_t x) { return (x + 255) & ~(size_t)255; }
constexpr size_t SZ_BIAS_GU = (size_t)3 * 2 * FF * 4, SZ_BIAS_IN = (size_t)3 * NINP * 4;
constexpr size_t WS_CTL = 0;
constexpr size_t WS_BIAS = 65536;
constexpr size_t SZ_BIAS_L = 2 * SZ_BIAS_GU + SZ_BIAS_IN;
constexpr size_t WS_ROWSS = al256(WS_BIAS + NL * SZ_BIAS_L);
constexpr size_t WS_ZERO_END = al256(WS_ROWSS + (size_t)NL * 3 * M * 4);
constexpr size_t WS_MODV = WS_ZERO_END;
constexpr size_t WS_GS = al256(WS_MODV + (size_t)NL * 3 * 9 * D * 4);
constexpr size_t WS_GATE = al256(WS_GS + (size_t)NL * 9 * D * 4);
constexpr size_t WS_ROPE = al256(WS_GATE + (size_t)NL * 9 * D * 4);
constexpr size_t SZ_WGU = (size_t)2 * FF * D * 2, SZ_WD = (size_t)D * FF * 2, SZ_WIN = (size_t)NINP * D * 2, SZ_WOUT = (size_t)D * D * 2, SZ_WGLU = (size_t)GW * GW * 2;
constexpr size_t OFF_W1GU = 0, OFF_W1D = OFF_W1GU + SZ_WGU, OFF_WIN = OFF_W1D + SZ_WD, OFF_WOUT = OFF_WIN + SZ_WIN, OFF_W2GU = OFF_WOUT + SZ_WOUT, OFF_W2D = OFF_W2GU + SZ_WGU, OFF_WGLU = OFF_W2D + SZ_WD, SZ_WL = OFF_WGLU + SZ_WGLU;
constexpr size_t WS_W = al256(WS_ROPE + 128 * 16 * 8);
constexpr size_t SZ_S5KC = (size_t)S5G * 2 * S5L * 256 * 4, SZ_S5ET = (size_t)S5G * 256 * 512 * 2, SZ_S5BT = (size_t)S5G * 512 * S5K * 2, SZ_S5LAM = (size_t)2 * GW * 4 * 8;
constexpr size_t SZ_S5LP = (size_t)2 * S5G * 64 * (S5L + 1) * 8, SZ_S5BETA = (size_t)2 * S5G * 64 * 16 * 8;
constexpr size_t OFF_S5KC = 0, OFF_S5ET = OFF_S5KC + SZ_S5KC, OFF_S5BT = OFF_S5ET + SZ_S5ET, OFF_S5LAM = OFF_S5BT + SZ_S5BT, OFF_S5LP = al256(OFF_S5LAM + SZ_S5LAM), OFF_S5BETA = OFF_S5LP + SZ_S5LP, SZ_S5L = al256(OFF_S5BETA + SZ_S5BETA);
constexpr size_t WS_S5T = al256(WS_W + NL * SZ_WL);
constexpr size_t WS_XC = al256(WS_S5T + NL * SZ_S5L);
constexpr size_t WS_AP = al256(WS_XC + (size_t)M_CTX * D * 4);
constexpr size_t WS_H = al256(WS_AP + (size_t)M * D * 2);
constexpr size_t WS_QA = al256(WS_H + (size_t)M * FF * 2);
constexpr size_t WS_KA = WS_QA + (size_t)M * GW * 2, WS_VA = WS_KA + (size_t)M * GW * 2, WS_QC = WS_VA + (size_t)M * GW * 2;
constexpr size_t WS_KC = WS_QC + (size_t)M * GW * 2, WS_VC = WS_KC + (size_t)M * 128 * 2;
constexpr size_t WS_PB = WS_VC + (size_t)M * 128 * 2;
constexpr size_t WS_PS = al256(WS_PB + (size_t)M * 3 * GW * 2);
constexpr size_t WS_UG = al256(WS_PS + (size_t)M * 160 * 4);
constexpr size_t WS_RW = al256(WS_UG + (size_t)S5G * NCHP * S5K * 2);
constexpr size_t SZ_RWA = (size_t)M * GW * 4;
enum { RW_R = 0, RW_V, RW_NKK, RW_G, RW_W0, RW_W1, RW_K0, RW_K1, RW_B0, RW_B1, RW_Y0, RW_Y1, RW_NARR };
constexpr size_t WS_XEND = al256(WS_RW + 256);
constexpr size_t WS_YG = al256(WS_XEND + (size_t)S5G * NCHP * 256 * 4);
constexpr size_t WS_OB = al256(WS_YG + (size_t)M * GW * 2);
constexpr int RCK = (TC + T) / 64, RSTR = NB * NH * 2, RITEM = RSTR * RCK;
constexpr size_t WS_QH = al256(WS_OB + (size_t)M * D * 2);
constexpr size_t WS_YL = al256(WS_QH + (size_t)RITEM * 8192);
constexpr size_t WS_MF = al256(WS_YL + (size_t)RITEM * 16384);
constexpr size_t WS_GF = al256(WS_MF + (size_t)RITEM * 8192);
constexpr size_t WS_SF = al256(WS_GF + (size_t)RITEM * 16384);
constexpr int RBLK = NB * NH * ((TC + T) / 64);
constexpr size_t WS_RVKG = al256(WS_SF + (size_t)RITEM * 8192);
constexpr size_t SZ_RWF = (size_t)14 * NH * 2 * 64 * 16;
constexpr size_t WS_RWF = al256(WS_RVKG + (size_t)RBLK * 32768);
constexpr size_t WS_RWS = al256(WS_RWF + NL * SZ_RWF);
constexpr size_t WS_END = al256(WS_RWS + (size_t)512 * 2 * 65536);
constexpr int CW_BAR = 1024;

constexpr int LDS_BYTES = 147456, RING_BYTES = 131072, MISC_OFF = LDS_BYTES - 256;

DI unsigned f2bf(float f) { unsigned u = __float_as_uint(f); return (u + 0x7fffu + ((u >> 16) & 1u)) >> 16; }
#ifdef EMU
DI unsigned pk2(float lo, float hi) { return f2bf(lo) | (f2bf(hi) << 16); }
#else
typedef __bf16 hbf16x2 __attribute__((ext_vector_type(2)));
DI unsigned pk2(float lo, float hi) { const f32x2 v = {lo, hi}; const hbf16x2 b = __builtin_convertvector(v, hbf16x2); return __builtin_bit_cast(unsigned, b); }
#endif
DI float bf2f(unsigned short b) { return __uint_as_float(((unsigned)b) << 16); }
DI float bflo(unsigned w) { return __uint_as_float(w << 16); }
DI float bfhi(unsigned w) { return __uint_as_float(w & 0xffff0000u); }
template <int N> DI float ror_add(float v) { return v + __int_as_float(__builtin_amdgcn_mov_dpp(__float_as_int(v), 0x120 + N, 0xf, 0xf, true)); }
DI float row16_sum(float v) { v = ror_add<8>(v); v = ror_add<4>(v); v = ror_add<2>(v); v = ror_add<1>(v); return v; }
DI float wave_sum(float v) {
    v = row16_sum(v);
    const float a = __int_as_float(__builtin_amdgcn_readlane(__float_as_int(v), 0)), b = __int_as_float(__builtin_amdgcn_readlane(__float_as_int(v), 16)),
                c = __int_as_float(__builtin_amdgcn_readlane(__float_as_int(v), 32)), d = __int_as_float(__builtin_amdgcn_readlane(__float_as_int(v), 48));
    return (a + b) + (c + d);
}
DI float siluf(float x) { return x * __builtin_amdgcn_rcpf(1.f + __expf(-x)); }
DI float sigmf(float x) { return __builtin_amdgcn_rcpf(1.f + __expf(-x)); }
DI float geluf(float x) { const float z = 0.7978845608028654f * (x + 0.044715f * x * x * x); const float e = __expf(2.f * z); return 0.5f * x * (1.f + (1.f - 2.f * __builtin_amdgcn_rcpf(e + 1.f))); }
DI int stream_of_row(int row) { return row < M_LAT ? row / T : NB; }
DI int stream_of_panel(int pm) { return stream_of_row(pm * 256); }

#define XB_TMO      128
#define XB_XCNT(j)  (256  + 64 * (j))
#define XB_XSUB(j)  (1280 + 64 * (j))
#define XB_XGEN(j)  (2304 + 64 * (j))
#define XB_TOP      3328
#define XB_TOPGEN   3392
#define XCD_BAR_WORDS 3456
#define XB_SPIN_CAP (1u << 18)
DI unsigned xb_ld(unsigned* p)              { return __hip_atomic_load(p, __ATOMIC_RELAXED, __HIP_MEMORY_SCOPE_AGENT); }
DI unsigned xb_add(unsigned* p, unsigned v) { return __hip_atomic_fetch_add(p, v, __ATOMIC_RELAXED, __HIP_MEMORY_SCOPE_AGENT); }
DI unsigned xb_xcc_id() { return (unsigned)__builtin_amdgcn_s_getreg((3 << 11) | 20) & 0xFu; }
#define XB_SPIN(cond, bar) do { unsigned _sp = 0; while (cond) { __builtin_amdgcn_s_sleep(1); \
    if ((++_sp & 255u) == 0u) { if (xb_ld(&(bar)[XB_TMO])) break; if (_sp > XB_SPIN_CAP) { atomicAdd(&(bar)[XB_TMO], 1u); break; } } } } while (0)
struct XcdBarrier { unsigned* bar; unsigned x; volatile LAS unsigned* st; };
DI XcdBarrier xcd_barrier_post(unsigned* bar, volatile LAS unsigned* st) {
    XcdBarrier b; b.bar = bar; b.x = xb_xcc_id(); b.st = st;
    if (threadIdx.x == 0) (void)xb_add(&bar[XB_XCNT(b.x)], 1u);
    return b;
}
DI void xcd_barrier_complete(unsigned* bar, unsigned x, unsigned& nloc, unsigned& nx) {
    const unsigned G = gridDim.x * gridDim.y * gridDim.z;
    unsigned sum, cnt, mine, sp = 0u;
    for (;;) {
        sum = 0u; cnt = 0u; mine = 0u;
#pragma unroll
        for (unsigned j = 0; j < 16; ++j) { const unsigned c = xb_ld(&bar[XB_XCNT(j)]); sum += c; cnt += (c > 0u) ? 1u : 0u; mine = (j == x) ? c : mine; }
        if (sum == G) break;
        __builtin_amdgcn_s_sleep(1);
        if ((++sp & 255u) == 0u) { if (xb_ld(&bar[XB_TMO])) break; if (sp > XB_SPIN_CAP) { atomicAdd(&bar[XB_TMO], 1u); break; } }
    }
    nloc = mine > 0u ? mine : 1u; nx = cnt > 0u ? cnt : 1u;
}
DI void xcd_barrier(const XcdBarrier& b) {
    ASMV("s_waitcnt vmcnt(0)" ::: "memory");
    __syncthreads();
    if (threadIdx.x == 0) {
        unsigned* bar = b.bar;
        __builtin_amdgcn_s_waitcnt(0);
        unsigned nloc = b.st[0], nx = b.st[1];
        if (nloc == 0u) { xcd_barrier_complete(bar, b.x, nloc, nx); b.st[0] = nloc; b.st[1] = nx; }
        const unsigned old = xb_add(&bar[XB_XSUB(b.x)], 1u);
        const unsigned gen = old / nloc;
        if (old + 1u == (gen + 1u) * nloc) {
            __builtin_amdgcn_fence(__ATOMIC_RELEASE, "agent");
            ASMV("s_waitcnt vmcnt(0)" ::: "memory");
            const unsigned og = xb_add(&bar[XB_TOP], 1u);
            const unsigned tg = og / nx;
            if (og + 1u == (tg + 1u) * nx) xb_add(&bar[XB_TOPGEN], 1u);
            else XB_SPIN(xb_ld(&bar[XB_TOPGEN]) == tg, bar);
            __builtin_amdgcn_fence(__ATOMIC_ACQUIRE, "agent");
            xb_add(&bar[XB_XGEN(b.x)], 1u);
            ASMV("s_waitcnt vmcnt(0)" ::: "memory");
        } else {
            XB_SPIN(xb_ld(&bar[XB_XGEN(b.x)]) == gen, bar);
            __builtin_amdgcn_fence(__ATOMIC_ACQUIRE, "agent");
            ASMV("s_waitcnt vmcnt(0)" ::: "memory");
        }
    }
    __syncthreads();
}

constexpr int BK = 64, HALF = 128, HTB = HALF * BK * 2, NXCD = 8, WGM = 8;
DI int lds_byte(int r, int c) { const int st = (r >> 4) * 2 + (c >> 5), rr = r & 15, cc = c & 31, ob = rr * 64 + cc * 2; return st * 1024 + (ob ^ (((ob >> 9) & 1) << 5)); }
DI void stage_rc(int b, int& R, int& C) { const int st = b / 1024, sb = b % 1024, swz = sb ^ (((sb >> 9) & 1) << 5); R = (st >> 1) * 16 + swz / 64; C = (st & 1) * 32 + (swz % 64) / 2; }
struct Unit { int pm, pn, z, kt0; };
struct Gemm { const bf16* A; const bf16* Bt; int lda, ldb, K; size_t zA, zB; };
struct Order {
    int nM, nN, nZ, per, total, G, c, nkt, pm0, spl;
    DI void init(int nM_, int nN_, int nZ_, int G_, int c_, int nkt_) { nM = nM_; nN = nN_; nZ = nZ_; per = nM * nN; total = per * nZ; G = G_; c = c_; nkt = nkt_; pm0 = 0; spl = 0; }
    DI void init_split(int pm0_, int xM, int nN_, int spl_, int G_, int c_, int nkt_full) { nM = xM; nN = nN_; nZ = 1; per = xM * nN_ * spl_; total = per; G = G_; c = c_; nkt = nkt_full / spl_; pm0 = pm0_; spl = spl_; }
    DI bool next(int i, Unit& u) const {
        const long L = (long)i * G + c; if (L >= total) return false;
        if (spl) { const int j = (int)L; u.z = 0; u.pm = pm0 + j / (nN * spl); const int rem = j % (nN * spl); u.pn = rem / spl; u.kt0 = (rem % spl) * nkt; return true; }
        u.kt0 = 0;
        u.z = (int)(L / per); int wgid = (int)(L % per);
        { const int q = per / NXCD, r = per % NXCD, xcd = wgid % NXCD, off = wgid / NXCD; wgid = (xcd < r ? xcd * (q + 1) : r * (q + 1) + (xcd - r) * q) + off; }
        const int nig = WGM * nN, gid = wgid / nig, fm = gid * WGM, gsz = (nM - fm) < WGM ? (nM - fm) : WGM;
        u.pm = fm + ((wgid % nig) % gsz); u.pn = (wgid % nig) / gsz; return true;
    }
};

template <class Epi>
DI void gemm_phase(LAS unsigned char* lds, const Gemm g, const Order& S, const Epi& E) {
    int tid_ = threadIdx.x; OPAQUE(tid_);
    const int tid = tid_, wid = __builtin_amdgcn_readfirstlane(tid >> 6), lane = tid & 63, wr = wid >> 2, wc = wid & 3, fr = lane & 15, fq = lane >> 4;
    Unit cur, nxt; int ui = 0;
    if (!S.next(0, cur)) return;
    f32x4 acc[2][2][4][2];
#ifdef EMU
    (void)lds;
    for (;; ++ui) {
        if (ui > 0) { if (!S.next(ui, cur)) break; }
        const bf16* A = (const bf16*)((const char*)g.A + cur.z * g.zA); const bf16* B = (const bf16*)((const char*)g.Bt + cur.z * g.zB);
        for (int ai = 0; ai < 2; ++ai) for (int bj = 0; bj < 2; ++bj) for (int m = 0; m < 4; ++m) for (int n = 0; n < 2; ++n) for (int j = 0; j < 4; ++j) {
            const int r = 256 * cur.pm + 128 * ai + 64 * wr + 16 * m + fr, c = 256 * cur.pn + 128 * bj + 32 * wc + 16 * n + 4 * fq + j;
            const bf16* a = A + (size_t)r * g.lda; const bf16* b = B + (size_t)c * g.ldb; float s = 0.f;
            for (int k = cur.kt0 * BK; k < (cur.kt0 + S.nkt) * BK; ++k) s += bf2f(a[k]) * bf2f(b[k]);
            acc[ai][bj][m][n][j] = s; }
        E(acc, cur, wr, wc, fr, fq);
    }
#else
    unsigned voffA[2], voffB[2];
#pragma unroll
    for (int i = 0; i < 2; ++i) { int R, C; stage_rc(tid * 16 + i * 8192, R, C); voffA[i] = (unsigned)(R * g.lda + C) * 2u; voffB[i] = (unsigned)(R * g.ldb + C) * 2u; }
    const size_t kstep = (size_t)(BK * 2);
    const size_t hstepA = (size_t)HALF * g.lda * 2, hstepB = (size_t)HALF * g.ldb * 2, tstepA = 2 * hstepA, tstepB = 2 * hstepB;
    const unsigned ldsw = (unsigned)wid * 1024u;
    const int aoff = lds_byte(wr * 64 + fr, fq * 8), boff = lds_byte(wc * 32 + fr, fq * 8);
#define PG8_SA(b, h) (((b) * 2 + (h)) * HTB)
#define PG8_SB(b, h) ((4 + (b) * 2 + (h)) * HTB)
#define PG8_STAGE(bufoff, gbase, voff) do { _Pragma("unroll") for (int _i = 0; _i < 2; ++_i) \
        __builtin_amdgcn_global_load_lds((const unsigned*)((const char*)(gbase) + (voff)[_i]), (LAS unsigned*)(lds + (bufoff) + ldsw + _i * 8192), 16, 0, 0); } while (0)
#define PG8_LDA(dst, b, h) do { _Pragma("unroll") for (int m = 0; m < 4; ++m) _Pragma("unroll") for (int k = 0; k < 2; ++k) dst[m][k] = *(const LAS bf16x8*)(lds + PG8_SA(b, h) + aoff + m * 2048 + k * 1024); } while (0)
#define PG8_LDB(dst, b, h) do { _Pragma("unroll") for (int n = 0; n < 2; ++n) _Pragma("unroll") for (int k = 0; k < 2; ++k) dst[n][k] = *(const LAS bf16x8*)(lds + PG8_SB(b, h) + boff + n * 2048 + k * 1024); } while (0)
#define PG8_MMA(ai, bj, At, Bt) do { __builtin_amdgcn_s_setprio(1); _Pragma("unroll") for (int m = 0; m < 4; ++m) _Pragma("unroll") for (int n = 0; n < 2; ++n) _Pragma("unroll") for (int k = 0; k < 2; ++k) \
        acc[ai][bj][m][n] = __builtin_amdgcn_mfma_f32_16x16x32_bf16(Bt[n][k], At[m][k], acc[ai][bj][m][n], 0, 0, 0); __builtin_amdgcn_s_setprio(0); } while (0)
#define PG8_WAIT_V(n) asm volatile("s_waitcnt vmcnt(" #n ")" ::: "memory")
#define PG8_WAIT_L(n) asm volatile("s_waitcnt lgkmcnt(" #n ")" ::: "memory")
#define PG8_BAR __builtin_amdgcn_s_barrier()
#define PG8_SCHED __builtin_amdgcn_sched_barrier(0)
#pragma unroll
    for (int a = 0; a < 2; ++a)
#pragma unroll
        for (int b = 0; b < 2; ++b)
#pragma unroll
            for (int m = 0; m < 4; ++m)
#pragma unroll
                for (int n = 0; n < 2; ++n) acc[a][b][m][n] = (f32x4){0.f, 0.f, 0.f, 0.f};
    bf16x8 At[4][2], B0[2][2], B1[2][2];
    const char* cA = (const char*)g.A + (size_t)cur.z * g.zA + (size_t)cur.pm * tstepA + (size_t)cur.kt0 * kstep; const char* cB = (const char*)g.Bt + (size_t)cur.z * g.zB + (size_t)cur.pn * tstepB + (size_t)cur.kt0 * kstep;
    PG8_STAGE(PG8_SB(0, 0), cB, voffB); PG8_STAGE(PG8_SB(0, 1), cB + hstepB, voffB); PG8_STAGE(PG8_SA(0, 0), cA, voffA); PG8_STAGE(PG8_SA(0, 1), cA + hstepA, voffA);
    if (wr == 1) PG8_BAR;
    PG8_WAIT_V(2); PG8_BAR;
    PG8_STAGE(PG8_SB(1, 0), cB + kstep, voffB); PG8_STAGE(PG8_SA(1, 0), cA + kstep, voffA); PG8_STAGE(PG8_SB(1, 1), cB + hstepB + kstep, voffB);
    PG8_WAIT_V(6); PG8_BAR;
    for (;;) {
        const bool has_next = S.next(ui + 1, nxt);
        const char* nA = has_next ? (const char*)g.A + (size_t)nxt.z * g.zA + (size_t)nxt.pm * tstepA + (size_t)nxt.kt0 * kstep : cA; const char* nB = has_next ? (const char*)g.Bt + (size_t)nxt.z * g.zB + (size_t)nxt.pn * tstepB + (size_t)nxt.kt0 * kstep : cB;
        const int nt = S.nkt;
        for (int t = 0; t < nt; t += 2) {
            const bool last = (t == nt - 2);
            const char* a1 = cA + (size_t)(t + 1) * kstep;
            const char* a2 = last ? nA : cA + (size_t)(t + 2) * kstep; const char* b2 = last ? nB : cB + (size_t)(t + 2) * kstep;
            const char* a3 = a2 + kstep; const char* b3 = b2 + kstep;
            PG8_LDB(B0, 0, 0); PG8_LDB(B1, 0, 1); PG8_SCHED; PG8_LDA(At, 0, 0); PG8_STAGE(PG8_SA(1, 1), a1 + hstepA, voffA);
            PG8_WAIT_V(8); PG8_WAIT_L(0); PG8_BAR; PG8_MMA(0, 0, At, B0); PG8_MMA(0, 1, At, B1); PG8_BAR; PG8_SCHED;
            PG8_LDA(At, 0, 1); PG8_STAGE(PG8_SB(0, 0), b2, voffB); PG8_STAGE(PG8_SB(0, 1), b2 + hstepB, voffB); PG8_STAGE(PG8_SA(0, 0), a2, voffA);
            PG8_WAIT_V(8); PG8_WAIT_L(0); PG8_BAR; PG8_MMA(1, 0, At, B0); PG8_MMA(1, 1, At, B1); PG8_BAR; PG8_SCHED;
            PG8_LDB(B0, 1, 0); PG8_LDB(B1, 1, 1); PG8_SCHED; PG8_LDA(At, 1, 0); PG8_STAGE(PG8_SA(0, 1), a2 + hstepA, voffA);
            PG8_WAIT_V(8); PG8_WAIT_L(0); PG8_BAR; PG8_MMA(0, 0, At, B0); PG8_MMA(0, 1, At, B1); PG8_BAR; PG8_SCHED;
            PG8_LDA(At, 1, 1); PG8_STAGE(PG8_SB(1, 0), b3, voffB); PG8_STAGE(PG8_SB(1, 1), b3 + hstepB, voffB); PG8_STAGE(PG8_SA(1, 0), a3, voffA);
            PG8_WAIT_V(8); PG8_WAIT_L(0); PG8_BAR; PG8_MMA(1, 0, At, B0); PG8_MMA(1, 1, At, B1); PG8_BAR; PG8_SCHED;
        }
        if (wr == 0) PG8_BAR;
        E(acc, cur, wr, wc, fr, fq);
        if (!has_next) break;
#pragma unroll
        for (int a = 0; a < 2; ++a)
#pragma unroll
            for (int b = 0; b < 2; ++b)
#pragma unroll
                for (int m = 0; m < 4; ++m)
#pragma unroll
                    for (int n = 0; n < 2; ++n) acc[a][b][m][n] = (f32x4){0.f, 0.f, 0.f, 0.f};
        cur = nxt; cA = nA; cB = nB; ++ui;
        if (wr == 1) PG8_BAR;
    }
    PG8_WAIT_V(0);
    PG8_BAR;
#undef PG8_SA
#undef PG8_SB
#undef PG8_STAGE
#undef PG8_LDA
#undef PG8_LDB
#undef PG8_MMA
#undef PG8_WAIT_V
#undef PG8_WAIT_L
#undef PG8_BAR
#undef PG8_SCHED
#endif
}

struct Args {
    const float* in[42]; float* out; unsigned char* ws;
    int ph_lo, ph_hi;
};
struct Ctx {
    const float* const* in; float* out; unsigned char* ws;
    LAS unsigned char* lds; int tid, lane, wave, G, bid;
};
DI float* xrow_ptr(const Ctx& C, int row) { return row < M_LAT ? C.out + (size_t)row * D : (float*)(C.ws + WS_XC) + (size_t)(row - M_LAT) * D; }
DI const bf16* wl(const Ctx& C, int l, size_t off) { return (const bf16*)(C.ws + WS_W + (size_t)l * SZ_WL + off); }
DI float* bias_ptr(const Ctx& C, int l, int which  ) { return (float*)(C.ws + WS_BIAS + (size_t)l * SZ_BIAS_L + (which == 0 ? 0 : which == 1 ? SZ_BIAS_GU : SZ_BIAS_GU + SZ_BIAS_IN)); }
DI float* rowss_ptr(const Ctx& C, int l, int sub) { return (float*)(C.ws + WS_ROWSS) + ((size_t)l * 3 + sub) * M; }
DI const float* gs_ptr(const Ctx& C, int l, int sub, int s) { return (const float*)(C.ws + WS_GS) + (((size_t)l * 3 + sub) * 3 + s) * D; }
DI const float* gate_ptr(const Ctx& C, int l, int sub, int s) { return (const float*)(C.ws + WS_GATE) + (((size_t)l * 3 + sub) * 3 + s) * D; }
DI float* rw_arr(const Ctx& C, int a) { return (float*)(C.ws + WS_RW + (size_t)a * SZ_RWA); }
enum { I_X = 0, I_C, I_CTX, I_CCTX, I_WADA, I_BADA, I_NORMG, I_F1WG, I_F1WU, I_F1WD, I_F2WG, I_F2WU, I_F2WD, I_WIN, I_WOUT, I_NAQG, I_NAKG, I_NARPB, I_RWCONV, I_RWW0, I_RWWUP, I_RWA0, I_RWAUP,
       I_RWGUP, I_RWKK, I_RWKA, I_RWRK, I_RWGNW, I_RWGNB, I_WAQG, I_WAKG, I_WASINK, I_S5ARE, I_S5AIM, I_S5LDT, I_S5BRE, I_S5BIM, I_S5CRE, I_S5CIM, I_S5D, I_S5GLUW, I_S5GLUB, I_NIN };

struct EpiGU {
    const float* rowss; const float* bias  ; bf16* H; int mrows;
    DI void operator()(const f32x4 (&acc)[2][2][4][2], const Unit& u, int wr, int wc, int fr_, int fq_) const {
        int tz_ = threadIdx.x; OPAQUE(tz_); const int fr = tz_ & 15, fq = (tz_ & 63) >> 4; (void)fr_; (void)fq_;
        const int s = stream_of_panel(u.pm); const float* bs = bias + (size_t)s * 2 * FF + u.pn * 256 + wc * 32 + 4 * fq;
        f32x4 bg[2], bu[2];
#pragma unroll
        for (int n = 0; n < 2; ++n) { bg[n] = *(const f32x4*)(bs + 16 * n); bu[n] = *(const f32x4*)(bs + 128 + 16 * n); }
        float rsv[2][4];
#pragma unroll
        for (int ai = 0; ai < 2; ++ai)
#pragma unroll
            for (int m = 0; m < 4; ++m) rsv[ai][m] = rowss[u.pm * 256 + ai * 128 + wr * 64 + m * 16 + fr];
#pragma unroll
        for (int ai = 0; ai < 2; ++ai)
#pragma unroll
            for (int m = 0; m < 4; ++m) {
                const int row = u.pm * 256 + ai * 128 + wr * 64 + m * 16 + fr;
                const float rstd = __builtin_amdgcn_rsqf(rsv[ai][m] * (1.0f / D) + NORM_EPS);
                bf16* hp = H + (size_t)row * FF + u.pn * 128 + wc * 32 + 8 * fq;
                u32x4 w;
                { const f32x4 g = acc[ai][0][m][0] * rstd + bg[0], v = acc[ai][1][m][0] * rstd + bu[0]; w.x = pk2(siluf(g[0]) * v[0], siluf(g[1]) * v[1]); w.y = pk2(siluf(g[2]) * v[2], siluf(g[3]) * v[3]); }
                { const f32x4 g = acc[ai][0][m][1] * rstd + bg[1], v = acc[ai][1][m][1] * rstd + bu[1]; w.z = pk2(siluf(g[0]) * v[0], siluf(g[1]) * v[1]); w.w = pk2(siluf(g[2]) * v[2], siluf(g[3]) * v[3]); }
                *(u32x4*)hp = w;
            }
    }
};
struct EpiRes {
    const Ctx* C; const float* gate  ; const float* gsn  ; float* rowss_next; bf16* AP;
    DI void operator()(const f32x4 (&acc)[2][2][4][2], const Unit& u, int wr, int wc, int fr_, int fq_) const {
        int tz_ = threadIdx.x; OPAQUE(tz_); const int fr = tz_ & 15, fq = (tz_ & 63) >> 4; (void)fr_; (void)fq_;
        const int s = stream_of_panel(u.pm); const int col0 = u.pn * 256 + wc * 32 + 4 * fq;
        f32x4 gv[2][2], sv[2][2];
#pragma unroll
        for (int bj = 0; bj < 2; ++bj)
#pragma unroll
            for (int n = 0; n < 2; ++n) { gv[bj][n] = *(const f32x4*)(gate + (size_t)s * D + col0 + bj * 128 + n * 16); sv[bj][n] = gsn ? *(const f32x4*)(gsn + (size_t)s * D + col0 + bj * 128 + n * 16) : (f32x4){0.f, 0.f, 0.f, 0.f}; }
        f32x4 xc[2][2], xn[2][2];
        { const float* xp0 = xrow_ptr(*C, u.pm * 256 + wr * 64 + fr) + col0;
#pragma unroll
          for (int bj = 0; bj < 2; ++bj)
#pragma unroll
              for (int n = 0; n < 2; ++n) xn[bj][n] = *(const f32x4*)(xp0 + bj * 128 + n * 16); }
#pragma unroll
        for (int ai = 0; ai < 2; ++ai)
#pragma unroll
            for (int m = 0; m < 4; ++m) {
                const int row = u.pm * 256 + ai * 128 + wr * 64 + m * 16 + fr;
                float* xp = xrow_ptr(*C, row) + col0; float ss = 0.f;
#pragma unroll
                for (int bj = 0; bj < 2; ++bj)
#pragma unroll
                    for (int n = 0; n < 2; ++n) xc[bj][n] = xn[bj][n];
                if (ai * 4 + m < 7) { const int rn = ai * 4 + m + 1; const float* xq = xrow_ptr(*C, u.pm * 256 + (rn >> 2) * 128 + wr * 64 + (rn & 3) * 16 + fr) + col0;
#pragma unroll
                    for (int bj = 0; bj < 2; ++bj)
#pragma unroll
                        for (int n = 0; n < 2; ++n) xn[bj][n] = *(const f32x4*)(xq + bj * 128 + n * 16); }
#pragma unroll
                for (int bj = 0; bj < 2; ++bj)
#pragma unroll
                    for (int n = 0; n < 2; ++n) { f32x4 x = xc[bj][n]; x += gv[bj][n] * acc[ai][bj][m][n]; *(f32x4*)(xp + bj * 128 + n * 16) = x;
                        if (gsn) { ss += (x[0] * x[0] + x[1] * x[1]) + (x[2] * x[2] + x[3] * x[3]); const f32x4 a = x * sv[bj][n]; u32x2 w; w.x = pk2(a[0], a[1]); w.y = pk2(a[2], a[3]);
                            *(u32x2*)(AP + (size_t)row * D + col0 + bj * 128 + n * 16) = w; } }
                if (gsn) { ss += __shfl_xor(ss, 16); ss += __shfl_xor(ss, 32); if (fq == 0) atomicAdd(rowss_next + row, ss); }
            }
    }
};
struct EpiAcc {
    const Ctx* C; const float* gate;
    DI void operator()(const f32x4 (&acc)[2][2][4][2], const Unit& u, int wr, int wc, int fr_, int fq_) const {
        int tz_ = threadIdx.x; OPAQUE(tz_); const int fr = tz_ & 15, fq = (tz_ & 63) >> 4; (void)fr_; (void)fq_;
        const int s = stream_of_panel(u.pm); const int col0 = u.pn * 256 + wc * 32 + 4 * fq;
#pragma unroll
        for (int bj = 0; bj < 2; ++bj)
#pragma unroll
            for (int n = 0; n < 2; ++n) { const f32x4 gv = *(const f32x4*)(gate + (size_t)s * D + col0 + bj * 128 + n * 16);
#pragma unroll
                for (int ai = 0; ai < 2; ++ai)
#pragma unroll
                    for (int m = 0; m < 4; ++m) { float* xp = xrow_ptr(*C, u.pm * 256 + ai * 128 + wr * 64 + m * 16 + fr) + col0 + bj * 128 + n * 16; const f32x4 d = gv * acc[ai][bj][m][n];
#pragma unroll
                        for (int j = 0; j < 4; ++j) atomicAdd(xp + j, d[j]); } }
    }
};
struct EpiIn {
    const Ctx* C; const float* rowss; const float* bias  ; int l;
    DI void operator()(const f32x4 (&acc)[2][2][4][2], const Unit& u, int wr, int wc, int fr_, int fq_) const {
        int tz_ = threadIdx.x; OPAQUE(tz_); const int fr = tz_ & 15, fq = (tz_ & 63) >> 4; (void)fr_; (void)fq_;
        const int s = stream_of_panel(u.pm), pn = u.pn; const float* bs = bias + (size_t)s * NINP + pn * 256 + wc * 32 + 4 * fq;
        unsigned char* ws = C->ws;
        f32x4 bv[2][2];
#pragma unroll
        for (int bj = 0; bj < 2; ++bj)
#pragma unroll
            for (int n = 0; n < 2; ++n) bv[bj][n] = *(const f32x4*)(bs + bj * 128 + n * 16);
        float rsv[2][4];
#pragma unroll
        for (int ai = 0; ai < 2; ++ai)
#pragma unroll
            for (int m = 0; m < 4; ++m) rsv[ai][m] = rowss[u.pm * 256 + ai * 128 + wr * 64 + m * 16 + fr];
        const bool permuted = pn < PN_AV || (pn >= PN_CQ && pn < PN_DU);
        if (permuted) {
            const bool is_ckv = pn == PN_CKV, is_c = pn >= PN_CQ, is_q = pn < PN_AK || (pn >= PN_CQ && pn < PN_CKV);
            const bool plain_v = is_ckv && wc >= 2;
            const float* gsrc = C->in[is_c ? (is_q ? I_WAQG : I_WAKG) : (is_q ? I_NAQG : I_NAKG)] + (size_t)l * 64;
            f32x4 gn[2][2];
#pragma unroll
            for (int bj = 0; bj < 2; ++bj)
#pragma unroll
                for (int n = 0; n < 2; ++n) { gn[bj][n] = *(const f32x4*)(gsrc + 32 * bj + 16 * n + 4 * fq); if (is_q) gn[bj][n] *= 0.125f; }
            bf16* dst; int pitch, hcol;
            if (pn < PN_AK) { dst = (bf16*)(ws + WS_QA); pitch = GW; hcol = ((pn - PN_AQ) * 4 + wc) * 64; }
            else if (pn < PN_AV) { dst = (bf16*)(ws + WS_KA); pitch = GW; hcol = ((pn - PN_AK) * 4 + wc) * 64; }
            else if (pn < PN_CKV) { dst = (bf16*)(ws + WS_QC); pitch = GW; hcol = ((pn - PN_CQ) * 4 + wc) * 64; }
            else if (wc < 2) { dst = (bf16*)(ws + WS_KC); pitch = 128; hcol = wc * 64; }
            else { dst = (bf16*)(ws + WS_VC); pitch = 128; hcol = (wc - 2) * 64; }
            const f32x4* rope = (const f32x4*)(ws + WS_ROPE);
#pragma unroll
            for (int ai = 0; ai < 2; ++ai)
#pragma unroll
                for (int m = 0; m < 4; ++m) {
                    const int row = pn * 0 + u.pm * 256 + ai * 128 + wr * 64 + m * 16 + fr;
                    const float rstd = __builtin_amdgcn_rsqf(rsv[ai][m] * (1.0f / D) + NORM_EPS);
                    f32x4 v[2][2]; float ss = 0.f;
#pragma unroll
                    for (int bj = 0; bj < 2; ++bj)
#pragma unroll
                        for (int n = 0; n < 2; ++n) { v[bj][n] = acc[ai][bj][m][n] * rstd + bv[bj][n]; ss += (v[bj][n][0] * v[bj][n][0] + v[bj][n][1] * v[bj][n][1]) + (v[bj][n][2] * v[bj][n][2] + v[bj][n][3] * v[bj][n][3]); }
                    ss += __shfl_xor(ss, 16); ss += __shfl_xor(ss, 32);
                    if (!plain_v) { const float rs = 1.0f / sqrtf(ss * (1.0f / 64.0f) + NORM_EPS);
#pragma unroll
                        for (int bj = 0; bj < 2; ++bj)
#pragma unroll
                            for (int n = 0; n < 2; ++n) v[bj][n] = v[bj][n] * rs * gn[bj][n];
                        if (is_c && row < M_LAT) {
                            const int t = row % T; const int pos[2] = {t / GRW, t % GRW};
#pragma unroll
                            for (int bj = 0; bj < 2; ++bj) { const f32x4 cs0 = rope[(pos[bj] * 16 + 4 * fq) / 2], cs1 = rope[(pos[bj] * 16 + 4 * fq) / 2 + 1];
                                const float cc[4] = {cs0[0], cs0[2], cs1[0], cs1[2]}, sn[4] = {cs0[1], cs0[3], cs1[1], cs1[3]};
#pragma unroll
                                for (int j = 0; j < 4; ++j) { const float x1 = v[bj][0][j], x2 = v[bj][1][j]; v[bj][0][j] = x1 * cc[j] - x2 * sn[j]; v[bj][1][j] = x2 * cc[j] + x1 * sn[j]; } }
                        }
                    }
                    bf16* op = dst + (size_t)row * pitch + hcol + 4 * fq;
#pragma unroll
                    for (int bj = 0; bj < 2; ++bj)
#pragma unroll
                        for (int n = 0; n < 2; ++n) { u32x2 w; w.x = pk2(v[bj][n][0], v[bj][n][1]); w.y = pk2(v[bj][n][2], v[bj][n][3]); *(u32x2*)(op + 32 * bj + 16 * n) = w; }
                }
        } else {
#pragma unroll
            for (int ai = 0; ai < 2; ++ai)
#pragma unroll
                for (int m = 0; m < 4; ++m) {
                    const int row = u.pm * 256 + ai * 128 + wr * 64 + m * 16 + fr;
                    const float rstd = __builtin_amdgcn_rsqf(rsv[ai][m] * (1.0f / D) + NORM_EPS);
#pragma unroll
                    for (int bj = 0; bj < 2; ++bj)
#pragma unroll
                        for (int n = 0; n < 2; ++n) { const f32x4 v = acc[ai][bj][m][n] * rstd + bv[bj][n]; const int c = bj * 128 + wc * 32 + n * 16 + 4 * fq;
                            u32x2 w; w.x = pk2(v[0], v[1]); w.y = pk2(v[2], v[3]);
                            if (pn < PN_BR) *(u32x2*)((bf16*)(ws + WS_VA) + (size_t)row * GW + (pn - PN_AV) * 256 + c) = w;
                            else if (pn < PN_BS) *(u32x2*)((bf16*)(ws + WS_PB) + (size_t)row * 3 * GW + (pn - PN_BR) * 256 + c) = w;
                            else if (pn == PN_BS) { if (c < 160) *(f32x4*)((float*)(ws + WS_PS) + (size_t)row * 160 + c) = v; }
                            else { const int cu = (pn - PN_DU) * 256 + c, gq = cu >> 4, p0 = cu & 15;
                                *(u32x2*)((bf16*)(ws + WS_UG) + ((size_t)gq * NCHP + row / S5L) * S5K + (row % S5L) * 16 + p0) = w; } }
                }
        }
    }
};
struct EpiS5A {
    float* XE;
    DI void operator()(const f32x4 (&acc)[2][2][4][2], const Unit& u, int wr, int wc, int fr_, int fq_) const {
        int tz_ = threadIdx.x; OPAQUE(tz_); const int fr = tz_ & 15, fq = (tz_ & 63) >> 4; (void)fr_; (void)fq_;
#pragma unroll
        for (int ai = 0; ai < 2; ++ai)
#pragma unroll
            for (int m = 0; m < 4; ++m) { const int ch = u.pm * 256 + ai * 128 + wr * 64 + m * 16 + fr; if (ch < NCH) { float* p = XE + ((size_t)u.z * NCHP + ch) * 256 + wc * 32 + 4 * fq;
#pragma unroll
                for (int bj = 0; bj < 2; ++bj)
#pragma unroll
                    for (int n = 0; n < 2; ++n) *(f32x4*)(p + bj * 128 + n * 16) = acc[ai][bj][m][n]; } }
    }
};
struct EpiS5C {
    const bf16* UG; const float* dsk  ; bf16* YG;
    DI void operator()(const f32x4 (&acc)[2][2][4][2], const Unit& u, int wr, int wc, int fr_, int fq_) const {
        int tz_ = threadIdx.x; OPAQUE(tz_); const int fr = tz_ & 15, fq = (tz_ & 63) >> 4; (void)fr_; (void)fq_;
        const int g = u.z;
#pragma unroll
        for (int ai = 0; ai < 2; ++ai)
#pragma unroll
            for (int m = 0; m < 4; ++m) { const int ch = u.pm * 256 + ai * 128 + wr * 64 + m * 16 + fr; if (ch < NCH) {
#pragma unroll
                for (int bj = 0; bj < 2; ++bj)
#pragma unroll
                    for (int n = 0; n < 2; ++n) { const int col = u.pn * 256 + bj * 128 + wc * 32 + n * 16 + 4 * fq, i = col >> 4, p0 = col & 15;
                        const u32x2 uw = *(const u32x2*)(UG + ((size_t)g * NCHP + ch) * S5K + col); const f32x4 dv = *(const f32x4*)(dsk + 16 * g + p0);
                        const f32x4 a = acc[ai][bj][m][n]; const float y0 = a[0] + dv[0] * bflo(uw.x), y1 = a[1] + dv[1] * bfhi(uw.x), y2 = a[2] + dv[2] * bflo(uw.y), y3 = a[3] + dv[3] * bfhi(uw.y);
                        u32x2 w; w.x = pk2(geluf(y0), geluf(y1)); w.y = pk2(geluf(y2), geluf(y3));
                        *(u32x2*)(YG + (size_t)(ch * S5L + i) * GW + 16 * g + p0) = w; } } }
    }
};
struct EpiGLU {
    const bf16* YG; const float* gb; bf16* OB;
    DI void operator()(const f32x4 (&acc)[2][2][4][2], const Unit& u, int wr, int wc, int fr_, int fq_) const {
        int tz_ = threadIdx.x; OPAQUE(tz_); const int fr = tz_ & 15, fq = (tz_ & 63) >> 4; (void)fr_; (void)fq_;
#pragma unroll
        for (int ai = 0; ai < 2; ++ai)
#pragma unroll
            for (int m = 0; m < 4; ++m) { const int row = u.pm * 256 + ai * 128 + wr * 64 + m * 16 + fr;
#pragma unroll
                for (int bj = 0; bj < 2; ++bj)
#pragma unroll
                    for (int n = 0; n < 2; ++n) { const int col = u.pn * 256 + bj * 128 + wc * 32 + n * 16 + 4 * fq; const f32x4 b = *(const f32x4*)(gb + col); const f32x4 a = acc[ai][bj][m][n] + b;
                        const u32x2 yw = *(const u32x2*)(YG + (size_t)row * GW + col);
                        u32x2 w; w.x = pk2(bflo(yw.x) * sigmf(a[0]), bfhi(yw.x) * sigmf(a[1])); w.y = pk2(bflo(yw.y) * sigmf(a[2]), bfhi(yw.y) * sigmf(a[3]));
                        *(u32x2*)(OB + (size_t)row * D + 3 * GW + col) = w; } }
    }
};

DI void ph_ada(const Ctx& C) {
    LAS float* sc = (LAS float*)C.lds;
    LAS float* red = sc + 3 * D;
    for (int i = C.tid; i < 3 * D; i += NTHR) { const int s = i / D, k = i % D; const float c = s < NB ? C.in[I_C][s * D + k] : C.in[I_CCTX][k]; sc[i] = siluf(c); }
    __syncthreads();
    const int nun = NL * (9 * D / 256);
    for (int un = C.bid; un < nun; un += C.G) {
        const int l = un / (9 * D / 256), col0 = (un % (9 * D / 256)) * 256;
        const float* W = C.in[I_WADA] + (size_t)l * D * 9 * D + col0 + 4 * C.lane;
        f32x4 a0 = {0.f, 0.f, 0.f, 0.f}, a1 = a0, a2 = a0;
        const int k0 = C.wave * (D / 8);
#pragma unroll 1
        for (int kb = k0; kb < k0 + D / 8; kb += 16) {
            f32x4 wv[16];
#pragma unroll
            for (int u = 0; u < 16; ++u) wv[u] = *(const f32x4*)(W + (size_t)(kb + u) * 9 * D);
#pragma unroll
            for (int u = 0; u < 16; ++u) { a0 += wv[u] * sc[kb + u]; a1 += wv[u] * sc[D + kb + u]; a2 += wv[u] * sc[2 * D + kb + u]; } }
        LAS float* r = red + C.wave * 768 + 4 * C.lane;
        *(LAS f32x4*)(r) = a0; *(LAS f32x4*)(r + 256) = a1; *(LAS f32x4*)(r + 512) = a2;
        __syncthreads();
        for (int i = C.tid; i < 768; i += NTHR) { float s = 0.f;
#pragma unroll
            for (int w = 0; w < 8; ++w) s += red[w * 768 + i];
            const int st = i / 256, c = col0 + (i % 256);
            ((float*)(C.ws + WS_MODV))[((size_t)l * 3 + st) * 9 * D + c] = s + C.in[I_BADA][(size_t)l * 9 * D + c]; }
        __syncthreads();
    }
}
DI const float* modv_ptr(const Ctx& C, int l, int s, int chunk) { return (const float*)(C.ws + WS_MODV) + ((size_t)l * 3 + s) * 9 * D + (size_t)chunk * D; }

DI int win_dest(int n) {
    if (n >= D_IN) return -1;
    if (n < SRC_AV) { const int piece = n / GW, loc = n % GW, head = loc / 64, d = loc % 64; return ((piece == 0 ? PN_AQ : PN_AK) + head / 4) * 256 + 128 * (d / 32) + 32 * (head % 4) + (d % 32); }
    if (n < SRC_BS) return PN_AV * 256 + (n - SRC_AV);
    if (n < SRC_CQ) return PN_BS * 256 + (n - SRC_BS);
    if (n < SRC_CK) { const int loc = n - SRC_CQ, head = loc / 64, d = loc % 64; return (PN_CQ + head / 4) * 256 + 128 * (d / 32) + 32 * (head % 4) + (d % 32); }
    if (n < SRC_DU) { const int loc = n - SRC_CK, hh = loc / 64, d = loc % 64; return PN_CKV * 256 + 128 * (d / 32) + 32 * hh + (d % 32); }
    return PN_DU * 256 + (n - SRC_DU);
}
DI int gu_dest(int n) { const int e = n & 31; return (n / 128) * 256 + (n % 128 - e) + 16 * ((e >> 2) & 1) + 4 * (e >> 3) + (e & 3); }
DI void conv_item(const Ctx& C, const float* W, int K, int N, bf16* Wt, int mode, int k0, int n0, float* bias, int bias_pitch, const float* shift  ) {
    LAS float* scr = (LAS float*)(C.lds + C.wave * 16640);
    const int n = n0 + C.lane; const bool ok = n < N; float b0 = 0.f, b1 = 0.f, b2 = 0.f;
#pragma unroll 1
    for (int kh = 0; kh < 4; ++kh) {
        float wv[16];
#pragma unroll
        for (int kk = 0; kk < 16; ++kk) wv[kk] = ok ? W[(size_t)(k0 + 16 * kh + kk) * N + n] : 0.f;
#pragma unroll
        for (int kk = 0; kk < 16; ++kk) { const float v = wv[kk]; scr[(16 * kh + kk) * 65 + C.lane] = v;
            if (bias) { b0 += shift[k0 + 16 * kh + kk] * v; b1 += shift[9 * D + k0 + 16 * kh + kk] * v; b2 += shift[18 * D + k0 + 16 * kh + kk] * v; } } }
    WSYNC();
    const int dme = !ok ? -1 : mode == 0 ? n : mode == 1 ? gu_dest(n) : mode == 2 ? gu_dest(n) + 128 : win_dest(n);
    if (bias && dme >= 0) { atomicAdd(bias + dme, b0); atomicAdd(bias + bias_pitch + dme, b1); atomicAdd(bias + 2 * bias_pitch + dme, b2); }
    const int c = C.lane & 7;
#pragma unroll
    for (int i = 0; i < 8; ++i) { const int nl = (C.lane >> 3) + 8 * i, nn = n0 + nl;
        const int dr = nn >= N ? -1 : mode == 0 ? nn : mode == 1 ? gu_dest(nn) : mode == 2 ? gu_dest(nn) + 128 : win_dest(nn);
        const LAS float* s = scr + (8 * c) * 65 + nl;
        u32x4 o; o.x = pk2(s[0], s[65]); o.y = pk2(s[2 * 65], s[3 * 65]); o.z = pk2(s[4 * 65], s[5 * 65]); o.w = pk2(s[6 * 65], s[7 * 65]);
        if (dr >= 0) *(u32x4*)(Wt + (size_t)dr * K + k0 + 8 * c) = o; }
    WSYNC();
}
struct Cplx { float re, im; };
DI Cplx cmul(Cplx a, Cplx b) { return Cplx{a.re * b.re - a.im * b.im, a.re * b.im + a.im * b.re}; }
DI Cplx s5_lam_pow(const Ctx& C, int l, int dir, int g, int n, float tau) {
    const size_t i = (((size_t)l * 2 + dir) * S5G + g) * 64 + n; const float dt = __expf(C.in[I_S5LDT][((size_t)l * 2 + dir) * S5G + g]);
    const float mag = __expf(tau * dt * C.in[I_S5ARE][i]), ang = tau * dt * C.in[I_S5AIM][i]; float sn, cs; sincosf(ang, &sn, &cs); return Cplx{mag * cs, mag * sn};
}
DI Cplx s5_coef(const Ctx& C, int l, int dir, int g, int n) {
    const size_t i = (((size_t)l * 2 + dir) * S5G + g) * 64 + n; const float are = C.in[I_S5ARE][i], aim = C.in[I_S5AIM][i];
    const Cplx ab = s5_lam_pow(C, l, dir, g, n, 1.0f); const float den = are * are + aim * aim, nr = ab.re - 1.0f;
    return Cplx{(nr * are + ab.im * aim) / den, (ab.im * are - nr * aim) / den};
}
DI Cplx s5_beta(const Ctx& C, int l, int dir, int g, int n, int q) {
    const size_t i = (((size_t)l * S5G + g) * 64 + n) * 16 + q; return cmul(s5_coef(C, l, dir, g, n), Cplx{C.in[I_S5BRE][i], C.in[I_S5BIM][i]});
}
DI Cplx s5_gamma(const Ctx& C, int l, int g, int p, int n) { const size_t i = (((size_t)l * S5G + g) * 16 + p) * 64 + n; return Cplx{C.in[I_S5CRE][i], C.in[I_S5CIM][i]}; }

constexpr int CI_GU = (D / 64) * (FF / 64), CI_DN = (FF / 64) * (D / 64), CI_IN = (D / 64) * ((D_IN + 63) / 64), CI_OUT = (D / 64) * (D / 64), CI_GLU = (GW / 64) * (GW / 64);
constexpr int CI_LAYER = 4 * CI_GU + 2 * CI_DN + CI_IN + CI_OUT + CI_GLU;
DI void conv_weights(const Ctx& C, int l, int wslot, int nslots) {
    for (int it = wslot; it < CI_LAYER; it += nslots) {
        int r = it;
        unsigned char* wbase = C.ws + WS_W + (size_t)l * SZ_WL;
        if (r < 2 * CI_GU) { const int up = r >= CI_GU; r -= up * CI_GU; const int kb = r / (FF / 64), nb = r % (FF / 64);
            conv_item(C, C.in[up ? I_F1WU : I_F1WG] + (size_t)l * D * FF, D, FF, (bf16*)(wbase + OFF_W1GU), 1 + up, kb * 64, nb * 64, bias_ptr(C, l, 0), 2 * FF, modv_ptr(C, l, 0, 0)); continue; } r -= 2 * CI_GU;
        if (r < CI_DN) { const int kb = r / (D / 64), nb = r % (D / 64); conv_item(C, C.in[I_F1WD] + (size_t)l * FF * D, FF, D, (bf16*)(wbase + OFF_W1D), 0, kb * 64, nb * 64, nullptr, 0, nullptr); continue; } r -= CI_DN;
        if (r < CI_IN) { const int nbn = (D_IN + 63) / 64, kb = r / nbn, nb = r % nbn; conv_item(C, C.in[I_WIN] + (size_t)l * D * D_IN, D, D_IN, (bf16*)(wbase + OFF_WIN), 3, kb * 64, nb * 64, bias_ptr(C, l, 1), NINP, modv_ptr(C, l, 0, 3)); continue; } r -= CI_IN;
        if (r < CI_OUT) { const int kb = r / (D / 64), nb = r % (D / 64); conv_item(C, C.in[I_WOUT] + (size_t)l * D * D, D, D, (bf16*)(wbase + OFF_WOUT), 0, kb * 64, nb * 64, nullptr, 0, nullptr); continue; } r -= CI_OUT;
        if (r < 2 * CI_GU) { const int up = r >= CI_GU; r -= up * CI_GU; const int kb = r / (FF / 64), nb = r % (FF / 64);
            conv_item(C, C.in[up ? I_F2WU : I_F2WG] + (size_t)l * D * FF, D, FF, (bf16*)(wbase + OFF_W2GU), 1 + up, kb * 64, nb * 64, bias_ptr(C, l, 2), 2 * FF, modv_ptr(C, l, 0, 6)); continue; } r -= 2 * CI_GU;
        if (r < CI_DN) { const int kb = r / (D / 64), nb = r % (D / 64); conv_item(C, C.in[I_F2WD] + (size_t)l * FF * D, FF, D, (bf16*)(wbase + OFF_W2D), 0, kb * 64, nb * 64, nullptr, 0, nullptr); continue; } r -= CI_DN;
        { const int kb = r / (GW / 64), nb = r % (GW / 64); conv_item(C, C.in[I_S5GLUW] + (size_t)l * GW * GW, GW, GW, (bf16*)(wbase + OFF_WGLU), 0, kb * 64, nb * 64, nullptr, 0, nullptr); }
    }
}
DI void ph_conv(const Ctx& C) {
    const int gt = C.bid * NTHR + C.tid, GT = C.G * NTHR;
    for (int i = gt; i < NL * 9 * D; i += GT) { const int k = i % D, s = (i / D) % 3, sub = (i / (3 * D)) % 3, l = i / (9 * D);
        const float* mv = (const float*)(C.ws + WS_MODV) + ((size_t)l * 3 + s) * 9 * D;
        ((float*)(C.ws + WS_GS))[i] = C.in[I_NORMG][((size_t)l * 3 + sub) * D + k] * (1.0f + mv[(3 * sub + 1) * D + k]);
        ((float*)(C.ws + WS_GATE))[i] = mv[(3 * sub + 2) * D + k] * (sub == 1 ? 1.0f : 0.5f); }
    for (int i = gt; i < 128 * 16; i += GT) { const int pos = i / 16, f = i % 16; const float inv = __expf(-(float)f * (9.210340371976184f / 16.0f)); float sn, cs; sincosf((float)pos * inv, &sn, &cs);
        ((f32x2*)(C.ws + WS_ROPE))[i] = (f32x2){cs, sn}; }
    const int gw = C.bid * NW + C.wave, GWV = C.G * NW;
    conv_weights(C, 0, gw, GWV);
    for (int i = gt; i < NL * 14 * NH * 2 * 64 * 8; i += GT) {
        const int j = i & 7, ln = (i >> 3) & 63, tj = (i >> 9) & 1, hd = (i >> 10) % NH, f = (i / (1024 * NH)) % 14, l = i / (1024 * NH * 14);
        const int col = hd * 64 + 32 * tj + (ln & 31); float v;
        if (f < 8) { const int d = (f >> 1) & 1, sx = f & 1, k = 16 * sx + 8 * (ln >> 5) + j; v = C.in[f < 4 ? I_RWWUP : I_RWAUP][(((size_t)l * 2 + d) * 32 + k) * GW + col]; }
        else { const int k = 16 * (f - 8) + 8 * (ln >> 5) + j; v = C.in[I_RWGUP][((size_t)l * 96 + k) * GW + col]; }
        ((bf16*)(C.ws + WS_RWF))[i] = (bf16)f2bf(v); }
    LAS float* wsc = (LAS float*)(C.lds + C.wave * 16640);
    for (int it = gw; it < NL * S5G * 2 * S5L; it += GWV) {
        const int tau = it % S5L, dir = (it / S5L) % 2, g = (it / (2 * S5L)) % S5G, l = it / (2 * S5L * S5G);
        const Cplx z = cmul(s5_lam_pow(C, l, dir, g, C.lane, (float)tau), s5_coef(C, l, dir, g, C.lane));
#pragma unroll 4
        for (int q = 0; q < 16; ++q) { const size_t i = (((size_t)l * S5G + g) * 64 + C.lane) * 16 + q; const Cplx w = cmul(z, Cplx{C.in[I_S5BRE][i], C.in[I_S5BIM][i]}); wsc[(C.lane * 16 + q) * 2] = w.re; wsc[(C.lane * 16 + q) * 2 + 1] = w.im; }
        WSYNC();
        float* kc = (float*)(C.ws + WS_S5T + (size_t)l * SZ_S5L + OFF_S5KC) + (((size_t)g * 2 + dir) * S5L + tau) * 256;
#pragma unroll 1
        for (int e = 0; e < 4; ++e) { const int pq = C.lane + 64 * e, p = pq >> 4, q = pq & 15; float s = 0.f;
#pragma unroll 4
            for (int n = 0; n < 64; ++n) { const Cplx gm = s5_gamma(C, l, g, p, n); s += gm.re * wsc[(n * 16 + q) * 2] - gm.im * wsc[(n * 16 + q) * 2 + 1]; }
            kc[pq] = s; }
        WSYNC();
    }
    for (int i = gt; i < NL * 2 * GW * 4 * (S5L + 1); i += GT) { const int tau = i % (S5L + 1), r = i / (S5L + 1), n = r % 64, g = (r / 64) % S5G, dir = (r / (64 * S5G)) % 2, l = r / (2 * 64 * S5G);
        const Cplx z = s5_lam_pow(C, l, dir, g, n, (float)tau); ((f32x2*)(C.ws + WS_S5T + (size_t)l * SZ_S5L + OFF_S5LP))[((size_t)(dir * S5G + g) * 64 + n) * (S5L + 1) + tau] = (f32x2){z.re, z.im}; }
    for (int i = gt; i < NL * 2 * GW * 4 * 16; i += GT) { const int q = i % 16, r = i / 16, n = r % 64, g = (r / 64) % S5G, dir = (r / (64 * S5G)) % 2, l = r / (2 * 64 * S5G);
        const Cplx z = s5_beta(C, l, dir, g, n, q); ((f32x2*)(C.ws + WS_S5T + (size_t)l * SZ_S5L + OFF_S5BETA))[((size_t)(dir * S5G + g) * 64 + n) * 16 + q] = (f32x2){z.re, z.im}; }
    for (int i = gt; i < NL * 2 * GW * 4; i += GT) { const int n = i % 64, g = (i / 64) % S5G, dir = (i / (64 * S5G)) % 2, l = i / (2 * 64 * S5G); const Cplx z = s5_lam_pow(C, l, dir, g, n, (float)S5L);
        ((f32x2*)(C.ws + WS_S5T + (size_t)l * SZ_S5L + OFF_S5LAM))[(dir * S5G + g) * 64 + n] = (f32x2){z.re, z.im}; }
}
DI void ph_tab(const Ctx& C) {
    const long gt = (long)C.bid * NTHR + C.tid, GT = (long)C.G * NTHR;
    for (long i = gt; i < (long)NL * S5G * 256 * 512; i += GT) {
        const int k = (int)(i % 512), np = (int)((i / 512) % 256), g = (int)((i / (512 * 256)) % S5G), l = (int)(i / ((long)512 * 256 * S5G));
        const int j = k >> 4, q = k & 15, dir = np >> 7, n = np & 63, im = (np >> 6) & 1;
        const f32x2 lp = ((const f32x2*)(C.ws + WS_S5T + (size_t)l * SZ_S5L + OFF_S5LP))[((size_t)(dir * S5G + g) * 64 + n) * (S5L + 1) + (dir == 0 ? S5L - 1 - j : j)];
        const f32x2 be = ((const f32x2*)(C.ws + WS_S5T + (size_t)l * SZ_S5L + OFF_S5BETA))[((size_t)(dir * S5G + g) * 64 + n) * 16 + q];
        const Cplx w = cmul(Cplx{lp[0], lp[1]}, Cplx{be[0], be[1]});
        ((bf16*)(C.ws + WS_S5T + (size_t)l * SZ_S5L + OFF_S5ET))[((size_t)g * 256 + np) * 512 + k] = (bf16)f2bf(im ? w.im : w.re); }
    for (long i = gt; i < (long)NL * S5G * 512 * S5K; i += GT) {
        const int k = (int)(i % S5K), nn = (int)((i / S5K) % 512), g = (int)((i / ((long)S5K * 512)) % S5G), l = (int)(i / ((long)S5K * 512 * S5G));
        const int ti = nn >> 4, p = nn & 15; float v;
        if (k < 512) { const int j = k >> 4, q = k & 15; const float* kc = (const float*)(C.ws + WS_S5T + (size_t)l * SZ_S5L + OFF_S5KC) + (size_t)g * 2 * S5L * 256;
            v = 0.f; if (j <= ti) v += kc[((ti - j)) * 256 + p * 16 + q]; if (j >= ti) v += kc[(S5L + (j - ti)) * 256 + p * 16 + q]; }
        else { const int kk = k - 512, dir = kk >> 7, im = (kk >> 6) & 1, n = kk & 63;
            const f32x2 lp = ((const f32x2*)(C.ws + WS_S5T + (size_t)l * SZ_S5L + OFF_S5LP))[((size_t)(dir * S5G + g) * 64 + n) * (S5L + 1) + (dir == 0 ? ti + 1 : S5L - ti)];
            const Cplx w = cmul(s5_gamma(C, l, g, p, n), Cplx{lp[0], lp[1]}); v = im ? -w.im : w.re; }
        ((bf16*)(C.ws + WS_S5T + (size_t)l * SZ_S5L + OFF_S5BT))[((size_t)g * 512 + nn) * S5K + k] = (bf16)f2bf(v); }
    const int gw = C.bid * NW + C.wave, GWV = C.G * NW;
    for (int row = gw; row < M; row += GWV) {
        const float* src = row < M_LAT ? C.in[I_X] + (size_t)row * D : C.in[I_CTX] + (size_t)(row - M_LAT) * D;
        float* dst = xrow_ptr(C, row); const float* gs = gs_ptr(C, 0, 0, stream_of_row(row)); bf16* ap = (bf16*)(C.ws + WS_AP) + (size_t)row * D; float ss = 0.f;
        for (int c = 4 * C.lane; c < D; c += 256) { const f32x4 x = *(const f32x4*)(src + c); *(f32x4*)(dst + c) = x; ss += (x[0] * x[0] + x[1] * x[1]) + (x[2] * x[2] + x[3] * x[3]);
            const f32x4 a = x * *(const f32x4*)(gs + c); u32x2 w; w.x = pk2(a[0], a[1]); w.y = pk2(a[2], a[3]); *(u32x2*)(ap + c) = w; }
        ss = wave_sum(ss); if (C.lane == 0) rowss_ptr(C, 0, 0)[row] = ss;
    }
}

#ifdef EMU
DI s16x4 tr_read1(const LAS unsigned char* a) { return emu_tr_read(a); }
#else
DI s16x4 tr_read1(const LAS unsigned char* a) { s16x4 r; asm volatile("ds_read_b64_tr_b16 %0, %1\n\ts_waitcnt lgkmcnt(0)" : "=&v"(r) : "v"((unsigned)(size_t)a) : "memory"); return r; }
#endif
DI bf16x8 tr_frag(const LAS unsigned char* a0, int hi_off) {
#ifdef EMU
    const s16x4 lo = emu_tr_read(a0), hi = emu_tr_read(a0 + hi_off);
#else
    s16x4 lo, hi; asm volatile("ds_read_b64_tr_b16 %0, %2\n\tds_read_b64_tr_b16 %1, %3\n\ts_waitcnt lgkmcnt(0)" : "=&v"(lo), "=&v"(hi) : "v"((unsigned)(size_t)a0), "v"((unsigned)(size_t)(a0 + hi_off)) : "memory");
#endif
    return __builtin_shufflevector(lo, hi, 0, 1, 2, 3, 4, 5, 6, 7);
}
DI void tr_frag4(const LAS unsigned char* a0, const LAS unsigned char* a1, const LAS unsigned char* a2, const LAS unsigned char* a3, int hi_off, bf16x8 (&f)[4]) {
#ifdef EMU
    f[0] = tr_frag(a0, hi_off); f[1] = tr_frag(a1, hi_off); f[2] = tr_frag(a2, hi_off); f[3] = tr_frag(a3, hi_off);
#else
    s16x4 l0, h0, l1, h1, l2, h2, l3, h3;
    asm volatile("ds_read_b64_tr_b16 %0, %8\n\tds_read_b64_tr_b16 %1, %9\n\tds_read_b64_tr_b16 %2, %10\n\tds_read_b64_tr_b16 %3, %11\n\tds_read_b64_tr_b16 %4, %12\n\tds_read_b64_tr_b16 %5, %13\n\tds_read_b64_tr_b16 %6, %14\n\tds_read_b64_tr_b16 %7, %15\n\ts_waitcnt lgkmcnt(0)"
        : "=&v"(l0), "=&v"(h0), "=&v"(l1), "=&v"(h1), "=&v"(l2), "=&v"(h2), "=&v"(l3), "=&v"(h3)
        : "v"((unsigned)(size_t)a0), "v"((unsigned)(size_t)(a0 + hi_off)), "v"((unsigned)(size_t)a1), "v"((unsigned)(size_t)(a1 + hi_off)), "v"((unsigned)(size_t)a2), "v"((unsigned)(size_t)(a2 + hi_off)), "v"((unsigned)(size_t)a3), "v"((unsigned)(size_t)(a3 + hi_off)) : "memory");
    f[0] = __builtin_shufflevector(l0, h0, 0, 1, 2, 3, 4, 5, 6, 7); f[1] = __builtin_shufflevector(l1, h1, 0, 1, 2, 3, 4, 5, 6, 7); f[2] = __builtin_shufflevector(l2, h2, 0, 1, 2, 3, 4, 5, 6, 7); f[3] = __builtin_shufflevector(l3, h3, 0, 1, 2, 3, 4, 5, 6, 7);
#endif
}
DI bf16x8 pack8(const f32x16& x, int s) {
    u32x4 p; p.x = pk2(x[8 * s], x[8 * s + 1]); p.y = pk2(x[8 * s + 2], x[8 * s + 3]); p.z = pk2(x[8 * s + 4], x[8 * s + 5]); p.w = pk2(x[8 * s + 6], x[8 * s + 7]);
    return __builtin_bit_cast(bf16x8, p);
}
struct AttnSt { f32x16 o0, o1; float m, l; };
struct KVregs { bf16x8 k[4]; u32x4 v[4]; };
struct Kregs { bf16x8 k[4]; };
DI void k_load(Kregs& r, const bf16* Kb, int kp, int lane) {
    const int r32 = lane & 31, h = lane >> 5;
#pragma unroll
    for (int kk = 0; kk < 4; ++kk) r.k[kk] = *(const bf16x8*)(Kb + (size_t)r32 * kp + 16 * kk + 8 * h);
}
DI void kv_load(KVregs& r, const Kregs& kpre, const bf16* Vb, int vp, int lane) {
#pragma unroll
    for (int kk = 0; kk < 4; ++kk) r.k[kk] = kpre.k[kk];
#pragma unroll
    for (int i = 0; i < 4; ++i) { const int idx = lane + 64 * i, key = idx >> 3, ch = idx & 7; r.v[i] = *(const u32x4*)(Vb + (size_t)key * vp + ch * 8); }
}
template <bool MASKED>
DI void attn_block(AttnSt& st, const bf16x8 (&qf)[4], const KVregs& kv, LAS unsigned char* vl, int lane, const float (&addv)[16], unsigned vmask) {
    const int h = lane >> 5;
#pragma unroll
    for (int i = 0; i < 4; ++i) { const int idx = lane + 64 * i, key = idx >> 3, ch = idx & 7; *(LAS u32x4*)(vl + key * 128 + ch * 16) = kv.v[i]; }
    f32x16 s;
#pragma unroll
    for (int i = 0; i < 16; ++i) s[i] = 0.f;
#pragma unroll
    for (int kk = 0; kk < 4; ++kk) s = __builtin_amdgcn_mfma_f32_32x32x16_bf16(kv.k[kk], qf[kk], s, 0, 0, 0);
    float bm = -1e30f;
#pragma unroll
    for (int i = 0; i < 16; ++i) { if (MASKED) { s[i] += addv[i]; if ((vmask >> i) & 1u) bm = fmaxf(bm, s[i]); } else bm = fmaxf(bm, s[i]); }
    bm = fmaxf(bm, __shfl_xor(bm, 32));
    const float mn = fmaxf(st.m, bm), alpha = __expf(st.m - mn); st.m = mn;
    float ls = 0.f;
#pragma unroll
    for (int i = 0; i < 16; ++i) { float p = __expf(s[i] - mn); if (MASKED) p = ((vmask >> i) & 1u) ? p : 0.f; s[i] = p; ls += p; }
    st.l = st.l * alpha + ls;
#pragma unroll
    for (int i = 0; i < 16; ++i) { st.o0[i] *= alpha; st.o1[i] *= alpha; }
    WSYNC();
    const int q = (lane & 15) >> 2, p4 = lane & 3, blk = (lane >> 4) & 1;
    { const LAS unsigned char* ab = vl + (4 * h + q) * 128 + (16 * blk) * 2 + 8 * p4; bf16x8 vf[4];
      tr_frag4(ab, ab + 64, ab + 16 * 128, ab + 16 * 128 + 64, 8 * 128, vf);
      const bf16x8 pf0 = pack8(s, 0), pf1 = pack8(s, 1);
      st.o0 = __builtin_amdgcn_mfma_f32_32x32x16_bf16(vf[0], pf0, st.o0, 0, 0, 0); st.o1 = __builtin_amdgcn_mfma_f32_32x32x16_bf16(vf[1], pf0, st.o1, 0, 0, 0);
      st.o0 = __builtin_amdgcn_mfma_f32_32x32x16_bf16(vf[2], pf1, st.o0, 0, 0, 0); st.o1 = __builtin_amdgcn_mfma_f32_32x32x16_bf16(vf[3], pf1, st.o1, 0, 0, 0); }
}
DI void attn_finish(AttnSt& st, bf16* orow  , int lane, float extra_l) {
    const int h = lane >> 5; float l = st.l + __shfl_xor(st.l, 32) + extra_l; const float inv = 1.0f / l;
#pragma unroll
    for (int g = 0; g < 4; ++g) {
        u32x2 w0, w1; w0.x = pk2(st.o0[4 * g] * inv, st.o0[4 * g + 1] * inv); w0.y = pk2(st.o0[4 * g + 2] * inv, st.o0[4 * g + 3] * inv);
        w1.x = pk2(st.o1[4 * g] * inv, st.o1[4 * g + 1] * inv); w1.y = pk2(st.o1[4 * g + 2] * inv, st.o1[4 * g + 3] * inv);
        *(u32x2*)(orow + 8 * g + 4 * h) = w0; *(u32x2*)(orow + 32 + 8 * g + 4 * h) = w1; }
}
DI int clampi(int v, int lo, int hi) { return v < lo ? lo : (v > hi ? hi : v); }
constexpr int AT_NA = NB * NH * (GRH / 2) * 4, AT_WA = NB * NH * (T / 32), AT_CX = NB * NH * (TC / 32);
DI void ph_attn(const Ctx& C, int l, bool want_ctx, int first_block) {
    if (C.bid < first_block) return;
    const int gw = (C.bid - first_block) * NW + C.wave, GWV = (C.G - first_block) * NW, lane = C.lane, r32 = lane & 31, h = lane >> 5;
    LAS unsigned char* vl = C.lds + C.wave * 4096;
    const bf16* QA = (const bf16*)(C.ws + WS_QA); const bf16* KA = (const bf16*)(C.ws + WS_KA); const bf16* VA = (const bf16*)(C.ws + WS_VA);
    const bf16* QC = (const bf16*)(C.ws + WS_QC); const bf16* KC = (const bf16*)(C.ws + WS_KC); const bf16* VC = (const bf16*)(C.ws + WS_VC);
    bf16* OB = (bf16*)(C.ws + WS_OB);
    const int ntiles = AT_NA + AT_WA + (want_ctx ? 2 * AT_CX : 0);
    const float zero16[16] = {0.f, 0.f, 0.f, 0.f, 0.f, 0.f, 0.f, 0.f, 0.f, 0.f, 0.f, 0.f, 0.f, 0.f, 0.f, 0.f};
    for (int tile = gw; tile < ntiles; tile += GWV) {
        AttnSt st; st.m = -1e30f; st.l = 0.f;
#pragma unroll
        for (int i = 0; i < 16; ++i) { st.o0[i] = 0.f; st.o1[i] = 0.f; }
        bf16x8 qf[4];
        if (tile < AT_NA) {
            const int cb = tile & 3, rp = (tile >> 2) % (GRH / 2), hd = (tile / (4 * (GRH / 2))) % NH, b = tile / (4 * (GRH / 2) * NH);
            const int r0 = 2 * rp, c0 = 16 * cb, qr = r0 + (r32 >> 4), qc = c0 + (r32 & 15), qrow = b * T + qr * GRW + qc;
#pragma unroll
            for (int kk = 0; kk < 4; ++kk) qf[kk] = *(const bf16x8*)(QA + (size_t)qrow * GW + hd * 64 + 16 * kk + 8 * h);
            const int rsq = clampi(qr - 4, 0, GRH - 8), csq = clampi(qc - 8, 0, GRW - 16);
            const int rsA = clampi(r0 - 4, 0, GRH - 8), rsB = clampi(r0 + 1 - 4, 0, GRH - 8), kc0 = clampi(c0 - 8, 0, GRW - 32);
            const float* rpb = C.in[I_NARPB] + ((size_t)l * NH + hd) * 465;
            const int nbn = rsB + 8 - rsA, nbt = nbn + TC / 32; KVregs cur; Kregs nxt;
#define NA_ROW(i) ((i) < nbn ? (size_t)b * T + (rsA + (i)) * GRW + kc0 : (size_t)M_LAT + b * TC + 32 * ((i) - nbn))
            { const size_t kr0 = NA_ROW(0); k_load(nxt, KA + kr0 * GW + hd * 64, GW, lane); }
            for (int ib = 0; ib < nbt; ++ib) {
                { const size_t kr0 = NA_ROW(ib); kv_load(cur, nxt, VA + kr0 * GW + hd * 64, GW, lane); }
                if (ib + 1 < nbt) { const size_t kr1 = NA_ROW(ib + 1); k_load(nxt, KA + kr1 * GW + hd * 64, GW, lane); }
                if (ib < nbn) { const int kr = rsA + ib; float addv[16]; unsigned vm = 0u; const bool rok = kr >= rsq && kr <= rsq + 7;
#pragma unroll
                    for (int i = 0; i < 16; ++i) { const int kb = (i & 3) + 8 * (i >> 2) + 4 * h, kc = kc0 + kb; const bool ok = rok && kc >= csq && kc <= csq + 15;
                        const int bi = ok ? (kr - qr + 7) * 31 + (kc - qc + 15) : 0; addv[i] = rpb[bi]; vm |= ok ? (1u << i) : 0u; }
                    attn_block<true>(st, qf, cur, vl, lane, addv, vm); }
                else attn_block<false>(st, qf, cur, vl, lane, zero16, 0xffffu); }
#undef NA_ROW
            attn_finish(st, OB + (size_t)qrow * D + hd * 64, lane, 0.f);
        } else if (tile < AT_NA + AT_WA) {
            const int t2 = tile - AT_NA, qb = t2 % (T / 32), hd = (t2 / (T / 32)) % NH, b = t2 / ((T / 32) * NH), kvh = hd / WAG;
            const int qt = 32 * qb + r32, qrow = b * T + qt;
#pragma unroll
            for (int kk = 0; kk < 4; ++kk) qf[kk] = *(const bf16x8*)(QC + (size_t)qrow * GW + hd * 64 + 16 * kk + 8 * h);
            const int i_lo = 4 - qb > 0 ? 4 - qb : 0, i_hi = (T / 32 - qb + 4) < 9 ? (T / 32 - qb + 4) : 9, nbw = i_hi - i_lo, nbt = nbw + TC / 32; KVregs cur; Kregs nxt;
#define WA_ROW(i) ((i) < nbw ? (size_t)b * T + 32 * qb - 128 + 32 * (i_lo + (i)) : (size_t)M_LAT + b * TC + 32 * ((i) - nbw))
            { const size_t kr0 = WA_ROW(0); k_load(nxt, KC + kr0 * 128 + kvh * 64, 128, lane); }
            for (int ib = 0; ib < nbt; ++ib) {
                { const size_t kr0 = WA_ROW(ib); kv_load(cur, nxt, VC + kr0 * 128 + kvh * 64, 128, lane); }
                if (ib + 1 < nbt) { const size_t kr1 = WA_ROW(ib + 1); k_load(nxt, KC + kr1 * 128 + kvh * 64, 128, lane); }
                if (ib < nbw) { const int t0 = 32 * qb - 128 + 32 * (i_lo + ib); float addv[16]; unsigned vm = 0u;
#pragma unroll
                    for (int i = 0; i < 16; ++i) { const int kt = t0 + (i & 3) + 8 * (i >> 2) + 4 * h, rel = kt - qt; addv[i] = 0.f; vm |= (rel >= -128 && rel <= 128) ? (1u << i) : 0u; }
                    attn_block<true>(st, qf, cur, vl, lane, addv, vm); }
                else attn_block<false>(st, qf, cur, vl, lane, zero16, 0xffffu); }
#undef WA_ROW
            const float sk = C.in[I_WASINK][(size_t)l * NH + hd];
            const float mfin = fmaxf(st.m, sk), a2 = __expf(st.m - mfin);
#pragma unroll
            for (int i = 0; i < 16; ++i) { st.o0[i] *= a2; st.o1[i] *= a2; }
            st.l *= a2; st.m = mfin;
            attn_finish(st, OB + (size_t)qrow * D + 2 * GW + hd * 64, lane, __expf(sk - mfin));
        } else {
            const int t2 = tile - AT_NA - AT_WA, isc = t2 >= AT_CX, t3 = t2 - isc * AT_CX, qb = t3 % (TC / 32), hd = (t3 / (TC / 32)) % NH, b = t3 / ((TC / 32) * NH), kvh = hd / WAG;
            const int qrow = M_LAT + b * TC + 32 * qb + r32;
            const bf16* Qs = isc ? QC : QA; const bf16* Ks = isc ? KC + kvh * 64 : KA + hd * 64; const bf16* Vs = isc ? VC + kvh * 64 : VA + hd * 64; const int kp = isc ? 128 : GW;
#pragma unroll
            for (int kk = 0; kk < 4; ++kk) qf[kk] = *(const bf16x8*)(Qs + (size_t)qrow * GW + hd * 64 + 16 * kk + 8 * h);
            { KVregs cur; Kregs nxt; const size_t kr0 = (size_t)M_LAT + b * TC; k_load(nxt, Ks + kr0 * kp, kp, lane);
              for (int cbk = 0; cbk < TC / 32; ++cbk) { kv_load(cur, nxt, Vs + (kr0 + 32 * cbk) * kp, kp, lane); if (cbk + 1 < TC / 32) k_load(nxt, Ks + (kr0 + 32 * (cbk + 1)) * kp, kp, lane);
                  attn_block<false>(st, qf, cur, vl, lane, zero16, 0xffffu); } }
            float extra = 0.f;
            if (isc) { const float sk = C.in[I_WASINK][(size_t)l * NH + hd]; const float mfin = fmaxf(st.m, sk), a2 = __expf(st.m - mfin);
#pragma unroll
                for (int i = 0; i < 16; ++i) { st.o0[i] *= a2; st.o1[i] *= a2; }
                st.l *= a2; st.m = mfin; extra = __expf(sk - mfin); }
            attn_finish(st, OB + (size_t)qrow * D + (isc ? 2 * GW : 0) + hd * 64, lane, extra);
        }
    }
}

DI void ph_ctxfix(const Ctx& C, const float* gsn  , float* rowss_next) {
    const int gw = C.bid * NW + C.wave, GWV = C.G * NW;
    for (int r = gw; r < M_CTX; r += GWV) { const int row = M_LAT + r; const float* xp = xrow_ptr(C, row); const float* gs = gsn + (size_t)NB * D; bf16* ap = (bf16*)(C.ws + WS_AP) + (size_t)row * D; float ss = 0.f;
        for (int c = 4 * C.lane; c < D; c += 256) { const f32x4 x = *(const f32x4*)(xp + c); ss += (x[0] * x[0] + x[1] * x[1]) + (x[2] * x[2] + x[3] * x[3]);
            const f32x4 a = x * *(const f32x4*)(gs + c); u32x2 w; w.x = pk2(a[0], a[1]); w.y = pk2(a[2], a[3]); *(u32x2*)(ap + c) = w; }
        ss = wave_sum(ss); if (C.lane == 0) rowss_next[row] = ss; }
}
constexpr int PT = 144;
constexpr int RW_HALF = 73472, IM_BT = 0, IM_KT = 9216, IM_RT = 18432, IM_ARB = 27648, IM_AT = 36864, IM_AAK = 46080, IM_F = 55296, IM_GC = 72704, FP = 68;
DI void chunk_rows(int b, int dir, int c, int& row0, int& step) {
    if (c < TC / 64) { const int p0 = 64 * c; row0 = M_LAT + b * TC + (dir ? TC - 1 - p0 : p0); } else { const int p0 = 64 * (c - TC / 64); row0 = b * T + (dir ? T - 1 - p0 : p0); }
    step = dir ? -1 : 1;
}
DI bf16x8 frag_rows(const LAS unsigned char* img, int tile, int s, int lane) { return *(const LAS bf16x8*)(img + (32 * tile + (lane & 31)) * PT + (16 * s + 8 * (lane >> 5)) * 2); }
DI bf16x8 frag_cols(const LAS unsigned char* img, int tile, int s, int lane) {
    const int h = lane >> 5, q = (lane & 15) >> 2, p4 = lane & 3, blk = (lane >> 4) & 1;
    const LAS unsigned char* a0 = img + (16 * s + 8 * h + q) * PT + (32 * tile + 16 * blk) * 2 + 8 * p4;
    return tr_frag(a0, 4 * PT);
}
DI void store_T(const f32x16& acc, LAS unsigned char* img, int ti, int tj, int lane) {
    const int c = lane & 31, h = lane >> 5;
#pragma unroll
    for (int g = 0; g < 4; ++g) { u32x2 w; w.x = pk2(acc[4 * g], acc[4 * g + 1]); w.y = pk2(acc[4 * g + 2], acc[4 * g + 3]); *(LAS u32x2*)(img + (32 * tj + c) * PT + (32 * ti + 8 * g + 4 * h) * 2) = w; }
}
DI f32x16 zero16v() { f32x16 z;
#pragma unroll
    for (int i = 0; i < 16; ++i) z[i] = 0.f; return z; }
#define MMA32(a, b, c) __builtin_amdgcn_mfma_f32_32x32x16_bf16((a), (b), (c), 0, 0, 0)
constexpr int PDW = 80, PDG = 208, IM_TW = 0, IM_TA = 17408, IM_DW = 36864, IM_DA = 41984, IM_DG = 47104;
DI void ph_rw1(const Ctx& C, int l) {
    const int wg = C.wave & 3, grp = C.wave >> 2, ti = wg >> 1, tj = wg & 1;
    bf16* QH = (bf16*)(C.ws + WS_QH); float* YL = (float*)(C.ws + WS_YL); bf16* MF = (bf16*)(C.ws + WS_MF); float* GF = (float*)(C.ws + WS_GF); bf16* RVKG = (bf16*)(C.ws + WS_RVKG);
    const bf16* PB = (const bf16*)(C.ws + WS_PB); const float* PS = (const float*)(C.ws + WS_PS);
    const bf16x8* RWF = (const bf16x8*)(C.ws + WS_RWF + (size_t)l * SZ_RWF);
    constexpr int nblk = (TC + T) / 64;
    for (int it0 = 2 * C.bid; it0 < RBLK; it0 += 2 * C.G) {
        int lane_ = threadIdx.x & 63; OPAQUE(lane_); const int lane = lane_, c32 = lane & 31, h = lane >> 5;
        LAS unsigned char* L = OPAQUE_LDS(C.lds + grp * RW_HALF);
        LAS float* F = (LAS float*)(L + IM_F); LAS float* SEG = (LAS float*)(L + IM_F); LAS float* GC = (LAS float*)(L + IM_GC);
        LAS float* TW = (LAS float*)(L + IM_TW); LAS float* TA = (LAS float*)(L + IM_TA);
        unsigned char* PK = C.ws + WS_RWS + ((size_t)C.bid * 2 + grp) * 65536;
        const int item = it0 + grp; const bool live = item < RBLK; const int itc = live ? item : RBLK - 1;
        const int tb = itc % nblk, hd = (itc / nblk) % NH, b = itc / (nblk * NH), cg = hd * 64 + lane;
        const int rowb = tb < TC / 64 ? M_LAT + b * TC + 64 * tb : b * T + 64 * (tb - TC / 64);
        const int seq_lo = tb < TC / 64 ? M_LAT + b * TC : b * T, seq_hi = seq_lo + (tb < TC / 64 ? TC : T);
        bf16* RV = RVKG + (size_t)itc * 4 * 4096;
        __syncthreads();
        float r_[16], kf_[16], kk_[16], ks_[16];
        { const float* cw = C.in[I_RWCONV] + (size_t)l * 9 * GW; float cwv[3][3];
#pragma unroll
          for (int j = 0; j < 3; ++j)
#pragma unroll
              for (int x = 0; x < 3; ++x) cwv[j][x] = cw[(size_t)j * 3 * GW + x * GW + cg];
          const float kkw = C.in[I_RWKK][(size_t)l * GW + cg];
          const int r0 = rowb + 16 * wg; float pr[3], cu[3], nx[3];
#pragma unroll
          for (int x = 0; x < 3; ++x) { pr[x] = r0 - 1 >= seq_lo ? bf2f(PB[(size_t)(r0 - 1) * 3 * GW + x * GW + cg]) : 0.f; cu[x] = bf2f(PB[(size_t)r0 * 3 * GW + x * GW + cg]); }
#pragma unroll
          for (int t = 0; t < 16; ++t) { const int row = r0 + t;
#pragma unroll
              for (int x = 0; x < 3; ++x) nx[x] = row + 1 < seq_hi ? bf2f(PB[(size_t)(row + 1) * 3 * GW + x * GW + cg]) : 0.f;
              r_[t] = pr[0] * cwv[0][0] + cu[0] * cwv[1][0] + nx[0] * cwv[2][0]; kf_[t] = pr[1] * cwv[0][1] + cu[1] * cwv[1][1] + nx[1] * cwv[2][1]; const float v_t = pr[2] * cwv[0][2] + cu[2] * cwv[1][2] + nx[2] * cwv[2][2];
#pragma unroll
              for (int x = 0; x < 3; ++x) { pr[x] = cu[x]; cu[x] = nx[x]; }
              const float kkv = kf_[t] * kkw, ssq = wave_sum(kkv * kkv); kk_[t] = kkv / fmaxf(sqrtf(ssq), 1e-12f); ks_[t] = 0.f;
              RV[(16 * wg + t) * 64 + lane] = (bf16)f2bf(r_[t]); RV[4096 + (16 * wg + t) * 64 + lane] = (bf16)f2bf(v_t);
#pragma unroll
              for (int kq = 0; kq < 3; ++kq) { const int k = lane + 64 * kq; if (k < 160) { const float pv = PS[(size_t)row * 160 + k]; const int tk = 16 * wg + t;
                  if (k < 32) *(LAS bf16*)(L + IM_DW + tk * PDW + k * 2) = (bf16)f2bf(tanhf(pv)); else if (k < 64) *(LAS bf16*)(L + IM_DA + tk * PDW + (k - 32) * 2) = (bf16)f2bf(pv); else *(LAS bf16*)(L + IM_DG + tk * PDG + (k - 64) * 2) = (bf16)f2bf(sigmf(pv)); } }
          }
        }
        __syncthreads();
        { f32x16 gacc = zero16v();
#pragma unroll
          for (int sx = 0; sx < 6; ++sx) gacc = MMA32(*(const LAS bf16x8*)(L + IM_DG + (32 * ti + c32) * PDG + (16 * sx + 8 * h) * 2), RWF[(((8 + sx) * NH + hd) * 2 + tj) * 64 + lane], gacc);
#pragma unroll
          for (int rg = 0; rg < 16; ++rg) { const int tk = 32 * ti + (rg & 3) + 8 * (rg >> 2) + 4 * h; RV[3 * 4096 + tk * 64 + 32 * tj + c32] = (bf16)f2bf(gacc[rg]); }
        }
        const float kaw = C.in[I_RWKA][(size_t)l * GW + cg];
#pragma unroll
        for (int pss = 0; pss < 2; ++pss) {
            const int dir = 1 - pss;
            __syncthreads();
            { f32x16 pw = zero16v(), pa = zero16v();
#pragma unroll
              for (int sx = 0; sx < 2; ++sx) { pw = MMA32(*(const LAS bf16x8*)(L + IM_DW + (32 * ti + c32) * PDW + (16 * sx + 8 * h) * 2), RWF[(((0 + 2 * dir + sx) * NH + hd) * 2 + tj) * 64 + lane], pw);
                                              pa = MMA32(*(const LAS bf16x8*)(L + IM_DA + (32 * ti + c32) * PDW + (16 * sx + 8 * h) * 2), RWF[(((4 + 2 * dir + sx) * NH + hd) * 2 + tj) * 64 + lane], pa); }
              const float w0 = C.in[I_RWW0][((size_t)l * 2 + dir) * GW + hd * 64 + 32 * tj + c32], a0 = C.in[I_RWA0][((size_t)l * 2 + dir) * GW + hd * 64 + 32 * tj + c32];
#pragma unroll
              for (int rg = 0; rg < 16; ++rg) { const int tk = 32 * ti + (rg & 3) + 8 * (rg >> 2) + 4 * h; const float z = -(w0 + pw[rg]), sp = z > 20.f ? z : log1pf(__expf(z));
                  TW[tk * FP + 32 * tj + c32] = -__expf(-sp - 0.5f); TA[tk * FP + 32 * tj + c32] = sigmf(a0 + pa[rg]); } }
            __syncthreads();
            const int cs = dir ? 3 - wg : wg;
            float lw[16], av[16], run = 0.f;
#pragma unroll
            for (int ii = 0; ii < 16; ++ii) { const int tl = dir ? 15 - ii : ii, tk = 16 * wg + tl; av[ii] = TA[tk * FP + lane]; run += TW[tk * FP + lane]; lw[ii] = run; }
            __syncthreads();
            SEG[cs * 64 + lane] = run;
            __syncthreads();
            float off = 0.f;
#pragma unroll
            for (int w2 = 0; w2 < 3; ++w2) off += (w2 < cs) ? SEG[w2 * 64 + lane] : 0.f;
            const float tot = SEG[lane] + SEG[64 + lane] + SEG[128 + lane] + SEG[192 + lane];
            if (wg == 0) { if (dir) ((float*)(PK + 32768))[lane] = __expf(tot); else GC[lane] = __expf(tot); }
#pragma unroll
            for (int ii = 0; ii < 16; ++ii) { const int tl = dir ? 15 - ii : ii, i = 16 * cs + ii;
                const float Li = lw[ii] + off, eL = __expf(Li), ieL = __builtin_amdgcn_rcpf(eL), eLm = __expf(Li - (lw[ii] - (ii ? lw[ii - 1] : 0.f)));
                const float a = av[ii], kd = kf_[tl] * (1.f + (a - 1.f) * kaw); ks_[tl] += kd;
                const bf16 vat = (bf16)f2bf(-kk_[tl] * eLm), vbt = (bf16)f2bf(kk_[tl] * a * ieL), vkt = (bf16)f2bf(kd * ieL), vrt = (bf16)f2bf(r_[tl] * eL);
                if (dir) { bf16* pk = (bf16*)PK + i * 64 + lane; pk[0] = vat; pk[4096] = vbt; pk[8192] = vkt; pk[12288] = vrt; }
                else { *(LAS bf16*)(L + IM_AT + i * PT + lane * 2) = vat; *(LAS bf16*)(L + IM_BT + i * PT + lane * 2) = vbt; *(LAS bf16*)(L + IM_KT + i * PT + lane * 2) = vkt; *(LAS bf16*)(L + IM_RT + i * PT + lane * 2) = vrt; } }
        }
#pragma unroll
        for (int t = 0; t < 16; ++t) RV[2 * 4096 + (16 * wg + t) * 64 + lane] = (bf16)f2bf(ks_[t]);
#pragma unroll 1
        for (int dir = 0; dir < 2; ++dir) {
            const int c = dir == 0 ? tb : (tb < TC / 64 ? TC / 64 - 1 - tb : TC / 64 + (T / 64 - 1 - (tb - TC / 64)));
            const size_t ci = ((size_t)((b * NH + hd) * 2 + dir)) * RCK + c;
            __syncthreads();
            if (dir) {
                const int tg = wg * 64 + lane;
#pragma unroll
                for (int im = 0; im < 4; ++im)
#pragma unroll
                    for (int rr = 0; rr < 2; ++rr) { const int idx = tg + 256 * rr, row = idx >> 3, ch = idx & 7; const int dsto = im == 0 ? IM_AT : im == 1 ? IM_BT : im == 2 ? IM_KT : IM_RT;
                        *(LAS u32x4*)(L + dsto + row * PT + ch * 16) = *(const u32x4*)(PK + im * 8192 + row * 128 + ch * 16); }
                if (wg == 0) GC[lane] = ((const float*)(PK + 32768))[lane];
                __syncthreads();
            }
            f32x16 accP;
            { f32x16 aab = zero16v(), aak = zero16v(), arb = zero16v(); accP = zero16v();
#pragma unroll
              for (int s = 0; s < 4; ++s) { const bf16x8 at_i = frag_rows(L + IM_AT, ti, s, lane), bt_j = frag_rows(L + IM_BT, tj, s, lane), kt_j = frag_rows(L + IM_KT, ti, s, lane), at_c = frag_rows(L + IM_AT, tj, s, lane),
                                              bt_r = frag_rows(L + IM_BT, ti, s, lane), rt_c = frag_rows(L + IM_RT, tj, s, lane);
                  aab = MMA32(at_i, bt_j, aab); aak = MMA32(kt_j, at_c, aak); arb = MMA32(bt_r, rt_c, arb); accP = MMA32(kt_j, rt_c, accP); }
#pragma unroll
              for (int r = 0; r < 16; ++r) { const int row = 32 * ti + (r & 3) + 8 * (r >> 2) + 4 * h, col = 32 * tj + c32;
                  F[row * FP + col] = col < row ? aab[r] : 0.f; aak[r] = row < col ? aak[r] : 0.f; arb[r] = row <= col ? arb[r] : 0.f; accP[r] = row <= col ? accP[r] : 0.f; }
              store_T(aak, L + IM_AAK, ti, tj, lane);
              store_T(arb, L + IM_ARB, ti, tj, lane); }
            __syncthreads();
            { float Wc[64]; const int col = 32 * wg + c32; const LAS unsigned char* src = col < 64 ? L + IM_AT + col * 2 : L + IM_AAK + (col - 64) * 2;
              const LAS float* Fo = OPAQUE_LDS(F);
#pragma unroll
              for (int i = 0; i < 64; ++i) Wc[i] = bf2f(*(const LAS bf16*)(src + i * PT));
#pragma unroll
              for (int i = 1; i < 64; ++i) { float a0 = Wc[i], a1 = 0.f, a2 = 0.f, a3 = 0.f;
#pragma unroll
                  for (int j4 = 0; j4 < (i + 3) / 4; ++j4) { const f32x4 f = *(const LAS f32x4*)(Fo + i * FP + 4 * j4); a0 += f[0] * Wc[4 * j4]; a1 += f[1] * Wc[4 * j4 + 1]; a2 += f[2] * Wc[4 * j4 + 2]; a3 += f[3] * Wc[4 * j4 + 3];
                      if ((j4 & 7) == 7) PIN4(a0, a1, a2, a3); }
                  PIN4(a0, a1, a2, a3); Wc[i] = (a0 + a1) + (a2 + a3); }
              __syncthreads();
              if (h == 0) { LAS unsigned char* dst = (col < 64 ? L + IM_AT + col * PT : L + IM_AAK + (col - 64) * PT);
#pragma unroll
                  for (int i8 = 0; i8 < 8; ++i8) { u32x4 w; w.x = pk2(Wc[8 * i8], Wc[8 * i8 + 1]); w.y = pk2(Wc[8 * i8 + 2], Wc[8 * i8 + 3]); w.z = pk2(Wc[8 * i8 + 4], Wc[8 * i8 + 5]); w.w = pk2(Wc[8 * i8 + 6], Wc[8 * i8 + 7]); *(LAS u32x4*)(dst + i8 * 16) = w; } }
#pragma unroll
              for (int ii = 0; ii < 16; ++ii) { const int tl = dir ? 15 - ii : ii, i = 16 * (dir ? 3 - wg : wg) + ii; *(LAS bf16*)(L + IM_F + i * PT + lane * 2) = RV[4096 + (16 * wg + tl) * 64 + lane]; }
            }
            __syncthreads();
            { f32x16 q;
#pragma unroll
              for (int g = 0; g < 4; ++g) { const u32x2 w = *(const LAS u32x2*)(L + IM_RT + (32 * tj + c32) * PT + (32 * ti + 8 * g + 4 * h) * 2); q[4 * g] = bflo(w.x); q[4 * g + 1] = bfhi(w.x); q[4 * g + 2] = bflo(w.y); q[4 * g + 3] = bfhi(w.y); }
#pragma unroll
              for (int s = 0; s < 4; ++s) { const bf16x8 arb = frag_rows(L + IM_ARB, tj, s, lane); q = MMA32(frag_rows(L + IM_AT, ti, s, lane), arb, q); accP = MMA32(frag_rows(L + IM_AAK, ti, s, lane), arb, accP); }
              if (live) {
#pragma unroll
                  for (int g = 0; g < 4; ++g) { u32x2 w; w.x = pk2(q[4 * g], q[4 * g + 1]); w.y = pk2(q[4 * g + 2], q[4 * g + 3]); *(u32x2*)(QH + ci * 4096 + (32 * tj + c32) * 64 + 32 * ti + 8 * g + 4 * h) = w; } }
            }
            __syncthreads();
            store_T(accP, L + IM_RT, ti, tj, lane);
            __syncthreads();
            { f32x16 y = zero16v(), m = zero16v(), n;
#pragma unroll
              for (int g = 0; g < 4; ++g) { const u32x2 w = *(const LAS u32x2*)(L + IM_KT + (32 * tj + c32) * PT + (32 * ti + 8 * g + 4 * h) * 2); n[4 * g] = bflo(w.x); n[4 * g + 1] = bfhi(w.x); n[4 * g + 2] = bflo(w.y); n[4 * g + 3] = bfhi(w.y); }
#pragma unroll
              for (int s = 0; s < 4; ++s) { const bf16x8 btc_j = frag_cols(L + IM_BT, tj, s, lane), btc_i = frag_cols(L + IM_BT, ti, s, lane);
                  y = MMA32(frag_rows(L + IM_RT, ti, s, lane), frag_cols(L + IM_F, tj, s, lane), y);
                  m = MMA32(frag_rows(L + IM_AT, ti, s, lane), btc_j, m);
                  n = MMA32(btc_i, frag_rows(L + IM_AAK, tj, s, lane), n); }
              const float gck = GC[32 * tj + c32];
#pragma unroll
              for (int r = 0; r < 16; ++r) { const int row = 32 * ti + (r & 3) + 8 * (r >> 2) + 4 * h, col = 32 * tj + c32; m[r] = (m[r] + (row == col ? 1.0f : 0.f)) * gck; n[r] *= GC[row]; }
              if (live) {
#pragma unroll
                  for (int g = 0; g < 4; ++g) *(f32x4*)(YL + ci * 4096 + ((wg * 4 + g) * 64 + lane) * 4) = (f32x4){y[4 * g], y[4 * g + 1], y[4 * g + 2], y[4 * g + 3]};
#pragma unroll
                  for (int s2 = 0; s2 < 2; ++s2) *(bf16x8*)(MF + ci * 4096 + ((wg * 2 + s2) * 64 + lane) * 8) = pack8(m, s2); }
              store_T(n, L + IM_ARB, ti, tj, lane);
            }
            __syncthreads();
            { f32x16 gacc = zero16v();
#pragma unroll
              for (int s = 0; s < 4; ++s) gacc = MMA32(frag_cols(L + IM_ARB, ti, s, lane), frag_cols(L + IM_F, tj, s, lane), gacc);
              if (live) {
#pragma unroll
                  for (int g = 0; g < 4; ++g) *(f32x4*)(GF + ci * 4096 + ((wg * 4 + g) * 64 + lane) * 4) = (f32x4){gacc[4 * g], gacc[4 * g + 1], gacc[4 * g + 2], gacc[4 * g + 3]}; }
            }
        }
    }
    __syncthreads();
}
DI void ph_rw2(const Ctx& C) {
    const int lane = C.lane;
    const bf16* MF = (const bf16*)(C.ws + WS_MF); const float* GF = (const float*)(C.ws + WS_GF); bf16* SF = (bf16*)(C.ws + WS_SF);
    const int nwork = RSTR * 2;
    for (int wk = C.wave == 0 ? C.bid : nwork; wk < nwork; wk += C.G) {
        const int tj = wk & 1, stream = wk >> 1;
        f32x16 s0 = zero16v(), s1 = zero16v();
        bf16x8 mf[2][2][2]; f32x4 gq[2][4];
#define RW2_LOAD(item_) do { const size_t it_ = (item_); \
            _Pragma("unroll") for (int kp = 0; kp < 2; ++kp) _Pragma("unroll") for (int kt = 0; kt < 2; ++kt) _Pragma("unroll") for (int s = 0; s < 2; ++s) mf[kp][kt][s] = *(const bf16x8*)(MF + it_ * 4096 + (((kp * 2 + kt) * 2 + s) * 64 + lane) * 8); \
            _Pragma("unroll") for (int kt = 0; kt < 2; ++kt) _Pragma("unroll") for (int g = 0; g < 4; ++g) gq[kt][g] = *(const f32x4*)(GF + it_ * 4096 + (((kt * 2 + tj) * 4 + g) * 64 + lane) * 4); } while (0)
        RW2_LOAD((size_t)stream * RCK);
        for (int c = 0; c < RCK; ++c) {
            const size_t item = (size_t)stream * RCK + c;
            bf16x8 sf[2][2];
#pragma unroll
            for (int s = 0; s < 2; ++s) { sf[0][s] = pack8(s0, s); sf[1][s] = pack8(s1, s); *(bf16x8*)(SF + item * 4096 + (((0 * 2 + tj) * 2 + s) * 64 + lane) * 8) = sf[0][s]; *(bf16x8*)(SF + item * 4096 + (((1 * 2 + tj) * 2 + s) * 64 + lane) * 8) = sf[1][s]; }
            f32x16 n0, n1;
#pragma unroll
            for (int g = 0; g < 4; ++g) { n0[4 * g] = gq[0][g][0]; n0[4 * g + 1] = gq[0][g][1]; n0[4 * g + 2] = gq[0][g][2]; n0[4 * g + 3] = gq[0][g][3]; n1[4 * g] = gq[1][g][0]; n1[4 * g + 1] = gq[1][g][1]; n1[4 * g + 2] = gq[1][g][2]; n1[4 * g + 3] = gq[1][g][3]; }
            bf16x8 mc[2][2][2];
#pragma unroll
            for (int kp = 0; kp < 2; ++kp)
#pragma unroll
                for (int kt = 0; kt < 2; ++kt)
#pragma unroll
                    for (int s = 0; s < 2; ++s) mc[kp][kt][s] = mf[kp][kt][s];
            if (c + 1 < RCK) RW2_LOAD(item + 1);
#pragma unroll
            for (int kp = 0; kp < 2; ++kp)
#pragma unroll
                for (int s = 0; s < 2; ++s) { n0 = MMA32(mc[kp][0][s], sf[kp][s], n0); n1 = MMA32(mc[kp][1][s], sf[kp][s], n1); }
            s0 = n0; s1 = n1;
        }
#undef RW2_LOAD
    }
}
DI void ph_rw3(const Ctx& C, int l, int mrows) {
    const int lane = C.lane, wg = C.wave & 3, grp = C.wave >> 2, ti = wg >> 1, tj = wg & 1, c32 = lane & 31, h = lane >> 5;
    LAS float* Ysum = (LAS float*)(C.lds + grp * RW_HALF);
    const bf16* QH = (const bf16*)(C.ws + WS_QH); const float* YL = (const float*)(C.ws + WS_YL); const bf16* SF = (const bf16*)(C.ws + WS_SF); bf16* OB = (bf16*)(C.ws + WS_OB);
    const int nblk = (TC + T) / 64, nitems = NB * NH * nblk;
    for (int it0 = 2 * C.bid; it0 < nitems; it0 += 2 * C.G) {
        const int item = it0 + grp; const bool live = item < nitems; const int itc = live ? item : nitems - 1;
        const int tb = itc % nblk, hd = (itc / nblk) % NH, b = itc / (nblk * NH);
        const int rowb = tb < TC / 64 ? M_LAT + b * TC + 64 * tb : b * T + 64 * (tb - TC / 64);
        __syncthreads();
        f32x4 yl[2][4]; u32x4 qa[2][4]; bf16x8 sb[2][4];
#pragma unroll
        for (int dir = 0; dir < 2; ++dir) {
            const int c = dir == 0 ? tb : (tb < TC / 64 ? TC / 64 - 1 - tb : TC / 64 + (T / 64 - 1 - (tb - TC / 64)));
            const size_t ci = ((size_t)((b * NH + hd) * 2 + dir)) * RCK + c;
#pragma unroll
            for (int g = 0; g < 4; ++g) yl[dir][g] = *(const f32x4*)(YL + ci * 4096 + ((wg * 4 + g) * 64 + lane) * 4);
#pragma unroll
            for (int kp = 0; kp < 2; ++kp)
#pragma unroll
                for (int s = 0; s < 2; ++s) { const bf16* qp = QH + ci * 4096 + (32 * ti + c32) * 64 + 32 * kp + 16 * s + 4 * h; const u32x2 lo = *(const u32x2*)qp, hi = *(const u32x2*)(qp + 8);
                    qa[dir][kp * 2 + s].x = lo.x; qa[dir][kp * 2 + s].y = lo.y; qa[dir][kp * 2 + s].z = hi.x; qa[dir][kp * 2 + s].w = hi.y;
                    sb[dir][kp * 2 + s] = *(const bf16x8*)(SF + ci * 4096 + (((kp * 2 + tj) * 2 + s) * 64 + lane) * 8); }
        }
#pragma unroll
        for (int dir = 0; dir < 2; ++dir) {
            f32x16 y;
#pragma unroll
            for (int g = 0; g < 4; ++g) { const f32x4 a = yl[dir][g]; y[4 * g] = a[0]; y[4 * g + 1] = a[1]; y[4 * g + 2] = a[2]; y[4 * g + 3] = a[3]; }
#pragma unroll
            for (int q4 = 0; q4 < 4; ++q4) y = MMA32(__builtin_bit_cast(bf16x8, qa[dir][q4]), sb[dir][q4], y);
#pragma unroll
            for (int r = 0; r < 16; ++r) { const int i = 32 * ti + (r & 3) + 8 * (r >> 2) + 4 * h, tk = dir ? 63 - i : i; LAS float* p = Ysum + tk * FP + 32 * tj + c32; if (dir == 0) *p = y[r]; else *p += y[r]; }
            __syncthreads();
        }
        if (live) {
            const int cch = hd * 64 + lane; const float rk = C.in[I_RWRK][((size_t)l * NH + hd) * 64 + lane], gw = C.in[I_RWGNW][(size_t)l * GW + cch], gb = C.in[I_RWGNB][(size_t)l * GW + cch];
#pragma unroll 1
            for (int t4 = 0; t4 < 16; t4 += 8) {
                bf16 rb[8], vb[8], kb[8], gb8[8];
#pragma unroll
                for (int u = 0; u < 8; ++u) { const bf16* rv = (const bf16*)(C.ws + WS_RVKG) + (size_t)item * 4 * 4096 + (16 * wg + t4 + u) * 64 + lane; rb[u] = rv[0]; vb[u] = rv[4096]; kb[u] = rv[8192]; gb8[u] = rv[12288]; }
#pragma unroll
                for (int u = 0; u < 8; ++u) { const int tk = 16 * wg + t4 + u, row = rowb + tk; const float r = bf2f(rb[u]), v = bf2f(vb[u]), ks = bf2f(kb[u]), gg = bf2f(gb8[u]);
                    float y = Ysum[tk * FP + lane] + wave_sum(r * ks * rk) * v;
                    const float mu = wave_sum(y) * (1.f / 64.f), dlt = y - mu, var = wave_sum(dlt * dlt) * (1.f / 64.f);
                    if (row < mrows) OB[(size_t)row * D + GW + cch] = (bf16)f2bf((dlt * __builtin_amdgcn_rsqf(var + RW_GN_EPS) * gw + gb) * gg); } }
        }
    }
    __syncthreads();
}
DI void ph_s5scan(const Ctx& C, int l, int first_block) {
    const int nthreads_total = NB * 2 * S5G * 64;
    if (C.bid < first_block) return;
    const float* XE = (const float*)(C.ws + WS_XEND); bf16* UG = (bf16*)(C.ws + WS_UG);
    const f32x2* LAM = (const f32x2*)(C.ws + WS_S5T + (size_t)l * SZ_S5L + OFF_S5LAM);
    for (int id = (C.bid - first_block) * NTHR + C.tid; id < nthreads_total; id += (C.G - first_block) * NTHR) {
        const int n = id & 63, g = (id >> 6) % S5G, dir = (id / (64 * S5G)) & 1, b = id / (128 * S5G);
        const f32x2 lm = LAM[(dir * S5G + g) * 64 + n]; float xr = 0.f, xi = 0.f;
        const int nc_ctx = TC / S5L, nc_lat = T / S5L, ntot = nc_ctx + nc_lat;
        for (int i0 = 0; i0 < ntot; i0 += 8) {
            float er[8], ei[8]; int chs[8];
#pragma unroll
            for (int u = 0; u < 8; ++u) { const int i = i0 + u; int ch;
                if (i < nc_ctx) ch = (M_LAT + b * TC) / S5L + (dir ? nc_ctx - 1 - i : i); else ch = (b * T) / S5L + (dir ? nc_lat - 1 - (i - nc_ctx) : (i - nc_ctx));
                chs[u] = ch; const float* p = XE + ((size_t)g * NCHP + ch) * 256 + dir * 128 + n; er[u] = p[0]; ei[u] = p[64]; }
#pragma unroll
            for (int u = 0; u < 8; ++u) { bf16* q = UG + ((size_t)g * NCHP + chs[u]) * S5K + 512 + dir * 128 + n; q[0] = (bf16)f2bf(xr); q[64] = (bf16)f2bf(xi);
                const float nr = lm[0] * xr - lm[1] * xi + er[u], ni = lm[0] * xi + lm[1] * xr + ei[u]; xr = nr; xi = ni; }
        }
    }
}

constexpr int PH_PRO = 3, PH_PER_L = 13, NPH = PH_PRO + PH_PER_L * NL;
#ifndef PROBE_REP
#define PROBE_REP -1
#endif
#define NREP(k) ((k) == PROBE_REP ? 2 : 1)
#ifdef ONLY
#define EN(k) ((k) == ONLY)
#else
#define EN(k) true
#endif
#ifdef EMU
void fwd(Args args) {
    unsigned char* lds = emu::lds_base();
#else
__global__ void __launch_bounds__(NTHR, 2) fwd(Args args) {
    extern __shared__ __attribute__((aligned(16))) unsigned char lds[];
#endif
    Ctx C; C.in = args.in; C.out = args.out; C.ws = args.ws; C.lds = (LAS unsigned char*)lds;
    C.tid = threadIdx.x; C.lane = C.tid & 63; C.wave = __builtin_amdgcn_readfirstlane(C.tid >> 6); C.G = gridDim.x; C.bid = blockIdx.x;
#define REFRESH() do { int t_ = threadIdx.x; OPAQUE(t_); C.tid = t_; C.lane = t_ & 63; C.wave = __builtin_amdgcn_readfirstlane(t_ >> 6); } while (0)
    volatile LAS unsigned* MISC = (volatile LAS unsigned*)(C.lds + MISC_OFF);
    if (C.tid < 32) MISC[C.tid] = 0u;
    __syncthreads();
    const int lo = args.ph_lo, hi = args.ph_hi;
    const bool use_bar = (hi - lo) > 1;
    XcdBarrier bar; bar.bar = (unsigned*)(C.ws + WS_CTL) + CW_BAR; bar.x = 0; bar.st = MISC + 8;
    if (use_bar) bar = xcd_barrier_post((unsigned*)(C.ws + WS_CTL) + CW_BAR, MISC + 8);
#define IN(k) (lo <= (k) && (k) < hi)
#define SEAM(k) do { if (IN(k) && IN((k) + 1)) xcd_barrier(bar); } while (0)
    if (EN(0) && IN(0)) for (int rep = 0; rep < NREP(0); ++rep) { REFRESH(); ph_ada(C); }
    SEAM(0);
    if (EN(1) && IN(1)) { REFRESH(); ph_conv(C); }
    SEAM(1);
    if (EN(2) && IN(2)) for (int rep = 0; rep < NREP(2); ++rep) { REFRESH(); ph_tab(C); }
    SEAM(2);
    for (int l = 0; l < NL; ++l) {
        const int pb = PH_PRO + PH_PER_L * l; const bool want_ctx = l < NL - 1;
        const int mrows_full = M, mrows_out = want_ctx ? M : M_LAT;
        bf16* AP = (bf16*)(C.ws + WS_AP); bf16* Hb = (bf16*)(C.ws + WS_H); bf16* OB = (bf16*)(C.ws + WS_OB);
        if (EN(3) && IN(pb + 0)) for (int rep = 0; rep < NREP(3); ++rep) { REFRESH();
            Gemm g{AP, wl(C, l, OFF_W1GU), D, D, D, 0, 0}; Order S; S.init(mrows_full / 256, 2 * FF / 256, 1, C.G, C.bid, D / 64);
            EpiGU E{rowss_ptr(C, l, 0), bias_ptr(C, l, 0), Hb, mrows_full}; gemm_phase(C.lds, g, S, E); }
        SEAM(pb + 0);
        if (EN(4) && IN(pb + 1)) { REFRESH();
            Gemm g{Hb, wl(C, l, OFF_W1D), FF, FF, FF, 0, 0}; Order S; S.init(M_LAT / 256, D / 256, 1, C.G, C.bid, FF / 64);
            EpiRes E{&C, gate_ptr(C, l, 0, 0), gs_ptr(C, l, 1, 0), rowss_ptr(C, l, 1), AP}; gemm_phase(C.lds, g, S, E);
            { REFRESH(); Order S2; S2.init_split(M_LAT / 256, M_CTX / 256, D / 256, 4, C.G, C.bid, FF / 64); EpiAcc E2{&C, gate_ptr(C, l, 0, 0)}; gemm_phase(C.lds, g, S2, E2); } }
        SEAM(pb + 1);
        if (EN(18) && IN(pb + 2)) { REFRESH(); ph_ctxfix(C, gs_ptr(C, l, 1, 0), rowss_ptr(C, l, 1)); }
        SEAM(pb + 2);
        if (EN(5) && IN(pb + 3)) for (int rep = 0; rep < NREP(5); ++rep) { REFRESH();
            Gemm g{AP, wl(C, l, OFF_WIN), D, D, D, 0, 0}; Order S; S.init(mrows_full / 256, NT_IN, 1, C.G, C.bid, D / 64);
            EpiIn E{&C, rowss_ptr(C, l, 1), bias_ptr(C, l, 1), l}; gemm_phase(C.lds, g, S, E); }
        SEAM(pb + 3);
        if (IN(pb + 4)) {
            if (EN(6)) for (int rep = 0; rep < NREP(6); ++rep) { REFRESH(); Gemm g{(const bf16*)(C.ws + WS_UG), (const bf16*)(C.ws + WS_S5T + (size_t)l * SZ_S5L + OFF_S5ET), S5K, 512, 512, (size_t)NCHP * S5K * 2, (size_t)256 * 512 * 2};
              Order S; S.init(NCHP / 256, 1, S5G, C.G, C.bid, 512 / 64); EpiS5A E{(float*)(C.ws + WS_XEND)}; gemm_phase(C.lds, g, S, E); }
            __syncthreads();
            for (int rep = 0; rep < NREP(9); ++rep) { if (EN(9)) { REFRESH(); ph_rw1(C, l); } }
            if (EN(7)) for (int rep = 0; rep < NREP(7); ++rep) { REFRESH(); ph_attn(C, l, want_ctx, (C.G >= 256 && 2 * C.G < RBLK && RBLK % (2 * C.G) != 0) ? (RBLK % (2 * C.G) + 1) / 2 : 0); }
        }
        SEAM(pb + 4);
        if (IN(pb + 5)) { if (EN(17)) for (int rep = 0; rep < NREP(17); ++rep) { REFRESH(); ph_rw2(C); } if (EN(10)) for (int rep = 0; rep < NREP(10); ++rep) { REFRESH(); ph_s5scan(C, l, C.G >= 256 ? 128 : 0); }
            if (EN(1) && l + 1 < NL) { REFRESH();
                if (C.G >= 256) { if (C.bid >= 64 && !(C.bid >= 128 && C.bid < 144)) { const int rk = C.bid - 64 - (C.bid >= 144 ? 16 : 0); conv_weights(C, l + 1, rk * NW + C.wave, (C.G - 80) * NW); } }
                else conv_weights(C, l + 1, C.bid * NW + C.wave, C.G * NW); } }
        SEAM(pb + 5);
        if (IN(pb + 6)) {
            if (EN(11)) for (int rep = 0; rep < NREP(11); ++rep) { REFRESH(); Gemm g{(const bf16*)(C.ws + WS_UG), (const bf16*)(C.ws + WS_S5T + (size_t)l * SZ_S5L + OFF_S5BT), S5K, S5K, S5K, (size_t)NCHP * S5K * 2, (size_t)512 * S5K * 2};
              Order S; S.init(NCHP / 256, 2, S5G, C.G, C.bid, S5K / 64); EpiS5C E{(const bf16*)(C.ws + WS_UG), C.in[I_S5D] + (size_t)l * GW, (bf16*)(C.ws + WS_YG)}; gemm_phase(C.lds, g, S, E); }
            if (EN(12)) for (int rep = 0; rep < NREP(12); ++rep) { REFRESH(); ph_rw3(C, l, mrows_out); }
        }
        SEAM(pb + 6);
        if (EN(13) && IN(pb + 7)) for (int rep = 0; rep < NREP(13); ++rep) { REFRESH();
            Gemm g{(const bf16*)(C.ws + WS_YG), wl(C, l, OFF_WGLU), GW, GW, GW, 0, 0}; Order S; S.init(mrows_out / 256, GW / 256, 1, C.G, C.bid, GW / 64);
            EpiGLU E{(const bf16*)(C.ws + WS_YG), C.in[I_S5GLUB] + (size_t)l * GW, OB}; gemm_phase(C.lds, g, S, E); }
        SEAM(pb + 7);
        if (EN(14) && IN(pb + 8)) { REFRESH();
            Gemm g{OB, wl(C, l, OFF_WOUT), D, D, D, 0, 0}; Order S; S.init(M_LAT / 256, D / 256, 1, C.G, C.bid, D / 64);
            EpiRes E{&C, gate_ptr(C, l, 1, 0), gs_ptr(C, l, 2, 0), rowss_ptr(C, l, 2), AP}; gemm_phase(C.lds, g, S, E);
            if (want_ctx) { REFRESH(); Order S2; S2.init_split(M_LAT / 256, M_CTX / 256, D / 256, 4, C.G, C.bid, D / 64); EpiAcc E2{&C, gate_ptr(C, l, 1, 0)}; gemm_phase(C.lds, g, S2, E2); } }
        SEAM(pb + 8);
        if (EN(18) && IN(pb + 9) && want_ctx) { REFRESH(); ph_ctxfix(C, gs_ptr(C, l, 2, 0), rowss_ptr(C, l, 2)); }
        SEAM(pb + 9);
        if (EN(15) && IN(pb + 10)) { REFRESH();
            Gemm g{AP, wl(C, l, OFF_W2GU), D, D, D, 0, 0}; Order S; S.init(mrows_out / 256, 2 * FF / 256, 1, C.G, C.bid, D / 64);
            EpiGU E{rowss_ptr(C, l, 2), bias_ptr(C, l, 2), Hb, mrows_out}; gemm_phase(C.lds, g, S, E); }
        SEAM(pb + 10);
        if (EN(16) && IN(pb + 11)) { REFRESH();
            Gemm g{Hb, wl(C, l, OFF_W2D), FF, FF, FF, 0, 0}; Order S; S.init(M_LAT / 256, D / 256, 1, C.G, C.bid, FF / 64);
            const bool more = l + 1 < NL;
            EpiRes E{&C, gate_ptr(C, l, 2, 0), more ? gs_ptr(C, l + 1, 0, 0) : nullptr, more ? rowss_ptr(C, l + 1, 0) : nullptr, AP}; gemm_phase(C.lds, g, S, E);
            if (want_ctx) { REFRESH(); Order S2; S2.init_split(M_LAT / 256, M_CTX / 256, D / 256, 4, C.G, C.bid, FF / 64); EpiAcc E2{&C, gate_ptr(C, l, 2, 0)}; gemm_phase(C.lds, g, S2, E2); } }
        SEAM(pb + 11);
        if (EN(18) && IN(pb + 12) && want_ctx) { REFRESH(); ph_ctxfix(C, gs_ptr(C, l + 1, 0, 0), rowss_ptr(C, l + 1, 0)); }
        SEAM(pb + 12);
    }
#undef IN
#undef SEAM
}

#ifndef MK_PER_PHASE
#define MK_PER_PHASE 0
#endif
#ifdef EMU
int g_emu_grid = 4, g_emu_lo = 0, g_emu_hi = NPH;
#endif
extern "C" void kernel_launch(void* const* d_in, const int* in_sizes, int n_in, void* d_out, int out_size, void* d_ws, size_t ws_size, hipStream_t stream) {
    Args a{};
    for (int i = 0; i < 42; ++i) a.in[i] = (const float*)d_in[i];
    a.out = (float*)d_out; a.ws = (unsigned char*)d_ws;
#ifdef EMU
    if (g_emu_lo == 0) hipMemsetAsync(d_ws, 0, WS_ZERO_END, stream);
    for (int ph = g_emu_lo; ph < g_emu_hi; ++ph) { a.ph_lo = ph; a.ph_hi = ph + 1; fprintf(stderr, "phase %d\n", ph); emu::launch(g_emu_grid, NTHR, LDS_BYTES, [=] { fwd(a); }); }
#else
    static int grid = 0;
    if (grid == 0) {
        if (n_in != 42 || out_size != M_LAT * D || ws_size < WS_END) { fprintf(stderr, "kernel_launch: unexpected shapes (n_in %d out %d ws %zu need %zu)\n", n_in, out_size, ws_size, (size_t)WS_END); grid = -1; return; }
        int dev = 0, cus = 0;
        if (hipGetDevice(&dev) != hipSuccess || hipDeviceGetAttribute(&cus, hipDeviceAttributeMultiprocessorCount, dev) != hipSuccess) { grid = -1; return; }
        if (hipFuncSetAttribute((const void*)fwd, hipFuncAttributeMaxDynamicSharedMemorySize, LDS_BYTES) != hipSuccess) { fprintf(stderr, "kernel_launch: hipFuncSetAttribute failed\n"); grid = -1; return; }
        int per_cu = 0; (void)hipOccupancyMaxActiveBlocksPerMultiprocessor(&per_cu, (const void*)fwd, NTHR, LDS_BYTES); (void)hipGetLastError();
        if (per_cu < 1) fprintf(stderr, "kernel_launch: occupancy query reports %d\n", per_cu);
        grid = cus;
    }
    if (grid < 0) return;
    (void)hipMemsetAsync(d_ws, 0, WS_ZERO_END, stream);
#if MK_PER_PHASE
    for (int ph = 0; ph < NPH; ++ph) { a.ph_lo = ph; a.ph_hi = ph + 1; hipLaunchKernelGGL(fwd, dim3(grid), dim3(NTHR), LDS_BYTES, stream, a); }
#else
    a.ph_lo = 0; a.ph_hi = NPH;
    hipLaunchKernelGGL(fwd, dim3(grid), dim3(NTHR), LDS_BYTES, stream, a);
#endif
#endif
}
```

```cpp
#ifdef EMU
#include "emu/emu.h"
#define LAS
#define GAS
#define ASMV(...) ((void)0)
#define WSYNC() do { int _z = 0; (void)emu::wave_gather(&_z, 4); } while (0)
#define OPAQUE(x) ((void)0)
#define OPAQUE_S(x) ((void)0)
#define PIN(x) ((void)0)
#define PIN4(a, b, c, d) ((void)0)
#define OPAQUE_LDS(p) (p)
#else
#include <hip/hip_runtime.h>
#include <cstdio>
#include <cstdint>
#define LAS __attribute__((address_space(3)))
#define GAS __attribute__((address_space(1)))
#define ASMV(...) asm volatile(__VA_ARGS__)
#define PIN(x) asm volatile("" : "+v"(x) :: "memory")
#define PIN4(a, b, c, d) asm volatile("" : "+v"(a), "+v"(b), "+v"(c), "+v"(d) :: "memory")
template <class P> __device__ __forceinline__ P opaque_lds(P p) { unsigned a = (unsigned)(size_t)p; asm volatile("" : "+v"(a)); return (P)(size_t)a; }
#define OPAQUE_LDS(p) opaque_lds(p)
#define OPAQUE_S(x) asm volatile("" : "+s"(x))
#define OPAQUE(x) asm volatile("" : "+v"(x))
#define WSYNC() asm volatile("s_waitcnt lgkmcnt(0)" ::: "memory")
#endif

#ifdef EMU
constexpr int D = 1024, NB = 2, T = 1024, NL = 2, TC = 256, FF = 1024;
#else
constexpr int D = 2048, NB = 2, T = 8192, NL = 4, TC = 256, FF = 5632;
#endif
constexpr int GW = D / 4, NH = GW / 64, WAG = NH / 2, S5G = GW / 16, GRW = 64, GRH = T / GRW;
constexpr int M_LAT = NB * T, M_CTX = NB * TC, M = M_LAT + M_CTX, NPAN = M / 256;
constexpr int TP = GW / 256;
constexpr int NT_IN = 8 * TP + 2, NINP = NT_IN * 256, D_IN = 8 * GW + 416;
constexpr int PN_AQ = 0, PN_AK = TP, PN_AV = 2 * TP, PN_BR = 3 * TP, PN_BK = 4 * TP, PN_BV = 5 * TP, PN_BS = 6 * TP, PN_CQ = 6 * TP + 1, PN_CKV = 7 * TP + 1, PN_DU = 7 * TP + 2;
constexpr int SRC_AQ = 0, SRC_AK = GW, SRC_AV = 2 * GW, SRC_BR = 3 * GW, SRC_BK = 4 * GW, SRC_BV = 5 * GW, SRC_BS = 6 * GW, SRC_CQ = 6 * GW + 160, SRC_CK = 7 * GW + 160, SRC_CV = 7 * GW + 288, SRC_DU = 7 * GW + 416;
constexpr int S5L = 32, NCH = M / S5L, NCHP = ((NCH + 255) / 256) * 256, S5K = 768;
constexpr int NW = 8, NTHR = 512;
constexpr float NORM_EPS = 1e-6f, RW_GN_EPS = 64e-5f;

typedef unsigned short bf16;
typedef short bf16x8 __attribute__((ext_vector_type(8)));
typedef short s16x4 __attribute__((ext_vector_type(4)));
typedef float f32x4 __attribute__((ext_vector_type(4)));
typedef float f32x2 __attribute__((ext_vector_type(2)));
typedef float f32x16 __attribute__((ext_vector_type(16)));
typedef unsigned u32x4 __attribute__((ext_vector_type(4)));
typedef unsigned u32x2 __attribute__((ext_vector_type(2)));
#define DI __device__ __forceinline__

constexpr size_t al256(size_t x) { return (x + 255) & ~(size_t)255; }
constexpr size_t SZ_BIAS_GU = (size_t)3 * 2 * FF * 4, SZ_BIAS_IN = (size_t)3 * NINP * 4;
constexpr size_t WS_CTL = 0;
constexpr size_t WS_BIAS = 65536;
constexpr size_t SZ_BIAS_L = 2 * SZ_BIAS_GU + SZ_BIAS_IN;
constexpr size_t WS_ROWSS = al256(WS_BIAS + NL * SZ_BIAS_L);
constexpr size_t WS_ZERO_END = al256(WS_ROWSS + (size_t)NL * 3 * M * 4);
constexpr size_t WS_MODV = WS_ZERO_END;
constexpr size_t WS_GS = al256(WS_MODV + (size_t)NL * 3 * 9 * D * 4);
constexpr size_t WS_GATE = al256(WS_GS + (size_t)NL * 9 * D * 4);
constexpr size_t WS_ROPE = al256(WS_GATE + (size_t)NL * 9 * D * 4);
constexpr size_t SZ_WGU = (size_t)2 * FF * D * 2, SZ_WD = (size_t)D * FF * 2, SZ_WIN = (size_t)NINP * D * 2, SZ_WOUT = (size_t)D * D * 2, SZ_WGLU = (size_t)GW * GW * 2;
constexpr size_t OFF_W1GU = 0, OFF_W1D = OFF_W1GU + SZ_WGU, OFF_WIN = OFF_W1D + SZ_WD, OFF_WOUT = OFF_WIN + SZ_WIN, OFF_W2GU = OFF_WOUT + SZ_WOUT, OFF_W2D = OFF_W2GU + SZ_WGU, OFF_WGLU = OFF_W2D + SZ_WD, SZ_WL = OFF_WGLU + SZ_WGLU;
constexpr size_t WS_W = al256(WS_ROPE + 128 * 16 * 8);
constexpr size_t SZ_S5KC = (size_t)S5G * 2 * S5L * 256 * 4, SZ_S5ET = (size_t)S5G * 256 * 512 * 2, SZ_S5BT = (size_t)S5G * 512 * S5K * 2, SZ_S5LAM = (size_t)2 * GW * 4 * 8;
constexpr size_t SZ_S5LP = (size_t)2 * S5G * 64 * (S5L + 1) * 8, SZ_S5BETA = (size_t)2 * S5G * 64 * 16 * 8;
constexpr size_t OFF_S5KC = 0, OFF_S5ET = OFF_S5KC + SZ_S5KC, OFF_S5BT = OFF_S5ET + SZ_S5ET, OFF_S5LAM = OFF_S5BT + SZ_S5BT, OFF_S5LP = al256(OFF_S5LAM + SZ_S5LAM), OFF_S5BETA = OFF_S5LP + SZ_S5LP, SZ_S5L = al256(OFF_S5BETA + SZ_S5BETA);
constexpr size_t WS_S5T = al256(WS_W + NL * SZ_WL);
constexpr size_t WS_XC = al256(WS_S5T + NL * SZ_S5L);
constexpr size_t WS_AP = al256(WS_XC + (size_t)M_CTX * D * 4);
constexpr size_t WS_H = al256(WS_AP + (size_t)M * D * 2);
constexpr size_t WS_QA = al256(WS_H + (size_t)M * FF * 2);
constexpr size_t WS_KA = WS_QA + (size_t)M * GW * 2, WS_VA = WS_KA + (size_t)M * GW * 2, WS_QC = WS_VA + (size_t)M * GW * 2;
constexpr size_t WS_KC = WS_QC + (size_t)M * GW * 2, WS_VC = WS_KC + (size_t)M * 128 * 2;
constexpr size_t WS_PB = WS_VC + (size_t)M * 128 * 2;
constexpr size_t WS_PS = al256(WS_PB + (size_t)M * 3 * GW * 2);
constexpr size_t WS_UG = al256(WS_PS + (size_t)M * 160 * 4);
constexpr size_t WS_RW = al256(WS_UG + (size_t)S5G * NCHP * S5K * 2);
constexpr size_t SZ_RWA = (size_t)M * GW * 4;
enum { RW_R = 0, RW_V, RW_NKK, RW_G, RW_W0, RW_W1, RW_K0, RW_K1, RW_B0, RW_B1, RW_Y0, RW_Y1, RW_NARR };
constexpr size_t WS_XEND = al256(WS_RW + 256);
constexpr size_t WS_YG = al256(WS_XEND + (size_t)S5G * NCHP * 256 * 4);
constexpr size_t WS_OB = al256(WS_YG + (size_t)M * GW * 2);
constexpr int RCK = (TC + T) / 64, RSTR = NB * NH * 2, RITEM = RSTR * RCK;
constexpr size_t WS_QH = al256(WS_OB + (size_t)M * D * 2);
constexpr size_t WS_YL = al256(WS_QH + (size_t)RITEM * 8192);
constexpr size_t WS_MF = al256(WS_YL + (size_t)RITEM * 16384);
constexpr size_t WS_GF = al256(WS_MF + (size_t)RITEM * 8192);
constexpr size_t WS_SF = al256(WS_GF + (size_t)RITEM * 16384);
constexpr int RBLK = NB * NH * ((TC + T) / 64);
constexpr size_t WS_RVKG = al256(WS_SF + (size_t)RITEM * 8192);
constexpr size_t SZ_RWF = (size_t)14 * NH * 2 * 64 * 16;
constexpr size_t WS_RWF = al256(WS_RVKG + (size_t)RBLK * 32768);
constexpr size_t WS_RWS = al256(WS_RWF + NL * SZ_RWF);
constexpr size_t WS_END = al256(WS_RWS + (size_t)512 * 2 * 65536);
constexpr int CW_BAR = 1024;

constexpr int LDS_BYTES = 147456, RING_BYTES = 131072, MISC_OFF = LDS_BYTES - 256;

DI unsigned f2bf(float f) { unsigned u = __float_as_uint(f); return (u + 0x7fffu + ((u >> 16) & 1u)) >> 16; }
#ifdef EMU
DI unsigned pk2(float lo, float hi) { return f2bf(lo) | (f2bf(hi) << 16); }
#else
typedef __bf16 hbf16x2 __attribute__((ext_vector_type(2)));
DI unsigned pk2(float lo, float hi) { const f32x2 v = {lo, hi}; const hbf16x2 b = __builtin_convertvector(v, hbf16x2); return __builtin_bit_cast(unsigned, b); }
#endif
DI float bf2f(unsigned short b) { return __uint_as_float(((unsigned)b) << 16); }
DI float bflo(unsigned w) { return __uint_as_float(w << 16); }
DI float bfhi(unsigned w) { return __uint_as_float(w & 0xffff0000u); }
template <int N> DI float ror_add(float v) { return v + __int_as_float(__builtin_amdgcn_mov_dpp(__float_as_int(v), 0x120 + N, 0xf, 0xf, true)); }
DI float row16_sum(float v) { v = ror_add<8>(v); v = ror_add<4>(v); v = ror_add<2>(v); v = ror_add<1>(v); return v; }
DI float wave_sum(float v) {
    v = row16_sum(v);
    const float a = __int_as_float(__builtin_amdgcn_readlane(__float_as_int(v), 0)), b = __int_as_float(__builtin_amdgcn_readlane(__float_as_int(v), 16)),
                c = __int_as_float(__builtin_amdgcn_readlane(__float_as_int(v), 32)), d = __int_as_float(__builtin_amdgcn_readlane(__float_as_int(v), 48));
    return (a + b) + (c + d);
}
DI float siluf(float x) { return x * __builtin_amdgcn_rcpf(1.f + __expf(-x)); }
DI float sigmf(float x) { return __builtin_amdgcn_rcpf(1.f + __expf(-x)); }
DI float geluf(float x) { const float z = 0.7978845608028654f * (x + 0.044715f * x * x * x); const float e = __expf(2.f * z); return 0.5f * x * (1.f + (1.f - 2.f * __builtin_amdgcn_rcpf(e + 1.f))); }
DI int stream_of_row(int row) { return row < M_LAT ? row / T : NB; }
DI int stream_of_panel(int pm) { return stream_of_row(pm * 256); }

#define XB_TMO      128
#define XB_XCNT(j)  (256  + 64 * (j))
#define XB_XSUB(j)  (1280 + 64 * (j))
#define XB_XGEN(j)  (2304 + 64 * (j))
#define XB_TOP      3328
#define XB_TOPGEN   3392
#define XCD_BAR_WORDS 3456
#define XB_SPIN_CAP (1u << 18)
DI unsigned xb_ld(unsigned* p)              { return __hip_atomic_load(p, __ATOMIC_RELAXED, __HIP_MEMORY_SCOPE_AGENT); }
DI unsigned xb_add(unsigned* p, unsigned v) { return __hip_atomic_fetch_add(p, v, __ATOMIC_RELAXED, __HIP_MEMORY_SCOPE_AGENT); }
DI unsigned xb_xcc_id() { return (unsigned)__builtin_amdgcn_s_getreg((3 << 11) | 20) & 0xFu; }
#define XB_SPIN(cond, bar) do { unsigned _sp = 0; while (cond) { __builtin_amdgcn_s_sleep(1); \
    if ((++_sp & 255u) == 0u) { if (xb_ld(&(bar)[XB_TMO])) break; if (_sp > XB_SPIN_CAP) { atomicAdd(&(bar)[XB_TMO], 1u); break; } } } } while (0)
struct XcdBarrier { unsigned* bar; unsigned x; volatile LAS unsigned* st; };
DI XcdBarrier xcd_barrier_post(unsigned* bar, volatile LAS unsigned* st) {
    XcdBarrier b; b.bar = bar; b.x = xb_xcc_id(); b.st = st;
    if (threadIdx.x == 0) (void)xb_add(&bar[XB_XCNT(b.x)], 1u);
    return b;
}
DI void xcd_barrier_complete(unsigned* bar, unsigned x, unsigned& nloc, unsigned& nx) {
    const unsigned G = gridDim.x * gridDim.y * gridDim.z;
    unsigned sum, cnt, mine, sp = 0u;
    for (;;) {
        sum = 0u; cnt = 0u; mine = 0u;
#pragma unroll
        for (unsigned j = 0; j < 16; ++j) { const unsigned c = xb_ld(&bar[XB_XCNT(j)]); sum += c; cnt += (c > 0u) ? 1u : 0u; mine = (j == x) ? c : mine; }
        if (sum == G) break;
        __builtin_amdgcn_s_sleep(1);
        if ((++sp & 255u) == 0u) { if (xb_ld(&bar[XB_TMO])) break; if (sp > XB_SPIN_CAP) { atomicAdd(&bar[XB_TMO], 1u); break; } }
    }
    nloc = mine > 0u ? mine : 1u; nx = cnt > 0u ? cnt : 1u;
}
DI void xcd_barrier(const XcdBarrier& b) {
    ASMV("s_waitcnt vmcnt(0)" ::: "memory");
    __syncthreads();
    if (threadIdx.x == 0) {
        unsigned* bar = b.bar;
        __builtin_amdgcn_s_waitcnt(0);
        unsigned nloc = b.st[0], nx = b.st[1];
        if (nloc == 0u) { xcd_barrier_complete(bar, b.x, nloc, nx); b.st[0] = nloc; b.st[1] = nx; }
        const unsigned old = xb_add(&bar[XB_XSUB(b.x)], 1u);
        const unsigned gen = old / nloc;
        if (old + 1u == (gen + 1u) * nloc) {
            __builtin_amdgcn_fence(__ATOMIC_RELEASE, "agent");
            ASMV("s_waitcnt vmcnt(0)" ::: "memory");
            const unsigned og = xb_add(&bar[XB_TOP], 1u);
            const unsigned tg = og / nx;
            if (og + 1u == (tg + 1u) * nx) xb_add(&bar[XB_TOPGEN], 1u);
            else XB_SPIN(xb_ld(&bar[XB_TOPGEN]) == tg, bar);
            __builtin_amdgcn_fence(__ATOMIC_ACQUIRE, "agent");
            xb_add(&bar[XB_XGEN(b.x)], 1u);
            ASMV("s_waitcnt vmcnt(0)" ::: "memory");
        } else {
            XB_SPIN(xb_ld(&bar[XB_XGEN(b.x)]) == gen, bar);
            __builtin_amdgcn_fence(__ATOMIC_ACQUIRE, "agent");
            ASMV("s_waitcnt vmcnt(0)" ::: "memory");
        }
    }
    __syncthreads();
}

constexpr int BK = 64, HALF = 128, HTB = HALF * BK * 2, NXCD = 8, WGM = 4;
DI int lds_byte(int r, int c) { const int st = (r >> 4) * 2 + (c >> 5), rr = r & 15, cc = c & 31, ob = rr * 64 + cc * 2; return st * 1024 + (ob ^ (((ob >> 9) & 1) << 5)); }
DI void stage_rc(int b, int& R, int& C) { const int st = b / 1024, sb = b % 1024, swz = sb ^ (((sb >> 9) & 1) << 5); R = (st >> 1) * 16 + swz / 64; C = (st & 1) * 32 + (swz % 64) / 2; }
struct Unit { int pm, pn, z, kt0; };
struct Gemm { const bf16* A; const bf16* Bt; int lda, ldb, K; size_t zA, zB; };
struct Order {
    int nM, nN, nZ, per, total, G, c, nkt, pm0, spl;
    DI void init(int nM_, int nN_, int nZ_, int G_, int c_, int nkt_) { nM = nM_; nN = nN_; nZ = nZ_; per = nM * nN; total = per * nZ; G = G_; c = c_; nkt = nkt_; pm0 = 0; spl = 0; }
    DI void init_split(int pm0_, int xM, int nN_, int spl_, int G_, int c_, int nkt_full) { nM = xM; nN = nN_; nZ = 1; per = xM * nN_ * spl_; total = per; G = G_; c = c_; nkt = nkt_full / spl_; pm0 = pm0_; spl = spl_; }
    DI bool next(int i, Unit& u) const {
        const long L = (long)i * G + c; if (L >= total) return false;
        if (spl) { const int j = (int)L; u.z = 0; u.pm = pm0 + j / (nN * spl); const int rem = j % (nN * spl); u.pn = rem / spl; u.kt0 = (rem % spl) * nkt; return true; }
        u.kt0 = 0;
        u.z = (int)(L / per); int wgid = (int)(L % per);
        { const int q = per / NXCD, r = per % NXCD, xcd = wgid % NXCD, off = wgid / NXCD; wgid = (xcd < r ? xcd * (q + 1) : r * (q + 1) + (xcd - r) * q) + off; }
        const int nig = WGM * nN, gid = wgid / nig, fm = gid * WGM, gsz = (nM - fm) < WGM ? (nM - fm) : WGM;
        u.pm = fm + ((wgid % nig) % gsz); u.pn = (wgid % nig) / gsz; return true;
    }
};

template <class Epi>
DI void gemm_phase(LAS unsigned char* lds, const Gemm g, const Order& S, const Epi& E) {
    int tid_ = threadIdx.x; OPAQUE(tid_);
    const int tid = tid_, wid = __builtin_amdgcn_readfirstlane(tid >> 6), lane = tid & 63, wr = wid >> 2, wc = wid & 3, fr = lane & 15, fq = lane >> 4;
    Unit cur, nxt; int ui = 0;
    if (!S.next(0, cur)) return;
    f32x4 acc[2][2][4][2];
#ifdef EMU
    (void)lds;
    for (;; ++ui) {
        if (ui > 0) { if (!S.next(ui, cur)) break; }
        const bf16* A = (const bf16*)((const char*)g.A + cur.z * g.zA); const bf16* B = (const bf16*)((const char*)g.Bt + cur.z * g.zB);
        for (int ai = 0; ai < 2; ++ai) for (int bj = 0; bj < 2; ++bj) for (int m = 0; m < 4; ++m) for (int n = 0; n < 2; ++n) for (int j = 0; j < 4; ++j) {
            const int r = 256 * cur.pm + 128 * ai + 64 * wr + 16 * m + fr, c = 256 * cur.pn + 128 * bj + 32 * wc + 16 * n + 4 * fq + j;
            const bf16* a = A + (size_t)r * g.lda; const bf16* b = B + (size_t)c * g.ldb; float s = 0.f;
            for (int k = cur.kt0 * BK; k < (cur.kt0 + S.nkt) * BK; ++k) s += bf2f(a[k]) * bf2f(b[k]);
            acc[ai][bj][m][n][j] = s; }
        E(acc, cur, wr, wc, fr, fq);
    }
#else
    unsigned voffA[2], voffB[2];
#pragma unroll
    for (int i = 0; i < 2; ++i) { int R, C; stage_rc(tid * 16 + i * 8192, R, C); voffA[i] = (unsigned)(R * g.lda + C) * 2u; voffB[i] = (unsigned)(R * g.ldb + C) * 2u; }
    const size_t kstep = (size_t)(BK * 2);
    const size_t hstepA = (size_t)HALF * g.lda * 2, hstepB = (size_t)HALF * g.ldb * 2, tstepA = 2 * hstepA, tstepB = 2 * hstepB;
    const unsigned ldsw = (unsigned)wid * 1024u;
    const int aoff = lds_byte(wr * 64 + fr, fq * 8), boff = lds_byte(wc * 32 + fr, fq * 8);
#define PG8_SA(b, h) (((b) * 2 + (h)) * HTB)
#define PG8_SB(b, h) ((4 + (b) * 2 + (h)) * HTB)
#define PG8_STAGE(bufoff, gbase, voff) do { _Pragma("unroll") for (int _i = 0; _i < 2; ++_i) \
        __builtin_amdgcn_global_load_lds((const unsigned*)((const char*)(gbase) + (voff)[_i]), (LAS unsigned*)(lds + (bufoff) + ldsw + _i * 8192), 16, 0, 0); } while (0)
#define PG8_LDA(dst, b, h) do { _Pragma("unroll") for (int m = 0; m < 4; ++m) _Pragma("unroll") for (int k = 0; k < 2; ++k) dst[m][k] = *(const LAS bf16x8*)(lds + PG8_SA(b, h) + aoff + m * 2048 + k * 1024); } while (0)
#define PG8_LDB(dst, b, h) do { _Pragma("unroll") for (int n = 0; n < 2; ++n) _Pragma("unroll") for (int k = 0; k < 2; ++k) dst[n][k] = *(const LAS bf16x8*)(lds + PG8_SB(b, h) + boff + n * 2048 + k * 1024); } while (0)
#define PG8_MMA(ai, bj, At, Bt) do { __builtin_amdgcn_s_setprio(1); _Pragma("unroll") for (int m = 0; m < 4; ++m) _Pragma("unroll") for (int n = 0; n < 2; ++n) _Pragma("unroll") for (int k = 0; k < 2; ++k) \
        acc[ai][bj][m][n] = __builtin_amdgcn_mfma_f32_16x16x32_bf16(Bt[n][k], At[m][k], acc[ai][bj][m][n], 0, 0, 0); __builtin_amdgcn_s_setprio(0); } while (0)
#define PG8_WAIT_V(n) asm volatile("s_waitcnt vmcnt(" #n ")" ::: "memory")
#define PG8_WAIT_L(n) asm volatile("s_waitcnt lgkmcnt(" #n ")" ::: "memory")
#define PG8_BAR __builtin_amdgcn_s_barrier()
#define PG8_SCHED __builtin_amdgcn_sched_barrier(0)
#pragma unroll
    for (int a = 0; a < 2; ++a)
#pragma unroll
        for (int b = 0; b < 2; ++b)
#pragma unroll
            for (int m = 0; m < 4; ++m)
#pragma unroll
                for (int n = 0; n < 2; ++n) acc[a][b][m][n] = (f32x4){0.f, 0.f, 0.f, 0.f};
    bf16x8 At[4][2], B0[2][2], B1[2][2];
    const char* cA = (const char*)g.A + (size_t)cur.z * g.zA + (size_t)cur.pm * tstepA + (size_t)cur.kt0 * kstep; const char* cB = (const char*)g.Bt + (size_t)cur.z * g.zB + (size_t)cur.pn * tstepB + (size_t)cur.kt0 * kstep;
    PG8_STAGE(PG8_SB(0, 0), cB, voffB); PG8_STAGE(PG8_SB(0, 1), cB + hstepB, voffB); PG8_STAGE(PG8_SA(0, 0), cA, voffA); PG8_STAGE(PG8_SA(0, 1), cA + hstepA, voffA);
    if (wr == 1) PG8_BAR;
    PG8_WAIT_V(2); PG8_BAR;
    PG8_STAGE(PG8_SB(1, 0), cB + kstep, voffB); PG8_STAGE(PG8_SA(1, 0), cA + kstep, voffA); PG8_STAGE(PG8_SB(1, 1), cB + hstepB + kstep, voffB);
    PG8_WAIT_V(6); PG8_BAR;
    for (;;) {
        const bool has_next = S.next(ui + 1, nxt);
        const char* nA = has_next ? (const char*)g.A + (size_t)nxt.z * g.zA + (size_t)nxt.pm * tstepA + (size_t)nxt.kt0 * kstep : cA; const char* nB = has_next ? (const char*)g.Bt + (size_t)nxt.z * g.zB + (size_t)nxt.pn * tstepB + (size_t)nxt.kt0 * kstep : cB;
        const int nt = S.nkt;
        for (int t = 0; t < nt; t += 2) {
            const bool last = (t == nt - 2);
            const char* a1 = cA + (size_t)(t + 1) * kstep;
            const char* a2 = last ? nA : cA + (size_t)(t + 2) * kstep; const char* b2 = last ? nB : cB + (size_t)(t + 2) * kstep;
            const char* a3 = a2 + kstep; const char* b3 = b2 + kstep;
            PG8_LDB(B0, 0, 0); PG8_LDB(B1, 0, 1); PG8_SCHED; PG8_LDA(At, 0, 0); PG8_STAGE(PG8_SA(1, 1), a1 + hstepA, voffA);
            PG8_WAIT_V(8); PG8_WAIT_L(0); PG8_BAR; PG8_MMA(0, 0, At, B0); PG8_MMA(0, 1, At, B1); PG8_BAR; PG8_SCHED;
            PG8_LDA(At, 0, 1); PG8_STAGE(PG8_SB(0, 0), b2, voffB); PG8_STAGE(PG8_SB(0, 1), b2 + hstepB, voffB); PG8_STAGE(PG8_SA(0, 0), a2, voffA);
            PG8_WAIT_V(8); PG8_WAIT_L(0); PG8_BAR; PG8_MMA(1, 0, At, B0); PG8_MMA(1, 1, At, B1); PG8_BAR; PG8_SCHED;
            PG8_LDB(B0, 1, 0); PG8_LDB(B1, 1, 1); PG8_SCHED; PG8_LDA(At, 1, 0); PG8_STAGE(PG8_SA(0, 1), a2 + hstepA, voffA);
            PG8_WAIT_V(8); PG8_WAIT_L(0); PG8_BAR; PG8_MMA(0, 0, At, B0); PG8_MMA(0, 1, At, B1); PG8_BAR; PG8_SCHED;
            PG8_LDA(At, 1, 1); PG8_STAGE(PG8_SB(1, 0), b3, voffB); PG8_STAGE(PG8_SB(1, 1), b3 + hstepB, voffB); PG8_STAGE(PG8_SA(1, 0), a3, voffA);
            PG8_WAIT_V(8); PG8_WAIT_L(0); PG8_BAR; PG8_MMA(1, 0, At, B0); PG8_MMA(1, 1, At, B1); PG8_BAR; PG8_SCHED;
        }
        if (wr == 0) PG8_BAR;
        E(acc, cur, wr, wc, fr, fq);
        if (!has_next) break;
#pragma unroll
        for (int a = 0; a < 2; ++a)
#pragma unroll
            for (int b = 0; b < 2; ++b)
#pragma unroll
                for (int m = 0; m < 4; ++m)
#pragma unroll
                    for (int n = 0; n < 2; ++n) acc[a][b][m][n] = (f32x4){0.f, 0.f, 0.f, 0.f};
        cur = nxt; cA = nA; cB = nB; ++ui;
        if (wr == 1) PG8_BAR;
    }
    PG8_WAIT_V(0);
    PG8_BAR;
#undef PG8_SA
#undef PG8_SB
#undef PG8_STAGE
#undef PG8_LDA
#undef PG8_LDB
#undef PG8_MMA
#undef PG8_WAIT_V
#undef PG8_WAIT_L
#undef PG8_BAR
#undef PG8_SCHED
#endif
}

struct Args {
    const float* in[42]; float* out; unsigned char* ws;
    int ph_lo, ph_hi;
};
struct Ctx {
    const float* const* in; float* out; unsigned char* ws;
    LAS unsigned char* lds; int tid, lane, wave, G, bid;
};
DI float* xrow_ptr(const Ctx& C, int row) { return row < M_LAT ? C.out + (size_t)row * D : (float*)(C.ws + WS_XC) + (size_t)(row - M_LAT) * D; }
DI const bf16* wl(const Ctx& C, int l, size_t off) { return (const bf16*)(C.ws + WS_W + (size_t)l * SZ_WL + off); }
DI float* bias_ptr(const Ctx& C, int l, int which  ) { return (float*)(C.ws + WS_BIAS + (size_t)l * SZ_BIAS_L + (which == 0 ? 0 : which == 1 ? SZ_BIAS_GU : SZ_BIAS_GU + SZ_BIAS_IN)); }
DI float* rowss_ptr(const Ctx& C, int l, int sub) { return (float*)(C.ws + WS_ROWSS) + ((size_t)l * 3 + sub) * M; }
DI const float* gs_ptr(const Ctx& C, int l, int sub, int s) { return (const float*)(C.ws + WS_GS) + (((size_t)l * 3 + sub) * 3 + s) * D; }
DI const float* gate_ptr(const Ctx& C, int l, int sub, int s) { return (const float*)(C.ws + WS_GATE) + (((size_t)l * 3 + sub) * 3 + s) * D; }
DI float* rw_arr(const Ctx& C, int a) { return (float*)(C.ws + WS_RW + (size_t)a * SZ_RWA); }
enum { I_X = 0, I_C, I_CTX, I_CCTX, I_WADA, I_BADA, I_NORMG, I_F1WG, I_F1WU, I_F1WD, I_F2WG, I_F2WU, I_F2WD, I_WIN, I_WOUT, I_NAQG, I_NAKG, I_NARPB, I_RWCONV, I_RWW0, I_RWWUP, I_RWA0, I_RWAUP,
       I_RWGUP, I_RWKK, I_RWKA, I_RWRK, I_RWGNW, I_RWGNB, I_WAQG, I_WAKG, I_WASINK, I_S5ARE, I_S5AIM, I_S5LDT, I_S5BRE, I_S5BIM, I_S5CRE, I_S5CIM, I_S5D, I_S5GLUW, I_S5GLUB, I_NIN };

struct EpiGU {
    const float* rowss; const float* bias  ; bf16* H; int mrows;
    DI void operator()(const f32x4 (&acc)[2][2][4][2], const Unit& u, int wr, int wc, int fr_, int fq_) const {
        int tz_ = threadIdx.x; OPAQUE(tz_); const int fr = tz_ & 15, fq = (tz_ & 63) >> 4; (void)fr_; (void)fq_;
        const int s = stream_of_panel(u.pm); const float* bs = bias + (size_t)s * 2 * FF + u.pn * 256 + wc * 32 + 4 * fq;
        f32x4 bg[2], bu[2];
#pragma unroll
        for (int n = 0; n < 2; ++n) { bg[n] = *(const f32x4*)(bs + 16 * n); bu[n] = *(const f32x4*)(bs + 128 + 16 * n); }
        float rsv[2][4];
#pragma unroll
        for (int ai = 0; ai < 2; ++ai)
#pragma unroll
            for (int m = 0; m < 4; ++m) rsv[ai][m] = rowss[u.pm * 256 + ai * 128 + wr * 64 + m * 16 + fr];
#pragma unroll
        for (int ai = 0; ai < 2; ++ai)
#pragma unroll
            for (int m = 0; m < 4; ++m) {
                const int row = u.pm * 256 + ai * 128 + wr * 64 + m * 16 + fr;
                const float rstd = __builtin_amdgcn_rsqf(rsv[ai][m] * (1.0f / D) + NORM_EPS);
                bf16* hp = H + (size_t)row * FF + u.pn * 128 + wc * 32 + 8 * fq;
                u32x4 w;
                { const f32x4 g = acc[ai][0][m][0] * rstd + bg[0], v = acc[ai][1][m][0] * rstd + bu[0]; w.x = pk2(siluf(g[0]) * v[0], siluf(g[1]) * v[1]); w.y = pk2(siluf(g[2]) * v[2], siluf(g[3]) * v[3]); }
                { const f32x4 g = acc[ai][0][m][1] * rstd + bg[1], v = acc[ai][1][m][1] * rstd + bu[1]; w.z = pk2(siluf(g[0]) * v[0], siluf(g[1]) * v[1]); w.w = pk2(siluf(g[2]) * v[2], siluf(g[3]) * v[3]); }
                *(u32x4*)hp = w;
            }
    }
};
struct EpiRes {
    const Ctx* C; const float* gate  ; const float* gsn  ; float* rowss_next; bf16* AP;
    DI void operator()(const f32x4 (&acc)[2][2][4][2], const Unit& u, int wr, int wc, int fr_, int fq_) const {
        int tz_ = threadIdx.x; OPAQUE(tz_); const int fr = tz_ & 15, fq = (tz_ & 63) >> 4; (void)fr_; (void)fq_;
        const int s = stream_of_panel(u.pm); const int col0 = u.pn * 256 + wc * 32 + 4 * fq;
        f32x4 gv[2][2], sv[2][2];
#pragma unroll
        for (int bj = 0; bj < 2; ++bj)
#pragma unroll
            for (int n = 0; n < 2; ++n) { gv[bj][n] = *(const f32x4*)(gate + (size_t)s * D + col0 + bj * 128 + n * 16); sv[bj][n] = gsn ? *(const f32x4*)(gsn + (size_t)s * D + col0 + bj * 128 + n * 16) : (f32x4){0.f, 0.f, 0.f, 0.f}; }
        f32x4 xc[2][2], xn[2][2];
        { const float* xp0 = xrow_ptr(*C, u.pm * 256 + wr * 64 + fr) + col0;
#pragma unroll
          for (int bj = 0; bj < 2; ++bj)
#pragma unroll
              for (int n = 0; n < 2; ++n) xn[bj][n] = *(const f32x4*)(xp0 + bj * 128 + n * 16); }
#pragma unroll
        for (int ai = 0; ai < 2; ++ai)
#pragma unroll
            for (int m = 0; m < 4; ++m) {
                const int row = u.pm * 256 + ai * 128 + wr * 64 + m * 16 + fr;
                float* xp = xrow_ptr(*C, row) + col0; float ss = 0.f;
#pragma unroll
                for (int bj = 0; bj < 2; ++bj)
#pragma unroll
                    for (int n = 0; n < 2; ++n) xc[bj][n] = xn[bj][n];
                if (ai * 4 + m < 7) { const int rn = ai * 4 + m + 1; const float* xq = xrow_ptr(*C, u.pm * 256 + (rn >> 2) * 128 + wr * 64 + (rn & 3) * 16 + fr) + col0;
#pragma unroll
                    for (int bj = 0; bj < 2; ++bj)
#pragma unroll
                        for (int n = 0; n < 2; ++n) xn[bj][n] = *(const f32x4*)(xq + bj * 128 + n * 16); }
#pragma unroll
                for (int bj = 0; bj < 2; ++bj)
#pragma unroll
                    for (int n = 0; n < 2; ++n) { f32x4 x = xc[bj][n]; x += gv[bj][n] * acc[ai][bj][m][n]; *(f32x4*)(xp + bj * 128 + n * 16) = x;
                        if (gsn) { ss += (x[0] * x[0] + x[1] * x[1]) + (x[2] * x[2] + x[3] * x[3]); const f32x4 a = x * sv[bj][n]; u32x2 w; w.x = pk2(a[0], a[1]); w.y = pk2(a[2], a[3]);
                            *(u32x2*)(AP + (size_t)row * D + col0 + bj * 128 + n * 16) = w; } }
                if (gsn) { ss += __shfl_xor(ss, 16); ss += __shfl_xor(ss, 32); if (fq == 0) atomicAdd(rowss_next + row, ss); }
            }
    }
};
struct EpiAcc {
    const Ctx* C; const float* gate;
    DI void operator()(const f32x4 (&acc)[2][2][4][2], const Unit& u, int wr, int wc, int fr_, int fq_) const {
        int tz_ = threadIdx.x; OPAQUE(tz_); const int fr = tz_ & 15, fq = (tz_ & 63) >> 4; (void)fr_; (void)fq_;
        const int s = stream_of_panel(u.pm); const int col0 = u.pn * 256 + wc * 32 + 4 * fq;
#pragma unroll
        for (int bj = 0; bj < 2; ++bj)
#pragma unroll
            for (int n = 0; n < 2; ++n) { const f32x4 gv = *(const f32x4*)(gate + (size_t)s * D + col0 + bj * 128 + n * 16);
#pragma unroll
                for (int ai = 0; ai < 2; ++ai)
#pragma unroll
                    for (int m = 0; m < 4; ++m) { float* xp = xrow_ptr(*C, u.pm * 256 + ai * 128 + wr * 64 + m * 16 + fr) + col0 + bj * 128 + n * 16; const f32x4 d = gv * acc[ai][bj][m][n];
#pragma unroll
                        for (int j = 0; j < 4; ++j) atomicAdd(xp + j, d[j]); } }
    }
};
struct EpiIn {
    const Ctx* C; const float* rowss; const float* bias  ; int l;
    DI void operator()(const f32x4 (&acc)[2][2][4][2], const Unit& u, int wr, int wc, int fr_, int fq_) const {
        int tz_ = threadIdx.x; OPAQUE(tz_); const int fr = tz_ & 15, fq = (tz_ & 63) >> 4; (void)fr_; (void)fq_;
        const int s = stream_of_panel(u.pm), pn = u.pn; const float* bs = bias + (size_t)s * NINP + pn * 256 + wc * 32 + 4 * fq;
        unsigned char* ws = C->ws;
        f32x4 bv[2][2];
#pragma unroll
        for (int bj = 0; bj < 2; ++bj)
#pragma unroll
            for (int n = 0; n < 2; ++n) bv[bj][n] = *(const f32x4*)(bs + bj * 128 + n * 16);
        float rsv[2][4];
#pragma unroll
        for (int ai = 0; ai < 2; ++ai)
#pragma unroll
            for (int m = 0; m < 4; ++m) rsv[ai][m] = rowss[u.pm * 256 + ai * 128 + wr * 64 + m * 16 + fr];
        const bool permuted = pn < PN_AV || (pn >= PN_CQ && pn < PN_DU);
        if (permuted) {
            const bool is_ckv = pn == PN_CKV, is_c = pn >= PN_CQ, is_q = pn < PN_AK || (pn >= PN_CQ && pn < PN_CKV);
            const bool plain_v = is_ckv && wc >= 2;
            const float* gsrc = C->in[is_c ? (is_q ? I_WAQG : I_WAKG) : (is_q ? I_NAQG : I_NAKG)] + (size_t)l * 64;
            f32x4 gn[2][2];
#pragma unroll
            for (int bj = 0; bj < 2; ++bj)
#pragma unroll
                for (int n = 0; n < 2; ++n) { gn[bj][n] = *(const f32x4*)(gsrc + 32 * bj + 16 * n + 4 * fq); if (is_q) gn[bj][n] *= 0.125f; }
            bf16* dst; int pitch, hcol;
            if (pn < PN_AK) { dst = (bf16*)(ws + WS_QA); pitch = GW; hcol = ((pn - PN_AQ) * 4 + wc) * 64; }
            else if (pn < PN_AV) { dst = (bf16*)(ws + WS_KA); pitch = GW; hcol = ((pn - PN_AK) * 4 + wc) * 64; }
            else if (pn < PN_CKV) { dst = (bf16*)(ws + WS_QC); pitch = GW; hcol = ((pn - PN_CQ) * 4 + wc) * 64; }
            else if (wc < 2) { dst = (bf16*)(ws + WS_KC); pitch = 128; hcol = wc * 64; }
            else { dst = (bf16*)(ws + WS_VC); pitch = 128; hcol = (wc - 2) * 64; }
            const f32x4* rope = (const f32x4*)(ws + WS_ROPE);
#pragma unroll
            for (int ai = 0; ai < 2; ++ai)
#pragma unroll
                for (int m = 0; m < 4; ++m) {
                    const int row = pn * 0 + u.pm * 256 + ai * 128 + wr * 64 + m * 16 + fr;
                    const float rstd = __builtin_amdgcn_rsqf(rsv[ai][m] * (1.0f / D) + NORM_EPS);
                    f32x4 v[2][2]; float ss = 0.f;
#pragma unroll
                    for (int bj = 0; bj < 2; ++bj)
#pragma unroll
                        for (int n = 0; n < 2; ++n) { v[bj][n] = acc[ai][bj][m][n] * rstd + bv[bj][n]; ss += (v[bj][n][0] * v[bj][n][0] + v[bj][n][1] * v[bj][n][1]) + (v[bj][n][2] * v[bj][n][2] + v[bj][n][3] * v[bj][n][3]); }
                    ss += __shfl_xor(ss, 16); ss += __shfl_xor(ss, 32);
                    if (!plain_v) { const float rs = 1.0f / sqrtf(ss * (1.0f / 64.0f) + NORM_EPS);
#pragma unroll
                        for (int bj = 0; bj < 2; ++bj)
#pragma unroll
                            for (int n = 0; n < 2; ++n) v[bj][n] = v[bj][n] * rs * gn[bj][n];
                        if (is_c && row < M_LAT) {
                            const int t = row % T; const int pos[2] = {t / GRW, t % GRW};
#pragma unroll
                            for (int bj = 0; bj < 2; ++bj) { const f32x4 cs0 = rope[(pos[bj] * 16 + 4 * fq) / 2], cs1 = rope[(pos[bj] * 16 + 4 * fq) / 2 + 1];
                                const float cc[4] = {cs0[0], cs0[2], cs1[0], cs1[2]}, sn[4] = {cs0[1], cs0[3], cs1[1], cs1[3]};
#pragma unroll
                                for (int j = 0; j < 4; ++j) { const float x1 = v[bj][0][j], x2 = v[bj][1][j]; v[bj][0][j] = x1 * cc[j] - x2 * sn[j]; v[bj][1][j] = x2 * cc[j] + x1 * sn[j]; } }
                        }
                    }
                    bf16* op = dst + (size_t)row * pitch + hcol + 4 * fq;
#pragma unroll
                    for (int bj = 0; bj < 2; ++bj)
#pragma unroll
                        for (int n = 0; n < 2; ++n) { u32x2 w; w.x = pk2(v[bj][n][0], v[bj][n][1]); w.y = pk2(v[bj][n][2], v[bj][n][3]); *(u32x2*)(op + 32 * bj + 16 * n) = w; }
                }
        } else {
#pragma unroll
            for (int ai = 0; ai < 2; ++ai)
#pragma unroll
                for (int m = 0; m < 4; ++m) {
                    const int row = u.pm * 256 + ai * 128 + wr * 64 + m * 16 + fr;
                    const float rstd = __builtin_amdgcn_rsqf(rsv[ai][m] * (1.0f / D) + NORM_EPS);
#pragma unroll
                    for (int bj = 0; bj < 2; ++bj)
#pragma unroll
                        for (int n = 0; n < 2; ++n) { const f32x4 v = acc[ai][bj][m][n] * rstd + bv[bj][n]; const int c = bj * 128 + wc * 32 + n * 16 + 4 * fq;
                            u32x2 w; w.x = pk2(v[0], v[1]); w.y = pk2(v[2], v[3]);
                            if (pn < PN_BR) *(u32x2*)((bf16*)(ws + WS_VA) + (size_t)row * GW + (pn - PN_AV) * 256 + c) = w;
                            else if (pn < PN_BS) *(u32x2*)((bf16*)(ws + WS_PB) + (size_t)row * 3 * GW + (pn - PN_BR) * 256 + c) = w;
                            else if (pn == PN_BS) { if (c < 160) *(f32x4*)((float*)(ws + WS_PS) + (size_t)row * 160 + c) = v; }
                            else { const int cu = (pn - PN_DU) * 256 + c, gq = cu >> 4, p0 = cu & 15;
                                *(u32x2*)((bf16*)(ws + WS_UG) + ((size_t)gq * NCHP + row / S5L) * S5K + (row % S5L) * 16 + p0) = w; } }
                }
        }
    }
};
struct EpiS5A {
    float* XE;
    DI void operator()(const f32x4 (&acc)[2][2][4][2], const Unit& u, int wr, int wc, int fr_, int fq_) const {
        int tz_ = threadIdx.x; OPAQUE(tz_); const int fr = tz_ & 15, fq = (tz_ & 63) >> 4; (void)fr_; (void)fq_;
#pragma unroll
        for (int ai = 0; ai < 2; ++ai)
#pragma unroll
            for (int m = 0; m < 4; ++m) { const int ch = u.pm * 256 + ai * 128 + wr * 64 + m * 16 + fr; if (ch < NCH) { float* p = XE + ((size_t)u.z * NCHP + ch) * 256 + wc * 32 + 4 * fq;
#pragma unroll
                for (int bj = 0; bj < 2; ++bj)
#pragma unroll
                    for (int n = 0; n < 2; ++n) *(f32x4*)(p + bj * 128 + n * 16) = acc[ai][bj][m][n]; } }
    }
};
struct EpiS5C {
    const bf16* UG; const float* dsk  ; bf16* YG;
    DI void operator()(const f32x4 (&acc)[2][2][4][2], const Unit& u, int wr, int wc, int fr_, int fq_) const {
        int tz_ = threadIdx.x; OPAQUE(tz_); const int fr = tz_ & 15, fq = (tz_ & 63) >> 4; (void)fr_; (void)fq_;
        const int g = u.z;
#pragma unroll
        for (int ai = 0; ai < 2; ++ai)
#pragma unroll
            for (int m = 0; m < 4; ++m) { const int ch = u.pm * 256 + ai * 128 + wr * 64 + m * 16 + fr; if (ch < NCH) {
#pragma unroll
                for (int bj = 0; bj < 2; ++bj)
#pragma unroll
                    for (int n = 0; n < 2; ++n) { const int col = u.pn * 256 + bj * 128 + wc * 32 + n * 16 + 4 * fq, i = col >> 4, p0 = col & 15;
                        const u32x2 uw = *(const u32x2*)(UG + ((size_t)g * NCHP + ch) * S5K + col); const f32x4 dv = *(const f32x4*)(dsk + 16 * g + p0);
                        const f32x4 a = acc[ai][bj][m][n]; const float y0 = a[0] + dv[0] * bflo(uw.x), y1 = a[1] + dv[1] * bfhi(uw.x), y2 = a[2] + dv[2] * bflo(uw.y), y3 = a[3] + dv[3] * bfhi(uw.y);
                        u32x2 w; w.x = pk2(geluf(y0), geluf(y1)); w.y = pk2(geluf(y2), geluf(y3));
                        *(u32x2*)(YG + (size_t)(ch * S5L + i) * GW + 16 * g + p0) = w; } } }
    }
};
struct EpiGLU {
    const bf16* YG; const float* gb; bf16* OB;
    DI void operator()(const f32x4 (&acc)[2][2][4][2], const Unit& u, int wr, int wc, int fr_, int fq_) const {
        int tz_ = threadIdx.x; OPAQUE(tz_); const int fr = tz_ & 15, fq = (tz_ & 63) >> 4; (void)fr_; (void)fq_;
#pragma unroll
        for (int ai = 0; ai < 2; ++ai)
#pragma unroll
            for (int m = 0; m < 4; ++m) { const int row = u.pm * 256 + ai * 128 + wr * 64 + m * 16 + fr;
#pragma unroll
                for (int bj = 0; bj < 2; ++bj)
#pragma unroll
                    for (int n = 0; n < 2; ++n) { const int col = u.pn * 256 + bj * 128 + wc * 32 + n * 16 + 4 * fq; const f32x4 b = *(const f32x4*)(gb + col); const f32x4 a = acc[ai][bj][m][n] + b;
                        const u32x2 yw = *(const u32x2*)(YG + (size_t)row * GW + col);
                        u32x2 w; w.x = pk2(bflo(yw.x) * sigmf(a[0]), bfhi(yw.x) * sigmf(a[1])); w.y = pk2(bflo(yw.y) * sigmf(a[2]), bfhi(yw.y) * sigmf(a[3]));
                        *(u32x2*)(OB + (size_t)row * D + 3 * GW + col) = w; } }
    }
};

DI void ph_ada(const Ctx& C) {
    LAS float* sc = (LAS float*)C.lds;
    LAS float* red = sc + 3 * D;
    for (int i = C.tid; i < 3 * D; i += NTHR) { const int s = i / D, k = i % D; const float c = s < NB ? C.in[I_C][s * D + k] : C.in[I_CCTX][k]; sc[i] = siluf(c); }
    __syncthreads();
    const int nun = NL * (9 * D / 256);
    for (int un = C.bid; un < nun; un += C.G) {
        const int l = un / (9 * D / 256), col0 = (un % (9 * D / 256)) * 256;
        const float* W = C.in[I_WADA] + (size_t)l * D * 9 * D + col0 + 4 * C.lane;
        f32x4 a0 = {0.f, 0.f, 0.f, 0.f}, a1 = a0, a2 = a0;
        const int k0 = C.wave * (D / 8);
#pragma unroll 1
        for (int kb = k0; kb < k0 + D / 8; kb += 16) {
            f32x4 wv[16];
#pragma unroll
            for (int u = 0; u < 16; ++u) wv[u] = *(const f32x4*)(W + (size_t)(kb + u) * 9 * D);
#pragma unroll
            for (int u = 0; u < 16; ++u) { a0 += wv[u] * sc[kb + u]; a1 += wv[u] * sc[D + kb + u]; a2 += wv[u] * sc[2 * D + kb + u]; } }
        LAS float* r = red + C.wave * 768 + 4 * C.lane;
        *(LAS f32x4*)(r) = a0; *(LAS f32x4*)(r + 256) = a1; *(LAS f32x4*)(r + 512) = a2;
        __syncthreads();
        for (int i = C.tid; i < 768; i += NTHR) { float s = 0.f;
#pragma unroll
            for (int w = 0; w < 8; ++w) s += red[w * 768 + i];
            const int st = i / 256, c = col0 + (i % 256);
            ((float*)(C.ws + WS_MODV))[((size_t)l * 3 + st) * 9 * D + c] = s + C.in[I_BADA][(size_t)l * 9 * D + c]; }
        __syncthreads();
    }
}
DI const float* modv_ptr(const Ctx& C, int l, int s, int chunk) { return (const float*)(C.ws + WS_MODV) + ((size_t)l * 3 + s) * 9 * D + (size_t)chunk * D; }

DI int win_dest(int n) {
    if (n >= D_IN) return -1;
    if (n < SRC_AV) { const int piece = n / GW, loc = n % GW, head = loc / 64, d = loc % 64; return ((piece == 0 ? PN_AQ : PN_AK) + head / 4) * 256 + 128 * (d / 32) + 32 * (head % 4) + (d % 32); }
    if (n < SRC_BS) return PN_AV * 256 + (n - SRC_AV);
    if (n < SRC_CQ) return PN_BS * 256 + (n - SRC_BS);
    if (n < SRC_CK) { const int loc = n - SRC_CQ, head = loc / 64, d = loc % 64; return (PN_CQ + head / 4) * 256 + 128 * (d / 32) + 32 * (head % 4) + (d % 32); }
    if (n < SRC_DU) { const int loc = n - SRC_CK, hh = loc / 64, d = loc % 64; return PN_CKV * 256 + 128 * (d / 32) + 32 * hh + (d % 32); }
    return PN_DU * 256 + (n - SRC_DU);
}
DI int gu_dest(int n) { const int e = n & 31; return (n / 128) * 256 + (n % 128 - e) + 16 * ((e >> 2) & 1) + 4 * (e >> 3) + (e & 3); }
DI void conv_item(const Ctx& C, const float* W, int K, int N, bf16* Wt, int mode, int k0, int n0, float* bias, int bias_pitch, const float* shift  ) {
    LAS float* scr = (LAS float*)(C.lds + C.wave * 16640);
    const int n = n0 + C.lane; const bool ok = n < N; float b0 = 0.f, b1 = 0.f, b2 = 0.f;
#pragma unroll 1
    for (int kh = 0; kh < 4; ++kh) {
        float wv[16];
#pragma unroll
        for (int kk = 0; kk < 16; ++kk) wv[kk] = ok ? W[(size_t)(k0 + 16 * kh + kk) * N + n] : 0.f;
#pragma unroll
        for (int kk = 0; kk < 16; ++kk) { const float v = wv[kk]; scr[(16 * kh + kk) * 65 + C.lane] = v;
            if (bias) { b0 += shift[k0 + 16 * kh + kk] * v; b1 += shift[9 * D + k0 + 16 * kh + kk] * v; b2 += shift[18 * D + k0 + 16 * kh + kk] * v; } } }
    WSYNC();
    const int dme = !ok ? -1 : mode == 0 ? n : mode == 1 ? gu_dest(n) : mode == 2 ? gu_dest(n) + 128 : win_dest(n);
    if (bias && dme >= 0) { atomicAdd(bias + dme, b0); atomicAdd(bias + bias_pitch + dme, b1); atomicAdd(bias + 2 * bias_pitch + dme, b2); }
    const int c = C.lane & 7;
#pragma unroll
    for (int i = 0; i < 8; ++i) { const int nl = (C.lane >> 3) + 8 * i, nn = n0 + nl;
        const int dr = nn >= N ? -1 : mode == 0 ? nn : mode == 1 ? gu_dest(nn) : mode == 2 ? gu_dest(nn) + 128 : win_dest(nn);
        const LAS float* s = scr + (8 * c) * 65 + nl;
        u32x4 o; o.x = pk2(s[0], s[65]); o.y = pk2(s[2 * 65], s[3 * 65]); o.z = pk2(s[4 * 65], s[5 * 65]); o.w = pk2(s[6 * 65], s[7 * 65]);
        if (dr >= 0) *(u32x4*)(Wt + (size_t)dr * K + k0 + 8 * c) = o; }
    WSYNC();
}
struct Cplx { float re, im; };
DI Cplx cmul(Cplx a, Cplx b) { return Cplx{a.re * b.re - a.im * b.im, a.re * b.im + a.im * b.re}; }
DI Cplx s5_lam_pow(const Ctx& C, int l, int dir, int g, int n, float tau) {
    const size_t i = (((size_t)l * 2 + dir) * S5G + g) * 64 + n; const float dt = __expf(C.in[I_S5LDT][((size_t)l * 2 + dir) * S5G + g]);
    const float mag = __expf(tau * dt * C.in[I_S5ARE][i]), ang = tau * dt * C.in[I_S5AIM][i]; float sn, cs; sincosf(ang, &sn, &cs); return Cplx{mag * cs, mag * sn};
}
DI Cplx s5_coef(const Ctx& C, int l, int dir, int g, int n) {
    const size_t i = (((size_t)l * 2 + dir) * S5G + g) * 64 + n; const float are = C.in[I_S5ARE][i], aim = C.in[I_S5AIM][i];
    const Cplx ab = s5_lam_pow(C, l, dir, g, n, 1.0f); const float den = are * are + aim * aim, nr = ab.re - 1.0f;
    return Cplx{(nr * are + ab.im * aim) / den, (ab.im * are - nr * aim) / den};
}
DI Cplx s5_beta(const Ctx& C, int l, int dir, int g, int n, int q) {
    const size_t i = (((size_t)l * S5G + g) * 64 + n) * 16 + q; return cmul(s5_coef(C, l, dir, g, n), Cplx{C.in[I_S5BRE][i], C.in[I_S5BIM][i]});
}
DI Cplx s5_gamma(const Ctx& C, int l, int g, int p, int n) { const size_t i = (((size_t)l * S5G + g) * 16 + p) * 64 + n; return Cplx{C.in[I_S5CRE][i], C.in[I_S5CIM][i]}; }

constexpr int CI_GU = (D / 64) * (FF / 64), CI_DN = (FF / 64) * (D / 64), CI_IN = (D / 64) * ((D_IN + 63) / 64), CI_OUT = (D / 64) * (D / 64), CI_GLU = (GW / 64) * (GW / 64);
constexpr int CI_LAYER = 4 * CI_GU + 2 * CI_DN + CI_IN + CI_OUT + CI_GLU;
DI void conv_weights(const Ctx& C, int l, int wslot, int nslots) {
    for (int it = wslot; it < CI_LAYER; it += nslots) {
        int r = it;
        unsigned char* wbase = C.ws + WS_W + (size_t)l * SZ_WL;
        if (r < 2 * CI_GU) { const int up = r >= CI_GU; r -= up * CI_GU; const int kb = r / (FF / 64), nb = r % (FF / 64);
            conv_item(C, C.in[up ? I_F1WU : I_F1WG] + (size_t)l * D * FF, D, FF, (bf16*)(wbase + OFF_W1GU), 1 + up, kb * 64, nb * 64, bias_ptr(C, l, 0), 2 * FF, modv_ptr(C, l, 0, 0)); continue; } r -= 2 * CI_GU;
        if (r < CI_DN) { const int kb = r / (D / 64), nb = r % (D / 64); conv_item(C, C.in[I_F1WD] + (size_t)l * FF * D, FF, D, (bf16*)(wbase + OFF_W1D), 0, kb * 64, nb * 64, nullptr, 0, nullptr); continue; } r -= CI_DN;
        if (r < CI_IN) { const int nbn = (D_IN + 63) / 64, kb = r / nbn, nb = r % nbn; conv_item(C, C.in[I_WIN] + (size_t)l * D * D_IN, D, D_IN, (bf16*)(wbase + OFF_WIN), 3, kb * 64, nb * 64, bias_ptr(C, l, 1), NINP, modv_ptr(C, l, 0, 3)); continue; } r -= CI_IN;
        if (r < CI_OUT) { const int kb = r / (D / 64), nb = r % (D / 64); conv_item(C, C.in[I_WOUT] + (size_t)l * D * D, D, D, (bf16*)(wbase + OFF_WOUT), 0, kb * 64, nb * 64, nullptr, 0, nullptr); continue; } r -= CI_OUT;
        if (r < 2 * CI_GU) { const int up = r >= CI_GU; r -= up * CI_GU; const int kb = r / (FF / 64), nb = r % (FF / 64);
            conv_item(C, C.in[up ? I_F2WU : I_F2WG] + (size_t)l * D * FF, D, FF, (bf16*)(wbase + OFF_W2GU), 1 + up, kb * 64, nb * 64, bias_ptr(C, l, 2), 2 * FF, modv_ptr(C, l, 0, 6)); continue; } r -= 2 * CI_GU;
        if (r < CI_DN) { const int kb = r / (D / 64), nb = r % (D / 64); conv_item(C, C.in[I_F2WD] + (size_t)l * FF * D, FF, D, (bf16*)(wbase + OFF_W2D), 0, kb * 64, nb * 64, nullptr, 0, nullptr); continue; } r -= CI_DN;
        { const int kb = r / (GW / 64), nb = r % (GW / 64); conv_item(C, C.in[I_S5GLUW] + (size_t)l * GW * GW, GW, GW, (bf16*)(wbase + OFF_WGLU), 0, kb * 64, nb * 64, nullptr, 0, nullptr); }
    }
}
DI void ph_conv(const Ctx& C) {
    const int gt = C.bid * NTHR + C.tid, GT = C.G * NTHR;
    for (int i = gt; i < NL * 9 * D; i += GT) { const int k = i % D, s = (i / D) % 3, sub = (i / (3 * D)) % 3, l = i / (9 * D);
        const float* mv = (const float*)(C.ws + WS_MODV) + ((size_t)l * 3 + s) * 9 * D;
        ((float*)(C.ws + WS_GS))[i] = C.in[I_NORMG][((size_t)l * 3 + sub) * D + k] * (1.0f + mv[(3 * sub + 1) * D + k]);
        ((float*)(C.ws + WS_GATE))[i] = mv[(3 * sub + 2) * D + k] * (sub == 1 ? 1.0f : 0.5f); }
    for (int i = gt; i < 128 * 16; i += GT) { const int pos = i / 16, f = i % 16; const float inv = __expf(-(float)f * (9.210340371976184f / 16.0f)); float sn, cs; sincosf((float)pos * inv, &sn, &cs);
        ((f32x2*)(C.ws + WS_ROPE))[i] = (f32x2){cs, sn}; }
    const int gw = C.bid * NW + C.wave, GWV = C.G * NW;
    conv_weights(C, 0, gw, GWV);
    for (int i = gt; i < NL * 14 * NH * 2 * 64 * 8; i += GT) {
        const int j = i & 7, ln = (i >> 3) & 63, tj = (i >> 9) & 1, hd = (i >> 10) % NH, f = (i / (1024 * NH)) % 14, l = i / (1024 * NH * 14);
        const int col = hd * 64 + 32 * tj + (ln & 31); float v;
        if (f < 8) { const int d = (f >> 1) & 1, sx = f & 1, k = 16 * sx + 8 * (ln >> 5) + j; v = C.in[f < 4 ? I_RWWUP : I_RWAUP][(((size_t)l * 2 + d) * 32 + k) * GW + col]; }
        else { const int k = 16 * (f - 8) + 8 * (ln >> 5) + j; v = C.in[I_RWGUP][((size_t)l * 96 + k) * GW + col]; }
        ((bf16*)(C.ws + WS_RWF))[i] = (bf16)f2bf(v); }
    LAS float* wsc = (LAS float*)(C.lds + C.wave * 16640);
    for (int it = gw; it < NL * S5G * 2 * S5L; it += GWV) {
        const int tau = it % S5L, dir = (it / S5L) % 2, g = (it / (2 * S5L)) % S5G, l = it / (2 * S5L * S5G);
        const Cplx z = cmul(s5_lam_pow(C, l, dir, g, C.lane, (float)tau), s5_coef(C, l, dir, g, C.lane));
#pragma unroll 4
        for (int q = 0; q < 16; ++q) { const size_t i = (((size_t)l * S5G + g) * 64 + C.lane) * 16 + q; const Cplx w = cmul(z, Cplx{C.in[I_S5BRE][i], C.in[I_S5BIM][i]}); wsc[(C.lane * 16 + q) * 2] = w.re; wsc[(C.lane * 16 + q) * 2 + 1] = w.im; }
        WSYNC();
        float* kc = (float*)(C.ws + WS_S5T + (size_t)l * SZ_S5L + OFF_S5KC) + (((size_t)g * 2 + dir) * S5L + tau) * 256;
#pragma unroll 1
        for (int e = 0; e < 4; ++e) { const int pq = C.lane + 64 * e, p = pq >> 4, q = pq & 15; float s = 0.f;
#pragma unroll 4
            for (int n = 0; n < 64; ++n) { const Cplx gm = s5_gamma(C, l, g, p, n); s += gm.re * wsc[(n * 16 + q) * 2] - gm.im * wsc[(n * 16 + q) * 2 + 1]; }
            kc[pq] = s; }
        WSYNC();
    }
    for (int i = gt; i < NL * 2 * GW * 4 * (S5L + 1); i += GT) { const int tau = i % (S5L + 1), r = i / (S5L + 1), n = r % 64, g = (r / 64) % S5G, dir = (r / (64 * S5G)) % 2, l = r / (2 * 64 * S5G);
        const Cplx z = s5_lam_pow(C, l, dir, g, n, (float)tau); ((f32x2*)(C.ws + WS_S5T + (size_t)l * SZ_S5L + OFF_S5LP))[((size_t)(dir * S5G + g) * 64 + n) * (S5L + 1) + tau] = (f32x2){z.re, z.im}; }
    for (int i = gt; i < NL * 2 * GW * 4 * 16; i += GT) { const int q = i % 16, r = i / 16, n = r % 64, g = (r / 64) % S5G, dir = (r / (64 * S5G)) % 2, l = r / (2 * 64 * S5G);
        const Cplx z = s5_beta(C, l, dir, g, n, q); ((f32x2*)(C.ws + WS_S5T + (size_t)l * SZ_S5L + OFF_S5BETA))[((size_t)(dir * S5G + g) * 64 + n) * 16 + q] = (f32x2){z.re, z.im}; }
    for (int i = gt; i < NL * 2 * GW * 4; i += GT) { const int n = i % 64, g = (i / 64) % S5G, dir = (i / (64 * S5G)) % 2, l = i / (2 * 64 * S5G); const Cplx z = s5_lam_pow(C, l, dir, g, n, (float)S5L);
        ((f32x2*)(C.ws + WS_S5T + (size_t)l * SZ_S5L + OFF_S5LAM))[(dir * S5G + g) * 64 + n] = (f32x2){z.re, z.im}; }
}
DI void ph_tab(const Ctx& C) {
    const long gt = (long)C.bid * NTHR + C.tid, GT = (long)C.G * NTHR;
    for (long i = gt; i < (long)NL * S5G * 256 * 512; i += GT) {
        const int k = (int)(i % 512), np = (int)((i / 512) % 256), g = (int)((i / (512 * 256)) % S5G), l = (int)(i / ((long)512 * 256 * S5G));
        const int j = k >> 4, q = k & 15, dir = np >> 7, n = np & 63, im = (np >> 6) & 1;
        const f32x2 lp = ((const f32x2*)(C.ws + WS_S5T + (size_t)l * SZ_S5L + OFF_S5LP))[((size_t)(dir * S5G + g) * 64 + n) * (S5L + 1) + (dir == 0 ? S5L - 1 - j : j)];
        const f32x2 be = ((const f32x2*)(C.ws + WS_S5T + (size_t)l * SZ_S5L + OFF_S5BETA))[((size_t)(dir * S5G + g) * 64 + n) * 16 + q];
        const Cplx w = cmul(Cplx{lp[0], lp[1]}, Cplx{be[0], be[1]});
        ((bf16*)(C.ws + WS_S5T + (size_t)l * SZ_S5L + OFF_S5ET))[((size_t)g * 256 + np) * 512 + k] = (bf16)f2bf(im ? w.im : w.re); }
    for (long i = gt; i < (long)NL * S5G * 512 * S5K; i += GT) {
        const int k = (int)(i % S5K), nn = (int)((i / S5K) % 512), g = (int)((i / ((long)S5K * 512)) % S5G), l = (int)(i / ((long)S5K * 512 * S5G));
        const int ti = nn >> 4, p = nn & 15; float v;
        if (k < 512) { const int j = k >> 4, q = k & 15; const float* kc = (const float*)(C.ws + WS_S5T + (size_t)l * SZ_S5L + OFF_S5KC) + (size_t)g * 2 * S5L * 256;
            v = 0.f; if (j <= ti) v += kc[((ti - j)) * 256 + p * 16 + q]; if (j >= ti) v += kc[(S5L + (j - ti)) * 256 + p * 16 + q]; }
        else { const int kk = k - 512, dir = kk >> 7, im = (kk >> 6) & 1, n = kk & 63;
            const f32x2 lp = ((const f32x2*)(C.ws + WS_S5T + (size_t)l * SZ_S5L + OFF_S5LP))[((size_t)(dir * S5G + g) * 64 + n) * (S5L + 1) + (dir == 0 ? ti + 1 : S5L - ti)];
            const Cplx w = cmul(s5_gamma(C, l, g, p, n), Cplx{lp[0], lp[1]}); v = im ? -w.im : w.re; }
        ((bf16*)(C.ws + WS_S5T + (size_t)l * SZ_S5L + OFF_S5BT))[((size_t)g * 512 + nn) * S5K + k] = (bf16)f2bf(v); }
    const int gw = C.bid * NW + C.wave, GWV = C.G * NW;
    for (int row = gw; row < M; row += GWV) {
        const float* src = row < M_LAT ? C.in[I_X] + (size_t)row * D : C.in[I_CTX] + (size_t)(row - M_LAT) * D;
        float* dst = xrow_ptr(C, row); const float* gs = gs_ptr(C, 0, 0, stream_of_row(row)); bf16* ap = (bf16*)(C.ws + WS_AP) + (size_t)row * D; float ss = 0.f;
        for (int c = 4 * C.lane; c < D; c += 256) { const f32x4 x = *(const f32x4*)(src + c); *(f32x4*)(dst + c) = x; ss += (x[0] * x[0] + x[1] * x[1]) + (x[2] * x[2] + x[3] * x[3]);
            const f32x4 a = x * *(const f32x4*)(gs + c); u32x2 w; w.x = pk2(a[0], a[1]); w.y = pk2(a[2], a[3]); *(u32x2*)(ap + c) = w; }
        ss = wave_sum(ss); if (C.lane == 0) rowss_ptr(C, 0, 0)[row] = ss;
    }
}

#ifdef EMU
DI s16x4 tr_read1(const LAS unsigned char* a) { return emu_tr_read(a); }
#else
DI s16x4 tr_read1(const LAS unsigned char* a) { s16x4 r; asm volatile("ds_read_b64_tr_b16 %0, %1\n\ts_waitcnt lgkmcnt(0)" : "=&v"(r) : "v"((unsigned)(size_t)a) : "memory"); return r; }
#endif
DI bf16x8 tr_frag(const LAS unsigned char* a0, int hi_off) {
#ifdef EMU
    const s16x4 lo = emu_tr_read(a0), hi = emu_tr_read(a0 + hi_off);
#else
    s16x4 lo, hi; asm volatile("ds_read_b64_tr_b16 %0, %2\n\tds_read_b64_tr_b16 %1, %3\n\ts_waitcnt lgkmcnt(0)" : "=&v"(lo), "=&v"(hi) : "v"((unsigned)(size_t)a0), "v"((unsigned)(size_t)(a0 + hi_off)) : "memory");
#endif
    return __builtin_shufflevector(lo, hi, 0, 1, 2, 3, 4, 5, 6, 7);
}
DI void tr_frag4(const LAS unsigned char* a0, const LAS unsigned char* a1, const LAS unsigned char* a2, const LAS unsigned char* a3, int hi_off, bf16x8 (&f)[4]) {
#ifdef EMU
    f[0] = tr_frag(a0, hi_off); f[1] = tr_frag(a1, hi_off); f[2] = tr_frag(a2, hi_off); f[3] = tr_frag(a3, hi_off);
#else
    s16x4 l0, h0, l1, h1, l2, h2, l3, h3;
    asm volatile("ds_read_b64_tr_b16 %0, %8\n\tds_read_b64_tr_b16 %1, %9\n\tds_read_b64_tr_b16 %2, %10\n\tds_read_b64_tr_b16 %3, %11\n\tds_read_b64_tr_b16 %4, %12\n\tds_read_b64_tr_b16 %5, %13\n\tds_read_b64_tr_b16 %6, %14\n\tds_read_b64_tr_b16 %7, %15\n\ts_waitcnt lgkmcnt(0)"
        : "=&v"(l0), "=&v"(h0), "=&v"(l1), "=&v"(h1), "=&v"(l2), "=&v"(h2), "=&v"(l3), "=&v"(h3)
        : "v"((unsigned)(size_t)a0), "v"((unsigned)(size_t)(a0 + hi_off)), "v"((unsigned)(size_t)a1), "v"((unsigned)(size_t)(a1 + hi_off)), "v"((unsigned)(size_t)a2), "v"((unsigned)(size_t)(a2 + hi_off)), "v"((unsigned)(size_t)a3), "v"((unsigned)(size_t)(a3 + hi_off)) : "memory");
    f[0] = __builtin_shufflevector(l0, h0, 0, 1, 2, 3, 4, 5, 6, 7); f[1] = __builtin_shufflevector(l1, h1, 0, 1, 2, 3, 4, 5, 6, 7); f[2] = __builtin_shufflevector(l2, h2, 0, 1, 2, 3, 4, 5, 6, 7); f[3] = __builtin_shufflevector(l3, h3, 0, 1, 2, 3, 4, 5, 6, 7);
#endif
}
DI bf16x8 pack8(const f32x16& x, int s) {
    u32x4 p; p.x = pk2(x[8 * s], x[8 * s + 1]); p.y = pk2(x[8 * s + 2], x[8 * s + 3]); p.z = pk2(x[8 * s + 4], x[8 * s + 5]); p.w = pk2(x[8 * s + 6], x[8 * s + 7]);
    return __builtin_bit_cast(bf16x8, p);
}
struct AttnSt { f32x16 o0, o1; float m, l; };
struct KVregs { bf16x8 k[4]; u32x4 v[4]; };
struct Kregs { bf16x8 k[4]; };
DI void k_load(Kregs& r, const bf16* Kb, int kp, int lane) {
    const int r32 = lane & 31, h = lane >> 5;
#pragma unroll
    for (int kk = 0; kk < 4; ++kk) r.k[kk] = *(const bf16x8*)(Kb + (size_t)r32 * kp + 16 * kk + 8 * h);
}
DI void kv_load(KVregs& r, const Kregs& kpre, const bf16* Vb, int vp, int lane) {
#pragma unroll
    for (int kk = 0; kk < 4; ++kk) r.k[kk] = kpre.k[kk];
#pragma unroll
    for (int i = 0; i < 4; ++i) { const int idx = lane + 64 * i, key = idx >> 3, ch = idx & 7; r.v[i] = *(const u32x4*)(Vb + (size_t)key * vp + ch * 8); }
}
template <bool MASKED>
DI void attn_block(AttnSt& st, const bf16x8 (&qf)[4], const KVregs& kv, LAS unsigned char* vl, int lane, const float (&addv)[16], unsigned vmask) {
    const int h = lane >> 5;
#pragma unroll
    for (int i = 0; i < 4; ++i) { const int idx = lane + 64 * i, key = idx >> 3, ch = idx & 7; *(LAS u32x4*)(vl + key * 128 + ch * 16) = kv.v[i]; }
    f32x16 s;
#pragma unroll
    for (int i = 0; i < 16; ++i) s[i] = 0.f;
#pragma unroll
    for (int kk = 0; kk < 4; ++kk) s = __builtin_amdgcn_mfma_f32_32x32x16_bf16(kv.k[kk], qf[kk], s, 0, 0, 0);
    float bm = -1e30f;
#pragma unroll
    for (int i = 0; i < 16; ++i) { if (MASKED) { s[i] += addv[i]; if ((vmask >> i) & 1u) bm = fmaxf(bm, s[i]); } else bm = fmaxf(bm, s[i]); }
    bm = fmaxf(bm, __shfl_xor(bm, 32));
    const float mn = fmaxf(st.m, bm), alpha = __expf(st.m - mn); st.m = mn;
    float ls = 0.f;
#pragma unroll
    for (int i = 0; i < 16; ++i) { float p = __expf(s[i] - mn); if (MASKED) p = ((vmask >> i) & 1u) ? p : 0.f; s[i] = p; ls += p; }
    st.l = st.l * alpha + ls;
#pragma unroll
    for (int i = 0; i < 16; ++i) { st.o0[i] *= alpha; st.o1[i] *= alpha; }
    WSYNC();
    const int q = (lane & 15) >> 2, p4 = lane & 3, blk = (lane >> 4) & 1;
    { const LAS unsigned char* ab = vl + (4 * h + q) * 128 + (16 * blk) * 2 + 8 * p4; bf16x8 vf[4];
      tr_frag4(ab, ab + 64, ab + 16 * 128, ab + 16 * 128 + 64, 8 * 128, vf);
      const bf16x8 pf0 = pack8(s, 0), pf1 = pack8(s, 1);
      st.o0 = __builtin_amdgcn_mfma_f32_32x32x16_bf16(vf[0], pf0, st.o0, 0, 0, 0); st.o1 = __builtin_amdgcn_mfma_f32_32x32x16_bf16(vf[1], pf0, st.o1, 0, 0, 0);
      st.o0 = __builtin_amdgcn_mfma_f32_32x32x16_bf16(vf[2], pf1, st.o0, 0, 0, 0); st.o1 = __builtin_amdgcn_mfma_f32_32x32x16_bf16(vf[3], pf1, st.o1, 0, 0, 0); }
}
DI void attn_finish(AttnSt& st, bf16* orow  , int lane, float extra_l) {
    const int h = lane >> 5; float l = st.l + __shfl_xor(st.l, 32) + extra_l; const float inv = 1.0f / l;
#pragma unroll
    for (int g = 0; g < 4; ++g) {
        u32x2 w0, w1; w0.x = pk2(st.o0[4 * g] * inv, st.o0[4 * g + 1] * inv); w0.y = pk2(st.o0[4 * g + 2] * inv, st.o0[4 * g + 3] * inv);
        w1.x = pk2(st.o1[4 * g] * inv, st.o1[4 * g + 1] * inv); w1.y = pk2(st.o1[4 * g + 2] * inv, st.o1[4 * g + 3] * inv);
        *(u32x2*)(orow + 8 * g + 4 * h) = w0; *(u32x2*)(orow + 32 + 8 * g + 4 * h) = w1; }
}
DI int clampi(int v, int lo, int hi) { return v < lo ? lo : (v > hi ? hi : v); }
constexpr int AT_NA = NB * NH * (GRH / 2) * 4, AT_WA = NB * NH * (T / 32), AT_CX = NB * NH * (TC / 32);
DI void ph_attn(const Ctx& C, int l, bool want_ctx, int first_block) {
    if (C.bid < first_block) return;
    const int gw = (C.bid - first_block) * NW + C.wave, GWV = (C.G - first_block) * NW, lane = C.lane, r32 = lane & 31, h = lane >> 5;
    LAS unsigned char* vl = C.lds + C.wave * 4096;
    const bf16* QA = (const bf16*)(C.ws + WS_QA); const bf16* KA = (const bf16*)(C.ws + WS_KA); const bf16* VA = (const bf16*)(C.ws + WS_VA);
    const bf16* QC = (const bf16*)(C.ws + WS_QC); const bf16* KC = (const bf16*)(C.ws + WS_KC); const bf16* VC = (const bf16*)(C.ws + WS_VC);
    bf16* OB = (bf16*)(C.ws + WS_OB);
    const int ntiles = AT_NA + AT_WA + (want_ctx ? 2 * AT_CX : 0);
    const float zero16[16] = {0.f, 0.f, 0.f, 0.f, 0.f, 0.f, 0.f, 0.f, 0.f, 0.f, 0.f, 0.f, 0.f, 0.f, 0.f, 0.f};
    for (int tile = gw; tile < ntiles; tile += GWV) {
        AttnSt st; st.m = -1e30f; st.l = 0.f;
#pragma unroll
        for (int i = 0; i < 16; ++i) { st.o0[i] = 0.f; st.o1[i] = 0.f; }
        bf16x8 qf[4];
        if (tile < AT_NA) {
            const int cb = tile & 3, rp = (tile >> 2) % (GRH / 2), hd = (tile / (4 * (GRH / 2))) % NH, b = tile / (4 * (GRH / 2) * NH);
            const int r0 = 2 * rp, c0 = 16 * cb, qr = r0 + (r32 >> 4), qc = c0 + (r32 & 15), qrow = b * T + qr * GRW + qc;
#pragma unroll
            for (int kk = 0; kk < 4; ++kk) qf[kk] = *(const bf16x8*)(QA + (size_t)qrow * GW + hd * 64 + 16 * kk + 8 * h);
            const int rsq = clampi(qr - 4, 0, GRH - 8), csq = clampi(qc - 8, 0, GRW - 16);
            const int rsA = clampi(r0 - 4, 0, GRH - 8), rsB = clampi(r0 + 1 - 4, 0, GRH - 8), kc0 = clampi(c0 - 8, 0, GRW - 32);
            const float* rpb = C.in[I_NARPB] + ((size_t)l * NH + hd) * 465;
            const int nbn = rsB + 8 - rsA, nbt = nbn + TC / 32; KVregs cur; Kregs nxt;
#define NA_ROW(i) ((i) < nbn ? (size_t)b * T + (rsA + (i)) * GRW + kc0 : (size_t)M_LAT + b * TC + 32 * ((i) - nbn))
            { const size_t kr0 = NA_ROW(0); k_load(nxt, KA + kr0 * GW + hd * 64, GW, lane); }
            for (int ib = 0; ib < nbt; ++ib) {
                { const size_t kr0 = NA_ROW(ib); kv_load(cur, nxt, VA + kr0 * GW + hd * 64, GW, lane); }
                if (ib + 1 < nbt) { const size_t kr1 = NA_ROW(ib + 1); k_load(nxt, KA + kr1 * GW + hd * 64, GW, lane); }
                if (ib < nbn) { const int kr = rsA + ib; float addv[16]; unsigned vm = 0u; const bool rok = kr >= rsq && kr <= rsq + 7;
#pragma unroll
                    for (int i = 0; i < 16; ++i) { const int kb = (i & 3) + 8 * (i >> 2) + 4 * h, kc = kc0 + kb; const bool ok = rok && kc >= csq && kc <= csq + 15;
                        const int bi = ok ? (kr - qr + 7) * 31 + (kc - qc + 15) : 0; addv[i] = rpb[bi]; vm |= ok ? (1u << i) : 0u; }
                    attn_block<true>(st, qf, cur, vl, lane, addv, vm); }
                else attn_block<false>(st, qf, cur, vl, lane, zero16, 0xffffu); }
#undef NA_ROW
            attn_finish(st, OB + (size_t)qrow * D + hd * 64, lane, 0.f);
        } else if (tile < AT_NA + AT_WA) {
            const int t2 = tile - AT_NA, qb = t2 % (T / 32), hd = (t2 / (T / 32)) % NH, b = t2 / ((T / 32) * NH), kvh = hd / WAG;
            const int qt = 32 * qb + r32, qrow = b * T + qt;
#pragma unroll
            for (int kk = 0; kk < 4; ++kk) qf[kk] = *(const bf16x8*)(QC + (size_t)qrow * GW + hd * 64 + 16 * kk + 8 * h);
            const int i_lo = 4 - qb > 0 ? 4 - qb : 0, i_hi = (T / 32 - qb + 4) < 9 ? (T / 32 - qb + 4) : 9, nbw = i_hi - i_lo, nbt = nbw + TC / 32; KVregs cur; Kregs nxt;
#define WA_ROW(i) ((i) < nbw ? (size_t)b * T + 32 * qb - 128 + 32 * (i_lo + (i)) : (size_t)M_LAT + b * TC + 32 * ((i) - nbw))
            { const size_t kr0 = WA_ROW(0); k_load(nxt, KC + kr0 * 128 + kvh * 64, 128, lane); }
            for (int ib = 0; ib < nbt; ++ib) {
                { const size_t kr0 = WA_ROW(ib); kv_load(cur, nxt, VC + kr0 * 128 + kvh * 64, 128, lane); }
                if (ib + 1 < nbt) { const size_t kr1 = WA_ROW(ib + 1); k_load(nxt, KC + kr1 * 128 + kvh * 64, 128, lane); }
                if (ib < nbw) { const int t0 = 32 * qb - 128 + 32 * (i_lo + ib); float addv[16]; unsigned vm = 0u;
#pragma unroll
                    for (int i = 0; i < 16; ++i) { const int kt = t0 + (i & 3) + 8 * (i >> 2) + 4 * h, rel = kt - qt; addv[i] = 0.f; vm |= (rel >= -128 && rel <= 128) ? (1u << i) : 0u; }
                    attn_block<true>(st, qf, cur, vl, lane, addv, vm); }
                else attn_block<false>(st, qf, cur, vl, lane, zero16, 0xffffu); }
#undef WA_ROW
            const float sk = C.in[I_WASINK][(size_t)l * NH + hd];
            const float mfin = fmaxf(st.m, sk), a2 = __expf(st.m - mfin);
#pragma unroll
            for (int i = 0; i < 16; ++i) { st.o0[i] *= a2; st.o1[i] *= a2; }
            st.l *= a2; st.m = mfin;
            attn_finish(st, OB + (size_t)qrow * D + 2 * GW + hd * 64, lane, __expf(sk - mfin));
        } else {
            const int t2 = tile - AT_NA - AT_WA, isc = t2 >= AT_CX, t3 = t2 - isc * AT_CX, qb = t3 % (TC / 32), hd = (t3 / (TC / 32)) % NH, b = t3 / ((TC / 32) * NH), kvh = hd / WAG;
            const int qrow = M_LAT + b * TC + 32 * qb + r32;
            const bf16* Qs = isc ? QC : QA; const bf16* Ks = isc ? KC + kvh * 64 : KA + hd * 64; const bf16* Vs = isc ? VC + kvh * 64 : VA + hd * 64; const int kp = isc ? 128 : GW;
#pragma unroll
            for (int kk = 0; kk < 4; ++kk) qf[kk] = *(const bf16x8*)(Qs + (size_t)qrow * GW + hd * 64 + 16 * kk + 8 * h);
            { KVregs cur; Kregs nxt; const size_t kr0 = (size_t)M_LAT + b * TC; k_load(nxt, Ks + kr0 * kp, kp, lane);
              for (int cbk = 0; cbk < TC / 32; ++cbk) { kv_load(cur, nxt, Vs + (kr0 + 32 * cbk) * kp, kp, lane); if (cbk + 1 < TC / 32) k_load(nxt, Ks + (kr0 + 32 * (cbk + 1)) * kp, kp, lane);
                  attn_block<false>(st, qf, cur, vl, lane, zero16, 0xffffu); } }
            float extra = 0.f;
            if (isc) { const float sk = C.in[I_WASINK][(size_t)l * NH + hd]; const float mfin = fmaxf(st.m, sk), a2 = __expf(st.m - mfin);
#pragma unroll
                for (int i = 0; i < 16; ++i) { st.o0[i] *= a2; st.o1[i] *= a2; }
                st.l *= a2; st.m = mfin; extra = __expf(sk - mfin); }
            attn_finish(st, OB + (size_t)qrow * D + (isc ? 2 * GW : 0) + hd * 64, lane, extra);
        }
    }
}

DI void ph_ctxfix(const Ctx& C, const float* gsn  , float* rowss_next) {
    const int gw = C.bid * NW + C.wave, GWV = C.G * NW;
    for (int r = gw; r < M_CTX; r += GWV) { const int row = M_LAT + r; const float* xp = xrow_ptr(C, row); const float* gs = gsn + (size_t)NB * D; bf16* ap = (bf16*)(C.ws + WS_AP) + (size_t)row * D; float ss = 0.f;
        for (int c = 4 * C.lane; c < D; c += 256) { const f32x4 x = *(const f32x4*)(xp + c); ss += (x[0] * x[0] + x[1] * x[1]) + (x[2] * x[2] + x[3] * x[3]);
            const f32x4 a = x * *(const f32x4*)(gs + c); u32x2 w; w.x = pk2(a[0], a[1]); w.y = pk2(a[2], a[3]); *(u32x2*)(ap + c) = w; }
        ss = wave_sum(ss); if (C.lane == 0) rowss_next[row] = ss; }
}
constexpr int PT = 144;
constexpr int RW_HALF = 73472, IM_BT = 0, IM_KT = 9216, IM_RT = 18432, IM_ARB = 27648, IM_AT = 36864, IM_AAK = 46080, IM_F = 55296, IM_GC = 72704, FP = 68;
DI void chunk_rows(int b, int dir, int c, int& row0, int& step) {
    if (c < TC / 64) { const int p0 = 64 * c; row0 = M_LAT + b * TC + (dir ? TC - 1 - p0 : p0); } else { const int p0 = 64 * (c - TC / 64); row0 = b * T + (dir ? T - 1 - p0 : p0); }
    step = dir ? -1 : 1;
}
DI bf16x8 frag_rows(const LAS unsigned char* img, int tile, int s, int lane) { return *(const LAS bf16x8*)(img + (32 * tile + (lane & 31)) * PT + (16 * s + 8 * (lane >> 5)) * 2); }
DI bf16x8 frag_cols(const LAS unsigned char* img, int tile, int s, int lane) {
    const int h = lane >> 5, q = (lane & 15) >> 2, p4 = lane & 3, blk = (lane >> 4) & 1;
    const LAS unsigned char* a0 = img + (16 * s + 8 * h + q) * PT + (32 * tile + 16 * blk) * 2 + 8 * p4;
    return tr_frag(a0, 4 * PT);
}
DI void store_T(const f32x16& acc, LAS unsigned char* img, int ti, int tj, int lane) {
    const int c = lane & 31, h = lane >> 5;
#pragma unroll
    for (int g = 0; g < 4; ++g) { u32x2 w; w.x = pk2(acc[4 * g], acc[4 * g + 1]); w.y = pk2(acc[4 * g + 2], acc[4 * g + 3]); *(LAS u32x2*)(img + (32 * tj + c) * PT + (32 * ti + 8 * g + 4 * h) * 2) = w; }
}
DI f32x16 zero16v() { f32x16 z;
#pragma unroll
    for (int i = 0; i < 16; ++i) z[i] = 0.f; return z; }
#define MMA32(a, b, c) __builtin_amdgcn_mfma_f32_32x32x16_bf16((a), (b), (c), 0, 0, 0)
constexpr int PDW = 80, PDG = 208, IM_TW = 0, IM_TA = 17408, IM_DW = 36864, IM_DA = 41984, IM_DG = 47104;
DI void ph_rw1(const Ctx& C, int l) {
    const int wg = C.wave & 3, grp = C.wave >> 2, ti = wg >> 1, tj = wg & 1;
    bf16* QH = (bf16*)(C.ws + WS_QH); float* YL = (float*)(C.ws + WS_YL); bf16* MF = (bf16*)(C.ws + WS_MF); float* GF = (float*)(C.ws + WS_GF); bf16* RVKG = (bf16*)(C.ws + WS_RVKG);
    const bf16* PB = (const bf16*)(C.ws + WS_PB); const float* PS = (const float*)(C.ws + WS_PS);
    const bf16x8* RWF = (const bf16x8*)(C.ws + WS_RWF + (size_t)l * SZ_RWF);
    constexpr int nblk = (TC + T) / 64;
    for (int it0 = 2 * C.bid; it0 < RBLK; it0 += 2 * C.G) {
        int lane_ = threadIdx.x & 63; OPAQUE(lane_); const int lane = lane_, c32 = lane & 31, h = lane >> 5;
        LAS unsigned char* L = OPAQUE_LDS(C.lds + grp * RW_HALF);
        LAS float* F = (LAS float*)(L + IM_F); LAS float* SEG = (LAS float*)(L + IM_F); LAS float* GC = (LAS float*)(L + IM_GC);
        LAS float* TW = (LAS float*)(L + IM_TW); LAS float* TA = (LAS float*)(L + IM_TA);
        unsigned char* PK = C.ws + WS_RWS + ((size_t)C.bid * 2 + grp) * 65536;
        const int item = it0 + grp; const bool live = item < RBLK; const int itc = live ? item : RBLK - 1;
        const int tb = itc % nblk, hd = (itc / nblk) % NH, b = itc / (nblk * NH), cg = hd * 64 + lane;
        const int rowb = tb < TC / 64 ? M_LAT + b * TC + 64 * tb : b * T + 64 * (tb - TC / 64);
        const int seq_lo = tb < TC / 64 ? M_LAT + b * TC : b * T, seq_hi = seq_lo + (tb < TC / 64 ? TC : T);
        bf16* RV = RVKG + (size_t)itc * 4 * 4096;
        __syncthreads();
        float r_[16], kf_[16], kk_[16], ks_[16];
        { const float* cw = C.in[I_RWCONV] + (size_t)l * 9 * GW; float cwv[3][3];
#pragma unroll
          for (int j = 0; j < 3; ++j)
#pragma unroll
              for (int x = 0; x < 3; ++x) cwv[j][x] = cw[(size_t)j * 3 * GW + x * GW + cg];
          const float kkw = C.in[I_RWKK][(size_t)l * GW + cg];
          const int r0 = rowb + 16 * wg; float pr[3], cu[3], nx[3];
#pragma unroll
          for (int x = 0; x < 3; ++x) { pr[x] = r0 - 1 >= seq_lo ? bf2f(PB[(size_t)(r0 - 1) * 3 * GW + x * GW + cg]) : 0.f; cu[x] = bf2f(PB[(size_t)r0 * 3 * GW + x * GW + cg]); }
#pragma unroll
          for (int t = 0; t < 16; ++t) { const int row = r0 + t;
#pragma unroll
              for (int x = 0; x < 3; ++x) nx[x] = row + 1 < seq_hi ? bf2f(PB[(size_t)(row + 1) * 3 * GW + x * GW + cg]) : 0.f;
              r_[t] = pr[0] * cwv[0][0] + cu[0] * cwv[1][0] + nx[0] * cwv[2][0]; kf_[t] = pr[1] * cwv[0][1] + cu[1] * cwv[1][1] + nx[1] * cwv[2][1]; const float v_t = pr[2] * cwv[0][2] + cu[2] * cwv[1][2] + nx[2] * cwv[2][2];
#pragma unroll
              for (int x = 0; x < 3; ++x) { pr[x] = cu[x]; cu[x] = nx[x]; }
              const float kkv = kf_[t] * kkw, ssq = wave_sum(kkv * kkv); kk_[t] = kkv / fmaxf(sqrtf(ssq), 1e-12f); ks_[t] = 0.f;
              RV[(16 * wg + t) * 64 + lane] = (bf16)f2bf(r_[t]); RV[4096 + (16 * wg + t) * 64 + lane] = (bf16)f2bf(v_t);
#pragma unroll
              for (int kq = 0; kq < 3; ++kq) { const int k = lane + 64 * kq; if (k < 160) { const float pv = PS[(size_t)row * 160 + k]; const int tk = 16 * wg + t;
                  if (k < 32) *(LAS bf16*)(L + IM_DW + tk * PDW + k * 2) = (bf16)f2bf(tanhf(pv)); else if (k < 64) *(LAS bf16*)(L + IM_DA + tk * PDW + (k - 32) * 2) = (bf16)f2bf(pv); else *(LAS bf16*)(L + IM_DG + tk * PDG + (k - 64) * 2) = (bf16)f2bf(sigmf(pv)); } }
          }
        }
        __syncthreads();
        { f32x16 gacc = zero16v();
#pragma unroll
          for (int sx = 0; sx < 6; ++sx) gacc = MMA32(*(const LAS bf16x8*)(L + IM_DG + (32 * ti + c32) * PDG + (16 * sx + 8 * h) * 2), RWF[(((8 + sx) * NH + hd) * 2 + tj) * 64 + lane], gacc);
#pragma unroll
          for (int rg = 0; rg < 16; ++rg) { const int tk = 32 * ti + (rg & 3) + 8 * (rg >> 2) + 4 * h; RV[3 * 4096 + tk * 64 + 32 * tj + c32] = (bf16)f2bf(gacc[rg]); }
        }
        const float kaw = C.in[I_RWKA][(size_t)l * GW + cg];
#pragma unroll
        for (int pss = 0; pss < 2; ++pss) {
            const int dir = 1 - pss;
            __syncthreads();
            { f32x16 pw = zero16v(), pa = zero16v();
#pragma unroll
              for (int sx = 0; sx < 2; ++sx) { pw = MMA32(*(const LAS bf16x8*)(L + IM_DW + (32 * ti + c32) * PDW + (16 * sx + 8 * h) * 2), RWF[(((0 + 2 * dir + sx) * NH + hd) * 2 + tj) * 64 + lane], pw);
                                              pa = MMA32(*(const LAS bf16x8*)(L + IM_DA + (32 * ti + c32) * PDW + (16 * sx + 8 * h) * 2), RWF[(((4 + 2 * dir + sx) * NH + hd) * 2 + tj) * 64 + lane], pa); }
              const float w0 = C.in[I_RWW0][((size_t)l * 2 + dir) * GW + hd * 64 + 32 * tj + c32], a0 = C.in[I_RWA0][((size_t)l * 2 + dir) * GW + hd * 64 + 32 * tj + c32];
#pragma unroll
              for (int rg = 0; rg < 16; ++rg) { const int tk = 32 * ti + (rg & 3) + 8 * (rg >> 2) + 4 * h; const float z = -(w0 + pw[rg]), sp = z > 20.f ? z : log1pf(__expf(z));
                  TW[tk * FP + 32 * tj + c32] = -__expf(-sp - 0.5f); TA[tk * FP + 32 * tj + c32] = sigmf(a0 + pa[rg]); } }
            __syncthreads();
            const int cs = dir ? 3 - wg : wg;
            float lw[16], av[16], run = 0.f;
#pragma unroll
            for (int ii = 0; ii < 16; ++ii) { const int tl = dir ? 15 - ii : ii, tk = 16 * wg + tl; av[ii] = TA[tk * FP + lane]; run += TW[tk * FP + lane]; lw[ii] = run; }
            __syncthreads();
            SEG[cs * 64 + lane] = run;
            __syncthreads();
            float off = 0.f;
#pragma unroll
            for (int w2 = 0; w2 < 3; ++w2) off += (w2 < cs) ? SEG[w2 * 64 + lane] : 0.f;
            const float tot = SEG[lane] + SEG[64 + lane] + SEG[128 + lane] + SEG[192 + lane];
            if (wg == 0) { if (dir) ((float*)(PK + 32768))[lane] = __expf(tot); else GC[lane] = __expf(tot); }
#pragma unroll
            for (int ii = 0; ii < 16; ++ii) { const int tl = dir ? 15 - ii : ii, i = 16 * cs + ii;
                const float Li = lw[ii] + off, eL = __expf(Li), ieL = __builtin_amdgcn_rcpf(eL), eLm = __expf(Li - (lw[ii] - (ii ? lw[ii - 1] : 0.f)));
                const float a = av[ii], kd = kf_[tl] * (1.f + (a - 1.f) * kaw); ks_[tl] += kd;
                const bf16 vat = (bf16)f2bf(-kk_[tl] * eLm), vbt = (bf16)f2bf(kk_[tl] * a * ieL), vkt = (bf16)f2bf(kd * ieL), vrt = (bf16)f2bf(r_[tl] * eL);
                if (dir) { bf16* pk = (bf16*)PK + i * 64 + lane; pk[0] = vat; pk[4096] = vbt; pk[8192] = vkt; pk[12288] = vrt; }
                else { *(LAS bf16*)(L + IM_AT + i * PT + lane * 2) = vat; *(LAS bf16*)(L + IM_BT + i * PT + lane * 2) = vbt; *(LAS bf16*)(L + IM_KT + i * PT + lane * 2) = vkt; *(LAS bf16*)(L + IM_RT + i * PT + lane * 2) = vrt; } }
        }
#pragma unroll
        for (int t = 0; t < 16; ++t) RV[2 * 4096 + (16 * wg + t) * 64 + lane] = (bf16)f2bf(ks_[t]);
#pragma unroll 1
        for (int dir = 0; dir < 2; ++dir) {
            const int c = dir == 0 ? tb : (tb < TC / 64 ? TC / 64 - 1 - tb : TC / 64 + (T / 64 - 1 - (tb - TC / 64)));
            const size_t ci = ((size_t)((b * NH + hd) * 2 + dir)) * RCK + c;
            __syncthreads();
            if (dir) {
                const int tg = wg * 64 + lane;
#pragma unroll
                for (int im = 0; im < 4; ++im)
#pragma unroll
                    for (int rr = 0; rr < 2; ++rr) { const int idx = tg + 256 * rr, row = idx >> 3, ch = idx & 7; const int dsto = im == 0 ? IM_AT : im == 1 ? IM_BT : im == 2 ? IM_KT : IM_RT;
                        *(LAS u32x4*)(L + dsto + row * PT + ch * 16) = *(const u32x4*)(PK + im * 8192 + row * 128 + ch * 16); }
                if (wg == 0) GC[lane] = ((const float*)(PK + 32768))[lane];
                __syncthreads();
            }
            f32x16 accP;
            { f32x16 aab = zero16v(), aak = zero16v(), arb = zero16v(); accP = zero16v();
#pragma unroll
              for (int s = 0; s < 4; ++s) { const bf16x8 at_i = frag_rows(L + IM_AT, ti, s, lane), bt_j = frag_rows(L + IM_BT, tj, s, lane), kt_j = frag_rows(L + IM_KT, ti, s, lane), at_c = frag_rows(L + IM_AT, tj, s, lane),
                                              bt_r = frag_rows(L + IM_BT, ti, s, lane), rt_c = frag_rows(L + IM_RT, tj, s, lane);
                  aab = MMA32(at_i, bt_j, aab); aak = MMA32(kt_j, at_c, aak); arb = MMA32(bt_r, rt_c, arb); accP = MMA32(kt_j, rt_c, accP); }
#pragma unroll
              for (int r = 0; r < 16; ++r) { const int row = 32 * ti + (r & 3) + 8 * (r >> 2) + 4 * h, col = 32 * tj + c32;
                  F[row * FP + col] = col < row ? aab[r] : 0.f; aak[r] = row < col ? aak[r] : 0.f; arb[r] = row <= col ? arb[r] : 0.f; accP[r] = row <= col ? accP[r] : 0.f; }
              store_T(aak, L + IM_AAK, ti, tj, lane);
              store_T(arb, L + IM_ARB, ti, tj, lane); }
            __syncthreads();
            { float Wc[64]; const int col = 32 * wg + c32; const LAS unsigned char* src = col < 64 ? L + IM_AT + col * 2 : L + IM_AAK + (col - 64) * 2;
              const LAS float* Fo = OPAQUE_LDS(F);
#pragma unroll
              for (int i = 0; i < 64; ++i) Wc[i] = bf2f(*(const LAS bf16*)(src + i * PT));
#pragma unroll
              for (int i = 1; i < 64; ++i) { float a0 = Wc[i], a1 = 0.f, a2 = 0.f, a3 = 0.f;
#pragma unroll
                  for (int j4 = 0; j4 < (i + 3) / 4; ++j4) { const f32x4 f = *(const LAS f32x4*)(Fo + i * FP + 4 * j4); a0 += f[0] * Wc[4 * j4]; a1 += f[1] * Wc[4 * j4 + 1]; a2 += f[2] * Wc[4 * j4 + 2]; a3 += f[3] * Wc[4 * j4 + 3];
                      if ((j4 & 7) == 7) PIN4(a0, a1, a2, a3); }
                  PIN4(a0, a1, a2, a3); Wc[i] = (a0 + a1) + (a2 + a3); }
              __syncthreads();
              if (h == 0) { LAS unsigned char* dst = (col < 64 ? L + IM_AT + col * PT : L + IM_AAK + (col - 64) * PT);
#pragma unroll
                  for (int i8 = 0; i8 < 8; ++i8) { u32x4 w; w.x = pk2(Wc[8 * i8], Wc[8 * i8 + 1]); w.y = pk2(Wc[8 * i8 + 2], Wc[8 * i8 + 3]); w.z = pk2(Wc[8 * i8 + 4], Wc[8 * i8 + 5]); w.w = pk2(Wc[8 * i8 + 6], Wc[8 * i8 + 7]); *(LAS u32x4*)(dst + i8 * 16) = w; } }
#pragma unroll
              for (int ii = 0; ii < 16; ++ii) { const int tl = dir ? 15 - ii : ii, i = 16 * (dir ? 3 - wg : wg) + ii; *(LAS bf16*)(L + IM_F + i * PT + lane * 2) = RV[4096 + (16 * wg + tl) * 64 + lane]; }
            }
            __syncthreads();
            { f32x16 q;
#pragma unroll
              for (int g = 0; g < 4; ++g) { const u32x2 w = *(const LAS u32x2*)(L + IM_RT + (32 * tj + c32) * PT + (32 * ti + 8 * g + 4 * h) * 2); q[4 * g] = bflo(w.x); q[4 * g + 1] = bfhi(w.x); q[4 * g + 2] = bflo(w.y); q[4 * g + 3] = bfhi(w.y); }
#pragma unroll
              for (int s = 0; s < 4; ++s) { const bf16x8 arb = frag_rows(L + IM_ARB, tj, s, lane); q = MMA32(frag_rows(L + IM_AT, ti, s, lane), arb, q); accP = MMA32(frag_rows(L + IM_AAK, ti, s, lane), arb, accP); }
              if (live) {
#pragma unroll
                  for (int g = 0; g < 4; ++g) { u32x2 w; w.x = pk2(q[4 * g], q[4 * g + 1]); w.y = pk2(q[4 * g + 2], q[4 * g + 3]); *(u32x2*)(QH + ci * 4096 + (32 * tj + c32) * 64 + 32 * ti + 8 * g + 4 * h) = w; } }
            }
            __syncthreads();
            store_T(accP, L + IM_RT, ti, tj, lane);
            __syncthreads();
            { f32x16 y = zero16v(), m = zero16v(), n;
#pragma unroll
              for (int g = 0; g < 4; ++g) { const u32x2 w = *(const LAS u32x2*)(L + IM_KT + (32 * tj + c32) * PT + (32 * ti + 8 * g + 4 * h) * 2); n[4 * g] = bflo(w.x); n[4 * g + 1] = bfhi(w.x); n[4 * g + 2] = bflo(w.y); n[4 * g + 3] = bfhi(w.y); }
#pragma unroll
              for (int s = 0; s < 4; ++s) { const bf16x8 btc_j = frag_cols(L + IM_BT, tj, s, lane), btc_i = frag_cols(L + IM_BT, ti, s, lane);
                  y = MMA32(frag_rows(L + IM_RT, ti, s, lane), frag_cols(L + IM_F, tj, s, lane), y);
                  m = MMA32(frag_rows(L + IM_AT, ti, s, lane), btc_j, m);
                  n = MMA32(btc_i, frag_rows(L + IM_AAK, tj, s, lane), n); }
              const float gck = GC[32 * tj + c32];
#pragma unroll
              for (int r = 0; r < 16; ++r) { const int row = 32 * ti + (r & 3) + 8 * (r >> 2) + 4 * h, col = 32 * tj + c32; m[r] = (m[r] + (row == col ? 1.0f : 0.f)) * gck; n[r] *= GC[row]; }
              if (live) {
#pragma unroll
                  for (int g = 0; g < 4; ++g) *(f32x4*)(YL + ci * 4096 + ((wg * 4 + g) * 64 + lane) * 4) = (f32x4){y[4 * g], y[4 * g + 1], y[4 * g + 2], y[4 * g + 3]};
#pragma unroll
                  for (int s2 = 0; s2 < 2; ++s2) *(bf16x8*)(MF + ci * 4096 + ((wg * 2 + s2) * 64 + lane) * 8) = pack8(m, s2); }
              store_T(n, L + IM_ARB, ti, tj, lane);
            }
            __syncthreads();
            { f32x16 gacc = zero16v();
#pragma unroll
              for (int s = 0; s < 4; ++s) gacc = MMA32(frag_cols(L + IM_ARB, ti, s, lane), frag_cols(L + IM_F, tj, s, lane), gacc);
              if (live) {
#pragma unroll
                  for (int g = 0; g < 4; ++g) *(f32x4*)(GF + ci * 4096 + ((wg * 4 + g) * 64 + lane) * 4) = (f32x4){gacc[4 * g], gacc[4 * g + 1], gacc[4 * g + 2], gacc[4 * g + 3]}; }
            }
        }
    }
    __syncthreads();
}
DI void ph_rw2(const Ctx& C) {
    const int lane = C.lane;
    const bf16* MF = (const bf16*)(C.ws + WS_MF); const float* GF = (const float*)(C.ws + WS_GF); bf16* SF = (bf16*)(C.ws + WS_SF);
    const int nwork = RSTR * 2;
    for (int wk = C.wave == 0 ? C.bid : nwork; wk < nwork; wk += C.G) {
        const int tj = wk & 1, stream = wk >> 1;
        f32x16 s0 = zero16v(), s1 = zero16v();
        bf16x8 mf[2][2][2]; f32x4 gq[2][4];
#define RW2_LOAD(item_) do { const size_t it_ = (item_); \
            _Pragma("unroll") for (int kp = 0; kp < 2; ++kp) _Pragma("unroll") for (int kt = 0; kt < 2; ++kt) _Pragma("unroll") for (int s = 0; s < 2; ++s) mf[kp][kt][s] = *(const bf16x8*)(MF + it_ * 4096 + (((kp * 2 + kt) * 2 + s) * 64 + lane) * 8); \
            _Pragma("unroll") for (int kt = 0; kt < 2; ++kt) _Pragma("unroll") for (int g = 0; g < 4; ++g) gq[kt][g] = *(const f32x4*)(GF + it_ * 4096 + (((kt * 2 + tj) * 4 + g) * 64 + lane) * 4); } while (0)
        RW2_LOAD((size_t)stream * RCK);
        for (int c = 0; c < RCK; ++c) {
            const size_t item = (size_t)stream * RCK + c;
            bf16x8 sf[2][2];
#pragma unroll
            for (int s = 0; s < 2; ++s) { sf[0][s] = pack8(s0, s); sf[1][s] = pack8(s1, s); *(bf16x8*)(SF + item * 4096 + (((0 * 2 + tj) * 2 + s) * 64 + lane) * 8) = sf[0][s]; *(bf16x8*)(SF + item * 4096 + (((1 * 2 + tj) * 2 + s) * 64 + lane) * 8) = sf[1][s]; }
            f32x16 n0, n1;
#pragma unroll
            for (int g = 0; g < 4; ++g) { n0[4 * g] = gq[0][g][0]; n0[4 * g + 1] = gq[0][g][1]; n0[4 * g + 2] = gq[0][g][2]; n0[4 * g + 3] = gq[0][g][3]; n1[4 * g] = gq[1][g][0]; n1[4 * g + 1] = gq[1][g][1]; n1[4 * g + 2] = gq[1][g][2]; n1[4 * g + 3] = gq[1][g][3]; }
            bf16x8 mc[2][2][2];
#pragma unroll
            for (int kp = 0; kp < 2; ++kp)
#pragma unroll
                for (int kt = 0; kt < 2; ++kt)
#pragma unroll
                    for (int s = 0; s < 2; ++s) mc[kp][kt][s] = mf[kp][kt][s];
            if (c + 1 < RCK) RW2_LOAD(item + 1);
#pragma unroll
            for (int kp = 0; kp < 2; ++kp)
#pragma unroll
                for (int s = 0; s < 2; ++s) { n0 = MMA32(mc[kp][0][s], sf[kp][s], n0); n1 = MMA32(mc[kp][1][s], sf[kp][s], n1); }
            s0 = n0; s1 = n1;
        }
#undef RW2_LOAD
    }
}
DI void ph_rw3(const Ctx& C, int l, int mrows) {
    const int lane = C.lane, wg = C.wave & 3, grp = C.wave >> 2, ti = wg >> 1, tj = wg & 1, c32 = lane & 31, h = lane >> 5;
    LAS float* Ysum = (LAS float*)(C.lds + grp * RW_HALF);
    const bf16* QH = (const bf16*)(C.ws + WS_QH); const float* YL = (const float*)(C.ws + WS_YL); const bf16* SF = (const bf16*)(C.ws + WS_SF); bf16* OB = (bf16*)(C.ws + WS_OB);
    const int nblk = (TC + T) / 64, nitems = NB * NH * nblk;
    for (int it0 = 2 * C.bid; it0 < nitems; it0 += 2 * C.G) {
        const int item = it0 + grp; const bool live = item < nitems; const int itc = live ? item : nitems - 1;
        const int tb = itc % nblk, hd = (itc / nblk) % NH, b = itc / (nblk * NH);
        const int rowb = tb < TC / 64 ? M_LAT + b * TC + 64 * tb : b * T + 64 * (tb - TC / 64);
        __syncthreads();
        f32x4 yl[2][4]; u32x4 qa[2][4]; bf16x8 sb[2][4];
#pragma unroll
        for (int dir = 0; dir < 2; ++dir) {
            const int c = dir == 0 ? tb : (tb < TC / 64 ? TC / 64 - 1 - tb : TC / 64 + (T / 64 - 1 - (tb - TC / 64)));
            const size_t ci = ((size_t)((b * NH + hd) * 2 + dir)) * RCK + c;
#pragma unroll
            for (int g = 0; g < 4; ++g) yl[dir][g] = *(const f32x4*)(YL + ci * 4096 + ((wg * 4 + g) * 64 + lane) * 4);
#pragma unroll
            for (int kp = 0; kp < 2; ++kp)
#pragma unroll
                for (int s = 0; s < 2; ++s) { const bf16* qp = QH + ci * 4096 + (32 * ti + c32) * 64 + 32 * kp + 16 * s + 4 * h; const u32x2 lo = *(const u32x2*)qp, hi = *(const u32x2*)(qp + 8);
                    qa[dir][kp * 2 + s].x = lo.x; qa[dir][kp * 2 + s].y = lo.y; qa[dir][kp * 2 + s].z = hi.x; qa[dir][kp * 2 + s].w = hi.y;
                    sb[dir][kp * 2 + s] = *(const bf16x8*)(SF + ci * 4096 + (((kp * 2 + tj) * 2 + s) * 64 + lane) * 8); }
        }
#pragma unroll
        for (int dir = 0; dir < 2; ++dir) {
            f32x16 y;
#pragma unroll
            for (int g = 0; g < 4; ++g) { const f32x4 a = yl[dir][g]; y[4 * g] = a[0]; y[4 * g + 1] = a[1]; y[4 * g + 2] = a[2]; y[4 * g + 3] = a[3]; }
#pragma unroll
            for (int q4 = 0; q4 < 4; ++q4) y = MMA32(__builtin_bit_cast(bf16x8, qa[dir][q4]), sb[dir][q4], y);
#pragma unroll
            for (int r = 0; r < 16; ++r) { const int i = 32 * ti + (r & 3) + 8 * (r >> 2) + 4 * h, tk = dir ? 63 - i : i; LAS float* p = Ysum + tk * FP + 32 * tj + c32; if (dir == 0) *p = y[r]; else *p += y[r]; }
            __syncthreads();
        }
        if (live) {
            const int cch = hd * 64 + lane; const float rk = C.in[I_RWRK][((size_t)l * NH + hd) * 64 + lane], gw = C.in[I_RWGNW][(size_t)l * GW + cch], gb = C.in[I_RWGNB][(size_t)l * GW + cch];
#pragma unroll 1
            for (int t4 = 0; t4 < 16; t4 += 8) {
                bf16 rb[8], vb[8], kb[8], gb8[8];
#pragma unroll
                for (int u = 0; u < 8; ++u) { const bf16* rv = (const bf16*)(C.ws + WS_RVKG) + (size_t)item * 4 * 4096 + (16 * wg + t4 + u) * 64 + lane; rb[u] = rv[0]; vb[u] = rv[4096]; kb[u] = rv[8192]; gb8[u] = rv[12288]; }
#pragma unroll
                for (int u = 0; u < 8; ++u) { const int tk = 16 * wg + t4 + u, row = rowb + tk; const float r = bf2f(rb[u]), v = bf2f(vb[u]), ks = bf2f(kb[u]), gg = bf2f(gb8[u]);
                    float y = Ysum[tk * FP + lane] + wave_sum(r * ks * rk) * v;
                    const float mu = wave_sum(y) * (1.f / 64.f), dlt = y - mu, var = wave_sum(dlt * dlt) * (1.f / 64.f);
                    if (row < mrows) OB[(size_t)row * D + GW + cch] = (bf16)f2bf((dlt * __builtin_amdgcn_rsqf(var + RW_GN_EPS) * gw + gb) * gg); } }
        }
    }
    __syncthreads();
}
DI void ph_s5scan(const Ctx& C, int l, int first_block) {
    const int nthreads_total = NB * 2 * S5G * 64;
    if (C.bid < first_block) return;
    const float* XE = (const float*)(C.ws + WS_XEND); bf16* UG = (bf16*)(C.ws + WS_UG);
    const f32x2* LAM = (const f32x2*)(C.ws + WS_S5T + (size_t)l * SZ_S5L + OFF_S5LAM);
    for (int id = (C.bid - first_block) * NTHR + C.tid; id < nthreads_total; id += (C.G - first_block) * NTHR) {
        const int n = id & 63, g = (id >> 6) % S5G, dir = (id / (64 * S5G)) & 1, b = id / (128 * S5G);
        const f32x2 lm = LAM[(dir * S5G + g) * 64 + n]; float xr = 0.f, xi = 0.f;
        const int nc_ctx = TC / S5L, nc_lat = T / S5L, ntot = nc_ctx + nc_lat;
        for (int i0 = 0; i0 < ntot; i0 += 8) {
            float er[8], ei[8]; int chs[8];
#pragma unroll
            for (int u = 0; u < 8; ++u) { const int i = i0 + u; int ch;
                if (i < nc_ctx) ch = (M_LAT + b * TC) / S5L + (dir ? nc_ctx - 1 - i : i); else ch = (b * T) / S5L + (dir ? nc_lat - 1 - (i - nc_ctx) : (i - nc_ctx));
                chs[u] = ch; const float* p = XE + ((size_t)g * NCHP + ch) * 256 + dir * 128 + n; er[u] = p[0]; ei[u] = p[64]; }
#pragma unroll
            for (int u = 0; u < 8; ++u) { bf16* q = UG + ((size_t)g * NCHP + chs[u]) * S5K + 512 + dir * 128 + n; q[0] = (bf16)f2bf(xr); q[64] = (bf16)f2bf(xi);
                const float nr = lm[0] * xr - lm[1] * xi + er[u], ni = lm[0] * xi + lm[1] * xr + ei[u]; xr = nr; xi = ni; }
        }
    }
}

constexpr int PH_PRO = 3, PH_PER_L = 13, NPH = PH_PRO + PH_PER_L * NL;
#ifndef PROBE_REP
#define PROBE_REP -1
#endif
#define NREP(k) ((k) == PROBE_REP ? 2 : 1)
#ifdef ONLY
#define EN(k) ((k) == ONLY)
#else
#define EN(k) true
#endif
#ifdef EMU
void fwd(Args args) {
    unsigned char* lds = emu::lds_base();
#else
__global__ void __launch_bounds__(NTHR, 2) fwd(Args args) {
    extern __shared__ __attribute__((aligned(16))) unsigned char lds[];
#endif
    Ctx C; C.in = args.in; C.out = args.out; C.ws = args.ws; C.lds = (LAS unsigned char*)lds;
    C.tid = threadIdx.x; C.lane = C.tid & 63; C.wave = __builtin_amdgcn_readfirstlane(C.tid >> 6); C.G = gridDim.x; C.bid = blockIdx.x;
#define REFRESH() do { int t_ = threadIdx.x; OPAQUE(t_); C.tid = t_; C.lane = t_ & 63; C.wave = __builtin_amdgcn_readfirstlane(t_ >> 6); } while (0)
    volatile LAS unsigned* MISC = (volatile LAS unsigned*)(C.lds + MISC_OFF);
    if (C.tid < 32) MISC[C.tid] = 0u;
    __syncthreads();
    const int lo = args.ph_lo, hi = args.ph_hi;
    const bool use_bar = (hi - lo) > 1;
    XcdBarrier bar; bar.bar = (unsigned*)(C.ws + WS_CTL) + CW_BAR; bar.x = 0; bar.st = MISC + 8;
    if (use_bar) bar = xcd_barrier_post((unsigned*)(C.ws + WS_CTL) + CW_BAR, MISC + 8);
#define IN(k) (lo <= (k) && (k) < hi)
#define SEAM(k) do { if (IN(k) && IN((k) + 1)) xcd_barrier(bar); } while (0)
    if (EN(0) && IN(0)) for (int rep = 0; rep < NREP(0); ++rep) { REFRESH(); ph_ada(C); }
    SEAM(0);
    if (EN(1) && IN(1)) { REFRESH(); ph_conv(C); }
    SEAM(1);
    if (EN(2) && IN(2)) for (int rep = 0; rep < NREP(2); ++rep) { REFRESH(); ph_tab(C); }
    SEAM(2);
    for (int l = 0; l < NL; ++l) {
        const int pb = PH_PRO + PH_PER_L * l; const bool want_ctx = l < NL - 1;
        const int mrows_full = M, mrows_out = want_ctx ? M : M_LAT;
        bf16* AP = (bf16*)(C.ws + WS_AP); bf16* Hb = (bf16*)(C.ws + WS_H); bf16* OB = (bf16*)(C.ws + WS_OB);
        if (EN(3) && IN(pb + 0)) for (int rep = 0; rep < NREP(3); ++rep) { REFRESH();
            Gemm g{AP, wl(C, l, OFF_W1GU), D, D, D, 0, 0}; Order S; S.init(mrows_full / 256, 2 * FF / 256, 1, C.G, C.bid, D / 64);
            EpiGU E{rowss_ptr(C, l, 0), bias_ptr(C, l, 0), Hb, mrows_full}; gemm_phase(C.lds, g, S, E); }
        SEAM(pb + 0);
        if (EN(4) && IN(pb + 1)) { REFRESH();
            Gemm g{Hb, wl(C, l, OFF_W1D), FF, FF, FF, 0, 0}; Order S; S.init(M_LAT / 256, D / 256, 1, C.G, C.bid, FF / 64);
            EpiRes E{&C, gate_ptr(C, l, 0, 0), gs_ptr(C, l, 1, 0), rowss_ptr(C, l, 1), AP}; gemm_phase(C.lds, g, S, E);
            { REFRESH(); Order S2; S2.init_split(M_LAT / 256, M_CTX / 256, D / 256, 4, C.G, C.bid, FF / 64); EpiAcc E2{&C, gate_ptr(C, l, 0, 0)}; gemm_phase(C.lds, g, S2, E2); } }
        SEAM(pb + 1);
        if (EN(18) && IN(pb + 2)) { REFRESH(); ph_ctxfix(C, gs_ptr(C, l, 1, 0), rowss_ptr(C, l, 1)); }
        SEAM(pb + 2);
        if (EN(5) && IN(pb + 3)) for (int rep = 0; rep < NREP(5); ++rep) { REFRESH();
            Gemm g{AP, wl(C, l, OFF_WIN), D, D, D, 0, 0}; Order S; S.init(mrows_full / 256, NT_IN, 1, C.G, C.bid, D / 64);
            EpiIn E{&C, rowss_ptr(C, l, 1), bias_ptr(C, l, 1), l}; gemm_phase(C.lds, g, S, E); }
        SEAM(pb + 3);
        if (IN(pb + 4)) {
            if (EN(6)) for (int rep = 0; rep < NREP(6); ++rep) { REFRESH(); Gemm g{(const bf16*)(C.ws + WS_UG), (const bf16*)(C.ws + WS_S5T + (size_t)l * SZ_S5L + OFF_S5ET), S5K, 512, 512, (size_t)NCHP * S5K * 2, (size_t)256 * 512 * 2};
              Order S; S.init(NCHP / 256, 1, S5G, C.G, C.bid, 512 / 64); EpiS5A E{(float*)(C.ws + WS_XEND)}; gemm_phase(C.lds, g, S, E); }
            __syncthreads();
            for (int rep = 0; rep < NREP(9); ++rep) { if (EN(9)) { REFRESH(); ph_rw1(C, l); } }
            if (EN(7)) for (int rep = 0; rep < NREP(7); ++rep) { REFRESH(); ph_attn(C, l, want_ctx, (C.G >= 256 && 2 * C.G < RBLK && RBLK % (2 * C.G) != 0) ? (RBLK % (2 * C.G) + 1) / 2 : 0); }
        }
        SEAM(pb + 4);
        if (IN(pb + 5)) { if (EN(17)) for (int rep = 0; rep < NREP(17); ++rep) { REFRESH(); ph_rw2(C); } if (EN(10)) for (int rep = 0; rep < NREP(10); ++rep) { REFRESH(); ph_s5scan(C, l, C.G >= 256 ? 128 : 0); }
            if (EN(1) && l + 1 < NL) { REFRESH();
                if (C.G >= 256) { if (C.bid >= 64 && !(C.bid >= 128 && C.bid < 144)) { const int rk = C.bid - 64 - (C.bid >= 144 ? 16 : 0); conv_weights(C, l + 1, rk * NW + C.wave, (C.G - 80) * NW); } }
                else conv_weights(C, l + 1, C.bid * NW + C.wave, C.G * NW); } }
        SEAM(pb + 5);
        if (IN(pb + 6)) {
            if (EN(11)) for (int rep = 0; rep < NREP(11); ++rep) { REFRESH(); Gemm g{(const bf16*)(C.ws + WS_UG), (const bf16*)(C.ws + WS_S5T + (size_t)l * SZ_S5L + OFF_S5BT), S5K, S5K, S5K, (size_t)NCHP * S5K * 2, (size_t)512 * S5K * 2};
              Order S; S.init(NCHP / 256, 2, S5G, C.G, C.bid, S5K / 64); EpiS5C E{(const bf16*)(C.ws + WS_UG), C.in[I_S5D] + (size_t)l * GW, (bf16*)(C.ws + WS_YG)}; gemm_phase(C.lds, g, S, E); }
            if (EN(12)) for (int rep = 0; rep < NREP(12); ++rep) { REFRESH(); ph_rw3(C, l, mrows_out); }
        }
        SEAM(pb + 6);
        if (EN(13) && IN(pb + 7)) for (int rep = 0; rep < NREP(13); ++rep) { REFRESH();
            Gemm g{(const bf16*)(C.ws + WS_YG), wl(C, l, OFF_WGLU), GW, GW, GW, 0, 0}; Order S; S.init(mrows_out / 256, GW / 256, 1, C.G, C.bid, GW / 64);
            EpiGLU E{(const bf16*)(C.ws + WS_YG), C.in[I_S5GLUB] + (size_t)l * GW, OB}; gemm_phase(C.lds, g, S, E); }
        SEAM(pb + 7);
        if (EN(14) && IN(pb + 8)) { REFRESH();
            Gemm g{OB, wl(C, l, OFF_WOUT), D, D, D, 0, 0}; Order S; S.init(M_LAT / 256, D / 256, 1, C.G, C.bid, D / 64);
            EpiRes E{&C, gate_ptr(C, l, 1, 0), gs_ptr(C, l, 2, 0), rowss_ptr(C, l, 2), AP}; gemm_phase(C.lds, g, S, E);
            if (want_ctx) { REFRESH(); Order S2; S2.init_split(M_LAT / 256, M_CTX / 256, D / 256, 4, C.G, C.bid, D / 64); EpiAcc E2{&C, gate_ptr(C, l, 1, 0)}; gemm_phase(C.lds, g, S2, E2); } }
        SEAM(pb + 8);
        if (EN(18) && IN(pb + 9) && want_ctx) { REFRESH(); ph_ctxfix(C, gs_ptr(C, l, 2, 0), rowss_ptr(C, l, 2)); }
        SEAM(pb + 9);
        if (EN(15) && IN(pb + 10)) { REFRESH();
            Gemm g{AP, wl(C, l, OFF_W2GU), D, D, D, 0, 0}; Order S; S.init(mrows_out / 256, 2 * FF / 256, 1, C.G, C.bid, D / 64);
            EpiGU E{rowss_ptr(C, l, 2), bias_ptr(C, l, 2), Hb, mrows_out}; gemm_phase(C.lds, g, S, E); }
        SEAM(pb + 10);
        if (EN(16) && IN(pb + 11)) { REFRESH();
            Gemm g{Hb, wl(C, l, OFF_W2D), FF, FF, FF, 0, 0}; Order S; S.init(M_LAT / 256, D / 256, 1, C.G, C.bid, FF / 64);
            const bool more = l + 1 < NL;
            EpiRes E{&C, gate_ptr(C, l, 2, 0), more ? gs_ptr(C, l + 1, 0, 0) : nullptr, more ? rowss_ptr(C, l + 1, 0) : nullptr, AP}; gemm_phase(C.lds, g, S, E);
            if (want_ctx) { REFRESH(); Order S2; S2.init_split(M_LAT / 256, M_CTX / 256, D / 256, 4, C.G, C.bid, FF / 64); EpiAcc E2{&C, gate_ptr(C, l, 2, 0)}; gemm_phase(C.lds, g, S2, E2); } }
        SEAM(pb + 11);
        if (EN(18) && IN(pb + 12) && want_ctx) { REFRESH(); ph_ctxfix(C, gs_ptr(C, l + 1, 0, 0), rowss_ptr(C, l + 1, 0)); }
        SEAM(pb + 12);
    }
#undef IN
#undef SEAM
}

#ifndef MK_PER_PHASE
#define MK_PER_PHASE 0
#endif
#ifdef EMU
int g_emu_grid = 4, g_emu_lo = 0, g_emu_hi = NPH;
#endif
extern "C" void kernel_launch(void* const* d_in, const int* in_sizes, int n_in, void* d_out, int out_size, void* d_ws, size_t ws_size, hipStream_t stream) {
    Args a{};
    for (int i = 0; i < 42; ++i) a.in[i] = (const float*)d_in[i];
    a.out = (float*)d_out; a.ws = (unsigned char*)d_ws;
#ifdef EMU
    if (g_emu_lo == 0) hipMemsetAsync(d_ws, 0, WS_ZERO_END, stream);
    for (int ph = g_emu_lo; ph < g_emu_hi; ++ph) { a.ph_lo = ph; a.ph_hi = ph + 1; fprintf(stderr, "phase %d\n", ph); emu::launch(g_emu_grid, NTHR, LDS_BYTES, [=] { fwd(a); }); }
#else
    static int grid = 0;
    if (grid == 0) {
        if (n_in != 42 || out_size != M_LAT * D || ws_size < WS_END) { fprintf(stderr, "kernel_launch: unexpected shapes (n_in %d out %d ws %zu need %zu)\n", n_in, out_size, ws_size, (size_t)WS_END); grid = -1; return; }
        int dev = 0, cus = 0;
        if (hipGetDevice(&dev) != hipSuccess || hipDeviceGetAttribute(&cus, hipDeviceAttributeMultiprocessorCount, dev) != hipSuccess) { grid = -1; return; }
        if (hipFuncSetAttribute((const void*)fwd, hipFuncAttributeMaxDynamicSharedMemorySize, LDS_BYTES) != hipSuccess) { fprintf(stderr, "kernel_launch: hipFuncSetAttribute failed\n"); grid = -1; return; }
        int per_cu = 0; (void)hipOccupancyMaxActiveBlocksPerMultiprocessor(&per_cu, (const void*)fwd, NTHR, LDS_BYTES); (void)hipGetLastError();
        if (per_cu < 1) fprintf(stderr, "kernel_launch: occupancy query reports %d\n", per_cu);
        grid = cus;
    }
    if (grid < 0) return;
    (void)hipMemsetAsync(d_ws, 0, WS_ZERO_END, stream);
#if MK_PER_PHASE
    for (int ph = 0; ph < NPH; ++ph) { a.ph_lo = ph; a.ph_hi = ph + 1; hipLaunchKernelGGL(fwd, dim3(grid), dim3(NTHR), LDS_BYTES, stream, a); }
#else
    a.ph_lo = 0; a.ph_hi = NPH;
    hipLaunchKernelGGL(fwd, dim3(grid), dim3(NTHR), LDS_BYTES, stream, a);
#endif
#endif
}
```

```cpp
#ifdef EMU
#include "emu/emu.h"
#define LAS
#define GAS
#define ASMV(...) ((void)0)
#define WSYNC() do { int _z = 0; (void)emu::wave_gather(&_z, 4); } while (0)
#define OPAQUE(x) ((void)0)
#define OPAQUE_S(x) ((void)0)
#define PIN(x) ((void)0)
#define PIN4(a, b, c, d) ((void)0)
#define OPAQUE_LDS(p) (p)
#else
#include <hip/hip_runtime.h>
#include <cstdio>
#include <cstdint>
#define LAS __attribute__((address_space(3)))
#define GAS __attribute__((address_space(1)))
#define ASMV(...) asm volatile(__VA_ARGS__)
#define PIN(x) asm volatile("" : "+v"(x) :: "memory")
#define PIN4(a, b, c, d) asm volatile("" : "+v"(a), "+v"(b), "+v"(c), "+v"(d) :: "memory")
template <class P> __device__ __forceinline__ P opaque_lds(P p) { unsigned a = (unsigned)(size_t)p; asm volatile("" : "+v"(a)); return (P)(size_t)a; }
#define OPAQUE_LDS(p) opaque_lds(p)
#define OPAQUE_S(x) asm volatile("" : "+s"(x))
#define OPAQUE(x) asm volatile("" : "+v"(x))
#define WSYNC() asm volatile("s_waitcnt lgkmcnt(0)" ::: "memory")
#endif

#ifdef EMU
constexpr int D = 1024, NB = 2, T = 1024, NL = 2, TC = 256, FF = 1024;
#else
constexpr int D = 2048, NB = 2, T = 8192, NL = 4, TC = 256, FF = 5632;
#endif
constexpr int GW = D / 4, NH = GW / 64, WAG = NH / 2, S5G = GW / 16, GRW = 64, GRH = T / GRW;
constexpr int M_LAT = NB * T, M_CTX = NB * TC, M = M_LAT + M_CTX, NPAN = M / 256;
constexpr int TP = GW / 256;
constexpr int NT_IN = 8 * TP + 2, NINP = NT_IN * 256, D_IN = 8 * GW + 416;
constexpr int PN_AQ = 0, PN_AK = TP, PN_AV = 2 * TP, PN_BR = 3 * TP, PN_BK = 4 * TP, PN_BV = 5 * TP, PN_BS = 6 * TP, PN_CQ = 6 * TP + 1, PN_CKV = 7 * TP + 1, PN_DU = 7 * TP + 2;
constexpr int SRC_AQ = 0, SRC_AK = GW, SRC_AV = 2 * GW, SRC_BR = 3 * GW, SRC_BK = 4 * GW, SRC_BV = 5 * GW, SRC_BS = 6 * GW, SRC_CQ = 6 * GW + 160, SRC_CK = 7 * GW + 160, SRC_CV = 7 * GW + 288, SRC_DU = 7 * GW + 416;
constexpr int S5L = 32, NCH = M / S5L, NCHP = ((NCH + 255) / 256) * 256, S5K = 768;
constexpr int NW = 8, NTHR = 512;
constexpr float NORM_EPS = 1e-6f, RW_GN_EPS = 64e-5f;

typedef unsigned short bf16;
typedef short bf16x8 __attribute__((ext_vector_type(8)));
typedef short s16x4 __attribute__((ext_vector_type(4)));
typedef float f32x4 __attribute__((ext_vector_type(4)));
typedef float f32x2 __attribute__((ext_vector_type(2)));
typedef float f32x16 __attribute__((ext_vector_type(16)));
typedef unsigned u32x4 __attribute__((ext_vector_type(4)));
typedef unsigned u32x2 __attribute__((ext_vector_type(2)));
#define DI __device__ __forceinline__

constexpr size_t al256(size_t x) { return (x + 255) & ~(size_t)255; }
constexpr size_t SZ_BIAS_GU = (size_t)3 * 2 * FF * 4, SZ_BIAS_IN = (size_t)3 * NINP * 4;
constexpr size_t WS_CTL = 0;
constexpr size_t WS_BIAS = 65536;
constexpr size_t SZ_BIAS_L = 2 * SZ_BIAS_GU + SZ_BIAS_IN;
constexpr size_t WS_ROWSS = al256(WS_BIAS + NL * SZ_BIAS_L);
constexpr size_t WS_ZERO_END = al256(WS_ROWSS + (size_t)NL * 3 * M * 4);
constexpr size_t WS_MODV = WS_ZERO_END;
constexpr size_t WS_GS = al256(WS_MODV + (size_t)NL * 3 * 9 * D * 4);
constexpr size_t WS_GATE = al256(WS_GS + (size_t)NL * 9 * D * 4);
constexpr size_t WS_ROPE = al256(WS_GATE + (size_t)NL * 9 * D * 4);
constexpr size_t SZ_WGU = (size_t)2 * FF * D * 2, SZ_WD = (size_t)D * FF * 2, SZ_WIN = (size_t)NINP * D * 2, SZ_WOUT = (size_t)D * D * 2, SZ_WGLU = (size_t)GW * GW * 2;
constexpr size_t OFF_W1GU = 0, OFF_W1D = OFF_W1GU + SZ_WGU, OFF_WIN = OFF_W1D + SZ_WD, OFF_WOUT = OFF_WIN + SZ_WIN, OFF_W2GU = OFF_WOUT + SZ_WOUT, OFF_W2D = OFF_W2GU + SZ_WGU, OFF_WGLU = OFF_W2D + SZ_WD, SZ_WL = OFF_WGLU + SZ_WGLU;
constexpr size_t WS_W = al256(WS_ROPE + 128 * 16 * 8);
constexpr size_t SZ_S5KC = (size_t)S5G * 2 * S5L * 256 * 4, SZ_S5ET = (size_t)S5G * 256 * 512 * 2, SZ_S5BT = (size_t)S5G * 512 * S5K * 2, SZ_S5LAM = (size_t)2 * GW * 4 * 8;
constexpr size_t SZ_S5LP = (size_t)2 * S5G * 64 * (S5L + 1) * 8, SZ_S5BETA = (size_t)2 * S5G * 64 * 16 * 8;
constexpr size_t OFF_S5KC = 0, OFF_S5ET = OFF_S5KC + SZ_S5KC, OFF_S5BT = OFF_S5ET + SZ_S5ET, OFF_S5LAM = OFF_S5BT + SZ_S5BT, OFF_S5LP = al256(OFF_S5LAM + SZ_S5LAM), OFF_S5BETA = OFF_S5LP + SZ_S5LP, SZ_S5L = al256(OFF_S5BETA + SZ_S5BETA);
constexpr size_t WS_S5T = al256(WS_W + NL * SZ_WL);
constexpr size_t WS_XC = al256(WS_S5T + NL * SZ_S5L);
constexpr size_t WS_AP = al256(WS_XC + (size_t)M_CTX * D * 4);
constexpr size_t WS_H = al256(WS_AP + (size_t)M * D * 2);
constexpr size_t WS_QA = al256(WS_H + (size_t)M * FF * 2);
constexpr size_t WS_KA = WS_QA + (size_t)M * GW * 2, WS_VA = WS_KA + (size_t)M * GW * 2, WS_QC = WS_VA + (size_t)M * GW * 2;
constexpr size_t WS_KC = WS_QC + (size_t)M * GW * 2, WS_VC = WS_KC + (size_t)M * 128 * 2;
constexpr size_t WS_PB = WS_VC + (size_t)M * 128 * 2;
constexpr size_t WS_PS = al256(WS_PB + (size_t)M * 3 * GW * 2);
constexpr size_t WS_UG = al256(WS_PS + (size_t)M * 160 * 4);
constexpr size_t WS_RW = al256(WS_UG + (size_t)S5G * NCHP * S5K * 2);
constexpr size_t SZ_RWA = (size_t)M * GW * 4;
enum { RW_R = 0, RW_V, RW_NKK, RW_G, RW_W0, RW_W1, RW_K0, RW_K1, RW_B0, RW_B1, RW_Y0, RW_Y1, RW_NARR };
constexpr size_t WS_XEND = al256(WS_RW + 256);
constexpr size_t WS_YG = al256(WS_XEND + (size_t)S5G * NCHP * 256 * 4);
constexpr size_t WS_OB = al256(WS_YG + (size_t)M * GW * 2);
constexpr int RCK = (TC + T) / 64, RSTR = NB * NH * 2, RITEM = RSTR * RCK;
constexpr size_t WS_QH = al256(WS_OB + (size_t)M * D * 2);
constexpr size_t WS_YL = al256(WS_QH + (size_t)RITEM * 8192);
constexpr size_t WS_MF = al256(WS_YL + (size_t)RITEM * 16384);
constexpr size_t WS_GF = al256(WS_MF + (size_t)RITEM * 8192);
constexpr size_t WS_SF = al256(WS_GF + (size_t)RITEM * 16384);
constexpr int RBLK = NB * NH * ((TC + T) / 64);
constexpr size_t WS_RVKG = al256(WS_SF + (size_t)RITEM * 8192);
constexpr size_t SZ_RWF = (size_t)14 * NH * 2 * 64 * 16;
constexpr size_t WS_RWF = al256(WS_RVKG + (size_t)RBLK * 32768);
constexpr size_t WS_RWS = al256(WS_RWF + NL * SZ_RWF);
constexpr size_t WS_END = al256(WS_RWS + (size_t)512 * 2 * 65536);
constexpr int CW_BAR = 1024;

constexpr int LDS_BYTES = 147456, RING_BYTES = 131072, MISC_OFF = LDS_BYTES - 256;

DI unsigned f2bf(float f) { unsigned u = __float_as_uint(f); return (u + 0x7fffu + ((u >> 16) & 1u)) >> 16; }
#ifdef EMU
DI unsigned pk2(float lo, float hi) { return f2bf(lo) | (f2bf(hi) << 16); }
#else
typedef __bf16 hbf16x2 __attribute__((ext_vector_type(2)));
DI unsigned pk2(float lo, float hi) { const f32x2 v = {lo, hi}; const hbf16x2 b = __builtin_convertvector(v, hbf16x2); return __builtin_bit_cast(unsigned, b); }
#endif
DI float bf2f(unsigned short b) { return __uint_as_float(((unsigned)b) << 16); }
DI float bflo(unsigned w) { return __uint_as_float(w << 16); }
DI float bfhi(unsigned w) { return __uint_as_float(w & 0xffff0000u); }
template <int N> DI float ror_add(float v) { return v + __int_as_float(__builtin_amdgcn_mov_dpp(__float_as_int(v), 0x120 + N, 0xf, 0xf, true)); }
DI float row16_sum(float v) { v = ror_add<8>(v); v = ror_add<4>(v); v = ror_add<2>(v); v = ror_add<1>(v); return v; }
DI float wave_sum(float v) {
    v = row16_sum(v);
    const float a = __int_as_float(__builtin_amdgcn_readlane(__float_as_int(v), 0)), b = __int_as_float(__builtin_amdgcn_readlane(__float_as_int(v), 16)),
                c = __int_as_float(__builtin_amdgcn_readlane(__float_as_int(v), 32)), d = __int_as_float(__builtin_amdgcn_readlane(__float_as_int(v), 48));
    return (a + b) + (c + d);
}
DI float siluf(float x) { return x * __builtin_amdgcn_rcpf(1.f + __expf(-x)); }
DI float fast_tanh(float x) { const float e = __expf(2.f * x); return 1.f - 2.f * __builtin_amdgcn_rcpf(e + 1.f); }
DI float sigmf(float x) { return __builtin_amdgcn_rcpf(1.f + __expf(-x)); }
DI float geluf(float x) { const float z = 0.7978845608028654f * (x + 0.044715f * x * x * x); const float e = __expf(2.f * z); return 0.5f * x * (1.f + (1.f - 2.f * __builtin_amdgcn_rcpf(e + 1.f))); }
DI int stream_of_row(int row) { return row < M_LAT ? row / T : NB; }
DI int stream_of_panel(int pm) { return stream_of_row(pm * 256); }

#define XB_TMO      128
#define XB_XCNT(j)  (256  + 64 * (j))
#define XB_XSUB(j)  (1280 + 64 * (j))
#define XB_XGEN(j)  (2304 + 64 * (j))
#define XB_TOP      3328
#define XB_TOPGEN   3392
#define XCD_BAR_WORDS 3456
#define XB_SPIN_CAP (1u << 18)
DI unsigned xb_ld(unsigned* p)              { return __hip_atomic_load(p, __ATOMIC_RELAXED, __HIP_MEMORY_SCOPE_AGENT); }
DI unsigned xb_add(unsigned* p, unsigned v) { return __hip_atomic_fetch_add(p, v, __ATOMIC_RELAXED, __HIP_MEMORY_SCOPE_AGENT); }
DI unsigned xb_xcc_id() { return (unsigned)__builtin_amdgcn_s_getreg((3 << 11) | 20) & 0xFu; }
#define XB_SPIN(cond, bar) do { unsigned _sp = 0; while (cond) { __builtin_amdgcn_s_sleep(1); \
    if ((++_sp & 255u) == 0u) { if (xb_ld(&(bar)[XB_TMO])) break; if (_sp > XB_SPIN_CAP) { atomicAdd(&(bar)[XB_TMO], 1u); break; } } } } while (0)
struct XcdBarrier { unsigned* bar; unsigned x; volatile LAS unsigned* st; };
DI XcdBarrier xcd_barrier_post(unsigned* bar, volatile LAS unsigned* st) {
    XcdBarrier b; b.bar = bar; b.x = xb_xcc_id(); b.st = st;
    if (threadIdx.x == 0) (void)xb_add(&bar[XB_XCNT(b.x)], 1u);
    return b;
}
DI void xcd_barrier_complete(unsigned* bar, unsigned x, unsigned& nloc, unsigned& nx) {
    const unsigned G = gridDim.x * gridDim.y * gridDim.z;
    unsigned sum, cnt, mine, sp = 0u;
    for (;;) {
        sum = 0u; cnt = 0u; mine = 0u;
#pragma unroll
        for (unsigned j = 0; j < 16; ++j) { const unsigned c = xb_ld(&bar[XB_XCNT(j)]); sum += c; cnt += (c > 0u) ? 1u : 0u; mine = (j == x) ? c : mine; }
        if (sum == G) break;
        __builtin_amdgcn_s_sleep(1);
        if ((++sp & 255u) == 0u) { if (xb_ld(&bar[XB_TMO])) break; if (sp > XB_SPIN_CAP) { atomicAdd(&bar[XB_TMO], 1u); break; } }
    }
    nloc = mine > 0u ? mine : 1u; nx = cnt > 0u ? cnt : 1u;
}
DI void xcd_barrier(const XcdBarrier& b) {
    ASMV("s_waitcnt vmcnt(0)" ::: "memory");
    __syncthreads();
    if (threadIdx.x == 0) {
        unsigned* bar = b.bar;
        __builtin_amdgcn_s_waitcnt(0);
        unsigned nloc = b.st[0], nx = b.st[1];
        if (nloc == 0u) { xcd_barrier_complete(bar, b.x, nloc, nx); b.st[0] = nloc; b.st[1] = nx; }
        const unsigned old = xb_add(&bar[XB_XSUB(b.x)], 1u);
        const unsigned gen = old / nloc;
        if (old + 1u == (gen + 1u) * nloc) {
            __builtin_amdgcn_fence(__ATOMIC_RELEASE, "agent");
            ASMV("s_waitcnt vmcnt(0)" ::: "memory");
            const unsigned og = xb_add(&bar[XB_TOP], 1u);
            const unsigned tg = og / nx;
            if (og + 1u == (tg + 1u) * nx) xb_add(&bar[XB_TOPGEN], 1u);
            else XB_SPIN(xb_ld(&bar[XB_TOPGEN]) == tg, bar);
            __builtin_amdgcn_fence(__ATOMIC_ACQUIRE, "agent");
            xb_add(&bar[XB_XGEN(b.x)], 1u);
            ASMV("s_waitcnt vmcnt(0)" ::: "memory");
        } else {
            XB_SPIN(xb_ld(&bar[XB_XGEN(b.x)]) == gen, bar);
            __builtin_amdgcn_fence(__ATOMIC_ACQUIRE, "agent");
            ASMV("s_waitcnt vmcnt(0)" ::: "memory");
        }
    }
    __syncthreads();
}

constexpr int BK = 64, HALF = 128, HTB = HALF * BK * 2, NXCD = 8, WGM = 4;
DI int lds_byte(int r, int c) { const int st = (r >> 4) * 2 + (c >> 5), rr = r & 15, cc = c & 31, ob = rr * 64 + cc * 2; return st * 1024 + (ob ^ (((ob >> 9) & 1) << 5)); }
DI void stage_rc(int b, int& R, int& C) { const int st = b / 1024, sb = b % 1024, swz = sb ^ (((sb >> 9) & 1) << 5); R = (st >> 1) * 16 + swz / 64; C = (st & 1) * 32 + (swz % 64) / 2; }
struct Unit { int pm, pn, z, kt0; };
struct Gemm { const bf16* A; const bf16* Bt; int lda, ldb, K; size_t zA, zB; };
struct Order {
    int nM, nN, nZ, per, total, G, c, nkt, pm0, spl;
    DI void init(int nM_, int nN_, int nZ_, int G_, int c_, int nkt_) { nM = nM_; nN = nN_; nZ = nZ_; per = nM * nN; total = per * nZ; G = G_; c = c_; nkt = nkt_; pm0 = 0; spl = 0; }
    DI void init_split(int pm0_, int xM, int nN_, int spl_, int G_, int c_, int nkt_full) { nM = xM; nN = nN_; nZ = 1; per = xM * nN_ * spl_; total = per; G = G_; c = c_; nkt = nkt_full / spl_; pm0 = pm0_; spl = spl_; }
    DI bool next(int i, Unit& u) const {
        const long L = (long)i * G + c; if (L >= total) return false;
        if (spl) { const int j = (int)L; u.z = 0; u.pm = pm0 + j / (nN * spl); const int rem = j % (nN * spl); u.pn = rem / spl; u.kt0 = (rem % spl) * nkt; return true; }
        u.kt0 = 0;
        u.z = (int)(L / per); int wgid = (int)(L % per);
        { const int q = per / NXCD, r = per % NXCD, xcd = wgid % NXCD, off = wgid / NXCD; wgid = (xcd < r ? xcd * (q + 1) : r * (q + 1) + (xcd - r) * q) + off; }
        const int nig = WGM * nN, gid = wgid / nig, fm = gid * WGM, gsz = (nM - fm) < WGM ? (nM - fm) : WGM;
        u.pm = fm + ((wgid % nig) % gsz); u.pn = (wgid % nig) / gsz; return true;
    }
};

template <class Epi>
DI void gemm_phase(LAS unsigned char* lds, const Gemm g, const Order& S, const Epi& E) {
    int tid_ = threadIdx.x; OPAQUE(tid_);
    const int tid = tid_, wid = __builtin_amdgcn_readfirstlane(tid >> 6), lane = tid & 63, wr = wid >> 2, wc = wid & 3, fr = lane & 15, fq = lane >> 4;
    Unit cur, nxt; int ui = 0;
    if (!S.next(0, cur)) return;
    f32x4 acc[2][2][4][2];
#ifdef EMU
    (void)lds;
    for (;; ++ui) {
        if (ui > 0) { if (!S.next(ui, cur)) break; }
        const bf16* A = (const bf16*)((const char*)g.A + cur.z * g.zA); const bf16* B = (const bf16*)((const char*)g.Bt + cur.z * g.zB);
        for (int ai = 0; ai < 2; ++ai) for (int bj = 0; bj < 2; ++bj) for (int m = 0; m < 4; ++m) for (int n = 0; n < 2; ++n) for (int j = 0; j < 4; ++j) {
            const int r = 256 * cur.pm + 128 * ai + 64 * wr + 16 * m + fr, c = 256 * cur.pn + 128 * bj + 32 * wc + 16 * n + 4 * fq + j;
            const bf16* a = A + (size_t)r * g.lda; const bf16* b = B + (size_t)c * g.ldb; float s = 0.f;
            for (int k = cur.kt0 * BK; k < (cur.kt0 + S.nkt) * BK; ++k) s += bf2f(a[k]) * bf2f(b[k]);
            acc[ai][bj][m][n][j] = s; }
        E(acc, cur, wr, wc, fr, fq);
    }
#else
    unsigned voffA[2], voffB[2];
#pragma unroll
    for (int i = 0; i < 2; ++i) { int R, C; stage_rc(tid * 16 + i * 8192, R, C); voffA[i] = (unsigned)(R * g.lda + C) * 2u; voffB[i] = (unsigned)(R * g.ldb + C) * 2u; }
    const size_t kstep = (size_t)(BK * 2);
    const size_t hstepA = (size_t)HALF * g.lda * 2, hstepB = (size_t)HALF * g.ldb * 2, tstepA = 2 * hstepA, tstepB = 2 * hstepB;
    const unsigned ldsw = (unsigned)wid * 1024u;
    const int aoff = lds_byte(wr * 64 + fr, fq * 8), boff = lds_byte(wc * 32 + fr, fq * 8);
#define PG8_SA(b, h) (((b) * 2 + (h)) * HTB)
#define PG8_SB(b, h) ((4 + (b) * 2 + (h)) * HTB)
#define PG8_STAGE(bufoff, gbase, voff) do { _Pragma("unroll") for (int _i = 0; _i < 2; ++_i) \
        __builtin_amdgcn_global_load_lds((const unsigned*)((const char*)(gbase) + (voff)[_i]), (LAS unsigned*)(lds + (bufoff) + ldsw + _i * 8192), 16, 0, 0); } while (0)
#define PG8_LDA(dst, b, h) do { _Pragma("unroll") for (int m = 0; m < 4; ++m) _Pragma("unroll") for (int k = 0; k < 2; ++k) dst[m][k] = *(const LAS bf16x8*)(lds + PG8_SA(b, h) + aoff + m * 2048 + k * 1024); } while (0)
#define PG8_LDB(dst, b, h) do { _Pragma("unroll") for (int n = 0; n < 2; ++n) _Pragma("unroll") for (int k = 0; k < 2; ++k) dst[n][k] = *(const LAS bf16x8*)(lds + PG8_SB(b, h) + boff + n * 2048 + k * 1024); } while (0)
#define PG8_MMA(ai, bj, At, Bt) do { __builtin_amdgcn_s_setprio(1); _Pragma("unroll") for (int m = 0; m < 4; ++m) _Pragma("unroll") for (int n = 0; n < 2; ++n) _Pragma("unroll") for (int k = 0; k < 2; ++k) \
        acc[ai][bj][m][n] = __builtin_amdgcn_mfma_f32_16x16x32_bf16(Bt[n][k], At[m][k], acc[ai][bj][m][n], 0, 0, 0); __builtin_amdgcn_s_setprio(0); } while (0)
#define PG8_WAIT_V(n) asm volatile("s_waitcnt vmcnt(" #n ")" ::: "memory")
#define PG8_WAIT_L(n) asm volatile("s_waitcnt lgkmcnt(" #n ")" ::: "memory")
#define PG8_BAR __builtin_amdgcn_s_barrier()
#define PG8_SCHED __builtin_amdgcn_sched_barrier(0)
#pragma unroll
    for (int a = 0; a < 2; ++a)
#pragma unroll
        for (int b = 0; b < 2; ++b)
#pragma unroll
            for (int m = 0; m < 4; ++m)
#pragma unroll
                for (int n = 0; n < 2; ++n) acc[a][b][m][n] = (f32x4){0.f, 0.f, 0.f, 0.f};
    bf16x8 At[4][2], B0[2][2], B1[2][2];
    const char* cA = (const char*)g.A + (size_t)cur.z * g.zA + (size_t)cur.pm * tstepA + (size_t)cur.kt0 * kstep; const char* cB = (const char*)g.Bt + (size_t)cur.z * g.zB + (size_t)cur.pn * tstepB + (size_t)cur.kt0 * kstep;
    PG8_STAGE(PG8_SB(0, 0), cB, voffB); PG8_STAGE(PG8_SB(0, 1), cB + hstepB, voffB); PG8_STAGE(PG8_SA(0, 0), cA, voffA); PG8_STAGE(PG8_SA(0, 1), cA + hstepA, voffA);
    if (wr == 1) PG8_BAR;
    PG8_WAIT_V(2); PG8_BAR;
    PG8_STAGE(PG8_SB(1, 0), cB + kstep, voffB); PG8_STAGE(PG8_SA(1, 0), cA + kstep, voffA); PG8_STAGE(PG8_SB(1, 1), cB + hstepB + kstep, voffB);
    PG8_WAIT_V(6); PG8_BAR;
    for (;;) {
        const bool has_next = S.next(ui + 1, nxt);
        const char* nA = has_next ? (const char*)g.A + (size_t)nxt.z * g.zA + (size_t)nxt.pm * tstepA + (size_t)nxt.kt0 * kstep : cA; const char* nB = has_next ? (const char*)g.Bt + (size_t)nxt.z * g.zB + (size_t)nxt.pn * tstepB + (size_t)nxt.kt0 * kstep : cB;
        const int nt = S.nkt;
        for (int t = 0; t < nt; t += 2) {
            const bool last = (t == nt - 2);
            const char* a1 = cA + (size_t)(t + 1) * kstep;
            const char* a2 = last ? nA : cA + (size_t)(t + 2) * kstep; const char* b2 = last ? nB : cB + (size_t)(t + 2) * kstep;
            const char* a3 = a2 + kstep; const char* b3 = b2 + kstep;
            PG8_LDB(B0, 0, 0); PG8_LDB(B1, 0, 1); PG8_SCHED; PG8_LDA(At, 0, 0); PG8_STAGE(PG8_SA(1, 1), a1 + hstepA, voffA);
            PG8_WAIT_V(8); PG8_WAIT_L(0); PG8_BAR; PG8_MMA(0, 0, At, B0); PG8_MMA(0, 1, At, B1); PG8_BAR; PG8_SCHED;
            PG8_LDA(At, 0, 1); PG8_STAGE(PG8_SB(0, 0), b2, voffB); PG8_STAGE(PG8_SB(0, 1), b2 + hstepB, voffB); PG8_STAGE(PG8_SA(0, 0), a2, voffA);
            PG8_WAIT_V(8); PG8_WAIT_L(0); PG8_BAR; PG8_MMA(1, 0, At, B0); PG8_MMA(1, 1, At, B1); PG8_BAR; PG8_SCHED;
            PG8_LDB(B0, 1, 0); PG8_LDB(B1, 1, 1); PG8_SCHED; PG8_LDA(At, 1, 0); PG8_STAGE(PG8_SA(0, 1), a2 + hstepA, voffA);
            PG8_WAIT_V(8); PG8_WAIT_L(0); PG8_BAR; PG8_MMA(0, 0, At, B0); PG8_MMA(0, 1, At, B1); PG8_BAR; PG8_SCHED;
            PG8_LDA(At, 1, 1); PG8_STAGE(PG8_SB(1, 0), b3, voffB); PG8_STAGE(PG8_SB(1, 1), b3 + hstepB, voffB); PG8_STAGE(PG8_SA(1, 0), a3, voffA);
            PG8_WAIT_V(8); PG8_WAIT_L(0); PG8_BAR; PG8_MMA(1, 0, At, B0); PG8_MMA(1, 1, At, B1); PG8_BAR; PG8_SCHED;
        }
        if (wr == 0) PG8_BAR;
        E(acc, cur, wr, wc, fr, fq);
        if (!has_next) break;
#pragma unroll
        for (int a = 0; a < 2; ++a)
#pragma unroll
            for (int b = 0; b < 2; ++b)
#pragma unroll
                for (int m = 0; m < 4; ++m)
#pragma unroll
                    for (int n = 0; n < 2; ++n) acc[a][b][m][n] = (f32x4){0.f, 0.f, 0.f, 0.f};
        cur = nxt; cA = nA; cB = nB; ++ui;
        if (wr == 1) PG8_BAR;
    }
    PG8_WAIT_V(0);
    PG8_BAR;
#undef PG8_SA
#undef PG8_SB
#undef PG8_STAGE
#undef PG8_LDA
#undef PG8_LDB
#undef PG8_MMA
#undef PG8_WAIT_V
#undef PG8_WAIT_L
#undef PG8_BAR
#undef PG8_SCHED
#endif
}

struct Args {
    const float* in[42]; float* out; unsigned char* ws;
    int ph_lo, ph_hi;
};
struct Ctx {
    const float* const* in; float* out; unsigned char* ws;
    LAS unsigned char* lds; int tid, lane, wave, G, bid;
};
DI float* xrow_ptr(const Ctx& C, int row) { return row < M_LAT ? C.out + (size_t)row * D : (float*)(C.ws + WS_XC) + (size_t)(row - M_LAT) * D; }
DI const bf16* wl(const Ctx& C, int l, size_t off) { return (const bf16*)(C.ws + WS_W + (size_t)l * SZ_WL + off); }
DI float* bias_ptr(const Ctx& C, int l, int which  ) { return (float*)(C.ws + WS_BIAS + (size_t)l * SZ_BIAS_L + (which == 0 ? 0 : which == 1 ? SZ_BIAS_GU : SZ_BIAS_GU + SZ_BIAS_IN)); }
DI float* rowss_ptr(const Ctx& C, int l, int sub) { return (float*)(C.ws + WS_ROWSS) + ((size_t)l * 3 + sub) * M; }
DI const float* gs_ptr(const Ctx& C, int l, int sub, int s) { return (const float*)(C.ws + WS_GS) + (((size_t)l * 3 + sub) * 3 + s) * D; }
DI const float* gate_ptr(const Ctx& C, int l, int sub, int s) { return (const float*)(C.ws + WS_GATE) + (((size_t)l * 3 + sub) * 3 + s) * D; }
DI float* rw_arr(const Ctx& C, int a) { return (float*)(C.ws + WS_RW + (size_t)a * SZ_RWA); }
enum { I_X = 0, I_C, I_CTX, I_CCTX, I_WADA, I_BADA, I_NORMG, I_F1WG, I_F1WU, I_F1WD, I_F2WG, I_F2WU, I_F2WD, I_WIN, I_WOUT, I_NAQG, I_NAKG, I_NARPB, I_RWCONV, I_RWW0, I_RWWUP, I_RWA0, I_RWAUP,
       I_RWGUP, I_RWKK, I_RWKA, I_RWRK, I_RWGNW, I_RWGNB, I_WAQG, I_WAKG, I_WASINK, I_S5ARE, I_S5AIM, I_S5LDT, I_S5BRE, I_S5BIM, I_S5CRE, I_S5CIM, I_S5D, I_S5GLUW, I_S5GLUB, I_NIN };

struct EpiGU {
    const float* rowss; const float* bias  ; bf16* H; int mrows;
    DI void operator()(const f32x4 (&acc)[2][2][4][2], const Unit& u, int wr, int wc, int fr_, int fq_) const {
        int tz_ = threadIdx.x; OPAQUE(tz_); const int fr = tz_ & 15, fq = (tz_ & 63) >> 4; (void)fr_; (void)fq_;
        const int s = stream_of_panel(u.pm); const float* bs = bias + (size_t)s * 2 * FF + u.pn * 256 + wc * 32 + 4 * fq;
        f32x4 bg[2], bu[2];
#pragma unroll
        for (int n = 0; n < 2; ++n) { bg[n] = *(const f32x4*)(bs + 16 * n); bu[n] = *(const f32x4*)(bs + 128 + 16 * n); }
        float rsv[2][4];
#pragma unroll
        for (int ai = 0; ai < 2; ++ai)
#pragma unroll
            for (int m = 0; m < 4; ++m) rsv[ai][m] = rowss[u.pm * 256 + ai * 128 + wr * 64 + m * 16 + fr];
#pragma unroll
        for (int ai = 0; ai < 2; ++ai)
#pragma unroll
            for (int m = 0; m < 4; ++m) {
                const int row = u.pm * 256 + ai * 128 + wr * 64 + m * 16 + fr;
                const float rstd = __builtin_amdgcn_rsqf(rsv[ai][m] * (1.0f / D) + NORM_EPS);
                bf16* hp = H + (size_t)row * FF + u.pn * 128 + wc * 32 + 8 * fq;
                u32x4 w;
                { const f32x4 g = acc[ai][0][m][0] * rstd + bg[0], v = acc[ai][1][m][0] * rstd + bu[0]; w.x = pk2(siluf(g[0]) * v[0], siluf(g[1]) * v[1]); w.y = pk2(siluf(g[2]) * v[2], siluf(g[3]) * v[3]); }
                { const f32x4 g = acc[ai][0][m][1] * rstd + bg[1], v = acc[ai][1][m][1] * rstd + bu[1]; w.z = pk2(siluf(g[0]) * v[0], siluf(g[1]) * v[1]); w.w = pk2(siluf(g[2]) * v[2], siluf(g[3]) * v[3]); }
                *(u32x4*)hp = w;
            }
    }
};
struct EpiRes {
    const Ctx* C; const float* gate  ; const float* gsn  ; float* rowss_next; bf16* AP;
    DI void operator()(const f32x4 (&acc)[2][2][4][2], const Unit& u, int wr, int wc, int fr_, int fq_) const {
        int tz_ = threadIdx.x; OPAQUE(tz_); const int fr = tz_ & 15, fq = (tz_ & 63) >> 4; (void)fr_; (void)fq_;
        const int s = stream_of_panel(u.pm); const int col0 = u.pn * 256 + wc * 32 + 4 * fq;
        f32x4 gv[2][2], sv[2][2];
#pragma unroll
        for (int bj = 0; bj < 2; ++bj)
#pragma unroll
            for (int n = 0; n < 2; ++n) { gv[bj][n] = *(const f32x4*)(gate + (size_t)s * D + col0 + bj * 128 + n * 16); sv[bj][n] = gsn ? *(const f32x4*)(gsn + (size_t)s * D + col0 + bj * 128 + n * 16) : (f32x4){0.f, 0.f, 0.f, 0.f}; }
        f32x4 xc[2][2], xn[2][2];
        { const float* xp0 = xrow_ptr(*C, u.pm * 256 + wr * 64 + fr) + col0;
#pragma unroll
          for (int bj = 0; bj < 2; ++bj)
#pragma unroll
              for (int n = 0; n < 2; ++n) xn[bj][n] = *(const f32x4*)(xp0 + bj * 128 + n * 16); }
#pragma unroll
        for (int ai = 0; ai < 2; ++ai)
#pragma unroll
            for (int m = 0; m < 4; ++m) {
                const int row = u.pm * 256 + ai * 128 + wr * 64 + m * 16 + fr;
                float* xp = xrow_ptr(*C, row) + col0; float ss = 0.f;
#pragma unroll
                for (int bj = 0; bj < 2; ++bj)
#pragma unroll
                    for (int n = 0; n < 2; ++n) xc[bj][n] = xn[bj][n];
                if (ai * 4 + m < 7) { const int rn = ai * 4 + m + 1; const float* xq = xrow_ptr(*C, u.pm * 256 + (rn >> 2) * 128 + wr * 64 + (rn & 3) * 16 + fr) + col0;
#pragma unroll
                    for (int bj = 0; bj < 2; ++bj)
#pragma unroll
                        for (int n = 0; n < 2; ++n) xn[bj][n] = *(const f32x4*)(xq + bj * 128 + n * 16); }
#pragma unroll
                for (int bj = 0; bj < 2; ++bj)
#pragma unroll
                    for (int n = 0; n < 2; ++n) { f32x4 x = xc[bj][n]; x += gv[bj][n] * acc[ai][bj][m][n]; *(f32x4*)(xp + bj * 128 + n * 16) = x;
                        if (gsn) { ss += (x[0] * x[0] + x[1] * x[1]) + (x[2] * x[2] + x[3] * x[3]); const f32x4 a = x * sv[bj][n]; u32x2 w; w.x = pk2(a[0], a[1]); w.y = pk2(a[2], a[3]);
                            *(u32x2*)(AP + (size_t)row * D + col0 + bj * 128 + n * 16) = w; } }
                if (gsn) { ss += __shfl_xor(ss, 16); ss += __shfl_xor(ss, 32); if (fq == 0) atomicAdd(rowss_next + row, ss); }
            }
    }
};
struct EpiAcc {
    const Ctx* C; const float* gate;
    DI void operator()(const f32x4 (&acc)[2][2][4][2], const Unit& u, int wr, int wc, int fr_, int fq_) const {
        int tz_ = threadIdx.x; OPAQUE(tz_); const int fr = tz_ & 15, fq = (tz_ & 63) >> 4; (void)fr_; (void)fq_;
        const int s = stream_of_panel(u.pm); const int col0 = u.pn * 256 + wc * 32 + 4 * fq;
#pragma unroll
        for (int bj = 0; bj < 2; ++bj)
#pragma unroll
            for (int n = 0; n < 2; ++n) { const f32x4 gv = *(const f32x4*)(gate + (size_t)s * D + col0 + bj * 128 + n * 16);
#pragma unroll
                for (int ai = 0; ai < 2; ++ai)
#pragma unroll
                    for (int m = 0; m < 4; ++m) { float* xp = xrow_ptr(*C, u.pm * 256 + ai * 128 + wr * 64 + m * 16 + fr) + col0 + bj * 128 + n * 16; const f32x4 d = gv * acc[ai][bj][m][n];
#pragma unroll
                        for (int j = 0; j < 4; ++j) atomicAdd(xp + j, d[j]); } }
    }
};
struct EpiIn {
    const Ctx* C; const float* rowss; const float* bias  ; int l;
    DI void operator()(const f32x4 (&acc)[2][2][4][2], const Unit& u, int wr, int wc, int fr_, int fq_) const {
        int tz_ = threadIdx.x; OPAQUE(tz_); const int fr = tz_ & 15, fq = (tz_ & 63) >> 4; (void)fr_; (void)fq_;
        const int s = stream_of_panel(u.pm), pn = u.pn; const float* bs = bias + (size_t)s * NINP + pn * 256 + wc * 32 + 4 * fq;
        unsigned char* ws = C->ws;
        f32x4 bv[2][2];
#pragma unroll
        for (int bj = 0; bj < 2; ++bj)
#pragma unroll
            for (int n = 0; n < 2; ++n) bv[bj][n] = *(const f32x4*)(bs + bj * 128 + n * 16);
        float rsv[2][4];
#pragma unroll
        for (int ai = 0; ai < 2; ++ai)
#pragma unroll
            for (int m = 0; m < 4; ++m) rsv[ai][m] = rowss[u.pm * 256 + ai * 128 + wr * 64 + m * 16 + fr];
        const bool permuted = pn < PN_AV || (pn >= PN_CQ && pn < PN_DU);
        if (permuted) {
            const bool is_ckv = pn == PN_CKV, is_c = pn >= PN_CQ, is_q = pn < PN_AK || (pn >= PN_CQ && pn < PN_CKV);
            const bool plain_v = is_ckv && wc >= 2;
            const float* gsrc = C->in[is_c ? (is_q ? I_WAQG : I_WAKG) : (is_q ? I_NAQG : I_NAKG)] + (size_t)l * 64;
            f32x4 gn[2][2];
#pragma unroll
            for (int bj = 0; bj < 2; ++bj)
#pragma unroll
                for (int n = 0; n < 2; ++n) { gn[bj][n] = *(const f32x4*)(gsrc + 32 * bj + 16 * n + 4 * fq); if (is_q) gn[bj][n] *= 0.125f; }
            bf16* dst; int pitch, hcol;
            if (pn < PN_AK) { dst = (bf16*)(ws + WS_QA); pitch = GW; hcol = ((pn - PN_AQ) * 4 + wc) * 64; }
            else if (pn < PN_AV) { dst = (bf16*)(ws + WS_KA); pitch = GW; hcol = ((pn - PN_AK) * 4 + wc) * 64; }
            else if (pn < PN_CKV) { dst = (bf16*)(ws + WS_QC); pitch = GW; hcol = ((pn - PN_CQ) * 4 + wc) * 64; }
            else if (wc < 2) { dst = (bf16*)(ws + WS_KC); pitch = 128; hcol = wc * 64; }
            else { dst = (bf16*)(ws + WS_VC); pitch = 128; hcol = (wc - 2) * 64; }
            const f32x4* rope = (const f32x4*)(ws + WS_ROPE);
#pragma unroll
            for (int ai = 0; ai < 2; ++ai)
#pragma unroll
                for (int m = 0; m < 4; ++m) {
                    const int row = pn * 0 + u.pm * 256 + ai * 128 + wr * 64 + m * 16 + fr;
                    const float rstd = __builtin_amdgcn_rsqf(rsv[ai][m] * (1.0f / D) + NORM_EPS);
                    f32x4 v[2][2]; float ss = 0.f;
#pragma unroll
                    for (int bj = 0; bj < 2; ++bj)
#pragma unroll
                        for (int n = 0; n < 2; ++n) { v[bj][n] = acc[ai][bj][m][n] * rstd + bv[bj][n]; ss += (v[bj][n][0] * v[bj][n][0] + v[bj][n][1] * v[bj][n][1]) + (v[bj][n][2] * v[bj][n][2] + v[bj][n][3] * v[bj][n][3]); }
                    ss += __shfl_xor(ss, 16); ss += __shfl_xor(ss, 32);
                    if (!plain_v) { const float rs = 1.0f / sqrtf(ss * (1.0f / 64.0f) + NORM_EPS);
#pragma unroll
                        for (int bj = 0; bj < 2; ++bj)
#pragma unroll
                            for (int n = 0; n < 2; ++n) v[bj][n] = v[bj][n] * rs * gn[bj][n];
                        if (is_c && row < M_LAT) {
                            const int t = row % T; const int pos[2] = {t / GRW, t % GRW};
#pragma unroll
                            for (int bj = 0; bj < 2; ++bj) { const f32x4 cs0 = rope[(pos[bj] * 16 + 4 * fq) / 2], cs1 = rope[(pos[bj] * 16 + 4 * fq) / 2 + 1];
                                const float cc[4] = {cs0[0], cs0[2], cs1[0], cs1[2]}, sn[4] = {cs0[1], cs0[3], cs1[1], cs1[3]};
#pragma unroll
                                for (int j = 0; j < 4; ++j) { const float x1 = v[bj][0][j], x2 = v[bj][1][j]; v[bj][0][j] = x1 * cc[j] - x2 * sn[j]; v[bj][1][j] = x2 * cc[j] + x1 * sn[j]; } }
                        }
                    }
                    bf16* op = dst + (size_t)row * pitch + hcol + 4 * fq;
#pragma unroll
                    for (int bj = 0; bj < 2; ++bj)
#pragma unroll
                        for (int n = 0; n < 2; ++n) { u32x2 w; w.x = pk2(v[bj][n][0], v[bj][n][1]); w.y = pk2(v[bj][n][2], v[bj][n][3]); *(u32x2*)(op + 32 * bj + 16 * n) = w; }
                }
        } else {
#pragma unroll
            for (int ai = 0; ai < 2; ++ai)
#pragma unroll
                for (int m = 0; m < 4; ++m) {
                    const int row = u.pm * 256 + ai * 128 + wr * 64 + m * 16 + fr;
                    const float rstd = __builtin_amdgcn_rsqf(rsv[ai][m] * (1.0f / D) + NORM_EPS);
#pragma unroll
                    for (int bj = 0; bj < 2; ++bj)
#pragma unroll
                        for (int n = 0; n < 2; ++n) { const f32x4 v = acc[ai][bj][m][n] * rstd + bv[bj][n]; const int c = bj * 128 + wc * 32 + n * 16 + 4 * fq;
                            u32x2 w; w.x = pk2(v[0], v[1]); w.y = pk2(v[2], v[3]);
                            if (pn < PN_BR) *(u32x2*)((bf16*)(ws + WS_VA) + (size_t)row * GW + (pn - PN_AV) * 256 + c) = w;
                            else if (pn < PN_BS) *(u32x2*)((bf16*)(ws + WS_PB) + (size_t)row * 3 * GW + (pn - PN_BR) * 256 + c) = w;
                            else if (pn == PN_BS) { if (c < 160) *(f32x4*)((float*)(ws + WS_PS) + (size_t)row * 160 + c) = v; }
                            else { const int cu = (pn - PN_DU) * 256 + c, gq = cu >> 4, p0 = cu & 15;
                                *(u32x2*)((bf16*)(ws + WS_UG) + ((size_t)gq * NCHP + row / S5L) * S5K + (row % S5L) * 16 + p0) = w; } }
                }
        }
    }
};
struct EpiS5A {
    float* XE;
    DI void operator()(const f32x4 (&acc)[2][2][4][2], const Unit& u, int wr, int wc, int fr_, int fq_) const {
        int tz_ = threadIdx.x; OPAQUE(tz_); const int fr = tz_ & 15, fq = (tz_ & 63) >> 4; (void)fr_; (void)fq_;
#pragma unroll
        for (int ai = 0; ai < 2; ++ai)
#pragma unroll
            for (int m = 0; m < 4; ++m) { const int ch = u.pm * 256 + ai * 128 + wr * 64 + m * 16 + fr; if (ch < NCH) { float* p = XE + ((size_t)u.z * NCHP + ch) * 256 + wc * 32 + 4 * fq;
#pragma unroll
                for (int bj = 0; bj < 2; ++bj)
#pragma unroll
                    for (int n = 0; n < 2; ++n) *(f32x4*)(p + bj * 128 + n * 16) = acc[ai][bj][m][n]; } }
    }
};
struct EpiS5C {
    const bf16* UG; const float* dsk  ; bf16* YG;
    DI void operator()(const f32x4 (&acc)[2][2][4][2], const Unit& u, int wr, int wc, int fr_, int fq_) const {
        int tz_ = threadIdx.x; OPAQUE(tz_); const int fr = tz_ & 15, fq = (tz_ & 63) >> 4; (void)fr_; (void)fq_;
        const int g = u.z;
#pragma unroll
        for (int ai = 0; ai < 2; ++ai)
#pragma unroll
            for (int m = 0; m < 4; ++m) { const int ch = u.pm * 256 + ai * 128 + wr * 64 + m * 16 + fr; if (ch < NCH) {
#pragma unroll
                for (int bj = 0; bj < 2; ++bj)
#pragma unroll
                    for (int n = 0; n < 2; ++n) { const int col = u.pn * 256 + bj * 128 + wc * 32 + n * 16 + 4 * fq, i = col >> 4, p0 = col & 15;
                        const u32x2 uw = *(const u32x2*)(UG + ((size_t)g * NCHP + ch) * S5K + col); const f32x4 dv = *(const f32x4*)(dsk + 16 * g + p0);
                        const f32x4 a = acc[ai][bj][m][n]; const float y0 = a[0] + dv[0] * bflo(uw.x), y1 = a[1] + dv[1] * bfhi(uw.x), y2 = a[2] + dv[2] * bflo(uw.y), y3 = a[3] + dv[3] * bfhi(uw.y);
                        u32x2 w; w.x = pk2(geluf(y0), geluf(y1)); w.y = pk2(geluf(y2), geluf(y3));
                        *(u32x2*)(YG + (size_t)(ch * S5L + i) * GW + 16 * g + p0) = w; } } }
    }
};
struct EpiGLU {
    const bf16* YG; const float* gb; bf16* OB;
    DI void operator()(const f32x4 (&acc)[2][2][4][2], const Unit& u, int wr, int wc, int fr_, int fq_) const {
        int tz_ = threadIdx.x; OPAQUE(tz_); const int fr = tz_ & 15, fq = (tz_ & 63) >> 4; (void)fr_; (void)fq_;
#pragma unroll
        for (int ai = 0; ai < 2; ++ai)
#pragma unroll
            for (int m = 0; m < 4; ++m) { const int row = u.pm * 256 + ai * 128 + wr * 64 + m * 16 + fr;
#pragma unroll
                for (int bj = 0; bj < 2; ++bj)
#pragma unroll
                    for (int n = 0; n < 2; ++n) { const int col = u.pn * 256 + bj * 128 + wc * 32 + n * 16 + 4 * fq; const f32x4 b = *(const f32x4*)(gb + col); const f32x4 a = acc[ai][bj][m][n] + b;
                        const u32x2 yw = *(const u32x2*)(YG + (size_t)row * GW + col);
                        u32x2 w; w.x = pk2(bflo(yw.x) * sigmf(a[0]), bfhi(yw.x) * sigmf(a[1])); w.y = pk2(bflo(yw.y) * sigmf(a[2]), bfhi(yw.y) * sigmf(a[3]));
                        *(u32x2*)(OB + (size_t)row * D + 3 * GW + col) = w; } }
    }
};

DI void ph_ada(const Ctx& C) {
    LAS float* sc = (LAS float*)C.lds;
    LAS float* red = sc + 3 * D;
    for (int i = C.tid; i < 3 * D; i += NTHR) { const int s = i / D, k = i % D; const float c = s < NB ? C.in[I_C][s * D + k] : C.in[I_CCTX][k]; sc[i] = siluf(c); }
    __syncthreads();
    const int nun = NL * (9 * D / 256);
    for (int un = C.bid; un < nun; un += C.G) {
        const int l = un / (9 * D / 256), col0 = (un % (9 * D / 256)) * 256;
        const float* W = C.in[I_WADA] + (size_t)l * D * 9 * D + col0 + 4 * C.lane;
        f32x4 a0 = {0.f, 0.f, 0.f, 0.f}, a1 = a0, a2 = a0;
        const int k0 = C.wave * (D / 8);
#pragma unroll 1
        for (int kb = k0; kb < k0 + D / 8; kb += 16) {
            f32x4 wv[16];
#pragma unroll
            for (int u = 0; u < 16; ++u) wv[u] = *(const f32x4*)(W + (size_t)(kb + u) * 9 * D);
#pragma unroll
            for (int u = 0; u < 16; ++u) { a0 += wv[u] * sc[kb + u]; a1 += wv[u] * sc[D + kb + u]; a2 += wv[u] * sc[2 * D + kb + u]; } }
        LAS float* r = red + C.wave * 768 + 4 * C.lane;
        *(LAS f32x4*)(r) = a0; *(LAS f32x4*)(r + 256) = a1; *(LAS f32x4*)(r + 512) = a2;
        __syncthreads();
        for (int i = C.tid; i < 768; i += NTHR) { float s = 0.f;
#pragma unroll
            for (int w = 0; w < 8; ++w) s += red[w * 768 + i];
            const int st = i / 256, c = col0 + (i % 256);
            ((float*)(C.ws + WS_MODV))[((size_t)l * 3 + st) * 9 * D + c] = s + C.in[I_BADA][(size_t)l * 9 * D + c]; }
        __syncthreads();
    }
}
DI const float* modv_ptr(const Ctx& C, int l, int s, int chunk) { return (const float*)(C.ws + WS_MODV) + ((size_t)l * 3 + s) * 9 * D + (size_t)chunk * D; }

DI int win_dest(int n) {
    if (n >= D_IN) return -1;
    if (n < SRC_AV) { const int piece = n / GW, loc = n % GW, head = loc / 64, d = loc % 64; return ((piece == 0 ? PN_AQ : PN_AK) + head / 4) * 256 + 128 * (d / 32) + 32 * (head % 4) + (d % 32); }
    if (n < SRC_BS) return PN_AV * 256 + (n - SRC_AV);
    if (n < SRC_CQ) return PN_BS * 256 + (n - SRC_BS);
    if (n < SRC_CK) { const int loc = n - SRC_CQ, head = loc / 64, d = loc % 64; return (PN_CQ + head / 4) * 256 + 128 * (d / 32) + 32 * (head % 4) + (d % 32); }
    if (n < SRC_DU) { const int loc = n - SRC_CK, hh = loc / 64, d = loc % 64; return PN_CKV * 256 + 128 * (d / 32) + 32 * hh + (d % 32); }
    return PN_DU * 256 + (n - SRC_DU);
}
DI int gu_dest(int n) { const int e = n & 31; return (n / 128) * 256 + (n % 128 - e) + 16 * ((e >> 2) & 1) + 4 * (e >> 3) + (e & 3); }
DI void conv_item(const Ctx& C, const float* W, int K, int N, bf16* Wt, int mode, int k0, int n0, float* bias, int bias_pitch, const float* shift  ) {
    LAS float* scr = (LAS float*)(C.lds + C.wave * 16640);
    const int n = n0 + C.lane; const bool ok = n < N; float b0 = 0.f, b1 = 0.f, b2 = 0.f;
#pragma unroll 1
    for (int kh = 0; kh < 4; ++kh) {
        float wv[16];
#pragma unroll
        for (int kk = 0; kk < 16; ++kk) wv[kk] = ok ? W[(size_t)(k0 + 16 * kh + kk) * N + n] : 0.f;
#pragma unroll
        for (int kk = 0; kk < 16; ++kk) { const float v = wv[kk]; scr[(16 * kh + kk) * 65 + C.lane] = v;
            if (bias) { b0 += shift[k0 + 16 * kh + kk] * v; b1 += shift[9 * D + k0 + 16 * kh + kk] * v; b2 += shift[18 * D + k0 + 16 * kh + kk] * v; } } }
    WSYNC();
    const int dme = !ok ? -1 : mode == 0 ? n : mode == 1 ? gu_dest(n) : mode == 2 ? gu_dest(n) + 128 : win_dest(n);
    if (bias && dme >= 0) { atomicAdd(bias + dme, b0); atomicAdd(bias + bias_pitch + dme, b1); atomicAdd(bias + 2 * bias_pitch + dme, b2); }
    const int c = C.lane & 7;
#pragma unroll
    for (int i = 0; i < 8; ++i) { const int nl = (C.lane >> 3) + 8 * i, nn = n0 + nl;
        const int dr = nn >= N ? -1 : mode == 0 ? nn : mode == 1 ? gu_dest(nn) : mode == 2 ? gu_dest(nn) + 128 : win_dest(nn);
        const LAS float* s = scr + (8 * c) * 65 + nl;
        u32x4 o; o.x = pk2(s[0], s[65]); o.y = pk2(s[2 * 65], s[3 * 65]); o.z = pk2(s[4 * 65], s[5 * 65]); o.w = pk2(s[6 * 65], s[7 * 65]);
        if (dr >= 0) *(u32x4*)(Wt + (size_t)dr * K + k0 + 8 * c) = o; }
    WSYNC();
}
struct Cplx { float re, im; };
DI Cplx cmul(Cplx a, Cplx b) { return Cplx{a.re * b.re - a.im * b.im, a.re * b.im + a.im * b.re}; }
DI Cplx s5_lam_pow(const Ctx& C, int l, int dir, int g, int n, float tau) {
    const size_t i = (((size_t)l * 2 + dir) * S5G + g) * 64 + n; const float dt = __expf(C.in[I_S5LDT][((size_t)l * 2 + dir) * S5G + g]);
    const float mag = __expf(tau * dt * C.in[I_S5ARE][i]), ang = tau * dt * C.in[I_S5AIM][i]; float sn, cs; sincosf(ang, &sn, &cs); return Cplx{mag * cs, mag * sn};
}
DI Cplx s5_coef(const Ctx& C, int l, int dir, int g, int n) {
    const size_t i = (((size_t)l * 2 + dir) * S5G + g) * 64 + n; const float are = C.in[I_S5ARE][i], aim = C.in[I_S5AIM][i];
    const Cplx ab = s5_lam_pow(C, l, dir, g, n, 1.0f); const float den = are * are + aim * aim, nr = ab.re - 1.0f;
    return Cplx{(nr * are + ab.im * aim) / den, (ab.im * are - nr * aim) / den};
}
DI Cplx s5_beta(const Ctx& C, int l, int dir, int g, int n, int q) {
    const size_t i = (((size_t)l * S5G + g) * 64 + n) * 16 + q; return cmul(s5_coef(C, l, dir, g, n), Cplx{C.in[I_S5BRE][i], C.in[I_S5BIM][i]});
}
DI Cplx s5_gamma(const Ctx& C, int l, int g, int p, int n) { const size_t i = (((size_t)l * S5G + g) * 16 + p) * 64 + n; return Cplx{C.in[I_S5CRE][i], C.in[I_S5CIM][i]}; }

constexpr int CI_GU = (D / 64) * (FF / 64), CI_DN = (FF / 64) * (D / 64), CI_IN = (D / 64) * ((D_IN + 63) / 64), CI_OUT = (D / 64) * (D / 64), CI_GLU = (GW / 64) * (GW / 64);
constexpr int CI_LAYER = 4 * CI_GU + 2 * CI_DN + CI_IN + CI_OUT + CI_GLU;
DI void conv_weights(const Ctx& C, int l, int wslot, int nslots) {
    for (int it = wslot; it < CI_LAYER; it += nslots) {
        int r = it;
        unsigned char* wbase = C.ws + WS_W + (size_t)l * SZ_WL;
        if (r < 2 * CI_GU) { const int up = r >= CI_GU; r -= up * CI_GU; const int kb = r / (FF / 64), nb = r % (FF / 64);
            conv_item(C, C.in[up ? I_F1WU : I_F1WG] + (size_t)l * D * FF, D, FF, (bf16*)(wbase + OFF_W1GU), 1 + up, kb * 64, nb * 64, bias_ptr(C, l, 0), 2 * FF, modv_ptr(C, l, 0, 0)); continue; } r -= 2 * CI_GU;
        if (r < CI_DN) { const int kb = r / (D / 64), nb = r % (D / 64); conv_item(C, C.in[I_F1WD] + (size_t)l * FF * D, FF, D, (bf16*)(wbase + OFF_W1D), 0, kb * 64, nb * 64, nullptr, 0, nullptr); continue; } r -= CI_DN;
        if (r < CI_IN) { const int nbn = (D_IN + 63) / 64, kb = r / nbn, nb = r % nbn; conv_item(C, C.in[I_WIN] + (size_t)l * D * D_IN, D, D_IN, (bf16*)(wbase + OFF_WIN), 3, kb * 64, nb * 64, bias_ptr(C, l, 1), NINP, modv_ptr(C, l, 0, 3)); continue; } r -= CI_IN;
        if (r < CI_OUT) { const int kb = r / (D / 64), nb = r % (D / 64); conv_item(C, C.in[I_WOUT] + (size_t)l * D * D, D, D, (bf16*)(wbase + OFF_WOUT), 0, kb * 64, nb * 64, nullptr, 0, nullptr); continue; } r -= CI_OUT;
        if (r < 2 * CI_GU) { const int up = r >= CI_GU; r -= up * CI_GU; const int kb = r / (FF / 64), nb = r % (FF / 64);
            conv_item(C, C.in[up ? I_F2WU : I_F2WG] + (size_t)l * D * FF, D, FF, (bf16*)(wbase + OFF_W2GU), 1 + up, kb * 64, nb * 64, bias_ptr(C, l, 2), 2 * FF, modv_ptr(C, l, 0, 6)); continue; } r -= 2 * CI_GU;
        if (r < CI_DN) { const int kb = r / (D / 64), nb = r % (D / 64); conv_item(C, C.in[I_F2WD] + (size_t)l * FF * D, FF, D, (bf16*)(wbase + OFF_W2D), 0, kb * 64, nb * 64, nullptr, 0, nullptr); continue; } r -= CI_DN;
        { const int kb = r / (GW / 64), nb = r % (GW / 64); conv_item(C, C.in[I_S5GLUW] + (size_t)l * GW * GW, GW, GW, (bf16*)(wbase + OFF_WGLU), 0, kb * 64, nb * 64, nullptr, 0, nullptr); }
    }
}
DI void ph_conv(const Ctx& C) {
    const int gt = C.bid * NTHR + C.tid, GT = C.G * NTHR;
    for (int i = gt; i < NL * 9 * D; i += GT) { const int k = i % D, s = (i / D) % 3, sub = (i / (3 * D)) % 3, l = i / (9 * D);
        const float* mv = (const float*)(C.ws + WS_MODV) + ((size_t)l * 3 + s) * 9 * D;
        ((float*)(C.ws + WS_GS))[i] = C.in[I_NORMG][((size_t)l * 3 + sub) * D + k] * (1.0f + mv[(3 * sub + 1) * D + k]);
        ((float*)(C.ws + WS_GATE))[i] = mv[(3 * sub + 2) * D + k] * (sub == 1 ? 1.0f : 0.5f); }
    for (int i = gt; i < 128 * 16; i += GT) { const int pos = i / 16, f = i % 16; const float inv = __expf(-(float)f * (9.210340371976184f / 16.0f)); float sn, cs; sincosf((float)pos * inv, &sn, &cs);
        ((f32x2*)(C.ws + WS_ROPE))[i] = (f32x2){cs, sn}; }
    const int gw = C.bid * NW + C.wave, GWV = C.G * NW;
    conv_weights(C, 0, gw, GWV);
    for (int i = gt; i < NL * 14 * NH * 2 * 64 * 8; i += GT) {
        const int j = i & 7, ln = (i >> 3) & 63, tj = (i >> 9) & 1, hd = (i >> 10) % NH, f = (i / (1024 * NH)) % 14, l = i / (1024 * NH * 14);
        const int col = hd * 64 + 32 * tj + (ln & 31); float v;
        if (f < 8) { const int d = (f >> 1) & 1, sx = f & 1, k = 16 * sx + 8 * (ln >> 5) + j; v = C.in[f < 4 ? I_RWWUP : I_RWAUP][(((size_t)l * 2 + d) * 32 + k) * GW + col]; }
        else { const int k = 16 * (f - 8) + 8 * (ln >> 5) + j; v = C.in[I_RWGUP][((size_t)l * 96 + k) * GW + col]; }
        ((bf16*)(C.ws + WS_RWF))[i] = (bf16)f2bf(v); }
    LAS float* wsc = (LAS float*)(C.lds + C.wave * 16640);
    for (int it = gw; it < NL * S5G * 2 * S5L; it += GWV) {
        const int tau = it % S5L, dir = (it / S5L) % 2, g = (it / (2 * S5L)) % S5G, l = it / (2 * S5L * S5G);
        const Cplx z = cmul(s5_lam_pow(C, l, dir, g, C.lane, (float)tau), s5_coef(C, l, dir, g, C.lane));
#pragma unroll 4
        for (int q = 0; q < 16; ++q) { const size_t i = (((size_t)l * S5G + g) * 64 + C.lane) * 16 + q; const Cplx w = cmul(z, Cplx{C.in[I_S5BRE][i], C.in[I_S5BIM][i]}); wsc[(C.lane * 16 + q) * 2] = w.re; wsc[(C.lane * 16 + q) * 2 + 1] = w.im; }
        WSYNC();
        float* kc = (float*)(C.ws + WS_S5T + (size_t)l * SZ_S5L + OFF_S5KC) + (((size_t)g * 2 + dir) * S5L + tau) * 256;
#pragma unroll 1
        for (int e = 0; e < 4; ++e) { const int pq = C.lane + 64 * e, p = pq >> 4, q = pq & 15; float s = 0.f;
#pragma unroll 4
            for (int n = 0; n < 64; ++n) { const Cplx gm = s5_gamma(C, l, g, p, n); s += gm.re * wsc[(n * 16 + q) * 2] - gm.im * wsc[(n * 16 + q) * 2 + 1]; }
            kc[pq] = s; }
        WSYNC();
    }
    for (int i = gt; i < NL * 2 * GW * 4 * (S5L + 1); i += GT) { const int tau = i % (S5L + 1), r = i / (S5L + 1), n = r % 64, g = (r / 64) % S5G, dir = (r / (64 * S5G)) % 2, l = r / (2 * 64 * S5G);
        const Cplx z = s5_lam_pow(C, l, dir, g, n, (float)tau); ((f32x2*)(C.ws + WS_S5T + (size_t)l * SZ_S5L + OFF_S5LP))[((size_t)(dir * S5G + g) * 64 + n) * (S5L + 1) + tau] = (f32x2){z.re, z.im}; }
    for (int i = gt; i < NL * 2 * GW * 4 * 16; i += GT) { const int q = i % 16, r = i / 16, n = r % 64, g = (r / 64) % S5G, dir = (r / (64 * S5G)) % 2, l = r / (2 * 64 * S5G);
        const Cplx z = s5_beta(C, l, dir, g, n, q); ((f32x2*)(C.ws + WS_S5T + (size_t)l * SZ_S5L + OFF_S5BETA))[((size_t)(dir * S5G + g) * 64 + n) * 16 + q] = (f32x2){z.re, z.im}; }
    for (int i = gt; i < NL * 2 * GW * 4; i += GT) { const int n = i % 64, g = (i / 64) % S5G, dir = (i / (64 * S5G)) % 2, l = i / (2 * 64 * S5G); const Cplx z = s5_lam_pow(C, l, dir, g, n, (float)S5L);
        ((f32x2*)(C.ws + WS_S5T + (size_t)l * SZ_S5L + OFF_S5LAM))[(dir * S5G + g) * 64 + n] = (f32x2){z.re, z.im}; }
}
DI void ph_tab(const Ctx& C) {
    const long gt = (long)C.bid * NTHR + C.tid, GT = (long)C.G * NTHR;
    for (long i = gt; i < (long)NL * S5G * 256 * 512; i += GT) {
        const int k = (int)(i % 512), np = (int)((i / 512) % 256), g = (int)((i / (512 * 256)) % S5G), l = (int)(i / ((long)512 * 256 * S5G));
        const int j = k >> 4, q = k & 15, dir = np >> 7, n = np & 63, im = (np >> 6) & 1;
        const f32x2 lp = ((const f32x2*)(C.ws + WS_S5T + (size_t)l * SZ_S5L + OFF_S5LP))[((size_t)(dir * S5G + g) * 64 + n) * (S5L + 1) + (dir == 0 ? S5L - 1 - j : j)];
        const f32x2 be = ((const f32x2*)(C.ws + WS_S5T + (size_t)l * SZ_S5L + OFF_S5BETA))[((size_t)(dir * S5G + g) * 64 + n) * 16 + q];
        const Cplx w = cmul(Cplx{lp[0], lp[1]}, Cplx{be[0], be[1]});
        ((bf16*)(C.ws + WS_S5T + (size_t)l * SZ_S5L + OFF_S5ET))[((size_t)g * 256 + np) * 512 + k] = (bf16)f2bf(im ? w.im : w.re); }
    for (long i = gt; i < (long)NL * S5G * 512 * S5K; i += GT) {
        const int k = (int)(i % S5K), nn = (int)((i / S5K) % 512), g = (int)((i / ((long)S5K * 512)) % S5G), l = (int)(i / ((long)S5K * 512 * S5G));
        const int ti = nn >> 4, p = nn & 15; float v;
        if (k < 512) { const int j = k >> 4, q = k & 15; const float* kc = (const float*)(C.ws + WS_S5T + (size_t)l * SZ_S5L + OFF_S5KC) + (size_t)g * 2 * S5L * 256;
            v = 0.f; if (j <= ti) v += kc[((ti - j)) * 256 + p * 16 + q]; if (j >= ti) v += kc[(S5L + (j - ti)) * 256 + p * 16 + q]; }
        else { const int kk = k - 512, dir = kk >> 7, im = (kk >> 6) & 1, n = kk & 63;
            const f32x2 lp = ((const f32x2*)(C.ws + WS_S5T + (size_t)l * SZ_S5L + OFF_S5LP))[((size_t)(dir * S5G + g) * 64 + n) * (S5L + 1) + (dir == 0 ? ti + 1 : S5L - ti)];
            const Cplx w = cmul(s5_gamma(C, l, g, p, n), Cplx{lp[0], lp[1]}); v = im ? -w.im : w.re; }
        ((bf16*)(C.ws + WS_S5T + (size_t)l * SZ_S5L + OFF_S5BT))[((size_t)g * 512 + nn) * S5K + k] = (bf16)f2bf(v); }
    const int gw = C.bid * NW + C.wave, GWV = C.G * NW;
    for (int row = gw; row < M; row += GWV) {
        const float* src = row < M_LAT ? C.in[I_X] + (size_t)row * D : C.in[I_CTX] + (size_t)(row - M_LAT) * D;
        float* dst = xrow_ptr(C, row); const float* gs = gs_ptr(C, 0, 0, stream_of_row(row)); bf16* ap = (bf16*)(C.ws + WS_AP) + (size_t)row * D; float ss = 0.f;
        f32x4 xv[D / 256], gv[D / 256];
#pragma unroll
        for (int i = 0; i < D / 256; ++i) { xv[i] = *(const f32x4*)(src + 4 * C.lane + 256 * i); gv[i] = *(const f32x4*)(gs + 4 * C.lane + 256 * i); }
#pragma unroll
        for (int i = 0; i < D / 256; ++i) { const int c = 4 * C.lane + 256 * i; const f32x4 x = xv[i]; *(f32x4*)(dst + c) = x; ss += (x[0] * x[0] + x[1] * x[1]) + (x[2] * x[2] + x[3] * x[3]);
            const f32x4 a = x * gv[i]; u32x2 w; w.x = pk2(a[0], a[1]); w.y = pk2(a[2], a[3]); *(u32x2*)(ap + c) = w; }
        ss = wave_sum(ss); if (C.lane == 0) rowss_ptr(C, 0, 0)[row] = ss;
    }
}

#ifdef EMU
DI s16x4 tr_read1(const LAS unsigned char* a) { return emu_tr_read(a); }
#else
DI s16x4 tr_read1(const LAS unsigned char* a) { s16x4 r; asm volatile("ds_read_b64_tr_b16 %0, %1\n\ts_waitcnt lgkmcnt(0)" : "=&v"(r) : "v"((unsigned)(size_t)a) : "memory"); return r; }
#endif
DI bf16x8 tr_frag(const LAS unsigned char* a0, int hi_off) {
#ifdef EMU
    const s16x4 lo = emu_tr_read(a0), hi = emu_tr_read(a0 + hi_off);
#else
    s16x4 lo, hi; asm volatile("ds_read_b64_tr_b16 %0, %2\n\tds_read_b64_tr_b16 %1, %3\n\ts_waitcnt lgkmcnt(0)" : "=&v"(lo), "=&v"(hi) : "v"((unsigned)(size_t)a0), "v"((unsigned)(size_t)(a0 + hi_off)) : "memory");
#endif
    return __builtin_shufflevector(lo, hi, 0, 1, 2, 3, 4, 5, 6, 7);
}
DI void tr_frag4(const LAS unsigned char* a0, const LAS unsigned char* a1, const LAS unsigned char* a2, const LAS unsigned char* a3, int hi_off, bf16x8 (&f)[4]) {
#ifdef EMU
    f[0] = tr_frag(a0, hi_off); f[1] = tr_frag(a1, hi_off); f[2] = tr_frag(a2, hi_off); f[3] = tr_frag(a3, hi_off);
#else
    s16x4 l0, h0, l1, h1, l2, h2, l3, h3;
    asm volatile("ds_read_b64_tr_b16 %0, %8\n\tds_read_b64_tr_b16 %1, %9\n\tds_read_b64_tr_b16 %2, %10\n\tds_read_b64_tr_b16 %3, %11\n\tds_read_b64_tr_b16 %4, %12\n\tds_read_b64_tr_b16 %5, %13\n\tds_read_b64_tr_b16 %6, %14\n\tds_read_b64_tr_b16 %7, %15\n\ts_waitcnt lgkmcnt(0)"
        : "=&v"(l0), "=&v"(h0), "=&v"(l1), "=&v"(h1), "=&v"(l2), "=&v"(h2), "=&v"(l3), "=&v"(h3)
        : "v"((unsigned)(size_t)a0), "v"((unsigned)(size_t)(a0 + hi_off)), "v"((unsigned)(size_t)a1), "v"((unsigned)(size_t)(a1 + hi_off)), "v"((unsigned)(size_t)a2), "v"((unsigned)(size_t)(a2 + hi_off)), "v"((unsigned)(size_t)a3), "v"((unsigned)(size_t)(a3 + hi_off)) : "memory");
    f[0] = __builtin_shufflevector(l0, h0, 0, 1, 2, 3, 4, 5, 6, 7); f[1] = __builtin_shufflevector(l1, h1, 0, 1, 2, 3, 4, 5, 6, 7); f[2] = __builtin_shufflevector(l2, h2, 0, 1, 2, 3, 4, 5, 6, 7); f[3] = __builtin_shufflevector(l3, h3, 0, 1, 2, 3, 4, 5, 6, 7);
#endif
}
DI bf16x8 pack8(const f32x16& x, int s) {
    u32x4 p; p.x = pk2(x[8 * s], x[8 * s + 1]); p.y = pk2(x[8 * s + 2], x[8 * s + 3]); p.z = pk2(x[8 * s + 4], x[8 * s + 5]); p.w = pk2(x[8 * s + 6], x[8 * s + 7]);
    return __builtin_bit_cast(bf16x8, p);
}
struct AttnSt { f32x16 o0, o1; float m, l; };
struct KVregs { bf16x8 k[4]; u32x4 v[4]; };
struct Kregs { bf16x8 k[4]; };
DI void k_load(Kregs& r, const bf16* Kb, int kp, int lane) {
    const int r32 = lane & 31, h = lane >> 5;
#pragma unroll
    for (int kk = 0; kk < 4; ++kk) r.k[kk] = *(const bf16x8*)(Kb + (size_t)r32 * kp + 16 * kk + 8 * h);
}
DI void kv_load(KVregs& r, const Kregs& kpre, const bf16* Vb, int vp, int lane) {
#pragma unroll
    for (int kk = 0; kk < 4; ++kk) r.k[kk] = kpre.k[kk];
#pragma unroll
    for (int i = 0; i < 4; ++i) { const int idx = lane + 64 * i, key = idx >> 3, ch = idx & 7; r.v[i] = *(const u32x4*)(Vb + (size_t)key * vp + ch * 8); }
}
template <bool MASKED>
DI void attn_block(AttnSt& st, const bf16x8 (&qf)[4], const KVregs& kv, LAS unsigned char* vl, int lane, const float (&addv)[16], unsigned vmask) {
    const int h = lane >> 5;
#pragma unroll
    for (int i = 0; i < 4; ++i) { const int idx = lane + 64 * i, key = idx >> 3, ch = idx & 7; *(LAS u32x4*)(vl + key * 128 + ch * 16) = kv.v[i]; }
    f32x16 s;
#pragma unroll
    for (int i = 0; i < 16; ++i) s[i] = 0.f;
#pragma unroll
    for (int kk = 0; kk < 4; ++kk) s = __builtin_amdgcn_mfma_f32_32x32x16_bf16(kv.k[kk], qf[kk], s, 0, 0, 0);
    float bm = -1e30f;
#pragma unroll
    for (int i = 0; i < 16; ++i) { if (MASKED) { s[i] += addv[i]; if ((vmask >> i) & 1u) bm = fmaxf(bm, s[i]); } else bm = fmaxf(bm, s[i]); }
    bm = fmaxf(bm, __shfl_xor(bm, 32));
    const float mn = fmaxf(st.m, bm), alpha = __expf(st.m - mn); st.m = mn;
    float ls = 0.f;
#pragma unroll
    for (int i = 0; i < 16; ++i) { float p = __expf(s[i] - mn); if (MASKED) p = ((vmask >> i) & 1u) ? p : 0.f; s[i] = p; ls += p; }
    st.l = st.l * alpha + ls;
#pragma unroll
    for (int i = 0; i < 16; ++i) { st.o0[i] *= alpha; st.o1[i] *= alpha; }
    WSYNC();
    const int q = (lane & 15) >> 2, p4 = lane & 3, blk = (lane >> 4) & 1;
    { const LAS unsigned char* ab = vl + (4 * h + q) * 128 + (16 * blk) * 2 + 8 * p4; bf16x8 vf[4];
      tr_frag4(ab, ab + 64, ab + 16 * 128, ab + 16 * 128 + 64, 8 * 128, vf);
      const bf16x8 pf0 = pack8(s, 0), pf1 = pack8(s, 1);
      st.o0 = __builtin_amdgcn_mfma_f32_32x32x16_bf16(vf[0], pf0, st.o0, 0, 0, 0); st.o1 = __builtin_amdgcn_mfma_f32_32x32x16_bf16(vf[1], pf0, st.o1, 0, 0, 0);
      st.o0 = __builtin_amdgcn_mfma_f32_32x32x16_bf16(vf[2], pf1, st.o0, 0, 0, 0); st.o1 = __builtin_amdgcn_mfma_f32_32x32x16_bf16(vf[3], pf1, st.o1, 0, 0, 0); }
}
DI void attn_finish(AttnSt& st, bf16* orow  , int lane, float extra_l) {
    const int h = lane >> 5; float l = st.l + __shfl_xor(st.l, 32) + extra_l; const float inv = 1.0f / l;
#pragma unroll
    for (int g = 0; g < 4; ++g) {
        u32x2 w0, w1; w0.x = pk2(st.o0[4 * g] * inv, st.o0[4 * g + 1] * inv); w0.y = pk2(st.o0[4 * g + 2] * inv, st.o0[4 * g + 3] * inv);
        w1.x = pk2(st.o1[4 * g] * inv, st.o1[4 * g + 1] * inv); w1.y = pk2(st.o1[4 * g + 2] * inv, st.o1[4 * g + 3] * inv);
        *(u32x2*)(orow + 8 * g + 4 * h) = w0; *(u32x2*)(orow + 32 + 8 * g + 4 * h) = w1; }
}
DI int clampi(int v, int lo, int hi) { return v < lo ? lo : (v > hi ? hi : v); }
constexpr int AT_NA = NB * NH * (GRH / 2) * 4, AT_WA = NB * NH * (T / 32), AT_CX = NB * NH * (TC / 32);
DI void ph_attn(const Ctx& C, int l, bool want_ctx, int first_block) {
    if (C.bid < first_block) return;
    const int gw = (C.bid - first_block) * NW + C.wave, GWV = (C.G - first_block) * NW, lane = C.lane, r32 = lane & 31, h = lane >> 5;
    LAS unsigned char* vl = C.lds + C.wave * 4096;
    const bf16* QA = (const bf16*)(C.ws + WS_QA); const bf16* KA = (const bf16*)(C.ws + WS_KA); const bf16* VA = (const bf16*)(C.ws + WS_VA);
    const bf16* QC = (const bf16*)(C.ws + WS_QC); const bf16* KC = (const bf16*)(C.ws + WS_KC); const bf16* VC = (const bf16*)(C.ws + WS_VC);
    bf16* OB = (bf16*)(C.ws + WS_OB);
    const int ntiles = AT_NA + AT_WA + (want_ctx ? 2 * AT_CX : 0);
    const float zero16[16] = {0.f, 0.f, 0.f, 0.f, 0.f, 0.f, 0.f, 0.f, 0.f, 0.f, 0.f, 0.f, 0.f, 0.f, 0.f, 0.f};
    for (int tile = gw; tile < ntiles; tile += GWV) {
        AttnSt st; st.m = -1e30f; st.l = 0.f;
#pragma unroll
        for (int i = 0; i < 16; ++i) { st.o0[i] = 0.f; st.o1[i] = 0.f; }
        bf16x8 qf[4];
        if (tile < AT_NA) {
            const int cb = tile & 3, rp = (tile >> 2) % (GRH / 2), hd = (tile / (4 * (GRH / 2))) % NH, b = tile / (4 * (GRH / 2) * NH);
            const int r0 = 2 * rp, c0 = 16 * cb, qr = r0 + (r32 >> 4), qc = c0 + (r32 & 15), qrow = b * T + qr * GRW + qc;
#pragma unroll
            for (int kk = 0; kk < 4; ++kk) qf[kk] = *(const bf16x8*)(QA + (size_t)qrow * GW + hd * 64 + 16 * kk + 8 * h);
            const int rsq = clampi(qr - 4, 0, GRH - 8), csq = clampi(qc - 8, 0, GRW - 16);
            const int rsA = clampi(r0 - 4, 0, GRH - 8), rsB = clampi(r0 + 1 - 4, 0, GRH - 8), kc0 = clampi(c0 - 8, 0, GRW - 32);
            const float* rpb = C.in[I_NARPB] + ((size_t)l * NH + hd) * 465;
            const int nbn = rsB + 8 - rsA, nbt = nbn + TC / 32; KVregs cur; Kregs nxt;
#define NA_ROW(i) ((i) < nbn ? (size_t)b * T + (rsA + (i)) * GRW + kc0 : (size_t)M_LAT + b * TC + 32 * ((i) - nbn))
            { const size_t kr0 = NA_ROW(0); k_load(nxt, KA + kr0 * GW + hd * 64, GW, lane); }
            for (int ib = 0; ib < nbt; ++ib) {
                { const size_t kr0 = NA_ROW(ib); kv_load(cur, nxt, VA + kr0 * GW + hd * 64, GW, lane); }
                if (ib + 1 < nbt) { const size_t kr1 = NA_ROW(ib + 1); k_load(nxt, KA + kr1 * GW + hd * 64, GW, lane); }
                if (ib < nbn) { const int kr = rsA + ib; float addv[16]; unsigned vm = 0u; const bool rok = kr >= rsq && kr <= rsq + 7;
#pragma unroll
                    for (int i = 0; i < 16; ++i) { const int kb = (i & 3) + 8 * (i >> 2) + 4 * h, kc = kc0 + kb; const bool ok = rok && kc >= csq && kc <= csq + 15;
                        const int bi = ok ? (kr - qr + 7) * 31 + (kc - qc + 15) : 0; addv[i] = rpb[bi]; vm |= ok ? (1u << i) : 0u; }
                    attn_block<true>(st, qf, cur, vl, lane, addv, vm); }
                else attn_block<false>(st, qf, cur, vl, lane, zero16, 0xffffu); }
#undef NA_ROW
            attn_finish(st, OB + (size_t)qrow * D + hd * 64, lane, 0.f);
        } else if (tile < AT_NA + AT_WA) {
            const int t2 = tile - AT_NA, qb = t2 % (T / 32), hd = (t2 / (T / 32)) % NH, b = t2 / ((T / 32) * NH), kvh = hd / WAG;
            const int qt = 32 * qb + r32, qrow = b * T + qt;
#pragma unroll
            for (int kk = 0; kk < 4; ++kk) qf[kk] = *(const bf16x8*)(QC + (size_t)qrow * GW + hd * 64 + 16 * kk + 8 * h);
            const int i_lo = 4 - qb > 0 ? 4 - qb : 0, i_hi = (T / 32 - qb + 4) < 9 ? (T / 32 - qb + 4) : 9, nbw = i_hi - i_lo, nbt = nbw + TC / 32; KVregs cur; Kregs nxt;
#define WA_ROW(i) ((i) < nbw ? (size_t)b * T + 32 * qb - 128 + 32 * (i_lo + (i)) : (size_t)M_LAT + b * TC + 32 * ((i) - nbw))
            { const size_t kr0 = WA_ROW(0); k_load(nxt, KC + kr0 * 128 + kvh * 64, 128, lane); }
            for (int ib = 0; ib < nbt; ++ib) {
                { const size_t kr0 = WA_ROW(ib); kv_load(cur, nxt, VC + kr0 * 128 + kvh * 64, 128, lane); }
                if (ib + 1 < nbt) { const size_t kr1 = WA_ROW(ib + 1); k_load(nxt, KC + kr1 * 128 + kvh * 64, 128, lane); }
                if (ib < nbw) { const int t0 = 32 * qb - 128 + 32 * (i_lo + ib); float addv[16]; unsigned vm = 0u;
#pragma unroll
                    for (int i = 0; i < 16; ++i) { const int kt = t0 + (i & 3) + 8 * (i >> 2) + 4 * h, rel = kt - qt; addv[i] = 0.f; vm |= (rel >= -128 && rel <= 128) ? (1u << i) : 0u; }
                    attn_block<true>(st, qf, cur, vl, lane, addv, vm); }
                else attn_block<false>(st, qf, cur, vl, lane, zero16, 0xffffu); }
#undef WA_ROW
            const float sk = C.in[I_WASINK][(size_t)l * NH + hd];
            const float mfin = fmaxf(st.m, sk), a2 = __expf(st.m - mfin);
#pragma unroll
            for (int i = 0; i < 16; ++i) { st.o0[i] *= a2; st.o1[i] *= a2; }
            st.l *= a2; st.m = mfin;
            attn_finish(st, OB + (size_t)qrow * D + 2 * GW + hd * 64, lane, __expf(sk - mfin));
        } else {
            const int t2 = tile - AT_NA - AT_WA, isc = t2 >= AT_CX, t3 = t2 - isc * AT_CX, qb = t3 % (TC / 32), hd = (t3 / (TC / 32)) % NH, b = t3 / ((TC / 32) * NH), kvh = hd / WAG;
            const int qrow = M_LAT + b * TC + 32 * qb + r32;
            const bf16* Qs = isc ? QC : QA; const bf16* Ks = isc ? KC + kvh * 64 : KA + hd * 64; const bf16* Vs = isc ? VC + kvh * 64 : VA + hd * 64; const int kp = isc ? 128 : GW;
#pragma unroll
            for (int kk = 0; kk < 4; ++kk) qf[kk] = *(const bf16x8*)(Qs + (size_t)qrow * GW + hd * 64 + 16 * kk + 8 * h);
            { KVregs cur; Kregs nxt; const size_t kr0 = (size_t)M_LAT + b * TC; k_load(nxt, Ks + kr0 * kp, kp, lane);
              for (int cbk = 0; cbk < TC / 32; ++cbk) { kv_load(cur, nxt, Vs + (kr0 + 32 * cbk) * kp, kp, lane); if (cbk + 1 < TC / 32) k_load(nxt, Ks + (kr0 + 32 * (cbk + 1)) * kp, kp, lane);
                  attn_block<false>(st, qf, cur, vl, lane, zero16, 0xffffu); } }
            float extra = 0.f;
            if (isc) { const float sk = C.in[I_WASINK][(size_t)l * NH + hd]; const float mfin = fmaxf(st.m, sk), a2 = __expf(st.m - mfin);
#pragma unroll
                for (int i = 0; i < 16; ++i) { st.o0[i] *= a2; st.o1[i] *= a2; }
                st.l *= a2; st.m = mfin; extra = __expf(sk - mfin); }
            attn_finish(st, OB + (size_t)qrow * D + (isc ? 2 * GW : 0) + hd * 64, lane, extra);
        }
    }
}

DI void ph_ctxfix(const Ctx& C, const float* gsn  , float* rowss_next) {
    const int gw = C.bid * NW + C.wave, GWV = C.G * NW;
    for (int r = gw; r < M_CTX; r += GWV) { const int row = M_LAT + r; const float* xp = xrow_ptr(C, row); const float* gs = gsn + (size_t)NB * D; bf16* ap = (bf16*)(C.ws + WS_AP) + (size_t)row * D; float ss = 0.f;
        f32x4 xv[D / 256], gv[D / 256];
#pragma unroll
        for (int i = 0; i < D / 256; ++i) { xv[i] = *(const f32x4*)(xp + 4 * C.lane + 256 * i); gv[i] = *(const f32x4*)(gs + 4 * C.lane + 256 * i); }
#pragma unroll
        for (int i = 0; i < D / 256; ++i) { const int c = 4 * C.lane + 256 * i; const f32x4 x = xv[i]; ss += (x[0] * x[0] + x[1] * x[1]) + (x[2] * x[2] + x[3] * x[3]);
            const f32x4 a = x * gv[i]; u32x2 w; w.x = pk2(a[0], a[1]); w.y = pk2(a[2], a[3]); *(u32x2*)(ap + c) = w; }
        ss = wave_sum(ss); if (C.lane == 0) rowss_next[row] = ss; }
}
constexpr int PT = 144;
constexpr int RW_HALF = 73472, IM_BT = 0, IM_KT = 9216, IM_RT = 18432, IM_ARB = 27648, IM_AT = 36864, IM_AAK = 46080, IM_F = 55296, IM_GC = 72704, FP = 68;
DI void chunk_rows(int b, int dir, int c, int& row0, int& step) {
    if (c < TC / 64) { const int p0 = 64 * c; row0 = M_LAT + b * TC + (dir ? TC - 1 - p0 : p0); } else { const int p0 = 64 * (c - TC / 64); row0 = b * T + (dir ? T - 1 - p0 : p0); }
    step = dir ? -1 : 1;
}
DI bf16x8 frag_rows(const LAS unsigned char* img, int tile, int s, int lane) { return *(const LAS bf16x8*)(img + (32 * tile + (lane & 31)) * PT + (16 * s + 8 * (lane >> 5)) * 2); }
DI bf16x8 frag_cols(const LAS unsigned char* img, int tile, int s, int lane) {
    const int h = lane >> 5, q = (lane & 15) >> 2, p4 = lane & 3, blk = (lane >> 4) & 1;
    const LAS unsigned char* a0 = img + (16 * s + 8 * h + q) * PT + (32 * tile + 16 * blk) * 2 + 8 * p4;
    return tr_frag(a0, 4 * PT);
}
DI void frag_cols4(const LAS unsigned char* img, int tile, int lane, bf16x8 (&f)[4]) {
    const int h = lane >> 5, q = (lane & 15) >> 2, p4 = lane & 3, blk = (lane >> 4) & 1;
    const LAS unsigned char* a0 = img + (8 * h + q) * PT + (32 * tile + 16 * blk) * 2 + 8 * p4;
    tr_frag4(a0, a0 + 16 * PT, a0 + 32 * PT, a0 + 48 * PT, 4 * PT, f);
}
DI void store_T(const f32x16& acc, LAS unsigned char* img, int ti, int tj, int lane) {
    const int c = lane & 31, h = lane >> 5;
#pragma unroll
    for (int g = 0; g < 4; ++g) { u32x2 w; w.x = pk2(acc[4 * g], acc[4 * g + 1]); w.y = pk2(acc[4 * g + 2], acc[4 * g + 3]); *(LAS u32x2*)(img + (32 * tj + c) * PT + (32 * ti + 8 * g + 4 * h) * 2) = w; }
}
DI f32x16 zero16v() { f32x16 z;
#pragma unroll
    for (int i = 0; i < 16; ++i) z[i] = 0.f; return z; }
#define MMA32(a, b, c) __builtin_amdgcn_mfma_f32_32x32x16_bf16((a), (b), (c), 0, 0, 0)
constexpr int PDW = 80, PDG = 208, IM_TW = 0, IM_TA = 17408, IM_DW = 36864, IM_DA = 41984, IM_DG = 47104;
DI void ph_rw1(const Ctx& C, int l) {
    const int wg = C.wave & 3, grp = C.wave >> 2, ti = wg >> 1, tj = wg & 1;
    bf16* QH = (bf16*)(C.ws + WS_QH); float* YL = (float*)(C.ws + WS_YL); bf16* MF = (bf16*)(C.ws + WS_MF); float* GF = (float*)(C.ws + WS_GF); bf16* RVKG = (bf16*)(C.ws + WS_RVKG);
    const bf16* PB = (const bf16*)(C.ws + WS_PB); const float* PS = (const float*)(C.ws + WS_PS);
    const bf16x8* RWF = (const bf16x8*)(C.ws + WS_RWF + (size_t)l * SZ_RWF);
    constexpr int nblk = (TC + T) / 64;
    for (int it0 = 2 * C.bid; it0 < RBLK; it0 += 2 * C.G) {
        int lane_ = threadIdx.x & 63; OPAQUE(lane_); const int lane = lane_, c32 = lane & 31, h = lane >> 5;
        LAS unsigned char* L = OPAQUE_LDS(C.lds + grp * RW_HALF);
        LAS float* F = (LAS float*)(L + IM_F); LAS float* SEG = (LAS float*)(L + IM_F); LAS float* GC = (LAS float*)(L + IM_GC);
        LAS float* TW = (LAS float*)(L + IM_TW); LAS float* TA = (LAS float*)(L + IM_TA);
        unsigned char* PK = C.ws + WS_RWS + ((size_t)C.bid * 2 + grp) * 65536;
        const int item = it0 + grp; const bool live = item < RBLK; const int itc = live ? item : RBLK - 1;
        const int tb = itc % nblk, hd = (itc / nblk) % NH, b = itc / (nblk * NH), cg = hd * 64 + lane;
        const int rowb = tb < TC / 64 ? M_LAT + b * TC + 64 * tb : b * T + 64 * (tb - TC / 64);
        const int seq_lo = tb < TC / 64 ? M_LAT + b * TC : b * T, seq_hi = seq_lo + (tb < TC / 64 ? TC : T);
        bf16* RV = RVKG + (size_t)itc * 4 * 4096;
        __syncthreads();
        float r_[16], kf_[16], kk_[16], ks_[16];
        { const float* cw = C.in[I_RWCONV] + (size_t)l * 9 * GW; float cwv[3][3];
#pragma unroll
          for (int j = 0; j < 3; ++j)
#pragma unroll
              for (int x = 0; x < 3; ++x) cwv[j][x] = cw[(size_t)j * 3 * GW + x * GW + cg];
          const float kkw = C.in[I_RWKK][(size_t)l * GW + cg];
          const int r0 = rowb + 16 * wg;
          bf16 pbv[18][3]; float psv[16][3];
#pragma unroll
          for (int rr = 0; rr < 18; ++rr) { int row = r0 - 1 + rr; row = row < seq_lo ? seq_lo : (row >= seq_hi ? seq_hi - 1 : row);
#pragma unroll
              for (int x = 0; x < 3; ++x) pbv[rr][x] = PB[(size_t)row * 3 * GW + x * GW + cg]; }
#pragma unroll
          for (int t = 0; t < 16; ++t)
#pragma unroll
              for (int kq = 0; kq < 3; ++kq) { const int k = lane + 64 * kq; psv[t][kq] = PS[(size_t)(r0 + t) * 160 + (k < 160 ? k : 159)]; }
          const float m_lo = r0 - 1 >= seq_lo ? 1.f : 0.f, m_hi = r0 + 16 < seq_hi ? 1.f : 0.f;
          float v_[16];
#pragma unroll
          for (int t = 0; t < 16; ++t) {
              float xa[3], xb[3], xc[3];
#pragma unroll
              for (int x = 0; x < 3; ++x) { xa[x] = bf2f(pbv[t][x]) * (t == 0 ? m_lo : 1.f); xb[x] = bf2f(pbv[t + 1][x]); xc[x] = bf2f(pbv[t + 2][x]) * (t == 15 ? m_hi : 1.f); }
              r_[t] = xa[0] * cwv[0][0] + xb[0] * cwv[1][0] + xc[0] * cwv[2][0]; kf_[t] = xa[1] * cwv[0][1] + xb[1] * cwv[1][1] + xc[1] * cwv[2][1]; v_[t] = xa[2] * cwv[0][2] + xb[2] * cwv[1][2] + xc[2] * cwv[2][2];
              const float kkv = kf_[t] * kkw, ssq = wave_sum(kkv * kkv); kk_[t] = kkv * __builtin_amdgcn_rsqf(fmaxf(ssq, 1e-24f)); ks_[t] = 0.f;
              const int tk = 16 * wg + t;
              if (lane < 32) *(LAS bf16*)(L + IM_DW + tk * PDW + lane * 2) = (bf16)f2bf(fast_tanh(psv[t][0])); else *(LAS bf16*)(L + IM_DA + tk * PDW + (lane - 32) * 2) = (bf16)f2bf(psv[t][0]);
              *(LAS bf16*)(L + IM_DG + tk * PDG + lane * 2) = (bf16)f2bf(sigmf(psv[t][1]));
              if (lane < 32) *(LAS bf16*)(L + IM_DG + tk * PDG + (lane + 64) * 2) = (bf16)f2bf(sigmf(psv[t][2]));
          }
#pragma unroll
          for (int t = 0; t < 16; ++t) { RV[(16 * wg + t) * 64 + lane] = (bf16)f2bf(r_[t]); RV[4096 + (16 * wg + t) * 64 + lane] = (bf16)f2bf(v_[t]); }
        }
        __syncthreads();
        bf16x8 lrf[2][4]; float w0v[2], a0v[2];
#pragma unroll
        for (int d = 0; d < 2; ++d) {
#pragma unroll
            for (int sx = 0; sx < 2; ++sx) { lrf[d][sx] = RWF[(((0 + 2 * d + sx) * NH + hd) * 2 + tj) * 64 + lane]; lrf[d][2 + sx] = RWF[(((4 + 2 * d + sx) * NH + hd) * 2 + tj) * 64 + lane]; }
            w0v[d] = C.in[I_RWW0][((size_t)l * 2 + d) * GW + hd * 64 + 32 * tj + c32]; a0v[d] = C.in[I_RWA0][((size_t)l * 2 + d) * GW + hd * 64 + 32 * tj + c32]; }
        { f32x16 gacc = zero16v();
#pragma unroll
          for (int sx = 0; sx < 6; ++sx) gacc = MMA32(*(const LAS bf16x8*)(L + IM_DG + (32 * ti + c32) * PDG + (16 * sx + 8 * h) * 2), RWF[(((8 + sx) * NH + hd) * 2 + tj) * 64 + lane], gacc);
#pragma unroll
          for (int rg = 0; rg < 16; ++rg) { const int tk = 32 * ti + (rg & 3) + 8 * (rg >> 2) + 4 * h; RV[3 * 4096 + tk * 64 + 32 * tj + c32] = (bf16)f2bf(gacc[rg]); }
        }
        const float kaw = C.in[I_RWKA][(size_t)l * GW + cg];
#pragma unroll
        for (int pss = 0; pss < 2; ++pss) {
            const int dir = 1 - pss;
            __syncthreads();
            { f32x16 pw = zero16v(), pa = zero16v();
#pragma unroll
              for (int sx = 0; sx < 2; ++sx) { pw = MMA32(*(const LAS bf16x8*)(L + IM_DW + (32 * ti + c32) * PDW + (16 * sx + 8 * h) * 2), lrf[dir][sx], pw);
                                              pa = MMA32(*(const LAS bf16x8*)(L + IM_DA + (32 * ti + c32) * PDW + (16 * sx + 8 * h) * 2), lrf[dir][2 + sx], pa); }
              const float w0 = w0v[dir], a0 = a0v[dir];
#pragma unroll
              for (int rg = 0; rg < 16; ++rg) { const int tk = 32 * ti + (rg & 3) + 8 * (rg >> 2) + 4 * h; const float z = -(w0 + pw[rg]), sp = z > 20.f ? z : __logf(1.f + __expf(z));
                  TW[tk * FP + 32 * tj + c32] = -__expf(-sp - 0.5f); TA[tk * FP + 32 * tj + c32] = sigmf(a0 + pa[rg]); } }
            __syncthreads();
            const int cs = dir ? 3 - wg : wg;
            float lw[16], av[16], run = 0.f;
#pragma unroll
            for (int ii = 0; ii < 16; ++ii) { const int tl = dir ? 15 - ii : ii, tk = 16 * wg + tl; av[ii] = TA[tk * FP + lane]; run += TW[tk * FP + lane]; lw[ii] = run; }
            __syncthreads();
            SEG[cs * 64 + lane] = run;
            __syncthreads();
            float off = 0.f;
#pragma unroll
            for (int w2 = 0; w2 < 3; ++w2) off += (w2 < cs) ? SEG[w2 * 64 + lane] : 0.f;
            const float tot = SEG[lane] + SEG[64 + lane] + SEG[128 + lane] + SEG[192 + lane];
            if (wg == 0) { if (dir) ((float*)(PK + 32768))[lane] = __expf(tot); else GC[lane] = __expf(tot); }
            float ePrev = __expf(off);
#pragma unroll
            for (int ii = 0; ii < 16; ++ii) { const int tl = dir ? 15 - ii : ii, i = 16 * cs + ii;
                const float Li = lw[ii] + off, eL = __expf(Li), ieL = __builtin_amdgcn_rcpf(eL), eLm = ePrev; ePrev = eL;
                const float a = av[ii], kd = kf_[tl] * (1.f + (a - 1.f) * kaw); ks_[tl] += kd;
                const bf16 vat = (bf16)f2bf(-kk_[tl] * eLm), vbt = (bf16)f2bf(kk_[tl] * a * ieL), vkt = (bf16)f2bf(kd * ieL), vrt = (bf16)f2bf(r_[tl] * eL);
                if (dir) { bf16* pk = (bf16*)PK + i * 64 + lane; pk[0] = vat; pk[4096] = vbt; pk[8192] = vkt; pk[12288] = vrt; }
                else { *(LAS bf16*)(L + IM_AT + i * PT + lane * 2) = vat; *(LAS bf16*)(L + IM_BT + i * PT + lane * 2) = vbt; *(LAS bf16*)(L + IM_KT + i * PT + lane * 2) = vkt; *(LAS bf16*)(L + IM_RT + i * PT + lane * 2) = vrt; } }
        }
#pragma unroll
        for (int t = 0; t < 16; ++t) RV[2 * 4096 + (16 * wg + t) * 64 + lane] = (bf16)f2bf(ks_[t]);
#pragma unroll 1
        for (int dir = 0; dir < 2; ++dir) {
            const int c = dir == 0 ? tb : (tb < TC / 64 ? TC / 64 - 1 - tb : TC / 64 + (T / 64 - 1 - (tb - TC / 64)));
            const size_t ci = ((size_t)((b * NH + hd) * 2 + dir)) * RCK + c;
            __syncthreads();
            if (dir) {
                const int tg = wg * 64 + lane;
#pragma unroll
                for (int im = 0; im < 4; ++im)
#pragma unroll
                    for (int rr = 0; rr < 2; ++rr) { const int idx = tg + 256 * rr, row = idx >> 3, ch = idx & 7; const int dsto = im == 0 ? IM_AT : im == 1 ? IM_BT : im == 2 ? IM_KT : IM_RT;
                        *(LAS u32x4*)(L + dsto + row * PT + ch * 16) = *(const u32x4*)(PK + im * 8192 + row * 128 + ch * 16); }
                if (wg == 0) GC[lane] = ((const float*)(PK + 32768))[lane];
                __syncthreads();
            }
            f32x16 accP;
            { f32x16 aab = zero16v(), aak = zero16v(), arb = zero16v(); accP = zero16v();
#pragma unroll
              for (int s = 0; s < 4; ++s) { const bf16x8 at_i = frag_rows(L + IM_AT, ti, s, lane), bt_j = frag_rows(L + IM_BT, tj, s, lane), kt_j = frag_rows(L + IM_KT, ti, s, lane), at_c = frag_rows(L + IM_AT, tj, s, lane),
                                              bt_r = frag_rows(L + IM_BT, ti, s, lane), rt_c = frag_rows(L + IM_RT, tj, s, lane);
                  aab = MMA32(at_i, bt_j, aab); aak = MMA32(kt_j, at_c, aak); arb = MMA32(bt_r, rt_c, arb); accP = MMA32(kt_j, rt_c, accP); }
#pragma unroll
              for (int r = 0; r < 16; ++r) { const int row = 32 * ti + (r & 3) + 8 * (r >> 2) + 4 * h, col = 32 * tj + c32;
                  F[row * FP + col] = col < row ? aab[r] : 0.f; aak[r] = row < col ? aak[r] : 0.f; arb[r] = row <= col ? arb[r] : 0.f; accP[r] = row <= col ? accP[r] : 0.f; }
              store_T(aak, L + IM_AAK, ti, tj, lane);
              store_T(arb, L + IM_ARB, ti, tj, lane); }
            __syncthreads();
            { float Wc[64]; const int col = 32 * wg + c32; const LAS unsigned char* src = col < 64 ? L + IM_AT + col * 2 : L + IM_AAK + (col - 64) * 2;
              const LAS float* Fo = OPAQUE_LDS(F);
#pragma unroll
              for (int i = 0; i < 64; ++i) Wc[i] = bf2f(*(const LAS bf16*)(src + i * PT));
#pragma unroll
              for (int i = 1; i < 64; ++i) { float a0 = Wc[i], a1 = 0.f, a2 = 0.f, a3 = 0.f;
#pragma unroll
                  for (int j4 = 0; j4 < (i + 3) / 4; ++j4) { const f32x4 f = *(const LAS f32x4*)(Fo + i * FP + 4 * j4); a0 += f[0] * Wc[4 * j4]; a1 += f[1] * Wc[4 * j4 + 1]; a2 += f[2] * Wc[4 * j4 + 2]; a3 += f[3] * Wc[4 * j4 + 3];
                      if ((j4 & 7) == 7) PIN4(a0, a1, a2, a3); }
                  PIN4(a0, a1, a2, a3); Wc[i] = (a0 + a1) + (a2 + a3); }
              __syncthreads();
              if (h == 0) { LAS unsigned char* dst = (col < 64 ? L + IM_AT + col * PT : L + IM_AAK + (col - 64) * PT);
#pragma unroll
                  for (int i8 = 0; i8 < 8; ++i8) { u32x4 w; w.x = pk2(Wc[8 * i8], Wc[8 * i8 + 1]); w.y = pk2(Wc[8 * i8 + 2], Wc[8 * i8 + 3]); w.z = pk2(Wc[8 * i8 + 4], Wc[8 * i8 + 5]); w.w = pk2(Wc[8 * i8 + 6], Wc[8 * i8 + 7]); *(LAS u32x4*)(dst + i8 * 16) = w; } }
#pragma unroll
              for (int ii = 0; ii < 16; ++ii) { const int tl = dir ? 15 - ii : ii, i = 16 * (dir ? 3 - wg : wg) + ii; *(LAS bf16*)(L + IM_F + i * PT + lane * 2) = RV[4096 + (16 * wg + tl) * 64 + lane]; }
            }
            __syncthreads();
            { f32x16 q;
#pragma unroll
              for (int g = 0; g < 4; ++g) { const u32x2 w = *(const LAS u32x2*)(L + IM_RT + (32 * tj + c32) * PT + (32 * ti + 8 * g + 4 * h) * 2); q[4 * g] = bflo(w.x); q[4 * g + 1] = bfhi(w.x); q[4 * g + 2] = bflo(w.y); q[4 * g + 3] = bfhi(w.y); }
#pragma unroll
              for (int s = 0; s < 4; ++s) { const bf16x8 arb = frag_rows(L + IM_ARB, tj, s, lane); q = MMA32(frag_rows(L + IM_AT, ti, s, lane), arb, q); accP = MMA32(frag_rows(L + IM_AAK, ti, s, lane), arb, accP); }
              if (live) {
#pragma unroll
                  for (int g = 0; g < 4; ++g) { u32x2 w; w.x = pk2(q[4 * g], q[4 * g + 1]); w.y = pk2(q[4 * g + 2], q[4 * g + 3]); *(u32x2*)(QH + ci * 4096 + (32 * tj + c32) * 64 + 32 * ti + 8 * g + 4 * h) = w; } }
            }
            __syncthreads();
            store_T(accP, L + IM_RT, ti, tj, lane);
            __syncthreads();
            { f32x16 y = zero16v(), m = zero16v(), n;
#pragma unroll
              for (int g = 0; g < 4; ++g) { const u32x2 w = *(const LAS u32x2*)(L + IM_KT + (32 * tj + c32) * PT + (32 * ti + 8 * g + 4 * h) * 2); n[4 * g] = bflo(w.x); n[4 * g + 1] = bfhi(w.x); n[4 * g + 2] = bflo(w.y); n[4 * g + 3] = bfhi(w.y); }
              bf16x8 btj[4], bti[4], vfj[4]; frag_cols4(L + IM_BT, tj, lane, btj); frag_cols4(L + IM_BT, ti, lane, bti); frag_cols4(L + IM_F, tj, lane, vfj);
#pragma unroll
              for (int s = 0; s < 4; ++s) { const bf16x8 btc_j = btj[s], btc_i = bti[s];
                  y = MMA32(frag_rows(L + IM_RT, ti, s, lane), vfj[s], y);
                  m = MMA32(frag_rows(L + IM_AT, ti, s, lane), btc_j, m);
                  n = MMA32(btc_i, frag_rows(L + IM_AAK, tj, s, lane), n); }
              const float gck = GC[32 * tj + c32];
#pragma unroll
              for (int r = 0; r < 16; ++r) { const int row = 32 * ti + (r & 3) + 8 * (r >> 2) + 4 * h, col = 32 * tj + c32; m[r] = (m[r] + (row == col ? 1.0f : 0.f)) * gck; n[r] *= GC[row]; }
              if (live) {
#pragma unroll
                  for (int g = 0; g < 4; ++g) *(f32x4*)(YL + ci * 4096 + ((wg * 4 + g) * 64 + lane) * 4) = (f32x4){y[4 * g], y[4 * g + 1], y[4 * g + 2], y[4 * g + 3]};
#pragma unroll
                  for (int s2 = 0; s2 < 2; ++s2) *(bf16x8*)(MF + ci * 4096 + ((wg * 2 + s2) * 64 + lane) * 8) = pack8(m, s2); }
              store_T(n, L + IM_ARB, ti, tj, lane);
            }
            __syncthreads();
            { f32x16 gacc = zero16v(); bf16x8 nfi[4], vfj[4]; frag_cols4(L + IM_ARB, ti, lane, nfi); frag_cols4(L + IM_F, tj, lane, vfj);
#pragma unroll
              for (int s = 0; s < 4; ++s) gacc = MMA32(nfi[s], vfj[s], gacc);
              if (live) {
#pragma unroll
                  for (int g = 0; g < 4; ++g) *(f32x4*)(GF + ci * 4096 + ((wg * 4 + g) * 64 + lane) * 4) = (f32x4){gacc[4 * g], gacc[4 * g + 1], gacc[4 * g + 2], gacc[4 * g + 3]}; }
            }
        }
    }
    __syncthreads();
}
DI void ph_rw2(const Ctx& C) {
    const int lane = C.lane;
    const bf16* MF = (const bf16*)(C.ws + WS_MF); const float* GF = (const float*)(C.ws + WS_GF); bf16* SF = (bf16*)(C.ws + WS_SF);
    const int nwork = RSTR * 2;
    for (int wk = C.wave == 0 ? C.bid : nwork; wk < nwork; wk += C.G) {
        const int tj = wk & 1, stream = wk >> 1;
        f32x16 s0 = zero16v(), s1 = zero16v();
        bf16x8 mf[2][2][2]; f32x4 gq[2][4];
#define RW2_LOAD(item_) do { const size_t it_ = (item_); \
            _Pragma("unroll") for (int kp = 0; kp < 2; ++kp) _Pragma("unroll") for (int kt = 0; kt < 2; ++kt) _Pragma("unroll") for (int s = 0; s < 2; ++s) mf[kp][kt][s] = *(const bf16x8*)(MF + it_ * 4096 + (((kp * 2 + kt) * 2 + s) * 64 + lane) * 8); \
            _Pragma("unroll") for (int kt = 0; kt < 2; ++kt) _Pragma("unroll") for (int g = 0; g < 4; ++g) gq[kt][g] = *(const f32x4*)(GF + it_ * 4096 + (((kt * 2 + tj) * 4 + g) * 64 + lane) * 4); } while (0)
        RW2_LOAD((size_t)stream * RCK);
        for (int c = 0; c < RCK; ++c) {
            const size_t item = (size_t)stream * RCK + c;
            bf16x8 sf[2][2];
#pragma unroll
            for (int s = 0; s < 2; ++s) { sf[0][s] = pack8(s0, s); sf[1][s] = pack8(s1, s); *(bf16x8*)(SF + item * 4096 + (((0 * 2 + tj) * 2 + s) * 64 + lane) * 8) = sf[0][s]; *(bf16x8*)(SF + item * 4096 + (((1 * 2 + tj) * 2 + s) * 64 + lane) * 8) = sf[1][s]; }
            f32x16 n0, n1;
#pragma unroll
            for (int g = 0; g < 4; ++g) { n0[4 * g] = gq[0][g][0]; n0[4 * g + 1] = gq[0][g][1]; n0[4 * g + 2] = gq[0][g][2]; n0[4 * g + 3] = gq[0][g][3]; n1[4 * g] = gq[1][g][0]; n1[4 * g + 1] = gq[1][g][1]; n1[4 * g + 2] = gq[1][g][2]; n1[4 * g + 3] = gq[1][g][3]; }
            bf16x8 mc[2][2][2];
#pragma unroll
            for (int kp = 0; kp < 2; ++kp)
#pragma unroll
                for (int kt = 0; kt < 2; ++kt)
#pragma unroll
                    for (int s = 0; s < 2; ++s) mc[kp][kt][s] = mf[kp][kt][s];
            if (c + 1 < RCK) RW2_LOAD(item + 1);
#pragma unroll
            for (int kp = 0; kp < 2; ++kp)
#pragma unroll
                for (int s = 0; s < 2; ++s) { n0 = MMA32(mc[kp][0][s], sf[kp][s], n0); n1 = MMA32(mc[kp][1][s], sf[kp][s], n1); }
            s0 = n0; s1 = n1;
        }
#undef RW2_LOAD
    }
}
DI void ph_rw3(const Ctx& C, int l, int mrows) {
    const int lane = C.lane, wg = C.wave & 3, grp = C.wave >> 2, ti = wg >> 1, tj = wg & 1, c32 = lane & 31, h = lane >> 5;
    LAS float* Ysum = (LAS float*)(C.lds + grp * RW_HALF);
    const bf16* QH = (const bf16*)(C.ws + WS_QH); const float* YL = (const float*)(C.ws + WS_YL); const bf16* SF = (const bf16*)(C.ws + WS_SF); bf16* OB = (bf16*)(C.ws + WS_OB);
    const int nblk = (TC + T) / 64, nitems = NB * NH * nblk;
    for (int it0 = 2 * C.bid; it0 < nitems; it0 += 2 * C.G) {
        const int item = it0 + grp; const bool live = item < nitems; const int itc = live ? item : nitems - 1;
        const int tb = itc % nblk, hd = (itc / nblk) % NH, b = itc / (nblk * NH);
        const int rowb = tb < TC / 64 ? M_LAT + b * TC + 64 * tb : b * T + 64 * (tb - TC / 64);
        __syncthreads();
        f32x4 yl[2][4]; u32x4 qa[2][4]; bf16x8 sb[2][4];
#pragma unroll
        for (int dir = 0; dir < 2; ++dir) {
            const int c = dir == 0 ? tb : (tb < TC / 64 ? TC / 64 - 1 - tb : TC / 64 + (T / 64 - 1 - (tb - TC / 64)));
            const size_t ci = ((size_t)((b * NH + hd) * 2 + dir)) * RCK + c;
#pragma unroll
            for (int g = 0; g < 4; ++g) yl[dir][g] = *(const f32x4*)(YL + ci * 4096 + ((wg * 4 + g) * 64 + lane) * 4);
#pragma unroll
            for (int kp = 0; kp < 2; ++kp)
#pragma unroll
                for (int s = 0; s < 2; ++s) { const bf16* qp = QH + ci * 4096 + (32 * ti + c32) * 64 + 32 * kp + 16 * s + 4 * h; const u32x2 lo = *(const u32x2*)qp, hi = *(const u32x2*)(qp + 8);
                    qa[dir][kp * 2 + s].x = lo.x; qa[dir][kp * 2 + s].y = lo.y; qa[dir][kp * 2 + s].z = hi.x; qa[dir][kp * 2 + s].w = hi.y;
                    sb[dir][kp * 2 + s] = *(const bf16x8*)(SF + ci * 4096 + (((kp * 2 + tj) * 2 + s) * 64 + lane) * 8); }
        }
#pragma unroll
        for (int dir = 0; dir < 2; ++dir) {
            f32x16 y;
#pragma unroll
            for (int g = 0; g < 4; ++g) { const f32x4 a = yl[dir][g]; y[4 * g] = a[0]; y[4 * g + 1] = a[1]; y[4 * g + 2] = a[2]; y[4 * g + 3] = a[3]; }
#pragma unroll
            for (int q4 = 0; q4 < 4; ++q4) y = MMA32(__builtin_bit_cast(bf16x8, qa[dir][q4]), sb[dir][q4], y);
#pragma unroll
            for (int r = 0; r < 16; ++r) { const int i = 32 * ti + (r & 3) + 8 * (r >> 2) + 4 * h, tk = dir ? 63 - i : i; LAS float* p = Ysum + tk * FP + 32 * tj + c32; if (dir == 0) *p = y[r]; else *p += y[r]; }
            __syncthreads();
        }
        if (live) {
            const int cch = hd * 64 + lane; const float rk = C.in[I_RWRK][((size_t)l * NH + hd) * 64 + lane], gw = C.in[I_RWGNW][(size_t)l * GW + cch], gb = C.in[I_RWGNB][(size_t)l * GW + cch];
#pragma unroll 1
            for (int t4 = 0; t4 < 16; t4 += 8) {
                bf16 rb[8], vb[8], kb[8], gb8[8];
#pragma unroll
                for (int u = 0; u < 8; ++u) { const bf16* rv = (const bf16*)(C.ws + WS_RVKG) + (size_t)item * 4 * 4096 + (16 * wg + t4 + u) * 64 + lane; rb[u] = rv[0]; vb[u] = rv[4096]; kb[u] = rv[8192]; gb8[u] = rv[12288]; }
#pragma unroll
                for (int u = 0; u < 8; ++u) { const int tk = 16 * wg + t4 + u, row = rowb + tk; const float r = bf2f(rb[u]), v = bf2f(vb[u]), ks = bf2f(kb[u]), gg = bf2f(gb8[u]);
                    float y = Ysum[tk * FP + lane] + wave_sum(r * ks * rk) * v;
                    const float mu = wave_sum(y) * (1.f / 64.f), dlt = y - mu, var = wave_sum(dlt * dlt) * (1.f / 64.f);
                    if (row < mrows) OB[(size_t)row * D + GW + cch] = (bf16)f2bf((dlt * __builtin_amdgcn_rsqf(var + RW_GN_EPS) * gw + gb) * gg); } }
        }
    }
    __syncthreads();
}
DI void ph_s5scan(const Ctx& C, int l, int first_block) {
    const int nthreads_total = NB * 2 * S5G * 64;
    if (C.bid < first_block) return;
    const float* XE = (const float*)(C.ws + WS_XEND); bf16* UG = (bf16*)(C.ws + WS_UG);
    const f32x2* LAM = (const f32x2*)(C.ws + WS_S5T + (size_t)l * SZ_S5L + OFF_S5LAM);
    for (int id = (C.bid - first_block) * NTHR + C.tid; id < nthreads_total; id += (C.G - first_block) * NTHR) {
        const int n = id & 63, g = (id >> 6) % S5G, dir = (id / (64 * S5G)) & 1, b = id / (128 * S5G);
        const f32x2 lm = LAM[(dir * S5G + g) * 64 + n]; float xr = 0.f, xi = 0.f;
        const int nc_ctx = TC / S5L, nc_lat = T / S5L, ntot = nc_ctx + nc_lat;
        for (int i0 = 0; i0 < ntot; i0 += 8) {
            float er[8], ei[8]; int chs[8];
#pragma unroll
            for (int u = 0; u < 8; ++u) { const int i = i0 + u; int ch;
                if (i < nc_ctx) ch = (M_LAT + b * TC) / S5L + (dir ? nc_ctx - 1 - i : i); else ch = (b * T) / S5L + (dir ? nc_lat - 1 - (i - nc_ctx) : (i - nc_ctx));
                chs[u] = ch; const float* p = XE + ((size_t)g * NCHP + ch) * 256 + dir * 128 + n; er[u] = p[0]; ei[u] = p[64]; }
#pragma unroll
            for (int u = 0; u < 8; ++u) { bf16* q = UG + ((size_t)g * NCHP + chs[u]) * S5K + 512 + dir * 128 + n; q[0] = (bf16)f2bf(xr); q[64] = (bf16)f2bf(xi);
                const float nr = lm[0] * xr - lm[1] * xi + er[u], ni = lm[0] * xi + lm[1] * xr + ei[u]; xr = nr; xi = ni; }
        }
    }
}

constexpr int PH_PRO = 3, PH_PER_L = 13, NPH = PH_PRO + PH_PER_L * NL;
#ifndef PROBE_REP
#define PROBE_REP -1
#endif
#define NREP(k) ((k) == PROBE_REP ? 2 : 1)
#ifdef ONLY
#define EN(k) ((k) == ONLY)
#else
#define EN(k) true
#endif
#ifdef EMU
void fwd(Args args) {
    unsigned char* lds = emu::lds_base();
#else
__global__ void __launch_bounds__(NTHR, 2) fwd(Args args) {
    extern __shared__ __attribute__((aligned(16))) unsigned char lds[];
#endif
    Ctx C; C.in = args.in; C.out = args.out; C.ws = args.ws; C.lds = (LAS unsigned char*)lds;
    C.tid = threadIdx.x; C.lane = C.tid & 63; C.wave = __builtin_amdgcn_readfirstlane(C.tid >> 6); C.G = gridDim.x; C.bid = blockIdx.x;
#define REFRESH() do { int t_ = threadIdx.x; OPAQUE(t_); C.tid = t_; C.lane = t_ & 63; C.wave = __builtin_amdgcn_readfirstlane(t_ >> 6); } while (0)
    volatile LAS unsigned* MISC = (volatile LAS unsigned*)(C.lds + MISC_OFF);
    if (C.tid < 32) MISC[C.tid] = 0u;
    __syncthreads();
    const int lo = args.ph_lo, hi = args.ph_hi;
    const bool use_bar = (hi - lo) > 1;
    XcdBarrier bar; bar.bar = (unsigned*)(C.ws + WS_CTL) + CW_BAR; bar.x = 0; bar.st = MISC + 8;
    if (use_bar) bar = xcd_barrier_post((unsigned*)(C.ws + WS_CTL) + CW_BAR, MISC + 8);
#define IN(k) (lo <= (k) && (k) < hi)
#define SEAM(k) do { if (IN(k) && IN((k) + 1)) xcd_barrier(bar); } while (0)
    if (EN(0) && IN(0)) for (int rep = 0; rep < NREP(0); ++rep) { REFRESH(); ph_ada(C); }
    SEAM(0);
    if (EN(1) && IN(1)) { REFRESH(); ph_conv(C); }
    SEAM(1);
    if (EN(2) && IN(2)) for (int rep = 0; rep < NREP(2); ++rep) { REFRESH(); ph_tab(C); }
    SEAM(2);
    for (int l = 0; l < NL; ++l) {
        const int pb = PH_PRO + PH_PER_L * l; const bool want_ctx = l < NL - 1;
        const int mrows_full = M, mrows_out = want_ctx ? M : M_LAT;
        bf16* AP = (bf16*)(C.ws + WS_AP); bf16* Hb = (bf16*)(C.ws + WS_H); bf16* OB = (bf16*)(C.ws + WS_OB);
        if (EN(3) && IN(pb + 0)) for (int rep = 0; rep < NREP(3); ++rep) { REFRESH();
            Gemm g{AP, wl(C, l, OFF_W1GU), D, D, D, 0, 0}; Order S; S.init(mrows_full / 256, 2 * FF / 256, 1, C.G, C.bid, D / 64);
            EpiGU E{rowss_ptr(C, l, 0), bias_ptr(C, l, 0), Hb, mrows_full}; gemm_phase(C.lds, g, S, E); }
        SEAM(pb + 0);
        if (EN(4) && IN(pb + 1)) { REFRESH();
            Gemm g{Hb, wl(C, l, OFF_W1D), FF, FF, FF, 0, 0}; Order S; S.init(M_LAT / 256, D / 256, 1, C.G, C.bid, FF / 64);
            EpiRes E{&C, gate_ptr(C, l, 0, 0), gs_ptr(C, l, 1, 0), rowss_ptr(C, l, 1), AP}; gemm_phase(C.lds, g, S, E);
            { REFRESH(); Order S2; S2.init_split(M_LAT / 256, M_CTX / 256, D / 256, 4, C.G, C.bid, FF / 64); EpiAcc E2{&C, gate_ptr(C, l, 0, 0)}; gemm_phase(C.lds, g, S2, E2); } }
        SEAM(pb + 1);
        if (EN(18) && IN(pb + 2)) { REFRESH(); ph_ctxfix(C, gs_ptr(C, l, 1, 0), rowss_ptr(C, l, 1)); }
        SEAM(pb + 2);
        if (EN(5) && IN(pb + 3)) for (int rep = 0; rep < NREP(5); ++rep) { REFRESH();
            Gemm g{AP, wl(C, l, OFF_WIN), D, D, D, 0, 0}; Order S; S.init(mrows_full / 256, NT_IN, 1, C.G, C.bid, D / 64);
            EpiIn E{&C, rowss_ptr(C, l, 1), bias_ptr(C, l, 1), l}; gemm_phase(C.lds, g, S, E); }
        SEAM(pb + 3);
        if (IN(pb + 4)) {
            if (EN(6)) for (int rep = 0; rep < NREP(6); ++rep) { REFRESH(); Gemm g{(const bf16*)(C.ws + WS_UG), (const bf16*)(C.ws + WS_S5T + (size_t)l * SZ_S5L + OFF_S5ET), S5K, 512, 512, (size_t)NCHP * S5K * 2, (size_t)256 * 512 * 2};
              Order S; S.init(NCHP / 256, 1, S5G, C.G, C.bid, 512 / 64); EpiS5A E{(float*)(C.ws + WS_XEND)}; gemm_phase(C.lds, g, S, E); }
            __syncthreads();
            for (int rep = 0; rep < NREP(9); ++rep) { if (EN(9)) { REFRESH(); ph_rw1(C, l); } }
            if (EN(7)) for (int rep = 0; rep < NREP(7); ++rep) { REFRESH(); ph_attn(C, l, want_ctx, (C.G >= 256 && 2 * C.G < RBLK && RBLK % (2 * C.G) != 0) ? (RBLK % (2 * C.G) + 1) / 2 : 0); }
        }
        SEAM(pb + 4);
        if (IN(pb + 5)) { if (EN(17)) for (int rep = 0; rep < NREP(17); ++rep) { REFRESH(); ph_rw2(C); } if (EN(10)) for (int rep = 0; rep < NREP(10); ++rep) { REFRESH(); ph_s5scan(C, l, C.G >= 256 ? 128 : 0); }
            if (EN(1) && l + 1 < NL) { REFRESH();
                if (C.G >= 256) { if (C.bid >= 64 && !(C.bid >= 128 && C.bid < 144)) { const int rk = C.bid - 64 - (C.bid >= 144 ? 16 : 0); conv_weights(C, l + 1, rk * NW + C.wave, (C.G - 80) * NW); } }
                else conv_weights(C, l + 1, C.bid * NW + C.wave, C.G * NW); } }
        SEAM(pb + 5);
        if (IN(pb + 6)) {
            if (EN(11)) for (int rep = 0; rep < NREP(11); ++rep) { REFRESH(); Gemm g{(const bf16*)(C.ws + WS_UG), (const bf16*)(C.ws + WS_S5T + (size_t)l * SZ_S5L + OFF_S5BT), S5K, S5K, S5K, (size_t)NCHP * S5K * 2, (size_t)512 * S5K * 2};
              Order S; S.init(NCHP / 256, 2, S5G, C.G, C.bid, S5K / 64); EpiS5C E{(const bf16*)(C.ws + WS_UG), C.in[I_S5D] + (size_t)l * GW, (bf16*)(C.ws + WS_YG)}; gemm_phase(C.lds, g, S, E); }
            if (EN(12)) for (int rep = 0; rep < NREP(12); ++rep) { REFRESH(); ph_rw3(C, l, mrows_out); }
        }
        SEAM(pb + 6);
        if (EN(13) && IN(pb + 7)) for (int rep = 0; rep < NREP(13); ++rep) { REFRESH();
            Gemm g{(const bf16*)(C.ws + WS_YG), wl(C, l, OFF_WGLU), GW, GW, GW, 0, 0}; Order S; S.init(mrows_out / 256, GW / 256, 1, C.G, C.bid, GW / 64);
            EpiGLU E{(const bf16*)(C.ws + WS_YG), C.in[I_S5GLUB] + (size_t)l * GW, OB}; gemm_phase(C.lds, g, S, E); }
        SEAM(pb + 7);
        if (EN(14) && IN(pb + 8)) { REFRESH();
            Gemm g{OB, wl(C, l, OFF_WOUT), D, D, D, 0, 0}; Order S; S.init(M_LAT / 256, D / 256, 1, C.G, C.bid, D / 64);
            EpiRes E{&C, gate_ptr(C, l, 1, 0), gs_ptr(C, l, 2, 0), rowss_ptr(C, l, 2), AP}; gemm_phase(C.lds, g, S, E);
            if (want_ctx) { REFRESH(); Order S2; S2.init_split(M_LAT / 256, M_CTX / 256, D / 256, 4, C.G, C.bid, D / 64); EpiAcc E2{&C, gate_ptr(C, l, 1, 0)}; gemm_phase(C.lds, g, S2, E2); } }
        SEAM(pb + 8);
        if (EN(18) && IN(pb + 9) && want_ctx) { REFRESH(); ph_ctxfix(C, gs_ptr(C, l, 2, 0), rowss_ptr(C, l, 2)); }
        SEAM(pb + 9);
        if (EN(15) && IN(pb + 10)) { REFRESH();
            Gemm g{AP, wl(C, l, OFF_W2GU), D, D, D, 0, 0}; Order S; S.init(mrows_out / 256, 2 * FF / 256, 1, C.G, C.bid, D / 64);
            EpiGU E{rowss_ptr(C, l, 2), bias_ptr(C, l, 2), Hb, mrows_out}; gemm_phase(C.lds, g, S, E); }
        SEAM(pb + 10);
        if (EN(16) && IN(pb + 11)) { REFRESH();
            Gemm g{Hb, wl(C, l, OFF_W2D), FF, FF, FF, 0, 0}; Order S; S.init(M_LAT / 256, D / 256, 1, C.G, C.bid, FF / 64);
            const bool more = l + 1 < NL;
            EpiRes E{&C, gate_ptr(C, l, 2, 0), more ? gs_ptr(C, l + 1, 0, 0) : nullptr, more ? rowss_ptr(C, l + 1, 0) : nullptr, AP}; gemm_phase(C.lds, g, S, E);
            if (want_ctx) { REFRESH(); Order S2; S2.init_split(M_LAT / 256, M_CTX / 256, D / 256, 4, C.G, C.bid, FF / 64); EpiAcc E2{&C, gate_ptr(C, l, 2, 0)}; gemm_phase(C.lds, g, S2, E2); } }
        SEAM(pb + 11);
        if (EN(18) && IN(pb + 12) && want_ctx) { REFRESH(); ph_ctxfix(C, gs_ptr(C, l + 1, 0, 0), rowss_ptr(C, l + 1, 0)); }
        SEAM(pb + 12);
    }
#undef IN
#undef SEAM
}

#ifndef MK_PER_PHASE
#define MK_PER_PHASE 0
#endif
#ifdef EMU
int g_emu_grid = 4, g_emu_lo = 0, g_emu_hi = NPH;
#endif
extern "C" void kernel_launch(void* const* d_in, const int* in_sizes, int n_in, void* d_out, int out_size, void* d_ws, size_t ws_size, hipStream_t stream) {
    Args a{};
    for (int i = 0; i < 42; ++i) a.in[i] = (const float*)d_in[i];
    a.out = (float*)d_out; a.ws = (unsigned char*)d_ws;
#ifdef EMU
    if (g_emu_lo == 0) hipMemsetAsync(d_ws, 0, WS_ZERO_END, stream);
    for (int ph = g_emu_lo; ph < g_emu_hi; ++ph) { a.ph_lo = ph; a.ph_hi = ph + 1; fprintf(stderr, "phase %d\n", ph); emu::launch(g_emu_grid, NTHR, LDS_BYTES, [=] { fwd(a); }); }
#else
    static int grid = 0;
    if (grid == 0) {
        if (n_in != 42 || out_size != M_LAT * D || ws_size < WS_END) { fprintf(stderr, "kernel_launch: unexpected shapes (n_in %d out %d ws %zu need %zu)\n", n_in, out_size, ws_size, (size_t)WS_END); grid = -1; return; }
        int dev = 0, cus = 0;
        if (hipGetDevice(&dev) != hipSuccess || hipDeviceGetAttribute(&cus, hipDeviceAttributeMultiprocessorCount, dev) != hipSuccess) { grid = -1; return; }
        if (hipFuncSetAttribute((const void*)fwd, hipFuncAttributeMaxDynamicSharedMemorySize, LDS_BYTES) != hipSuccess) { fprintf(stderr, "kernel_launch: hipFuncSetAttribute failed\n"); grid = -1; return; }
        int per_cu = 0; (void)hipOccupancyMaxActiveBlocksPerMultiprocessor(&per_cu, (const void*)fwd, NTHR, LDS_BYTES); (void)hipGetLastError();
        if (per_cu < 1) fprintf(stderr, "kernel_launch: occupancy query reports %d\n", per_cu);
        grid = cus;
    }
    if (grid < 0) return;
    (void)hipMemsetAsync(d_ws, 0, WS_ZERO_END, stream);
#if MK_PER_PHASE
    for (int ph = 0; ph < NPH; ++ph) { a.ph_lo = ph; a.ph_hi = ph + 1; hipLaunchKernelGGL(fwd, dim3(grid), dim3(NTHR), LDS_BYTES, stream, a); }
#else
    a.ph_lo = 0; a.ph_hi = NPH;
    hipLaunchKernelGGL(fwd, dim3(grid), dim3(NTHR), LDS_BYTES, stream, a);
#endif
#endif
}
```

```cpp
#ifdef EMU
#include "emu/emu.h"
#define LAS
#define GAS
#define ASMV(...) ((void)0)
#define WSYNC() do { int _z = 0; (void)emu::wave_gather(&_z, 4); } while (0)
#define OPAQUE(x) ((void)0)
#define OPAQUE_S(x) ((void)0)
#define PIN(x) ((void)0)
#define PIN4(a, b, c, d) ((void)0)
#define OPAQUE_LDS(p) (p)
#else
#include <hip/hip_runtime.h>
#include <cstdio>
#include <cstdint>
#define LAS __attribute__((address_space(3)))
#define GAS __attribute__((address_space(1)))
#define ASMV(...) asm volatile(__VA_ARGS__)
#define PIN(x) asm volatile("" : "+v"(x) :: "memory")
#define PIN4(a, b, c, d) asm volatile("" : "+v"(a), "+v"(b), "+v"(c), "+v"(d) :: "memory")
template <class P> __device__ __forceinline__ P opaque_lds(P p) { unsigned a = (unsigned)(size_t)p; asm volatile("" : "+v"(a)); return (P)(size_t)a; }
#define OPAQUE_LDS(p) opaque_lds(p)
#define OPAQUE_S(x) asm volatile("" : "+s"(x))
#define OPAQUE(x) asm volatile("" : "+v"(x))
#define WSYNC() asm volatile("s_waitcnt lgkmcnt(0)" ::: "memory")
#endif

#ifdef EMU
constexpr int D = 1024, NB = 2, T = 1024, NL = 2, TC = 256, FF = 1024;
#else
constexpr int D = 2048, NB = 2, T = 8192, NL = 4, TC = 256, FF = 5632;
#endif
constexpr int GW = D / 4, NH = GW / 64, WAG = NH / 2, S5G = GW / 16, GRW = 64, GRH = T / GRW;
constexpr int M_LAT = NB * T, M_CTX = NB * TC, M = M_LAT + M_CTX, NPAN = M / 256;
constexpr int TP = GW / 256;
constexpr int NT_IN = 8 * TP + 2, NINP = NT_IN * 256, D_IN = 8 * GW + 416;
constexpr int PN_AQ = 0, PN_AK = TP, PN_AV = 2 * TP, PN_BR = 3 * TP, PN_BK = 4 * TP, PN_BV = 5 * TP, PN_BS = 6 * TP, PN_CQ = 6 * TP + 1, PN_CKV = 7 * TP + 1, PN_DU = 7 * TP + 2;
constexpr int SRC_AQ = 0, SRC_AK = GW, SRC_AV = 2 * GW, SRC_BR = 3 * GW, SRC_BK = 4 * GW, SRC_BV = 5 * GW, SRC_BS = 6 * GW, SRC_CQ = 6 * GW + 160, SRC_CK = 7 * GW + 160, SRC_CV = 7 * GW + 288, SRC_DU = 7 * GW + 416;
constexpr int S5L = 32, NCH = M / S5L, NCHP = ((NCH + 255) / 256) * 256, S5K = 768;
constexpr int NW = 8, NTHR = 512;
constexpr float NORM_EPS = 1e-6f, RW_GN_EPS = 64e-5f;

typedef unsigned short bf16;
typedef short bf16x8 __attribute__((ext_vector_type(8)));
typedef short s16x4 __attribute__((ext_vector_type(4)));
typedef float f32x4 __attribute__((ext_vector_type(4)));
typedef float f32x2 __attribute__((ext_vector_type(2)));
typedef float f32x16 __attribute__((ext_vector_type(16)));
typedef unsigned u32x4 __attribute__((ext_vector_type(4)));
typedef unsigned u32x2 __attribute__((ext_vector_type(2)));
#define DI __device__ __forceinline__

constexpr size_t al256(size_t x) { return (x + 255) & ~(size_t)255; }
constexpr size_t SZ_BIAS_GU = (size_t)3 * 2 * FF * 4, SZ_BIAS_IN = (size_t)3 * NINP * 4;
constexpr size_t WS_CTL = 0;
constexpr size_t WS_BIAS = 65536;
constexpr size_t SZ_BIAS_L = 2 * SZ_BIAS_GU + SZ_BIAS_IN;
constexpr size_t WS_ROWSS = al256(WS_BIAS + NL * SZ_BIAS_L);
constexpr size_t WS_ZERO_END = al256(WS_ROWSS + (size_t)NL * 3 * M * 4);
constexpr size_t WS_MODV = WS_ZERO_END;
constexpr size_t WS_GS = al256(WS_MODV + (size_t)NL * 3 * 9 * D * 4);
constexpr size_t WS_GATE = al256(WS_GS + (size_t)NL * 9 * D * 4);
constexpr size_t WS_ROPE = al256(WS_GATE + (size_t)NL * 9 * D * 4);
constexpr size_t SZ_WGU = (size_t)2 * FF * D * 2, SZ_WD = (size_t)D * FF * 2, SZ_WIN = (size_t)NINP * D * 2, SZ_WOUT = (size_t)D * D * 2, SZ_WGLU = (size_t)GW * GW * 2;
constexpr size_t OFF_W1GU = 0, OFF_W1D = OFF_W1GU + SZ_WGU, OFF_WIN = OFF_W1D + SZ_WD, OFF_WOUT = OFF_WIN + SZ_WIN, OFF_W2GU = OFF_WOUT + SZ_WOUT, OFF_W2D = OFF_W2GU + SZ_WGU, OFF_WGLU = OFF_W2D + SZ_WD, SZ_WL = OFF_WGLU + SZ_WGLU;
constexpr size_t WS_W = al256(WS_ROPE + 128 * 16 * 8);
constexpr size_t SZ_S5KC = (size_t)S5G * 2 * S5L * 256 * 4, SZ_S5ET = (size_t)S5G * 256 * 512 * 2, SZ_S5BT = (size_t)S5G * 512 * S5K * 2, SZ_S5LAM = (size_t)2 * GW * 4 * 8;
constexpr size_t SZ_S5LP = (size_t)2 * S5G * 64 * (S5L + 1) * 8, SZ_S5BETA = (size_t)2 * S5G * 64 * 16 * 8;
constexpr size_t OFF_S5KC = 0, OFF_S5ET = OFF_S5KC + SZ_S5KC, OFF_S5BT = OFF_S5ET + SZ_S5ET, OFF_S5LAM = OFF_S5BT + SZ_S5BT, OFF_S5LP = al256(OFF_S5LAM + SZ_S5LAM), OFF_S5BETA = OFF_S5LP + SZ_S5LP, SZ_S5L = al256(OFF_S5BETA + SZ_S5BETA);
constexpr size_t WS_S5T = al256(WS_W + NL * SZ_WL);
constexpr size_t WS_XC = al256(WS_S5T + NL * SZ_S5L);
constexpr size_t WS_AP = al256(WS_XC + (size_t)M_CTX * D * 4);
constexpr size_t WS_H = al256(WS_AP + (size_t)M * D * 2);
constexpr size_t WS_QA = al256(WS_H + (size_t)M * FF * 2);
constexpr size_t WS_KA = WS_QA + (size_t)M * GW * 2, WS_VA = WS_KA + (size_t)M * GW * 2, WS_QC = WS_VA + (size_t)M * GW * 2;
constexpr size_t WS_KC = WS_QC + (size_t)M * GW * 2, WS_VC = WS_KC + (size_t)M * 128 * 2;
constexpr size_t WS_PB = WS_VC + (size_t)M * 128 * 2;
constexpr size_t WS_PS = al256(WS_PB + (size_t)M * 3 * GW * 2);
constexpr size_t WS_UG = al256(WS_PS + (size_t)M * 160 * 4);
constexpr size_t WS_RW = al256(WS_UG + (size_t)S5G * NCHP * S5K * 2);
constexpr size_t SZ_RWA = (size_t)M * GW * 4;
enum { RW_R = 0, RW_V, RW_NKK, RW_G, RW_W0, RW_W1, RW_K0, RW_K1, RW_B0, RW_B1, RW_Y0, RW_Y1, RW_NARR };
constexpr size_t WS_XEND = al256(WS_RW + 256);
constexpr size_t WS_YG = al256(WS_XEND + (size_t)S5G * NCHP * 256 * 4);
constexpr size_t WS_OB = al256(WS_YG + (size_t)M * GW * 2);
constexpr int RCK = (TC + T) / 64, RSTR = NB * NH * 2, RITEM = RSTR * RCK;
constexpr size_t WS_QH = al256(WS_OB + (size_t)M * D * 2);
constexpr size_t WS_YL = al256(WS_QH + (size_t)RITEM * 8192);
constexpr size_t WS_MF = al256(WS_YL + (size_t)RITEM * 16384);
constexpr size_t WS_GF = al256(WS_MF + (size_t)RITEM * 8192);
constexpr size_t WS_SF = al256(WS_GF + (size_t)RITEM * 16384);
constexpr int RBLK = NB * NH * ((TC + T) / 64);
constexpr size_t WS_RVKG = al256(WS_SF + (size_t)RITEM * 8192);
constexpr size_t SZ_RWF = (size_t)14 * NH * 2 * 64 * 16;
constexpr size_t WS_RWF = al256(WS_RVKG + (size_t)RBLK * 32768);
constexpr size_t WS_RWS = al256(WS_RWF + NL * SZ_RWF);
constexpr size_t WS_END = al256(WS_RWS + (size_t)512 * 2 * 65536);
constexpr int CW_BAR = 1024;

constexpr int LDS_BYTES = 147456, RING_BYTES = 131072, MISC_OFF = LDS_BYTES - 256;

DI unsigned f2bf(float f) { unsigned u = __float_as_uint(f); return (u + 0x7fffu + ((u >> 16) & 1u)) >> 16; }
#ifdef EMU
DI unsigned pk2(float lo, float hi) { return f2bf(lo) | (f2bf(hi) << 16); }
#else
typedef __bf16 hbf16x2 __attribute__((ext_vector_type(2)));
DI unsigned pk2(float lo, float hi) { const f32x2 v = {lo, hi}; const hbf16x2 b = __builtin_convertvector(v, hbf16x2); return __builtin_bit_cast(unsigned, b); }
#endif
DI float bf2f(unsigned short b) { return __uint_as_float(((unsigned)b) << 16); }
DI float bflo(unsigned w) { return __uint_as_float(w << 16); }
DI float bfhi(unsigned w) { return __uint_as_float(w & 0xffff0000u); }
template <int N> DI float ror_add(float v) { return v + __int_as_float(__builtin_amdgcn_mov_dpp(__float_as_int(v), 0x120 + N, 0xf, 0xf, true)); }
DI float row16_sum(float v) { v = ror_add<8>(v); v = ror_add<4>(v); v = ror_add<2>(v); v = ror_add<1>(v); return v; }
DI float wave_sum(float v) {
    v = row16_sum(v);
    const float a = __int_as_float(__builtin_amdgcn_readlane(__float_as_int(v), 0)), b = __int_as_float(__builtin_amdgcn_readlane(__float_as_int(v), 16)),
                c = __int_as_float(__builtin_amdgcn_readlane(__float_as_int(v), 32)), d = __int_as_float(__builtin_amdgcn_readlane(__float_as_int(v), 48));
    return (a + b) + (c + d);
}
DI float siluf(float x) { return x * __builtin_amdgcn_rcpf(1.f + __expf(-x)); }
DI float fast_tanh(float x) { const float e = __expf(2.f * x); return 1.f - 2.f * __builtin_amdgcn_rcpf(e + 1.f); }
DI float sigmf(float x) { return __builtin_amdgcn_rcpf(1.f + __expf(-x)); }
DI float geluf(float x) { const float z = 0.7978845608028654f * (x + 0.044715f * x * x * x); const float e = __expf(2.f * z); return 0.5f * x * (1.f + (1.f - 2.f * __builtin_amdgcn_rcpf(e + 1.f))); }
DI int stream_of_row(int row) { return row < M_LAT ? row / T : NB; }
DI int stream_of_panel(int pm) { return stream_of_row(pm * 256); }

#define XB_TMO      128
#define XB_XCNT(j)  (256  + 64 * (j))
#define XB_XSUB(j)  (1280 + 64 * (j))
#define XB_XGEN(j)  (2304 + 64 * (j))
#define XB_TOP      3328
#define XB_TOPGEN   3392
#define XCD_BAR_WORDS 3456
#define XB_SPIN_CAP (1u << 18)
DI unsigned xb_ld(unsigned* p)              { return __hip_atomic_load(p, __ATOMIC_RELAXED, __HIP_MEMORY_SCOPE_AGENT); }
DI unsigned xb_add(unsigned* p, unsigned v) { return __hip_atomic_fetch_add(p, v, __ATOMIC_RELAXED, __HIP_MEMORY_SCOPE_AGENT); }
DI unsigned xb_xcc_id() { return (unsigned)__builtin_amdgcn_s_getreg((3 << 11) | 20) & 0xFu; }
#define XB_SPIN(cond, bar) do { unsigned _sp = 0; while (cond) { __builtin_amdgcn_s_sleep(1); \
    if ((++_sp & 255u) == 0u) { if (xb_ld(&(bar)[XB_TMO])) break; if (_sp > XB_SPIN_CAP) { atomicAdd(&(bar)[XB_TMO], 1u); break; } } } } while (0)
struct XcdBarrier { unsigned* bar; unsigned x; volatile LAS unsigned* st; };
DI XcdBarrier xcd_barrier_post(unsigned* bar, volatile LAS unsigned* st) {
    XcdBarrier b; b.bar = bar; b.x = xb_xcc_id(); b.st = st;
    if (threadIdx.x == 0) (void)xb_add(&bar[XB_XCNT(b.x)], 1u);
    return b;
}
DI void xcd_barrier_complete(unsigned* bar, unsigned x, unsigned& nloc, unsigned& nx) {
    const unsigned G = gridDim.x * gridDim.y * gridDim.z;
    unsigned sum, cnt, mine, sp = 0u;
    for (;;) {
        sum = 0u; cnt = 0u; mine = 0u;
#pragma unroll
        for (unsigned j = 0; j < 16; ++j) { const unsigned c = xb_ld(&bar[XB_XCNT(j)]); sum += c; cnt += (c > 0u) ? 1u : 0u; mine = (j == x) ? c : mine; }
        if (sum == G) break;
        __builtin_amdgcn_s_sleep(1);
        if ((++sp & 255u) == 0u) { if (xb_ld(&bar[XB_TMO])) break; if (sp > XB_SPIN_CAP) { atomicAdd(&bar[XB_TMO], 1u); break; } }
    }
    nloc = mine > 0u ? mine : 1u; nx = cnt > 0u ? cnt : 1u;
}
DI void xcd_barrier(const XcdBarrier& b) {
    ASMV("s_waitcnt vmcnt(0)" ::: "memory");
    __syncthreads();
    if (threadIdx.x == 0) {
        unsigned* bar = b.bar;
        __builtin_amdgcn_s_waitcnt(0);
        unsigned nloc = b.st[0], nx = b.st[1];
        if (nloc == 0u) { xcd_barrier_complete(bar, b.x, nloc, nx); b.st[0] = nloc; b.st[1] = nx; }
        const unsigned old = xb_add(&bar[XB_XSUB(b.x)], 1u);
        const unsigned gen = old / nloc;
        if (old + 1u == (gen + 1u) * nloc) {
            __builtin_amdgcn_fence(__ATOMIC_RELEASE, "agent");
            ASMV("s_waitcnt vmcnt(0)" ::: "memory");
            const unsigned og = xb_add(&bar[XB_TOP], 1u);
            const unsigned tg = og / nx;
            if (og + 1u == (tg + 1u) * nx) xb_add(&bar[XB_TOPGEN], 1u);
            else XB_SPIN(xb_ld(&bar[XB_TOPGEN]) == tg, bar);
            __builtin_amdgcn_fence(__ATOMIC_ACQUIRE, "agent");
            xb_add(&bar[XB_XGEN(b.x)], 1u);
            ASMV("s_waitcnt vmcnt(0)" ::: "memory");
        } else {
            XB_SPIN(xb_ld(&bar[XB_XGEN(b.x)]) == gen, bar);
            __builtin_amdgcn_fence(__ATOMIC_ACQUIRE, "agent");
            ASMV("s_waitcnt vmcnt(0)" ::: "memory");
        }
    }
    __syncthreads();
}

constexpr int BK = 64, HALF = 128, HTB = HALF * BK * 2, NXCD = 8, WGM = 4;
DI int lds_byte(int r, int c) { const int st = (r >> 4) * 2 + (c >> 5), rr = r & 15, cc = c & 31, ob = rr * 64 + cc * 2; return st * 1024 + (ob ^ (((ob >> 9) & 1) << 5)); }
DI void stage_rc(int b, int& R, int& C) { const int st = b / 1024, sb = b % 1024, swz = sb ^ (((sb >> 9) & 1) << 5); R = (st >> 1) * 16 + swz / 64; C = (st & 1) * 32 + (swz % 64) / 2; }
struct Unit { int pm, pn, z, kt0; };
struct Gemm { const bf16* A; const bf16* Bt; int lda, ldb, K; size_t zA, zB; };
struct Order {
    int nM, nN, nZ, per, total, G, c, nkt, pm0, spl;
    DI void init(int nM_, int nN_, int nZ_, int G_, int c_, int nkt_) { nM = nM_; nN = nN_; nZ = nZ_; per = nM * nN; total = per * nZ; G = G_; c = c_; nkt = nkt_; pm0 = 0; spl = 0; }
    DI void init_split(int pm0_, int xM, int nN_, int spl_, int G_, int c_, int nkt_full) { nM = xM; nN = nN_; nZ = 1; per = xM * nN_ * spl_; total = per; G = G_; c = c_; nkt = nkt_full / spl_; pm0 = pm0_; spl = spl_; }
    DI bool next(int i, Unit& u) const {
        const long L = (long)i * G + c; if (L >= total) return false;
        if (spl) { const int j = (int)L; u.z = 0; u.pm = pm0 + j / (nN * spl); const int rem = j % (nN * spl); u.pn = rem / spl; u.kt0 = (rem % spl) * nkt; return true; }
        u.kt0 = 0;
        u.z = (int)(L / per); int wgid = (int)(L % per);
        { const int q = per / NXCD, r = per % NXCD, xcd = wgid % NXCD, off = wgid / NXCD; wgid = (xcd < r ? xcd * (q + 1) : r * (q + 1) + (xcd - r) * q) + off; }
        const int nig = WGM * nN, gid = wgid / nig, fm = gid * WGM, gsz = (nM - fm) < WGM ? (nM - fm) : WGM;
        u.pm = fm + ((wgid % nig) % gsz); u.pn = (wgid % nig) / gsz; return true;
    }
};

template <class Epi>
DI void gemm_phase(LAS unsigned char* lds, const Gemm g, const Order& S, const Epi& E) {
    int tid_ = threadIdx.x; OPAQUE(tid_);
    const int tid = tid_, wid = __builtin_amdgcn_readfirstlane(tid >> 6), lane = tid & 63, wr = wid >> 2, wc = wid & 3, fr = lane & 15, fq = lane >> 4;
    Unit cur, nxt; int ui = 0;
    if (!S.next(0, cur)) return;
    f32x4 acc[2][2][4][2];
#ifdef EMU
    (void)lds;
    for (;; ++ui) {
        if (ui > 0) { if (!S.next(ui, cur)) break; }
        const bf16* A = (const bf16*)((const char*)g.A + cur.z * g.zA); const bf16* B = (const bf16*)((const char*)g.Bt + cur.z * g.zB);
        for (int ai = 0; ai < 2; ++ai) for (int bj = 0; bj < 2; ++bj) for (int m = 0; m < 4; ++m) for (int n = 0; n < 2; ++n) for (int j = 0; j < 4; ++j) {
            const int r = 256 * cur.pm + 128 * ai + 64 * wr + 16 * m + fr, c = 256 * cur.pn + 128 * bj + 32 * wc + 16 * n + 4 * fq + j;
            const bf16* a = A + (size_t)r * g.lda; const bf16* b = B + (size_t)c * g.ldb; float s = 0.f;
            for (int k = cur.kt0 * BK; k < (cur.kt0 + S.nkt) * BK; ++k) s += bf2f(a[k]) * bf2f(b[k]);
            acc[ai][bj][m][n][j] = s; }
        E(acc, cur, wr, wc, fr, fq);
    }
#else
    unsigned voffA[2], voffB[2];
#pragma unroll
    for (int i = 0; i < 2; ++i) { int R, C; stage_rc(tid * 16 + i * 8192, R, C); voffA[i] = (unsigned)(R * g.lda + C) * 2u; voffB[i] = (unsigned)(R * g.ldb + C) * 2u; }
    const size_t kstep = (size_t)(BK * 2);
    const size_t hstepA = (size_t)HALF * g.lda * 2, hstepB = (size_t)HALF * g.ldb * 2, tstepA = 2 * hstepA, tstepB = 2 * hstepB;
    const unsigned ldsw = (unsigned)wid * 1024u;
    const int aoff = lds_byte(wr * 64 + fr, fq * 8), boff = lds_byte(wc * 32 + fr, fq * 8);
#define PG8_SA(b, h) (((b) * 2 + (h)) * HTB)
#define PG8_SB(b, h) ((4 + (b) * 2 + (h)) * HTB)
#define PG8_STAGE(bufoff, gbase, voff) do { _Pragma("unroll") for (int _i = 0; _i < 2; ++_i) \
        __builtin_amdgcn_global_load_lds((const unsigned*)((const char*)(gbase) + (voff)[_i]), (LAS unsigned*)(lds + (bufoff) + ldsw + _i * 8192), 16, 0, 0); } while (0)
#define PG8_LDA(dst, b, h) do { _Pragma("unroll") for (int m = 0; m < 4; ++m) _Pragma("unroll") for (int k = 0; k < 2; ++k) dst[m][k] = *(const LAS bf16x8*)(lds + PG8_SA(b, h) + aoff + m * 2048 + k * 1024); } while (0)
#define PG8_LDB(dst, b, h) do { _Pragma("unroll") for (int n = 0; n < 2; ++n) _Pragma("unroll") for (int k = 0; k < 2; ++k) dst[n][k] = *(const LAS bf16x8*)(lds + PG8_SB(b, h) + boff + n * 2048 + k * 1024); } while (0)
#define PG8_MMA(ai, bj, At, Bt) do { __builtin_amdgcn_s_setprio(1); _Pragma("unroll") for (int m = 0; m < 4; ++m) _Pragma("unroll") for (int n = 0; n < 2; ++n) _Pragma("unroll") for (int k = 0; k < 2; ++k) \
        acc[ai][bj][m][n] = __builtin_amdgcn_mfma_f32_16x16x32_bf16(Bt[n][k], At[m][k], acc[ai][bj][m][n], 0, 0, 0); __builtin_amdgcn_s_setprio(0); } while (0)
#define PG8_WAIT_V(n) asm volatile("s_waitcnt vmcnt(" #n ")" ::: "memory")
#define PG8_WAIT_L(n) asm volatile("s_waitcnt lgkmcnt(" #n ")" ::: "memory")
#define PG8_BAR __builtin_amdgcn_s_barrier()
#define PG8_SCHED __builtin_amdgcn_sched_barrier(0)
#pragma unroll
    for (int a = 0; a < 2; ++a)
#pragma unroll
        for (int b = 0; b < 2; ++b)
#pragma unroll
            for (int m = 0; m < 4; ++m)
#pragma unroll
                for (int n = 0; n < 2; ++n) acc[a][b][m][n] = (f32x4){0.f, 0.f, 0.f, 0.f};
    bf16x8 At[4][2], B0[2][2], B1[2][2];
    const char* cA = (const char*)g.A + (size_t)cur.z * g.zA + (size_t)cur.pm * tstepA + (size_t)cur.kt0 * kstep; const char* cB = (const char*)g.Bt + (size_t)cur.z * g.zB + (size_t)cur.pn * tstepB + (size_t)cur.kt0 * kstep;
    PG8_STAGE(PG8_SB(0, 0), cB, voffB); PG8_STAGE(PG8_SB(0, 1), cB + hstepB, voffB); PG8_STAGE(PG8_SA(0, 0), cA, voffA); PG8_STAGE(PG8_SA(0, 1), cA + hstepA, voffA);
    if (wr == 1) PG8_BAR;
    PG8_WAIT_V(2); PG8_BAR;
    PG8_STAGE(PG8_SB(1, 0), cB + kstep, voffB); PG8_STAGE(PG8_SA(1, 0), cA + kstep, voffA); PG8_STAGE(PG8_SB(1, 1), cB + hstepB + kstep, voffB);
    PG8_WAIT_V(6); PG8_BAR;
    for (;;) {
        const bool has_next = S.next(ui + 1, nxt);
        const char* nA = has_next ? (const char*)g.A + (size_t)nxt.z * g.zA + (size_t)nxt.pm * tstepA + (size_t)nxt.kt0 * kstep : cA; const char* nB = has_next ? (const char*)g.Bt + (size_t)nxt.z * g.zB + (size_t)nxt.pn * tstepB + (size_t)nxt.kt0 * kstep : cB;
        const int nt = S.nkt;
        for (int t = 0; t < nt; t += 2) {
            const bool last = (t == nt - 2);
            const char* a1 = cA + (size_t)(t + 1) * kstep;
            const char* a2 = last ? nA : cA + (size_t)(t + 2) * kstep; const char* b2 = last ? nB : cB + (size_t)(t + 2) * kstep;
            const char* a3 = a2 + kstep; const char* b3 = b2 + kstep;
            PG8_LDB(B0, 0, 0); PG8_LDB(B1, 0, 1); PG8_SCHED; PG8_LDA(At, 0, 0); PG8_STAGE(PG8_SA(1, 1), a1 + hstepA, voffA);
            PG8_WAIT_V(8); PG8_WAIT_L(0); PG8_BAR; PG8_MMA(0, 0, At, B0); PG8_MMA(0, 1, At, B1); PG8_BAR; PG8_SCHED;
            PG8_LDA(At, 0, 1); PG8_STAGE(PG8_SB(0, 0), b2, voffB); PG8_STAGE(PG8_SB(0, 1), b2 + hstepB, voffB); PG8_STAGE(PG8_SA(0, 0), a2, voffA);
            PG8_WAIT_V(8); PG8_WAIT_L(0); PG8_BAR; PG8_MMA(1, 0, At, B0); PG8_MMA(1, 1, At, B1); PG8_BAR; PG8_SCHED;
            PG8_LDB(B0, 1, 0); PG8_LDB(B1, 1, 1); PG8_SCHED; PG8_LDA(At, 1, 0); PG8_STAGE(PG8_SA(0, 1), a2 + hstepA, voffA);
            PG8_WAIT_V(8); PG8_WAIT_L(0); PG8_BAR; PG8_MMA(0, 0, At, B0); PG8_MMA(0, 1, At, B1); PG8_BAR; PG8_SCHED;
            PG8_LDA(At, 1, 1); PG8_STAGE(PG8_SB(1, 0), b3, voffB); PG8_STAGE(PG8_SB(1, 1), b3 + hstepB, voffB); PG8_STAGE(PG8_SA(1, 0), a3, voffA);
            PG8_WAIT_V(8); PG8_WAIT_L(0); PG8_BAR; PG8_MMA(1, 0, At, B0); PG8_MMA(1, 1, At, B1); PG8_BAR; PG8_SCHED;
        }
        if (wr == 0) PG8_BAR;
        E(acc, cur, wr, wc, fr, fq);
        if (!has_next) break;
#pragma unroll
        for (int a = 0; a < 2; ++a)
#pragma unroll
            for (int b = 0; b < 2; ++b)
#pragma unroll
                for (int m = 0; m < 4; ++m)
#pragma unroll
                    for (int n = 0; n < 2; ++n) acc[a][b][m][n] = (f32x4){0.f, 0.f, 0.f, 0.f};
        cur = nxt; cA = nA; cB = nB; ++ui;
        if (wr == 1) PG8_BAR;
    }
    PG8_WAIT_V(0);
    PG8_BAR;
#undef PG8_SA
#undef PG8_SB
#undef PG8_STAGE
#undef PG8_LDA
#undef PG8_LDB
#undef PG8_MMA
#undef PG8_WAIT_V
#undef PG8_WAIT_L
#undef PG8_BAR
#undef PG8_SCHED
#endif
}

struct Args {
    const float* in[42]; float* out; unsigned char* ws;
    int ph_lo, ph_hi;
};
struct Ctx {
    const float* const* in; float* out; unsigned char* ws;
    LAS unsigned char* lds; int tid, lane, wave, G, bid;
};
DI float* xrow_ptr(const Ctx& C, int row) { return row < M_LAT ? C.out + (size_t)row * D : (float*)(C.ws + WS_XC) + (size_t)(row - M_LAT) * D; }
DI const bf16* wl(const Ctx& C, int l, size_t off) { return (const bf16*)(C.ws + WS_W + (size_t)l * SZ_WL + off); }
DI float* bias_ptr(const Ctx& C, int l, int which  ) { return (float*)(C.ws + WS_BIAS + (size_t)l * SZ_BIAS_L + (which == 0 ? 0 : which == 1 ? SZ_BIAS_GU : SZ_BIAS_GU + SZ_BIAS_IN)); }
DI float* rowss_ptr(const Ctx& C, int l, int sub) { return (float*)(C.ws + WS_ROWSS) + ((size_t)l * 3 + sub) * M; }
DI const float* gs_ptr(const Ctx& C, int l, int sub, int s) { return (const float*)(C.ws + WS_GS) + (((size_t)l * 3 + sub) * 3 + s) * D; }
DI const float* gate_ptr(const Ctx& C, int l, int sub, int s) { return (const float*)(C.ws + WS_GATE) + (((size_t)l * 3 + sub) * 3 + s) * D; }
DI float* rw_arr(const Ctx& C, int a) { return (float*)(C.ws + WS_RW + (size_t)a * SZ_RWA); }
enum { I_X = 0, I_C, I_CTX, I_CCTX, I_WADA, I_BADA, I_NORMG, I_F1WG, I_F1WU, I_F1WD, I_F2WG, I_F2WU, I_F2WD, I_WIN, I_WOUT, I_NAQG, I_NAKG, I_NARPB, I_RWCONV, I_RWW0, I_RWWUP, I_RWA0, I_RWAUP,
       I_RWGUP, I_RWKK, I_RWKA, I_RWRK, I_RWGNW, I_RWGNB, I_WAQG, I_WAKG, I_WASINK, I_S5ARE, I_S5AIM, I_S5LDT, I_S5BRE, I_S5BIM, I_S5CRE, I_S5CIM, I_S5D, I_S5GLUW, I_S5GLUB, I_NIN };

struct EpiGU {
    const float* rowss; const float* bias  ; bf16* H; int mrows;
    DI void operator()(const f32x4 (&acc)[2][2][4][2], const Unit& u, int wr, int wc, int fr_, int fq_) const {
        int tz_ = threadIdx.x; OPAQUE(tz_); const int fr = tz_ & 15, fq = (tz_ & 63) >> 4; (void)fr_; (void)fq_;
        const int s = stream_of_panel(u.pm); const float* bs = bias + (size_t)s * 2 * FF + u.pn * 256 + wc * 32 + 4 * fq;
        f32x4 bg[2], bu[2];
#pragma unroll
        for (int n = 0; n < 2; ++n) { bg[n] = *(const f32x4*)(bs + 16 * n); bu[n] = *(const f32x4*)(bs + 128 + 16 * n); }
        float rsv[2][4];
#pragma unroll
        for (int ai = 0; ai < 2; ++ai)
#pragma unroll
            for (int m = 0; m < 4; ++m) rsv[ai][m] = rowss[u.pm * 256 + ai * 128 + wr * 64 + m * 16 + fr];
#pragma unroll
        for (int ai = 0; ai < 2; ++ai)
#pragma unroll
            for (int m = 0; m < 4; ++m) {
                const int row = u.pm * 256 + ai * 128 + wr * 64 + m * 16 + fr;
                const float rstd = __builtin_amdgcn_rsqf(rsv[ai][m] * (1.0f / D) + NORM_EPS);
                bf16* hp = H + (size_t)row * FF + u.pn * 128 + wc * 32 + 8 * fq;
                u32x4 w;
                { const f32x4 g = acc[ai][0][m][0] * rstd + bg[0], v = acc[ai][1][m][0] * rstd + bu[0]; w.x = pk2(siluf(g[0]) * v[0], siluf(g[1]) * v[1]); w.y = pk2(siluf(g[2]) * v[2], siluf(g[3]) * v[3]); }
                { const f32x4 g = acc[ai][0][m][1] * rstd + bg[1], v = acc[ai][1][m][1] * rstd + bu[1]; w.z = pk2(siluf(g[0]) * v[0], siluf(g[1]) * v[1]); w.w = pk2(siluf(g[2]) * v[2], siluf(g[3]) * v[3]); }
                *(u32x4*)hp = w;
            }
    }
};
struct EpiRes {
    const Ctx* C; const float* gate  ; const float* gsn  ; float* rowss_next; bf16* AP;
    DI void operator()(const f32x4 (&acc)[2][2][4][2], const Unit& u, int wr, int wc, int fr_, int fq_) const {
        int tz_ = threadIdx.x; OPAQUE(tz_); const int fr = tz_ & 15, fq = (tz_ & 63) >> 4; (void)fr_; (void)fq_;
        const int s = stream_of_panel(u.pm); const int col0 = u.pn * 256 + wc * 32 + 4 * fq;
        f32x4 gv[2][2], sv[2][2];
#pragma unroll
        for (int bj = 0; bj < 2; ++bj)
#pragma unroll
            for (int n = 0; n < 2; ++n) { gv[bj][n] = *(const f32x4*)(gate + (size_t)s * D + col0 + bj * 128 + n * 16); sv[bj][n] = gsn ? *(const f32x4*)(gsn + (size_t)s * D + col0 + bj * 128 + n * 16) : (f32x4){0.f, 0.f, 0.f, 0.f}; }
        f32x4 xc[2][2], xn[2][2];
        { const float* xp0 = xrow_ptr(*C, u.pm * 256 + wr * 64 + fr) + col0;
#pragma unroll
          for (int bj = 0; bj < 2; ++bj)
#pragma unroll
              for (int n = 0; n < 2; ++n) xn[bj][n] = *(const f32x4*)(xp0 + bj * 128 + n * 16); }
#pragma unroll
        for (int ai = 0; ai < 2; ++ai)
#pragma unroll
            for (int m = 0; m < 4; ++m) {
                const int row = u.pm * 256 + ai * 128 + wr * 64 + m * 16 + fr;
                float* xp = xrow_ptr(*C, row) + col0; float ss = 0.f;
#pragma unroll
                for (int bj = 0; bj < 2; ++bj)
#pragma unroll
                    for (int n = 0; n < 2; ++n) xc[bj][n] = xn[bj][n];
                if (ai * 4 + m < 7) { const int rn = ai * 4 + m + 1; const float* xq = xrow_ptr(*C, u.pm * 256 + (rn >> 2) * 128 + wr * 64 + (rn & 3) * 16 + fr) + col0;
#pragma unroll
                    for (int bj = 0; bj < 2; ++bj)
#pragma unroll
                        for (int n = 0; n < 2; ++n) xn[bj][n] = *(const f32x4*)(xq + bj * 128 + n * 16); }
#pragma unroll
                for (int bj = 0; bj < 2; ++bj)
#pragma unroll
                    for (int n = 0; n < 2; ++n) { f32x4 x = xc[bj][n]; x += gv[bj][n] * acc[ai][bj][m][n]; *(f32x4*)(xp + bj * 128 + n * 16) = x;
                        if (gsn) { ss += (x[0] * x[0] + x[1] * x[1]) + (x[2] * x[2] + x[3] * x[3]); const f32x4 a = x * sv[bj][n]; u32x2 w; w.x = pk2(a[0], a[1]); w.y = pk2(a[2], a[3]);
                            *(u32x2*)(AP + (size_t)row * D + col0 + bj * 128 + n * 16) = w; } }
                if (gsn) { ss += __shfl_xor(ss, 16); ss += __shfl_xor(ss, 32); if (fq == 0) atomicAdd(rowss_next + row, ss); }
            }
    }
};
struct EpiAcc {
    const Ctx* C; const float* gate;
    DI void operator()(const f32x4 (&acc)[2][2][4][2], const Unit& u, int wr, int wc, int fr_, int fq_) const {
        int tz_ = threadIdx.x; OPAQUE(tz_); const int fr = tz_ & 15, fq = (tz_ & 63) >> 4; (void)fr_; (void)fq_;
        const int s = stream_of_panel(u.pm); const int col0 = u.pn * 256 + wc * 32 + 4 * fq;
#pragma unroll
        for (int bj = 0; bj < 2; ++bj)
#pragma unroll
            for (int n = 0; n < 2; ++n) { const f32x4 gv = *(const f32x4*)(gate + (size_t)s * D + col0 + bj * 128 + n * 16);
#pragma unroll
                for (int ai = 0; ai < 2; ++ai)
#pragma unroll
                    for (int m = 0; m < 4; ++m) { float* xp = xrow_ptr(*C, u.pm * 256 + ai * 128 + wr * 64 + m * 16 + fr) + col0 + bj * 128 + n * 16; const f32x4 d = gv * acc[ai][bj][m][n];
#pragma unroll
                        for (int j = 0; j < 4; ++j) atomicAdd(xp + j, d[j]); } }
    }
};
struct EpiIn {
    const Ctx* C; const float* rowss; const float* bias  ; int l;
    DI void operator()(const f32x4 (&acc)[2][2][4][2], const Unit& u, int wr, int wc, int fr_, int fq_) const {
        int tz_ = threadIdx.x; OPAQUE(tz_); const int fr = tz_ & 15, fq = (tz_ & 63) >> 4; (void)fr_; (void)fq_;
        const int s = stream_of_panel(u.pm), pn = u.pn; const float* bs = bias + (size_t)s * NINP + pn * 256 + wc * 32 + 4 * fq;
        unsigned char* ws = C->ws;
        f32x4 bv[2][2];
#pragma unroll
        for (int bj = 0; bj < 2; ++bj)
#pragma unroll
            for (int n = 0; n < 2; ++n) bv[bj][n] = *(const f32x4*)(bs + bj * 128 + n * 16);
        float rsv[2][4];
#pragma unroll
        for (int ai = 0; ai < 2; ++ai)
#pragma unroll
            for (int m = 0; m < 4; ++m) rsv[ai][m] = rowss[u.pm * 256 + ai * 128 + wr * 64 + m * 16 + fr];
        const bool permuted = pn < PN_AV || (pn >= PN_CQ && pn < PN_DU);
        if (permuted) {
            const bool is_ckv = pn == PN_CKV, is_c = pn >= PN_CQ, is_q = pn < PN_AK || (pn >= PN_CQ && pn < PN_CKV);
            const bool plain_v = is_ckv && wc >= 2;
            const float* gsrc = C->in[is_c ? (is_q ? I_WAQG : I_WAKG) : (is_q ? I_NAQG : I_NAKG)] + (size_t)l * 64;
            f32x4 gn[2][2];
#pragma unroll
            for (int bj = 0; bj < 2; ++bj)
#pragma unroll
                for (int n = 0; n < 2; ++n) { gn[bj][n] = *(const f32x4*)(gsrc + 32 * bj + 16 * n + 4 * fq); if (is_q) gn[bj][n] *= 0.125f; }
            bf16* dst; int pitch, hcol;
            if (pn < PN_AK) { dst = (bf16*)(ws + WS_QA); pitch = GW; hcol = ((pn - PN_AQ) * 4 + wc) * 64; }
            else if (pn < PN_AV) { dst = (bf16*)(ws + WS_KA); pitch = GW; hcol = ((pn - PN_AK) * 4 + wc) * 64; }
            else if (pn < PN_CKV) { dst = (bf16*)(ws + WS_QC); pitch = GW; hcol = ((pn - PN_CQ) * 4 + wc) * 64; }
            else if (wc < 2) { dst = (bf16*)(ws + WS_KC); pitch = 128; hcol = wc * 64; }
            else { dst = (bf16*)(ws + WS_VC); pitch = 128; hcol = (wc - 2) * 64; }
            const f32x4* rope = (const f32x4*)(ws + WS_ROPE);
#pragma unroll
            for (int ai = 0; ai < 2; ++ai)
#pragma unroll
                for (int m = 0; m < 4; ++m) {
                    const int row = pn * 0 + u.pm * 256 + ai * 128 + wr * 64 + m * 16 + fr;
                    const float rstd = __builtin_amdgcn_rsqf(rsv[ai][m] * (1.0f / D) + NORM_EPS);
                    f32x4 v[2][2]; float ss = 0.f;
#pragma unroll
                    for (int bj = 0; bj < 2; ++bj)
#pragma unroll
                        for (int n = 0; n < 2; ++n) { v[bj][n] = acc[ai][bj][m][n] * rstd + bv[bj][n]; ss += (v[bj][n][0] * v[bj][n][0] + v[bj][n][1] * v[bj][n][1]) + (v[bj][n][2] * v[bj][n][2] + v[bj][n][3] * v[bj][n][3]); }
                    ss += __shfl_xor(ss, 16); ss += __shfl_xor(ss, 32);
                    if (!plain_v) { const float rs = 1.0f / sqrtf(ss * (1.0f / 64.0f) + NORM_EPS);
#pragma unroll
                        for (int bj = 0; bj < 2; ++bj)
#pragma unroll
                            for (int n = 0; n < 2; ++n) v[bj][n] = v[bj][n] * rs * gn[bj][n];
                        if (is_c && row < M_LAT) {
                            const int t = row % T; const int pos[2] = {t / GRW, t % GRW};
#pragma unroll
                            for (int bj = 0; bj < 2; ++bj) { const f32x4 cs0 = rope[(pos[bj] * 16 + 4 * fq) / 2], cs1 = rope[(pos[bj] * 16 + 4 * fq) / 2 + 1];
                                const float cc[4] = {cs0[0], cs0[2], cs1[0], cs1[2]}, sn[4] = {cs0[1], cs0[3], cs1[1], cs1[3]};
#pragma unroll
                                for (int j = 0; j < 4; ++j) { const float x1 = v[bj][0][j], x2 = v[bj][1][j]; v[bj][0][j] = x1 * cc[j] - x2 * sn[j]; v[bj][1][j] = x2 * cc[j] + x1 * sn[j]; } }
                        }
                    }
                    bf16* op = dst + (size_t)row * pitch + hcol + 4 * fq;
#pragma unroll
                    for (int bj = 0; bj < 2; ++bj)
#pragma unroll
                        for (int n = 0; n < 2; ++n) { u32x2 w; w.x = pk2(v[bj][n][0], v[bj][n][1]); w.y = pk2(v[bj][n][2], v[bj][n][3]); *(u32x2*)(op + 32 * bj + 16 * n) = w; }
                }
        } else {
#pragma unroll
            for (int ai = 0; ai < 2; ++ai)
#pragma unroll
                for (int m = 0; m < 4; ++m) {
                    const int row = u.pm * 256 + ai * 128 + wr * 64 + m * 16 + fr;
                    const float rstd = __builtin_amdgcn_rsqf(rsv[ai][m] * (1.0f / D) + NORM_EPS);
#pragma unroll
                    for (int bj = 0; bj < 2; ++bj)
#pragma unroll
                        for (int n = 0; n < 2; ++n) { const f32x4 v = acc[ai][bj][m][n] * rstd + bv[bj][n]; const int c = bj * 128 + wc * 32 + n * 16 + 4 * fq;
                            u32x2 w; w.x = pk2(v[0], v[1]); w.y = pk2(v[2], v[3]);
                            if (pn < PN_BR) *(u32x2*)((bf16*)(ws + WS_VA) + (size_t)row * GW + (pn - PN_AV) * 256 + c) = w;
                            else if (pn < PN_BS) *(u32x2*)((bf16*)(ws + WS_PB) + (size_t)row * 3 * GW + (pn - PN_BR) * 256 + c) = w;
                            else if (pn == PN_BS) { if (c < 160) *(f32x4*)((float*)(ws + WS_PS) + (size_t)row * 160 + c) = v; }
                            else { const int cu = (pn - PN_DU) * 256 + c, gq = cu >> 4, p0 = cu & 15;
                                *(u32x2*)((bf16*)(ws + WS_UG) + ((size_t)gq * NCHP + row / S5L) * S5K + (row % S5L) * 16 + p0) = w; } }
                }
        }
    }
};
struct EpiS5A {
    float* XE;
    DI void operator()(const f32x4 (&acc)[2][2][4][2], const Unit& u, int wr, int wc, int fr_, int fq_) const {
        int tz_ = threadIdx.x; OPAQUE(tz_); const int fr = tz_ & 15, fq = (tz_ & 63) >> 4; (void)fr_; (void)fq_;
#pragma unroll
        for (int ai = 0; ai < 2; ++ai)
#pragma unroll
            for (int m = 0; m < 4; ++m) { const int ch = u.pm * 256 + ai * 128 + wr * 64 + m * 16 + fr; if (ch < NCH) { float* p = XE + ((size_t)u.z * NCHP + ch) * 256 + wc * 32 + 4 * fq;
#pragma unroll
                for (int bj = 0; bj < 2; ++bj)
#pragma unroll
                    for (int n = 0; n < 2; ++n) *(f32x4*)(p + bj * 128 + n * 16) = acc[ai][bj][m][n]; } }
    }
};
struct EpiS5C {
    const bf16* UG; const float* dsk  ; bf16* YG;
    DI void operator()(const f32x4 (&acc)[2][2][4][2], const Unit& u, int wr, int wc, int fr_, int fq_) const {
        int tz_ = threadIdx.x; OPAQUE(tz_); const int fr = tz_ & 15, fq = (tz_ & 63) >> 4; (void)fr_; (void)fq_;
        const int g = u.z;
#pragma unroll
        for (int ai = 0; ai < 2; ++ai)
#pragma unroll
            for (int m = 0; m < 4; ++m) { const int ch = u.pm * 256 + ai * 128 + wr * 64 + m * 16 + fr; if (ch < NCH) {
#pragma unroll
                for (int bj = 0; bj < 2; ++bj)
#pragma unroll
                    for (int n = 0; n < 2; ++n) { const int col = u.pn * 256 + bj * 128 + wc * 32 + n * 16 + 4 * fq, i = col >> 4, p0 = col & 15;
                        const u32x2 uw = *(const u32x2*)(UG + ((size_t)g * NCHP + ch) * S5K + col); const f32x4 dv = *(const f32x4*)(dsk + 16 * g + p0);
                        const f32x4 a = acc[ai][bj][m][n]; const float y0 = a[0] + dv[0] * bflo(uw.x), y1 = a[1] + dv[1] * bfhi(uw.x), y2 = a[2] + dv[2] * bflo(uw.y), y3 = a[3] + dv[3] * bfhi(uw.y);
                        u32x2 w; w.x = pk2(geluf(y0), geluf(y1)); w.y = pk2(geluf(y2), geluf(y3));
                        *(u32x2*)(YG + (size_t)(ch * S5L + i) * GW + 16 * g + p0) = w; } } }
    }
};
struct EpiGLU {
    const bf16* YG; const float* gb; bf16* OB;
    DI void operator()(const f32x4 (&acc)[2][2][4][2], const Unit& u, int wr, int wc, int fr_, int fq_) const {
        int tz_ = threadIdx.x; OPAQUE(tz_); const int fr = tz_ & 15, fq = (tz_ & 63) >> 4; (void)fr_; (void)fq_;
#pragma unroll
        for (int ai = 0; ai < 2; ++ai)
#pragma unroll
            for (int m = 0; m < 4; ++m) { const int row = u.pm * 256 + ai * 128 + wr * 64 + m * 16 + fr;
#pragma unroll
                for (int bj = 0; bj < 2; ++bj)
#pragma unroll
                    for (int n = 0; n < 2; ++n) { const int col = u.pn * 256 + bj * 128 + wc * 32 + n * 16 + 4 * fq; const f32x4 b = *(const f32x4*)(gb + col); const f32x4 a = acc[ai][bj][m][n] + b;
                        const u32x2 yw = *(const u32x2*)(YG + (size_t)row * GW + col);
                        u32x2 w; w.x = pk2(bflo(yw.x) * sigmf(a[0]), bfhi(yw.x) * sigmf(a[1])); w.y = pk2(bflo(yw.y) * sigmf(a[2]), bfhi(yw.y) * sigmf(a[3]));
                        *(u32x2*)(OB + (size_t)row * D + 3 * GW + col) = w; } }
    }
};

DI void ph_ada(const Ctx& C) {
    LAS float* sc = (LAS float*)C.lds;
    LAS float* red = sc + 3 * D;
    for (int i = C.tid; i < 3 * D; i += NTHR) { const int s = i / D, k = i % D; const float c = s < NB ? C.in[I_C][s * D + k] : C.in[I_CCTX][k]; sc[i] = siluf(c); }
    __syncthreads();
    const int nun = NL * (9 * D / 256);
    for (int un = C.bid; un < nun; un += C.G) {
        const int l = un / (9 * D / 256), col0 = (un % (9 * D / 256)) * 256;
        const float* W = C.in[I_WADA] + (size_t)l * D * 9 * D + col0 + 4 * C.lane;
        f32x4 a0 = {0.f, 0.f, 0.f, 0.f}, a1 = a0, a2 = a0;
        const int k0 = C.wave * (D / 8);
#pragma unroll 1
        for (int kb = k0; kb < k0 + D / 8; kb += 16) {
            f32x4 wv[16];
#pragma unroll
            for (int u = 0; u < 16; ++u) wv[u] = *(const f32x4*)(W + (size_t)(kb + u) * 9 * D);
#pragma unroll
            for (int u = 0; u < 16; ++u) { a0 += wv[u] * sc[kb + u]; a1 += wv[u] * sc[D + kb + u]; a2 += wv[u] * sc[2 * D + kb + u]; } }
        LAS float* r = red + C.wave * 768 + 4 * C.lane;
        *(LAS f32x4*)(r) = a0; *(LAS f32x4*)(r + 256) = a1; *(LAS f32x4*)(r + 512) = a2;
        __syncthreads();
        for (int i = C.tid; i < 768; i += NTHR) { float s = 0.f;
#pragma unroll
            for (int w = 0; w < 8; ++w) s += red[w * 768 + i];
            const int st = i / 256, c = col0 + (i % 256);
            ((float*)(C.ws + WS_MODV))[((size_t)l * 3 + st) * 9 * D + c] = s + C.in[I_BADA][(size_t)l * 9 * D + c]; }
        __syncthreads();
    }
}
DI const float* modv_ptr(const Ctx& C, int l, int s, int chunk) { return (const float*)(C.ws + WS_MODV) + ((size_t)l * 3 + s) * 9 * D + (size_t)chunk * D; }

DI int win_dest(int n) {
    if (n >= D_IN) return -1;
    if (n < SRC_AV) { const int piece = n / GW, loc = n % GW, head = loc / 64, d = loc % 64; return ((piece == 0 ? PN_AQ : PN_AK) + head / 4) * 256 + 128 * (d / 32) + 32 * (head % 4) + (d % 32); }
    if (n < SRC_BS) return PN_AV * 256 + (n - SRC_AV);
    if (n < SRC_CQ) return PN_BS * 256 + (n - SRC_BS);
    if (n < SRC_CK) { const int loc = n - SRC_CQ, head = loc / 64, d = loc % 64; return (PN_CQ + head / 4) * 256 + 128 * (d / 32) + 32 * (head % 4) + (d % 32); }
    if (n < SRC_DU) { const int loc = n - SRC_CK, hh = loc / 64, d = loc % 64; return PN_CKV * 256 + 128 * (d / 32) + 32 * hh + (d % 32); }
    return PN_DU * 256 + (n - SRC_DU);
}
DI int gu_dest(int n) { const int e = n & 31; return (n / 128) * 256 + (n % 128 - e) + 16 * ((e >> 2) & 1) + 4 * (e >> 3) + (e & 3); }
DI void conv_item(const Ctx& C, const float* W, int K, int N, bf16* Wt, int mode, int k0, int n0, float* bias, int bias_pitch, const float* shift  ) {
    LAS float* scr = (LAS float*)(C.lds + C.wave * 16640);
    const int n = n0 + C.lane; const bool ok = n < N; float b0 = 0.f, b1 = 0.f, b2 = 0.f;
#pragma unroll 1
    for (int kh = 0; kh < 4; ++kh) {
        float wv[16];
#pragma unroll
        for (int kk = 0; kk < 16; ++kk) wv[kk] = ok ? W[(size_t)(k0 + 16 * kh + kk) * N + n] : 0.f;
#pragma unroll
        for (int kk = 0; kk < 16; ++kk) { const float v = wv[kk]; scr[(16 * kh + kk) * 65 + C.lane] = v;
            if (bias) { b0 += shift[k0 + 16 * kh + kk] * v; b1 += shift[9 * D + k0 + 16 * kh + kk] * v; b2 += shift[18 * D + k0 + 16 * kh + kk] * v; } } }
    WSYNC();
    const int dme = !ok ? -1 : mode == 0 ? n : mode == 1 ? gu_dest(n) : mode == 2 ? gu_dest(n) + 128 : win_dest(n);
    if (bias && dme >= 0) { atomicAdd(bias + dme, b0); atomicAdd(bias + bias_pitch + dme, b1); atomicAdd(bias + 2 * bias_pitch + dme, b2); }
    const int c = C.lane & 7;
#pragma unroll
    for (int i = 0; i < 8; ++i) { const int nl = (C.lane >> 3) + 8 * i, nn = n0 + nl;
        const int dr = nn >= N ? -1 : mode == 0 ? nn : mode == 1 ? gu_dest(nn) : mode == 2 ? gu_dest(nn) + 128 : win_dest(nn);
        const LAS float* s = scr + (8 * c) * 65 + nl;
        u32x4 o; o.x = pk2(s[0], s[65]); o.y = pk2(s[2 * 65], s[3 * 65]); o.z = pk2(s[4 * 65], s[5 * 65]); o.w = pk2(s[6 * 65], s[7 * 65]);
        if (dr >= 0) *(u32x4*)(Wt + (size_t)dr * K + k0 + 8 * c) = o; }
    WSYNC();
}
struct Cplx { float re, im; };
DI Cplx cmul(Cplx a, Cplx b) { return Cplx{a.re * b.re - a.im * b.im, a.re * b.im + a.im * b.re}; }
DI Cplx s5_lam_pow(const Ctx& C, int l, int dir, int g, int n, float tau) {
    const size_t i = (((size_t)l * 2 + dir) * S5G + g) * 64 + n; const float dt = __expf(C.in[I_S5LDT][((size_t)l * 2 + dir) * S5G + g]);
    const float mag = __expf(tau * dt * C.in[I_S5ARE][i]), ang = tau * dt * C.in[I_S5AIM][i]; float sn, cs; sincosf(ang, &sn, &cs); return Cplx{mag * cs, mag * sn};
}
DI Cplx s5_coef(const Ctx& C, int l, int dir, int g, int n) {
    const size_t i = (((size_t)l * 2 + dir) * S5G + g) * 64 + n; const float are = C.in[I_S5ARE][i], aim = C.in[I_S5AIM][i];
    const Cplx ab = s5_lam_pow(C, l, dir, g, n, 1.0f); const float den = are * are + aim * aim, nr = ab.re - 1.0f;
    return Cplx{(nr * are + ab.im * aim) / den, (ab.im * are - nr * aim) / den};
}
DI Cplx s5_beta(const Ctx& C, int l, int dir, int g, int n, int q) {
    const size_t i = (((size_t)l * S5G + g) * 64 + n) * 16 + q; return cmul(s5_coef(C, l, dir, g, n), Cplx{C.in[I_S5BRE][i], C.in[I_S5BIM][i]});
}
DI Cplx s5_gamma(const Ctx& C, int l, int g, int p, int n) { const size_t i = (((size_t)l * S5G + g) * 16 + p) * 64 + n; return Cplx{C.in[I_S5CRE][i], C.in[I_S5CIM][i]}; }

#ifndef CONV_G1_PCT
#define CONV_G1_PCT 55
#endif
constexpr int CI_GU = (D / 64) * (FF / 64), CI_DN = (FF / 64) * (D / 64), CI_IN = (D / 64) * ((D_IN + 63) / 64), CI_OUT = (D / 64) * (D / 64), CI_GLU = (GW / 64) * (GW / 64);
constexpr int CI_LAYER = 4 * CI_GU + 2 * CI_DN + CI_IN + CI_OUT + CI_GLU, CI_X1 = (int)((long)CI_LAYER * CONV_G1_PCT / 100) & ~7;
DI void conv_weights(const Ctx& C, int l, int wslot, int nslots, int it_lo, int it_hi) {
    for (int it = it_lo + wslot; it < it_hi; it += nslots) {
        int r = it;
        unsigned char* wbase = C.ws + WS_W + (size_t)l * SZ_WL;
        if (r < 2 * CI_GU) { const int up = r >= CI_GU; r -= up * CI_GU; const int kb = r / (FF / 64), nb = r % (FF / 64);
            conv_item(C, C.in[up ? I_F1WU : I_F1WG] + (size_t)l * D * FF, D, FF, (bf16*)(wbase + OFF_W1GU), 1 + up, kb * 64, nb * 64, bias_ptr(C, l, 0), 2 * FF, modv_ptr(C, l, 0, 0)); continue; } r -= 2 * CI_GU;
        if (r < CI_DN) { const int kb = r / (D / 64), nb = r % (D / 64); conv_item(C, C.in[I_F1WD] + (size_t)l * FF * D, FF, D, (bf16*)(wbase + OFF_W1D), 0, kb * 64, nb * 64, nullptr, 0, nullptr); continue; } r -= CI_DN;
        if (r < CI_IN) { const int nbn = (D_IN + 63) / 64, kb = r / nbn, nb = r % nbn; conv_item(C, C.in[I_WIN] + (size_t)l * D * D_IN, D, D_IN, (bf16*)(wbase + OFF_WIN), 3, kb * 64, nb * 64, bias_ptr(C, l, 1), NINP, modv_ptr(C, l, 0, 3)); continue; } r -= CI_IN;
        if (r < CI_OUT) { const int kb = r / (D / 64), nb = r % (D / 64); conv_item(C, C.in[I_WOUT] + (size_t)l * D * D, D, D, (bf16*)(wbase + OFF_WOUT), 0, kb * 64, nb * 64, nullptr, 0, nullptr); continue; } r -= CI_OUT;
        if (r < 2 * CI_GU) { const int up = r >= CI_GU; r -= up * CI_GU; const int kb = r / (FF / 64), nb = r % (FF / 64);
            conv_item(C, C.in[up ? I_F2WU : I_F2WG] + (size_t)l * D * FF, D, FF, (bf16*)(wbase + OFF_W2GU), 1 + up, kb * 64, nb * 64, bias_ptr(C, l, 2), 2 * FF, modv_ptr(C, l, 0, 6)); continue; } r -= 2 * CI_GU;
        if (r < CI_DN) { const int kb = r / (D / 64), nb = r % (D / 64); conv_item(C, C.in[I_F2WD] + (size_t)l * FF * D, FF, D, (bf16*)(wbase + OFF_W2D), 0, kb * 64, nb * 64, nullptr, 0, nullptr); continue; } r -= CI_DN;
        { const int kb = r / (GW / 64), nb = r % (GW / 64); conv_item(C, C.in[I_S5GLUW] + (size_t)l * GW * GW, GW, GW, (bf16*)(wbase + OFF_WGLU), 0, kb * 64, nb * 64, nullptr, 0, nullptr); }
    }
}
DI void ph_conv(const Ctx& C) {
    const int gt = C.bid * NTHR + C.tid, GT = C.G * NTHR;
    for (int i = gt; i < NL * 9 * D; i += GT) { const int k = i % D, s = (i / D) % 3, sub = (i / (3 * D)) % 3, l = i / (9 * D);
        const float* mv = (const float*)(C.ws + WS_MODV) + ((size_t)l * 3 + s) * 9 * D;
        ((float*)(C.ws + WS_GS))[i] = C.in[I_NORMG][((size_t)l * 3 + sub) * D + k] * (1.0f + mv[(3 * sub + 1) * D + k]);
        ((float*)(C.ws + WS_GATE))[i] = mv[(3 * sub + 2) * D + k] * (sub == 1 ? 1.0f : 0.5f); }
    for (int i = gt; i < 128 * 16; i += GT) { const int pos = i / 16, f = i % 16; const float inv = __expf(-(float)f * (9.210340371976184f / 16.0f)); float sn, cs; sincosf((float)pos * inv, &sn, &cs);
        ((f32x2*)(C.ws + WS_ROPE))[i] = (f32x2){cs, sn}; }
    const int gw = C.bid * NW + C.wave, GWV = C.G * NW;
    conv_weights(C, 0, gw, GWV, 0, CI_LAYER);
    for (int i = gt; i < NL * 14 * NH * 2 * 64 * 8; i += GT) {
        const int j = i & 7, ln = (i >> 3) & 63, tj = (i >> 9) & 1, hd = (i >> 10) % NH, f = (i / (1024 * NH)) % 14, l = i / (1024 * NH * 14);
        const int col = hd * 64 + 32 * tj + (ln & 31); float v;
        if (f < 8) { const int d = (f >> 1) & 1, sx = f & 1, k = 16 * sx + 8 * (ln >> 5) + j; v = C.in[f < 4 ? I_RWWUP : I_RWAUP][(((size_t)l * 2 + d) * 32 + k) * GW + col]; }
        else { const int k = 16 * (f - 8) + 8 * (ln >> 5) + j; v = C.in[I_RWGUP][((size_t)l * 96 + k) * GW + col]; }
        ((bf16*)(C.ws + WS_RWF))[i] = (bf16)f2bf(v); }
    LAS float* wsc = (LAS float*)(C.lds + C.wave * 16640);
    for (int it = gw; it < NL * S5G * 2 * S5L; it += GWV) {
        const int tau = it % S5L, dir = (it / S5L) % 2, g = (it / (2 * S5L)) % S5G, l = it / (2 * S5L * S5G);
        const Cplx z = cmul(s5_lam_pow(C, l, dir, g, C.lane, (float)tau), s5_coef(C, l, dir, g, C.lane));
#pragma unroll 4
        for (int q = 0; q < 16; ++q) { const size_t i = (((size_t)l * S5G + g) * 64 + C.lane) * 16 + q; const Cplx w = cmul(z, Cplx{C.in[I_S5BRE][i], C.in[I_S5BIM][i]}); wsc[(C.lane * 16 + q) * 2] = w.re; wsc[(C.lane * 16 + q) * 2 + 1] = w.im; }
        WSYNC();
        float* kc = (float*)(C.ws + WS_S5T + (size_t)l * SZ_S5L + OFF_S5KC) + (((size_t)g * 2 + dir) * S5L + tau) * 256;
#pragma unroll 1
        for (int e = 0; e < 4; ++e) { const int pq = C.lane + 64 * e, p = pq >> 4, q = pq & 15; float s = 0.f;
#pragma unroll 4
            for (int n = 0; n < 64; ++n) { const Cplx gm = s5_gamma(C, l, g, p, n); s += gm.re * wsc[(n * 16 + q) * 2] - gm.im * wsc[(n * 16 + q) * 2 + 1]; }
            kc[pq] = s; }
        WSYNC();
    }
    for (int i = gt; i < NL * 2 * GW * 4 * (S5L + 1); i += GT) { const int tau = i % (S5L + 1), r = i / (S5L + 1), n = r % 64, g = (r / 64) % S5G, dir = (r / (64 * S5G)) % 2, l = r / (2 * 64 * S5G);
        const Cplx z = s5_lam_pow(C, l, dir, g, n, (float)tau); ((f32x2*)(C.ws + WS_S5T + (size_t)l * SZ_S5L + OFF_S5LP))[((size_t)(dir * S5G + g) * 64 + n) * (S5L + 1) + tau] = (f32x2){z.re, z.im}; }
    for (int i = gt; i < NL * 2 * GW * 4 * 16; i += GT) { const int q = i % 16, r = i / 16, n = r % 64, g = (r / 64) % S5G, dir = (r / (64 * S5G)) % 2, l = r / (2 * 64 * S5G);
        const Cplx z = s5_beta(C, l, dir, g, n, q); ((f32x2*)(C.ws + WS_S5T + (size_t)l * SZ_S5L + OFF_S5BETA))[((size_t)(dir * S5G + g) * 64 + n) * 16 + q] = (f32x2){z.re, z.im}; }
    for (int i = gt; i < NL * 2 * GW * 4; i += GT) { const int n = i % 64, g = (i / 64) % S5G, dir = (i / (64 * S5G)) % 2, l = i / (2 * 64 * S5G); const Cplx z = s5_lam_pow(C, l, dir, g, n, (float)S5L);
        ((f32x2*)(C.ws + WS_S5T + (size_t)l * SZ_S5L + OFF_S5LAM))[(dir * S5G + g) * 64 + n] = (f32x2){z.re, z.im}; }
}
DI void ph_tab(const Ctx& C) {
    const long gt = (long)C.bid * NTHR + C.tid, GT = (long)C.G * NTHR;
    for (long i = gt; i < (long)NL * S5G * 256 * 512; i += GT) {
        const int k = (int)(i % 512), np = (int)((i / 512) % 256), g = (int)((i / (512 * 256)) % S5G), l = (int)(i / ((long)512 * 256 * S5G));
        const int j = k >> 4, q = k & 15, dir = np >> 7, n = np & 63, im = (np >> 6) & 1;
        const f32x2 lp = ((const f32x2*)(C.ws + WS_S5T + (size_t)l * SZ_S5L + OFF_S5LP))[((size_t)(dir * S5G + g) * 64 + n) * (S5L + 1) + (dir == 0 ? S5L - 1 - j : j)];
        const f32x2 be = ((const f32x2*)(C.ws + WS_S5T + (size_t)l * SZ_S5L + OFF_S5BETA))[((size_t)(dir * S5G + g) * 64 + n) * 16 + q];
        const Cplx w = cmul(Cplx{lp[0], lp[1]}, Cplx{be[0], be[1]});
        ((bf16*)(C.ws + WS_S5T + (size_t)l * SZ_S5L + OFF_S5ET))[((size_t)g * 256 + np) * 512 + k] = (bf16)f2bf(im ? w.im : w.re); }
    for (long i = gt; i < (long)NL * S5G * 512 * S5K; i += GT) {
        const int k = (int)(i % S5K), nn = (int)((i / S5K) % 512), g = (int)((i / ((long)S5K * 512)) % S5G), l = (int)(i / ((long)S5K * 512 * S5G));
        const int ti = nn >> 4, p = nn & 15; float v;
        if (k < 512) { const int j = k >> 4, q = k & 15; const float* kc = (const float*)(C.ws + WS_S5T + (size_t)l * SZ_S5L + OFF_S5KC) + (size_t)g * 2 * S5L * 256;
            v = 0.f; if (j <= ti) v += kc[((ti - j)) * 256 + p * 16 + q]; if (j >= ti) v += kc[(S5L + (j - ti)) * 256 + p * 16 + q]; }
        else { const int kk = k - 512, dir = kk >> 7, im = (kk >> 6) & 1, n = kk & 63;
            const f32x2 lp = ((const f32x2*)(C.ws + WS_S5T + (size_t)l * SZ_S5L + OFF_S5LP))[((size_t)(dir * S5G + g) * 64 + n) * (S5L + 1) + (dir == 0 ? ti + 1 : S5L - ti)];
            const Cplx w = cmul(s5_gamma(C, l, g, p, n), Cplx{lp[0], lp[1]}); v = im ? -w.im : w.re; }
        ((bf16*)(C.ws + WS_S5T + (size_t)l * SZ_S5L + OFF_S5BT))[((size_t)g * 512 + nn) * S5K + k] = (bf16)f2bf(v); }
    const int gw = C.bid * NW + C.wave, GWV = C.G * NW;
    for (int row = gw; row < M; row += GWV) {
        const float* src = row < M_LAT ? C.in[I_X] + (size_t)row * D : C.in[I_CTX] + (size_t)(row - M_LAT) * D;
        float* dst = xrow_ptr(C, row); const float* gs = gs_ptr(C, 0, 0, stream_of_row(row)); bf16* ap = (bf16*)(C.ws + WS_AP) + (size_t)row * D; float ss = 0.f;
        f32x4 xv[D / 256], gv[D / 256];
#pragma unroll
        for (int i = 0; i < D / 256; ++i) { xv[i] = *(const f32x4*)(src + 4 * C.lane + 256 * i); gv[i] = *(const f32x4*)(gs + 4 * C.lane + 256 * i); }
#pragma unroll
        for (int i = 0; i < D / 256; ++i) { const int c = 4 * C.lane + 256 * i; const f32x4 x = xv[i]; *(f32x4*)(dst + c) = x; ss += (x[0] * x[0] + x[1] * x[1]) + (x[2] * x[2] + x[3] * x[3]);
            const f32x4 a = x * gv[i]; u32x2 w; w.x = pk2(a[0], a[1]); w.y = pk2(a[2], a[3]); *(u32x2*)(ap + c) = w; }
        ss = wave_sum(ss); if (C.lane == 0) rowss_ptr(C, 0, 0)[row] = ss;
    }
}

#ifdef EMU
DI s16x4 tr_read1(const LAS unsigned char* a) { return emu_tr_read(a); }
#else
DI s16x4 tr_read1(const LAS unsigned char* a) { s16x4 r; asm volatile("ds_read_b64_tr_b16 %0, %1\n\ts_waitcnt lgkmcnt(0)" : "=&v"(r) : "v"((unsigned)(size_t)a) : "memory"); return r; }
#endif
DI bf16x8 tr_frag(const LAS unsigned char* a0, int hi_off) {
#ifdef EMU
    const s16x4 lo = emu_tr_read(a0), hi = emu_tr_read(a0 + hi_off);
#else
    s16x4 lo, hi; asm volatile("ds_read_b64_tr_b16 %0, %2\n\tds_read_b64_tr_b16 %1, %3\n\ts_waitcnt lgkmcnt(0)" : "=&v"(lo), "=&v"(hi) : "v"((unsigned)(size_t)a0), "v"((unsigned)(size_t)(a0 + hi_off)) : "memory");
#endif
    return __builtin_shufflevector(lo, hi, 0, 1, 2, 3, 4, 5, 6, 7);
}
DI void tr_frag4(const LAS unsigned char* a0, const LAS unsigned char* a1, const LAS unsigned char* a2, const LAS unsigned char* a3, int hi_off, bf16x8 (&f)[4]) {
#ifdef EMU
    f[0] = tr_frag(a0, hi_off); f[1] = tr_frag(a1, hi_off); f[2] = tr_frag(a2, hi_off); f[3] = tr_frag(a3, hi_off);
#else
    s16x4 l0, h0, l1, h1, l2, h2, l3, h3;
    asm volatile("ds_read_b64_tr_b16 %0, %8\n\tds_read_b64_tr_b16 %1, %9\n\tds_read_b64_tr_b16 %2, %10\n\tds_read_b64_tr_b16 %3, %11\n\tds_read_b64_tr_b16 %4, %12\n\tds_read_b64_tr_b16 %5, %13\n\tds_read_b64_tr_b16 %6, %14\n\tds_read_b64_tr_b16 %7, %15\n\ts_waitcnt lgkmcnt(0)"
        : "=&v"(l0), "=&v"(h0), "=&v"(l1), "=&v"(h1), "=&v"(l2), "=&v"(h2), "=&v"(l3), "=&v"(h3)
        : "v"((unsigned)(size_t)a0), "v"((unsigned)(size_t)(a0 + hi_off)), "v"((unsigned)(size_t)a1), "v"((unsigned)(size_t)(a1 + hi_off)), "v"((unsigned)(size_t)a2), "v"((unsigned)(size_t)(a2 + hi_off)), "v"((unsigned)(size_t)a3), "v"((unsigned)(size_t)(a3 + hi_off)) : "memory");
    f[0] = __builtin_shufflevector(l0, h0, 0, 1, 2, 3, 4, 5, 6, 7); f[1] = __builtin_shufflevector(l1, h1, 0, 1, 2, 3, 4, 5, 6, 7); f[2] = __builtin_shufflevector(l2, h2, 0, 1, 2, 3, 4, 5, 6, 7); f[3] = __builtin_shufflevector(l3, h3, 0, 1, 2, 3, 4, 5, 6, 7);
#endif
}
DI bf16x8 pack8(const f32x16& x, int s) {
    u32x4 p; p.x = pk2(x[8 * s], x[8 * s + 1]); p.y = pk2(x[8 * s + 2], x[8 * s + 3]); p.z = pk2(x[8 * s + 4], x[8 * s + 5]); p.w = pk2(x[8 * s + 6], x[8 * s + 7]);
    return __builtin_bit_cast(bf16x8, p);
}
struct AttnSt { f32x16 o0, o1; float m, l; };
struct KVregs { bf16x8 k[4]; u32x4 v[4]; };
struct Kregs { bf16x8 k[4]; };
DI void k_load(Kregs& r, const bf16* Kb, int kp, int lane) {
    const int r32 = lane & 31, h = lane >> 5;
#pragma unroll
    for (int kk = 0; kk < 4; ++kk) r.k[kk] = *(const bf16x8*)(Kb + (size_t)r32 * kp + 16 * kk + 8 * h);
}
DI void kv_load(KVregs& r, const Kregs& kpre, const bf16* Vb, int vp, int lane) {
#pragma unroll
    for (int kk = 0; kk < 4; ++kk) r.k[kk] = kpre.k[kk];
#pragma unroll
    for (int i = 0; i < 4; ++i) { const int idx = lane + 64 * i, key = idx >> 3, ch = idx & 7; r.v[i] = *(const u32x4*)(Vb + (size_t)key * vp + ch * 8); }
}
template <bool MASKED>
DI void attn_block(AttnSt& st, const bf16x8 (&qf)[4], const KVregs& kv, LAS unsigned char* vl, int lane, const float (&addv)[16], unsigned vmask) {
    const int h = lane >> 5;
    f32x16 s;
#pragma unroll
    for (int i = 0; i < 16; ++i) s[i] = 0.f;
#pragma unroll
    for (int kk = 0; kk < 4; ++kk) s = __builtin_amdgcn_mfma_f32_32x32x16_bf16(kv.k[kk], qf[kk], s, 0, 0, 0);
    float bm = -1e30f;
#pragma unroll
    for (int i = 0; i < 16; ++i) { if (MASKED) { s[i] += addv[i]; if ((vmask >> i) & 1u) bm = fmaxf(bm, s[i]); } else bm = fmaxf(bm, s[i]); }
    bm = fmaxf(bm, __shfl_xor(bm, 32));
    const float mn = fmaxf(st.m, bm), alpha = __expf(st.m - mn); st.m = mn;
    float ls = 0.f;
#pragma unroll
    for (int i = 0; i < 16; ++i) { float p = __expf(s[i] - mn); if (MASKED) p = ((vmask >> i) & 1u) ? p : 0.f; s[i] = p; ls += p; }
    st.l = st.l * alpha + ls;
#pragma unroll
    for (int i = 0; i < 16; ++i) { st.o0[i] *= alpha; st.o1[i] *= alpha; }
#pragma unroll
    for (int i = 0; i < 4; ++i) { const int idx = lane + 64 * i, key = idx >> 3, ch = idx & 7; *(LAS u32x4*)(vl + key * 128 + ch * 16) = kv.v[i]; }
    WSYNC();
    const int q = (lane & 15) >> 2, p4 = lane & 3, blk = (lane >> 4) & 1;
    { const LAS unsigned char* ab = vl + (4 * h + q) * 128 + (16 * blk) * 2 + 8 * p4; bf16x8 vf[4];
      tr_frag4(ab, ab + 64, ab + 16 * 128, ab + 16 * 128 + 64, 8 * 128, vf);
      const bf16x8 pf0 = pack8(s, 0), pf1 = pack8(s, 1);
      st.o0 = __builtin_amdgcn_mfma_f32_32x32x16_bf16(vf[0], pf0, st.o0, 0, 0, 0); st.o1 = __builtin_amdgcn_mfma_f32_32x32x16_bf16(vf[1], pf0, st.o1, 0, 0, 0);
      st.o0 = __builtin_amdgcn_mfma_f32_32x32x16_bf16(vf[2], pf1, st.o0, 0, 0, 0); st.o1 = __builtin_amdgcn_mfma_f32_32x32x16_bf16(vf[3], pf1, st.o1, 0, 0, 0); }
}
DI void attn_finish(AttnSt& st, bf16* orow  , int lane, float extra_l) {
    const int h = lane >> 5; float l = st.l + __shfl_xor(st.l, 32) + extra_l; const float inv = 1.0f / l;
#pragma unroll
    for (int g = 0; g < 4; ++g) {
        u32x2 w0, w1; w0.x = pk2(st.o0[4 * g] * inv, st.o0[4 * g + 1] * inv); w0.y = pk2(st.o0[4 * g + 2] * inv, st.o0[4 * g + 3] * inv);
        w1.x = pk2(st.o1[4 * g] * inv, st.o1[4 * g + 1] * inv); w1.y = pk2(st.o1[4 * g + 2] * inv, st.o1[4 * g + 3] * inv);
        *(u32x2*)(orow + 8 * g + 4 * h) = w0; *(u32x2*)(orow + 32 + 8 * g + 4 * h) = w1; }
}
DI int clampi(int v, int lo, int hi) { return v < lo ? lo : (v > hi ? hi : v); }
#ifndef ATTN_A_PCT
#define ATTN_A_PCT 35
#endif
constexpr int AT_NA = NB * NH * (GRH / 2) * 4, AT_WA = NB * NH * (T / 32), AT_CX = NB * NH * (TC / 32);
DI void ph_attn(const Ctx& C, int l, bool want_ctx, int widx, int nworkers, int t_lo, int t_hi) {
    if (widx < 0) return;
    const int gw = t_lo + widx, GWV = nworkers, lane = C.lane, r32 = lane & 31, h = lane >> 5;
    LAS unsigned char* vl = C.lds + C.wave * 16640;
    const bf16* QA = (const bf16*)(C.ws + WS_QA); const bf16* KA = (const bf16*)(C.ws + WS_KA); const bf16* VA = (const bf16*)(C.ws + WS_VA);
    const bf16* QC = (const bf16*)(C.ws + WS_QC); const bf16* KC = (const bf16*)(C.ws + WS_KC); const bf16* VC = (const bf16*)(C.ws + WS_VC);
    bf16* OB = (bf16*)(C.ws + WS_OB);
    const int ntiles = t_hi;
    const float zero16[16] = {0.f, 0.f, 0.f, 0.f, 0.f, 0.f, 0.f, 0.f, 0.f, 0.f, 0.f, 0.f, 0.f, 0.f, 0.f, 0.f};
    for (int tile = gw; tile < ntiles; tile += GWV) {
        AttnSt st; st.m = -1e30f; st.l = 0.f;
#pragma unroll
        for (int i = 0; i < 16; ++i) { st.o0[i] = 0.f; st.o1[i] = 0.f; }
        bf16x8 qf[4];
        if (tile < AT_NA) {
            const int cb = tile & 3, rp = (tile >> 2) % (GRH / 2), hd = (tile / (4 * (GRH / 2))) % NH, b = tile / (4 * (GRH / 2) * NH);
            const int r0 = 2 * rp, c0 = 16 * cb, qr = r0 + (r32 >> 4), qc = c0 + (r32 & 15), qrow = b * T + qr * GRW + qc;
#pragma unroll
            for (int kk = 0; kk < 4; ++kk) qf[kk] = *(const bf16x8*)(QA + (size_t)qrow * GW + hd * 64 + 16 * kk + 8 * h);
            const int rsq = clampi(qr - 4, 0, GRH - 8), csq = clampi(qc - 8, 0, GRW - 16);
            const int rsA = clampi(r0 - 4, 0, GRH - 8), rsB = clampi(r0 + 1 - 4, 0, GRH - 8), kc0 = clampi(c0 - 8, 0, GRW - 32);
            const float* rpb = C.in[I_NARPB] + ((size_t)l * NH + hd) * 465;
            const int nbn = rsB + 8 - rsA, nbt = nbn + TC / 32; KVregs cur; Kregs nxt;
#define NA_ROW(i) ((i) < nbn ? (size_t)b * T + (rsA + (i)) * GRW + kc0 : (size_t)M_LAT + b * TC + 32 * ((i) - nbn))
            { const size_t kr0 = NA_ROW(0); k_load(nxt, KA + kr0 * GW + hd * 64, GW, lane); }
            for (int ib = 0; ib < nbt; ++ib) {
                { const size_t kr0 = NA_ROW(ib); kv_load(cur, nxt, VA + kr0 * GW + hd * 64, GW, lane); }
                if (ib + 1 < nbt) { const size_t kr1 = NA_ROW(ib + 1); k_load(nxt, KA + kr1 * GW + hd * 64, GW, lane); }
                if (ib < nbn) { const int kr = rsA + ib; float addv[16]; unsigned vm = 0u; const bool rok = kr >= rsq && kr <= rsq + 7;
#pragma unroll
                    for (int i = 0; i < 16; ++i) { const int kb = (i & 3) + 8 * (i >> 2) + 4 * h, kc = kc0 + kb; const bool ok = rok && kc >= csq && kc <= csq + 15;
                        const int bi = ok ? (kr - qr + 7) * 31 + (kc - qc + 15) : 0; addv[i] = rpb[bi]; vm |= ok ? (1u << i) : 0u; }
                    attn_block<true>(st, qf, cur, vl, lane, addv, vm); }
                else attn_block<false>(st, qf, cur, vl, lane, zero16, 0xffffu); }
#undef NA_ROW
            attn_finish(st, OB + (size_t)qrow * D + hd * 64, lane, 0.f);
        } else if (tile < AT_NA + AT_WA) {
            const int t2 = tile - AT_NA, qb = t2 % (T / 32), hd = (t2 / (T / 32)) % NH, b = t2 / ((T / 32) * NH), kvh = hd / WAG;
            const int qt = 32 * qb + r32, qrow = b * T + qt;
#pragma unroll
            for (int kk = 0; kk < 4; ++kk) qf[kk] = *(const bf16x8*)(QC + (size_t)qrow * GW + hd * 64 + 16 * kk + 8 * h);
            const int i_lo = 4 - qb > 0 ? 4 - qb : 0, i_hi = (T / 32 - qb + 4) < 9 ? (T / 32 - qb + 4) : 9, nbw = i_hi - i_lo, nbt = nbw + TC / 32; KVregs cur; Kregs nxt;
#define WA_ROW(i) ((i) < nbw ? (size_t)b * T + 32 * qb - 128 + 32 * (i_lo + (i)) : (size_t)M_LAT + b * TC + 32 * ((i) - nbw))
            { const size_t kr0 = WA_ROW(0); k_load(nxt, KC + kr0 * 128 + kvh * 64, 128, lane); }
            for (int ib = 0; ib < nbt; ++ib) {
                { const size_t kr0 = WA_ROW(ib); kv_load(cur, nxt, VC + kr0 * 128 + kvh * 64, 128, lane); }
                if (ib + 1 < nbt) { const size_t kr1 = WA_ROW(ib + 1); k_load(nxt, KC + kr1 * 128 + kvh * 64, 128, lane); }
                if (ib < nbw) { const int t0 = 32 * qb - 128 + 32 * (i_lo + ib); float addv[16]; unsigned vm = 0u;
#pragma unroll
                    for (int i = 0; i < 16; ++i) { const int kt = t0 + (i & 3) + 8 * (i >> 2) + 4 * h, rel = kt - qt; addv[i] = 0.f; vm |= (rel >= -128 && rel <= 128) ? (1u << i) : 0u; }
                    attn_block<true>(st, qf, cur, vl, lane, addv, vm); }
                else attn_block<false>(st, qf, cur, vl, lane, zero16, 0xffffu); }
#undef WA_ROW
            const float sk = C.in[I_WASINK][(size_t)l * NH + hd];
            const float mfin = fmaxf(st.m, sk), a2 = __expf(st.m - mfin);
#pragma unroll
            for (int i = 0; i < 16; ++i) { st.o0[i] *= a2; st.o1[i] *= a2; }
            st.l *= a2; st.m = mfin;
            attn_finish(st, OB + (size_t)qrow * D + 2 * GW + hd * 64, lane, __expf(sk - mfin));
        } else {
            const int t2 = tile - AT_NA - AT_WA, isc = t2 >= AT_CX, t3 = t2 - isc * AT_CX, qb = t3 % (TC / 32), hd = (t3 / (TC / 32)) % NH, b = t3 / ((TC / 32) * NH), kvh = hd / WAG;
            const int qrow = M_LAT + b * TC + 32 * qb + r32;
            const bf16* Qs = isc ? QC : QA; const bf16* Ks = isc ? KC + kvh * 64 : KA + hd * 64; const bf16* Vs = isc ? VC + kvh * 64 : VA + hd * 64; const int kp = isc ? 128 : GW;
#pragma unroll
            for (int kk = 0; kk < 4; ++kk) qf[kk] = *(const bf16x8*)(Qs + (size_t)qrow * GW + hd * 64 + 16 * kk + 8 * h);
            { KVregs cur; Kregs nxt; const size_t kr0 = (size_t)M_LAT + b * TC; k_load(nxt, Ks + kr0 * kp, kp, lane);
              for (int cbk = 0; cbk < TC / 32; ++cbk) { kv_load(cur, nxt, Vs + (kr0 + 32 * cbk) * kp, kp, lane); if (cbk + 1 < TC / 32) k_load(nxt, Ks + (kr0 + 32 * (cbk + 1)) * kp, kp, lane);
                  attn_block<false>(st, qf, cur, vl, lane, zero16, 0xffffu); } }
            float extra = 0.f;
            if (isc) { const float sk = C.in[I_WASINK][(size_t)l * NH + hd]; const float mfin = fmaxf(st.m, sk), a2 = __expf(st.m - mfin);
#pragma unroll
                for (int i = 0; i < 16; ++i) { st.o0[i] *= a2; st.o1[i] *= a2; }
                st.l *= a2; st.m = mfin; extra = __expf(sk - mfin); }
            attn_finish(st, OB + (size_t)qrow * D + (isc ? 2 * GW : 0) + hd * 64, lane, extra);
        }
    }
}

DI void ph_ctxfix(const Ctx& C, const float* gsn  , float* rowss_next) {
    const int gw = C.bid * NW + C.wave, GWV = C.G * NW;
    for (int r = gw; r < M_CTX; r += GWV) { const int row = M_LAT + r; const float* xp = xrow_ptr(C, row); const float* gs = gsn + (size_t)NB * D; bf16* ap = (bf16*)(C.ws + WS_AP) + (size_t)row * D; float ss = 0.f;
        f32x4 xv[D / 256], gv[D / 256];
#pragma unroll
        for (int i = 0; i < D / 256; ++i) { xv[i] = *(const f32x4*)(xp + 4 * C.lane + 256 * i); gv[i] = *(const f32x4*)(gs + 4 * C.lane + 256 * i); }
#pragma unroll
        for (int i = 0; i < D / 256; ++i) { const int c = 4 * C.lane + 256 * i; const f32x4 x = xv[i]; ss += (x[0] * x[0] + x[1] * x[1]) + (x[2] * x[2] + x[3] * x[3]);
            const f32x4 a = x * gv[i]; u32x2 w; w.x = pk2(a[0], a[1]); w.y = pk2(a[2], a[3]); *(u32x2*)(ap + c) = w; }
        ss = wave_sum(ss); if (C.lane == 0) rowss_next[row] = ss; }
}
constexpr int PT = 144;
constexpr int RW_HALF = 73472, IM_BT = 0, IM_KT = 9216, IM_RT = 18432, IM_ARB = 27648, IM_AT = 36864, IM_AAK = 46080, IM_F = 55296, IM_GC = 72704, FP = 68;
DI void chunk_rows(int b, int dir, int c, int& row0, int& step) {
    if (c < TC / 64) { const int p0 = 64 * c; row0 = M_LAT + b * TC + (dir ? TC - 1 - p0 : p0); } else { const int p0 = 64 * (c - TC / 64); row0 = b * T + (dir ? T - 1 - p0 : p0); }
    step = dir ? -1 : 1;
}
DI bf16x8 frag_rows(const LAS unsigned char* img, int tile, int s, int lane) { return *(const LAS bf16x8*)(img + (32 * tile + (lane & 31)) * PT + (16 * s + 8 * (lane >> 5)) * 2); }
DI bf16x8 frag_cols(const LAS unsigned char* img, int tile, int s, int lane) {
    const int h = lane >> 5, q = (lane & 15) >> 2, p4 = lane & 3, blk = (lane >> 4) & 1;
    const LAS unsigned char* a0 = img + (16 * s + 8 * h + q) * PT + (32 * tile + 16 * blk) * 2 + 8 * p4;
    return tr_frag(a0, 4 * PT);
}
DI void frag_cols4(const LAS unsigned char* img, int tile, int lane, bf16x8 (&f)[4]) {
    const int h = lane >> 5, q = (lane & 15) >> 2, p4 = lane & 3, blk = (lane >> 4) & 1;
    const LAS unsigned char* a0 = img + (8 * h + q) * PT + (32 * tile + 16 * blk) * 2 + 8 * p4;
    tr_frag4(a0, a0 + 16 * PT, a0 + 32 * PT, a0 + 48 * PT, 4 * PT, f);
}
DI void store_T(const f32x16& acc, LAS unsigned char* img, int ti, int tj, int lane) {
    const int c = lane & 31, h = lane >> 5;
#pragma unroll
    for (int g = 0; g < 4; ++g) { u32x2 w; w.x = pk2(acc[4 * g], acc[4 * g + 1]); w.y = pk2(acc[4 * g + 2], acc[4 * g + 3]); *(LAS u32x2*)(img + (32 * tj + c) * PT + (32 * ti + 8 * g + 4 * h) * 2) = w; }
}
DI f32x16 zero16v() { f32x16 z;
#pragma unroll
    for (int i = 0; i < 16; ++i) z[i] = 0.f; return z; }
#define MMA32(a, b, c) __builtin_amdgcn_mfma_f32_32x32x16_bf16((a), (b), (c), 0, 0, 0)
constexpr int PDW = 80, PDG = 208, IM_TW = 0, IM_TA = 17408, IM_DW = 36864, IM_DA = 41984, IM_DG = 47104;
DI void ph_rw1(const Ctx& C, int l) {
    const int wg = C.wave & 3, grp = C.wave >> 2, ti = wg >> 1, tj = wg & 1;
    bf16* QH = (bf16*)(C.ws + WS_QH); float* YL = (float*)(C.ws + WS_YL); bf16* MF = (bf16*)(C.ws + WS_MF); float* GF = (float*)(C.ws + WS_GF); bf16* RVKG = (bf16*)(C.ws + WS_RVKG);
    const bf16* PB = (const bf16*)(C.ws + WS_PB); const float* PS = (const float*)(C.ws + WS_PS);
    const bf16x8* RWF = (const bf16x8*)(C.ws + WS_RWF + (size_t)l * SZ_RWF);
    constexpr int nblk = (TC + T) / 64;
    for (int it0 = 2 * C.bid; it0 < RBLK; it0 += 2 * C.G) {
        int lane_ = threadIdx.x & 63; OPAQUE(lane_); const int lane = lane_, c32 = lane & 31, h = lane >> 5;
        LAS unsigned char* L = OPAQUE_LDS(C.lds + grp * RW_HALF);
        LAS float* F = (LAS float*)(L + IM_F); LAS float* SEG = (LAS float*)(L + IM_F); LAS float* GC = (LAS float*)(L + IM_GC);
        LAS float* TW = (LAS float*)(L + IM_TW); LAS float* TA = (LAS float*)(L + IM_TA);
        unsigned char* PK = C.ws + WS_RWS + ((size_t)C.bid * 2 + grp) * 65536;
        const int item = it0 + grp; const bool live = item < RBLK; const int itc = live ? item : RBLK - 1;
        const int tb = itc % nblk, hd = (itc / nblk) % NH, b = itc / (nblk * NH), cg = hd * 64 + lane;
        const int rowb = tb < TC / 64 ? M_LAT + b * TC + 64 * tb : b * T + 64 * (tb - TC / 64);
        const int seq_lo = tb < TC / 64 ? M_LAT + b * TC : b * T, seq_hi = seq_lo + (tb < TC / 64 ? TC : T);
        bf16* RV = RVKG + (size_t)itc * 4 * 4096;
        __syncthreads();
        float r_[16], kf_[16], kk_[16], ks_[16];
        { const float* cw = C.in[I_RWCONV] + (size_t)l * 9 * GW; float cwv[3][3];
#pragma unroll
          for (int j = 0; j < 3; ++j)
#pragma unroll
              for (int x = 0; x < 3; ++x) cwv[j][x] = cw[(size_t)j * 3 * GW + x * GW + cg];
          const float kkw = C.in[I_RWKK][(size_t)l * GW + cg];
          const int r0 = rowb + 16 * wg;
          bf16 pbv[18][3]; float psv[16][3];
#pragma unroll
          for (int rr = 0; rr < 18; ++rr) { int row = r0 - 1 + rr; row = row < seq_lo ? seq_lo : (row >= seq_hi ? seq_hi - 1 : row);
#pragma unroll
              for (int x = 0; x < 3; ++x) pbv[rr][x] = PB[(size_t)row * 3 * GW + x * GW + cg]; }
#pragma unroll
          for (int t = 0; t < 16; ++t)
#pragma unroll
              for (int kq = 0; kq < 3; ++kq) { const int k = lane + 64 * kq; psv[t][kq] = PS[(size_t)(r0 + t) * 160 + (k < 160 ? k : 159)]; }
          const float m_lo = r0 - 1 >= seq_lo ? 1.f : 0.f, m_hi = r0 + 16 < seq_hi ? 1.f : 0.f;
          float v_[16];
#pragma unroll
          for (int t = 0; t < 16; ++t) {
              float xa[3], xb[3], xc[3];
#pragma unroll
              for (int x = 0; x < 3; ++x) { xa[x] = bf2f(pbv[t][x]) * (t == 0 ? m_lo : 1.f); xb[x] = bf2f(pbv[t + 1][x]); xc[x] = bf2f(pbv[t + 2][x]) * (t == 15 ? m_hi : 1.f); }
              r_[t] = xa[0] * cwv[0][0] + xb[0] * cwv[1][0] + xc[0] * cwv[2][0]; kf_[t] = xa[1] * cwv[0][1] + xb[1] * cwv[1][1] + xc[1] * cwv[2][1]; v_[t] = xa[2] * cwv[0][2] + xb[2] * cwv[1][2] + xc[2] * cwv[2][2];
              const float kkv = kf_[t] * kkw, ssq = wave_sum(kkv * kkv); kk_[t] = kkv * __builtin_amdgcn_rsqf(fmaxf(ssq, 1e-24f)); ks_[t] = 0.f;
              const int tk = 16 * wg + t;
              if (lane < 32) *(LAS bf16*)(L + IM_DW + tk * PDW + lane * 2) = (bf16)f2bf(fast_tanh(psv[t][0])); else *(LAS bf16*)(L + IM_DA + tk * PDW + (lane - 32) * 2) = (bf16)f2bf(psv[t][0]);
              *(LAS bf16*)(L + IM_DG + tk * PDG + lane * 2) = (bf16)f2bf(sigmf(psv[t][1]));
              if (lane < 32) *(LAS bf16*)(L + IM_DG + tk * PDG + (lane + 64) * 2) = (bf16)f2bf(sigmf(psv[t][2]));
          }
#pragma unroll
          for (int t = 0; t < 16; ++t) { RV[(16 * wg + t) * 64 + lane] = (bf16)f2bf(r_[t]); RV[4096 + (16 * wg + t) * 64 + lane] = (bf16)f2bf(v_[t]); }
        }
        __syncthreads();
        bf16x8 lrf[2][4]; float w0v[2], a0v[2];
#pragma unroll
        for (int d = 0; d < 2; ++d) {
#pragma unroll
            for (int sx = 0; sx < 2; ++sx) { lrf[d][sx] = RWF[(((0 + 2 * d + sx) * NH + hd) * 2 + tj) * 64 + lane]; lrf[d][2 + sx] = RWF[(((4 + 2 * d + sx) * NH + hd) * 2 + tj) * 64 + lane]; }
            w0v[d] = C.in[I_RWW0][((size_t)l * 2 + d) * GW + hd * 64 + 32 * tj + c32]; a0v[d] = C.in[I_RWA0][((size_t)l * 2 + d) * GW + hd * 64 + 32 * tj + c32]; }
        { f32x16 gacc = zero16v();
#pragma unroll
          for (int sx = 0; sx < 6; ++sx) gacc = MMA32(*(const LAS bf16x8*)(L + IM_DG + (32 * ti + c32) * PDG + (16 * sx + 8 * h) * 2), RWF[(((8 + sx) * NH + hd) * 2 + tj) * 64 + lane], gacc);
#pragma unroll
          for (int rg = 0; rg < 16; ++rg) { const int tk = 32 * ti + (rg & 3) + 8 * (rg >> 2) + 4 * h; RV[3 * 4096 + tk * 64 + 32 * tj + c32] = (bf16)f2bf(gacc[rg]); }
        }
        const float kaw = C.in[I_RWKA][(size_t)l * GW + cg];
#pragma unroll
        for (int pss = 0; pss < 2; ++pss) {
            const int dir = 1 - pss;
            __syncthreads();
            { f32x16 pw = zero16v(), pa = zero16v();
#pragma unroll
              for (int sx = 0; sx < 2; ++sx) { pw = MMA32(*(const LAS bf16x8*)(L + IM_DW + (32 * ti + c32) * PDW + (16 * sx + 8 * h) * 2), lrf[dir][sx], pw);
                                              pa = MMA32(*(const LAS bf16x8*)(L + IM_DA + (32 * ti + c32) * PDW + (16 * sx + 8 * h) * 2), lrf[dir][2 + sx], pa); }
              const float w0 = w0v[dir], a0 = a0v[dir];
#pragma unroll
              for (int rg = 0; rg < 16; ++rg) { const int tk = 32 * ti + (rg & 3) + 8 * (rg >> 2) + 4 * h; const float z = -(w0 + pw[rg]), sp = z > 20.f ? z : __logf(1.f + __expf(z));
                  TW[tk * FP + 32 * tj + c32] = -__expf(-sp - 0.5f); TA[tk * FP + 32 * tj + c32] = sigmf(a0 + pa[rg]); } }
            __syncthreads();
            const int cs = dir ? 3 - wg : wg;
            float lw[16], av[16], run = 0.f;
#pragma unroll
            for (int ii = 0; ii < 16; ++ii) { const int tl = dir ? 15 - ii : ii, tk = 16 * wg + tl; av[ii] = TA[tk * FP + lane]; run += TW[tk * FP + lane]; lw[ii] = run; }
            __syncthreads();
            SEG[cs * 64 + lane] = run;
            __syncthreads();
            float off = 0.f;
#pragma unroll
            for (int w2 = 0; w2 < 3; ++w2) off += (w2 < cs) ? SEG[w2 * 64 + lane] : 0.f;
            const float tot = SEG[lane] + SEG[64 + lane] + SEG[128 + lane] + SEG[192 + lane];
            if (wg == 0) { if (dir) ((float*)(PK + 32768))[lane] = __expf(tot); else GC[lane] = __expf(tot); }
            float ePrev = __expf(off);
#pragma unroll
            for (int ii = 0; ii < 16; ++ii) { const int tl = dir ? 15 - ii : ii, i = 16 * cs + ii;
                const float Li = lw[ii] + off, eL = __expf(Li), ieL = __builtin_amdgcn_rcpf(eL), eLm = ePrev; ePrev = eL;
                const float a = av[ii], kd = kf_[tl] * (1.f + (a - 1.f) * kaw); ks_[tl] += kd;
                const bf16 vat = (bf16)f2bf(-kk_[tl] * eLm), vbt = (bf16)f2bf(kk_[tl] * a * ieL), vkt = (bf16)f2bf(kd * ieL), vrt = (bf16)f2bf(r_[tl] * eL);
                if (dir) { bf16* pk = (bf16*)PK + i * 64 + lane; pk[0] = vat; pk[4096] = vbt; pk[8192] = vkt; pk[12288] = vrt; }
                else { *(LAS bf16*)(L + IM_AT + i * PT + lane * 2) = vat; *(LAS bf16*)(L + IM_BT + i * PT + lane * 2) = vbt; *(LAS bf16*)(L + IM_KT + i * PT + lane * 2) = vkt; *(LAS bf16*)(L + IM_RT + i * PT + lane * 2) = vrt; } }
        }
#pragma unroll
        for (int t = 0; t < 16; ++t) RV[2 * 4096 + (16 * wg + t) * 64 + lane] = (bf16)f2bf(ks_[t]);
#pragma unroll 1
        for (int dir = 0; dir < 2; ++dir) {
            const int c = dir == 0 ? tb : (tb < TC / 64 ? TC / 64 - 1 - tb : TC / 64 + (T / 64 - 1 - (tb - TC / 64)));
            const size_t ci = ((size_t)((b * NH + hd) * 2 + dir)) * RCK + c;
            __syncthreads();
            if (dir) {
                const int tg = wg * 64 + lane;
                u32x4 pkv[4][2]; const float gcv = ((const float*)(PK + 32768))[lane];
#pragma unroll
                for (int im = 0; im < 4; ++im)
#pragma unroll
                    for (int rr = 0; rr < 2; ++rr) { const int idx = tg + 256 * rr, row = idx >> 3, ch = idx & 7; pkv[im][rr] = *(const u32x4*)(PK + im * 8192 + row * 128 + ch * 16); }
#pragma unroll
                for (int im = 0; im < 4; ++im)
#pragma unroll
                    for (int rr = 0; rr < 2; ++rr) { const int idx = tg + 256 * rr, row = idx >> 3, ch = idx & 7; const int dsto = im == 0 ? IM_AT : im == 1 ? IM_BT : im == 2 ? IM_KT : IM_RT;
                        *(LAS u32x4*)(L + dsto + row * PT + ch * 16) = pkv[im][rr]; }
                if (wg == 0) GC[lane] = gcv;
                __syncthreads();
            }
            f32x16 accP;
            { f32x16 aab = zero16v(), aak = zero16v(), arb = zero16v(); accP = zero16v();
#pragma unroll
              for (int s = 0; s < 4; ++s) { const bf16x8 at_i = frag_rows(L + IM_AT, ti, s, lane), bt_j = frag_rows(L + IM_BT, tj, s, lane), kt_j = frag_rows(L + IM_KT, ti, s, lane), at_c = frag_rows(L + IM_AT, tj, s, lane),
                                              bt_r = frag_rows(L + IM_BT, ti, s, lane), rt_c = frag_rows(L + IM_RT, tj, s, lane);
                  aab = MMA32(at_i, bt_j, aab); aak = MMA32(kt_j, at_c, aak); arb = MMA32(bt_r, rt_c, arb); accP = MMA32(kt_j, rt_c, accP); }
#pragma unroll
              for (int r = 0; r < 16; ++r) { const int row = 32 * ti + (r & 3) + 8 * (r >> 2) + 4 * h, col = 32 * tj + c32;
                  F[row * FP + col] = col < row ? aab[r] : 0.f; aak[r] = row < col ? aak[r] : 0.f; arb[r] = row <= col ? arb[r] : 0.f; accP[r] = row <= col ? accP[r] : 0.f; }
              store_T(aak, L + IM_AAK, ti, tj, lane);
              store_T(arb, L + IM_ARB, ti, tj, lane); }
            __syncthreads();
            { float Wc[64]; const int col = 32 * wg + c32; const LAS unsigned char* src = col < 64 ? L + IM_AT + col * 2 : L + IM_AAK + (col - 64) * 2;
              const LAS float* Fo = OPAQUE_LDS(F);
#pragma unroll
              for (int i = 0; i < 64; ++i) Wc[i] = bf2f(*(const LAS bf16*)(src + i * PT));
#pragma unroll
              for (int i = 1; i < 64; ++i) { float a0 = Wc[i], a1 = 0.f, a2 = 0.f, a3 = 0.f;
#pragma unroll
                  for (int j4 = 0; j4 < (i + 3) / 4; ++j4) { const f32x4 f = *(const LAS f32x4*)(Fo + i * FP + 4 * j4); a0 += f[0] * Wc[4 * j4]; a1 += f[1] * Wc[4 * j4 + 1]; a2 += f[2] * Wc[4 * j4 + 2]; a3 += f[3] * Wc[4 * j4 + 3];
                      if ((j4 & 7) == 7) PIN4(a0, a1, a2, a3); }
                  PIN4(a0, a1, a2, a3); Wc[i] = (a0 + a1) + (a2 + a3); }
              __syncthreads();
              if (h == 0) { LAS unsigned char* dst = (col < 64 ? L + IM_AT + col * PT : L + IM_AAK + (col - 64) * PT);
#pragma unroll
                  for (int i8 = 0; i8 < 8; ++i8) { u32x4 w; w.x = pk2(Wc[8 * i8], Wc[8 * i8 + 1]); w.y = pk2(Wc[8 * i8 + 2], Wc[8 * i8 + 3]); w.z = pk2(Wc[8 * i8 + 4], Wc[8 * i8 + 5]); w.w = pk2(Wc[8 * i8 + 6], Wc[8 * i8 + 7]); *(LAS u32x4*)(dst + i8 * 16) = w; } }
              bf16 vtmp[16];
#pragma unroll
              for (int ii = 0; ii < 16; ++ii) { const int tl = dir ? 15 - ii : ii; vtmp[ii] = RV[4096 + (16 * wg + tl) * 64 + lane]; }
#pragma unroll
              for (int ii = 0; ii < 16; ++ii) { const int i = 16 * (dir ? 3 - wg : wg) + ii; *(LAS bf16*)(L + IM_F + i * PT + lane * 2) = vtmp[ii]; }
            }
            __syncthreads();
            { f32x16 q;
#pragma unroll
              for (int g = 0; g < 4; ++g) { const u32x2 w = *(const LAS u32x2*)(L + IM_RT + (32 * tj + c32) * PT + (32 * ti + 8 * g + 4 * h) * 2); q[4 * g] = bflo(w.x); q[4 * g + 1] = bfhi(w.x); q[4 * g + 2] = bflo(w.y); q[4 * g + 3] = bfhi(w.y); }
#pragma unroll
              for (int s = 0; s < 4; ++s) { const bf16x8 arb = frag_rows(L + IM_ARB, tj, s, lane); q = MMA32(frag_rows(L + IM_AT, ti, s, lane), arb, q); accP = MMA32(frag_rows(L + IM_AAK, ti, s, lane), arb, accP); }
              if (live) {
#pragma unroll
                  for (int g = 0; g < 4; ++g) { u32x2 w; w.x = pk2(q[4 * g], q[4 * g + 1]); w.y = pk2(q[4 * g + 2], q[4 * g + 3]); *(u32x2*)(QH + ci * 4096 + (32 * tj + c32) * 64 + 32 * ti + 8 * g + 4 * h) = w; } }
            }
            __syncthreads();
            store_T(accP, L + IM_RT, ti, tj, lane);
            __syncthreads();
            { f32x16 y = zero16v(), m = zero16v(), n;
#pragma unroll
              for (int g = 0; g < 4; ++g) { const u32x2 w = *(const LAS u32x2*)(L + IM_KT + (32 * tj + c32) * PT + (32 * ti + 8 * g + 4 * h) * 2); n[4 * g] = bflo(w.x); n[4 * g + 1] = bfhi(w.x); n[4 * g + 2] = bflo(w.y); n[4 * g + 3] = bfhi(w.y); }
              bf16x8 btj[4], bti[4], vfj[4]; frag_cols4(L + IM_BT, tj, lane, btj); frag_cols4(L + IM_BT, ti, lane, bti); frag_cols4(L + IM_F, tj, lane, vfj);
#pragma unroll
              for (int s = 0; s < 4; ++s) { const bf16x8 btc_j = btj[s], btc_i = bti[s];
                  y = MMA32(frag_rows(L + IM_RT, ti, s, lane), vfj[s], y);
                  m = MMA32(frag_rows(L + IM_AT, ti, s, lane), btc_j, m);
                  n = MMA32(btc_i, frag_rows(L + IM_AAK, tj, s, lane), n); }
              const float gck = GC[32 * tj + c32];
#pragma unroll
              for (int r = 0; r < 16; ++r) { const int row = 32 * ti + (r & 3) + 8 * (r >> 2) + 4 * h, col = 32 * tj + c32; m[r] = (m[r] + (row == col ? 1.0f : 0.f)) * gck; n[r] *= GC[row]; }
              if (live) {
#pragma unroll
                  for (int g = 0; g < 4; ++g) *(f32x4*)(YL + ci * 4096 + ((wg * 4 + g) * 64 + lane) * 4) = (f32x4){y[4 * g], y[4 * g + 1], y[4 * g + 2], y[4 * g + 3]};
#pragma unroll
                  for (int s2 = 0; s2 < 2; ++s2) *(bf16x8*)(MF + ci * 4096 + ((wg * 2 + s2) * 64 + lane) * 8) = pack8(m, s2); }
              store_T(n, L + IM_ARB, ti, tj, lane);
            }
            __syncthreads();
            { f32x16 gacc = zero16v(); bf16x8 nfi[4], vfj[4]; frag_cols4(L + IM_ARB, ti, lane, nfi); frag_cols4(L + IM_F, tj, lane, vfj);
#pragma unroll
              for (int s = 0; s < 4; ++s) gacc = MMA32(nfi[s], vfj[s], gacc);
              if (live) {
#pragma unroll
                  for (int hf = 0; hf < 2; ++hf) { u32x4 w; w.x = pk2(gacc[8 * hf], gacc[8 * hf + 1]); w.y = pk2(gacc[8 * hf + 2], gacc[8 * hf + 3]); w.z = pk2(gacc[8 * hf + 4], gacc[8 * hf + 5]); w.w = pk2(gacc[8 * hf + 6], gacc[8 * hf + 7]);
                      *(u32x4*)((unsigned*)GF + ci * 2048 + ((wg * 2 + hf) * 64 + lane) * 4) = w; } }
            }
        }
    }
    __syncthreads();
}
struct R2Buf { bf16x8 mf[8]; u32x4 g[4]; };
DI void rw2_load(R2Buf& b, const bf16* MF, const unsigned* GFu, size_t item, int tj, int lane) {
#pragma unroll
    for (int q = 0; q < 8; ++q) b.mf[q] = *(const bf16x8*)(MF + item * 4096 + (q * 64 + lane) * 8);
#pragma unroll
    for (int kt = 0; kt < 2; ++kt)
#pragma unroll
        for (int hf = 0; hf < 2; ++hf) b.g[kt * 2 + hf] = *(const u32x4*)(GFu + item * 2048 + (((kt * 2 + tj) * 2 + hf) * 64 + lane) * 4);
}
DI void rw2_step(const R2Buf& b, f32x16& s0, f32x16& s1, bf16* SF, size_t item, int tj, int lane) {
    bf16x8 sf[2][2];
#pragma unroll
    for (int s = 0; s < 2; ++s) { sf[0][s] = pack8(s0, s); sf[1][s] = pack8(s1, s); *(bf16x8*)(SF + item * 4096 + (((0 * 2 + tj) * 2 + s) * 64 + lane) * 8) = sf[0][s]; *(bf16x8*)(SF + item * 4096 + (((1 * 2 + tj) * 2 + s) * 64 + lane) * 8) = sf[1][s]; }
    f32x16 n0, n1;
#pragma unroll
    for (int hf = 0; hf < 2; ++hf) { const u32x4 a = b.g[hf], c = b.g[2 + hf];
        n0[8 * hf] = bflo(a.x); n0[8 * hf + 1] = bfhi(a.x); n0[8 * hf + 2] = bflo(a.y); n0[8 * hf + 3] = bfhi(a.y); n0[8 * hf + 4] = bflo(a.z); n0[8 * hf + 5] = bfhi(a.z); n0[8 * hf + 6] = bflo(a.w); n0[8 * hf + 7] = bfhi(a.w);
        n1[8 * hf] = bflo(c.x); n1[8 * hf + 1] = bfhi(c.x); n1[8 * hf + 2] = bflo(c.y); n1[8 * hf + 3] = bfhi(c.y); n1[8 * hf + 4] = bflo(c.z); n1[8 * hf + 5] = bfhi(c.z); n1[8 * hf + 6] = bflo(c.w); n1[8 * hf + 7] = bfhi(c.w); }
#pragma unroll
    for (int kp = 0; kp < 2; ++kp)
#pragma unroll
        for (int s = 0; s < 2; ++s) { n0 = MMA32(b.mf[(kp * 2 + 0) * 2 + s], sf[kp][s], n0); n1 = MMA32(b.mf[(kp * 2 + 1) * 2 + s], sf[kp][s], n1); }
    s0 = n0; s1 = n1;
}
DI void ph_rw2(const Ctx& C) {
    const int lane = C.lane;
    const bf16* MF = (const bf16*)(C.ws + WS_MF); const unsigned* GFu = (const unsigned*)(C.ws + WS_GF); bf16* SF = (bf16*)(C.ws + WS_SF);
    const int nwork = RSTR * 2;
    for (int wk = C.wave == 0 ? C.bid : nwork; wk < nwork; wk += C.G) {
        const int tj = wk & 1, stream = wk >> 1; const size_t it0 = (size_t)stream * RCK;
        f32x16 s0 = zero16v(), s1 = zero16v();
        R2Buf A, B, Cb;
        rw2_load(A, MF, GFu, it0, tj, lane); rw2_load(B, MF, GFu, it0 + (1 < RCK ? 1 : 0), tj, lane); rw2_load(Cb, MF, GFu, it0 + (2 < RCK ? 2 : 0), tj, lane);
        for (int c = 0; c < RCK; c += 3) {
            rw2_step(A, s0, s1, SF, it0 + c, tj, lane); if (c + 3 < RCK) rw2_load(A, MF, GFu, it0 + c + 3, tj, lane);
            if (c + 1 < RCK) { rw2_step(B, s0, s1, SF, it0 + c + 1, tj, lane); if (c + 4 < RCK) rw2_load(B, MF, GFu, it0 + c + 4, tj, lane); }
            if (c + 2 < RCK) { rw2_step(Cb, s0, s1, SF, it0 + c + 2, tj, lane); if (c + 5 < RCK) rw2_load(Cb, MF, GFu, it0 + c + 5, tj, lane); }
        }
    }
}
DI void ph_rw3(const Ctx& C, int l, int mrows) {
    const int lane = C.lane, wg = C.wave & 3, grp = C.wave >> 2, ti = wg >> 1, tj = wg & 1, c32 = lane & 31, h = lane >> 5;
    LAS float* Ysum = (LAS float*)(C.lds + grp * RW_HALF);
    const bf16* QH = (const bf16*)(C.ws + WS_QH); const float* YL = (const float*)(C.ws + WS_YL); const bf16* SF = (const bf16*)(C.ws + WS_SF); bf16* OB = (bf16*)(C.ws + WS_OB);
    const int nblk = (TC + T) / 64, nitems = NB * NH * nblk;
    for (int it0 = 2 * C.bid; it0 < nitems; it0 += 2 * C.G) {
        const int item = it0 + grp; const bool live = item < nitems; const int itc = live ? item : nitems - 1;
        const int tb = itc % nblk, hd = (itc / nblk) % NH, b = itc / (nblk * NH);
        const int rowb = tb < TC / 64 ? M_LAT + b * TC + 64 * tb : b * T + 64 * (tb - TC / 64);
        __syncthreads();
        f32x4 yl[2][4]; u32x4 qa[2][4]; bf16x8 sb[2][4];
#pragma unroll
        for (int dir = 0; dir < 2; ++dir) {
            const int c = dir == 0 ? tb : (tb < TC / 64 ? TC / 64 - 1 - tb : TC / 64 + (T / 64 - 1 - (tb - TC / 64)));
            const size_t ci = ((size_t)((b * NH + hd) * 2 + dir)) * RCK + c;
#pragma unroll
            for (int g = 0; g < 4; ++g) yl[dir][g] = *(const f32x4*)(YL + ci * 4096 + ((wg * 4 + g) * 64 + lane) * 4);
#pragma unroll
            for (int kp = 0; kp < 2; ++kp)
#pragma unroll
                for (int s = 0; s < 2; ++s) { const bf16* qp = QH + ci * 4096 + (32 * ti + c32) * 64 + 32 * kp + 16 * s + 4 * h; const u32x2 lo = *(const u32x2*)qp, hi = *(const u32x2*)(qp + 8);
                    qa[dir][kp * 2 + s].x = lo.x; qa[dir][kp * 2 + s].y = lo.y; qa[dir][kp * 2 + s].z = hi.x; qa[dir][kp * 2 + s].w = hi.y;
                    sb[dir][kp * 2 + s] = *(const bf16x8*)(SF + ci * 4096 + (((kp * 2 + tj) * 2 + s) * 64 + lane) * 8); }
        }
#pragma unroll
        for (int dir = 0; dir < 2; ++dir) {
            f32x16 y;
#pragma unroll
            for (int g = 0; g < 4; ++g) { const f32x4 a = yl[dir][g]; y[4 * g] = a[0]; y[4 * g + 1] = a[1]; y[4 * g + 2] = a[2]; y[4 * g + 3] = a[3]; }
#pragma unroll
            for (int q4 = 0; q4 < 4; ++q4) y = MMA32(__builtin_bit_cast(bf16x8, qa[dir][q4]), sb[dir][q4], y);
#pragma unroll
            for (int r = 0; r < 16; ++r) { const int i = 32 * ti + (r & 3) + 8 * (r >> 2) + 4 * h, tk = dir ? 63 - i : i; LAS float* p = Ysum + tk * FP + 32 * tj + c32; if (dir == 0) *p = y[r]; else *p += y[r]; }
            __syncthreads();
        }
        if (live) {
            const int cch = hd * 64 + lane; const float rk = C.in[I_RWRK][((size_t)l * NH + hd) * 64 + lane], gw = C.in[I_RWGNW][(size_t)l * GW + cch], gb = C.in[I_RWGNB][(size_t)l * GW + cch];
#pragma unroll 1
            for (int t4 = 0; t4 < 16; t4 += 8) {
                bf16 rb[8], vb[8], kb[8], gb8[8];
#pragma unroll
                for (int u = 0; u < 8; ++u) { const bf16* rv = (const bf16*)(C.ws + WS_RVKG) + (size_t)item * 4 * 4096 + (16 * wg + t4 + u) * 64 + lane; rb[u] = rv[0]; vb[u] = rv[4096]; kb[u] = rv[8192]; gb8[u] = rv[12288]; }
#pragma unroll
                for (int u = 0; u < 8; ++u) { const int tk = 16 * wg + t4 + u, row = rowb + tk; const float r = bf2f(rb[u]), v = bf2f(vb[u]), ks = bf2f(kb[u]), gg = bf2f(gb8[u]);
                    float y = Ysum[tk * FP + lane] + wave_sum(r * ks * rk) * v;
                    const float mu = wave_sum(y) * (1.f / 64.f), dlt = y - mu, var = wave_sum(dlt * dlt) * (1.f / 64.f);
                    if (row < mrows) OB[(size_t)row * D + GW + cch] = (bf16)f2bf((dlt * __builtin_amdgcn_rsqf(var + RW_GN_EPS) * gw + gb) * gg); } }
        }
    }
    __syncthreads();
}
DI void ph_s5scan(const Ctx& C, int l, int first_block) {
    const int nthreads_total = NB * 2 * S5G * 64;
    if (C.bid < first_block) return;
    const float* XE = (const float*)(C.ws + WS_XEND); bf16* UG = (bf16*)(C.ws + WS_UG);
    const f32x2* LAM = (const f32x2*)(C.ws + WS_S5T + (size_t)l * SZ_S5L + OFF_S5LAM);
    for (int id = (C.bid - first_block) * NTHR + C.tid; id < nthreads_total; id += (C.G - first_block) * NTHR) {
        const int n = id & 63, g = (id >> 6) % S5G, dir = (id / (64 * S5G)) & 1, b = id / (128 * S5G);
        const f32x2 lm = LAM[(dir * S5G + g) * 64 + n]; float xr = 0.f, xi = 0.f;
        const int nc_ctx = TC / S5L, nc_lat = T / S5L, ntot = nc_ctx + nc_lat;
        for (int i0 = 0; i0 < ntot; i0 += 8) {
            float er[8], ei[8]; int chs[8];
#pragma unroll
            for (int u = 0; u < 8; ++u) { const int i = i0 + u; int ch;
                if (i < nc_ctx) ch = (M_LAT + b * TC) / S5L + (dir ? nc_ctx - 1 - i : i); else ch = (b * T) / S5L + (dir ? nc_lat - 1 - (i - nc_ctx) : (i - nc_ctx));
                chs[u] = ch; const float* p = XE + ((size_t)g * NCHP + ch) * 256 + dir * 128 + n; er[u] = p[0]; ei[u] = p[64]; }
#pragma unroll
            for (int u = 0; u < 8; ++u) { bf16* q = UG + ((size_t)g * NCHP + chs[u]) * S5K + 512 + dir * 128 + n; q[0] = (bf16)f2bf(xr); q[64] = (bf16)f2bf(xi);
                const float nr = lm[0] * xr - lm[1] * xi + er[u], ni = lm[0] * xi + lm[1] * xr + ei[u]; xr = nr; xi = ni; }
        }
    }
}

constexpr int PH_PRO = 3, PH_PER_L = 13, NPH = PH_PRO + PH_PER_L * NL;
#ifndef PROBE_REP
#define PROBE_REP -1
#endif
#define NREP(k) ((k) == PROBE_REP ? 2 : 1)
#ifdef ONLY
#define EN(k) ((k) == ONLY)
#else
#define EN(k) true
#endif
#ifdef EMU
void fwd(Args args) {
    unsigned char* lds = emu::lds_base();
#else
__global__ void __launch_bounds__(NTHR, 2) fwd(Args args) {
    extern __shared__ __attribute__((aligned(16))) unsigned char lds[];
#endif
    Ctx C; C.in = args.in; C.out = args.out; C.ws = args.ws; C.lds = (LAS unsigned char*)lds;
    C.tid = threadIdx.x; C.lane = C.tid & 63; C.wave = __builtin_amdgcn_readfirstlane(C.tid >> 6); C.G = gridDim.x; C.bid = blockIdx.x;
#define REFRESH() do { int t_ = threadIdx.x; OPAQUE(t_); C.tid = t_; C.lane = t_ & 63; C.wave = __builtin_amdgcn_readfirstlane(t_ >> 6); } while (0)
    volatile LAS unsigned* MISC = (volatile LAS unsigned*)(C.lds + MISC_OFF);
    if (C.tid < 32) MISC[C.tid] = 0u;
    __syncthreads();
    const int lo = args.ph_lo, hi = args.ph_hi;
    const bool use_bar = (hi - lo) > 1;
    XcdBarrier bar; bar.bar = (unsigned*)(C.ws + WS_CTL) + CW_BAR; bar.x = 0; bar.st = MISC + 8;
    if (use_bar) bar = xcd_barrier_post((unsigned*)(C.ws + WS_CTL) + CW_BAR, MISC + 8);
#define IN(k) (lo <= (k) && (k) < hi)
#define SEAM(k) do { if (IN(k) && IN((k) + 1)) xcd_barrier(bar); } while (0)
    if (EN(0) && IN(0)) for (int rep = 0; rep < NREP(0); ++rep) { REFRESH(); ph_ada(C); }
    SEAM(0);
    if (EN(1) && IN(1)) { REFRESH(); ph_conv(C); }
    SEAM(1);
    if (EN(2) && IN(2)) for (int rep = 0; rep < NREP(2); ++rep) { REFRESH(); ph_tab(C); }
    SEAM(2);
    for (int l = 0; l < NL; ++l) {
        const int pb = PH_PRO + PH_PER_L * l; const bool want_ctx = l < NL - 1;
        const int mrows_full = M, mrows_out = want_ctx ? M : M_LAT;
        const int nt_attn = AT_NA + AT_WA + (want_ctx ? 2 * AT_CX : 0), nt_attn_a = (int)((long)nt_attn * ATTN_A_PCT / 100);
        bf16* AP = (bf16*)(C.ws + WS_AP); bf16* Hb = (bf16*)(C.ws + WS_H); bf16* OB = (bf16*)(C.ws + WS_OB);
        if (EN(3) && IN(pb + 0)) for (int rep = 0; rep < NREP(3); ++rep) { REFRESH();
            Gemm g{AP, wl(C, l, OFF_W1GU), D, D, D, 0, 0}; Order S; S.init(mrows_full / 256, 2 * FF / 256, 1, C.G, C.bid, D / 64);
            EpiGU E{rowss_ptr(C, l, 0), bias_ptr(C, l, 0), Hb, mrows_full}; gemm_phase(C.lds, g, S, E);
            if (EN(1) && l + 1 < NL) { REFRESH(); const int r = S.total % C.G;
                if ((int)C.bid >= r) conv_weights(C, l + 1, (C.bid - r) * NW + C.wave, (C.G - r) * NW, 0, CI_X1); } }
        SEAM(pb + 0);
        if (EN(4) && IN(pb + 1)) { REFRESH();
            Gemm g{Hb, wl(C, l, OFF_W1D), FF, FF, FF, 0, 0}; Order S; S.init(M_LAT / 256, D / 256, 1, C.G, C.bid, FF / 64);
            EpiRes E{&C, gate_ptr(C, l, 0, 0), gs_ptr(C, l, 1, 0), rowss_ptr(C, l, 1), AP}; gemm_phase(C.lds, g, S, E);
            { REFRESH(); Order S2; S2.init_split(M_LAT / 256, M_CTX / 256, D / 256, 4, C.G, C.bid, FF / 64); EpiAcc E2{&C, gate_ptr(C, l, 0, 0)}; gemm_phase(C.lds, g, S2, E2); } }
        SEAM(pb + 1);
        if (EN(18) && IN(pb + 2)) { REFRESH(); ph_ctxfix(C, gs_ptr(C, l, 1, 0), rowss_ptr(C, l, 1)); }
        SEAM(pb + 2);
        if (EN(5) && IN(pb + 3)) for (int rep = 0; rep < NREP(5); ++rep) { REFRESH();
            Gemm g{AP, wl(C, l, OFF_WIN), D, D, D, 0, 0}; Order S; S.init(mrows_full / 256, NT_IN, 1, C.G, C.bid, D / 64);
            EpiIn E{&C, rowss_ptr(C, l, 1), bias_ptr(C, l, 1), l}; gemm_phase(C.lds, g, S, E); }
        SEAM(pb + 3);
        if (IN(pb + 4)) {
            if (EN(6)) for (int rep = 0; rep < NREP(6); ++rep) { REFRESH(); Gemm g{(const bf16*)(C.ws + WS_UG), (const bf16*)(C.ws + WS_S5T + (size_t)l * SZ_S5L + OFF_S5ET), S5K, 512, 512, (size_t)NCHP * S5K * 2, (size_t)256 * 512 * 2};
              const int off5 = C.G >= 256 ? 32 : 0; Order S; S.init(NCHP / 256, 1, S5G, C.G - off5, (int)C.bid < off5 ? (1 << 28) : (int)C.bid - off5, 512 / 64);        EpiS5A E{(float*)(C.ws + WS_XEND)}; gemm_phase(C.lds, g, S, E); }
            __syncthreads();
            for (int rep = 0; rep < NREP(9); ++rep) { if (EN(9)) { REFRESH(); ph_rw1(C, l); } }
            if (EN(7)) for (int rep = 0; rep < NREP(7); ++rep) { REFRESH(); const int fb = (C.G >= 256 && 2 * C.G < RBLK && RBLK % (2 * C.G) != 0) ? (RBLK % (2 * C.G) + 1) / 2 : 0;
                ph_attn(C, l, want_ctx, C.bid >= fb ? (C.bid - fb) * NW + C.wave : -1, (C.G - fb) * NW, 0, nt_attn_a); }
        }
        SEAM(pb + 4);
        if (IN(pb + 5)) {
            if (EN(17)) for (int rep = 0; rep < NREP(17); ++rep) { REFRESH(); ph_rw2(C); }
            if (EN(10)) for (int rep = 0; rep < NREP(10); ++rep) { REFRESH(); ph_s5scan(C, l, C.G >= 256 ? 128 : 0); }
            { REFRESH();
              const int nrb = C.G < RSTR * 2 ? C.G : RSTR * 2, sb_lo = C.G >= 256 ? 128 : C.G, sb_hi = C.G >= 256 ? 144 : C.G;
              const int nworkers = nrb * 7 + (C.G - nrb - (sb_hi - sb_lo)) * NW;
              const int widx = C.bid < nrb ? (C.wave == 0 ? -1 : C.bid * 7 + C.wave - 1) : (C.bid >= sb_lo && C.bid < sb_hi) ? -1 : nrb * 7 + (C.bid - nrb - (C.bid >= sb_hi ? sb_hi - sb_lo : 0)) * NW + C.wave;
              if (EN(7)) ph_attn(C, l, want_ctx, widx, nworkers, nt_attn_a, nt_attn); }
        }
        SEAM(pb + 5);
        if (IN(pb + 6)) {
            if (EN(11)) for (int rep = 0; rep < NREP(11); ++rep) { REFRESH(); Gemm g{(const bf16*)(C.ws + WS_UG), (const bf16*)(C.ws + WS_S5T + (size_t)l * SZ_S5L + OFF_S5BT), S5K, S5K, S5K, (size_t)NCHP * S5K * 2, (size_t)512 * S5K * 2};
              const int off5 = C.G >= 256 ? 64 : 0; Order S; S.init(NCHP / 256, 2, S5G, C.G - off5, (int)C.bid < off5 ? (1 << 28) : (int)C.bid - off5, S5K / 64);        EpiS5C E{(const bf16*)(C.ws + WS_UG), C.in[I_S5D] + (size_t)l * GW, (bf16*)(C.ws + WS_YG)}; gemm_phase(C.lds, g, S, E); }
            if (EN(12)) for (int rep = 0; rep < NREP(12); ++rep) { REFRESH(); ph_rw3(C, l, mrows_out); }
        }
        SEAM(pb + 6);
        if (EN(13) && IN(pb + 7)) for (int rep = 0; rep < NREP(13); ++rep) { REFRESH();
            Gemm g{(const bf16*)(C.ws + WS_YG), wl(C, l, OFF_WGLU), GW, GW, GW, 0, 0}; Order S; S.init(mrows_out / 256, GW / 256, 1, C.G, C.bid, GW / 64);
            EpiGLU E{(const bf16*)(C.ws + WS_YG), C.in[I_S5GLUB] + (size_t)l * GW, OB}; gemm_phase(C.lds, g, S, E); }
        SEAM(pb + 7);
        if (EN(14) && IN(pb + 8)) { REFRESH();
            Gemm g{OB, wl(C, l, OFF_WOUT), D, D, D, 0, 0}; Order S; S.init(M_LAT / 256, D / 256, 1, C.G, C.bid, D / 64);
            EpiRes E{&C, gate_ptr(C, l, 1, 0), gs_ptr(C, l, 2, 0), rowss_ptr(C, l, 2), AP}; gemm_phase(C.lds, g, S, E);
            if (want_ctx) { REFRESH(); Order S2; S2.init_split(M_LAT / 256, M_CTX / 256, D / 256, 4, C.G, C.bid, D / 64); EpiAcc E2{&C, gate_ptr(C, l, 1, 0)}; gemm_phase(C.lds, g, S2, E2); } }
        SEAM(pb + 8);
        if (EN(18) && IN(pb + 9) && want_ctx) { REFRESH(); ph_ctxfix(C, gs_ptr(C, l, 2, 0), rowss_ptr(C, l, 2)); }
        SEAM(pb + 9);
        if (EN(15) && IN(pb + 10)) { REFRESH();
            Gemm g{AP, wl(C, l, OFF_W2GU), D, D, D, 0, 0}; Order S; S.init(mrows_out / 256, 2 * FF / 256, 1, C.G, C.bid, D / 64);
            EpiGU E{rowss_ptr(C, l, 2), bias_ptr(C, l, 2), Hb, mrows_out}; gemm_phase(C.lds, g, S, E);
            if (EN(1) && l + 1 < NL) { REFRESH(); const int r = S.total % C.G;
                if ((int)C.bid >= r) conv_weights(C, l + 1, (C.bid - r) * NW + C.wave, (C.G - r) * NW, CI_X1, CI_LAYER); } }
        SEAM(pb + 10);
        if (EN(16) && IN(pb + 11)) { REFRESH();
            Gemm g{Hb, wl(C, l, OFF_W2D), FF, FF, FF, 0, 0}; Order S; S.init(M_LAT / 256, D / 256, 1, C.G, C.bid, FF / 64);
            const bool more = l + 1 < NL;
            EpiRes E{&C, gate_ptr(C, l, 2, 0), more ? gs_ptr(C, l + 1, 0, 0) : nullptr, more ? rowss_ptr(C, l + 1, 0) : nullptr, AP}; gemm_phase(C.lds, g, S, E);
            if (want_ctx) { REFRESH(); Order S2; S2.init_split(M_LAT / 256, M_CTX / 256, D / 256, 4, C.G, C.bid, FF / 64); EpiAcc E2{&C, gate_ptr(C, l, 2, 0)}; gemm_phase(C.lds, g, S2, E2); } }
        SEAM(pb + 11);
        if (EN(18) && IN(pb + 12) && want_ctx) { REFRESH(); ph_ctxfix(C, gs_ptr(C, l + 1, 0, 0), rowss_ptr(C, l + 1, 0)); }
        SEAM(pb + 12);
    }
#undef IN
#undef SEAM
}

#ifndef MK_PER_PHASE
#define MK_PER_PHASE 0
#endif
#ifdef EMU
int g_emu_grid = 4, g_emu_lo = 0, g_emu_hi = NPH;
#endif
extern "C" void kernel_launch(void* const* d_in, const int* in_sizes, int n_in, void* d_out, int out_size, void* d_ws, size_t ws_size, hipStream_t stream) {
    Args a{};
    for (int i = 0; i < 42; ++i) a.in[i] = (const float*)d_in[i];
    a.out = (float*)d_out; a.ws = (unsigned char*)d_ws;
#ifdef EMU
    if (g_emu_lo == 0) hipMemsetAsync(d_ws, 0, WS_ZERO_END, stream);
    for (int ph = g_emu_lo; ph < g_emu_hi; ++ph) { a.ph_lo = ph; a.ph_hi = ph + 1; fprintf(stderr, "phase %d\n", ph); emu::launch(g_emu_grid, NTHR, LDS_BYTES, [=] { fwd(a); }); }
#else
    static int grid = 0;
    if (grid == 0) {
        if (n_in != 42 || out_size != M_LAT * D || ws_size < WS_END) { fprintf(stderr, "kernel_launch: unexpected shapes (n_in %d out %d ws %zu need %zu)\n", n_in, out_size, ws_size, (size_t)WS_END); grid = -1; return; }
        int dev = 0, cus = 0;
        if (hipGetDevice(&dev) != hipSuccess || hipDeviceGetAttribute(&cus, hipDeviceAttributeMultiprocessorCount, dev) != hipSuccess) { grid = -1; return; }
        if (hipFuncSetAttribute((const void*)fwd, hipFuncAttributeMaxDynamicSharedMemorySize, LDS_BYTES) != hipSuccess) { fprintf(stderr, "kernel_launch: hipFuncSetAttribute failed\n"); grid = -1; return; }
        int per_cu = 0; (void)hipOccupancyMaxActiveBlocksPerMultiprocessor(&per_cu, (const void*)fwd, NTHR, LDS_BYTES); (void)hipGetLastError();
        if (per_cu < 1) fprintf(stderr, "kernel_launch: occupancy query reports %d\n", per_cu);
        grid = cus;
    }
    if (grid < 0) return;
    (void)hipMemsetAsync(d_ws, 0, WS_ZERO_END, stream);
#if MK_PER_PHASE
    for (int ph = 0; ph < NPH; ++ph) { a.ph_lo = ph; a.ph_hi = ph + 1; hipLaunchKernelGGL(fwd, dim3(grid), dim3(NTHR), LDS_BYTES, stream, a); }
#else
    a.ph_lo = 0; a.ph_hi = NPH;
    hipLaunchKernelGGL(fwd, dim3(grid), dim3(NTHR), LDS_BYTES, stream, a);
#endif
#endif
}
```

```cpp
#ifdef EMU
#include "emu/emu.h"
#define LAS
#define GAS
#define ASMV(...) ((void)0)
#define WSYNC() do { int _z = 0; (void)emu::wave_gather(&_z, 4); } while (0)
#define OPAQUE(x) ((void)0)
#define OPAQUE_S(x) ((void)0)
#define PIN(x) ((void)0)
#define PIN4(a, b, c, d) ((void)0)
#define OPAQUE_LDS(p) (p)
#else
#include <hip/hip_runtime.h>
#include <cstdio>
#include <cstdint>
#define LAS __attribute__((address_space(3)))
#define GAS __attribute__((address_space(1)))
#define ASMV(...) asm volatile(__VA_ARGS__)
#define PIN(x) asm volatile("" : "+v"(x) :: "memory")
#define PIN4(a, b, c, d) asm volatile("" : "+v"(a), "+v"(b), "+v"(c), "+v"(d) :: "memory")
template <class P> __device__ __forceinline__ P opaque_lds(P p) { unsigned a = (unsigned)(size_t)p; asm volatile("" : "+v"(a)); return (P)(size_t)a; }
#define OPAQUE_LDS(p) opaque_lds(p)
#define OPAQUE_S(x) asm volatile("" : "+s"(x))
#define OPAQUE(x) asm volatile("" : "+v"(x))
#define WSYNC() asm volatile("s_waitcnt lgkmcnt(0)" ::: "memory")
#endif

#ifdef EMU
constexpr int D = 1024, NB = 2, T = 1024, NL = 2, TC = 256, FF = 1024;
#else
constexpr int D = 2048, NB = 2, T = 8192, NL = 4, TC = 256, FF = 5632;
#endif
constexpr int GW = D / 4, NH = GW / 64, WAG = NH / 2, S5G = GW / 16, GRW = 64, GRH = T / GRW;
constexpr int M_LAT = NB * T, M_CTX = NB * TC, M = M_LAT + M_CTX, NPAN = M / 256;
constexpr int TP = GW / 256;
constexpr int NT_IN = 8 * TP + 2, NINP = NT_IN * 256, D_IN = 8 * GW + 416;
constexpr int PN_AQ = 0, PN_AK = TP, PN_AV = 2 * TP, PN_BR = 3 * TP, PN_BK = 4 * TP, PN_BV = 5 * TP, PN_BS = 6 * TP, PN_CQ = 6 * TP + 1, PN_CKV = 7 * TP + 1, PN_DU = 7 * TP + 2;
constexpr int SRC_AQ = 0, SRC_AK = GW, SRC_AV = 2 * GW, SRC_BR = 3 * GW, SRC_BK = 4 * GW, SRC_BV = 5 * GW, SRC_BS = 6 * GW, SRC_CQ = 6 * GW + 160, SRC_CK = 7 * GW + 160, SRC_CV = 7 * GW + 288, SRC_DU = 7 * GW + 416;
constexpr int S5L = 32, NCH = M / S5L, NCHP = ((NCH + 255) / 256) * 256, S5K = 768;
constexpr int NW = 8, NTHR = 512;
constexpr float NORM_EPS = 1e-6f, RW_GN_EPS = 64e-5f;

typedef unsigned short bf16;
typedef short bf16x8 __attribute__((ext_vector_type(8)));
typedef short s16x4 __attribute__((ext_vector_type(4)));
typedef float f32x4 __attribute__((ext_vector_type(4)));
typedef float f32x2 __attribute__((ext_vector_type(2)));
typedef float f32x16 __attribute__((ext_vector_type(16)));
typedef unsigned u32x4 __attribute__((ext_vector_type(4)));
typedef unsigned u32x2 __attribute__((ext_vector_type(2)));
#define DI __device__ __forceinline__

constexpr size_t al256(size_t x) { return (x + 255) & ~(size_t)255; }
constexpr size_t SZ_BIAS_GU = (size_t)3 * 2 * FF * 4, SZ_BIAS_IN = (size_t)3 * NINP * 4;
constexpr size_t WS_CTL = 0;
constexpr size_t WS_BIAS = 65536;
constexpr size_t SZ_BIAS_L = 2 * SZ_BIAS_GU + SZ_BIAS_IN;
constexpr size_t WS_ROWSS = al256(WS_BIAS + NL * SZ_BIAS_L);
constexpr size_t WS_ZERO_END = al256(WS_ROWSS + (size_t)NL * 3 * M * 4);
constexpr size_t WS_MODV = WS_ZERO_END;
constexpr size_t WS_GS = al256(WS_MODV + (size_t)NL * 3 * 9 * D * 4);
constexpr size_t WS_GATE = al256(WS_GS + (size_t)NL * 9 * D * 4);
constexpr size_t WS_ROPE = al256(WS_GATE + (size_t)NL * 9 * D * 4);
constexpr size_t SZ_WGU = (size_t)2 * FF * D * 2, SZ_WD = (size_t)D * FF * 2, SZ_WIN = (size_t)NINP * D * 2, SZ_WOUT = (size_t)D * D * 2, SZ_WGLU = (size_t)GW * GW * 2;
constexpr size_t OFF_W1GU = 0, OFF_W1D = OFF_W1GU + SZ_WGU, OFF_WIN = OFF_W1D + SZ_WD, OFF_WOUT = OFF_WIN + SZ_WIN, OFF_W2GU = OFF_WOUT + SZ_WOUT, OFF_W2D = OFF_W2GU + SZ_WGU, OFF_WGLU = OFF_W2D + SZ_WD, SZ_WL = OFF_WGLU + SZ_WGLU;
constexpr size_t WS_W = al256(WS_ROPE + 128 * 16 * 8);
constexpr size_t SZ_S5KC = (size_t)S5G * 2 * S5L * 256 * 4, SZ_S5ET = (size_t)S5G * 256 * 512 * 2, SZ_S5BT = (size_t)S5G * 512 * S5K * 2, SZ_S5LAM = (size_t)2 * GW * 4 * 8;
constexpr size_t SZ_S5LP = (size_t)2 * S5G * 64 * (S5L + 1) * 8, SZ_S5BETA = (size_t)2 * S5G * 64 * 16 * 8;
constexpr size_t OFF_S5KC = 0, OFF_S5ET = OFF_S5KC + SZ_S5KC, OFF_S5BT = OFF_S5ET + SZ_S5ET, OFF_S5LAM = OFF_S5BT + SZ_S5BT, OFF_S5LP = al256(OFF_S5LAM + SZ_S5LAM), OFF_S5BETA = OFF_S5LP + SZ_S5LP, SZ_S5L = al256(OFF_S5BETA + SZ_S5BETA);
constexpr size_t WS_S5T = al256(WS_W + NL * SZ_WL);
constexpr size_t WS_XC = al256(WS_S5T + NL * SZ_S5L);
constexpr size_t WS_AP = al256(WS_XC + (size_t)M_CTX * D * 4);
constexpr size_t WS_H = al256(WS_AP + (size_t)M * D * 2);
constexpr size_t WS_QA = al256(WS_H + (size_t)M * FF * 2);
constexpr size_t WS_KA = WS_QA + (size_t)M * GW * 2, WS_VA = WS_KA + (size_t)M * GW * 2, WS_QC = WS_VA + (size_t)M * GW * 2;
constexpr size_t WS_KC = WS_QC + (size_t)M * GW * 2, WS_VC = WS_KC + (size_t)M * 128 * 2;
constexpr size_t WS_PB = WS_VC + (size_t)M * 128 * 2;
constexpr size_t WS_PS = al256(WS_PB + (size_t)M * 3 * GW * 2);
constexpr size_t WS_UG = al256(WS_PS + (size_t)M * 160 * 4);
constexpr size_t WS_RW = al256(WS_UG + (size_t)S5G * NCHP * S5K * 2);
constexpr size_t SZ_RWA = (size_t)M * GW * 4;
enum { RW_R = 0, RW_V, RW_NKK, RW_G, RW_W0, RW_W1, RW_K0, RW_K1, RW_B0, RW_B1, RW_Y0, RW_Y1, RW_NARR };
constexpr size_t WS_XEND = al256(WS_RW + 256);
constexpr size_t WS_YG = al256(WS_XEND + (size_t)S5G * NCHP * 256 * 4);
constexpr size_t WS_OB = al256(WS_YG + (size_t)M * GW * 2);
constexpr int RCK = (TC + T) / 64, RSTR = NB * NH * 2, RITEM = RSTR * RCK;
constexpr size_t WS_QH = al256(WS_OB + (size_t)M * D * 2);
constexpr size_t WS_YL = al256(WS_QH + (size_t)RITEM * 8192);
constexpr size_t WS_MF = al256(WS_YL + (size_t)RITEM * 16384);
constexpr size_t WS_GF = al256(WS_MF + (size_t)RITEM * 8192);
constexpr size_t WS_SF = al256(WS_GF + (size_t)RITEM * 16384);
constexpr int RBLK = NB * NH * ((TC + T) / 64);
constexpr size_t WS_RVKG = al256(WS_SF + (size_t)RITEM * 8192);
constexpr size_t SZ_RWF = (size_t)14 * NH * 2 * 64 * 16;
constexpr size_t WS_RWF = al256(WS_RVKG + (size_t)RBLK * 32768);
constexpr size_t WS_RWS = al256(WS_RWF + NL * SZ_RWF);
constexpr size_t WS_END = al256(WS_RWS + (size_t)512 * 2 * 65536);
constexpr int CW_BAR = 1024;

constexpr int LDS_BYTES = 147456, RING_BYTES = 131072, MISC_OFF = LDS_BYTES - 256;

DI unsigned f2bf(float f) { unsigned u = __float_as_uint(f); return (u + 0x7fffu + ((u >> 16) & 1u)) >> 16; }
#ifdef EMU
DI unsigned pk2(float lo, float hi) { return f2bf(lo) | (f2bf(hi) << 16); }
#else
typedef __bf16 hbf16x2 __attribute__((ext_vector_type(2)));
DI unsigned pk2(float lo, float hi) { const f32x2 v = {lo, hi}; const hbf16x2 b = __builtin_convertvector(v, hbf16x2); return __builtin_bit_cast(unsigned, b); }
#endif
DI float bf2f(unsigned short b) { return __uint_as_float(((unsigned)b) << 16); }
DI float bflo(unsigned w) { return __uint_as_float(w << 16); }
DI float bfhi(unsigned w) { return __uint_as_float(w & 0xffff0000u); }
template <int N> DI float ror_add(float v) { return v + __int_as_float(__builtin_amdgcn_mov_dpp(__float_as_int(v), 0x120 + N, 0xf, 0xf, true)); }
DI float row16_sum(float v) { v = ror_add<8>(v); v = ror_add<4>(v); v = ror_add<2>(v); v = ror_add<1>(v); return v; }
DI float wave_sum(float v) {
    v = row16_sum(v);
    const float a = __int_as_float(__builtin_amdgcn_readlane(__float_as_int(v), 0)), b = __int_as_float(__builtin_amdgcn_readlane(__float_as_int(v), 16)),
                c = __int_as_float(__builtin_amdgcn_readlane(__float_as_int(v), 32)), d = __int_as_float(__builtin_amdgcn_readlane(__float_as_int(v), 48));
    return (a + b) + (c + d);
}
DI float siluf(float x) { return x * __builtin_amdgcn_rcpf(1.f + __expf(-x)); }
DI float fast_tanh(float x) { const float e = __expf(2.f * x); return 1.f - 2.f * __builtin_amdgcn_rcpf(e + 1.f); }
DI float sigmf(float x) { return __builtin_amdgcn_rcpf(1.f + __expf(-x)); }
DI float geluf(float x) { const float z = 0.7978845608028654f * (x + 0.044715f * x * x * x); const float e = __expf(2.f * z); return 0.5f * x * (1.f + (1.f - 2.f * __builtin_amdgcn_rcpf(e + 1.f))); }
DI int stream_of_row(int row) { return row < M_LAT ? row / T : NB; }
DI int stream_of_panel(int pm) { return stream_of_row(pm * 256); }

#define XB_TMO      128
#define XB_XCNT(j)  (256  + 64 * (j))
#define XB_XSUB(j)  (1280 + 64 * (j))
#define XB_XGEN(j)  (2304 + 64 * (j))
#define XB_TOP      3328
#define XB_TOPGEN   3392
#define XCD_BAR_WORDS 3456
#define XB_SPIN_CAP (1u << 18)
DI unsigned xb_ld(unsigned* p)              { return __hip_atomic_load(p, __ATOMIC_RELAXED, __HIP_MEMORY_SCOPE_AGENT); }
DI unsigned xb_add(unsigned* p, unsigned v) { return __hip_atomic_fetch_add(p, v, __ATOMIC_RELAXED, __HIP_MEMORY_SCOPE_AGENT); }
DI unsigned xb_xcc_id() { return (unsigned)__builtin_amdgcn_s_getreg((3 << 11) | 20) & 0xFu; }
#define XB_SPIN(cond, bar) do { unsigned _sp = 0; while (cond) { __builtin_amdgcn_s_sleep(1); \
    if ((++_sp & 255u) == 0u) { if (xb_ld(&(bar)[XB_TMO])) break; if (_sp > XB_SPIN_CAP) { atomicAdd(&(bar)[XB_TMO], 1u); break; } } } } while (0)
struct XcdBarrier { unsigned* bar; unsigned x; volatile LAS unsigned* st; };
DI XcdBarrier xcd_barrier_post(unsigned* bar, volatile LAS unsigned* st) {
    XcdBarrier b; b.bar = bar; b.x = xb_xcc_id(); b.st = st;
    if (threadIdx.x == 0) (void)xb_add(&bar[XB_XCNT(b.x)], 1u);
    return b;
}
DI void xcd_barrier_complete(unsigned* bar, unsigned x, unsigned& nloc, unsigned& nx) {
    const unsigned G = gridDim.x * gridDim.y * gridDim.z;
    unsigned sum, cnt, mine, sp = 0u;
    for (;;) {
        sum = 0u; cnt = 0u; mine = 0u;
#pragma unroll
        for (unsigned j = 0; j < 16; ++j) { const unsigned c = xb_ld(&bar[XB_XCNT(j)]); sum += c; cnt += (c > 0u) ? 1u : 0u; mine = (j == x) ? c : mine; }
        if (sum == G) break;
        __builtin_amdgcn_s_sleep(1);
        if ((++sp & 255u) == 0u) { if (xb_ld(&bar[XB_TMO])) break; if (sp > XB_SPIN_CAP) { atomicAdd(&bar[XB_TMO], 1u); break; } }
    }
    nloc = mine > 0u ? mine : 1u; nx = cnt > 0u ? cnt : 1u;
}
DI void xcd_barrier(const XcdBarrier& b) {
    ASMV("s_waitcnt vmcnt(0)" ::: "memory");
    __syncthreads();
    if (threadIdx.x == 0) {
        unsigned* bar = b.bar;
        __builtin_amdgcn_s_waitcnt(0);
        unsigned nloc = b.st[0], nx = b.st[1];
        if (nloc == 0u) { xcd_barrier_complete(bar, b.x, nloc, nx); b.st[0] = nloc; b.st[1] = nx; }
        const unsigned old = xb_add(&bar[XB_XSUB(b.x)], 1u);
        const unsigned gen = old / nloc;
        if (old + 1u == (gen + 1u) * nloc) {
            __builtin_amdgcn_fence(__ATOMIC_RELEASE, "agent");
            ASMV("s_waitcnt vmcnt(0)" ::: "memory");
            const unsigned og = xb_add(&bar[XB_TOP], 1u);
            const unsigned tg = og / nx;
            if (og + 1u == (tg + 1u) * nx) xb_add(&bar[XB_TOPGEN], 1u);
            else XB_SPIN(xb_ld(&bar[XB_TOPGEN]) == tg, bar);
            __builtin_amdgcn_fence(__ATOMIC_ACQUIRE, "agent");
            xb_add(&bar[XB_XGEN(b.x)], 1u);
            ASMV("s_waitcnt vmcnt(0)" ::: "memory");
        } else {
            XB_SPIN(xb_ld(&bar[XB_XGEN(b.x)]) == gen, bar);
            __builtin_amdgcn_fence(__ATOMIC_ACQUIRE, "agent");
            ASMV("s_waitcnt vmcnt(0)" ::: "memory");
        }
    }
    __syncthreads();
}

constexpr int BK = 64, HALF = 128, HTB = HALF * BK * 2, NXCD = 8, WGM = 4;
DI int lds_byte(int r, int c) { const int st = (r >> 4) * 2 + (c >> 5), rr = r & 15, cc = c & 31, ob = rr * 64 + cc * 2; return st * 1024 + (ob ^ (((ob >> 9) & 1) << 5)); }
DI void stage_rc(int b, int& R, int& C) { const int st = b / 1024, sb = b % 1024, swz = sb ^ (((sb >> 9) & 1) << 5); R = (st >> 1) * 16 + swz / 64; C = (st & 1) * 32 + (swz % 64) / 2; }
struct Unit { int pm, pn, z, kt0; };
struct Gemm { const bf16* A; const bf16* Bt; int lda, ldb, K; size_t zA, zB; };
struct Order {
    int nM, nN, nZ, per, total, G, c, nkt, pm0, spl;
    DI void init(int nM_, int nN_, int nZ_, int G_, int c_, int nkt_) { nM = nM_; nN = nN_; nZ = nZ_; per = nM * nN; total = per * nZ; G = G_; c = c_; nkt = nkt_; pm0 = 0; spl = 0; }
    DI void init_split(int pm0_, int xM, int nN_, int spl_, int G_, int c_, int nkt_full) { nM = xM; nN = nN_; nZ = 1; per = xM * nN_ * spl_; total = per; G = G_; c = c_; nkt = nkt_full / spl_; pm0 = pm0_; spl = spl_; }
    DI bool next(int i, Unit& u) const {
        const long L = (long)i * G + c; if (L >= total) return false;
        if (spl) { const int j = (int)L; u.z = 0; u.pm = pm0 + j / (nN * spl); const int rem = j % (nN * spl); u.pn = rem / spl; u.kt0 = (rem % spl) * nkt; return true; }
        u.kt0 = 0;
        u.z = (int)(L / per); int wgid = (int)(L % per);
        { const int q = per / NXCD, r = per % NXCD, xcd = wgid % NXCD, off = wgid / NXCD; wgid = (xcd < r ? xcd * (q + 1) : r * (q + 1) + (xcd - r) * q) + off; }
        const int nig = WGM * nN, gid = wgid / nig, fm = gid * WGM, gsz = (nM - fm) < WGM ? (nM - fm) : WGM;
        u.pm = fm + ((wgid % nig) % gsz); u.pn = (wgid % nig) / gsz; return true;
    }
};

template <class Epi>
DI void gemm_phase(LAS unsigned char* lds, const Gemm g, const Order& S, const Epi& E) {
    int tid_ = threadIdx.x; OPAQUE(tid_);
    const int tid = tid_, wid = __builtin_amdgcn_readfirstlane(tid >> 6), lane = tid & 63, wr = wid >> 2, wc = wid & 3, fr = lane & 15, fq = lane >> 4;
    Unit cur, nxt; int ui = 0;
    if (!S.next(0, cur)) return;
    f32x4 acc[2][2][4][2];
#ifdef EMU
    (void)lds;
    for (;; ++ui) {
        if (ui > 0) { if (!S.next(ui, cur)) break; }
        const bf16* A = (const bf16*)((const char*)g.A + cur.z * g.zA); const bf16* B = (const bf16*)((const char*)g.Bt + cur.z * g.zB);
        for (int ai = 0; ai < 2; ++ai) for (int bj = 0; bj < 2; ++bj) for (int m = 0; m < 4; ++m) for (int n = 0; n < 2; ++n) for (int j = 0; j < 4; ++j) {
            const int r = 256 * cur.pm + 128 * ai + 64 * wr + 16 * m + fr, c = 256 * cur.pn + 128 * bj + 32 * wc + 16 * n + 4 * fq + j;
            const bf16* a = A + (size_t)r * g.lda; const bf16* b = B + (size_t)c * g.ldb; float s = 0.f;
            for (int k = cur.kt0 * BK; k < (cur.kt0 + S.nkt) * BK; ++k) s += bf2f(a[k]) * bf2f(b[k]);
            acc[ai][bj][m][n][j] = s; }
        E(acc, cur, wr, wc, fr, fq);
    }
#else
    unsigned voffA[2], voffB[2];
#pragma unroll
    for (int i = 0; i < 2; ++i) { int R, C; stage_rc(tid * 16 + i * 8192, R, C); voffA[i] = (unsigned)(R * g.lda + C) * 2u; voffB[i] = (unsigned)(R * g.ldb + C) * 2u; }
    const size_t kstep = (size_t)(BK * 2);
    const size_t hstepA = (size_t)HALF * g.lda * 2, hstepB = (size_t)HALF * g.ldb * 2, tstepA = 2 * hstepA, tstepB = 2 * hstepB;
    const unsigned ldsw = (unsigned)wid * 1024u;
    const int aoff = lds_byte(wr * 64 + fr, fq * 8), boff = lds_byte(wc * 32 + fr, fq * 8);
#define PG8_SA(b, h) (((b) * 2 + (h)) * HTB)
#define PG8_SB(b, h) ((4 + (b) * 2 + (h)) * HTB)
#define PG8_STAGE(bufoff, gbase, voff) do { _Pragma("unroll") for (int _i = 0; _i < 2; ++_i) \
        __builtin_amdgcn_global_load_lds((const unsigned*)((const char*)(gbase) + (voff)[_i]), (LAS unsigned*)(lds + (bufoff) + ldsw + _i * 8192), 16, 0, 0); } while (0)
#define PG8_LDA(dst, b, h) do { _Pragma("unroll") for (int m = 0; m < 4; ++m) _Pragma("unroll") for (int k = 0; k < 2; ++k) dst[m][k] = *(const LAS bf16x8*)(lds + PG8_SA(b, h) + aoff + m * 2048 + k * 1024); } while (0)
#define PG8_LDB(dst, b, h) do { _Pragma("unroll") for (int n = 0; n < 2; ++n) _Pragma("unroll") for (int k = 0; k < 2; ++k) dst[n][k] = *(const LAS bf16x8*)(lds + PG8_SB(b, h) + boff + n * 2048 + k * 1024); } while (0)
#define PG8_MMA(ai, bj, At, Bt) do { __builtin_amdgcn_s_setprio(1); _Pragma("unroll") for (int m = 0; m < 4; ++m) _Pragma("unroll") for (int n = 0; n < 2; ++n) _Pragma("unroll") for (int k = 0; k < 2; ++k) \
        acc[ai][bj][m][n] = __builtin_amdgcn_mfma_f32_16x16x32_bf16(Bt[n][k], At[m][k], acc[ai][bj][m][n], 0, 0, 0); __builtin_amdgcn_s_setprio(0); } while (0)
#define PG8_WAIT_V(n) asm volatile("s_waitcnt vmcnt(" #n ")" ::: "memory")
#define PG8_WAIT_L(n) asm volatile("s_waitcnt lgkmcnt(" #n ")" ::: "memory")
#define PG8_BAR __builtin_amdgcn_s_barrier()
#define PG8_SCHED __builtin_amdgcn_sched_barrier(0)
#pragma unroll
    for (int a = 0; a < 2; ++a)
#pragma unroll
        for (int b = 0; b < 2; ++b)
#pragma unroll
            for (int m = 0; m < 4; ++m)
#pragma unroll
                for (int n = 0; n < 2; ++n) acc[a][b][m][n] = (f32x4){0.f, 0.f, 0.f, 0.f};
    bf16x8 At[4][2], B0[2][2], B1[2][2];
    const char* cA = (const char*)g.A + (size_t)cur.z * g.zA + (size_t)cur.pm * tstepA + (size_t)cur.kt0 * kstep; const char* cB = (const char*)g.Bt + (size_t)cur.z * g.zB + (size_t)cur.pn * tstepB + (size_t)cur.kt0 * kstep;
    PG8_STAGE(PG8_SB(0, 0), cB, voffB); PG8_STAGE(PG8_SB(0, 1), cB + hstepB, voffB); PG8_STAGE(PG8_SA(0, 0), cA, voffA); PG8_STAGE(PG8_SA(0, 1), cA + hstepA, voffA);
    if (wr == 1) PG8_BAR;
    PG8_WAIT_V(2); PG8_BAR;
    PG8_STAGE(PG8_SB(1, 0), cB + kstep, voffB); PG8_STAGE(PG8_SA(1, 0), cA + kstep, voffA); PG8_STAGE(PG8_SB(1, 1), cB + hstepB + kstep, voffB);
    PG8_WAIT_V(6); PG8_BAR;
    for (;;) {
        const bool has_next = S.next(ui + 1, nxt);
        const char* nA = has_next ? (const char*)g.A + (size_t)nxt.z * g.zA + (size_t)nxt.pm * tstepA + (size_t)nxt.kt0 * kstep : cA; const char* nB = has_next ? (const char*)g.Bt + (size_t)nxt.z * g.zB + (size_t)nxt.pn * tstepB + (size_t)nxt.kt0 * kstep : cB;
        const int nt = S.nkt;
        for (int t = 0; t < nt; t += 2) {
            const bool last = (t == nt - 2);
            const char* a1 = cA + (size_t)(t + 1) * kstep;
            const char* a2 = last ? nA : cA + (size_t)(t + 2) * kstep; const char* b2 = last ? nB : cB + (size_t)(t + 2) * kstep;
            const char* a3 = a2 + kstep; const char* b3 = b2 + kstep;
            PG8_LDB(B0, 0, 0); PG8_LDB(B1, 0, 1); PG8_SCHED; PG8_LDA(At, 0, 0); PG8_STAGE(PG8_SA(1, 1), a1 + hstepA, voffA);
            PG8_WAIT_V(8); PG8_WAIT_L(0); PG8_BAR; PG8_MMA(0, 0, At, B0); PG8_MMA(0, 1, At, B1); PG8_BAR; PG8_SCHED;
            PG8_LDA(At, 0, 1); PG8_STAGE(PG8_SB(0, 0), b2, voffB); PG8_STAGE(PG8_SB(0, 1), b2 + hstepB, voffB); PG8_STAGE(PG8_SA(0, 0), a2, voffA);
            PG8_WAIT_V(8); PG8_WAIT_L(0); PG8_BAR; PG8_MMA(1, 0, At, B0); PG8_MMA(1, 1, At, B1); PG8_BAR; PG8_SCHED;
            PG8_LDB(B0, 1, 0); PG8_LDB(B1, 1, 1); PG8_SCHED; PG8_LDA(At, 1, 0); PG8_STAGE(PG8_SA(0, 1), a2 + hstepA, voffA);
            PG8_WAIT_V(8); PG8_WAIT_L(0); PG8_BAR; PG8_MMA(0, 0, At, B0); PG8_MMA(0, 1, At, B1); PG8_BAR; PG8_SCHED;
            PG8_LDA(At, 1, 1); PG8_STAGE(PG8_SB(1, 0), b3, voffB); PG8_STAGE(PG8_SB(1, 1), b3 + hstepB, voffB); PG8_STAGE(PG8_SA(1, 0), a3, voffA);
            PG8_WAIT_V(8); PG8_WAIT_L(0); PG8_BAR; PG8_MMA(1, 0, At, B0); PG8_MMA(1, 1, At, B1); PG8_BAR; PG8_SCHED;
        }
        if (wr == 0) PG8_BAR;
        E(acc, cur, wr, wc, fr, fq);
        if (!has_next) break;
#pragma unroll
        for (int a = 0; a < 2; ++a)
#pragma unroll
            for (int b = 0; b < 2; ++b)
#pragma unroll
                for (int m = 0; m < 4; ++m)
#pragma unroll
                    for (int n = 0; n < 2; ++n) acc[a][b][m][n] = (f32x4){0.f, 0.f, 0.f, 0.f};
        cur = nxt; cA = nA; cB = nB; ++ui;
        if (wr == 1) PG8_BAR;
    }
    PG8_WAIT_V(0);
    PG8_BAR;
#undef PG8_SA
#undef PG8_SB
#undef PG8_STAGE
#undef PG8_LDA
#undef PG8_LDB
#undef PG8_MMA
#undef PG8_WAIT_V
#undef PG8_WAIT_L
#undef PG8_BAR
#undef PG8_SCHED
#endif
}

struct Args {
    const float* in[42]; float* out; unsigned char* ws;
    int ph_lo, ph_hi;
};
struct Ctx {
    const float* const* in; float* out; unsigned char* ws;
    LAS unsigned char* lds; int tid, lane, wave, G, bid;
};
DI float* xrow_ptr(const Ctx& C, int row) { return row < M_LAT ? C.out + (size_t)row * D : (float*)(C.ws + WS_XC) + (size_t)(row - M_LAT) * D; }
DI const bf16* wl(const Ctx& C, int l, size_t off) { return (const bf16*)(C.ws + WS_W + (size_t)l * SZ_WL + off); }
DI float* bias_ptr(const Ctx& C, int l, int which  ) { return (float*)(C.ws + WS_BIAS + (size_t)l * SZ_BIAS_L + (which == 0 ? 0 : which == 1 ? SZ_BIAS_GU : SZ_BIAS_GU + SZ_BIAS_IN)); }
DI float* rowss_ptr(const Ctx& C, int l, int sub) { return (float*)(C.ws + WS_ROWSS) + ((size_t)l * 3 + sub) * M; }
DI const float* gs_ptr(const Ctx& C, int l, int sub, int s) { return (const float*)(C.ws + WS_GS) + (((size_t)l * 3 + sub) * 3 + s) * D; }
DI const float* gate_ptr(const Ctx& C, int l, int sub, int s) { return (const float*)(C.ws + WS_GATE) + (((size_t)l * 3 + sub) * 3 + s) * D; }
DI float* rw_arr(const Ctx& C, int a) { return (float*)(C.ws + WS_RW + (size_t)a * SZ_RWA); }
enum { I_X = 0, I_C, I_CTX, I_CCTX, I_WADA, I_BADA, I_NORMG, I_F1WG, I_F1WU, I_F1WD, I_F2WG, I_F2WU, I_F2WD, I_WIN, I_WOUT, I_NAQG, I_NAKG, I_NARPB, I_RWCONV, I_RWW0, I_RWWUP, I_RWA0, I_RWAUP,
       I_RWGUP, I_RWKK, I_RWKA, I_RWRK, I_RWGNW, I_RWGNB, I_WAQG, I_WAKG, I_WASINK, I_S5ARE, I_S5AIM, I_S5LDT, I_S5BRE, I_S5BIM, I_S5CRE, I_S5CIM, I_S5D, I_S5GLUW, I_S5GLUB, I_NIN };

struct EpiGU {
    const float* rowss; const float* bias  ; bf16* H; int mrows;
    DI void operator()(const f32x4 (&acc)[2][2][4][2], const Unit& u, int wr, int wc, int fr_, int fq_) const {
        int tz_ = threadIdx.x; OPAQUE(tz_); const int fr = tz_ & 15, fq = (tz_ & 63) >> 4; (void)fr_; (void)fq_;
        const int s = stream_of_panel(u.pm); const float* bs = bias + (size_t)s * 2 * FF + u.pn * 256 + wc * 32 + 4 * fq;
        f32x4 bg[2], bu[2];
#pragma unroll
        for (int n = 0; n < 2; ++n) { bg[n] = *(const f32x4*)(bs + 16 * n); bu[n] = *(const f32x4*)(bs + 128 + 16 * n); }
        float rsv[2][4];
#pragma unroll
        for (int ai = 0; ai < 2; ++ai)
#pragma unroll
            for (int m = 0; m < 4; ++m) rsv[ai][m] = rowss[u.pm * 256 + ai * 128 + wr * 64 + m * 16 + fr];
#pragma unroll
        for (int ai = 0; ai < 2; ++ai)
#pragma unroll
            for (int m = 0; m < 4; ++m) {
                const int row = u.pm * 256 + ai * 128 + wr * 64 + m * 16 + fr;
                const float rstd = __builtin_amdgcn_rsqf(rsv[ai][m] * (1.0f / D) + NORM_EPS);
                bf16* hp = H + (size_t)row * FF + u.pn * 128 + wc * 32 + 8 * fq;
                u32x4 w;
                { const f32x4 g = acc[ai][0][m][0] * rstd + bg[0], v = acc[ai][1][m][0] * rstd + bu[0]; w.x = pk2(siluf(g[0]) * v[0], siluf(g[1]) * v[1]); w.y = pk2(siluf(g[2]) * v[2], siluf(g[3]) * v[3]); }
                { const f32x4 g = acc[ai][0][m][1] * rstd + bg[1], v = acc[ai][1][m][1] * rstd + bu[1]; w.z = pk2(siluf(g[0]) * v[0], siluf(g[1]) * v[1]); w.w = pk2(siluf(g[2]) * v[2], siluf(g[3]) * v[3]); }
                *(u32x4*)hp = w;
            }
    }
};
struct EpiRes {
    const Ctx* C; const float* gate  ; const float* gsn  ; float* rowss_next; bf16* AP;
    DI void operator()(const f32x4 (&acc)[2][2][4][2], const Unit& u, int wr, int wc, int fr_, int fq_) const {
        int tz_ = threadIdx.x; OPAQUE(tz_); const int fr = tz_ & 15, fq = (tz_ & 63) >> 4; (void)fr_; (void)fq_;
        const int s = stream_of_panel(u.pm); const int col0 = u.pn * 256 + wc * 32 + 4 * fq;
        f32x4 gv[2][2], sv[2][2];
#pragma unroll
        for (int bj = 0; bj < 2; ++bj)
#pragma unroll
            for (int n = 0; n < 2; ++n) { gv[bj][n] = *(const f32x4*)(gate + (size_t)s * D + col0 + bj * 128 + n * 16); sv[bj][n] = gsn ? *(const f32x4*)(gsn + (size_t)s * D + col0 + bj * 128 + n * 16) : (f32x4){0.f, 0.f, 0.f, 0.f}; }
        f32x4 xc[2][2], xn[2][2];
        { const float* xp0 = xrow_ptr(*C, u.pm * 256 + wr * 64 + fr) + col0;
#pragma unroll
          for (int bj = 0; bj < 2; ++bj)
#pragma unroll
              for (int n = 0; n < 2; ++n) xn[bj][n] = *(const f32x4*)(xp0 + bj * 128 + n * 16); }
#pragma unroll
        for (int ai = 0; ai < 2; ++ai)
#pragma unroll
            for (int m = 0; m < 4; ++m) {
                const int row = u.pm * 256 + ai * 128 + wr * 64 + m * 16 + fr;
                float* xp = xrow_ptr(*C, row) + col0; float ss = 0.f;
#pragma unroll
                for (int bj = 0; bj < 2; ++bj)
#pragma unroll
                    for (int n = 0; n < 2; ++n) xc[bj][n] = xn[bj][n];
                if (ai * 4 + m < 7) { const int rn = ai * 4 + m + 1; const float* xq = xrow_ptr(*C, u.pm * 256 + (rn >> 2) * 128 + wr * 64 + (rn & 3) * 16 + fr) + col0;
#pragma unroll
                    for (int bj = 0; bj < 2; ++bj)
#pragma unroll
                        for (int n = 0; n < 2; ++n) xn[bj][n] = *(const f32x4*)(xq + bj * 128 + n * 16); }
#pragma unroll
                for (int bj = 0; bj < 2; ++bj)
#pragma unroll
                    for (int n = 0; n < 2; ++n) { f32x4 x = xc[bj][n]; x += gv[bj][n] * acc[ai][bj][m][n]; *(f32x4*)(xp + bj * 128 + n * 16) = x;
                        if (gsn) { ss += (x[0] * x[0] + x[1] * x[1]) + (x[2] * x[2] + x[3] * x[3]); const f32x4 a = x * sv[bj][n]; u32x2 w; w.x = pk2(a[0], a[1]); w.y = pk2(a[2], a[3]);
                            *(u32x2*)(AP + (size_t)row * D + col0 + bj * 128 + n * 16) = w; } }
                if (gsn) { ss += __shfl_xor(ss, 16); ss += __shfl_xor(ss, 32); if (fq == 0) atomicAdd(rowss_next + row, ss); }
            }
    }
};
struct EpiAcc {
    const Ctx* C; const float* gate;
    DI void operator()(const f32x4 (&acc)[2][2][4][2], const Unit& u, int wr, int wc, int fr_, int fq_) const {
        int tz_ = threadIdx.x; OPAQUE(tz_); const int fr = tz_ & 15, fq = (tz_ & 63) >> 4; (void)fr_; (void)fq_;
        const int s = stream_of_panel(u.pm); const int col0 = u.pn * 256 + wc * 32 + 4 * fq;
#pragma unroll
        for (int bj = 0; bj < 2; ++bj)
#pragma unroll
            for (int n = 0; n < 2; ++n) { const f32x4 gv = *(const f32x4*)(gate + (size_t)s * D + col0 + bj * 128 + n * 16);
#pragma unroll
                for (int ai = 0; ai < 2; ++ai)
#pragma unroll
                    for (int m = 0; m < 4; ++m) { float* xp = xrow_ptr(*C, u.pm * 256 + ai * 128 + wr * 64 + m * 16 + fr) + col0 + bj * 128 + n * 16; const f32x4 d = gv * acc[ai][bj][m][n];
#pragma unroll
                        for (int j = 0; j < 4; ++j) atomicAdd(xp + j, d[j]); } }
    }
};
struct EpiIn {
    const Ctx* C; const float* rowss; const float* bias  ; int l;
    DI void operator()(const f32x4 (&acc)[2][2][4][2], const Unit& u, int wr, int wc, int fr_, int fq_) const {
        int tz_ = threadIdx.x; OPAQUE(tz_); const int fr = tz_ & 15, fq = (tz_ & 63) >> 4; (void)fr_; (void)fq_;
        const int s = stream_of_panel(u.pm), pn = u.pn; const float* bs = bias + (size_t)s * NINP + pn * 256 + wc * 32 + 4 * fq;
        unsigned char* ws = C->ws;
        f32x4 bv[2][2];
#pragma unroll
        for (int bj = 0; bj < 2; ++bj)
#pragma unroll
            for (int n = 0; n < 2; ++n) bv[bj][n] = *(const f32x4*)(bs + bj * 128 + n * 16);
        float rsv[2][4];
#pragma unroll
        for (int ai = 0; ai < 2; ++ai)
#pragma unroll
            for (int m = 0; m < 4; ++m) rsv[ai][m] = rowss[u.pm * 256 + ai * 128 + wr * 64 + m * 16 + fr];
        const bool permuted = pn < PN_AV || (pn >= PN_CQ && pn < PN_DU);
        if (permuted) {
            const bool is_ckv = pn == PN_CKV, is_c = pn >= PN_CQ, is_q = pn < PN_AK || (pn >= PN_CQ && pn < PN_CKV);
            const bool plain_v = is_ckv && wc >= 2;
            const float* gsrc = C->in[is_c ? (is_q ? I_WAQG : I_WAKG) : (is_q ? I_NAQG : I_NAKG)] + (size_t)l * 64;
            f32x4 gn[2][2];
#pragma unroll
            for (int bj = 0; bj < 2; ++bj)
#pragma unroll
                for (int n = 0; n < 2; ++n) { gn[bj][n] = *(const f32x4*)(gsrc + 32 * bj + 16 * n + 4 * fq); if (is_q) gn[bj][n] *= 0.125f; }
            bf16* dst; int pitch, hcol;
            if (pn < PN_AK) { dst = (bf16*)(ws + WS_QA); pitch = GW; hcol = ((pn - PN_AQ) * 4 + wc) * 64; }
            else if (pn < PN_AV) { dst = (bf16*)(ws + WS_KA); pitch = GW; hcol = ((pn - PN_AK) * 4 + wc) * 64; }
            else if (pn < PN_CKV) { dst = (bf16*)(ws + WS_QC); pitch = GW; hcol = ((pn - PN_CQ) * 4 + wc) * 64; }
            else if (wc < 2) { dst = (bf16*)(ws + WS_KC); pitch = 128; hcol = wc * 64; }
            else { dst = (bf16*)(ws + WS_VC); pitch = 128; hcol = (wc - 2) * 64; }
            const f32x4* rope = (const f32x4*)(ws + WS_ROPE);
#pragma unroll
            for (int ai = 0; ai < 2; ++ai)
#pragma unroll
                for (int m = 0; m < 4; ++m) {
                    const int row = pn * 0 + u.pm * 256 + ai * 128 + wr * 64 + m * 16 + fr;
                    const float rstd = __builtin_amdgcn_rsqf(rsv[ai][m] * (1.0f / D) + NORM_EPS);
                    f32x4 v[2][2]; float ss = 0.f;
#pragma unroll
                    for (int bj = 0; bj < 2; ++bj)
#pragma unroll
                        for (int n = 0; n < 2; ++n) { v[bj][n] = acc[ai][bj][m][n] * rstd + bv[bj][n]; ss += (v[bj][n][0] * v[bj][n][0] + v[bj][n][1] * v[bj][n][1]) + (v[bj][n][2] * v[bj][n][2] + v[bj][n][3] * v[bj][n][3]); }
                    ss += __shfl_xor(ss, 16); ss += __shfl_xor(ss, 32);
                    if (!plain_v) { const float rs = 1.0f / sqrtf(ss * (1.0f / 64.0f) + NORM_EPS);
#pragma unroll
                        for (int bj = 0; bj < 2; ++bj)
#pragma unroll
                            for (int n = 0; n < 2; ++n) v[bj][n] = v[bj][n] * rs * gn[bj][n];
                        if (is_c && row < M_LAT) {
                            const int t = row % T; const int pos[2] = {t / GRW, t % GRW};
#pragma unroll
                            for (int bj = 0; bj < 2; ++bj) { const f32x4 cs0 = rope[(pos[bj] * 16 + 4 * fq) / 2], cs1 = rope[(pos[bj] * 16 + 4 * fq) / 2 + 1];
                                const float cc[4] = {cs0[0], cs0[2], cs1[0], cs1[2]}, sn[4] = {cs0[1], cs0[3], cs1[1], cs1[3]};
#pragma unroll
                                for (int j = 0; j < 4; ++j) { const float x1 = v[bj][0][j], x2 = v[bj][1][j]; v[bj][0][j] = x1 * cc[j] - x2 * sn[j]; v[bj][1][j] = x2 * cc[j] + x1 * sn[j]; } }
                        }
                    }
                    bf16* op = dst + (size_t)row * pitch + hcol + 4 * fq;
#pragma unroll
                    for (int bj = 0; bj < 2; ++bj)
#pragma unroll
                        for (int n = 0; n < 2; ++n) { u32x2 w; w.x = pk2(v[bj][n][0], v[bj][n][1]); w.y = pk2(v[bj][n][2], v[bj][n][3]); *(u32x2*)(op + 32 * bj + 16 * n) = w; }
                }
        } else {
#pragma unroll
            for (int ai = 0; ai < 2; ++ai)
#pragma unroll
                for (int m = 0; m < 4; ++m) {
                    const int row = u.pm * 256 + ai * 128 + wr * 64 + m * 16 + fr;
                    const float rstd = __builtin_amdgcn_rsqf(rsv[ai][m] * (1.0f / D) + NORM_EPS);
#pragma unroll
                    for (int bj = 0; bj < 2; ++bj)
#pragma unroll
                        for (int n = 0; n < 2; ++n) { const f32x4 v = acc[ai][bj][m][n] * rstd + bv[bj][n]; const int c = bj * 128 + wc * 32 + n * 16 + 4 * fq;
                            u32x2 w; w.x = pk2(v[0], v[1]); w.y = pk2(v[2], v[3]);
                            if (pn < PN_BR) *(u32x2*)((bf16*)(ws + WS_VA) + (size_t)row * GW + (pn - PN_AV) * 256 + c) = w;
                            else if (pn < PN_BS) *(u32x2*)((bf16*)(ws + WS_PB) + (size_t)row * 3 * GW + (pn - PN_BR) * 256 + c) = w;
                            else if (pn == PN_BS) { if (c < 160) *(f32x4*)((float*)(ws + WS_PS) + (size_t)row * 160 + c) = v; }
                            else { const int cu = (pn - PN_DU) * 256 + c, gq = cu >> 4, p0 = cu & 15;
                                *(u32x2*)((bf16*)(ws + WS_UG) + ((size_t)gq * NCHP + row / S5L) * S5K + (row % S5L) * 16 + p0) = w; } }
                }
        }
    }
};
struct EpiS5A {
    float* XE;
    DI void operator()(const f32x4 (&acc)[2][2][4][2], const Unit& u, int wr, int wc, int fr_, int fq_) const {
        int tz_ = threadIdx.x; OPAQUE(tz_); const int fr = tz_ & 15, fq = (tz_ & 63) >> 4; (void)fr_; (void)fq_;
#pragma unroll
        for (int ai = 0; ai < 2; ++ai)
#pragma unroll
            for (int m = 0; m < 4; ++m) { const int ch = u.pm * 256 + ai * 128 + wr * 64 + m * 16 + fr; if (ch < NCH) { float* p = XE + ((size_t)u.z * NCHP + ch) * 256 + wc * 32 + 4 * fq;
#pragma unroll
                for (int bj = 0; bj < 2; ++bj)
#pragma unroll
                    for (int n = 0; n < 2; ++n) *(f32x4*)(p + bj * 128 + n * 16) = acc[ai][bj][m][n]; } }
    }
};
struct EpiS5C {
    const bf16* UG; const float* dsk  ; bf16* YG;
    DI void operator()(const f32x4 (&acc)[2][2][4][2], const Unit& u, int wr, int wc, int fr_, int fq_) const {
        int tz_ = threadIdx.x; OPAQUE(tz_); const int fr = tz_ & 15, fq = (tz_ & 63) >> 4; (void)fr_; (void)fq_;
        const int g = u.z;
#pragma unroll
        for (int ai = 0; ai < 2; ++ai)
#pragma unroll
            for (int m = 0; m < 4; ++m) { const int ch = u.pm * 256 + ai * 128 + wr * 64 + m * 16 + fr; if (ch < NCH) {
#pragma unroll
                for (int bj = 0; bj < 2; ++bj)
#pragma unroll
                    for (int n = 0; n < 2; ++n) { const int col = u.pn * 256 + bj * 128 + wc * 32 + n * 16 + 4 * fq, i = col >> 4, p0 = col & 15;
                        const u32x2 uw = *(const u32x2*)(UG + ((size_t)g * NCHP + ch) * S5K + col); const f32x4 dv = *(const f32x4*)(dsk + 16 * g + p0);
                        const f32x4 a = acc[ai][bj][m][n]; const float y0 = a[0] + dv[0] * bflo(uw.x), y1 = a[1] + dv[1] * bfhi(uw.x), y2 = a[2] + dv[2] * bflo(uw.y), y3 = a[3] + dv[3] * bfhi(uw.y);
                        u32x2 w; w.x = pk2(geluf(y0), geluf(y1)); w.y = pk2(geluf(y2), geluf(y3));
                        *(u32x2*)(YG + (size_t)(ch * S5L + i) * GW + 16 * g + p0) = w; } } }
    }
};
struct EpiGLU {
    const bf16* YG; const float* gb; bf16* OB;
    DI void operator()(const f32x4 (&acc)[2][2][4][2], const Unit& u, int wr, int wc, int fr_, int fq_) const {
        int tz_ = threadIdx.x; OPAQUE(tz_); const int fr = tz_ & 15, fq = (tz_ & 63) >> 4; (void)fr_; (void)fq_;
#pragma unroll
        for (int ai = 0; ai < 2; ++ai)
#pragma unroll
            for (int m = 0; m < 4; ++m) { const int row = u.pm * 256 + ai * 128 + wr * 64 + m * 16 + fr;
#pragma unroll
                for (int bj = 0; bj < 2; ++bj)
#pragma unroll
                    for (int n = 0; n < 2; ++n) { const int col = u.pn * 256 + bj * 128 + wc * 32 + n * 16 + 4 * fq; const f32x4 b = *(const f32x4*)(gb + col); const f32x4 a = acc[ai][bj][m][n] + b;
                        const u32x2 yw = *(const u32x2*)(YG + (size_t)row * GW + col);
                        u32x2 w; w.x = pk2(bflo(yw.x) * sigmf(a[0]), bfhi(yw.x) * sigmf(a[1])); w.y = pk2(bflo(yw.y) * sigmf(a[2]), bfhi(yw.y) * sigmf(a[3]));
                        *(u32x2*)(OB + (size_t)row * D + 3 * GW + col) = w; } }
    }
};

DI void ph_ada(const Ctx& C) {
    LAS float* sc = (LAS float*)C.lds;
    LAS float* red = sc + 3 * D;
    for (int i = C.tid; i < 3 * D; i += NTHR) { const int s = i / D, k = i % D; const float c = s < NB ? C.in[I_C][s * D + k] : C.in[I_CCTX][k]; sc[i] = siluf(c); }
    __syncthreads();
    const int nun = NL * (9 * D / 256);
    for (int un = C.bid; un < nun; un += C.G) {
        const int l = un / (9 * D / 256), col0 = (un % (9 * D / 256)) * 256;
        const float* W = C.in[I_WADA] + (size_t)l * D * 9 * D + col0 + 4 * C.lane;
        f32x4 a0 = {0.f, 0.f, 0.f, 0.f}, a1 = a0, a2 = a0;
        const int k0 = C.wave * (D / 8);
#pragma unroll 1
        for (int kb = k0; kb < k0 + D / 8; kb += 16) {
            f32x4 wv[16];
#pragma unroll
            for (int u = 0; u < 16; ++u) wv[u] = *(const f32x4*)(W + (size_t)(kb + u) * 9 * D);
#pragma unroll
            for (int u = 0; u < 16; ++u) { a0 += wv[u] * sc[kb + u]; a1 += wv[u] * sc[D + kb + u]; a2 += wv[u] * sc[2 * D + kb + u]; } }
        LAS float* r = red + C.wave * 768 + 4 * C.lane;
        *(LAS f32x4*)(r) = a0; *(LAS f32x4*)(r + 256) = a1; *(LAS f32x4*)(r + 512) = a2;
        __syncthreads();
        for (int i = C.tid; i < 768; i += NTHR) { float s = 0.f;
#pragma unroll
            for (int w = 0; w < 8; ++w) s += red[w * 768 + i];
            const int st = i / 256, c = col0 + (i % 256);
            ((float*)(C.ws + WS_MODV))[((size_t)l * 3 + st) * 9 * D + c] = s + C.in[I_BADA][(size_t)l * 9 * D + c]; }
        __syncthreads();
    }
}
DI const float* modv_ptr(const Ctx& C, int l, int s, int chunk) { return (const float*)(C.ws + WS_MODV) + ((size_t)l * 3 + s) * 9 * D + (size_t)chunk * D; }

DI int win_dest(int n) {
    if (n >= D_IN) return -1;
    if (n < SRC_AV) { const int piece = n / GW, loc = n % GW, head = loc / 64, d = loc % 64; return ((piece == 0 ? PN_AQ : PN_AK) + head / 4) * 256 + 128 * (d / 32) + 32 * (head % 4) + (d % 32); }
    if (n < SRC_BS) return PN_AV * 256 + (n - SRC_AV);
    if (n < SRC_CQ) return PN_BS * 256 + (n - SRC_BS);
    if (n < SRC_CK) { const int loc = n - SRC_CQ, head = loc / 64, d = loc % 64; return (PN_CQ + head / 4) * 256 + 128 * (d / 32) + 32 * (head % 4) + (d % 32); }
    if (n < SRC_DU) { const int loc = n - SRC_CK, hh = loc / 64, d = loc % 64; return PN_CKV * 256 + 128 * (d / 32) + 32 * hh + (d % 32); }
    return PN_DU * 256 + (n - SRC_DU);
}
DI int gu_dest(int n) { const int e = n & 31; return (n / 128) * 256 + (n % 128 - e) + 16 * ((e >> 2) & 1) + 4 * (e >> 3) + (e & 3); }
DI void conv_item(const Ctx& C, const float* W, int K, int N, bf16* Wt, int mode, int k0, int n0, float* bias, int bias_pitch, const float* shift  ) {
    LAS float* scr = (LAS float*)(C.lds + C.wave * 16640);
    const int n = n0 + C.lane; const bool ok = n < N; float b0 = 0.f, b1 = 0.f, b2 = 0.f;
#pragma unroll 1
    for (int kh = 0; kh < 4; ++kh) {
        float wv[16];
#pragma unroll
        for (int kk = 0; kk < 16; ++kk) wv[kk] = ok ? W[(size_t)(k0 + 16 * kh + kk) * N + n] : 0.f;
#pragma unroll
        for (int kk = 0; kk < 16; ++kk) { const float v = wv[kk]; scr[(16 * kh + kk) * 65 + C.lane] = v;
            if (bias) { b0 += shift[k0 + 16 * kh + kk] * v; b1 += shift[9 * D + k0 + 16 * kh + kk] * v; b2 += shift[18 * D + k0 + 16 * kh + kk] * v; } } }
    WSYNC();
    const int dme = !ok ? -1 : mode == 0 ? n : mode == 1 ? gu_dest(n) : mode == 2 ? gu_dest(n) + 128 : win_dest(n);
    if (bias && dme >= 0) { atomicAdd(bias + dme, b0); atomicAdd(bias + bias_pitch + dme, b1); atomicAdd(bias + 2 * bias_pitch + dme, b2); }
    const int c = C.lane & 7;
#pragma unroll
    for (int i = 0; i < 8; ++i) { const int nl = (C.lane >> 3) + 8 * i, nn = n0 + nl;
        const int dr = nn >= N ? -1 : mode == 0 ? nn : mode == 1 ? gu_dest(nn) : mode == 2 ? gu_dest(nn) + 128 : win_dest(nn);
        const LAS float* s = scr + (8 * c) * 65 + nl;
        u32x4 o; o.x = pk2(s[0], s[65]); o.y = pk2(s[2 * 65], s[3 * 65]); o.z = pk2(s[4 * 65], s[5 * 65]); o.w = pk2(s[6 * 65], s[7 * 65]);
        if (dr >= 0) *(u32x4*)(Wt + (size_t)dr * K + k0 + 8 * c) = o; }
    WSYNC();
}
struct Cplx { float re, im; };
DI Cplx cmul(Cplx a, Cplx b) { return Cplx{a.re * b.re - a.im * b.im, a.re * b.im + a.im * b.re}; }
DI Cplx s5_lam_pow(const Ctx& C, int l, int dir, int g, int n, float tau) {
    const size_t i = (((size_t)l * 2 + dir) * S5G + g) * 64 + n; const float dt = __expf(C.in[I_S5LDT][((size_t)l * 2 + dir) * S5G + g]);
    const float mag = __expf(tau * dt * C.in[I_S5ARE][i]), ang = tau * dt * C.in[I_S5AIM][i]; float sn, cs; sincosf(ang, &sn, &cs); return Cplx{mag * cs, mag * sn};
}
DI Cplx s5_coef(const Ctx& C, int l, int dir, int g, int n) {
    const size_t i = (((size_t)l * 2 + dir) * S5G + g) * 64 + n; const float are = C.in[I_S5ARE][i], aim = C.in[I_S5AIM][i];
    const Cplx ab = s5_lam_pow(C, l, dir, g, n, 1.0f); const float den = are * are + aim * aim, nr = ab.re - 1.0f;
    return Cplx{(nr * are + ab.im * aim) / den, (ab.im * are - nr * aim) / den};
}
DI Cplx s5_beta(const Ctx& C, int l, int dir, int g, int n, int q) {
    const size_t i = (((size_t)l * S5G + g) * 64 + n) * 16 + q; return cmul(s5_coef(C, l, dir, g, n), Cplx{C.in[I_S5BRE][i], C.in[I_S5BIM][i]});
}
DI Cplx s5_gamma(const Ctx& C, int l, int g, int p, int n) { const size_t i = (((size_t)l * S5G + g) * 16 + p) * 64 + n; return Cplx{C.in[I_S5CRE][i], C.in[I_S5CIM][i]}; }

#ifndef CONV_G1_PCT
#define CONV_G1_PCT 55
#endif
constexpr int CI_GU = (D / 64) * (FF / 64), CI_DN = (FF / 64) * (D / 64), CI_IN = (D / 64) * ((D_IN + 63) / 64), CI_OUT = (D / 64) * (D / 64), CI_GLU = (GW / 64) * (GW / 64);
constexpr int CI_LAYER = 4 * CI_GU + 2 * CI_DN + CI_IN + CI_OUT + CI_GLU, CI_X1 = (int)((long)CI_LAYER * CONV_G1_PCT / 100) & ~7;
DI void conv_weights(const Ctx& C, int l, int wslot, int nslots, int it_lo, int it_hi) {
    for (int it = it_lo + wslot; it < it_hi; it += nslots) {
        int r = it;
        unsigned char* wbase = C.ws + WS_W + (size_t)l * SZ_WL;
        if (r < 2 * CI_GU) { const int up = r >= CI_GU; r -= up * CI_GU; const int kb = r / (FF / 64), nb = r % (FF / 64);
            conv_item(C, C.in[up ? I_F1WU : I_F1WG] + (size_t)l * D * FF, D, FF, (bf16*)(wbase + OFF_W1GU), 1 + up, kb * 64, nb * 64, bias_ptr(C, l, 0), 2 * FF, modv_ptr(C, l, 0, 0)); continue; } r -= 2 * CI_GU;
        if (r < CI_DN) { const int kb = r / (D / 64), nb = r % (D / 64); conv_item(C, C.in[I_F1WD] + (size_t)l * FF * D, FF, D, (bf16*)(wbase + OFF_W1D), 0, kb * 64, nb * 64, nullptr, 0, nullptr); continue; } r -= CI_DN;
        if (r < CI_IN) { const int nbn = (D_IN + 63) / 64, kb = r / nbn, nb = r % nbn; conv_item(C, C.in[I_WIN] + (size_t)l * D * D_IN, D, D_IN, (bf16*)(wbase + OFF_WIN), 3, kb * 64, nb * 64, bias_ptr(C, l, 1), NINP, modv_ptr(C, l, 0, 3)); continue; } r -= CI_IN;
        if (r < CI_OUT) { const int kb = r / (D / 64), nb = r % (D / 64); conv_item(C, C.in[I_WOUT] + (size_t)l * D * D, D, D, (bf16*)(wbase + OFF_WOUT), 0, kb * 64, nb * 64, nullptr, 0, nullptr); continue; } r -= CI_OUT;
        if (r < 2 * CI_GU) { const int up = r >= CI_GU; r -= up * CI_GU; const int kb = r / (FF / 64), nb = r % (FF / 64);
            conv_item(C, C.in[up ? I_F2WU : I_F2WG] + (size_t)l * D * FF, D, FF, (bf16*)(wbase + OFF_W2GU), 1 + up, kb * 64, nb * 64, bias_ptr(C, l, 2), 2 * FF, modv_ptr(C, l, 0, 6)); continue; } r -= 2 * CI_GU;
        if (r < CI_DN) { const int kb = r / (D / 64), nb = r % (D / 64); conv_item(C, C.in[I_F2WD] + (size_t)l * FF * D, FF, D, (bf16*)(wbase + OFF_W2D), 0, kb * 64, nb * 64, nullptr, 0, nullptr); continue; } r -= CI_DN;
        { const int kb = r / (GW / 64), nb = r % (GW / 64); conv_item(C, C.in[I_S5GLUW] + (size_t)l * GW * GW, GW, GW, (bf16*)(wbase + OFF_WGLU), 0, kb * 64, nb * 64, nullptr, 0, nullptr); }
    }
}
DI void ph_conv(const Ctx& C) {
    const int gt = C.bid * NTHR + C.tid, GT = C.G * NTHR;
    for (int i = gt; i < NL * 9 * D; i += GT) { const int k = i % D, s = (i / D) % 3, sub = (i / (3 * D)) % 3, l = i / (9 * D);
        const float* mv = (const float*)(C.ws + WS_MODV) + ((size_t)l * 3 + s) * 9 * D;
        ((float*)(C.ws + WS_GS))[i] = C.in[I_NORMG][((size_t)l * 3 + sub) * D + k] * (1.0f + mv[(3 * sub + 1) * D + k]);
        ((float*)(C.ws + WS_GATE))[i] = mv[(3 * sub + 2) * D + k] * (sub == 1 ? 1.0f : 0.5f); }
    for (int i = gt; i < 128 * 16; i += GT) { const int pos = i / 16, f = i % 16; const float inv = __expf(-(float)f * (9.210340371976184f / 16.0f)); float sn, cs; sincosf((float)pos * inv, &sn, &cs);
        ((f32x2*)(C.ws + WS_ROPE))[i] = (f32x2){cs, sn}; }
    const int gw = C.bid * NW + C.wave, GWV = C.G * NW;
    conv_weights(C, 0, gw, GWV, 0, CI_LAYER);
    for (int i = gt; i < NL * 14 * NH * 2 * 64 * 8; i += GT) {
        const int j = i & 7, ln = (i >> 3) & 63, tj = (i >> 9) & 1, hd = (i >> 10) % NH, f = (i / (1024 * NH)) % 14, l = i / (1024 * NH * 14);
        const int col = hd * 64 + 32 * tj + (ln & 31); float v;
        if (f < 8) { const int d = (f >> 1) & 1, sx = f & 1, k = 16 * sx + 8 * (ln >> 5) + j; v = C.in[f < 4 ? I_RWWUP : I_RWAUP][(((size_t)l * 2 + d) * 32 + k) * GW + col]; }
        else { const int k = 16 * (f - 8) + 8 * (ln >> 5) + j; v = C.in[I_RWGUP][((size_t)l * 96 + k) * GW + col]; }
        ((bf16*)(C.ws + WS_RWF))[i] = (bf16)f2bf(v); }
    LAS float* wsc = (LAS float*)(C.lds + C.wave * 16640);
    for (int it = gw; it < NL * S5G * 2 * S5L; it += GWV) {
        const int tau = it % S5L, dir = (it / S5L) % 2, g = (it / (2 * S5L)) % S5G, l = it / (2 * S5L * S5G);
        const Cplx z = cmul(s5_lam_pow(C, l, dir, g, C.lane, (float)tau), s5_coef(C, l, dir, g, C.lane));
#pragma unroll 4
        for (int q = 0; q < 16; ++q) { const size_t i = (((size_t)l * S5G + g) * 64 + C.lane) * 16 + q; const Cplx w = cmul(z, Cplx{C.in[I_S5BRE][i], C.in[I_S5BIM][i]}); wsc[(C.lane * 16 + q) * 2] = w.re; wsc[(C.lane * 16 + q) * 2 + 1] = w.im; }
        WSYNC();
        float* kc = (float*)(C.ws + WS_S5T + (size_t)l * SZ_S5L + OFF_S5KC) + (((size_t)g * 2 + dir) * S5L + tau) * 256;
#pragma unroll 1
        for (int e = 0; e < 4; ++e) { const int pq = C.lane + 64 * e, p = pq >> 4, q = pq & 15; float s = 0.f;
#pragma unroll 4
            for (int n = 0; n < 64; ++n) { const Cplx gm = s5_gamma(C, l, g, p, n); s += gm.re * wsc[(n * 16 + q) * 2] - gm.im * wsc[(n * 16 + q) * 2 + 1]; }
            kc[pq] = s; }
        WSYNC();
    }
    for (int i = gt; i < NL * 2 * GW * 4 * (S5L + 1); i += GT) { const int tau = i % (S5L + 1), r = i / (S5L + 1), n = r % 64, g = (r / 64) % S5G, dir = (r / (64 * S5G)) % 2, l = r / (2 * 64 * S5G);
        const Cplx z = s5_lam_pow(C, l, dir, g, n, (float)tau); ((f32x2*)(C.ws + WS_S5T + (size_t)l * SZ_S5L + OFF_S5LP))[((size_t)(dir * S5G + g) * 64 + n) * (S5L + 1) + tau] = (f32x2){z.re, z.im}; }
    for (int i = gt; i < NL * 2 * GW * 4 * 16; i += GT) { const int q = i % 16, r = i / 16, n = r % 64, g = (r / 64) % S5G, dir = (r / (64 * S5G)) % 2, l = r / (2 * 64 * S5G);
        const Cplx z = s5_beta(C, l, dir, g, n, q); ((f32x2*)(C.ws + WS_S5T + (size_t)l * SZ_S5L + OFF_S5BETA))[((size_t)(dir * S5G + g) * 64 + n) * 16 + q] = (f32x2){z.re, z.im}; }
    for (int i = gt; i < NL * 2 * GW * 4; i += GT) { const int n = i % 64, g = (i / 64) % S5G, dir = (i / (64 * S5G)) % 2, l = i / (2 * 64 * S5G); const Cplx z = s5_lam_pow(C, l, dir, g, n, (float)S5L);
        ((f32x2*)(C.ws + WS_S5T + (size_t)l * SZ_S5L + OFF_S5LAM))[(dir * S5G + g) * 64 + n] = (f32x2){z.re, z.im}; }
}
DI void ph_tab(const Ctx& C) {
    const long gt = (long)C.bid * NTHR + C.tid, GT = (long)C.G * NTHR;
    for (long i = gt; i < (long)NL * S5G * 256 * 512; i += GT) {
        const int k = (int)(i % 512), np = (int)((i / 512) % 256), g = (int)((i / (512 * 256)) % S5G), l = (int)(i / ((long)512 * 256 * S5G));
        const int j = k >> 4, q = k & 15, dir = np >> 7, n = np & 63, im = (np >> 6) & 1;
        const f32x2 lp = ((const f32x2*)(C.ws + WS_S5T + (size_t)l * SZ_S5L + OFF_S5LP))[((size_t)(dir * S5G + g) * 64 + n) * (S5L + 1) + (dir == 0 ? S5L - 1 - j : j)];
        const f32x2 be = ((const f32x2*)(C.ws + WS_S5T + (size_t)l * SZ_S5L + OFF_S5BETA))[((size_t)(dir * S5G + g) * 64 + n) * 16 + q];
        const Cplx w = cmul(Cplx{lp[0], lp[1]}, Cplx{be[0], be[1]});
        ((bf16*)(C.ws + WS_S5T + (size_t)l * SZ_S5L + OFF_S5ET))[((size_t)g * 256 + np) * 512 + k] = (bf16)f2bf(im ? w.im : w.re); }
    for (long i = gt; i < (long)NL * S5G * 512 * S5K; i += GT) {
        const int k = (int)(i % S5K), nn = (int)((i / S5K) % 512), g = (int)((i / ((long)S5K * 512)) % S5G), l = (int)(i / ((long)S5K * 512 * S5G));
        const int ti = nn >> 4, p = nn & 15; float v;
        if (k < 512) { const int j = k >> 4, q = k & 15; const float* kc = (const float*)(C.ws + WS_S5T + (size_t)l * SZ_S5L + OFF_S5KC) + (size_t)g * 2 * S5L * 256;
            v = 0.f; if (j <= ti) v += kc[((ti - j)) * 256 + p * 16 + q]; if (j >= ti) v += kc[(S5L + (j - ti)) * 256 + p * 16 + q]; }
        else { const int kk = k - 512, dir = kk >> 7, im = (kk >> 6) & 1, n = kk & 63;
            const f32x2 lp = ((const f32x2*)(C.ws + WS_S5T + (size_t)l * SZ_S5L + OFF_S5LP))[((size_t)(dir * S5G + g) * 64 + n) * (S5L + 1) + (dir == 0 ? ti + 1 : S5L - ti)];
            const Cplx w = cmul(s5_gamma(C, l, g, p, n), Cplx{lp[0], lp[1]}); v = im ? -w.im : w.re; }
        ((bf16*)(C.ws + WS_S5T + (size_t)l * SZ_S5L + OFF_S5BT))[((size_t)g * 512 + nn) * S5K + k] = (bf16)f2bf(v); }
    const int gw = C.bid * NW + C.wave, GWV = C.G * NW;
    for (int row = gw; row < M; row += GWV) {
        const float* src = row < M_LAT ? C.in[I_X] + (size_t)row * D : C.in[I_CTX] + (size_t)(row - M_LAT) * D;
        float* dst = xrow_ptr(C, row); const float* gs = gs_ptr(C, 0, 0, stream_of_row(row)); bf16* ap = (bf16*)(C.ws + WS_AP) + (size_t)row * D; float ss = 0.f;
        f32x4 xv[D / 256], gv[D / 256];
#pragma unroll
        for (int i = 0; i < D / 256; ++i) { xv[i] = *(const f32x4*)(src + 4 * C.lane + 256 * i); gv[i] = *(const f32x4*)(gs + 4 * C.lane + 256 * i); }
#pragma unroll
        for (int i = 0; i < D / 256; ++i) { const int c = 4 * C.lane + 256 * i; const f32x4 x = xv[i]; *(f32x4*)(dst + c) = x; ss += (x[0] * x[0] + x[1] * x[1]) + (x[2] * x[2] + x[3] * x[3]);
            const f32x4 a = x * gv[i]; u32x2 w; w.x = pk2(a[0], a[1]); w.y = pk2(a[2], a[3]); *(u32x2*)(ap + c) = w; }
        ss = wave_sum(ss); if (C.lane == 0) rowss_ptr(C, 0, 0)[row] = ss;
    }
}

#ifdef EMU
DI s16x4 tr_read1(const LAS unsigned char* a) { return emu_tr_read(a); }
#else
DI s16x4 tr_read1(const LAS unsigned char* a) { s16x4 r; asm volatile("ds_read_b64_tr_b16 %0, %1\n\ts_waitcnt lgkmcnt(0)" : "=&v"(r) : "v"((unsigned)(size_t)a) : "memory"); return r; }
#endif
DI bf16x8 tr_frag(const LAS unsigned char* a0, int hi_off) {
#ifdef EMU
    const s16x4 lo = emu_tr_read(a0), hi = emu_tr_read(a0 + hi_off);
#else
    s16x4 lo, hi; asm volatile("ds_read_b64_tr_b16 %0, %2\n\tds_read_b64_tr_b16 %1, %3\n\ts_waitcnt lgkmcnt(0)" : "=&v"(lo), "=&v"(hi) : "v"((unsigned)(size_t)a0), "v"((unsigned)(size_t)(a0 + hi_off)) : "memory");
#endif
    return __builtin_shufflevector(lo, hi, 0, 1, 2, 3, 4, 5, 6, 7);
}
DI void tr_frag4(const LAS unsigned char* a0, const LAS unsigned char* a1, const LAS unsigned char* a2, const LAS unsigned char* a3, int hi_off, bf16x8 (&f)[4]) {
#ifdef EMU
    f[0] = tr_frag(a0, hi_off); f[1] = tr_frag(a1, hi_off); f[2] = tr_frag(a2, hi_off); f[3] = tr_frag(a3, hi_off);
#else
    s16x4 l0, h0, l1, h1, l2, h2, l3, h3;
    asm volatile("ds_read_b64_tr_b16 %0, %8\n\tds_read_b64_tr_b16 %1, %9\n\tds_read_b64_tr_b16 %2, %10\n\tds_read_b64_tr_b16 %3, %11\n\tds_read_b64_tr_b16 %4, %12\n\tds_read_b64_tr_b16 %5, %13\n\tds_read_b64_tr_b16 %6, %14\n\tds_read_b64_tr_b16 %7, %15\n\ts_waitcnt lgkmcnt(0)"
        : "=&v"(l0), "=&v"(h0), "=&v"(l1), "=&v"(h1), "=&v"(l2), "=&v"(h2), "=&v"(l3), "=&v"(h3)
        : "v"((unsigned)(size_t)a0), "v"((unsigned)(size_t)(a0 + hi_off)), "v"((unsigned)(size_t)a1), "v"((unsigned)(size_t)(a1 + hi_off)), "v"((unsigned)(size_t)a2), "v"((unsigned)(size_t)(a2 + hi_off)), "v"((unsigned)(size_t)a3), "v"((unsigned)(size_t)(a3 + hi_off)) : "memory");
    f[0] = __builtin_shufflevector(l0, h0, 0, 1, 2, 3, 4, 5, 6, 7); f[1] = __builtin_shufflevector(l1, h1, 0, 1, 2, 3, 4, 5, 6, 7); f[2] = __builtin_shufflevector(l2, h2, 0, 1, 2, 3, 4, 5, 6, 7); f[3] = __builtin_shufflevector(l3, h3, 0, 1, 2, 3, 4, 5, 6, 7);
#endif
}
DI bf16x8 pack8(const f32x16& x, int s) {
    u32x4 p; p.x = pk2(x[8 * s], x[8 * s + 1]); p.y = pk2(x[8 * s + 2], x[8 * s + 3]); p.z = pk2(x[8 * s + 4], x[8 * s + 5]); p.w = pk2(x[8 * s + 6], x[8 * s + 7]);
    return __builtin_bit_cast(bf16x8, p);
}
struct AttnSt { f32x16 o0, o1; float m, l; };
constexpr int APT = 144;
struct KVregs { u32x4 k[4]; u32x4 v[4]; };
struct Kregs { bf16x8 k[4]; };
DI void k_load(Kregs& r, const bf16* Kb, int kp, int lane) {
    const int r32 = lane & 31, h = lane >> 5;
#pragma unroll
    for (int kk = 0; kk < 4; ++kk) r.k[kk] = *(const bf16x8*)(Kb + (size_t)r32 * kp + 16 * kk + 8 * h);
}
DI void kv_load2(KVregs& r, const bf16* Kb, int kp, const bf16* Vb, int vp, int lane) {
#pragma unroll
    for (int i = 0; i < 4; ++i) { const int idx = lane + 64 * i, key = idx >> 3, ch = idx & 7; r.k[i] = *(const u32x4*)(Kb + (size_t)key * kp + ch * 8); }
#pragma unroll
    for (int i = 0; i < 4; ++i) { const int idx = lane + 64 * i, key = idx >> 3, ch = idx & 7; r.v[i] = *(const u32x4*)(Vb + (size_t)key * vp + ch * 8); }
}
#if 0
DI void kv_load(KVregs& r, const Kregs& kpre, const bf16* Vb, int vp, int lane) {
#pragma unroll
    for (int kk = 0; kk < 4; ++kk) r.k[kk] = kpre.k[kk];
#pragma unroll
    for (int i = 0; i < 4; ++i) { const int idx = lane + 64 * i, key = idx >> 3, ch = idx & 7; r.v[i] = *(const u32x4*)(Vb + (size_t)key * vp + ch * 8); }
}
#endif
DI void attn_stage(const KVregs& kv, LAS unsigned char* vl, int lane) {
    LAS unsigned char* vk = vl; LAS unsigned char* vv = vl + 32 * APT;
#pragma unroll
    for (int i = 0; i < 4; ++i) { const int idx = lane + 64 * i, key = idx >> 3, ch = idx & 7; *(LAS u32x4*)(vk + key * APT + ch * 16) = kv.k[i]; *(LAS u32x4*)(vv + key * APT + ch * 16) = kv.v[i]; }
}
template <bool MASKED>
DI void attn_block(AttnSt& st, const bf16x8 (&qf)[4], LAS unsigned char* vl, int lane, const float (&addv)[16], unsigned vmask) {
    const int h = lane >> 5;
    LAS unsigned char* vk = vl; LAS unsigned char* vv = vl + 32 * APT;
    WSYNC();
    bf16x8 kf[4];
#pragma unroll
    for (int kk = 0; kk < 4; ++kk) kf[kk] = *(const LAS bf16x8*)(vk + (lane & 31) * APT + (16 * kk + 8 * h) * 2);
    f32x16 s;
#pragma unroll
    for (int i = 0; i < 16; ++i) s[i] = 0.f;
#pragma unroll
    for (int kk = 0; kk < 4; ++kk) s = __builtin_amdgcn_mfma_f32_32x32x16_bf16(kf[kk], qf[kk], s, 0, 0, 0);
    float bm = -1e30f;
#pragma unroll
    for (int i = 0; i < 16; ++i) { if (MASKED) { s[i] += addv[i]; if ((vmask >> i) & 1u) bm = fmaxf(bm, s[i]); } else bm = fmaxf(bm, s[i]); }
    bm = fmaxf(bm, __shfl_xor(bm, 32));
    const float mn = fmaxf(st.m, bm), alpha = __expf(st.m - mn); st.m = mn;
    float ls = 0.f;
#pragma unroll
    for (int i = 0; i < 16; ++i) { float p = __expf(s[i] - mn); if (MASKED) p = ((vmask >> i) & 1u) ? p : 0.f; s[i] = p; ls += p; }
    st.l = st.l * alpha + ls;
#pragma unroll
    for (int i = 0; i < 16; ++i) { st.o0[i] *= alpha; st.o1[i] *= alpha; }
    const int q = (lane & 15) >> 2, p4 = lane & 3, blk = (lane >> 4) & 1;
    { const LAS unsigned char* ab = vv + (4 * h + q) * APT + (16 * blk) * 2 + 8 * p4; bf16x8 vf[4];
      tr_frag4(ab, ab + 64, ab + 16 * APT, ab + 16 * APT + 64, 8 * APT, vf);
      const bf16x8 pf0 = pack8(s, 0), pf1 = pack8(s, 1);
      st.o0 = __builtin_amdgcn_mfma_f32_32x32x16_bf16(vf[0], pf0, st.o0, 0, 0, 0); st.o1 = __builtin_amdgcn_mfma_f32_32x32x16_bf16(vf[1], pf0, st.o1, 0, 0, 0);
      st.o0 = __builtin_amdgcn_mfma_f32_32x32x16_bf16(vf[2], pf1, st.o0, 0, 0, 0); st.o1 = __builtin_amdgcn_mfma_f32_32x32x16_bf16(vf[3], pf1, st.o1, 0, 0, 0); }
}
DI void attn_finish(AttnSt& st, bf16* orow  , int lane, float extra_l) {
    const int h = lane >> 5; float l = st.l + __shfl_xor(st.l, 32) + extra_l; const float inv = 1.0f / l;
#pragma unroll
    for (int g = 0; g < 4; ++g) {
        u32x2 w0, w1; w0.x = pk2(st.o0[4 * g] * inv, st.o0[4 * g + 1] * inv); w0.y = pk2(st.o0[4 * g + 2] * inv, st.o0[4 * g + 3] * inv);
        w1.x = pk2(st.o1[4 * g] * inv, st.o1[4 * g + 1] * inv); w1.y = pk2(st.o1[4 * g + 2] * inv, st.o1[4 * g + 3] * inv);
        *(u32x2*)(orow + 8 * g + 4 * h) = w0; *(u32x2*)(orow + 32 + 8 * g + 4 * h) = w1; }
}
DI int clampi(int v, int lo, int hi) { return v < lo ? lo : (v > hi ? hi : v); }
#ifndef ATTN_A_PCT
#define ATTN_A_PCT 20
#endif
constexpr int AT_NA = NB * NH * (GRH / 2) * 4, AT_WA = NB * NH * (T / 32), AT_CX = NB * NH * (TC / 32);
DI void ph_attn(const Ctx& C, int l, bool want_ctx, int widx, int nworkers, int t_lo, int t_hi) {
    if (widx < 0) return;
    const int gw = t_lo + widx, GWV = nworkers, lane = C.lane, r32 = lane & 31, h = lane >> 5;
    LAS unsigned char* vl = C.lds + C.wave * 16640;
    const bf16* QA = (const bf16*)(C.ws + WS_QA); const bf16* KA = (const bf16*)(C.ws + WS_KA); const bf16* VA = (const bf16*)(C.ws + WS_VA);
    const bf16* QC = (const bf16*)(C.ws + WS_QC); const bf16* KC = (const bf16*)(C.ws + WS_KC); const bf16* VC = (const bf16*)(C.ws + WS_VC);
    bf16* OB = (bf16*)(C.ws + WS_OB);
    const int ntiles = t_hi;
    const float zero16[16] = {0.f, 0.f, 0.f, 0.f, 0.f, 0.f, 0.f, 0.f, 0.f, 0.f, 0.f, 0.f, 0.f, 0.f, 0.f, 0.f};
    for (int tile = gw; tile < ntiles; tile += GWV) {
        AttnSt st; st.m = -1e30f; st.l = 0.f;
#pragma unroll
        for (int i = 0; i < 16; ++i) { st.o0[i] = 0.f; st.o1[i] = 0.f; }
        bf16x8 qf[4];
        if (tile < AT_NA) {
            const int cb = tile & 3, rp = (tile >> 2) % (GRH / 2), hd = (tile / (4 * (GRH / 2))) % NH, b = tile / (4 * (GRH / 2) * NH);
            const int r0 = 2 * rp, c0 = 16 * cb, qr = r0 + (r32 >> 4), qc = c0 + (r32 & 15), qrow = b * T + qr * GRW + qc;
#pragma unroll
            for (int kk = 0; kk < 4; ++kk) qf[kk] = *(const bf16x8*)(QA + (size_t)qrow * GW + hd * 64 + 16 * kk + 8 * h);
            const int rsq = clampi(qr - 4, 0, GRH - 8), csq = clampi(qc - 8, 0, GRW - 16);
            const int rsA = clampi(r0 - 4, 0, GRH - 8), rsB = clampi(r0 + 1 - 4, 0, GRH - 8), kc0 = clampi(c0 - 8, 0, GRW - 32);
            const float* rpb = C.in[I_NARPB] + ((size_t)l * NH + hd) * 465;
            const int nbn = rsB + 8 - rsA, nbt = nbn + TC / 32; KVregs nxt;
#define NA_ROW(i) ((i) < nbn ? (size_t)b * T + (rsA + (i)) * GRW + kc0 : (size_t)M_LAT + b * TC + 32 * ((i) - nbn))
            { const size_t kr0 = NA_ROW(0); kv_load2(nxt, KA + kr0 * GW + hd * 64, GW, VA + kr0 * GW + hd * 64, GW, lane); }
            LAS float* rpbL = (LAS float*)(vl + 64 * APT);
            { float tb[8];
#pragma unroll
              for (int i = 0; i < 8; ++i) { const int j = lane + 64 * i; tb[i] = rpb[j < 465 ? j : 464]; }
#pragma unroll
              for (int i = 0; i < 8; ++i) { const int j = lane + 64 * i; if (j < 465) rpbL[j] = tb[i]; }
              WSYNC(); }
            for (int ib = 0; ib < nbt; ++ib) {
                attn_stage(nxt, vl, lane);
                { const int in_ = ib + 1 < nbt ? ib + 1 : ib; const size_t kr1 = NA_ROW(in_); kv_load2(nxt, KA + kr1 * GW + hd * 64, GW, VA + kr1 * GW + hd * 64, GW, lane); }
                if (ib < nbn) { const int kr = rsA + ib; float addv[16]; unsigned vm = 0u; const bool rok = kr >= rsq && kr <= rsq + 7;
#pragma unroll
                    for (int i = 0; i < 16; ++i) { const int kb = (i & 3) + 8 * (i >> 2) + 4 * h, kc = kc0 + kb; const bool ok = rok && kc >= csq && kc <= csq + 15;
                        const int bi = ok ? (kr - qr + 7) * 31 + (kc - qc + 15) : 0; addv[i] = rpbL[bi]; vm |= ok ? (1u << i) : 0u; }
                    attn_block<true>(st, qf, vl, lane, addv, vm); }
                else attn_block<false>(st, qf, vl, lane, zero16, 0xffffu); }
#undef NA_ROW
            attn_finish(st, OB + (size_t)qrow * D + hd * 64, lane, 0.f);
        } else if (tile < AT_NA + AT_WA) {
            const int t2 = tile - AT_NA, hl_ = t2 % WAG, qb = (t2 / WAG) % (T / 32), kvh = (t2 / (WAG * (T / 32))) % (NH / WAG), b = t2 / ((T / 32) * NH), hd = kvh * WAG + hl_;
            const int qt = 32 * qb + r32, qrow = b * T + qt;
#pragma unroll
            for (int kk = 0; kk < 4; ++kk) qf[kk] = *(const bf16x8*)(QC + (size_t)qrow * GW + hd * 64 + 16 * kk + 8 * h);
            const int i_lo = 4 - qb > 0 ? 4 - qb : 0, i_hi = (T / 32 - qb + 4) < 9 ? (T / 32 - qb + 4) : 9, nbw = i_hi - i_lo, nbt = nbw + TC / 32; KVregs nxt;
#define WA_ROW(i) ((i) < nbw ? (size_t)b * T + 32 * qb - 128 + 32 * (i_lo + (i)) : (size_t)M_LAT + b * TC + 32 * ((i) - nbw))
            { const size_t kr0 = WA_ROW(0); kv_load2(nxt, KC + kr0 * 128 + kvh * 64, 128, VC + kr0 * 128 + kvh * 64, 128, lane); }
            for (int ib = 0; ib < nbt; ++ib) {
                attn_stage(nxt, vl, lane);
                { const int in_ = ib + 1 < nbt ? ib + 1 : ib; const size_t kr1 = WA_ROW(in_); kv_load2(nxt, KC + kr1 * 128 + kvh * 64, 128, VC + kr1 * 128 + kvh * 64, 128, lane); }
                if (ib < nbw) { const int t0 = 32 * qb - 128 + 32 * (i_lo + ib); float addv[16]; unsigned vm = 0u;
#pragma unroll
                    for (int i = 0; i < 16; ++i) { const int kt = t0 + (i & 3) + 8 * (i >> 2) + 4 * h, rel = kt - qt; addv[i] = 0.f; vm |= (rel >= -128 && rel <= 128) ? (1u << i) : 0u; }
                    attn_block<true>(st, qf, vl, lane, addv, vm); }
                else attn_block<false>(st, qf, vl, lane, zero16, 0xffffu); }
#undef WA_ROW
            const float sk = C.in[I_WASINK][(size_t)l * NH + hd];
            const float mfin = fmaxf(st.m, sk), a2 = __expf(st.m - mfin);
#pragma unroll
            for (int i = 0; i < 16; ++i) { st.o0[i] *= a2; st.o1[i] *= a2; }
            st.l *= a2; st.m = mfin;
            attn_finish(st, OB + (size_t)qrow * D + 2 * GW + hd * 64, lane, __expf(sk - mfin));
        } else {
            const int t2 = tile - AT_NA - AT_WA, isc = t2 >= AT_CX, t3 = t2 - isc * AT_CX, qb = t3 % (TC / 32), hd = (t3 / (TC / 32)) % NH, b = t3 / ((TC / 32) * NH), kvh = hd / WAG;
            const int qrow = M_LAT + b * TC + 32 * qb + r32;
            const bf16* Qs = isc ? QC : QA; const bf16* Ks = isc ? KC + kvh * 64 : KA + hd * 64; const bf16* Vs = isc ? VC + kvh * 64 : VA + hd * 64; const int kp = isc ? 128 : GW;
#pragma unroll
            for (int kk = 0; kk < 4; ++kk) qf[kk] = *(const bf16x8*)(Qs + (size_t)qrow * GW + hd * 64 + 16 * kk + 8 * h);
            { KVregs nxt; const size_t kr0 = (size_t)M_LAT + b * TC; kv_load2(nxt, Ks + kr0 * kp, kp, Vs + kr0 * kp, kp, lane);
              for (int cbk = 0; cbk < TC / 32; ++cbk) { attn_stage(nxt, vl, lane); const int cn = cbk + 1 < TC / 32 ? cbk + 1 : cbk; kv_load2(nxt, Ks + (kr0 + 32 * cn) * kp, kp, Vs + (kr0 + 32 * cn) * kp, kp, lane);
                  attn_block<false>(st, qf, vl, lane, zero16, 0xffffu); } }
            float extra = 0.f;
            if (isc) { const float sk = C.in[I_WASINK][(size_t)l * NH + hd]; const float mfin = fmaxf(st.m, sk), a2 = __expf(st.m - mfin);
#pragma unroll
                for (int i = 0; i < 16; ++i) { st.o0[i] *= a2; st.o1[i] *= a2; }
                st.l *= a2; st.m = mfin; extra = __expf(sk - mfin); }
            attn_finish(st, OB + (size_t)qrow * D + (isc ? 2 * GW : 0) + hd * 64, lane, extra);
        }
    }
}

DI void ph_ctxfix(const Ctx& C, const float* gsn  , float* rowss_next) {
    const int gw = C.bid * NW + C.wave, GWV = C.G * NW;
    for (int r = gw; r < M_CTX; r += GWV) { const int row = M_LAT + r; const float* xp = xrow_ptr(C, row); const float* gs = gsn + (size_t)NB * D; bf16* ap = (bf16*)(C.ws + WS_AP) + (size_t)row * D; float ss = 0.f;
        f32x4 xv[D / 256], gv[D / 256];
#pragma unroll
        for (int i = 0; i < D / 256; ++i) { xv[i] = *(const f32x4*)(xp + 4 * C.lane + 256 * i); gv[i] = *(const f32x4*)(gs + 4 * C.lane + 256 * i); }
#pragma unroll
        for (int i = 0; i < D / 256; ++i) { const int c = 4 * C.lane + 256 * i; const f32x4 x = xv[i]; ss += (x[0] * x[0] + x[1] * x[1]) + (x[2] * x[2] + x[3] * x[3]);
            const f32x4 a = x * gv[i]; u32x2 w; w.x = pk2(a[0], a[1]); w.y = pk2(a[2], a[3]); *(u32x2*)(ap + c) = w; }
        ss = wave_sum(ss); if (C.lane == 0) rowss_next[row] = ss; }
}
constexpr int PT = 144;
constexpr int RW_HALF = 73472, IM_BT = 0, IM_KT = 9216, IM_RT = 18432, IM_ARB = 27648, IM_AT = 36864, IM_AAK = 46080, IM_F = 55296, IM_GC = 72704, FP = 68;
DI void chunk_rows(int b, int dir, int c, int& row0, int& step) {
    if (c < TC / 64) { const int p0 = 64 * c; row0 = M_LAT + b * TC + (dir ? TC - 1 - p0 : p0); } else { const int p0 = 64 * (c - TC / 64); row0 = b * T + (dir ? T - 1 - p0 : p0); }
    step = dir ? -1 : 1;
}
DI bf16x8 frag_rows(const LAS unsigned char* img, int tile, int s, int lane) { return *(const LAS bf16x8*)(img + (32 * tile + (lane & 31)) * PT + (16 * s + 8 * (lane >> 5)) * 2); }
DI bf16x8 frag_cols(const LAS unsigned char* img, int tile, int s, int lane) {
    const int h = lane >> 5, q = (lane & 15) >> 2, p4 = lane & 3, blk = (lane >> 4) & 1;
    const LAS unsigned char* a0 = img + (16 * s + 8 * h + q) * PT + (32 * tile + 16 * blk) * 2 + 8 * p4;
    return tr_frag(a0, 4 * PT);
}
DI void frag_cols4(const LAS unsigned char* img, int tile, int lane, bf16x8 (&f)[4]) {
    const int h = lane >> 5, q = (lane & 15) >> 2, p4 = lane & 3, blk = (lane >> 4) & 1;
    const LAS unsigned char* a0 = img + (8 * h + q) * PT + (32 * tile + 16 * blk) * 2 + 8 * p4;
    tr_frag4(a0, a0 + 16 * PT, a0 + 32 * PT, a0 + 48 * PT, 4 * PT, f);
}
DI void store_T(const f32x16& acc, LAS unsigned char* img, int ti, int tj, int lane) {
    const int c = lane & 31, h = lane >> 5;
#pragma unroll
    for (int g = 0; g < 4; ++g) { u32x2 w; w.x = pk2(acc[4 * g], acc[4 * g + 1]); w.y = pk2(acc[4 * g + 2], acc[4 * g + 3]); *(LAS u32x2*)(img + (32 * tj + c) * PT + (32 * ti + 8 * g + 4 * h) * 2) = w; }
}
DI f32x16 zero16v() { f32x16 z;
#pragma unroll
    for (int i = 0; i < 16; ++i) z[i] = 0.f; return z; }
#define MMA32(a, b, c) __builtin_amdgcn_mfma_f32_32x32x16_bf16((a), (b), (c), 0, 0, 0)
constexpr int PDW = 80, PDG = 208, IM_TW = 0, IM_TA = 17408, IM_DW = 36864, IM_DA = 41984, IM_DG = 47104;
DI void ph_rw1(const Ctx& C, int l) {
    const int wg = C.wave & 3, grp = C.wave >> 2, ti = wg >> 1, tj = wg & 1;
    bf16* QH = (bf16*)(C.ws + WS_QH); float* YL = (float*)(C.ws + WS_YL); bf16* MF = (bf16*)(C.ws + WS_MF); float* GF = (float*)(C.ws + WS_GF); bf16* RVKG = (bf16*)(C.ws + WS_RVKG);
    const bf16* PB = (const bf16*)(C.ws + WS_PB); const float* PS = (const float*)(C.ws + WS_PS);
    const bf16x8* RWF = (const bf16x8*)(C.ws + WS_RWF + (size_t)l * SZ_RWF);
    constexpr int nblk = (TC + T) / 64;
    for (int it0 = 2 * C.bid; it0 < RBLK; it0 += 2 * C.G) {
        int lane_ = threadIdx.x & 63; OPAQUE(lane_); const int lane = lane_, c32 = lane & 31, h = lane >> 5;
        LAS unsigned char* L = OPAQUE_LDS(C.lds + grp * RW_HALF);
        LAS float* F = (LAS float*)(L + IM_F); LAS float* SEG = (LAS float*)(L + IM_F); LAS float* GC = (LAS float*)(L + IM_GC);
        LAS float* TW = (LAS float*)(L + IM_TW); LAS float* TA = (LAS float*)(L + IM_TA);
        unsigned char* PK = C.ws + WS_RWS + ((size_t)C.bid * 2 + grp) * 65536;
        const int item = it0 + grp; const bool live = item < RBLK; const int itc = live ? item : RBLK - 1;
        const int tb = itc % nblk, hd = (itc / nblk) % NH, b = itc / (nblk * NH), cg = hd * 64 + lane;
        const int rowb = tb < TC / 64 ? M_LAT + b * TC + 64 * tb : b * T + 64 * (tb - TC / 64);
        const int seq_lo = tb < TC / 64 ? M_LAT + b * TC : b * T, seq_hi = seq_lo + (tb < TC / 64 ? TC : T);
        bf16* RV = RVKG + (size_t)itc * 4 * 4096;
        __syncthreads();
        float r_[16], kf_[16], kk_[16], ks_[16];
        { const float* cw = C.in[I_RWCONV] + (size_t)l * 9 * GW; float cwv[3][3];
#pragma unroll
          for (int j = 0; j < 3; ++j)
#pragma unroll
              for (int x = 0; x < 3; ++x) cwv[j][x] = cw[(size_t)j * 3 * GW + x * GW + cg];
          const float kkw = C.in[I_RWKK][(size_t)l * GW + cg];
          const int r0 = rowb + 16 * wg;
          bf16 pbv[18][3]; float psv[16][3];
#pragma unroll
          for (int rr = 0; rr < 18; ++rr) { int row = r0 - 1 + rr; row = row < seq_lo ? seq_lo : (row >= seq_hi ? seq_hi - 1 : row);
#pragma unroll
              for (int x = 0; x < 3; ++x) pbv[rr][x] = PB[(size_t)row * 3 * GW + x * GW + cg]; }
#pragma unroll
          for (int t = 0; t < 16; ++t)
#pragma unroll
              for (int kq = 0; kq < 3; ++kq) { const int k = lane + 64 * kq; psv[t][kq] = PS[(size_t)(r0 + t) * 160 + (k < 160 ? k : 159)]; }
          const float m_lo = r0 - 1 >= seq_lo ? 1.f : 0.f, m_hi = r0 + 16 < seq_hi ? 1.f : 0.f;
          float v_[16];
#pragma unroll
          for (int t = 0; t < 16; ++t) {
              float xa[3], xb[3], xc[3];
#pragma unroll
              for (int x = 0; x < 3; ++x) { xa[x] = bf2f(pbv[t][x]) * (t == 0 ? m_lo : 1.f); xb[x] = bf2f(pbv[t + 1][x]); xc[x] = bf2f(pbv[t + 2][x]) * (t == 15 ? m_hi : 1.f); }
              r_[t] = xa[0] * cwv[0][0] + xb[0] * cwv[1][0] + xc[0] * cwv[2][0]; kf_[t] = xa[1] * cwv[0][1] + xb[1] * cwv[1][1] + xc[1] * cwv[2][1]; v_[t] = xa[2] * cwv[0][2] + xb[2] * cwv[1][2] + xc[2] * cwv[2][2];
              const float kkv = kf_[t] * kkw, ssq = wave_sum(kkv * kkv); kk_[t] = kkv * __builtin_amdgcn_rsqf(fmaxf(ssq, 1e-24f)); ks_[t] = 0.f;
              const int tk = 16 * wg + t;
              if (lane < 32) *(LAS bf16*)(L + IM_DW + tk * PDW + lane * 2) = (bf16)f2bf(fast_tanh(psv[t][0])); else *(LAS bf16*)(L + IM_DA + tk * PDW + (lane - 32) * 2) = (bf16)f2bf(psv[t][0]);
              *(LAS bf16*)(L + IM_DG + tk * PDG + lane * 2) = (bf16)f2bf(sigmf(psv[t][1]));
              if (lane < 32) *(LAS bf16*)(L + IM_DG + tk * PDG + (lane + 64) * 2) = (bf16)f2bf(sigmf(psv[t][2]));
          }
#pragma unroll
          for (int t = 0; t < 16; ++t) { RV[(16 * wg + t) * 64 + lane] = (bf16)f2bf(r_[t]); RV[4096 + (16 * wg + t) * 64 + lane] = (bf16)f2bf(v_[t]); }
        }
        __syncthreads();
        bf16x8 lrf[2][4]; float w0v[2], a0v[2];
#pragma unroll
        for (int d = 0; d < 2; ++d) {
#pragma unroll
            for (int sx = 0; sx < 2; ++sx) { lrf[d][sx] = RWF[(((0 + 2 * d + sx) * NH + hd) * 2 + tj) * 64 + lane]; lrf[d][2 + sx] = RWF[(((4 + 2 * d + sx) * NH + hd) * 2 + tj) * 64 + lane]; }
            w0v[d] = C.in[I_RWW0][((size_t)l * 2 + d) * GW + hd * 64 + 32 * tj + c32]; a0v[d] = C.in[I_RWA0][((size_t)l * 2 + d) * GW + hd * 64 + 32 * tj + c32]; }
        { f32x16 gacc = zero16v();
#pragma unroll
          for (int sx = 0; sx < 6; ++sx) gacc = MMA32(*(const LAS bf16x8*)(L + IM_DG + (32 * ti + c32) * PDG + (16 * sx + 8 * h) * 2), RWF[(((8 + sx) * NH + hd) * 2 + tj) * 64 + lane], gacc);
#pragma unroll
          for (int rg = 0; rg < 16; ++rg) { const int tk = 32 * ti + (rg & 3) + 8 * (rg >> 2) + 4 * h; RV[3 * 4096 + tk * 64 + 32 * tj + c32] = (bf16)f2bf(gacc[rg]); }
        }
        const float kaw = C.in[I_RWKA][(size_t)l * GW + cg];
#pragma unroll
        for (int pss = 0; pss < 2; ++pss) {
            const int dir = 1 - pss;
            __syncthreads();
            { f32x16 pw = zero16v(), pa = zero16v();
#pragma unroll
              for (int sx = 0; sx < 2; ++sx) { pw = MMA32(*(const LAS bf16x8*)(L + IM_DW + (32 * ti + c32) * PDW + (16 * sx + 8 * h) * 2), lrf[dir][sx], pw);
                                              pa = MMA32(*(const LAS bf16x8*)(L + IM_DA + (32 * ti + c32) * PDW + (16 * sx + 8 * h) * 2), lrf[dir][2 + sx], pa); }
              const float w0 = w0v[dir], a0 = a0v[dir];
#pragma unroll
              for (int rg = 0; rg < 16; ++rg) { const int tk = 32 * ti + (rg & 3) + 8 * (rg >> 2) + 4 * h; const float z = -(w0 + pw[rg]), sp = z > 20.f ? z : __logf(1.f + __expf(z));
                  TW[tk * FP + 32 * tj + c32] = -__expf(-sp - 0.5f); TA[tk * FP + 32 * tj + c32] = sigmf(a0 + pa[rg]); } }
            __syncthreads();
            const int cs = dir ? 3 - wg : wg;
            float lw[16], av[16], run = 0.f;
#pragma unroll
            for (int ii = 0; ii < 16; ++ii) { const int tl = dir ? 15 - ii : ii, tk = 16 * wg + tl; av[ii] = TA[tk * FP + lane]; run += TW[tk * FP + lane]; lw[ii] = run; }
            __syncthreads();
            SEG[cs * 64 + lane] = run;
            __syncthreads();
            float off = 0.f;
#pragma unroll
            for (int w2 = 0; w2 < 3; ++w2) off += (w2 < cs) ? SEG[w2 * 64 + lane] : 0.f;
            const float tot = SEG[lane] + SEG[64 + lane] + SEG[128 + lane] + SEG[192 + lane];
            if (wg == 0) { if (dir) ((float*)(PK + 32768))[lane] = __expf(tot); else GC[lane] = __expf(tot); }
            float ePrev = __expf(off);
#pragma unroll
            for (int ii = 0; ii < 16; ++ii) { const int tl = dir ? 15 - ii : ii, i = 16 * cs + ii;
                const float Li = lw[ii] + off, eL = __expf(Li), ieL = __builtin_amdgcn_rcpf(eL), eLm = ePrev; ePrev = eL;
                const float a = av[ii], kd = kf_[tl] * (1.f + (a - 1.f) * kaw); ks_[tl] += kd;
                const bf16 vat = (bf16)f2bf(-kk_[tl] * eLm), vbt = (bf16)f2bf(kk_[tl] * a * ieL), vkt = (bf16)f2bf(kd * ieL), vrt = (bf16)f2bf(r_[tl] * eL);
                if (dir) { bf16* pk = (bf16*)PK + i * 64 + lane; pk[0] = vat; pk[4096] = vbt; pk[8192] = vkt; pk[12288] = vrt; }
                else { *(LAS bf16*)(L + IM_AT + i * PT + lane * 2) = vat; *(LAS bf16*)(L + IM_BT + i * PT + lane * 2) = vbt; *(LAS bf16*)(L + IM_KT + i * PT + lane * 2) = vkt; *(LAS bf16*)(L + IM_RT + i * PT + lane * 2) = vrt; } }
        }
#pragma unroll
        for (int t = 0; t < 16; ++t) RV[2 * 4096 + (16 * wg + t) * 64 + lane] = (bf16)f2bf(ks_[t]);
#pragma unroll 1
        for (int dir = 0; dir < 2; ++dir) {
            const int c = dir == 0 ? tb : (tb < TC / 64 ? TC / 64 - 1 - tb : TC / 64 + (T / 64 - 1 - (tb - TC / 64)));
            const size_t ci = ((size_t)((b * NH + hd) * 2 + dir)) * RCK + c;
            __syncthreads();
            if (dir) {
                const int tg = wg * 64 + lane;
                u32x4 pkv[4][2]; const float gcv = ((const float*)(PK + 32768))[lane];
#pragma unroll
                for (int im = 0; im < 4; ++im)
#pragma unroll
                    for (int rr = 0; rr < 2; ++rr) { const int idx = tg + 256 * rr, row = idx >> 3, ch = idx & 7; pkv[im][rr] = *(const u32x4*)(PK + im * 8192 + row * 128 + ch * 16); }
#pragma unroll
                for (int im = 0; im < 4; ++im)
#pragma unroll
                    for (int rr = 0; rr < 2; ++rr) { const int idx = tg + 256 * rr, row = idx >> 3, ch = idx & 7; const int dsto = im == 0 ? IM_AT : im == 1 ? IM_BT : im == 2 ? IM_KT : IM_RT;
                        *(LAS u32x4*)(L + dsto + row * PT + ch * 16) = pkv[im][rr]; }
                if (wg == 0) GC[lane] = gcv;
                __syncthreads();
            }
            f32x16 accP;
            { f32x16 aab = zero16v(), aak = zero16v(), arb = zero16v(); accP = zero16v();
#pragma unroll
              for (int s = 0; s < 4; ++s) { const bf16x8 at_i = frag_rows(L + IM_AT, ti, s, lane), bt_j = frag_rows(L + IM_BT, tj, s, lane), kt_j = frag_rows(L + IM_KT, ti, s, lane), at_c = frag_rows(L + IM_AT, tj, s, lane),
                                              bt_r = frag_rows(L + IM_BT, ti, s, lane), rt_c = frag_rows(L + IM_RT, tj, s, lane);
                  aab = MMA32(at_i, bt_j, aab); aak = MMA32(kt_j, at_c, aak); arb = MMA32(bt_r, rt_c, arb); accP = MMA32(kt_j, rt_c, accP); }
#pragma unroll
              for (int r = 0; r < 16; ++r) { const int row = 32 * ti + (r & 3) + 8 * (r >> 2) + 4 * h, col = 32 * tj + c32;
                  F[row * FP + col] = col < row ? aab[r] : 0.f; aak[r] = row < col ? aak[r] : 0.f; arb[r] = row <= col ? arb[r] : 0.f; accP[r] = row <= col ? accP[r] : 0.f; }
              store_T(aak, L + IM_AAK, ti, tj, lane);
              store_T(arb, L + IM_ARB, ti, tj, lane); }
            __syncthreads();
            { float Wc[64]; const int col = 32 * wg + c32; const LAS unsigned char* src = col < 64 ? L + IM_AT + col * 2 : L + IM_AAK + (col - 64) * 2;
              const LAS float* Fo = OPAQUE_LDS(F);
#pragma unroll
              for (int i = 0; i < 64; ++i) Wc[i] = bf2f(*(const LAS bf16*)(src + i * PT));
#pragma unroll
              for (int i = 1; i < 64; ++i) { float a0 = Wc[i], a1 = 0.f, a2 = 0.f, a3 = 0.f;
#pragma unroll
                  for (int j4 = 0; j4 < (i + 3) / 4; ++j4) { const f32x4 f = *(const LAS f32x4*)(Fo + i * FP + 4 * j4); a0 += f[0] * Wc[4 * j4]; a1 += f[1] * Wc[4 * j4 + 1]; a2 += f[2] * Wc[4 * j4 + 2]; a3 += f[3] * Wc[4 * j4 + 3];
                      if ((j4 & 7) == 7) PIN4(a0, a1, a2, a3); }
                  PIN4(a0, a1, a2, a3); Wc[i] = (a0 + a1) + (a2 + a3); }
              __syncthreads();
              if (h == 0) { LAS unsigned char* dst = (col < 64 ? L + IM_AT + col * PT : L + IM_AAK + (col - 64) * PT);
#pragma unroll
                  for (int i8 = 0; i8 < 8; ++i8) { u32x4 w; w.x = pk2(Wc[8 * i8], Wc[8 * i8 + 1]); w.y = pk2(Wc[8 * i8 + 2], Wc[8 * i8 + 3]); w.z = pk2(Wc[8 * i8 + 4], Wc[8 * i8 + 5]); w.w = pk2(Wc[8 * i8 + 6], Wc[8 * i8 + 7]); *(LAS u32x4*)(dst + i8 * 16) = w; } }
              bf16 vtmp[16];
#pragma unroll
              for (int ii = 0; ii < 16; ++ii) { const int tl = dir ? 15 - ii : ii; vtmp[ii] = RV[4096 + (16 * wg + tl) * 64 + lane]; }
#pragma unroll
              for (int ii = 0; ii < 16; ++ii) { const int i = 16 * (dir ? 3 - wg : wg) + ii; *(LAS bf16*)(L + IM_F + i * PT + lane * 2) = vtmp[ii]; }
            }
            __syncthreads();
            { f32x16 q;
#pragma unroll
              for (int g = 0; g < 4; ++g) { const u32x2 w = *(const LAS u32x2*)(L + IM_RT + (32 * tj + c32) * PT + (32 * ti + 8 * g + 4 * h) * 2); q[4 * g] = bflo(w.x); q[4 * g + 1] = bfhi(w.x); q[4 * g + 2] = bflo(w.y); q[4 * g + 3] = bfhi(w.y); }
#pragma unroll
              for (int s = 0; s < 4; ++s) { const bf16x8 arb = frag_rows(L + IM_ARB, tj, s, lane); q = MMA32(frag_rows(L + IM_AT, ti, s, lane), arb, q); accP = MMA32(frag_rows(L + IM_AAK, ti, s, lane), arb, accP); }
              if (live) {
#pragma unroll
                  for (int g = 0; g < 4; ++g) { u32x2 w; w.x = pk2(q[4 * g], q[4 * g + 1]); w.y = pk2(q[4 * g + 2], q[4 * g + 3]); *(u32x2*)(QH + ci * 4096 + (32 * tj + c32) * 64 + 32 * ti + 8 * g + 4 * h) = w; } }
            }
            __syncthreads();
            store_T(accP, L + IM_RT, ti, tj, lane);
            __syncthreads();
            { f32x16 y = zero16v(), m = zero16v(), n;
#pragma unroll
              for (int g = 0; g < 4; ++g) { const u32x2 w = *(const LAS u32x2*)(L + IM_KT + (32 * tj + c32) * PT + (32 * ti + 8 * g + 4 * h) * 2); n[4 * g] = bflo(w.x); n[4 * g + 1] = bfhi(w.x); n[4 * g + 2] = bflo(w.y); n[4 * g + 3] = bfhi(w.y); }
              bf16x8 btj[4], bti[4], vfj[4]; frag_cols4(L + IM_BT, tj, lane, btj); frag_cols4(L + IM_BT, ti, lane, bti); frag_cols4(L + IM_F, tj, lane, vfj);
#pragma unroll
              for (int s = 0; s < 4; ++s) { const bf16x8 btc_j = btj[s], btc_i = bti[s];
                  y = MMA32(frag_rows(L + IM_RT, ti, s, lane), vfj[s], y);
                  m = MMA32(frag_rows(L + IM_AT, ti, s, lane), btc_j, m);
                  n = MMA32(btc_i, frag_rows(L + IM_AAK, tj, s, lane), n); }
              const float gck = GC[32 * tj + c32];
#pragma unroll
              for (int r = 0; r < 16; ++r) { const int row = 32 * ti + (r & 3) + 8 * (r >> 2) + 4 * h, col = 32 * tj + c32; m[r] = (m[r] + (row == col ? 1.0f : 0.f)) * gck; n[r] *= GC[row]; }
              if (live) {
#pragma unroll
                  for (int g = 0; g < 4; ++g) *(f32x4*)(YL + ci * 4096 + ((wg * 4 + g) * 64 + lane) * 4) = (f32x4){y[4 * g], y[4 * g + 1], y[4 * g + 2], y[4 * g + 3]};
#pragma unroll
                  for (int s2 = 0; s2 < 2; ++s2) *(bf16x8*)(MF + ci * 4096 + ((wg * 2 + s2) * 64 + lane) * 8) = pack8(m, s2); }
              store_T(n, L + IM_ARB, ti, tj, lane);
            }
            __syncthreads();
            { f32x16 gacc = zero16v(); bf16x8 nfi[4], vfj[4]; frag_cols4(L + IM_ARB, ti, lane, nfi); frag_cols4(L + IM_F, tj, lane, vfj);
#pragma unroll
              for (int s = 0; s < 4; ++s) gacc = MMA32(nfi[s], vfj[s], gacc);
              if (live) {
#pragma unroll
                  for (int hf = 0; hf < 2; ++hf) { u32x4 w; w.x = pk2(gacc[8 * hf], gacc[8 * hf + 1]); w.y = pk2(gacc[8 * hf + 2], gacc[8 * hf + 3]); w.z = pk2(gacc[8 * hf + 4], gacc[8 * hf + 5]); w.w = pk2(gacc[8 * hf + 6], gacc[8 * hf + 7]);
                      *(u32x4*)((unsigned*)GF + ci * 2048 + ((wg * 2 + hf) * 64 + lane) * 4) = w; } }
            }
        }
    }
    __syncthreads();
}
struct R2Buf { bf16x8 mf[8]; u32x4 g[4]; };
DI void rw2_load(R2Buf& b, const bf16* MF, const unsigned* GFu, size_t item, int tj, int lane) {
#pragma unroll
    for (int q = 0; q < 8; ++q) b.mf[q] = *(const bf16x8*)(MF + item * 4096 + (q * 64 + lane) * 8);
#pragma unroll
    for (int kt = 0; kt < 2; ++kt)
#pragma unroll
        for (int hf = 0; hf < 2; ++hf) b.g[kt * 2 + hf] = *(const u32x4*)(GFu + item * 2048 + (((kt * 2 + tj) * 2 + hf) * 64 + lane) * 4);
}
DI void rw2_step(const R2Buf& b, f32x16& s0, f32x16& s1, bf16* SF, size_t item, int tj, int lane) {
    bf16x8 sf[2][2];
#pragma unroll
    for (int s = 0; s < 2; ++s) { sf[0][s] = pack8(s0, s); sf[1][s] = pack8(s1, s); *(bf16x8*)(SF + item * 4096 + (((0 * 2 + tj) * 2 + s) * 64 + lane) * 8) = sf[0][s]; *(bf16x8*)(SF + item * 4096 + (((1 * 2 + tj) * 2 + s) * 64 + lane) * 8) = sf[1][s]; }
    f32x16 n0, n1;
#pragma unroll
    for (int hf = 0; hf < 2; ++hf) { const u32x4 a = b.g[hf], c = b.g[2 + hf];
        n0[8 * hf] = bflo(a.x); n0[8 * hf + 1] = bfhi(a.x); n0[8 * hf + 2] = bflo(a.y); n0[8 * hf + 3] = bfhi(a.y); n0[8 * hf + 4] = bflo(a.z); n0[8 * hf + 5] = bfhi(a.z); n0[8 * hf + 6] = bflo(a.w); n0[8 * hf + 7] = bfhi(a.w);
        n1[8 * hf] = bflo(c.x); n1[8 * hf + 1] = bfhi(c.x); n1[8 * hf + 2] = bflo(c.y); n1[8 * hf + 3] = bfhi(c.y); n1[8 * hf + 4] = bflo(c.z); n1[8 * hf + 5] = bfhi(c.z); n1[8 * hf + 6] = bflo(c.w); n1[8 * hf + 7] = bfhi(c.w); }
#pragma unroll
    for (int kp = 0; kp < 2; ++kp)
#pragma unroll
        for (int s = 0; s < 2; ++s) { n0 = MMA32(b.mf[(kp * 2 + 0) * 2 + s], sf[kp][s], n0); n1 = MMA32(b.mf[(kp * 2 + 1) * 2 + s], sf[kp][s], n1); }
    s0 = n0; s1 = n1;
}
DI void ph_rw2(const Ctx& C) {
    const int lane = C.lane;
    const bf16* MF = (const bf16*)(C.ws + WS_MF); const unsigned* GFu = (const unsigned*)(C.ws + WS_GF); bf16* SF = (bf16*)(C.ws + WS_SF);
    const int nwork = RSTR * 2;
    for (int wk = C.wave == 0 ? C.bid : nwork; wk < nwork; wk += C.G) {
        const int tj = wk & 1, stream = wk >> 1; const size_t it0 = (size_t)stream * RCK;
        f32x16 s0 = zero16v(), s1 = zero16v();
        R2Buf A, B, Cb;
        rw2_load(A, MF, GFu, it0, tj, lane); rw2_load(B, MF, GFu, it0 + (1 < RCK ? 1 : 0), tj, lane); rw2_load(Cb, MF, GFu, it0 + (2 < RCK ? 2 : 0), tj, lane);
        for (int c = 0; c < RCK; c += 3) {
            rw2_step(A, s0, s1, SF, it0 + c, tj, lane); rw2_load(A, MF, GFu, it0 + (c + 3 < RCK ? c + 3 : RCK - 1), tj, lane);
            if (c + 1 < RCK) { rw2_step(B, s0, s1, SF, it0 + c + 1, tj, lane); rw2_load(B, MF, GFu, it0 + (c + 4 < RCK ? c + 4 : RCK - 1), tj, lane); }
            if (c + 2 < RCK) { rw2_step(Cb, s0, s1, SF, it0 + c + 2, tj, lane); rw2_load(Cb, MF, GFu, it0 + (c + 5 < RCK ? c + 5 : RCK - 1), tj, lane); }
        }
    }
}
DI void ph_rw3(const Ctx& C, int l, int mrows) {
    const int lane = C.lane, wg = C.wave & 3, grp = C.wave >> 2, ti = wg >> 1, tj = wg & 1, c32 = lane & 31, h = lane >> 5;
    LAS float* Ysum = (LAS float*)(C.lds + grp * RW_HALF);
    const bf16* QH = (const bf16*)(C.ws + WS_QH); const float* YL = (const float*)(C.ws + WS_YL); const bf16* SF = (const bf16*)(C.ws + WS_SF); bf16* OB = (bf16*)(C.ws + WS_OB);
    const int nblk = (TC + T) / 64, nitems = NB * NH * nblk;
    for (int it0 = 2 * C.bid; it0 < nitems; it0 += 2 * C.G) {
        const int item = it0 + grp; const bool live = item < nitems; const int itc = live ? item : nitems - 1;
        const int tb = itc % nblk, hd = (itc / nblk) % NH, b = itc / (nblk * NH);
        const int rowb = tb < TC / 64 ? M_LAT + b * TC + 64 * tb : b * T + 64 * (tb - TC / 64);
        __syncthreads();
        f32x4 yl[2][4]; u32x4 qa[2][4]; bf16x8 sb[2][4];
#pragma unroll
        for (int dir = 0; dir < 2; ++dir) {
            const int c = dir == 0 ? tb : (tb < TC / 64 ? TC / 64 - 1 - tb : TC / 64 + (T / 64 - 1 - (tb - TC / 64)));
            const size_t ci = ((size_t)((b * NH + hd) * 2 + dir)) * RCK + c;
#pragma unroll
            for (int g = 0; g < 4; ++g) yl[dir][g] = *(const f32x4*)(YL + ci * 4096 + ((wg * 4 + g) * 64 + lane) * 4);
#pragma unroll
            for (int kp = 0; kp < 2; ++kp)
#pragma unroll
                for (int s = 0; s < 2; ++s) { const bf16* qp = QH + ci * 4096 + (32 * ti + c32) * 64 + 32 * kp + 16 * s + 4 * h; const u32x2 lo = *(const u32x2*)qp, hi = *(const u32x2*)(qp + 8);
                    qa[dir][kp * 2 + s].x = lo.x; qa[dir][kp * 2 + s].y = lo.y; qa[dir][kp * 2 + s].z = hi.x; qa[dir][kp * 2 + s].w = hi.y;
                    sb[dir][kp * 2 + s] = *(const bf16x8*)(SF + ci * 4096 + (((kp * 2 + tj) * 2 + s) * 64 + lane) * 8); }
        }
#pragma unroll
        for (int dir = 0; dir < 2; ++dir) {
            f32x16 y;
#pragma unroll
            for (int g = 0; g < 4; ++g) { const f32x4 a = yl[dir][g]; y[4 * g] = a[0]; y[4 * g + 1] = a[1]; y[4 * g + 2] = a[2]; y[4 * g + 3] = a[3]; }
#pragma unroll
            for (int q4 = 0; q4 < 4; ++q4) y = MMA32(__builtin_bit_cast(bf16x8, qa[dir][q4]), sb[dir][q4], y);
#pragma unroll
            for (int r = 0; r < 16; ++r) { const int i = 32 * ti + (r & 3) + 8 * (r >> 2) + 4 * h, tk = dir ? 63 - i : i; LAS float* p = Ysum + tk * FP + 32 * tj + c32; if (dir == 0) *p = y[r]; else *p += y[r]; }
            __syncthreads();
        }
        if (live) {
            const int cch = hd * 64 + lane; const float rk = C.in[I_RWRK][((size_t)l * NH + hd) * 64 + lane], gw = C.in[I_RWGNW][(size_t)l * GW + cch], gb = C.in[I_RWGNB][(size_t)l * GW + cch];
#pragma unroll 1
            for (int t4 = 0; t4 < 16; t4 += 8) {
                bf16 rb[8], vb[8], kb[8], gb8[8];
#pragma unroll
                for (int u = 0; u < 8; ++u) { const bf16* rv = (const bf16*)(C.ws + WS_RVKG) + (size_t)item * 4 * 4096 + (16 * wg + t4 + u) * 64 + lane; rb[u] = rv[0]; vb[u] = rv[4096]; kb[u] = rv[8192]; gb8[u] = rv[12288]; }
#pragma unroll
                for (int u = 0; u < 8; ++u) { const int tk = 16 * wg + t4 + u, row = rowb + tk; const float r = bf2f(rb[u]), v = bf2f(vb[u]), ks = bf2f(kb[u]), gg = bf2f(gb8[u]);
                    float y = Ysum[tk * FP + lane] + wave_sum(r * ks * rk) * v;
                    const float mu = wave_sum(y) * (1.f / 64.f), dlt = y - mu, var = wave_sum(dlt * dlt) * (1.f / 64.f);
                    if (row < mrows) OB[(size_t)row * D + GW + cch] = (bf16)f2bf((dlt * __builtin_amdgcn_rsqf(var + RW_GN_EPS) * gw + gb) * gg); } }
        }
    }
    __syncthreads();
}
constexpr int S5X_OFF = NW * 16640;
DI void ph_s5scan(const Ctx& C, int l, int first_block, int nblocks) {
    constexpr int nc_ctx = TC / S5L, nc_lat = T / S5L, ntot = nc_ctx + nc_lat, SEG = ntot / NW;
    static_assert(ntot % NW == 0 && S5X_OFF + NW * 64 * 8 <= MISC_OFF, "S5 scan segmentation");
    if ((int)C.bid < first_block || (int)C.bid >= first_block + nblocks) return;
    const float* XE = (const float*)(C.ws + WS_XEND); bf16* UG = (bf16*)(C.ws + WS_UG);
    const f32x2* LAM = (const f32x2*)(C.ws + WS_S5T + (size_t)l * SZ_S5L + OFF_S5LAM);
    LAS f32x2* XCH = (LAS f32x2*)(C.lds + S5X_OFF);
    for (int combo = C.bid - first_block; combo < NB * 2 * S5G; combo += nblocks) {
        const int g = combo % S5G, dir = (combo / S5G) & 1, b = combo / (2 * S5G), n = C.lane, seg = C.wave;
        const f32x2 lm = LAM[(dir * S5G + g) * 64 + n];
        float er[SEG], ei[SEG];
#pragma unroll
        for (int u = 0; u < SEG; ++u) { const int i = seg * SEG + u; const int ch = i < nc_ctx ? (M_LAT + b * TC) / S5L + (dir ? nc_ctx - 1 - i : i) : (b * T) / S5L + (dir ? nc_lat - 1 - (i - nc_ctx) : (i - nc_ctx));
            const float* p = XE + ((size_t)g * NCHP + ch) * 256 + dir * 128 + n; er[u] = p[0]; ei[u] = p[64]; }
        float pr = lm[0], pi = lm[1];
#pragma unroll 1
        for (int u = 1; u < SEG; ++u) { const float tr = pr * lm[0] - pi * lm[1], ti2 = pr * lm[1] + pi * lm[0]; pr = tr; pi = ti2; }
        float xr = 0.f, xi = 0.f;
#pragma unroll
        for (int u = 0; u < SEG; ++u) { const float nr = lm[0] * xr - lm[1] * xi + er[u], ni = lm[0] * xi + lm[1] * xr + ei[u]; xr = nr; xi = ni; }
        XCH[seg * 64 + n] = (f32x2){xr, xi};
        __syncthreads();
        xr = 0.f; xi = 0.f;
        for (int s2 = 0; s2 < seg; ++s2) { const f32x2 e = XCH[s2 * 64 + n]; const float nr = pr * xr - pi * xi + e[0], ni = pr * xi + pi * xr + e[1]; xr = nr; xi = ni; }
        __syncthreads();
#pragma unroll
        for (int u = 0; u < SEG; ++u) { const int i = seg * SEG + u; const int ch = i < nc_ctx ? (M_LAT + b * TC) / S5L + (dir ? nc_ctx - 1 - i : i) : (b * T) / S5L + (dir ? nc_lat - 1 - (i - nc_ctx) : (i - nc_ctx));
            bf16* q = UG + ((size_t)g * NCHP + ch) * S5K + 512 + dir * 128 + n; q[0] = (bf16)f2bf(xr); q[64] = (bf16)f2bf(xi);
            const float nr = lm[0] * xr - lm[1] * xi + er[u], ni = lm[0] * xi + lm[1] * xr + ei[u]; xr = nr; xi = ni; }
    }
}

constexpr int PH_PRO = 3, PH_PER_L = 13, NPH = PH_PRO + PH_PER_L * NL;
#ifndef PROBE_REP
#define PROBE_REP -1
#endif
#define NREP(k) ((k) == PROBE_REP ? 2 : 1)
#ifdef ONLY
#define EN(k) ((k) == ONLY)
#else
#define EN(k) true
#endif
#ifdef EMU
void fwd(Args args) {
    unsigned char* lds = emu::lds_base();
#else
__global__ void __launch_bounds__(NTHR, 2) fwd(Args args) {
    extern __shared__ __attribute__((aligned(16))) unsigned char lds[];
#endif
    Ctx C; C.in = args.in; C.out = args.out; C.ws = args.ws; C.lds = (LAS unsigned char*)lds;
    C.tid = threadIdx.x; C.lane = C.tid & 63; C.wave = __builtin_amdgcn_readfirstlane(C.tid >> 6); C.G = gridDim.x; C.bid = blockIdx.x;
#define REFRESH() do { int t_ = threadIdx.x; OPAQUE(t_); C.tid = t_; C.lane = t_ & 63; C.wave = __builtin_amdgcn_readfirstlane(t_ >> 6); } while (0)
    volatile LAS unsigned* MISC = (volatile LAS unsigned*)(C.lds + MISC_OFF);
    if (C.tid < 32) MISC[C.tid] = 0u;
    __syncthreads();
    const int lo = args.ph_lo, hi = args.ph_hi;
    const bool use_bar = (hi - lo) > 1;
    XcdBarrier bar; bar.bar = (unsigned*)(C.ws + WS_CTL) + CW_BAR; bar.x = 0; bar.st = MISC + 8;
    if (use_bar) bar = xcd_barrier_post((unsigned*)(C.ws + WS_CTL) + CW_BAR, MISC + 8);
#define IN(k) (lo <= (k) && (k) < hi)
#define SEAM(k) do { if (IN(k) && IN((k) + 1)) xcd_barrier(bar); } while (0)
    if (EN(0) && IN(0)) for (int rep = 0; rep < NREP(0); ++rep) { REFRESH(); ph_ada(C); }
    SEAM(0);
    if (EN(1) && IN(1)) { REFRESH(); ph_conv(C); }
    SEAM(1);
    if (EN(2) && IN(2)) for (int rep = 0; rep < NREP(2); ++rep) { REFRESH(); ph_tab(C); }
    SEAM(2);
    for (int l = 0; l < NL; ++l) {
        const int pb = PH_PRO + PH_PER_L * l; const bool want_ctx = l < NL - 1;
        const int mrows_full = M, mrows_out = want_ctx ? M : M_LAT;
        const int nt_attn = AT_NA + AT_WA + (want_ctx ? 2 * AT_CX : 0), nt_attn_a = (int)((long)nt_attn * ATTN_A_PCT / 100);
        bf16* AP = (bf16*)(C.ws + WS_AP); bf16* Hb = (bf16*)(C.ws + WS_H); bf16* OB = (bf16*)(C.ws + WS_OB);
        if (EN(3) && IN(pb + 0)) for (int rep = 0; rep < NREP(3); ++rep) { REFRESH();
            Gemm g{AP, wl(C, l, OFF_W1GU), D, D, D, 0, 0}; Order S; S.init(mrows_full / 256, 2 * FF / 256, 1, C.G, C.bid, D / 64);
            EpiGU E{rowss_ptr(C, l, 0), bias_ptr(C, l, 0), Hb, mrows_full}; gemm_phase(C.lds, g, S, E);
            if (EN(1) && l + 1 < NL) { REFRESH(); const int r = S.total % C.G;
                if ((int)C.bid >= r) conv_weights(C, l + 1, (C.bid - r) * NW + C.wave, (C.G - r) * NW, 0, CI_X1); } }
        SEAM(pb + 0);
        if (EN(4) && IN(pb + 1)) { REFRESH();
            Gemm g{Hb, wl(C, l, OFF_W1D), FF, FF, FF, 0, 0}; Order S; S.init(M_LAT / 256, D / 256, 1, C.G, C.bid, FF / 64);
            EpiRes E{&C, gate_ptr(C, l, 0, 0), gs_ptr(C, l, 1, 0), rowss_ptr(C, l, 1), AP}; gemm_phase(C.lds, g, S, E);
            { REFRESH(); Order S2; S2.init_split(M_LAT / 256, M_CTX / 256, D / 256, 4, C.G, C.bid, FF / 64); EpiAcc E2{&C, gate_ptr(C, l, 0, 0)}; gemm_phase(C.lds, g, S2, E2); } }
        SEAM(pb + 1);
        if (EN(18) && IN(pb + 2)) { REFRESH(); ph_ctxfix(C, gs_ptr(C, l, 1, 0), rowss_ptr(C, l, 1)); }
        SEAM(pb + 2);
        if (EN(5) && IN(pb + 3)) for (int rep = 0; rep < NREP(5); ++rep) { REFRESH();
            Gemm g{AP, wl(C, l, OFF_WIN), D, D, D, 0, 0}; Order S; S.init(mrows_full / 256, NT_IN, 1, C.G, C.bid, D / 64);
            EpiIn E{&C, rowss_ptr(C, l, 1), bias_ptr(C, l, 1), l}; gemm_phase(C.lds, g, S, E); }
        SEAM(pb + 3);
        if (IN(pb + 4)) {
            if (EN(6)) for (int rep = 0; rep < NREP(6); ++rep) { REFRESH(); Gemm g{(const bf16*)(C.ws + WS_UG), (const bf16*)(C.ws + WS_S5T + (size_t)l * SZ_S5L + OFF_S5ET), S5K, 512, 512, (size_t)NCHP * S5K * 2, (size_t)256 * 512 * 2};
              const int off5 = C.G >= 256 ? 32 : 0; Order S; S.init(NCHP / 256, 1, S5G, C.G - off5, (int)C.bid < off5 ? (1 << 28) : (int)C.bid - off5, 512 / 64);        EpiS5A E{(float*)(C.ws + WS_XEND)}; gemm_phase(C.lds, g, S, E); }
            __syncthreads();
            for (int rep = 0; rep < NREP(9); ++rep) { if (EN(9)) { REFRESH(); ph_rw1(C, l); } }
            if (EN(7)) for (int rep = 0; rep < NREP(7); ++rep) { REFRESH(); const int fb = (C.G >= 256 && 2 * C.G < RBLK && RBLK % (2 * C.G) != 0) ? (RBLK % (2 * C.G) + 1) / 2 : 0;
                ph_attn(C, l, want_ctx, C.bid >= fb ? (C.bid - fb) * NW + C.wave : -1, (C.G - fb) * NW, 0, nt_attn_a); }
        }
        SEAM(pb + 4);
        if (IN(pb + 5)) {
            if (EN(17)) for (int rep = 0; rep < NREP(17); ++rep) { REFRESH(); ph_rw2(C); }
            if (EN(10)) for (int rep = 0; rep < NREP(10); ++rep) { REFRESH(); ph_s5scan(C, l, C.G >= 256 ? 64 : 0, C.G >= 256 ? 128 : C.G); }
            { REFRESH();
              const int nrb = C.G < RSTR * 2 ? C.G : RSTR * 2, sb_lo = C.G, sb_hi = C.G;
              const int nworkers = nrb * 7 + (C.G - nrb - (sb_hi - sb_lo)) * NW;
              const int widx = C.bid < nrb ? (C.wave == 0 ? -1 : C.bid * 7 + C.wave - 1) : (C.bid >= sb_lo && C.bid < sb_hi) ? -1 : nrb * 7 + (C.bid - nrb - (C.bid >= sb_hi ? sb_hi - sb_lo : 0)) * NW + C.wave;
              if (EN(7)) ph_attn(C, l, want_ctx, widx, nworkers, nt_attn_a, nt_attn); }
        }
        SEAM(pb + 5);
        if (IN(pb + 6)) {
            if (EN(11)) for (int rep = 0; rep < NREP(11); ++rep) { REFRESH(); Gemm g{(const bf16*)(C.ws + WS_UG), (const bf16*)(C.ws + WS_S5T + (size_t)l * SZ_S5L + OFF_S5BT), S5K, S5K, S5K, (size_t)NCHP * S5K * 2, (size_t)512 * S5K * 2};
              const int off5 = C.G >= 256 ? 64 : 0; Order S; S.init(NCHP / 256, 2, S5G, C.G - off5, (int)C.bid < off5 ? (1 << 28) : (int)C.bid - off5, S5K / 64);        EpiS5C E{(const bf16*)(C.ws + WS_UG), C.in[I_S5D] + (size_t)l * GW, (bf16*)(C.ws + WS_YG)}; gemm_phase(C.lds, g, S, E); }
            if (EN(12)) for (int rep = 0; rep < NREP(12); ++rep) { REFRESH(); ph_rw3(C, l, mrows_out); }
        }
        SEAM(pb + 6);
        if (EN(13) && IN(pb + 7)) for (int rep = 0; rep < NREP(13); ++rep) { REFRESH();
            Gemm g{(const bf16*)(C.ws + WS_YG), wl(C, l, OFF_WGLU), GW, GW, GW, 0, 0}; Order S; S.init(mrows_out / 256, GW / 256, 1, C.G, C.bid, GW / 64);
            EpiGLU E{(const bf16*)(C.ws + WS_YG), C.in[I_S5GLUB] + (size_t)l * GW, OB}; gemm_phase(C.lds, g, S, E); }
        SEAM(pb + 7);
        if (EN(14) && IN(pb + 8)) { REFRESH();
            Gemm g{OB, wl(C, l, OFF_WOUT), D, D, D, 0, 0}; Order S; S.init(M_LAT / 256, D / 256, 1, C.G, C.bid, D / 64);
            EpiRes E{&C, gate_ptr(C, l, 1, 0), gs_ptr(C, l, 2, 0), rowss_ptr(C, l, 2), AP}; gemm_phase(C.lds, g, S, E);
            if (want_ctx) { REFRESH(); Order S2; S2.init_split(M_LAT / 256, M_CTX / 256, D / 256, 4, C.G, C.bid, D / 64); EpiAcc E2{&C, gate_ptr(C, l, 1, 0)}; gemm_phase(C.lds, g, S2, E2); } }
        SEAM(pb + 8);
        if (EN(18) && IN(pb + 9) && want_ctx) { REFRESH(); ph_ctxfix(C, gs_ptr(C, l, 2, 0), rowss_ptr(C, l, 2)); }
        SEAM(pb + 9);
        if (EN(15) && IN(pb + 10)) { REFRESH();
            Gemm g{AP, wl(C, l, OFF_W2GU), D, D, D, 0, 0}; Order S; S.init(mrows_out / 256, 2 * FF / 256, 1, C.G, C.bid, D / 64);
            EpiGU E{rowss_ptr(C, l, 2), bias_ptr(C, l, 2), Hb, mrows_out}; gemm_phase(C.lds, g, S, E);
            if (EN(1) && l + 1 < NL) { REFRESH(); const int r = S.total % C.G;
                if ((int)C.bid >= r) conv_weights(C, l + 1, (C.bid - r) * NW + C.wave, (C.G - r) * NW, CI_X1, CI_LAYER); } }
        SEAM(pb + 10);
        if (EN(16) && IN(pb + 11)) { REFRESH();
            Gemm g{Hb, wl(C, l, OFF_W2D), FF, FF, FF, 0, 0}; Order S; S.init(M_LAT / 256, D / 256, 1, C.G, C.bid, FF / 64);
            const bool more = l + 1 < NL;
            EpiRes E{&C, gate_ptr(C, l, 2, 0), more ? gs_ptr(C, l + 1, 0, 0) : nullptr, more ? rowss_ptr(C, l + 1, 0) : nullptr, AP}; gemm_phase(C.lds, g, S, E);
            if (want_ctx) { REFRESH(); Order S2; S2.init_split(M_LAT / 256, M_CTX / 256, D / 256, 4, C.G, C.bid, FF / 64); EpiAcc E2{&C, gate_ptr(C, l, 2, 0)}; gemm_phase(C.lds, g, S2, E2); } }
        SEAM(pb + 11);
        if (EN(18) && IN(pb + 12) && want_ctx) { REFRESH(); ph_ctxfix(C, gs_ptr(C, l + 1, 0, 0), rowss_ptr(C, l + 1, 0)); }
        SEAM(pb + 12);
    }
#undef IN
#undef SEAM
}

#ifndef MK_PER_PHASE
#define MK_PER_PHASE 0
#endif
#ifdef EMU
int g_emu_grid = 4, g_emu_lo = 0, g_emu_hi = NPH;
#endif
extern "C" void kernel_launch(void* const* d_in, const int* in_sizes, int n_in, void* d_out, int out_size, void* d_ws, size_t ws_size, hipStream_t stream) {
    Args a{};
    for (int i = 0; i < 42; ++i) a.in[i] = (const float*)d_in[i];
    a.out = (float*)d_out; a.ws = (unsigned char*)d_ws;
#ifdef EMU
    if (g_emu_lo == 0) hipMemsetAsync(d_ws, 0, WS_ZERO_END, stream);
    for (int ph = g_emu_lo; ph < g_emu_hi; ++ph) { a.ph_lo = ph; a.ph_hi = ph + 1; fprintf(stderr, "phase %d\n", ph); emu::launch(g_emu_grid, NTHR, LDS_BYTES, [=] { fwd(a); }); }
#else
    static int grid = 0;
    if (grid == 0) {
        if (n_in != 42 || out_size != M_LAT * D || ws_size < WS_END) { fprintf(stderr, "kernel_launch: unexpected shapes (n_in %d out %d ws %zu need %zu)\n", n_in, out_size, ws_size, (size_t)WS_END); grid = -1; return; }
        int dev = 0, cus = 0;
        if (hipGetDevice(&dev) != hipSuccess || hipDeviceGetAttribute(&cus, hipDeviceAttributeMultiprocessorCount, dev) != hipSuccess) { grid = -1; return; }
        if (hipFuncSetAttribute((const void*)fwd, hipFuncAttributeMaxDynamicSharedMemorySize, LDS_BYTES) != hipSuccess) { fprintf(stderr, "kernel_launch: hipFuncSetAttribute failed\n"); grid = -1; return; }
        int per_cu = 0; (void)hipOccupancyMaxActiveBlocksPerMultiprocessor(&per_cu, (const void*)fwd, NTHR, LDS_BYTES); (void)hipGetLastError();
        if (per_cu < 1) fprintf(stderr, "kernel_launch: occupancy query reports %d\n", per_cu);
        grid = cus;
    }
    if (grid < 0) return;
    (void)hipMemsetAsync(d_ws, 0, WS_ZERO_END, stream);
#if MK_PER_PHASE
    for (int ph = 0; ph < NPH; ++ph) { a.ph_lo = ph; a.ph_hi = ph + 1; hipLaunchKernelGGL(fwd, dim3(grid), dim3(NTHR), LDS_BYTES, stream, a); }
#else
    a.ph_lo = 0; a.ph_hi = NPH;
    hipLaunchKernelGGL(fwd, dim3(grid), dim3(NTHR), LDS_BYTES, stream, a);
#endif
#endif
}
```

```cpp
#ifdef EMU
#include "emu/emu.h"
#define LAS
#define GAS
#define ASMV(...) ((void)0)
#define WSYNC() do { int _z = 0; (void)emu::wave_gather(&_z, 4); } while (0)
#define OPAQUE(x) ((void)0)
#define OPAQUE_S(x) ((void)0)
#define PIN(x) ((void)0)
#define PIN4(a, b, c, d) ((void)0)
#define OPAQUE_LDS(p) (p)
#else
#include <hip/hip_runtime.h>
#include <cstdio>
#include <cstdint>
#define LAS __attribute__((address_space(3)))
#define GAS __attribute__((address_space(1)))
#define ASMV(...) asm volatile(__VA_ARGS__)
#define PIN(x) asm volatile("" : "+v"(x) :: "memory")
#define PIN4(a, b, c, d) asm volatile("" : "+v"(a), "+v"(b), "+v"(c), "+v"(d) :: "memory")
template <class P> __device__ __forceinline__ P opaque_lds(P p) { unsigned a = (unsigned)(size_t)p; asm volatile("" : "+v"(a)); return (P)(size_t)a; }
#define OPAQUE_LDS(p) opaque_lds(p)
#define OPAQUE_S(x) asm volatile("" : "+s"(x))
#define OPAQUE(x) asm volatile("" : "+v"(x))
#define WSYNC() asm volatile("s_waitcnt lgkmcnt(0)" ::: "memory")
#endif

#ifdef EMU
constexpr int D = 1024, NB = 2, T = 1024, NL = 2, TC = 256, FF = 1024;
#else
constexpr int D = 2048, NB = 2, T = 8192, NL = 4, TC = 256, FF = 5632;
#endif
constexpr int GW = D / 4, NH = GW / 64, WAG = NH / 2, S5G = GW / 16, GRW = 64, GRH = T / GRW;
constexpr int M_LAT = NB * T, M_CTX = NB * TC, M = M_LAT + M_CTX, NPAN = M / 256;
constexpr int TP = GW / 256;
constexpr int NT_IN = 8 * TP + 2, NINP = NT_IN * 256, D_IN = 8 * GW + 416;
constexpr int PN_AQ = 0, PN_AK = TP, PN_AV = 2 * TP, PN_BR = 3 * TP, PN_BK = 4 * TP, PN_BV = 5 * TP, PN_BS = 6 * TP, PN_CQ = 6 * TP + 1, PN_CKV = 7 * TP + 1, PN_DU = 7 * TP + 2;
constexpr int SRC_AQ = 0, SRC_AK = GW, SRC_AV = 2 * GW, SRC_BR = 3 * GW, SRC_BK = 4 * GW, SRC_BV = 5 * GW, SRC_BS = 6 * GW, SRC_CQ = 6 * GW + 160, SRC_CK = 7 * GW + 160, SRC_CV = 7 * GW + 288, SRC_DU = 7 * GW + 416;
constexpr int S5L = 32, NCH = M / S5L, NCHP = ((NCH + 255) / 256) * 256, S5K = 768;
constexpr int NW = 8, NTHR = 512;
constexpr float NORM_EPS = 1e-6f, RW_GN_EPS = 64e-5f;

typedef unsigned short bf16;
typedef short bf16x8 __attribute__((ext_vector_type(8)));
typedef short s16x4 __attribute__((ext_vector_type(4)));
typedef float f32x4 __attribute__((ext_vector_type(4)));
typedef float f32x2 __attribute__((ext_vector_type(2)));
typedef float f32x16 __attribute__((ext_vector_type(16)));
typedef unsigned u32x4 __attribute__((ext_vector_type(4)));
typedef unsigned u32x2 __attribute__((ext_vector_type(2)));
#define DI __device__ __forceinline__

constexpr size_t al256(size_t x) { return (x + 255) & ~(size_t)255; }
constexpr size_t SZ_BIAS_GU = (size_t)3 * 2 * FF * 4, SZ_BIAS_IN = (size_t)3 * NINP * 4;
constexpr size_t WS_CTL = 0;
constexpr size_t WS_BIAS = 65536;
constexpr size_t SZ_BIAS_L = 2 * SZ_BIAS_GU + SZ_BIAS_IN;
constexpr size_t WS_ROWSS = al256(WS_BIAS + NL * SZ_BIAS_L);
constexpr size_t WS_ZERO_END = al256(WS_ROWSS + (size_t)NL * 3 * M * 4);
constexpr size_t WS_MODV = WS_ZERO_END;
constexpr size_t WS_GS = al256(WS_MODV + (size_t)NL * 3 * 9 * D * 4);
constexpr size_t WS_GATE = al256(WS_GS + (size_t)NL * 9 * D * 4);
constexpr size_t WS_ROPE = al256(WS_GATE + (size_t)NL * 9 * D * 4);
constexpr size_t SZ_WGU = (size_t)2 * FF * D * 2, SZ_WD = (size_t)D * FF * 2, SZ_WIN = (size_t)NINP * D * 2, SZ_WOUT = (size_t)D * D * 2, SZ_WGLU = (size_t)GW * GW * 2;
constexpr size_t OFF_W1GU = 0, OFF_W1D = OFF_W1GU + SZ_WGU, OFF_WIN = OFF_W1D + SZ_WD, OFF_WOUT = OFF_WIN + SZ_WIN, OFF_W2GU = OFF_WOUT + SZ_WOUT, OFF_W2D = OFF_W2GU + SZ_WGU, OFF_WGLU = OFF_W2D + SZ_WD, SZ_WL = OFF_WGLU + SZ_WGLU;
constexpr size_t WS_W = al256(WS_ROPE + 128 * 16 * 8);
constexpr size_t SZ_S5KC = (size_t)S5G * 2 * S5L * 256 * 4, SZ_S5ET = (size_t)S5G * 256 * 512 * 2, SZ_S5BT = (size_t)S5G * 512 * S5K * 2, SZ_S5LAM = (size_t)2 * GW * 4 * 8;
constexpr size_t SZ_S5LP = (size_t)2 * S5G * 64 * (S5L + 1) * 8, SZ_S5BETA = (size_t)2 * S5G * 64 * 16 * 8;
constexpr size_t OFF_S5KC = 0, OFF_S5ET = OFF_S5KC + SZ_S5KC, OFF_S5BT = OFF_S5ET + SZ_S5ET, OFF_S5LAM = OFF_S5BT + SZ_S5BT, OFF_S5LP = al256(OFF_S5LAM + SZ_S5LAM), OFF_S5BETA = OFF_S5LP + SZ_S5LP, SZ_S5L = al256(OFF_S5BETA + SZ_S5BETA);
constexpr size_t WS_S5T = al256(WS_W + NL * SZ_WL);
constexpr size_t WS_XC = al256(WS_S5T + NL * SZ_S5L);
constexpr size_t WS_AP = al256(WS_XC + (size_t)M_CTX * D * 4);
constexpr size_t WS_H = al256(WS_AP + (size_t)M * D * 2);
constexpr size_t WS_QA = al256(WS_H + (size_t)M * FF * 2);
constexpr size_t WS_KA = WS_QA + (size_t)M * GW * 2, WS_VA = WS_KA + (size_t)M * GW * 2, WS_QC = WS_VA + (size_t)M * GW * 2;
constexpr size_t WS_KC = WS_QC + (size_t)M * GW * 2, WS_VC = WS_KC + (size_t)M * 128 * 2;
constexpr size_t WS_PB = WS_VC + (size_t)M * 128 * 2;
constexpr size_t WS_PS = al256(WS_PB + (size_t)M * 3 * GW * 2);
constexpr size_t WS_UG = al256(WS_PS + (size_t)M * 160 * 4);
constexpr size_t WS_RW = al256(WS_UG + (size_t)S5G * NCHP * S5K * 2);
constexpr size_t SZ_RWA = (size_t)M * GW * 4;
enum { RW_R = 0, RW_V, RW_NKK, RW_G, RW_W0, RW_W1, RW_K0, RW_K1, RW_B0, RW_B1, RW_Y0, RW_Y1, RW_NARR };
constexpr size_t WS_XEND = al256(WS_RW + 256);
constexpr size_t WS_YG = al256(WS_XEND + (size_t)S5G * NCHP * 256 * 4);
constexpr size_t WS_OB = al256(WS_YG + (size_t)M * GW * 2);
constexpr int RCK = (TC + T) / 64, RSTR = NB * NH * 2, RITEM = RSTR * RCK;
constexpr size_t WS_QH = al256(WS_OB + (size_t)M * D * 2);
constexpr size_t WS_YL = al256(WS_QH + (size_t)RITEM * 8192);
constexpr size_t WS_MF = al256(WS_YL + (size_t)RITEM * 16384);
constexpr size_t WS_GF = al256(WS_MF + (size_t)RITEM * 8192);
constexpr size_t WS_SF = al256(WS_GF + (size_t)RITEM * 16384);
constexpr int RBLK = NB * NH * ((TC + T) / 64);
constexpr size_t WS_RVKG = al256(WS_SF + (size_t)RITEM * 8192);
constexpr size_t SZ_RWF = (size_t)14 * NH * 2 * 64 * 16;
constexpr size_t WS_RWF = al256(WS_RVKG + (size_t)RBLK * 32768);
constexpr size_t WS_RWS = al256(WS_RWF + NL * SZ_RWF);
constexpr size_t WS_END = al256(WS_RWS + (size_t)512 * 2 * 65536);
constexpr int CW_BAR = 1024;

constexpr int LDS_BYTES = 147456, RING_BYTES = 131072, MISC_OFF = LDS_BYTES - 256;

DI unsigned f2bf(float f) { unsigned u = __float_as_uint(f); return (u + 0x7fffu + ((u >> 16) & 1u)) >> 16; }
#ifdef EMU
DI unsigned pk2(float lo, float hi) { return f2bf(lo) | (f2bf(hi) << 16); }
#else
typedef __bf16 hbf16x2 __attribute__((ext_vector_type(2)));
DI unsigned pk2(float lo, float hi) { const f32x2 v = {lo, hi}; const hbf16x2 b = __builtin_convertvector(v, hbf16x2); return __builtin_bit_cast(unsigned, b); }
#endif
DI float bf2f(unsigned short b) { return __uint_as_float(((unsigned)b) << 16); }
DI float bflo(unsigned w) { return __uint_as_float(w << 16); }
DI float bfhi(unsigned w) { return __uint_as_float(w & 0xffff0000u); }
template <int N> DI float ror_add(float v) { return v + __int_as_float(__builtin_amdgcn_mov_dpp(__float_as_int(v), 0x120 + N, 0xf, 0xf, true)); }
DI float row16_sum(float v) { v = ror_add<8>(v); v = ror_add<4>(v); v = ror_add<2>(v); v = ror_add<1>(v); return v; }
DI float wave_sum(float v) {
    v = row16_sum(v);
    const float a = __int_as_float(__builtin_amdgcn_readlane(__float_as_int(v), 0)), b = __int_as_float(__builtin_amdgcn_readlane(__float_as_int(v), 16)),
                c = __int_as_float(__builtin_amdgcn_readlane(__float_as_int(v), 32)), d = __int_as_float(__builtin_amdgcn_readlane(__float_as_int(v), 48));
    return (a + b) + (c + d);
}
DI float siluf(float x) { return x * __builtin_amdgcn_rcpf(1.f + __expf(-x)); }
DI float fast_tanh(float x) { const float e = __expf(2.f * x); return 1.f - 2.f * __builtin_amdgcn_rcpf(e + 1.f); }
DI float sigmf(float x) { return __builtin_amdgcn_rcpf(1.f + __expf(-x)); }
DI float geluf(float x) { const float z = 0.7978845608028654f * (x + 0.044715f * x * x * x); const float e = __expf(2.f * z); return 0.5f * x * (1.f + (1.f - 2.f * __builtin_amdgcn_rcpf(e + 1.f))); }
DI int stream_of_row(int row) { return row < M_LAT ? row / T : NB; }
DI int stream_of_panel(int pm) { return stream_of_row(pm * 256); }

#define XB_TMO      128
#define XB_XCNT(j)  (256  + 64 * (j))
#define XB_XSUB(j)  (1280 + 64 * (j))
#define XB_XGEN(j)  (2304 + 64 * (j))
#define XB_TOP      3328
#define XB_TOPGEN   3392
#define XCD_BAR_WORDS 3456
#define XB_SPIN_CAP (1u << 18)
DI unsigned xb_ld(unsigned* p)              { return __hip_atomic_load(p, __ATOMIC_RELAXED, __HIP_MEMORY_SCOPE_AGENT); }
DI unsigned xb_add(unsigned* p, unsigned v) { return __hip_atomic_fetch_add(p, v, __ATOMIC_RELAXED, __HIP_MEMORY_SCOPE_AGENT); }
DI unsigned xb_xcc_id() { return (unsigned)__builtin_amdgcn_s_getreg((3 << 11) | 20) & 0xFu; }
#define XB_SPIN(cond, bar) do { unsigned _sp = 0; while (cond) { __builtin_amdgcn_s_sleep(1); \
    if ((++_sp & 255u) == 0u) { if (xb_ld(&(bar)[XB_TMO])) break; if (_sp > XB_SPIN_CAP) { atomicAdd(&(bar)[XB_TMO], 1u); break; } } } } while (0)
struct XcdBarrier { unsigned* bar; unsigned x; volatile LAS unsigned* st; };
DI XcdBarrier xcd_barrier_post(unsigned* bar, volatile LAS unsigned* st) {
    XcdBarrier b; b.bar = bar; b.x = xb_xcc_id(); b.st = st;
    if (threadIdx.x == 0) (void)xb_add(&bar[XB_XCNT(b.x)], 1u);
    return b;
}
DI void xcd_barrier_complete(unsigned* bar, unsigned x, unsigned& nloc, unsigned& nx) {
    const unsigned G = gridDim.x * gridDim.y * gridDim.z;
    unsigned sum, cnt, mine, sp = 0u;
    for (;;) {
        sum = 0u; cnt = 0u; mine = 0u;
#pragma unroll
        for (unsigned j = 0; j < 16; ++j) { const unsigned c = xb_ld(&bar[XB_XCNT(j)]); sum += c; cnt += (c > 0u) ? 1u : 0u; mine = (j == x) ? c : mine; }
        if (sum == G) break;
        __builtin_amdgcn_s_sleep(1);
        if ((++sp & 255u) == 0u) { if (xb_ld(&bar[XB_TMO])) break; if (sp > XB_SPIN_CAP) { atomicAdd(&bar[XB_TMO], 1u); break; } }
    }
    nloc = mine > 0u ? mine : 1u; nx = cnt > 0u ? cnt : 1u;
}
DI void xcd_barrier(const XcdBarrier& b) {
    ASMV("s_waitcnt vmcnt(0)" ::: "memory");
    __syncthreads();
    if (threadIdx.x == 0) {
        unsigned* bar = b.bar;
        __builtin_amdgcn_s_waitcnt(0);
        unsigned nloc = b.st[0], nx = b.st[1];
        if (nloc == 0u) { xcd_barrier_complete(bar, b.x, nloc, nx); b.st[0] = nloc; b.st[1] = nx; }
        const unsigned old = xb_add(&bar[XB_XSUB(b.x)], 1u);
        const unsigned gen = old / nloc;
        if (old + 1u == (gen + 1u) * nloc) {
            __builtin_amdgcn_fence(__ATOMIC_RELEASE, "agent");
            ASMV("s_waitcnt vmcnt(0)" ::: "memory");
            const unsigned og = xb_add(&bar[XB_TOP], 1u);
            const unsigned tg = og / nx;
            if (og + 1u == (tg + 1u) * nx) xb_add(&bar[XB_TOPGEN], 1u);
            else XB_SPIN(xb_ld(&bar[XB_TOPGEN]) == tg, bar);
            __builtin_amdgcn_fence(__ATOMIC_ACQUIRE, "agent");
            xb_add(&bar[XB_XGEN(b.x)], 1u);
            ASMV("s_waitcnt vmcnt(0)" ::: "memory");
        } else {
            XB_SPIN(xb_ld(&bar[XB_XGEN(b.x)]) == gen, bar);
            __builtin_amdgcn_fence(__ATOMIC_ACQUIRE, "agent");
            ASMV("s_waitcnt vmcnt(0)" ::: "memory");
        }
    }
    __syncthreads();
}

constexpr int BK = 64, HALF = 128, HTB = HALF * BK * 2, NXCD = 8, WGM = 4;
DI int lds_byte(int r, int c) { const int st = (r >> 4) * 2 + (c >> 5), rr = r & 15, cc = c & 31, ob = rr * 64 + cc * 2; return st * 1024 + (ob ^ (((ob >> 9) & 1) << 5)); }
DI void stage_rc(int b, int& R, int& C) { const int st = b / 1024, sb = b % 1024, swz = sb ^ (((sb >> 9) & 1) << 5); R = (st >> 1) * 16 + swz / 64; C = (st & 1) * 32 + (swz % 64) / 2; }
struct Unit { int pm, pn, z, kt0; };
struct Gemm { const bf16* A; const bf16* Bt; int lda, ldb, K; size_t zA, zB; };
struct Order {
    int nM, nN, nZ, per, total, G, c, nkt, pm0, spl;
    DI void init(int nM_, int nN_, int nZ_, int G_, int c_, int nkt_) { nM = nM_; nN = nN_; nZ = nZ_; per = nM * nN; total = per * nZ; G = G_; c = c_; nkt = nkt_; pm0 = 0; spl = 0; }
    DI void init_split(int pm0_, int xM, int nN_, int spl_, int G_, int c_, int nkt_full) { nM = xM; nN = nN_; nZ = 1; per = xM * nN_ * spl_; total = per; G = G_; c = c_; nkt = nkt_full / spl_; pm0 = pm0_; spl = spl_; }
    DI bool next(int i, Unit& u) const {
        const long L = (long)i * G + c; if (L >= total) return false;
        if (spl) { const int j = (int)L; u.z = 0; u.pm = pm0 + j / (nN * spl); const int rem = j % (nN * spl); u.pn = rem / spl; u.kt0 = (rem % spl) * nkt; return true; }
        u.kt0 = 0;
        u.z = (int)(L / per); int wgid = (int)(L % per);
        { const int q = per / NXCD, r = per % NXCD, xcd = wgid % NXCD, off = wgid / NXCD; wgid = (xcd < r ? xcd * (q + 1) : r * (q + 1) + (xcd - r) * q) + off; }
        const int nig = WGM * nN, gid = wgid / nig, fm = gid * WGM, gsz = (nM - fm) < WGM ? (nM - fm) : WGM;
        u.pm = fm + ((wgid % nig) % gsz); u.pn = (wgid % nig) / gsz; return true;
    }
};

template <class Epi>
DI void gemm_phase(LAS unsigned char* lds, const Gemm g, const Order& S, const Epi& E) {
    int tid_ = threadIdx.x; OPAQUE(tid_);
    const int tid = tid_, wid = __builtin_amdgcn_readfirstlane(tid >> 6), lane = tid & 63, wr = wid >> 2, wc = wid & 3, fr = lane & 15, fq = lane >> 4;
    Unit cur, nxt; int ui = 0;
    if (!S.next(0, cur)) return;
    f32x4 acc[2][2][4][2];
#ifdef EMU
    (void)lds;
    for (;; ++ui) {
        if (ui > 0) { if (!S.next(ui, cur)) break; }
        const bf16* A = (const bf16*)((const char*)g.A + cur.z * g.zA); const bf16* B = (const bf16*)((const char*)g.Bt + cur.z * g.zB);
        for (int ai = 0; ai < 2; ++ai) for (int bj = 0; bj < 2; ++bj) for (int m = 0; m < 4; ++m) for (int n = 0; n < 2; ++n) for (int j = 0; j < 4; ++j) {
            const int r = 256 * cur.pm + 128 * ai + 64 * wr + 16 * m + fr, c = 256 * cur.pn + 128 * bj + 32 * wc + 16 * n + 4 * fq + j;
            const bf16* a = A + (size_t)r * g.lda; const bf16* b = B + (size_t)c * g.ldb; float s = 0.f;
            for (int k = cur.kt0 * BK; k < (cur.kt0 + S.nkt) * BK; ++k) s += bf2f(a[k]) * bf2f(b[k]);
            acc[ai][bj][m][n][j] = s; }
        E(acc, cur, wr, wc, fr, fq);
    }
#else
    unsigned voffA[2], voffB[2];
#pragma unroll
    for (int i = 0; i < 2; ++i) { int R, C; stage_rc(tid * 16 + i * 8192, R, C); voffA[i] = (unsigned)(R * g.lda + C) * 2u; voffB[i] = (unsigned)(R * g.ldb + C) * 2u; }
    const size_t kstep = (size_t)(BK * 2);
    const size_t hstepA = (size_t)HALF * g.lda * 2, hstepB = (size_t)HALF * g.ldb * 2, tstepA = 2 * hstepA, tstepB = 2 * hstepB;
    const unsigned ldsw = (unsigned)wid * 1024u;
    const int aoff = lds_byte(wr * 64 + fr, fq * 8), boff = lds_byte(wc * 32 + fr, fq * 8);
#define PG8_SA(b, h) (((b) * 2 + (h)) * HTB)
#define PG8_SB(b, h) ((4 + (b) * 2 + (h)) * HTB)
#define PG8_STAGE(bufoff, gbase, voff) do { _Pragma("unroll") for (int _i = 0; _i < 2; ++_i) \
        __builtin_amdgcn_global_load_lds((const unsigned*)((const char*)(gbase) + (voff)[_i]), (LAS unsigned*)(lds + (bufoff) + ldsw + _i * 8192), 16, 0, 0); } while (0)
#define PG8_LDA(dst, b, h) do { _Pragma("unroll") for (int m = 0; m < 4; ++m) _Pragma("unroll") for (int k = 0; k < 2; ++k) dst[m][k] = *(const LAS bf16x8*)(lds + PG8_SA(b, h) + aoff + m * 2048 + k * 1024); } while (0)
#define PG8_LDB(dst, b, h) do { _Pragma("unroll") for (int n = 0; n < 2; ++n) _Pragma("unroll") for (int k = 0; k < 2; ++k) dst[n][k] = *(const LAS bf16x8*)(lds + PG8_SB(b, h) + boff + n * 2048 + k * 1024); } while (0)
#define PG8_MMA(ai, bj, At, Bt) do { __builtin_amdgcn_s_setprio(1); _Pragma("unroll") for (int m = 0; m < 4; ++m) _Pragma("unroll") for (int n = 0; n < 2; ++n) _Pragma("unroll") for (int k = 0; k < 2; ++k) \
        acc[ai][bj][m][n] = __builtin_amdgcn_mfma_f32_16x16x32_bf16(Bt[n][k], At[m][k], acc[ai][bj][m][n], 0, 0, 0); __builtin_amdgcn_s_setprio(0); } while (0)
#define PG8_WAIT_V(n) asm volatile("s_waitcnt vmcnt(" #n ")" ::: "memory")
#define PG8_WAIT_L(n) asm volatile("s_waitcnt lgkmcnt(" #n ")" ::: "memory")
#define PG8_BAR __builtin_amdgcn_s_barrier()
#define PG8_SCHED __builtin_amdgcn_sched_barrier(0)
#pragma unroll
    for (int a = 0; a < 2; ++a)
#pragma unroll
        for (int b = 0; b < 2; ++b)
#pragma unroll
            for (int m = 0; m < 4; ++m)
#pragma unroll
                for (int n = 0; n < 2; ++n) acc[a][b][m][n] = (f32x4){0.f, 0.f, 0.f, 0.f};
    bf16x8 At[4][2], B0[2][2], B1[2][2];
    const char* cA = (const char*)g.A + (size_t)cur.z * g.zA + (size_t)cur.pm * tstepA + (size_t)cur.kt0 * kstep; const char* cB = (const char*)g.Bt + (size_t)cur.z * g.zB + (size_t)cur.pn * tstepB + (size_t)cur.kt0 * kstep;
    PG8_STAGE(PG8_SB(0, 0), cB, voffB); PG8_STAGE(PG8_SB(0, 1), cB + hstepB, voffB); PG8_STAGE(PG8_SA(0, 0), cA, voffA); PG8_STAGE(PG8_SA(0, 1), cA + hstepA, voffA);
    if (wr == 1) PG8_BAR;
    PG8_WAIT_V(2); PG8_BAR;
    PG8_STAGE(PG8_SB(1, 0), cB + kstep, voffB); PG8_STAGE(PG8_SA(1, 0), cA + kstep, voffA); PG8_STAGE(PG8_SB(1, 1), cB + hstepB + kstep, voffB);
    PG8_WAIT_V(6); PG8_BAR;
    for (;;) {
        const bool has_next = S.next(ui + 1, nxt);
        const char* nA = has_next ? (const char*)g.A + (size_t)nxt.z * g.zA + (size_t)nxt.pm * tstepA + (size_t)nxt.kt0 * kstep : cA; const char* nB = has_next ? (const char*)g.Bt + (size_t)nxt.z * g.zB + (size_t)nxt.pn * tstepB + (size_t)nxt.kt0 * kstep : cB;
        const int nt = S.nkt;
        for (int t = 0; t < nt; t += 2) {
            const bool last = (t == nt - 2);
            const char* a1 = cA + (size_t)(t + 1) * kstep;
            const char* a2 = last ? nA : cA + (size_t)(t + 2) * kstep; const char* b2 = last ? nB : cB + (size_t)(t + 2) * kstep;
            const char* a3 = a2 + kstep; const char* b3 = b2 + kstep;
            PG8_LDB(B0, 0, 0); PG8_LDB(B1, 0, 1); PG8_SCHED; PG8_LDA(At, 0, 0); PG8_STAGE(PG8_SA(1, 1), a1 + hstepA, voffA);
            PG8_WAIT_V(8); PG8_WAIT_L(0); PG8_BAR; PG8_MMA(0, 0, At, B0); PG8_MMA(0, 1, At, B1); PG8_BAR; PG8_SCHED;
            PG8_LDA(At, 0, 1); PG8_STAGE(PG8_SB(0, 0), b2, voffB); PG8_STAGE(PG8_SB(0, 1), b2 + hstepB, voffB); PG8_STAGE(PG8_SA(0, 0), a2, voffA);
            PG8_WAIT_V(8); PG8_WAIT_L(0); PG8_BAR; PG8_MMA(1, 0, At, B0); PG8_MMA(1, 1, At, B1); PG8_BAR; PG8_SCHED;
            PG8_LDB(B0, 1, 0); PG8_LDB(B1, 1, 1); PG8_SCHED; PG8_LDA(At, 1, 0); PG8_STAGE(PG8_SA(0, 1), a2 + hstepA, voffA);
            PG8_WAIT_V(8); PG8_WAIT_L(0); PG8_BAR; PG8_MMA(0, 0, At, B0); PG8_MMA(0, 1, At, B1); PG8_BAR; PG8_SCHED;
            PG8_LDA(At, 1, 1); PG8_STAGE(PG8_SB(1, 0), b3, voffB); PG8_STAGE(PG8_SB(1, 1), b3 + hstepB, voffB); PG8_STAGE(PG8_SA(1, 0), a3, voffA);
            PG8_WAIT_V(8); PG8_WAIT_L(0); PG8_BAR; PG8_MMA(1, 0, At, B0); PG8_MMA(1, 1, At, B1); PG8_BAR; PG8_SCHED;
        }
        if (wr == 0) PG8_BAR;
        E(acc, cur, wr, wc, fr, fq);
        if (!has_next) break;
#pragma unroll
        for (int a = 0; a < 2; ++a)
#pragma unroll
            for (int b = 0; b < 2; ++b)
#pragma unroll
                for (int m = 0; m < 4; ++m)
#pragma unroll
                    for (int n = 0; n < 2; ++n) acc[a][b][m][n] = (f32x4){0.f, 0.f, 0.f, 0.f};
        cur = nxt; cA = nA; cB = nB; ++ui;
        if (wr == 1) PG8_BAR;
    }
    PG8_WAIT_V(0);
    PG8_BAR;
#undef PG8_SA
#undef PG8_SB
#undef PG8_STAGE
#undef PG8_LDA
#undef PG8_LDB
#undef PG8_MMA
#undef PG8_WAIT_V
#undef PG8_WAIT_L
#undef PG8_BAR
#undef PG8_SCHED
#endif
}

struct Args {
    const float* in[42]; float* out; unsigned char* ws;
    int ph_lo, ph_hi;
};
struct Ctx {
    const float* const* in; float* out; unsigned char* ws;
    LAS unsigned char* lds; int tid, lane, wave, G, bid;
};
DI float* xrow_ptr(const Ctx& C, int row) { return row < M_LAT ? C.out + (size_t)row * D : (float*)(C.ws + WS_XC) + (size_t)(row - M_LAT) * D; }
DI const bf16* wl(const Ctx& C, int l, size_t off) { return (const bf16*)(C.ws + WS_W + (size_t)l * SZ_WL + off); }
DI float* bias_ptr(const Ctx& C, int l, int which  ) { return (float*)(C.ws + WS_BIAS + (size_t)l * SZ_BIAS_L + (which == 0 ? 0 : which == 1 ? SZ_BIAS_GU : SZ_BIAS_GU + SZ_BIAS_IN)); }
DI float* rowss_ptr(const Ctx& C, int l, int sub) { return (float*)(C.ws + WS_ROWSS) + ((size_t)l * 3 + sub) * M; }
DI const float* gs_ptr(const Ctx& C, int l, int sub, int s) { return (const float*)(C.ws + WS_GS) + (((size_t)l * 3 + sub) * 3 + s) * D; }
DI const float* gate_ptr(const Ctx& C, int l, int sub, int s) { return (const float*)(C.ws + WS_GATE) + (((size_t)l * 3 + sub) * 3 + s) * D; }
DI float* rw_arr(const Ctx& C, int a) { return (float*)(C.ws + WS_RW + (size_t)a * SZ_RWA); }
enum { I_X = 0, I_C, I_CTX, I_CCTX, I_WADA, I_BADA, I_NORMG, I_F1WG, I_F1WU, I_F1WD, I_F2WG, I_F2WU, I_F2WD, I_WIN, I_WOUT, I_NAQG, I_NAKG, I_NARPB, I_RWCONV, I_RWW0, I_RWWUP, I_RWA0, I_RWAUP,
       I_RWGUP, I_RWKK, I_RWKA, I_RWRK, I_RWGNW, I_RWGNB, I_WAQG, I_WAKG, I_WASINK, I_S5ARE, I_S5AIM, I_S5LDT, I_S5BRE, I_S5BIM, I_S5CRE, I_S5CIM, I_S5D, I_S5GLUW, I_S5GLUB, I_NIN };

struct EpiGU {
    const float* rowss; const float* bias  ; bf16* H; int mrows;
    DI void operator()(const f32x4 (&acc)[2][2][4][2], const Unit& u, int wr, int wc, int fr_, int fq_) const {
        int tz_ = threadIdx.x; OPAQUE(tz_); const int fr = tz_ & 15, fq = (tz_ & 63) >> 4; (void)fr_; (void)fq_;
        const int s = stream_of_panel(u.pm); const float* bs = bias + (size_t)s * 2 * FF + u.pn * 256 + wc * 32 + 4 * fq;
        f32x4 bg[2], bu[2];
#pragma unroll
        for (int n = 0; n < 2; ++n) { bg[n] = *(const f32x4*)(bs + 16 * n); bu[n] = *(const f32x4*)(bs + 128 + 16 * n); }
        float rsv[2][4];
#pragma unroll
        for (int ai = 0; ai < 2; ++ai)
#pragma unroll
            for (int m = 0; m < 4; ++m) rsv[ai][m] = rowss[u.pm * 256 + ai * 128 + wr * 64 + m * 16 + fr];
#pragma unroll
        for (int ai = 0; ai < 2; ++ai)
#pragma unroll
            for (int m = 0; m < 4; ++m) {
                const int row = u.pm * 256 + ai * 128 + wr * 64 + m * 16 + fr;
                const float rstd = __builtin_amdgcn_rsqf(rsv[ai][m] * (1.0f / D) + NORM_EPS);
                bf16* hp = H + (size_t)row * FF + u.pn * 128 + wc * 32 + 8 * fq;
                u32x4 w;
                { const f32x4 g = acc[ai][0][m][0] * rstd + bg[0], v = acc[ai][1][m][0] * rstd + bu[0]; w.x = pk2(siluf(g[0]) * v[0], siluf(g[1]) * v[1]); w.y = pk2(siluf(g[2]) * v[2], siluf(g[3]) * v[3]); }
                { const f32x4 g = acc[ai][0][m][1] * rstd + bg[1], v = acc[ai][1][m][1] * rstd + bu[1]; w.z = pk2(siluf(g[0]) * v[0], siluf(g[1]) * v[1]); w.w = pk2(siluf(g[2]) * v[2], siluf(g[3]) * v[3]); }
                *(u32x4*)hp = w;
            }
    }
};
struct EpiRes {
    const Ctx* C; const float* gate  ; const float* gsn  ; float* rowss_next; bf16* AP;
    DI void operator()(const f32x4 (&acc)[2][2][4][2], const Unit& u, int wr, int wc, int fr_, int fq_) const {
        int tz_ = threadIdx.x; OPAQUE(tz_); const int fr = tz_ & 15, fq = (tz_ & 63) >> 4; (void)fr_; (void)fq_;
        const int s = stream_of_panel(u.pm); const int col0 = u.pn * 256 + wc * 32 + 4 * fq;
        f32x4 gv[2][2], sv[2][2];
#pragma unroll
        for (int bj = 0; bj < 2; ++bj)
#pragma unroll
            for (int n = 0; n < 2; ++n) { gv[bj][n] = *(const f32x4*)(gate + (size_t)s * D + col0 + bj * 128 + n * 16); sv[bj][n] = gsn ? *(const f32x4*)(gsn + (size_t)s * D + col0 + bj * 128 + n * 16) : (f32x4){0.f, 0.f, 0.f, 0.f}; }
        f32x4 xc[2][2], xn[2][2];
        { const float* xp0 = xrow_ptr(*C, u.pm * 256 + wr * 64 + fr) + col0;
#pragma unroll
          for (int bj = 0; bj < 2; ++bj)
#pragma unroll
              for (int n = 0; n < 2; ++n) xn[bj][n] = *(const f32x4*)(xp0 + bj * 128 + n * 16); }
#pragma unroll
        for (int ai = 0; ai < 2; ++ai)
#pragma unroll
            for (int m = 0; m < 4; ++m) {
                const int row = u.pm * 256 + ai * 128 + wr * 64 + m * 16 + fr;
                float* xp = xrow_ptr(*C, row) + col0; float ss = 0.f;
#pragma unroll
                for (int bj = 0; bj < 2; ++bj)
#pragma unroll
                    for (int n = 0; n < 2; ++n) xc[bj][n] = xn[bj][n];
                if (ai * 4 + m < 7) { const int rn = ai * 4 + m + 1; const float* xq = xrow_ptr(*C, u.pm * 256 + (rn >> 2) * 128 + wr * 64 + (rn & 3) * 16 + fr) + col0;
#pragma unroll
                    for (int bj = 0; bj < 2; ++bj)
#pragma unroll
                        for (int n = 0; n < 2; ++n) xn[bj][n] = *(const f32x4*)(xq + bj * 128 + n * 16); }
#pragma unroll
                for (int bj = 0; bj < 2; ++bj)
#pragma unroll
                    for (int n = 0; n < 2; ++n) { f32x4 x = xc[bj][n]; x += gv[bj][n] * acc[ai][bj][m][n]; *(f32x4*)(xp + bj * 128 + n * 16) = x;
                        if (gsn) { ss += (x[0] * x[0] + x[1] * x[1]) + (x[2] * x[2] + x[3] * x[3]); const f32x4 a = x * sv[bj][n]; u32x2 w; w.x = pk2(a[0], a[1]); w.y = pk2(a[2], a[3]);
                            *(u32x2*)(AP + (size_t)row * D + col0 + bj * 128 + n * 16) = w; } }
                if (gsn) { ss += __shfl_xor(ss, 16); ss += __shfl_xor(ss, 32); if (fq == 0) atomicAdd(rowss_next + row, ss); }
            }
    }
};
struct EpiAcc {
    const Ctx* C; const float* gate;
    DI void operator()(const f32x4 (&acc)[2][2][4][2], const Unit& u, int wr, int wc, int fr_, int fq_) const {
        int tz_ = threadIdx.x; OPAQUE(tz_); const int fr = tz_ & 15, fq = (tz_ & 63) >> 4; (void)fr_; (void)fq_;
        const int s = stream_of_panel(u.pm); const int col0 = u.pn * 256 + wc * 32 + 4 * fq;
#pragma unroll
        for (int bj = 0; bj < 2; ++bj)
#pragma unroll
            for (int n = 0; n < 2; ++n) { const f32x4 gv = *(const f32x4*)(gate + (size_t)s * D + col0 + bj * 128 + n * 16);
#pragma unroll
                for (int ai = 0; ai < 2; ++ai)
#pragma unroll
                    for (int m = 0; m < 4; ++m) { float* xp = xrow_ptr(*C, u.pm * 256 + ai * 128 + wr * 64 + m * 16 + fr) + col0 + bj * 128 + n * 16; const f32x4 d = gv * acc[ai][bj][m][n];
#pragma unroll
                        for (int j = 0; j < 4; ++j) atomicAdd(xp + j, d[j]); } }
    }
};
struct EpiIn {
    const Ctx* C; const float* rowss; const float* bias  ; int l;
    DI void operator()(const f32x4 (&acc)[2][2][4][2], const Unit& u, int wr, int wc, int fr_, int fq_) const {
        int tz_ = threadIdx.x; OPAQUE(tz_); const int fr = tz_ & 15, fq = (tz_ & 63) >> 4; (void)fr_; (void)fq_;
        const int s = stream_of_panel(u.pm), pn = u.pn; const float* bs = bias + (size_t)s * NINP + pn * 256 + wc * 32 + 4 * fq;
        unsigned char* ws = C->ws;
        f32x4 bv[2][2];
#pragma unroll
        for (int bj = 0; bj < 2; ++bj)
#pragma unroll
            for (int n = 0; n < 2; ++n) bv[bj][n] = *(const f32x4*)(bs + bj * 128 + n * 16);
        float rsv[2][4];
#pragma unroll
        for (int ai = 0; ai < 2; ++ai)
#pragma unroll
            for (int m = 0; m < 4; ++m) rsv[ai][m] = rowss[u.pm * 256 + ai * 128 + wr * 64 + m * 16 + fr];
        const bool permuted = pn < PN_AV || (pn >= PN_CQ && pn < PN_DU);
        if (permuted) {
            const bool is_ckv = pn == PN_CKV, is_c = pn >= PN_CQ, is_q = pn < PN_AK || (pn >= PN_CQ && pn < PN_CKV);
            const bool plain_v = is_ckv && wc >= 2;
            const float* gsrc = C->in[is_c ? (is_q ? I_WAQG : I_WAKG) : (is_q ? I_NAQG : I_NAKG)] + (size_t)l * 64;
            f32x4 gn[2][2];
#pragma unroll
            for (int bj = 0; bj < 2; ++bj)
#pragma unroll
                for (int n = 0; n < 2; ++n) { gn[bj][n] = *(const f32x4*)(gsrc + 32 * bj + 16 * n + 4 * fq); if (is_q) gn[bj][n] *= 0.125f; }
            bf16* dst; int pitch, hcol;
            if (pn < PN_AK) { dst = (bf16*)(ws + WS_QA); pitch = GW; hcol = ((pn - PN_AQ) * 4 + wc) * 64; }
            else if (pn < PN_AV) { dst = (bf16*)(ws + WS_KA) + (size_t)((pn - PN_AK) * 4 + wc) * M * 64; pitch = 64; hcol = 0; }
            else if (pn < PN_CKV) { dst = (bf16*)(ws + WS_QC); pitch = GW; hcol = ((pn - PN_CQ) * 4 + wc) * 64; }
            else if (wc < 2) { dst = (bf16*)(ws + WS_KC) + (size_t)wc * M * 64; pitch = 64; hcol = 0; }
            else { dst = (bf16*)(ws + WS_VC) + (size_t)(wc - 2) * M * 64; pitch = 64; hcol = 0; }
            const f32x4* rope = (const f32x4*)(ws + WS_ROPE);
#pragma unroll
            for (int ai = 0; ai < 2; ++ai)
#pragma unroll
                for (int m = 0; m < 4; ++m) {
                    const int row = pn * 0 + u.pm * 256 + ai * 128 + wr * 64 + m * 16 + fr;
                    const float rstd = __builtin_amdgcn_rsqf(rsv[ai][m] * (1.0f / D) + NORM_EPS);
                    f32x4 v[2][2]; float ss = 0.f;
#pragma unroll
                    for (int bj = 0; bj < 2; ++bj)
#pragma unroll
                        for (int n = 0; n < 2; ++n) { v[bj][n] = acc[ai][bj][m][n] * rstd + bv[bj][n]; ss += (v[bj][n][0] * v[bj][n][0] + v[bj][n][1] * v[bj][n][1]) + (v[bj][n][2] * v[bj][n][2] + v[bj][n][3] * v[bj][n][3]); }
                    ss += __shfl_xor(ss, 16); ss += __shfl_xor(ss, 32);
                    if (!plain_v) { const float rs = 1.0f / sqrtf(ss * (1.0f / 64.0f) + NORM_EPS);
#pragma unroll
                        for (int bj = 0; bj < 2; ++bj)
#pragma unroll
                            for (int n = 0; n < 2; ++n) v[bj][n] = v[bj][n] * rs * gn[bj][n];
                        if (is_c && row < M_LAT) {
                            const int t = row % T; const int pos[2] = {t / GRW, t % GRW};
#pragma unroll
                            for (int bj = 0; bj < 2; ++bj) { const f32x4 cs0 = rope[(pos[bj] * 16 + 4 * fq) / 2], cs1 = rope[(pos[bj] * 16 + 4 * fq) / 2 + 1];
                                const float cc[4] = {cs0[0], cs0[2], cs1[0], cs1[2]}, sn[4] = {cs0[1], cs0[3], cs1[1], cs1[3]};
#pragma unroll
                                for (int j = 0; j < 4; ++j) { const float x1 = v[bj][0][j], x2 = v[bj][1][j]; v[bj][0][j] = x1 * cc[j] - x2 * sn[j]; v[bj][1][j] = x2 * cc[j] + x1 * sn[j]; } }
                        }
                    }
                    bf16* op = dst + (size_t)row * pitch + hcol + 4 * fq;
#pragma unroll
                    for (int bj = 0; bj < 2; ++bj)
#pragma unroll
                        for (int n = 0; n < 2; ++n) { u32x2 w; w.x = pk2(v[bj][n][0], v[bj][n][1]); w.y = pk2(v[bj][n][2], v[bj][n][3]); *(u32x2*)(op + 32 * bj + 16 * n) = w; }
                }
        } else {
#pragma unroll
            for (int ai = 0; ai < 2; ++ai)
#pragma unroll
                for (int m = 0; m < 4; ++m) {
                    const int row = u.pm * 256 + ai * 128 + wr * 64 + m * 16 + fr;
                    const float rstd = __builtin_amdgcn_rsqf(rsv[ai][m] * (1.0f / D) + NORM_EPS);
#pragma unroll
                    for (int bj = 0; bj < 2; ++bj)
#pragma unroll
                        for (int n = 0; n < 2; ++n) { const f32x4 v = acc[ai][bj][m][n] * rstd + bv[bj][n]; const int c = bj * 128 + wc * 32 + n * 16 + 4 * fq;
                            u32x2 w; w.x = pk2(v[0], v[1]); w.y = pk2(v[2], v[3]);
                            if (pn < PN_BR) *(u32x2*)((bf16*)(ws + WS_VA) + ((size_t)((pn - PN_AV) * 4 + bj * 2 + (wc >> 1)) * M + row) * 64 + (wc & 1) * 32 + n * 16 + 4 * fq) = w;
                            else if (pn < PN_BS) *(u32x2*)((bf16*)(ws + WS_PB) + (size_t)row * 3 * GW + (pn - PN_BR) * 256 + c) = w;
                            else if (pn == PN_BS) { if (c < 160) *(f32x4*)((float*)(ws + WS_PS) + (size_t)row * 160 + c) = v; }
                            else { const int cu = (pn - PN_DU) * 256 + c, gq = cu >> 4, p0 = cu & 15;
                                *(u32x2*)((bf16*)(ws + WS_UG) + ((size_t)gq * NCHP + row / S5L) * S5K + (row % S5L) * 16 + p0) = w; } }
                }
        }
    }
};
struct EpiS5A {
    float* XE;
    DI void operator()(const f32x4 (&acc)[2][2][4][2], const Unit& u, int wr, int wc, int fr_, int fq_) const {
        int tz_ = threadIdx.x; OPAQUE(tz_); const int fr = tz_ & 15, fq = (tz_ & 63) >> 4; (void)fr_; (void)fq_;
#pragma unroll
        for (int ai = 0; ai < 2; ++ai)
#pragma unroll
            for (int m = 0; m < 4; ++m) { const int ch = u.pm * 256 + ai * 128 + wr * 64 + m * 16 + fr; if (ch < NCH) { float* p = XE + ((size_t)u.z * NCHP + ch) * 256 + wc * 32 + 4 * fq;
#pragma unroll
                for (int bj = 0; bj < 2; ++bj)
#pragma unroll
                    for (int n = 0; n < 2; ++n) *(f32x4*)(p + bj * 128 + n * 16) = acc[ai][bj][m][n]; } }
    }
};
struct EpiS5C {
    const bf16* UG; const float* dsk  ; bf16* YG;
    DI void operator()(const f32x4 (&acc)[2][2][4][2], const Unit& u, int wr, int wc, int fr_, int fq_) const {
        int tz_ = threadIdx.x; OPAQUE(tz_); const int fr = tz_ & 15, fq = (tz_ & 63) >> 4; (void)fr_; (void)fq_;
        const int g = u.z;
#pragma unroll
        for (int ai = 0; ai < 2; ++ai)
#pragma unroll
            for (int m = 0; m < 4; ++m) { const int ch = u.pm * 256 + ai * 128 + wr * 64 + m * 16 + fr; if (ch < NCH) {
#pragma unroll
                for (int bj = 0; bj < 2; ++bj)
#pragma unroll
                    for (int n = 0; n < 2; ++n) { const int col = u.pn * 256 + bj * 128 + wc * 32 + n * 16 + 4 * fq, i = col >> 4, p0 = col & 15;
                        const u32x2 uw = *(const u32x2*)(UG + ((size_t)g * NCHP + ch) * S5K + col); const f32x4 dv = *(const f32x4*)(dsk + 16 * g + p0);
                        const f32x4 a = acc[ai][bj][m][n]; const float y0 = a[0] + dv[0] * bflo(uw.x), y1 = a[1] + dv[1] * bfhi(uw.x), y2 = a[2] + dv[2] * bflo(uw.y), y3 = a[3] + dv[3] * bfhi(uw.y);
                        u32x2 w; w.x = pk2(geluf(y0), geluf(y1)); w.y = pk2(geluf(y2), geluf(y3));
                        *(u32x2*)(YG + (size_t)(ch * S5L + i) * GW + 16 * g + p0) = w; } } }
    }
};
struct EpiGLU {
    const bf16* YG; const float* gb; bf16* OB;
    DI void operator()(const f32x4 (&acc)[2][2][4][2], const Unit& u, int wr, int wc, int fr_, int fq_) const {
        int tz_ = threadIdx.x; OPAQUE(tz_); const int fr = tz_ & 15, fq = (tz_ & 63) >> 4; (void)fr_; (void)fq_;
#pragma unroll
        for (int ai = 0; ai < 2; ++ai)
#pragma unroll
            for (int m = 0; m < 4; ++m) { const int row = u.pm * 256 + ai * 128 + wr * 64 + m * 16 + fr;
#pragma unroll
                for (int bj = 0; bj < 2; ++bj)
#pragma unroll
                    for (int n = 0; n < 2; ++n) { const int col = u.pn * 256 + bj * 128 + wc * 32 + n * 16 + 4 * fq; const f32x4 b = *(const f32x4*)(gb + col); const f32x4 a = acc[ai][bj][m][n] + b;
                        const u32x2 yw = *(const u32x2*)(YG + (size_t)row * GW + col);
                        u32x2 w; w.x = pk2(bflo(yw.x) * sigmf(a[0]), bfhi(yw.x) * sigmf(a[1])); w.y = pk2(bflo(yw.y) * sigmf(a[2]), bfhi(yw.y) * sigmf(a[3]));
                        *(u32x2*)(OB + (size_t)row * D + 3 * GW + col) = w; } }
    }
};

DI void ph_ada(const Ctx& C) {
    LAS float* sc = (LAS float*)C.lds;
    LAS float* red = sc + 3 * D;
    for (int i = C.tid; i < 3 * D; i += NTHR) { const int s = i / D, k = i % D; const float c = s < NB ? C.in[I_C][s * D + k] : C.in[I_CCTX][k]; sc[i] = siluf(c); }
    __syncthreads();
    const int nun = NL * (9 * D / 256);
    for (int un = C.bid; un < nun; un += C.G) {
        const int l = un / (9 * D / 256), col0 = (un % (9 * D / 256)) * 256;
        const float* W = C.in[I_WADA] + (size_t)l * D * 9 * D + col0 + 4 * C.lane;
        f32x4 a0 = {0.f, 0.f, 0.f, 0.f}, a1 = a0, a2 = a0;
        const int k0 = C.wave * (D / 8);
#pragma unroll 1
        for (int kb = k0; kb < k0 + D / 8; kb += 16) {
            f32x4 wv[16];
#pragma unroll
            for (int u = 0; u < 16; ++u) wv[u] = *(const f32x4*)(W + (size_t)(kb + u) * 9 * D);
#pragma unroll
            for (int u = 0; u < 16; ++u) { a0 += wv[u] * sc[kb + u]; a1 += wv[u] * sc[D + kb + u]; a2 += wv[u] * sc[2 * D + kb + u]; } }
        LAS float* r = red + C.wave * 768 + 4 * C.lane;
        *(LAS f32x4*)(r) = a0; *(LAS f32x4*)(r + 256) = a1; *(LAS f32x4*)(r + 512) = a2;
        __syncthreads();
        for (int i = C.tid; i < 768; i += NTHR) { float s = 0.f;
#pragma unroll
            for (int w = 0; w < 8; ++w) s += red[w * 768 + i];
            const int st = i / 256, c = col0 + (i % 256);
            ((float*)(C.ws + WS_MODV))[((size_t)l * 3 + st) * 9 * D + c] = s + C.in[I_BADA][(size_t)l * 9 * D + c]; }
        __syncthreads();
    }
}
DI const float* modv_ptr(const Ctx& C, int l, int s, int chunk) { return (const float*)(C.ws + WS_MODV) + ((size_t)l * 3 + s) * 9 * D + (size_t)chunk * D; }

DI int win_dest(int n) {
    if (n >= D_IN) return -1;
    if (n < SRC_AV) { const int piece = n / GW, loc = n % GW, head = loc / 64, d = loc % 64; return ((piece == 0 ? PN_AQ : PN_AK) + head / 4) * 256 + 128 * (d / 32) + 32 * (head % 4) + (d % 32); }
    if (n < SRC_BS) return PN_AV * 256 + (n - SRC_AV);
    if (n < SRC_CQ) return PN_BS * 256 + (n - SRC_BS);
    if (n < SRC_CK) { const int loc = n - SRC_CQ, head = loc / 64, d = loc % 64; return (PN_CQ + head / 4) * 256 + 128 * (d / 32) + 32 * (head % 4) + (d % 32); }
    if (n < SRC_DU) { const int loc = n - SRC_CK, hh = loc / 64, d = loc % 64; return PN_CKV * 256 + 128 * (d / 32) + 32 * hh + (d % 32); }
    return PN_DU * 256 + (n - SRC_DU);
}
DI int gu_dest(int n) { const int e = n & 31; return (n / 128) * 256 + (n % 128 - e) + 16 * ((e >> 2) & 1) + 4 * (e >> 3) + (e & 3); }
DI void conv_item(const Ctx& C, const float* W, int K, int N, bf16* Wt, int mode, int k0, int n0, float* bias, int bias_pitch, const float* shift  ) {
    LAS float* scr = (LAS float*)(C.lds + C.wave * 16640);
    const int n = n0 + C.lane; const bool ok = n < N; float b0 = 0.f, b1 = 0.f, b2 = 0.f;
#pragma unroll 1
    for (int kh = 0; kh < 4; ++kh) {
        float wv[16];
#pragma unroll
        for (int kk = 0; kk < 16; ++kk) wv[kk] = ok ? W[(size_t)(k0 + 16 * kh + kk) * N + n] : 0.f;
#pragma unroll
        for (int kk = 0; kk < 16; ++kk) { const float v = wv[kk]; scr[(16 * kh + kk) * 65 + C.lane] = v;
            if (bias) { b0 += shift[k0 + 16 * kh + kk] * v; b1 += shift[9 * D + k0 + 16 * kh + kk] * v; b2 += shift[18 * D + k0 + 16 * kh + kk] * v; } } }
    WSYNC();
    const int dme = !ok ? -1 : mode == 0 ? n : mode == 1 ? gu_dest(n) : mode == 2 ? gu_dest(n) + 128 : win_dest(n);
    if (bias && dme >= 0) { atomicAdd(bias + dme, b0); atomicAdd(bias + bias_pitch + dme, b1); atomicAdd(bias + 2 * bias_pitch + dme, b2); }
    const int c = C.lane & 7;
#pragma unroll
    for (int i = 0; i < 8; ++i) { const int nl = (C.lane >> 3) + 8 * i, nn = n0 + nl;
        const int dr = nn >= N ? -1 : mode == 0 ? nn : mode == 1 ? gu_dest(nn) : mode == 2 ? gu_dest(nn) + 128 : win_dest(nn);
        const LAS float* s = scr + (8 * c) * 65 + nl;
        u32x4 o; o.x = pk2(s[0], s[65]); o.y = pk2(s[2 * 65], s[3 * 65]); o.z = pk2(s[4 * 65], s[5 * 65]); o.w = pk2(s[6 * 65], s[7 * 65]);
        if (dr >= 0) *(u32x4*)(Wt + (size_t)dr * K + k0 + 8 * c) = o; }
    WSYNC();
}
struct Cplx { float re, im; };
DI Cplx cmul(Cplx a, Cplx b) { return Cplx{a.re * b.re - a.im * b.im, a.re * b.im + a.im * b.re}; }
DI Cplx s5_lam_pow(const Ctx& C, int l, int dir, int g, int n, float tau) {
    const size_t i = (((size_t)l * 2 + dir) * S5G + g) * 64 + n; const float dt = __expf(C.in[I_S5LDT][((size_t)l * 2 + dir) * S5G + g]);
    const float mag = __expf(tau * dt * C.in[I_S5ARE][i]), ang = tau * dt * C.in[I_S5AIM][i]; float sn, cs; sincosf(ang, &sn, &cs); return Cplx{mag * cs, mag * sn};
}
DI Cplx s5_coef(const Ctx& C, int l, int dir, int g, int n) {
    const size_t i = (((size_t)l * 2 + dir) * S5G + g) * 64 + n; const float are = C.in[I_S5ARE][i], aim = C.in[I_S5AIM][i];
    const Cplx ab = s5_lam_pow(C, l, dir, g, n, 1.0f); const float den = are * are + aim * aim, nr = ab.re - 1.0f;
    return Cplx{(nr * are + ab.im * aim) / den, (ab.im * are - nr * aim) / den};
}
DI Cplx s5_beta(const Ctx& C, int l, int dir, int g, int n, int q) {
    const size_t i = (((size_t)l * S5G + g) * 64 + n) * 16 + q; return cmul(s5_coef(C, l, dir, g, n), Cplx{C.in[I_S5BRE][i], C.in[I_S5BIM][i]});
}
DI Cplx s5_gamma(const Ctx& C, int l, int g, int p, int n) { const size_t i = (((size_t)l * S5G + g) * 16 + p) * 64 + n; return Cplx{C.in[I_S5CRE][i], C.in[I_S5CIM][i]}; }

#ifndef CONV_G1_PCT
#define CONV_G1_PCT 55
#endif
constexpr int CI_GU = (D / 64) * (FF / 64), CI_DN = (FF / 64) * (D / 64), CI_IN = (D / 64) * ((D_IN + 63) / 64), CI_OUT = (D / 64) * (D / 64), CI_GLU = (GW / 64) * (GW / 64);
constexpr int CI_LAYER = 4 * CI_GU + 2 * CI_DN + CI_IN + CI_OUT + CI_GLU, CI_X1 = (int)((long)CI_LAYER * CONV_G1_PCT / 100) & ~7;
DI void conv_weights(const Ctx& C, int l, int wslot, int nslots, int it_lo, int it_hi) {
    for (int it = it_lo + wslot; it < it_hi; it += nslots) {
        int r = it;
        unsigned char* wbase = C.ws + WS_W + (size_t)l * SZ_WL;
        if (r < 2 * CI_GU) { const int up = r >= CI_GU; r -= up * CI_GU; const int kb = r / (FF / 64), nb = r % (FF / 64);
            conv_item(C, C.in[up ? I_F1WU : I_F1WG] + (size_t)l * D * FF, D, FF, (bf16*)(wbase + OFF_W1GU), 1 + up, kb * 64, nb * 64, bias_ptr(C, l, 0), 2 * FF, modv_ptr(C, l, 0, 0)); continue; } r -= 2 * CI_GU;
        if (r < CI_DN) { const int kb = r / (D / 64), nb = r % (D / 64); conv_item(C, C.in[I_F1WD] + (size_t)l * FF * D, FF, D, (bf16*)(wbase + OFF_W1D), 0, kb * 64, nb * 64, nullptr, 0, nullptr); continue; } r -= CI_DN;
        if (r < CI_IN) { const int nbn = (D_IN + 63) / 64, kb = r / nbn, nb = r % nbn; conv_item(C, C.in[I_WIN] + (size_t)l * D * D_IN, D, D_IN, (bf16*)(wbase + OFF_WIN), 3, kb * 64, nb * 64, bias_ptr(C, l, 1), NINP, modv_ptr(C, l, 0, 3)); continue; } r -= CI_IN;
        if (r < CI_OUT) { const int kb = r / (D / 64), nb = r % (D / 64); conv_item(C, C.in[I_WOUT] + (size_t)l * D * D, D, D, (bf16*)(wbase + OFF_WOUT), 0, kb * 64, nb * 64, nullptr, 0, nullptr); continue; } r -= CI_OUT;
        if (r < 2 * CI_GU) { const int up = r >= CI_GU; r -= up * CI_GU; const int kb = r / (FF / 64), nb = r % (FF / 64);
            conv_item(C, C.in[up ? I_F2WU : I_F2WG] + (size_t)l * D * FF, D, FF, (bf16*)(wbase + OFF_W2GU), 1 + up, kb * 64, nb * 64, bias_ptr(C, l, 2), 2 * FF, modv_ptr(C, l, 0, 6)); continue; } r -= 2 * CI_GU;
        if (r < CI_DN) { const int kb = r / (D / 64), nb = r % (D / 64); conv_item(C, C.in[I_F2WD] + (size_t)l * FF * D, FF, D, (bf16*)(wbase + OFF_W2D), 0, kb * 64, nb * 64, nullptr, 0, nullptr); continue; } r -= CI_DN;
        { const int kb = r / (GW / 64), nb = r % (GW / 64); conv_item(C, C.in[I_S5GLUW] + (size_t)l * GW * GW, GW, GW, (bf16*)(wbase + OFF_WGLU), 0, kb * 64, nb * 64, nullptr, 0, nullptr); }
    }
}
DI void ph_conv(const Ctx& C) {
    const int gt = C.bid * NTHR + C.tid, GT = C.G * NTHR;
    for (int i = gt; i < NL * 9 * D; i += GT) { const int k = i % D, s = (i / D) % 3, sub = (i / (3 * D)) % 3, l = i / (9 * D);
        const float* mv = (const float*)(C.ws + WS_MODV) + ((size_t)l * 3 + s) * 9 * D;
        ((float*)(C.ws + WS_GS))[i] = C.in[I_NORMG][((size_t)l * 3 + sub) * D + k] * (1.0f + mv[(3 * sub + 1) * D + k]);
        ((float*)(C.ws + WS_GATE))[i] = mv[(3 * sub + 2) * D + k] * (sub == 1 ? 1.0f : 0.5f); }
    for (int i = gt; i < 128 * 16; i += GT) { const int pos = i / 16, f = i % 16; const float inv = __expf(-(float)f * (9.210340371976184f / 16.0f)); float sn, cs; sincosf((float)pos * inv, &sn, &cs);
        ((f32x2*)(C.ws + WS_ROPE))[i] = (f32x2){cs, sn}; }
    const int gw = C.bid * NW + C.wave, GWV = C.G * NW;
    conv_weights(C, 0, gw, GWV, 0, CI_LAYER);
    for (int i = gt; i < NL * 14 * NH * 2 * 64 * 8; i += GT) {
        const int j = i & 7, ln = (i >> 3) & 63, tj = (i >> 9) & 1, hd = (i >> 10) % NH, f = (i / (1024 * NH)) % 14, l = i / (1024 * NH * 14);
        const int col = hd * 64 + 32 * tj + (ln & 31); float v;
        if (f < 8) { const int d = (f >> 1) & 1, sx = f & 1, k = 16 * sx + 8 * (ln >> 5) + j; v = C.in[f < 4 ? I_RWWUP : I_RWAUP][(((size_t)l * 2 + d) * 32 + k) * GW + col]; }
        else { const int k = 16 * (f - 8) + 8 * (ln >> 5) + j; v = C.in[I_RWGUP][((size_t)l * 96 + k) * GW + col]; }
        ((bf16*)(C.ws + WS_RWF))[i] = (bf16)f2bf(v); }
    LAS float* wsc = (LAS float*)(C.lds + C.wave * 16640);
    for (int it = gw; it < NL * S5G * 2 * S5L; it += GWV) {
        const int tau = it % S5L, dir = (it / S5L) % 2, g = (it / (2 * S5L)) % S5G, l = it / (2 * S5L * S5G);
        const Cplx z = cmul(s5_lam_pow(C, l, dir, g, C.lane, (float)tau), s5_coef(C, l, dir, g, C.lane));
#pragma unroll 4
        for (int q = 0; q < 16; ++q) { const size_t i = (((size_t)l * S5G + g) * 64 + C.lane) * 16 + q; const Cplx w = cmul(z, Cplx{C.in[I_S5BRE][i], C.in[I_S5BIM][i]}); wsc[(C.lane * 16 + q) * 2] = w.re; wsc[(C.lane * 16 + q) * 2 + 1] = w.im; }
        WSYNC();
        float* kc = (float*)(C.ws + WS_S5T + (size_t)l * SZ_S5L + OFF_S5KC) + (((size_t)g * 2 + dir) * S5L + tau) * 256;
#pragma unroll 1
        for (int e = 0; e < 4; ++e) { const int pq = C.lane + 64 * e, p = pq >> 4, q = pq & 15; float s = 0.f;
#pragma unroll 4
            for (int n = 0; n < 64; ++n) { const Cplx gm = s5_gamma(C, l, g, p, n); s += gm.re * wsc[(n * 16 + q) * 2] - gm.im * wsc[(n * 16 + q) * 2 + 1]; }
            kc[pq] = s; }
        WSYNC();
    }
    for (int i = gt; i < NL * 2 * GW * 4 * (S5L + 1); i += GT) { const int tau = i % (S5L + 1), r = i / (S5L + 1), n = r % 64, g = (r / 64) % S5G, dir = (r / (64 * S5G)) % 2, l = r / (2 * 64 * S5G);
        const Cplx z = s5_lam_pow(C, l, dir, g, n, (float)tau); ((f32x2*)(C.ws + WS_S5T + (size_t)l * SZ_S5L + OFF_S5LP))[((size_t)(dir * S5G + g) * 64 + n) * (S5L + 1) + tau] = (f32x2){z.re, z.im}; }
    for (int i = gt; i < NL * 2 * GW * 4 * 16; i += GT) { const int q = i % 16, r = i / 16, n = r % 64, g = (r / 64) % S5G, dir = (r / (64 * S5G)) % 2, l = r / (2 * 64 * S5G);
        const Cplx z = s5_beta(C, l, dir, g, n, q); ((f32x2*)(C.ws + WS_S5T + (size_t)l * SZ_S5L + OFF_S5BETA))[((size_t)(dir * S5G + g) * 64 + n) * 16 + q] = (f32x2){z.re, z.im}; }
    for (int i = gt; i < NL * 2 * GW * 4; i += GT) { const int n = i % 64, g = (i / 64) % S5G, dir = (i / (64 * S5G)) % 2, l = i / (2 * 64 * S5G); const Cplx z = s5_lam_pow(C, l, dir, g, n, (float)S5L);
        ((f32x2*)(C.ws + WS_S5T + (size_t)l * SZ_S5L + OFF_S5LAM))[(dir * S5G + g) * 64 + n] = (f32x2){z.re, z.im}; }
}
DI void ph_tab(const Ctx& C) {
    const long gt = (long)C.bid * NTHR + C.tid, GT = (long)C.G * NTHR;
    for (long i = gt; i < (long)NL * S5G * 256 * 512; i += GT) {
        const int k = (int)(i % 512), np = (int)((i / 512) % 256), g = (int)((i / (512 * 256)) % S5G), l = (int)(i / ((long)512 * 256 * S5G));
        const int j = k >> 4, q = k & 15, dir = np >> 7, n = np & 63, im = (np >> 6) & 1;
        const f32x2 lp = ((const f32x2*)(C.ws + WS_S5T + (size_t)l * SZ_S5L + OFF_S5LP))[((size_t)(dir * S5G + g) * 64 + n) * (S5L + 1) + (dir == 0 ? S5L - 1 - j : j)];
        const f32x2 be = ((const f32x2*)(C.ws + WS_S5T + (size_t)l * SZ_S5L + OFF_S5BETA))[((size_t)(dir * S5G + g) * 64 + n) * 16 + q];
        const Cplx w = cmul(Cplx{lp[0], lp[1]}, Cplx{be[0], be[1]});
        ((bf16*)(C.ws + WS_S5T + (size_t)l * SZ_S5L + OFF_S5ET))[((size_t)g * 256 + np) * 512 + k] = (bf16)f2bf(im ? w.im : w.re); }
    for (long i = gt; i < (long)NL * S5G * 512 * S5K; i += GT) {
        const int k = (int)(i % S5K), nn = (int)((i / S5K) % 512), g = (int)((i / ((long)S5K * 512)) % S5G), l = (int)(i / ((long)S5K * 512 * S5G));
        const int ti = nn >> 4, p = nn & 15; float v;
        if (k < 512) { const int j = k >> 4, q = k & 15; const float* kc = (const float*)(C.ws + WS_S5T + (size_t)l * SZ_S5L + OFF_S5KC) + (size_t)g * 2 * S5L * 256;
            v = 0.f; if (j <= ti) v += kc[((ti - j)) * 256 + p * 16 + q]; if (j >= ti) v += kc[(S5L + (j - ti)) * 256 + p * 16 + q]; }
        else { const int kk = k - 512, dir = kk >> 7, im = (kk >> 6) & 1, n = kk & 63;
            const f32x2 lp = ((const f32x2*)(C.ws + WS_S5T + (size_t)l * SZ_S5L + OFF_S5LP))[((size_t)(dir * S5G + g) * 64 + n) * (S5L + 1) + (dir == 0 ? ti + 1 : S5L - ti)];
            const Cplx w = cmul(s5_gamma(C, l, g, p, n), Cplx{lp[0], lp[1]}); v = im ? -w.im : w.re; }
        ((bf16*)(C.ws + WS_S5T + (size_t)l * SZ_S5L + OFF_S5BT))[((size_t)g * 512 + nn) * S5K + k] = (bf16)f2bf(v); }
    const int gw = C.bid * NW + C.wave, GWV = C.G * NW;
    for (int row = gw; row < M; row += GWV) {
        const float* src = row < M_LAT ? C.in[I_X] + (size_t)row * D : C.in[I_CTX] + (size_t)(row - M_LAT) * D;
        float* dst = xrow_ptr(C, row); const float* gs = gs_ptr(C, 0, 0, stream_of_row(row)); bf16* ap = (bf16*)(C.ws + WS_AP) + (size_t)row * D; float ss = 0.f;
        f32x4 xv[D / 256], gv[D / 256];
#pragma unroll
        for (int i = 0; i < D / 256; ++i) { xv[i] = *(const f32x4*)(src + 4 * C.lane + 256 * i); gv[i] = *(const f32x4*)(gs + 4 * C.lane + 256 * i); }
#pragma unroll
        for (int i = 0; i < D / 256; ++i) { const int c = 4 * C.lane + 256 * i; const f32x4 x = xv[i]; *(f32x4*)(dst + c) = x; ss += (x[0] * x[0] + x[1] * x[1]) + (x[2] * x[2] + x[3] * x[3]);
            const f32x4 a = x * gv[i]; u32x2 w; w.x = pk2(a[0], a[1]); w.y = pk2(a[2], a[3]); *(u32x2*)(ap + c) = w; }
        ss = wave_sum(ss); if (C.lane == 0) rowss_ptr(C, 0, 0)[row] = ss;
    }
}

#ifdef EMU
DI s16x4 tr_read1(const LAS unsigned char* a) { return emu_tr_read(a); }
#else
DI s16x4 tr_read1(const LAS unsigned char* a) { s16x4 r; asm volatile("ds_read_b64_tr_b16 %0, %1\n\ts_waitcnt lgkmcnt(0)" : "=&v"(r) : "v"((unsigned)(size_t)a) : "memory"); return r; }
#endif
DI bf16x8 tr_frag(const LAS unsigned char* a0, int hi_off) {
#ifdef EMU
    const s16x4 lo = emu_tr_read(a0), hi = emu_tr_read(a0 + hi_off);
#else
    s16x4 lo, hi; asm volatile("ds_read_b64_tr_b16 %0, %2\n\tds_read_b64_tr_b16 %1, %3\n\ts_waitcnt lgkmcnt(0)" : "=&v"(lo), "=&v"(hi) : "v"((unsigned)(size_t)a0), "v"((unsigned)(size_t)(a0 + hi_off)) : "memory");
#endif
    return __builtin_shufflevector(lo, hi, 0, 1, 2, 3, 4, 5, 6, 7);
}
DI void tr_frag4(const LAS unsigned char* a0, const LAS unsigned char* a1, const LAS unsigned char* a2, const LAS unsigned char* a3, int hi_off, bf16x8 (&f)[4]) {
#ifdef EMU
    f[0] = tr_frag(a0, hi_off); f[1] = tr_frag(a1, hi_off); f[2] = tr_frag(a2, hi_off); f[3] = tr_frag(a3, hi_off);
#else
    s16x4 l0, h0, l1, h1, l2, h2, l3, h3;
    asm volatile("ds_read_b64_tr_b16 %0, %8\n\tds_read_b64_tr_b16 %1, %9\n\tds_read_b64_tr_b16 %2, %10\n\tds_read_b64_tr_b16 %3, %11\n\tds_read_b64_tr_b16 %4, %12\n\tds_read_b64_tr_b16 %5, %13\n\tds_read_b64_tr_b16 %6, %14\n\tds_read_b64_tr_b16 %7, %15\n\ts_waitcnt lgkmcnt(0)"
        : "=&v"(l0), "=&v"(h0), "=&v"(l1), "=&v"(h1), "=&v"(l2), "=&v"(h2), "=&v"(l3), "=&v"(h3)
        : "v"((unsigned)(size_t)a0), "v"((unsigned)(size_t)(a0 + hi_off)), "v"((unsigned)(size_t)a1), "v"((unsigned)(size_t)(a1 + hi_off)), "v"((unsigned)(size_t)a2), "v"((unsigned)(size_t)(a2 + hi_off)), "v"((unsigned)(size_t)a3), "v"((unsigned)(size_t)(a3 + hi_off)) : "memory");
    f[0] = __builtin_shufflevector(l0, h0, 0, 1, 2, 3, 4, 5, 6, 7); f[1] = __builtin_shufflevector(l1, h1, 0, 1, 2, 3, 4, 5, 6, 7); f[2] = __builtin_shufflevector(l2, h2, 0, 1, 2, 3, 4, 5, 6, 7); f[3] = __builtin_shufflevector(l3, h3, 0, 1, 2, 3, 4, 5, 6, 7);
#endif
}
DI bf16x8 pack8(const f32x16& x, int s) {
    u32x4 p; p.x = pk2(x[8 * s], x[8 * s + 1]); p.y = pk2(x[8 * s + 2], x[8 * s + 3]); p.z = pk2(x[8 * s + 4], x[8 * s + 5]); p.w = pk2(x[8 * s + 6], x[8 * s + 7]);
    return __builtin_bit_cast(bf16x8, p);
}
struct AttnSt { f32x16 o0, o1; float m, l; };
constexpr int APT = 144;
struct KVregs { u32x4 k[4]; u32x4 v[4]; };
struct Kregs { bf16x8 k[4]; };
DI void k_load(Kregs& r, const bf16* Kb, int kp, int lane) {
    const int r32 = lane & 31, h = lane >> 5;
#pragma unroll
    for (int kk = 0; kk < 4; ++kk) r.k[kk] = *(const bf16x8*)(Kb + (size_t)r32 * kp + 16 * kk + 8 * h);
}
DI void kv_load2(KVregs& r, const bf16* Kb, int kp, const bf16* Vb, int vp, int lane) {
#pragma unroll
    for (int i = 0; i < 4; ++i) { const int idx = lane + 64 * i, key = idx >> 3, ch = idx & 7; r.k[i] = *(const u32x4*)(Kb + (size_t)key * kp + ch * 8); }
#pragma unroll
    for (int i = 0; i < 4; ++i) { const int idx = lane + 64 * i, key = idx >> 3, ch = idx & 7; r.v[i] = *(const u32x4*)(Vb + (size_t)key * vp + ch * 8); }
}
#if 0
DI void kv_load(KVregs& r, const Kregs& kpre, const bf16* Vb, int vp, int lane) {
#pragma unroll
    for (int kk = 0; kk < 4; ++kk) r.k[kk] = kpre.k[kk];
#pragma unroll
    for (int i = 0; i < 4; ++i) { const int idx = lane + 64 * i, key = idx >> 3, ch = idx & 7; r.v[i] = *(const u32x4*)(Vb + (size_t)key * vp + ch * 8); }
}
#endif
DI void attn_stage(const KVregs& kv, LAS unsigned char* vl, int lane) {
    LAS unsigned char* vk = vl; LAS unsigned char* vv = vl + 32 * APT;
#pragma unroll
    for (int i = 0; i < 4; ++i) { const int idx = lane + 64 * i, key = idx >> 3, ch = idx & 7; *(LAS u32x4*)(vk + key * APT + ch * 16) = kv.k[i]; *(LAS u32x4*)(vv + key * APT + ch * 16) = kv.v[i]; }
}
template <bool MASKED>
DI void attn_block(AttnSt& st, const bf16x8 (&qf)[4], LAS unsigned char* vl, int lane, const float (&addv)[16], unsigned vmask) {
    const int h = lane >> 5;
    LAS unsigned char* vk = vl; LAS unsigned char* vv = vl + 32 * APT;
    WSYNC();
    bf16x8 kf[4];
#pragma unroll
    for (int kk = 0; kk < 4; ++kk) kf[kk] = *(const LAS bf16x8*)(vk + (lane & 31) * APT + (16 * kk + 8 * h) * 2);
    f32x16 s;
#pragma unroll
    for (int i = 0; i < 16; ++i) s[i] = 0.f;
#pragma unroll
    for (int kk = 0; kk < 4; ++kk) s = __builtin_amdgcn_mfma_f32_32x32x16_bf16(kf[kk], qf[kk], s, 0, 0, 0);
    float bm = -1e30f;
#pragma unroll
    for (int i = 0; i < 16; ++i) { if (MASKED) { s[i] += addv[i]; if ((vmask >> i) & 1u) bm = fmaxf(bm, s[i]); } else bm = fmaxf(bm, s[i]); }
    bm = fmaxf(bm, __shfl_xor(bm, 32));
    const float mn = fmaxf(st.m, bm), alpha = __expf(st.m - mn); st.m = mn;
    float ls = 0.f;
#pragma unroll
    for (int i = 0; i < 16; ++i) { float p = __expf(s[i] - mn); if (MASKED) p = ((vmask >> i) & 1u) ? p : 0.f; s[i] = p; ls += p; }
    st.l = st.l * alpha + ls;
#pragma unroll
    for (int i = 0; i < 16; ++i) { st.o0[i] *= alpha; st.o1[i] *= alpha; }
    const int q = (lane & 15) >> 2, p4 = lane & 3, blk = (lane >> 4) & 1;
    { const LAS unsigned char* ab = vv + (4 * h + q) * APT + (16 * blk) * 2 + 8 * p4; bf16x8 vf[4];
      tr_frag4(ab, ab + 64, ab + 16 * APT, ab + 16 * APT + 64, 8 * APT, vf);
      const bf16x8 pf0 = pack8(s, 0), pf1 = pack8(s, 1);
      st.o0 = __builtin_amdgcn_mfma_f32_32x32x16_bf16(vf[0], pf0, st.o0, 0, 0, 0); st.o1 = __builtin_amdgcn_mfma_f32_32x32x16_bf16(vf[1], pf0, st.o1, 0, 0, 0);
      st.o0 = __builtin_amdgcn_mfma_f32_32x32x16_bf16(vf[2], pf1, st.o0, 0, 0, 0); st.o1 = __builtin_amdgcn_mfma_f32_32x32x16_bf16(vf[3], pf1, st.o1, 0, 0, 0); }
}
DI void attn_finish(AttnSt& st, bf16* orow  , int lane, float extra_l) {
    const int h = lane >> 5; float l = st.l + __shfl_xor(st.l, 32) + extra_l; const float inv = 1.0f / l;
#pragma unroll
    for (int g = 0; g < 4; ++g) {
        u32x2 w0, w1; w0.x = pk2(st.o0[4 * g] * inv, st.o0[4 * g + 1] * inv); w0.y = pk2(st.o0[4 * g + 2] * inv, st.o0[4 * g + 3] * inv);
        w1.x = pk2(st.o1[4 * g] * inv, st.o1[4 * g + 1] * inv); w1.y = pk2(st.o1[4 * g + 2] * inv, st.o1[4 * g + 3] * inv);
        *(u32x2*)(orow + 8 * g + 4 * h) = w0; *(u32x2*)(orow + 32 + 8 * g + 4 * h) = w1; }
}
DI int clampi(int v, int lo, int hi) { return v < lo ? lo : (v > hi ? hi : v); }
#ifndef ATTN_A_PCT
#define ATTN_A_PCT 20
#endif
constexpr int AT_NA = NB * NH * (GRH / 2) * 4, AT_WA = NB * NH * (T / 32), AT_CX = NB * NH * (TC / 32);
DI void ph_attn(const Ctx& C, int l, bool want_ctx, int widx, int nworkers, int t_lo, int t_hi) {
    if (widx < 0) return;
    const int gw = t_lo + widx, GWV = nworkers, lane = C.lane, r32 = lane & 31, h = lane >> 5;
    LAS unsigned char* vl = C.lds + C.wave * 16640;
    const bf16* QA = (const bf16*)(C.ws + WS_QA); const bf16* KA = (const bf16*)(C.ws + WS_KA); const bf16* VA = (const bf16*)(C.ws + WS_VA);
    const bf16* QC = (const bf16*)(C.ws + WS_QC); const bf16* KC = (const bf16*)(C.ws + WS_KC); const bf16* VC = (const bf16*)(C.ws + WS_VC);
    bf16* OB = (bf16*)(C.ws + WS_OB);
    const int ntiles = t_hi;
    const float zero16[16] = {0.f, 0.f, 0.f, 0.f, 0.f, 0.f, 0.f, 0.f, 0.f, 0.f, 0.f, 0.f, 0.f, 0.f, 0.f, 0.f};
    for (int tile = gw; tile < ntiles; tile += GWV) {
        AttnSt st; st.m = -1e30f; st.l = 0.f;
#pragma unroll
        for (int i = 0; i < 16; ++i) { st.o0[i] = 0.f; st.o1[i] = 0.f; }
        bf16x8 qf[4];
        if (tile < AT_NA) {
            const int cb = tile & 3, rp = (tile >> 2) % (GRH / 2), hd = (tile / (4 * (GRH / 2))) % NH, b = tile / (4 * (GRH / 2) * NH);
            const int r0 = 2 * rp, c0 = 16 * cb, qr = r0 + (r32 >> 4), qc = c0 + (r32 & 15), qrow = b * T + qr * GRW + qc;
#pragma unroll
            for (int kk = 0; kk < 4; ++kk) qf[kk] = *(const bf16x8*)(QA + (size_t)qrow * GW + hd * 64 + 16 * kk + 8 * h);
            const int rsq = clampi(qr - 4, 0, GRH - 8), csq = clampi(qc - 8, 0, GRW - 16);
            const int rsA = clampi(r0 - 4, 0, GRH - 8), rsB = clampi(r0 + 1 - 4, 0, GRH - 8), kc0 = clampi(c0 - 8, 0, GRW - 32);
            const float* rpb = C.in[I_NARPB] + ((size_t)l * NH + hd) * 465;
            const int nbn = rsB + 8 - rsA, nbt = nbn + TC / 32; KVregs nxt;
#define NA_ROW(i) ((i) < nbn ? (size_t)b * T + (rsA + (i)) * GRW + kc0 : (size_t)M_LAT + b * TC + 32 * ((i) - nbn))
            const bf16* KAh = KA + (size_t)hd * M * 64; const bf16* VAh = VA + (size_t)hd * M * 64;
            { const size_t kr0 = NA_ROW(0); kv_load2(nxt, KAh + kr0 * 64, 64, VAh + kr0 * 64, 64, lane); }
            LAS float* rpbL = (LAS float*)(vl + 64 * APT);
            { float tb[8];
#pragma unroll
              for (int i = 0; i < 8; ++i) { const int j = lane + 64 * i; tb[i] = rpb[j < 465 ? j : 464]; }
#pragma unroll
              for (int i = 0; i < 8; ++i) { const int j = lane + 64 * i; if (j < 465) rpbL[j] = tb[i]; }
              WSYNC(); }
            for (int ib = 0; ib < nbt; ++ib) {
                attn_stage(nxt, vl, lane);
                { const int in_ = ib + 1 < nbt ? ib + 1 : ib; const size_t kr1 = NA_ROW(in_); kv_load2(nxt, KAh + kr1 * 64, 64, VAh + kr1 * 64, 64, lane); }
                if (ib < nbn) { const int kr = rsA + ib; float addv[16]; unsigned vm = 0u; const bool rok = kr >= rsq && kr <= rsq + 7;
#pragma unroll
                    for (int i = 0; i < 16; ++i) { const int kb = (i & 3) + 8 * (i >> 2) + 4 * h, kc = kc0 + kb; const bool ok = rok && kc >= csq && kc <= csq + 15;
                        const int bi = ok ? (kr - qr + 7) * 31 + (kc - qc + 15) : 0; addv[i] = rpbL[bi]; vm |= ok ? (1u << i) : 0u; }
                    attn_block<true>(st, qf, vl, lane, addv, vm); }
                else attn_block<false>(st, qf, vl, lane, zero16, 0xffffu); }
#undef NA_ROW
            attn_finish(st, OB + (size_t)qrow * D + hd * 64, lane, 0.f);
        } else if (tile < AT_NA + AT_WA) {
            const int t2 = tile - AT_NA, hl_ = t2 % WAG, qb = (t2 / WAG) % (T / 32), kvh = (t2 / (WAG * (T / 32))) % (NH / WAG), b = t2 / ((T / 32) * NH), hd = kvh * WAG + hl_;
            const int qt = 32 * qb + r32, qrow = b * T + qt;
#pragma unroll
            for (int kk = 0; kk < 4; ++kk) qf[kk] = *(const bf16x8*)(QC + (size_t)qrow * GW + hd * 64 + 16 * kk + 8 * h);
            const int i_lo = 4 - qb > 0 ? 4 - qb : 0, i_hi = (T / 32 - qb + 4) < 9 ? (T / 32 - qb + 4) : 9, nbw = i_hi - i_lo, nbt = nbw + TC / 32; KVregs nxt;
#define WA_ROW(i) ((i) < nbw ? (size_t)b * T + 32 * qb - 128 + 32 * (i_lo + (i)) : (size_t)M_LAT + b * TC + 32 * ((i) - nbw))
            const bf16* KCh = KC + (size_t)kvh * M * 64; const bf16* VCh = VC + (size_t)kvh * M * 64;
            { const size_t kr0 = WA_ROW(0); kv_load2(nxt, KCh + kr0 * 64, 64, VCh + kr0 * 64, 64, lane); }
            for (int ib = 0; ib < nbt; ++ib) {
                attn_stage(nxt, vl, lane);
                { const int in_ = ib + 1 < nbt ? ib + 1 : ib; const size_t kr1 = WA_ROW(in_); kv_load2(nxt, KCh + kr1 * 64, 64, VCh + kr1 * 64, 64, lane); }
                if (ib < nbw) { const int t0 = 32 * qb - 128 + 32 * (i_lo + ib); float addv[16]; unsigned vm = 0u;
#pragma unroll
                    for (int i = 0; i < 16; ++i) { const int kt = t0 + (i & 3) + 8 * (i >> 2) + 4 * h, rel = kt - qt; addv[i] = 0.f; vm |= (rel >= -128 && rel <= 128) ? (1u << i) : 0u; }
                    attn_block<true>(st, qf, vl, lane, addv, vm); }
                else attn_block<false>(st, qf, vl, lane, zero16, 0xffffu); }
#undef WA_ROW
            const float sk = C.in[I_WASINK][(size_t)l * NH + hd];
            const float mfin = fmaxf(st.m, sk), a2 = __expf(st.m - mfin);
#pragma unroll
            for (int i = 0; i < 16; ++i) { st.o0[i] *= a2; st.o1[i] *= a2; }
            st.l *= a2; st.m = mfin;
            attn_finish(st, OB + (size_t)qrow * D + 2 * GW + hd * 64, lane, __expf(sk - mfin));
        } else {
            const int t2 = tile - AT_NA - AT_WA, isc = t2 >= AT_CX, t3 = t2 - isc * AT_CX, qb = t3 % (TC / 32), hd = (t3 / (TC / 32)) % NH, b = t3 / ((TC / 32) * NH), kvh = hd / WAG;
            const int qrow = M_LAT + b * TC + 32 * qb + r32;
            const bf16* Qs = isc ? QC : QA; const bf16* Ks = isc ? KC + (size_t)kvh * M * 64 : KA + (size_t)hd * M * 64; const bf16* Vs = isc ? VC + (size_t)kvh * M * 64 : VA + (size_t)hd * M * 64; const int kp = 64;
#pragma unroll
            for (int kk = 0; kk < 4; ++kk) qf[kk] = *(const bf16x8*)(Qs + (size_t)qrow * GW + hd * 64 + 16 * kk + 8 * h);
            { KVregs nxt; const size_t kr0 = (size_t)M_LAT + b * TC; kv_load2(nxt, Ks + kr0 * kp, kp, Vs + kr0 * kp, kp, lane);
              for (int cbk = 0; cbk < TC / 32; ++cbk) { attn_stage(nxt, vl, lane); const int cn = cbk + 1 < TC / 32 ? cbk + 1 : cbk; kv_load2(nxt, Ks + (kr0 + 32 * cn) * kp, kp, Vs + (kr0 + 32 * cn) * kp, kp, lane);
                  attn_block<false>(st, qf, vl, lane, zero16, 0xffffu); } }
            float extra = 0.f;
            if (isc) { const float sk = C.in[I_WASINK][(size_t)l * NH + hd]; const float mfin = fmaxf(st.m, sk), a2 = __expf(st.m - mfin);
#pragma unroll
                for (int i = 0; i < 16; ++i) { st.o0[i] *= a2; st.o1[i] *= a2; }
                st.l *= a2; st.m = mfin; extra = __expf(sk - mfin); }
            attn_finish(st, OB + (size_t)qrow * D + (isc ? 2 * GW : 0) + hd * 64, lane, extra);
        }
    }
}

DI void ph_ctxfix(const Ctx& C, const float* gsn  , float* rowss_next) {
    const int gw = C.bid * NW + C.wave, GWV = C.G * NW;
    for (int r = gw; r < M_CTX; r += GWV) { const int row = M_LAT + r; const float* xp = xrow_ptr(C, row); const float* gs = gsn + (size_t)NB * D; bf16* ap = (bf16*)(C.ws + WS_AP) + (size_t)row * D; float ss = 0.f;
        f32x4 xv[D / 256], gv[D / 256];
#pragma unroll
        for (int i = 0; i < D / 256; ++i) { xv[i] = *(const f32x4*)(xp + 4 * C.lane + 256 * i); gv[i] = *(const f32x4*)(gs + 4 * C.lane + 256 * i); }
#pragma unroll
        for (int i = 0; i < D / 256; ++i) { const int c = 4 * C.lane + 256 * i; const f32x4 x = xv[i]; ss += (x[0] * x[0] + x[1] * x[1]) + (x[2] * x[2] + x[3] * x[3]);
            const f32x4 a = x * gv[i]; u32x2 w; w.x = pk2(a[0], a[1]); w.y = pk2(a[2], a[3]); *(u32x2*)(ap + c) = w; }
        ss = wave_sum(ss); if (C.lane == 0) rowss_next[row] = ss; }
}
constexpr int PT = 144;
constexpr int RW_HALF = 73472, IM_BT = 0, IM_KT = 9216, IM_RT = 18432, IM_ARB = 27648, IM_AT = 36864, IM_AAK = 46080, IM_F = 55296, IM_GC = 72704, FP = 68;
DI void chunk_rows(int b, int dir, int c, int& row0, int& step) {
    if (c < TC / 64) { const int p0 = 64 * c; row0 = M_LAT + b * TC + (dir ? TC - 1 - p0 : p0); } else { const int p0 = 64 * (c - TC / 64); row0 = b * T + (dir ? T - 1 - p0 : p0); }
    step = dir ? -1 : 1;
}
DI bf16x8 frag_rows(const LAS unsigned char* img, int tile, int s, int lane) { return *(const LAS bf16x8*)(img + (32 * tile + (lane & 31)) * PT + (16 * s + 8 * (lane >> 5)) * 2); }
DI bf16x8 frag_cols(const LAS unsigned char* img, int tile, int s, int lane) {
    const int h = lane >> 5, q = (lane & 15) >> 2, p4 = lane & 3, blk = (lane >> 4) & 1;
    const LAS unsigned char* a0 = img + (16 * s + 8 * h + q) * PT + (32 * tile + 16 * blk) * 2 + 8 * p4;
    return tr_frag(a0, 4 * PT);
}
DI void frag_cols4(const LAS unsigned char* img, int tile, int lane, bf16x8 (&f)[4]) {
    const int h = lane >> 5, q = (lane & 15) >> 2, p4 = lane & 3, blk = (lane >> 4) & 1;
    const LAS unsigned char* a0 = img + (8 * h + q) * PT + (32 * tile + 16 * blk) * 2 + 8 * p4;
    tr_frag4(a0, a0 + 16 * PT, a0 + 32 * PT, a0 + 48 * PT, 4 * PT, f);
}
DI void store_T(const f32x16& acc, LAS unsigned char* img, int ti, int tj, int lane) {
    const int c = lane & 31, h = lane >> 5;
#pragma unroll
    for (int g = 0; g < 4; ++g) { u32x2 w; w.x = pk2(acc[4 * g], acc[4 * g + 1]); w.y = pk2(acc[4 * g + 2], acc[4 * g + 3]); *(LAS u32x2*)(img + (32 * tj + c) * PT + (32 * ti + 8 * g + 4 * h) * 2) = w; }
}
DI f32x16 zero16v() { f32x16 z;
#pragma unroll
    for (int i = 0; i < 16; ++i) z[i] = 0.f; return z; }
#define MMA32(a, b, c) __builtin_amdgcn_mfma_f32_32x32x16_bf16((a), (b), (c), 0, 0, 0)
constexpr int PDW = 80, PDG = 208, IM_TW = 0, IM_TA = 17408, IM_DW = 36864, IM_DA = 41984, IM_DG = 47104;
DI void ph_rw1(const Ctx& C, int l) {
    const int wg = C.wave & 3, grp = C.wave >> 2, ti = wg >> 1, tj = wg & 1;
    bf16* QH = (bf16*)(C.ws + WS_QH); float* YL = (float*)(C.ws + WS_YL); bf16* MF = (bf16*)(C.ws + WS_MF); float* GF = (float*)(C.ws + WS_GF); bf16* RVKG = (bf16*)(C.ws + WS_RVKG);
    const bf16* PB = (const bf16*)(C.ws + WS_PB); const float* PS = (const float*)(C.ws + WS_PS);
    const bf16x8* RWF = (const bf16x8*)(C.ws + WS_RWF + (size_t)l * SZ_RWF);
    constexpr int nblk = (TC + T) / 64;
    for (int it0 = 2 * C.bid; it0 < RBLK; it0 += 2 * C.G) {
        int lane_ = threadIdx.x & 63; OPAQUE(lane_); const int lane = lane_, c32 = lane & 31, h = lane >> 5;
        LAS unsigned char* L = OPAQUE_LDS(C.lds + grp * RW_HALF);
        LAS float* F = (LAS float*)(L + IM_F); LAS float* SEG = (LAS float*)(L + IM_F); LAS float* GC = (LAS float*)(L + IM_GC);
        LAS float* TW = (LAS float*)(L + IM_TW); LAS float* TA = (LAS float*)(L + IM_TA);
        unsigned char* PK = C.ws + WS_RWS + ((size_t)C.bid * 2 + grp) * 65536;
        const int item = it0 + grp; const bool live = item < RBLK; const int itc = live ? item : RBLK - 1;
        const int tb = itc % nblk, hd = (itc / nblk) % NH, b = itc / (nblk * NH), cg = hd * 64 + lane;
        const int rowb = tb < TC / 64 ? M_LAT + b * TC + 64 * tb : b * T + 64 * (tb - TC / 64);
        const int seq_lo = tb < TC / 64 ? M_LAT + b * TC : b * T, seq_hi = seq_lo + (tb < TC / 64 ? TC : T);
        bf16* RV = RVKG + (size_t)itc * 4 * 4096;
        __syncthreads();
        float r_[16], kf_[16], kk_[16], ks_[16];
        { const float* cw = C.in[I_RWCONV] + (size_t)l * 9 * GW; float cwv[3][3];
#pragma unroll
          for (int j = 0; j < 3; ++j)
#pragma unroll
              for (int x = 0; x < 3; ++x) cwv[j][x] = cw[(size_t)j * 3 * GW + x * GW + cg];
          const float kkw = C.in[I_RWKK][(size_t)l * GW + cg];
          const int r0 = rowb + 16 * wg;
          bf16 pbv[18][3]; float psv[16][3];
#pragma unroll
          for (int rr = 0; rr < 18; ++rr) { int row = r0 - 1 + rr; row = row < seq_lo ? seq_lo : (row >= seq_hi ? seq_hi - 1 : row);
#pragma unroll
              for (int x = 0; x < 3; ++x) pbv[rr][x] = PB[(size_t)row * 3 * GW + x * GW + cg]; }
#pragma unroll
          for (int t = 0; t < 16; ++t)
#pragma unroll
              for (int kq = 0; kq < 3; ++kq) { const int k = lane + 64 * kq; psv[t][kq] = PS[(size_t)(r0 + t) * 160 + (k < 160 ? k : 159)]; }
          const float m_lo = r0 - 1 >= seq_lo ? 1.f : 0.f, m_hi = r0 + 16 < seq_hi ? 1.f : 0.f;
          float v_[16];
#pragma unroll
          for (int t = 0; t < 16; ++t) {
              float xa[3], xb[3], xc[3];
#pragma unroll
              for (int x = 0; x < 3; ++x) { xa[x] = bf2f(pbv[t][x]) * (t == 0 ? m_lo : 1.f); xb[x] = bf2f(pbv[t + 1][x]); xc[x] = bf2f(pbv[t + 2][x]) * (t == 15 ? m_hi : 1.f); }
              r_[t] = xa[0] * cwv[0][0] + xb[0] * cwv[1][0] + xc[0] * cwv[2][0]; kf_[t] = xa[1] * cwv[0][1] + xb[1] * cwv[1][1] + xc[1] * cwv[2][1]; v_[t] = xa[2] * cwv[0][2] + xb[2] * cwv[1][2] + xc[2] * cwv[2][2];
              const float kkv = kf_[t] * kkw, ssq = wave_sum(kkv * kkv); kk_[t] = kkv * __builtin_amdgcn_rsqf(fmaxf(ssq, 1e-24f)); ks_[t] = 0.f;
              const int tk = 16 * wg + t;
              if (lane < 32) *(LAS bf16*)(L + IM_DW + tk * PDW + lane * 2) = (bf16)f2bf(fast_tanh(psv[t][0])); else *(LAS bf16*)(L + IM_DA + tk * PDW + (lane - 32) * 2) = (bf16)f2bf(psv[t][0]);
              *(LAS bf16*)(L + IM_DG + tk * PDG + lane * 2) = (bf16)f2bf(sigmf(psv[t][1]));
              if (lane < 32) *(LAS bf16*)(L + IM_DG + tk * PDG + (lane + 64) * 2) = (bf16)f2bf(sigmf(psv[t][2]));
          }
#pragma unroll
          for (int t = 0; t < 16; ++t) { RV[(16 * wg + t) * 64 + lane] = (bf16)f2bf(r_[t]); RV[4096 + (16 * wg + t) * 64 + lane] = (bf16)f2bf(v_[t]); }
        }
        __syncthreads();
        bf16x8 lrf[2][4]; float w0v[2], a0v[2];
#pragma unroll
        for (int d = 0; d < 2; ++d) {
#pragma unroll
            for (int sx = 0; sx < 2; ++sx) { lrf[d][sx] = RWF[(((0 + 2 * d + sx) * NH + hd) * 2 + tj) * 64 + lane]; lrf[d][2 + sx] = RWF[(((4 + 2 * d + sx) * NH + hd) * 2 + tj) * 64 + lane]; }
            w0v[d] = C.in[I_RWW0][((size_t)l * 2 + d) * GW + hd * 64 + 32 * tj + c32]; a0v[d] = C.in[I_RWA0][((size_t)l * 2 + d) * GW + hd * 64 + 32 * tj + c32]; }
        { f32x16 gacc = zero16v();
#pragma unroll
          for (int sx = 0; sx < 6; ++sx) gacc = MMA32(*(const LAS bf16x8*)(L + IM_DG + (32 * ti + c32) * PDG + (16 * sx + 8 * h) * 2), RWF[(((8 + sx) * NH + hd) * 2 + tj) * 64 + lane], gacc);
#pragma unroll
          for (int rg = 0; rg < 16; ++rg) { const int tk = 32 * ti + (rg & 3) + 8 * (rg >> 2) + 4 * h; RV[3 * 4096 + tk * 64 + 32 * tj + c32] = (bf16)f2bf(gacc[rg]); }
        }
        const float kaw = C.in[I_RWKA][(size_t)l * GW + cg];
#pragma unroll
        for (int pss = 0; pss < 2; ++pss) {
            const int dir = 1 - pss;
            __syncthreads();
            { f32x16 pw = zero16v(), pa = zero16v();
#pragma unroll
              for (int sx = 0; sx < 2; ++sx) { pw = MMA32(*(const LAS bf16x8*)(L + IM_DW + (32 * ti + c32) * PDW + (16 * sx + 8 * h) * 2), lrf[dir][sx], pw);
                                              pa = MMA32(*(const LAS bf16x8*)(L + IM_DA + (32 * ti + c32) * PDW + (16 * sx + 8 * h) * 2), lrf[dir][2 + sx], pa); }
              const float w0 = w0v[dir], a0 = a0v[dir];
#pragma unroll
              for (int rg = 0; rg < 16; ++rg) { const int tk = 32 * ti + (rg & 3) + 8 * (rg >> 2) + 4 * h; const float z = -(w0 + pw[rg]), sp = z > 20.f ? z : __logf(1.f + __expf(z));
                  TW[tk * FP + 32 * tj + c32] = -__expf(-sp - 0.5f); TA[tk * FP + 32 * tj + c32] = sigmf(a0 + pa[rg]); } }
            __syncthreads();
            const int cs = dir ? 3 - wg : wg;
            float lw[16], av[16], run = 0.f;
#pragma unroll
            for (int ii = 0; ii < 16; ++ii) { const int tl = dir ? 15 - ii : ii, tk = 16 * wg + tl; av[ii] = TA[tk * FP + lane]; run += TW[tk * FP + lane]; lw[ii] = run; }
            __syncthreads();
            SEG[cs * 64 + lane] = run;
            __syncthreads();
            float off = 0.f;
#pragma unroll
            for (int w2 = 0; w2 < 3; ++w2) off += (w2 < cs) ? SEG[w2 * 64 + lane] : 0.f;
            const float tot = SEG[lane] + SEG[64 + lane] + SEG[128 + lane] + SEG[192 + lane];
            if (wg == 0) { if (dir) ((float*)(PK + 32768))[lane] = __expf(tot); else GC[lane] = __expf(tot); }
            float ePrev = __expf(off);
#pragma unroll
            for (int ii = 0; ii < 16; ++ii) { const int tl = dir ? 15 - ii : ii, i = 16 * cs + ii;
                const float Li = lw[ii] + off, eL = __expf(Li), ieL = __builtin_amdgcn_rcpf(eL), eLm = ePrev; ePrev = eL;
                const float a = av[ii], kd = kf_[tl] * (1.f + (a - 1.f) * kaw); ks_[tl] += kd;
                const bf16 vat = (bf16)f2bf(-kk_[tl] * eLm), vbt = (bf16)f2bf(kk_[tl] * a * ieL), vkt = (bf16)f2bf(kd * ieL), vrt = (bf16)f2bf(r_[tl] * eL);
                if (dir) { bf16* pk = (bf16*)PK + i * 64 + lane; pk[0] = vat; pk[4096] = vbt; pk[8192] = vkt; pk[12288] = vrt; }
                else { *(LAS bf16*)(L + IM_AT + i * PT + lane * 2) = vat; *(LAS bf16*)(L + IM_BT + i * PT + lane * 2) = vbt; *(LAS bf16*)(L + IM_KT + i * PT + lane * 2) = vkt; *(LAS bf16*)(L + IM_RT + i * PT + lane * 2) = vrt; } }
        }
#pragma unroll
        for (int t = 0; t < 16; ++t) RV[2 * 4096 + (16 * wg + t) * 64 + lane] = (bf16)f2bf(ks_[t]);
#pragma unroll 1
        for (int dir = 0; dir < 2; ++dir) {
            const int c = dir == 0 ? tb : (tb < TC / 64 ? TC / 64 - 1 - tb : TC / 64 + (T / 64 - 1 - (tb - TC / 64)));
            const size_t ci = ((size_t)((b * NH + hd) * 2 + dir)) * RCK + c;
            __syncthreads();
            if (dir) {
                const int tg = wg * 64 + lane;
                u32x4 pkv[4][2]; const float gcv = ((const float*)(PK + 32768))[lane];
#pragma unroll
                for (int im = 0; im < 4; ++im)
#pragma unroll
                    for (int rr = 0; rr < 2; ++rr) { const int idx = tg + 256 * rr, row = idx >> 3, ch = idx & 7; pkv[im][rr] = *(const u32x4*)(PK + im * 8192 + row * 128 + ch * 16); }
#pragma unroll
                for (int im = 0; im < 4; ++im)
#pragma unroll
                    for (int rr = 0; rr < 2; ++rr) { const int idx = tg + 256 * rr, row = idx >> 3, ch = idx & 7; const int dsto = im == 0 ? IM_AT : im == 1 ? IM_BT : im == 2 ? IM_KT : IM_RT;
                        *(LAS u32x4*)(L + dsto + row * PT + ch * 16) = pkv[im][rr]; }
                if (wg == 0) GC[lane] = gcv;
                __syncthreads();
            }
            f32x16 accP;
            { f32x16 aab = zero16v(), aak = zero16v(), arb = zero16v(); accP = zero16v();
#pragma unroll
              for (int s = 0; s < 4; ++s) { const bf16x8 at_i = frag_rows(L + IM_AT, ti, s, lane), bt_j = frag_rows(L + IM_BT, tj, s, lane), kt_j = frag_rows(L + IM_KT, ti, s, lane), at_c = frag_rows(L + IM_AT, tj, s, lane),
                                              bt_r = frag_rows(L + IM_BT, ti, s, lane), rt_c = frag_rows(L + IM_RT, tj, s, lane);
                  aab = MMA32(at_i, bt_j, aab); aak = MMA32(kt_j, at_c, aak); arb = MMA32(bt_r, rt_c, arb); accP = MMA32(kt_j, rt_c, accP); }
#pragma unroll
              for (int r = 0; r < 16; ++r) { const int row = 32 * ti + (r & 3) + 8 * (r >> 2) + 4 * h, col = 32 * tj + c32;
                  F[row * FP + col] = col < row ? aab[r] : 0.f; aak[r] = row < col ? aak[r] : 0.f; arb[r] = row <= col ? arb[r] : 0.f; accP[r] = row <= col ? accP[r] : 0.f; }
              store_T(aak, L + IM_AAK, ti, tj, lane);
              store_T(arb, L + IM_ARB, ti, tj, lane); }
            __syncthreads();
            { float Wc[64]; const int col = 32 * wg + c32; const LAS unsigned char* src = col < 64 ? L + IM_AT + col * 2 : L + IM_AAK + (col - 64) * 2;
              const LAS float* Fo = OPAQUE_LDS(F);
#pragma unroll
              for (int i = 0; i < 64; ++i) Wc[i] = bf2f(*(const LAS bf16*)(src + i * PT));
#pragma unroll
              for (int i = 1; i < 64; ++i) { float a0 = Wc[i], a1 = 0.f, a2 = 0.f, a3 = 0.f;
#pragma unroll
                  for (int j4 = 0; j4 < (i + 3) / 4; ++j4) { const f32x4 f = *(const LAS f32x4*)(Fo + i * FP + 4 * j4); a0 += f[0] * Wc[4 * j4]; a1 += f[1] * Wc[4 * j4 + 1]; a2 += f[2] * Wc[4 * j4 + 2]; a3 += f[3] * Wc[4 * j4 + 3];
                      if ((j4 & 7) == 7) PIN4(a0, a1, a2, a3); }
                  PIN4(a0, a1, a2, a3); Wc[i] = (a0 + a1) + (a2 + a3); }
              __syncthreads();
              if (h == 0) { LAS unsigned char* dst = (col < 64 ? L + IM_AT + col * PT : L + IM_AAK + (col - 64) * PT);
#pragma unroll
                  for (int i8 = 0; i8 < 8; ++i8) { u32x4 w; w.x = pk2(Wc[8 * i8], Wc[8 * i8 + 1]); w.y = pk2(Wc[8 * i8 + 2], Wc[8 * i8 + 3]); w.z = pk2(Wc[8 * i8 + 4], Wc[8 * i8 + 5]); w.w = pk2(Wc[8 * i8 + 6], Wc[8 * i8 + 7]); *(LAS u32x4*)(dst + i8 * 16) = w; } }
              bf16 vtmp[16];
#pragma unroll
              for (int ii = 0; ii < 16; ++ii) { const int tl = dir ? 15 - ii : ii; vtmp[ii] = RV[4096 + (16 * wg + tl) * 64 + lane]; }
#pragma unroll
              for (int ii = 0; ii < 16; ++ii) { const int i = 16 * (dir ? 3 - wg : wg) + ii; *(LAS bf16*)(L + IM_F + i * PT + lane * 2) = vtmp[ii]; }
            }
            __syncthreads();
            { f32x16 q;
#pragma unroll
              for (int g = 0; g < 4; ++g) { const u32x2 w = *(const LAS u32x2*)(L + IM_RT + (32 * tj + c32) * PT + (32 * ti + 8 * g + 4 * h) * 2); q[4 * g] = bflo(w.x); q[4 * g + 1] = bfhi(w.x); q[4 * g + 2] = bflo(w.y); q[4 * g + 3] = bfhi(w.y); }
#pragma unroll
              for (int s = 0; s < 4; ++s) { const bf16x8 arb = frag_rows(L + IM_ARB, tj, s, lane); q = MMA32(frag_rows(L + IM_AT, ti, s, lane), arb, q); accP = MMA32(frag_rows(L + IM_AAK, ti, s, lane), arb, accP); }
              if (live) {
#pragma unroll
                  for (int g = 0; g < 4; ++g) { u32x2 w; w.x = pk2(q[4 * g], q[4 * g + 1]); w.y = pk2(q[4 * g + 2], q[4 * g + 3]); *(u32x2*)(QH + ci * 4096 + (32 * tj + c32) * 64 + 32 * ti + 8 * g + 4 * h) = w; } }
            }
            __syncthreads();
            store_T(accP, L + IM_RT, ti, tj, lane);
            __syncthreads();
            { f32x16 y = zero16v(), m = zero16v(), n;
#pragma unroll
              for (int g = 0; g < 4; ++g) { const u32x2 w = *(const LAS u32x2*)(L + IM_KT + (32 * tj + c32) * PT + (32 * ti + 8 * g + 4 * h) * 2); n[4 * g] = bflo(w.x); n[4 * g + 1] = bfhi(w.x); n[4 * g + 2] = bflo(w.y); n[4 * g + 3] = bfhi(w.y); }
              bf16x8 btj[4], bti[4], vfj[4]; frag_cols4(L + IM_BT, tj, lane, btj); frag_cols4(L + IM_BT, ti, lane, bti); frag_cols4(L + IM_F, tj, lane, vfj);
#pragma unroll
              for (int s = 0; s < 4; ++s) { const bf16x8 btc_j = btj[s], btc_i = bti[s];
                  y = MMA32(frag_rows(L + IM_RT, ti, s, lane), vfj[s], y);
                  m = MMA32(frag_rows(L + IM_AT, ti, s, lane), btc_j, m);
                  n = MMA32(btc_i, frag_rows(L + IM_AAK, tj, s, lane), n); }
              const float gck = GC[32 * tj + c32];
#pragma unroll
              for (int r = 0; r < 16; ++r) { const int row = 32 * ti + (r & 3) + 8 * (r >> 2) + 4 * h, col = 32 * tj + c32; m[r] = (m[r] + (row == col ? 1.0f : 0.f)) * gck; n[r] *= GC[row]; }
              if (live) {
#pragma unroll
                  for (int g = 0; g < 4; ++g) *(f32x4*)(YL + ci * 4096 + ((wg * 4 + g) * 64 + lane) * 4) = (f32x4){y[4 * g], y[4 * g + 1], y[4 * g + 2], y[4 * g + 3]};
#pragma unroll
                  for (int s2 = 0; s2 < 2; ++s2) *(bf16x8*)(MF + ci * 4096 + ((wg * 2 + s2) * 64 + lane) * 8) = pack8(m, s2); }
              store_T(n, L + IM_ARB, ti, tj, lane);
            }
            __syncthreads();
            { f32x16 gacc = zero16v(); bf16x8 nfi[4], vfj[4]; frag_cols4(L + IM_ARB, ti, lane, nfi); frag_cols4(L + IM_F, tj, lane, vfj);
#pragma unroll
              for (int s = 0; s < 4; ++s) gacc = MMA32(nfi[s], vfj[s], gacc);
              if (live) {
#pragma unroll
                  for (int hf = 0; hf < 2; ++hf) { u32x4 w; w.x = pk2(gacc[8 * hf], gacc[8 * hf + 1]); w.y = pk2(gacc[8 * hf + 2], gacc[8 * hf + 3]); w.z = pk2(gacc[8 * hf + 4], gacc[8 * hf + 5]); w.w = pk2(gacc[8 * hf + 6], gacc[8 * hf + 7]);
                      *(u32x4*)((unsigned*)GF + ci * 2048 + ((wg * 2 + hf) * 64 + lane) * 4) = w; } }
            }
        }
    }
    __syncthreads();
}
struct R2Buf { bf16x8 mf[8]; u32x4 g[4]; };
DI void rw2_load(R2Buf& b, const bf16* MF, const unsigned* GFu, size_t item, int tj, int lane) {
#pragma unroll
    for (int q = 0; q < 8; ++q) b.mf[q] = *(const bf16x8*)(MF + item * 4096 + (q * 64 + lane) * 8);
#pragma unroll
    for (int kt = 0; kt < 2; ++kt)
#pragma unroll
        for (int hf = 0; hf < 2; ++hf) b.g[kt * 2 + hf] = *(const u32x4*)(GFu + item * 2048 + (((kt * 2 + tj) * 2 + hf) * 64 + lane) * 4);
}
DI void rw2_step(const R2Buf& b, f32x16& s0, f32x16& s1, bf16* SF, size_t item, int tj, int lane) {
    bf16x8 sf[2][2];
#pragma unroll
    for (int s = 0; s < 2; ++s) { sf[0][s] = pack8(s0, s); sf[1][s] = pack8(s1, s); *(bf16x8*)(SF + item * 4096 + (((0 * 2 + tj) * 2 + s) * 64 + lane) * 8) = sf[0][s]; *(bf16x8*)(SF + item * 4096 + (((1 * 2 + tj) * 2 + s) * 64 + lane) * 8) = sf[1][s]; }
    f32x16 n0, n1;
#pragma unroll
    for (int hf = 0; hf < 2; ++hf) { const u32x4 a = b.g[hf], c = b.g[2 + hf];
        n0[8 * hf] = bflo(a.x); n0[8 * hf + 1] = bfhi(a.x); n0[8 * hf + 2] = bflo(a.y); n0[8 * hf + 3] = bfhi(a.y); n0[8 * hf + 4] = bflo(a.z); n0[8 * hf + 5] = bfhi(a.z); n0[8 * hf + 6] = bflo(a.w); n0[8 * hf + 7] = bfhi(a.w);
        n1[8 * hf] = bflo(c.x); n1[8 * hf + 1] = bfhi(c.x); n1[8 * hf + 2] = bflo(c.y); n1[8 * hf + 3] = bfhi(c.y); n1[8 * hf + 4] = bflo(c.z); n1[8 * hf + 5] = bfhi(c.z); n1[8 * hf + 6] = bflo(c.w); n1[8 * hf + 7] = bfhi(c.w); }
#pragma unroll
    for (int kp = 0; kp < 2; ++kp)
#pragma unroll
        for (int s = 0; s < 2; ++s) { n0 = MMA32(b.mf[(kp * 2 + 0) * 2 + s], sf[kp][s], n0); n1 = MMA32(b.mf[(kp * 2 + 1) * 2 + s], sf[kp][s], n1); }
    s0 = n0; s1 = n1;
}
DI void ph_rw2(const Ctx& C) {
    const int lane = C.lane;
    const bf16* MF = (const bf16*)(C.ws + WS_MF); const unsigned* GFu = (const unsigned*)(C.ws + WS_GF); bf16* SF = (bf16*)(C.ws + WS_SF);
    const int nwork = RSTR * 2;
    for (int wk = C.wave == 0 ? C.bid : nwork; wk < nwork; wk += C.G) {
        const int tj = wk & 1, stream = wk >> 1; const size_t it0 = (size_t)stream * RCK;
        f32x16 s0 = zero16v(), s1 = zero16v();
        R2Buf A, B, Cb;
        rw2_load(A, MF, GFu, it0, tj, lane); rw2_load(B, MF, GFu, it0 + (1 < RCK ? 1 : 0), tj, lane); rw2_load(Cb, MF, GFu, it0 + (2 < RCK ? 2 : 0), tj, lane);
        for (int c = 0; c < RCK; c += 3) {
            rw2_step(A, s0, s1, SF, it0 + c, tj, lane); rw2_load(A, MF, GFu, it0 + (c + 3 < RCK ? c + 3 : RCK - 1), tj, lane);
            if (c + 1 < RCK) { rw2_step(B, s0, s1, SF, it0 + c + 1, tj, lane); rw2_load(B, MF, GFu, it0 + (c + 4 < RCK ? c + 4 : RCK - 1), tj, lane); }
            if (c + 2 < RCK) { rw2_step(Cb, s0, s1, SF, it0 + c + 2, tj, lane); rw2_load(Cb, MF, GFu, it0 + (c + 5 < RCK ? c + 5 : RCK - 1), tj, lane); }
        }
    }
}
DI void ph_rw3(const Ctx& C, int l, int mrows) {
    const int lane = C.lane, wg = C.wave & 3, grp = C.wave >> 2, ti = wg >> 1, tj = wg & 1, c32 = lane & 31, h = lane >> 5;
    LAS float* Ysum = (LAS float*)(C.lds + grp * RW_HALF);
    const bf16* QH = (const bf16*)(C.ws + WS_QH); const float* YL = (const float*)(C.ws + WS_YL); const bf16* SF = (const bf16*)(C.ws + WS_SF); bf16* OB = (bf16*)(C.ws + WS_OB);
    const int nblk = (TC + T) / 64, nitems = NB * NH * nblk;
    for (int it0 = 2 * C.bid; it0 < nitems; it0 += 2 * C.G) {
        const int item = it0 + grp; const bool live = item < nitems; const int itc = live ? item : nitems - 1;
        const int tb = itc % nblk, hd = (itc / nblk) % NH, b = itc / (nblk * NH);
        const int rowb = tb < TC / 64 ? M_LAT + b * TC + 64 * tb : b * T + 64 * (tb - TC / 64);
        __syncthreads();
        f32x4 yl[2][4]; u32x4 qa[2][4]; bf16x8 sb[2][4];
#pragma unroll
        for (int dir = 0; dir < 2; ++dir) {
            const int c = dir == 0 ? tb : (tb < TC / 64 ? TC / 64 - 1 - tb : TC / 64 + (T / 64 - 1 - (tb - TC / 64)));
            const size_t ci = ((size_t)((b * NH + hd) * 2 + dir)) * RCK + c;
#pragma unroll
            for (int g = 0; g < 4; ++g) yl[dir][g] = *(const f32x4*)(YL + ci * 4096 + ((wg * 4 + g) * 64 + lane) * 4);
#pragma unroll
            for (int kp = 0; kp < 2; ++kp)
#pragma unroll
                for (int s = 0; s < 2; ++s) { const bf16* qp = QH + ci * 4096 + (32 * ti + c32) * 64 + 32 * kp + 16 * s + 4 * h; const u32x2 lo = *(const u32x2*)qp, hi = *(const u32x2*)(qp + 8);
                    qa[dir][kp * 2 + s].x = lo.x; qa[dir][kp * 2 + s].y = lo.y; qa[dir][kp * 2 + s].z = hi.x; qa[dir][kp * 2 + s].w = hi.y;
                    sb[dir][kp * 2 + s] = *(const bf16x8*)(SF + ci * 4096 + (((kp * 2 + tj) * 2 + s) * 64 + lane) * 8); }
        }
#pragma unroll
        for (int dir = 0; dir < 2; ++dir) {
            f32x16 y;
#pragma unroll
            for (int g = 0; g < 4; ++g) { const f32x4 a = yl[dir][g]; y[4 * g] = a[0]; y[4 * g + 1] = a[1]; y[4 * g + 2] = a[2]; y[4 * g + 3] = a[3]; }
#pragma unroll
            for (int q4 = 0; q4 < 4; ++q4) y = MMA32(__builtin_bit_cast(bf16x8, qa[dir][q4]), sb[dir][q4], y);
#pragma unroll
            for (int r = 0; r < 16; ++r) { const int i = 32 * ti + (r & 3) + 8 * (r >> 2) + 4 * h, tk = dir ? 63 - i : i; LAS float* p = Ysum + tk * FP + 32 * tj + c32; if (dir == 0) *p = y[r]; else *p += y[r]; }
            __syncthreads();
        }
        if (live) {
            const int cch = hd * 64 + lane; const float rk = C.in[I_RWRK][((size_t)l * NH + hd) * 64 + lane], gw = C.in[I_RWGNW][(size_t)l * GW + cch], gb = C.in[I_RWGNB][(size_t)l * GW + cch];
#pragma unroll 1
            for (int t4 = 0; t4 < 16; t4 += 8) {
                bf16 rb[8], vb[8], kb[8], gb8[8];
#pragma unroll
                for (int u = 0; u < 8; ++u) { const bf16* rv = (const bf16*)(C.ws + WS_RVKG) + (size_t)item * 4 * 4096 + (16 * wg + t4 + u) * 64 + lane; rb[u] = rv[0]; vb[u] = rv[4096]; kb[u] = rv[8192]; gb8[u] = rv[12288]; }
#pragma unroll
                for (int u = 0; u < 8; ++u) { const int tk = 16 * wg + t4 + u, row = rowb + tk; const float r = bf2f(rb[u]), v = bf2f(vb[u]), ks = bf2f(kb[u]), gg = bf2f(gb8[u]);
                    float y = Ysum[tk * FP + lane] + wave_sum(r * ks * rk) * v;
                    const float mu = wave_sum(y) * (1.f / 64.f), dlt = y - mu, var = wave_sum(dlt * dlt) * (1.f / 64.f);
                    if (row < mrows) OB[(size_t)row * D + GW + cch] = (bf16)f2bf((dlt * __builtin_amdgcn_rsqf(var + RW_GN_EPS) * gw + gb) * gg); } }
        }
    }
    __syncthreads();
}
constexpr int S5X_OFF = NW * 16640;
DI void ph_s5scan(const Ctx& C, int l, int first_block, int nblocks) {
    constexpr int nc_ctx = TC / S5L, nc_lat = T / S5L, ntot = nc_ctx + nc_lat, SEG = ntot / NW;
    static_assert(ntot % NW == 0 && S5X_OFF + NW * 64 * 8 <= MISC_OFF, "S5 scan segmentation");
    if ((int)C.bid < first_block || (int)C.bid >= first_block + nblocks) return;
    const float* XE = (const float*)(C.ws + WS_XEND); bf16* UG = (bf16*)(C.ws + WS_UG);
    const f32x2* LAM = (const f32x2*)(C.ws + WS_S5T + (size_t)l * SZ_S5L + OFF_S5LAM);
    LAS f32x2* XCH = (LAS f32x2*)(C.lds + S5X_OFF);
    for (int combo = C.bid - first_block; combo < NB * 2 * S5G; combo += nblocks) {
        const int g = combo % S5G, dir = (combo / S5G) & 1, b = combo / (2 * S5G), n = C.lane, seg = C.wave;
        const f32x2 lm = LAM[(dir * S5G + g) * 64 + n];
        float er[SEG], ei[SEG];
#pragma unroll
        for (int u = 0; u < SEG; ++u) { const int i = seg * SEG + u; const int ch = i < nc_ctx ? (M_LAT + b * TC) / S5L + (dir ? nc_ctx - 1 - i : i) : (b * T) / S5L + (dir ? nc_lat - 1 - (i - nc_ctx) : (i - nc_ctx));
            const float* p = XE + ((size_t)g * NCHP + ch) * 256 + dir * 128 + n; er[u] = p[0]; ei[u] = p[64]; }
        float pr = lm[0], pi = lm[1];
#pragma unroll 1
        for (int u = 1; u < SEG; ++u) { const float tr = pr * lm[0] - pi * lm[1], ti2 = pr * lm[1] + pi * lm[0]; pr = tr; pi = ti2; }
        float xr = 0.f, xi = 0.f;
#pragma unroll
        for (int u = 0; u < SEG; ++u) { const float nr = lm[0] * xr - lm[1] * xi + er[u], ni = lm[0] * xi + lm[1] * xr + ei[u]; xr = nr; xi = ni; }
        XCH[seg * 64 + n] = (f32x2){xr, xi};
        __syncthreads();
        xr = 0.f; xi = 0.f;
        for (int s2 = 0; s2 < seg; ++s2) { const f32x2 e = XCH[s2 * 64 + n]; const float nr = pr * xr - pi * xi + e[0], ni = pr * xi + pi * xr + e[1]; xr = nr; xi = ni; }
        __syncthreads();
#pragma unroll
        for (int u = 0; u < SEG; ++u) { const int i = seg * SEG + u; const int ch = i < nc_ctx ? (M_LAT + b * TC) / S5L + (dir ? nc_ctx - 1 - i : i) : (b * T) / S5L + (dir ? nc_lat - 1 - (i - nc_ctx) : (i - nc_ctx));
            bf16* q = UG + ((size_t)g * NCHP + ch) * S5K + 512 + dir * 128 + n; q[0] = (bf16)f2bf(xr); q[64] = (bf16)f2bf(xi);
            const float nr = lm[0] * xr - lm[1] * xi + er[u], ni = lm[0] * xi + lm[1] * xr + ei[u]; xr = nr; xi = ni; }
    }
}

constexpr int PH_PRO = 3, PH_PER_L = 13, NPH = PH_PRO + PH_PER_L * NL;
#ifndef PROBE_REP
#define PROBE_REP -1
#endif
#define NREP(k) ((k) == PROBE_REP ? 2 : 1)
#ifdef ONLY
#define EN(k) ((k) == ONLY)
#else
#define EN(k) true
#endif
#ifdef EMU
void fwd(Args args) {
    unsigned char* lds = emu::lds_base();
#else
__global__ void __launch_bounds__(NTHR, 2) fwd(Args args) {
    extern __shared__ __attribute__((aligned(16))) unsigned char lds[];
#endif
    Ctx C; C.in = args.in; C.out = args.out; C.ws = args.ws; C.lds = (LAS unsigned char*)lds;
    C.tid = threadIdx.x; C.lane = C.tid & 63; C.wave = __builtin_amdgcn_readfirstlane(C.tid >> 6); C.G = gridDim.x; C.bid = blockIdx.x;
#define REFRESH() do { int t_ = threadIdx.x; OPAQUE(t_); C.tid = t_; C.lane = t_ & 63; C.wave = __builtin_amdgcn_readfirstlane(t_ >> 6); } while (0)
    volatile LAS unsigned* MISC = (volatile LAS unsigned*)(C.lds + MISC_OFF);
    if (C.tid < 32) MISC[C.tid] = 0u;
    __syncthreads();
    const int lo = args.ph_lo, hi = args.ph_hi;
    const bool use_bar = (hi - lo) > 1;
    XcdBarrier bar; bar.bar = (unsigned*)(C.ws + WS_CTL) + CW_BAR; bar.x = 0; bar.st = MISC + 8;
    if (use_bar) bar = xcd_barrier_post((unsigned*)(C.ws + WS_CTL) + CW_BAR, MISC + 8);
#define IN(k) (lo <= (k) && (k) < hi)
#define SEAM(k) do { if (IN(k) && IN((k) + 1)) xcd_barrier(bar); } while (0)
    if (EN(0) && IN(0)) for (int rep = 0; rep < NREP(0); ++rep) { REFRESH(); ph_ada(C); }
    SEAM(0);
    if (EN(1) && IN(1)) { REFRESH(); ph_conv(C); }
    SEAM(1);
    if (EN(2) && IN(2)) for (int rep = 0; rep < NREP(2); ++rep) { REFRESH(); ph_tab(C); }
    SEAM(2);
    for (int l = 0; l < NL; ++l) {
        const int pb = PH_PRO + PH_PER_L * l; const bool want_ctx = l < NL - 1;
        const int mrows_full = M, mrows_out = want_ctx ? M : M_LAT;
        const int nt_attn = AT_NA + AT_WA + (want_ctx ? 2 * AT_CX : 0), nt_attn_a = (int)((long)nt_attn * ATTN_A_PCT / 100);
        bf16* AP = (bf16*)(C.ws + WS_AP); bf16* Hb = (bf16*)(C.ws + WS_H); bf16* OB = (bf16*)(C.ws + WS_OB);
        if (EN(3) && IN(pb + 0)) for (int rep = 0; rep < NREP(3); ++rep) { REFRESH();
            Gemm g{AP, wl(C, l, OFF_W1GU), D, D, D, 0, 0}; Order S; S.init(mrows_full / 256, 2 * FF / 256, 1, C.G, C.bid, D / 64);
            EpiGU E{rowss_ptr(C, l, 0), bias_ptr(C, l, 0), Hb, mrows_full}; gemm_phase(C.lds, g, S, E);
            if (EN(1) && l + 1 < NL) { REFRESH(); const int r = S.total % C.G;
                if ((int)C.bid >= r) conv_weights(C, l + 1, (C.bid - r) * NW + C.wave, (C.G - r) * NW, 0, CI_X1); } }
        SEAM(pb + 0);
        if (EN(4) && IN(pb + 1)) { REFRESH();
            Gemm g{Hb, wl(C, l, OFF_W1D), FF, FF, FF, 0, 0}; Order S; S.init(M_LAT / 256, D / 256, 1, C.G, C.bid, FF / 64);
            EpiRes E{&C, gate_ptr(C, l, 0, 0), gs_ptr(C, l, 1, 0), rowss_ptr(C, l, 1), AP}; gemm_phase(C.lds, g, S, E);
            { REFRESH(); Order S2; S2.init_split(M_LAT / 256, M_CTX / 256, D / 256, 4, C.G, C.bid, FF / 64); EpiAcc E2{&C, gate_ptr(C, l, 0, 0)}; gemm_phase(C.lds, g, S2, E2); } }
        SEAM(pb + 1);
        if (EN(18) && IN(pb + 2)) { REFRESH(); ph_ctxfix(C, gs_ptr(C, l, 1, 0), rowss_ptr(C, l, 1)); }
        SEAM(pb + 2);
        if (EN(5) && IN(pb + 3)) for (int rep = 0; rep < NREP(5); ++rep) { REFRESH();
            Gemm g{AP, wl(C, l, OFF_WIN), D, D, D, 0, 0}; Order S; S.init(mrows_full / 256, NT_IN, 1, C.G, C.bid, D / 64);
            EpiIn E{&C, rowss_ptr(C, l, 1), bias_ptr(C, l, 1), l}; gemm_phase(C.lds, g, S, E); }
        SEAM(pb + 3);
        if (IN(pb + 4)) {
            if (EN(6)) for (int rep = 0; rep < NREP(6); ++rep) { REFRESH(); Gemm g{(const bf16*)(C.ws + WS_UG), (const bf16*)(C.ws + WS_S5T + (size_t)l * SZ_S5L + OFF_S5ET), S5K, 512, 512, (size_t)NCHP * S5K * 2, (size_t)256 * 512 * 2};
              const int off5 = C.G >= 256 ? 32 : 0; Order S; S.init(NCHP / 256, 1, S5G, C.G - off5, (int)C.bid < off5 ? (1 << 28) : (int)C.bid - off5, 512 / 64);        EpiS5A E{(float*)(C.ws + WS_XEND)}; gemm_phase(C.lds, g, S, E); }
            __syncthreads();
            for (int rep = 0; rep < NREP(9); ++rep) { if (EN(9)) { REFRESH(); ph_rw1(C, l); } }
            if (EN(7)) for (int rep = 0; rep < NREP(7); ++rep) { REFRESH(); const int fb = (C.G >= 256 && 2 * C.G < RBLK && RBLK % (2 * C.G) != 0) ? (RBLK % (2 * C.G) + 1) / 2 : 0;
                ph_attn(C, l, want_ctx, C.bid >= fb ? (C.bid - fb) * NW + C.wave : -1, (C.G - fb) * NW, 0, nt_attn_a); }
        }
        SEAM(pb + 4);
        if (IN(pb + 5)) {
            if (EN(17)) for (int rep = 0; rep < NREP(17); ++rep) { REFRESH(); ph_rw2(C); }
            if (EN(10)) for (int rep = 0; rep < NREP(10); ++rep) { REFRESH(); ph_s5scan(C, l, C.G >= 256 ? 64 : 0, C.G >= 256 ? 128 : C.G); }
            { REFRESH();
              const int nrb = C.G < RSTR * 2 ? C.G : RSTR * 2, sb_lo = C.G, sb_hi = C.G;
              const int nworkers = nrb * 7 + (C.G - nrb - (sb_hi - sb_lo)) * NW;
              const int widx = C.bid < nrb ? (C.wave == 0 ? -1 : C.bid * 7 + C.wave - 1) : (C.bid >= sb_lo && C.bid < sb_hi) ? -1 : nrb * 7 + (C.bid - nrb - (C.bid >= sb_hi ? sb_hi - sb_lo : 0)) * NW + C.wave;
              if (EN(7)) ph_attn(C, l, want_ctx, widx, nworkers, nt_attn_a, nt_attn); }
        }
        SEAM(pb + 5);
        if (IN(pb + 6)) {
            if (EN(11)) for (int rep = 0; rep < NREP(11); ++rep) { REFRESH(); Gemm g{(const bf16*)(C.ws + WS_UG), (const bf16*)(C.ws + WS_S5T + (size_t)l * SZ_S5L + OFF_S5BT), S5K, S5K, S5K, (size_t)NCHP * S5K * 2, (size_t)512 * S5K * 2};
              const int off5 = C.G >= 256 ? 64 : 0; Order S; S.init(NCHP / 256, 2, S5G, C.G - off5, (int)C.bid < off5 ? (1 << 28) : (int)C.bid - off5, S5K / 64);        EpiS5C E{(const bf16*)(C.ws + WS_UG), C.in[I_S5D] + (size_t)l * GW, (bf16*)(C.ws + WS_YG)}; gemm_phase(C.lds, g, S, E); }
            if (EN(12)) for (int rep = 0; rep < NREP(12); ++rep) { REFRESH(); ph_rw3(C, l, mrows_out); }
        }
        SEAM(pb + 6);
        if (EN(13) && IN(pb + 7)) for (int rep = 0; rep < NREP(13); ++rep) { REFRESH();
            Gemm g{(const bf16*)(C.ws + WS_YG), wl(C, l, OFF_WGLU), GW, GW, GW, 0, 0}; Order S; S.init(mrows_out / 256, GW / 256, 1, C.G, C.bid, GW / 64);
            EpiGLU E{(const bf16*)(C.ws + WS_YG), C.in[I_S5GLUB] + (size_t)l * GW, OB}; gemm_phase(C.lds, g, S, E); }
        SEAM(pb + 7);
        if (EN(14) && IN(pb + 8)) { REFRESH();
            Gemm g{OB, wl(C, l, OFF_WOUT), D, D, D, 0, 0}; Order S; S.init(M_LAT / 256, D / 256, 1, C.G, C.bid, D / 64);
            EpiRes E{&C, gate_ptr(C, l, 1, 0), gs_ptr(C, l, 2, 0), rowss_ptr(C, l, 2), AP}; gemm_phase(C.lds, g, S, E);
            if (want_ctx) { REFRESH(); Order S2; S2.init_split(M_LAT / 256, M_CTX / 256, D / 256, 4, C.G, C.bid, D / 64); EpiAcc E2{&C, gate_ptr(C, l, 1, 0)}; gemm_phase(C.lds, g, S2, E2); } }
        SEAM(pb + 8);
        if (EN(18) && IN(pb + 9) && want_ctx) { REFRESH(); ph_ctxfix(C, gs_ptr(C, l, 2, 0), rowss_ptr(C, l, 2)); }
        SEAM(pb + 9);
        if (EN(15) && IN(pb + 10)) { REFRESH();
            Gemm g{AP, wl(C, l, OFF_W2GU), D, D, D, 0, 0}; Order S; S.init(mrows_out / 256, 2 * FF / 256, 1, C.G, C.bid, D / 64);
            EpiGU E{rowss_ptr(C, l, 2), bias_ptr(C, l, 2), Hb, mrows_out}; gemm_phase(C.lds, g, S, E);
            if (EN(1) && l + 1 < NL) { REFRESH(); const int r = S.total % C.G;
                if ((int)C.bid >= r) conv_weights(C, l + 1, (C.bid - r) * NW + C.wave, (C.G - r) * NW, CI_X1, CI_LAYER); } }
        SEAM(pb + 10);
        if (EN(16) && IN(pb + 11)) { REFRESH();
            Gemm g{Hb, wl(C, l, OFF_W2D), FF, FF, FF, 0, 0}; Order S; S.init(M_LAT / 256, D / 256, 1, C.G, C.bid, FF / 64);
            const bool more = l + 1 < NL;
            EpiRes E{&C, gate_ptr(C, l, 2, 0), more ? gs_ptr(C, l + 1, 0, 0) : nullptr, more ? rowss_ptr(C, l + 1, 0) : nullptr, AP}; gemm_phase(C.lds, g, S, E);
            if (want_ctx) { REFRESH(); Order S2; S2.init_split(M_LAT / 256, M_CTX / 256, D / 256, 4, C.G, C.bid, FF / 64); EpiAcc E2{&C, gate_ptr(C, l, 2, 0)}; gemm_phase(C.lds, g, S2, E2); } }
        SEAM(pb + 11);
        if (EN(18) && IN(pb + 12) && want_ctx) { REFRESH(); ph_ctxfix(C, gs_ptr(C, l + 1, 0, 0), rowss_ptr(C, l + 1, 0)); }
        SEAM(pb + 12);
    }
#undef IN
#undef SEAM
}

#ifndef MK_PER_PHASE
#define MK_PER_PHASE 0
#endif
#ifdef EMU
int g_emu_grid = 4, g_emu_lo = 0, g_emu_hi = NPH;
#endif
extern "C" void kernel_launch(void* const* d_in, const int* in_sizes, int n_in, void* d_out, int out_size, void* d_ws, size_t ws_size, hipStream_t stream) {
    Args a{};
    for (int i = 0; i < 42; ++i) a.in[i] = (const float*)d_in[i];
    a.out = (float*)d_out; a.ws = (unsigned char*)d_ws;
#ifdef EMU
    if (g_emu_lo == 0) hipMemsetAsync(d_ws, 0, WS_ZERO_END, stream);
    for (int ph = g_emu_lo; ph < g_emu_hi; ++ph) { a.ph_lo = ph; a.ph_hi = ph + 1; fprintf(stderr, "phase %d\n", ph); emu::launch(g_emu_grid, NTHR, LDS_BYTES, [=] { fwd(a); }); }
#else
    static int grid = 0;
    if (grid == 0) {
        if (n_in != 42 || out_size != M_LAT * D || ws_size < WS_END) { fprintf(stderr, "kernel_launch: unexpected shapes (n_in %d out %d ws %zu need %zu)\n", n_in, out_size, ws_size, (size_t)WS_END); grid = -1; return; }
        int dev = 0, cus = 0;
        if (hipGetDevice(&dev) != hipSuccess || hipDeviceGetAttribute(&cus, hipDeviceAttributeMultiprocessorCount, dev) != hipSuccess) { grid = -1; return; }
        if (hipFuncSetAttribute((const void*)fwd, hipFuncAttributeMaxDynamicSharedMemorySize, LDS_BYTES) != hipSuccess) { fprintf(stderr, "kernel_launch: hipFuncSetAttribute failed\n"); grid = -1; return; }
        int per_cu = 0; (void)hipOccupancyMaxActiveBlocksPerMultiprocessor(&per_cu, (const void*)fwd, NTHR, LDS_BYTES); (void)hipGetLastError();
        if (per_cu < 1) fprintf(stderr, "kernel_launch: occupancy query reports %d\n", per_cu);
        grid = cus;
    }
    if (grid < 0) return;
    (void)hipMemsetAsync(d_ws, 0, WS_ZERO_END, stream);
#if MK_PER_PHASE
    for (int ph = 0; ph < NPH; ++ph) { a.ph_lo = ph; a.ph_hi = ph + 1; hipLaunchKernelGGL(fwd, dim3(grid), dim3(NTHR), LDS_BYTES, stream, a); }
#else
    a.ph_lo = 0; a.ph_hi = NPH;
    hipLaunchKernelGGL(fwd, dim3(grid), dim3(NTHR), LDS_BYTES, stream, a);
#endif
#endif
}
```

```cpp
#ifdef EMU
#include "emu/emu.h"
#define LAS
#define GAS
#define ASMV(...) ((void)0)
#define WSYNC() do { int _z = 0; (void)emu::wave_gather(&_z, 4); } while (0)
#define OPAQUE(x) ((void)0)
#define OPAQUE_S(x) ((void)0)
#define PIN(x) ((void)0)
#define PIN4(a, b, c, d) ((void)0)
#define OPAQUE_LDS(p) (p)
#else
#include <hip/hip_runtime.h>
#include <cstdio>
#include <cstdint>
#define LAS __attribute__((address_space(3)))
#define GAS __attribute__((address_space(1)))
#define ASMV(...) asm volatile(__VA_ARGS__)
#define PIN(x) asm volatile("" : "+v"(x) :: "memory")
#define PIN4(a, b, c, d) asm volatile("" : "+v"(a), "+v"(b), "+v"(c), "+v"(d) :: "memory")
template <class P> __device__ __forceinline__ P opaque_lds(P p) { unsigned a = (unsigned)(size_t)p; asm volatile("" : "+v"(a)); return (P)(size_t)a; }
#define OPAQUE_LDS(p) opaque_lds(p)
#define OPAQUE_S(x) asm volatile("" : "+s"(x))
#define OPAQUE(x) asm volatile("" : "+v"(x))
#define WSYNC() asm volatile("s_waitcnt lgkmcnt(0)" ::: "memory")
#endif

#ifdef EMU
constexpr int D = 1024, NB = 2, T = 1024, NL = 2, TC = 256, FF = 1024;
#else
constexpr int D = 2048, NB = 2, T = 8192, NL = 4, TC = 256, FF = 5632;
#endif
constexpr int GW = D / 4, NH = GW / 64, WAG = NH / 2, S5G = GW / 16, GRW = 64, GRH = T / GRW;
constexpr int M_LAT = NB * T, M_CTX = NB * TC, M = M_LAT + M_CTX, NPAN = M / 256;
constexpr int TP = GW / 256;
constexpr int NT_IN = 8 * TP + 2, NINP = NT_IN * 256, D_IN = 8 * GW + 416;
constexpr int PN_AQ = 0, PN_AK = TP, PN_AV = 2 * TP, PN_BR = 3 * TP, PN_BK = 4 * TP, PN_BV = 5 * TP, PN_BS = 6 * TP, PN_CQ = 6 * TP + 1, PN_CKV = 7 * TP + 1, PN_DU = 7 * TP + 2;
constexpr int SRC_AQ = 0, SRC_AK = GW, SRC_AV = 2 * GW, SRC_BR = 3 * GW, SRC_BK = 4 * GW, SRC_BV = 5 * GW, SRC_BS = 6 * GW, SRC_CQ = 6 * GW + 160, SRC_CK = 7 * GW + 160, SRC_CV = 7 * GW + 288, SRC_DU = 7 * GW + 416;
constexpr int S5L = 32, NCH = M / S5L, NCHP = ((NCH + 255) / 256) * 256, S5K = 768;
constexpr int NW = 8, NTHR = 512;
constexpr float NORM_EPS = 1e-6f, RW_GN_EPS = 64e-5f;

typedef unsigned short bf16;
typedef short bf16x8 __attribute__((ext_vector_type(8)));
typedef short s16x4 __attribute__((ext_vector_type(4)));
typedef float f32x4 __attribute__((ext_vector_type(4)));
typedef float f32x2 __attribute__((ext_vector_type(2)));
typedef float f32x16 __attribute__((ext_vector_type(16)));
typedef unsigned u32x4 __attribute__((ext_vector_type(4)));
typedef unsigned u32x2 __attribute__((ext_vector_type(2)));
#define DI __device__ __forceinline__

constexpr size_t al256(size_t x) { return (x + 255) & ~(size_t)255; }
constexpr size_t SZ_BIAS_GU = (size_t)3 * 2 * FF * 4, SZ_BIAS_IN = (size_t)3 * NINP * 4;
constexpr size_t WS_CTL = 0;
constexpr size_t WS_BIAS = 65536;
constexpr size_t SZ_BIAS_L = 2 * SZ_BIAS_GU + SZ_BIAS_IN;
constexpr size_t WS_ROWSS = al256(WS_BIAS + NL * SZ_BIAS_L);
constexpr size_t WS_ZERO_END = al256(WS_ROWSS + (size_t)NL * 3 * M * 4);
constexpr size_t WS_MODV = WS_ZERO_END;
constexpr size_t WS_GS = al256(WS_MODV + (size_t)NL * 3 * 9 * D * 4);
constexpr size_t WS_GATE = al256(WS_GS + (size_t)NL * 9 * D * 4);
constexpr size_t WS_ROPE = al256(WS_GATE + (size_t)NL * 9 * D * 4);
constexpr size_t SZ_WGU = (size_t)2 * FF * D * 2, SZ_WD = (size_t)D * FF * 2, SZ_WIN = (size_t)NINP * D * 2, SZ_WOUT = (size_t)D * D * 2, SZ_WGLU = (size_t)GW * GW * 2;
constexpr size_t OFF_W1GU = 0, OFF_W1D = OFF_W1GU + SZ_WGU, OFF_WIN = OFF_W1D + SZ_WD, OFF_WOUT = OFF_WIN + SZ_WIN, OFF_W2GU = OFF_WOUT + SZ_WOUT, OFF_W2D = OFF_W2GU + SZ_WGU, OFF_WGLU = OFF_W2D + SZ_WD, SZ_WL = OFF_WGLU + SZ_WGLU;
constexpr size_t WS_W = al256(WS_ROPE + 128 * 16 * 8);
constexpr size_t SZ_S5KC = (size_t)S5G * 2 * S5L * 256 * 4, SZ_S5ET = (size_t)S5G * 256 * 512 * 2, SZ_S5BT = (size_t)S5G * 512 * S5K * 2, SZ_S5LAM = (size_t)2 * GW * 4 * 8;
constexpr size_t SZ_S5LP = (size_t)2 * S5G * 64 * (S5L + 1) * 8, SZ_S5BETA = (size_t)2 * S5G * 64 * 16 * 8;
constexpr size_t OFF_S5KC = 0, OFF_S5ET = OFF_S5KC + SZ_S5KC, OFF_S5BT = OFF_S5ET + SZ_S5ET, OFF_S5LAM = OFF_S5BT + SZ_S5BT, OFF_S5LP = al256(OFF_S5LAM + SZ_S5LAM), OFF_S5BETA = OFF_S5LP + SZ_S5LP, SZ_S5L = al256(OFF_S5BETA + SZ_S5BETA);
constexpr size_t WS_S5T = al256(WS_W + NL * SZ_WL);
constexpr size_t WS_XC = al256(WS_S5T + NL * SZ_S5L);
constexpr size_t WS_AP = al256(WS_XC + (size_t)M_CTX * D * 4);
constexpr size_t WS_H = al256(WS_AP + (size_t)M * D * 2);
constexpr size_t WS_QA = al256(WS_H + (size_t)M * FF * 2);
constexpr size_t WS_KA = WS_QA + (size_t)M * GW * 2, WS_VA = WS_KA + (size_t)M * GW * 2, WS_QC = WS_VA + (size_t)M * GW * 2;
constexpr size_t WS_KC = WS_QC + (size_t)M * GW * 2, WS_VC = WS_KC + (size_t)M * 128 * 2;
constexpr size_t WS_PB = WS_VC + (size_t)M * 128 * 2;
constexpr size_t WS_PS = al256(WS_PB + (size_t)M * 3 * GW * 2);
constexpr size_t WS_UG = al256(WS_PS + (size_t)M * 160 * 4);
constexpr size_t WS_RW = al256(WS_UG + (size_t)S5G * NCHP * S5K * 2);
constexpr size_t SZ_RWA = (size_t)M * GW * 4;
enum { RW_R = 0, RW_V, RW_NKK, RW_G, RW_W0, RW_W1, RW_K0, RW_K1, RW_B0, RW_B1, RW_Y0, RW_Y1, RW_NARR };
constexpr size_t WS_XEND = al256(WS_RW + 256);
constexpr size_t WS_YG = al256(WS_XEND + (size_t)S5G * NCHP * 256 * 4);
constexpr size_t WS_OB = al256(WS_YG + (size_t)M * GW * 2);
constexpr int RCK = (TC + T) / 64, RSTR = NB * NH * 2, RITEM = RSTR * RCK;
constexpr size_t WS_QH = al256(WS_OB + (size_t)M * D * 2);
constexpr size_t WS_YL = al256(WS_QH + (size_t)RITEM * 8192);
constexpr size_t WS_MF = al256(WS_YL + (size_t)RITEM * 16384);
constexpr size_t WS_GF = al256(WS_MF + (size_t)RITEM * 8192);
constexpr size_t WS_SF = al256(WS_GF + (size_t)RITEM * 16384);
constexpr int RBLK = NB * NH * ((TC + T) / 64);
constexpr size_t WS_RVKG = al256(WS_SF + (size_t)RITEM * 8192);
constexpr size_t SZ_RWF = (size_t)14 * NH * 2 * 64 * 16;
constexpr size_t WS_RWF = al256(WS_RVKG + (size_t)RBLK * 32768);
constexpr size_t WS_RWS = al256(WS_RWF + NL * SZ_RWF);
constexpr size_t WS_END = al256(WS_RWS + (size_t)512 * 2 * 65536);
constexpr int CW_BAR = 1024;

constexpr int LDS_BYTES = 147456, RING_BYTES = 131072, MISC_OFF = LDS_BYTES - 256;

DI unsigned f2bf(float f) { unsigned u = __float_as_uint(f); return (u + 0x7fffu + ((u >> 16) & 1u)) >> 16; }
#ifdef EMU
DI unsigned pk2(float lo, float hi) { return f2bf(lo) | (f2bf(hi) << 16); }
#else
typedef __bf16 hbf16x2 __attribute__((ext_vector_type(2)));
DI unsigned pk2(float lo, float hi) { const f32x2 v = {lo, hi}; const hbf16x2 b = __builtin_convertvector(v, hbf16x2); return __builtin_bit_cast(unsigned, b); }
#endif
DI float bf2f(unsigned short b) { return __uint_as_float(((unsigned)b) << 16); }
DI float bflo(unsigned w) { return __uint_as_float(w << 16); }
DI float bfhi(unsigned w) { return __uint_as_float(w & 0xffff0000u); }
template <int N> DI float ror_add(float v) { return v + __int_as_float(__builtin_amdgcn_mov_dpp(__float_as_int(v), 0x120 + N, 0xf, 0xf, true)); }
DI float row16_sum(float v) { v = ror_add<8>(v); v = ror_add<4>(v); v = ror_add<2>(v); v = ror_add<1>(v); return v; }
DI float wave_sum(float v) {
    v = row16_sum(v);
    const float a = __int_as_float(__builtin_amdgcn_readlane(__float_as_int(v), 0)), b = __int_as_float(__builtin_amdgcn_readlane(__float_as_int(v), 16)),
                c = __int_as_float(__builtin_amdgcn_readlane(__float_as_int(v), 32)), d = __int_as_float(__builtin_amdgcn_readlane(__float_as_int(v), 48));
    return (a + b) + (c + d);
}
DI float siluf(float x) { return x * __builtin_amdgcn_rcpf(1.f + __expf(-x)); }
DI float fast_tanh(float x) { const float e = __expf(2.f * x); return 1.f - 2.f * __builtin_amdgcn_rcpf(e + 1.f); }
DI float sigmf(float x) { return __builtin_amdgcn_rcpf(1.f + __expf(-x)); }
DI float geluf(float x) { const float z = 0.7978845608028654f * (x + 0.044715f * x * x * x); const float e = __expf(2.f * z); return 0.5f * x * (1.f + (1.f - 2.f * __builtin_amdgcn_rcpf(e + 1.f))); }
DI int stream_of_row(int row) { return row < M_LAT ? row / T : NB; }
DI int stream_of_panel(int pm) { return stream_of_row(pm * 256); }

#define XB_TMO      128
#define XB_XCNT(j)  (256  + 64 * (j))
#define XB_XSUB(j)  (1280 + 64 * (j))
#define XB_XGEN(j)  (2304 + 64 * (j))
#define XB_TOP      3328
#define XB_TOPGEN   3392
#define XCD_BAR_WORDS 3456
#define XB_SPIN_CAP (1u << 18)
DI unsigned xb_ld(unsigned* p)              { return __hip_atomic_load(p, __ATOMIC_RELAXED, __HIP_MEMORY_SCOPE_AGENT); }
DI unsigned xb_add(unsigned* p, unsigned v) { return __hip_atomic_fetch_add(p, v, __ATOMIC_RELAXED, __HIP_MEMORY_SCOPE_AGENT); }
DI unsigned xb_xcc_id() { return (unsigned)__builtin_amdgcn_s_getreg((3 << 11) | 20) & 0xFu; }
#define XB_SPIN(cond, bar) do { unsigned _sp = 0; while (cond) { __builtin_amdgcn_s_sleep(1); \
    if ((++_sp & 255u) == 0u) { if (xb_ld(&(bar)[XB_TMO])) break; if (_sp > XB_SPIN_CAP) { atomicAdd(&(bar)[XB_TMO], 1u); break; } } } } while (0)
struct XcdBarrier { unsigned* bar; unsigned x; volatile LAS unsigned* st; };
DI XcdBarrier xcd_barrier_post(unsigned* bar, volatile LAS unsigned* st) {
    XcdBarrier b; b.bar = bar; b.x = xb_xcc_id(); b.st = st;
    if (threadIdx.x == 0) (void)xb_add(&bar[XB_XCNT(b.x)], 1u);
    return b;
}
DI void xcd_barrier_complete(unsigned* bar, unsigned x, unsigned& nloc, unsigned& nx) {
    const unsigned G = gridDim.x * gridDim.y * gridDim.z;
    unsigned sum, cnt, mine, sp = 0u;
    for (;;) {
        sum = 0u; cnt = 0u; mine = 0u;
#pragma unroll
        for (unsigned j = 0; j < 16; ++j) { const unsigned c = xb_ld(&bar[XB_XCNT(j)]); sum += c; cnt += (c > 0u) ? 1u : 0u; mine = (j == x) ? c : mine; }
        if (sum == G) break;
        __builtin_amdgcn_s_sleep(1);
        if ((++sp & 255u) == 0u) { if (xb_ld(&bar[XB_TMO])) break; if (sp > XB_SPIN_CAP) { atomicAdd(&bar[XB_TMO], 1u); break; } }
    }
    nloc = mine > 0u ? mine : 1u; nx = cnt > 0u ? cnt : 1u;
}
DI void xcd_barrier(const XcdBarrier& b) {
    ASMV("s_waitcnt vmcnt(0)" ::: "memory");
    __syncthreads();
    if (threadIdx.x == 0) {
        unsigned* bar = b.bar;
        __builtin_amdgcn_s_waitcnt(0);
        unsigned nloc = b.st[0], nx = b.st[1];
        if (nloc == 0u) { xcd_barrier_complete(bar, b.x, nloc, nx); b.st[0] = nloc; b.st[1] = nx; }
        const unsigned old = xb_add(&bar[XB_XSUB(b.x)], 1u);
        const unsigned gen = old / nloc;
        if (old + 1u == (gen + 1u) * nloc) {
            __builtin_amdgcn_fence(__ATOMIC_RELEASE, "agent");
            ASMV("s_waitcnt vmcnt(0)" ::: "memory");
            const unsigned og = xb_add(&bar[XB_TOP], 1u);
            const unsigned tg = og / nx;
            if (og + 1u == (tg + 1u) * nx) xb_add(&bar[XB_TOPGEN], 1u);
            else XB_SPIN(xb_ld(&bar[XB_TOPGEN]) == tg, bar);
            __builtin_amdgcn_fence(__ATOMIC_ACQUIRE, "agent");
            xb_add(&bar[XB_XGEN(b.x)], 1u);
            ASMV("s_waitcnt vmcnt(0)" ::: "memory");
        } else {
            XB_SPIN(xb_ld(&bar[XB_XGEN(b.x)]) == gen, bar);
            __builtin_amdgcn_fence(__ATOMIC_ACQUIRE, "agent");
            ASMV("s_waitcnt vmcnt(0)" ::: "memory");
        }
    }
    __syncthreads();
}

constexpr int BK = 64, HALF = 128, HTB = HALF * BK * 2, NXCD = 8, WGM = 4;
DI int lds_byte(int r, int c) { const int st = (r >> 4) * 2 + (c >> 5), rr = r & 15, cc = c & 31, ob = rr * 64 + cc * 2; return st * 1024 + (ob ^ (((ob >> 9) & 1) << 5)); }
DI void stage_rc(int b, int& R, int& C) { const int st = b / 1024, sb = b % 1024, swz = sb ^ (((sb >> 9) & 1) << 5); R = (st >> 1) * 16 + swz / 64; C = (st & 1) * 32 + (swz % 64) / 2; }
struct Unit { int pm, pn, z, kt0; };
struct Gemm { const bf16* A; const bf16* Bt; int lda, ldb, K; size_t zA, zB; };
struct Order {
    int nM, nN, nZ, per, total, G, c, nkt, pm0, spl;
    DI void init(int nM_, int nN_, int nZ_, int G_, int c_, int nkt_) { nM = nM_; nN = nN_; nZ = nZ_; per = nM * nN; total = per * nZ; G = G_; c = c_; nkt = nkt_; pm0 = 0; spl = 0; }
    DI void init_split(int pm0_, int xM, int nN_, int spl_, int G_, int c_, int nkt_full) { nM = xM; nN = nN_; nZ = 1; per = xM * nN_ * spl_; total = per; G = G_; c = c_; nkt = nkt_full / spl_; pm0 = pm0_; spl = spl_; }
    DI bool next(int i, Unit& u) const {
        const long L = (long)i * G + c; if (L >= total) return false;
        if (spl) { const int j = (int)L; u.z = 0; u.pm = pm0 + j / (nN * spl); const int rem = j % (nN * spl); u.pn = rem / spl; u.kt0 = (rem % spl) * nkt; return true; }
        u.kt0 = 0;
        u.z = (int)(L / per); int wgid = (int)(L % per);
        { const int q = per / NXCD, r = per % NXCD, xcd = wgid % NXCD, off = wgid / NXCD; wgid = (xcd < r ? xcd * (q + 1) : r * (q + 1) + (xcd - r) * q) + off; }
        const int nig = WGM * nN, gid = wgid / nig, fm = gid * WGM, gsz = (nM - fm) < WGM ? (nM - fm) : WGM;
        u.pm = fm + ((wgid % nig) % gsz); u.pn = (wgid % nig) / gsz; return true;
    }
};

template <class Epi>
DI void gemm_phase(LAS unsigned char* lds, const Gemm g, const Order& S, const Epi& E) {
    int tid_ = threadIdx.x; OPAQUE(tid_);
    const int tid = tid_, wid = __builtin_amdgcn_readfirstlane(tid >> 6), lane = tid & 63, wr = wid >> 2, wc = wid & 3, fr = lane & 15, fq = lane >> 4;
    Unit cur, nxt; int ui = 0;
    if (!S.next(0, cur)) return;
    f32x4 acc[2][2][4][2];
#ifdef EMU
    (void)lds;
    for (;; ++ui) {
        if (ui > 0) { if (!S.next(ui, cur)) break; }
        const bf16* A = (const bf16*)((const char*)g.A + cur.z * g.zA); const bf16* B = (const bf16*)((const char*)g.Bt + cur.z * g.zB);
        for (int ai = 0; ai < 2; ++ai) for (int bj = 0; bj < 2; ++bj) for (int m = 0; m < 4; ++m) for (int n = 0; n < 2; ++n) for (int j = 0; j < 4; ++j) {
            const int r = 256 * cur.pm + 128 * ai + 64 * wr + 16 * m + fr, c = 256 * cur.pn + 128 * bj + 32 * wc + 16 * n + 4 * fq + j;
            const bf16* a = A + (size_t)r * g.lda; const bf16* b = B + (size_t)c * g.ldb; float s = 0.f;
            for (int k = cur.kt0 * BK; k < (cur.kt0 + S.nkt) * BK; ++k) s += bf2f(a[k]) * bf2f(b[k]);
            acc[ai][bj][m][n][j] = s; }
        E(acc, cur, wr, wc, fr, fq);
    }
#else
    unsigned voffA[2], voffB[2];
#pragma unroll
    for (int i = 0; i < 2; ++i) { int R, C; stage_rc(tid * 16 + i * 8192, R, C); voffA[i] = (unsigned)(R * g.lda + C) * 2u; voffB[i] = (unsigned)(R * g.ldb + C) * 2u; }
    const size_t kstep = (size_t)(BK * 2);
    const size_t hstepA = (size_t)HALF * g.lda * 2, hstepB = (size_t)HALF * g.ldb * 2, tstepA = 2 * hstepA, tstepB = 2 * hstepB;
    const unsigned ldsw = (unsigned)wid * 1024u;
    const int aoff = lds_byte(wr * 64 + fr, fq * 8), boff = lds_byte(wc * 32 + fr, fq * 8);
#define PG8_SA(b, h) (((b) * 2 + (h)) * HTB)
#define PG8_SB(b, h) ((4 + (b) * 2 + (h)) * HTB)
#define PG8_STAGE(bufoff, gbase, voff) do { _Pragma("unroll") for (int _i = 0; _i < 2; ++_i) \
        __builtin_amdgcn_global_load_lds((const unsigned*)((const char*)(gbase) + (voff)[_i]), (LAS unsigned*)(lds + (bufoff) + ldsw + _i * 8192), 16, 0, 0); } while (0)
#define PG8_LDA(dst, b, h) do { _Pragma("unroll") for (int m = 0; m < 4; ++m) _Pragma("unroll") for (int k = 0; k < 2; ++k) dst[m][k] = *(const LAS bf16x8*)(lds + PG8_SA(b, h) + aoff + m * 2048 + k * 1024); } while (0)
#define PG8_LDB(dst, b, h) do { _Pragma("unroll") for (int n = 0; n < 2; ++n) _Pragma("unroll") for (int k = 0; k < 2; ++k) dst[n][k] = *(const LAS bf16x8*)(lds + PG8_SB(b, h) + boff + n * 2048 + k * 1024); } while (0)
#define PG8_MMA(ai, bj, At, Bt) do { __builtin_amdgcn_s_setprio(1); _Pragma("unroll") for (int m = 0; m < 4; ++m) _Pragma("unroll") for (int n = 0; n < 2; ++n) _Pragma("unroll") for (int k = 0; k < 2; ++k) \
        acc[ai][bj][m][n] = __builtin_amdgcn_mfma_f32_16x16x32_bf16(Bt[n][k], At[m][k], acc[ai][bj][m][n], 0, 0, 0); __builtin_amdgcn_s_setprio(0); } while (0)
#define PG8_WAIT_V(n) asm volatile("s_waitcnt vmcnt(" #n ")" ::: "memory")
#define PG8_WAIT_L(n) asm volatile("s_waitcnt lgkmcnt(" #n ")" ::: "memory")
#define PG8_BAR __builtin_amdgcn_s_barrier()
#define PG8_SCHED __builtin_amdgcn_sched_barrier(0)
#pragma unroll
    for (int a = 0; a < 2; ++a)
#pragma unroll
        for (int b = 0; b < 2; ++b)
#pragma unroll
            for (int m = 0; m < 4; ++m)
#pragma unroll
                for (int n = 0; n < 2; ++n) acc[a][b][m][n] = (f32x4){0.f, 0.f, 0.f, 0.f};
    bf16x8 At[4][2], B0[2][2], B1[2][2];
    const char* cA = (const char*)g.A + (size_t)cur.z * g.zA + (size_t)cur.pm * tstepA + (size_t)cur.kt0 * kstep; const char* cB = (const char*)g.Bt + (size_t)cur.z * g.zB + (size_t)cur.pn * tstepB + (size_t)cur.kt0 * kstep;
    PG8_STAGE(PG8_SB(0, 0), cB, voffB); PG8_STAGE(PG8_SB(0, 1), cB + hstepB, voffB); PG8_STAGE(PG8_SA(0, 0), cA, voffA); PG8_STAGE(PG8_SA(0, 1), cA + hstepA, voffA);
    if (wr == 1) PG8_BAR;
    PG8_WAIT_V(2); PG8_BAR;
    PG8_STAGE(PG8_SB(1, 0), cB + kstep, voffB); PG8_STAGE(PG8_SA(1, 0), cA + kstep, voffA); PG8_STAGE(PG8_SB(1, 1), cB + hstepB + kstep, voffB);
    PG8_WAIT_V(6); PG8_BAR;
    for (;;) {
        const bool has_next = S.next(ui + 1, nxt);
        const char* nA = has_next ? (const char*)g.A + (size_t)nxt.z * g.zA + (size_t)nxt.pm * tstepA + (size_t)nxt.kt0 * kstep : cA; const char* nB = has_next ? (const char*)g.Bt + (size_t)nxt.z * g.zB + (size_t)nxt.pn * tstepB + (size_t)nxt.kt0 * kstep : cB;
        const int nt = S.nkt;
        for (int t = 0; t < nt; t += 2) {
            const bool last = (t == nt - 2);
            const char* a1 = cA + (size_t)(t + 1) * kstep;
            const char* a2 = last ? nA : cA + (size_t)(t + 2) * kstep; const char* b2 = last ? nB : cB + (size_t)(t + 2) * kstep;
            const char* a3 = a2 + kstep; const char* b3 = b2 + kstep;
            PG8_LDB(B0, 0, 0); PG8_LDB(B1, 0, 1); PG8_SCHED; PG8_LDA(At, 0, 0); PG8_STAGE(PG8_SA(1, 1), a1 + hstepA, voffA);
            PG8_WAIT_V(8); PG8_WAIT_L(0); PG8_BAR; PG8_MMA(0, 0, At, B0); PG8_MMA(0, 1, At, B1); PG8_BAR; PG8_SCHED;
            PG8_LDA(At, 0, 1); PG8_STAGE(PG8_SB(0, 0), b2, voffB); PG8_STAGE(PG8_SB(0, 1), b2 + hstepB, voffB); PG8_STAGE(PG8_SA(0, 0), a2, voffA);
            PG8_WAIT_V(8); PG8_WAIT_L(0); PG8_BAR; PG8_MMA(1, 0, At, B0); PG8_MMA(1, 1, At, B1); PG8_BAR; PG8_SCHED;
            PG8_LDB(B0, 1, 0); PG8_LDB(B1, 1, 1); PG8_SCHED; PG8_LDA(At, 1, 0); PG8_STAGE(PG8_SA(0, 1), a2 + hstepA, voffA);
            PG8_WAIT_V(8); PG8_WAIT_L(0); PG8_BAR; PG8_MMA(0, 0, At, B0); PG8_MMA(0, 1, At, B1); PG8_BAR; PG8_SCHED;
            PG8_LDA(At, 1, 1); PG8_STAGE(PG8_SB(1, 0), b3, voffB); PG8_STAGE(PG8_SB(1, 1), b3 + hstepB, voffB); PG8_STAGE(PG8_SA(1, 0), a3, voffA);
            PG8_WAIT_V(8); PG8_WAIT_L(0); PG8_BAR; PG8_MMA(1, 0, At, B0); PG8_MMA(1, 1, At, B1); PG8_BAR; PG8_SCHED;
        }
        if (wr == 0) PG8_BAR;
        E(acc, cur, wr, wc, fr, fq);
        if (!has_next) break;
#pragma unroll
        for (int a = 0; a < 2; ++a)
#pragma unroll
            for (int b = 0; b < 2; ++b)
#pragma unroll
                for (int m = 0; m < 4; ++m)
#pragma unroll
                    for (int n = 0; n < 2; ++n) acc[a][b][m][n] = (f32x4){0.f, 0.f, 0.f, 0.f};
        cur = nxt; cA = nA; cB = nB; ++ui;
        if (wr == 1) PG8_BAR;
    }
    PG8_WAIT_V(0);
    PG8_BAR;
#undef PG8_SA
#undef PG8_SB
#undef PG8_STAGE
#undef PG8_LDA
#undef PG8_LDB
#undef PG8_MMA
#undef PG8_WAIT_V
#undef PG8_WAIT_L
#undef PG8_BAR
#undef PG8_SCHED
#endif
}

struct Args {
    const float* in[42]; float* out; unsigned char* ws;
    int ph_lo, ph_hi;
};
struct Ctx {
    const float* const* in; float* out; unsigned char* ws;
    LAS unsigned char* lds; int tid, lane, wave, G, bid;
};
DI float* xrow_ptr(const Ctx& C, int row) { return row < M_LAT ? C.out + (size_t)row * D : (float*)(C.ws + WS_XC) + (size_t)(row - M_LAT) * D; }
DI const bf16* wl(const Ctx& C, int l, size_t off) { return (const bf16*)(C.ws + WS_W + (size_t)l * SZ_WL + off); }
DI float* bias_ptr(const Ctx& C, int l, int which  ) { return (float*)(C.ws + WS_BIAS + (size_t)l * SZ_BIAS_L + (which == 0 ? 0 : which == 1 ? SZ_BIAS_GU : SZ_BIAS_GU + SZ_BIAS_IN)); }
DI float* rowss_ptr(const Ctx& C, int l, int sub) { return (float*)(C.ws + WS_ROWSS) + ((size_t)l * 3 + sub) * M; }
DI const float* gs_ptr(const Ctx& C, int l, int sub, int s) { return (const float*)(C.ws + WS_GS) + (((size_t)l * 3 + sub) * 3 + s) * D; }
DI const float* gate_ptr(const Ctx& C, int l, int sub, int s) { return (const float*)(C.ws + WS_GATE) + (((size_t)l * 3 + sub) * 3 + s) * D; }
DI float* rw_arr(const Ctx& C, int a) { return (float*)(C.ws + WS_RW + (size_t)a * SZ_RWA); }
enum { I_X = 0, I_C, I_CTX, I_CCTX, I_WADA, I_BADA, I_NORMG, I_F1WG, I_F1WU, I_F1WD, I_F2WG, I_F2WU, I_F2WD, I_WIN, I_WOUT, I_NAQG, I_NAKG, I_NARPB, I_RWCONV, I_RWW0, I_RWWUP, I_RWA0, I_RWAUP,
       I_RWGUP, I_RWKK, I_RWKA, I_RWRK, I_RWGNW, I_RWGNB, I_WAQG, I_WAKG, I_WASINK, I_S5ARE, I_S5AIM, I_S5LDT, I_S5BRE, I_S5BIM, I_S5CRE, I_S5CIM, I_S5D, I_S5GLUW, I_S5GLUB, I_NIN };

struct EpiGU {
    const float* rowss; const float* bias  ; bf16* H; int mrows;
    DI void operator()(const f32x4 (&acc)[2][2][4][2], const Unit& u, int wr, int wc, int fr_, int fq_) const {
        int tz_ = threadIdx.x; OPAQUE(tz_); const int fr = tz_ & 15, fq = (tz_ & 63) >> 4; (void)fr_; (void)fq_;
        const int s = stream_of_panel(u.pm); const float* bs = bias + (size_t)s * 2 * FF + u.pn * 256 + wc * 32 + 4 * fq;
        f32x4 bg[2], bu[2];
#pragma unroll
        for (int n = 0; n < 2; ++n) { bg[n] = *(const f32x4*)(bs + 16 * n); bu[n] = *(const f32x4*)(bs + 128 + 16 * n); }
        float rsv[2][4];
#pragma unroll
        for (int ai = 0; ai < 2; ++ai)
#pragma unroll
            for (int m = 0; m < 4; ++m) rsv[ai][m] = rowss[u.pm * 256 + ai * 128 + wr * 64 + m * 16 + fr];
#pragma unroll
        for (int ai = 0; ai < 2; ++ai)
#pragma unroll
            for (int m = 0; m < 4; ++m) {
                const int row = u.pm * 256 + ai * 128 + wr * 64 + m * 16 + fr;
                const float rstd = __builtin_amdgcn_rsqf(rsv[ai][m] * (1.0f / D) + NORM_EPS);
                bf16* hp = H + (size_t)row * FF + u.pn * 128 + wc * 32 + 8 * fq;
                u32x4 w;
                { const f32x4 g = acc[ai][0][m][0] * rstd + bg[0], v = acc[ai][1][m][0] * rstd + bu[0]; w.x = pk2(siluf(g[0]) * v[0], siluf(g[1]) * v[1]); w.y = pk2(siluf(g[2]) * v[2], siluf(g[3]) * v[3]); }
                { const f32x4 g = acc[ai][0][m][1] * rstd + bg[1], v = acc[ai][1][m][1] * rstd + bu[1]; w.z = pk2(siluf(g[0]) * v[0], siluf(g[1]) * v[1]); w.w = pk2(siluf(g[2]) * v[2], siluf(g[3]) * v[3]); }
                *(u32x4*)hp = w;
            }
    }
};
struct EpiRes {
    const Ctx* C; const float* gate  ; const float* gsn  ; float* rowss_next; bf16* AP;
    DI void operator()(const f32x4 (&acc)[2][2][4][2], const Unit& u, int wr, int wc, int fr_, int fq_) const {
        int tz_ = threadIdx.x; OPAQUE(tz_); const int fr = tz_ & 15, fq = (tz_ & 63) >> 4; (void)fr_; (void)fq_;
        const int s = stream_of_panel(u.pm); const int col0 = u.pn * 256 + wc * 32 + 4 * fq;
        f32x4 gv[2][2], sv[2][2];
#pragma unroll
        for (int bj = 0; bj < 2; ++bj)
#pragma unroll
            for (int n = 0; n < 2; ++n) { gv[bj][n] = *(const f32x4*)(gate + (size_t)s * D + col0 + bj * 128 + n * 16); sv[bj][n] = gsn ? *(const f32x4*)(gsn + (size_t)s * D + col0 + bj * 128 + n * 16) : (f32x4){0.f, 0.f, 0.f, 0.f}; }
        f32x4 xc[2][2], xn[2][2];
        { const float* xp0 = xrow_ptr(*C, u.pm * 256 + wr * 64 + fr) + col0;
#pragma unroll
          for (int bj = 0; bj < 2; ++bj)
#pragma unroll
              for (int n = 0; n < 2; ++n) xn[bj][n] = *(const f32x4*)(xp0 + bj * 128 + n * 16); }
#pragma unroll
        for (int ai = 0; ai < 2; ++ai)
#pragma unroll
            for (int m = 0; m < 4; ++m) {
                const int row = u.pm * 256 + ai * 128 + wr * 64 + m * 16 + fr;
                float* xp = xrow_ptr(*C, row) + col0; float ss = 0.f;
#pragma unroll
                for (int bj = 0; bj < 2; ++bj)
#pragma unroll
                    for (int n = 0; n < 2; ++n) xc[bj][n] = xn[bj][n];
                if (ai * 4 + m < 7) { const int rn = ai * 4 + m + 1; const float* xq = xrow_ptr(*C, u.pm * 256 + (rn >> 2) * 128 + wr * 64 + (rn & 3) * 16 + fr) + col0;
#pragma unroll
                    for (int bj = 0; bj < 2; ++bj)
#pragma unroll
                        for (int n = 0; n < 2; ++n) xn[bj][n] = *(const f32x4*)(xq + bj * 128 + n * 16); }
#pragma unroll
                for (int bj = 0; bj < 2; ++bj)
#pragma unroll
                    for (int n = 0; n < 2; ++n) { f32x4 x = xc[bj][n]; x += gv[bj][n] * acc[ai][bj][m][n]; *(f32x4*)(xp + bj * 128 + n * 16) = x;
                        if (gsn) { ss += (x[0] * x[0] + x[1] * x[1]) + (x[2] * x[2] + x[3] * x[3]); const f32x4 a = x * sv[bj][n]; u32x2 w; w.x = pk2(a[0], a[1]); w.y = pk2(a[2], a[3]);
                            *(u32x2*)(AP + (size_t)row * D + col0 + bj * 128 + n * 16) = w; } }
                if (gsn) { ss += __shfl_xor(ss, 16); ss += __shfl_xor(ss, 32); if (fq == 0) atomicAdd(rowss_next + row, ss); }
            }
    }
};
struct EpiAcc {
    const Ctx* C; const float* gate;
    DI void operator()(const f32x4 (&acc)[2][2][4][2], const Unit& u, int wr, int wc, int fr_, int fq_) const {
        int tz_ = threadIdx.x; OPAQUE(tz_); const int fr = tz_ & 15, fq = (tz_ & 63) >> 4; (void)fr_; (void)fq_;
        const int s = stream_of_panel(u.pm); const int col0 = u.pn * 256 + wc * 32 + 4 * fq;
#pragma unroll
        for (int bj = 0; bj < 2; ++bj)
#pragma unroll
            for (int n = 0; n < 2; ++n) { const f32x4 gv = *(const f32x4*)(gate + (size_t)s * D + col0 + bj * 128 + n * 16);
#pragma unroll
                for (int ai = 0; ai < 2; ++ai)
#pragma unroll
                    for (int m = 0; m < 4; ++m) { float* xp = xrow_ptr(*C, u.pm * 256 + ai * 128 + wr * 64 + m * 16 + fr) + col0 + bj * 128 + n * 16; const f32x4 d = gv * acc[ai][bj][m][n];
#pragma unroll
                        for (int j = 0; j < 4; ++j) atomicAdd(xp + j, d[j]); } }
    }
};
struct EpiIn {
    const Ctx* C; const float* rowss; const float* bias  ; int l;
    DI void operator()(const f32x4 (&acc)[2][2][4][2], const Unit& u, int wr, int wc, int fr_, int fq_) const {
        int tz_ = threadIdx.x; OPAQUE(tz_); const int fr = tz_ & 15, fq = (tz_ & 63) >> 4; (void)fr_; (void)fq_;
        const int s = stream_of_panel(u.pm), pn = u.pn; const float* bs = bias + (size_t)s * NINP + pn * 256 + wc * 32 + 4 * fq;
        unsigned char* ws = C->ws;
        f32x4 bv[2][2];
#pragma unroll
        for (int bj = 0; bj < 2; ++bj)
#pragma unroll
            for (int n = 0; n < 2; ++n) bv[bj][n] = *(const f32x4*)(bs + bj * 128 + n * 16);
        float rsv[2][4];
#pragma unroll
        for (int ai = 0; ai < 2; ++ai)
#pragma unroll
            for (int m = 0; m < 4; ++m) rsv[ai][m] = rowss[u.pm * 256 + ai * 128 + wr * 64 + m * 16 + fr];
        const bool permuted = pn < PN_AV || (pn >= PN_CQ && pn < PN_DU);
        if (permuted) {
            const bool is_ckv = pn == PN_CKV, is_c = pn >= PN_CQ, is_q = pn < PN_AK || (pn >= PN_CQ && pn < PN_CKV);
            const bool plain_v = is_ckv && wc >= 2;
            const float* gsrc = C->in[is_c ? (is_q ? I_WAQG : I_WAKG) : (is_q ? I_NAQG : I_NAKG)] + (size_t)l * 64;
            f32x4 gn[2][2];
#pragma unroll
            for (int bj = 0; bj < 2; ++bj)
#pragma unroll
                for (int n = 0; n < 2; ++n) { gn[bj][n] = *(const f32x4*)(gsrc + 32 * bj + 16 * n + 4 * fq); if (is_q) gn[bj][n] *= 0.125f; }
            bf16* dst; int pitch, hcol;
            if (pn < PN_AK) { dst = (bf16*)(ws + WS_QA); pitch = GW; hcol = ((pn - PN_AQ) * 4 + wc) * 64; }
            else if (pn < PN_AV) { dst = (bf16*)(ws + WS_KA) + (size_t)((pn - PN_AK) * 4 + wc) * M * 64; pitch = 64; hcol = 0; }
            else if (pn < PN_CKV) { dst = (bf16*)(ws + WS_QC); pitch = GW; hcol = ((pn - PN_CQ) * 4 + wc) * 64; }
            else if (wc < 2) { dst = (bf16*)(ws + WS_KC) + (size_t)wc * M * 64; pitch = 64; hcol = 0; }
            else { dst = (bf16*)(ws + WS_VC) + (size_t)(wc - 2) * M * 64; pitch = 64; hcol = 0; }
            const f32x4* rope = (const f32x4*)(ws + WS_ROPE);
#pragma unroll
            for (int ai = 0; ai < 2; ++ai)
#pragma unroll
                for (int m = 0; m < 4; ++m) {
                    const int row = pn * 0 + u.pm * 256 + ai * 128 + wr * 64 + m * 16 + fr;
                    const float rstd = __builtin_amdgcn_rsqf(rsv[ai][m] * (1.0f / D) + NORM_EPS);
                    f32x4 v[2][2]; float ss = 0.f;
#pragma unroll
                    for (int bj = 0; bj < 2; ++bj)
#pragma unroll
                        for (int n = 0; n < 2; ++n) { v[bj][n] = acc[ai][bj][m][n] * rstd + bv[bj][n]; ss += (v[bj][n][0] * v[bj][n][0] + v[bj][n][1] * v[bj][n][1]) + (v[bj][n][2] * v[bj][n][2] + v[bj][n][3] * v[bj][n][3]); }
                    ss += __shfl_xor(ss, 16); ss += __shfl_xor(ss, 32);
                    if (!plain_v) { const float rs = 1.0f / sqrtf(ss * (1.0f / 64.0f) + NORM_EPS);
#pragma unroll
                        for (int bj = 0; bj < 2; ++bj)
#pragma unroll
                            for (int n = 0; n < 2; ++n) v[bj][n] = v[bj][n] * rs * gn[bj][n];
                        if (is_c && row < M_LAT) {
                            const int t = row % T; const int pos[2] = {t / GRW, t % GRW};
#pragma unroll
                            for (int bj = 0; bj < 2; ++bj) { const f32x4 cs0 = rope[(pos[bj] * 16 + 4 * fq) / 2], cs1 = rope[(pos[bj] * 16 + 4 * fq) / 2 + 1];
                                const float cc[4] = {cs0[0], cs0[2], cs1[0], cs1[2]}, sn[4] = {cs0[1], cs0[3], cs1[1], cs1[3]};
#pragma unroll
                                for (int j = 0; j < 4; ++j) { const float x1 = v[bj][0][j], x2 = v[bj][1][j]; v[bj][0][j] = x1 * cc[j] - x2 * sn[j]; v[bj][1][j] = x2 * cc[j] + x1 * sn[j]; } }
                        }
                    }
                    bf16* op = dst + (size_t)row * pitch + hcol + 4 * fq;
#pragma unroll
                    for (int bj = 0; bj < 2; ++bj)
#pragma unroll
                        for (int n = 0; n < 2; ++n) { u32x2 w; w.x = pk2(v[bj][n][0], v[bj][n][1]); w.y = pk2(v[bj][n][2], v[bj][n][3]); *(u32x2*)(op + 32 * bj + 16 * n) = w; }
                }
        } else {
#pragma unroll
            for (int ai = 0; ai < 2; ++ai)
#pragma unroll
                for (int m = 0; m < 4; ++m) {
                    const int row = u.pm * 256 + ai * 128 + wr * 64 + m * 16 + fr;
                    const float rstd = __builtin_amdgcn_rsqf(rsv[ai][m] * (1.0f / D) + NORM_EPS);
#pragma unroll
                    for (int bj = 0; bj < 2; ++bj)
#pragma unroll
                        for (int n = 0; n < 2; ++n) { const f32x4 v = acc[ai][bj][m][n] * rstd + bv[bj][n]; const int c = bj * 128 + wc * 32 + n * 16 + 4 * fq;
                            u32x2 w; w.x = pk2(v[0], v[1]); w.y = pk2(v[2], v[3]);
                            if (pn < PN_BR) *(u32x2*)((bf16*)(ws + WS_VA) + ((size_t)((pn - PN_AV) * 4 + bj * 2 + (wc >> 1)) * M + row) * 64 + (wc & 1) * 32 + n * 16 + 4 * fq) = w;
                            else if (pn < PN_BS) *(u32x2*)((bf16*)(ws + WS_PB) + (size_t)row * 3 * GW + (pn - PN_BR) * 256 + c) = w;
                            else if (pn == PN_BS) { if (c < 160) *(f32x4*)((float*)(ws + WS_PS) + (size_t)row * 160 + c) = v; }
                            else { const int cu = (pn - PN_DU) * 256 + c, gq = cu >> 4, p0 = cu & 15;
                                *(u32x2*)((bf16*)(ws + WS_UG) + ((size_t)gq * NCHP + row / S5L) * S5K + (row % S5L) * 16 + p0) = w; } }
                }
        }
    }
};
struct EpiS5A {
    float* XE;
    DI void operator()(const f32x4 (&acc)[2][2][4][2], const Unit& u, int wr, int wc, int fr_, int fq_) const {
        int tz_ = threadIdx.x; OPAQUE(tz_); const int fr = tz_ & 15, fq = (tz_ & 63) >> 4; (void)fr_; (void)fq_;
#pragma unroll
        for (int ai = 0; ai < 2; ++ai)
#pragma unroll
            for (int m = 0; m < 4; ++m) { const int ch = u.pm * 256 + ai * 128 + wr * 64 + m * 16 + fr; if (ch < NCH) { float* p = XE + ((size_t)u.z * NCHP + ch) * 256 + wc * 32 + 4 * fq;
#pragma unroll
                for (int bj = 0; bj < 2; ++bj)
#pragma unroll
                    for (int n = 0; n < 2; ++n) *(f32x4*)(p + bj * 128 + n * 16) = acc[ai][bj][m][n]; } }
    }
};
struct EpiS5C {
    const bf16* UG; const float* dsk  ; bf16* YG;
    DI void operator()(const f32x4 (&acc)[2][2][4][2], const Unit& u, int wr, int wc, int fr_, int fq_) const {
        int tz_ = threadIdx.x; OPAQUE(tz_); const int fr = tz_ & 15, fq = (tz_ & 63) >> 4; (void)fr_; (void)fq_;
        const int g = u.z;
#pragma unroll
        for (int ai = 0; ai < 2; ++ai)
#pragma unroll
            for (int m = 0; m < 4; ++m) { const int ch = u.pm * 256 + ai * 128 + wr * 64 + m * 16 + fr; if (ch < NCH) {
#pragma unroll
                for (int bj = 0; bj < 2; ++bj)
#pragma unroll
                    for (int n = 0; n < 2; ++n) { const int col = u.pn * 256 + bj * 128 + wc * 32 + n * 16 + 4 * fq, i = col >> 4, p0 = col & 15;
                        const u32x2 uw = *(const u32x2*)(UG + ((size_t)g * NCHP + ch) * S5K + col); const f32x4 dv = *(const f32x4*)(dsk + 16 * g + p0);
                        const f32x4 a = acc[ai][bj][m][n]; const float y0 = a[0] + dv[0] * bflo(uw.x), y1 = a[1] + dv[1] * bfhi(uw.x), y2 = a[2] + dv[2] * bflo(uw.y), y3 = a[3] + dv[3] * bfhi(uw.y);
                        u32x2 w; w.x = pk2(geluf(y0), geluf(y1)); w.y = pk2(geluf(y2), geluf(y3));
                        *(u32x2*)(YG + (size_t)(ch * S5L + i) * GW + 16 * g + p0) = w; } } }
    }
};
struct EpiGLU {
    const bf16* YG; const float* gb; bf16* OB;
    DI void operator()(const f32x4 (&acc)[2][2][4][2], const Unit& u, int wr, int wc, int fr_, int fq_) const {
        int tz_ = threadIdx.x; OPAQUE(tz_); const int fr = tz_ & 15, fq = (tz_ & 63) >> 4; (void)fr_; (void)fq_;
#pragma unroll
        for (int ai = 0; ai < 2; ++ai)
#pragma unroll
            for (int m = 0; m < 4; ++m) { const int row = u.pm * 256 + ai * 128 + wr * 64 + m * 16 + fr;
#pragma unroll
                for (int bj = 0; bj < 2; ++bj)
#pragma unroll
                    for (int n = 0; n < 2; ++n) { const int col = u.pn * 256 + bj * 128 + wc * 32 + n * 16 + 4 * fq; const f32x4 b = *(const f32x4*)(gb + col); const f32x4 a = acc[ai][bj][m][n] + b;
                        const u32x2 yw = *(const u32x2*)(YG + (size_t)row * GW + col);
                        u32x2 w; w.x = pk2(bflo(yw.x) * sigmf(a[0]), bfhi(yw.x) * sigmf(a[1])); w.y = pk2(bflo(yw.y) * sigmf(a[2]), bfhi(yw.y) * sigmf(a[3]));
                        *(u32x2*)(OB + (size_t)row * D + 3 * GW + col) = w; } }
    }
};

DI void ph_ada(const Ctx& C) {
    LAS float* sc = (LAS float*)C.lds;
    LAS float* red = sc + 3 * D;
    for (int i = C.tid; i < 3 * D; i += NTHR) { const int s = i / D, k = i % D; const float c = s < NB ? C.in[I_C][s * D + k] : C.in[I_CCTX][k]; sc[i] = siluf(c); }
    __syncthreads();
    const int nun = NL * (9 * D / 256);
    for (int un = C.bid; un < nun; un += C.G) {
        const int l = un / (9 * D / 256), col0 = (un % (9 * D / 256)) * 256;
        const float* W = C.in[I_WADA] + (size_t)l * D * 9 * D + col0 + 4 * C.lane;
        f32x4 a0 = {0.f, 0.f, 0.f, 0.f}, a1 = a0, a2 = a0;
        const int k0 = C.wave * (D / 8);
#pragma unroll 1
        for (int kb = k0; kb < k0 + D / 8; kb += 16) {
            f32x4 wv[16];
#pragma unroll
            for (int u = 0; u < 16; ++u) wv[u] = *(const f32x4*)(W + (size_t)(kb + u) * 9 * D);
#pragma unroll
            for (int u = 0; u < 16; ++u) { a0 += wv[u] * sc[kb + u]; a1 += wv[u] * sc[D + kb + u]; a2 += wv[u] * sc[2 * D + kb + u]; } }
        LAS float* r = red + C.wave * 768 + 4 * C.lane;
        *(LAS f32x4*)(r) = a0; *(LAS f32x4*)(r + 256) = a1; *(LAS f32x4*)(r + 512) = a2;
        __syncthreads();
        for (int i = C.tid; i < 768; i += NTHR) { float s = 0.f;
#pragma unroll
            for (int w = 0; w < 8; ++w) s += red[w * 768 + i];
            const int st = i / 256, c = col0 + (i % 256);
            ((float*)(C.ws + WS_MODV))[((size_t)l * 3 + st) * 9 * D + c] = s + C.in[I_BADA][(size_t)l * 9 * D + c]; }
        __syncthreads();
    }
}
DI const float* modv_ptr(const Ctx& C, int l, int s, int chunk) { return (const float*)(C.ws + WS_MODV) + ((size_t)l * 3 + s) * 9 * D + (size_t)chunk * D; }

DI int win_dest(int n) {
    if (n >= D_IN) return -1;
    if (n < SRC_AV) { const int piece = n / GW, loc = n % GW, head = loc / 64, d = loc % 64; return ((piece == 0 ? PN_AQ : PN_AK) + head / 4) * 256 + 128 * (d / 32) + 32 * (head % 4) + (d % 32); }
    if (n < SRC_BS) return PN_AV * 256 + (n - SRC_AV);
    if (n < SRC_CQ) return PN_BS * 256 + (n - SRC_BS);
    if (n < SRC_CK) { const int loc = n - SRC_CQ, head = loc / 64, d = loc % 64; return (PN_CQ + head / 4) * 256 + 128 * (d / 32) + 32 * (head % 4) + (d % 32); }
    if (n < SRC_DU) { const int loc = n - SRC_CK, hh = loc / 64, d = loc % 64; return PN_CKV * 256 + 128 * (d / 32) + 32 * hh + (d % 32); }
    return PN_DU * 256 + (n - SRC_DU);
}
DI int gu_dest(int n) { const int e = n & 31; return (n / 128) * 256 + (n % 128 - e) + 16 * ((e >> 2) & 1) + 4 * (e >> 3) + (e & 3); }
DI void conv_item(const Ctx& C, const float* W, int K, int N, bf16* Wt, int mode, int k0, int n0, float* bias, int bias_pitch, const float* shift  ) {
    LAS float* scr = (LAS float*)(C.lds + C.wave * 16640);
    const int n = n0 + C.lane; const bool ok = n < N; float b0 = 0.f, b1 = 0.f, b2 = 0.f;
#pragma unroll 1
    for (int kh = 0; kh < 4; ++kh) {
        float wv[16];
#pragma unroll
        for (int kk = 0; kk < 16; ++kk) wv[kk] = ok ? W[(size_t)(k0 + 16 * kh + kk) * N + n] : 0.f;
#pragma unroll
        for (int kk = 0; kk < 16; ++kk) { const float v = wv[kk]; scr[(16 * kh + kk) * 65 + C.lane] = v;
            if (bias) { b0 += shift[k0 + 16 * kh + kk] * v; b1 += shift[9 * D + k0 + 16 * kh + kk] * v; b2 += shift[18 * D + k0 + 16 * kh + kk] * v; } } }
    WSYNC();
    const int dme = !ok ? -1 : mode == 0 ? n : mode == 1 ? gu_dest(n) : mode == 2 ? gu_dest(n) + 128 : win_dest(n);
    if (bias && dme >= 0) { atomicAdd(bias + dme, b0); atomicAdd(bias + bias_pitch + dme, b1); atomicAdd(bias + 2 * bias_pitch + dme, b2); }
    const int c = C.lane & 7;
#pragma unroll
    for (int i = 0; i < 8; ++i) { const int nl = (C.lane >> 3) + 8 * i, nn = n0 + nl;
        const int dr = nn >= N ? -1 : mode == 0 ? nn : mode == 1 ? gu_dest(nn) : mode == 2 ? gu_dest(nn) + 128 : win_dest(nn);
        const LAS float* s = scr + (8 * c) * 65 + nl;
        u32x4 o; o.x = pk2(s[0], s[65]); o.y = pk2(s[2 * 65], s[3 * 65]); o.z = pk2(s[4 * 65], s[5 * 65]); o.w = pk2(s[6 * 65], s[7 * 65]);
        if (dr >= 0) *(u32x4*)(Wt + (size_t)dr * K + k0 + 8 * c) = o; }
    WSYNC();
}
struct Cplx { float re, im; };
DI Cplx cmul(Cplx a, Cplx b) { return Cplx{a.re * b.re - a.im * b.im, a.re * b.im + a.im * b.re}; }
DI Cplx s5_lam_pow(const Ctx& C, int l, int dir, int g, int n, float tau) {
    const size_t i = (((size_t)l * 2 + dir) * S5G + g) * 64 + n; const float dt = __expf(C.in[I_S5LDT][((size_t)l * 2 + dir) * S5G + g]);
    const float mag = __expf(tau * dt * C.in[I_S5ARE][i]), ang = tau * dt * C.in[I_S5AIM][i]; float sn, cs; sincosf(ang, &sn, &cs); return Cplx{mag * cs, mag * sn};
}
DI Cplx s5_coef(const Ctx& C, int l, int dir, int g, int n) {
    const size_t i = (((size_t)l * 2 + dir) * S5G + g) * 64 + n; const float are = C.in[I_S5ARE][i], aim = C.in[I_S5AIM][i];
    const Cplx ab = s5_lam_pow(C, l, dir, g, n, 1.0f); const float den = are * are + aim * aim, nr = ab.re - 1.0f;
    return Cplx{(nr * are + ab.im * aim) / den, (ab.im * are - nr * aim) / den};
}
DI Cplx s5_beta(const Ctx& C, int l, int dir, int g, int n, int q) {
    const size_t i = (((size_t)l * S5G + g) * 64 + n) * 16 + q; return cmul(s5_coef(C, l, dir, g, n), Cplx{C.in[I_S5BRE][i], C.in[I_S5BIM][i]});
}
DI Cplx s5_gamma(const Ctx& C, int l, int g, int p, int n) { const size_t i = (((size_t)l * S5G + g) * 16 + p) * 64 + n; return Cplx{C.in[I_S5CRE][i], C.in[I_S5CIM][i]}; }

#ifndef CONV_G1_PCT
#define CONV_G1_PCT 55
#endif
constexpr int CI_GU = (D / 64) * (FF / 64), CI_DN = (FF / 64) * (D / 64), CI_IN = (D / 64) * ((D_IN + 63) / 64), CI_OUT = (D / 64) * (D / 64), CI_GLU = (GW / 64) * (GW / 64);
constexpr int CI_LAYER = 4 * CI_GU + 2 * CI_DN + CI_IN + CI_OUT + CI_GLU, CI_X1 = (int)((long)CI_LAYER * CONV_G1_PCT / 100) & ~7;
DI void conv_weights(const Ctx& C, int l, int wslot, int nslots, int it_lo, int it_hi) {
    for (int it = it_lo + wslot; it < it_hi; it += nslots) {
        int r = it;
        unsigned char* wbase = C.ws + WS_W + (size_t)l * SZ_WL;
        if (r < 2 * CI_GU) { const int up = r >= CI_GU; r -= up * CI_GU; const int kb = r / (FF / 64), nb = r % (FF / 64);
            conv_item(C, C.in[up ? I_F1WU : I_F1WG] + (size_t)l * D * FF, D, FF, (bf16*)(wbase + OFF_W1GU), 1 + up, kb * 64, nb * 64, bias_ptr(C, l, 0), 2 * FF, modv_ptr(C, l, 0, 0)); continue; } r -= 2 * CI_GU;
        if (r < CI_DN) { const int kb = r / (D / 64), nb = r % (D / 64); conv_item(C, C.in[I_F1WD] + (size_t)l * FF * D, FF, D, (bf16*)(wbase + OFF_W1D), 0, kb * 64, nb * 64, nullptr, 0, nullptr); continue; } r -= CI_DN;
        if (r < CI_IN) { const int nbn = (D_IN + 63) / 64, kb = r / nbn, nb = r % nbn; conv_item(C, C.in[I_WIN] + (size_t)l * D * D_IN, D, D_IN, (bf16*)(wbase + OFF_WIN), 3, kb * 64, nb * 64, bias_ptr(C, l, 1), NINP, modv_ptr(C, l, 0, 3)); continue; } r -= CI_IN;
        if (r < CI_OUT) { const int kb = r / (D / 64), nb = r % (D / 64); conv_item(C, C.in[I_WOUT] + (size_t)l * D * D, D, D, (bf16*)(wbase + OFF_WOUT), 0, kb * 64, nb * 64, nullptr, 0, nullptr); continue; } r -= CI_OUT;
        if (r < 2 * CI_GU) { const int up = r >= CI_GU; r -= up * CI_GU; const int kb = r / (FF / 64), nb = r % (FF / 64);
            conv_item(C, C.in[up ? I_F2WU : I_F2WG] + (size_t)l * D * FF, D, FF, (bf16*)(wbase + OFF_W2GU), 1 + up, kb * 64, nb * 64, bias_ptr(C, l, 2), 2 * FF, modv_ptr(C, l, 0, 6)); continue; } r -= 2 * CI_GU;
        if (r < CI_DN) { const int kb = r / (D / 64), nb = r % (D / 64); conv_item(C, C.in[I_F2WD] + (size_t)l * FF * D, FF, D, (bf16*)(wbase + OFF_W2D), 0, kb * 64, nb * 64, nullptr, 0, nullptr); continue; } r -= CI_DN;
        { const int kb = r / (GW / 64), nb = r % (GW / 64); conv_item(C, C.in[I_S5GLUW] + (size_t)l * GW * GW, GW, GW, (bf16*)(wbase + OFF_WGLU), 0, kb * 64, nb * 64, nullptr, 0, nullptr); }
    }
}
DI void ph_conv(const Ctx& C) {
    const int gt = C.bid * NTHR + C.tid, GT = C.G * NTHR;
    for (int i = gt; i < NL * 9 * D; i += GT) { const int k = i % D, s = (i / D) % 3, sub = (i / (3 * D)) % 3, l = i / (9 * D);
        const float* mv = (const float*)(C.ws + WS_MODV) + ((size_t)l * 3 + s) * 9 * D;
        ((float*)(C.ws + WS_GS))[i] = C.in[I_NORMG][((size_t)l * 3 + sub) * D + k] * (1.0f + mv[(3 * sub + 1) * D + k]);
        ((float*)(C.ws + WS_GATE))[i] = mv[(3 * sub + 2) * D + k] * (sub == 1 ? 1.0f : 0.5f); }
    for (int i = gt; i < 128 * 16; i += GT) { const int pos = i / 16, f = i % 16; const float inv = __expf(-(float)f * (9.210340371976184f / 16.0f)); float sn, cs; sincosf((float)pos * inv, &sn, &cs);
        ((f32x2*)(C.ws + WS_ROPE))[i] = (f32x2){cs, sn}; }
    const int gw = C.bid * NW + C.wave, GWV = C.G * NW;
    conv_weights(C, 0, gw, GWV, 0, CI_LAYER);
    for (int i = gt; i < NL * 14 * NH * 2 * 64 * 8; i += GT) {
        const int j = i & 7, ln = (i >> 3) & 63, tj = (i >> 9) & 1, hd = (i >> 10) % NH, f = (i / (1024 * NH)) % 14, l = i / (1024 * NH * 14);
        const int col = hd * 64 + 32 * tj + (ln & 31); float v;
        if (f < 8) { const int d = (f >> 1) & 1, sx = f & 1, k = 16 * sx + 8 * (ln >> 5) + j; v = C.in[f < 4 ? I_RWWUP : I_RWAUP][(((size_t)l * 2 + d) * 32 + k) * GW + col]; }
        else { const int k = 16 * (f - 8) + 8 * (ln >> 5) + j; v = C.in[I_RWGUP][((size_t)l * 96 + k) * GW + col]; }
        ((bf16*)(C.ws + WS_RWF))[i] = (bf16)f2bf(v); }
    LAS float* wsc = (LAS float*)(C.lds + C.wave * 16640);
    for (int it = gw; it < NL * S5G * 2 * S5L; it += GWV) {
        const int tau = it % S5L, dir = (it / S5L) % 2, g = (it / (2 * S5L)) % S5G, l = it / (2 * S5L * S5G);
        const Cplx z = cmul(s5_lam_pow(C, l, dir, g, C.lane, (float)tau), s5_coef(C, l, dir, g, C.lane));
#pragma unroll 4
        for (int q = 0; q < 16; ++q) { const size_t i = (((size_t)l * S5G + g) * 64 + C.lane) * 16 + q; const Cplx w = cmul(z, Cplx{C.in[I_S5BRE][i], C.in[I_S5BIM][i]}); wsc[(C.lane * 16 + q) * 2] = w.re; wsc[(C.lane * 16 + q) * 2 + 1] = w.im; }
        WSYNC();
        float* kc = (float*)(C.ws + WS_S5T + (size_t)l * SZ_S5L + OFF_S5KC) + (((size_t)g * 2 + dir) * S5L + tau) * 256;
#pragma unroll 1
        for (int e = 0; e < 4; ++e) { const int pq = C.lane + 64 * e, p = pq >> 4, q = pq & 15; float s = 0.f;
#pragma unroll 4
            for (int n = 0; n < 64; ++n) { const Cplx gm = s5_gamma(C, l, g, p, n); s += gm.re * wsc[(n * 16 + q) * 2] - gm.im * wsc[(n * 16 + q) * 2 + 1]; }
            kc[pq] = s; }
        WSYNC();
    }
    for (int i = gt; i < NL * 2 * GW * 4 * (S5L + 1); i += GT) { const int tau = i % (S5L + 1), r = i / (S5L + 1), n = r % 64, g = (r / 64) % S5G, dir = (r / (64 * S5G)) % 2, l = r / (2 * 64 * S5G);
        const Cplx z = s5_lam_pow(C, l, dir, g, n, (float)tau); ((f32x2*)(C.ws + WS_S5T + (size_t)l * SZ_S5L + OFF_S5LP))[((size_t)(dir * S5G + g) * 64 + n) * (S5L + 1) + tau] = (f32x2){z.re, z.im}; }
    for (int i = gt; i < NL * 2 * GW * 4 * 16; i += GT) { const int q = i % 16, r = i / 16, n = r % 64, g = (r / 64) % S5G, dir = (r / (64 * S5G)) % 2, l = r / (2 * 64 * S5G);
        const Cplx z = s5_beta(C, l, dir, g, n, q); ((f32x2*)(C.ws + WS_S5T + (size_t)l * SZ_S5L + OFF_S5BETA))[((size_t)(dir * S5G + g) * 64 + n) * 16 + q] = (f32x2){z.re, z.im}; }
    for (int i = gt; i < NL * 2 * GW * 4; i += GT) { const int n = i % 64, g = (i / 64) % S5G, dir = (i / (64 * S5G)) % 2, l = i / (2 * 64 * S5G); const Cplx z = s5_lam_pow(C, l, dir, g, n, (float)S5L);
        ((f32x2*)(C.ws + WS_S5T + (size_t)l * SZ_S5L + OFF_S5LAM))[(dir * S5G + g) * 64 + n] = (f32x2){z.re, z.im}; }
}
DI void ph_tab(const Ctx& C) {
    const long gt = (long)C.bid * NTHR + C.tid, GT = (long)C.G * NTHR;
    for (long i = gt; i < (long)NL * S5G * 256 * 512; i += GT) {
        const int k = (int)(i % 512), np = (int)((i / 512) % 256), g = (int)((i / (512 * 256)) % S5G), l = (int)(i / ((long)512 * 256 * S5G));
        const int j = k >> 4, q = k & 15, dir = np >> 7, n = np & 63, im = (np >> 6) & 1;
        const f32x2 lp = ((const f32x2*)(C.ws + WS_S5T + (size_t)l * SZ_S5L + OFF_S5LP))[((size_t)(dir * S5G + g) * 64 + n) * (S5L + 1) + (dir == 0 ? S5L - 1 - j : j)];
        const f32x2 be = ((const f32x2*)(C.ws + WS_S5T + (size_t)l * SZ_S5L + OFF_S5BETA))[((size_t)(dir * S5G + g) * 64 + n) * 16 + q];
        const Cplx w = cmul(Cplx{lp[0], lp[1]}, Cplx{be[0], be[1]});
        ((bf16*)(C.ws + WS_S5T + (size_t)l * SZ_S5L + OFF_S5ET))[((size_t)g * 256 + np) * 512 + k] = (bf16)f2bf(im ? w.im : w.re); }
    for (long i = gt; i < (long)NL * S5G * 512 * S5K; i += GT) {
        const int k = (int)(i % S5K), nn = (int)((i / S5K) % 512), g = (int)((i / ((long)S5K * 512)) % S5G), l = (int)(i / ((long)S5K * 512 * S5G));
        const int ti = nn >> 4, p = nn & 15; float v;
        if (k < 512) { const int j = k >> 4, q = k & 15; const float* kc = (const float*)(C.ws + WS_S5T + (size_t)l * SZ_S5L + OFF_S5KC) + (size_t)g * 2 * S5L * 256;
            v = 0.f; if (j <= ti) v += kc[((ti - j)) * 256 + p * 16 + q]; if (j >= ti) v += kc[(S5L + (j - ti)) * 256 + p * 16 + q]; }
        else { const int kk = k - 512, dir = kk >> 7, im = (kk >> 6) & 1, n = kk & 63;
            const f32x2 lp = ((const f32x2*)(C.ws + WS_S5T + (size_t)l * SZ_S5L + OFF_S5LP))[((size_t)(dir * S5G + g) * 64 + n) * (S5L + 1) + (dir == 0 ? ti + 1 : S5L - ti)];
            const Cplx w = cmul(s5_gamma(C, l, g, p, n), Cplx{lp[0], lp[1]}); v = im ? -w.im : w.re; }
        ((bf16*)(C.ws + WS_S5T + (size_t)l * SZ_S5L + OFF_S5BT))[((size_t)g * 512 + nn) * S5K + k] = (bf16)f2bf(v); }
    const int gw = C.bid * NW + C.wave, GWV = C.G * NW;
    for (int row = gw; row < M; row += GWV) {
        const float* src = row < M_LAT ? C.in[I_X] + (size_t)row * D : C.in[I_CTX] + (size_t)(row - M_LAT) * D;
        float* dst = xrow_ptr(C, row); const float* gs = gs_ptr(C, 0, 0, stream_of_row(row)); bf16* ap = (bf16*)(C.ws + WS_AP) + (size_t)row * D; float ss = 0.f;
        f32x4 xv[D / 256], gv[D / 256];
#pragma unroll
        for (int i = 0; i < D / 256; ++i) { xv[i] = *(const f32x4*)(src + 4 * C.lane + 256 * i); gv[i] = *(const f32x4*)(gs + 4 * C.lane + 256 * i); }
#pragma unroll
        for (int i = 0; i < D / 256; ++i) { const int c = 4 * C.lane + 256 * i; const f32x4 x = xv[i]; *(f32x4*)(dst + c) = x; ss += (x[0] * x[0] + x[1] * x[1]) + (x[2] * x[2] + x[3] * x[3]);
            const f32x4 a = x * gv[i]; u32x2 w; w.x = pk2(a[0], a[1]); w.y = pk2(a[2], a[3]); *(u32x2*)(ap + c) = w; }
        ss = wave_sum(ss); if (C.lane == 0) rowss_ptr(C, 0, 0)[row] = ss;
    }
}

#ifdef EMU
DI s16x4 tr_read1(const LAS unsigned char* a) { return emu_tr_read(a); }
#else
DI s16x4 tr_read1(const LAS unsigned char* a) { s16x4 r; asm volatile("ds_read_b64_tr_b16 %0, %1\n\ts_waitcnt lgkmcnt(0)" : "=&v"(r) : "v"((unsigned)(size_t)a) : "memory"); return r; }
#endif
DI bf16x8 tr_frag(const LAS unsigned char* a0, int hi_off) {
#ifdef EMU
    const s16x4 lo = emu_tr_read(a0), hi = emu_tr_read(a0 + hi_off);
#else
    s16x4 lo, hi; asm volatile("ds_read_b64_tr_b16 %0, %2\n\tds_read_b64_tr_b16 %1, %3\n\ts_waitcnt lgkmcnt(0)" : "=&v"(lo), "=&v"(hi) : "v"((unsigned)(size_t)a0), "v"((unsigned)(size_t)(a0 + hi_off)) : "memory");
#endif
    return __builtin_shufflevector(lo, hi, 0, 1, 2, 3, 4, 5, 6, 7);
}
DI void tr_frag4(const LAS unsigned char* a0, const LAS unsigned char* a1, const LAS unsigned char* a2, const LAS unsigned char* a3, int hi_off, bf16x8 (&f)[4]) {
#ifdef EMU
    f[0] = tr_frag(a0, hi_off); f[1] = tr_frag(a1, hi_off); f[2] = tr_frag(a2, hi_off); f[3] = tr_frag(a3, hi_off);
#else
    s16x4 l0, h0, l1, h1, l2, h2, l3, h3;
    asm volatile("ds_read_b64_tr_b16 %0, %8\n\tds_read_b64_tr_b16 %1, %9\n\tds_read_b64_tr_b16 %2, %10\n\tds_read_b64_tr_b16 %3, %11\n\tds_read_b64_tr_b16 %4, %12\n\tds_read_b64_tr_b16 %5, %13\n\tds_read_b64_tr_b16 %6, %14\n\tds_read_b64_tr_b16 %7, %15\n\ts_waitcnt lgkmcnt(0)"
        : "=&v"(l0), "=&v"(h0), "=&v"(l1), "=&v"(h1), "=&v"(l2), "=&v"(h2), "=&v"(l3), "=&v"(h3)
        : "v"((unsigned)(size_t)a0), "v"((unsigned)(size_t)(a0 + hi_off)), "v"((unsigned)(size_t)a1), "v"((unsigned)(size_t)(a1 + hi_off)), "v"((unsigned)(size_t)a2), "v"((unsigned)(size_t)(a2 + hi_off)), "v"((unsigned)(size_t)a3), "v"((unsigned)(size_t)(a3 + hi_off)) : "memory");
    f[0] = __builtin_shufflevector(l0, h0, 0, 1, 2, 3, 4, 5, 6, 7); f[1] = __builtin_shufflevector(l1, h1, 0, 1, 2, 3, 4, 5, 6, 7); f[2] = __builtin_shufflevector(l2, h2, 0, 1, 2, 3, 4, 5, 6, 7); f[3] = __builtin_shufflevector(l3, h3, 0, 1, 2, 3, 4, 5, 6, 7);
#endif
}
DI bf16x8 pack8(const f32x16& x, int s) {
    u32x4 p; p.x = pk2(x[8 * s], x[8 * s + 1]); p.y = pk2(x[8 * s + 2], x[8 * s + 3]); p.z = pk2(x[8 * s + 4], x[8 * s + 5]); p.w = pk2(x[8 * s + 6], x[8 * s + 7]);
    return __builtin_bit_cast(bf16x8, p);
}
struct AttnSt { f32x16 o0, o1; float m, l; };
constexpr int APT = 144;
struct KVregs { u32x4 k[4]; u32x4 v[4]; };
struct Kregs { bf16x8 k[4]; };
DI void k_load(Kregs& r, const bf16* Kb, int kp, int lane) {
    const int r32 = lane & 31, h = lane >> 5;
#pragma unroll
    for (int kk = 0; kk < 4; ++kk) r.k[kk] = *(const bf16x8*)(Kb + (size_t)r32 * kp + 16 * kk + 8 * h);
}
DI void kv_load2(KVregs& r, const bf16* Kb, int kp, const bf16* Vb, int vp, int lane) {
#pragma unroll
    for (int i = 0; i < 4; ++i) { const int idx = lane + 64 * i, key = idx >> 3, ch = idx & 7; r.k[i] = *(const u32x4*)(Kb + (size_t)key * kp + ch * 8); }
#pragma unroll
    for (int i = 0; i < 4; ++i) { const int idx = lane + 64 * i, key = idx >> 3, ch = idx & 7; r.v[i] = *(const u32x4*)(Vb + (size_t)key * vp + ch * 8); }
}
#if 0
DI void kv_load(KVregs& r, const Kregs& kpre, const bf16* Vb, int vp, int lane) {
#pragma unroll
    for (int kk = 0; kk < 4; ++kk) r.k[kk] = kpre.k[kk];
#pragma unroll
    for (int i = 0; i < 4; ++i) { const int idx = lane + 64 * i, key = idx >> 3, ch = idx & 7; r.v[i] = *(const u32x4*)(Vb + (size_t)key * vp + ch * 8); }
}
#endif
DI void attn_stage(const KVregs& kv, LAS unsigned char* vl, int lane) {
    LAS unsigned char* vk = vl; LAS unsigned char* vv = vl + 32 * APT;
#pragma unroll
    for (int i = 0; i < 4; ++i) { const int idx = lane + 64 * i, key = idx >> 3, ch = idx & 7; *(LAS u32x4*)(vk + key * APT + ch * 16) = kv.k[i]; *(LAS u32x4*)(vv + key * APT + ch * 16) = kv.v[i]; }
}
template <bool MASKED>
DI void attn_block(AttnSt& st, const bf16x8 (&qf)[4], LAS unsigned char* vl, int lane, const float (&addv)[16], unsigned vmask) {
    const int h = lane >> 5;
    LAS unsigned char* vk = vl; LAS unsigned char* vv = vl + 32 * APT;
    WSYNC();
    bf16x8 kf[4];
#pragma unroll
    for (int kk = 0; kk < 4; ++kk) kf[kk] = *(const LAS bf16x8*)(vk + (lane & 31) * APT + (16 * kk + 8 * h) * 2);
    f32x16 s;
#pragma unroll
    for (int i = 0; i < 16; ++i) s[i] = 0.f;
#pragma unroll
    for (int kk = 0; kk < 4; ++kk) s = __builtin_amdgcn_mfma_f32_32x32x16_bf16(kf[kk], qf[kk], s, 0, 0, 0);
    float bm = -1e30f;
#pragma unroll
    for (int i = 0; i < 16; ++i) { if (MASKED) { s[i] += addv[i]; if ((vmask >> i) & 1u) bm = fmaxf(bm, s[i]); } else bm = fmaxf(bm, s[i]); }
    bm = fmaxf(bm, __shfl_xor(bm, 32));
    const float mn = fmaxf(st.m, bm), alpha = __expf(st.m - mn); st.m = mn;
    float ls = 0.f;
#pragma unroll
    for (int i = 0; i < 16; ++i) { float p = __expf(s[i] - mn); if (MASKED) p = ((vmask >> i) & 1u) ? p : 0.f; s[i] = p; ls += p; }
    st.l = st.l * alpha + ls;
#pragma unroll
    for (int i = 0; i < 16; ++i) { st.o0[i] *= alpha; st.o1[i] *= alpha; }
    const int q = (lane & 15) >> 2, p4 = lane & 3, blk = (lane >> 4) & 1;
    { const LAS unsigned char* ab = vv + (4 * h + q) * APT + (16 * blk) * 2 + 8 * p4; bf16x8 vf[4];
      tr_frag4(ab, ab + 64, ab + 16 * APT, ab + 16 * APT + 64, 8 * APT, vf);
      const bf16x8 pf0 = pack8(s, 0), pf1 = pack8(s, 1);
      st.o0 = __builtin_amdgcn_mfma_f32_32x32x16_bf16(vf[0], pf0, st.o0, 0, 0, 0); st.o1 = __builtin_amdgcn_mfma_f32_32x32x16_bf16(vf[1], pf0, st.o1, 0, 0, 0);
      st.o0 = __builtin_amdgcn_mfma_f32_32x32x16_bf16(vf[2], pf1, st.o0, 0, 0, 0); st.o1 = __builtin_amdgcn_mfma_f32_32x32x16_bf16(vf[3], pf1, st.o1, 0, 0, 0); }
}
DI void attn_finish(AttnSt& st, bf16* orow  , int lane, float extra_l) {
    const int h = lane >> 5; float l = st.l + __shfl_xor(st.l, 32) + extra_l; const float inv = 1.0f / l;
#pragma unroll
    for (int g = 0; g < 4; ++g) {
        u32x2 w0, w1; w0.x = pk2(st.o0[4 * g] * inv, st.o0[4 * g + 1] * inv); w0.y = pk2(st.o0[4 * g + 2] * inv, st.o0[4 * g + 3] * inv);
        w1.x = pk2(st.o1[4 * g] * inv, st.o1[4 * g + 1] * inv); w1.y = pk2(st.o1[4 * g + 2] * inv, st.o1[4 * g + 3] * inv);
        *(u32x2*)(orow + 8 * g + 4 * h) = w0; *(u32x2*)(orow + 32 + 8 * g + 4 * h) = w1; }
}
DI int clampi(int v, int lo, int hi) { return v < lo ? lo : (v > hi ? hi : v); }
#ifndef ATTN_A_PCT
#define ATTN_A_PCT 20
#endif
constexpr int AT_NA = NB * NH * (GRH / 2) * 4, AT_WA = NB * NH * (T / 32), AT_CX = NB * NH * (TC / 32);
DI void ph_attn(const Ctx& C, int l, bool want_ctx, int widx, int nworkers, int t_lo, int t_hi) {
    if (widx < 0) return;
    const int gw = t_lo + widx, GWV = nworkers, lane = C.lane, r32 = lane & 31, h = lane >> 5;
    LAS unsigned char* vl = C.lds + C.wave * 16640;
    const bf16* QA = (const bf16*)(C.ws + WS_QA); const bf16* KA = (const bf16*)(C.ws + WS_KA); const bf16* VA = (const bf16*)(C.ws + WS_VA);
    const bf16* QC = (const bf16*)(C.ws + WS_QC); const bf16* KC = (const bf16*)(C.ws + WS_KC); const bf16* VC = (const bf16*)(C.ws + WS_VC);
    bf16* OB = (bf16*)(C.ws + WS_OB);
    const int ntiles = t_hi;
    const float zero16[16] = {0.f, 0.f, 0.f, 0.f, 0.f, 0.f, 0.f, 0.f, 0.f, 0.f, 0.f, 0.f, 0.f, 0.f, 0.f, 0.f};
    for (int tile = gw; tile < ntiles; tile += GWV) {
        AttnSt st; st.m = -1e30f; st.l = 0.f;
#pragma unroll
        for (int i = 0; i < 16; ++i) { st.o0[i] = 0.f; st.o1[i] = 0.f; }
        bf16x8 qf[4];
        if (tile < AT_NA) {
            const int cb = tile & 3, rp = (tile >> 2) % (GRH / 2), hd = (tile / (4 * (GRH / 2))) % NH, b = tile / (4 * (GRH / 2) * NH);
            const int r0 = 2 * rp, c0 = 16 * cb, qr = r0 + (r32 >> 4), qc = c0 + (r32 & 15), qrow = b * T + qr * GRW + qc;
#pragma unroll
            for (int kk = 0; kk < 4; ++kk) qf[kk] = *(const bf16x8*)(QA + (size_t)qrow * GW + hd * 64 + 16 * kk + 8 * h);
            const int rsq = clampi(qr - 4, 0, GRH - 8), csq = clampi(qc - 8, 0, GRW - 16);
            const int rsA = clampi(r0 - 4, 0, GRH - 8), rsB = clampi(r0 + 1 - 4, 0, GRH - 8), kc0 = clampi(c0 - 8, 0, GRW - 32);
            const float* rpb = C.in[I_NARPB] + ((size_t)l * NH + hd) * 465;
            const int nbn = rsB + 8 - rsA, nbt = nbn + TC / 32; KVregs nxt;
#define NA_ROW(i) ((i) < nbn ? (size_t)b * T + (rsA + (i)) * GRW + kc0 : (size_t)M_LAT + b * TC + 32 * ((i) - nbn))
            const bf16* KAh = KA + (size_t)hd * M * 64; const bf16* VAh = VA + (size_t)hd * M * 64;
            { const size_t kr0 = NA_ROW(0); kv_load2(nxt, KAh + kr0 * 64, 64, VAh + kr0 * 64, 64, lane); }
            LAS float* rpbL = (LAS float*)(vl + 64 * APT);
            { float tb[8];
#pragma unroll
              for (int i = 0; i < 8; ++i) { const int j = lane + 64 * i; tb[i] = rpb[j < 465 ? j : 464]; }
#pragma unroll
              for (int i = 0; i < 8; ++i) { const int j = lane + 64 * i; if (j < 465) rpbL[j] = tb[i]; }
              WSYNC(); }
            const int cb0 = kc0 + 4 * h - qc + 15; unsigned vmcol = 0u;
#pragma unroll
            for (int i = 0; i < 16; ++i) { const int kc = kc0 + (i & 3) + 8 * (i >> 2) + 4 * h; vmcol |= (kc >= csq && kc <= csq + 15) ? (1u << i) : 0u; }
            for (int ib = 0; ib < nbt; ++ib) {
                attn_stage(nxt, vl, lane);
                { const int in_ = ib + 1 < nbt ? ib + 1 : ib; const size_t kr1 = NA_ROW(in_); kv_load2(nxt, KAh + kr1 * 64, 64, VAh + kr1 * 64, 64, lane); }
                if (ib < nbn) { const int kr = rsA + ib; float addv[16]; const bool rok = kr >= rsq && kr <= rsq + 7;
                    const LAS float* rb = rpbL + (kr - qr + 7) * 31 + cb0;
#pragma unroll
                    for (int i = 0; i < 16; ++i) addv[i] = rb[(i & 3) + 8 * (i >> 2)];
                    attn_block<true>(st, qf, vl, lane, addv, rok ? vmcol : 0u); }
                else attn_block<false>(st, qf, vl, lane, zero16, 0xffffu); }
#undef NA_ROW
            attn_finish(st, OB + (size_t)qrow * D + hd * 64, lane, 0.f);
        } else if (tile < AT_NA + AT_WA) {
            const int t2 = tile - AT_NA, hl_ = t2 % WAG, qb = (t2 / WAG) % (T / 32), kvh = (t2 / (WAG * (T / 32))) % (NH / WAG), b = t2 / ((T / 32) * NH), hd = kvh * WAG + hl_;
            const int qt = 32 * qb + r32, qrow = b * T + qt;
#pragma unroll
            for (int kk = 0; kk < 4; ++kk) qf[kk] = *(const bf16x8*)(QC + (size_t)qrow * GW + hd * 64 + 16 * kk + 8 * h);
            const int i_lo = 4 - qb > 0 ? 4 - qb : 0, i_hi = (T / 32 - qb + 4) < 9 ? (T / 32 - qb + 4) : 9, nbw = i_hi - i_lo, nbt = nbw + TC / 32; KVregs nxt;
#define WA_ROW(i) ((i) < nbw ? (size_t)b * T + 32 * qb - 128 + 32 * (i_lo + (i)) : (size_t)M_LAT + b * TC + 32 * ((i) - nbw))
            const bf16* KCh = KC + (size_t)kvh * M * 64; const bf16* VCh = VC + (size_t)kvh * M * 64;
            { const size_t kr0 = WA_ROW(0); kv_load2(nxt, KCh + kr0 * 64, 64, VCh + kr0 * 64, 64, lane); }
            for (int ib = 0; ib < nbt; ++ib) {
                attn_stage(nxt, vl, lane);
                { const int in_ = ib + 1 < nbt ? ib + 1 : ib; const size_t kr1 = WA_ROW(in_); kv_load2(nxt, KCh + kr1 * 64, 64, VCh + kr1 * 64, 64, lane); }
                if (ib < nbw && (i_lo + ib == 0 || i_lo + ib == 8)) { const int t0 = 32 * qb - 128 + 32 * (i_lo + ib); float addv[16]; unsigned vm = 0u;
#pragma unroll
                    for (int i = 0; i < 16; ++i) { const int kt = t0 + (i & 3) + 8 * (i >> 2) + 4 * h, rel = kt - qt; addv[i] = 0.f; vm |= (rel >= -128 && rel <= 128) ? (1u << i) : 0u; }
                    attn_block<true>(st, qf, vl, lane, addv, vm); }
                else attn_block<false>(st, qf, vl, lane, zero16, 0xffffu); }
#undef WA_ROW
            const float sk = C.in[I_WASINK][(size_t)l * NH + hd];
            const float mfin = fmaxf(st.m, sk), a2 = __expf(st.m - mfin);
#pragma unroll
            for (int i = 0; i < 16; ++i) { st.o0[i] *= a2; st.o1[i] *= a2; }
            st.l *= a2; st.m = mfin;
            attn_finish(st, OB + (size_t)qrow * D + 2 * GW + hd * 64, lane, __expf(sk - mfin));
        } else {
            const int t2 = tile - AT_NA - AT_WA, isc = t2 >= AT_CX, t3 = t2 - isc * AT_CX, qb = t3 % (TC / 32), hd = (t3 / (TC / 32)) % NH, b = t3 / ((TC / 32) * NH), kvh = hd / WAG;
            const int qrow = M_LAT + b * TC + 32 * qb + r32;
            const bf16* Qs = isc ? QC : QA; const bf16* Ks = isc ? KC + (size_t)kvh * M * 64 : KA + (size_t)hd * M * 64; const bf16* Vs = isc ? VC + (size_t)kvh * M * 64 : VA + (size_t)hd * M * 64; const int kp = 64;
#pragma unroll
            for (int kk = 0; kk < 4; ++kk) qf[kk] = *(const bf16x8*)(Qs + (size_t)qrow * GW + hd * 64 + 16 * kk + 8 * h);
            { KVregs nxt; const size_t kr0 = (size_t)M_LAT + b * TC; kv_load2(nxt, Ks + kr0 * kp, kp, Vs + kr0 * kp, kp, lane);
              for (int cbk = 0; cbk < TC / 32; ++cbk) { attn_stage(nxt, vl, lane); const int cn = cbk + 1 < TC / 32 ? cbk + 1 : cbk; kv_load2(nxt, Ks + (kr0 + 32 * cn) * kp, kp, Vs + (kr0 + 32 * cn) * kp, kp, lane);
                  attn_block<false>(st, qf, vl, lane, zero16, 0xffffu); } }
            float extra = 0.f;
            if (isc) { const float sk = C.in[I_WASINK][(size_t)l * NH + hd]; const float mfin = fmaxf(st.m, sk), a2 = __expf(st.m - mfin);
#pragma unroll
                for (int i = 0; i < 16; ++i) { st.o0[i] *= a2; st.o1[i] *= a2; }
                st.l *= a2; st.m = mfin; extra = __expf(sk - mfin); }
            attn_finish(st, OB + (size_t)qrow * D + (isc ? 2 * GW : 0) + hd * 64, lane, extra);
        }
    }
}

DI void ph_ctxfix(const Ctx& C, const float* gsn  , float* rowss_next) {
    const int gw = C.bid * NW + C.wave, GWV = C.G * NW;
    for (int r = gw; r < M_CTX; r += GWV) { const int row = M_LAT + r; const float* xp = xrow_ptr(C, row); const float* gs = gsn + (size_t)NB * D; bf16* ap = (bf16*)(C.ws + WS_AP) + (size_t)row * D; float ss = 0.f;
        f32x4 xv[D / 256], gv[D / 256];
#pragma unroll
        for (int i = 0; i < D / 256; ++i) { xv[i] = *(const f32x4*)(xp + 4 * C.lane + 256 * i); gv[i] = *(const f32x4*)(gs + 4 * C.lane + 256 * i); }
#pragma unroll
        for (int i = 0; i < D / 256; ++i) { const int c = 4 * C.lane + 256 * i; const f32x4 x = xv[i]; ss += (x[0] * x[0] + x[1] * x[1]) + (x[2] * x[2] + x[3] * x[3]);
            const f32x4 a = x * gv[i]; u32x2 w; w.x = pk2(a[0], a[1]); w.y = pk2(a[2], a[3]); *(u32x2*)(ap + c) = w; }
        ss = wave_sum(ss); if (C.lane == 0) rowss_next[row] = ss; }
}
constexpr int PT = 144;
constexpr int RW_HALF = 73472, IM_BT = 0, IM_KT = 9216, IM_RT = 18432, IM_ARB = 27648, IM_AT = 36864, IM_AAK = 46080, IM_F = 55296, IM_GC = 72704, FP = 68;
DI void chunk_rows(int b, int dir, int c, int& row0, int& step) {
    if (c < TC / 64) { const int p0 = 64 * c; row0 = M_LAT + b * TC + (dir ? TC - 1 - p0 : p0); } else { const int p0 = 64 * (c - TC / 64); row0 = b * T + (dir ? T - 1 - p0 : p0); }
    step = dir ? -1 : 1;
}
DI bf16x8 frag_rows(const LAS unsigned char* img, int tile, int s, int lane) { return *(const LAS bf16x8*)(img + (32 * tile + (lane & 31)) * PT + (16 * s + 8 * (lane >> 5)) * 2); }
DI bf16x8 frag_cols(const LAS unsigned char* img, int tile, int s, int lane) {
    const int h = lane >> 5, q = (lane & 15) >> 2, p4 = lane & 3, blk = (lane >> 4) & 1;
    const LAS unsigned char* a0 = img + (16 * s + 8 * h + q) * PT + (32 * tile + 16 * blk) * 2 + 8 * p4;
    return tr_frag(a0, 4 * PT);
}
DI void frag_cols4(const LAS unsigned char* img, int tile, int lane, bf16x8 (&f)[4]) {
    const int h = lane >> 5, q = (lane & 15) >> 2, p4 = lane & 3, blk = (lane >> 4) & 1;
    const LAS unsigned char* a0 = img + (8 * h + q) * PT + (32 * tile + 16 * blk) * 2 + 8 * p4;
    tr_frag4(a0, a0 + 16 * PT, a0 + 32 * PT, a0 + 48 * PT, 4 * PT, f);
}
DI void store_T(const f32x16& acc, LAS unsigned char* img, int ti, int tj, int lane) {
    const int c = lane & 31, h = lane >> 5;
#pragma unroll
    for (int g = 0; g < 4; ++g) { u32x2 w; w.x = pk2(acc[4 * g], acc[4 * g + 1]); w.y = pk2(acc[4 * g + 2], acc[4 * g + 3]); *(LAS u32x2*)(img + (32 * tj + c) * PT + (32 * ti + 8 * g + 4 * h) * 2) = w; }
}
DI f32x16 zero16v() { f32x16 z;
#pragma unroll
    for (int i = 0; i < 16; ++i) z[i] = 0.f; return z; }
#define MMA32(a, b, c) __builtin_amdgcn_mfma_f32_32x32x16_bf16((a), (b), (c), 0, 0, 0)
constexpr int PDW = 80, PDG = 208, IM_TW = 0, IM_TA = 17408, IM_DW = 36864, IM_DA = 41984, IM_DG = 47104;
DI void ph_rw1(const Ctx& C, int l) {
    const int wg = C.wave & 3, grp = C.wave >> 2, ti = wg >> 1, tj = wg & 1;
    bf16* QH = (bf16*)(C.ws + WS_QH); float* YL = (float*)(C.ws + WS_YL); bf16* MF = (bf16*)(C.ws + WS_MF); float* GF = (float*)(C.ws + WS_GF); bf16* RVKG = (bf16*)(C.ws + WS_RVKG);
    const bf16* PB = (const bf16*)(C.ws + WS_PB); const float* PS = (const float*)(C.ws + WS_PS);
    const bf16x8* RWF = (const bf16x8*)(C.ws + WS_RWF + (size_t)l * SZ_RWF);
    constexpr int nblk = (TC + T) / 64;
    for (int it0 = 2 * C.bid; it0 < RBLK; it0 += 2 * C.G) {
        int lane_ = threadIdx.x & 63; OPAQUE(lane_); const int lane = lane_, c32 = lane & 31, h = lane >> 5;
        LAS unsigned char* L = OPAQUE_LDS(C.lds + grp * RW_HALF);
        LAS float* F = (LAS float*)(L + IM_F); LAS float* SEG = (LAS float*)(L + IM_F); LAS float* GC = (LAS float*)(L + IM_GC);
        LAS float* TW = (LAS float*)(L + IM_TW); LAS float* TA = (LAS float*)(L + IM_TA);
        unsigned char* PK = C.ws + WS_RWS + ((size_t)C.bid * 2 + grp) * 65536;
        const int item = it0 + grp; const bool live = item < RBLK; const int itc = live ? item : RBLK - 1;
        const int tb = itc % nblk, hd = (itc / nblk) % NH, b = itc / (nblk * NH), cg = hd * 64 + lane;
        const int rowb = tb < TC / 64 ? M_LAT + b * TC + 64 * tb : b * T + 64 * (tb - TC / 64);
        const int seq_lo = tb < TC / 64 ? M_LAT + b * TC : b * T, seq_hi = seq_lo + (tb < TC / 64 ? TC : T);
        bf16* RV = RVKG + (size_t)itc * 4 * 4096;
        __syncthreads();
        float r_[16], kf_[16], kk_[16], ks_[16];
        { const float* cw = C.in[I_RWCONV] + (size_t)l * 9 * GW; float cwv[3][3];
#pragma unroll
          for (int j = 0; j < 3; ++j)
#pragma unroll
              for (int x = 0; x < 3; ++x) cwv[j][x] = cw[(size_t)j * 3 * GW + x * GW + cg];
          const float kkw = C.in[I_RWKK][(size_t)l * GW + cg];
          const int r0 = rowb + 16 * wg;
          bf16 pbv[18][3]; float psv[16][3];
#pragma unroll
          for (int rr = 0; rr < 18; ++rr) { int row = r0 - 1 + rr; row = row < seq_lo ? seq_lo : (row >= seq_hi ? seq_hi - 1 : row);
#pragma unroll
              for (int x = 0; x < 3; ++x) pbv[rr][x] = PB[(size_t)row * 3 * GW + x * GW + cg]; }
#pragma unroll
          for (int t = 0; t < 16; ++t)
#pragma unroll
              for (int kq = 0; kq < 3; ++kq) { const int k = lane + 64 * kq; psv[t][kq] = PS[(size_t)(r0 + t) * 160 + (k < 160 ? k : 159)]; }
          const float m_lo = r0 - 1 >= seq_lo ? 1.f : 0.f, m_hi = r0 + 16 < seq_hi ? 1.f : 0.f;
          float v_[16];
#pragma unroll
          for (int t = 0; t < 16; ++t) {
              float xa[3], xb[3], xc[3];
#pragma unroll
              for (int x = 0; x < 3; ++x) { xa[x] = bf2f(pbv[t][x]) * (t == 0 ? m_lo : 1.f); xb[x] = bf2f(pbv[t + 1][x]); xc[x] = bf2f(pbv[t + 2][x]) * (t == 15 ? m_hi : 1.f); }
              r_[t] = xa[0] * cwv[0][0] + xb[0] * cwv[1][0] + xc[0] * cwv[2][0]; kf_[t] = xa[1] * cwv[0][1] + xb[1] * cwv[1][1] + xc[1] * cwv[2][1]; v_[t] = xa[2] * cwv[0][2] + xb[2] * cwv[1][2] + xc[2] * cwv[2][2];
              const float kkv = kf_[t] * kkw, ssq = wave_sum(kkv * kkv); kk_[t] = kkv * __builtin_amdgcn_rsqf(fmaxf(ssq, 1e-24f)); ks_[t] = 0.f;
              const int tk = 16 * wg + t;
              if (lane < 32) *(LAS bf16*)(L + IM_DW + tk * PDW + lane * 2) = (bf16)f2bf(fast_tanh(psv[t][0])); else *(LAS bf16*)(L + IM_DA + tk * PDW + (lane - 32) * 2) = (bf16)f2bf(psv[t][0]);
              *(LAS bf16*)(L + IM_DG + tk * PDG + lane * 2) = (bf16)f2bf(sigmf(psv[t][1]));
              if (lane < 32) *(LAS bf16*)(L + IM_DG + tk * PDG + (lane + 64) * 2) = (bf16)f2bf(sigmf(psv[t][2]));
          }
#pragma unroll
          for (int t = 0; t < 16; ++t) { RV[(16 * wg + t) * 64 + lane] = (bf16)f2bf(r_[t]); RV[4096 + (16 * wg + t) * 64 + lane] = (bf16)f2bf(v_[t]); }
        }
        __syncthreads();
        bf16x8 lrf[2][4]; float w0v[2], a0v[2];
#pragma unroll
        for (int d = 0; d < 2; ++d) {
#pragma unroll
            for (int sx = 0; sx < 2; ++sx) { lrf[d][sx] = RWF[(((0 + 2 * d + sx) * NH + hd) * 2 + tj) * 64 + lane]; lrf[d][2 + sx] = RWF[(((4 + 2 * d + sx) * NH + hd) * 2 + tj) * 64 + lane]; }
            w0v[d] = C.in[I_RWW0][((size_t)l * 2 + d) * GW + hd * 64 + 32 * tj + c32]; a0v[d] = C.in[I_RWA0][((size_t)l * 2 + d) * GW + hd * 64 + 32 * tj + c32]; }
        { f32x16 gacc = zero16v();
#pragma unroll
          for (int sx = 0; sx < 6; ++sx) gacc = MMA32(*(const LAS bf16x8*)(L + IM_DG + (32 * ti + c32) * PDG + (16 * sx + 8 * h) * 2), RWF[(((8 + sx) * NH + hd) * 2 + tj) * 64 + lane], gacc);
#pragma unroll
          for (int rg = 0; rg < 16; ++rg) { const int tk = 32 * ti + (rg & 3) + 8 * (rg >> 2) + 4 * h; RV[3 * 4096 + tk * 64 + 32 * tj + c32] = (bf16)f2bf(gacc[rg]); }
        }
        const float kaw = C.in[I_RWKA][(size_t)l * GW + cg];
#pragma unroll
        for (int pss = 0; pss < 2; ++pss) {
            const int dir = 1 - pss;
            __syncthreads();
            { f32x16 pw = zero16v(), pa = zero16v();
#pragma unroll
              for (int sx = 0; sx < 2; ++sx) { pw = MMA32(*(const LAS bf16x8*)(L + IM_DW + (32 * ti + c32) * PDW + (16 * sx + 8 * h) * 2), lrf[dir][sx], pw);
                                              pa = MMA32(*(const LAS bf16x8*)(L + IM_DA + (32 * ti + c32) * PDW + (16 * sx + 8 * h) * 2), lrf[dir][2 + sx], pa); }
              const float w0 = w0v[dir], a0 = a0v[dir];
#pragma unroll
              for (int rg = 0; rg < 16; ++rg) { const int tk = 32 * ti + (rg & 3) + 8 * (rg >> 2) + 4 * h; const float z = -(w0 + pw[rg]), sp = z > 20.f ? z : __logf(1.f + __expf(z));
                  TW[tk * FP + 32 * tj + c32] = -__expf(-sp - 0.5f); TA[tk * FP + 32 * tj + c32] = sigmf(a0 + pa[rg]); } }
            __syncthreads();
            const int cs = dir ? 3 - wg : wg;
            float lw[16], av[16], run = 0.f;
#pragma unroll
            for (int ii = 0; ii < 16; ++ii) { const int tl = dir ? 15 - ii : ii, tk = 16 * wg + tl; av[ii] = TA[tk * FP + lane]; run += TW[tk * FP + lane]; lw[ii] = run; }
            __syncthreads();
            SEG[cs * 64 + lane] = run;
            __syncthreads();
            float off = 0.f;
#pragma unroll
            for (int w2 = 0; w2 < 3; ++w2) off += (w2 < cs) ? SEG[w2 * 64 + lane] : 0.f;
            const float tot = SEG[lane] + SEG[64 + lane] + SEG[128 + lane] + SEG[192 + lane];
            if (wg == 0) { if (dir) ((float*)(PK + 32768))[lane] = __expf(tot); else GC[lane] = __expf(tot); }
            float ePrev = __expf(off);
#pragma unroll
            for (int ii = 0; ii < 16; ++ii) { const int tl = dir ? 15 - ii : ii, i = 16 * cs + ii;
                const float Li = lw[ii] + off, eL = __expf(Li), ieL = __builtin_amdgcn_rcpf(eL), eLm = ePrev; ePrev = eL;
                const float a = av[ii], kd = kf_[tl] * (1.f + (a - 1.f) * kaw); ks_[tl] += kd;
                const bf16 vat = (bf16)f2bf(-kk_[tl] * eLm), vbt = (bf16)f2bf(kk_[tl] * a * ieL), vkt = (bf16)f2bf(kd * ieL), vrt = (bf16)f2bf(r_[tl] * eL);
                if (dir) { bf16* pk = (bf16*)PK + i * 64 + lane; pk[0] = vat; pk[4096] = vbt; pk[8192] = vkt; pk[12288] = vrt; }
                else { *(LAS bf16*)(L + IM_AT + i * PT + lane * 2) = vat; *(LAS bf16*)(L + IM_BT + i * PT + lane * 2) = vbt; *(LAS bf16*)(L + IM_KT + i * PT + lane * 2) = vkt; *(LAS bf16*)(L + IM_RT + i * PT + lane * 2) = vrt; } }
        }
#pragma unroll
        for (int t = 0; t < 16; ++t) RV[2 * 4096 + (16 * wg + t) * 64 + lane] = (bf16)f2bf(ks_[t]);
#pragma unroll 1
        for (int dir = 0; dir < 2; ++dir) {
            const int c = dir == 0 ? tb : (tb < TC / 64 ? TC / 64 - 1 - tb : TC / 64 + (T / 64 - 1 - (tb - TC / 64)));
            const size_t ci = ((size_t)((b * NH + hd) * 2 + dir)) * RCK + c;
            __syncthreads();
            if (dir) {
                const int tg = wg * 64 + lane;
                u32x4 pkv[4][2]; const float gcv = ((const float*)(PK + 32768))[lane];
#pragma unroll
                for (int im = 0; im < 4; ++im)
#pragma unroll
                    for (int rr = 0; rr < 2; ++rr) { const int idx = tg + 256 * rr, row = idx >> 3, ch = idx & 7; pkv[im][rr] = *(const u32x4*)(PK + im * 8192 + row * 128 + ch * 16); }
#pragma unroll
                for (int im = 0; im < 4; ++im)
#pragma unroll
                    for (int rr = 0; rr < 2; ++rr) { const int idx = tg + 256 * rr, row = idx >> 3, ch = idx & 7; const int dsto = im == 0 ? IM_AT : im == 1 ? IM_BT : im == 2 ? IM_KT : IM_RT;
                        *(LAS u32x4*)(L + dsto + row * PT + ch * 16) = pkv[im][rr]; }
                if (wg == 0) GC[lane] = gcv;
                __syncthreads();
            }
            f32x16 accP;
            { f32x16 aab = zero16v(), aak = zero16v(), arb = zero16v(); accP = zero16v();
#pragma unroll
              for (int s = 0; s < 4; ++s) { const bf16x8 at_i = frag_rows(L + IM_AT, ti, s, lane), bt_j = frag_rows(L + IM_BT, tj, s, lane), kt_j = frag_rows(L + IM_KT, ti, s, lane), at_c = frag_rows(L + IM_AT, tj, s, lane),
                                              bt_r = frag_rows(L + IM_BT, ti, s, lane), rt_c = frag_rows(L + IM_RT, tj, s, lane);
                  aab = MMA32(at_i, bt_j, aab); aak = MMA32(kt_j, at_c, aak); arb = MMA32(bt_r, rt_c, arb); accP = MMA32(kt_j, rt_c, accP); }
#pragma unroll
              for (int r = 0; r < 16; ++r) { const int row = 32 * ti + (r & 3) + 8 * (r >> 2) + 4 * h, col = 32 * tj + c32;
                  F[row * FP + col] = col < row ? aab[r] : 0.f; aak[r] = row < col ? aak[r] : 0.f; arb[r] = row <= col ? arb[r] : 0.f; accP[r] = row <= col ? accP[r] : 0.f; }
              store_T(aak, L + IM_AAK, ti, tj, lane);
              store_T(arb, L + IM_ARB, ti, tj, lane); }
            __syncthreads();
            { float Wc[64]; const int col = 32 * wg + c32; const LAS unsigned char* src = col < 64 ? L + IM_AT + col * 2 : L + IM_AAK + (col - 64) * 2;
              const LAS float* Fo = OPAQUE_LDS(F);
#pragma unroll
              for (int i = 0; i < 64; ++i) Wc[i] = bf2f(*(const LAS bf16*)(src + i * PT));
#pragma unroll
              for (int i = 1; i < 64; ++i) { float a0 = Wc[i], a1 = 0.f, a2 = 0.f, a3 = 0.f;
#pragma unroll
                  for (int j4 = 0; j4 < (i + 3) / 4; ++j4) { const f32x4 f = *(const LAS f32x4*)(Fo + i * FP + 4 * j4); a0 += f[0] * Wc[4 * j4]; a1 += f[1] * Wc[4 * j4 + 1]; a2 += f[2] * Wc[4 * j4 + 2]; a3 += f[3] * Wc[4 * j4 + 3];
                      if ((j4 & 7) == 7) PIN4(a0, a1, a2, a3); }
                  PIN4(a0, a1, a2, a3); Wc[i] = (a0 + a1) + (a2 + a3); }
              __syncthreads();
              if (h == 0) { LAS unsigned char* dst = (col < 64 ? L + IM_AT + col * PT : L + IM_AAK + (col - 64) * PT);
#pragma unroll
                  for (int i8 = 0; i8 < 8; ++i8) { u32x4 w; w.x = pk2(Wc[8 * i8], Wc[8 * i8 + 1]); w.y = pk2(Wc[8 * i8 + 2], Wc[8 * i8 + 3]); w.z = pk2(Wc[8 * i8 + 4], Wc[8 * i8 + 5]); w.w = pk2(Wc[8 * i8 + 6], Wc[8 * i8 + 7]); *(LAS u32x4*)(dst + i8 * 16) = w; } }
              bf16 vtmp[16];
#pragma unroll
              for (int ii = 0; ii < 16; ++ii) { const int tl = dir ? 15 - ii : ii; vtmp[ii] = RV[4096 + (16 * wg + tl) * 64 + lane]; }
#pragma unroll
              for (int ii = 0; ii < 16; ++ii) { const int i = 16 * (dir ? 3 - wg : wg) + ii; *(LAS bf16*)(L + IM_F + i * PT + lane * 2) = vtmp[ii]; }
            }
            __syncthreads();
            { f32x16 q;
#pragma unroll
              for (int g = 0; g < 4; ++g) { const u32x2 w = *(const LAS u32x2*)(L + IM_RT + (32 * tj + c32) * PT + (32 * ti + 8 * g + 4 * h) * 2); q[4 * g] = bflo(w.x); q[4 * g + 1] = bfhi(w.x); q[4 * g + 2] = bflo(w.y); q[4 * g + 3] = bfhi(w.y); }
#pragma unroll
              for (int s = 0; s < 4; ++s) { const bf16x8 arb = frag_rows(L + IM_ARB, tj, s, lane); q = MMA32(frag_rows(L + IM_AT, ti, s, lane), arb, q); accP = MMA32(frag_rows(L + IM_AAK, ti, s, lane), arb, accP); }
              if (live) {
#pragma unroll
                  for (int g = 0; g < 4; ++g) { u32x2 w; w.x = pk2(q[4 * g], q[4 * g + 1]); w.y = pk2(q[4 * g + 2], q[4 * g + 3]); *(u32x2*)(QH + ci * 4096 + (32 * tj + c32) * 64 + 32 * ti + 8 * g + 4 * h) = w; } }
            }
            __syncthreads();
            store_T(accP, L + IM_RT, ti, tj, lane);
            __syncthreads();
            { f32x16 y = zero16v(), m = zero16v(), n;
#pragma unroll
              for (int g = 0; g < 4; ++g) { const u32x2 w = *(const LAS u32x2*)(L + IM_KT + (32 * tj + c32) * PT + (32 * ti + 8 * g + 4 * h) * 2); n[4 * g] = bflo(w.x); n[4 * g + 1] = bfhi(w.x); n[4 * g + 2] = bflo(w.y); n[4 * g + 3] = bfhi(w.y); }
              bf16x8 btj[4], bti[4], vfj[4]; frag_cols4(L + IM_BT, tj, lane, btj); frag_cols4(L + IM_BT, ti, lane, bti); frag_cols4(L + IM_F, tj, lane, vfj);
#pragma unroll
              for (int s = 0; s < 4; ++s) { const bf16x8 btc_j = btj[s], btc_i = bti[s];
                  y = MMA32(frag_rows(L + IM_RT, ti, s, lane), vfj[s], y);
                  m = MMA32(frag_rows(L + IM_AT, ti, s, lane), btc_j, m);
                  n = MMA32(btc_i, frag_rows(L + IM_AAK, tj, s, lane), n); }
              const float gck = GC[32 * tj + c32];
#pragma unroll
              for (int r = 0; r < 16; ++r) { const int row = 32 * ti + (r & 3) + 8 * (r >> 2) + 4 * h, col = 32 * tj + c32; m[r] = (m[r] + (row == col ? 1.0f : 0.f)) * gck; n[r] *= GC[row]; }
              if (live) {
#pragma unroll
                  for (int g = 0; g < 4; ++g) *(f32x4*)(YL + ci * 4096 + ((wg * 4 + g) * 64 + lane) * 4) = (f32x4){y[4 * g], y[4 * g + 1], y[4 * g + 2], y[4 * g + 3]};
#pragma unroll
                  for (int s2 = 0; s2 < 2; ++s2) *(bf16x8*)(MF + ci * 4096 + ((wg * 2 + s2) * 64 + lane) * 8) = pack8(m, s2); }
              store_T(n, L + IM_ARB, ti, tj, lane);
            }
            __syncthreads();
            { f32x16 gacc = zero16v(); bf16x8 nfi[4], vfj[4]; frag_cols4(L + IM_ARB, ti, lane, nfi); frag_cols4(L + IM_F, tj, lane, vfj);
#pragma unroll
              for (int s = 0; s < 4; ++s) gacc = MMA32(nfi[s], vfj[s], gacc);
              if (live) {
#pragma unroll
                  for (int hf = 0; hf < 2; ++hf) { u32x4 w; w.x = pk2(gacc[8 * hf], gacc[8 * hf + 1]); w.y = pk2(gacc[8 * hf + 2], gacc[8 * hf + 3]); w.z = pk2(gacc[8 * hf + 4], gacc[8 * hf + 5]); w.w = pk2(gacc[8 * hf + 6], gacc[8 * hf + 7]);
                      *(u32x4*)((unsigned*)GF + ci * 2048 + ((wg * 2 + hf) * 64 + lane) * 4) = w; } }
            }
        }
    }
    __syncthreads();
}
struct R2Buf { bf16x8 mf[8]; u32x4 g[4]; };
DI void rw2_load(R2Buf& b, const bf16* MF, const unsigned* GFu, size_t item, int tj, int lane) {
#pragma unroll
    for (int q = 0; q < 8; ++q) b.mf[q] = *(const bf16x8*)(MF + item * 4096 + (q * 64 + lane) * 8);
#pragma unroll
    for (int kt = 0; kt < 2; ++kt)
#pragma unroll
        for (int hf = 0; hf < 2; ++hf) b.g[kt * 2 + hf] = *(const u32x4*)(GFu + item * 2048 + (((kt * 2 + tj) * 2 + hf) * 64 + lane) * 4);
}
DI void rw2_step(const R2Buf& b, f32x16& s0, f32x16& s1, bf16* SF, size_t item, int tj, int lane) {
    bf16x8 sf[2][2];
#pragma unroll
    for (int s = 0; s < 2; ++s) { sf[0][s] = pack8(s0, s); sf[1][s] = pack8(s1, s); *(bf16x8*)(SF + item * 4096 + (((0 * 2 + tj) * 2 + s) * 64 + lane) * 8) = sf[0][s]; *(bf16x8*)(SF + item * 4096 + (((1 * 2 + tj) * 2 + s) * 64 + lane) * 8) = sf[1][s]; }
    f32x16 n0, n1;
#pragma unroll
    for (int hf = 0; hf < 2; ++hf) { const u32x4 a = b.g[hf], c = b.g[2 + hf];
        n0[8 * hf] = bflo(a.x); n0[8 * hf + 1] = bfhi(a.x); n0[8 * hf + 2] = bflo(a.y); n0[8 * hf + 3] = bfhi(a.y); n0[8 * hf + 4] = bflo(a.z); n0[8 * hf + 5] = bfhi(a.z); n0[8 * hf + 6] = bflo(a.w); n0[8 * hf + 7] = bfhi(a.w);
        n1[8 * hf] = bflo(c.x); n1[8 * hf + 1] = bfhi(c.x); n1[8 * hf + 2] = bflo(c.y); n1[8 * hf + 3] = bfhi(c.y); n1[8 * hf + 4] = bflo(c.z); n1[8 * hf + 5] = bfhi(c.z); n1[8 * hf + 6] = bflo(c.w); n1[8 * hf + 7] = bfhi(c.w); }
#pragma unroll
    for (int kp = 0; kp < 2; ++kp)
#pragma unroll
        for (int s = 0; s < 2; ++s) { n0 = MMA32(b.mf[(kp * 2 + 0) * 2 + s], sf[kp][s], n0); n1 = MMA32(b.mf[(kp * 2 + 1) * 2 + s], sf[kp][s], n1); }
    s0 = n0; s1 = n1;
}
DI void ph_rw2(const Ctx& C) {
    const int lane = C.lane;
    const bf16* MF = (const bf16*)(C.ws + WS_MF); const unsigned* GFu = (const unsigned*)(C.ws + WS_GF); bf16* SF = (bf16*)(C.ws + WS_SF);
    const int nwork = RSTR * 2;
    for (int wk = C.wave == 0 ? C.bid : nwork; wk < nwork; wk += C.G) {
        const int tj = wk & 1, stream = wk >> 1; const size_t it0 = (size_t)stream * RCK;
        f32x16 s0 = zero16v(), s1 = zero16v();
        R2Buf A, B, Cb;
        rw2_load(A, MF, GFu, it0, tj, lane); rw2_load(B, MF, GFu, it0 + (1 < RCK ? 1 : 0), tj, lane); rw2_load(Cb, MF, GFu, it0 + (2 < RCK ? 2 : 0), tj, lane);
        for (int c = 0; c < RCK; c += 3) {
            rw2_step(A, s0, s1, SF, it0 + c, tj, lane); rw2_load(A, MF, GFu, it0 + (c + 3 < RCK ? c + 3 : RCK - 1), tj, lane);
            if (c + 1 < RCK) { rw2_step(B, s0, s1, SF, it0 + c + 1, tj, lane); rw2_load(B, MF, GFu, it0 + (c + 4 < RCK ? c + 4 : RCK - 1), tj, lane); }
            if (c + 2 < RCK) { rw2_step(Cb, s0, s1, SF, it0 + c + 2, tj, lane); rw2_load(Cb, MF, GFu, it0 + (c + 5 < RCK ? c + 5 : RCK - 1), tj, lane); }
        }
    }
}
DI void ph_rw3(const Ctx& C, int l, int mrows) {
    const int lane = C.lane, wg = C.wave & 3, grp = C.wave >> 2, ti = wg >> 1, tj = wg & 1, c32 = lane & 31, h = lane >> 5;
    LAS float* Ysum = (LAS float*)(C.lds + grp * RW_HALF);
    const bf16* QH = (const bf16*)(C.ws + WS_QH); const float* YL = (const float*)(C.ws + WS_YL); const bf16* SF = (const bf16*)(C.ws + WS_SF); bf16* OB = (bf16*)(C.ws + WS_OB);
    const int nblk = (TC + T) / 64, nitems = NB * NH * nblk;
    for (int it0 = 2 * C.bid; it0 < nitems; it0 += 2 * C.G) {
        const int item = it0 + grp; const bool live = item < nitems; const int itc = live ? item : nitems - 1;
        const int tb = itc % nblk, hd = (itc / nblk) % NH, b = itc / (nblk * NH);
        const int rowb = tb < TC / 64 ? M_LAT + b * TC + 64 * tb : b * T + 64 * (tb - TC / 64);
        __syncthreads();
        f32x4 yl[2][4]; u32x4 qa[2][4]; bf16x8 sb[2][4];
#pragma unroll
        for (int dir = 0; dir < 2; ++dir) {
            const int c = dir == 0 ? tb : (tb < TC / 64 ? TC / 64 - 1 - tb : TC / 64 + (T / 64 - 1 - (tb - TC / 64)));
            const size_t ci = ((size_t)((b * NH + hd) * 2 + dir)) * RCK + c;
#pragma unroll
            for (int g = 0; g < 4; ++g) yl[dir][g] = *(const f32x4*)(YL + ci * 4096 + ((wg * 4 + g) * 64 + lane) * 4);
#pragma unroll
            for (int kp = 0; kp < 2; ++kp)
#pragma unroll
                for (int s = 0; s < 2; ++s) { const bf16* qp = QH + ci * 4096 + (32 * ti + c32) * 64 + 32 * kp + 16 * s + 4 * h; const u32x2 lo = *(const u32x2*)qp, hi = *(const u32x2*)(qp + 8);
                    qa[dir][kp * 2 + s].x = lo.x; qa[dir][kp * 2 + s].y = lo.y; qa[dir][kp * 2 + s].z = hi.x; qa[dir][kp * 2 + s].w = hi.y;
                    sb[dir][kp * 2 + s] = *(const bf16x8*)(SF + ci * 4096 + (((kp * 2 + tj) * 2 + s) * 64 + lane) * 8); }
        }
#pragma unroll
        for (int dir = 0; dir < 2; ++dir) {
            f32x16 y;
#pragma unroll
            for (int g = 0; g < 4; ++g) { const f32x4 a = yl[dir][g]; y[4 * g] = a[0]; y[4 * g + 1] = a[1]; y[4 * g + 2] = a[2]; y[4 * g + 3] = a[3]; }
#pragma unroll
            for (int q4 = 0; q4 < 4; ++q4) y = MMA32(__builtin_bit_cast(bf16x8, qa[dir][q4]), sb[dir][q4], y);
#pragma unroll
            for (int r = 0; r < 16; ++r) { const int i = 32 * ti + (r & 3) + 8 * (r >> 2) + 4 * h, tk = dir ? 63 - i : i; LAS float* p = Ysum + tk * FP + 32 * tj + c32; if (dir == 0) *p = y[r]; else *p += y[r]; }
            __syncthreads();
        }
        if (live) {
            const int cch = hd * 64 + lane; const float rk = C.in[I_RWRK][((size_t)l * NH + hd) * 64 + lane], gw = C.in[I_RWGNW][(size_t)l * GW + cch], gb = C.in[I_RWGNB][(size_t)l * GW + cch];
#pragma unroll 1
            for (int t4 = 0; t4 < 16; t4 += 8) {
                bf16 rb[8], vb[8], kb[8], gb8[8];
#pragma unroll
                for (int u = 0; u < 8; ++u) { const bf16* rv = (const bf16*)(C.ws + WS_RVKG) + (size_t)item * 4 * 4096 + (16 * wg + t4 + u) * 64 + lane; rb[u] = rv[0]; vb[u] = rv[4096]; kb[u] = rv[8192]; gb8[u] = rv[12288]; }
#pragma unroll
                for (int u = 0; u < 8; ++u) { const int tk = 16 * wg + t4 + u, row = rowb + tk; const float r = bf2f(rb[u]), v = bf2f(vb[u]), ks = bf2f(kb[u]), gg = bf2f(gb8[u]);
                    float y = Ysum[tk * FP + lane] + wave_sum(r * ks * rk) * v;
                    const float mu = wave_sum(y) * (1.f / 64.f), dlt = y - mu, var = wave_sum(dlt * dlt) * (1.f / 64.f);
                    if (row < mrows) OB[(size_t)row * D + GW + cch] = (bf16)f2bf((dlt * __builtin_amdgcn_rsqf(var + RW_GN_EPS) * gw + gb) * gg); } }
        }
    }
    __syncthreads();
}
constexpr int S5X_OFF = NW * 16640;
DI void ph_s5scan(const Ctx& C, int l, int first_block, int nblocks) {
    constexpr int nc_ctx = TC / S5L, nc_lat = T / S5L, ntot = nc_ctx + nc_lat, SEG = ntot / NW;
    static_assert(ntot % NW == 0 && S5X_OFF + NW * 64 * 8 <= MISC_OFF, "S5 scan segmentation");
    if ((int)C.bid < first_block || (int)C.bid >= first_block + nblocks) return;
    const float* XE = (const float*)(C.ws + WS_XEND); bf16* UG = (bf16*)(C.ws + WS_UG);
    const f32x2* LAM = (const f32x2*)(C.ws + WS_S5T + (size_t)l * SZ_S5L + OFF_S5LAM);
    LAS f32x2* XCH = (LAS f32x2*)(C.lds + S5X_OFF);
    for (int combo = C.bid - first_block; combo < NB * 2 * S5G; combo += nblocks) {
        const int g = combo % S5G, dir = (combo / S5G) & 1, b = combo / (2 * S5G), n = C.lane, seg = C.wave;
        const f32x2 lm = LAM[(dir * S5G + g) * 64 + n];
        float er[SEG], ei[SEG];
#pragma unroll
        for (int u = 0; u < SEG; ++u) { const int i = seg * SEG + u; const int ch = i < nc_ctx ? (M_LAT + b * TC) / S5L + (dir ? nc_ctx - 1 - i : i) : (b * T) / S5L + (dir ? nc_lat - 1 - (i - nc_ctx) : (i - nc_ctx));
            const float* p = XE + ((size_t)g * NCHP + ch) * 256 + dir * 128 + n; er[u] = p[0]; ei[u] = p[64]; }
        float pr = lm[0], pi = lm[1];
#pragma unroll 1
        for (int u = 1; u < SEG; ++u) { const float tr = pr * lm[0] - pi * lm[1], ti2 = pr * lm[1] + pi * lm[0]; pr = tr; pi = ti2; }
        float xr = 0.f, xi = 0.f;
#pragma unroll
        for (int u = 0; u < SEG; ++u) { const float nr = lm[0] * xr - lm[1] * xi + er[u], ni = lm[0] * xi + lm[1] * xr + ei[u]; xr = nr; xi = ni; }
        XCH[seg * 64 + n] = (f32x2){xr, xi};
        __syncthreads();
        xr = 0.f; xi = 0.f;
        for (int s2 = 0; s2 < seg; ++s2) { const f32x2 e = XCH[s2 * 64 + n]; const float nr = pr * xr - pi * xi + e[0], ni = pr * xi + pi * xr + e[1]; xr = nr; xi = ni; }
        __syncthreads();
#pragma unroll
        for (int u = 0; u < SEG; ++u) { const int i = seg * SEG + u; const int ch = i < nc_ctx ? (M_LAT + b * TC) / S5L + (dir ? nc_ctx - 1 - i : i) : (b * T) / S5L + (dir ? nc_lat - 1 - (i - nc_ctx) : (i - nc_ctx));
            bf16* q = UG + ((size_t)g * NCHP + ch) * S5K + 512 + dir * 128 + n; q[0] = (bf16)f2bf(xr); q[64] = (bf16)f2bf(xi);
            const float nr = lm[0] * xr - lm[1] * xi + er[u], ni = lm[0] * xi + lm[1] * xr + ei[u]; xr = nr; xi = ni; }
    }
}

constexpr int PH_PRO = 3, PH_PER_L = 13, NPH = PH_PRO + PH_PER_L * NL;
#ifndef PROBE_REP
#define PROBE_REP -1
#endif
#define NREP(k) ((k) == PROBE_REP ? 2 : 1)
#ifdef ONLY
#define EN(k) ((k) == ONLY)
#else
#define EN(k) true
#endif
#ifdef EMU
void fwd(Args args) {
    unsigned char* lds = emu::lds_base();
#else
__global__ void __launch_bounds__(NTHR, 2) fwd(Args args) {
    extern __shared__ __attribute__((aligned(16))) unsigned char lds[];
#endif
    Ctx C; C.in = args.in; C.out = args.out; C.ws = args.ws; C.lds = (LAS unsigned char*)lds;
    C.tid = threadIdx.x; C.lane = C.tid & 63; C.wave = __builtin_amdgcn_readfirstlane(C.tid >> 6); C.G = gridDim.x; C.bid = blockIdx.x;
#define REFRESH() do { int t_ = threadIdx.x; OPAQUE(t_); C.tid = t_; C.lane = t_ & 63; C.wave = __builtin_amdgcn_readfirstlane(t_ >> 6); } while (0)
    volatile LAS unsigned* MISC = (volatile LAS unsigned*)(C.lds + MISC_OFF);
    if (C.tid < 32) MISC[C.tid] = 0u;
    __syncthreads();
    const int lo = args.ph_lo, hi = args.ph_hi;
    const bool use_bar = (hi - lo) > 1;
    XcdBarrier bar; bar.bar = (unsigned*)(C.ws + WS_CTL) + CW_BAR; bar.x = 0; bar.st = MISC + 8;
    if (use_bar) bar = xcd_barrier_post((unsigned*)(C.ws + WS_CTL) + CW_BAR, MISC + 8);
#define IN(k) (lo <= (k) && (k) < hi)
#define SEAM(k) do { if (IN(k) && IN((k) + 1)) xcd_barrier(bar); } while (0)
    if (EN(0) && IN(0)) for (int rep = 0; rep < NREP(0); ++rep) { REFRESH(); ph_ada(C); }
    SEAM(0);
    if (EN(1) && IN(1)) { REFRESH(); ph_conv(C); }
    SEAM(1);
    if (EN(2) && IN(2)) for (int rep = 0; rep < NREP(2); ++rep) { REFRESH(); ph_tab(C); }
    SEAM(2);
    for (int l = 0; l < NL; ++l) {
        const int pb = PH_PRO + PH_PER_L * l; const bool want_ctx = l < NL - 1;
        const int mrows_full = M, mrows_out = want_ctx ? M : M_LAT;
        const int nt_attn = AT_NA + AT_WA + (want_ctx ? 2 * AT_CX : 0), nt_attn_a = (int)((long)nt_attn * ATTN_A_PCT / 100);
        bf16* AP = (bf16*)(C.ws + WS_AP); bf16* Hb = (bf16*)(C.ws + WS_H); bf16* OB = (bf16*)(C.ws + WS_OB);
        if (EN(3) && IN(pb + 0)) for (int rep = 0; rep < NREP(3); ++rep) { REFRESH();
            Gemm g{AP, wl(C, l, OFF_W1GU), D, D, D, 0, 0}; Order S; S.init(mrows_full / 256, 2 * FF / 256, 1, C.G, C.bid, D / 64);
            EpiGU E{rowss_ptr(C, l, 0), bias_ptr(C, l, 0), Hb, mrows_full}; gemm_phase(C.lds, g, S, E);
            if (EN(1) && l + 1 < NL) { REFRESH(); const int r = S.total % C.G;
                if ((int)C.bid >= r) conv_weights(C, l + 1, (C.bid - r) * NW + C.wave, (C.G - r) * NW, 0, CI_X1); } }
        SEAM(pb + 0);
        if (EN(4) && IN(pb + 1)) { REFRESH();
            Gemm g{Hb, wl(C, l, OFF_W1D), FF, FF, FF, 0, 0}; Order S; S.init(M_LAT / 256, D / 256, 1, C.G, C.bid, FF / 64);
            EpiRes E{&C, gate_ptr(C, l, 0, 0), gs_ptr(C, l, 1, 0), rowss_ptr(C, l, 1), AP}; gemm_phase(C.lds, g, S, E);
            { REFRESH(); Order S2; S2.init_split(M_LAT / 256, M_CTX / 256, D / 256, 4, C.G, C.bid, FF / 64); EpiAcc E2{&C, gate_ptr(C, l, 0, 0)}; gemm_phase(C.lds, g, S2, E2); } }
        SEAM(pb + 1);
        if (EN(18) && IN(pb + 2)) { REFRESH(); ph_ctxfix(C, gs_ptr(C, l, 1, 0), rowss_ptr(C, l, 1)); }
        SEAM(pb + 2);
        if (EN(5) && IN(pb + 3)) for (int rep = 0; rep < NREP(5); ++rep) { REFRESH();
            Gemm g{AP, wl(C, l, OFF_WIN), D, D, D, 0, 0}; Order S; S.init(mrows_full / 256, NT_IN, 1, C.G, C.bid, D / 64);
            EpiIn E{&C, rowss_ptr(C, l, 1), bias_ptr(C, l, 1), l}; gemm_phase(C.lds, g, S, E); }
        SEAM(pb + 3);
        if (IN(pb + 4)) {
            if (EN(6)) for (int rep = 0; rep < NREP(6); ++rep) { REFRESH(); Gemm g{(const bf16*)(C.ws + WS_UG), (const bf16*)(C.ws + WS_S5T + (size_t)l * SZ_S5L + OFF_S5ET), S5K, 512, 512, (size_t)NCHP * S5K * 2, (size_t)256 * 512 * 2};
              const int off5 = C.G >= 256 ? 32 : 0; Order S; S.init(NCHP / 256, 1, S5G, C.G - off5, (int)C.bid < off5 ? (1 << 28) : (int)C.bid - off5, 512 / 64);        EpiS5A E{(float*)(C.ws + WS_XEND)}; gemm_phase(C.lds, g, S, E); }
            __syncthreads();
            for (int rep = 0; rep < NREP(9); ++rep) { if (EN(9)) { REFRESH(); ph_rw1(C, l); } }
            if (EN(7)) for (int rep = 0; rep < NREP(7); ++rep) { REFRESH(); const int fb = (C.G >= 256 && 2 * C.G < RBLK && RBLK % (2 * C.G) != 0) ? (RBLK % (2 * C.G) + 1) / 2 : 0;
                ph_attn(C, l, want_ctx, C.bid >= fb ? (C.bid - fb) * NW + C.wave : -1, (C.G - fb) * NW, 0, nt_attn_a); }
        }
        SEAM(pb + 4);
        if (IN(pb + 5)) {
            if (EN(17)) for (int rep = 0; rep < NREP(17); ++rep) { REFRESH(); ph_rw2(C); }
            if (EN(10)) for (int rep = 0; rep < NREP(10); ++rep) { REFRESH(); ph_s5scan(C, l, C.G >= 256 ? 64 : 0, C.G >= 256 ? 128 : C.G); }
            { REFRESH();
              const int nrb = C.G < RSTR * 2 ? C.G : RSTR * 2, sb_lo = C.G, sb_hi = C.G;
              const int nworkers = nrb * 7 + (C.G - nrb - (sb_hi - sb_lo)) * NW;
              const int widx = C.bid < nrb ? (C.wave == 0 ? -1 : C.bid * 7 + C.wave - 1) : (C.bid >= sb_lo && C.bid < sb_hi) ? -1 : nrb * 7 + (C.bid - nrb - (C.bid >= sb_hi ? sb_hi - sb_lo : 0)) * NW + C.wave;
              if (EN(7)) ph_attn(C, l, want_ctx, widx, nworkers, nt_attn_a, nt_attn); }
        }
        SEAM(pb + 5);
        if (IN(pb + 6)) {
            if (EN(11)) for (int rep = 0; rep < NREP(11); ++rep) { REFRESH(); Gemm g{(const bf16*)(C.ws + WS_UG), (const bf16*)(C.ws + WS_S5T + (size_t)l * SZ_S5L + OFF_S5BT), S5K, S5K, S5K, (size_t)NCHP * S5K * 2, (size_t)512 * S5K * 2};
              const int off5 = C.G >= 256 ? 64 : 0; Order S; S.init(NCHP / 256, 2, S5G, C.G - off5, (int)C.bid < off5 ? (1 << 28) : (int)C.bid - off5, S5K / 64);        EpiS5C E{(const bf16*)(C.ws + WS_UG), C.in[I_S5D] + (size_t)l * GW, (bf16*)(C.ws + WS_YG)}; gemm_phase(C.lds, g, S, E); }
            if (EN(12)) for (int rep = 0; rep < NREP(12); ++rep) { REFRESH(); ph_rw3(C, l, mrows_out); }
        }
        SEAM(pb + 6);
        if (EN(13) && IN(pb + 7)) for (int rep = 0; rep < NREP(13); ++rep) { REFRESH();
            Gemm g{(const bf16*)(C.ws + WS_YG), wl(C, l, OFF_WGLU), GW, GW, GW, 0, 0}; Order S; S.init(mrows_out / 256, GW / 256, 1, C.G, C.bid, GW / 64);
            EpiGLU E{(const bf16*)(C.ws + WS_YG), C.in[I_S5GLUB] + (size_t)l * GW, OB}; gemm_phase(C.lds, g, S, E); }
        SEAM(pb + 7);
        if (EN(14) && IN(pb + 8)) { REFRESH();
            Gemm g{OB, wl(C, l, OFF_WOUT), D, D, D, 0, 0}; Order S; S.init(M_LAT / 256, D / 256, 1, C.G, C.bid, D / 64);
            EpiRes E{&C, gate_ptr(C, l, 1, 0), gs_ptr(C, l, 2, 0), rowss_ptr(C, l, 2), AP}; gemm_phase(C.lds, g, S, E);
            if (want_ctx) { REFRESH(); Order S2; S2.init_split(M_LAT / 256, M_CTX / 256, D / 256, 4, C.G, C.bid, D / 64); EpiAcc E2{&C, gate_ptr(C, l, 1, 0)}; gemm_phase(C.lds, g, S2, E2); } }
        SEAM(pb + 8);
        if (EN(18) && IN(pb + 9) && want_ctx) { REFRESH(); ph_ctxfix(C, gs_ptr(C, l, 2, 0), rowss_ptr(C, l, 2)); }
        SEAM(pb + 9);
        if (EN(15) && IN(pb + 10)) { REFRESH();
            Gemm g{AP, wl(C, l, OFF_W2GU), D, D, D, 0, 0}; Order S; S.init(mrows_out / 256, 2 * FF / 256, 1, C.G, C.bid, D / 64);
            EpiGU E{rowss_ptr(C, l, 2), bias_ptr(C, l, 2), Hb, mrows_out}; gemm_phase(C.lds, g, S, E);
            if (EN(1) && l + 1 < NL) { REFRESH(); const int r = S.total % C.G;
                if ((int)C.bid >= r) conv_weights(C, l + 1, (C.bid - r) * NW + C.wave, (C.G - r) * NW, CI_X1, CI_LAYER); } }
        SEAM(pb + 10);
        if (EN(16) && IN(pb + 11)) { REFRESH();
            Gemm g{Hb, wl(C, l, OFF_W2D), FF, FF, FF, 0, 0}; Order S; S.init(M_LAT / 256, D / 256, 1, C.G, C.bid, FF / 64);
            const bool more = l + 1 < NL;
            EpiRes E{&C, gate_ptr(C, l, 2, 0), more ? gs_ptr(C, l + 1, 0, 0) : nullptr, more ? rowss_ptr(C, l + 1, 0) : nullptr, AP}; gemm_phase(C.lds, g, S, E);
            if (want_ctx) { REFRESH(); Order S2; S2.init_split(M_LAT / 256, M_CTX / 256, D / 256, 4, C.G, C.bid, FF / 64); EpiAcc E2{&C, gate_ptr(C, l, 2, 0)}; gemm_phase(C.lds, g, S2, E2); } }
        SEAM(pb + 11);
        if (EN(18) && IN(pb + 12) && want_ctx) { REFRESH(); ph_ctxfix(C, gs_ptr(C, l + 1, 0, 0), rowss_ptr(C, l + 1, 0)); }
        SEAM(pb + 12);
    }
#undef IN
#undef SEAM
}

#ifndef MK_PER_PHASE
#define MK_PER_PHASE 0
#endif
#ifdef EMU
int g_emu_grid = 4, g_emu_lo = 0, g_emu_hi = NPH;
#endif
extern "C" void kernel_launch(void* const* d_in, const int* in_sizes, int n_in, void* d_out, int out_size, void* d_ws, size_t ws_size, hipStream_t stream) {
    Args a{};
    for (int i = 0; i < 42; ++i) a.in[i] = (const float*)d_in[i];
    a.out = (float*)d_out; a.ws = (unsigned char*)d_ws;
#ifdef EMU
    if (g_emu_lo == 0) hipMemsetAsync(d_ws, 0, WS_ZERO_END, stream);
    for (int ph = g_emu_lo; ph < g_emu_hi; ++ph) { a.ph_lo = ph; a.ph_hi = ph + 1; fprintf(stderr, "phase %d\n", ph); emu::launch(g_emu_grid, NTHR, LDS_BYTES, [=] { fwd(a); }); }
#else
    static int grid = 0;
    if (grid == 0) {
        if (n_in != 42 || out_size != M_LAT * D || ws_size < WS_END) { fprintf(stderr, "kernel_launch: unexpected shapes (n_in %d out %d ws %zu need %zu)\n", n_in, out_size, ws_size, (size_t)WS_END); grid = -1; return; }
        int dev = 0, cus = 0;
        if (hipGetDevice(&dev) != hipSuccess || hipDeviceGetAttribute(&cus, hipDeviceAttributeMultiprocessorCount, dev) != hipSuccess) { grid = -1; return; }
        if (hipFuncSetAttribute((const void*)fwd, hipFuncAttributeMaxDynamicSharedMemorySize, LDS_BYTES) != hipSuccess) { fprintf(stderr, "kernel_launch: hipFuncSetAttribute failed\n"); grid = -1; return; }
        int per_cu = 0; (void)hipOccupancyMaxActiveBlocksPerMultiprocessor(&per_cu, (const void*)fwd, NTHR, LDS_BYTES); (void)hipGetLastError();
        if (per_cu < 1) fprintf(stderr, "kernel_launch: occupancy query reports %d\n", per_cu);
        grid = cus;
    }
    if (grid < 0) return;
    (void)hipMemsetAsync(d_ws, 0, WS_ZERO_END, stream);
#if MK_PER_PHASE
    for (int ph = 0; ph < NPH; ++ph) { a.ph_lo = ph; a.ph_hi = ph + 1; hipLaunchKernelGGL(fwd, dim3(grid), dim3(NTHR), LDS_BYTES, stream, a); }
#else
    a.ph_lo = 0; a.ph_hi = NPH;
    hipLaunchKernelGGL(fwd, dim3(grid), dim3(NTHR), LDS_BYTES, stream, a);
#endif
#endif
}
```

```cpp
#ifdef EMU
#include "emu/emu.h"
#define LAS
#define GAS
#define ASMV(...) ((void)0)
#define WSYNC() do { int _z = 0; (void)emu::wave_gather(&_z, 4); } while (0)
#define OPAQUE(x) ((void)0)
#define OPAQUE_S(x) ((void)0)
#define PIN(x) ((void)0)
#define PIN4(a, b, c, d) ((void)0)
#define OPAQUE_LDS(p) (p)
#else
#include <hip/hip_runtime.h>
#include <cstdio>
#include <cstdint>
#define LAS __attribute__((address_space(3)))
#define GAS __attribute__((address_space(1)))
#define ASMV(...) asm volatile(__VA_ARGS__)
#define PIN(x) asm volatile("" : "+v"(x) :: "memory")
#define PIN4(a, b, c, d) asm volatile("" : "+v"(a), "+v"(b), "+v"(c), "+v"(d) :: "memory")
template <class P> __device__ __forceinline__ P opaque_lds(P p) { unsigned a = (unsigned)(size_t)p; asm volatile("" : "+v"(a)); return (P)(size_t)a; }
#define OPAQUE_LDS(p) opaque_lds(p)
#define OPAQUE_S(x) asm volatile("" : "+s"(x))
#define OPAQUE(x) asm volatile("" : "+v"(x))
#define WSYNC() asm volatile("s_waitcnt lgkmcnt(0)" ::: "memory")
#endif

#ifdef EMU
constexpr int D = 1024, NB = 2, T = 1024, NL = 2, TC = 256, FF = 1024;
#else
constexpr int D = 2048, NB = 2, T = 8192, NL = 4, TC = 256, FF = 5632;
#endif
constexpr int GW = D / 4, NH = GW / 64, WAG = NH / 2, S5G = GW / 16, GRW = 64, GRH = T / GRW;
constexpr int M_LAT = NB * T, M_CTX = NB * TC, M = M_LAT + M_CTX, NPAN = M / 256;
constexpr int TP = GW / 256;
constexpr int NT_IN = 8 * TP + 2, NINP = NT_IN * 256, D_IN = 8 * GW + 416;
constexpr int PN_AQ = 0, PN_AK = TP, PN_AV = 2 * TP, PN_BR = 3 * TP, PN_BK = 4 * TP, PN_BV = 5 * TP, PN_BS = 6 * TP, PN_CQ = 6 * TP + 1, PN_CKV = 7 * TP + 1, PN_DU = 7 * TP + 2;
constexpr int SRC_AQ = 0, SRC_AK = GW, SRC_AV = 2 * GW, SRC_BR = 3 * GW, SRC_BK = 4 * GW, SRC_BV = 5 * GW, SRC_BS = 6 * GW, SRC_CQ = 6 * GW + 160, SRC_CK = 7 * GW + 160, SRC_CV = 7 * GW + 288, SRC_DU = 7 * GW + 416;
constexpr int S5L = 32, NCH = M / S5L, NCHP = ((NCH + 255) / 256) * 256, S5K = 768;
constexpr int NW = 8, NTHR = 512;
constexpr float NORM_EPS = 1e-6f, RW_GN_EPS = 64e-5f;

typedef unsigned short bf16;
typedef short bf16x8 __attribute__((ext_vector_type(8)));
typedef short s16x4 __attribute__((ext_vector_type(4)));
typedef float f32x4 __attribute__((ext_vector_type(4)));
typedef float f32x2 __attribute__((ext_vector_type(2)));
typedef float f32x16 __attribute__((ext_vector_type(16)));
typedef unsigned u32x4 __attribute__((ext_vector_type(4)));
typedef unsigned u32x2 __attribute__((ext_vector_type(2)));
#define DI __device__ __forceinline__

constexpr size_t al256(size_t x) { return (x + 255) & ~(size_t)255; }
constexpr size_t SZ_BIAS_GU = (size_t)3 * 2 * FF * 4, SZ_BIAS_IN = (size_t)3 * NINP * 4;
constexpr size_t WS_CTL = 0;
constexpr size_t WS_BIAS = 65536;
constexpr size_t SZ_BIAS_L = 2 * SZ_BIAS_GU + SZ_BIAS_IN;
constexpr size_t WS_ROWSS = al256(WS_BIAS + NL * SZ_BIAS_L);
constexpr size_t WS_ZERO_END = al256(WS_ROWSS + (size_t)NL * 3 * M * 4);
constexpr size_t WS_MODV = WS_ZERO_END;
constexpr size_t WS_GS = al256(WS_MODV + (size_t)NL * 3 * 9 * D * 4);
constexpr size_t WS_GATE = al256(WS_GS + (size_t)NL * 9 * D * 4);
constexpr size_t WS_ROPE = al256(WS_GATE + (size_t)NL * 9 * D * 4);
constexpr size_t SZ_WGU = (size_t)2 * FF * D * 2, SZ_WD = (size_t)D * FF * 2, SZ_WIN = (size_t)NINP * D * 2, SZ_WOUT = (size_t)D * D * 2, SZ_WGLU = (size_t)GW * GW * 2;
constexpr size_t OFF_W1GU = 0, OFF_W1D = OFF_W1GU + SZ_WGU, OFF_WIN = OFF_W1D + SZ_WD, OFF_WOUT = OFF_WIN + SZ_WIN, OFF_W2GU = OFF_WOUT + SZ_WOUT, OFF_W2D = OFF_W2GU + SZ_WGU, OFF_WGLU = OFF_W2D + SZ_WD, SZ_WL = OFF_WGLU + SZ_WGLU;
constexpr size_t WS_W = al256(WS_ROPE + 128 * 16 * 8);
constexpr size_t SZ_S5KC = (size_t)S5G * 2 * S5L * 256 * 4, SZ_S5ET = (size_t)S5G * 256 * 512 * 2, SZ_S5BT = (size_t)S5G * 512 * S5K * 2, SZ_S5LAM = (size_t)2 * GW * 4 * 8;
constexpr size_t SZ_S5LP = (size_t)2 * S5G * 64 * (S5L + 1) * 8, SZ_S5BETA = (size_t)2 * S5G * 64 * 16 * 8;
constexpr size_t OFF_S5KC = 0, OFF_S5ET = OFF_S5KC + SZ_S5KC, OFF_S5BT = OFF_S5ET + SZ_S5ET, OFF_S5LAM = OFF_S5BT + SZ_S5BT, OFF_S5LP = al256(OFF_S5LAM + SZ_S5LAM), OFF_S5BETA = OFF_S5LP + SZ_S5LP, SZ_S5L = al256(OFF_S5BETA + SZ_S5BETA);
constexpr size_t WS_S5T = al256(WS_W + NL * SZ_WL);
constexpr size_t WS_XC = al256(WS_S5T + NL * SZ_S5L);
constexpr size_t WS_AP = al256(WS_XC + (size_t)M_CTX * D * 4);
constexpr size_t WS_H = al256(WS_AP + (size_t)M * D * 2);
constexpr size_t WS_QA = al256(WS_H + (size_t)M * FF * 2);
constexpr size_t WS_KA = WS_QA + (size_t)M * GW * 2, WS_VA = WS_KA + (size_t)M * GW * 2, WS_QC = WS_VA + (size_t)M * GW * 2;
constexpr size_t WS_KC = WS_QC + (size_t)M * GW * 2, WS_VC = WS_KC + (size_t)M * 128 * 2;
constexpr size_t WS_PB = WS_VC + (size_t)M * 128 * 2;
constexpr size_t WS_PS = al256(WS_PB + (size_t)M * 3 * GW * 2);
constexpr size_t WS_UG = al256(WS_PS + (size_t)M * 160 * 4);
constexpr size_t WS_RW = al256(WS_UG + (size_t)S5G * NCHP * S5K * 2);
constexpr size_t SZ_RWA = (size_t)M * GW * 4;
enum { RW_R = 0, RW_V, RW_NKK, RW_G, RW_W0, RW_W1, RW_K0, RW_K1, RW_B0, RW_B1, RW_Y0, RW_Y1, RW_NARR };
constexpr size_t WS_XEND = al256(WS_RW + 256);
constexpr size_t WS_YG = al256(WS_XEND + (size_t)S5G * NCHP * 256 * 4);
constexpr size_t WS_OB = al256(WS_YG + (size_t)M * GW * 2);
constexpr int RCK = (TC + T) / 64, RSTR = NB * NH * 2, RITEM = RSTR * RCK;
constexpr size_t WS_QH = al256(WS_OB + (size_t)M * D * 2);
constexpr size_t WS_YL = al256(WS_QH + (size_t)RITEM * 8192);
constexpr size_t WS_MF = al256(WS_YL + (size_t)RITEM * 16384);
constexpr size_t WS_GF = al256(WS_MF + (size_t)RITEM * 8192);
constexpr size_t WS_SF = al256(WS_GF + (size_t)RITEM * 16384);
constexpr int RBLK = NB * NH * ((TC + T) / 64);
constexpr size_t WS_RVKG = al256(WS_SF + (size_t)RITEM * 8192);
constexpr size_t SZ_RWF = (size_t)14 * NH * 2 * 64 * 16;
constexpr size_t WS_RWF = al256(WS_RVKG + (size_t)RBLK * 32768);
constexpr size_t WS_RWS = al256(WS_RWF + NL * SZ_RWF);
constexpr size_t WS_END = al256(WS_RWS + (size_t)512 * 2 * 65536);
constexpr int CW_BAR = 1024;

constexpr int LDS_BYTES = 147456, RING_BYTES = 131072, MISC_OFF = LDS_BYTES - 256;

DI unsigned f2bf(float f) { unsigned u = __float_as_uint(f); return (u + 0x7fffu + ((u >> 16) & 1u)) >> 16; }
#ifdef EMU
DI unsigned pk2(float lo, float hi) { return f2bf(lo) | (f2bf(hi) << 16); }
#else
typedef __bf16 hbf16x2 __attribute__((ext_vector_type(2)));
DI unsigned pk2(float lo, float hi) { const f32x2 v = {lo, hi}; const hbf16x2 b = __builtin_convertvector(v, hbf16x2); return __builtin_bit_cast(unsigned, b); }
#endif
DI float bf2f(unsigned short b) { return __uint_as_float(((unsigned)b) << 16); }
DI float bflo(unsigned w) { return __uint_as_float(w << 16); }
DI float bfhi(unsigned w) { return __uint_as_float(w & 0xffff0000u); }
template <int N> DI float ror_add(float v) { return v + __int_as_float(__builtin_amdgcn_mov_dpp(__float_as_int(v), 0x120 + N, 0xf, 0xf, true)); }
DI float row16_sum(float v) { v = ror_add<8>(v); v = ror_add<4>(v); v = ror_add<2>(v); v = ror_add<1>(v); return v; }
DI float wave_sum(float v) {
    v = row16_sum(v);
    const float a = __int_as_float(__builtin_amdgcn_readlane(__float_as_int(v), 0)), b = __int_as_float(__builtin_amdgcn_readlane(__float_as_int(v), 16)),
                c = __int_as_float(__builtin_amdgcn_readlane(__float_as_int(v), 32)), d = __int_as_float(__builtin_amdgcn_readlane(__float_as_int(v), 48));
    return (a + b) + (c + d);
}
DI float siluf(float x) { return x * __builtin_amdgcn_rcpf(1.f + __expf(-x)); }
DI float fast_tanh(float x) { const float e = __expf(2.f * x); return 1.f - 2.f * __builtin_amdgcn_rcpf(e + 1.f); }
DI float sigmf(float x) { return __builtin_amdgcn_rcpf(1.f + __expf(-x)); }
DI float geluf(float x) { const float z = 0.7978845608028654f * (x + 0.044715f * x * x * x); const float e = __expf(2.f * z); return 0.5f * x * (1.f + (1.f - 2.f * __builtin_amdgcn_rcpf(e + 1.f))); }
DI int stream_of_row(int row) { return row < M_LAT ? row / T : NB; }
DI int stream_of_panel(int pm) { return stream_of_row(pm * 256); }

#define XB_TMO      128
#define XB_XCNT(j)  (256  + 64 * (j))
#define XB_XSUB(j)  (1280 + 64 * (j))
#define XB_XGEN(j)  (2304 + 64 * (j))
#define XB_TOP      3328
#define XB_TOPGEN   3392
#define XCD_BAR_WORDS 3456
#define XB_SPIN_CAP (1u << 18)
DI unsigned xb_ld(unsigned* p)              { return __hip_atomic_load(p, __ATOMIC_RELAXED, __HIP_MEMORY_SCOPE_AGENT); }
DI unsigned xb_add(unsigned* p, unsigned v) { return __hip_atomic_fetch_add(p, v, __ATOMIC_RELAXED, __HIP_MEMORY_SCOPE_AGENT); }
DI unsigned xb_xcc_id() { return (unsigned)__builtin_amdgcn_s_getreg((3 << 11) | 20) & 0xFu; }
#define XB_SPIN(cond, bar) do { unsigned _sp = 0; while (cond) { __builtin_amdgcn_s_sleep(1); \
    if ((++_sp & 255u) == 0u) { if (xb_ld(&(bar)[XB_TMO])) break; if (_sp > XB_SPIN_CAP) { atomicAdd(&(bar)[XB_TMO], 1u); break; } } } } while (0)
struct XcdBarrier { unsigned* bar; unsigned x; volatile LAS unsigned* st; };
DI XcdBarrier xcd_barrier_post(unsigned* bar, volatile LAS unsigned* st) {
    XcdBarrier b; b.bar = bar; b.x = xb_xcc_id(); b.st = st;
    if (threadIdx.x == 0) (void)xb_add(&bar[XB_XCNT(b.x)], 1u);
    return b;
}
DI void xcd_barrier_complete(unsigned* bar, unsigned x, unsigned& nloc, unsigned& nx) {
    const unsigned G = gridDim.x * gridDim.y * gridDim.z;
    unsigned sum, cnt, mine, sp = 0u;
    for (;;) {
        sum = 0u; cnt = 0u; mine = 0u;
#pragma unroll
        for (unsigned j = 0; j < 16; ++j) { const unsigned c = xb_ld(&bar[XB_XCNT(j)]); sum += c; cnt += (c > 0u) ? 1u : 0u; mine = (j == x) ? c : mine; }
        if (sum == G) break;
        __builtin_amdgcn_s_sleep(1);
        if ((++sp & 255u) == 0u) { if (xb_ld(&bar[XB_TMO])) break; if (sp > XB_SPIN_CAP) { atomicAdd(&bar[XB_TMO], 1u); break; } }
    }
    nloc = mine > 0u ? mine : 1u; nx = cnt > 0u ? cnt : 1u;
}
DI void xcd_barrier(const XcdBarrier& b) {
    ASMV("s_waitcnt vmcnt(0)" ::: "memory");
    __syncthreads();
    if (threadIdx.x == 0) {
        unsigned* bar = b.bar;
        __builtin_amdgcn_s_waitcnt(0);
        unsigned nloc = b.st[0], nx = b.st[1];
        if (nloc == 0u) { xcd_barrier_complete(bar, b.x, nloc, nx); b.st[0] = nloc; b.st[1] = nx; }
        const unsigned old = xb_add(&bar[XB_XSUB(b.x)], 1u);
        const unsigned gen = old / nloc;
        if (old + 1u == (gen + 1u) * nloc) {
            __builtin_amdgcn_fence(__ATOMIC_RELEASE, "agent");
            ASMV("s_waitcnt vmcnt(0)" ::: "memory");
            const unsigned og = xb_add(&bar[XB_TOP], 1u);
            const unsigned tg = og / nx;
            if (og + 1u == (tg + 1u) * nx) xb_add(&bar[XB_TOPGEN], 1u);
            else XB_SPIN(xb_ld(&bar[XB_TOPGEN]) == tg, bar);
            __builtin_amdgcn_fence(__ATOMIC_ACQUIRE, "agent");
            xb_add(&bar[XB_XGEN(b.x)], 1u);
            ASMV("s_waitcnt vmcnt(0)" ::: "memory");
        } else {
            XB_SPIN(xb_ld(&bar[XB_XGEN(b.x)]) == gen, bar);
            __builtin_amdgcn_fence(__ATOMIC_ACQUIRE, "agent");
            ASMV("s_waitcnt vmcnt(0)" ::: "memory");
        }
    }
    __syncthreads();
}

constexpr int BK = 64, HALF = 128, HTB = HALF * BK * 2, NXCD = 8, WGM = 4;
DI int lds_byte(int r, int c) { const int st = (r >> 4) * 2 + (c >> 5), rr = r & 15, cc = c & 31, ob = rr * 64 + cc * 2; return st * 1024 + (ob ^ (((ob >> 9) & 1) << 5)); }
DI void stage_rc(int b, int& R, int& C) { const int st = b / 1024, sb = b % 1024, swz = sb ^ (((sb >> 9) & 1) << 5); R = (st >> 1) * 16 + swz / 64; C = (st & 1) * 32 + (swz % 64) / 2; }
struct Unit { int pm, pn, z, kt0; };
struct Gemm { const bf16* A; const bf16* Bt; int lda, ldb, K; size_t zA, zB; };
struct Order {
    int nM, nN, nZ, per, total, G, c, nkt, pm0, spl;
    DI void init(int nM_, int nN_, int nZ_, int G_, int c_, int nkt_) { nM = nM_; nN = nN_; nZ = nZ_; per = nM * nN; total = per * nZ; G = G_; c = c_; nkt = nkt_; pm0 = 0; spl = 0; }
    DI void init_split(int pm0_, int xM, int nN_, int spl_, int G_, int c_, int nkt_full) { nM = xM; nN = nN_; nZ = 1; per = xM * nN_ * spl_; total = per; G = G_; c = c_; nkt = nkt_full / spl_; pm0 = pm0_; spl = spl_; }
    DI bool next(int i, Unit& u) const {
        const long L = (long)i * G + c; if (L >= total) return false;
        if (spl) { const int j = (int)L; u.z = 0; u.pm = pm0 + j / (nN * spl); const int rem = j % (nN * spl); u.pn = rem / spl; u.kt0 = (rem % spl) * nkt; return true; }
        u.kt0 = 0;
        u.z = (int)(L / per); int wgid = (int)(L % per);
        { const int q = per / NXCD, r = per % NXCD, xcd = wgid % NXCD, off = wgid / NXCD; wgid = (xcd < r ? xcd * (q + 1) : r * (q + 1) + (xcd - r) * q) + off; }
        const int nig = WGM * nN, gid = wgid / nig, fm = gid * WGM, gsz = (nM - fm) < WGM ? (nM - fm) : WGM;
        u.pm = fm + ((wgid % nig) % gsz); u.pn = (wgid % nig) / gsz; return true;
    }
};

template <class Epi>
DI void gemm_phase(LAS unsigned char* lds, const Gemm g, const Order& S, const Epi& E) {
    int tid_ = threadIdx.x; OPAQUE(tid_);
    const int tid = tid_, wid = __builtin_amdgcn_readfirstlane(tid >> 6), lane = tid & 63, wr = wid >> 2, wc = wid & 3, fr = lane & 15, fq = lane >> 4;
    Unit cur, nxt; int ui = 0;
    if (!S.next(0, cur)) return;
    f32x4 acc[2][2][4][2];
#ifdef EMU
    (void)lds;
    for (;; ++ui) {
        if (ui > 0) { if (!S.next(ui, cur)) break; }
        const bf16* A = (const bf16*)((const char*)g.A + cur.z * g.zA); const bf16* B = (const bf16*)((const char*)g.Bt + cur.z * g.zB);
        for (int ai = 0; ai < 2; ++ai) for (int bj = 0; bj < 2; ++bj) for (int m = 0; m < 4; ++m) for (int n = 0; n < 2; ++n) for (int j = 0; j < 4; ++j) {
            const int r = 256 * cur.pm + 128 * ai + 64 * wr + 16 * m + fr, c = 256 * cur.pn + 128 * bj + 32 * wc + 16 * n + 4 * fq + j;
            const bf16* a = A + (size_t)r * g.lda; const bf16* b = B + (size_t)c * g.ldb; float s = 0.f;
            for (int k = cur.kt0 * BK; k < (cur.kt0 + S.nkt) * BK; ++k) s += bf2f(a[k]) * bf2f(b[k]);
            acc[ai][bj][m][n][j] = s; }
        E(acc, cur, wr, wc, fr, fq);
    }
#else
    unsigned voffA[2], voffB[2];
#pragma unroll
    for (int i = 0; i < 2; ++i) { int R, C; stage_rc(tid * 16 + i * 8192, R, C); voffA[i] = (unsigned)(R * g.lda + C) * 2u; voffB[i] = (unsigned)(R * g.ldb + C) * 2u; }
    const size_t kstep = (size_t)(BK * 2);
    const size_t hstepA = (size_t)HALF * g.lda * 2, hstepB = (size_t)HALF * g.ldb * 2, tstepA = 2 * hstepA, tstepB = 2 * hstepB;
    const unsigned ldsw = (unsigned)wid * 1024u;
    const int aoff = lds_byte(wr * 64 + fr, fq * 8), boff = lds_byte(wc * 32 + fr, fq * 8);
#define PG8_SA(b, h) (((b) * 2 + (h)) * HTB)
#define PG8_SB(b, h) ((4 + (b) * 2 + (h)) * HTB)
#define PG8_STAGE(bufoff, gbase, voff) do { _Pragma("unroll") for (int _i = 0; _i < 2; ++_i) \
        __builtin_amdgcn_global_load_lds((const unsigned*)((const char*)(gbase) + (voff)[_i]), (LAS unsigned*)(lds + (bufoff) + ldsw + _i * 8192), 16, 0, 0); } while (0)
#define PG8_LDA(dst, b, h) do { _Pragma("unroll") for (int m = 0; m < 4; ++m) _Pragma("unroll") for (int k = 0; k < 2; ++k) dst[m][k] = *(const LAS bf16x8*)(lds + PG8_SA(b, h) + aoff + m * 2048 + k * 1024); } while (0)
#define PG8_LDB(dst, b, h) do { _Pragma("unroll") for (int n = 0; n < 2; ++n) _Pragma("unroll") for (int k = 0; k < 2; ++k) dst[n][k] = *(const LAS bf16x8*)(lds + PG8_SB(b, h) + boff + n * 2048 + k * 1024); } while (0)
#define PG8_MMA(ai, bj, At, Bt) do { __builtin_amdgcn_s_setprio(1); _Pragma("unroll") for (int m = 0; m < 4; ++m) _Pragma("unroll") for (int n = 0; n < 2; ++n) _Pragma("unroll") for (int k = 0; k < 2; ++k) \
        acc[ai][bj][m][n] = __builtin_amdgcn_mfma_f32_16x16x32_bf16(Bt[n][k], At[m][k], acc[ai][bj][m][n], 0, 0, 0); __builtin_amdgcn_s_setprio(0); } while (0)
#define PG8_WAIT_V(n) asm volatile("s_waitcnt vmcnt(" #n ")" ::: "memory")
#define PG8_WAIT_L(n) asm volatile("s_waitcnt lgkmcnt(" #n ")" ::: "memory")
#define PG8_BAR __builtin_amdgcn_s_barrier()
#define PG8_SCHED __builtin_amdgcn_sched_barrier(0)
#pragma unroll
    for (int a = 0; a < 2; ++a)
#pragma unroll
        for (int b = 0; b < 2; ++b)
#pragma unroll
            for (int m = 0; m < 4; ++m)
#pragma unroll
                for (int n = 0; n < 2; ++n) acc[a][b][m][n] = (f32x4){0.f, 0.f, 0.f, 0.f};
    bf16x8 At[4][2], B0[2][2], B1[2][2];
    const char* cA = (const char*)g.A + (size_t)cur.z * g.zA + (size_t)cur.pm * tstepA + (size_t)cur.kt0 * kstep; const char* cB = (const char*)g.Bt + (size_t)cur.z * g.zB + (size_t)cur.pn * tstepB + (size_t)cur.kt0 * kstep;
    PG8_STAGE(PG8_SB(0, 0), cB, voffB); PG8_STAGE(PG8_SB(0, 1), cB + hstepB, voffB); PG8_STAGE(PG8_SA(0, 0), cA, voffA); PG8_STAGE(PG8_SA(0, 1), cA + hstepA, voffA);
    if (wr == 1) PG8_BAR;
    PG8_WAIT_V(2); PG8_BAR;
    PG8_STAGE(PG8_SB(1, 0), cB + kstep, voffB); PG8_STAGE(PG8_SA(1, 0), cA + kstep, voffA); PG8_STAGE(PG8_SB(1, 1), cB + hstepB + kstep, voffB);
    PG8_WAIT_V(6); PG8_BAR;
    for (;;) {
        const bool has_next = S.next(ui + 1, nxt);
        const char* nA = has_next ? (const char*)g.A + (size_t)nxt.z * g.zA + (size_t)nxt.pm * tstepA + (size_t)nxt.kt0 * kstep : cA; const char* nB = has_next ? (const char*)g.Bt + (size_t)nxt.z * g.zB + (size_t)nxt.pn * tstepB + (size_t)nxt.kt0 * kstep : cB;
        const int nt = S.nkt;
        for (int t = 0; t < nt; t += 2) {
            const bool last = (t == nt - 2);
            const char* a1 = cA + (size_t)(t + 1) * kstep;
            const char* a2 = last ? nA : cA + (size_t)(t + 2) * kstep; const char* b2 = last ? nB : cB + (size_t)(t + 2) * kstep;
            const char* a3 = a2 + kstep; const char* b3 = b2 + kstep;
            PG8_LDB(B0, 0, 0); PG8_LDB(B1, 0, 1); PG8_SCHED; PG8_LDA(At, 0, 0); PG8_STAGE(PG8_SA(1, 1), a1 + hstepA, voffA);
            PG8_WAIT_V(8); PG8_WAIT_L(0); PG8_BAR; PG8_MMA(0, 0, At, B0); PG8_MMA(0, 1, At, B1); PG8_BAR; PG8_SCHED;
            PG8_LDA(At, 0, 1); PG8_STAGE(PG8_SB(0, 0), b2, voffB); PG8_STAGE(PG8_SB(0, 1), b2 + hstepB, voffB); PG8_STAGE(PG8_SA(0, 0), a2, voffA);
            PG8_WAIT_V(8); PG8_WAIT_L(0); PG8_BAR; PG8_MMA(1, 0, At, B0); PG8_MMA(1, 1, At, B1); PG8_BAR; PG8_SCHED;
            PG8_LDB(B0, 1, 0); PG8_LDB(B1, 1, 1); PG8_SCHED; PG8_LDA(At, 1, 0); PG8_STAGE(PG8_SA(0, 1), a2 + hstepA, voffA);
            PG8_WAIT_V(8); PG8_WAIT_L(0); PG8_BAR; PG8_MMA(0, 0, At, B0); PG8_MMA(0, 1, At, B1); PG8_BAR; PG8_SCHED;
            PG8_LDA(At, 1, 1); PG8_STAGE(PG8_SB(1, 0), b3, voffB); PG8_STAGE(PG8_SB(1, 1), b3 + hstepB, voffB); PG8_STAGE(PG8_SA(1, 0), a3, voffA);
            PG8_WAIT_V(8); PG8_WAIT_L(0); PG8_BAR; PG8_MMA(1, 0, At, B0); PG8_MMA(1, 1, At, B1); PG8_BAR; PG8_SCHED;
        }
        if (wr == 0) PG8_BAR;
        E(acc, cur, wr, wc, fr, fq);
        if (!has_next) break;
#pragma unroll
        for (int a = 0; a < 2; ++a)
#pragma unroll
            for (int b = 0; b < 2; ++b)
#pragma unroll
                for (int m = 0; m < 4; ++m)
#pragma unroll
                    for (int n = 0; n < 2; ++n) acc[a][b][m][n] = (f32x4){0.f, 0.f, 0.f, 0.f};
        cur = nxt; cA = nA; cB = nB; ++ui;
        if (wr == 1) PG8_BAR;
    }
    PG8_WAIT_V(0);
    PG8_BAR;
#undef PG8_SA
#undef PG8_SB
#undef PG8_STAGE
#undef PG8_LDA
#undef PG8_LDB
#undef PG8_MMA
#undef PG8_WAIT_V
#undef PG8_WAIT_L
#undef PG8_BAR
#undef PG8_SCHED
#endif
}

struct Args {
    const float* in[42]; float* out; unsigned char* ws;
    int ph_lo, ph_hi;
};
struct Ctx {
    const float* const* in; float* out; unsigned char* ws;
    LAS unsigned char* lds; int tid, lane, wave, G, bid;
};
DI float* xrow_ptr(const Ctx& C, int row) { return row < M_LAT ? C.out + (size_t)row * D : (float*)(C.ws + WS_XC) + (size_t)(row - M_LAT) * D; }
DI const bf16* wl(const Ctx& C, int l, size_t off) { return (const bf16*)(C.ws + WS_W + (size_t)l * SZ_WL + off); }
DI float* bias_ptr(const Ctx& C, int l, int which  ) { return (float*)(C.ws + WS_BIAS + (size_t)l * SZ_BIAS_L + (which == 0 ? 0 : which == 1 ? SZ_BIAS_GU : SZ_BIAS_GU + SZ_BIAS_IN)); }
DI float* rowss_ptr(const Ctx& C, int l, int sub) { return (float*)(C.ws + WS_ROWSS) + ((size_t)l * 3 + sub) * M; }
DI const float* gs_ptr(const Ctx& C, int l, int sub, int s) { return (const float*)(C.ws + WS_GS) + (((size_t)l * 3 + sub) * 3 + s) * D; }
DI const float* gate_ptr(const Ctx& C, int l, int sub, int s) { return (const float*)(C.ws + WS_GATE) + (((size_t)l * 3 + sub) * 3 + s) * D; }
DI float* rw_arr(const Ctx& C, int a) { return (float*)(C.ws + WS_RW + (size_t)a * SZ_RWA); }
enum { I_X = 0, I_C, I_CTX, I_CCTX, I_WADA, I_BADA, I_NORMG, I_F1WG, I_F1WU, I_F1WD, I_F2WG, I_F2WU, I_F2WD, I_WIN, I_WOUT, I_NAQG, I_NAKG, I_NARPB, I_RWCONV, I_RWW0, I_RWWUP, I_RWA0, I_RWAUP,
       I_RWGUP, I_RWKK, I_RWKA, I_RWRK, I_RWGNW, I_RWGNB, I_WAQG, I_WAKG, I_WASINK, I_S5ARE, I_S5AIM, I_S5LDT, I_S5BRE, I_S5BIM, I_S5CRE, I_S5CIM, I_S5D, I_S5GLUW, I_S5GLUB, I_NIN };

struct EpiGU {
    const float* rowss; const float* bias  ; bf16* H; int mrows;
    DI void operator()(const f32x4 (&acc)[2][2][4][2], const Unit& u, int wr, int wc, int fr_, int fq_) const {
        int tz_ = threadIdx.x; OPAQUE(tz_); const int fr = tz_ & 15, fq = (tz_ & 63) >> 4; (void)fr_; (void)fq_;
        const int s = stream_of_panel(u.pm); const float* bs = bias + (size_t)s * 2 * FF + u.pn * 256 + wc * 32 + 4 * fq;
        f32x4 bg[2], bu[2];
#pragma unroll
        for (int n = 0; n < 2; ++n) { bg[n] = *(const f32x4*)(bs + 16 * n); bu[n] = *(const f32x4*)(bs + 128 + 16 * n); }
        float rsv[2][4];
#pragma unroll
        for (int ai = 0; ai < 2; ++ai)
#pragma unroll
            for (int m = 0; m < 4; ++m) rsv[ai][m] = rowss[u.pm * 256 + ai * 128 + wr * 64 + m * 16 + fr];
#pragma unroll
        for (int ai = 0; ai < 2; ++ai)
#pragma unroll
            for (int m = 0; m < 4; ++m) {
                const int row = u.pm * 256 + ai * 128 + wr * 64 + m * 16 + fr;
                const float rstd = __builtin_amdgcn_rsqf(rsv[ai][m] * (1.0f / D) + NORM_EPS);
                bf16* hp = H + (size_t)row * FF + u.pn * 128 + wc * 32 + 8 * fq;
                u32x4 w;
                { const f32x4 g = acc[ai][0][m][0] * rstd + bg[0], v = acc[ai][1][m][0] * rstd + bu[0]; w.x = pk2(siluf(g[0]) * v[0], siluf(g[1]) * v[1]); w.y = pk2(siluf(g[2]) * v[2], siluf(g[3]) * v[3]); }
                { const f32x4 g = acc[ai][0][m][1] * rstd + bg[1], v = acc[ai][1][m][1] * rstd + bu[1]; w.z = pk2(siluf(g[0]) * v[0], siluf(g[1]) * v[1]); w.w = pk2(siluf(g[2]) * v[2], siluf(g[3]) * v[3]); }
                *(u32x4*)hp = w;
            }
    }
};
struct EpiRes {
    const Ctx* C; const float* gate  ; const float* gsn  ; float* rowss_next; bf16* AP;
    DI void operator()(const f32x4 (&acc)[2][2][4][2], const Unit& u, int wr, int wc, int fr_, int fq_) const {
        int tz_ = threadIdx.x; OPAQUE(tz_); const int fr = tz_ & 15, fq = (tz_ & 63) >> 4; (void)fr_; (void)fq_;
        const int s = stream_of_panel(u.pm); const int col0 = u.pn * 256 + wc * 32 + 4 * fq;
        f32x4 gv[2][2], sv[2][2];
#pragma unroll
        for (int bj = 0; bj < 2; ++bj)
#pragma unroll
            for (int n = 0; n < 2; ++n) { gv[bj][n] = *(const f32x4*)(gate + (size_t)s * D + col0 + bj * 128 + n * 16); sv[bj][n] = gsn ? *(const f32x4*)(gsn + (size_t)s * D + col0 + bj * 128 + n * 16) : (f32x4){0.f, 0.f, 0.f, 0.f}; }
        f32x4 xc[2][2], xn[2][2];
        { const float* xp0 = xrow_ptr(*C, u.pm * 256 + wr * 64 + fr) + col0;
#pragma unroll
          for (int bj = 0; bj < 2; ++bj)
#pragma unroll
              for (int n = 0; n < 2; ++n) xn[bj][n] = *(const f32x4*)(xp0 + bj * 128 + n * 16); }
#pragma unroll
        for (int ai = 0; ai < 2; ++ai)
#pragma unroll
            for (int m = 0; m < 4; ++m) {
                const int row = u.pm * 256 + ai * 128 + wr * 64 + m * 16 + fr;
                float* xp = xrow_ptr(*C, row) + col0; float ss = 0.f;
#pragma unroll
                for (int bj = 0; bj < 2; ++bj)
#pragma unroll
                    for (int n = 0; n < 2; ++n) xc[bj][n] = xn[bj][n];
                if (ai * 4 + m < 7) { const int rn = ai * 4 + m + 1; const float* xq = xrow_ptr(*C, u.pm * 256 + (rn >> 2) * 128 + wr * 64 + (rn & 3) * 16 + fr) + col0;
#pragma unroll
                    for (int bj = 0; bj < 2; ++bj)
#pragma unroll
                        for (int n = 0; n < 2; ++n) xn[bj][n] = *(const f32x4*)(xq + bj * 128 + n * 16); }
#pragma unroll
                for (int bj = 0; bj < 2; ++bj)
#pragma unroll
                    for (int n = 0; n < 2; ++n) { f32x4 x = xc[bj][n]; x += gv[bj][n] * acc[ai][bj][m][n]; *(f32x4*)(xp + bj * 128 + n * 16) = x;
                        if (gsn) { ss += (x[0] * x[0] + x[1] * x[1]) + (x[2] * x[2] + x[3] * x[3]); const f32x4 a = x * sv[bj][n]; u32x2 w; w.x = pk2(a[0], a[1]); w.y = pk2(a[2], a[3]);
                            *(u32x2*)(AP + (size_t)row * D + col0 + bj * 128 + n * 16) = w; } }
                if (gsn) { ss += __shfl_xor(ss, 16); ss += __shfl_xor(ss, 32); if (fq == 0) atomicAdd(rowss_next + row, ss); }
            }
    }
};
struct EpiAcc {
    const Ctx* C; const float* gate;
    DI void operator()(const f32x4 (&acc)[2][2][4][2], const Unit& u, int wr, int wc, int fr_, int fq_) const {
        int tz_ = threadIdx.x; OPAQUE(tz_); const int fr = tz_ & 15, fq = (tz_ & 63) >> 4; (void)fr_; (void)fq_;
        const int s = stream_of_panel(u.pm); const int col0 = u.pn * 256 + wc * 32 + 4 * fq;
#pragma unroll
        for (int bj = 0; bj < 2; ++bj)
#pragma unroll
            for (int n = 0; n < 2; ++n) { const f32x4 gv = *(const f32x4*)(gate + (size_t)s * D + col0 + bj * 128 + n * 16);
#pragma unroll
                for (int ai = 0; ai < 2; ++ai)
#pragma unroll
                    for (int m = 0; m < 4; ++m) { float* xp = xrow_ptr(*C, u.pm * 256 + ai * 128 + wr * 64 + m * 16 + fr) + col0 + bj * 128 + n * 16; const f32x4 d = gv * acc[ai][bj][m][n];
#pragma unroll
                        for (int j = 0; j < 4; ++j) atomicAdd(xp + j, d[j]); } }
    }
};
struct EpiIn {
    const Ctx* C; const float* rowss; const float* bias  ; int l;
    DI void operator()(const f32x4 (&acc)[2][2][4][2], const Unit& u, int wr, int wc, int fr_, int fq_) const {
        int tz_ = threadIdx.x; OPAQUE(tz_); const int fr = tz_ & 15, fq = (tz_ & 63) >> 4; (void)fr_; (void)fq_;
        const int s = stream_of_panel(u.pm), pn = u.pn; const float* bs = bias + (size_t)s * NINP + pn * 256 + wc * 32 + 4 * fq;
        unsigned char* ws = C->ws;
        f32x4 bv[2][2];
#pragma unroll
        for (int bj = 0; bj < 2; ++bj)
#pragma unroll
            for (int n = 0; n < 2; ++n) bv[bj][n] = *(const f32x4*)(bs + bj * 128 + n * 16);
        float rsv[2][4];
#pragma unroll
        for (int ai = 0; ai < 2; ++ai)
#pragma unroll
            for (int m = 0; m < 4; ++m) rsv[ai][m] = rowss[u.pm * 256 + ai * 128 + wr * 64 + m * 16 + fr];
        const bool permuted = pn < PN_AV || (pn >= PN_CQ && pn < PN_DU);
        if (permuted) {
            const bool is_ckv = pn == PN_CKV, is_c = pn >= PN_CQ, is_q = pn < PN_AK || (pn >= PN_CQ && pn < PN_CKV);
            const bool plain_v = is_ckv && wc >= 2;
            const float* gsrc = C->in[is_c ? (is_q ? I_WAQG : I_WAKG) : (is_q ? I_NAQG : I_NAKG)] + (size_t)l * 64;
            f32x4 gn[2][2];
#pragma unroll
            for (int bj = 0; bj < 2; ++bj)
#pragma unroll
                for (int n = 0; n < 2; ++n) { gn[bj][n] = *(const f32x4*)(gsrc + 32 * bj + 16 * n + 4 * fq); if (is_q) gn[bj][n] *= 0.125f; }
            bf16* dst; int pitch, hcol;
            if (pn < PN_AK) { dst = (bf16*)(ws + WS_QA); pitch = GW; hcol = ((pn - PN_AQ) * 4 + wc) * 64; }
            else if (pn < PN_AV) { dst = (bf16*)(ws + WS_KA) + (size_t)((pn - PN_AK) * 4 + wc) * M * 64; pitch = 64; hcol = 0; }
            else if (pn < PN_CKV) { dst = (bf16*)(ws + WS_QC); pitch = GW; hcol = ((pn - PN_CQ) * 4 + wc) * 64; }
            else if (wc < 2) { dst = (bf16*)(ws + WS_KC) + (size_t)wc * M * 64; pitch = 64; hcol = 0; }
            else { dst = (bf16*)(ws + WS_VC) + (size_t)(wc - 2) * M * 64; pitch = 64; hcol = 0; }
            const f32x4* rope = (const f32x4*)(ws + WS_ROPE);
#pragma unroll
            for (int ai = 0; ai < 2; ++ai)
#pragma unroll
                for (int m = 0; m < 4; ++m) {
                    const int row = pn * 0 + u.pm * 256 + ai * 128 + wr * 64 + m * 16 + fr;
                    const float rstd = __builtin_amdgcn_rsqf(rsv[ai][m] * (1.0f / D) + NORM_EPS);
                    f32x4 v[2][2]; float ss = 0.f;
#pragma unroll
                    for (int bj = 0; bj < 2; ++bj)
#pragma unroll
                        for (int n = 0; n < 2; ++n) { v[bj][n] = acc[ai][bj][m][n] * rstd + bv[bj][n]; ss += (v[bj][n][0] * v[bj][n][0] + v[bj][n][1] * v[bj][n][1]) + (v[bj][n][2] * v[bj][n][2] + v[bj][n][3] * v[bj][n][3]); }
                    ss += __shfl_xor(ss, 16); ss += __shfl_xor(ss, 32);
                    if (!plain_v) { const float rs = 1.0f / sqrtf(ss * (1.0f / 64.0f) + NORM_EPS);
#pragma unroll
                        for (int bj = 0; bj < 2; ++bj)
#pragma unroll
                            for (int n = 0; n < 2; ++n) v[bj][n] = v[bj][n] * rs * gn[bj][n];
                        if (is_c && row < M_LAT) {
                            const int t = row % T; const int pos[2] = {t / GRW, t % GRW};
#pragma unroll
                            for (int bj = 0; bj < 2; ++bj) { const f32x4 cs0 = rope[(pos[bj] * 16 + 4 * fq) / 2], cs1 = rope[(pos[bj] * 16 + 4 * fq) / 2 + 1];
                                const float cc[4] = {cs0[0], cs0[2], cs1[0], cs1[2]}, sn[4] = {cs0[1], cs0[3], cs1[1], cs1[3]};
#pragma unroll
                                for (int j = 0; j < 4; ++j) { const float x1 = v[bj][0][j], x2 = v[bj][1][j]; v[bj][0][j] = x1 * cc[j] - x2 * sn[j]; v[bj][1][j] = x2 * cc[j] + x1 * sn[j]; } }
                        }
                    }
                    bf16* op = dst + (size_t)row * pitch + hcol + 4 * fq;
#pragma unroll
                    for (int bj = 0; bj < 2; ++bj)
#pragma unroll
                        for (int n = 0; n < 2; ++n) { u32x2 w; w.x = pk2(v[bj][n][0], v[bj][n][1]); w.y = pk2(v[bj][n][2], v[bj][n][3]); *(u32x2*)(op + 32 * bj + 16 * n) = w; }
                }
        } else {
#pragma unroll
            for (int ai = 0; ai < 2; ++ai)
#pragma unroll
                for (int m = 0; m < 4; ++m) {
                    const int row = u.pm * 256 + ai * 128 + wr * 64 + m * 16 + fr;
                    const float rstd = __builtin_amdgcn_rsqf(rsv[ai][m] * (1.0f / D) + NORM_EPS);
#pragma unroll
                    for (int bj = 0; bj < 2; ++bj)
#pragma unroll
                        for (int n = 0; n < 2; ++n) { const f32x4 v = acc[ai][bj][m][n] * rstd + bv[bj][n]; const int c = bj * 128 + wc * 32 + n * 16 + 4 * fq;
                            u32x2 w; w.x = pk2(v[0], v[1]); w.y = pk2(v[2], v[3]);
                            if (pn < PN_BR) *(u32x2*)((bf16*)(ws + WS_VA) + ((size_t)((pn - PN_AV) * 4 + bj * 2 + (wc >> 1)) * M + row) * 64 + (wc & 1) * 32 + n * 16 + 4 * fq) = w;
                            else if (pn < PN_BS) *(u32x2*)((bf16*)(ws + WS_PB) + (size_t)row * 3 * GW + (pn - PN_BR) * 256 + c) = w;
                            else if (pn == PN_BS) { if (c < 160) *(f32x4*)((float*)(ws + WS_PS) + (size_t)row * 160 + c) = v; }
                            else { const int cu = (pn - PN_DU) * 256 + c, gq = cu >> 4, p0 = cu & 15;
                                *(u32x2*)((bf16*)(ws + WS_UG) + ((size_t)gq * NCHP + row / S5L) * S5K + (row % S5L) * 16 + p0) = w; } }
                }
        }
    }
};
struct EpiS5A {
    float* XE;
    DI void operator()(const f32x4 (&acc)[2][2][4][2], const Unit& u, int wr, int wc, int fr_, int fq_) const {
        int tz_ = threadIdx.x; OPAQUE(tz_); const int fr = tz_ & 15, fq = (tz_ & 63) >> 4; (void)fr_; (void)fq_;
#pragma unroll
        for (int ai = 0; ai < 2; ++ai)
#pragma unroll
            for (int m = 0; m < 4; ++m) { const int ch = u.pm * 256 + ai * 128 + wr * 64 + m * 16 + fr; if (ch < NCH) { float* p = XE + ((size_t)u.z * NCHP + ch) * 256 + wc * 32 + 4 * fq;
#pragma unroll
                for (int bj = 0; bj < 2; ++bj)
#pragma unroll
                    for (int n = 0; n < 2; ++n) *(f32x4*)(p + bj * 128 + n * 16) = acc[ai][bj][m][n]; } }
    }
};
struct EpiS5C {
    const bf16* UG; const float* dsk  ; bf16* YG;
    DI void operator()(const f32x4 (&acc)[2][2][4][2], const Unit& u, int wr, int wc, int fr_, int fq_) const {
        int tz_ = threadIdx.x; OPAQUE(tz_); const int fr = tz_ & 15, fq = (tz_ & 63) >> 4; (void)fr_; (void)fq_;
        const int g = u.z;
#pragma unroll
        for (int ai = 0; ai < 2; ++ai)
#pragma unroll
            for (int m = 0; m < 4; ++m) { const int ch = u.pm * 256 + ai * 128 + wr * 64 + m * 16 + fr; if (ch < NCH) {
#pragma unroll
                for (int bj = 0; bj < 2; ++bj)
#pragma unroll
                    for (int n = 0; n < 2; ++n) { const int col = u.pn * 256 + bj * 128 + wc * 32 + n * 16 + 4 * fq, i = col >> 4, p0 = col & 15;
                        const u32x2 uw = *(const u32x2*)(UG + ((size_t)g * NCHP + ch) * S5K + col); const f32x4 dv = *(const f32x4*)(dsk + 16 * g + p0);
                        const f32x4 a = acc[ai][bj][m][n]; const float y0 = a[0] + dv[0] * bflo(uw.x), y1 = a[1] + dv[1] * bfhi(uw.x), y2 = a[2] + dv[2] * bflo(uw.y), y3 = a[3] + dv[3] * bfhi(uw.y);
                        u32x2 w; w.x = pk2(geluf(y0), geluf(y1)); w.y = pk2(geluf(y2), geluf(y3));
                        *(u32x2*)(YG + (size_t)(ch * S5L + i) * GW + 16 * g + p0) = w; } } }
    }
};
struct EpiGLU {
    const bf16* YG; const float* gb; bf16* OB;
    DI void operator()(const f32x4 (&acc)[2][2][4][2], const Unit& u, int wr, int wc, int fr_, int fq_) const {
        int tz_ = threadIdx.x; OPAQUE(tz_); const int fr = tz_ & 15, fq = (tz_ & 63) >> 4; (void)fr_; (void)fq_;
#pragma unroll
        for (int ai = 0; ai < 2; ++ai)
#pragma unroll
            for (int m = 0; m < 4; ++m) { const int row = u.pm * 256 + ai * 128 + wr * 64 + m * 16 + fr;
#pragma unroll
                for (int bj = 0; bj < 2; ++bj)
#pragma unroll
                    for (int n = 0; n < 2; ++n) { const int col = u.pn * 256 + bj * 128 + wc * 32 + n * 16 + 4 * fq; const f32x4 b = *(const f32x4*)(gb + col); const f32x4 a = acc[ai][bj][m][n] + b;
                        const u32x2 yw = *(const u32x2*)(YG + (size_t)row * GW + col);
                        u32x2 w; w.x = pk2(bflo(yw.x) * sigmf(a[0]), bfhi(yw.x) * sigmf(a[1])); w.y = pk2(bflo(yw.y) * sigmf(a[2]), bfhi(yw.y) * sigmf(a[3]));
                        *(u32x2*)(OB + (size_t)row * D + 3 * GW + col) = w; } }
    }
};

DI void ph_ada(const Ctx& C) {
    LAS float* sc = (LAS float*)C.lds;
    LAS float* red = sc + 3 * D;
    for (int i = C.tid; i < 3 * D; i += NTHR) { const int s = i / D, k = i % D; const float c = s < NB ? C.in[I_C][s * D + k] : C.in[I_CCTX][k]; sc[i] = siluf(c); }
    __syncthreads();
    const int nun = NL * (9 * D / 256);
    for (int un = C.bid; un < nun; un += C.G) {
        const int l = un / (9 * D / 256), col0 = (un % (9 * D / 256)) * 256;
        const float* W = C.in[I_WADA] + (size_t)l * D * 9 * D + col0 + 4 * C.lane;
        f32x4 a0 = {0.f, 0.f, 0.f, 0.f}, a1 = a0, a2 = a0;
        const int k0 = C.wave * (D / 8);
#pragma unroll 1
        for (int kb = k0; kb < k0 + D / 8; kb += 16) {
            f32x4 wv[16];
#pragma unroll
            for (int u = 0; u < 16; ++u) wv[u] = *(const f32x4*)(W + (size_t)(kb + u) * 9 * D);
#pragma unroll
            for (int u = 0; u < 16; ++u) { a0 += wv[u] * sc[kb + u]; a1 += wv[u] * sc[D + kb + u]; a2 += wv[u] * sc[2 * D + kb + u]; } }
        LAS float* r = red + C.wave * 768 + 4 * C.lane;
        *(LAS f32x4*)(r) = a0; *(LAS f32x4*)(r + 256) = a1; *(LAS f32x4*)(r + 512) = a2;
        __syncthreads();
        for (int i = C.tid; i < 768; i += NTHR) { float s = 0.f;
#pragma unroll
            for (int w = 0; w < 8; ++w) s += red[w * 768 + i];
            const int st = i / 256, c = col0 + (i % 256);
            ((float*)(C.ws + WS_MODV))[((size_t)l * 3 + st) * 9 * D + c] = s + C.in[I_BADA][(size_t)l * 9 * D + c]; }
        __syncthreads();
    }
}
DI const float* modv_ptr(const Ctx& C, int l, int s, int chunk) { return (const float*)(C.ws + WS_MODV) + ((size_t)l * 3 + s) * 9 * D + (size_t)chunk * D; }

DI int win_dest(int n) {
    if (n >= D_IN) return -1;
    if (n < SRC_AV) { const int piece = n / GW, loc = n % GW, head = loc / 64, d = loc % 64; return ((piece == 0 ? PN_AQ : PN_AK) + head / 4) * 256 + 128 * (d / 32) + 32 * (head % 4) + (d % 32); }
    if (n < SRC_BS) return PN_AV * 256 + (n - SRC_AV);
    if (n < SRC_CQ) return PN_BS * 256 + (n - SRC_BS);
    if (n < SRC_CK) { const int loc = n - SRC_CQ, head = loc / 64, d = loc % 64; return (PN_CQ + head / 4) * 256 + 128 * (d / 32) + 32 * (head % 4) + (d % 32); }
    if (n < SRC_DU) { const int loc = n - SRC_CK, hh = loc / 64, d = loc % 64; return PN_CKV * 256 + 128 * (d / 32) + 32 * hh + (d % 32); }
    return PN_DU * 256 + (n - SRC_DU);
}
DI int gu_dest(int n) { const int e = n & 31; return (n / 128) * 256 + (n % 128 - e) + 16 * ((e >> 2) & 1) + 4 * (e >> 3) + (e & 3); }
DI void conv_item(const Ctx& C, const float* W, int K, int N, bf16* Wt, int mode, int k0, int n0, float* bias, int bias_pitch, const float* shift  ) {
    LAS float* scr = (LAS float*)(C.lds + C.wave * 16640);
    const int n = n0 + C.lane; const bool ok = n < N; float b0 = 0.f, b1 = 0.f, b2 = 0.f;
#pragma unroll 1
    for (int kh = 0; kh < 4; ++kh) {
        float wv[16];
#pragma unroll
        for (int kk = 0; kk < 16; ++kk) wv[kk] = ok ? W[(size_t)(k0 + 16 * kh + kk) * N + n] : 0.f;
#pragma unroll
        for (int kk = 0; kk < 16; ++kk) { const float v = wv[kk]; scr[(16 * kh + kk) * 65 + C.lane] = v;
            if (bias) { b0 += shift[k0 + 16 * kh + kk] * v; b1 += shift[9 * D + k0 + 16 * kh + kk] * v; b2 += shift[18 * D + k0 + 16 * kh + kk] * v; } } }
    WSYNC();
    const int dme = !ok ? -1 : mode == 0 ? n : mode == 1 ? gu_dest(n) : mode == 2 ? gu_dest(n) + 128 : win_dest(n);
    if (bias && dme >= 0) { atomicAdd(bias + dme, b0); atomicAdd(bias + bias_pitch + dme, b1); atomicAdd(bias + 2 * bias_pitch + dme, b2); }
    const int c = C.lane & 7;
#pragma unroll
    for (int i = 0; i < 8; ++i) { const int nl = (C.lane >> 3) + 8 * i, nn = n0 + nl;
        const int dr = nn >= N ? -1 : mode == 0 ? nn : mode == 1 ? gu_dest(nn) : mode == 2 ? gu_dest(nn) + 128 : win_dest(nn);
        const LAS float* s = scr + (8 * c) * 65 + nl;
        u32x4 o; o.x = pk2(s[0], s[65]); o.y = pk2(s[2 * 65], s[3 * 65]); o.z = pk2(s[4 * 65], s[5 * 65]); o.w = pk2(s[6 * 65], s[7 * 65]);
        if (dr >= 0) *(u32x4*)(Wt + (size_t)dr * K + k0 + 8 * c) = o; }
    WSYNC();
}
struct Cplx { float re, im; };
DI Cplx cmul(Cplx a, Cplx b) { return Cplx{a.re * b.re - a.im * b.im, a.re * b.im + a.im * b.re}; }
DI Cplx s5_lam_pow(const Ctx& C, int l, int dir, int g, int n, float tau) {
    const size_t i = (((size_t)l * 2 + dir) * S5G + g) * 64 + n; const float dt = __expf(C.in[I_S5LDT][((size_t)l * 2 + dir) * S5G + g]);
    const float mag = __expf(tau * dt * C.in[I_S5ARE][i]), ang = tau * dt * C.in[I_S5AIM][i]; float sn, cs; sincosf(ang, &sn, &cs); return Cplx{mag * cs, mag * sn};
}
DI Cplx s5_coef(const Ctx& C, int l, int dir, int g, int n) {
    const size_t i = (((size_t)l * 2 + dir) * S5G + g) * 64 + n; const float are = C.in[I_S5ARE][i], aim = C.in[I_S5AIM][i];
    const Cplx ab = s5_lam_pow(C, l, dir, g, n, 1.0f); const float den = are * are + aim * aim, nr = ab.re - 1.0f;
    return Cplx{(nr * are + ab.im * aim) / den, (ab.im * are - nr * aim) / den};
}
DI Cplx s5_beta(const Ctx& C, int l, int dir, int g, int n, int q) {
    const size_t i = (((size_t)l * S5G + g) * 64 + n) * 16 + q; return cmul(s5_coef(C, l, dir, g, n), Cplx{C.in[I_S5BRE][i], C.in[I_S5BIM][i]});
}
DI Cplx s5_gamma(const Ctx& C, int l, int g, int p, int n) { const size_t i = (((size_t)l * S5G + g) * 16 + p) * 64 + n; return Cplx{C.in[I_S5CRE][i], C.in[I_S5CIM][i]}; }

#ifndef CONV_G1_PCT
#define CONV_G1_PCT 55
#endif
constexpr int CI_GU = (D / 64) * (FF / 64), CI_DN = (FF / 64) * (D / 64), CI_IN = (D / 64) * ((D_IN + 63) / 64), CI_OUT = (D / 64) * (D / 64), CI_GLU = (GW / 64) * (GW / 64);
constexpr int CI_LAYER = 4 * CI_GU + 2 * CI_DN + CI_IN + CI_OUT + CI_GLU, CI_X1 = (int)((long)CI_LAYER * CONV_G1_PCT / 100) & ~7;
DI void conv_weights(const Ctx& C, int l, int wslot, int nslots, int it_lo, int it_hi) {
    for (int it = it_lo + wslot; it < it_hi; it += nslots) {
        int r = it;
        unsigned char* wbase = C.ws + WS_W + (size_t)l * SZ_WL;
        if (r < 2 * CI_GU) { const int up = r >= CI_GU; r -= up * CI_GU; const int kb = r / (FF / 64), nb = r % (FF / 64);
            conv_item(C, C.in[up ? I_F1WU : I_F1WG] + (size_t)l * D * FF, D, FF, (bf16*)(wbase + OFF_W1GU), 1 + up, kb * 64, nb * 64, bias_ptr(C, l, 0), 2 * FF, modv_ptr(C, l, 0, 0)); continue; } r -= 2 * CI_GU;
        if (r < CI_DN) { const int kb = r / (D / 64), nb = r % (D / 64); conv_item(C, C.in[I_F1WD] + (size_t)l * FF * D, FF, D, (bf16*)(wbase + OFF_W1D), 0, kb * 64, nb * 64, nullptr, 0, nullptr); continue; } r -= CI_DN;
        if (r < CI_IN) { const int nbn = (D_IN + 63) / 64, kb = r / nbn, nb = r % nbn; conv_item(C, C.in[I_WIN] + (size_t)l * D * D_IN, D, D_IN, (bf16*)(wbase + OFF_WIN), 3, kb * 64, nb * 64, bias_ptr(C, l, 1), NINP, modv_ptr(C, l, 0, 3)); continue; } r -= CI_IN;
        if (r < CI_OUT) { const int kb = r / (D / 64), nb = r % (D / 64); conv_item(C, C.in[I_WOUT] + (size_t)l * D * D, D, D, (bf16*)(wbase + OFF_WOUT), 0, kb * 64, nb * 64, nullptr, 0, nullptr); continue; } r -= CI_OUT;
        if (r < 2 * CI_GU) { const int up = r >= CI_GU; r -= up * CI_GU; const int kb = r / (FF / 64), nb = r % (FF / 64);
            conv_item(C, C.in[up ? I_F2WU : I_F2WG] + (size_t)l * D * FF, D, FF, (bf16*)(wbase + OFF_W2GU), 1 + up, kb * 64, nb * 64, bias_ptr(C, l, 2), 2 * FF, modv_ptr(C, l, 0, 6)); continue; } r -= 2 * CI_GU;
        if (r < CI_DN) { const int kb = r / (D / 64), nb = r % (D / 64); conv_item(C, C.in[I_F2WD] + (size_t)l * FF * D, FF, D, (bf16*)(wbase + OFF_W2D), 0, kb * 64, nb * 64, nullptr, 0, nullptr); continue; } r -= CI_DN;
        { const int kb = r / (GW / 64), nb = r % (GW / 64); conv_item(C, C.in[I_S5GLUW] + (size_t)l * GW * GW, GW, GW, (bf16*)(wbase + OFF_WGLU), 0, kb * 64, nb * 64, nullptr, 0, nullptr); }
    }
}
DI void ph_conv(const Ctx& C) {
    const int gt = C.bid * NTHR + C.tid, GT = C.G * NTHR;
    for (int i = gt; i < NL * 9 * D; i += GT) { const int k = i % D, s = (i / D) % 3, sub = (i / (3 * D)) % 3, l = i / (9 * D);
        const float* mv = (const float*)(C.ws + WS_MODV) + ((size_t)l * 3 + s) * 9 * D;
        ((float*)(C.ws + WS_GS))[i] = C.in[I_NORMG][((size_t)l * 3 + sub) * D + k] * (1.0f + mv[(3 * sub + 1) * D + k]);
        ((float*)(C.ws + WS_GATE))[i] = mv[(3 * sub + 2) * D + k] * (sub == 1 ? 1.0f : 0.5f); }
    for (int i = gt; i < 128 * 16; i += GT) { const int pos = i / 16, f = i % 16; const float inv = __expf(-(float)f * (9.210340371976184f / 16.0f)); float sn, cs; sincosf((float)pos * inv, &sn, &cs);
        ((f32x2*)(C.ws + WS_ROPE))[i] = (f32x2){cs, sn}; }
    const int gw = C.bid * NW + C.wave, GWV = C.G * NW;
    conv_weights(C, 0, gw, GWV, 0, CI_LAYER);
    for (int i = gt; i < NL * 14 * NH * 2 * 64 * 8; i += GT) {
        const int j = i & 7, ln = (i >> 3) & 63, tj = (i >> 9) & 1, hd = (i >> 10) % NH, f = (i / (1024 * NH)) % 14, l = i / (1024 * NH * 14);
        const int col = hd * 64 + 32 * tj + (ln & 31); float v;
        if (f < 8) { const int d = (f >> 1) & 1, sx = f & 1, k = 16 * sx + 8 * (ln >> 5) + j; v = C.in[f < 4 ? I_RWWUP : I_RWAUP][(((size_t)l * 2 + d) * 32 + k) * GW + col]; }
        else { const int k = 16 * (f - 8) + 8 * (ln >> 5) + j; v = C.in[I_RWGUP][((size_t)l * 96 + k) * GW + col]; }
        ((bf16*)(C.ws + WS_RWF))[i] = (bf16)f2bf(v); }
    LAS float* wsc = (LAS float*)(C.lds + C.wave * 16640);
    for (int it = gw; it < NL * S5G * 2 * S5L; it += GWV) {
        const int tau = it % S5L, dir = (it / S5L) % 2, g = (it / (2 * S5L)) % S5G, l = it / (2 * S5L * S5G);
        const Cplx z = cmul(s5_lam_pow(C, l, dir, g, C.lane, (float)tau), s5_coef(C, l, dir, g, C.lane));
#pragma unroll 4
        for (int q = 0; q < 16; ++q) { const size_t i = (((size_t)l * S5G + g) * 64 + C.lane) * 16 + q; const Cplx w = cmul(z, Cplx{C.in[I_S5BRE][i], C.in[I_S5BIM][i]}); wsc[(C.lane * 16 + q) * 2] = w.re; wsc[(C.lane * 16 + q) * 2 + 1] = w.im; }
        WSYNC();
        float* kc = (float*)(C.ws + WS_S5T + (size_t)l * SZ_S5L + OFF_S5KC) + (((size_t)g * 2 + dir) * S5L + tau) * 256;
#pragma unroll 1
        for (int e = 0; e < 4; ++e) { const int pq = C.lane + 64 * e, p = pq >> 4, q = pq & 15; float s = 0.f;
#pragma unroll 4
            for (int n = 0; n < 64; ++n) { const Cplx gm = s5_gamma(C, l, g, p, n); s += gm.re * wsc[(n * 16 + q) * 2] - gm.im * wsc[(n * 16 + q) * 2 + 1]; }
            kc[pq] = s; }
        WSYNC();
    }
    for (int i = gt; i < NL * 2 * GW * 4 * (S5L + 1); i += GT) { const int tau = i % (S5L + 1), r = i / (S5L + 1), n = r % 64, g = (r / 64) % S5G, dir = (r / (64 * S5G)) % 2, l = r / (2 * 64 * S5G);
        const Cplx z = s5_lam_pow(C, l, dir, g, n, (float)tau); ((f32x2*)(C.ws + WS_S5T + (size_t)l * SZ_S5L + OFF_S5LP))[((size_t)(dir * S5G + g) * 64 + n) * (S5L + 1) + tau] = (f32x2){z.re, z.im}; }
    for (int i = gt; i < NL * 2 * GW * 4 * 16; i += GT) { const int q = i % 16, r = i / 16, n = r % 64, g = (r / 64) % S5G, dir = (r / (64 * S5G)) % 2, l = r / (2 * 64 * S5G);
        const Cplx z = s5_beta(C, l, dir, g, n, q); ((f32x2*)(C.ws + WS_S5T + (size_t)l * SZ_S5L + OFF_S5BETA))[((size_t)(dir * S5G + g) * 64 + n) * 16 + q] = (f32x2){z.re, z.im}; }
    for (int i = gt; i < NL * 2 * GW * 4; i += GT) { const int n = i % 64, g = (i / 64) % S5G, dir = (i / (64 * S5G)) % 2, l = i / (2 * 64 * S5G); const Cplx z = s5_lam_pow(C, l, dir, g, n, (float)S5L);
        ((f32x2*)(C.ws + WS_S5T + (size_t)l * SZ_S5L + OFF_S5LAM))[(dir * S5G + g) * 64 + n] = (f32x2){z.re, z.im}; }
}
DI u32x4 pack8f(const float (&o)[8]) { u32x4 w; w.x = pk2(o[0], o[1]); w.y = pk2(o[2], o[3]); w.z = pk2(o[4], o[5]); w.w = pk2(o[6], o[7]); return w; }
DI void et_group(const Ctx& C, int l, int i, bf16* ET) {
    const int k = i & 511, np = (i >> 9) & 255, g = i >> 17;
    const int j = k >> 4, q0 = k & 15, dir = np >> 7, n = np & 63, im = (np >> 6) & 1;
    const f32x2 lp = ((const f32x2*)(C.ws + WS_S5T + (size_t)l * SZ_S5L + OFF_S5LP))[((dir * S5G + g) * 64 + n) * (S5L + 1) + (dir == 0 ? S5L - 1 - j : j)];
    const f32x4* be = (const f32x4*)((const f32x2*)(C.ws + WS_S5T + (size_t)l * SZ_S5L + OFF_S5BETA) + ((dir * S5G + g) * 64 + n) * 16 + q0);
    const f32x4 b[4] = {be[0], be[1], be[2], be[3]}; float o[8];
#pragma unroll
    for (int t = 0; t < 8; ++t) { const float br = b[t >> 1][2 * (t & 1)], bi = b[t >> 1][2 * (t & 1) + 1]; o[t] = im ? lp[0] * bi + lp[1] * br : lp[0] * br - lp[1] * bi; }
    *(u32x4*)(ET + i) = pack8f(o);
}
DI void bt_group(const Ctx& C, int l, int i, bf16* BT) {
    const int k = i % S5K, r = i / S5K, nn = r & 511, g = r >> 9, ti = nn >> 4, p = nn & 15; float o[8];
    if (k < 512) { const int j = k >> 4, q0 = k & 15; const float* kc = (const float*)(C.ws + WS_S5T + (size_t)l * SZ_S5L + OFF_S5KC) + (size_t)g * 2 * S5L * 256 + p * 16 + q0;
        const f32x4* c1 = (const f32x4*)(kc + (j <= ti ? ti - j : 0) * 256); const f32x4* c2 = (const f32x4*)(kc + (S5L + (j >= ti ? j - ti : 0)) * 256);
        const f32x4 a0 = c1[0], a1 = c1[1], d0 = c2[0], d1 = c2[1]; const float m1 = j <= ti ? 1.f : 0.f, m2 = j >= ti ? 1.f : 0.f;
#pragma unroll
        for (int t = 0; t < 4; ++t) { o[t] = m1 * a0[t] + m2 * d0[t]; o[4 + t] = m1 * a1[t] + m2 * d1[t]; } }
    else { const int kk = k - 512, dir = kk >> 7, im = (kk >> 6) & 1, n0 = kk & 63; const int li = dir == 0 ? ti + 1 : S5L - ti;
        const f32x2* LPp = (const f32x2*)(C.ws + WS_S5T + (size_t)l * SZ_S5L + OFF_S5LP) + ((dir * S5G + g) * 64 + n0) * (S5L + 1) + li;
        const size_t gi = (((size_t)l * S5G + g) * 16 + p) * 64 + n0;
        const f32x4* gr = (const f32x4*)(C.in[I_S5CRE] + gi); const f32x4* gm = (const f32x4*)(C.in[I_S5CIM] + gi);
        const f32x4 r0 = gr[0], r1 = gr[1], m0 = gm[0], m1 = gm[1]; f32x2 lp[8];
#pragma unroll
        for (int t = 0; t < 8; ++t) lp[t] = LPp[t * (S5L + 1)];
#pragma unroll
        for (int t = 0; t < 8; ++t) { const float cr = t < 4 ? r0[t & 3] : r1[t & 3], ci = t < 4 ? m0[t & 3] : m1[t & 3]; o[t] = im ? -(cr * lp[t][1] + ci * lp[t][0]) : cr * lp[t][0] - ci * lp[t][1]; } }
    *(u32x4*)(BT + i) = pack8f(o);
}
DI void ph_tab(const Ctx& C) {
    const int gt = C.bid * NTHR + C.tid, GT = C.G * NTHR;
    constexpr int NET = S5G * 256 * 512, NBT = S5G * 512 * S5K;
    for (int l = 0; l < NL; ++l) {
        bf16* ET = (bf16*)(C.ws + WS_S5T + (size_t)l * SZ_S5L + OFF_S5ET); bf16* BT = (bf16*)(C.ws + WS_S5T + (size_t)l * SZ_S5L + OFF_S5BT);
#pragma unroll 1
        for (int i8 = gt; i8 < NET / 8; i8 += GT) et_group(C, l, i8 * 8, ET);
#pragma unroll 1
        for (int i8 = gt; i8 < NBT / 8; i8 += GT) bt_group(C, l, i8 * 8, BT);
    }
    const int gw = C.bid * NW + C.wave, GWV = C.G * NW;
    for (int row = gw; row < M; row += GWV) {
        const float* src = row < M_LAT ? C.in[I_X] + (size_t)row * D : C.in[I_CTX] + (size_t)(row - M_LAT) * D;
        float* dst = xrow_ptr(C, row); const float* gs = gs_ptr(C, 0, 0, stream_of_row(row)); bf16* ap = (bf16*)(C.ws + WS_AP) + (size_t)row * D; float ss = 0.f;
        f32x4 xv[D / 256], gv[D / 256];
#pragma unroll
        for (int i = 0; i < D / 256; ++i) { xv[i] = *(const f32x4*)(src + 4 * C.lane + 256 * i); gv[i] = *(const f32x4*)(gs + 4 * C.lane + 256 * i); }
#pragma unroll
        for (int i = 0; i < D / 256; ++i) { const int c = 4 * C.lane + 256 * i; const f32x4 x = xv[i]; *(f32x4*)(dst + c) = x; ss += (x[0] * x[0] + x[1] * x[1]) + (x[2] * x[2] + x[3] * x[3]);
            const f32x4 a = x * gv[i]; u32x2 w; w.x = pk2(a[0], a[1]); w.y = pk2(a[2], a[3]); *(u32x2*)(ap + c) = w; }
        ss = wave_sum(ss); if (C.lane == 0) rowss_ptr(C, 0, 0)[row] = ss;
    }
}

#ifdef EMU
DI s16x4 tr_read1(const LAS unsigned char* a) { return emu_tr_read(a); }
#else
DI s16x4 tr_read1(const LAS unsigned char* a) { s16x4 r; asm volatile("ds_read_b64_tr_b16 %0, %1\n\ts_waitcnt lgkmcnt(0)" : "=&v"(r) : "v"((unsigned)(size_t)a) : "memory"); return r; }
#endif
DI bf16x8 tr_frag(const LAS unsigned char* a0, int hi_off) {
#ifdef EMU
    const s16x4 lo = emu_tr_read(a0), hi = emu_tr_read(a0 + hi_off);
#else
    s16x4 lo, hi; asm volatile("ds_read_b64_tr_b16 %0, %2\n\tds_read_b64_tr_b16 %1, %3\n\ts_waitcnt lgkmcnt(0)" : "=&v"(lo), "=&v"(hi) : "v"((unsigned)(size_t)a0), "v"((unsigned)(size_t)(a0 + hi_off)) : "memory");
#endif
    return __builtin_shufflevector(lo, hi, 0, 1, 2, 3, 4, 5, 6, 7);
}
DI void tr_frag4(const LAS unsigned char* a0, const LAS unsigned char* a1, const LAS unsigned char* a2, const LAS unsigned char* a3, int hi_off, bf16x8 (&f)[4]) {
#ifdef EMU
    f[0] = tr_frag(a0, hi_off); f[1] = tr_frag(a1, hi_off); f[2] = tr_frag(a2, hi_off); f[3] = tr_frag(a3, hi_off);
#else
    s16x4 l0, h0, l1, h1, l2, h2, l3, h3;
    asm volatile("ds_read_b64_tr_b16 %0, %8\n\tds_read_b64_tr_b16 %1, %9\n\tds_read_b64_tr_b16 %2, %10\n\tds_read_b64_tr_b16 %3, %11\n\tds_read_b64_tr_b16 %4, %12\n\tds_read_b64_tr_b16 %5, %13\n\tds_read_b64_tr_b16 %6, %14\n\tds_read_b64_tr_b16 %7, %15\n\ts_waitcnt lgkmcnt(0)"
        : "=&v"(l0), "=&v"(h0), "=&v"(l1), "=&v"(h1), "=&v"(l2), "=&v"(h2), "=&v"(l3), "=&v"(h3)
        : "v"((unsigned)(size_t)a0), "v"((unsigned)(size_t)(a0 + hi_off)), "v"((unsigned)(size_t)a1), "v"((unsigned)(size_t)(a1 + hi_off)), "v"((unsigned)(size_t)a2), "v"((unsigned)(size_t)(a2 + hi_off)), "v"((unsigned)(size_t)a3), "v"((unsigned)(size_t)(a3 + hi_off)) : "memory");
    f[0] = __builtin_shufflevector(l0, h0, 0, 1, 2, 3, 4, 5, 6, 7); f[1] = __builtin_shufflevector(l1, h1, 0, 1, 2, 3, 4, 5, 6, 7); f[2] = __builtin_shufflevector(l2, h2, 0, 1, 2, 3, 4, 5, 6, 7); f[3] = __builtin_shufflevector(l3, h3, 0, 1, 2, 3, 4, 5, 6, 7);
#endif
}
DI bf16x8 pack8(const f32x16& x, int s) {
    u32x4 p; p.x = pk2(x[8 * s], x[8 * s + 1]); p.y = pk2(x[8 * s + 2], x[8 * s + 3]); p.z = pk2(x[8 * s + 4], x[8 * s + 5]); p.w = pk2(x[8 * s + 6], x[8 * s + 7]);
    return __builtin_bit_cast(bf16x8, p);
}
struct AttnSt { f32x16 o0, o1; float m, l; };
constexpr int APT = 144;
struct KVregs { u32x4 k[4]; u32x4 v[4]; };
struct Kregs { bf16x8 k[4]; };
DI void k_load(Kregs& r, const bf16* Kb, int kp, int lane) {
    const int r32 = lane & 31, h = lane >> 5;
#pragma unroll
    for (int kk = 0; kk < 4; ++kk) r.k[kk] = *(const bf16x8*)(Kb + (size_t)r32 * kp + 16 * kk + 8 * h);
}
DI void kv_load2(KVregs& r, const bf16* Kb, int kp, const bf16* Vb, int vp, int lane) {
#pragma unroll
    for (int i = 0; i < 4; ++i) { const int idx = lane + 64 * i, key = idx >> 3, ch = idx & 7; r.k[i] = *(const u32x4*)(Kb + (size_t)key * kp + ch * 8); }
#pragma unroll
    for (int i = 0; i < 4; ++i) { const int idx = lane + 64 * i, key = idx >> 3, ch = idx & 7; r.v[i] = *(const u32x4*)(Vb + (size_t)key * vp + ch * 8); }
}
#if 0
DI void kv_load(KVregs& r, const Kregs& kpre, const bf16* Vb, int vp, int lane) {
#pragma unroll
    for (int kk = 0; kk < 4; ++kk) r.k[kk] = kpre.k[kk];
#pragma unroll
    for (int i = 0; i < 4; ++i) { const int idx = lane + 64 * i, key = idx >> 3, ch = idx & 7; r.v[i] = *(const u32x4*)(Vb + (size_t)key * vp + ch * 8); }
}
#endif
DI void attn_stage(const KVregs& kv, LAS unsigned char* vl, int lane) {
    LAS unsigned char* vk = vl; LAS unsigned char* vv = vl + 32 * APT;
#pragma unroll
    for (int i = 0; i < 4; ++i) { const int idx = lane + 64 * i, key = idx >> 3, ch = idx & 7; *(LAS u32x4*)(vk + key * APT + ch * 16) = kv.k[i]; *(LAS u32x4*)(vv + key * APT + ch * 16) = kv.v[i]; }
}
template <bool MASKED>
DI void attn_block(AttnSt& st, const bf16x8 (&qf)[4], LAS unsigned char* vl, int lane, const float (&addv)[16], unsigned vmask) {
    const int h = lane >> 5;
    LAS unsigned char* vk = vl; LAS unsigned char* vv = vl + 32 * APT;
    WSYNC();
    bf16x8 kf[4];
#pragma unroll
    for (int kk = 0; kk < 4; ++kk) kf[kk] = *(const LAS bf16x8*)(vk + (lane & 31) * APT + (16 * kk + 8 * h) * 2);
    f32x16 s;
#pragma unroll
    for (int i = 0; i < 16; ++i) s[i] = 0.f;
#pragma unroll
    for (int kk = 0; kk < 4; ++kk) s = __builtin_amdgcn_mfma_f32_32x32x16_bf16(kf[kk], qf[kk], s, 0, 0, 0);
    float bm = -1e30f;
#pragma unroll
    for (int i = 0; i < 16; ++i) { if (MASKED) { s[i] += addv[i]; if ((vmask >> i) & 1u) bm = fmaxf(bm, s[i]); } else bm = fmaxf(bm, s[i]); }
    bm = fmaxf(bm, __shfl_xor(bm, 32));
    const float mn = fmaxf(st.m, bm), alpha = __expf(st.m - mn); st.m = mn;
    float ls = 0.f;
#pragma unroll
    for (int i = 0; i < 16; ++i) { float p = __expf(s[i] - mn); if (MASKED) p = ((vmask >> i) & 1u) ? p : 0.f; s[i] = p; ls += p; }
    st.l = st.l * alpha + ls;
#pragma unroll
    for (int i = 0; i < 16; ++i) { st.o0[i] *= alpha; st.o1[i] *= alpha; }
    const int q = (lane & 15) >> 2, p4 = lane & 3, blk = (lane >> 4) & 1;
    { const LAS unsigned char* ab = vv + (4 * h + q) * APT + (16 * blk) * 2 + 8 * p4; bf16x8 vf[4];
      tr_frag4(ab, ab + 64, ab + 16 * APT, ab + 16 * APT + 64, 8 * APT, vf);
      const bf16x8 pf0 = pack8(s, 0), pf1 = pack8(s, 1);
      st.o0 = __builtin_amdgcn_mfma_f32_32x32x16_bf16(vf[0], pf0, st.o0, 0, 0, 0); st.o1 = __builtin_amdgcn_mfma_f32_32x32x16_bf16(vf[1], pf0, st.o1, 0, 0, 0);
      st.o0 = __builtin_amdgcn_mfma_f32_32x32x16_bf16(vf[2], pf1, st.o0, 0, 0, 0); st.o1 = __builtin_amdgcn_mfma_f32_32x32x16_bf16(vf[3], pf1, st.o1, 0, 0, 0); }
}
DI void attn_finish(AttnSt& st, bf16* orow  , int lane, float extra_l) {
    const int h = lane >> 5; float l = st.l + __shfl_xor(st.l, 32) + extra_l; const float inv = 1.0f / l;
#pragma unroll
    for (int g = 0; g < 4; ++g) {
        u32x2 w0, w1; w0.x = pk2(st.o0[4 * g] * inv, st.o0[4 * g + 1] * inv); w0.y = pk2(st.o0[4 * g + 2] * inv, st.o0[4 * g + 3] * inv);
        w1.x = pk2(st.o1[4 * g] * inv, st.o1[4 * g + 1] * inv); w1.y = pk2(st.o1[4 * g + 2] * inv, st.o1[4 * g + 3] * inv);
        *(u32x2*)(orow + 8 * g + 4 * h) = w0; *(u32x2*)(orow + 32 + 8 * g + 4 * h) = w1; }
}
DI int clampi(int v, int lo, int hi) { return v < lo ? lo : (v > hi ? hi : v); }
#ifndef ATTN_A_PCT
#define ATTN_A_PCT 20
#endif
constexpr int AT_NA = NB * NH * (GRH / 2) * 4, AT_WA = NB * NH * (T / 32), AT_CX = NB * NH * (TC / 32);
DI void ph_attn(const Ctx& C, int l, bool want_ctx, int widx, int nworkers, int t_lo, int t_hi) {
    if (widx < 0) return;
    const int gw = t_lo + widx, GWV = nworkers, lane = C.lane, r32 = lane & 31, h = lane >> 5;
    LAS unsigned char* vl = C.lds + C.wave * 16640;
    const bf16* QA = (const bf16*)(C.ws + WS_QA); const bf16* KA = (const bf16*)(C.ws + WS_KA); const bf16* VA = (const bf16*)(C.ws + WS_VA);
    const bf16* QC = (const bf16*)(C.ws + WS_QC); const bf16* KC = (const bf16*)(C.ws + WS_KC); const bf16* VC = (const bf16*)(C.ws + WS_VC);
    bf16* OB = (bf16*)(C.ws + WS_OB);
    const int ntiles = t_hi;
    const float zero16[16] = {0.f, 0.f, 0.f, 0.f, 0.f, 0.f, 0.f, 0.f, 0.f, 0.f, 0.f, 0.f, 0.f, 0.f, 0.f, 0.f};
    for (int tile = gw; tile < ntiles; tile += GWV) {
        AttnSt st; st.m = -1e30f; st.l = 0.f;
#pragma unroll
        for (int i = 0; i < 16; ++i) { st.o0[i] = 0.f; st.o1[i] = 0.f; }
        bf16x8 qf[4];
        if (tile < AT_NA) {
            const int cb = tile & 3, rp = (tile >> 2) % (GRH / 2), hd = (tile / (4 * (GRH / 2))) % NH, b = tile / (4 * (GRH / 2) * NH);
            const int r0 = 2 * rp, c0 = 16 * cb, qr = r0 + (r32 >> 4), qc = c0 + (r32 & 15), qrow = b * T + qr * GRW + qc;
#pragma unroll
            for (int kk = 0; kk < 4; ++kk) qf[kk] = *(const bf16x8*)(QA + (size_t)qrow * GW + hd * 64 + 16 * kk + 8 * h);
            const int rsq = clampi(qr - 4, 0, GRH - 8), csq = clampi(qc - 8, 0, GRW - 16);
            const int rsA = clampi(r0 - 4, 0, GRH - 8), rsB = clampi(r0 + 1 - 4, 0, GRH - 8), kc0 = clampi(c0 - 8, 0, GRW - 32);
            const float* rpb = C.in[I_NARPB] + ((size_t)l * NH + hd) * 465;
            const int nbn = rsB + 8 - rsA, nbt = nbn + TC / 32; KVregs nxt;
#define NA_ROW(i) ((i) < nbn ? (size_t)b * T + (rsA + (i)) * GRW + kc0 : (size_t)M_LAT + b * TC + 32 * ((i) - nbn))
            const bf16* KAh = KA + (size_t)hd * M * 64; const bf16* VAh = VA + (size_t)hd * M * 64;
            { const size_t kr0 = NA_ROW(0); kv_load2(nxt, KAh + kr0 * 64, 64, VAh + kr0 * 64, 64, lane); }
            LAS float* rpbL = (LAS float*)(vl + 64 * APT);
            { float tb[8];
#pragma unroll
              for (int i = 0; i < 8; ++i) { const int j = lane + 64 * i; tb[i] = rpb[j < 465 ? j : 464]; }
#pragma unroll
              for (int i = 0; i < 8; ++i) { const int j = lane + 64 * i; if (j < 465) rpbL[j] = tb[i]; }
              WSYNC(); }
            const int cb0 = kc0 + 4 * h - qc + 15; unsigned vmcol = 0u;
#pragma unroll
            for (int i = 0; i < 16; ++i) { const int kc = kc0 + (i & 3) + 8 * (i >> 2) + 4 * h; vmcol |= (kc >= csq && kc <= csq + 15) ? (1u << i) : 0u; }
            for (int ib = 0; ib < nbt; ++ib) {
                attn_stage(nxt, vl, lane);
                { const int in_ = ib + 1 < nbt ? ib + 1 : ib; const size_t kr1 = NA_ROW(in_); kv_load2(nxt, KAh + kr1 * 64, 64, VAh + kr1 * 64, 64, lane); }
                if (ib < nbn) { const int kr = rsA + ib; float addv[16]; const bool rok = kr >= rsq && kr <= rsq + 7;
                    const LAS float* rb = rpbL + (kr - qr + 7) * 31 + cb0;
#pragma unroll
                    for (int i = 0; i < 16; ++i) addv[i] = rb[(i & 3) + 8 * (i >> 2)];
                    attn_block<true>(st, qf, vl, lane, addv, rok ? vmcol : 0u); }
                else attn_block<false>(st, qf, vl, lane, zero16, 0xffffu); }
#undef NA_ROW
            attn_finish(st, OB + (size_t)qrow * D + hd * 64, lane, 0.f);
        } else if (tile < AT_NA + AT_WA) {
            const int t2 = tile - AT_NA, hl_ = t2 % WAG, qb = (t2 / WAG) % (T / 32), kvh = (t2 / (WAG * (T / 32))) % (NH / WAG), b = t2 / ((T / 32) * NH), hd = kvh * WAG + hl_;
            const int qt = 32 * qb + r32, qrow = b * T + qt;
#pragma unroll
            for (int kk = 0; kk < 4; ++kk) qf[kk] = *(const bf16x8*)(QC + (size_t)qrow * GW + hd * 64 + 16 * kk + 8 * h);
            const int i_lo = 4 - qb > 0 ? 4 - qb : 0, i_hi = (T / 32 - qb + 4) < 9 ? (T / 32 - qb + 4) : 9, nbw = i_hi - i_lo, nbt = nbw + TC / 32; KVregs nxt;
#define WA_ROW(i) ((i) < nbw ? (size_t)b * T + 32 * qb - 128 + 32 * (i_lo + (i)) : (size_t)M_LAT + b * TC + 32 * ((i) - nbw))
            const bf16* KCh = KC + (size_t)kvh * M * 64; const bf16* VCh = VC + (size_t)kvh * M * 64;
            { const size_t kr0 = WA_ROW(0); kv_load2(nxt, KCh + kr0 * 64, 64, VCh + kr0 * 64, 64, lane); }
            for (int ib = 0; ib < nbt; ++ib) {
                attn_stage(nxt, vl, lane);
                { const int in_ = ib + 1 < nbt ? ib + 1 : ib; const size_t kr1 = WA_ROW(in_); kv_load2(nxt, KCh + kr1 * 64, 64, VCh + kr1 * 64, 64, lane); }
                if (ib < nbw && (i_lo + ib == 0 || i_lo + ib == 8)) { const int t0 = 32 * qb - 128 + 32 * (i_lo + ib); float addv[16]; unsigned vm = 0u;
#pragma unroll
                    for (int i = 0; i < 16; ++i) { const int kt = t0 + (i & 3) + 8 * (i >> 2) + 4 * h, rel = kt - qt; addv[i] = 0.f; vm |= (rel >= -128 && rel <= 128) ? (1u << i) : 0u; }
                    attn_block<true>(st, qf, vl, lane, addv, vm); }
                else attn_block<false>(st, qf, vl, lane, zero16, 0xffffu); }
#undef WA_ROW
            const float sk = C.in[I_WASINK][(size_t)l * NH + hd];
            const float mfin = fmaxf(st.m, sk), a2 = __expf(st.m - mfin);
#pragma unroll
            for (int i = 0; i < 16; ++i) { st.o0[i] *= a2; st.o1[i] *= a2; }
            st.l *= a2; st.m = mfin;
            attn_finish(st, OB + (size_t)qrow * D + 2 * GW + hd * 64, lane, __expf(sk - mfin));
        } else {
            const int t2 = tile - AT_NA - AT_WA, isc = t2 >= AT_CX, t3 = t2 - isc * AT_CX, qb = t3 % (TC / 32), hd = (t3 / (TC / 32)) % NH, b = t3 / ((TC / 32) * NH), kvh = hd / WAG;
            const int qrow = M_LAT + b * TC + 32 * qb + r32;
            const bf16* Qs = isc ? QC : QA; const bf16* Ks = isc ? KC + (size_t)kvh * M * 64 : KA + (size_t)hd * M * 64; const bf16* Vs = isc ? VC + (size_t)kvh * M * 64 : VA + (size_t)hd * M * 64; const int kp = 64;
#pragma unroll
            for (int kk = 0; kk < 4; ++kk) qf[kk] = *(const bf16x8*)(Qs + (size_t)qrow * GW + hd * 64 + 16 * kk + 8 * h);
            { KVregs nxt; const size_t kr0 = (size_t)M_LAT + b * TC; kv_load2(nxt, Ks + kr0 * kp, kp, Vs + kr0 * kp, kp, lane);
              for (int cbk = 0; cbk < TC / 32; ++cbk) { attn_stage(nxt, vl, lane); const int cn = cbk + 1 < TC / 32 ? cbk + 1 : cbk; kv_load2(nxt, Ks + (kr0 + 32 * cn) * kp, kp, Vs + (kr0 + 32 * cn) * kp, kp, lane);
                  attn_block<false>(st, qf, vl, lane, zero16, 0xffffu); } }
            float extra = 0.f;
            if (isc) { const float sk = C.in[I_WASINK][(size_t)l * NH + hd]; const float mfin = fmaxf(st.m, sk), a2 = __expf(st.m - mfin);
#pragma unroll
                for (int i = 0; i < 16; ++i) { st.o0[i] *= a2; st.o1[i] *= a2; }
                st.l *= a2; st.m = mfin; extra = __expf(sk - mfin); }
            attn_finish(st, OB + (size_t)qrow * D + (isc ? 2 * GW : 0) + hd * 64, lane, extra);
        }
    }
}

DI void ph_ctxfix(const Ctx& C, const float* gsn  , float* rowss_next) {
    const int gw = C.bid * NW + C.wave, GWV = C.G * NW;
    for (int r = gw; r < M_CTX; r += GWV) { const int row = M_LAT + r; const float* xp = xrow_ptr(C, row); const float* gs = gsn + (size_t)NB * D; bf16* ap = (bf16*)(C.ws + WS_AP) + (size_t)row * D; float ss = 0.f;
        f32x4 xv[D / 256], gv[D / 256];
#pragma unroll
        for (int i = 0; i < D / 256; ++i) { xv[i] = *(const f32x4*)(xp + 4 * C.lane + 256 * i); gv[i] = *(const f32x4*)(gs + 4 * C.lane + 256 * i); }
#pragma unroll
        for (int i = 0; i < D / 256; ++i) { const int c = 4 * C.lane + 256 * i; const f32x4 x = xv[i]; ss += (x[0] * x[0] + x[1] * x[1]) + (x[2] * x[2] + x[3] * x[3]);
            const f32x4 a = x * gv[i]; u32x2 w; w.x = pk2(a[0], a[1]); w.y = pk2(a[2], a[3]); *(u32x2*)(ap + c) = w; }
        ss = wave_sum(ss); if (C.lane == 0) rowss_next[row] = ss; }
}
constexpr int PT = 144;
constexpr int RW_HALF = 73472, IM_BT = 0, IM_KT = 9216, IM_RT = 18432, IM_ARB = 27648, IM_AT = 36864, IM_AAK = 46080, IM_F = 55296, IM_GC = 72704, FP = 68;
DI void chunk_rows(int b, int dir, int c, int& row0, int& step) {
    if (c < TC / 64) { const int p0 = 64 * c; row0 = M_LAT + b * TC + (dir ? TC - 1 - p0 : p0); } else { const int p0 = 64 * (c - TC / 64); row0 = b * T + (dir ? T - 1 - p0 : p0); }
    step = dir ? -1 : 1;
}
DI bf16x8 frag_rows(const LAS unsigned char* img, int tile, int s, int lane) { return *(const LAS bf16x8*)(img + (32 * tile + (lane & 31)) * PT + (16 * s + 8 * (lane >> 5)) * 2); }
DI bf16x8 frag_cols(const LAS unsigned char* img, int tile, int s, int lane) {
    const int h = lane >> 5, q = (lane & 15) >> 2, p4 = lane & 3, blk = (lane >> 4) & 1;
    const LAS unsigned char* a0 = img + (16 * s + 8 * h + q) * PT + (32 * tile + 16 * blk) * 2 + 8 * p4;
    return tr_frag(a0, 4 * PT);
}
DI void frag_cols4(const LAS unsigned char* img, int tile, int lane, bf16x8 (&f)[4]) {
    const int h = lane >> 5, q = (lane & 15) >> 2, p4 = lane & 3, blk = (lane >> 4) & 1;
    const LAS unsigned char* a0 = img + (8 * h + q) * PT + (32 * tile + 16 * blk) * 2 + 8 * p4;
    tr_frag4(a0, a0 + 16 * PT, a0 + 32 * PT, a0 + 48 * PT, 4 * PT, f);
}
DI void store_T(const f32x16& acc, LAS unsigned char* img, int ti, int tj, int lane) {
    const int c = lane & 31, h = lane >> 5;
#pragma unroll
    for (int g = 0; g < 4; ++g) { u32x2 w; w.x = pk2(acc[4 * g], acc[4 * g + 1]); w.y = pk2(acc[4 * g + 2], acc[4 * g + 3]); *(LAS u32x2*)(img + (32 * tj + c) * PT + (32 * ti + 8 * g + 4 * h) * 2) = w; }
}
DI f32x16 zero16v() { f32x16 z;
#pragma unroll
    for (int i = 0; i < 16; ++i) z[i] = 0.f; return z; }
#define MMA32(a, b, c) __builtin_amdgcn_mfma_f32_32x32x16_bf16((a), (b), (c), 0, 0, 0)
constexpr int PDW = 80, PDG = 208, IM_TW = 0, IM_TA = 17408, IM_DW = 36864, IM_DA = 41984, IM_DG = 47104;
DI void ph_rw1(const Ctx& C, int l) {
    const int wg = C.wave & 3, grp = C.wave >> 2, ti = wg >> 1, tj = wg & 1;
    bf16* QH = (bf16*)(C.ws + WS_QH); float* YL = (float*)(C.ws + WS_YL); bf16* MF = (bf16*)(C.ws + WS_MF); float* GF = (float*)(C.ws + WS_GF); bf16* RVKG = (bf16*)(C.ws + WS_RVKG);
    const bf16* PB = (const bf16*)(C.ws + WS_PB); const float* PS = (const float*)(C.ws + WS_PS);
    const bf16x8* RWF = (const bf16x8*)(C.ws + WS_RWF + (size_t)l * SZ_RWF);
    constexpr int nblk = (TC + T) / 64;
    for (int it0 = 2 * C.bid; it0 < RBLK; it0 += 2 * C.G) {
        int lane_ = threadIdx.x & 63; OPAQUE(lane_); const int lane = lane_, c32 = lane & 31, h = lane >> 5;
        LAS unsigned char* L = OPAQUE_LDS(C.lds + grp * RW_HALF);
        LAS float* F = (LAS float*)(L + IM_F); LAS float* SEG = (LAS float*)(L + IM_F); LAS float* GC = (LAS float*)(L + IM_GC);
        LAS float* TW = (LAS float*)(L + IM_TW); LAS float* TA = (LAS float*)(L + IM_TA);
        unsigned char* PK = C.ws + WS_RWS + ((size_t)C.bid * 2 + grp) * 65536;
        const int item = it0 + grp; const bool live = item < RBLK; const int itc = live ? item : RBLK - 1;
        const int tb = itc % nblk, hd = (itc / nblk) % NH, b = itc / (nblk * NH), cg = hd * 64 + lane;
        const int rowb = tb < TC / 64 ? M_LAT + b * TC + 64 * tb : b * T + 64 * (tb - TC / 64);
        const int seq_lo = tb < TC / 64 ? M_LAT + b * TC : b * T, seq_hi = seq_lo + (tb < TC / 64 ? TC : T);
        bf16* RV = RVKG + (size_t)itc * 4 * 4096;
        __syncthreads();
        float r_[16], kf_[16], kk_[16], ks_[16];
        { const float* cw = C.in[I_RWCONV] + (size_t)l * 9 * GW; float cwv[3][3];
#pragma unroll
          for (int j = 0; j < 3; ++j)
#pragma unroll
              for (int x = 0; x < 3; ++x) cwv[j][x] = cw[(size_t)j * 3 * GW + x * GW + cg];
          const float kkw = C.in[I_RWKK][(size_t)l * GW + cg];
          const int r0 = rowb + 16 * wg;
          bf16 pbv[18][3]; float psv[16][3];
#pragma unroll
          for (int rr = 0; rr < 18; ++rr) { int row = r0 - 1 + rr; row = row < seq_lo ? seq_lo : (row >= seq_hi ? seq_hi - 1 : row);
#pragma unroll
              for (int x = 0; x < 3; ++x) pbv[rr][x] = PB[(size_t)row * 3 * GW + x * GW + cg]; }
#pragma unroll
          for (int t = 0; t < 16; ++t)
#pragma unroll
              for (int kq = 0; kq < 3; ++kq) { const int k = lane + 64 * kq; psv[t][kq] = PS[(size_t)(r0 + t) * 160 + (k < 160 ? k : 159)]; }
          const float m_lo = r0 - 1 >= seq_lo ? 1.f : 0.f, m_hi = r0 + 16 < seq_hi ? 1.f : 0.f;
          float v_[16];
#pragma unroll
          for (int t = 0; t < 16; ++t) {
              float xa[3], xb[3], xc[3];
#pragma unroll
              for (int x = 0; x < 3; ++x) { xa[x] = bf2f(pbv[t][x]) * (t == 0 ? m_lo : 1.f); xb[x] = bf2f(pbv[t + 1][x]); xc[x] = bf2f(pbv[t + 2][x]) * (t == 15 ? m_hi : 1.f); }
              r_[t] = xa[0] * cwv[0][0] + xb[0] * cwv[1][0] + xc[0] * cwv[2][0]; kf_[t] = xa[1] * cwv[0][1] + xb[1] * cwv[1][1] + xc[1] * cwv[2][1]; v_[t] = xa[2] * cwv[0][2] + xb[2] * cwv[1][2] + xc[2] * cwv[2][2];
              const float kkv = kf_[t] * kkw, ssq = wave_sum(kkv * kkv); kk_[t] = kkv * __builtin_amdgcn_rsqf(fmaxf(ssq, 1e-24f)); ks_[t] = 0.f;
              const int tk = 16 * wg + t;
              if (lane < 32) *(LAS bf16*)(L + IM_DW + tk * PDW + lane * 2) = (bf16)f2bf(fast_tanh(psv[t][0])); else *(LAS bf16*)(L + IM_DA + tk * PDW + (lane - 32) * 2) = (bf16)f2bf(psv[t][0]);
              *(LAS bf16*)(L + IM_DG + tk * PDG + lane * 2) = (bf16)f2bf(sigmf(psv[t][1]));
              if (lane < 32) *(LAS bf16*)(L + IM_DG + tk * PDG + (lane + 64) * 2) = (bf16)f2bf(sigmf(psv[t][2]));
          }
#pragma unroll
          for (int t = 0; t < 16; ++t) { RV[(16 * wg + t) * 64 + lane] = (bf16)f2bf(r_[t]); RV[4096 + (16 * wg + t) * 64 + lane] = (bf16)f2bf(v_[t]); }
        }
        __syncthreads();
        bf16x8 lrf[2][4]; float w0v[2], a0v[2];
#pragma unroll
        for (int d = 0; d < 2; ++d) {
#pragma unroll
            for (int sx = 0; sx < 2; ++sx) { lrf[d][sx] = RWF[(((0 + 2 * d + sx) * NH + hd) * 2 + tj) * 64 + lane]; lrf[d][2 + sx] = RWF[(((4 + 2 * d + sx) * NH + hd) * 2 + tj) * 64 + lane]; }
            w0v[d] = C.in[I_RWW0][((size_t)l * 2 + d) * GW + hd * 64 + 32 * tj + c32]; a0v[d] = C.in[I_RWA0][((size_t)l * 2 + d) * GW + hd * 64 + 32 * tj + c32]; }
        { f32x16 gacc = zero16v();
#pragma unroll
          for (int sx = 0; sx < 6; ++sx) gacc = MMA32(*(const LAS bf16x8*)(L + IM_DG + (32 * ti + c32) * PDG + (16 * sx + 8 * h) * 2), RWF[(((8 + sx) * NH + hd) * 2 + tj) * 64 + lane], gacc);
#pragma unroll
          for (int rg = 0; rg < 16; ++rg) { const int tk = 32 * ti + (rg & 3) + 8 * (rg >> 2) + 4 * h; RV[3 * 4096 + tk * 64 + 32 * tj + c32] = (bf16)f2bf(gacc[rg]); }
        }
        const float kaw = C.in[I_RWKA][(size_t)l * GW + cg];
#pragma unroll
        for (int pss = 0; pss < 2; ++pss) {
            const int dir = 1 - pss;
            __syncthreads();
            { f32x16 pw = zero16v(), pa = zero16v();
#pragma unroll
              for (int sx = 0; sx < 2; ++sx) { pw = MMA32(*(const LAS bf16x8*)(L + IM_DW + (32 * ti + c32) * PDW + (16 * sx + 8 * h) * 2), lrf[dir][sx], pw);
                                              pa = MMA32(*(const LAS bf16x8*)(L + IM_DA + (32 * ti + c32) * PDW + (16 * sx + 8 * h) * 2), lrf[dir][2 + sx], pa); }
              const float w0 = w0v[dir], a0 = a0v[dir];
#pragma unroll
              for (int rg = 0; rg < 16; ++rg) { const int tk = 32 * ti + (rg & 3) + 8 * (rg >> 2) + 4 * h; const float z = -(w0 + pw[rg]), sp = z > 20.f ? z : __logf(1.f + __expf(z));
                  TW[tk * FP + 32 * tj + c32] = -__expf(-sp - 0.5f); TA[tk * FP + 32 * tj + c32] = sigmf(a0 + pa[rg]); } }
            __syncthreads();
            const int cs = dir ? 3 - wg : wg;
            float lw[16], av[16], run = 0.f;
#pragma unroll
            for (int ii = 0; ii < 16; ++ii) { const int tl = dir ? 15 - ii : ii, tk = 16 * wg + tl; av[ii] = TA[tk * FP + lane]; run += TW[tk * FP + lane]; lw[ii] = run; }
            __syncthreads();
            SEG[cs * 64 + lane] = run;
            __syncthreads();
            float off = 0.f;
#pragma unroll
            for (int w2 = 0; w2 < 3; ++w2) off += (w2 < cs) ? SEG[w2 * 64 + lane] : 0.f;
            const float tot = SEG[lane] + SEG[64 + lane] + SEG[128 + lane] + SEG[192 + lane];
            if (wg == 0) { if (dir) ((float*)(PK + 32768))[lane] = __expf(tot); else GC[lane] = __expf(tot); }
            float ePrev = __expf(off);
#pragma unroll
            for (int ii = 0; ii < 16; ++ii) { const int tl = dir ? 15 - ii : ii, i = 16 * cs + ii;
                const float Li = lw[ii] + off, eL = __expf(Li), ieL = __builtin_amdgcn_rcpf(eL), eLm = ePrev; ePrev = eL;
                const float a = av[ii], kd = kf_[tl] * (1.f + (a - 1.f) * kaw); ks_[tl] += kd;
                const bf16 vat = (bf16)f2bf(-kk_[tl] * eLm), vbt = (bf16)f2bf(kk_[tl] * a * ieL), vkt = (bf16)f2bf(kd * ieL), vrt = (bf16)f2bf(r_[tl] * eL);
                if (dir) { bf16* pk = (bf16*)PK + i * 64 + lane; pk[0] = vat; pk[4096] = vbt; pk[8192] = vkt; pk[12288] = vrt; }
                else { *(LAS bf16*)(L + IM_AT + i * PT + lane * 2) = vat; *(LAS bf16*)(L + IM_BT + i * PT + lane * 2) = vbt; *(LAS bf16*)(L + IM_KT + i * PT + lane * 2) = vkt; *(LAS bf16*)(L + IM_RT + i * PT + lane * 2) = vrt; } }
        }
#pragma unroll
        for (int t = 0; t < 16; ++t) RV[2 * 4096 + (16 * wg + t) * 64 + lane] = (bf16)f2bf(ks_[t]);
#pragma unroll 1
        for (int dir = 0; dir < 2; ++dir) {
            const int c = dir == 0 ? tb : (tb < TC / 64 ? TC / 64 - 1 - tb : TC / 64 + (T / 64 - 1 - (tb - TC / 64)));
            const size_t ci = ((size_t)((b * NH + hd) * 2 + dir)) * RCK + c;
            __syncthreads();
            if (dir) {
                const int tg = wg * 64 + lane;
                u32x4 pkv[4][2]; const float gcv = ((const float*)(PK + 32768))[lane];
#pragma unroll
                for (int im = 0; im < 4; ++im)
#pragma unroll
                    for (int rr = 0; rr < 2; ++rr) { const int idx = tg + 256 * rr, row = idx >> 3, ch = idx & 7; pkv[im][rr] = *(const u32x4*)(PK + im * 8192 + row * 128 + ch * 16); }
#pragma unroll
                for (int im = 0; im < 4; ++im)
#pragma unroll
                    for (int rr = 0; rr < 2; ++rr) { const int idx = tg + 256 * rr, row = idx >> 3, ch = idx & 7; const int dsto = im == 0 ? IM_AT : im == 1 ? IM_BT : im == 2 ? IM_KT : IM_RT;
                        *(LAS u32x4*)(L + dsto + row * PT + ch * 16) = pkv[im][rr]; }
                if (wg == 0) GC[lane] = gcv;
                __syncthreads();
            }
            f32x16 accP;
            { f32x16 aab = zero16v(), aak = zero16v(), arb = zero16v(); accP = zero16v();
#pragma unroll
              for (int s = 0; s < 4; ++s) { const bf16x8 at_i = frag_rows(L + IM_AT, ti, s, lane), bt_j = frag_rows(L + IM_BT, tj, s, lane), kt_j = frag_rows(L + IM_KT, ti, s, lane), at_c = frag_rows(L + IM_AT, tj, s, lane),
                                              bt_r = frag_rows(L + IM_BT, ti, s, lane), rt_c = frag_rows(L + IM_RT, tj, s, lane);
                  aab = MMA32(at_i, bt_j, aab); aak = MMA32(kt_j, at_c, aak); arb = MMA32(bt_r, rt_c, arb); accP = MMA32(kt_j, rt_c, accP); }
#pragma unroll
              for (int r = 0; r < 16; ++r) { const int row = 32 * ti + (r & 3) + 8 * (r >> 2) + 4 * h, col = 32 * tj + c32;
                  F[row * FP + col] = col < row ? aab[r] : 0.f; aak[r] = row < col ? aak[r] : 0.f; arb[r] = row <= col ? arb[r] : 0.f; accP[r] = row <= col ? accP[r] : 0.f; }
              store_T(aak, L + IM_AAK, ti, tj, lane);
              store_T(arb, L + IM_ARB, ti, tj, lane); }
            __syncthreads();
            { float Wc[64]; const int col = 32 * wg + c32; const LAS unsigned char* src = col < 64 ? L + IM_AT + col * 2 : L + IM_AAK + (col - 64) * 2;
              const LAS float* Fo = OPAQUE_LDS(F);
#pragma unroll
              for (int i = 0; i < 64; ++i) Wc[i] = bf2f(*(const LAS bf16*)(src + i * PT));
#pragma unroll
              for (int i = 1; i < 64; ++i) { float a0 = Wc[i], a1 = 0.f, a2 = 0.f, a3 = 0.f;
#pragma unroll
                  for (int j4 = 0; j4 < (i + 3) / 4; ++j4) { const f32x4 f = *(const LAS f32x4*)(Fo + i * FP + 4 * j4); a0 += f[0] * Wc[4 * j4]; a1 += f[1] * Wc[4 * j4 + 1]; a2 += f[2] * Wc[4 * j4 + 2]; a3 += f[3] * Wc[4 * j4 + 3];
                      if ((j4 & 7) == 7) PIN4(a0, a1, a2, a3); }
                  PIN4(a0, a1, a2, a3); Wc[i] = (a0 + a1) + (a2 + a3); }
              __syncthreads();
              if (h == 0) { LAS unsigned char* dst = (col < 64 ? L + IM_AT + col * PT : L + IM_AAK + (col - 64) * PT);
#pragma unroll
                  for (int i8 = 0; i8 < 8; ++i8) { u32x4 w; w.x = pk2(Wc[8 * i8], Wc[8 * i8 + 1]); w.y = pk2(Wc[8 * i8 + 2], Wc[8 * i8 + 3]); w.z = pk2(Wc[8 * i8 + 4], Wc[8 * i8 + 5]); w.w = pk2(Wc[8 * i8 + 6], Wc[8 * i8 + 7]); *(LAS u32x4*)(dst + i8 * 16) = w; } }
              bf16 vtmp[16];
#pragma unroll
              for (int ii = 0; ii < 16; ++ii) { const int tl = dir ? 15 - ii : ii; vtmp[ii] = RV[4096 + (16 * wg + tl) * 64 + lane]; }
#pragma unroll
              for (int ii = 0; ii < 16; ++ii) { const int i = 16 * (dir ? 3 - wg : wg) + ii; *(LAS bf16*)(L + IM_F + i * PT + lane * 2) = vtmp[ii]; }
            }
            __syncthreads();
            { f32x16 q;
#pragma unroll
              for (int g = 0; g < 4; ++g) { const u32x2 w = *(const LAS u32x2*)(L + IM_RT + (32 * tj + c32) * PT + (32 * ti + 8 * g + 4 * h) * 2); q[4 * g] = bflo(w.x); q[4 * g + 1] = bfhi(w.x); q[4 * g + 2] = bflo(w.y); q[4 * g + 3] = bfhi(w.y); }
#pragma unroll
              for (int s = 0; s < 4; ++s) { const bf16x8 arb = frag_rows(L + IM_ARB, tj, s, lane); q = MMA32(frag_rows(L + IM_AT, ti, s, lane), arb, q); accP = MMA32(frag_rows(L + IM_AAK, ti, s, lane), arb, accP); }
              if (live) {
#pragma unroll
                  for (int g = 0; g < 4; ++g) { u32x2 w; w.x = pk2(q[4 * g], q[4 * g + 1]); w.y = pk2(q[4 * g + 2], q[4 * g + 3]); *(u32x2*)(QH + ci * 4096 + (32 * tj + c32) * 64 + 32 * ti + 8 * g + 4 * h) = w; } }
            }
            __syncthreads();
            store_T(accP, L + IM_RT, ti, tj, lane);
            __syncthreads();
            { f32x16 y = zero16v(), m = zero16v(), n;
#pragma unroll
              for (int g = 0; g < 4; ++g) { const u32x2 w = *(const LAS u32x2*)(L + IM_KT + (32 * tj + c32) * PT + (32 * ti + 8 * g + 4 * h) * 2); n[4 * g] = bflo(w.x); n[4 * g + 1] = bfhi(w.x); n[4 * g + 2] = bflo(w.y); n[4 * g + 3] = bfhi(w.y); }
              bf16x8 btj[4], bti[4], vfj[4]; frag_cols4(L + IM_BT, tj, lane, btj); frag_cols4(L + IM_BT, ti, lane, bti); frag_cols4(L + IM_F, tj, lane, vfj);
#pragma unroll
              for (int s = 0; s < 4; ++s) { const bf16x8 btc_j = btj[s], btc_i = bti[s];
                  y = MMA32(frag_rows(L + IM_RT, ti, s, lane), vfj[s], y);
                  m = MMA32(frag_rows(L + IM_AT, ti, s, lane), btc_j, m);
                  n = MMA32(btc_i, frag_rows(L + IM_AAK, tj, s, lane), n); }
              const float gck = GC[32 * tj + c32];
#pragma unroll
              for (int r = 0; r < 16; ++r) { const int row = 32 * ti + (r & 3) + 8 * (r >> 2) + 4 * h, col = 32 * tj + c32; m[r] = (m[r] + (row == col ? 1.0f : 0.f)) * gck; n[r] *= GC[row]; }
              if (live) {
#pragma unroll
                  for (int g = 0; g < 4; ++g) *(f32x4*)(YL + ci * 4096 + ((wg * 4 + g) * 64 + lane) * 4) = (f32x4){y[4 * g], y[4 * g + 1], y[4 * g + 2], y[4 * g + 3]};
#pragma unroll
                  for (int s2 = 0; s2 < 2; ++s2) *(bf16x8*)(MF + ci * 4096 + ((wg * 2 + s2) * 64 + lane) * 8) = pack8(m, s2); }
              store_T(n, L + IM_ARB, ti, tj, lane);
            }
            __syncthreads();
            { f32x16 gacc = zero16v(); bf16x8 nfi[4], vfj[4]; frag_cols4(L + IM_ARB, ti, lane, nfi); frag_cols4(L + IM_F, tj, lane, vfj);
#pragma unroll
              for (int s = 0; s < 4; ++s) gacc = MMA32(nfi[s], vfj[s], gacc);
              if (live) {
#pragma unroll
                  for (int hf = 0; hf < 2; ++hf) { u32x4 w; w.x = pk2(gacc[8 * hf], gacc[8 * hf + 1]); w.y = pk2(gacc[8 * hf + 2], gacc[8 * hf + 3]); w.z = pk2(gacc[8 * hf + 4], gacc[8 * hf + 5]); w.w = pk2(gacc[8 * hf + 6], gacc[8 * hf + 7]);
                      *(u32x4*)((unsigned*)GF + ci * 2048 + ((wg * 2 + hf) * 64 + lane) * 4) = w; } }
            }
        }
    }
    __syncthreads();
}
struct R2Buf { bf16x8 mf[8]; u32x4 g[4]; };
DI void rw2_load(R2Buf& b, const bf16* MF, const unsigned* GFu, size_t item, int tj, int lane) {
#pragma unroll
    for (int q = 0; q < 8; ++q) b.mf[q] = *(const bf16x8*)(MF + item * 4096 + (q * 64 + lane) * 8);
#pragma unroll
    for (int kt = 0; kt < 2; ++kt)
#pragma unroll
        for (int hf = 0; hf < 2; ++hf) b.g[kt * 2 + hf] = *(const u32x4*)(GFu + item * 2048 + (((kt * 2 + tj) * 2 + hf) * 64 + lane) * 4);
}
DI void rw2_step(const R2Buf& b, f32x16& s0, f32x16& s1, bf16* SF, size_t item, int tj, int lane) {
    bf16x8 sf[2][2];
#pragma unroll
    for (int s = 0; s < 2; ++s) { sf[0][s] = pack8(s0, s); sf[1][s] = pack8(s1, s); *(bf16x8*)(SF + item * 4096 + (((0 * 2 + tj) * 2 + s) * 64 + lane) * 8) = sf[0][s]; *(bf16x8*)(SF + item * 4096 + (((1 * 2 + tj) * 2 + s) * 64 + lane) * 8) = sf[1][s]; }
    f32x16 n0, n1;
#pragma unroll
    for (int hf = 0; hf < 2; ++hf) { const u32x4 a = b.g[hf], c = b.g[2 + hf];
        n0[8 * hf] = bflo(a.x); n0[8 * hf + 1] = bfhi(a.x); n0[8 * hf + 2] = bflo(a.y); n0[8 * hf + 3] = bfhi(a.y); n0[8 * hf + 4] = bflo(a.z); n0[8 * hf + 5] = bfhi(a.z); n0[8 * hf + 6] = bflo(a.w); n0[8 * hf + 7] = bfhi(a.w);
        n1[8 * hf] = bflo(c.x); n1[8 * hf + 1] = bfhi(c.x); n1[8 * hf + 2] = bflo(c.y); n1[8 * hf + 3] = bfhi(c.y); n1[8 * hf + 4] = bflo(c.z); n1[8 * hf + 5] = bfhi(c.z); n1[8 * hf + 6] = bflo(c.w); n1[8 * hf + 7] = bfhi(c.w); }
#pragma unroll
    for (int kp = 0; kp < 2; ++kp)
#pragma unroll
        for (int s = 0; s < 2; ++s) { n0 = MMA32(b.mf[(kp * 2 + 0) * 2 + s], sf[kp][s], n0); n1 = MMA32(b.mf[(kp * 2 + 1) * 2 + s], sf[kp][s], n1); }
    s0 = n0; s1 = n1;
}
DI void ph_rw2(const Ctx& C) {
    const int lane = C.lane;
    const bf16* MF = (const bf16*)(C.ws + WS_MF); const unsigned* GFu = (const unsigned*)(C.ws + WS_GF); bf16* SF = (bf16*)(C.ws + WS_SF);
    const int nwork = RSTR * 2;
    for (int wk = C.wave == 0 ? C.bid : nwork; wk < nwork; wk += C.G) {
        const int tj = wk & 1, stream = wk >> 1; const size_t it0 = (size_t)stream * RCK;
        f32x16 s0 = zero16v(), s1 = zero16v();
        R2Buf A, B, Cb;
        rw2_load(A, MF, GFu, it0, tj, lane); rw2_load(B, MF, GFu, it0 + (1 < RCK ? 1 : 0), tj, lane); rw2_load(Cb, MF, GFu, it0 + (2 < RCK ? 2 : 0), tj, lane);
        for (int c = 0; c < RCK; c += 3) {
            rw2_step(A, s0, s1, SF, it0 + c, tj, lane); rw2_load(A, MF, GFu, it0 + (c + 3 < RCK ? c + 3 : RCK - 1), tj, lane);
            if (c + 1 < RCK) { rw2_step(B, s0, s1, SF, it0 + c + 1, tj, lane); rw2_load(B, MF, GFu, it0 + (c + 4 < RCK ? c + 4 : RCK - 1), tj, lane); }
            if (c + 2 < RCK) { rw2_step(Cb, s0, s1, SF, it0 + c + 2, tj, lane); rw2_load(Cb, MF, GFu, it0 + (c + 5 < RCK ? c + 5 : RCK - 1), tj, lane); }
        }
    }
}
DI void ph_rw3(const Ctx& C, int l, int mrows) {
    const int lane = C.lane, wg = C.wave & 3, grp = C.wave >> 2, ti = wg >> 1, tj = wg & 1, c32 = lane & 31, h = lane >> 5;
    LAS float* Ysum = (LAS float*)(C.lds + grp * RW_HALF);
    const bf16* QH = (const bf16*)(C.ws + WS_QH); const float* YL = (const float*)(C.ws + WS_YL); const bf16* SF = (const bf16*)(C.ws + WS_SF); bf16* OB = (bf16*)(C.ws + WS_OB);
    const int nblk = (TC + T) / 64, nitems = NB * NH * nblk;
    for (int it0 = 2 * C.bid; it0 < nitems; it0 += 2 * C.G) {
        const int item = it0 + grp; const bool live = item < nitems; const int itc = live ? item : nitems - 1;
        const int tb = itc % nblk, hd = (itc / nblk) % NH, b = itc / (nblk * NH);
        const int rowb = tb < TC / 64 ? M_LAT + b * TC + 64 * tb : b * T + 64 * (tb - TC / 64);
        __syncthreads();
        f32x4 yl[2][4]; u32x4 qa[2][4]; bf16x8 sb[2][4];
#pragma unroll
        for (int dir = 0; dir < 2; ++dir) {
            const int c = dir == 0 ? tb : (tb < TC / 64 ? TC / 64 - 1 - tb : TC / 64 + (T / 64 - 1 - (tb - TC / 64)));
            const size_t ci = ((size_t)((b * NH + hd) * 2 + dir)) * RCK + c;
#pragma unroll
            for (int g = 0; g < 4; ++g) yl[dir][g] = *(const f32x4*)(YL + ci * 4096 + ((wg * 4 + g) * 64 + lane) * 4);
#pragma unroll
            for (int kp = 0; kp < 2; ++kp)
#pragma unroll
                for (int s = 0; s < 2; ++s) { const bf16* qp = QH + ci * 4096 + (32 * ti + c32) * 64 + 32 * kp + 16 * s + 4 * h; const u32x2 lo = *(const u32x2*)qp, hi = *(const u32x2*)(qp + 8);
                    qa[dir][kp * 2 + s].x = lo.x; qa[dir][kp * 2 + s].y = lo.y; qa[dir][kp * 2 + s].z = hi.x; qa[dir][kp * 2 + s].w = hi.y;
                    sb[dir][kp * 2 + s] = *(const bf16x8*)(SF + ci * 4096 + (((kp * 2 + tj) * 2 + s) * 64 + lane) * 8); }
        }
#pragma unroll
        for (int dir = 0; dir < 2; ++dir) {
            f32x16 y;
#pragma unroll
            for (int g = 0; g < 4; ++g) { const f32x4 a = yl[dir][g]; y[4 * g] = a[0]; y[4 * g + 1] = a[1]; y[4 * g + 2] = a[2]; y[4 * g + 3] = a[3]; }
#pragma unroll
            for (int q4 = 0; q4 < 4; ++q4) y = MMA32(__builtin_bit_cast(bf16x8, qa[dir][q4]), sb[dir][q4], y);
#pragma unroll
            for (int r = 0; r < 16; ++r) { const int i = 32 * ti + (r & 3) + 8 * (r >> 2) + 4 * h, tk = dir ? 63 - i : i; LAS float* p = Ysum + tk * FP + 32 * tj + c32; if (dir == 0) *p = y[r]; else *p += y[r]; }
            __syncthreads();
        }
        if (live) {
            const int cch = hd * 64 + lane; const float rk = C.in[I_RWRK][((size_t)l * NH + hd) * 64 + lane], gw = C.in[I_RWGNW][(size_t)l * GW + cch], gb = C.in[I_RWGNB][(size_t)l * GW + cch];
#pragma unroll 1
            for (int t4 = 0; t4 < 16; t4 += 8) {
                bf16 rb[8], vb[8], kb[8], gb8[8];
#pragma unroll
                for (int u = 0; u < 8; ++u) { const bf16* rv = (const bf16*)(C.ws + WS_RVKG) + (size_t)item * 4 * 4096 + (16 * wg + t4 + u) * 64 + lane; rb[u] = rv[0]; vb[u] = rv[4096]; kb[u] = rv[8192]; gb8[u] = rv[12288]; }
#pragma unroll
                for (int u = 0; u < 8; ++u) { const int tk = 16 * wg + t4 + u, row = rowb + tk; const float r = bf2f(rb[u]), v = bf2f(vb[u]), ks = bf2f(kb[u]), gg = bf2f(gb8[u]);
                    float y = Ysum[tk * FP + lane] + wave_sum(r * ks * rk) * v;
                    const float mu = wave_sum(y) * (1.f / 64.f), dlt = y - mu, var = wave_sum(dlt * dlt) * (1.f / 64.f);
                    if (row < mrows) OB[(size_t)row * D + GW + cch] = (bf16)f2bf((dlt * __builtin_amdgcn_rsqf(var + RW_GN_EPS) * gw + gb) * gg); } }
        }
    }
    __syncthreads();
}
constexpr int S5X_OFF = NW * 16640;
DI void ph_s5scan(const Ctx& C, int l, int first_block, int nblocks) {
    constexpr int nc_ctx = TC / S5L, nc_lat = T / S5L, ntot = nc_ctx + nc_lat, SEG = ntot / NW;
    static_assert(ntot % NW == 0 && S5X_OFF + NW * 64 * 8 <= MISC_OFF, "S5 scan segmentation");
    if ((int)C.bid < first_block || (int)C.bid >= first_block + nblocks) return;
    const float* XE = (const float*)(C.ws + WS_XEND); bf16* UG = (bf16*)(C.ws + WS_UG);
    const f32x2* LAM = (const f32x2*)(C.ws + WS_S5T + (size_t)l * SZ_S5L + OFF_S5LAM);
    LAS f32x2* XCH = (LAS f32x2*)(C.lds + S5X_OFF);
    for (int combo = C.bid - first_block; combo < NB * 2 * S5G; combo += nblocks) {
        const int g = combo % S5G, dir = (combo / S5G) & 1, b = combo / (2 * S5G), n = C.lane, seg = C.wave;
        const f32x2 lm = LAM[(dir * S5G + g) * 64 + n];
        float er[SEG], ei[SEG];
#pragma unroll
        for (int u = 0; u < SEG; ++u) { const int i = seg * SEG + u; const int ch = i < nc_ctx ? (M_LAT + b * TC) / S5L + (dir ? nc_ctx - 1 - i : i) : (b * T) / S5L + (dir ? nc_lat - 1 - (i - nc_ctx) : (i - nc_ctx));
            const float* p = XE + ((size_t)g * NCHP + ch) * 256 + dir * 128 + n; er[u] = p[0]; ei[u] = p[64]; }
        float pr = lm[0], pi = lm[1];
#pragma unroll 1
        for (int u = 1; u < SEG; ++u) { const float tr = pr * lm[0] - pi * lm[1], ti2 = pr * lm[1] + pi * lm[0]; pr = tr; pi = ti2; }
        float xr = 0.f, xi = 0.f;
#pragma unroll
        for (int u = 0; u < SEG; ++u) { const float nr = lm[0] * xr - lm[1] * xi + er[u], ni = lm[0] * xi + lm[1] * xr + ei[u]; xr = nr; xi = ni; }
        XCH[seg * 64 + n] = (f32x2){xr, xi};
        __syncthreads();
        xr = 0.f; xi = 0.f;
        for (int s2 = 0; s2 < seg; ++s2) { const f32x2 e = XCH[s2 * 64 + n]; const float nr = pr * xr - pi * xi + e[0], ni = pr * xi + pi * xr + e[1]; xr = nr; xi = ni; }
        __syncthreads();
#pragma unroll
        for (int u = 0; u < SEG; ++u) { const int i = seg * SEG + u; const int ch = i < nc_ctx ? (M_LAT + b * TC) / S5L + (dir ? nc_ctx - 1 - i : i) : (b * T) / S5L + (dir ? nc_lat - 1 - (i - nc_ctx) : (i - nc_ctx));
            bf16* q = UG + ((size_t)g * NCHP + ch) * S5K + 512 + dir * 128 + n; q[0] = (bf16)f2bf(xr); q[64] = (bf16)f2bf(xi);
            const float nr = lm[0] * xr - lm[1] * xi + er[u], ni = lm[0] * xi + lm[1] * xr + ei[u]; xr = nr; xi = ni; }
    }
}

constexpr int PH_PRO = 3, PH_PER_L = 13, NPH = PH_PRO + PH_PER_L * NL;
#ifndef PROBE_REP
#define PROBE_REP -1
#endif
#define NREP(k) ((k) == PROBE_REP ? 2 : 1)
#ifdef ONLY
#define EN(k) ((k) == ONLY)
#else
#define EN(k) true
#endif
#ifdef EMU
void fwd(Args args) {
    unsigned char* lds = emu::lds_base();
#else
__global__ void __launch_bounds__(NTHR, 2) fwd(Args args) {
    extern __shared__ __attribute__((aligned(16))) unsigned char lds[];
#endif
    Ctx C; C.in = args.in; C.out = args.out; C.ws = args.ws; C.lds = (LAS unsigned char*)lds;
    C.tid = threadIdx.x; C.lane = C.tid & 63; C.wave = __builtin_amdgcn_readfirstlane(C.tid >> 6); C.G = gridDim.x; C.bid = blockIdx.x;
#define REFRESH() do { int t_ = threadIdx.x; OPAQUE(t_); C.tid = t_; C.lane = t_ & 63; C.wave = __builtin_amdgcn_readfirstlane(t_ >> 6); } while (0)
    volatile LAS unsigned* MISC = (volatile LAS unsigned*)(C.lds + MISC_OFF);
    if (C.tid < 32) MISC[C.tid] = 0u;
    __syncthreads();
    const int lo = args.ph_lo, hi = args.ph_hi;
    const bool use_bar = (hi - lo) > 1;
    XcdBarrier bar; bar.bar = (unsigned*)(C.ws + WS_CTL) + CW_BAR; bar.x = 0; bar.st = MISC + 8;
    if (use_bar) bar = xcd_barrier_post((unsigned*)(C.ws + WS_CTL) + CW_BAR, MISC + 8);
#define IN(k) (lo <= (k) && (k) < hi)
#define SEAM(k) do { if (IN(k) && IN((k) + 1)) xcd_barrier(bar); } while (0)
    if (EN(0) && IN(0)) for (int rep = 0; rep < NREP(0); ++rep) { REFRESH(); ph_ada(C); }
    SEAM(0);
    if (EN(1) && IN(1)) { REFRESH(); ph_conv(C); }
    SEAM(1);
    if (EN(2) && IN(2)) for (int rep = 0; rep < NREP(2); ++rep) { REFRESH(); ph_tab(C); }
    SEAM(2);
    for (int l = 0; l < NL; ++l) {
        const int pb = PH_PRO + PH_PER_L * l; const bool want_ctx = l < NL - 1;
        const int mrows_full = M, mrows_out = want_ctx ? M : M_LAT;
        const int nt_attn = AT_NA + AT_WA + (want_ctx ? 2 * AT_CX : 0), nt_attn_a = (int)((long)nt_attn * ATTN_A_PCT / 100);
        bf16* AP = (bf16*)(C.ws + WS_AP); bf16* Hb = (bf16*)(C.ws + WS_H); bf16* OB = (bf16*)(C.ws + WS_OB);
        if (EN(3) && IN(pb + 0)) for (int rep = 0; rep < NREP(3); ++rep) { REFRESH();
            Gemm g{AP, wl(C, l, OFF_W1GU), D, D, D, 0, 0}; Order S; S.init(mrows_full / 256, 2 * FF / 256, 1, C.G, C.bid, D / 64);
            EpiGU E{rowss_ptr(C, l, 0), bias_ptr(C, l, 0), Hb, mrows_full}; gemm_phase(C.lds, g, S, E);
            if (EN(1) && l + 1 < NL) { REFRESH(); const int r = S.total % C.G;
                if ((int)C.bid >= r) conv_weights(C, l + 1, (C.bid - r) * NW + C.wave, (C.G - r) * NW, 0, CI_X1); } }
        SEAM(pb + 0);
        if (EN(4) && IN(pb + 1)) { REFRESH();
            Gemm g{Hb, wl(C, l, OFF_W1D), FF, FF, FF, 0, 0}; Order S; S.init(M_LAT / 256, D / 256, 1, C.G, C.bid, FF / 64);
            EpiRes E{&C, gate_ptr(C, l, 0, 0), gs_ptr(C, l, 1, 0), rowss_ptr(C, l, 1), AP}; gemm_phase(C.lds, g, S, E);
            { REFRESH(); Order S2; S2.init_split(M_LAT / 256, M_CTX / 256, D / 256, 4, C.G, C.bid, FF / 64); EpiAcc E2{&C, gate_ptr(C, l, 0, 0)}; gemm_phase(C.lds, g, S2, E2); } }
        SEAM(pb + 1);
        if (EN(18) && IN(pb + 2)) { REFRESH(); ph_ctxfix(C, gs_ptr(C, l, 1, 0), rowss_ptr(C, l, 1)); }
        SEAM(pb + 2);
        if (EN(5) && IN(pb + 3)) for (int rep = 0; rep < NREP(5); ++rep) { REFRESH();
            Gemm g{AP, wl(C, l, OFF_WIN), D, D, D, 0, 0}; Order S; S.init(mrows_full / 256, NT_IN, 1, C.G, C.bid, D / 64);
            EpiIn E{&C, rowss_ptr(C, l, 1), bias_ptr(C, l, 1), l}; gemm_phase(C.lds, g, S, E); }
        SEAM(pb + 3);
        if (IN(pb + 4)) {
            if (EN(6)) for (int rep = 0; rep < NREP(6); ++rep) { REFRESH(); Gemm g{(const bf16*)(C.ws + WS_UG), (const bf16*)(C.ws + WS_S5T + (size_t)l * SZ_S5L + OFF_S5ET), S5K, 512, 512, (size_t)NCHP * S5K * 2, (size_t)256 * 512 * 2};
              const int off5 = C.G >= 256 ? 32 : 0; Order S; S.init(NCHP / 256, 1, S5G, C.G - off5, (int)C.bid < off5 ? (1 << 28) : (int)C.bid - off5, 512 / 64);        EpiS5A E{(float*)(C.ws + WS_XEND)}; gemm_phase(C.lds, g, S, E); }
            __syncthreads();
            for (int rep = 0; rep < NREP(9); ++rep) { if (EN(9)) { REFRESH(); ph_rw1(C, l); } }
            if (EN(7)) for (int rep = 0; rep < NREP(7); ++rep) { REFRESH(); const int fb = (C.G >= 256 && 2 * C.G < RBLK && RBLK % (2 * C.G) != 0) ? (RBLK % (2 * C.G) + 1) / 2 : 0;
                ph_attn(C, l, want_ctx, C.bid >= fb ? (C.bid - fb) * NW + C.wave : -1, (C.G - fb) * NW, 0, nt_attn_a); }
        }
        SEAM(pb + 4);
        if (IN(pb + 5)) {
            if (EN(17)) for (int rep = 0; rep < NREP(17); ++rep) { REFRESH(); ph_rw2(C); }
            if (EN(10)) for (int rep = 0; rep < NREP(10); ++rep) { REFRESH(); ph_s5scan(C, l, C.G >= 256 ? 64 : 0, C.G >= 256 ? 128 : C.G); }
            { REFRESH();
              const int nrb = C.G < RSTR * 2 ? C.G : RSTR * 2, sb_lo = C.G, sb_hi = C.G;
              const int nworkers = nrb * 7 + (C.G - nrb - (sb_hi - sb_lo)) * NW;
              const int widx = C.bid < nrb ? (C.wave == 0 ? -1 : C.bid * 7 + C.wave - 1) : (C.bid >= sb_lo && C.bid < sb_hi) ? -1 : nrb * 7 + (C.bid - nrb - (C.bid >= sb_hi ? sb_hi - sb_lo : 0)) * NW + C.wave;
              if (EN(7)) ph_attn(C, l, want_ctx, widx, nworkers, nt_attn_a, nt_attn); }
        }
        SEAM(pb + 5);
        if (IN(pb + 6)) {
            if (EN(11)) for (int rep = 0; rep < NREP(11); ++rep) { REFRESH(); Gemm g{(const bf16*)(C.ws + WS_UG), (const bf16*)(C.ws + WS_S5T + (size_t)l * SZ_S5L + OFF_S5BT), S5K, S5K, S5K, (size_t)NCHP * S5K * 2, (size_t)512 * S5K * 2};
              const int off5 = C.G >= 256 ? 64 : 0; Order S; S.init(NCHP / 256, 2, S5G, C.G - off5, (int)C.bid < off5 ? (1 << 28) : (int)C.bid - off5, S5K / 64);        EpiS5C E{(const bf16*)(C.ws + WS_UG), C.in[I_S5D] + (size_t)l * GW, (bf16*)(C.ws + WS_YG)}; gemm_phase(C.lds, g, S, E); }
            if (EN(12)) for (int rep = 0; rep < NREP(12); ++rep) { REFRESH(); ph_rw3(C, l, mrows_out); }
        }
        SEAM(pb + 6);
        if (EN(13) && IN(pb + 7)) for (int rep = 0; rep < NREP(13); ++rep) { REFRESH();
            Gemm g{(const bf16*)(C.ws + WS_YG), wl(C, l, OFF_WGLU), GW, GW, GW, 0, 0}; Order S; S.init(mrows_out / 256, GW / 256, 1, C.G, C.bid, GW / 64);
            EpiGLU E{(const bf16*)(C.ws + WS_YG), C.in[I_S5GLUB] + (size_t)l * GW, OB}; gemm_phase(C.lds, g, S, E); }
        SEAM(pb + 7);
        if (EN(14) && IN(pb + 8)) { REFRESH();
            Gemm g{OB, wl(C, l, OFF_WOUT), D, D, D, 0, 0}; Order S; S.init(M_LAT / 256, D / 256, 1, C.G, C.bid, D / 64);
            EpiRes E{&C, gate_ptr(C, l, 1, 0), gs_ptr(C, l, 2, 0), rowss_ptr(C, l, 2), AP}; gemm_phase(C.lds, g, S, E);
            if (want_ctx) { REFRESH(); Order S2; S2.init_split(M_LAT / 256, M_CTX / 256, D / 256, 4, C.G, C.bid, D / 64); EpiAcc E2{&C, gate_ptr(C, l, 1, 0)}; gemm_phase(C.lds, g, S2, E2); } }
        SEAM(pb + 8);
        if (EN(18) && IN(pb + 9) && want_ctx) { REFRESH(); ph_ctxfix(C, gs_ptr(C, l, 2, 0), rowss_ptr(C, l, 2)); }
        SEAM(pb + 9);
        if (EN(15) && IN(pb + 10)) { REFRESH();
            Gemm g{AP, wl(C, l, OFF_W2GU), D, D, D, 0, 0}; Order S; S.init(mrows_out / 256, 2 * FF / 256, 1, C.G, C.bid, D / 64);
            EpiGU E{rowss_ptr(C, l, 2), bias_ptr(C, l, 2), Hb, mrows_out}; gemm_phase(C.lds, g, S, E);
            if (EN(1) && l + 1 < NL) { REFRESH(); const int r = S.total % C.G;
                if ((int)C.bid >= r) conv_weights(C, l + 1, (C.bid - r) * NW + C.wave, (C.G - r) * NW, CI_X1, CI_LAYER); } }
        SEAM(pb + 10);
        if (EN(16) && IN(pb + 11)) { REFRESH();
            Gemm g{Hb, wl(C, l, OFF_W2D), FF, FF, FF, 0, 0}; Order S; S.init(M_LAT / 256, D / 256, 1, C.G, C.bid, FF / 64);
            const bool more = l + 1 < NL;
            EpiRes E{&C, gate_ptr(C, l, 2, 0), more ? gs_ptr(C, l + 1, 0, 0) : nullptr, more ? rowss_ptr(C, l + 1, 0) : nullptr, AP}; gemm_phase(C.lds, g, S, E);
            if (want_ctx) { REFRESH(); Order S2; S2.init_split(M_LAT / 256, M_CTX / 256, D / 256, 4, C.G, C.bid, FF / 64); EpiAcc E2{&C, gate_ptr(C, l, 2, 0)}; gemm_phase(C.lds, g, S2, E2); } }
        SEAM(pb + 11);
        if (EN(18) && IN(pb + 12) && want_ctx) { REFRESH(); ph_ctxfix(C, gs_ptr(C, l + 1, 0, 0), rowss_ptr(C, l + 1, 0)); }
        SEAM(pb + 12);
    }
#undef IN
#undef SEAM
}

#ifndef MK_PER_PHASE
#define MK_PER_PHASE 0
#endif
#ifdef EMU
int g_emu_grid = 4, g_emu_lo = 0, g_emu_hi = NPH;
#endif
extern "C" void kernel_launch(void* const* d_in, const int* in_sizes, int n_in, void* d_out, int out_size, void* d_ws, size_t ws_size, hipStream_t stream) {
    Args a{};
    for (int i = 0; i < 42; ++i) a.in[i] = (const float*)d_in[i];
    a.out = (float*)d_out; a.ws = (unsigned char*)d_ws;
#ifdef EMU
    if (g_emu_lo == 0) hipMemsetAsync(d_ws, 0, WS_ZERO_END, stream);
    for (int ph = g_emu_lo; ph < g_emu_hi; ++ph) { a.ph_lo = ph; a.ph_hi = ph + 1; fprintf(stderr, "phase %d\n", ph); emu::launch(g_emu_grid, NTHR, LDS_BYTES, [=] { fwd(a); }); }
#else
    static int grid = 0;
    if (grid == 0) {
        if (n_in != 42 || out_size != M_LAT * D || ws_size < WS_END) { fprintf(stderr, "kernel_launch: unexpected shapes (n_in %d out %d ws %zu need %zu)\n", n_in, out_size, ws_size, (size_t)WS_END); grid = -1; return; }
        int dev = 0, cus = 0;
        if (hipGetDevice(&dev) != hipSuccess || hipDeviceGetAttribute(&cus, hipDeviceAttributeMultiprocessorCount, dev) != hipSuccess) { grid = -1; return; }
        if (hipFuncSetAttribute((const void*)fwd, hipFuncAttributeMaxDynamicSharedMemorySize, LDS_BYTES) != hipSuccess) { fprintf(stderr, "kernel_launch: hipFuncSetAttribute failed\n"); grid = -1; return; }
        int per_cu = 0; (void)hipOccupancyMaxActiveBlocksPerMultiprocessor(&per_cu, (const void*)fwd, NTHR, LDS_BYTES); (void)hipGetLastError();
        if (per_cu < 1) fprintf(stderr, "kernel_launch: occupancy query reports %d\n", per_cu);
        grid = cus;
    }
    if (grid < 0) return;
    (void)hipMemsetAsync(d_ws, 0, WS_ZERO_END, stream);
#if MK_PER_PHASE
    for (int ph = 0; ph < NPH; ++ph) { a.ph_lo = ph; a.ph_hi = ph + 1; hipLaunchKernelGGL(fwd, dim3(grid), dim3(NTHR), LDS_BYTES, stream, a); }
#else
    a.ph_lo = 0; a.ph_hi = NPH;
    hipLaunchKernelGGL(fwd, dim3(grid), dim3(NTHR), LDS_BYTES, stream, a);
#endif
#endif
}
```

```cpp
#ifdef EMU
#include "emu/emu.h"
#define LAS
#define GAS
#define ASMV(...) ((void)0)
#define WSYNC() do { int _z = 0; (void)emu::wave_gather(&_z, 4); } while (0)
#define OPAQUE(x) ((void)0)
#define OPAQUE_S(x) ((void)0)
#define PIN(x) ((void)0)
#define PIN4(a, b, c, d) ((void)0)
#define OPAQUE_LDS(p) (p)
#else
#include <hip/hip_runtime.h>
#include <cstdio>
#include <cstdint>
#define LAS __attribute__((address_space(3)))
#define GAS __attribute__((address_space(1)))
#define ASMV(...) asm volatile(__VA_ARGS__)
#define PIN(x) asm volatile("" : "+v"(x) :: "memory")
#define PIN4(a, b, c, d) asm volatile("" : "+v"(a), "+v"(b), "+v"(c), "+v"(d) :: "memory")
template <class P> __device__ __forceinline__ P opaque_lds(P p) { unsigned a = (unsigned)(size_t)p; asm volatile("" : "+v"(a)); return (P)(size_t)a; }
#define OPAQUE_LDS(p) opaque_lds(p)
#define OPAQUE_S(x) asm volatile("" : "+s"(x))
#define OPAQUE(x) asm volatile("" : "+v"(x))
#define WSYNC() asm volatile("s_waitcnt lgkmcnt(0)" ::: "memory")
#endif

#ifdef EMU
constexpr int D = 1024, NB = 2, T = 1024, NL = 2, TC = 256, FF = 1024;
#else
constexpr int D = 2048, NB = 2, T = 8192, NL = 4, TC = 256, FF = 5632;
#endif
constexpr int GW = D / 4, NH = GW / 64, WAG = NH / 2, S5G = GW / 16, GRW = 64, GRH = T / GRW;
constexpr int M_LAT = NB * T, M_CTX = NB * TC, M = M_LAT + M_CTX, NPAN = M / 256;
constexpr int TP = GW / 256;
constexpr int NT_IN = 8 * TP + 2, NINP = NT_IN * 256, D_IN = 8 * GW + 416;
constexpr int PN_AQ = 0, PN_AK = TP, PN_AV = 2 * TP, PN_BR = 3 * TP, PN_BK = 4 * TP, PN_BV = 5 * TP, PN_BS = 6 * TP, PN_CQ = 6 * TP + 1, PN_CKV = 7 * TP + 1, PN_DU = 7 * TP + 2;
constexpr int SRC_AQ = 0, SRC_AK = GW, SRC_AV = 2 * GW, SRC_BR = 3 * GW, SRC_BK = 4 * GW, SRC_BV = 5 * GW, SRC_BS = 6 * GW, SRC_CQ = 6 * GW + 160, SRC_CK = 7 * GW + 160, SRC_CV = 7 * GW + 288, SRC_DU = 7 * GW + 416;
constexpr int S5L = 32, NCH = M / S5L, NCHP = ((NCH + 255) / 256) * 256, S5K = 768;
constexpr int NW = 8, NTHR = 512;
constexpr float NORM_EPS = 1e-6f, RW_GN_EPS = 64e-5f;

typedef unsigned short bf16;
typedef short bf16x8 __attribute__((ext_vector_type(8)));
typedef short s16x4 __attribute__((ext_vector_type(4)));
typedef float f32x4 __attribute__((ext_vector_type(4)));
typedef float f32x2 __attribute__((ext_vector_type(2)));
typedef float f32x16 __attribute__((ext_vector_type(16)));
typedef unsigned u32x4 __attribute__((ext_vector_type(4)));
typedef unsigned u32x2 __attribute__((ext_vector_type(2)));
#define DI __device__ __forceinline__

constexpr size_t al256(size_t x) { return (x + 255) & ~(size_t)255; }
constexpr size_t SZ_BIAS_GU = (size_t)3 * 2 * FF * 4, SZ_BIAS_IN = (size_t)3 * NINP * 4;
constexpr size_t WS_CTL = 0;
constexpr size_t WS_BIAS = 65536;
constexpr size_t SZ_BIAS_L = 2 * SZ_BIAS_GU + SZ_BIAS_IN;
constexpr size_t WS_ROWSS = al256(WS_BIAS + NL * SZ_BIAS_L);
constexpr size_t WS_ZERO_END = al256(WS_ROWSS + (size_t)NL * 3 * M * 4);
constexpr size_t WS_MODV = WS_ZERO_END;
constexpr size_t WS_GS = al256(WS_MODV + (size_t)NL * 3 * 9 * D * 4);
constexpr size_t WS_GATE = al256(WS_GS + (size_t)NL * 9 * D * 4);
constexpr size_t WS_ROPE = al256(WS_GATE + (size_t)NL * 9 * D * 4);
constexpr size_t SZ_WGU = (size_t)2 * FF * D * 2, SZ_WD = (size_t)D * FF * 2, SZ_WIN = (size_t)NINP * D * 2, SZ_WOUT = (size_t)D * D * 2, SZ_WGLU = (size_t)GW * GW * 2;
constexpr size_t OFF_W1GU = 0, OFF_W1D = OFF_W1GU + SZ_WGU, OFF_WIN = OFF_W1D + SZ_WD, OFF_WOUT = OFF_WIN + SZ_WIN, OFF_W2GU = OFF_WOUT + SZ_WOUT, OFF_W2D = OFF_W2GU + SZ_WGU, OFF_WGLU = OFF_W2D + SZ_WD, SZ_WL = OFF_WGLU + SZ_WGLU;
constexpr size_t WS_W = al256(WS_ROPE + 128 * 16 * 8);
constexpr size_t SZ_S5KC = (size_t)S5G * 2 * S5L * 256 * 4, SZ_S5ET = (size_t)S5G * 256 * 512 * 2, SZ_S5BT = (size_t)S5G * 512 * S5K * 2, SZ_S5LAM = (size_t)2 * GW * 4 * 8;
constexpr size_t SZ_S5LP = (size_t)2 * S5G * 64 * (S5L + 1) * 8, SZ_S5BETA = (size_t)2 * S5G * 64 * 16 * 8;
constexpr size_t OFF_S5KC = 0, OFF_S5ET = OFF_S5KC + SZ_S5KC, OFF_S5BT = OFF_S5ET + SZ_S5ET, OFF_S5LAM = OFF_S5BT + SZ_S5BT, OFF_S5LP = al256(OFF_S5LAM + SZ_S5LAM), OFF_S5BETA = OFF_S5LP + SZ_S5LP, SZ_S5L = al256(OFF_S5BETA + SZ_S5BETA);
constexpr size_t WS_S5T = al256(WS_W + NL * SZ_WL);
constexpr size_t WS_XC = al256(WS_S5T + NL * SZ_S5L);
constexpr size_t WS_AP = al256(WS_XC + (size_t)M_CTX * D * 4);
constexpr size_t WS_H = al256(WS_AP + (size_t)M * D * 2);
constexpr size_t WS_QA = al256(WS_H + (size_t)M * FF * 2);
constexpr size_t WS_KA = WS_QA + (size_t)M * GW * 2, WS_VA = WS_KA + (size_t)M * GW * 2, WS_QC = WS_VA + (size_t)M * GW * 2;
constexpr size_t WS_KC = WS_QC + (size_t)M * GW * 2, WS_VC = WS_KC + (size_t)M * 128 * 2;
constexpr size_t WS_PB = WS_VC + (size_t)M * 128 * 2;
constexpr size_t WS_PS = al256(WS_PB + (size_t)M * 3 * GW * 2);
constexpr size_t WS_UG = al256(WS_PS + (size_t)M * 160 * 4);
constexpr size_t WS_RW = al256(WS_UG + (size_t)S5G * NCHP * S5K * 2);
constexpr size_t SZ_RWA = (size_t)M * GW * 4;
enum { RW_R = 0, RW_V, RW_NKK, RW_G, RW_W0, RW_W1, RW_K0, RW_K1, RW_B0, RW_B1, RW_Y0, RW_Y1, RW_NARR };
constexpr size_t WS_XEND = al256(WS_RW + 256);
constexpr size_t WS_YG = al256(WS_XEND + (size_t)S5G * NCHP * 256 * 4);
constexpr size_t WS_OB = al256(WS_YG + (size_t)M * GW * 2);
constexpr int RCK = (TC + T) / 64, RSTR = NB * NH * 2, RITEM = RSTR * RCK;
constexpr size_t WS_QH = al256(WS_OB + (size_t)M * D * 2);
constexpr size_t WS_YL = al256(WS_QH + (size_t)RITEM * 8192);
constexpr size_t WS_MF = al256(WS_YL + (size_t)RITEM * 16384);
constexpr size_t WS_GF = al256(WS_MF + (size_t)RITEM * 8192);
constexpr size_t WS_SF = al256(WS_GF + (size_t)RITEM * 16384);
constexpr int RBLK = NB * NH * ((TC + T) / 64);
constexpr size_t WS_RVKG = al256(WS_SF + (size_t)RITEM * 8192);
constexpr size_t SZ_RWF = (size_t)14 * NH * 2 * 64 * 16;
constexpr size_t WS_RWF = al256(WS_RVKG + (size_t)RBLK * 32768);
constexpr size_t WS_RWS = al256(WS_RWF + NL * SZ_RWF);
constexpr size_t WS_END = al256(WS_RWS + (size_t)512 * 2 * 65536);
constexpr int CW_BAR = 1024;

constexpr int LDS_BYTES = 147456, RING_BYTES = 131072, MISC_OFF = LDS_BYTES - 256;

DI unsigned f2bf(float f) { unsigned u = __float_as_uint(f); return (u + 0x7fffu + ((u >> 16) & 1u)) >> 16; }
#ifdef EMU
DI unsigned pk2(float lo, float hi) { return f2bf(lo) | (f2bf(hi) << 16); }
#else
typedef __bf16 hbf16x2 __attribute__((ext_vector_type(2)));
DI unsigned pk2(float lo, float hi) { const f32x2 v = {lo, hi}; const hbf16x2 b = __builtin_convertvector(v, hbf16x2); return __builtin_bit_cast(unsigned, b); }
#endif
DI float bf2f(unsigned short b) { return __uint_as_float(((unsigned)b) << 16); }
DI float bflo(unsigned w) { return __uint_as_float(w << 16); }
DI float bfhi(unsigned w) { return __uint_as_float(w & 0xffff0000u); }
template <int N> DI float ror_add(float v) { return v + __int_as_float(__builtin_amdgcn_mov_dpp(__float_as_int(v), 0x120 + N, 0xf, 0xf, true)); }
DI float row16_sum(float v) { v = ror_add<8>(v); v = ror_add<4>(v); v = ror_add<2>(v); v = ror_add<1>(v); return v; }
DI float wave_sum(float v) {
    v = row16_sum(v);
    const float a = __int_as_float(__builtin_amdgcn_readlane(__float_as_int(v), 0)), b = __int_as_float(__builtin_amdgcn_readlane(__float_as_int(v), 16)),
                c = __int_as_float(__builtin_amdgcn_readlane(__float_as_int(v), 32)), d = __int_as_float(__builtin_amdgcn_readlane(__float_as_int(v), 48));
    return (a + b) + (c + d);
}
DI float siluf(float x) { return x * __builtin_amdgcn_rcpf(1.f + __expf(-x)); }
DI float fast_tanh(float x) { const float e = __expf(2.f * x); return 1.f - 2.f * __builtin_amdgcn_rcpf(e + 1.f); }
DI float sigmf(float x) { return __builtin_amdgcn_rcpf(1.f + __expf(-x)); }
DI float geluf(float x) { const float z = 0.7978845608028654f * (x + 0.044715f * x * x * x); const float e = __expf(2.f * z); return 0.5f * x * (1.f + (1.f - 2.f * __builtin_amdgcn_rcpf(e + 1.f))); }
DI int stream_of_row(int row) { return row < M_LAT ? row / T : NB; }
DI int stream_of_panel(int pm) { return stream_of_row(pm * 256); }

#define XB_TMO      128
#define XB_XCNT(j)  (256  + 64 * (j))
#define XB_XSUB(j)  (1280 + 64 * (j))
#define XB_XGEN(j)  (2304 + 64 * (j))
#define XB_TOP      3328
#define XB_TOPGEN   3392
#define XCD_BAR_WORDS 3456
#define XB_SPIN_CAP (1u << 18)
DI unsigned xb_ld(unsigned* p)              { return __hip_atomic_load(p, __ATOMIC_RELAXED, __HIP_MEMORY_SCOPE_AGENT); }
DI unsigned xb_add(unsigned* p, unsigned v) { return __hip_atomic_fetch_add(p, v, __ATOMIC_RELAXED, __HIP_MEMORY_SCOPE_AGENT); }
DI unsigned xb_xcc_id() { return (unsigned)__builtin_amdgcn_s_getreg((3 << 11) | 20) & 0xFu; }
#define XB_SPIN(cond, bar) do { unsigned _sp = 0; while (cond) { __builtin_amdgcn_s_sleep(1); \
    if ((++_sp & 255u) == 0u) { if (xb_ld(&(bar)[XB_TMO])) break; if (_sp > XB_SPIN_CAP) { atomicAdd(&(bar)[XB_TMO], 1u); break; } } } } while (0)
struct XcdBarrier { unsigned* bar; unsigned x; volatile LAS unsigned* st; };
DI XcdBarrier xcd_barrier_post(unsigned* bar, volatile LAS unsigned* st) {
    XcdBarrier b; b.bar = bar; b.x = xb_xcc_id(); b.st = st;
    if (threadIdx.x == 0) (void)xb_add(&bar[XB_XCNT(b.x)], 1u);
    return b;
}
DI void xcd_barrier_complete(unsigned* bar, unsigned x, unsigned& nloc, unsigned& nx) {
    const unsigned G = gridDim.x * gridDim.y * gridDim.z;
    unsigned sum, cnt, mine, sp = 0u;
    for (;;) {
        sum = 0u; cnt = 0u; mine = 0u;
#pragma unroll
        for (unsigned j = 0; j < 16; ++j) { const unsigned c = xb_ld(&bar[XB_XCNT(j)]); sum += c; cnt += (c > 0u) ? 1u : 0u; mine = (j == x) ? c : mine; }
        if (sum == G) break;
        __builtin_amdgcn_s_sleep(1);
        if ((++sp & 255u) == 0u) { if (xb_ld(&bar[XB_TMO])) break; if (sp > XB_SPIN_CAP) { atomicAdd(&bar[XB_TMO], 1u); break; } }
    }
    nloc = mine > 0u ? mine : 1u; nx = cnt > 0u ? cnt : 1u;
}
DI void xcd_barrier(const XcdBarrier& b) {
    ASMV("s_waitcnt vmcnt(0)" ::: "memory");
    __syncthreads();
    if (threadIdx.x == 0) {
        unsigned* bar = b.bar;
        __builtin_amdgcn_s_waitcnt(0);
        unsigned nloc = b.st[0], nx = b.st[1];
        if (nloc == 0u) { xcd_barrier_complete(bar, b.x, nloc, nx); b.st[0] = nloc; b.st[1] = nx; }
        const unsigned old = xb_add(&bar[XB_XSUB(b.x)], 1u);
        const unsigned gen = old / nloc;
        if (old + 1u == (gen + 1u) * nloc) {
            __builtin_amdgcn_fence(__ATOMIC_RELEASE, "agent");
            ASMV("s_waitcnt vmcnt(0)" ::: "memory");
            const unsigned og = xb_add(&bar[XB_TOP], 1u);
            const unsigned tg = og / nx;
            if (og + 1u == (tg + 1u) * nx) xb_add(&bar[XB_TOPGEN], 1u);
            else XB_SPIN(xb_ld(&bar[XB_TOPGEN]) == tg, bar);
            __builtin_amdgcn_fence(__ATOMIC_ACQUIRE, "agent");
            xb_add(&bar[XB_XGEN(b.x)], 1u);
            ASMV("s_waitcnt vmcnt(0)" ::: "memory");
        } else {
            XB_SPIN(xb_ld(&bar[XB_XGEN(b.x)]) == gen, bar);
            __builtin_amdgcn_fence(__ATOMIC_ACQUIRE, "agent");
            ASMV("s_waitcnt vmcnt(0)" ::: "memory");
        }
    }
    __syncthreads();
}

constexpr int BK = 64, HALF = 128, HTB = HALF * BK * 2, NXCD = 8, WGM = 4;
DI int lds_byte(int r, int c) { const int st = (r >> 4) * 2 + (c >> 5), rr = r & 15, cc = c & 31, ob = rr * 64 + cc * 2; return st * 1024 + (ob ^ (((ob >> 9) & 1) << 5)); }
DI void stage_rc(int b, int& R, int& C) { const int st = b / 1024, sb = b % 1024, swz = sb ^ (((sb >> 9) & 1) << 5); R = (st >> 1) * 16 + swz / 64; C = (st & 1) * 32 + (swz % 64) / 2; }
struct Unit { int pm, pn, z, kt0; };
struct Gemm { const bf16* A; const bf16* Bt; int lda, ldb, K; size_t zA, zB; };
struct Order {
    int nM, nN, nZ, per, total, G, c, nkt, pm0, spl;
    DI void init(int nM_, int nN_, int nZ_, int G_, int c_, int nkt_) { nM = nM_; nN = nN_; nZ = nZ_; per = nM * nN; total = per * nZ; G = G_; c = c_; nkt = nkt_; pm0 = 0; spl = 0; }
    DI void init_split(int pm0_, int xM, int nN_, int spl_, int G_, int c_, int nkt_full) { nM = xM; nN = nN_; nZ = 1; per = xM * nN_ * spl_; total = per; G = G_; c = c_; nkt = nkt_full / spl_; pm0 = pm0_; spl = spl_; }
    DI bool next(int i, Unit& u) const {
        const long L = (long)i * G + c; if (L >= total) return false;
        if (spl) { const int j = (int)L; u.z = 0; u.pm = pm0 + j / (nN * spl); const int rem = j % (nN * spl); u.pn = rem / spl; u.kt0 = (rem % spl) * nkt; return true; }
        u.kt0 = 0;
        u.z = (int)(L / per); int wgid = (int)(L % per);
        { const int q = per / NXCD, r = per % NXCD, xcd = wgid % NXCD, off = wgid / NXCD; wgid = (xcd < r ? xcd * (q + 1) : r * (q + 1) + (xcd - r) * q) + off; }
        const int nig = WGM * nN, gid = wgid / nig, fm = gid * WGM, gsz = (nM - fm) < WGM ? (nM - fm) : WGM;
        u.pm = fm + ((wgid % nig) % gsz); u.pn = (wgid % nig) / gsz; return true;
    }
};

template <class Epi>
DI void gemm_phase(LAS unsigned char* lds, const Gemm g, const Order& S, const Epi& E) {
    int tid_ = threadIdx.x; OPAQUE(tid_);
    const int tid = tid_, wid = __builtin_amdgcn_readfirstlane(tid >> 6), lane = tid & 63, wr = wid >> 2, wc = wid & 3, fr = lane & 15, fq = lane >> 4;
    Unit cur, nxt; int ui = 0;
    if (!S.next(0, cur)) return;
    f32x4 acc[2][2][4][2];
#ifdef EMU
    (void)lds;
    for (;; ++ui) {
        if (ui > 0) { if (!S.next(ui, cur)) break; }
        const bf16* A = (const bf16*)((const char*)g.A + cur.z * g.zA); const bf16* B = (const bf16*)((const char*)g.Bt + cur.z * g.zB);
        for (int ai = 0; ai < 2; ++ai) for (int bj = 0; bj < 2; ++bj) for (int m = 0; m < 4; ++m) for (int n = 0; n < 2; ++n) for (int j = 0; j < 4; ++j) {
            const int r = 256 * cur.pm + 128 * ai + 64 * wr + 16 * m + fr, c = 256 * cur.pn + 128 * bj + 32 * wc + 16 * n + 4 * fq + j;
            const bf16* a = A + (size_t)r * g.lda; const bf16* b = B + (size_t)c * g.ldb; float s = 0.f;
            for (int k = cur.kt0 * BK; k < (cur.kt0 + S.nkt) * BK; ++k) s += bf2f(a[k]) * bf2f(b[k]);
            acc[ai][bj][m][n][j] = s; }
        E(acc, cur, wr, wc, fr, fq);
    }
#else
    unsigned voffA[2], voffB[2];
#pragma unroll
    for (int i = 0; i < 2; ++i) { int R, C; stage_rc(tid * 16 + i * 8192, R, C); voffA[i] = (unsigned)(R * g.lda + C) * 2u; voffB[i] = (unsigned)(R * g.ldb + C) * 2u; }
    const size_t kstep = (size_t)(BK * 2);
    const size_t hstepA = (size_t)HALF * g.lda * 2, hstepB = (size_t)HALF * g.ldb * 2, tstepA = 2 * hstepA, tstepB = 2 * hstepB;
    const unsigned ldsw = (unsigned)wid * 1024u;
    const int aoff = lds_byte(wr * 64 + fr, fq * 8), boff = lds_byte(wc * 32 + fr, fq * 8);
#define PG8_SA(b, h) (((b) * 2 + (h)) * HTB)
#define PG8_SB(b, h) ((4 + (b) * 2 + (h)) * HTB)
#define PG8_STAGE(bufoff, gbase, voff) do { _Pragma("unroll") for (int _i = 0; _i < 2; ++_i) \
        __builtin_amdgcn_global_load_lds((const unsigned*)((const char*)(gbase) + (voff)[_i]), (LAS unsigned*)(lds + (bufoff) + ldsw + _i * 8192), 16, 0, 0); } while (0)
#define PG8_LDA(dst, b, h) do { _Pragma("unroll") for (int m = 0; m < 4; ++m) _Pragma("unroll") for (int k = 0; k < 2; ++k) dst[m][k] = *(const LAS bf16x8*)(lds + PG8_SA(b, h) + aoff + m * 2048 + k * 1024); } while (0)
#define PG8_LDB(dst, b, h) do { _Pragma("unroll") for (int n = 0; n < 2; ++n) _Pragma("unroll") for (int k = 0; k < 2; ++k) dst[n][k] = *(const LAS bf16x8*)(lds + PG8_SB(b, h) + boff + n * 2048 + k * 1024); } while (0)
#define PG8_MMA(ai, bj, At, Bt) do { __builtin_amdgcn_s_setprio(1); _Pragma("unroll") for (int m = 0; m < 4; ++m) _Pragma("unroll") for (int n = 0; n < 2; ++n) _Pragma("unroll") for (int k = 0; k < 2; ++k) \
        acc[ai][bj][m][n] = __builtin_amdgcn_mfma_f32_16x16x32_bf16(Bt[n][k], At[m][k], acc[ai][bj][m][n], 0, 0, 0); __builtin_amdgcn_s_setprio(0); } while (0)
#define PG8_WAIT_V(n) asm volatile("s_waitcnt vmcnt(" #n ")" ::: "memory")
#define PG8_WAIT_L(n) asm volatile("s_waitcnt lgkmcnt(" #n ")" ::: "memory")
#define PG8_BAR __builtin_amdgcn_s_barrier()
#define PG8_SCHED __builtin_amdgcn_sched_barrier(0)
#pragma unroll
    for (int a = 0; a < 2; ++a)
#pragma unroll
        for (int b = 0; b < 2; ++b)
#pragma unroll
            for (int m = 0; m < 4; ++m)
#pragma unroll
                for (int n = 0; n < 2; ++n) acc[a][b][m][n] = (f32x4){0.f, 0.f, 0.f, 0.f};
    bf16x8 At[4][2], B0[2][2], B1[2][2];
    const char* cA = (const char*)g.A + (size_t)cur.z * g.zA + (size_t)cur.pm * tstepA + (size_t)cur.kt0 * kstep; const char* cB = (const char*)g.Bt + (size_t)cur.z * g.zB + (size_t)cur.pn * tstepB + (size_t)cur.kt0 * kstep;
    PG8_STAGE(PG8_SB(0, 0), cB, voffB); PG8_STAGE(PG8_SB(0, 1), cB + hstepB, voffB); PG8_STAGE(PG8_SA(0, 0), cA, voffA); PG8_STAGE(PG8_SA(0, 1), cA + hstepA, voffA);
    if (wr == 1) PG8_BAR;
    PG8_WAIT_V(2); PG8_BAR;
    PG8_STAGE(PG8_SB(1, 0), cB + kstep, voffB); PG8_STAGE(PG8_SA(1, 0), cA + kstep, voffA); PG8_STAGE(PG8_SB(1, 1), cB + hstepB + kstep, voffB);
    PG8_WAIT_V(6); PG8_BAR;
    for (;;) {
        const bool has_next = S.next(ui + 1, nxt);
        const char* nA = has_next ? (const char*)g.A + (size_t)nxt.z * g.zA + (size_t)nxt.pm * tstepA + (size_t)nxt.kt0 * kstep : cA; const char* nB = has_next ? (const char*)g.Bt + (size_t)nxt.z * g.zB + (size_t)nxt.pn * tstepB + (size_t)nxt.kt0 * kstep : cB;
        const int nt = S.nkt;
        for (int t = 0; t < nt; t += 2) {
            const bool last = (t == nt - 2);
            const char* a1 = cA + (size_t)(t + 1) * kstep;
            const char* a2 = last ? nA : cA + (size_t)(t + 2) * kstep; const char* b2 = last ? nB : cB + (size_t)(t + 2) * kstep;
            const char* a3 = a2 + kstep; const char* b3 = b2 + kstep;
            PG8_LDB(B0, 0, 0); PG8_LDB(B1, 0, 1); PG8_SCHED; PG8_LDA(At, 0, 0); PG8_STAGE(PG8_SA(1, 1), a1 + hstepA, voffA);
            PG8_WAIT_V(8); PG8_WAIT_L(0); PG8_BAR; PG8_MMA(0, 0, At, B0); PG8_MMA(0, 1, At, B1); PG8_BAR; PG8_SCHED;
            PG8_LDA(At, 0, 1); PG8_STAGE(PG8_SB(0, 0), b2, voffB); PG8_STAGE(PG8_SB(0, 1), b2 + hstepB, voffB); PG8_STAGE(PG8_SA(0, 0), a2, voffA);
            PG8_WAIT_V(8); PG8_WAIT_L(0); PG8_BAR; PG8_MMA(1, 0, At, B0); PG8_MMA(1, 1, At, B1); PG8_BAR; PG8_SCHED;
            PG8_LDB(B0, 1, 0); PG8_LDB(B1, 1, 1); PG8_SCHED; PG8_LDA(At, 1, 0); PG8_STAGE(PG8_SA(0, 1), a2 + hstepA, voffA);
            PG8_WAIT_V(8); PG8_WAIT_L(0); PG8_BAR; PG8_MMA(0, 0, At, B0); PG8_MMA(0, 1, At, B1); PG8_BAR; PG8_SCHED;
            PG8_LDA(At, 1, 1); PG8_STAGE(PG8_SB(1, 0), b3, voffB); PG8_STAGE(PG8_SB(1, 1), b3 + hstepB, voffB); PG8_STAGE(PG8_SA(1, 0), a3, voffA);
            PG8_WAIT_V(8); PG8_WAIT_L(0); PG8_BAR; PG8_MMA(1, 0, At, B0); PG8_MMA(1, 1, At, B1); PG8_BAR; PG8_SCHED;
        }
        if (wr == 0) PG8_BAR;
        E(acc, cur, wr, wc, fr, fq);
        if (!has_next) break;
#pragma unroll
        for (int a = 0; a < 2; ++a)
#pragma unroll
            for (int b = 0; b < 2; ++b)
#pragma unroll
                for (int m = 0; m < 4; ++m)
#pragma unroll
                    for (int n = 0; n < 2; ++n) acc[a][b][m][n] = (f32x4){0.f, 0.f, 0.f, 0.f};
        cur = nxt; cA = nA; cB = nB; ++ui;
        if (wr == 1) PG8_BAR;
    }
    PG8_WAIT_V(0);
    PG8_BAR;
#undef PG8_SA
#undef PG8_SB
#undef PG8_STAGE
#undef PG8_LDA
#undef PG8_LDB
#undef PG8_MMA
#undef PG8_WAIT_V
#undef PG8_WAIT_L
#undef PG8_BAR
#undef PG8_SCHED
#endif
}

struct Args {
    const float* in[42]; float* out; unsigned char* ws;
    int ph_lo, ph_hi;
};
struct Ctx {
    const float* const* in; float* out; unsigned char* ws;
    LAS unsigned char* lds; int tid, lane, wave, G, bid;
};
DI float* xrow_ptr(const Ctx& C, int row) { return row < M_LAT ? C.out + (size_t)row * D : (float*)(C.ws + WS_XC) + (size_t)(row - M_LAT) * D; }
DI const bf16* wl(const Ctx& C, int l, size_t off) { return (const bf16*)(C.ws + WS_W + (size_t)l * SZ_WL + off); }
DI float* bias_ptr(const Ctx& C, int l, int which  ) { return (float*)(C.ws + WS_BIAS + (size_t)l * SZ_BIAS_L + (which == 0 ? 0 : which == 1 ? SZ_BIAS_GU : SZ_BIAS_GU + SZ_BIAS_IN)); }
DI float* rowss_ptr(const Ctx& C, int l, int sub) { return (float*)(C.ws + WS_ROWSS) + ((size_t)l * 3 + sub) * M; }
DI const float* gs_ptr(const Ctx& C, int l, int sub, int s) { return (const float*)(C.ws + WS_GS) + (((size_t)l * 3 + sub) * 3 + s) * D; }
DI const float* gate_ptr(const Ctx& C, int l, int sub, int s) { return (const float*)(C.ws + WS_GATE) + (((size_t)l * 3 + sub) * 3 + s) * D; }
DI float* rw_arr(const Ctx& C, int a) { return (float*)(C.ws + WS_RW + (size_t)a * SZ_RWA); }
enum { I_X = 0, I_C, I_CTX, I_CCTX, I_WADA, I_BADA, I_NORMG, I_F1WG, I_F1WU, I_F1WD, I_F2WG, I_F2WU, I_F2WD, I_WIN, I_WOUT, I_NAQG, I_NAKG, I_NARPB, I_RWCONV, I_RWW0, I_RWWUP, I_RWA0, I_RWAUP,
       I_RWGUP, I_RWKK, I_RWKA, I_RWRK, I_RWGNW, I_RWGNB, I_WAQG, I_WAKG, I_WASINK, I_S5ARE, I_S5AIM, I_S5LDT, I_S5BRE, I_S5BIM, I_S5CRE, I_S5CIM, I_S5D, I_S5GLUW, I_S5GLUB, I_NIN };

struct EpiGU {
    const float* rowss; const float* bias  ; bf16* H; int mrows;
    DI void operator()(const f32x4 (&acc)[2][2][4][2], const Unit& u, int wr, int wc, int fr_, int fq_) const {
        int tz_ = threadIdx.x; OPAQUE(tz_); const int fr = tz_ & 15, fq = (tz_ & 63) >> 4; (void)fr_; (void)fq_;
        const int s = stream_of_panel(u.pm); const float* bs = bias + (size_t)s * 2 * FF + u.pn * 256 + wc * 32 + 4 * fq;
        f32x4 bg[2], bu[2];
#pragma unroll
        for (int n = 0; n < 2; ++n) { bg[n] = *(const f32x4*)(bs + 16 * n); bu[n] = *(const f32x4*)(bs + 128 + 16 * n); }
        float rsv[2][4];
#pragma unroll
        for (int ai = 0; ai < 2; ++ai)
#pragma unroll
            for (int m = 0; m < 4; ++m) rsv[ai][m] = rowss[u.pm * 256 + ai * 128 + wr * 64 + m * 16 + fr];
#pragma unroll
        for (int ai = 0; ai < 2; ++ai)
#pragma unroll
            for (int m = 0; m < 4; ++m) {
                const int row = u.pm * 256 + ai * 128 + wr * 64 + m * 16 + fr;
                const float rstd = __builtin_amdgcn_rsqf(rsv[ai][m] * (1.0f / D) + NORM_EPS);
                bf16* hp = H + (size_t)row * FF + u.pn * 128 + wc * 32 + 8 * fq;
                u32x4 w;
                { const f32x4 g = acc[ai][0][m][0] * rstd + bg[0], v = acc[ai][1][m][0] * rstd + bu[0]; w.x = pk2(siluf(g[0]) * v[0], siluf(g[1]) * v[1]); w.y = pk2(siluf(g[2]) * v[2], siluf(g[3]) * v[3]); }
                { const f32x4 g = acc[ai][0][m][1] * rstd + bg[1], v = acc[ai][1][m][1] * rstd + bu[1]; w.z = pk2(siluf(g[0]) * v[0], siluf(g[1]) * v[1]); w.w = pk2(siluf(g[2]) * v[2], siluf(g[3]) * v[3]); }
                *(u32x4*)hp = w;
            }
    }
};
struct EpiRes {
    const Ctx* C; const float* gate  ; const float* gsn  ; float* rowss_next; bf16* AP;
    DI void operator()(const f32x4 (&acc)[2][2][4][2], const Unit& u, int wr, int wc, int fr_, int fq_) const {
        int tz_ = threadIdx.x; OPAQUE(tz_); const int fr = tz_ & 15, fq = (tz_ & 63) >> 4; (void)fr_; (void)fq_;
        const int s = stream_of_panel(u.pm); const int col0 = u.pn * 256 + wc * 32 + 4 * fq;
        f32x4 gv[2][2], sv[2][2];
#pragma unroll
        for (int bj = 0; bj < 2; ++bj)
#pragma unroll
            for (int n = 0; n < 2; ++n) { gv[bj][n] = *(const f32x4*)(gate + (size_t)s * D + col0 + bj * 128 + n * 16); sv[bj][n] = gsn ? *(const f32x4*)(gsn + (size_t)s * D + col0 + bj * 128 + n * 16) : (f32x4){0.f, 0.f, 0.f, 0.f}; }
        f32x4 xc[2][2], xn[2][2];
        { const float* xp0 = xrow_ptr(*C, u.pm * 256 + wr * 64 + fr) + col0;
#pragma unroll
          for (int bj = 0; bj < 2; ++bj)
#pragma unroll
              for (int n = 0; n < 2; ++n) xn[bj][n] = *(const f32x4*)(xp0 + bj * 128 + n * 16); }
#pragma unroll
        for (int ai = 0; ai < 2; ++ai)
#pragma unroll
            for (int m = 0; m < 4; ++m) {
                const int row = u.pm * 256 + ai * 128 + wr * 64 + m * 16 + fr;
                float* xp = xrow_ptr(*C, row) + col0; float ss = 0.f;
#pragma unroll
                for (int bj = 0; bj < 2; ++bj)
#pragma unroll
                    for (int n = 0; n < 2; ++n) xc[bj][n] = xn[bj][n];
                if (ai * 4 + m < 7) { const int rn = ai * 4 + m + 1; const float* xq = xrow_ptr(*C, u.pm * 256 + (rn >> 2) * 128 + wr * 64 + (rn & 3) * 16 + fr) + col0;
#pragma unroll
                    for (int bj = 0; bj < 2; ++bj)
#pragma unroll
                        for (int n = 0; n < 2; ++n) xn[bj][n] = *(const f32x4*)(xq + bj * 128 + n * 16); }
#pragma unroll
                for (int bj = 0; bj < 2; ++bj)
#pragma unroll
                    for (int n = 0; n < 2; ++n) { f32x4 x = xc[bj][n]; x += gv[bj][n] * acc[ai][bj][m][n]; *(f32x4*)(xp + bj * 128 + n * 16) = x;
                        if (gsn) { ss += (x[0] * x[0] + x[1] * x[1]) + (x[2] * x[2] + x[3] * x[3]); const f32x4 a = x * sv[bj][n]; u32x2 w; w.x = pk2(a[0], a[1]); w.y = pk2(a[2], a[3]);
                            *(u32x2*)(AP + (size_t)row * D + col0 + bj * 128 + n * 16) = w; } }
                if (gsn) { ss += __shfl_xor(ss, 16); ss += __shfl_xor(ss, 32); if (fq == 0) atomicAdd(rowss_next + row, ss); }
            }
    }
};
struct EpiAcc {
    const Ctx* C; const float* gate;
    DI void operator()(const f32x4 (&acc)[2][2][4][2], const Unit& u, int wr, int wc, int fr_, int fq_) const {
        int tz_ = threadIdx.x; OPAQUE(tz_); const int fr = tz_ & 15, fq = (tz_ & 63) >> 4; (void)fr_; (void)fq_;
        const int s = stream_of_panel(u.pm); const int col0 = u.pn * 256 + wc * 32 + 4 * fq;
#pragma unroll
        for (int bj = 0; bj < 2; ++bj)
#pragma unroll
            for (int n = 0; n < 2; ++n) { const f32x4 gv = *(const f32x4*)(gate + (size_t)s * D + col0 + bj * 128 + n * 16);
#pragma unroll
                for (int ai = 0; ai < 2; ++ai)
#pragma unroll
                    for (int m = 0; m < 4; ++m) { float* xp = xrow_ptr(*C, u.pm * 256 + ai * 128 + wr * 64 + m * 16 + fr) + col0 + bj * 128 + n * 16; const f32x4 d = gv * acc[ai][bj][m][n];
#pragma unroll
                        for (int j = 0; j < 4; ++j) atomicAdd(xp + j, d[j]); } }
    }
};
struct EpiIn {
    const Ctx* C; const float* rowss; const float* bias  ; int l;
    DI void operator()(const f32x4 (&acc)[2][2][4][2], const Unit& u, int wr, int wc, int fr_, int fq_) const {
        int tz_ = threadIdx.x; OPAQUE(tz_); const int fr = tz_ & 15, fq = (tz_ & 63) >> 4; (void)fr_; (void)fq_;
        const int s = stream_of_panel(u.pm), pn = u.pn; const float* bs = bias + (size_t)s * NINP + pn * 256 + wc * 32 + 4 * fq;
        unsigned char* ws = C->ws;
        f32x4 bv[2][2];
#pragma unroll
        for (int bj = 0; bj < 2; ++bj)
#pragma unroll
            for (int n = 0; n < 2; ++n) bv[bj][n] = *(const f32x4*)(bs + bj * 128 + n * 16);
        float rsv[2][4];
#pragma unroll
        for (int ai = 0; ai < 2; ++ai)
#pragma unroll
            for (int m = 0; m < 4; ++m) rsv[ai][m] = rowss[u.pm * 256 + ai * 128 + wr * 64 + m * 16 + fr];
        const bool permuted = pn < PN_AV || (pn >= PN_CQ && pn < PN_DU);
        if (permuted) {
            const bool is_ckv = pn == PN_CKV, is_c = pn >= PN_CQ, is_q = pn < PN_AK || (pn >= PN_CQ && pn < PN_CKV);
            const bool plain_v = is_ckv && wc >= 2;
            const float* gsrc = C->in[is_c ? (is_q ? I_WAQG : I_WAKG) : (is_q ? I_NAQG : I_NAKG)] + (size_t)l * 64;
            f32x4 gn[2][2];
#pragma unroll
            for (int bj = 0; bj < 2; ++bj)
#pragma unroll
                for (int n = 0; n < 2; ++n) { gn[bj][n] = *(const f32x4*)(gsrc + 32 * bj + 16 * n + 4 * fq); if (is_q) gn[bj][n] *= 0.125f; }
            bf16* dst; int pitch, hcol;
            if (pn < PN_AK) { dst = (bf16*)(ws + WS_QA); pitch = GW; hcol = ((pn - PN_AQ) * 4 + wc) * 64; }
            else if (pn < PN_AV) { dst = (bf16*)(ws + WS_KA) + (size_t)((pn - PN_AK) * 4 + wc) * M * 64; pitch = 64; hcol = 0; }
            else if (pn < PN_CKV) { dst = (bf16*)(ws + WS_QC); pitch = GW; hcol = ((pn - PN_CQ) * 4 + wc) * 64; }
            else if (wc < 2) { dst = (bf16*)(ws + WS_KC) + (size_t)wc * M * 64; pitch = 64; hcol = 0; }
            else { dst = (bf16*)(ws + WS_VC) + (size_t)(wc - 2) * M * 64; pitch = 64; hcol = 0; }
            const f32x4* rope = (const f32x4*)(ws + WS_ROPE);
#pragma unroll
            for (int ai = 0; ai < 2; ++ai)
#pragma unroll
                for (int m = 0; m < 4; ++m) {
                    const int row = pn * 0 + u.pm * 256 + ai * 128 + wr * 64 + m * 16 + fr;
                    const float rstd = __builtin_amdgcn_rsqf(rsv[ai][m] * (1.0f / D) + NORM_EPS);
                    f32x4 v[2][2]; float ss = 0.f;
#pragma unroll
                    for (int bj = 0; bj < 2; ++bj)
#pragma unroll
                        for (int n = 0; n < 2; ++n) { v[bj][n] = acc[ai][bj][m][n] * rstd + bv[bj][n]; ss += (v[bj][n][0] * v[bj][n][0] + v[bj][n][1] * v[bj][n][1]) + (v[bj][n][2] * v[bj][n][2] + v[bj][n][3] * v[bj][n][3]); }
                    ss += __shfl_xor(ss, 16); ss += __shfl_xor(ss, 32);
                    if (!plain_v) { const float rs = 1.0f / sqrtf(ss * (1.0f / 64.0f) + NORM_EPS);
#pragma unroll
                        for (int bj = 0; bj < 2; ++bj)
#pragma unroll
                            for (int n = 0; n < 2; ++n) v[bj][n] = v[bj][n] * rs * gn[bj][n];
                        if (is_c && row < M_LAT) {
                            const int t = row % T; const int pos[2] = {t / GRW, t % GRW};
#pragma unroll
                            for (int bj = 0; bj < 2; ++bj) { const f32x4 cs0 = rope[(pos[bj] * 16 + 4 * fq) / 2], cs1 = rope[(pos[bj] * 16 + 4 * fq) / 2 + 1];
                                const float cc[4] = {cs0[0], cs0[2], cs1[0], cs1[2]}, sn[4] = {cs0[1], cs0[3], cs1[1], cs1[3]};
#pragma unroll
                                for (int j = 0; j < 4; ++j) { const float x1 = v[bj][0][j], x2 = v[bj][1][j]; v[bj][0][j] = x1 * cc[j] - x2 * sn[j]; v[bj][1][j] = x2 * cc[j] + x1 * sn[j]; } }
                        }
                    }
                    bf16* op = dst + (size_t)row * pitch + hcol + 4 * fq;
#pragma unroll
                    for (int bj = 0; bj < 2; ++bj)
#pragma unroll
                        for (int n = 0; n < 2; ++n) { u32x2 w; w.x = pk2(v[bj][n][0], v[bj][n][1]); w.y = pk2(v[bj][n][2], v[bj][n][3]); *(u32x2*)(op + 32 * bj + 16 * n) = w; }
                }
        } else {
#pragma unroll
            for (int ai = 0; ai < 2; ++ai)
#pragma unroll
                for (int m = 0; m < 4; ++m) {
                    const int row = u.pm * 256 + ai * 128 + wr * 64 + m * 16 + fr;
                    const float rstd = __builtin_amdgcn_rsqf(rsv[ai][m] * (1.0f / D) + NORM_EPS);
#pragma unroll
                    for (int bj = 0; bj < 2; ++bj)
#pragma unroll
                        for (int n = 0; n < 2; ++n) { const f32x4 v = acc[ai][bj][m][n] * rstd + bv[bj][n]; const int c = bj * 128 + wc * 32 + n * 16 + 4 * fq;
                            u32x2 w; w.x = pk2(v[0], v[1]); w.y = pk2(v[2], v[3]);
                            if (pn < PN_BR) *(u32x2*)((bf16*)(ws + WS_VA) + ((size_t)((pn - PN_AV) * 4 + bj * 2 + (wc >> 1)) * M + row) * 64 + (wc & 1) * 32 + n * 16 + 4 * fq) = w;
                            else if (pn < PN_BS) *(u32x2*)((bf16*)(ws + WS_PB) + (size_t)row * 3 * GW + (pn - PN_BR) * 256 + c) = w;
                            else if (pn == PN_BS) { if (c < 160) *(f32x4*)((float*)(ws + WS_PS) + (size_t)row * 160 + c) = v; }
                            else { const int cu = (pn - PN_DU) * 256 + c, gq = cu >> 4, p0 = cu & 15;
                                *(u32x2*)((bf16*)(ws + WS_UG) + ((size_t)gq * NCHP + row / S5L) * S5K + (row % S5L) * 16 + p0) = w; } }
                }
        }
    }
};
struct EpiS5A {
    float* XE;
    DI void operator()(const f32x4 (&acc)[2][2][4][2], const Unit& u, int wr, int wc, int fr_, int fq_) const {
        int tz_ = threadIdx.x; OPAQUE(tz_); const int fr = tz_ & 15, fq = (tz_ & 63) >> 4; (void)fr_; (void)fq_;
#pragma unroll
        for (int ai = 0; ai < 2; ++ai)
#pragma unroll
            for (int m = 0; m < 4; ++m) { const int ch = u.pm * 256 + ai * 128 + wr * 64 + m * 16 + fr; if (ch < NCH) { float* p = XE + ((size_t)u.z * NCHP + ch) * 256 + wc * 32 + 4 * fq;
#pragma unroll
                for (int bj = 0; bj < 2; ++bj)
#pragma unroll
                    for (int n = 0; n < 2; ++n) *(f32x4*)(p + bj * 128 + n * 16) = acc[ai][bj][m][n]; } }
    }
};
struct EpiS5C {
    const bf16* UG; const float* dsk  ; bf16* YG;
    DI void operator()(const f32x4 (&acc)[2][2][4][2], const Unit& u, int wr, int wc, int fr_, int fq_) const {
        int tz_ = threadIdx.x; OPAQUE(tz_); const int fr = tz_ & 15, fq = (tz_ & 63) >> 4; (void)fr_; (void)fq_;
        const int g = u.z;
#pragma unroll
        for (int ai = 0; ai < 2; ++ai)
#pragma unroll
            for (int m = 0; m < 4; ++m) { const int ch = u.pm * 256 + ai * 128 + wr * 64 + m * 16 + fr; if (ch < NCH) {
#pragma unroll
                for (int bj = 0; bj < 2; ++bj)
#pragma unroll
                    for (int n = 0; n < 2; ++n) { const int col = u.pn * 256 + bj * 128 + wc * 32 + n * 16 + 4 * fq, i = col >> 4, p0 = col & 15;
                        const u32x2 uw = *(const u32x2*)(UG + ((size_t)g * NCHP + ch) * S5K + col); const f32x4 dv = *(const f32x4*)(dsk + 16 * g + p0);
                        const f32x4 a = acc[ai][bj][m][n]; const float y0 = a[0] + dv[0] * bflo(uw.x), y1 = a[1] + dv[1] * bfhi(uw.x), y2 = a[2] + dv[2] * bflo(uw.y), y3 = a[3] + dv[3] * bfhi(uw.y);
                        u32x2 w; w.x = pk2(geluf(y0), geluf(y1)); w.y = pk2(geluf(y2), geluf(y3));
                        *(u32x2*)(YG + (size_t)(ch * S5L + i) * GW + 16 * g + p0) = w; } } }
    }
};
struct EpiGLU {
    const bf16* YG; const float* gb; bf16* OB;
    DI void operator()(const f32x4 (&acc)[2][2][4][2], const Unit& u, int wr, int wc, int fr_, int fq_) const {
        int tz_ = threadIdx.x; OPAQUE(tz_); const int fr = tz_ & 15, fq = (tz_ & 63) >> 4; (void)fr_; (void)fq_;
#pragma unroll
        for (int ai = 0; ai < 2; ++ai)
#pragma unroll
            for (int m = 0; m < 4; ++m) { const int row = u.pm * 256 + ai * 128 + wr * 64 + m * 16 + fr;
#pragma unroll
                for (int bj = 0; bj < 2; ++bj)
#pragma unroll
                    for (int n = 0; n < 2; ++n) { const int col = u.pn * 256 + bj * 128 + wc * 32 + n * 16 + 4 * fq; const f32x4 b = *(const f32x4*)(gb + col); const f32x4 a = acc[ai][bj][m][n] + b;
                        const u32x2 yw = *(const u32x2*)(YG + (size_t)row * GW + col);
                        u32x2 w; w.x = pk2(bflo(yw.x) * sigmf(a[0]), bfhi(yw.x) * sigmf(a[1])); w.y = pk2(bflo(yw.y) * sigmf(a[2]), bfhi(yw.y) * sigmf(a[3]));
                        *(u32x2*)(OB + (size_t)row * D + 3 * GW + col) = w; } }
    }
};

DI void ph_ada(const Ctx& C) {
    LAS float* sc = (LAS float*)C.lds;
    LAS float* red = sc + 3 * D;
    for (int i = C.tid; i < 3 * D; i += NTHR) { const int s = i / D, k = i % D; const float c = s < NB ? C.in[I_C][s * D + k] : C.in[I_CCTX][k]; sc[i] = siluf(c); }
    __syncthreads();
    constexpr int ACW = 64, ALPR = ACW / 4, ARPW = 64 / ALPR;
    const int nun = NL * (9 * D / ACW);
    for (int un = C.bid; un < nun; un += C.G) {
        const int l = un / (9 * D / ACW), col0 = (un % (9 * D / ACW)) * ACW, c4 = C.lane % ALPR, sub = C.lane / ALPR;
        const float* W = C.in[I_WADA] + (size_t)l * D * 9 * D + col0 + 4 * c4;
        f32x4 a0 = {0.f, 0.f, 0.f, 0.f}, a1 = a0, a2 = a0;
        const int k0 = C.wave * (D / 8);
#pragma unroll 1
        for (int kb = k0; kb < k0 + D / 8; kb += 16 * ARPW) {
            f32x4 wv[16];
#pragma unroll
            for (int u = 0; u < 16; ++u) wv[u] = *(const f32x4*)(W + (size_t)(kb + u * ARPW + sub) * 9 * D);
#pragma unroll
            for (int u = 0; u < 16; ++u) { const int kr = kb + u * ARPW + sub; a0 += wv[u] * sc[kr]; a1 += wv[u] * sc[D + kr]; a2 += wv[u] * sc[2 * D + kr]; } }
        LAS float* r = red + (C.wave * ARPW + sub) * (3 * ACW) + 4 * c4;
        *(LAS f32x4*)(r) = a0; *(LAS f32x4*)(r + ACW) = a1; *(LAS f32x4*)(r + 2 * ACW) = a2;
        __syncthreads();
        for (int i = C.tid; i < 3 * ACW; i += NTHR) { float s = 0.f;
#pragma unroll
            for (int w = 0; w < 8 * ARPW; ++w) s += red[w * (3 * ACW) + i];
            const int st = i / ACW, c = col0 + (i % ACW);
            ((float*)(C.ws + WS_MODV))[((size_t)l * 3 + st) * 9 * D + c] = s + C.in[I_BADA][(size_t)l * 9 * D + c]; }
        __syncthreads();
    }
}
DI const float* modv_ptr(const Ctx& C, int l, int s, int chunk) { return (const float*)(C.ws + WS_MODV) + ((size_t)l * 3 + s) * 9 * D + (size_t)chunk * D; }

DI int win_dest(int n) {
    if (n >= D_IN) return -1;
    if (n < SRC_AV) { const int piece = n / GW, loc = n % GW, head = loc / 64, d = loc % 64; return ((piece == 0 ? PN_AQ : PN_AK) + head / 4) * 256 + 128 * (d / 32) + 32 * (head % 4) + (d % 32); }
    if (n < SRC_BS) return PN_AV * 256 + (n - SRC_AV);
    if (n < SRC_CQ) return PN_BS * 256 + (n - SRC_BS);
    if (n < SRC_CK) { const int loc = n - SRC_CQ, head = loc / 64, d = loc % 64; return (PN_CQ + head / 4) * 256 + 128 * (d / 32) + 32 * (head % 4) + (d % 32); }
    if (n < SRC_DU) { const int loc = n - SRC_CK, hh = loc / 64, d = loc % 64; return PN_CKV * 256 + 128 * (d / 32) + 32 * hh + (d % 32); }
    return PN_DU * 256 + (n - SRC_DU);
}
DI int gu_dest(int n) { const int e = n & 31; return (n / 128) * 256 + (n % 128 - e) + 16 * ((e >> 2) & 1) + 4 * (e >> 3) + (e & 3); }
DI void conv_item(const Ctx& C, const float* W, int K, int N, bf16* Wt, int mode, int k0, int n0, float* bias, int bias_pitch, const float* shift  ) {
    LAS float* scr = (LAS float*)(C.lds + C.wave * 16640);
    const int n = n0 + C.lane; const bool ok = n < N; float b0 = 0.f, b1 = 0.f, b2 = 0.f;
#pragma unroll 1
    for (int kh = 0; kh < 4; ++kh) {
        float wv[16];
#pragma unroll
        for (int kk = 0; kk < 16; ++kk) wv[kk] = ok ? W[(size_t)(k0 + 16 * kh + kk) * N + n] : 0.f;
#pragma unroll
        for (int kk = 0; kk < 16; ++kk) { const float v = wv[kk]; scr[(16 * kh + kk) * 65 + C.lane] = v;
            if (bias) { b0 += shift[k0 + 16 * kh + kk] * v; b1 += shift[9 * D + k0 + 16 * kh + kk] * v; b2 += shift[18 * D + k0 + 16 * kh + kk] * v; } } }
    WSYNC();
    const int dme = !ok ? -1 : mode == 0 ? n : mode == 1 ? gu_dest(n) : mode == 2 ? gu_dest(n) + 128 : win_dest(n);
    if (bias && dme >= 0) { atomicAdd(bias + dme, b0); atomicAdd(bias + bias_pitch + dme, b1); atomicAdd(bias + 2 * bias_pitch + dme, b2); }
    const int c = C.lane & 7;
#pragma unroll
    for (int i = 0; i < 8; ++i) { const int nl = (C.lane >> 3) + 8 * i, nn = n0 + nl;
        const int dr = nn >= N ? -1 : mode == 0 ? nn : mode == 1 ? gu_dest(nn) : mode == 2 ? gu_dest(nn) + 128 : win_dest(nn);
        const LAS float* s = scr + (8 * c) * 65 + nl;
        u32x4 o; o.x = pk2(s[0], s[65]); o.y = pk2(s[2 * 65], s[3 * 65]); o.z = pk2(s[4 * 65], s[5 * 65]); o.w = pk2(s[6 * 65], s[7 * 65]);
        if (dr >= 0) *(u32x4*)(Wt + (size_t)dr * K + k0 + 8 * c) = o; }
    WSYNC();
}
struct Cplx { float re, im; };
DI Cplx cmul(Cplx a, Cplx b) { return Cplx{a.re * b.re - a.im * b.im, a.re * b.im + a.im * b.re}; }
DI Cplx s5_lam_pow(const Ctx& C, int l, int dir, int g, int n, float tau) {
    const size_t i = (((size_t)l * 2 + dir) * S5G + g) * 64 + n; const float dt = __expf(C.in[I_S5LDT][((size_t)l * 2 + dir) * S5G + g]);
    const float mag = __expf(tau * dt * C.in[I_S5ARE][i]), ang = tau * dt * C.in[I_S5AIM][i]; float sn, cs; sincosf(ang, &sn, &cs); return Cplx{mag * cs, mag * sn};
}
DI Cplx s5_coef(const Ctx& C, int l, int dir, int g, int n) {
    const size_t i = (((size_t)l * 2 + dir) * S5G + g) * 64 + n; const float are = C.in[I_S5ARE][i], aim = C.in[I_S5AIM][i];
    const Cplx ab = s5_lam_pow(C, l, dir, g, n, 1.0f); const float den = are * are + aim * aim, nr = ab.re - 1.0f;
    return Cplx{(nr * are + ab.im * aim) / den, (ab.im * are - nr * aim) / den};
}
DI Cplx s5_beta(const Ctx& C, int l, int dir, int g, int n, int q) {
    const size_t i = (((size_t)l * S5G + g) * 64 + n) * 16 + q; return cmul(s5_coef(C, l, dir, g, n), Cplx{C.in[I_S5BRE][i], C.in[I_S5BIM][i]});
}
DI Cplx s5_gamma(const Ctx& C, int l, int g, int p, int n) { const size_t i = (((size_t)l * S5G + g) * 16 + p) * 64 + n; return Cplx{C.in[I_S5CRE][i], C.in[I_S5CIM][i]}; }

#ifndef CONV_G1_PCT
#define CONV_G1_PCT 55
#endif
constexpr int CI_GU = (D / 64) * (FF / 64), CI_DN = (FF / 64) * (D / 64), CI_IN = (D / 64) * ((D_IN + 63) / 64), CI_OUT = (D / 64) * (D / 64), CI_GLU = (GW / 64) * (GW / 64);
constexpr int CI_LAYER = 4 * CI_GU + 2 * CI_DN + CI_IN + CI_OUT + CI_GLU, CI_X1 = (int)((long)CI_LAYER * CONV_G1_PCT / 100) & ~7;
DI void conv_weights(const Ctx& C, int l, int wslot, int nslots, int it_lo, int it_hi) {
    for (int it = it_lo + wslot; it < it_hi; it += nslots) {
        int r = it;
        unsigned char* wbase = C.ws + WS_W + (size_t)l * SZ_WL;
        if (r < 2 * CI_GU) { const int up = r >= CI_GU; r -= up * CI_GU; const int kb = r / (FF / 64), nb = r % (FF / 64);
            conv_item(C, C.in[up ? I_F1WU : I_F1WG] + (size_t)l * D * FF, D, FF, (bf16*)(wbase + OFF_W1GU), 1 + up, kb * 64, nb * 64, bias_ptr(C, l, 0), 2 * FF, modv_ptr(C, l, 0, 0)); continue; } r -= 2 * CI_GU;
        if (r < CI_DN) { const int kb = r / (D / 64), nb = r % (D / 64); conv_item(C, C.in[I_F1WD] + (size_t)l * FF * D, FF, D, (bf16*)(wbase + OFF_W1D), 0, kb * 64, nb * 64, nullptr, 0, nullptr); continue; } r -= CI_DN;
        if (r < CI_IN) { const int nbn = (D_IN + 63) / 64, kb = r / nbn, nb = r % nbn; conv_item(C, C.in[I_WIN] + (size_t)l * D * D_IN, D, D_IN, (bf16*)(wbase + OFF_WIN), 3, kb * 64, nb * 64, bias_ptr(C, l, 1), NINP, modv_ptr(C, l, 0, 3)); continue; } r -= CI_IN;
        if (r < CI_OUT) { const int kb = r / (D / 64), nb = r % (D / 64); conv_item(C, C.in[I_WOUT] + (size_t)l * D * D, D, D, (bf16*)(wbase + OFF_WOUT), 0, kb * 64, nb * 64, nullptr, 0, nullptr); continue; } r -= CI_OUT;
        if (r < 2 * CI_GU) { const int up = r >= CI_GU; r -= up * CI_GU; const int kb = r / (FF / 64), nb = r % (FF / 64);
            conv_item(C, C.in[up ? I_F2WU : I_F2WG] + (size_t)l * D * FF, D, FF, (bf16*)(wbase + OFF_W2GU), 1 + up, kb * 64, nb * 64, bias_ptr(C, l, 2), 2 * FF, modv_ptr(C, l, 0, 6)); continue; } r -= 2 * CI_GU;
        if (r < CI_DN) { const int kb = r / (D / 64), nb = r % (D / 64); conv_item(C, C.in[I_F2WD] + (size_t)l * FF * D, FF, D, (bf16*)(wbase + OFF_W2D), 0, kb * 64, nb * 64, nullptr, 0, nullptr); continue; } r -= CI_DN;
        { const int kb = r / (GW / 64), nb = r % (GW / 64); conv_item(C, C.in[I_S5GLUW] + (size_t)l * GW * GW, GW, GW, (bf16*)(wbase + OFF_WGLU), 0, kb * 64, nb * 64, nullptr, 0, nullptr); }
    }
}
DI void ph_conv(const Ctx& C) {
    const int gt = C.bid * NTHR + C.tid, GT = C.G * NTHR;
    for (int i = gt; i < NL * 9 * D; i += GT) { const int k = i % D, s = (i / D) % 3, sub = (i / (3 * D)) % 3, l = i / (9 * D);
        const float* mv = (const float*)(C.ws + WS_MODV) + ((size_t)l * 3 + s) * 9 * D;
        ((float*)(C.ws + WS_GS))[i] = C.in[I_NORMG][((size_t)l * 3 + sub) * D + k] * (1.0f + mv[(3 * sub + 1) * D + k]);
        ((float*)(C.ws + WS_GATE))[i] = mv[(3 * sub + 2) * D + k] * (sub == 1 ? 1.0f : 0.5f); }
    for (int i = gt; i < 128 * 16; i += GT) { const int pos = i / 16, f = i % 16; const float inv = __expf(-(float)f * (9.210340371976184f / 16.0f)); float sn, cs; sincosf((float)pos * inv, &sn, &cs);
        ((f32x2*)(C.ws + WS_ROPE))[i] = (f32x2){cs, sn}; }
    const int gw = C.bid * NW + C.wave, GWV = C.G * NW;
    conv_weights(C, 0, gw, GWV, 0, CI_LAYER);
    for (int i = gt; i < NL * 14 * NH * 2 * 64 * 8; i += GT) {
        const int j = i & 7, ln = (i >> 3) & 63, tj = (i >> 9) & 1, hd = (i >> 10) % NH, f = (i / (1024 * NH)) % 14, l = i / (1024 * NH * 14);
        const int col = hd * 64 + 32 * tj + (ln & 31); float v;
        if (f < 8) { const int d = (f >> 1) & 1, sx = f & 1, k = 16 * sx + 8 * (ln >> 5) + j; v = C.in[f < 4 ? I_RWWUP : I_RWAUP][(((size_t)l * 2 + d) * 32 + k) * GW + col]; }
        else { const int k = 16 * (f - 8) + 8 * (ln >> 5) + j; v = C.in[I_RWGUP][((size_t)l * 96 + k) * GW + col]; }
        ((bf16*)(C.ws + WS_RWF))[i] = (bf16)f2bf(v); }
    LAS float* wsc = (LAS float*)(C.lds + C.wave * 16640);
    for (int it = gw; it < NL * S5G * 2 * S5L; it += GWV) {
        const int tau = it % S5L, dir = (it / S5L) % 2, g = (it / (2 * S5L)) % S5G, l = it / (2 * S5L * S5G);
        const Cplx z = cmul(s5_lam_pow(C, l, dir, g, C.lane, (float)tau), s5_coef(C, l, dir, g, C.lane));
#pragma unroll 4
        for (int q = 0; q < 16; ++q) { const size_t i = (((size_t)l * S5G + g) * 64 + C.lane) * 16 + q; const Cplx w = cmul(z, Cplx{C.in[I_S5BRE][i], C.in[I_S5BIM][i]}); wsc[(C.lane * 16 + q) * 2] = w.re; wsc[(C.lane * 16 + q) * 2 + 1] = w.im; }
        WSYNC();
        float* kc = (float*)(C.ws + WS_S5T + (size_t)l * SZ_S5L + OFF_S5KC) + (((size_t)g * 2 + dir) * S5L + tau) * 256;
#pragma unroll 1
        for (int e = 0; e < 4; ++e) { const int pq = C.lane + 64 * e, p = pq >> 4, q = pq & 15; float s = 0.f;
#pragma unroll 4
            for (int n = 0; n < 64; ++n) { const Cplx gm = s5_gamma(C, l, g, p, n); s += gm.re * wsc[(n * 16 + q) * 2] - gm.im * wsc[(n * 16 + q) * 2 + 1]; }
            kc[pq] = s; }
        WSYNC();
    }
    for (int i = gt; i < NL * 2 * GW * 4 * (S5L + 1); i += GT) { const int tau = i % (S5L + 1), r = i / (S5L + 1), n = r % 64, g = (r / 64) % S5G, dir = (r / (64 * S5G)) % 2, l = r / (2 * 64 * S5G);
        const Cplx z = s5_lam_pow(C, l, dir, g, n, (float)tau); ((f32x2*)(C.ws + WS_S5T + (size_t)l * SZ_S5L + OFF_S5LP))[((size_t)(dir * S5G + g) * 64 + n) * (S5L + 1) + tau] = (f32x2){z.re, z.im}; }
    for (int i = gt; i < NL * 2 * GW * 4 * 16; i += GT) { const int q = i % 16, r = i / 16, n = r % 64, g = (r / 64) % S5G, dir = (r / (64 * S5G)) % 2, l = r / (2 * 64 * S5G);
        const Cplx z = s5_beta(C, l, dir, g, n, q); ((f32x2*)(C.ws + WS_S5T + (size_t)l * SZ_S5L + OFF_S5BETA))[((size_t)(dir * S5G + g) * 64 + n) * 16 + q] = (f32x2){z.re, z.im}; }
    for (int i = gt; i < NL * 2 * GW * 4; i += GT) { const int n = i % 64, g = (i / 64) % S5G, dir = (i / (64 * S5G)) % 2, l = i / (2 * 64 * S5G); const Cplx z = s5_lam_pow(C, l, dir, g, n, (float)S5L);
        ((f32x2*)(C.ws + WS_S5T + (size_t)l * SZ_S5L + OFF_S5LAM))[(dir * S5G + g) * 64 + n] = (f32x2){z.re, z.im}; }
}
DI u32x4 pack8f(const float (&o)[8]) { u32x4 w; w.x = pk2(o[0], o[1]); w.y = pk2(o[2], o[3]); w.z = pk2(o[4], o[5]); w.w = pk2(o[6], o[7]); return w; }
DI void et_group(const Ctx& C, int l, int i, bf16* ET) {
    const int k = i & 511, np = (i >> 9) & 255, g = i >> 17;
    const int j = k >> 4, q0 = k & 15, dir = np >> 7, n = np & 63, im = (np >> 6) & 1;
    const f32x2 lp = ((const f32x2*)(C.ws + WS_S5T + (size_t)l * SZ_S5L + OFF_S5LP))[((dir * S5G + g) * 64 + n) * (S5L + 1) + (dir == 0 ? S5L - 1 - j : j)];
    const f32x4* be = (const f32x4*)((const f32x2*)(C.ws + WS_S5T + (size_t)l * SZ_S5L + OFF_S5BETA) + ((dir * S5G + g) * 64 + n) * 16 + q0);
    const f32x4 b[4] = {be[0], be[1], be[2], be[3]}; float o[8];
#pragma unroll
    for (int t = 0; t < 8; ++t) { const float br = b[t >> 1][2 * (t & 1)], bi = b[t >> 1][2 * (t & 1) + 1]; o[t] = im ? lp[0] * bi + lp[1] * br : lp[0] * br - lp[1] * bi; }
    *(u32x4*)(ET + i) = pack8f(o);
}
DI void bt_group(const Ctx& C, int l, int i, bf16* BT) {
    const int k = i % S5K, r = i / S5K, nn = r & 511, g = r >> 9, ti = nn >> 4, p = nn & 15; float o[8];
    if (k < 512) { const int j = k >> 4, q0 = k & 15; const float* kc = (const float*)(C.ws + WS_S5T + (size_t)l * SZ_S5L + OFF_S5KC) + (size_t)g * 2 * S5L * 256 + p * 16 + q0;
        const f32x4* c1 = (const f32x4*)(kc + (j <= ti ? ti - j : 0) * 256); const f32x4* c2 = (const f32x4*)(kc + (S5L + (j >= ti ? j - ti : 0)) * 256);
        const f32x4 a0 = c1[0], a1 = c1[1], d0 = c2[0], d1 = c2[1]; const float m1 = j <= ti ? 1.f : 0.f, m2 = j >= ti ? 1.f : 0.f;
#pragma unroll
        for (int t = 0; t < 4; ++t) { o[t] = m1 * a0[t] + m2 * d0[t]; o[4 + t] = m1 * a1[t] + m2 * d1[t]; } }
    else { const int kk = k - 512, dir = kk >> 7, im = (kk >> 6) & 1, n0 = kk & 63; const int li = dir == 0 ? ti + 1 : S5L - ti;
        const f32x2* LPp = (const f32x2*)(C.ws + WS_S5T + (size_t)l * SZ_S5L + OFF_S5LP) + ((dir * S5G + g) * 64 + n0) * (S5L + 1) + li;
        const size_t gi = (((size_t)l * S5G + g) * 16 + p) * 64 + n0;
        const f32x4* gr = (const f32x4*)(C.in[I_S5CRE] + gi); const f32x4* gm = (const f32x4*)(C.in[I_S5CIM] + gi);
        const f32x4 r0 = gr[0], r1 = gr[1], m0 = gm[0], m1 = gm[1]; f32x2 lp[8];
#pragma unroll
        for (int t = 0; t < 8; ++t) lp[t] = LPp[t * (S5L + 1)];
#pragma unroll
        for (int t = 0; t < 8; ++t) { const float cr = t < 4 ? r0[t & 3] : r1[t & 3], ci = t < 4 ? m0[t & 3] : m1[t & 3]; o[t] = im ? -(cr * lp[t][1] + ci * lp[t][0]) : cr * lp[t][0] - ci * lp[t][1]; } }
    *(u32x4*)(BT + i) = pack8f(o);
}
DI void ph_tab(const Ctx& C) {
    const int gt = C.bid * NTHR + C.tid, GT = C.G * NTHR;
    constexpr int NET = S5G * 256 * 512, NBT = S5G * 512 * S5K;
    for (int l = 0; l < NL; ++l) {
        bf16* ET = (bf16*)(C.ws + WS_S5T + (size_t)l * SZ_S5L + OFF_S5ET); bf16* BT = (bf16*)(C.ws + WS_S5T + (size_t)l * SZ_S5L + OFF_S5BT);
#pragma unroll 1
        for (int i8 = gt; i8 < NET / 8; i8 += GT) et_group(C, l, i8 * 8, ET);
#pragma unroll 1
        for (int i8 = gt; i8 < NBT / 8; i8 += GT) bt_group(C, l, i8 * 8, BT);
    }
    const int gw = C.bid * NW + C.wave, GWV = C.G * NW;
    for (int row = gw; row < M; row += GWV) {
        const float* src = row < M_LAT ? C.in[I_X] + (size_t)row * D : C.in[I_CTX] + (size_t)(row - M_LAT) * D;
        float* dst = xrow_ptr(C, row); const float* gs = gs_ptr(C, 0, 0, stream_of_row(row)); bf16* ap = (bf16*)(C.ws + WS_AP) + (size_t)row * D; float ss = 0.f;
        f32x4 xv[D / 256], gv[D / 256];
#pragma unroll
        for (int i = 0; i < D / 256; ++i) { xv[i] = *(const f32x4*)(src + 4 * C.lane + 256 * i); gv[i] = *(const f32x4*)(gs + 4 * C.lane + 256 * i); }
#pragma unroll
        for (int i = 0; i < D / 256; ++i) { const int c = 4 * C.lane + 256 * i; const f32x4 x = xv[i]; *(f32x4*)(dst + c) = x; ss += (x[0] * x[0] + x[1] * x[1]) + (x[2] * x[2] + x[3] * x[3]);
            const f32x4 a = x * gv[i]; u32x2 w; w.x = pk2(a[0], a[1]); w.y = pk2(a[2], a[3]); *(u32x2*)(ap + c) = w; }
        ss = wave_sum(ss); if (C.lane == 0) rowss_ptr(C, 0, 0)[row] = ss;
    }
}

#ifdef EMU
DI s16x4 tr_read1(const LAS unsigned char* a) { return emu_tr_read(a); }
#else
DI s16x4 tr_read1(const LAS unsigned char* a) { s16x4 r; asm volatile("ds_read_b64_tr_b16 %0, %1\n\ts_waitcnt lgkmcnt(0)" : "=&v"(r) : "v"((unsigned)(size_t)a) : "memory"); return r; }
#endif
DI bf16x8 tr_frag(const LAS unsigned char* a0, int hi_off) {
#ifdef EMU
    const s16x4 lo = emu_tr_read(a0), hi = emu_tr_read(a0 + hi_off);
#else
    s16x4 lo, hi; asm volatile("ds_read_b64_tr_b16 %0, %2\n\tds_read_b64_tr_b16 %1, %3\n\ts_waitcnt lgkmcnt(0)" : "=&v"(lo), "=&v"(hi) : "v"((unsigned)(size_t)a0), "v"((unsigned)(size_t)(a0 + hi_off)) : "memory");
#endif
    return __builtin_shufflevector(lo, hi, 0, 1, 2, 3, 4, 5, 6, 7);
}
DI void tr_frag4(const LAS unsigned char* a0, const LAS unsigned char* a1, const LAS unsigned char* a2, const LAS unsigned char* a3, int hi_off, bf16x8 (&f)[4]) {
#ifdef EMU
    f[0] = tr_frag(a0, hi_off); f[1] = tr_frag(a1, hi_off); f[2] = tr_frag(a2, hi_off); f[3] = tr_frag(a3, hi_off);
#else
    s16x4 l0, h0, l1, h1, l2, h2, l3, h3;
    asm volatile("ds_read_b64_tr_b16 %0, %8\n\tds_read_b64_tr_b16 %1, %9\n\tds_read_b64_tr_b16 %2, %10\n\tds_read_b64_tr_b16 %3, %11\n\tds_read_b64_tr_b16 %4, %12\n\tds_read_b64_tr_b16 %5, %13\n\tds_read_b64_tr_b16 %6, %14\n\tds_read_b64_tr_b16 %7, %15\n\ts_waitcnt lgkmcnt(0)"
        : "=&v"(l0), "=&v"(h0), "=&v"(l1), "=&v"(h1), "=&v"(l2), "=&v"(h2), "=&v"(l3), "=&v"(h3)
        : "v"((unsigned)(size_t)a0), "v"((unsigned)(size_t)(a0 + hi_off)), "v"((unsigned)(size_t)a1), "v"((unsigned)(size_t)(a1 + hi_off)), "v"((unsigned)(size_t)a2), "v"((unsigned)(size_t)(a2 + hi_off)), "v"((unsigned)(size_t)a3), "v"((unsigned)(size_t)(a3 + hi_off)) : "memory");
    f[0] = __builtin_shufflevector(l0, h0, 0, 1, 2, 3, 4, 5, 6, 7); f[1] = __builtin_shufflevector(l1, h1, 0, 1, 2, 3, 4, 5, 6, 7); f[2] = __builtin_shufflevector(l2, h2, 0, 1, 2, 3, 4, 5, 6, 7); f[3] = __builtin_shufflevector(l3, h3, 0, 1, 2, 3, 4, 5, 6, 7);
#endif
}
DI bf16x8 pack8(const f32x16& x, int s) {
    u32x4 p; p.x = pk2(x[8 * s], x[8 * s + 1]); p.y = pk2(x[8 * s + 2], x[8 * s + 3]); p.z = pk2(x[8 * s + 4], x[8 * s + 5]); p.w = pk2(x[8 * s + 6], x[8 * s + 7]);
    return __builtin_bit_cast(bf16x8, p);
}
struct AttnSt { f32x16 o0, o1; float m, l; };
constexpr int APT = 144;
struct KVregs { u32x4 k[4]; u32x4 v[4]; };
struct Kregs { bf16x8 k[4]; };
DI void k_load(Kregs& r, const bf16* Kb, int kp, int lane) {
    const int r32 = lane & 31, h = lane >> 5;
#pragma unroll
    for (int kk = 0; kk < 4; ++kk) r.k[kk] = *(const bf16x8*)(Kb + (size_t)r32 * kp + 16 * kk + 8 * h);
}
DI void kv_load2(KVregs& r, const bf16* Kb, int kp, const bf16* Vb, int vp, int lane) {
#pragma unroll
    for (int i = 0; i < 4; ++i) { const int idx = lane + 64 * i, key = idx >> 3, ch = idx & 7; r.k[i] = *(const u32x4*)(Kb + (size_t)key * kp + ch * 8); }
#pragma unroll
    for (int i = 0; i < 4; ++i) { const int idx = lane + 64 * i, key = idx >> 3, ch = idx & 7; r.v[i] = *(const u32x4*)(Vb + (size_t)key * vp + ch * 8); }
}
#if 0
DI void kv_load(KVregs& r, const Kregs& kpre, const bf16* Vb, int vp, int lane) {
#pragma unroll
    for (int kk = 0; kk < 4; ++kk) r.k[kk] = kpre.k[kk];
#pragma unroll
    for (int i = 0; i < 4; ++i) { const int idx = lane + 64 * i, key = idx >> 3, ch = idx & 7; r.v[i] = *(const u32x4*)(Vb + (size_t)key * vp + ch * 8); }
}
#endif
DI void attn_stage(const KVregs& kv, LAS unsigned char* vl, int lane) {
    LAS unsigned char* vk = vl; LAS unsigned char* vv = vl + 32 * APT;
#pragma unroll
    for (int i = 0; i < 4; ++i) { const int idx = lane + 64 * i, key = idx >> 3, ch = idx & 7; *(LAS u32x4*)(vk + key * APT + ch * 16) = kv.k[i]; *(LAS u32x4*)(vv + key * APT + ch * 16) = kv.v[i]; }
}
template <bool MASKED>
DI void attn_block(AttnSt& st, const bf16x8 (&qf)[4], LAS unsigned char* vl, int lane, const float (&addv)[16], unsigned vmask) {
    const int h = lane >> 5;
    LAS unsigned char* vk = vl; LAS unsigned char* vv = vl + 32 * APT;
    WSYNC();
    bf16x8 kf[4];
#pragma unroll
    for (int kk = 0; kk < 4; ++kk) kf[kk] = *(const LAS bf16x8*)(vk + (lane & 31) * APT + (16 * kk + 8 * h) * 2);
    f32x16 s;
#pragma unroll
    for (int i = 0; i < 16; ++i) s[i] = 0.f;
#pragma unroll
    for (int kk = 0; kk < 4; ++kk) s = __builtin_amdgcn_mfma_f32_32x32x16_bf16(kf[kk], qf[kk], s, 0, 0, 0);
    float bm = -1e30f;
#pragma unroll
    for (int i = 0; i < 16; ++i) { if (MASKED) { s[i] += addv[i]; if ((vmask >> i) & 1u) bm = fmaxf(bm, s[i]); } else bm = fmaxf(bm, s[i]); }
    bm = fmaxf(bm, __shfl_xor(bm, 32));
    const float mn = fmaxf(st.m, bm), alpha = __expf(st.m - mn); st.m = mn;
    float ls = 0.f;
#pragma unroll
    for (int i = 0; i < 16; ++i) { float p = __expf(s[i] - mn); if (MASKED) p = ((vmask >> i) & 1u) ? p : 0.f; s[i] = p; ls += p; }
    st.l = st.l * alpha + ls;
#pragma unroll
    for (int i = 0; i < 16; ++i) { st.o0[i] *= alpha; st.o1[i] *= alpha; }
    const int q = (lane & 15) >> 2, p4 = lane & 3, blk = (lane >> 4) & 1;
    { const LAS unsigned char* ab = vv + (4 * h + q) * APT + (16 * blk) * 2 + 8 * p4; bf16x8 vf[4];
      tr_frag4(ab, ab + 64, ab + 16 * APT, ab + 16 * APT + 64, 8 * APT, vf);
      const bf16x8 pf0 = pack8(s, 0), pf1 = pack8(s, 1);
      st.o0 = __builtin_amdgcn_mfma_f32_32x32x16_bf16(vf[0], pf0, st.o0, 0, 0, 0); st.o1 = __builtin_amdgcn_mfma_f32_32x32x16_bf16(vf[1], pf0, st.o1, 0, 0, 0);
      st.o0 = __builtin_amdgcn_mfma_f32_32x32x16_bf16(vf[2], pf1, st.o0, 0, 0, 0); st.o1 = __builtin_amdgcn_mfma_f32_32x32x16_bf16(vf[3], pf1, st.o1, 0, 0, 0); }
}
DI void attn_finish(AttnSt& st, bf16* orow  , int lane, float extra_l) {
    const int h = lane >> 5; float l = st.l + __shfl_xor(st.l, 32) + extra_l; const float inv = 1.0f / l;
#pragma unroll
    for (int g = 0; g < 4; ++g) {
        u32x2 w0, w1; w0.x = pk2(st.o0[4 * g] * inv, st.o0[4 * g + 1] * inv); w0.y = pk2(st.o0[4 * g + 2] * inv, st.o0[4 * g + 3] * inv);
        w1.x = pk2(st.o1[4 * g] * inv, st.o1[4 * g + 1] * inv); w1.y = pk2(st.o1[4 * g + 2] * inv, st.o1[4 * g + 3] * inv);
        *(u32x2*)(orow + 8 * g + 4 * h) = w0; *(u32x2*)(orow + 32 + 8 * g + 4 * h) = w1; }
}
DI int clampi(int v, int lo, int hi) { return v < lo ? lo : (v > hi ? hi : v); }
#ifndef ATTN_A_PCT
#define ATTN_A_PCT 20
#endif
constexpr int AT_NA = NB * NH * (GRH / 2) * 4, AT_WA = NB * NH * (T / 32), AT_CX = NB * NH * (TC / 32);
DI void ph_attn(const Ctx& C, int l, bool want_ctx, int widx, int nworkers, int t_lo, int t_hi) {
    if (widx < 0) return;
    const int gw = t_lo + widx, GWV = nworkers, lane = C.lane, r32 = lane & 31, h = lane >> 5;
    LAS unsigned char* vl = C.lds + C.wave * 16640;
    const bf16* QA = (const bf16*)(C.ws + WS_QA); const bf16* KA = (const bf16*)(C.ws + WS_KA); const bf16* VA = (const bf16*)(C.ws + WS_VA);
    const bf16* QC = (const bf16*)(C.ws + WS_QC); const bf16* KC = (const bf16*)(C.ws + WS_KC); const bf16* VC = (const bf16*)(C.ws + WS_VC);
    bf16* OB = (bf16*)(C.ws + WS_OB);
    const int ntiles = t_hi;
    const float zero16[16] = {0.f, 0.f, 0.f, 0.f, 0.f, 0.f, 0.f, 0.f, 0.f, 0.f, 0.f, 0.f, 0.f, 0.f, 0.f, 0.f};
    for (int tile = gw; tile < ntiles; tile += GWV) {
        AttnSt st; st.m = -1e30f; st.l = 0.f;
#pragma unroll
        for (int i = 0; i < 16; ++i) { st.o0[i] = 0.f; st.o1[i] = 0.f; }
        bf16x8 qf[4];
        if (tile < AT_NA) {
            const int cb = tile & 3, rp = (tile >> 2) % (GRH / 2), hd = (tile / (4 * (GRH / 2))) % NH, b = tile / (4 * (GRH / 2) * NH);
            const int r0 = 2 * rp, c0 = 16 * cb, qr = r0 + (r32 >> 4), qc = c0 + (r32 & 15), qrow = b * T + qr * GRW + qc;
#pragma unroll
            for (int kk = 0; kk < 4; ++kk) qf[kk] = *(const bf16x8*)(QA + (size_t)qrow * GW + hd * 64 + 16 * kk + 8 * h);
            const int rsq = clampi(qr - 4, 0, GRH - 8), csq = clampi(qc - 8, 0, GRW - 16);
            const int rsA = clampi(r0 - 4, 0, GRH - 8), rsB = clampi(r0 + 1 - 4, 0, GRH - 8), kc0 = clampi(c0 - 8, 0, GRW - 32);
            const float* rpb = C.in[I_NARPB] + ((size_t)l * NH + hd) * 465;
            const int nbn = rsB + 8 - rsA, nbt = nbn + TC / 32; KVregs nxt;
#define NA_ROW(i) ((i) < nbn ? (size_t)b * T + (rsA + (i)) * GRW + kc0 : (size_t)M_LAT + b * TC + 32 * ((i) - nbn))
            const bf16* KAh = KA + (size_t)hd * M * 64; const bf16* VAh = VA + (size_t)hd * M * 64;
            { const size_t kr0 = NA_ROW(0); kv_load2(nxt, KAh + kr0 * 64, 64, VAh + kr0 * 64, 64, lane); }
            LAS float* rpbL = (LAS float*)(vl + 64 * APT);
            { float tb[8];
#pragma unroll
              for (int i = 0; i < 8; ++i) { const int j = lane + 64 * i; tb[i] = rpb[j < 465 ? j : 464]; }
#pragma unroll
              for (int i = 0; i < 8; ++i) { const int j = lane + 64 * i; if (j < 465) rpbL[j] = tb[i]; }
              WSYNC(); }
            const int cb0 = kc0 + 4 * h - qc + 15; unsigned vmcol = 0u;
#pragma unroll
            for (int i = 0; i < 16; ++i) { const int kc = kc0 + (i & 3) + 8 * (i >> 2) + 4 * h; vmcol |= (kc >= csq && kc <= csq + 15) ? (1u << i) : 0u; }
            for (int ib = 0; ib < nbt; ++ib) {
                attn_stage(nxt, vl, lane);
                { const int in_ = ib + 1 < nbt ? ib + 1 : ib; const size_t kr1 = NA_ROW(in_); kv_load2(nxt, KAh + kr1 * 64, 64, VAh + kr1 * 64, 64, lane); }
                if (ib < nbn) { const int kr = rsA + ib; float addv[16]; const bool rok = kr >= rsq && kr <= rsq + 7;
                    const LAS float* rb = rpbL + (kr - qr + 7) * 31 + cb0;
#pragma unroll
                    for (int i = 0; i < 16; ++i) addv[i] = rb[(i & 3) + 8 * (i >> 2)];
                    attn_block<true>(st, qf, vl, lane, addv, rok ? vmcol : 0u); }
                else attn_block<false>(st, qf, vl, lane, zero16, 0xffffu); }
#undef NA_ROW
            attn_finish(st, OB + (size_t)qrow * D + hd * 64, lane, 0.f);
        } else if (tile < AT_NA + AT_WA) {
            const int t2 = tile - AT_NA, hl_ = t2 % WAG, qb = (t2 / WAG) % (T / 32), kvh = (t2 / (WAG * (T / 32))) % (NH / WAG), b = t2 / ((T / 32) * NH), hd = kvh * WAG + hl_;
            const int qt = 32 * qb + r32, qrow = b * T + qt;
#pragma unroll
            for (int kk = 0; kk < 4; ++kk) qf[kk] = *(const bf16x8*)(QC + (size_t)qrow * GW + hd * 64 + 16 * kk + 8 * h);
            const int i_lo = 4 - qb > 0 ? 4 - qb : 0, i_hi = (T / 32 - qb + 4) < 9 ? (T / 32 - qb + 4) : 9, nbw = i_hi - i_lo, nbt = nbw + TC / 32; KVregs nxt;
#define WA_ROW(i) ((i) < nbw ? (size_t)b * T + 32 * qb - 128 + 32 * (i_lo + (i)) : (size_t)M_LAT + b * TC + 32 * ((i) - nbw))
            const bf16* KCh = KC + (size_t)kvh * M * 64; const bf16* VCh = VC + (size_t)kvh * M * 64;
            { const size_t kr0 = WA_ROW(0); kv_load2(nxt, KCh + kr0 * 64, 64, VCh + kr0 * 64, 64, lane); }
            for (int ib = 0; ib < nbt; ++ib) {
                attn_stage(nxt, vl, lane);
                { const int in_ = ib + 1 < nbt ? ib + 1 : ib; const size_t kr1 = WA_ROW(in_); kv_load2(nxt, KCh + kr1 * 64, 64, VCh + kr1 * 64, 64, lane); }
                if (ib < nbw && (i_lo + ib == 0 || i_lo + ib == 8)) { const int t0 = 32 * qb - 128 + 32 * (i_lo + ib); float addv[16]; unsigned vm = 0u;
#pragma unroll
                    for (int i = 0; i < 16; ++i) { const int kt = t0 + (i & 3) + 8 * (i >> 2) + 4 * h, rel = kt - qt; addv[i] = 0.f; vm |= (rel >= -128 && rel <= 128) ? (1u << i) : 0u; }
                    attn_block<true>(st, qf, vl, lane, addv, vm); }
                else attn_block<false>(st, qf, vl, lane, zero16, 0xffffu); }
#undef WA_ROW
            const float sk = C.in[I_WASINK][(size_t)l * NH + hd];
            const float mfin = fmaxf(st.m, sk), a2 = __expf(st.m - mfin);
#pragma unroll
            for (int i = 0; i < 16; ++i) { st.o0[i] *= a2; st.o1[i] *= a2; }
            st.l *= a2; st.m = mfin;
            attn_finish(st, OB + (size_t)qrow * D + 2 * GW + hd * 64, lane, __expf(sk - mfin));
        } else {
            const int t2 = tile - AT_NA - AT_WA, isc = t2 >= AT_CX, t3 = t2 - isc * AT_CX, qb = t3 % (TC / 32), hd = (t3 / (TC / 32)) % NH, b = t3 / ((TC / 32) * NH), kvh = hd / WAG;
            const int qrow = M_LAT + b * TC + 32 * qb + r32;
            const bf16* Qs = isc ? QC : QA; const bf16* Ks = isc ? KC + (size_t)kvh * M * 64 : KA + (size_t)hd * M * 64; const bf16* Vs = isc ? VC + (size_t)kvh * M * 64 : VA + (size_t)hd * M * 64; const int kp = 64;
#pragma unroll
            for (int kk = 0; kk < 4; ++kk) qf[kk] = *(const bf16x8*)(Qs + (size_t)qrow * GW + hd * 64 + 16 * kk + 8 * h);
            { KVregs nxt; const size_t kr0 = (size_t)M_LAT + b * TC; kv_load2(nxt, Ks + kr0 * kp, kp, Vs + kr0 * kp, kp, lane);
              for (int cbk = 0; cbk < TC / 32; ++cbk) { attn_stage(nxt, vl, lane); const int cn = cbk + 1 < TC / 32 ? cbk + 1 : cbk; kv_load2(nxt, Ks + (kr0 + 32 * cn) * kp, kp, Vs + (kr0 + 32 * cn) * kp, kp, lane);
                  attn_block<false>(st, qf, vl, lane, zero16, 0xffffu); } }
            float extra = 0.f;
            if (isc) { const float sk = C.in[I_WASINK][(size_t)l * NH + hd]; const float mfin = fmaxf(st.m, sk), a2 = __expf(st.m - mfin);
#pragma unroll
                for (int i = 0; i < 16; ++i) { st.o0[i] *= a2; st.o1[i] *= a2; }
                st.l *= a2; st.m = mfin; extra = __expf(sk - mfin); }
            attn_finish(st, OB + (size_t)qrow * D + (isc ? 2 * GW : 0) + hd * 64, lane, extra);
        }
    }
}

DI void ph_ctxfix(const Ctx& C, const float* gsn  , float* rowss_next) {
    const int gw = C.bid * NW + C.wave, GWV = C.G * NW;
    for (int r = gw; r < M_CTX; r += GWV) { const int row = M_LAT + r; const float* xp = xrow_ptr(C, row); const float* gs = gsn + (size_t)NB * D; bf16* ap = (bf16*)(C.ws + WS_AP) + (size_t)row * D; float ss = 0.f;
        f32x4 xv[D / 256], gv[D / 256];
#pragma unroll
        for (int i = 0; i < D / 256; ++i) { xv[i] = *(const f32x4*)(xp + 4 * C.lane + 256 * i); gv[i] = *(const f32x4*)(gs + 4 * C.lane + 256 * i); }
#pragma unroll
        for (int i = 0; i < D / 256; ++i) { const int c = 4 * C.lane + 256 * i; const f32x4 x = xv[i]; ss += (x[0] * x[0] + x[1] * x[1]) + (x[2] * x[2] + x[3] * x[3]);
            const f32x4 a = x * gv[i]; u32x2 w; w.x = pk2(a[0], a[1]); w.y = pk2(a[2], a[3]); *(u32x2*)(ap + c) = w; }
        ss = wave_sum(ss); if (C.lane == 0) rowss_next[row] = ss; }
}
constexpr int PT = 144;
constexpr int RW_HALF = 73472, IM_BT = 0, IM_KT = 9216, IM_RT = 18432, IM_ARB = 27648, IM_AT = 36864, IM_AAK = 46080, IM_F = 55296, IM_GC = 72704, FP = 68;
DI void chunk_rows(int b, int dir, int c, int& row0, int& step) {
    if (c < TC / 64) { const int p0 = 64 * c; row0 = M_LAT + b * TC + (dir ? TC - 1 - p0 : p0); } else { const int p0 = 64 * (c - TC / 64); row0 = b * T + (dir ? T - 1 - p0 : p0); }
    step = dir ? -1 : 1;
}
DI bf16x8 frag_rows(const LAS unsigned char* img, int tile, int s, int lane) { return *(const LAS bf16x8*)(img + (32 * tile + (lane & 31)) * PT + (16 * s + 8 * (lane >> 5)) * 2); }
DI bf16x8 frag_cols(const LAS unsigned char* img, int tile, int s, int lane) {
    const int h = lane >> 5, q = (lane & 15) >> 2, p4 = lane & 3, blk = (lane >> 4) & 1;
    const LAS unsigned char* a0 = img + (16 * s + 8 * h + q) * PT + (32 * tile + 16 * blk) * 2 + 8 * p4;
    return tr_frag(a0, 4 * PT);
}
DI void frag_cols4(const LAS unsigned char* img, int tile, int lane, bf16x8 (&f)[4]) {
    const int h = lane >> 5, q = (lane & 15) >> 2, p4 = lane & 3, blk = (lane >> 4) & 1;
    const LAS unsigned char* a0 = img + (8 * h + q) * PT + (32 * tile + 16 * blk) * 2 + 8 * p4;
    tr_frag4(a0, a0 + 16 * PT, a0 + 32 * PT, a0 + 48 * PT, 4 * PT, f);
}
DI void store_T(const f32x16& acc, LAS unsigned char* img, int ti, int tj, int lane) {
    const int c = lane & 31, h = lane >> 5;
#pragma unroll
    for (int g = 0; g < 4; ++g) { u32x2 w; w.x = pk2(acc[4 * g], acc[4 * g + 1]); w.y = pk2(acc[4 * g + 2], acc[4 * g + 3]); *(LAS u32x2*)(img + (32 * tj + c) * PT + (32 * ti + 8 * g + 4 * h) * 2) = w; }
}
DI f32x16 zero16v() { f32x16 z;
#pragma unroll
    for (int i = 0; i < 16; ++i) z[i] = 0.f; return z; }
#define MMA32(a, b, c) __builtin_amdgcn_mfma_f32_32x32x16_bf16((a), (b), (c), 0, 0, 0)
constexpr int PDW = 80, PDG = 208, IM_TW = 0, IM_TA = 17408, IM_DW = 36864, IM_DA = 41984, IM_DG = 47104;
DI void ph_rw1(const Ctx& C, int l) {
    const int wg = C.wave & 3, grp = C.wave >> 2, ti = wg >> 1, tj = wg & 1;
    bf16* QH = (bf16*)(C.ws + WS_QH); float* YL = (float*)(C.ws + WS_YL); bf16* MF = (bf16*)(C.ws + WS_MF); float* GF = (float*)(C.ws + WS_GF); bf16* RVKG = (bf16*)(C.ws + WS_RVKG);
    const bf16* PB = (const bf16*)(C.ws + WS_PB); const float* PS = (const float*)(C.ws + WS_PS);
    const bf16x8* RWF = (const bf16x8*)(C.ws + WS_RWF + (size_t)l * SZ_RWF);
    constexpr int nblk = (TC + T) / 64;
    for (int it0 = 2 * C.bid; it0 < RBLK; it0 += 2 * C.G) {
        int lane_ = threadIdx.x & 63; OPAQUE(lane_); const int lane = lane_, c32 = lane & 31, h = lane >> 5;
        LAS unsigned char* L = OPAQUE_LDS(C.lds + grp * RW_HALF);
        LAS float* F = (LAS float*)(L + IM_F); LAS float* SEG = (LAS float*)(L + IM_F); LAS float* GC = (LAS float*)(L + IM_GC);
        LAS float* TW = (LAS float*)(L + IM_TW); LAS float* TA = (LAS float*)(L + IM_TA);
        unsigned char* PK = C.ws + WS_RWS + ((size_t)C.bid * 2 + grp) * 65536;
        const int item = it0 + grp; const bool live = item < RBLK; const int itc = live ? item : RBLK - 1;
        const int tb = itc % nblk, hd = (itc / nblk) % NH, b = itc / (nblk * NH), cg = hd * 64 + lane;
        const int rowb = tb < TC / 64 ? M_LAT + b * TC + 64 * tb : b * T + 64 * (tb - TC / 64);
        const int seq_lo = tb < TC / 64 ? M_LAT + b * TC : b * T, seq_hi = seq_lo + (tb < TC / 64 ? TC : T);
        bf16* RV = RVKG + (size_t)itc * 4 * 4096;
        __syncthreads();
        float r_[16], kf_[16], kk_[16], ks_[16];
        { const float* cw = C.in[I_RWCONV] + (size_t)l * 9 * GW; float cwv[3][3];
#pragma unroll
          for (int j = 0; j < 3; ++j)
#pragma unroll
              for (int x = 0; x < 3; ++x) cwv[j][x] = cw[(size_t)j * 3 * GW + x * GW + cg];
          const float kkw = C.in[I_RWKK][(size_t)l * GW + cg];
          const int r0 = rowb + 16 * wg;
          bf16 pbv[18][3]; float psv[16][3];
#pragma unroll
          for (int rr = 0; rr < 18; ++rr) { int row = r0 - 1 + rr; row = row < seq_lo ? seq_lo : (row >= seq_hi ? seq_hi - 1 : row);
#pragma unroll
              for (int x = 0; x < 3; ++x) pbv[rr][x] = PB[(size_t)row * 3 * GW + x * GW + cg]; }
#pragma unroll
          for (int t = 0; t < 16; ++t)
#pragma unroll
              for (int kq = 0; kq < 3; ++kq) { const int k = lane + 64 * kq; psv[t][kq] = PS[(size_t)(r0 + t) * 160 + (k < 160 ? k : 159)]; }
          const float m_lo = r0 - 1 >= seq_lo ? 1.f : 0.f, m_hi = r0 + 16 < seq_hi ? 1.f : 0.f;
          float v_[16];
#pragma unroll
          for (int t = 0; t < 16; ++t) {
              float xa[3], xb[3], xc[3];
#pragma unroll
              for (int x = 0; x < 3; ++x) { xa[x] = bf2f(pbv[t][x]) * (t == 0 ? m_lo : 1.f); xb[x] = bf2f(pbv[t + 1][x]); xc[x] = bf2f(pbv[t + 2][x]) * (t == 15 ? m_hi : 1.f); }
              r_[t] = xa[0] * cwv[0][0] + xb[0] * cwv[1][0] + xc[0] * cwv[2][0]; kf_[t] = xa[1] * cwv[0][1] + xb[1] * cwv[1][1] + xc[1] * cwv[2][1]; v_[t] = xa[2] * cwv[0][2] + xb[2] * cwv[1][2] + xc[2] * cwv[2][2];
              const float kkv = kf_[t] * kkw, ssq = wave_sum(kkv * kkv); kk_[t] = kkv * __builtin_amdgcn_rsqf(fmaxf(ssq, 1e-24f)); ks_[t] = 0.f;
              const int tk = 16 * wg + t;
              if (lane < 32) *(LAS bf16*)(L + IM_DW + tk * PDW + lane * 2) = (bf16)f2bf(fast_tanh(psv[t][0])); else *(LAS bf16*)(L + IM_DA + tk * PDW + (lane - 32) * 2) = (bf16)f2bf(psv[t][0]);
              *(LAS bf16*)(L + IM_DG + tk * PDG + lane * 2) = (bf16)f2bf(sigmf(psv[t][1]));
              if (lane < 32) *(LAS bf16*)(L + IM_DG + tk * PDG + (lane + 64) * 2) = (bf16)f2bf(sigmf(psv[t][2]));
          }
#pragma unroll
          for (int t = 0; t < 16; ++t) { RV[(16 * wg + t) * 64 + lane] = (bf16)f2bf(r_[t]); RV[4096 + (16 * wg + t) * 64 + lane] = (bf16)f2bf(v_[t]); }
        }
        __syncthreads();
        bf16x8 lrf[2][4]; float w0v[2], a0v[2];
#pragma unroll
        for (int d = 0; d < 2; ++d) {
#pragma unroll
            for (int sx = 0; sx < 2; ++sx) { lrf[d][sx] = RWF[(((0 + 2 * d + sx) * NH + hd) * 2 + tj) * 64 + lane]; lrf[d][2 + sx] = RWF[(((4 + 2 * d + sx) * NH + hd) * 2 + tj) * 64 + lane]; }
            w0v[d] = C.in[I_RWW0][((size_t)l * 2 + d) * GW + hd * 64 + 32 * tj + c32]; a0v[d] = C.in[I_RWA0][((size_t)l * 2 + d) * GW + hd * 64 + 32 * tj + c32]; }
        { f32x16 gacc = zero16v();
#pragma unroll
          for (int sx = 0; sx < 6; ++sx) gacc = MMA32(*(const LAS bf16x8*)(L + IM_DG + (32 * ti + c32) * PDG + (16 * sx + 8 * h) * 2), RWF[(((8 + sx) * NH + hd) * 2 + tj) * 64 + lane], gacc);
#pragma unroll
          for (int rg = 0; rg < 16; ++rg) { const int tk = 32 * ti + (rg & 3) + 8 * (rg >> 2) + 4 * h; RV[3 * 4096 + tk * 64 + 32 * tj + c32] = (bf16)f2bf(gacc[rg]); }
        }
        const float kaw = C.in[I_RWKA][(size_t)l * GW + cg];
#pragma unroll
        for (int pss = 0; pss < 2; ++pss) {
            const int dir = 1 - pss;
            __syncthreads();
            { f32x16 pw = zero16v(), pa = zero16v();
#pragma unroll
              for (int sx = 0; sx < 2; ++sx) { pw = MMA32(*(const LAS bf16x8*)(L + IM_DW + (32 * ti + c32) * PDW + (16 * sx + 8 * h) * 2), lrf[dir][sx], pw);
                                              pa = MMA32(*(const LAS bf16x8*)(L + IM_DA + (32 * ti + c32) * PDW + (16 * sx + 8 * h) * 2), lrf[dir][2 + sx], pa); }
              const float w0 = w0v[dir], a0 = a0v[dir];
#pragma unroll
              for (int rg = 0; rg < 16; ++rg) { const int tk = 32 * ti + (rg & 3) + 8 * (rg >> 2) + 4 * h; const float z = -(w0 + pw[rg]), sp = z > 20.f ? z : __logf(1.f + __expf(z));
                  TW[tk * FP + 32 * tj + c32] = -__expf(-sp - 0.5f); TA[tk * FP + 32 * tj + c32] = sigmf(a0 + pa[rg]); } }
            __syncthreads();
            const int cs = dir ? 3 - wg : wg;
            float lw[16], av[16], run = 0.f;
#pragma unroll
            for (int ii = 0; ii < 16; ++ii) { const int tl = dir ? 15 - ii : ii, tk = 16 * wg + tl; av[ii] = TA[tk * FP + lane]; run += TW[tk * FP + lane]; lw[ii] = run; }
            __syncthreads();
            SEG[cs * 64 + lane] = run;
            __syncthreads();
            float off = 0.f;
#pragma unroll
            for (int w2 = 0; w2 < 3; ++w2) off += (w2 < cs) ? SEG[w2 * 64 + lane] : 0.f;
            const float tot = SEG[lane] + SEG[64 + lane] + SEG[128 + lane] + SEG[192 + lane];
            if (wg == 0) { if (dir) ((float*)(PK + 32768))[lane] = __expf(tot); else GC[lane] = __expf(tot); }
            float ePrev = __expf(off);
#pragma unroll
            for (int ii = 0; ii < 16; ++ii) { const int tl = dir ? 15 - ii : ii, i = 16 * cs + ii;
                const float Li = lw[ii] + off, eL = __expf(Li), ieL = __builtin_amdgcn_rcpf(eL), eLm = ePrev; ePrev = eL;
                const float a = av[ii], kd = kf_[tl] * (1.f + (a - 1.f) * kaw); ks_[tl] += kd;
                const bf16 vat = (bf16)f2bf(-kk_[tl] * eLm), vbt = (bf16)f2bf(kk_[tl] * a * ieL), vkt = (bf16)f2bf(kd * ieL), vrt = (bf16)f2bf(r_[tl] * eL);
                if (dir) { bf16* pk = (bf16*)PK + i * 64 + lane; pk[0] = vat; pk[4096] = vbt; pk[8192] = vkt; pk[12288] = vrt; }
                else { *(LAS bf16*)(L + IM_AT + i * PT + lane * 2) = vat; *(LAS bf16*)(L + IM_BT + i * PT + lane * 2) = vbt; *(LAS bf16*)(L + IM_KT + i * PT + lane * 2) = vkt; *(LAS bf16*)(L + IM_RT + i * PT + lane * 2) = vrt; } }
        }
#pragma unroll
        for (int t = 0; t < 16; ++t) RV[2 * 4096 + (16 * wg + t) * 64 + lane] = (bf16)f2bf(ks_[t]);
#pragma unroll 1
        for (int dir = 0; dir < 2; ++dir) {
            const int c = dir == 0 ? tb : (tb < TC / 64 ? TC / 64 - 1 - tb : TC / 64 + (T / 64 - 1 - (tb - TC / 64)));
            const size_t ci = ((size_t)((b * NH + hd) * 2 + dir)) * RCK + c;
            __syncthreads();
            if (dir) {
                const int tg = wg * 64 + lane;
                u32x4 pkv[4][2]; const float gcv = ((const float*)(PK + 32768))[lane];
#pragma unroll
                for (int im = 0; im < 4; ++im)
#pragma unroll
                    for (int rr = 0; rr < 2; ++rr) { const int idx = tg + 256 * rr, row = idx >> 3, ch = idx & 7; pkv[im][rr] = *(const u32x4*)(PK + im * 8192 + row * 128 + ch * 16); }
#pragma unroll
                for (int im = 0; im < 4; ++im)
#pragma unroll
                    for (int rr = 0; rr < 2; ++rr) { const int idx = tg + 256 * rr, row = idx >> 3, ch = idx & 7; const int dsto = im == 0 ? IM_AT : im == 1 ? IM_BT : im == 2 ? IM_KT : IM_RT;
                        *(LAS u32x4*)(L + dsto + row * PT + ch * 16) = pkv[im][rr]; }
                if (wg == 0) GC[lane] = gcv;
                __syncthreads();
            }
            f32x16 accP;
            { f32x16 aab = zero16v(), aak = zero16v(), arb = zero16v(); accP = zero16v();
#pragma unroll
              for (int s = 0; s < 4; ++s) { const bf16x8 at_i = frag_rows(L + IM_AT, ti, s, lane), bt_j = frag_rows(L + IM_BT, tj, s, lane), kt_j = frag_rows(L + IM_KT, ti, s, lane), at_c = frag_rows(L + IM_AT, tj, s, lane),
                                              bt_r = frag_rows(L + IM_BT, ti, s, lane), rt_c = frag_rows(L + IM_RT, tj, s, lane);
                  aab = MMA32(at_i, bt_j, aab); aak = MMA32(kt_j, at_c, aak); arb = MMA32(bt_r, rt_c, arb); accP = MMA32(kt_j, rt_c, accP); }
#pragma unroll
              for (int r = 0; r < 16; ++r) { const int row = 32 * ti + (r & 3) + 8 * (r >> 2) + 4 * h, col = 32 * tj + c32;
                  F[row * FP + col] = col < row ? aab[r] : 0.f; aak[r] = row < col ? aak[r] : 0.f; arb[r] = row <= col ? arb[r] : 0.f; accP[r] = row <= col ? accP[r] : 0.f; }
              store_T(aak, L + IM_AAK, ti, tj, lane);
              store_T(arb, L + IM_ARB, ti, tj, lane); }
            __syncthreads();
            { float Wc[64]; const int col = 32 * wg + c32; const LAS unsigned char* src = col < 64 ? L + IM_AT + col * 2 : L + IM_AAK + (col - 64) * 2;
              const LAS float* Fo = OPAQUE_LDS(F);
#pragma unroll
              for (int i = 0; i < 64; ++i) Wc[i] = bf2f(*(const LAS bf16*)(src + i * PT));
#pragma unroll
              for (int i = 1; i < 64; ++i) { float a0 = Wc[i], a1 = 0.f, a2 = 0.f, a3 = 0.f;
#pragma unroll
                  for (int j4 = 0; j4 < (i + 3) / 4; ++j4) { const f32x4 f = *(const LAS f32x4*)(Fo + i * FP + 4 * j4); a0 += f[0] * Wc[4 * j4]; a1 += f[1] * Wc[4 * j4 + 1]; a2 += f[2] * Wc[4 * j4 + 2]; a3 += f[3] * Wc[4 * j4 + 3];
                      if ((j4 & 7) == 7) PIN4(a0, a1, a2, a3); }
                  PIN4(a0, a1, a2, a3); Wc[i] = (a0 + a1) + (a2 + a3); }
              __syncthreads();
              if (h == 0) { LAS unsigned char* dst = (col < 64 ? L + IM_AT + col * PT : L + IM_AAK + (col - 64) * PT);
#pragma unroll
                  for (int i8 = 0; i8 < 8; ++i8) { u32x4 w; w.x = pk2(Wc[8 * i8], Wc[8 * i8 + 1]); w.y = pk2(Wc[8 * i8 + 2], Wc[8 * i8 + 3]); w.z = pk2(Wc[8 * i8 + 4], Wc[8 * i8 + 5]); w.w = pk2(Wc[8 * i8 + 6], Wc[8 * i8 + 7]); *(LAS u32x4*)(dst + i8 * 16) = w; } }
              bf16 vtmp[16];
#pragma unroll
              for (int ii = 0; ii < 16; ++ii) { const int tl = dir ? 15 - ii : ii; vtmp[ii] = RV[4096 + (16 * wg + tl) * 64 + lane]; }
#pragma unroll
              for (int ii = 0; ii < 16; ++ii) { const int i = 16 * (dir ? 3 - wg : wg) + ii; *(LAS bf16*)(L + IM_F + i * PT + lane * 2) = vtmp[ii]; }
            }
            __syncthreads();
            { f32x16 q;
#pragma unroll
              for (int g = 0; g < 4; ++g) { const u32x2 w = *(const LAS u32x2*)(L + IM_RT + (32 * tj + c32) * PT + (32 * ti + 8 * g + 4 * h) * 2); q[4 * g] = bflo(w.x); q[4 * g + 1] = bfhi(w.x); q[4 * g + 2] = bflo(w.y); q[4 * g + 3] = bfhi(w.y); }
#pragma unroll
              for (int s = 0; s < 4; ++s) { const bf16x8 arb = frag_rows(L + IM_ARB, tj, s, lane); q = MMA32(frag_rows(L + IM_AT, ti, s, lane), arb, q); accP = MMA32(frag_rows(L + IM_AAK, ti, s, lane), arb, accP); }
              if (live) {
#pragma unroll
                  for (int g = 0; g < 4; ++g) { u32x2 w; w.x = pk2(q[4 * g], q[4 * g + 1]); w.y = pk2(q[4 * g + 2], q[4 * g + 3]); *(u32x2*)(QH + ci * 4096 + (32 * tj + c32) * 64 + 32 * ti + 8 * g + 4 * h) = w; } }
            }
            __syncthreads();
            store_T(accP, L + IM_RT, ti, tj, lane);
            __syncthreads();
            { f32x16 y = zero16v(), m = zero16v(), n;
#pragma unroll
              for (int g = 0; g < 4; ++g) { const u32x2 w = *(const LAS u32x2*)(L + IM_KT + (32 * tj + c32) * PT + (32 * ti + 8 * g + 4 * h) * 2); n[4 * g] = bflo(w.x); n[4 * g + 1] = bfhi(w.x); n[4 * g + 2] = bflo(w.y); n[4 * g + 3] = bfhi(w.y); }
              bf16x8 btj[4], bti[4], vfj[4]; frag_cols4(L + IM_BT, tj, lane, btj); frag_cols4(L + IM_BT, ti, lane, bti); frag_cols4(L + IM_F, tj, lane, vfj);
#pragma unroll
              for (int s = 0; s < 4; ++s) { const bf16x8 btc_j = btj[s], btc_i = bti[s];
                  y = MMA32(frag_rows(L + IM_RT, ti, s, lane), vfj[s], y);
                  m = MMA32(frag_rows(L + IM_AT, ti, s, lane), btc_j, m);
                  n = MMA32(btc_i, frag_rows(L + IM_AAK, tj, s, lane), n); }
              const float gck = GC[32 * tj + c32];
#pragma unroll
              for (int r = 0; r < 16; ++r) { const int row = 32 * ti + (r & 3) + 8 * (r >> 2) + 4 * h, col = 32 * tj + c32; m[r] = (m[r] + (row == col ? 1.0f : 0.f)) * gck; n[r] *= GC[row]; }
              if (live) {
#pragma unroll
                  for (int g = 0; g < 4; ++g) *(f32x4*)(YL + ci * 4096 + ((wg * 4 + g) * 64 + lane) * 4) = (f32x4){y[4 * g], y[4 * g + 1], y[4 * g + 2], y[4 * g + 3]};
#pragma unroll
                  for (int s2 = 0; s2 < 2; ++s2) *(bf16x8*)(MF + ci * 4096 + ((wg * 2 + s2) * 64 + lane) * 8) = pack8(m, s2); }
              store_T(n, L + IM_ARB, ti, tj, lane);
            }
            __syncthreads();
            { f32x16 gacc = zero16v(); bf16x8 nfi[4], vfj[4]; frag_cols4(L + IM_ARB, ti, lane, nfi); frag_cols4(L + IM_F, tj, lane, vfj);
#pragma unroll
              for (int s = 0; s < 4; ++s) gacc = MMA32(nfi[s], vfj[s], gacc);
              if (live) {
#pragma unroll
                  for (int hf = 0; hf < 2; ++hf) { u32x4 w; w.x = pk2(gacc[8 * hf], gacc[8 * hf + 1]); w.y = pk2(gacc[8 * hf + 2], gacc[8 * hf + 3]); w.z = pk2(gacc[8 * hf + 4], gacc[8 * hf + 5]); w.w = pk2(gacc[8 * hf + 6], gacc[8 * hf + 7]);
                      *(u32x4*)((unsigned*)GF + ci * 2048 + ((wg * 2 + hf) * 64 + lane) * 4) = w; } }
            }
        }
    }
    __syncthreads();
}
struct R2Buf { bf16x8 mf[8]; u32x4 g[4]; };
DI void rw2_load(R2Buf& b, const bf16* MF, const unsigned* GFu, size_t item, int tj, int lane) {
#pragma unroll
    for (int q = 0; q < 8; ++q) b.mf[q] = *(const bf16x8*)(MF + item * 4096 + (q * 64 + lane) * 8);
#pragma unroll
    for (int kt = 0; kt < 2; ++kt)
#pragma unroll
        for (int hf = 0; hf < 2; ++hf) b.g[kt * 2 + hf] = *(const u32x4*)(GFu + item * 2048 + (((kt * 2 + tj) * 2 + hf) * 64 + lane) * 4);
}
DI void rw2_step(const R2Buf& b, f32x16& s0, f32x16& s1, bf16* SF, size_t item, int tj, int lane) {
    bf16x8 sf[2][2];
#pragma unroll
    for (int s = 0; s < 2; ++s) { sf[0][s] = pack8(s0, s); sf[1][s] = pack8(s1, s); *(bf16x8*)(SF + item * 4096 + (((0 * 2 + tj) * 2 + s) * 64 + lane) * 8) = sf[0][s]; *(bf16x8*)(SF + item * 4096 + (((1 * 2 + tj) * 2 + s) * 64 + lane) * 8) = sf[1][s]; }
    f32x16 n0, n1;
#pragma unroll
    for (int hf = 0; hf < 2; ++hf) { const u32x4 a = b.g[hf], c = b.g[2 + hf];
        n0[8 * hf] = bflo(a.x); n0[8 * hf + 1] = bfhi(a.x); n0[8 * hf + 2] = bflo(a.y); n0[8 * hf + 3] = bfhi(a.y); n0[8 * hf + 4] = bflo(a.z); n0[8 * hf + 5] = bfhi(a.z); n0[8 * hf + 6] = bflo(a.w); n0[8 * hf + 7] = bfhi(a.w);
        n1[8 * hf] = bflo(c.x); n1[8 * hf + 1] = bfhi(c.x); n1[8 * hf + 2] = bflo(c.y); n1[8 * hf + 3] = bfhi(c.y); n1[8 * hf + 4] = bflo(c.z); n1[8 * hf + 5] = bfhi(c.z); n1[8 * hf + 6] = bflo(c.w); n1[8 * hf + 7] = bfhi(c.w); }
#pragma unroll
    for (int kp = 0; kp < 2; ++kp)
#pragma unroll
        for (int s = 0; s < 2; ++s) { n0 = MMA32(b.mf[(kp * 2 + 0) * 2 + s], sf[kp][s], n0); n1 = MMA32(b.mf[(kp * 2 + 1) * 2 + s], sf[kp][s], n1); }
    s0 = n0; s1 = n1;
}
DI void ph_rw2(const Ctx& C) {
    const int lane = C.lane;
    const bf16* MF = (const bf16*)(C.ws + WS_MF); const unsigned* GFu = (const unsigned*)(C.ws + WS_GF); bf16* SF = (bf16*)(C.ws + WS_SF);
    const int nwork = RSTR * 2;
    for (int wk = C.wave == 0 ? C.bid : nwork; wk < nwork; wk += C.G) {
        const int tj = wk & 1, stream = wk >> 1; const size_t it0 = (size_t)stream * RCK;
        f32x16 s0 = zero16v(), s1 = zero16v();
        R2Buf A, B, Cb;
        rw2_load(A, MF, GFu, it0, tj, lane); rw2_load(B, MF, GFu, it0 + (1 < RCK ? 1 : 0), tj, lane); rw2_load(Cb, MF, GFu, it0 + (2 < RCK ? 2 : 0), tj, lane);
        for (int c = 0; c < RCK; c += 3) {
            rw2_step(A, s0, s1, SF, it0 + c, tj, lane); rw2_load(A, MF, GFu, it0 + (c + 3 < RCK ? c + 3 : RCK - 1), tj, lane);
            if (c + 1 < RCK) { rw2_step(B, s0, s1, SF, it0 + c + 1, tj, lane); rw2_load(B, MF, GFu, it0 + (c + 4 < RCK ? c + 4 : RCK - 1), tj, lane); }
            if (c + 2 < RCK) { rw2_step(Cb, s0, s1, SF, it0 + c + 2, tj, lane); rw2_load(Cb, MF, GFu, it0 + (c + 5 < RCK ? c + 5 : RCK - 1), tj, lane); }
        }
    }
}
DI void ph_rw3(const Ctx& C, int l, int mrows) {
    const int lane = C.lane, wg = C.wave & 3, grp = C.wave >> 2, ti = wg >> 1, tj = wg & 1, c32 = lane & 31, h = lane >> 5;
    LAS float* Ysum = (LAS float*)(C.lds + grp * RW_HALF);
    const bf16* QH = (const bf16*)(C.ws + WS_QH); const float* YL = (const float*)(C.ws + WS_YL); const bf16* SF = (const bf16*)(C.ws + WS_SF); bf16* OB = (bf16*)(C.ws + WS_OB);
    const int nblk = (TC + T) / 64, nitems = NB * NH * nblk;
    for (int it0 = 2 * C.bid; it0 < nitems; it0 += 2 * C.G) {
        const int item = it0 + grp; const bool live = item < nitems; const int itc = live ? item : nitems - 1;
        const int tb = itc % nblk, hd = (itc / nblk) % NH, b = itc / (nblk * NH);
        const int rowb = tb < TC / 64 ? M_LAT + b * TC + 64 * tb : b * T + 64 * (tb - TC / 64);
        __syncthreads();
        f32x4 yl[2][4]; u32x4 qa[2][4]; bf16x8 sb[2][4];
#pragma unroll
        for (int dir = 0; dir < 2; ++dir) {
            const int c = dir == 0 ? tb : (tb < TC / 64 ? TC / 64 - 1 - tb : TC / 64 + (T / 64 - 1 - (tb - TC / 64)));
            const size_t ci = ((size_t)((b * NH + hd) * 2 + dir)) * RCK + c;
#pragma unroll
            for (int g = 0; g < 4; ++g) yl[dir][g] = *(const f32x4*)(YL + ci * 4096 + ((wg * 4 + g) * 64 + lane) * 4);
#pragma unroll
            for (int kp = 0; kp < 2; ++kp)
#pragma unroll
                for (int s = 0; s < 2; ++s) { const bf16* qp = QH + ci * 4096 + (32 * ti + c32) * 64 + 32 * kp + 16 * s + 4 * h; const u32x2 lo = *(const u32x2*)qp, hi = *(const u32x2*)(qp + 8);
                    qa[dir][kp * 2 + s].x = lo.x; qa[dir][kp * 2 + s].y = lo.y; qa[dir][kp * 2 + s].z = hi.x; qa[dir][kp * 2 + s].w = hi.y;
                    sb[dir][kp * 2 + s] = *(const bf16x8*)(SF + ci * 4096 + (((kp * 2 + tj) * 2 + s) * 64 + lane) * 8); }
        }
#pragma unroll
        for (int dir = 0; dir < 2; ++dir) {
            f32x16 y;
#pragma unroll
            for (int g = 0; g < 4; ++g) { const f32x4 a = yl[dir][g]; y[4 * g] = a[0]; y[4 * g + 1] = a[1]; y[4 * g + 2] = a[2]; y[4 * g + 3] = a[3]; }
#pragma unroll
            for (int q4 = 0; q4 < 4; ++q4) y = MMA32(__builtin_bit_cast(bf16x8, qa[dir][q4]), sb[dir][q4], y);
#pragma unroll
            for (int r = 0; r < 16; ++r) { const int i = 32 * ti + (r & 3) + 8 * (r >> 2) + 4 * h, tk = dir ? 63 - i : i; LAS float* p = Ysum + tk * FP + 32 * tj + c32; if (dir == 0) *p = y[r]; else *p += y[r]; }
            __syncthreads();
        }
        if (live) {
            const int cch = hd * 64 + lane; const float rk = C.in[I_RWRK][((size_t)l * NH + hd) * 64 + lane], gw = C.in[I_RWGNW][(size_t)l * GW + cch], gb = C.in[I_RWGNB][(size_t)l * GW + cch];
#pragma unroll 1
            for (int t4 = 0; t4 < 16; t4 += 8) {
                bf16 rb[8], vb[8], kb[8], gb8[8];
#pragma unroll
                for (int u = 0; u < 8; ++u) { const bf16* rv = (const bf16*)(C.ws + WS_RVKG) + (size_t)item * 4 * 4096 + (16 * wg + t4 + u) * 64 + lane; rb[u] = rv[0]; vb[u] = rv[4096]; kb[u] = rv[8192]; gb8[u] = rv[12288]; }
#pragma unroll
                for (int u = 0; u < 8; ++u) { const int tk = 16 * wg + t4 + u, row = rowb + tk; const float r = bf2f(rb[u]), v = bf2f(vb[u]), ks = bf2f(kb[u]), gg = bf2f(gb8[u]);
                    float y = Ysum[tk * FP + lane] + wave_sum(r * ks * rk) * v;
                    const float mu = wave_sum(y) * (1.f / 64.f), dlt = y - mu, var = wave_sum(dlt * dlt) * (1.f / 64.f);
                    if (row < mrows) OB[(size_t)row * D + GW + cch] = (bf16)f2bf((dlt * __builtin_amdgcn_rsqf(var + RW_GN_EPS) * gw + gb) * gg); } }
        }
    }
    __syncthreads();
}
constexpr int S5X_OFF = NW * 16640;
DI void ph_s5scan(const Ctx& C, int l, int first_block, int nblocks) {
    constexpr int nc_ctx = TC / S5L, nc_lat = T / S5L, ntot = nc_ctx + nc_lat, SEG = ntot / NW;
    static_assert(ntot % NW == 0 && S5X_OFF + NW * 64 * 8 <= MISC_OFF, "S5 scan segmentation");
    if ((int)C.bid < first_block || (int)C.bid >= first_block + nblocks) return;
    const float* XE = (const float*)(C.ws + WS_XEND); bf16* UG = (bf16*)(C.ws + WS_UG);
    const f32x2* LAM = (const f32x2*)(C.ws + WS_S5T + (size_t)l * SZ_S5L + OFF_S5LAM);
    LAS f32x2* XCH = (LAS f32x2*)(C.lds + S5X_OFF);
    for (int combo = C.bid - first_block; combo < NB * 2 * S5G; combo += nblocks) {
        const int g = combo % S5G, dir = (combo / S5G) & 1, b = combo / (2 * S5G), n = C.lane, seg = C.wave;
        const f32x2 lm = LAM[(dir * S5G + g) * 64 + n];
        float er[SEG], ei[SEG];
#pragma unroll
        for (int u = 0; u < SEG; ++u) { const int i = seg * SEG + u; const int ch = i < nc_ctx ? (M_LAT + b * TC) / S5L + (dir ? nc_ctx - 1 - i : i) : (b * T) / S5L + (dir ? nc_lat - 1 - (i - nc_ctx) : (i - nc_ctx));
            const float* p = XE + ((size_t)g * NCHP + ch) * 256 + dir * 128 + n; er[u] = p[0]; ei[u] = p[64]; }
        float pr = lm[0], pi = lm[1];
#pragma unroll 1
        for (int u = 1; u < SEG; ++u) { const float tr = pr * lm[0] - pi * lm[1], ti2 = pr * lm[1] + pi * lm[0]; pr = tr; pi = ti2; }
        float xr = 0.f, xi = 0.f;
#pragma unroll
        for (int u = 0; u < SEG; ++u) { const float nr = lm[0] * xr - lm[1] * xi + er[u], ni = lm[0] * xi + lm[1] * xr + ei[u]; xr = nr; xi = ni; }
        XCH[seg * 64 + n] = (f32x2){xr, xi};
        __syncthreads();
        xr = 0.f; xi = 0.f;
        for (int s2 = 0; s2 < seg; ++s2) { const f32x2 e = XCH[s2 * 64 + n]; const float nr = pr * xr - pi * xi + e[0], ni = pr * xi + pi * xr + e[1]; xr = nr; xi = ni; }
        __syncthreads();
#pragma unroll
        for (int u = 0; u < SEG; ++u) { const int i = seg * SEG + u; const int ch = i < nc_ctx ? (M_LAT + b * TC) / S5L + (dir ? nc_ctx - 1 - i : i) : (b * T) / S5L + (dir ? nc_lat - 1 - (i - nc_ctx) : (i - nc_ctx));
            bf16* q = UG + ((size_t)g * NCHP + ch) * S5K + 512 + dir * 128 + n; q[0] = (bf16)f2bf(xr); q[64] = (bf16)f2bf(xi);
            const float nr = lm[0] * xr - lm[1] * xi + er[u], ni = lm[0] * xi + lm[1] * xr + ei[u]; xr = nr; xi = ni; }
    }
}

constexpr int PH_PRO = 3, PH_PER_L = 13, NPH = PH_PRO + PH_PER_L * NL;
#ifndef PROBE_REP
#define PROBE_REP -1
#endif
#define NREP(k) ((k) == PROBE_REP ? 2 : 1)
#ifdef ONLY
#define EN(k) ((k) == ONLY)
#else
#define EN(k) true
#endif
#ifdef EMU
void fwd(Args args) {
    unsigned char* lds = emu::lds_base();
#else
__global__ void __launch_bounds__(NTHR, 2) fwd(Args args) {
    extern __shared__ __attribute__((aligned(16))) unsigned char lds[];
#endif
    Ctx C; C.in = args.in; C.out = args.out; C.ws = args.ws; C.lds = (LAS unsigned char*)lds;
    C.tid = threadIdx.x; C.lane = C.tid & 63; C.wave = __builtin_amdgcn_readfirstlane(C.tid >> 6); C.G = gridDim.x; C.bid = blockIdx.x;
#define REFRESH() do { int t_ = threadIdx.x; OPAQUE(t_); C.tid = t_; C.lane = t_ & 63; C.wave = __builtin_amdgcn_readfirstlane(t_ >> 6); } while (0)
    volatile LAS unsigned* MISC = (volatile LAS unsigned*)(C.lds + MISC_OFF);
    if (C.tid < 32) MISC[C.tid] = 0u;
    __syncthreads();
    const int lo = args.ph_lo, hi = args.ph_hi;
    const bool use_bar = (hi - lo) > 1;
    XcdBarrier bar; bar.bar = (unsigned*)(C.ws + WS_CTL) + CW_BAR; bar.x = 0; bar.st = MISC + 8;
    if (use_bar) bar = xcd_barrier_post((unsigned*)(C.ws + WS_CTL) + CW_BAR, MISC + 8);
#define IN(k) (lo <= (k) && (k) < hi)
#define SEAM(k) do { if (IN(k) && IN((k) + 1)) xcd_barrier(bar); } while (0)
    if (EN(0) && IN(0)) for (int rep = 0; rep < NREP(0); ++rep) { REFRESH(); ph_ada(C); }
    SEAM(0);
    if (EN(1) && IN(1)) { REFRESH(); ph_conv(C); }
    SEAM(1);
    if (EN(2) && IN(2)) for (int rep = 0; rep < NREP(2); ++rep) { REFRESH(); ph_tab(C); }
    SEAM(2);
    for (int l = 0; l < NL; ++l) {
        const int pb = PH_PRO + PH_PER_L * l; const bool want_ctx = l < NL - 1;
        const int mrows_full = M, mrows_out = want_ctx ? M : M_LAT;
        const int nt_attn = AT_NA + AT_WA + (want_ctx ? 2 * AT_CX : 0), nt_attn_a = (int)((long)nt_attn * ATTN_A_PCT / 100);
        bf16* AP = (bf16*)(C.ws + WS_AP); bf16* Hb = (bf16*)(C.ws + WS_H); bf16* OB = (bf16*)(C.ws + WS_OB);
        if (EN(3) && IN(pb + 0)) for (int rep = 0; rep < NREP(3); ++rep) { REFRESH();
            Gemm g{AP, wl(C, l, OFF_W1GU), D, D, D, 0, 0}; Order S; S.init(mrows_full / 256, 2 * FF / 256, 1, C.G, C.bid, D / 64);
            EpiGU E{rowss_ptr(C, l, 0), bias_ptr(C, l, 0), Hb, mrows_full}; gemm_phase(C.lds, g, S, E);
            if (EN(1) && l + 1 < NL) { REFRESH(); const int r = S.total % C.G;
                if ((int)C.bid >= r) conv_weights(C, l + 1, (C.bid - r) * NW + C.wave, (C.G - r) * NW, 0, CI_X1); } }
        SEAM(pb + 0);
        if (EN(4) && IN(pb + 1)) { REFRESH();
            Gemm g{Hb, wl(C, l, OFF_W1D), FF, FF, FF, 0, 0}; Order S; S.init(M_LAT / 256, D / 256, 1, C.G, C.bid, FF / 64);
            EpiRes E{&C, gate_ptr(C, l, 0, 0), gs_ptr(C, l, 1, 0), rowss_ptr(C, l, 1), AP}; gemm_phase(C.lds, g, S, E);
            { REFRESH(); Order S2; S2.init_split(M_LAT / 256, M_CTX / 256, D / 256, 4, C.G, C.bid, FF / 64); EpiAcc E2{&C, gate_ptr(C, l, 0, 0)}; gemm_phase(C.lds, g, S2, E2); } }
        SEAM(pb + 1);
        if (EN(18) && IN(pb + 2)) { REFRESH(); ph_ctxfix(C, gs_ptr(C, l, 1, 0), rowss_ptr(C, l, 1)); }
        SEAM(pb + 2);
        if (EN(5) && IN(pb + 3)) for (int rep = 0; rep < NREP(5); ++rep) { REFRESH();
            Gemm g{AP, wl(C, l, OFF_WIN), D, D, D, 0, 0}; Order S; S.init(mrows_full / 256, NT_IN, 1, C.G, C.bid, D / 64);
            EpiIn E{&C, rowss_ptr(C, l, 1), bias_ptr(C, l, 1), l}; gemm_phase(C.lds, g, S, E); }
        SEAM(pb + 3);
        if (IN(pb + 4)) {
            if (EN(6)) for (int rep = 0; rep < NREP(6); ++rep) { REFRESH(); Gemm g{(const bf16*)(C.ws + WS_UG), (const bf16*)(C.ws + WS_S5T + (size_t)l * SZ_S5L + OFF_S5ET), S5K, 512, 512, (size_t)NCHP * S5K * 2, (size_t)256 * 512 * 2};
              const int off5 = C.G >= 256 ? 32 : 0; Order S; S.init(NCHP / 256, 1, S5G, C.G - off5, (int)C.bid < off5 ? (1 << 28) : (int)C.bid - off5, 512 / 64);        EpiS5A E{(float*)(C.ws + WS_XEND)}; gemm_phase(C.lds, g, S, E); }
            __syncthreads();
            for (int rep = 0; rep < NREP(9); ++rep) { if (EN(9)) { REFRESH(); ph_rw1(C, l); } }
            if (EN(7)) for (int rep = 0; rep < NREP(7); ++rep) { REFRESH(); const int fb = (C.G >= 256 && 2 * C.G < RBLK && RBLK % (2 * C.G) != 0) ? (RBLK % (2 * C.G) + 1) / 2 : 0;
                ph_attn(C, l, want_ctx, C.bid >= fb ? (C.bid - fb) * NW + C.wave : -1, (C.G - fb) * NW, 0, nt_attn_a); }
        }
        SEAM(pb + 4);
        if (IN(pb + 5)) {
            if (EN(17)) for (int rep = 0; rep < NREP(17); ++rep) { REFRESH(); ph_rw2(C); }
            if (EN(10)) for (int rep = 0; rep < NREP(10); ++rep) { REFRESH(); ph_s5scan(C, l, C.G >= 256 ? 64 : 0, C.G >= 256 ? 128 : C.G); }
            { REFRESH();
              const int nrb = C.G < RSTR * 2 ? C.G : RSTR * 2, sb_lo = C.G, sb_hi = C.G;
              const int nworkers = nrb * 7 + (C.G - nrb - (sb_hi - sb_lo)) * NW;
              const int widx = C.bid < nrb ? (C.wave == 0 ? -1 : C.bid * 7 + C.wave - 1) : (C.bid >= sb_lo && C.bid < sb_hi) ? -1 : nrb * 7 + (C.bid - nrb - (C.bid >= sb_hi ? sb_hi - sb_lo : 0)) * NW + C.wave;
              if (EN(7)) ph_attn(C, l, want_ctx, widx, nworkers, nt_attn_a, nt_attn); }
        }
        SEAM(pb + 5);
        if (IN(pb + 6)) {
            if (EN(11)) for (int rep = 0; rep < NREP(11); ++rep) { REFRESH(); Gemm g{(const bf16*)(C.ws + WS_UG), (const bf16*)(C.ws + WS_S5T + (size_t)l * SZ_S5L + OFF_S5BT), S5K, S5K, S5K, (size_t)NCHP * S5K * 2, (size_t)512 * S5K * 2};
              const int off5 = C.G >= 256 ? 64 : 0; Order S; S.init(NCHP / 256, 2, S5G, C.G - off5, (int)C.bid < off5 ? (1 << 28) : (int)C.bid - off5, S5K / 64);        EpiS5C E{(const bf16*)(C.ws + WS_UG), C.in[I_S5D] + (size_t)l * GW, (bf16*)(C.ws + WS_YG)}; gemm_phase(C.lds, g, S, E); }
            if (EN(12)) for (int rep = 0; rep < NREP(12); ++rep) { REFRESH(); ph_rw3(C, l, mrows_out); }
        }
        SEAM(pb + 6);
        if (EN(13) && IN(pb + 7)) for (int rep = 0; rep < NREP(13); ++rep) { REFRESH();
            Gemm g{(const bf16*)(C.ws + WS_YG), wl(C, l, OFF_WGLU), GW, GW, GW, 0, 0}; Order S; S.init(mrows_out / 256, GW / 256, 1, C.G, C.bid, GW / 64);
            EpiGLU E{(const bf16*)(C.ws + WS_YG), C.in[I_S5GLUB] + (size_t)l * GW, OB}; gemm_phase(C.lds, g, S, E); }
        SEAM(pb + 7);
        if (EN(14) && IN(pb + 8)) { REFRESH();
            Gemm g{OB, wl(C, l, OFF_WOUT), D, D, D, 0, 0}; Order S; S.init(M_LAT / 256, D / 256, 1, C.G, C.bid, D / 64);
            EpiRes E{&C, gate_ptr(C, l, 1, 0), gs_ptr(C, l, 2, 0), rowss_ptr(C, l, 2), AP}; gemm_phase(C.lds, g, S, E);
            if (want_ctx) { REFRESH(); Order S2; S2.init_split(M_LAT / 256, M_CTX / 256, D / 256, 4, C.G, C.bid, D / 64); EpiAcc E2{&C, gate_ptr(C, l, 1, 0)}; gemm_phase(C.lds, g, S2, E2); } }
        SEAM(pb + 8);
        if (EN(18) && IN(pb + 9) && want_ctx) { REFRESH(); ph_ctxfix(C, gs_ptr(C, l, 2, 0), rowss_ptr(C, l, 2)); }
        SEAM(pb + 9);
        if (EN(15) && IN(pb + 10)) { REFRESH();
            Gemm g{AP, wl(C, l, OFF_W2GU), D, D, D, 0, 0}; Order S; S.init(mrows_out / 256, 2 * FF / 256, 1, C.G, C.bid, D / 64);
            EpiGU E{rowss_ptr(C, l, 2), bias_ptr(C, l, 2), Hb, mrows_out}; gemm_phase(C.lds, g, S, E);
            if (EN(1) && l + 1 < NL) { REFRESH(); const int r = S.total % C.G;
                if ((int)C.bid >= r) conv_weights(C, l + 1, (C.bid - r) * NW + C.wave, (C.G - r) * NW, CI_X1, CI_LAYER); } }
        SEAM(pb + 10);
        if (EN(16) && IN(pb + 11)) { REFRESH();
            Gemm g{Hb, wl(C, l, OFF_W2D), FF, FF, FF, 0, 0}; Order S; S.init(M_LAT / 256, D / 256, 1, C.G, C.bid, FF / 64);
            const bool more = l + 1 < NL;
            EpiRes E{&C, gate_ptr(C, l, 2, 0), more ? gs_ptr(C, l + 1, 0, 0) : nullptr, more ? rowss_ptr(C, l + 1, 0) : nullptr, AP}; gemm_phase(C.lds, g, S, E);
            if (want_ctx) { REFRESH(); Order S2; S2.init_split(M_LAT / 256, M_CTX / 256, D / 256, 4, C.G, C.bid, FF / 64); EpiAcc E2{&C, gate_ptr(C, l, 2, 0)}; gemm_phase(C.lds, g, S2, E2); } }
        SEAM(pb + 11);
        if (EN(18) && IN(pb + 12) && want_ctx) { REFRESH(); ph_ctxfix(C, gs_ptr(C, l + 1, 0, 0), rowss_ptr(C, l + 1, 0)); }
        SEAM(pb + 12);
    }
#undef IN
#undef SEAM
}

#ifndef MK_PER_PHASE
#define MK_PER_PHASE 0
#endif
#ifdef EMU
int g_emu_grid = 4, g_emu_lo = 0, g_emu_hi = NPH;
#endif
extern "C" void kernel_launch(void* const* d_in, const int* in_sizes, int n_in, void* d_out, int out_size, void* d_ws, size_t ws_size, hipStream_t stream) {
    Args a{};
    for (int i = 0; i < 42; ++i) a.in[i] = (const float*)d_in[i];
    a.out = (float*)d_out; a.ws = (unsigned char*)d_ws;
#ifdef EMU
    if (g_emu_lo == 0) hipMemsetAsync(d_ws, 0, WS_ZERO_END, stream);
    for (int ph = g_emu_lo; ph < g_emu_hi; ++ph) { a.ph_lo = ph; a.ph_hi = ph + 1; fprintf(stderr, "phase %d\n", ph); emu::launch(g_emu_grid, NTHR, LDS_BYTES, [=] { fwd(a); }); }
#else
    static int grid = 0;
    if (grid == 0) {
        if (n_in != 42 || out_size != M_LAT * D || ws_size < WS_END) { fprintf(stderr, "kernel_launch: unexpected shapes (n_in %d out %d ws %zu need %zu)\n", n_in, out_size, ws_size, (size_t)WS_END); grid = -1; return; }
        int dev = 0, cus = 0;
        if (hipGetDevice(&dev) != hipSuccess || hipDeviceGetAttribute(&cus, hipDeviceAttributeMultiprocessorCount, dev) != hipSuccess) { grid = -1; return; }
        if (hipFuncSetAttribute((const void*)fwd, hipFuncAttributeMaxDynamicSharedMemorySize, LDS_BYTES) != hipSuccess) { fprintf(stderr, "kernel_launch: hipFuncSetAttribute failed\n"); grid = -1; return; }
        int per_cu = 0; (void)hipOccupancyMaxActiveBlocksPerMultiprocessor(&per_cu, (const void*)fwd, NTHR, LDS_BYTES); (void)hipGetLastError();
        if (per_cu < 1) fprintf(stderr, "kernel_launch: occupancy query reports %d\n", per_cu);
        grid = cus;
    }
    if (grid < 0) return;
    (void)hipMemsetAsync(d_ws, 0, WS_ZERO_END, stream);
#if MK_PER_PHASE
    for (int ph = 0; ph < NPH; ++ph) { a.ph_lo = ph; a.ph_hi = ph + 1; hipLaunchKernelGGL(fwd, dim3(grid), dim3(NTHR), LDS_BYTES, stream, a); }
#else
    a.ph_lo = 0; a.ph_hi = NPH;
    hipLaunchKernelGGL(fwd, dim3(grid), dim3(NTHR), LDS_BYTES, stream, a);
#endif
#endif
}
```

```cpp
#ifdef EMU
#include "emu/emu.h"
#define LAS
#define GAS
#define ASMV(...) ((void)0)
#define WSYNC() do { int _z = 0; (void)emu::wave_gather(&_z, 4); } while (0)
#define OPAQUE(x) ((void)0)
#define OPAQUE_S(x) ((void)0)
#define PIN(x) ((void)0)
#define PIN4(a, b, c, d) ((void)0)
#define OPAQUE_LDS(p) (p)
#else
#include <hip/hip_runtime.h>
#include <cstdio>
#include <cstdint>
#define LAS __attribute__((address_space(3)))
#define GAS __attribute__((address_space(1)))
#define ASMV(...) asm volatile(__VA_ARGS__)
#define PIN(x) asm volatile("" : "+v"(x) :: "memory")
#define PIN4(a, b, c, d) asm volatile("" : "+v"(a), "+v"(b), "+v"(c), "+v"(d) :: "memory")
template <class P> __device__ __forceinline__ P opaque_lds(P p) { unsigned a = (unsigned)(size_t)p; asm volatile("" : "+v"(a)); return (P)(size_t)a; }
#define OPAQUE_LDS(p) opaque_lds(p)
#define OPAQUE_S(x) asm volatile("" : "+s"(x))
#define OPAQUE(x) asm volatile("" : "+v"(x))
#define WSYNC() asm volatile("s_waitcnt lgkmcnt(0)" ::: "memory")
#endif

#ifdef EMU
constexpr int D = 1024, NB = 2, T = 1024, NL = 2, TC = 256, FF = 1024;
#else
constexpr int D = 2048, NB = 2, T = 8192, NL = 4, TC = 256, FF = 5632;
#endif
constexpr int GW = D / 4, NH = GW / 64, WAG = NH / 2, S5G = GW / 16, GRW = 64, GRH = T / GRW;
constexpr int M_LAT = NB * T, M_CTX = NB * TC, M = M_LAT + M_CTX, NPAN = M / 256;
constexpr int TP = GW / 256;
constexpr int NT_IN = 8 * TP + 2, NINP = NT_IN * 256, D_IN = 8 * GW + 416;
constexpr int PN_AQ = 0, PN_AK = TP, PN_AV = 2 * TP, PN_BR = 3 * TP, PN_BK = 4 * TP, PN_BV = 5 * TP, PN_BS = 6 * TP, PN_CQ = 6 * TP + 1, PN_CKV = 7 * TP + 1, PN_DU = 7 * TP + 2;
constexpr int SRC_AQ = 0, SRC_AK = GW, SRC_AV = 2 * GW, SRC_BR = 3 * GW, SRC_BK = 4 * GW, SRC_BV = 5 * GW, SRC_BS = 6 * GW, SRC_CQ = 6 * GW + 160, SRC_CK = 7 * GW + 160, SRC_CV = 7 * GW + 288, SRC_DU = 7 * GW + 416;
constexpr int S5L = 32, NCH = M / S5L, NCHP = ((NCH + 255) / 256) * 256, S5K = 768;
constexpr int NW = 8, NTHR = 512;
constexpr float NORM_EPS = 1e-6f, RW_GN_EPS = 64e-5f;

typedef unsigned short bf16;
typedef short bf16x8 __attribute__((ext_vector_type(8)));
typedef short s16x4 __attribute__((ext_vector_type(4)));
typedef float f32x4 __attribute__((ext_vector_type(4)));
typedef float f32x2 __attribute__((ext_vector_type(2)));
typedef float f32x16 __attribute__((ext_vector_type(16)));
typedef unsigned u32x4 __attribute__((ext_vector_type(4)));
typedef unsigned u32x2 __attribute__((ext_vector_type(2)));
#define DI __device__ __forceinline__

constexpr size_t al256(size_t x) { return (x + 255) & ~(size_t)255; }
constexpr size_t SZ_BIAS_GU = (size_t)3 * 2 * FF * 4, SZ_BIAS_IN = (size_t)3 * NINP * 4;
constexpr size_t WS_CTL = 0;
constexpr size_t WS_BIAS = 65536;
constexpr size_t SZ_BIAS_L = 2 * SZ_BIAS_GU + SZ_BIAS_IN;
constexpr size_t WS_ROWSS = al256(WS_BIAS + NL * SZ_BIAS_L);
constexpr size_t WS_ZERO_END = al256(WS_ROWSS + (size_t)NL * 3 * M * 4);
constexpr size_t WS_MODV = WS_ZERO_END;
constexpr size_t WS_GS = al256(WS_MODV + (size_t)NL * 3 * 9 * D * 4);
constexpr size_t WS_GATE = al256(WS_GS + (size_t)NL * 9 * D * 4);
constexpr size_t WS_ROPE = al256(WS_GATE + (size_t)NL * 9 * D * 4);
constexpr size_t SZ_WGU = (size_t)2 * FF * D * 2, SZ_WD = (size_t)D * FF * 2, SZ_WIN = (size_t)NINP * D * 2, SZ_WOUT = (size_t)D * D * 2, SZ_WGLU = (size_t)GW * GW * 2;
constexpr size_t OFF_W1GU = 0, OFF_W1D = OFF_W1GU + SZ_WGU, OFF_WIN = OFF_W1D + SZ_WD, OFF_WOUT = OFF_WIN + SZ_WIN, OFF_W2GU = OFF_WOUT + SZ_WOUT, OFF_W2D = OFF_W2GU + SZ_WGU, OFF_WGLU = OFF_W2D + SZ_WD, SZ_WL = OFF_WGLU + SZ_WGLU;
constexpr size_t WS_W = al256(WS_ROPE + 128 * 16 * 8);
constexpr size_t SZ_S5KC = (size_t)S5G * 2 * S5L * 256 * 4, SZ_S5ET = (size_t)S5G * 256 * 512 * 2, SZ_S5BT = (size_t)S5G * 512 * S5K * 2, SZ_S5LAM = (size_t)2 * GW * 4 * 8;
constexpr size_t SZ_S5LP = (size_t)2 * S5G * 64 * (S5L + 1) * 8, SZ_S5BETA = (size_t)2 * S5G * 64 * 16 * 8;
constexpr size_t OFF_S5KC = 0, OFF_S5ET = OFF_S5KC + SZ_S5KC, OFF_S5BT = OFF_S5ET + SZ_S5ET, OFF_S5LAM = OFF_S5BT + SZ_S5BT, OFF_S5LP = al256(OFF_S5LAM + SZ_S5LAM), OFF_S5BETA = OFF_S5LP + SZ_S5LP, SZ_S5L = al256(OFF_S5BETA + SZ_S5BETA);
constexpr size_t WS_S5T = al256(WS_W + NL * SZ_WL);
constexpr size_t WS_XC = al256(WS_S5T + NL * SZ_S5L);
constexpr size_t WS_AP = al256(WS_XC + (size_t)M_CTX * D * 4);
constexpr size_t WS_H = al256(WS_AP + (size_t)M * D * 2);
constexpr size_t WS_QA = al256(WS_H + (size_t)M * FF * 2);
constexpr size_t WS_KA = WS_QA + (size_t)M * GW * 2, WS_VA = WS_KA + (size_t)M * GW * 2, WS_QC = WS_VA + (size_t)M * GW * 2;
constexpr size_t WS_KC = WS_QC + (size_t)M * GW * 2, WS_VC = WS_KC + (size_t)M * 128 * 2;
constexpr size_t WS_PB = WS_VC + (size_t)M * 128 * 2;
constexpr size_t WS_PS = al256(WS_PB + (size_t)M * 3 * GW * 2);
constexpr size_t WS_UG = al256(WS_PS + (size_t)M * 160 * 4);
constexpr size_t WS_RW = al256(WS_UG + (size_t)S5G * NCHP * S5K * 2);
constexpr size_t SZ_RWA = (size_t)M * GW * 4;
enum { RW_R = 0, RW_V, RW_NKK, RW_G, RW_W0, RW_W1, RW_K0, RW_K1, RW_B0, RW_B1, RW_Y0, RW_Y1, RW_NARR };
constexpr size_t WS_XEND = al256(WS_RW + 256);
constexpr size_t WS_YG = al256(WS_XEND + (size_t)S5G * NCHP * 256 * 4);
constexpr size_t WS_OB = al256(WS_YG + (size_t)M * GW * 2);
constexpr int RCK = (TC + T) / 64, RSTR = NB * NH * 2, RITEM = RSTR * RCK;
constexpr size_t WS_QH = al256(WS_OB + (size_t)M * D * 2);
constexpr size_t WS_YL = al256(WS_QH + (size_t)RITEM * 8192);
constexpr size_t WS_MF = al256(WS_YL + (size_t)RITEM * 16384);
constexpr size_t WS_GF = al256(WS_MF + (size_t)RITEM * 8192);
constexpr size_t WS_SF = al256(WS_GF + (size_t)RITEM * 16384);
constexpr int RBLK = NB * NH * ((TC + T) / 64);
constexpr size_t WS_RVKG = al256(WS_SF + (size_t)RITEM * 8192);
constexpr size_t SZ_RWF = (size_t)14 * NH * 2 * 64 * 16;
constexpr size_t WS_RWF = al256(WS_RVKG + (size_t)RBLK * 32768);
constexpr size_t WS_RWS = al256(WS_RWF + NL * SZ_RWF);
constexpr size_t WS_END = al256(WS_RWS + (size_t)512 * 2 * 65536);
constexpr int CW_BAR = 1024;

constexpr int LDS_BYTES = 147456, RING_BYTES = 131072, MISC_OFF = LDS_BYTES - 256;

DI unsigned f2bf(float f) { unsigned u = __float_as_uint(f); return (u + 0x7fffu + ((u >> 16) & 1u)) >> 16; }
#ifdef EMU
DI unsigned pk2(float lo, float hi) { return f2bf(lo) | (f2bf(hi) << 16); }
#else
typedef __bf16 hbf16x2 __attribute__((ext_vector_type(2)));
DI unsigned pk2(float lo, float hi) { const f32x2 v = {lo, hi}; const hbf16x2 b = __builtin_convertvector(v, hbf16x2); return __builtin_bit_cast(unsigned, b); }
#endif
DI float bf2f(unsigned short b) { return __uint_as_float(((unsigned)b) << 16); }
DI float bflo(unsigned w) { return __uint_as_float(w << 16); }
DI float bfhi(unsigned w) { return __uint_as_float(w & 0xffff0000u); }
template <int N> DI float ror_add(float v) { return v + __int_as_float(__builtin_amdgcn_mov_dpp(__float_as_int(v), 0x120 + N, 0xf, 0xf, true)); }
DI float row16_sum(float v) { v = ror_add<8>(v); v = ror_add<4>(v); v = ror_add<2>(v); v = ror_add<1>(v); return v; }
DI float wave_sum(float v) {
    v = row16_sum(v);
    const float a = __int_as_float(__builtin_amdgcn_readlane(__float_as_int(v), 0)), b = __int_as_float(__builtin_amdgcn_readlane(__float_as_int(v), 16)),
                c = __int_as_float(__builtin_amdgcn_readlane(__float_as_int(v), 32)), d = __int_as_float(__builtin_amdgcn_readlane(__float_as_int(v), 48));
    return (a + b) + (c + d);
}
DI float siluf(float x) { return x * __builtin_amdgcn_rcpf(1.f + __expf(-x)); }
DI float fast_tanh(float x) { const float e = __expf(2.f * x); return 1.f - 2.f * __builtin_amdgcn_rcpf(e + 1.f); }
DI float sigmf(float x) { return __builtin_amdgcn_rcpf(1.f + __expf(-x)); }
DI float geluf(float x) { const float z = 0.7978845608028654f * (x + 0.044715f * x * x * x); const float e = __expf(2.f * z); return 0.5f * x * (1.f + (1.f - 2.f * __builtin_amdgcn_rcpf(e + 1.f))); }
DI int stream_of_row(int row) { return row < M_LAT ? row / T : NB; }
DI int stream_of_panel(int pm) { return stream_of_row(pm * 256); }

#define XB_TMO      128
#define XB_XCNT(j)  (256  + 64 * (j))
#define XB_XSUB(j)  (1280 + 64 * (j))
#define XB_XGEN(j)  (2304 + 64 * (j))
#define XB_TOP      3328
#define XB_TOPGEN   3392
#define XCD_BAR_WORDS 3456
#define XB_SPIN_CAP (1u << 18)
DI unsigned xb_ld(unsigned* p)              { return __hip_atomic_load(p, __ATOMIC_RELAXED, __HIP_MEMORY_SCOPE_AGENT); }
DI unsigned xb_add(unsigned* p, unsigned v) { return __hip_atomic_fetch_add(p, v, __ATOMIC_RELAXED, __HIP_MEMORY_SCOPE_AGENT); }
DI unsigned xb_xcc_id() { return (unsigned)__builtin_amdgcn_s_getreg((3 << 11) | 20) & 0xFu; }
#define XB_SPIN(cond, bar) do { unsigned _sp = 0; while (cond) { __builtin_amdgcn_s_sleep(1); \
    if ((++_sp & 255u) == 0u) { if (xb_ld(&(bar)[XB_TMO])) break; if (_sp > XB_SPIN_CAP) { atomicAdd(&(bar)[XB_TMO], 1u); break; } } } } while (0)
struct XcdBarrier { unsigned* bar; unsigned x; volatile LAS unsigned* st; };
DI XcdBarrier xcd_barrier_post(unsigned* bar, volatile LAS unsigned* st) {
    XcdBarrier b; b.bar = bar; b.x = xb_xcc_id(); b.st = st;
    if (threadIdx.x == 0) (void)xb_add(&bar[XB_XCNT(b.x)], 1u);
    return b;
}
DI void xcd_barrier_complete(unsigned* bar, unsigned x, unsigned& nloc, unsigned& nx) {
    const unsigned G = gridDim.x * gridDim.y * gridDim.z;
    unsigned sum, cnt, mine, sp = 0u;
    for (;;) {
        sum = 0u; cnt = 0u; mine = 0u;
#pragma unroll
        for (unsigned j = 0; j < 16; ++j) { const unsigned c = xb_ld(&bar[XB_XCNT(j)]); sum += c; cnt += (c > 0u) ? 1u : 0u; mine = (j == x) ? c : mine; }
        if (sum == G) break;
        __builtin_amdgcn_s_sleep(1);
        if ((++sp & 255u) == 0u) { if (xb_ld(&bar[XB_TMO])) break; if (sp > XB_SPIN_CAP) { atomicAdd(&bar[XB_TMO], 1u); break; } }
    }
    nloc = mine > 0u ? mine : 1u; nx = cnt > 0u ? cnt : 1u;
}
DI void xcd_barrier(const XcdBarrier& b) {
    ASMV("s_waitcnt vmcnt(0)" ::: "memory");
    __syncthreads();
    if (threadIdx.x == 0) {
        unsigned* bar = b.bar;
        __builtin_amdgcn_s_waitcnt(0);
        unsigned nloc = b.st[0], nx = b.st[1];
        if (nloc == 0u) { xcd_barrier_complete(bar, b.x, nloc, nx); b.st[0] = nloc; b.st[1] = nx; }
        const unsigned old = xb_add(&bar[XB_XSUB(b.x)], 1u);
        const unsigned gen = old / nloc;
        if (old + 1u == (gen + 1u) * nloc) {
            __builtin_amdgcn_fence(__ATOMIC_RELEASE, "agent");
            ASMV("s_waitcnt vmcnt(0)" ::: "memory");
            const unsigned og = xb_add(&bar[XB_TOP], 1u);
            const unsigned tg = og / nx;
            if (og + 1u == (tg + 1u) * nx) xb_add(&bar[XB_TOPGEN], 1u);
            else XB_SPIN(xb_ld(&bar[XB_TOPGEN]) == tg, bar);
            __builtin_amdgcn_fence(__ATOMIC_ACQUIRE, "agent");
            xb_add(&bar[XB_XGEN(b.x)], 1u);
            ASMV("s_waitcnt vmcnt(0)" ::: "memory");
        } else {
            XB_SPIN(xb_ld(&bar[XB_XGEN(b.x)]) == gen, bar);
            __builtin_amdgcn_fence(__ATOMIC_ACQUIRE, "agent");
            ASMV("s_waitcnt vmcnt(0)" ::: "memory");
        }
    }
    __syncthreads();
}

constexpr int BK = 64, HALF = 128, HTB = HALF * BK * 2, NXCD = 8, WGM = 4;
DI int lds_byte(int r, int c) { const int st = (r >> 4) * 2 + (c >> 5), rr = r & 15, cc = c & 31, ob = rr * 64 + cc * 2; return st * 1024 + (ob ^ (((ob >> 9) & 1) << 5)); }
DI void stage_rc(int b, int& R, int& C) { const int st = b / 1024, sb = b % 1024, swz = sb ^ (((sb >> 9) & 1) << 5); R = (st >> 1) * 16 + swz / 64; C = (st & 1) * 32 + (swz % 64) / 2; }
struct Unit { int pm, pn, z, kt0; };
struct Gemm { const bf16* A; const bf16* Bt; int lda, ldb, K; size_t zA, zB; };
struct Order {
    int nM, nN, nZ, per, total, G, c, nkt, pm0, spl;
    DI void init(int nM_, int nN_, int nZ_, int G_, int c_, int nkt_) { nM = nM_; nN = nN_; nZ = nZ_; per = nM * nN; total = per * nZ; G = G_; c = c_; nkt = nkt_; pm0 = 0; spl = 0; }
    DI void init_split(int pm0_, int xM, int nN_, int spl_, int G_, int c_, int nkt_full) { nM = xM; nN = nN_; nZ = 1; per = xM * nN_ * spl_; total = per; G = G_; c = c_; nkt = nkt_full / spl_; pm0 = pm0_; spl = spl_; }
    DI bool next(int i, Unit& u) const {
        const long L = (long)i * G + c; if (L >= total) return false;
        if (spl) { const int j = (int)L; u.z = 0; u.pm = pm0 + j / (nN * spl); const int rem = j % (nN * spl); u.pn = rem / spl; u.kt0 = (rem % spl) * nkt; return true; }
        u.kt0 = 0;
        u.z = (int)(L / per); int wgid = (int)(L % per);
        { const int q = per / NXCD, r = per % NXCD, xcd = wgid % NXCD, off = wgid / NXCD; wgid = (xcd < r ? xcd * (q + 1) : r * (q + 1) + (xcd - r) * q) + off; }
        const int nig = WGM * nN, gid = wgid / nig, fm = gid * WGM, gsz = (nM - fm) < WGM ? (nM - fm) : WGM;
        u.pm = fm + ((wgid % nig) % gsz); u.pn = (wgid % nig) / gsz; return true;
    }
};

template <class Epi>
DI void gemm_phase(LAS unsigned char* lds, const Gemm g, const Order& S, const Epi& E) {
    int tid_ = threadIdx.x; OPAQUE(tid_);
    const int tid = tid_, wid = __builtin_amdgcn_readfirstlane(tid >> 6), lane = tid & 63, wr = wid >> 2, wc = wid & 3, fr = lane & 15, fq = lane >> 4;
    Unit cur, nxt; int ui = 0;
    if (!S.next(0, cur)) return;
    f32x4 acc[2][2][4][2];
#ifdef EMU
    (void)lds;
    for (;; ++ui) {
        if (ui > 0) { if (!S.next(ui, cur)) break; }
        const bf16* A = (const bf16*)((const char*)g.A + cur.z * g.zA); const bf16* B = (const bf16*)((const char*)g.Bt + cur.z * g.zB);
        for (int ai = 0; ai < 2; ++ai) for (int bj = 0; bj < 2; ++bj) for (int m = 0; m < 4; ++m) for (int n = 0; n < 2; ++n) for (int j = 0; j < 4; ++j) {
            const int r = 256 * cur.pm + 128 * ai + 64 * wr + 16 * m + fr, c = 256 * cur.pn + 128 * bj + 32 * wc + 16 * n + 4 * fq + j;
            const bf16* a = A + (size_t)r * g.lda; const bf16* b = B + (size_t)c * g.ldb; float s = 0.f;
            for (int k = cur.kt0 * BK; k < (cur.kt0 + S.nkt) * BK; ++k) s += bf2f(a[k]) * bf2f(b[k]);
            acc[ai][bj][m][n][j] = s; }
        E(acc, cur, wr, wc, fr, fq);
    }
#else
    unsigned voffA[2], voffB[2];
#pragma unroll
    for (int i = 0; i < 2; ++i) { int R, C; stage_rc(tid * 16 + i * 8192, R, C); voffA[i] = (unsigned)(R * g.lda + C) * 2u; voffB[i] = (unsigned)(R * g.ldb + C) * 2u; }
    const size_t kstep = (size_t)(BK * 2);
    const size_t hstepA = (size_t)HALF * g.lda * 2, hstepB = (size_t)HALF * g.ldb * 2, tstepA = 2 * hstepA, tstepB = 2 * hstepB;
    const unsigned ldsw = (unsigned)wid * 1024u;
    const int aoff = lds_byte(wr * 64 + fr, fq * 8), boff = lds_byte(wc * 32 + fr, fq * 8);
#define PG8_SA(b, h) (((b) * 2 + (h)) * HTB)
#define PG8_SB(b, h) ((4 + (b) * 2 + (h)) * HTB)
#define PG8_STAGE(bufoff, gbase, voff) do { _Pragma("unroll") for (int _i = 0; _i < 2; ++_i) \
        __builtin_amdgcn_global_load_lds((const unsigned*)((const char*)(gbase) + (voff)[_i]), (LAS unsigned*)(lds + (bufoff) + ldsw + _i * 8192), 16, 0, 0); } while (0)
#define PG8_LDA(dst, b, h) do { _Pragma("unroll") for (int m = 0; m < 4; ++m) _Pragma("unroll") for (int k = 0; k < 2; ++k) dst[m][k] = *(const LAS bf16x8*)(lds + PG8_SA(b, h) + aoff + m * 2048 + k * 1024); } while (0)
#define PG8_LDB(dst, b, h) do { _Pragma("unroll") for (int n = 0; n < 2; ++n) _Pragma("unroll") for (int k = 0; k < 2; ++k) dst[n][k] = *(const LAS bf16x8*)(lds + PG8_SB(b, h) + boff + n * 2048 + k * 1024); } while (0)
#define PG8_MMA(ai, bj, At, Bt) do { __builtin_amdgcn_s_setprio(1); _Pragma("unroll") for (int m = 0; m < 4; ++m) _Pragma("unroll") for (int n = 0; n < 2; ++n) _Pragma("unroll") for (int k = 0; k < 2; ++k) \
        acc[ai][bj][m][n] = __builtin_amdgcn_mfma_f32_16x16x32_bf16(Bt[n][k], At[m][k], acc[ai][bj][m][n], 0, 0, 0); __builtin_amdgcn_s_setprio(0); } while (0)
#define PG8_WAIT_V(n) asm volatile("s_waitcnt vmcnt(" #n ")" ::: "memory")
#define PG8_WAIT_L(n) asm volatile("s_waitcnt lgkmcnt(" #n ")" ::: "memory")
#define PG8_BAR __builtin_amdgcn_s_barrier()
#define PG8_SCHED __builtin_amdgcn_sched_barrier(0)
#pragma unroll
    for (int a = 0; a < 2; ++a)
#pragma unroll
        for (int b = 0; b < 2; ++b)
#pragma unroll
            for (int m = 0; m < 4; ++m)
#pragma unroll
                for (int n = 0; n < 2; ++n) acc[a][b][m][n] = (f32x4){0.f, 0.f, 0.f, 0.f};
    bf16x8 At[4][2], B0[2][2], B1[2][2];
    const char* cA = (const char*)g.A + (size_t)cur.z * g.zA + (size_t)cur.pm * tstepA + (size_t)cur.kt0 * kstep; const char* cB = (const char*)g.Bt + (size_t)cur.z * g.zB + (size_t)cur.pn * tstepB + (size_t)cur.kt0 * kstep;
    PG8_STAGE(PG8_SB(0, 0), cB, voffB); PG8_STAGE(PG8_SB(0, 1), cB + hstepB, voffB); PG8_STAGE(PG8_SA(0, 0), cA, voffA); PG8_STAGE(PG8_SA(0, 1), cA + hstepA, voffA);
    if (wr == 1) PG8_BAR;
    PG8_WAIT_V(2); PG8_BAR;
    PG8_STAGE(PG8_SB(1, 0), cB + kstep, voffB); PG8_STAGE(PG8_SA(1, 0), cA + kstep, voffA); PG8_STAGE(PG8_SB(1, 1), cB + hstepB + kstep, voffB);
    PG8_WAIT_V(6); PG8_BAR;
    for (;;) {
        const bool has_next = S.next(ui + 1, nxt);
        const char* nA = has_next ? (const char*)g.A + (size_t)nxt.z * g.zA + (size_t)nxt.pm * tstepA + (size_t)nxt.kt0 * kstep : cA; const char* nB = has_next ? (const char*)g.Bt + (size_t)nxt.z * g.zB + (size_t)nxt.pn * tstepB + (size_t)nxt.kt0 * kstep : cB;
        const int nt = S.nkt;
        for (int t = 0; t < nt; t += 2) {
            const bool last = (t == nt - 2);
            const char* a1 = cA + (size_t)(t + 1) * kstep;
            const char* a2 = last ? nA : cA + (size_t)(t + 2) * kstep; const char* b2 = last ? nB : cB + (size_t)(t + 2) * kstep;
            const char* a3 = a2 + kstep; const char* b3 = b2 + kstep;
            PG8_LDB(B0, 0, 0); PG8_LDB(B1, 0, 1); PG8_SCHED; PG8_LDA(At, 0, 0); PG8_STAGE(PG8_SA(1, 1), a1 + hstepA, voffA);
            PG8_WAIT_V(8); PG8_WAIT_L(0); PG8_BAR; PG8_MMA(0, 0, At, B0); PG8_MMA(0, 1, At, B1); PG8_BAR; PG8_SCHED;
            PG8_LDA(At, 0, 1); PG8_STAGE(PG8_SB(0, 0), b2, voffB); PG8_STAGE(PG8_SB(0, 1), b2 + hstepB, voffB); PG8_STAGE(PG8_SA(0, 0), a2, voffA);
            PG8_WAIT_V(8); PG8_WAIT_L(0); PG8_BAR; PG8_MMA(1, 0, At, B0); PG8_MMA(1, 1, At, B1); PG8_BAR; PG8_SCHED;
            PG8_LDB(B0, 1, 0); PG8_LDB(B1, 1, 1); PG8_SCHED; PG8_LDA(At, 1, 0); PG8_STAGE(PG8_SA(0, 1), a2 + hstepA, voffA);
            PG8_WAIT_V(8); PG8_WAIT_L(0); PG8_BAR; PG8_MMA(0, 0, At, B0); PG8_MMA(0, 1, At, B1); PG8_BAR; PG8_SCHED;
            PG8_LDA(At, 1, 1); PG8_STAGE(PG8_SB(1, 0), b3, voffB); PG8_STAGE(PG8_SB(1, 1), b3 + hstepB, voffB); PG8_STAGE(PG8_SA(1, 0), a3, voffA);
            PG8_WAIT_V(8); PG8_WAIT_L(0); PG8_BAR; PG8_MMA(1, 0, At, B0); PG8_MMA(1, 1, At, B1); PG8_BAR; PG8_SCHED;
        }
        if (wr == 0) PG8_BAR;
        E(acc, cur, wr, wc, fr, fq);
        if (!has_next) break;
#pragma unroll
        for (int a = 0; a < 2; ++a)
#pragma unroll
            for (int b = 0; b < 2; ++b)
#pragma unroll
                for (int m = 0; m < 4; ++m)
#pragma unroll
                    for (int n = 0; n < 2; ++n) acc[a][b][m][n] = (f32x4){0.f, 0.f, 0.f, 0.f};
        cur = nxt; cA = nA; cB = nB; ++ui;
        if (wr == 1) PG8_BAR;
    }
    PG8_WAIT_V(0);
    PG8_BAR;
#undef PG8_SA
#undef PG8_SB
#undef PG8_STAGE
#undef PG8_LDA
#undef PG8_LDB
#undef PG8_MMA
#undef PG8_WAIT_V
#undef PG8_WAIT_L
#undef PG8_BAR
#undef PG8_SCHED
#endif
}

struct Args {
    const float* in[42]; float* out; unsigned char* ws;
    int ph_lo, ph_hi;
};
struct Ctx {
    const float* const* in; float* out; unsigned char* ws;
    LAS unsigned char* lds; int tid, lane, wave, G, bid;
};
DI float* xrow_ptr(const Ctx& C, int row) { return row < M_LAT ? C.out + (size_t)row * D : (float*)(C.ws + WS_XC) + (size_t)(row - M_LAT) * D; }
DI const bf16* wl(const Ctx& C, int l, size_t off) { return (const bf16*)(C.ws + WS_W + (size_t)l * SZ_WL + off); }
DI float* bias_ptr(const Ctx& C, int l, int which  ) { return (float*)(C.ws + WS_BIAS + (size_t)l * SZ_BIAS_L + (which == 0 ? 0 : which == 1 ? SZ_BIAS_GU : SZ_BIAS_GU + SZ_BIAS_IN)); }
DI float* rowss_ptr(const Ctx& C, int l, int sub) { return (float*)(C.ws + WS_ROWSS) + ((size_t)l * 3 + sub) * M; }
DI const float* gs_ptr(const Ctx& C, int l, int sub, int s) { return (const float*)(C.ws + WS_GS) + (((size_t)l * 3 + sub) * 3 + s) * D; }
DI const float* gate_ptr(const Ctx& C, int l, int sub, int s) { return (const float*)(C.ws + WS_GATE) + (((size_t)l * 3 + sub) * 3 + s) * D; }
DI float* rw_arr(const Ctx& C, int a) { return (float*)(C.ws + WS_RW + (size_t)a * SZ_RWA); }
enum { I_X = 0, I_C, I_CTX, I_CCTX, I_WADA, I_BADA, I_NORMG, I_F1WG, I_F1WU, I_F1WD, I_F2WG, I_F2WU, I_F2WD, I_WIN, I_WOUT, I_NAQG, I_NAKG, I_NARPB, I_RWCONV, I_RWW0, I_RWWUP, I_RWA0, I_RWAUP,
       I_RWGUP, I_RWKK, I_RWKA, I_RWRK, I_RWGNW, I_RWGNB, I_WAQG, I_WAKG, I_WASINK, I_S5ARE, I_S5AIM, I_S5LDT, I_S5BRE, I_S5BIM, I_S5CRE, I_S5CIM, I_S5D, I_S5GLUW, I_S5GLUB, I_NIN };

struct EpiGU {
    const float* rowss; const float* bias  ; bf16* H; int mrows;
    DI void operator()(const f32x4 (&acc)[2][2][4][2], const Unit& u, int wr, int wc, int fr_, int fq_) const {
        int tz_ = threadIdx.x; OPAQUE(tz_); const int fr = tz_ & 15, fq = (tz_ & 63) >> 4; (void)fr_; (void)fq_;
        const int s = stream_of_panel(u.pm); const float* bs = bias + (size_t)s * 2 * FF + u.pn * 256 + wc * 32 + 4 * fq;
        f32x4 bg[2], bu[2];
#pragma unroll
        for (int n = 0; n < 2; ++n) { bg[n] = *(const f32x4*)(bs + 16 * n); bu[n] = *(const f32x4*)(bs + 128 + 16 * n); }
        float rsv[2][4];
#pragma unroll
        for (int ai = 0; ai < 2; ++ai)
#pragma unroll
            for (int m = 0; m < 4; ++m) rsv[ai][m] = rowss[u.pm * 256 + ai * 128 + wr * 64 + m * 16 + fr];
#pragma unroll
        for (int ai = 0; ai < 2; ++ai)
#pragma unroll
            for (int m = 0; m < 4; ++m) {
                const int row = u.pm * 256 + ai * 128 + wr * 64 + m * 16 + fr;
                const float rstd = __builtin_amdgcn_rsqf(rsv[ai][m] * (1.0f / D) + NORM_EPS);
                bf16* hp = H + (size_t)row * FF + u.pn * 128 + wc * 32 + 8 * fq;
                u32x4 w;
                { const f32x4 g = acc[ai][0][m][0] * rstd + bg[0], v = acc[ai][1][m][0] * rstd + bu[0]; w.x = pk2(siluf(g[0]) * v[0], siluf(g[1]) * v[1]); w.y = pk2(siluf(g[2]) * v[2], siluf(g[3]) * v[3]); }
                { const f32x4 g = acc[ai][0][m][1] * rstd + bg[1], v = acc[ai][1][m][1] * rstd + bu[1]; w.z = pk2(siluf(g[0]) * v[0], siluf(g[1]) * v[1]); w.w = pk2(siluf(g[2]) * v[2], siluf(g[3]) * v[3]); }
                *(u32x4*)hp = w;
            }
    }
};
struct EpiRes {
    const Ctx* C; const float* gate  ; const float* gsn  ; float* rowss_next; bf16* AP;
    DI void operator()(const f32x4 (&acc)[2][2][4][2], const Unit& u, int wr, int wc, int fr_, int fq_) const {
        int tz_ = threadIdx.x; OPAQUE(tz_); const int fr = tz_ & 15, fq = (tz_ & 63) >> 4; (void)fr_; (void)fq_;
        const int s = stream_of_panel(u.pm); const int col0 = u.pn * 256 + wc * 32 + 4 * fq;
        f32x4 gv[2][2], sv[2][2];
#pragma unroll
        for (int bj = 0; bj < 2; ++bj)
#pragma unroll
            for (int n = 0; n < 2; ++n) { gv[bj][n] = *(const f32x4*)(gate + (size_t)s * D + col0 + bj * 128 + n * 16); sv[bj][n] = gsn ? *(const f32x4*)(gsn + (size_t)s * D + col0 + bj * 128 + n * 16) : (f32x4){0.f, 0.f, 0.f, 0.f}; }
        f32x4 xc[2][2], xn[2][2];
        { const float* xp0 = xrow_ptr(*C, u.pm * 256 + wr * 64 + fr) + col0;
#pragma unroll
          for (int bj = 0; bj < 2; ++bj)
#pragma unroll
              for (int n = 0; n < 2; ++n) xn[bj][n] = *(const f32x4*)(xp0 + bj * 128 + n * 16); }
#pragma unroll
        for (int ai = 0; ai < 2; ++ai)
#pragma unroll
            for (int m = 0; m < 4; ++m) {
                const int row = u.pm * 256 + ai * 128 + wr * 64 + m * 16 + fr;
                float* xp = xrow_ptr(*C, row) + col0; float ss = 0.f;
#pragma unroll
                for (int bj = 0; bj < 2; ++bj)
#pragma unroll
                    for (int n = 0; n < 2; ++n) xc[bj][n] = xn[bj][n];
                if (ai * 4 + m < 7) { const int rn = ai * 4 + m + 1; const float* xq = xrow_ptr(*C, u.pm * 256 + (rn >> 2) * 128 + wr * 64 + (rn & 3) * 16 + fr) + col0;
#pragma unroll
                    for (int bj = 0; bj < 2; ++bj)
#pragma unroll
                        for (int n = 0; n < 2; ++n) xn[bj][n] = *(const f32x4*)(xq + bj * 128 + n * 16); }
#pragma unroll
                for (int bj = 0; bj < 2; ++bj)
#pragma unroll
                    for (int n = 0; n < 2; ++n) { f32x4 x = xc[bj][n]; x += gv[bj][n] * acc[ai][bj][m][n]; *(f32x4*)(xp + bj * 128 + n * 16) = x;
                        if (gsn) { ss += (x[0] * x[0] + x[1] * x[1]) + (x[2] * x[2] + x[3] * x[3]); const f32x4 a = x * sv[bj][n]; u32x2 w; w.x = pk2(a[0], a[1]); w.y = pk2(a[2], a[3]);
                            *(u32x2*)(AP + (size_t)row * D + col0 + bj * 128 + n * 16) = w; } }
                if (gsn) { ss += __shfl_xor(ss, 16); ss += __shfl_xor(ss, 32); if (fq == 0) atomicAdd(rowss_next + row, ss); }
            }
    }
};
struct EpiAcc {
    const Ctx* C; const float* gate;
    DI void operator()(const f32x4 (&acc)[2][2][4][2], const Unit& u, int wr, int wc, int fr_, int fq_) const {
        int tz_ = threadIdx.x; OPAQUE(tz_); const int fr = tz_ & 15, fq = (tz_ & 63) >> 4; (void)fr_; (void)fq_;
        const int s = stream_of_panel(u.pm); const int col0 = u.pn * 256 + wc * 32 + 4 * fq;
#pragma unroll
        for (int bj = 0; bj < 2; ++bj)
#pragma unroll
            for (int n = 0; n < 2; ++n) { const f32x4 gv = *(const f32x4*)(gate + (size_t)s * D + col0 + bj * 128 + n * 16);
#pragma unroll
                for (int ai = 0; ai < 2; ++ai)
#pragma unroll
                    for (int m = 0; m < 4; ++m) { float* xp = xrow_ptr(*C, u.pm * 256 + ai * 128 + wr * 64 + m * 16 + fr) + col0 + bj * 128 + n * 16; const f32x4 d = gv * acc[ai][bj][m][n];
#pragma unroll
                        for (int j = 0; j < 4; ++j) atomicAdd(xp + j, d[j]); } }
    }
};
struct EpiIn {
    const Ctx* C; const float* rowss; const float* bias  ; int l;
    DI void operator()(const f32x4 (&acc)[2][2][4][2], const Unit& u, int wr, int wc, int fr_, int fq_) const {
        int tz_ = threadIdx.x; OPAQUE(tz_); const int fr = tz_ & 15, fq = (tz_ & 63) >> 4; (void)fr_; (void)fq_;
        const int s = stream_of_panel(u.pm), pn = u.pn; const float* bs = bias + (size_t)s * NINP + pn * 256 + wc * 32 + 4 * fq;
        unsigned char* ws = C->ws;
        f32x4 bv[2][2];
#pragma unroll
        for (int bj = 0; bj < 2; ++bj)
#pragma unroll
            for (int n = 0; n < 2; ++n) bv[bj][n] = *(const f32x4*)(bs + bj * 128 + n * 16);
        float rsv[2][4];
#pragma unroll
        for (int ai = 0; ai < 2; ++ai)
#pragma unroll
            for (int m = 0; m < 4; ++m) rsv[ai][m] = rowss[u.pm * 256 + ai * 128 + wr * 64 + m * 16 + fr];
        const bool permuted = pn < PN_AV || (pn >= PN_CQ && pn < PN_DU);
        if (permuted) {
            const bool is_ckv = pn == PN_CKV, is_c = pn >= PN_CQ, is_q = pn < PN_AK || (pn >= PN_CQ && pn < PN_CKV);
            const bool plain_v = is_ckv && wc >= 2;
            const float* gsrc = C->in[is_c ? (is_q ? I_WAQG : I_WAKG) : (is_q ? I_NAQG : I_NAKG)] + (size_t)l * 64;
            f32x4 gn[2][2];
#pragma unroll
            for (int bj = 0; bj < 2; ++bj)
#pragma unroll
                for (int n = 0; n < 2; ++n) { gn[bj][n] = *(const f32x4*)(gsrc + 32 * bj + 16 * n + 4 * fq); if (is_q) gn[bj][n] *= 0.125f; }
            bf16* dst; int pitch, hcol;
            if (pn < PN_AK) { dst = (bf16*)(ws + WS_QA); pitch = GW; hcol = ((pn - PN_AQ) * 4 + wc) * 64; }
            else if (pn < PN_AV) { dst = (bf16*)(ws + WS_KA) + (size_t)((pn - PN_AK) * 4 + wc) * M * 64; pitch = 64; hcol = 0; }
            else if (pn < PN_CKV) { dst = (bf16*)(ws + WS_QC); pitch = GW; hcol = ((pn - PN_CQ) * 4 + wc) * 64; }
            else if (wc < 2) { dst = (bf16*)(ws + WS_KC) + (size_t)wc * M * 64; pitch = 64; hcol = 0; }
            else { dst = (bf16*)(ws + WS_VC) + (size_t)(wc - 2) * M * 64; pitch = 64; hcol = 0; }
            const f32x4* rope = (const f32x4*)(ws + WS_ROPE);
#pragma unroll
            for (int ai = 0; ai < 2; ++ai)
#pragma unroll
                for (int m = 0; m < 4; ++m) {
                    const int row = pn * 0 + u.pm * 256 + ai * 128 + wr * 64 + m * 16 + fr;
                    const float rstd = __builtin_amdgcn_rsqf(rsv[ai][m] * (1.0f / D) + NORM_EPS);
                    f32x4 v[2][2]; float ss = 0.f;
#pragma unroll
                    for (int bj = 0; bj < 2; ++bj)
#pragma unroll
                        for (int n = 0; n < 2; ++n) { v[bj][n] = acc[ai][bj][m][n] * rstd + bv[bj][n]; ss += (v[bj][n][0] * v[bj][n][0] + v[bj][n][1] * v[bj][n][1]) + (v[bj][n][2] * v[bj][n][2] + v[bj][n][3] * v[bj][n][3]); }
                    ss += __shfl_xor(ss, 16); ss += __shfl_xor(ss, 32);
                    if (!plain_v) { const float rs = 1.0f / sqrtf(ss * (1.0f / 64.0f) + NORM_EPS);
#pragma unroll
                        for (int bj = 0; bj < 2; ++bj)
#pragma unroll
                            for (int n = 0; n < 2; ++n) v[bj][n] = v[bj][n] * rs * gn[bj][n];
                        if (is_c && row < M_LAT) {
                            const int t = row % T; const int pos[2] = {t / GRW, t % GRW};
#pragma unroll
                            for (int bj = 0; bj < 2; ++bj) { const f32x4 cs0 = rope[(pos[bj] * 16 + 4 * fq) / 2], cs1 = rope[(pos[bj] * 16 + 4 * fq) / 2 + 1];
                                const float cc[4] = {cs0[0], cs0[2], cs1[0], cs1[2]}, sn[4] = {cs0[1], cs0[3], cs1[1], cs1[3]};
#pragma unroll
                                for (int j = 0; j < 4; ++j) { const float x1 = v[bj][0][j], x2 = v[bj][1][j]; v[bj][0][j] = x1 * cc[j] - x2 * sn[j]; v[bj][1][j] = x2 * cc[j] + x1 * sn[j]; } }
                        }
                    }
                    bf16* op = dst + (size_t)row * pitch + hcol + 4 * fq;
#pragma unroll
                    for (int bj = 0; bj < 2; ++bj)
#pragma unroll
                        for (int n = 0; n < 2; ++n) { u32x2 w; w.x = pk2(v[bj][n][0], v[bj][n][1]); w.y = pk2(v[bj][n][2], v[bj][n][3]); *(u32x2*)(op + 32 * bj + 16 * n) = w; }
                }
        } else {
#pragma unroll
            for (int ai = 0; ai < 2; ++ai)
#pragma unroll
                for (int m = 0; m < 4; ++m) {
                    const int row = u.pm * 256 + ai * 128 + wr * 64 + m * 16 + fr;
                    const float rstd = __builtin_amdgcn_rsqf(rsv[ai][m] * (1.0f / D) + NORM_EPS);
#pragma unroll
                    for (int bj = 0; bj < 2; ++bj)
#pragma unroll
                        for (int n = 0; n < 2; ++n) { const f32x4 v = acc[ai][bj][m][n] * rstd + bv[bj][n]; const int c = bj * 128 + wc * 32 + n * 16 + 4 * fq;
                            u32x2 w; w.x = pk2(v[0], v[1]); w.y = pk2(v[2], v[3]);
                            if (pn < PN_BR) *(u32x2*)((bf16*)(ws + WS_VA) + ((size_t)((pn - PN_AV) * 4 + bj * 2 + (wc >> 1)) * M + row) * 64 + (wc & 1) * 32 + n * 16 + 4 * fq) = w;
                            else if (pn < PN_BS) *(u32x2*)((bf16*)(ws + WS_PB) + (size_t)row * 3 * GW + (pn - PN_BR) * 256 + c) = w;
                            else if (pn == PN_BS) { if (c < 160) *(f32x4*)((float*)(ws + WS_PS) + (size_t)row * 160 + c) = v; }
                            else { const int cu = (pn - PN_DU) * 256 + c, gq = cu >> 4, p0 = cu & 15;
                                *(u32x2*)((bf16*)(ws + WS_UG) + ((size_t)gq * NCHP + row / S5L) * S5K + (row % S5L) * 16 + p0) = w; } }
                }
        }
    }
};
struct EpiS5A {
    float* XE;
    DI void operator()(const f32x4 (&acc)[2][2][4][2], const Unit& u, int wr, int wc, int fr_, int fq_) const {
        int tz_ = threadIdx.x; OPAQUE(tz_); const int fr = tz_ & 15, fq = (tz_ & 63) >> 4; (void)fr_; (void)fq_;
#pragma unroll
        for (int ai = 0; ai < 2; ++ai)
#pragma unroll
            for (int m = 0; m < 4; ++m) { const int ch = u.pm * 256 + ai * 128 + wr * 64 + m * 16 + fr; if (ch < NCH) { float* p = XE + ((size_t)u.z * NCHP + ch) * 256 + wc * 32 + 4 * fq;
#pragma unroll
                for (int bj = 0; bj < 2; ++bj)
#pragma unroll
                    for (int n = 0; n < 2; ++n) *(f32x4*)(p + bj * 128 + n * 16) = acc[ai][bj][m][n]; } }
    }
};
struct EpiS5C {
    const bf16* UG; const float* dsk  ; bf16* YG;
    DI void operator()(const f32x4 (&acc)[2][2][4][2], const Unit& u, int wr, int wc, int fr_, int fq_) const {
        int tz_ = threadIdx.x; OPAQUE(tz_); const int fr = tz_ & 15, fq = (tz_ & 63) >> 4; (void)fr_; (void)fq_;
        const int g = u.z;
#pragma unroll
        for (int ai = 0; ai < 2; ++ai)
#pragma unroll
            for (int m = 0; m < 4; ++m) { const int ch = u.pm * 256 + ai * 128 + wr * 64 + m * 16 + fr; if (ch < NCH) {
#pragma unroll
                for (int bj = 0; bj < 2; ++bj)
#pragma unroll
                    for (int n = 0; n < 2; ++n) { const int col = u.pn * 256 + bj * 128 + wc * 32 + n * 16 + 4 * fq, i = col >> 4, p0 = col & 15;
                        const u32x2 uw = *(const u32x2*)(UG + ((size_t)g * NCHP + ch) * S5K + col); const f32x4 dv = *(const f32x4*)(dsk + 16 * g + p0);
                        const f32x4 a = acc[ai][bj][m][n]; const float y0 = a[0] + dv[0] * bflo(uw.x), y1 = a[1] + dv[1] * bfhi(uw.x), y2 = a[2] + dv[2] * bflo(uw.y), y3 = a[3] + dv[3] * bfhi(uw.y);
                        u32x2 w; w.x = pk2(geluf(y0), geluf(y1)); w.y = pk2(geluf(y2), geluf(y3));
                        *(u32x2*)(YG + (size_t)(ch * S5L + i) * GW + 16 * g + p0) = w; } } }
    }
};
struct EpiGLU {
    const bf16* YG; const float* gb; bf16* OB;
    DI void operator()(const f32x4 (&acc)[2][2][4][2], const Unit& u, int wr, int wc, int fr_, int fq_) const {
        int tz_ = threadIdx.x; OPAQUE(tz_); const int fr = tz_ & 15, fq = (tz_ & 63) >> 4; (void)fr_; (void)fq_;
#pragma unroll
        for (int ai = 0; ai < 2; ++ai)
#pragma unroll
            for (int m = 0; m < 4; ++m) { const int row = u.pm * 256 + ai * 128 + wr * 64 + m * 16 + fr;
#pragma unroll
                for (int bj = 0; bj < 2; ++bj)
#pragma unroll
                    for (int n = 0; n < 2; ++n) { const int col = u.pn * 256 + bj * 128 + wc * 32 + n * 16 + 4 * fq; const f32x4 b = *(const f32x4*)(gb + col); const f32x4 a = acc[ai][bj][m][n] + b;
                        const u32x2 yw = *(const u32x2*)(YG + (size_t)row * GW + col);
                        u32x2 w; w.x = pk2(bflo(yw.x) * sigmf(a[0]), bfhi(yw.x) * sigmf(a[1])); w.y = pk2(bflo(yw.y) * sigmf(a[2]), bfhi(yw.y) * sigmf(a[3]));
                        *(u32x2*)(OB + (size_t)row * D + 3 * GW + col) = w; } }
    }
};

DI void ph_ada(const Ctx& C) {
    LAS float* sc = (LAS float*)C.lds;
    LAS float* red = sc + 3 * D;
    for (int i = C.tid; i < 3 * D; i += NTHR) { const int s = i / D, k = i % D; const float c = s < NB ? C.in[I_C][s * D + k] : C.in[I_CCTX][k]; sc[i] = siluf(c); }
    __syncthreads();
    constexpr int ACW = 64, ALPR = ACW / 4, ARPW = 64 / ALPR;
    const int nun = NL * (9 * D / ACW);
    for (int un = C.bid; un < nun; un += C.G) {
        const int l = un / (9 * D / ACW), col0 = (un % (9 * D / ACW)) * ACW, c4 = C.lane % ALPR, sub = C.lane / ALPR;
        const float* W = C.in[I_WADA] + (size_t)l * D * 9 * D + col0 + 4 * c4;
        f32x4 a0 = {0.f, 0.f, 0.f, 0.f}, a1 = a0, a2 = a0;
        const int k0 = C.wave * (D / 8);
#pragma unroll 1
        for (int kb = k0; kb < k0 + D / 8; kb += 16 * ARPW) {
            f32x4 wv[16];
#pragma unroll
            for (int u = 0; u < 16; ++u) wv[u] = *(const f32x4*)(W + (size_t)(kb + u * ARPW + sub) * 9 * D);
#pragma unroll
            for (int u = 0; u < 16; ++u) { const int kr = kb + u * ARPW + sub; a0 += wv[u] * sc[kr]; a1 += wv[u] * sc[D + kr]; a2 += wv[u] * sc[2 * D + kr]; } }
        LAS float* r = red + (C.wave * ARPW + sub) * (3 * ACW) + 4 * c4;
        *(LAS f32x4*)(r) = a0; *(LAS f32x4*)(r + ACW) = a1; *(LAS f32x4*)(r + 2 * ACW) = a2;
        __syncthreads();
        for (int i = C.tid; i < 3 * ACW; i += NTHR) { float s = 0.f;
#pragma unroll
            for (int w = 0; w < 8 * ARPW; ++w) s += red[w * (3 * ACW) + i];
            const int st = i / ACW, c = col0 + (i % ACW);
            ((float*)(C.ws + WS_MODV))[((size_t)l * 3 + st) * 9 * D + c] = s + C.in[I_BADA][(size_t)l * 9 * D + c]; }
        __syncthreads();
    }
}
DI const float* modv_ptr(const Ctx& C, int l, int s, int chunk) { return (const float*)(C.ws + WS_MODV) + ((size_t)l * 3 + s) * 9 * D + (size_t)chunk * D; }

DI int win_dest(int n) {
    if (n >= D_IN) return -1;
    if (n < SRC_AV) { const int piece = n / GW, loc = n % GW, head = loc / 64, d = loc % 64; return ((piece == 0 ? PN_AQ : PN_AK) + head / 4) * 256 + 128 * (d / 32) + 32 * (head % 4) + (d % 32); }
    if (n < SRC_BS) return PN_AV * 256 + (n - SRC_AV);
    if (n < SRC_CQ) return PN_BS * 256 + (n - SRC_BS);
    if (n < SRC_CK) { const int loc = n - SRC_CQ, head = loc / 64, d = loc % 64; return (PN_CQ + head / 4) * 256 + 128 * (d / 32) + 32 * (head % 4) + (d % 32); }
    if (n < SRC_DU) { const int loc = n - SRC_CK, hh = loc / 64, d = loc % 64; return PN_CKV * 256 + 128 * (d / 32) + 32 * hh + (d % 32); }
    return PN_DU * 256 + (n - SRC_DU);
}
DI int gu_dest(int n) { const int e = n & 31; return (n / 128) * 256 + (n % 128 - e) + 16 * ((e >> 2) & 1) + 4 * (e >> 3) + (e & 3); }
DI void conv_item(const Ctx& C, const float* W, int K, int N, bf16* Wt, int mode, int k0, int n0, float* bias, int bias_pitch, const float* shift  ) {
    LAS float* scr = (LAS float*)(C.lds + C.wave * 16640);
    const int n = n0 + C.lane; const bool ok = n < N; float b0 = 0.f, b1 = 0.f, b2 = 0.f;
#pragma unroll 1
    for (int kh = 0; kh < 4; ++kh) {
        float wv[16];
#pragma unroll
        for (int kk = 0; kk < 16; ++kk) wv[kk] = ok ? W[(size_t)(k0 + 16 * kh + kk) * N + n] : 0.f;
#pragma unroll
        for (int kk = 0; kk < 16; ++kk) { const float v = wv[kk]; scr[(16 * kh + kk) * 65 + C.lane] = v;
            if (bias) { b0 += shift[k0 + 16 * kh + kk] * v; b1 += shift[9 * D + k0 + 16 * kh + kk] * v; b2 += shift[18 * D + k0 + 16 * kh + kk] * v; } } }
    WSYNC();
    const int dme = !ok ? -1 : mode == 0 ? n : mode == 1 ? gu_dest(n) : mode == 2 ? gu_dest(n) + 128 : win_dest(n);
    if (bias && dme >= 0) { atomicAdd(bias + dme, b0); atomicAdd(bias + bias_pitch + dme, b1); atomicAdd(bias + 2 * bias_pitch + dme, b2); }
    const int c = C.lane & 7;
#pragma unroll
    for (int i = 0; i < 8; ++i) { const int nl = (C.lane >> 3) + 8 * i, nn = n0 + nl;
        const int dr = nn >= N ? -1 : mode == 0 ? nn : mode == 1 ? gu_dest(nn) : mode == 2 ? gu_dest(nn) + 128 : win_dest(nn);
        const LAS float* s = scr + (8 * c) * 65 + nl;
        u32x4 o; o.x = pk2(s[0], s[65]); o.y = pk2(s[2 * 65], s[3 * 65]); o.z = pk2(s[4 * 65], s[5 * 65]); o.w = pk2(s[6 * 65], s[7 * 65]);
        if (dr >= 0) *(u32x4*)(Wt + (size_t)dr * K + k0 + 8 * c) = o; }
    WSYNC();
}
struct Cplx { float re, im; };
DI Cplx cmul(Cplx a, Cplx b) { return Cplx{a.re * b.re - a.im * b.im, a.re * b.im + a.im * b.re}; }
DI Cplx s5_lam_pow(const Ctx& C, int l, int dir, int g, int n, float tau) {
    const size_t i = (((size_t)l * 2 + dir) * S5G + g) * 64 + n; const float dt = __expf(C.in[I_S5LDT][((size_t)l * 2 + dir) * S5G + g]);
    const float mag = __expf(tau * dt * C.in[I_S5ARE][i]), ang = tau * dt * C.in[I_S5AIM][i]; float sn, cs; sincosf(ang, &sn, &cs); return Cplx{mag * cs, mag * sn};
}
DI Cplx s5_coef(const Ctx& C, int l, int dir, int g, int n) {
    const size_t i = (((size_t)l * 2 + dir) * S5G + g) * 64 + n; const float are = C.in[I_S5ARE][i], aim = C.in[I_S5AIM][i];
    const Cplx ab = s5_lam_pow(C, l, dir, g, n, 1.0f); const float den = are * are + aim * aim, nr = ab.re - 1.0f;
    return Cplx{(nr * are + ab.im * aim) / den, (ab.im * are - nr * aim) / den};
}
DI Cplx s5_beta(const Ctx& C, int l, int dir, int g, int n, int q) {
    const size_t i = (((size_t)l * S5G + g) * 64 + n) * 16 + q; return cmul(s5_coef(C, l, dir, g, n), Cplx{C.in[I_S5BRE][i], C.in[I_S5BIM][i]});
}
DI Cplx s5_gamma(const Ctx& C, int l, int g, int p, int n) { const size_t i = (((size_t)l * S5G + g) * 16 + p) * 64 + n; return Cplx{C.in[I_S5CRE][i], C.in[I_S5CIM][i]}; }

#ifndef CONV_G1_PCT
#define CONV_G1_PCT 55
#endif
constexpr int CI_GU = (D / 64) * (FF / 64), CI_DN = (FF / 64) * (D / 64), CI_IN = (D / 64) * ((D_IN + 63) / 64), CI_OUT = (D / 64) * (D / 64), CI_GLU = (GW / 64) * (GW / 64);
constexpr int CI_LAYER = 4 * CI_GU + 2 * CI_DN + CI_IN + CI_OUT + CI_GLU, CI_X1 = (int)((long)CI_LAYER * CONV_G1_PCT / 100) & ~7;
DI void conv_weights(const Ctx& C, int l, int wslot, int nslots, int it_lo, int it_hi) {
    for (int it = it_lo + wslot; it < it_hi; it += nslots) {
        int r = it;
        unsigned char* wbase = C.ws + WS_W + (size_t)l * SZ_WL;
        if (r < 2 * CI_GU) { const int up = r >= CI_GU; r -= up * CI_GU; const int kb = r / (FF / 64), nb = r % (FF / 64);
            conv_item(C, C.in[up ? I_F1WU : I_F1WG] + (size_t)l * D * FF, D, FF, (bf16*)(wbase + OFF_W1GU), 1 + up, kb * 64, nb * 64, bias_ptr(C, l, 0), 2 * FF, modv_ptr(C, l, 0, 0)); continue; } r -= 2 * CI_GU;
        if (r < CI_DN) { const int kb = r / (D / 64), nb = r % (D / 64); conv_item(C, C.in[I_F1WD] + (size_t)l * FF * D, FF, D, (bf16*)(wbase + OFF_W1D), 0, kb * 64, nb * 64, nullptr, 0, nullptr); continue; } r -= CI_DN;
        if (r < CI_IN) { const int nbn = (D_IN + 63) / 64, kb = r / nbn, nb = r % nbn; conv_item(C, C.in[I_WIN] + (size_t)l * D * D_IN, D, D_IN, (bf16*)(wbase + OFF_WIN), 3, kb * 64, nb * 64, bias_ptr(C, l, 1), NINP, modv_ptr(C, l, 0, 3)); continue; } r -= CI_IN;
        if (r < CI_OUT) { const int kb = r / (D / 64), nb = r % (D / 64); conv_item(C, C.in[I_WOUT] + (size_t)l * D * D, D, D, (bf16*)(wbase + OFF_WOUT), 0, kb * 64, nb * 64, nullptr, 0, nullptr); continue; } r -= CI_OUT;
        if (r < 2 * CI_GU) { const int up = r >= CI_GU; r -= up * CI_GU; const int kb = r / (FF / 64), nb = r % (FF / 64);
            conv_item(C, C.in[up ? I_F2WU : I_F2WG] + (size_t)l * D * FF, D, FF, (bf16*)(wbase + OFF_W2GU), 1 + up, kb * 64, nb * 64, bias_ptr(C, l, 2), 2 * FF, modv_ptr(C, l, 0, 6)); continue; } r -= 2 * CI_GU;
        if (r < CI_DN) { const int kb = r / (D / 64), nb = r % (D / 64); conv_item(C, C.in[I_F2WD] + (size_t)l * FF * D, FF, D, (bf16*)(wbase + OFF_W2D), 0, kb * 64, nb * 64, nullptr, 0, nullptr); continue; } r -= CI_DN;
        { const int kb = r / (GW / 64), nb = r % (GW / 64); conv_item(C, C.in[I_S5GLUW] + (size_t)l * GW * GW, GW, GW, (bf16*)(wbase + OFF_WGLU), 0, kb * 64, nb * 64, nullptr, 0, nullptr); }
    }
}
DI void ph_conv(const Ctx& C) {
    const int gt = C.bid * NTHR + C.tid, GT = C.G * NTHR;
    for (int i = gt; i < NL * 9 * D; i += GT) { const int k = i % D, s = (i / D) % 3, sub = (i / (3 * D)) % 3, l = i / (9 * D);
        const float* mv = (const float*)(C.ws + WS_MODV) + ((size_t)l * 3 + s) * 9 * D;
        ((float*)(C.ws + WS_GS))[i] = C.in[I_NORMG][((size_t)l * 3 + sub) * D + k] * (1.0f + mv[(3 * sub + 1) * D + k]);
        ((float*)(C.ws + WS_GATE))[i] = mv[(3 * sub + 2) * D + k] * (sub == 1 ? 1.0f : 0.5f); }
    for (int i = gt; i < 128 * 16; i += GT) { const int pos = i / 16, f = i % 16; const float inv = __expf(-(float)f * (9.210340371976184f / 16.0f)); float sn, cs; sincosf((float)pos * inv, &sn, &cs);
        ((f32x2*)(C.ws + WS_ROPE))[i] = (f32x2){cs, sn}; }
    const int gw = C.bid * NW + C.wave, GWV = C.G * NW;
    conv_weights(C, 0, gw, GWV, 0, CI_LAYER);
    for (int i = gt; i < NL * 14 * NH * 2 * 64 * 8; i += GT) {
        const int j = i & 7, ln = (i >> 3) & 63, tj = (i >> 9) & 1, hd = (i >> 10) % NH, f = (i / (1024 * NH)) % 14, l = i / (1024 * NH * 14);
        const int col = hd * 64 + 32 * tj + (ln & 31); float v;
        if (f < 8) { const int d = (f >> 1) & 1, sx = f & 1, k = 16 * sx + 8 * (ln >> 5) + j; v = C.in[f < 4 ? I_RWWUP : I_RWAUP][(((size_t)l * 2 + d) * 32 + k) * GW + col]; }
        else { const int k = 16 * (f - 8) + 8 * (ln >> 5) + j; v = C.in[I_RWGUP][((size_t)l * 96 + k) * GW + col]; }
        ((bf16*)(C.ws + WS_RWF))[i] = (bf16)f2bf(v); }
    LAS float* wsc = (LAS float*)(C.lds + C.wave * 16640);
    for (int it = gw; it < NL * S5G * 2 * S5L; it += GWV) {
        const int tau = it % S5L, dir = (it / S5L) % 2, g = (it / (2 * S5L)) % S5G, l = it / (2 * S5L * S5G);
        const Cplx z = cmul(s5_lam_pow(C, l, dir, g, C.lane, (float)tau), s5_coef(C, l, dir, g, C.lane));
        { const size_t i0 = (((size_t)l * S5G + g) * 64 + C.lane) * 16; const f32x4* br = (const f32x4*)(C.in[I_S5BRE] + i0); const f32x4* bi = (const f32x4*)(C.in[I_S5BIM] + i0);
          const f32x4 r4[4] = {br[0], br[1], br[2], br[3]}, m4[4] = {bi[0], bi[1], bi[2], bi[3]};
#pragma unroll
          for (int q = 0; q < 16; ++q) { const Cplx w = cmul(z, Cplx{r4[q >> 2][q & 3], m4[q >> 2][q & 3]}); wsc[(C.lane * 16 + q) * 2] = w.re; wsc[(C.lane * 16 + q) * 2 + 1] = w.im; } }
        WSYNC();
        float* kc = (float*)(C.ws + WS_S5T + (size_t)l * SZ_S5L + OFF_S5KC) + (((size_t)g * 2 + dir) * S5L + tau) * 256;
#pragma unroll 1
        for (int e = 0; e < 4; ++e) { const int pq = C.lane + 64 * e, p = pq >> 4, q = pq & 15; float s = 0.f;
            const size_t gi = (((size_t)l * S5G + g) * 16 + p) * 64; const f32x4* gr = (const f32x4*)(C.in[I_S5CRE] + gi); const f32x4* gm = (const f32x4*)(C.in[I_S5CIM] + gi);
#pragma unroll 1
            for (int hf = 0; hf < 2; ++hf) { f32x4 R[8], Mi[8];
#pragma unroll
                for (int t = 0; t < 8; ++t) { R[t] = gr[hf * 8 + t]; Mi[t] = gm[hf * 8 + t]; }
#pragma unroll
                for (int t = 0; t < 8; ++t)
#pragma unroll
                    for (int c = 0; c < 4; ++c) { const int n = hf * 32 + 4 * t + c; s += R[t][c] * wsc[(n * 16 + q) * 2] - Mi[t][c] * wsc[(n * 16 + q) * 2 + 1]; } }
            kc[pq] = s; }
        WSYNC();
    }
    for (int i = gt; i < NL * 2 * GW * 4 * (S5L + 1); i += GT) { const int tau = i % (S5L + 1), r = i / (S5L + 1), n = r % 64, g = (r / 64) % S5G, dir = (r / (64 * S5G)) % 2, l = r / (2 * 64 * S5G);
        const Cplx z = s5_lam_pow(C, l, dir, g, n, (float)tau); ((f32x2*)(C.ws + WS_S5T + (size_t)l * SZ_S5L + OFF_S5LP))[((size_t)(dir * S5G + g) * 64 + n) * (S5L + 1) + tau] = (f32x2){z.re, z.im}; }
    for (int i = gt; i < NL * 2 * GW * 4 * 16; i += GT) { const int q = i % 16, r = i / 16, n = r % 64, g = (r / 64) % S5G, dir = (r / (64 * S5G)) % 2, l = r / (2 * 64 * S5G);
        const Cplx z = s5_beta(C, l, dir, g, n, q); ((f32x2*)(C.ws + WS_S5T + (size_t)l * SZ_S5L + OFF_S5BETA))[((size_t)(dir * S5G + g) * 64 + n) * 16 + q] = (f32x2){z.re, z.im}; }
    for (int i = gt; i < NL * 2 * GW * 4; i += GT) { const int n = i % 64, g = (i / 64) % S5G, dir = (i / (64 * S5G)) % 2, l = i / (2 * 64 * S5G); const Cplx z = s5_lam_pow(C, l, dir, g, n, (float)S5L);
        ((f32x2*)(C.ws + WS_S5T + (size_t)l * SZ_S5L + OFF_S5LAM))[(dir * S5G + g) * 64 + n] = (f32x2){z.re, z.im}; }
}
DI u32x4 pack8f(const float (&o)[8]) { u32x4 w; w.x = pk2(o[0], o[1]); w.y = pk2(o[2], o[3]); w.z = pk2(o[4], o[5]); w.w = pk2(o[6], o[7]); return w; }
DI void et_group(const Ctx& C, int l, int i, bf16* ET) {
    const int k = i & 511, np = (i >> 9) & 255, g = i >> 17;
    const int j = k >> 4, q0 = k & 15, dir = np >> 7, n = np & 63, im = (np >> 6) & 1;
    const f32x2 lp = ((const f32x2*)(C.ws + WS_S5T + (size_t)l * SZ_S5L + OFF_S5LP))[((dir * S5G + g) * 64 + n) * (S5L + 1) + (dir == 0 ? S5L - 1 - j : j)];
    const f32x4* be = (const f32x4*)((const f32x2*)(C.ws + WS_S5T + (size_t)l * SZ_S5L + OFF_S5BETA) + ((dir * S5G + g) * 64 + n) * 16 + q0);
    const f32x4 b[4] = {be[0], be[1], be[2], be[3]}; float o[8];
#pragma unroll
    for (int t = 0; t < 8; ++t) { const float br = b[t >> 1][2 * (t & 1)], bi = b[t >> 1][2 * (t & 1) + 1]; o[t] = im ? lp[0] * bi + lp[1] * br : lp[0] * br - lp[1] * bi; }
    *(u32x4*)(ET + i) = pack8f(o);
}
DI void bt_group(const Ctx& C, int l, int i, bf16* BT) {
    const int k = i % S5K, r = i / S5K, nn = r & 511, g = r >> 9, ti = nn >> 4, p = nn & 15; float o[8];
    if (k < 512) { const int j = k >> 4, q0 = k & 15; const float* kc = (const float*)(C.ws + WS_S5T + (size_t)l * SZ_S5L + OFF_S5KC) + (size_t)g * 2 * S5L * 256 + p * 16 + q0;
        const f32x4* c1 = (const f32x4*)(kc + (j <= ti ? ti - j : 0) * 256); const f32x4* c2 = (const f32x4*)(kc + (S5L + (j >= ti ? j - ti : 0)) * 256);
        const f32x4 a0 = c1[0], a1 = c1[1], d0 = c2[0], d1 = c2[1]; const float m1 = j <= ti ? 1.f : 0.f, m2 = j >= ti ? 1.f : 0.f;
#pragma unroll
        for (int t = 0; t < 4; ++t) { o[t] = m1 * a0[t] + m2 * d0[t]; o[4 + t] = m1 * a1[t] + m2 * d1[t]; } }
    else { const int kk = k - 512, dir = kk >> 7, im = (kk >> 6) & 1, n0 = kk & 63; const int li = dir == 0 ? ti + 1 : S5L - ti;
        const f32x2* LPp = (const f32x2*)(C.ws + WS_S5T + (size_t)l * SZ_S5L + OFF_S5LP) + ((dir * S5G + g) * 64 + n0) * (S5L + 1) + li;
        const size_t gi = (((size_t)l * S5G + g) * 16 + p) * 64 + n0;
        const f32x4* gr = (const f32x4*)(C.in[I_S5CRE] + gi); const f32x4* gm = (const f32x4*)(C.in[I_S5CIM] + gi);
        const f32x4 r0 = gr[0], r1 = gr[1], m0 = gm[0], m1 = gm[1]; f32x2 lp[8];
#pragma unroll
        for (int t = 0; t < 8; ++t) lp[t] = LPp[t * (S5L + 1)];
#pragma unroll
        for (int t = 0; t < 8; ++t) { const float cr = t < 4 ? r0[t & 3] : r1[t & 3], ci = t < 4 ? m0[t & 3] : m1[t & 3]; o[t] = im ? -(cr * lp[t][1] + ci * lp[t][0]) : cr * lp[t][0] - ci * lp[t][1]; } }
    *(u32x4*)(BT + i) = pack8f(o);
}
DI void ph_tab(const Ctx& C) {
    const int gt = C.bid * NTHR + C.tid, GT = C.G * NTHR;
    constexpr int NET = S5G * 256 * 512, NBT = S5G * 512 * S5K;
    for (int l = 0; l < NL; ++l) {
        bf16* ET = (bf16*)(C.ws + WS_S5T + (size_t)l * SZ_S5L + OFF_S5ET); bf16* BT = (bf16*)(C.ws + WS_S5T + (size_t)l * SZ_S5L + OFF_S5BT);
#pragma unroll 1
        for (int i8 = gt; i8 < NET / 8; i8 += GT) et_group(C, l, i8 * 8, ET);
#pragma unroll 1
        for (int i8 = gt; i8 < NBT / 8; i8 += GT) bt_group(C, l, i8 * 8, BT);
    }
    const int gw = C.bid * NW + C.wave, GWV = C.G * NW;
    for (int row = gw; row < M; row += GWV) {
        const float* src = row < M_LAT ? C.in[I_X] + (size_t)row * D : C.in[I_CTX] + (size_t)(row - M_LAT) * D;
        float* dst = xrow_ptr(C, row); const float* gs = gs_ptr(C, 0, 0, stream_of_row(row)); bf16* ap = (bf16*)(C.ws + WS_AP) + (size_t)row * D; float ss = 0.f;
        f32x4 xv[D / 256], gv[D / 256];
#pragma unroll
        for (int i = 0; i < D / 256; ++i) { xv[i] = *(const f32x4*)(src + 4 * C.lane + 256 * i); gv[i] = *(const f32x4*)(gs + 4 * C.lane + 256 * i); }
#pragma unroll
        for (int i = 0; i < D / 256; ++i) { const int c = 4 * C.lane + 256 * i; const f32x4 x = xv[i]; *(f32x4*)(dst + c) = x; ss += (x[0] * x[0] + x[1] * x[1]) + (x[2] * x[2] + x[3] * x[3]);
            const f32x4 a = x * gv[i]; u32x2 w; w.x = pk2(a[0], a[1]); w.y = pk2(a[2], a[3]); *(u32x2*)(ap + c) = w; }
        ss = wave_sum(ss); if (C.lane == 0) rowss_ptr(C, 0, 0)[row] = ss;
    }
}

#ifdef EMU
DI s16x4 tr_read1(const LAS unsigned char* a) { return emu_tr_read(a); }
#else
DI s16x4 tr_read1(const LAS unsigned char* a) { s16x4 r; asm volatile("ds_read_b64_tr_b16 %0, %1\n\ts_waitcnt lgkmcnt(0)" : "=&v"(r) : "v"((unsigned)(size_t)a) : "memory"); return r; }
#endif
DI bf16x8 tr_frag(const LAS unsigned char* a0, int hi_off) {
#ifdef EMU
    const s16x4 lo = emu_tr_read(a0), hi = emu_tr_read(a0 + hi_off);
#else
    s16x4 lo, hi; asm volatile("ds_read_b64_tr_b16 %0, %2\n\tds_read_b64_tr_b16 %1, %3\n\ts_waitcnt lgkmcnt(0)" : "=&v"(lo), "=&v"(hi) : "v"((unsigned)(size_t)a0), "v"((unsigned)(size_t)(a0 + hi_off)) : "memory");
#endif
    return __builtin_shufflevector(lo, hi, 0, 1, 2, 3, 4, 5, 6, 7);
}
DI void tr_frag4(const LAS unsigned char* a0, const LAS unsigned char* a1, const LAS unsigned char* a2, const LAS unsigned char* a3, int hi_off, bf16x8 (&f)[4]) {
#ifdef EMU
    f[0] = tr_frag(a0, hi_off); f[1] = tr_frag(a1, hi_off); f[2] = tr_frag(a2, hi_off); f[3] = tr_frag(a3, hi_off);
#else
    s16x4 l0, h0, l1, h1, l2, h2, l3, h3;
    asm volatile("ds_read_b64_tr_b16 %0, %8\n\tds_read_b64_tr_b16 %1, %9\n\tds_read_b64_tr_b16 %2, %10\n\tds_read_b64_tr_b16 %3, %11\n\tds_read_b64_tr_b16 %4, %12\n\tds_read_b64_tr_b16 %5, %13\n\tds_read_b64_tr_b16 %6, %14\n\tds_read_b64_tr_b16 %7, %15\n\ts_waitcnt lgkmcnt(0)"
        : "=&v"(l0), "=&v"(h0), "=&v"(l1), "=&v"(h1), "=&v"(l2), "=&v"(h2), "=&v"(l3), "=&v"(h3)
        : "v"((unsigned)(size_t)a0), "v"((unsigned)(size_t)(a0 + hi_off)), "v"((unsigned)(size_t)a1), "v"((unsigned)(size_t)(a1 + hi_off)), "v"((unsigned)(size_t)a2), "v"((unsigned)(size_t)(a2 + hi_off)), "v"((unsigned)(size_t)a3), "v"((unsigned)(size_t)(a3 + hi_off)) : "memory");
    f[0] = __builtin_shufflevector(l0, h0, 0, 1, 2, 3, 4, 5, 6, 7); f[1] = __builtin_shufflevector(l1, h1, 0, 1, 2, 3, 4, 5, 6, 7); f[2] = __builtin_shufflevector(l2, h2, 0, 1, 2, 3, 4, 5, 6, 7); f[3] = __builtin_shufflevector(l3, h3, 0, 1, 2, 3, 4, 5, 6, 7);
#endif
}
DI bf16x8 pack8(const f32x16& x, int s) {
    u32x4 p; p.x = pk2(x[8 * s], x[8 * s + 1]); p.y = pk2(x[8 * s + 2], x[8 * s + 3]); p.z = pk2(x[8 * s + 4], x[8 * s + 5]); p.w = pk2(x[8 * s + 6], x[8 * s + 7]);
    return __builtin_bit_cast(bf16x8, p);
}
struct AttnSt { f32x16 o0, o1; float m, l; };
constexpr int APT = 144;
struct KVregs { u32x4 k[4]; u32x4 v[4]; };
struct Kregs { bf16x8 k[4]; };
DI void k_load(Kregs& r, const bf16* Kb, int kp, int lane) {
    const int r32 = lane & 31, h = lane >> 5;
#pragma unroll
    for (int kk = 0; kk < 4; ++kk) r.k[kk] = *(const bf16x8*)(Kb + (size_t)r32 * kp + 16 * kk + 8 * h);
}
DI void kv_load2(KVregs& r, const bf16* Kb, int kp, const bf16* Vb, int vp, int lane) {
#pragma unroll
    for (int i = 0; i < 4; ++i) { const int idx = lane + 64 * i, key = idx >> 3, ch = idx & 7; r.k[i] = *(const u32x4*)(Kb + (size_t)key * kp + ch * 8); }
#pragma unroll
    for (int i = 0; i < 4; ++i) { const int idx = lane + 64 * i, key = idx >> 3, ch = idx & 7; r.v[i] = *(const u32x4*)(Vb + (size_t)key * vp + ch * 8); }
}
#if 0
DI void kv_load(KVregs& r, const Kregs& kpre, const bf16* Vb, int vp, int lane) {
#pragma unroll
    for (int kk = 0; kk < 4; ++kk) r.k[kk] = kpre.k[kk];
#pragma unroll
    for (int i = 0; i < 4; ++i) { const int idx = lane + 64 * i, key = idx >> 3, ch = idx & 7; r.v[i] = *(const u32x4*)(Vb + (size_t)key * vp + ch * 8); }
}
#endif
DI void attn_stage(const KVregs& kv, LAS unsigned char* vl, int lane) {
    LAS unsigned char* vk = vl; LAS unsigned char* vv = vl + 32 * APT;
#pragma unroll
    for (int i = 0; i < 4; ++i) { const int idx = lane + 64 * i, key = idx >> 3, ch = idx & 7; *(LAS u32x4*)(vk + key * APT + ch * 16) = kv.k[i]; *(LAS u32x4*)(vv + key * APT + ch * 16) = kv.v[i]; }
}
template <bool MASKED>
DI void attn_block(AttnSt& st, const bf16x8 (&qf)[4], LAS unsigned char* vl, int lane, const float (&addv)[16], unsigned vmask) {
    const int h = lane >> 5;
    LAS unsigned char* vk = vl; LAS unsigned char* vv = vl + 32 * APT;
    WSYNC();
    bf16x8 kf[4];
#pragma unroll
    for (int kk = 0; kk < 4; ++kk) kf[kk] = *(const LAS bf16x8*)(vk + (lane & 31) * APT + (16 * kk + 8 * h) * 2);
    f32x16 s;
#pragma unroll
    for (int i = 0; i < 16; ++i) s[i] = 0.f;
#pragma unroll
    for (int kk = 0; kk < 4; ++kk) s = __builtin_amdgcn_mfma_f32_32x32x16_bf16(kf[kk], qf[kk], s, 0, 0, 0);
    float bm = -1e30f;
#pragma unroll
    for (int i = 0; i < 16; ++i) { if (MASKED) { s[i] += addv[i]; if ((vmask >> i) & 1u) bm = fmaxf(bm, s[i]); } else bm = fmaxf(bm, s[i]); }
    bm = fmaxf(bm, __shfl_xor(bm, 32));
    const float mn = fmaxf(st.m, bm), alpha = __expf(st.m - mn); st.m = mn;
    float ls = 0.f;
#pragma unroll
    for (int i = 0; i < 16; ++i) { float p = __expf(s[i] - mn); if (MASKED) p = ((vmask >> i) & 1u) ? p : 0.f; s[i] = p; ls += p; }
    st.l = st.l * alpha + ls;
#pragma unroll
    for (int i = 0; i < 16; ++i) { st.o0[i] *= alpha; st.o1[i] *= alpha; }
    const int q = (lane & 15) >> 2, p4 = lane & 3, blk = (lane >> 4) & 1;
    { const LAS unsigned char* ab = vv + (4 * h + q) * APT + (16 * blk) * 2 + 8 * p4; bf16x8 vf[4];
      tr_frag4(ab, ab + 64, ab + 16 * APT, ab + 16 * APT + 64, 8 * APT, vf);
      const bf16x8 pf0 = pack8(s, 0), pf1 = pack8(s, 1);
      st.o0 = __builtin_amdgcn_mfma_f32_32x32x16_bf16(vf[0], pf0, st.o0, 0, 0, 0); st.o1 = __builtin_amdgcn_mfma_f32_32x32x16_bf16(vf[1], pf0, st.o1, 0, 0, 0);
      st.o0 = __builtin_amdgcn_mfma_f32_32x32x16_bf16(vf[2], pf1, st.o0, 0, 0, 0); st.o1 = __builtin_amdgcn_mfma_f32_32x32x16_bf16(vf[3], pf1, st.o1, 0, 0, 0); }
}
DI void attn_finish(AttnSt& st, bf16* orow  , int lane, float extra_l) {
    const int h = lane >> 5; float l = st.l + __shfl_xor(st.l, 32) + extra_l; const float inv = 1.0f / l;
#pragma unroll
    for (int g = 0; g < 4; ++g) {
        u32x2 w0, w1; w0.x = pk2(st.o0[4 * g] * inv, st.o0[4 * g + 1] * inv); w0.y = pk2(st.o0[4 * g + 2] * inv, st.o0[4 * g + 3] * inv);
        w1.x = pk2(st.o1[4 * g] * inv, st.o1[4 * g + 1] * inv); w1.y = pk2(st.o1[4 * g + 2] * inv, st.o1[4 * g + 3] * inv);
        *(u32x2*)(orow + 8 * g + 4 * h) = w0; *(u32x2*)(orow + 32 + 8 * g + 4 * h) = w1; }
}
DI int clampi(int v, int lo, int hi) { return v < lo ? lo : (v > hi ? hi : v); }
#ifndef ATTN_A_PCT
#define ATTN_A_PCT 20
#endif
constexpr int AT_NA = NB * NH * (GRH / 2) * 4, AT_WA = NB * NH * (T / 32), AT_CX = NB * NH * (TC / 32);
DI void ph_attn(const Ctx& C, int l, bool want_ctx, int widx, int nworkers, int t_lo, int t_hi) {
    if (widx < 0) return;
    const int gw = t_lo + widx, GWV = nworkers, lane = C.lane, r32 = lane & 31, h = lane >> 5;
    LAS unsigned char* vl = C.lds + C.wave * 16640;
    const bf16* QA = (const bf16*)(C.ws + WS_QA); const bf16* KA = (const bf16*)(C.ws + WS_KA); const bf16* VA = (const bf16*)(C.ws + WS_VA);
    const bf16* QC = (const bf16*)(C.ws + WS_QC); const bf16* KC = (const bf16*)(C.ws + WS_KC); const bf16* VC = (const bf16*)(C.ws + WS_VC);
    bf16* OB = (bf16*)(C.ws + WS_OB);
    const int ntiles = t_hi;
    const float zero16[16] = {0.f, 0.f, 0.f, 0.f, 0.f, 0.f, 0.f, 0.f, 0.f, 0.f, 0.f, 0.f, 0.f, 0.f, 0.f, 0.f};
    for (int tile = gw; tile < ntiles; tile += GWV) {
        AttnSt st; st.m = -1e30f; st.l = 0.f;
#pragma unroll
        for (int i = 0; i < 16; ++i) { st.o0[i] = 0.f; st.o1[i] = 0.f; }
        bf16x8 qf[4];
        if (tile < AT_NA) {
            const int cb = tile & 3, rp = (tile >> 2) % (GRH / 2), hd = (tile / (4 * (GRH / 2))) % NH, b = tile / (4 * (GRH / 2) * NH);
            const int r0 = 2 * rp, c0 = 16 * cb, qr = r0 + (r32 >> 4), qc = c0 + (r32 & 15), qrow = b * T + qr * GRW + qc;
#pragma unroll
            for (int kk = 0; kk < 4; ++kk) qf[kk] = *(const bf16x8*)(QA + (size_t)qrow * GW + hd * 64 + 16 * kk + 8 * h);
            const int rsq = clampi(qr - 4, 0, GRH - 8), csq = clampi(qc - 8, 0, GRW - 16);
            const int rsA = clampi(r0 - 4, 0, GRH - 8), rsB = clampi(r0 + 1 - 4, 0, GRH - 8), kc0 = clampi(c0 - 8, 0, GRW - 32);
            const float* rpb = C.in[I_NARPB] + ((size_t)l * NH + hd) * 465;
            const int nbn = rsB + 8 - rsA, nbt = nbn + TC / 32; KVregs nxt;
#define NA_ROW(i) ((i) < nbn ? (size_t)b * T + (rsA + (i)) * GRW + kc0 : (size_t)M_LAT + b * TC + 32 * ((i) - nbn))
            const bf16* KAh = KA + (size_t)hd * M * 64; const bf16* VAh = VA + (size_t)hd * M * 64;
            { const size_t kr0 = NA_ROW(0); kv_load2(nxt, KAh + kr0 * 64, 64, VAh + kr0 * 64, 64, lane); }
            LAS float* rpbL = (LAS float*)(vl + 64 * APT);
            { float tb[8];
#pragma unroll
              for (int i = 0; i < 8; ++i) { const int j = lane + 64 * i; tb[i] = rpb[j < 465 ? j : 464]; }
#pragma unroll
              for (int i = 0; i < 8; ++i) { const int j = lane + 64 * i; if (j < 465) rpbL[j] = tb[i]; }
              WSYNC(); }
            const int cb0 = kc0 + 4 * h - qc + 15; unsigned vmcol = 0u;
#pragma unroll
            for (int i = 0; i < 16; ++i) { const int kc = kc0 + (i & 3) + 8 * (i >> 2) + 4 * h; vmcol |= (kc >= csq && kc <= csq + 15) ? (1u << i) : 0u; }
            for (int ib = 0; ib < nbt; ++ib) {
                attn_stage(nxt, vl, lane);
                { const int in_ = ib + 1 < nbt ? ib + 1 : ib; const size_t kr1 = NA_ROW(in_); kv_load2(nxt, KAh + kr1 * 64, 64, VAh + kr1 * 64, 64, lane); }
                if (ib < nbn) { const int kr = rsA + ib; float addv[16]; const bool rok = kr >= rsq && kr <= rsq + 7;
                    const LAS float* rb = rpbL + (kr - qr + 7) * 31 + cb0;
#pragma unroll
                    for (int i = 0; i < 16; ++i) addv[i] = rb[(i & 3) + 8 * (i >> 2)];
                    attn_block<true>(st, qf, vl, lane, addv, rok ? vmcol : 0u); }
                else attn_block<false>(st, qf, vl, lane, zero16, 0xffffu); }
#undef NA_ROW
            attn_finish(st, OB + (size_t)qrow * D + hd * 64, lane, 0.f);
        } else if (tile < AT_NA + AT_WA) {
            const int t2 = tile - AT_NA, hl_ = t2 % WAG, qb = (t2 / WAG) % (T / 32), kvh = (t2 / (WAG * (T / 32))) % (NH / WAG), b = t2 / ((T / 32) * NH), hd = kvh * WAG + hl_;
            const int qt = 32 * qb + r32, qrow = b * T + qt;
#pragma unroll
            for (int kk = 0; kk < 4; ++kk) qf[kk] = *(const bf16x8*)(QC + (size_t)qrow * GW + hd * 64 + 16 * kk + 8 * h);
            const int i_lo = 4 - qb > 0 ? 4 - qb : 0, i_hi = (T / 32 - qb + 4) < 9 ? (T / 32 - qb + 4) : 9, nbw = i_hi - i_lo, nbt = nbw + TC / 32; KVregs nxt;
#define WA_ROW(i) ((i) < nbw ? (size_t)b * T + 32 * qb - 128 + 32 * (i_lo + (i)) : (size_t)M_LAT + b * TC + 32 * ((i) - nbw))
            const bf16* KCh = KC + (size_t)kvh * M * 64; const bf16* VCh = VC + (size_t)kvh * M * 64;
            { const size_t kr0 = WA_ROW(0); kv_load2(nxt, KCh + kr0 * 64, 64, VCh + kr0 * 64, 64, lane); }
            for (int ib = 0; ib < nbt; ++ib) {
                attn_stage(nxt, vl, lane);
                { const int in_ = ib + 1 < nbt ? ib + 1 : ib; const size_t kr1 = WA_ROW(in_); kv_load2(nxt, KCh + kr1 * 64, 64, VCh + kr1 * 64, 64, lane); }
                if (ib < nbw && (i_lo + ib == 0 || i_lo + ib == 8)) { const int t0 = 32 * qb - 128 + 32 * (i_lo + ib); float addv[16]; unsigned vm = 0u;
#pragma unroll
                    for (int i = 0; i < 16; ++i) { const int kt = t0 + (i & 3) + 8 * (i >> 2) + 4 * h, rel = kt - qt; addv[i] = 0.f; vm |= (rel >= -128 && rel <= 128) ? (1u << i) : 0u; }
                    attn_block<true>(st, qf, vl, lane, addv, vm); }
                else attn_block<false>(st, qf, vl, lane, zero16, 0xffffu); }
#undef WA_ROW
            const float sk = C.in[I_WASINK][(size_t)l * NH + hd];
            const float mfin = fmaxf(st.m, sk), a2 = __expf(st.m - mfin);
#pragma unroll
            for (int i = 0; i < 16; ++i) { st.o0[i] *= a2; st.o1[i] *= a2; }
            st.l *= a2; st.m = mfin;
            attn_finish(st, OB + (size_t)qrow * D + 2 * GW + hd * 64, lane, __expf(sk - mfin));
        } else {
            const int t2 = tile - AT_NA - AT_WA, isc = t2 >= AT_CX, t3 = t2 - isc * AT_CX, qb = t3 % (TC / 32), hd = (t3 / (TC / 32)) % NH, b = t3 / ((TC / 32) * NH), kvh = hd / WAG;
            const int qrow = M_LAT + b * TC + 32 * qb + r32;
            const bf16* Qs = isc ? QC : QA; const bf16* Ks = isc ? KC + (size_t)kvh * M * 64 : KA + (size_t)hd * M * 64; const bf16* Vs = isc ? VC + (size_t)kvh * M * 64 : VA + (size_t)hd * M * 64; const int kp = 64;
#pragma unroll
            for (int kk = 0; kk < 4; ++kk) qf[kk] = *(const bf16x8*)(Qs + (size_t)qrow * GW + hd * 64 + 16 * kk + 8 * h);
            { KVregs nxt; const size_t kr0 = (size_t)M_LAT + b * TC; kv_load2(nxt, Ks + kr0 * kp, kp, Vs + kr0 * kp, kp, lane);
              for (int cbk = 0; cbk < TC / 32; ++cbk) { attn_stage(nxt, vl, lane); const int cn = cbk + 1 < TC / 32 ? cbk + 1 : cbk; kv_load2(nxt, Ks + (kr0 + 32 * cn) * kp, kp, Vs + (kr0 + 32 * cn) * kp, kp, lane);
                  attn_block<false>(st, qf, vl, lane, zero16, 0xffffu); } }
            float extra = 0.f;
            if (isc) { const float sk = C.in[I_WASINK][(size_t)l * NH + hd]; const float mfin = fmaxf(st.m, sk), a2 = __expf(st.m - mfin);
#pragma unroll
                for (int i = 0; i < 16; ++i) { st.o0[i] *= a2; st.o1[i] *= a2; }
                st.l *= a2; st.m = mfin; extra = __expf(sk - mfin); }
            attn_finish(st, OB + (size_t)qrow * D + (isc ? 2 * GW : 0) + hd * 64, lane, extra);
        }
    }
}

DI void ph_ctxfix(const Ctx& C, const float* gsn  , float* rowss_next) {
    const int gw = C.bid * NW + C.wave, GWV = C.G * NW;
    for (int r = gw; r < M_CTX; r += GWV) { const int row = M_LAT + r; const float* xp = xrow_ptr(C, row); const float* gs = gsn + (size_t)NB * D; bf16* ap = (bf16*)(C.ws + WS_AP) + (size_t)row * D; float ss = 0.f;
        f32x4 xv[D / 256], gv[D / 256];
#pragma unroll
        for (int i = 0; i < D / 256; ++i) { xv[i] = *(const f32x4*)(xp + 4 * C.lane + 256 * i); gv[i] = *(const f32x4*)(gs + 4 * C.lane + 256 * i); }
#pragma unroll
        for (int i = 0; i < D / 256; ++i) { const int c = 4 * C.lane + 256 * i; const f32x4 x = xv[i]; ss += (x[0] * x[0] + x[1] * x[1]) + (x[2] * x[2] + x[3] * x[3]);
            const f32x4 a = x * gv[i]; u32x2 w; w.x = pk2(a[0], a[1]); w.y = pk2(a[2], a[3]); *(u32x2*)(ap + c) = w; }
        ss = wave_sum(ss); if (C.lane == 0) rowss_next[row] = ss; }
}
constexpr int PT = 144;
constexpr int RW_HALF = 73472, IM_BT = 0, IM_KT = 9216, IM_RT = 18432, IM_ARB = 27648, IM_AT = 36864, IM_AAK = 46080, IM_F = 55296, IM_GC = 72704, FP = 68;
DI void chunk_rows(int b, int dir, int c, int& row0, int& step) {
    if (c < TC / 64) { const int p0 = 64 * c; row0 = M_LAT + b * TC + (dir ? TC - 1 - p0 : p0); } else { const int p0 = 64 * (c - TC / 64); row0 = b * T + (dir ? T - 1 - p0 : p0); }
    step = dir ? -1 : 1;
}
DI bf16x8 frag_rows(const LAS unsigned char* img, int tile, int s, int lane) { return *(const LAS bf16x8*)(img + (32 * tile + (lane & 31)) * PT + (16 * s + 8 * (lane >> 5)) * 2); }
DI bf16x8 frag_cols(const LAS unsigned char* img, int tile, int s, int lane) {
    const int h = lane >> 5, q = (lane & 15) >> 2, p4 = lane & 3, blk = (lane >> 4) & 1;
    const LAS unsigned char* a0 = img + (16 * s + 8 * h + q) * PT + (32 * tile + 16 * blk) * 2 + 8 * p4;
    return tr_frag(a0, 4 * PT);
}
DI void frag_cols4(const LAS unsigned char* img, int tile, int lane, bf16x8 (&f)[4]) {
    const int h = lane >> 5, q = (lane & 15) >> 2, p4 = lane & 3, blk = (lane >> 4) & 1;
    const LAS unsigned char* a0 = img + (8 * h + q) * PT + (32 * tile + 16 * blk) * 2 + 8 * p4;
    tr_frag4(a0, a0 + 16 * PT, a0 + 32 * PT, a0 + 48 * PT, 4 * PT, f);
}
DI void store_T(const f32x16& acc, LAS unsigned char* img, int ti, int tj, int lane) {
    const int c = lane & 31, h = lane >> 5;
#pragma unroll
    for (int g = 0; g < 4; ++g) { u32x2 w; w.x = pk2(acc[4 * g], acc[4 * g + 1]); w.y = pk2(acc[4 * g + 2], acc[4 * g + 3]); *(LAS u32x2*)(img + (32 * tj + c) * PT + (32 * ti + 8 * g + 4 * h) * 2) = w; }
}
DI f32x16 zero16v() { f32x16 z;
#pragma unroll
    for (int i = 0; i < 16; ++i) z[i] = 0.f; return z; }
#define MMA32(a, b, c) __builtin_amdgcn_mfma_f32_32x32x16_bf16((a), (b), (c), 0, 0, 0)
constexpr int PDW = 80, PDG = 208, IM_TW = 0, IM_TA = 17408, IM_DW = 36864, IM_DA = 41984, IM_DG = 47104;
DI void ph_rw1(const Ctx& C, int l) {
    const int wg = C.wave & 3, grp = C.wave >> 2, ti = wg >> 1, tj = wg & 1;
    bf16* QH = (bf16*)(C.ws + WS_QH); float* YL = (float*)(C.ws + WS_YL); bf16* MF = (bf16*)(C.ws + WS_MF); float* GF = (float*)(C.ws + WS_GF); bf16* RVKG = (bf16*)(C.ws + WS_RVKG);
    const bf16* PB = (const bf16*)(C.ws + WS_PB); const float* PS = (const float*)(C.ws + WS_PS);
    const bf16x8* RWF = (const bf16x8*)(C.ws + WS_RWF + (size_t)l * SZ_RWF);
    constexpr int nblk = (TC + T) / 64;
    for (int it0 = 2 * C.bid; it0 < RBLK; it0 += 2 * C.G) {
        int lane_ = threadIdx.x & 63; OPAQUE(lane_); const int lane = lane_, c32 = lane & 31, h = lane >> 5;
        LAS unsigned char* L = OPAQUE_LDS(C.lds + grp * RW_HALF);
        LAS float* F = (LAS float*)(L + IM_F); LAS float* SEG = (LAS float*)(L + IM_F); LAS float* GC = (LAS float*)(L + IM_GC);
        LAS float* TW = (LAS float*)(L + IM_TW); LAS float* TA = (LAS float*)(L + IM_TA);
        unsigned char* PK = C.ws + WS_RWS + ((size_t)C.bid * 2 + grp) * 65536;
        const int item = it0 + grp; const bool live = item < RBLK; const int itc = live ? item : RBLK - 1;
        const int tb = itc % nblk, hd = (itc / nblk) % NH, b = itc / (nblk * NH), cg = hd * 64 + lane;
        const int rowb = tb < TC / 64 ? M_LAT + b * TC + 64 * tb : b * T + 64 * (tb - TC / 64);
        const int seq_lo = tb < TC / 64 ? M_LAT + b * TC : b * T, seq_hi = seq_lo + (tb < TC / 64 ? TC : T);
        bf16* RV = RVKG + (size_t)itc * 4 * 4096;
        __syncthreads();
        float r_[16], kf_[16], kk_[16], ks_[16];
        { const float* cw = C.in[I_RWCONV] + (size_t)l * 9 * GW; float cwv[3][3];
#pragma unroll
          for (int j = 0; j < 3; ++j)
#pragma unroll
              for (int x = 0; x < 3; ++x) cwv[j][x] = cw[(size_t)j * 3 * GW + x * GW + cg];
          const float kkw = C.in[I_RWKK][(size_t)l * GW + cg];
          const int r0 = rowb + 16 * wg;
          bf16 pbv[18][3]; float psv[16][3];
#pragma unroll
          for (int rr = 0; rr < 18; ++rr) { int row = r0 - 1 + rr; row = row < seq_lo ? seq_lo : (row >= seq_hi ? seq_hi - 1 : row);
#pragma unroll
              for (int x = 0; x < 3; ++x) pbv[rr][x] = PB[(size_t)row * 3 * GW + x * GW + cg]; }
#pragma unroll
          for (int t = 0; t < 16; ++t)
#pragma unroll
              for (int kq = 0; kq < 3; ++kq) { const int k = lane + 64 * kq; psv[t][kq] = PS[(size_t)(r0 + t) * 160 + (k < 160 ? k : 159)]; }
          const float m_lo = r0 - 1 >= seq_lo ? 1.f : 0.f, m_hi = r0 + 16 < seq_hi ? 1.f : 0.f;
          float v_[16];
#pragma unroll
          for (int t = 0; t < 16; ++t) {
              float xa[3], xb[3], xc[3];
#pragma unroll
              for (int x = 0; x < 3; ++x) { xa[x] = bf2f(pbv[t][x]) * (t == 0 ? m_lo : 1.f); xb[x] = bf2f(pbv[t + 1][x]); xc[x] = bf2f(pbv[t + 2][x]) * (t == 15 ? m_hi : 1.f); }
              r_[t] = xa[0] * cwv[0][0] + xb[0] * cwv[1][0] + xc[0] * cwv[2][0]; kf_[t] = xa[1] * cwv[0][1] + xb[1] * cwv[1][1] + xc[1] * cwv[2][1]; v_[t] = xa[2] * cwv[0][2] + xb[2] * cwv[1][2] + xc[2] * cwv[2][2];
              const float kkv = kf_[t] * kkw, ssq = wave_sum(kkv * kkv); kk_[t] = kkv * __builtin_amdgcn_rsqf(fmaxf(ssq, 1e-24f)); ks_[t] = 0.f;
              const int tk = 16 * wg + t;
              if (lane < 32) *(LAS bf16*)(L + IM_DW + tk * PDW + lane * 2) = (bf16)f2bf(fast_tanh(psv[t][0])); else *(LAS bf16*)(L + IM_DA + tk * PDW + (lane - 32) * 2) = (bf16)f2bf(psv[t][0]);
              *(LAS bf16*)(L + IM_DG + tk * PDG + lane * 2) = (bf16)f2bf(sigmf(psv[t][1]));
              if (lane < 32) *(LAS bf16*)(L + IM_DG + tk * PDG + (lane + 64) * 2) = (bf16)f2bf(sigmf(psv[t][2]));
          }
#pragma unroll
          for (int t = 0; t < 16; ++t) { RV[(16 * wg + t) * 64 + lane] = (bf16)f2bf(r_[t]); RV[4096 + (16 * wg + t) * 64 + lane] = (bf16)f2bf(v_[t]); }
        }
        __syncthreads();
        bf16x8 lrf[2][4]; float w0v[2], a0v[2];
#pragma unroll
        for (int d = 0; d < 2; ++d) {
#pragma unroll
            for (int sx = 0; sx < 2; ++sx) { lrf[d][sx] = RWF[(((0 + 2 * d + sx) * NH + hd) * 2 + tj) * 64 + lane]; lrf[d][2 + sx] = RWF[(((4 + 2 * d + sx) * NH + hd) * 2 + tj) * 64 + lane]; }
            w0v[d] = C.in[I_RWW0][((size_t)l * 2 + d) * GW + hd * 64 + 32 * tj + c32]; a0v[d] = C.in[I_RWA0][((size_t)l * 2 + d) * GW + hd * 64 + 32 * tj + c32]; }
        { f32x16 gacc = zero16v();
#pragma unroll
          for (int sx = 0; sx < 6; ++sx) gacc = MMA32(*(const LAS bf16x8*)(L + IM_DG + (32 * ti + c32) * PDG + (16 * sx + 8 * h) * 2), RWF[(((8 + sx) * NH + hd) * 2 + tj) * 64 + lane], gacc);
#pragma unroll
          for (int rg = 0; rg < 16; ++rg) { const int tk = 32 * ti + (rg & 3) + 8 * (rg >> 2) + 4 * h; RV[3 * 4096 + tk * 64 + 32 * tj + c32] = (bf16)f2bf(gacc[rg]); }
        }
        const float kaw = C.in[I_RWKA][(size_t)l * GW + cg];
#pragma unroll
        for (int pss = 0; pss < 2; ++pss) {
            const int dir = 1 - pss;
            __syncthreads();
            { f32x16 pw = zero16v(), pa = zero16v();
#pragma unroll
              for (int sx = 0; sx < 2; ++sx) { pw = MMA32(*(const LAS bf16x8*)(L + IM_DW + (32 * ti + c32) * PDW + (16 * sx + 8 * h) * 2), lrf[dir][sx], pw);
                                              pa = MMA32(*(const LAS bf16x8*)(L + IM_DA + (32 * ti + c32) * PDW + (16 * sx + 8 * h) * 2), lrf[dir][2 + sx], pa); }
              const float w0 = w0v[dir], a0 = a0v[dir];
#pragma unroll
              for (int rg = 0; rg < 16; ++rg) { const int tk = 32 * ti + (rg & 3) + 8 * (rg >> 2) + 4 * h; const float z = -(w0 + pw[rg]), sp = z > 20.f ? z : __logf(1.f + __expf(z));
                  TW[tk * FP + 32 * tj + c32] = -__expf(-sp - 0.5f); TA[tk * FP + 32 * tj + c32] = sigmf(a0 + pa[rg]); } }
            __syncthreads();
            const int cs = dir ? 3 - wg : wg;
            float lw[16], av[16], run = 0.f;
#pragma unroll
            for (int ii = 0; ii < 16; ++ii) { const int tl = dir ? 15 - ii : ii, tk = 16 * wg + tl; av[ii] = TA[tk * FP + lane]; run += TW[tk * FP + lane]; lw[ii] = run; }
            __syncthreads();
            SEG[cs * 64 + lane] = run;
            __syncthreads();
            float off = 0.f;
#pragma unroll
            for (int w2 = 0; w2 < 3; ++w2) off += (w2 < cs) ? SEG[w2 * 64 + lane] : 0.f;
            const float tot = SEG[lane] + SEG[64 + lane] + SEG[128 + lane] + SEG[192 + lane];
            if (wg == 0) { if (dir) ((float*)(PK + 32768))[lane] = __expf(tot); else GC[lane] = __expf(tot); }
            float ePrev = __expf(off);
#pragma unroll
            for (int ii = 0; ii < 16; ++ii) { const int tl = dir ? 15 - ii : ii, i = 16 * cs + ii;
                const float Li = lw[ii] + off, eL = __expf(Li), ieL = __builtin_amdgcn_rcpf(eL), eLm = ePrev; ePrev = eL;
                const float a = av[ii], kd = kf_[tl] * (1.f + (a - 1.f) * kaw); ks_[tl] += kd;
                const bf16 vat = (bf16)f2bf(-kk_[tl] * eLm), vbt = (bf16)f2bf(kk_[tl] * a * ieL), vkt = (bf16)f2bf(kd * ieL), vrt = (bf16)f2bf(r_[tl] * eL);
                if (dir) { bf16* pk = (bf16*)PK + i * 64 + lane; pk[0] = vat; pk[4096] = vbt; pk[8192] = vkt; pk[12288] = vrt; }
                else { *(LAS bf16*)(L + IM_AT + i * PT + lane * 2) = vat; *(LAS bf16*)(L + IM_BT + i * PT + lane * 2) = vbt; *(LAS bf16*)(L + IM_KT + i * PT + lane * 2) = vkt; *(LAS bf16*)(L + IM_RT + i * PT + lane * 2) = vrt; } }
        }
#pragma unroll
        for (int t = 0; t < 16; ++t) RV[2 * 4096 + (16 * wg + t) * 64 + lane] = (bf16)f2bf(ks_[t]);
#pragma unroll 1
        for (int dir = 0; dir < 2; ++dir) {
            const int c = dir == 0 ? tb : (tb < TC / 64 ? TC / 64 - 1 - tb : TC / 64 + (T / 64 - 1 - (tb - TC / 64)));
            const size_t ci = ((size_t)((b * NH + hd) * 2 + dir)) * RCK + c;
            __syncthreads();
            if (dir) {
                const int tg = wg * 64 + lane;
                u32x4 pkv[4][2]; const float gcv = ((const float*)(PK + 32768))[lane];
#pragma unroll
                for (int im = 0; im < 4; ++im)
#pragma unroll
                    for (int rr = 0; rr < 2; ++rr) { const int idx = tg + 256 * rr, row = idx >> 3, ch = idx & 7; pkv[im][rr] = *(const u32x4*)(PK + im * 8192 + row * 128 + ch * 16); }
#pragma unroll
                for (int im = 0; im < 4; ++im)
#pragma unroll
                    for (int rr = 0; rr < 2; ++rr) { const int idx = tg + 256 * rr, row = idx >> 3, ch = idx & 7; const int dsto = im == 0 ? IM_AT : im == 1 ? IM_BT : im == 2 ? IM_KT : IM_RT;
                        *(LAS u32x4*)(L + dsto + row * PT + ch * 16) = pkv[im][rr]; }
                if (wg == 0) GC[lane] = gcv;
                __syncthreads();
            }
            f32x16 accP;
            { f32x16 aab = zero16v(), aak = zero16v(), arb = zero16v(); accP = zero16v();
#pragma unroll
              for (int s = 0; s < 4; ++s) { const bf16x8 at_i = frag_rows(L + IM_AT, ti, s, lane), bt_j = frag_rows(L + IM_BT, tj, s, lane), kt_j = frag_rows(L + IM_KT, ti, s, lane), at_c = frag_rows(L + IM_AT, tj, s, lane),
                                              bt_r = frag_rows(L + IM_BT, ti, s, lane), rt_c = frag_rows(L + IM_RT, tj, s, lane);
                  aab = MMA32(at_i, bt_j, aab); aak = MMA32(kt_j, at_c, aak); arb = MMA32(bt_r, rt_c, arb); accP = MMA32(kt_j, rt_c, accP); }
#pragma unroll
              for (int r = 0; r < 16; ++r) { const int row = 32 * ti + (r & 3) + 8 * (r >> 2) + 4 * h, col = 32 * tj + c32;
                  F[row * FP + col] = col < row ? aab[r] : 0.f; aak[r] = row < col ? aak[r] : 0.f; arb[r] = row <= col ? arb[r] : 0.f; accP[r] = row <= col ? accP[r] : 0.f; }
              store_T(aak, L + IM_AAK, ti, tj, lane);
              store_T(arb, L + IM_ARB, ti, tj, lane); }
            __syncthreads();
            { float Wc[64]; const int col = 32 * wg + c32; const LAS unsigned char* src = col < 64 ? L + IM_AT + col * 2 : L + IM_AAK + (col - 64) * 2;
              const LAS float* Fo = OPAQUE_LDS(F);
#pragma unroll
              for (int i = 0; i < 64; ++i) Wc[i] = bf2f(*(const LAS bf16*)(src + i * PT));
#pragma unroll
              for (int i = 1; i < 64; ++i) { float a0 = Wc[i], a1 = 0.f, a2 = 0.f, a3 = 0.f;
#pragma unroll
                  for (int j4 = 0; j4 < (i + 3) / 4; ++j4) { const f32x4 f = *(const LAS f32x4*)(Fo + i * FP + 4 * j4); a0 += f[0] * Wc[4 * j4]; a1 += f[1] * Wc[4 * j4 + 1]; a2 += f[2] * Wc[4 * j4 + 2]; a3 += f[3] * Wc[4 * j4 + 3];
                      if ((j4 & 7) == 7) PIN4(a0, a1, a2, a3); }
                  PIN4(a0, a1, a2, a3); Wc[i] = (a0 + a1) + (a2 + a3); }
              __syncthreads();
              if (h == 0) { LAS unsigned char* dst = (col < 64 ? L + IM_AT + col * PT : L + IM_AAK + (col - 64) * PT);
#pragma unroll
                  for (int i8 = 0; i8 < 8; ++i8) { u32x4 w; w.x = pk2(Wc[8 * i8], Wc[8 * i8 + 1]); w.y = pk2(Wc[8 * i8 + 2], Wc[8 * i8 + 3]); w.z = pk2(Wc[8 * i8 + 4], Wc[8 * i8 + 5]); w.w = pk2(Wc[8 * i8 + 6], Wc[8 * i8 + 7]); *(LAS u32x4*)(dst + i8 * 16) = w; } }
              bf16 vtmp[16];
#pragma unroll
              for (int ii = 0; ii < 16; ++ii) { const int tl = dir ? 15 - ii : ii; vtmp[ii] = RV[4096 + (16 * wg + tl) * 64 + lane]; }
#pragma unroll
              for (int ii = 0; ii < 16; ++ii) { const int i = 16 * (dir ? 3 - wg : wg) + ii; *(LAS bf16*)(L + IM_F + i * PT + lane * 2) = vtmp[ii]; }
            }
            __syncthreads();
            { f32x16 q;
#pragma unroll
              for (int g = 0; g < 4; ++g) { const u32x2 w = *(const LAS u32x2*)(L + IM_RT + (32 * tj + c32) * PT + (32 * ti + 8 * g + 4 * h) * 2); q[4 * g] = bflo(w.x); q[4 * g + 1] = bfhi(w.x); q[4 * g + 2] = bflo(w.y); q[4 * g + 3] = bfhi(w.y); }
#pragma unroll
              for (int s = 0; s < 4; ++s) { const bf16x8 arb = frag_rows(L + IM_ARB, tj, s, lane); q = MMA32(frag_rows(L + IM_AT, ti, s, lane), arb, q); accP = MMA32(frag_rows(L + IM_AAK, ti, s, lane), arb, accP); }
              if (live) {
#pragma unroll
                  for (int g = 0; g < 4; ++g) { u32x2 w; w.x = pk2(q[4 * g], q[4 * g + 1]); w.y = pk2(q[4 * g + 2], q[4 * g + 3]); *(u32x2*)(QH + ci * 4096 + (32 * tj + c32) * 64 + 32 * ti + 8 * g + 4 * h) = w; } }
            }
            __syncthreads();
            store_T(accP, L + IM_RT, ti, tj, lane);
            __syncthreads();
            { f32x16 y = zero16v(), m = zero16v(), n;
#pragma unroll
              for (int g = 0; g < 4; ++g) { const u32x2 w = *(const LAS u32x2*)(L + IM_KT + (32 * tj + c32) * PT + (32 * ti + 8 * g + 4 * h) * 2); n[4 * g] = bflo(w.x); n[4 * g + 1] = bfhi(w.x); n[4 * g + 2] = bflo(w.y); n[4 * g + 3] = bfhi(w.y); }
              bf16x8 btj[4], bti[4], vfj[4]; frag_cols4(L + IM_BT, tj, lane, btj); frag_cols4(L + IM_BT, ti, lane, bti); frag_cols4(L + IM_F, tj, lane, vfj);
#pragma unroll
              for (int s = 0; s < 4; ++s) { const bf16x8 btc_j = btj[s], btc_i = bti[s];
                  y = MMA32(frag_rows(L + IM_RT, ti, s, lane), vfj[s], y);
                  m = MMA32(frag_rows(L + IM_AT, ti, s, lane), btc_j, m);
                  n = MMA32(btc_i, frag_rows(L + IM_AAK, tj, s, lane), n); }
              const float gck = GC[32 * tj + c32];
#pragma unroll
              for (int r = 0; r < 16; ++r) { const int row = 32 * ti + (r & 3) + 8 * (r >> 2) + 4 * h, col = 32 * tj + c32; m[r] = (m[r] + (row == col ? 1.0f : 0.f)) * gck; n[r] *= GC[row]; }
              if (live) {
#pragma unroll
                  for (int g = 0; g < 4; ++g) *(f32x4*)(YL + ci * 4096 + ((wg * 4 + g) * 64 + lane) * 4) = (f32x4){y[4 * g], y[4 * g + 1], y[4 * g + 2], y[4 * g + 3]};
#pragma unroll
                  for (int s2 = 0; s2 < 2; ++s2) *(bf16x8*)(MF + ci * 4096 + ((wg * 2 + s2) * 64 + lane) * 8) = pack8(m, s2); }
              store_T(n, L + IM_ARB, ti, tj, lane);
            }
            __syncthreads();
            { f32x16 gacc = zero16v(); bf16x8 nfi[4], vfj[4]; frag_cols4(L + IM_ARB, ti, lane, nfi); frag_cols4(L + IM_F, tj, lane, vfj);
#pragma unroll
              for (int s = 0; s < 4; ++s) gacc = MMA32(nfi[s], vfj[s], gacc);
              if (live) {
#pragma unroll
                  for (int hf = 0; hf < 2; ++hf) { u32x4 w; w.x = pk2(gacc[8 * hf], gacc[8 * hf + 1]); w.y = pk2(gacc[8 * hf + 2], gacc[8 * hf + 3]); w.z = pk2(gacc[8 * hf + 4], gacc[8 * hf + 5]); w.w = pk2(gacc[8 * hf + 6], gacc[8 * hf + 7]);
                      *(u32x4*)((unsigned*)GF + ci * 2048 + ((wg * 2 + hf) * 64 + lane) * 4) = w; } }
            }
        }
    }
    __syncthreads();
}
struct R2Buf { bf16x8 mf[8]; u32x4 g[4]; };
DI void rw2_load(R2Buf& b, const bf16* MF, const unsigned* GFu, size_t item, int tj, int lane) {
#pragma unroll
    for (int q = 0; q < 8; ++q) b.mf[q] = *(const bf16x8*)(MF + item * 4096 + (q * 64 + lane) * 8);
#pragma unroll
    for (int kt = 0; kt < 2; ++kt)
#pragma unroll
        for (int hf = 0; hf < 2; ++hf) b.g[kt * 2 + hf] = *(const u32x4*)(GFu + item * 2048 + (((kt * 2 + tj) * 2 + hf) * 64 + lane) * 4);
}
DI void rw2_step(const R2Buf& b, f32x16& s0, f32x16& s1, bf16* SF, size_t item, int tj, int lane) {
    bf16x8 sf[2][2];
#pragma unroll
    for (int s = 0; s < 2; ++s) { sf[0][s] = pack8(s0, s); sf[1][s] = pack8(s1, s); *(bf16x8*)(SF + item * 4096 + (((0 * 2 + tj) * 2 + s) * 64 + lane) * 8) = sf[0][s]; *(bf16x8*)(SF + item * 4096 + (((1 * 2 + tj) * 2 + s) * 64 + lane) * 8) = sf[1][s]; }
    f32x16 n0, n1;
#pragma unroll
    for (int hf = 0; hf < 2; ++hf) { const u32x4 a = b.g[hf], c = b.g[2 + hf];
        n0[8 * hf] = bflo(a.x); n0[8 * hf + 1] = bfhi(a.x); n0[8 * hf + 2] = bflo(a.y); n0[8 * hf + 3] = bfhi(a.y); n0[8 * hf + 4] = bflo(a.z); n0[8 * hf + 5] = bfhi(a.z); n0[8 * hf + 6] = bflo(a.w); n0[8 * hf + 7] = bfhi(a.w);
        n1[8 * hf] = bflo(c.x); n1[8 * hf + 1] = bfhi(c.x); n1[8 * hf + 2] = bflo(c.y); n1[8 * hf + 3] = bfhi(c.y); n1[8 * hf + 4] = bflo(c.z); n1[8 * hf + 5] = bfhi(c.z); n1[8 * hf + 6] = bflo(c.w); n1[8 * hf + 7] = bfhi(c.w); }
#pragma unroll
    for (int kp = 0; kp < 2; ++kp)
#pragma unroll
        for (int s = 0; s < 2; ++s) { n0 = MMA32(b.mf[(kp * 2 + 0) * 2 + s], sf[kp][s], n0); n1 = MMA32(b.mf[(kp * 2 + 1) * 2 + s], sf[kp][s], n1); }
    s0 = n0; s1 = n1;
}
DI void ph_rw2(const Ctx& C) {
    const int lane = C.lane;
    const bf16* MF = (const bf16*)(C.ws + WS_MF); const unsigned* GFu = (const unsigned*)(C.ws + WS_GF); bf16* SF = (bf16*)(C.ws + WS_SF);
    const int nwork = RSTR * 2;
    for (int wk = C.wave == 0 ? C.bid : nwork; wk < nwork; wk += C.G) {
        const int tj = wk & 1, stream = wk >> 1; const size_t it0 = (size_t)stream * RCK;
        f32x16 s0 = zero16v(), s1 = zero16v();
        R2Buf A, B, Cb;
        rw2_load(A, MF, GFu, it0, tj, lane); rw2_load(B, MF, GFu, it0 + (1 < RCK ? 1 : 0), tj, lane); rw2_load(Cb, MF, GFu, it0 + (2 < RCK ? 2 : 0), tj, lane);
        for (int c = 0; c < RCK; c += 3) {
            rw2_step(A, s0, s1, SF, it0 + c, tj, lane); rw2_load(A, MF, GFu, it0 + (c + 3 < RCK ? c + 3 : RCK - 1), tj, lane);
            if (c + 1 < RCK) { rw2_step(B, s0, s1, SF, it0 + c + 1, tj, lane); rw2_load(B, MF, GFu, it0 + (c + 4 < RCK ? c + 4 : RCK - 1), tj, lane); }
            if (c + 2 < RCK) { rw2_step(Cb, s0, s1, SF, it0 + c + 2, tj, lane); rw2_load(Cb, MF, GFu, it0 + (c + 5 < RCK ? c + 5 : RCK - 1), tj, lane); }
        }
    }
}
DI void ph_rw3(const Ctx& C, int l, int mrows) {
    const int lane = C.lane, wg = C.wave & 3, grp = C.wave >> 2, ti = wg >> 1, tj = wg & 1, c32 = lane & 31, h = lane >> 5;
    LAS float* Ysum = (LAS float*)(C.lds + grp * RW_HALF);
    const bf16* QH = (const bf16*)(C.ws + WS_QH); const float* YL = (const float*)(C.ws + WS_YL); const bf16* SF = (const bf16*)(C.ws + WS_SF); bf16* OB = (bf16*)(C.ws + WS_OB);
    const int nblk = (TC + T) / 64, nitems = NB * NH * nblk;
    for (int it0 = 2 * C.bid; it0 < nitems; it0 += 2 * C.G) {
        const int item = it0 + grp; const bool live = item < nitems; const int itc = live ? item : nitems - 1;
        const int tb = itc % nblk, hd = (itc / nblk) % NH, b = itc / (nblk * NH);
        const int rowb = tb < TC / 64 ? M_LAT + b * TC + 64 * tb : b * T + 64 * (tb - TC / 64);
        __syncthreads();
        f32x4 yl[2][4]; u32x4 qa[2][4]; bf16x8 sb[2][4];
#pragma unroll
        for (int dir = 0; dir < 2; ++dir) {
            const int c = dir == 0 ? tb : (tb < TC / 64 ? TC / 64 - 1 - tb : TC / 64 + (T / 64 - 1 - (tb - TC / 64)));
            const size_t ci = ((size_t)((b * NH + hd) * 2 + dir)) * RCK + c;
#pragma unroll
            for (int g = 0; g < 4; ++g) yl[dir][g] = *(const f32x4*)(YL + ci * 4096 + ((wg * 4 + g) * 64 + lane) * 4);
#pragma unroll
            for (int kp = 0; kp < 2; ++kp)
#pragma unroll
                for (int s = 0; s < 2; ++s) { const bf16* qp = QH + ci * 4096 + (32 * ti + c32) * 64 + 32 * kp + 16 * s + 4 * h; const u32x2 lo = *(const u32x2*)qp, hi = *(const u32x2*)(qp + 8);
                    qa[dir][kp * 2 + s].x = lo.x; qa[dir][kp * 2 + s].y = lo.y; qa[dir][kp * 2 + s].z = hi.x; qa[dir][kp * 2 + s].w = hi.y;
                    sb[dir][kp * 2 + s] = *(const bf16x8*)(SF + ci * 4096 + (((kp * 2 + tj) * 2 + s) * 64 + lane) * 8); }
        }
#pragma unroll
        for (int dir = 0; dir < 2; ++dir) {
            f32x16 y;
#pragma unroll
            for (int g = 0; g < 4; ++g) { const f32x4 a = yl[dir][g]; y[4 * g] = a[0]; y[4 * g + 1] = a[1]; y[4 * g + 2] = a[2]; y[4 * g + 3] = a[3]; }
#pragma unroll
            for (int q4 = 0; q4 < 4; ++q4) y = MMA32(__builtin_bit_cast(bf16x8, qa[dir][q4]), sb[dir][q4], y);
#pragma unroll
            for (int r = 0; r < 16; ++r) { const int i = 32 * ti + (r & 3) + 8 * (r >> 2) + 4 * h, tk = dir ? 63 - i : i; LAS float* p = Ysum + tk * FP + 32 * tj + c32; if (dir == 0) *p = y[r]; else *p += y[r]; }
            __syncthreads();
        }
        if (live) {
            const int cch = hd * 64 + lane; const float rk = C.in[I_RWRK][((size_t)l * NH + hd) * 64 + lane], gw = C.in[I_RWGNW][(size_t)l * GW + cch], gb = C.in[I_RWGNB][(size_t)l * GW + cch];
#pragma unroll 1
            for (int t4 = 0; t4 < 16; t4 += 8) {
                bf16 rb[8], vb[8], kb[8], gb8[8];
#pragma unroll
                for (int u = 0; u < 8; ++u) { const bf16* rv = (const bf16*)(C.ws + WS_RVKG) + (size_t)item * 4 * 4096 + (16 * wg + t4 + u) * 64 + lane; rb[u] = rv[0]; vb[u] = rv[4096]; kb[u] = rv[8192]; gb8[u] = rv[12288]; }
#pragma unroll
                for (int u = 0; u < 8; ++u) { const int tk = 16 * wg + t4 + u, row = rowb + tk; const float r = bf2f(rb[u]), v = bf2f(vb[u]), ks = bf2f(kb[u]), gg = bf2f(gb8[u]);
                    float y = Ysum[tk * FP + lane] + wave_sum(r * ks * rk) * v;
                    const float mu = wave_sum(y) * (1.f / 64.f), dlt = y - mu, var = wave_sum(dlt * dlt) * (1.f / 64.f);
                    if (row < mrows) OB[(size_t)row * D + GW + cch] = (bf16)f2bf((dlt * __builtin_amdgcn_rsqf(var + RW_GN_EPS) * gw + gb) * gg); } }
        }
    }
    __syncthreads();
}
constexpr int S5X_OFF = NW * 16640;
DI void ph_s5scan(const Ctx& C, int l, int first_block, int nblocks) {
    constexpr int nc_ctx = TC / S5L, nc_lat = T / S5L, ntot = nc_ctx + nc_lat, SEG = ntot / NW;
    static_assert(ntot % NW == 0 && S5X_OFF + NW * 64 * 8 <= MISC_OFF, "S5 scan segmentation");
    if ((int)C.bid < first_block || (int)C.bid >= first_block + nblocks) return;
    const float* XE = (const float*)(C.ws + WS_XEND); bf16* UG = (bf16*)(C.ws + WS_UG);
    const f32x2* LAM = (const f32x2*)(C.ws + WS_S5T + (size_t)l * SZ_S5L + OFF_S5LAM);
    LAS f32x2* XCH = (LAS f32x2*)(C.lds + S5X_OFF);
    for (int combo = C.bid - first_block; combo < NB * 2 * S5G; combo += nblocks) {
        const int g = combo % S5G, dir = (combo / S5G) & 1, b = combo / (2 * S5G), n = C.lane, seg = C.wave;
        const f32x2 lm = LAM[(dir * S5G + g) * 64 + n];
        float er[SEG], ei[SEG];
#pragma unroll
        for (int u = 0; u < SEG; ++u) { const int i = seg * SEG + u; const int ch = i < nc_ctx ? (M_LAT + b * TC) / S5L + (dir ? nc_ctx - 1 - i : i) : (b * T) / S5L + (dir ? nc_lat - 1 - (i - nc_ctx) : (i - nc_ctx));
            const float* p = XE + ((size_t)g * NCHP + ch) * 256 + dir * 128 + n; er[u] = p[0]; ei[u] = p[64]; }
        float pr = lm[0], pi = lm[1];
#pragma unroll 1
        for (int u = 1; u < SEG; ++u) { const float tr = pr * lm[0] - pi * lm[1], ti2 = pr * lm[1] + pi * lm[0]; pr = tr; pi = ti2; }
        float xr = 0.f, xi = 0.f;
#pragma unroll
        for (int u = 0; u < SEG; ++u) { const float nr = lm[0] * xr - lm[1] * xi + er[u], ni = lm[0] * xi + lm[1] * xr + ei[u]; xr = nr; xi = ni; }
        XCH[seg * 64 + n] = (f32x2){xr, xi};
        __syncthreads();
        xr = 0.f; xi = 0.f;
        for (int s2 = 0; s2 < seg; ++s2) { const f32x2 e = XCH[s2 * 64 + n]; const float nr = pr * xr - pi * xi + e[0], ni = pr * xi + pi * xr + e[1]; xr = nr; xi = ni; }
        __syncthreads();
#pragma unroll
        for (int u = 0; u < SEG; ++u) { const int i = seg * SEG + u; const int ch = i < nc_ctx ? (M_LAT + b * TC) / S5L + (dir ? nc_ctx - 1 - i : i) : (b * T) / S5L + (dir ? nc_lat - 1 - (i - nc_ctx) : (i - nc_ctx));
            bf16* q = UG + ((size_t)g * NCHP + ch) * S5K + 512 + dir * 128 + n; q[0] = (bf16)f2bf(xr); q[64] = (bf16)f2bf(xi);
            const float nr = lm[0] * xr - lm[1] * xi + er[u], ni = lm[0] * xi + lm[1] * xr + ei[u]; xr = nr; xi = ni; }
    }
}

constexpr int PH_PRO = 3, PH_PER_L = 13, NPH = PH_PRO + PH_PER_L * NL;
#ifndef PROBE_REP
#define PROBE_REP -1
#endif
#define NREP(k) ((k) == PROBE_REP ? 2 : 1)
#ifdef ONLY
#define EN(k) ((k) == ONLY)
#else
#define EN(k) true
#endif
#ifdef EMU
void fwd(Args args) {
    unsigned char* lds = emu::lds_base();
#else
__global__ void __launch_bounds__(NTHR, 2) fwd(Args args) {
    extern __shared__ __attribute__((aligned(16))) unsigned char lds[];
#endif
    Ctx C; C.in = args.in; C.out = args.out; C.ws = args.ws; C.lds = (LAS unsigned char*)lds;
    C.tid = threadIdx.x; C.lane = C.tid & 63; C.wave = __builtin_amdgcn_readfirstlane(C.tid >> 6); C.G = gridDim.x; C.bid = blockIdx.x;
#define REFRESH() do { int t_ = threadIdx.x; OPAQUE(t_); C.tid = t_; C.lane = t_ & 63; C.wave = __builtin_amdgcn_readfirstlane(t_ >> 6); } while (0)
    volatile LAS unsigned* MISC = (volatile LAS unsigned*)(C.lds + MISC_OFF);
    if (C.tid < 32) MISC[C.tid] = 0u;
    __syncthreads();
    const int lo = args.ph_lo, hi = args.ph_hi;
    const bool use_bar = (hi - lo) > 1;
    XcdBarrier bar; bar.bar = (unsigned*)(C.ws + WS_CTL) + CW_BAR; bar.x = 0; bar.st = MISC + 8;
    if (use_bar) bar = xcd_barrier_post((unsigned*)(C.ws + WS_CTL) + CW_BAR, MISC + 8);
#define IN(k) (lo <= (k) && (k) < hi)
#define SEAM(k) do { if (IN(k) && IN((k) + 1)) xcd_barrier(bar); } while (0)
    if (EN(0) && IN(0)) for (int rep = 0; rep < NREP(0); ++rep) { REFRESH(); ph_ada(C); }
    SEAM(0);
    if (EN(1) && IN(1)) { REFRESH(); ph_conv(C); }
    SEAM(1);
    if (EN(2) && IN(2)) for (int rep = 0; rep < NREP(2); ++rep) { REFRESH(); ph_tab(C); }
    SEAM(2);
    for (int l = 0; l < NL; ++l) {
        const int pb = PH_PRO + PH_PER_L * l; const bool want_ctx = l < NL - 1;
        const int mrows_full = M, mrows_out = want_ctx ? M : M_LAT;
        const int nt_attn = AT_NA + AT_WA + (want_ctx ? 2 * AT_CX : 0), nt_attn_a = (int)((long)nt_attn * ATTN_A_PCT / 100);
        bf16* AP = (bf16*)(C.ws + WS_AP); bf16* Hb = (bf16*)(C.ws + WS_H); bf16* OB = (bf16*)(C.ws + WS_OB);
        if (EN(3) && IN(pb + 0)) for (int rep = 0; rep < NREP(3); ++rep) { REFRESH();
            Gemm g{AP, wl(C, l, OFF_W1GU), D, D, D, 0, 0}; Order S; S.init(mrows_full / 256, 2 * FF / 256, 1, C.G, C.bid, D / 64);
            EpiGU E{rowss_ptr(C, l, 0), bias_ptr(C, l, 0), Hb, mrows_full}; gemm_phase(C.lds, g, S, E);
            if (EN(1) && l + 1 < NL) { REFRESH(); const int r = S.total % C.G;
                if ((int)C.bid >= r) conv_weights(C, l + 1, (C.bid - r) * NW + C.wave, (C.G - r) * NW, 0, CI_X1); } }
        SEAM(pb + 0);
        if (EN(4) && IN(pb + 1)) { REFRESH();
            Gemm g{Hb, wl(C, l, OFF_W1D), FF, FF, FF, 0, 0}; Order S; S.init(M_LAT / 256, D / 256, 1, C.G, C.bid, FF / 64);
            EpiRes E{&C, gate_ptr(C, l, 0, 0), gs_ptr(C, l, 1, 0), rowss_ptr(C, l, 1), AP}; gemm_phase(C.lds, g, S, E);
            { REFRESH(); Order S2; S2.init_split(M_LAT / 256, M_CTX / 256, D / 256, 4, C.G, C.bid, FF / 64); EpiAcc E2{&C, gate_ptr(C, l, 0, 0)}; gemm_phase(C.lds, g, S2, E2); } }
        SEAM(pb + 1);
        if (EN(18) && IN(pb + 2)) { REFRESH(); ph_ctxfix(C, gs_ptr(C, l, 1, 0), rowss_ptr(C, l, 1)); }
        SEAM(pb + 2);
        if (EN(5) && IN(pb + 3)) for (int rep = 0; rep < NREP(5); ++rep) { REFRESH();
            Gemm g{AP, wl(C, l, OFF_WIN), D, D, D, 0, 0}; Order S; S.init(mrows_full / 256, NT_IN, 1, C.G, C.bid, D / 64);
            EpiIn E{&C, rowss_ptr(C, l, 1), bias_ptr(C, l, 1), l}; gemm_phase(C.lds, g, S, E); }
        SEAM(pb + 3);
        if (IN(pb + 4)) {
            if (EN(6)) for (int rep = 0; rep < NREP(6); ++rep) { REFRESH(); Gemm g{(const bf16*)(C.ws + WS_UG), (const bf16*)(C.ws + WS_S5T + (size_t)l * SZ_S5L + OFF_S5ET), S5K, 512, 512, (size_t)NCHP * S5K * 2, (size_t)256 * 512 * 2};
              const int off5 = C.G >= 256 ? 32 : 0; Order S; S.init(NCHP / 256, 1, S5G, C.G - off5, (int)C.bid < off5 ? (1 << 28) : (int)C.bid - off5, 512 / 64);        EpiS5A E{(float*)(C.ws + WS_XEND)}; gemm_phase(C.lds, g, S, E); }
            __syncthreads();
            for (int rep = 0; rep < NREP(9); ++rep) { if (EN(9)) { REFRESH(); ph_rw1(C, l); } }
            if (EN(7)) for (int rep = 0; rep < NREP(7); ++rep) { REFRESH(); const int fb = (C.G >= 256 && 2 * C.G < RBLK && RBLK % (2 * C.G) != 0) ? (RBLK % (2 * C.G) + 1) / 2 : 0;
                ph_attn(C, l, want_ctx, C.bid >= fb ? (C.bid - fb) * NW + C.wave : -1, (C.G - fb) * NW, 0, nt_attn_a); }
        }
        SEAM(pb + 4);
        if (IN(pb + 5)) {
            if (EN(17)) for (int rep = 0; rep < NREP(17); ++rep) { REFRESH(); ph_rw2(C); }
            if (EN(10)) for (int rep = 0; rep < NREP(10); ++rep) { REFRESH(); ph_s5scan(C, l, C.G >= 256 ? 64 : 0, C.G >= 256 ? 128 : C.G); }
            { REFRESH();
              const int nrb = C.G < RSTR * 2 ? C.G : RSTR * 2, sb_lo = C.G, sb_hi = C.G;
              const int nworkers = nrb * 7 + (C.G - nrb - (sb_hi - sb_lo)) * NW;
              const int widx = C.bid < nrb ? (C.wave == 0 ? -1 : C.bid * 7 + C.wave - 1) : (C.bid >= sb_lo && C.bid < sb_hi) ? -1 : nrb * 7 + (C.bid - nrb - (C.bid >= sb_hi ? sb_hi - sb_lo : 0)) * NW + C.wave;
              if (EN(7)) ph_attn(C, l, want_ctx, widx, nworkers, nt_attn_a, nt_attn); }
        }
        SEAM(pb + 5);
        if (IN(pb + 6)) {
            if (EN(11)) for (int rep = 0; rep < NREP(11); ++rep) { REFRESH(); Gemm g{(const bf16*)(C.ws + WS_UG), (const bf16*)(C.ws + WS_S5T + (size_t)l * SZ_S5L + OFF_S5BT), S5K, S5K, S5K, (size_t)NCHP * S5K * 2, (size_t)512 * S5K * 2};
              const int off5 = C.G >= 256 ? 64 : 0; Order S; S.init(NCHP / 256, 2, S5G, C.G - off5, (int)C.bid < off5 ? (1 << 28) : (int)C.bid - off5, S5K / 64);        EpiS5C E{(const bf16*)(C.ws + WS_UG), C.in[I_S5D] + (size_t)l * GW, (bf16*)(C.ws + WS_YG)}; gemm_phase(C.lds, g, S, E); }
            if (EN(12)) for (int rep = 0; rep < NREP(12); ++rep) { REFRESH(); ph_rw3(C, l, mrows_out); }
        }
        SEAM(pb + 6);
        if (EN(13) && IN(pb + 7)) for (int rep = 0; rep < NREP(13); ++rep) { REFRESH();
            Gemm g{(const bf16*)(C.ws + WS_YG), wl(C, l, OFF_WGLU), GW, GW, GW, 0, 0}; Order S; S.init(mrows_out / 256, GW / 256, 1, C.G, C.bid, GW / 64);
            EpiGLU E{(const bf16*)(C.ws + WS_YG), C.in[I_S5GLUB] + (size_t)l * GW, OB}; gemm_phase(C.lds, g, S, E); }
        SEAM(pb + 7);
        if (EN(14) && IN(pb + 8)) { REFRESH();
            Gemm g{OB, wl(C, l, OFF_WOUT), D, D, D, 0, 0}; Order S; S.init(M_LAT / 256, D / 256, 1, C.G, C.bid, D / 64);
            EpiRes E{&C, gate_ptr(C, l, 1, 0), gs_ptr(C, l, 2, 0), rowss_ptr(C, l, 2), AP}; gemm_phase(C.lds, g, S, E);
            if (want_ctx) { REFRESH(); Order S2; S2.init_split(M_LAT / 256, M_CTX / 256, D / 256, 4, C.G, C.bid, D / 64); EpiAcc E2{&C, gate_ptr(C, l, 1, 0)}; gemm_phase(C.lds, g, S2, E2); } }
        SEAM(pb + 8);
        if (EN(18) && IN(pb + 9) && want_ctx) { REFRESH(); ph_ctxfix(C, gs_ptr(C, l, 2, 0), rowss_ptr(C, l, 2)); }
        SEAM(pb + 9);
        if (EN(15) && IN(pb + 10)) { REFRESH();
            Gemm g{AP, wl(C, l, OFF_W2GU), D, D, D, 0, 0}; Order S; S.init(mrows_out / 256, 2 * FF / 256, 1, C.G, C.bid, D / 64);
            EpiGU E{rowss_ptr(C, l, 2), bias_ptr(C, l, 2), Hb, mrows_out}; gemm_phase(C.lds, g, S, E);
            if (EN(1) && l + 1 < NL) { REFRESH(); const int r = S.total % C.G;
                if ((int)C.bid >= r) conv_weights(C, l + 1, (C.bid - r) * NW + C.wave, (C.G - r) * NW, CI_X1, CI_LAYER); } }
        SEAM(pb + 10);
        if (EN(16) && IN(pb + 11)) { REFRESH();
            Gemm g{Hb, wl(C, l, OFF_W2D), FF, FF, FF, 0, 0}; Order S; S.init(M_LAT / 256, D / 256, 1, C.G, C.bid, FF / 64);
            const bool more = l + 1 < NL;
            EpiRes E{&C, gate_ptr(C, l, 2, 0), more ? gs_ptr(C, l + 1, 0, 0) : nullptr, more ? rowss_ptr(C, l + 1, 0) : nullptr, AP}; gemm_phase(C.lds, g, S, E);
            if (want_ctx) { REFRESH(); Order S2; S2.init_split(M_LAT / 256, M_CTX / 256, D / 256, 4, C.G, C.bid, FF / 64); EpiAcc E2{&C, gate_ptr(C, l, 2, 0)}; gemm_phase(C.lds, g, S2, E2); } }
        SEAM(pb + 11);
        if (EN(18) && IN(pb + 12) && want_ctx) { REFRESH(); ph_ctxfix(C, gs_ptr(C, l + 1, 0, 0), rowss_ptr(C, l + 1, 0)); }
        SEAM(pb + 12);
    }
#undef IN
#undef SEAM
}

#ifndef MK_PER_PHASE
#define MK_PER_PHASE 0
#endif
#ifdef EMU
int g_emu_grid = 4, g_emu_lo = 0, g_emu_hi = NPH;
#endif
extern "C" void kernel_launch(void* const* d_in, const int* in_sizes, int n_in, void* d_out, int out_size, void* d_ws, size_t ws_size, hipStream_t stream) {
    Args a{};
    for (int i = 0; i < 42; ++i) a.in[i] = (const float*)d_in[i];
    a.out = (float*)d_out; a.ws = (unsigned char*)d_ws;
#ifdef EMU
    if (g_emu_lo == 0) hipMemsetAsync(d_ws, 0, WS_ZERO_END, stream);
    for (int ph = g_emu_lo; ph < g_emu_hi; ++ph) { a.ph_lo = ph; a.ph_hi = ph + 1; fprintf(stderr, "phase %d\n", ph); emu::launch(g_emu_grid, NTHR, LDS_BYTES, [=] { fwd(a); }); }
#else
    static int grid = 0;
    if (grid == 0) {
        if (n_in != 42 || out_size != M_LAT * D || ws_size < WS_END) { fprintf(stderr, "kernel_launch: unexpected shapes (n_in %d out %d ws %zu need %zu)\n", n_in, out_size, ws_size, (size_t)WS_END); grid = -1; return; }
        int dev = 0, cus = 0;
        if (hipGetDevice(&dev) != hipSuccess || hipDeviceGetAttribute(&cus, hipDeviceAttributeMultiprocessorCount, dev) != hipSuccess) { grid = -1; return; }
        if (hipFuncSetAttribute((const void*)fwd, hipFuncAttributeMaxDynamicSharedMemorySize, LDS_BYTES) != hipSuccess) { fprintf(stderr, "kernel_launch: hipFuncSetAttribute failed\n"); grid = -1; return; }
        int per_cu = 0; (void)hipOccupancyMaxActiveBlocksPerMultiprocessor(&per_cu, (const void*)fwd, NTHR, LDS_BYTES); (void)hipGetLastError();
        if (per_cu < 1) fprintf(stderr, "kernel_launch: occupancy query reports %d\n", per_cu);
        grid = cus;
    }
    if (grid < 0) return;
    (void)hipMemsetAsync(d_ws, 0, WS_ZERO_END, stream);
#if MK_PER_PHASE
    for (int ph = 0; ph < NPH; ++ph) { a.ph_lo = ph; a.ph_hi = ph + 1; hipLaunchKernelGGL(fwd, dim3(grid), dim3(NTHR), LDS_BYTES, stream, a); }
#else
    a.ph_lo = 0; a.ph_hi = NPH;
    hipLaunchKernelGGL(fwd, dim3(grid), dim3(NTHR), LDS_BYTES, stream, a);
#endif
#endif
}
```
